# Optimizing an MI355X kernel written in HIP

```python
import math
import jax, jax.numpy as jnp
from jax import lax
import numpy as np

D_MODEL = 1024
BATCH = 1
SEQ = 16384
DEPTH = 1

D_MIX = D_MODEL
HEAD_DIM = 64
RET_WIDTH = D_MIX // 2
SB_WIDTH = D_MIX - RET_WIDTH
N_RET_HEADS = RET_WIDTH // HEAD_DIM
N_SB_HEADS = SB_WIDTH // HEAD_DIM
RET_CHUNK = 128
SB_BLOCK = 128
ROPE_BASE = 10000.0
IN_COLS = 4 * RET_WIDTH + 3 * SB_WIDTH
N_KEYS = 128
N_EXPERTS = N_KEYS * N_KEYS
PEER_HEADS = 8
PEER_TOPK = 16
PEER_QDIM = 256
PEER_HALF = PEER_QDIM // 2
PEER_BLOCK = 128
EPS = 1e-6

kernel_name = "hymba_retention_stickbreak_peer_adaln"


def rms_norm(x, gain):
    xf = x.astype(jnp.float32)
    y = xf * lax.rsqrt(jnp.mean(xf * xf, axis=-1, keepdims=True) + EPS)
    return (y * gain.astype(jnp.float32)).astype(x.dtype)


def rotary(x, positions):
    half = HEAD_DIM // 2
    inv_freq = ROPE_BASE ** (-jnp.arange(half, dtype=jnp.float32) / half)
    ang = positions.astype(jnp.float32)[..., None] * inv_freq
    cos = jnp.cos(ang)[:, :, None, :]
    sin = jnp.sin(ang)[:, :, None, :]
    x1 = x[..., :half].astype(jnp.float32)
    x2 = x[..., half:].astype(jnp.float32)
    out = jnp.concatenate([x1 * cos - x2 * sin, x2 * cos + x1 * sin], axis=-1)
    return out.astype(x.dtype)


def retention(q, k, v, positions):
    B, S, H, D = q.shape
    C = RET_CHUNK
    NC = S // C
    q = rotary(q, positions)
    k = rotary(k, positions) * (D ** -0.5)
    log_g = jnp.log1p(-(2.0 ** (-5.0 - jnp.arange(H, dtype=jnp.float32))))
    idx = jnp.arange(C, dtype=jnp.float32)
    rel = idx[:, None] - idx[None, :]
    decay_intra = jnp.where(rel >= 0, jnp.exp(log_g[:, None, None] * jnp.maximum(rel, 0.0)), 0.0)
    xi = jnp.exp(log_g[:, None] * (idx + 1.0))
    zeta = jnp.exp(log_g[:, None] * (C - 1.0 - idx))
    chunk_decay = jnp.exp(log_g * C)
    qc = q.reshape(B, NC, C, H, D)
    kc = k.reshape(B, NC, C, H, D)
    vc = v.reshape(B, NC, C, H, D)
    scores = jnp.einsum('bnihd,bnjhd->bnhij', qc, kc) * decay_intra
    y_intra = jnp.einsum('bnhij,bnjhd->bnihd', scores, vc)
    kv = jnp.einsum('bnjhd,hj,bnjhe->nbhde', kc, zeta, vc).astype(jnp.float32)

    def step(state, kv_i):
        return chunk_decay[None, :, None, None] * state + kv_i, state

    _, states = lax.scan(step, jnp.zeros((B, H, D, D), jnp.float32), kv)
    y_cross = jnp.einsum('bnihd,nbhde,hi->bnihe', qc, states, xi)
    return (y_intra + y_cross).reshape(B, S, H, D)


def head_group_norm(y, gain):
    B, S, H, D = y.shape
    yf = y.astype(jnp.float32)
    mu = jnp.mean(yf, axis=-1, keepdims=True)
    var = jnp.mean(jnp.square(yf - mu), axis=-1, keepdims=True)
    yn = (yf - mu) * lax.rsqrt(var + EPS)
    return yn.reshape(B, S, H * D) * gain.astype(jnp.float32)


def stick_breaking(q, k, v):
    B, S, H, D = q.shape
    NB = S // SB_BLOCK
    q_blocks = q.reshape(B, NB, SB_BLOCK, H, D).transpose(1, 0, 3, 2, 4)
    kt = k.transpose(0, 2, 1, 3)
    vt = v.transpose(0, 2, 1, 3)
    key_pos = jnp.arange(S)
    scale = D ** -0.5

    def block(args):
        qi, start = args
        z = jnp.einsum('bhqd,bhsd->bhqs', qi, kt).astype(jnp.float32) * scale
        q_pos = start + jnp.arange(SB_BLOCK)
        mask = key_pos[None, :] < q_pos[:, None]
        log_beta = jax.nn.log_sigmoid(z)
        log_stay = jnp.where(mask, log_beta - z, 0.0)
        log_w = log_beta + lax.cumsum(log_stay, axis=3, reverse=True) - log_stay
        w = jnp.where(mask, jnp.exp(log_w), 0.0)
        return jnp.einsum('bhqs,bhsd->bhqd', w.astype(vt.dtype), vt)

    starts = jnp.arange(NB) * SB_BLOCK
    out = lax.map(block, (q_blocks, starts))
    return out.transpose(1, 0, 3, 2, 4).reshape(B, S, H, D)


def peer(h, w_query, sub_keys, expert_down, expert_up):
    B, S, Dm = h.shape
    T = B * S
    K = PEER_TOPK
    ht = h.reshape(T, Dm)
    qry = (ht @ w_query).reshape(T, PEER_HEADS, 2, PEER_HALF)
    sub_scores = jnp.einsum('thpc,hpkc->thpk', qry, sub_keys).astype(jnp.float32)
    top_s, top_i = lax.top_k(sub_scores, K)
    cand_s = top_s[:, :, 0, :, None] + top_s[:, :, 1, None, :]
    cand_id = top_i[:, :, 0, :, None] * N_KEYS + top_i[:, :, 1, None, :]
    best_s, best_c = lax.top_k(cand_s.reshape(T, PEER_HEADS, K * K), K)
    expert_id = jnp.take_along_axis(cand_id.reshape(T, PEER_HEADS, K * K), best_c, axis=-1)
    gate = jax.nn.softmax(best_s, axis=-1)
    NBK = T // PEER_BLOCK
    ids = expert_id.reshape(NBK, PEER_BLOCK, PEER_HEADS * K)
    gates = gate.reshape(NBK, PEER_BLOCK, PEER_HEADS * K)
    xs = ht.reshape(NBK, PEER_BLOCK, Dm)

    def block(args):
        xb, ib, gb = args
        u = expert_down[ib]
        a = jnp.einsum('pd,ped->pe', xb, u).astype(jnp.float32)
        act = jax.nn.gelu(a, approximate=False) * gb
        v = expert_up[ib]
        return jnp.einsum('pe,ped->pd', act.astype(xb.dtype), v)

    y = lax.map(block, (xs, ids, gates))
    return y.reshape(B, S, Dm)


def setup_inputs(seed: int = 0) -> dict:
    key = jax.random.key(seed)
    ks = jax.random.split(key, 16)
    f32 = jnp.float32
    nrm = lambda k, shape, s: jax.random.normal(k, shape, f32) * s
    return {
        "x": nrm(ks[0], (BATCH, SEQ, D_MODEL), 1.0),
        "c": nrm(ks[1], (BATCH, D_MODEL), 1.0),
        "positions": jnp.broadcast_to(jnp.arange(SEQ, dtype=jnp.int32)[None, :], (BATCH, SEQ)),
        "ada_w": nrm(ks[2], (DEPTH, D_MODEL, 6 * D_MODEL), D_MODEL ** -0.5),
        "ada_b": nrm(ks[3], (DEPTH, 6 * D_MODEL), 0.1),
        "norm1_gain": 1.0 + nrm(ks[4], (DEPTH, D_MODEL), 0.1),
        "norm2_gain": 1.0 + nrm(ks[5], (DEPTH, D_MODEL), 0.1),
        "w_in": nrm(ks[6], (DEPTH, D_MODEL, IN_COLS), D_MODEL ** -0.5),
        "ret_norm_gain": 1.0 + nrm(ks[7], (DEPTH, RET_WIDTH), 0.1),
        "sb_q_gain": 1.0 + nrm(ks[8], (DEPTH, HEAD_DIM), 0.1),
        "sb_k_gain": 1.0 + nrm(ks[9], (DEPTH, HEAD_DIM), 0.1),
        "sb_out_gain": 1.0 + nrm(ks[10], (DEPTH, HEAD_DIM), 0.1),
        "w_out": nrm(ks[11], (DEPTH, D_MIX, D_MODEL), D_MIX ** -0.5),
        "peer_w_query": nrm(ks[12], (DEPTH, D_MODEL, PEER_HEADS * PEER_QDIM), D_MODEL ** -0.5),
        "peer_sub_keys": nrm(ks[13], (DEPTH, PEER_HEADS, 2, N_KEYS, PEER_HALF), PEER_HALF ** -0.5),
        "peer_down": nrm(ks[14], (DEPTH, N_EXPERTS, D_MODEL), D_MODEL ** -0.5),
        "peer_up": nrm(ks[15], (DEPTH, N_EXPERTS, D_MODEL), PEER_HEADS ** -0.5),
    }


def reference(x, c, positions, ada_w, ada_b, norm1_gain, norm2_gain, w_in, ret_norm_gain,
              sb_q_gain, sb_k_gain, sb_out_gain, w_out, peer_w_query, peer_sub_keys,
              peer_down, peer_up):
    B, S, _ = x.shape
    for layer in range(DEPTH):
        mod = jax.nn.silu(c) @ ada_w[layer] + ada_b[layer]
        shift1, scale1, gate1, shift2, scale2, gate2 = jnp.split(mod[:, None, :], 6, axis=-1)

        h = rms_norm(x, norm1_gain[layer]) * (1.0 + scale1) + shift1
        proj = h @ w_in[layer]
        r_q, r_k, r_v, r_g, s_q, s_k, s_v = jnp.split(
            proj, np.cumsum([RET_WIDTH] * 4 + [SB_WIDTH] * 2), axis=-1)
        heads_r = lambda t: t.reshape(B, S, N_RET_HEADS, HEAD_DIM)
        heads_s = lambda t: t.reshape(B, S, N_SB_HEADS, HEAD_DIM)

        y_ret = retention(heads_r(r_q), heads_r(r_k), heads_r(r_v), positions)
        y_ret = head_group_norm(y_ret, ret_norm_gain[layer]) * jax.nn.silu(r_g.astype(jnp.float32))

        q_sb = rms_norm(heads_s(s_q), sb_q_gain[layer])
        k_sb = rms_norm(heads_s(s_k), sb_k_gain[layer])
        y_sb = stick_breaking(q_sb, k_sb, heads_s(s_v))
        y_sb = rms_norm(y_sb, sb_out_gain[layer]).reshape(B, S, SB_WIDTH)

        mixed = jnp.concatenate([y_ret.astype(x.dtype), y_sb.astype(x.dtype)], axis=-1) @ w_out[layer]
        x = x + gate1 * mixed

        h2 = rms_norm(x, norm2_gain[layer]) * (1.0 + scale2) + shift2
        ffn = peer(h2, peer_w_query[layer], peer_sub_keys[layer], peer_down[layer], peer_up[layer])
        x = x + gate2 * ffn
    return x
```

```cpp
#include <hip/hip_runtime.h>
#include <stdint.h>
#include <math.h>

namespace {
constexpr int T = 16384, D = 1024, NH = 8, RW = 512;
constexpr float EPS = 1e-6f;
typedef unsigned short bf16_t;

__device__ __forceinline__ float bf2f(bf16_t b) { return __uint_as_float(((unsigned)b) << 16); }
__device__ __forceinline__ bf16_t f2bf(float f) { unsigned u = __float_as_uint(f); u += 0x7fffu + ((u >> 16) & 1u); return (bf16_t)(u >> 16); }

struct RopeC { double f[32]; };
struct RetC { float lg2[8]; };

constexpr size_t MiB = 1u << 20;
constexpr size_t OFF_MOD = 0, OFF_RINV1 = 64 * 1024, OFF_RINV2 = 128 * 1024, OFF_ROPE = 1 * MiB;
constexpr size_t OFF_P = 8 * MiB;
constexpr size_t OFF_KV = 120 * MiB, OFF_ST = 136 * MiB, OFF_YCAT = 152 * MiB, OFF_WEFF = 184 * MiB;
constexpr size_t OFF_IDS = 192 * MiB, OFF_GATES = 200 * MiB;
constexpr size_t OFF_SCORES = 8 * MiB;

__global__ __launch_bounds__(256) void k_mod(const float* __restrict__ c, const float* __restrict__ ada_w, const float* __restrict__ ada_b, float* __restrict__ mod) {
    __shared__ float red[42][24];
    const int u = blockIdx.x, tid = threadIdx.x, c4 = tid % 6, rg = tid / 6;
    float4 acc = {0.f, 0.f, 0.f, 0.f};
    if (rg < 42) {
        for (int r = rg; r < 1024; r += 42) {
            const float cv = c[r]; const float s = cv / (1.f + expf(-cv));
            const float4 w = *(const float4*)(ada_w + (size_t)r * 6144 + u * 24 + c4 * 4);
            acc.x += s * w.x; acc.y += s * w.y; acc.z += s * w.z; acc.w += s * w.w;
        }
        red[rg][c4 * 4 + 0] = acc.x; red[rg][c4 * 4 + 1] = acc.y; red[rg][c4 * 4 + 2] = acc.z; red[rg][c4 * 4 + 3] = acc.w;
    }
    __syncthreads();
    if (tid < 24) { float s = 0.f; for (int i = 0; i < 42; ++i) s += red[i][tid]; mod[u * 24 + tid] = s + ada_b[u * 24 + tid]; }
}

__global__ __launch_bounds__(256) void k_rowstat(const float* __restrict__ x, float* __restrict__ rinv) {
    const int row = blockIdx.x * 4 + (threadIdx.x >> 6), lane = threadIdx.x & 63;
    const float4* p = (const float4*)(x + (size_t)row * D);
    float s = 0.f;
#pragma unroll
    for (int j = 0; j < 4; ++j) { const float4 v = p[lane + 64 * j]; s += v.x * v.x + v.y * v.y + v.z * v.z + v.w * v.w; }
#pragma unroll
    for (int o = 32; o > 0; o >>= 1) s += __shfl_xor(s, o);
    if (lane == 0) rinv[row] = 1.0f / sqrtf(s * (1.0f / D) + EPS);
}

__global__ __launch_bounds__(256) void k_rope(const int* __restrict__ pos, float2* __restrict__ rope, RopeC rc) {
    const int idx = blockIdx.x * 256 + threadIdx.x, t = idx >> 5, i = idx & 31;
    double rev = (double)pos[t] * rc.f[i];
    rev -= floor(rev);
    const float r2 = (float)(2.0 * rev);
    float s, c; sincospif(r2, &s, &c);
    rope[idx] = make_float2(c, s);
}

struct ALoadNorm {
    const float* x; const float* rinv; const float* gain; const float* mscale; const float* mshift;
    __device__ __forceinline__ float operator()(int t, int i) const { return x[(size_t)t * D + i] * rinv[t] * gain[i] * (1.f + mscale[i]) + mshift[i]; }
};
struct ALoadBf16 {
    const bf16_t* a;
    __device__ __forceinline__ float operator()(int t, int i) const { return bf2f(a[(size_t)t * D + i]); }
};
struct EpiInproj {
    bf16_t* P; const float2* rope; const float* qg; const float* kg;
    __device__ __forceinline__ void operator()(float (*Cs)[65], int m0, int n0, int tid) const {
        const int type = n0 / 512, head = (n0 % 512) / 64, tl = tid >> 2, part = tid & 3, t = m0 + tl;
        bf16_t* out = P + (size_t)type * T * 512 + (size_t)t * 512 + head * 64;
        const float* row = Cs[tl];
        if (type <= 1) {
            const float sc = type == 1 ? 0.125f : 1.f;
            for (int q = 0; q < 8; ++q) { const int d = part * 8 + q; const float2 cs = rope[t * 32 + d]; const float x1 = row[d], x2 = row[d + 32];
                out[d] = f2bf((x1 * cs.x - x2 * cs.y) * sc); out[d + 32] = f2bf((x2 * cs.x + x1 * cs.y) * sc); }
        } else if (type == 2 || type == 6) {
            for (int q = 0; q < 16; ++q) { const int d = part * 16 + q; out[d] = f2bf(row[d]); }
        } else if (type == 3) {
            for (int q = 0; q < 16; ++q) { const int d = part * 16 + q; const float v = row[d]; out[d] = f2bf(v / (1.f + expf(-v))); }
        } else {
            float ss = 0.f; for (int d = 0; d < 64; ++d) ss += row[d] * row[d];
            const float r = 1.0f / sqrtf(ss * (1.f / 64.f) + EPS);
            const float* g = type == 4 ? qg : kg; const float sc = type == 4 ? 0.125f : 1.f;
            for (int q = 0; q < 16; ++q) { const int d = part * 16 + q; out[d] = f2bf(row[d] * r * g[d] * sc); }
        }
    }
};
struct EpiOutproj {
    const float* x; const float* gate1; float* x1;
    __device__ __forceinline__ void operator()(float (*Cs)[65], int m0, int n0, int tid) const {
        for (int e = tid; e < 4096; e += 256) { const int r = e >> 6, c = e & 63; const size_t o = (size_t)(m0 + r) * D + n0 + c; x1[o] = x[o] + gate1[n0 + c] * Cs[r][c]; }
    }
};
struct EpiStore {
    float* out; int ld;
    __device__ __forceinline__ void operator()(float (*Cs)[65], int m0, int n0, int tid) const {
        for (int e = tid; e < 4096; e += 256) { const int r = e >> 6, c = e & 63; out[(size_t)(m0 + r) * ld + n0 + c] = Cs[r][c]; }
    }
};
template <class AL, class Epi>
__global__ __launch_bounds__(256) void k_gemm(AL al, const float* __restrict__ B, int N, Epi epi) {
    __shared__ float As[16][68];
    __shared__ float Bs[16][68];
    __shared__ float Cs[64][65];
    const int tid = threadIdx.x, tx = tid & 15, ty = tid >> 4, m0 = blockIdx.y * 64, n0 = blockIdx.x * 64;
    float acc[4][4];
#pragma unroll
    for (int i = 0; i < 4; ++i)
#pragma unroll
        for (int j = 0; j < 4; ++j) acc[i][j] = 0.f;
    for (int k0 = 0; k0 < 1024; k0 += 16) {
#pragma unroll
        for (int i = 0; i < 4; ++i) { const int r = (tid >> 4) + 16 * i, c = tid & 15; As[c][r] = al(m0 + r, k0 + c); }
#pragma unroll
        for (int i = 0; i < 4; ++i) { const int r = (tid >> 6) + 4 * i, c = tid & 63; Bs[r][c] = B[(size_t)(k0 + r) * N + n0 + c]; }
        __syncthreads();
#pragma unroll
        for (int kk = 0; kk < 16; ++kk) {
            float a[4], b[4];
#pragma unroll
            for (int i = 0; i < 4; ++i) { a[i] = As[kk][ty * 4 + i]; b[i] = Bs[kk][tx * 4 + i]; }
#pragma unroll
            for (int i = 0; i < 4; ++i)
#pragma unroll
                for (int j = 0; j < 4; ++j) acc[i][j] += a[i] * b[j];
        }
        __syncthreads();
    }
#pragma unroll
    for (int i = 0; i < 4; ++i)
#pragma unroll
        for (int j = 0; j < 4; ++j) Cs[ty * 4 + i][tx * 4 + j] = acc[i][j];
    __syncthreads();
    epi(Cs, m0, n0, tid);
}

__global__ __launch_bounds__(256) void k_weff(const float* __restrict__ wq, const float* __restrict__ sk, float* __restrict__ weff) {
    const int idx = blockIdx.x * 256 + threadIdx.x, i = idx >> 11, n = idx & 2047, hp = n >> 7, k = n & 127;
    const float* a = wq + (size_t)i * 2048 + hp * 128; const float* b = sk + ((size_t)hp * 128 + k) * 128;
    float s = 0.f;
    for (int c = 0; c < 128; ++c) s += a[c] * b[c];
    weff[idx] = s;
}

__global__ __launch_bounds__(256) void k_ret_kv(const bf16_t* __restrict__ Kr, const bf16_t* __restrict__ Vr, float* __restrict__ kv, RetC rc) {
    __shared__ float ks[128][64];
    __shared__ float vs[128][64];
    const int n = blockIdx.x >> 3, h = blockIdx.x & 7, tid = threadIdx.x;
    for (int e = tid; e < 128 * 64; e += 256) { const int j = e >> 6, d = e & 63; const size_t g = (size_t)(n * 128 + j) * 512 + h * 64 + d;
        ks[j][d] = bf2f(Kr[g]) * exp2f((float)(127 - j) * rc.lg2[h]); vs[j][d] = bf2f(Vr[g]); }
    __syncthreads();
    const int d = tid >> 2, e0 = (tid & 3) * 16;
    float acc[16];
#pragma unroll
    for (int q = 0; q < 16; ++q) acc[q] = 0.f;
    for (int j = 0; j < 128; ++j) { const float kk = ks[j][d];
#pragma unroll
        for (int q = 0; q < 16; ++q) acc[q] += kk * vs[j][e0 + q]; }
#pragma unroll
    for (int q = 0; q < 16; ++q) kv[((size_t)(n * 8 + h) * 64 + d) * 64 + e0 + q] = acc[q];
}
__global__ __launch_bounds__(256) void k_ret_scan(const float* __restrict__ kv, float* __restrict__ st, RetC rc) {
    const int idx = blockIdx.x * 256 + threadIdx.x, h = idx >> 12;
    const float cd = exp2f(128.f * rc.lg2[h]);
    float s = 0.f;
    for (int n = 0; n < 128; ++n) { st[(size_t)n * 32768 + idx] = s; s = cd * s + kv[(size_t)n * 32768 + idx]; }
}
__global__ __launch_bounds__(128) void k_ret_out(const bf16_t* __restrict__ Qr, const bf16_t* __restrict__ Kr, const bf16_t* __restrict__ Vr, const bf16_t* __restrict__ Gr,
                                                 const float* __restrict__ st, const float* __restrict__ rgain, bf16_t* __restrict__ ycat, RetC rc) {
    __shared__ float ks[128][64];
    __shared__ float vs[128][64];
    __shared__ float ss[64][64];
    const int n = blockIdx.x >> 3, h = blockIdx.x & 7, i = threadIdx.x, t = n * 128 + i;
    for (int e = i; e < 128 * 64; e += 128) { const int j = e >> 6, d = e & 63; const size_t g = (size_t)(n * 128 + j) * 512 + h * 64 + d; ks[j][d] = bf2f(Kr[g]); vs[j][d] = bf2f(Vr[g]); }
    for (int e = i; e < 4096; e += 128) ss[e >> 6][e & 63] = st[(size_t)(n * 8 + h) * 4096 + e];
    float q[64], acc[64];
#pragma unroll
    for (int d = 0; d < 64; ++d) { q[d] = bf2f(Qr[(size_t)t * 512 + h * 64 + d]); acc[d] = 0.f; }
    __syncthreads();
    const float lg = rc.lg2[h];
    const float xi = exp2f((float)(i + 1) * lg);
#pragma unroll
    for (int d = 0; d < 64; ++d) { const float qd = q[d] * xi;
#pragma unroll
        for (int e = 0; e < 64; ++e) acc[e] += qd * ss[d][e]; }
    for (int j = 0; j <= i; ++j) {
        float s = 0.f;
#pragma unroll
        for (int d = 0; d < 64; ++d) s += q[d] * ks[j][d];
        s *= exp2f((float)(i - j) * lg);
#pragma unroll
        for (int e = 0; e < 64; ++e) acc[e] += s * vs[j][e];
    }
    float mean = 0.f;
#pragma unroll
    for (int e = 0; e < 64; ++e) mean += acc[e];
    mean *= (1.f / 64.f);
    float var = 0.f;
#pragma unroll
    for (int e = 0; e < 64; ++e) { const float dlt = acc[e] - mean; var += dlt * dlt; }
    const float r = 1.0f / sqrtf(var * (1.f / 64.f) + EPS);
#pragma unroll
    for (int e = 0; e < 64; ++e) ycat[(size_t)t * 1024 + h * 64 + e] = f2bf((acc[e] - mean) * r * rgain[h * 64 + e] * bf2f(Gr[(size_t)t * 512 + h * 64 + e]));
}

__global__ __launch_bounds__(64) void k_sb(const bf16_t* __restrict__ Qs, const bf16_t* __restrict__ Ks, const bf16_t* __restrict__ Vs, const float* __restrict__ og, bf16_t* __restrict__ ycat) {
    const int h = blockIdx.x & 7, t = (blockIdx.x >> 3) * 64 + threadIdx.x;
    float q[64], acc[64];
    {
        const uint4* qp = (const uint4*)(Qs + (size_t)t * 512 + h * 64);
#pragma unroll
        for (int c = 0; c < 8; ++c) { const uint4 u = qp[c]; const unsigned w[4] = {u.x, u.y, u.z, u.w};
#pragma unroll
            for (int k = 0; k < 4; ++k) { q[c * 8 + 2 * k] = __uint_as_float(w[k] << 16); q[c * 8 + 2 * k + 1] = __uint_as_float(w[k] & 0xffff0000u); } }
    }
#pragma unroll
    for (int d = 0; d < 64; ++d) acc[d] = 0.f;
    float R = 0.f;
    for (int s = t - 1; s >= 0; --s) {
        if (R > 88.f) break;
        const uint4* kp = (const uint4*)(Ks + (size_t)s * 512 + h * 64);
        float z = 0.f;
#pragma unroll
        for (int c = 0; c < 8; ++c) { const uint4 u = kp[c]; const unsigned w[4] = {u.x, u.y, u.z, u.w};
#pragma unroll
            for (int k = 0; k < 4; ++k) { z += q[c * 8 + 2 * k] * __uint_as_float(w[k] << 16); z += q[c * 8 + 2 * k + 1] * __uint_as_float(w[k] & 0xffff0000u); } }
        const float sp = fmaxf(z, 0.f) + log1pf(expf(-fabsf(z)));
        const float wgt = expf(z - sp - R);
        const uint4* vp = (const uint4*)(Vs + (size_t)s * 512 + h * 64);
#pragma unroll
        for (int c = 0; c < 8; ++c) { const uint4 u = vp[c]; const unsigned w[4] = {u.x, u.y, u.z, u.w};
#pragma unroll
            for (int k = 0; k < 4; ++k) { acc[c * 8 + 2 * k] += wgt * __uint_as_float(w[k] << 16); acc[c * 8 + 2 * k + 1] += wgt * __uint_as_float(w[k] & 0xffff0000u); } }
        R += sp;
    }
    float ss = 0.f;
#pragma unroll
    for (int d = 0; d < 64; ++d) ss += acc[d] * acc[d];
    const float r = 1.0f / sqrtf(ss * (1.f / 64.f) + EPS);
#pragma unroll
    for (int d = 0; d < 64; ++d) ycat[(size_t)t * 1024 + 512 + h * 64 + d] = f2bf(acc[d] * r * og[d]);
}

__device__ __forceinline__ void ins16(float (&s)[16], float x) {
#pragma unroll
    for (int i = 15; i >= 1; --i) s[i] = __builtin_amdgcn_fmed3f(s[i - 1], s[i], x);
    s[0] = fmaxf(s[0], x);
}
__global__ __launch_bounds__(256) void k_topk(const float* __restrict__ scores, int* __restrict__ ids, float* __restrict__ gates) {
    const int idx = blockIdx.x * 256 + threadIdx.x, t = idx >> 3, h = idx & 7;
    const float* sc = scores + (size_t)t * 2048 + h * 256;
    float s0[16], s1[16], tl[16];
#pragma unroll
    for (int i = 0; i < 16; ++i) { s0[i] = -INFINITY; s1[i] = -INFINITY; tl[i] = -INFINITY; }
    for (int k = 0; k < 128; k += 4) {
        const float4 v = *(const float4*)(sc + k);
        ins16(s0, __uint_as_float((__float_as_uint(v.x) & 0xFFFFFF80u) | (unsigned)(k + 0)));
        ins16(s0, __uint_as_float((__float_as_uint(v.y) & 0xFFFFFF80u) | (unsigned)(k + 1)));
        ins16(s0, __uint_as_float((__float_as_uint(v.z) & 0xFFFFFF80u) | (unsigned)(k + 2)));
        ins16(s0, __uint_as_float((__float_as_uint(v.w) & 0xFFFFFF80u) | (unsigned)(k + 3)));
    }
    for (int k = 0; k < 128; k += 4) {
        const float4 v = *(const float4*)(sc + 128 + k);
        ins16(s1, __uint_as_float((__float_as_uint(v.x) & 0xFFFFFF80u) | (unsigned)(k + 0)));
        ins16(s1, __uint_as_float((__float_as_uint(v.y) & 0xFFFFFF80u) | (unsigned)(k + 1)));
        ins16(s1, __uint_as_float((__float_as_uint(v.z) & 0xFFFFFF80u) | (unsigned)(k + 2)));
        ins16(s1, __uint_as_float((__float_as_uint(v.w) & 0xFFFFFF80u) | (unsigned)(k + 3)));
    }
#pragma unroll
    for (int a = 0; a < 16; ++a)
#pragma unroll
        for (int b = 0; b < 16; ++b)
            if ((a + 1) * (b + 1) <= 16) {
                const float v = __uint_as_float(__float_as_uint(s0[a]) & 0xFFFFFF80u) + __uint_as_float(__float_as_uint(s1[b]) & 0xFFFFFF80u);
                ins16(tl, __uint_as_float((__float_as_uint(v) & 0xFFFFFF00u) | (unsigned)(a * 16 + b)));
            }
    float ev[16]; float sum = 0.f;
    const float mx = __uint_as_float(__float_as_uint(tl[0]) & 0xFFFFFF00u);
#pragma unroll
    for (int j = 0; j < 16; ++j) { ev[j] = expf(__uint_as_float(__float_as_uint(tl[j]) & 0xFFFFFF00u) - mx); sum += ev[j]; }
    const float inv = 1.f / sum;
#pragma unroll
    for (int j = 0; j < 16; ++j) {
        const unsigned code = __float_as_uint(tl[j]) & 0xFFu; const int a = (int)(code >> 4), b = (int)(code & 15u);
        int i0 = 0, i1 = 0;
#pragma unroll
        for (int k = 0; k < 16; ++k) { i0 = (a == k) ? (int)(__float_as_uint(s0[k]) & 0x7Fu) : i0; i1 = (b == k) ? (int)(__float_as_uint(s1[k]) & 0x7Fu) : i1; }
        ids[(size_t)t * 128 + h * 16 + j] = i0 * 128 + i1;
        gates[(size_t)t * 128 + h * 16 + j] = ev[j] * inv;
    }
}

__global__ __launch_bounds__(256) void k_peer(const float* __restrict__ rinv2, const float* __restrict__ g2, const float* __restrict__ mod, const int* __restrict__ ids,
                                              const float* __restrict__ gates, const float* __restrict__ down, const float* __restrict__ up, float* out) {
    const int t = blockIdx.x * 4 + (threadIdx.x >> 6), lane = threadIdx.x & 63;
    const float* scale2 = mod + 4096; const float* shift2 = mod + 3072; const float* gate2 = mod + 5120;
    float xv[16], hv[16], acc[16];
    const float ri = rinv2[t];
#pragma unroll
    for (int j = 0; j < 4; ++j) {
        const int i0 = j * 256 + lane * 4;
        const float4 v = *(const float4*)(out + (size_t)t * D + i0);
        const float4 g = *(const float4*)(g2 + i0), sc = *(const float4*)(scale2 + i0), sh = *(const float4*)(shift2 + i0);
        xv[4 * j + 0] = v.x; xv[4 * j + 1] = v.y; xv[4 * j + 2] = v.z; xv[4 * j + 3] = v.w;
        hv[4 * j + 0] = v.x * ri * g.x * (1.f + sc.x) + sh.x; hv[4 * j + 1] = v.y * ri * g.y * (1.f + sc.y) + sh.y;
        hv[4 * j + 2] = v.z * ri * g.z * (1.f + sc.z) + sh.z; hv[4 * j + 3] = v.w * ri * g.w * (1.f + sc.w) + sh.w;
        acc[4 * j + 0] = 0.f; acc[4 * j + 1] = 0.f; acc[4 * j + 2] = 0.f; acc[4 * j + 3] = 0.f;
    }
#pragma unroll 2
    for (int e = 0; e < 128; ++e) {
        const int id = ids[(size_t)t * 128 + e]; const float g = gates[(size_t)t * 128 + e];
        const float4* dr = (const float4*)(down + (size_t)id * D); const float4* ur = (const float4*)(up + (size_t)id * D);
        float4 dw[4], uw[4];
#pragma unroll
        for (int j = 0; j < 4; ++j) { dw[j] = dr[j * 64 + lane]; uw[j] = ur[j * 64 + lane]; }
        float p = 0.f;
#pragma unroll
        for (int j = 0; j < 4; ++j) p += hv[4 * j] * dw[j].x + hv[4 * j + 1] * dw[j].y + hv[4 * j + 2] * dw[j].z + hv[4 * j + 3] * dw[j].w;
#pragma unroll
        for (int o = 32; o > 0; o >>= 1) p += __shfl_xor(p, o);
        const float act = 0.5f * p * (1.f + erff(p * 0.70710678118f)) * g;
#pragma unroll
        for (int j = 0; j < 4; ++j) { acc[4 * j] += act * uw[j].x; acc[4 * j + 1] += act * uw[j].y; acc[4 * j + 2] += act * uw[j].z; acc[4 * j + 3] += act * uw[j].w; }
    }
#pragma unroll
    for (int j = 0; j < 4; ++j) {
        const int i0 = j * 256 + lane * 4;
        const float4 gt = *(const float4*)(gate2 + i0);
        float4 o; o.x = xv[4 * j] + gt.x * acc[4 * j]; o.y = xv[4 * j + 1] + gt.y * acc[4 * j + 1]; o.z = xv[4 * j + 2] + gt.z * acc[4 * j + 2]; o.w = xv[4 * j + 3] + gt.w * acc[4 * j + 3];
        *(float4*)(out + (size_t)t * D + i0) = o;
    }
}
}

extern "C" void kernel_launch(void* const* d_in, const int* in_sizes, int n_in, void* d_out, int out_size, void* d_ws, size_t ws_size, hipStream_t stream) {
    const float* x = (const float*)d_in[0]; const float* c = (const float*)d_in[1]; const int* pos = (const int*)d_in[2];
    const float* ada_w = (const float*)d_in[3]; const float* ada_b = (const float*)d_in[4]; const float* g1 = (const float*)d_in[5]; const float* g2 = (const float*)d_in[6];
    const float* w_in = (const float*)d_in[7]; const float* rgain = (const float*)d_in[8]; const float* qg = (const float*)d_in[9]; const float* kg = (const float*)d_in[10];
    const float* og = (const float*)d_in[11]; const float* w_out = (const float*)d_in[12]; const float* wq = (const float*)d_in[13]; const float* sk = (const float*)d_in[14];
    const float* down = (const float*)d_in[15]; const float* up = (const float*)d_in[16];
    float* out = (float*)d_out; unsigned char* ws = (unsigned char*)d_ws;
    float* mod = (float*)(ws + OFF_MOD); float* rinv1 = (float*)(ws + OFF_RINV1); float* rinv2 = (float*)(ws + OFF_RINV2); float2* rope = (float2*)(ws + OFF_ROPE);
    bf16_t* P = (bf16_t*)(ws + OFF_P); float* kv = (float*)(ws + OFF_KV); float* st = (float*)(ws + OFF_ST); bf16_t* ycat = (bf16_t*)(ws + OFF_YCAT);
    float* weff = (float*)(ws + OFF_WEFF); int* ids = (int*)(ws + OFF_IDS); float* gates = (float*)(ws + OFF_GATES); float* scores = (float*)(ws + OFF_SCORES);
    const size_t PS = (size_t)T * 512;
    RopeC rc; for (int i = 0; i < 32; ++i) rc.f[i] = pow(10000.0, -(double)i / 32.0) / 6.283185307179586476925;
    RetC rt; for (int h = 0; h < 8; ++h) rt.lg2[h] = (float)(log1p(-pow(2.0, -5.0 - h)) / log(2.0));

    k_mod<<<256, 256, 0, stream>>>(c, ada_w, ada_b, mod);
    k_rowstat<<<T / 4, 256, 0, stream>>>(x, rinv1);
    k_rope<<<T * 32 / 256, 256, 0, stream>>>(pos, rope, rc);
    k_weff<<<1024 * 2048 / 256, 256, 0, stream>>>(wq, sk, weff);
    k_gemm<<<dim3(3584 / 64, T / 64), 256, 0, stream>>>(ALoadNorm{x, rinv1, g1, mod + 1024, mod}, w_in, 3584, EpiInproj{P, rope, qg, kg});
    k_ret_kv<<<1024, 256, 0, stream>>>(P + PS, P + 2 * PS, kv, rt);
    k_ret_scan<<<128, 256, 0, stream>>>(kv, st, rt);
    k_ret_out<<<1024, 128, 0, stream>>>(P, P + PS, P + 2 * PS, P + 3 * PS, st, rgain, ycat, rt);
    k_sb<<<T / 64 * 8, 64, 0, stream>>>(P + 4 * PS, P + 5 * PS, P + 6 * PS, og, ycat);
    k_gemm<<<dim3(1024 / 64, T / 64), 256, 0, stream>>>(ALoadBf16{ycat}, w_out, 1024, EpiOutproj{x, mod + 2048, out});
    k_rowstat<<<T / 4, 256, 0, stream>>>(out, rinv2);
    k_gemm<<<dim3(2048 / 64, T / 64), 256, 0, stream>>>(ALoadNorm{out, rinv2, g2, mod + 4096, mod + 3072}, weff, 2048, EpiStore{scores, 2048});
    k_topk<<<T * 8 / 256, 256, 0, stream>>>(scores, ids, gates);
    k_peer<<<T / 4, 256, 0, stream>>>(rinv2, g2, mod, ids, gates, down, up, out);
}
```

```cpp
#include <hip/hip_runtime.h>
#include <stdint.h>
#include <math.h>
#include <cstdio>

namespace {
constexpr int T = 16384, D = 1024;
constexpr float EPS = 1e-6f;
typedef unsigned short bf16_t;
#define LAS __attribute__((address_space(3)))

__device__ __forceinline__ float bf2f(bf16_t b) { return __uint_as_float(((unsigned)b) << 16); }
__device__ __forceinline__ bf16_t f2bf(float f) { unsigned u = __float_as_uint(f); u += 0x7fffu + ((u >> 16) & 1u); return (bf16_t)(u >> 16); }
__device__ __forceinline__ int vzero() { int z = 0; asm volatile("" : "+v"(z)); return z; }

struct RopeC { double f[32]; };
struct RetC { float lg2[8]; };

constexpr size_t MiB = 1u << 20;
constexpr size_t OFF_CTL = 0;
constexpr size_t CTL_BYTES = 64 * 1024;
constexpr size_t OFF_MOD = 64 * 1024, OFF_RINV1 = 128 * 1024, OFF_RINV2 = 192 * 1024, OFF_ROPE = 1 * MiB;
constexpr size_t OFF_P = 8 * MiB;
constexpr size_t OFF_KV = 120 * MiB, OFF_ST = 136 * MiB, OFF_YCAT = 152 * MiB, OFF_WEFF = 184 * MiB;
constexpr size_t OFF_IDS = 192 * MiB, OFF_GATES = 200 * MiB;
constexpr size_t OFF_SCORES = 8 * MiB;
constexpr int LDS_BYTES = 147456;
constexpr int LDS_ST_OFF = LDS_BYTES - 16;

#define XB_TMO      128
#define XB_XCNT(j)  (256  + 64 * (j))
#define XB_XSUB(j)  (1280 + 64 * (j))
#define XB_XGEN(j)  (2304 + 64 * (j))
#define XB_TOP      3328
#define XB_TOPGEN   3392
#define XCD_BAR_WORDS 3456
#define XB_SPIN_CAP (1u << 20)
__device__ __forceinline__ unsigned xb_ld(unsigned* p)              { return __hip_atomic_load(p, __ATOMIC_RELAXED, __HIP_MEMORY_SCOPE_AGENT); }
__device__ __forceinline__ unsigned xb_add(unsigned* p, unsigned v) { return __hip_atomic_fetch_add(p, v, __ATOMIC_RELAXED, __HIP_MEMORY_SCOPE_AGENT); }
__device__ __forceinline__ unsigned xb_xcc_id() { return (unsigned)__builtin_amdgcn_s_getreg((3 << 11) | 20) & 0xFu; }
#define XB_SPIN(cond, bar) do { unsigned _sp = 0; while (cond) { __builtin_amdgcn_s_sleep(1); \
    if ((++_sp & 255u) == 0u) { if (xb_ld(&(bar)[XB_TMO])) break; if (_sp > XB_SPIN_CAP) { atomicAdd(&(bar)[XB_TMO], 1u); break; } } } } while (0)
struct XcdBarrier { unsigned* bar; unsigned x; volatile LAS unsigned* st; };
__device__ __forceinline__ XcdBarrier xcd_barrier_post(unsigned* bar, volatile LAS unsigned* st) {
    XcdBarrier b; b.bar = bar; b.x = xb_xcc_id(); b.st = st;
    if (threadIdx.x == 0) (void)xb_add(&bar[XB_XCNT(b.x)], 1u);
    return b;
}
__device__ __forceinline__ void xcd_barrier_complete(unsigned* bar, unsigned x, unsigned& nloc, unsigned& nx) {
    const unsigned G = gridDim.x * gridDim.y * gridDim.z;
    unsigned sum, cnt, mine, sp = 0u;
    for (;;) {
        sum = 0u; cnt = 0u; mine = 0u;
#pragma unroll
        for (unsigned j = 0; j < 16; ++j) { const unsigned c = xb_ld(&bar[XB_XCNT(j)]); sum += c; cnt += (c > 0u) ? 1u : 0u; mine = (j == x) ? c : mine; }
        if (sum == G) break;
        __builtin_amdgcn_s_sleep(1);
        if ((++sp & 255u) == 0u) { if (xb_ld(&bar[XB_TMO])) break; if (sp > XB_SPIN_CAP) { atomicAdd(&bar[XB_TMO], 1u); break; } }
    }
    nloc = mine > 0u ? mine : 1u; nx = cnt > 0u ? cnt : 1u;
}
__device__ __forceinline__ void xcd_barrier(const XcdBarrier& b) {
    asm volatile("s_waitcnt vmcnt(0)" ::: "memory");
    __syncthreads();
    if (threadIdx.x == 0) {
        unsigned* bar = b.bar;
        __builtin_amdgcn_s_waitcnt(0);
        unsigned nloc = b.st[0], nx = b.st[1];
        if (nloc == 0u) { xcd_barrier_complete(bar, b.x, nloc, nx); b.st[0] = nloc; b.st[1] = nx; }
        const unsigned old = xb_add(&bar[XB_XSUB(b.x)], 1u);
        const unsigned gen = old / nloc;
        if (old + 1u == (gen + 1u) * nloc) {
            __builtin_amdgcn_fence(__ATOMIC_RELEASE, "agent");
            asm volatile("s_waitcnt vmcnt(0)" ::: "memory");
            const unsigned og = xb_add(&bar[XB_TOP], 1u);
            const unsigned tg = og / nx;
            if (og + 1u == (tg + 1u) * nx) xb_add(&bar[XB_TOPGEN], 1u);
            else XB_SPIN(xb_ld(&bar[XB_TOPGEN]) == tg, bar);
            __builtin_amdgcn_fence(__ATOMIC_ACQUIRE, "agent");
            xb_add(&bar[XB_XGEN(b.x)], 1u);
            asm volatile("s_waitcnt vmcnt(0)" ::: "memory");
        } else {
            XB_SPIN(xb_ld(&bar[XB_XGEN(b.x)]) == gen, bar);
            __builtin_amdgcn_fence(__ATOMIC_ACQUIRE, "agent");
            asm volatile("s_waitcnt vmcnt(0)" ::: "memory");
        }
    }
    __syncthreads();
}

struct ALoadNorm {
    const float* x; const float* rinv; const float* gain; const float* mscale; const float* mshift;
    __device__ __forceinline__ float operator()(int t, int i) const { return x[(size_t)t * D + i] * rinv[t] * gain[i] * (1.f + mscale[i]) + mshift[i]; }
};
struct ALoadBf16 {
    const bf16_t* a;
    __device__ __forceinline__ float operator()(int t, int i) const { return bf2f(a[(size_t)t * D + i]); }
};
struct EpiInproj {
    bf16_t* P; const float2* rope; const float* qg; const float* kg;
    __device__ __forceinline__ void operator()(float (*Cs)[65], int m0, int n0, int tid) const {
        const int type = n0 / 512, head = (n0 % 512) / 64, tl = tid >> 2, part = tid & 3, t = m0 + tl;
        bf16_t* out = P + (size_t)type * T * 512 + (size_t)t * 512 + head * 64;
        const float* row = Cs[tl];
        if (type <= 1) {
            const float sc = type == 1 ? 0.125f : 1.f;
            for (int q = 0; q < 8; ++q) { const int d = part * 8 + q; const float2 cs = rope[t * 32 + d]; const float x1 = row[d], x2 = row[d + 32];
                out[d] = f2bf((x1 * cs.x - x2 * cs.y) * sc); out[d + 32] = f2bf((x2 * cs.x + x1 * cs.y) * sc); }
        } else if (type == 2 || type == 6) {
            for (int q = 0; q < 16; ++q) { const int d = part * 16 + q; out[d] = f2bf(row[d]); }
        } else if (type == 3) {
            for (int q = 0; q < 16; ++q) { const int d = part * 16 + q; const float v = row[d]; out[d] = f2bf(v / (1.f + expf(-v))); }
        } else {
            float ss = 0.f; for (int d = 0; d < 64; ++d) ss += row[d] * row[d];
            const float r = 1.0f / sqrtf(ss * (1.f / 64.f) + EPS);
            const float* g = type == 4 ? qg : kg; const float sc = type == 4 ? 0.125f : 1.f;
            for (int q = 0; q < 16; ++q) { const int d = part * 16 + q; out[d] = f2bf(row[d] * r * g[d] * sc); }
        }
    }
};
struct EpiOutproj {
    const float* x; const float* gate1; float* x1;
    __device__ __forceinline__ void operator()(float (*Cs)[65], int m0, int n0, int tid) const {
        for (int e = tid; e < 4096; e += 256) { const int r = e >> 6, c = e & 63; const size_t o = (size_t)(m0 + r) * D + n0 + c; x1[o] = x[o] + gate1[n0 + c] * Cs[r][c]; }
    }
};
struct EpiStore {
    float* out; int ld;
    __device__ __forceinline__ void operator()(float (*Cs)[65], int m0, int n0, int tid) const {
        for (int e = tid; e < 4096; e += 256) { const int r = e >> 6, c = e & 63; out[(size_t)(m0 + r) * ld + n0 + c] = Cs[r][c]; }
    }
};
template <class AL, class Epi>
__device__ __forceinline__ void gemm_naive_phase(unsigned char* lds, const AL al, const float* B, const int N, const Epi epi, const int bid, const int G) {
    const int half = threadIdx.x >> 8, tid = threadIdx.x & 255, tx = tid & 15, ty = tid >> 4;
    float (*As)[68] = (float (*)[68])(lds + half * 25344);
    float (*Bs)[68] = (float (*)[68])(lds + half * 25344 + 4352);
    float (*Cs)[65] = (float (*)[65])(lds + half * 25344 + 8704);
    const int NT = N / 64, units = NT * (T / 64);
    for (int U0 = 0; U0 < units; U0 += 2 * G) {
        const int U = U0 + 2 * bid + half;
        const int m0 = (U / NT) * 64, n0 = (U % NT) * 64;
        float acc[4][4];
#pragma unroll
        for (int i = 0; i < 4; ++i)
#pragma unroll
            for (int j = 0; j < 4; ++j) acc[i][j] = 0.f;
        for (int k0 = 0; k0 < 1024; k0 += 16) {
#pragma unroll
            for (int i = 0; i < 4; ++i) { const int r = (tid >> 4) + 16 * i, c = tid & 15; As[c][r] = al(m0 + r, k0 + c); }
#pragma unroll
            for (int i = 0; i < 4; ++i) { const int r = (tid >> 6) + 4 * i, c = tid & 63; Bs[r][c] = B[(size_t)(k0 + r) * N + n0 + c]; }
            __syncthreads();
#pragma unroll
            for (int kk = 0; kk < 16; ++kk) {
                float a[4], b[4];
#pragma unroll
                for (int i = 0; i < 4; ++i) { a[i] = As[kk][ty * 4 + i]; b[i] = Bs[kk][tx * 4 + i]; }
#pragma unroll
                for (int i = 0; i < 4; ++i)
#pragma unroll
                    for (int j = 0; j < 4; ++j) acc[i][j] += a[i] * b[j];
            }
            __syncthreads();
        }
#pragma unroll
        for (int i = 0; i < 4; ++i)
#pragma unroll
            for (int j = 0; j < 4; ++j) Cs[ty * 4 + i][tx * 4 + j] = acc[i][j];
        __syncthreads();
        epi(Cs, m0, n0, tid);
        __syncthreads();
    }
}

__device__ __forceinline__ void ins16(float (&s)[16], float x) {
#pragma unroll
    for (int i = 15; i >= 1; --i) s[i] = __builtin_amdgcn_fmed3f(s[i - 1], s[i], x);
    s[0] = fmaxf(s[0], x);
}

struct Params {
    const float *x, *c; const int* pos; const float *ada_w, *ada_b, *g1, *g2, *w_in, *rgain, *qg, *kg, *og, *w_out, *wq, *sk, *down, *up;
    float* out; unsigned char* ws; RopeC rc; RetC rt;
};

__global__ void __launch_bounds__(512) mk_fwd(Params p) {
    extern __shared__ __attribute__((aligned(16))) unsigned char lds[];
    const int tid = threadIdx.x, lane = tid & 63, wave = tid >> 6, bid = blockIdx.x, G = gridDim.x;
    unsigned char* ws = p.ws;
    float* mod = (float*)(ws + OFF_MOD); float* rinv1 = (float*)(ws + OFF_RINV1); float* rinv2 = (float*)(ws + OFF_RINV2); float2* rope = (float2*)(ws + OFF_ROPE);
    bf16_t* P = (bf16_t*)(ws + OFF_P); float* kv = (float*)(ws + OFF_KV); float* st = (float*)(ws + OFF_ST); bf16_t* ycat = (bf16_t*)(ws + OFF_YCAT);
    float* weff = (float*)(ws + OFF_WEFF); int* ids = (int*)(ws + OFF_IDS); float* gates = (float*)(ws + OFF_GATES); float* scores = (float*)(ws + OFF_SCORES);
    const size_t PS = (size_t)T * 512;
    const bf16_t *Qr = P, *Kr = P + PS, *Vr = P + 2 * PS, *Gr = P + 3 * PS, *Qs = P + 4 * PS, *Ks = P + 5 * PS, *Vs = P + 6 * PS;
    float* out = p.out;

    if (tid < 4) ((LAS unsigned*)((LAS unsigned char*)lds + LDS_ST_OFF))[tid] = 0u;
    __syncthreads();
    XcdBarrier bar = xcd_barrier_post((unsigned*)(ws + OFF_CTL), (volatile LAS unsigned*)((LAS unsigned char*)lds + LDS_ST_OFF));

    for (int u = bid; u < 256; u += G) {
        float (*red)[24] = (float (*)[24])lds;
        const int c4 = tid % 6, rg = tid / 6;
        if (rg < 42) {
            float4 acc = {0.f, 0.f, 0.f, 0.f};
            for (int r = rg; r < 1024; r += 42) {
                const float cv = p.c[r]; const float s = cv / (1.f + expf(-cv));
                const float4 w = *(const float4*)(p.ada_w + (size_t)r * 6144 + u * 24 + c4 * 4);
                acc.x += s * w.x; acc.y += s * w.y; acc.z += s * w.z; acc.w += s * w.w;
            }
            red[rg][c4 * 4 + 0] = acc.x; red[rg][c4 * 4 + 1] = acc.y; red[rg][c4 * 4 + 2] = acc.z; red[rg][c4 * 4 + 3] = acc.w;
        }
        __syncthreads();
        if (tid < 24) { float s = 0.f; for (int i = 0; i < 42; ++i) s += red[i][tid]; mod[u * 24 + tid] = s + p.ada_b[u * 24 + tid]; }
        __syncthreads();
    }
    for (int row = bid * 8 + wave; row < T; row += G * 8) {
        const float4* xp = (const float4*)(p.x + (size_t)row * D);
        float s = 0.f;
#pragma unroll
        for (int j = 0; j < 4; ++j) { const float4 v = xp[lane + 64 * j]; s += v.x * v.x + v.y * v.y + v.z * v.z + v.w * v.w; }
#pragma unroll
        for (int o = 32; o > 0; o >>= 1) s += __shfl_xor(s, o);
        if (lane == 0) rinv1[row] = 1.0f / sqrtf(s * (1.0f / D) + EPS);
    }
    for (int idx = bid * 512 + tid; idx < T * 32; idx += G * 512) {
        const int t = idx >> 5, i = idx & 31;
        double rev = (double)p.pos[t] * p.rc.f[i];
        rev -= floor(rev);
        float s, c; sincospif((float)(2.0 * rev), &s, &c);
        rope[idx] = make_float2(c, s);
    }
    for (int idx = bid * 512 + tid; idx < 1024 * 2048; idx += G * 512) {
        const int i = idx >> 11, n = idx & 2047, hp = n >> 7, k = n & 127;
        const float* a = p.wq + (size_t)i * 2048 + hp * 128; const float* b = p.sk + ((size_t)hp * 128 + k) * 128;
        float s = 0.f;
        for (int c = 0; c < 128; ++c) s += a[c] * b[c];
        weff[idx] = s;
    }
    xcd_barrier(bar);

    gemm_naive_phase(lds, ALoadNorm{p.x, rinv1, p.g1, mod + 1024, mod}, p.w_in, 3584, EpiInproj{P, rope, p.qg, p.kg}, bid, G);
    xcd_barrier(bar);

    for (int U = bid; U < 1024; U += G) {
        float (*ks)[64] = (float (*)[64])lds; float (*vs)[64] = (float (*)[64])(lds + 32768);
        const int n = U >> 3, h = U & 7;
        for (int e = tid; e < 128 * 64; e += 512) { const int j = e >> 6, d = e & 63; const size_t g = (size_t)(n * 128 + j) * 512 + h * 64 + d;
            ks[j][d] = bf2f(Kr[g]) * exp2f((float)(127 - j) * p.rt.lg2[h]); vs[j][d] = bf2f(Vr[g]); }
        __syncthreads();
        if (tid < 256) {
            const int d = tid >> 2, e0 = (tid & 3) * 16;
            float acc[16];
#pragma unroll
            for (int q = 0; q < 16; ++q) acc[q] = 0.f;
            for (int j = 0; j < 128; ++j) { const float kk = ks[j][d];
#pragma unroll
                for (int q = 0; q < 16; ++q) acc[q] += kk * vs[j][e0 + q]; }
#pragma unroll
            for (int q = 0; q < 16; ++q) kv[((size_t)(n * 8 + h) * 64 + d) * 64 + e0 + q] = acc[q];
        }
        __syncthreads();
    }
    for (int u = bid * 8 + wave; u < 2048; u += G * 8) {
        const int h = u & 7, t = (u >> 3) * 64 + lane;
        float q[64], acc[64];
        {
            const uint4* qp = (const uint4*)(Qs + (size_t)t * 512 + h * 64);
#pragma unroll
            for (int c = 0; c < 8; ++c) { const uint4 w4 = qp[c]; const unsigned w[4] = {w4.x, w4.y, w4.z, w4.w};
#pragma unroll
                for (int k = 0; k < 4; ++k) { q[c * 8 + 2 * k] = __uint_as_float(w[k] << 16); q[c * 8 + 2 * k + 1] = __uint_as_float(w[k] & 0xffff0000u); } }
        }
#pragma unroll
        for (int d = 0; d < 64; ++d) acc[d] = 0.f;
        float R = 0.f;
        for (int s = t - 1; s >= 0; --s) {
            if (R > 88.f) break;
            const uint4* kp = (const uint4*)(Ks + (size_t)s * 512 + h * 64);
            float z = 0.f;
#pragma unroll
            for (int c = 0; c < 8; ++c) { const uint4 w4 = kp[c]; const unsigned w[4] = {w4.x, w4.y, w4.z, w4.w};
#pragma unroll
                for (int k = 0; k < 4; ++k) { z += q[c * 8 + 2 * k] * __uint_as_float(w[k] << 16); z += q[c * 8 + 2 * k + 1] * __uint_as_float(w[k] & 0xffff0000u); } }
            const float sp = fmaxf(z, 0.f) + log1pf(expf(-fabsf(z)));
            const float wgt = expf(z - sp - R);
            const uint4* vp = (const uint4*)(Vs + (size_t)s * 512 + h * 64);
#pragma unroll
            for (int c = 0; c < 8; ++c) { const uint4 w4 = vp[c]; const unsigned w[4] = {w4.x, w4.y, w4.z, w4.w};
#pragma unroll
                for (int k = 0; k < 4; ++k) { acc[c * 8 + 2 * k] += wgt * __uint_as_float(w[k] << 16); acc[c * 8 + 2 * k + 1] += wgt * __uint_as_float(w[k] & 0xffff0000u); } }
            R += sp;
        }
        float ss = 0.f;
#pragma unroll
        for (int d = 0; d < 64; ++d) ss += acc[d] * acc[d];
        const float r = 1.0f / sqrtf(ss * (1.f / 64.f) + EPS);
#pragma unroll
        for (int d = 0; d < 64; ++d) ycat[(size_t)t * 1024 + 512 + h * 64 + d] = f2bf(acc[d] * r * p.og[d]);
    }
    xcd_barrier(bar);

    for (int idx = bid * 512 + tid; idx < 32768; idx += G * 512) {
        const int h = idx >> 12;
        const float cd = exp2f(128.f * p.rt.lg2[h]);
        float s = 0.f;
        for (int n = 0; n < 128; ++n) { st[(size_t)n * 32768 + idx] = s; s = cd * s + kv[(size_t)n * 32768 + idx]; }
    }
    xcd_barrier(bar);

    for (int U = bid; U < 1024; U += G) {
        float (*ks)[64] = (float (*)[64])lds; float (*vs)[64] = (float (*)[64])(lds + 32768); float (*ss)[64] = (float (*)[64])(lds + 65536);
        const int n = U >> 3, h = U & 7;
        for (int e = tid; e < 128 * 64; e += 512) { const int j = e >> 6, d = e & 63; const size_t g = (size_t)(n * 128 + j) * 512 + h * 64 + d; ks[j][d] = bf2f(Kr[g]); vs[j][d] = bf2f(Vr[g]); }
        for (int e = tid; e < 4096; e += 512) ss[e >> 6][e & 63] = st[(size_t)(n * 8 + h) * 4096 + e];
        __syncthreads();
        if (tid < 128) {
            const int i = tid, t = n * 128 + i;
            float q[64], acc[64];
#pragma unroll
            for (int d = 0; d < 64; ++d) { q[d] = bf2f(Qr[(size_t)t * 512 + h * 64 + d]); acc[d] = 0.f; }
            const float lg = p.rt.lg2[h];
            const float xi = exp2f((float)(i + 1) * lg);
#pragma unroll
            for (int d = 0; d < 64; ++d) { const float qd = q[d] * xi;
#pragma unroll
                for (int e = 0; e < 64; ++e) acc[e] += qd * ss[d][e]; }
            for (int j = 0; j <= i; ++j) {
                float s = 0.f;
#pragma unroll
                for (int d = 0; d < 64; ++d) s += q[d] * ks[j][d];
                s *= exp2f((float)(i - j) * lg);
#pragma unroll
                for (int e = 0; e < 64; ++e) acc[e] += s * vs[j][e];
            }
            float mean = 0.f;
#pragma unroll
            for (int e = 0; e < 64; ++e) mean += acc[e];
            mean *= (1.f / 64.f);
            float var = 0.f;
#pragma unroll
            for (int e = 0; e < 64; ++e) { const float dlt = acc[e] - mean; var += dlt * dlt; }
            const float r = 1.0f / sqrtf(var * (1.f / 64.f) + EPS);
#pragma unroll
            for (int e = 0; e < 64; ++e) ycat[(size_t)t * 1024 + h * 64 + e] = f2bf((acc[e] - mean) * r * p.rgain[h * 64 + e] * bf2f(Gr[(size_t)t * 512 + h * 64 + e]));
        }
        __syncthreads();
    }
    xcd_barrier(bar);

    gemm_naive_phase(lds, ALoadBf16{ycat}, p.w_out, 1024, EpiOutproj{p.x, mod + 2048, out}, bid, G);
    xcd_barrier(bar);

    for (int row = bid * 8 + wave; row < T; row += G * 8) {
        const float4* xp = (const float4*)(out + (size_t)row * D);
        float s = 0.f;
#pragma unroll
        for (int j = 0; j < 4; ++j) { const float4 v = xp[lane + 64 * j]; s += v.x * v.x + v.y * v.y + v.z * v.z + v.w * v.w; }
#pragma unroll
        for (int o = 32; o > 0; o >>= 1) s += __shfl_xor(s, o);
        if (lane == 0) rinv2[row] = 1.0f / sqrtf(s * (1.0f / D) + EPS);
    }
    xcd_barrier(bar);

    gemm_naive_phase(lds, ALoadNorm{out, rinv2, p.g2, mod + 4096, mod + 3072}, weff, 2048, EpiStore{scores, 2048}, bid, G);
    xcd_barrier(bar);

    for (int idx = bid * 512 + tid; idx < T * 8; idx += G * 512) {
        const int t = idx >> 3, h = idx & 7;
        const float* sc = scores + (size_t)t * 2048 + h * 256;
        float s0[16], s1[16], tl[16];
#pragma unroll
        for (int i = 0; i < 16; ++i) { s0[i] = -INFINITY; s1[i] = -INFINITY; tl[i] = -INFINITY; }
        for (int k = 0; k < 128; k += 4) {
            const float4 v = *(const float4*)(sc + k);
            ins16(s0, __uint_as_float((__float_as_uint(v.x) & 0xFFFFFF80u) | (unsigned)(k + 0)));
            ins16(s0, __uint_as_float((__float_as_uint(v.y) & 0xFFFFFF80u) | (unsigned)(k + 1)));
            ins16(s0, __uint_as_float((__float_as_uint(v.z) & 0xFFFFFF80u) | (unsigned)(k + 2)));
            ins16(s0, __uint_as_float((__float_as_uint(v.w) & 0xFFFFFF80u) | (unsigned)(k + 3)));
        }
        for (int k = 0; k < 128; k += 4) {
            const float4 v = *(const float4*)(sc + 128 + k);
            ins16(s1, __uint_as_float((__float_as_uint(v.x) & 0xFFFFFF80u) | (unsigned)(k + 0)));
            ins16(s1, __uint_as_float((__float_as_uint(v.y) & 0xFFFFFF80u) | (unsigned)(k + 1)));
            ins16(s1, __uint_as_float((__float_as_uint(v.z) & 0xFFFFFF80u) | (unsigned)(k + 2)));
            ins16(s1, __uint_as_float((__float_as_uint(v.w) & 0xFFFFFF80u) | (unsigned)(k + 3)));
        }
#pragma unroll
        for (int a = 0; a < 16; ++a)
#pragma unroll
            for (int b = 0; b < 16; ++b)
                if ((a + 1) * (b + 1) <= 16) {
                    const float v = __uint_as_float(__float_as_uint(s0[a]) & 0xFFFFFF80u) + __uint_as_float(__float_as_uint(s1[b]) & 0xFFFFFF80u);
                    ins16(tl, __uint_as_float((__float_as_uint(v) & 0xFFFFFF00u) | (unsigned)(a * 16 + b)));
                }
        float ev[16]; float sum = 0.f;
        const float mx = __uint_as_float(__float_as_uint(tl[0]) & 0xFFFFFF00u);
#pragma unroll
        for (int j = 0; j < 16; ++j) { ev[j] = expf(__uint_as_float(__float_as_uint(tl[j]) & 0xFFFFFF00u) - mx); sum += ev[j]; }
        const float inv = 1.f / sum;
#pragma unroll
        for (int j = 0; j < 16; ++j) {
            const unsigned code = __float_as_uint(tl[j]) & 0xFFu; const int a = (int)(code >> 4), b = (int)(code & 15u);
            int i0 = 0, i1 = 0;
#pragma unroll
            for (int k = 0; k < 16; ++k) { i0 = (a == k) ? (int)(__float_as_uint(s0[k]) & 0x7Fu) : i0; i1 = (b == k) ? (int)(__float_as_uint(s1[k]) & 0x7Fu) : i1; }
            ids[(size_t)t * 128 + h * 16 + j] = i0 * 128 + i1;
            gates[(size_t)t * 128 + h * 16 + j] = ev[j] * inv;
        }
    }
    xcd_barrier(bar);

    {
        const float* scale2 = mod + 4096; const float* shift2 = mod + 3072; const float* gate2 = mod + 5120;
        const int vz = vzero();
        for (int t = bid * 8 + wave; t < T; t += G * 8) {
            float xv[16], hv[16], acc[16];
            const float ri = rinv2[t + vz];
            const int id_lo = ids[(size_t)t * 128 + lane], id_hi = ids[(size_t)t * 128 + 64 + lane];
            const float g_lo = gates[(size_t)t * 128 + lane], g_hi = gates[(size_t)t * 128 + 64 + lane];
#pragma unroll
            for (int j = 0; j < 4; ++j) {
                const int i0 = j * 256 + lane * 4;
                const float4 v = *(const float4*)(out + (size_t)t * D + i0);
                const float4 g = *(const float4*)(p.g2 + i0), sc = *(const float4*)(scale2 + i0), sh = *(const float4*)(shift2 + i0);
                xv[4 * j + 0] = v.x; xv[4 * j + 1] = v.y; xv[4 * j + 2] = v.z; xv[4 * j + 3] = v.w;
                hv[4 * j + 0] = v.x * ri * g.x * (1.f + sc.x) + sh.x; hv[4 * j + 1] = v.y * ri * g.y * (1.f + sc.y) + sh.y;
                hv[4 * j + 2] = v.z * ri * g.z * (1.f + sc.z) + sh.z; hv[4 * j + 3] = v.w * ri * g.w * (1.f + sc.w) + sh.w;
                acc[4 * j + 0] = 0.f; acc[4 * j + 1] = 0.f; acc[4 * j + 2] = 0.f; acc[4 * j + 3] = 0.f;
            }
#pragma unroll 2
            for (int e = 0; e < 128; ++e) {
                const int id = __shfl(e < 64 ? id_lo : id_hi, e & 63); const float g = __shfl(e < 64 ? g_lo : g_hi, e & 63);
                const float4* dr = (const float4*)(p.down + (size_t)id * D); const float4* ur = (const float4*)(p.up + (size_t)id * D);
                float4 dw[4], uw[4];
#pragma unroll
                for (int j = 0; j < 4; ++j) { dw[j] = dr[j * 64 + lane]; uw[j] = ur[j * 64 + lane]; }
                float pd = 0.f;
#pragma unroll
                for (int j = 0; j < 4; ++j) pd += hv[4 * j] * dw[j].x + hv[4 * j + 1] * dw[j].y + hv[4 * j + 2] * dw[j].z + hv[4 * j + 3] * dw[j].w;
#pragma unroll
                for (int o = 32; o > 0; o >>= 1) pd += __shfl_xor(pd, o);
                const float act = 0.5f * pd * (1.f + erff(pd * 0.70710678118f)) * g;
#pragma unroll
                for (int j = 0; j < 4; ++j) { acc[4 * j] += act * uw[j].x; acc[4 * j + 1] += act * uw[j].y; acc[4 * j + 2] += act * uw[j].z; acc[4 * j + 3] += act * uw[j].w; }
            }
#pragma unroll
            for (int j = 0; j < 4; ++j) {
                const int i0 = j * 256 + lane * 4;
                const float4 gt = *(const float4*)(gate2 + i0);
                float4 o; o.x = xv[4 * j] + gt.x * acc[4 * j]; o.y = xv[4 * j + 1] + gt.y * acc[4 * j + 1]; o.z = xv[4 * j + 2] + gt.z * acc[4 * j + 2]; o.w = xv[4 * j + 3] + gt.w * acc[4 * j + 3];
                *(float4*)(out + (size_t)t * D + i0) = o;
            }
        }
    }
}
}

extern "C" void kernel_launch(void* const* d_in, const int* in_sizes, int n_in, void* d_out, int out_size, void* d_ws, size_t ws_size, hipStream_t stream) {
    static int grid = 0;
    if (grid == 0) {
        int dev = 0, cus = 0, per_cu = 0;
        (void)hipGetDevice(&dev);
        (void)hipDeviceGetAttribute(&cus, hipDeviceAttributeMultiprocessorCount, dev);
        (void)hipFuncSetAttribute((const void*)mk_fwd, hipFuncAttributeMaxDynamicSharedMemorySize, LDS_BYTES);
        (void)hipOccupancyMaxActiveBlocksPerMultiprocessor(&per_cu, (const void*)mk_fwd, 512, LDS_BYTES);
        if (per_cu < 1 || cus != 256) { fprintf(stderr, "kernel_launch: needs 256 CUs with one resident workgroup each (cus %d, per_cu %d)\n", cus, per_cu); grid = -1; }
        else grid = cus;
    }
    if (grid < 0) return;
    (void)hipMemsetAsync((char*)d_ws + OFF_CTL, 0, CTL_BYTES, stream);
    Params p{};
    p.x = (const float*)d_in[0]; p.c = (const float*)d_in[1]; p.pos = (const int*)d_in[2]; p.ada_w = (const float*)d_in[3]; p.ada_b = (const float*)d_in[4];
    p.g1 = (const float*)d_in[5]; p.g2 = (const float*)d_in[6]; p.w_in = (const float*)d_in[7]; p.rgain = (const float*)d_in[8]; p.qg = (const float*)d_in[9];
    p.kg = (const float*)d_in[10]; p.og = (const float*)d_in[11]; p.w_out = (const float*)d_in[12]; p.wq = (const float*)d_in[13]; p.sk = (const float*)d_in[14];
    p.down = (const float*)d_in[15]; p.up = (const float*)d_in[16]; p.out = (float*)d_out; p.ws = (unsigned char*)d_ws;
    for (int i = 0; i < 32; ++i) p.rc.f[i] = pow(10000.0, -(double)i / 32.0) / 6.283185307179586476925;
    for (int h = 0; h < 8; ++h) p.rt.lg2[h] = (float)(log1p(-pow(2.0, -5.0 - h)) / log(2.0));
    void* args[] = {&p};
    hipError_t e = hipLaunchCooperativeKernel((const void*)mk_fwd, dim3(grid), dim3(512), args, LDS_BYTES, stream);
    if (e != hipSuccess) fprintf(stderr, "kernel_launch: cooperative launch failed: %s (grid %d)\n", hipGetErrorString(e), grid);
}
```

```cpp
#include <hip/hip_runtime.h>
#include <stdint.h>
#include <math.h>
#include <cstdio>

namespace {
constexpr int T = 16384, D = 1024;
constexpr float EPS = 1e-6f;
typedef unsigned short bf16_t;
#define LAS __attribute__((address_space(3)))

__device__ __forceinline__ float bf2f(bf16_t b) { return __uint_as_float(((unsigned)b) << 16); }
__device__ __forceinline__ bf16_t f2bf(float f) { unsigned u = __float_as_uint(f); u += 0x7fffu + ((u >> 16) & 1u); return (bf16_t)(u >> 16); }
__device__ __forceinline__ int vzero() { int z = 0; asm volatile("" : "+v"(z)); return z; }

struct RopeC { double f[32]; };
struct RetC { float lg2[8]; };

constexpr size_t MiB = 1u << 20;
constexpr size_t OFF_CTL = 0;
constexpr size_t CTL_BYTES = 64 * 1024;
constexpr size_t OFF_MOD = 64 * 1024, OFF_RINV1 = 128 * 1024, OFF_RINV2 = 192 * 1024, OFF_BIASF = 256 * 1024, OFF_ROPE = 1 * MiB;
constexpr size_t OFF_WINT = 6 * MiB;
constexpr size_t OFF_XB = 16 * MiB;
constexpr size_t OFF_YCAT = 16 * MiB;
constexpr size_t OFF_P = 48 * MiB;
constexpr size_t OFF_KV = 208 * MiB, OFF_ST = 224 * MiB;
constexpr size_t OFF_WEFFT = 240 * MiB;
constexpr size_t OFF_WOUTT = 13 * MiB;
constexpr size_t OFF_BIASQ = 272 * 1024;
constexpr size_t OFF_PART2 = 5 * MiB;
constexpr size_t OFF_X1B = 208 * MiB;
constexpr size_t OFF_SCORES = 48 * MiB;
constexpr size_t OFF_IDS = 244 * MiB, OFF_GATES = 248 * MiB;
constexpr size_t OFF_Q8 = 176 * MiB;
constexpr size_t OFF_QSC = 320 * 1024;
constexpr int LDS_BYTES = 147456;
constexpr int LDS_ST_OFF = LDS_BYTES - 16;

#define XB_TMO      128
#define XB_XCNT(j)  (256  + 64 * (j))
#define XB_XSUB(j)  (1280 + 64 * (j))
#define XB_XGEN(j)  (2304 + 64 * (j))
#define XB_TOP      3328
#define XB_TOPGEN   3392
#define XCD_BAR_WORDS 3456
#define XB_SPIN_CAP (1u << 20)
__device__ __forceinline__ unsigned xb_ld(unsigned* p)              { return __hip_atomic_load(p, __ATOMIC_RELAXED, __HIP_MEMORY_SCOPE_AGENT); }
__device__ __forceinline__ unsigned xb_add(unsigned* p, unsigned v) { return __hip_atomic_fetch_add(p, v, __ATOMIC_RELAXED, __HIP_MEMORY_SCOPE_AGENT); }
__device__ __forceinline__ unsigned xb_xcc_id() { return (unsigned)__builtin_amdgcn_s_getreg((3 << 11) | 20) & 0xFu; }
#define XB_SPIN(cond, bar) do { unsigned _sp = 0; while (cond) { __builtin_amdgcn_s_sleep(1); \
    if ((++_sp & 255u) == 0u) { if (xb_ld(&(bar)[XB_TMO])) break; if (_sp > XB_SPIN_CAP) { atomicAdd(&(bar)[XB_TMO], 1u); break; } } } } while (0)
struct XcdBarrier { unsigned* bar; unsigned x; volatile LAS unsigned* st; };
__device__ __forceinline__ XcdBarrier xcd_barrier_post(unsigned* bar, volatile LAS unsigned* st) {
    XcdBarrier b; b.bar = bar; b.x = xb_xcc_id(); b.st = st;
    if (threadIdx.x == 0) (void)xb_add(&bar[XB_XCNT(b.x)], 1u);
    return b;
}
__device__ __forceinline__ void xcd_barrier_complete(unsigned* bar, unsigned x, unsigned& nloc, unsigned& nx) {
    const unsigned G = gridDim.x * gridDim.y * gridDim.z;
    unsigned sum, cnt, mine, sp = 0u;
    for (;;) {
        sum = 0u; cnt = 0u; mine = 0u;
#pragma unroll
        for (unsigned j = 0; j < 16; ++j) { const unsigned c = xb_ld(&bar[XB_XCNT(j)]); sum += c; cnt += (c > 0u) ? 1u : 0u; mine = (j == x) ? c : mine; }
        if (sum == G) break;
        __builtin_amdgcn_s_sleep(1);
        if ((++sp & 255u) == 0u) { if (xb_ld(&bar[XB_TMO])) break; if (sp > XB_SPIN_CAP) { atomicAdd(&bar[XB_TMO], 1u); break; } }
    }
    nloc = mine > 0u ? mine : 1u; nx = cnt > 0u ? cnt : 1u;
}
__device__ __forceinline__ void xcd_barrier(const XcdBarrier& b) {
    asm volatile("s_waitcnt vmcnt(0)" ::: "memory");
    __syncthreads();
    if (threadIdx.x == 0) {
        unsigned* bar = b.bar;
        __builtin_amdgcn_s_waitcnt(0);
        unsigned nloc = b.st[0], nx = b.st[1];
        if (nloc == 0u) { xcd_barrier_complete(bar, b.x, nloc, nx); b.st[0] = nloc; b.st[1] = nx; }
        const unsigned old = xb_add(&bar[XB_XSUB(b.x)], 1u);
        const unsigned gen = old / nloc;
        if (old + 1u == (gen + 1u) * nloc) {
            __builtin_amdgcn_fence(__ATOMIC_RELEASE, "agent");
            asm volatile("s_waitcnt vmcnt(0)" ::: "memory");
            const unsigned og = xb_add(&bar[XB_TOP], 1u);
            const unsigned tg = og / nx;
            if (og + 1u == (tg + 1u) * nx) xb_add(&bar[XB_TOPGEN], 1u);
            else XB_SPIN(xb_ld(&bar[XB_TOPGEN]) == tg, bar);
            __builtin_amdgcn_fence(__ATOMIC_ACQUIRE, "agent");
            xb_add(&bar[XB_XGEN(b.x)], 1u);
            asm volatile("s_waitcnt vmcnt(0)" ::: "memory");
        } else {
            XB_SPIN(xb_ld(&bar[XB_XGEN(b.x)]) == gen, bar);
            __builtin_amdgcn_fence(__ATOMIC_ACQUIRE, "agent");
            asm volatile("s_waitcnt vmcnt(0)" ::: "memory");
        }
    }
    __syncthreads();
}

struct ALoadNorm {
    const float* x; const float* rinv; const float* gain; const float* mscale; const float* mshift;
    __device__ __forceinline__ float operator()(int t, int i) const { return x[(size_t)t * D + i] * rinv[t] * gain[i] * (1.f + mscale[i]) + mshift[i]; }
};
struct ALoadBf16 {
    const bf16_t* a;
    __device__ __forceinline__ float operator()(int t, int i) const { return bf2f(a[(size_t)t * D + i]); }
};
struct EpiInproj {
    bf16_t* P; const float2* rope; const float* qg; const float* kg;
    __device__ __forceinline__ void operator()(float (*Cs)[65], int m0, int n0, int tid) const {
        const int type = n0 / 512, head = (n0 % 512) / 64, tl = tid >> 2, part = tid & 3, t = m0 + tl;
        bf16_t* out = P + (size_t)type * T * 512 + (size_t)t * 512 + head * 64;
        const float* row = Cs[tl];
        if (type <= 1) {
            const float sc = type == 1 ? 0.125f : 1.f;
            for (int q = 0; q < 8; ++q) { const int d = part * 8 + q; const float2 cs = rope[t * 32 + d]; const float x1 = row[d], x2 = row[d + 32];
                out[d] = f2bf((x1 * cs.x - x2 * cs.y) * sc); out[d + 32] = f2bf((x2 * cs.x + x1 * cs.y) * sc); }
        } else if (type == 2 || type == 6) {
            for (int q = 0; q < 16; ++q) { const int d = part * 16 + q; out[d] = f2bf(row[d]); }
        } else if (type == 3) {
            for (int q = 0; q < 16; ++q) { const int d = part * 16 + q; const float v = row[d]; out[d] = f2bf(v / (1.f + expf(-v))); }
        } else {
            float ss = 0.f; for (int d = 0; d < 64; ++d) ss += row[d] * row[d];
            const float r = 1.0f / sqrtf(ss * (1.f / 64.f) + EPS);
            const float* g = type == 4 ? qg : kg; const float sc = type == 4 ? 0.125f : 1.f;
            for (int q = 0; q < 16; ++q) { const int d = part * 16 + q; out[d] = f2bf(row[d] * r * g[d] * sc); }
        }
    }
};
struct EpiOutproj {
    const float* x; const float* gate1; float* x1;
    __device__ __forceinline__ void operator()(float (*Cs)[65], int m0, int n0, int tid) const {
        for (int e = tid; e < 4096; e += 256) { const int r = e >> 6, c = e & 63; const size_t o = (size_t)(m0 + r) * D + n0 + c; x1[o] = x[o] + gate1[n0 + c] * Cs[r][c]; }
    }
};
struct EpiStore {
    float* out; int ld;
    __device__ __forceinline__ void operator()(float (*Cs)[65], int m0, int n0, int tid) const {
        for (int e = tid; e < 4096; e += 256) { const int r = e >> 6, c = e & 63; out[(size_t)(m0 + r) * ld + n0 + c] = Cs[r][c]; }
    }
};
template <class AL, class Epi>
__device__ __forceinline__ void gemm_naive_phase(unsigned char* lds, const AL al, const float* B, const int N, const Epi epi, const int bid, const int G) {
    const int half = threadIdx.x >> 8, tid = threadIdx.x & 255, tx = tid & 15, ty = tid >> 4;
    float (*As)[68] = (float (*)[68])(lds + half * 25344);
    float (*Bs)[68] = (float (*)[68])(lds + half * 25344 + 4352);
    float (*Cs)[65] = (float (*)[65])(lds + half * 25344 + 8704);
    const int NT = N / 64, units = NT * (T / 64);
    for (int U0 = 0; U0 < units; U0 += 2 * G) {
        const int U = U0 + 2 * bid + half;
        const int m0 = (U / NT) * 64, n0 = (U % NT) * 64;
        float acc[4][4];
#pragma unroll
        for (int i = 0; i < 4; ++i)
#pragma unroll
            for (int j = 0; j < 4; ++j) acc[i][j] = 0.f;
        for (int k0 = 0; k0 < 1024; k0 += 16) {
#pragma unroll
            for (int i = 0; i < 4; ++i) { const int r = (tid >> 4) + 16 * i, c = tid & 15; As[c][r] = al(m0 + r, k0 + c); }
#pragma unroll
            for (int i = 0; i < 4; ++i) { const int r = (tid >> 6) + 4 * i, c = tid & 63; Bs[r][c] = B[(size_t)(k0 + r) * N + n0 + c]; }
            __syncthreads();
#pragma unroll
            for (int kk = 0; kk < 16; ++kk) {
                float a[4], b[4];
#pragma unroll
                for (int i = 0; i < 4; ++i) { a[i] = As[kk][ty * 4 + i]; b[i] = Bs[kk][tx * 4 + i]; }
#pragma unroll
                for (int i = 0; i < 4; ++i)
#pragma unroll
                    for (int j = 0; j < 4; ++j) acc[i][j] += a[i] * b[j];
            }
            __syncthreads();
        }
#pragma unroll
        for (int i = 0; i < 4; ++i)
#pragma unroll
            for (int j = 0; j < 4; ++j) Cs[ty * 4 + i][tx * 4 + j] = acc[i][j];
        __syncthreads();
        epi(Cs, m0, n0, tid);
        __syncthreads();
    }
}


namespace pg8 {
#define PG8_LAS __attribute__((address_space(3)))
typedef short bf16x8 __attribute__((ext_vector_type(8)));
typedef float f32x4 __attribute__((ext_vector_type(4)));
typedef unsigned u32x4 __attribute__((ext_vector_type(4)));
typedef unsigned u32x2 __attribute__((ext_vector_type(2)));
constexpr int BM = 256, BK = 64, HALF = 128, HTB = HALF * BK * 2, STAGE_BYTES = 8 * HTB, NXCD = 8, WGM = 8;
__host__ __device__ __forceinline__ int lds_byte(int r, int c) { const int st = (r >> 4) * 2 + (c >> 5), rr = r & 15, cc = c & 31, ob = rr * 64 + cc * 2; return st * 1024 + (ob ^ (((ob >> 9) & 1) << 5)); }
__host__ __device__ __forceinline__ void stage_rc(int b, int& R, int& C) { const int st = b / 1024, sb = b % 1024, swz = sb ^ (((sb >> 9) & 1) << 5); R = (st >> 1) * 16 + swz / 64; C = (st & 1) * 32 + (swz % 64) / 2; }
__host__ __device__ __forceinline__ int perm32(int rho) { const int n = rho >> 4, i = rho & 15; return 8 * (i >> 2) + 4 * n + (i & 3); }
struct Unit { int pm, pn; };
struct Gemm { const bf16_t* A; const bf16_t* Bt; int M, N, K; };
struct StaticOrder {
    int nM, nN, nwg, G, c;
    __host__ __device__ void init(int M, int N, int G_, int c_) { nM = M / BM; nN = N / BM; nwg = nM * nN; G = G_; c = c_; }
    __host__ __device__ bool next(int i, Unit& u) const {
        const long L = (long)i * G + c; if (L >= nwg) return false;
        int wgid = (int)L; { const int q = nwg / NXCD, r = nwg % NXCD, xcd = wgid % NXCD, off = wgid / NXCD; wgid = (xcd < r ? xcd * (q + 1) : r * (q + 1) + (xcd - r) * q) + off; }
        const int nig = WGM * nN, gid = wgid / nig, fm = gid * WGM, gsz = (nM - fm) < WGM ? (nM - fm) : WGM;
        u.pm = fm + ((wgid % nig) % gsz); u.pn = (wgid % nig) / gsz; return true;
    }
    __device__ __forceinline__ void a_ready(const Unit&) const {}
    __device__ __forceinline__ void done(const Unit&) const {}
};
__device__ __forceinline__ unsigned cvt_pk_bf16(float lo, float hi) { unsigned r; asm volatile("v_cvt_pk_bf16_f32 %0, %1, %2" : "=v"(r) : "v"(lo), "v"(hi)); return r; }

template <class Epi, class Sched>
__device__ __forceinline__ void gemm_phase(PG8_LAS unsigned char* lds, const Gemm g, const Sched& S, const Epi& E) {
    int tid_ = threadIdx.x; asm volatile("" : "+v"(tid_));
    const int tid = tid_, wid = __builtin_amdgcn_readfirstlane(tid >> 6), lane = tid & 63, wr = wid >> 2, wc = wid & 3, fr = lane & 15, fq = lane >> 4;
    const int K = g.K, nt = K / BK;
    unsigned voffA[2], voffB[2];
#pragma unroll
    for (int i = 0; i < 2; ++i) { int R, C; stage_rc(tid * 16 + i * 8192, R, C); const int Rb = Epi::PERM ? ((R & ~31) + perm32(R & 31)) : R;
        voffA[i] = (unsigned)(R * K + C) * 2u; voffB[i] = (unsigned)(Rb * K + C) * 2u; }
    const size_t kstep = (size_t)(BK * 2);
    const size_t hstep = (size_t)HALF * K * 2;
    const size_t tstep = 2 * hstep;
    const unsigned ldsw = (unsigned)wid * 1024u;
    const int aoff = lds_byte(wr * 64 + fr, fq * 8), boff = lds_byte(wc * 32 + fr, fq * 8);
#define PG8_SA(b, h) (((b) * 2 + (h)) * HTB)
#define PG8_SB(b, h) ((4 + (b) * 2 + (h)) * HTB)
#define PG8_STAGE(bufoff, gbase, voff) do { _Pragma("unroll") for (int _i = 0; _i < 2; ++_i) \
        __builtin_amdgcn_global_load_lds((const unsigned*)((const char*)(gbase) + (voff)[_i]), (PG8_LAS unsigned*)(lds + (bufoff) + ldsw + _i * 8192), 16, 0, 0); } while (0)
#define PG8_LDA(dst, b, h) do { _Pragma("unroll") for (int m = 0; m < 4; ++m) _Pragma("unroll") for (int k = 0; k < 2; ++k) dst[m][k] = *(const PG8_LAS bf16x8*)(lds + PG8_SA(b, h) + aoff + m * 2048 + k * 1024); } while (0)
#define PG8_LDB(dst, b, h) do { _Pragma("unroll") for (int n = 0; n < 2; ++n) _Pragma("unroll") for (int k = 0; k < 2; ++k) dst[n][k] = *(const PG8_LAS bf16x8*)(lds + PG8_SB(b, h) + boff + n * 2048 + k * 1024); } while (0)
#define PG8_MMA(ai, bj, At, Bt) do { __builtin_amdgcn_s_setprio(1); _Pragma("unroll") for (int m = 0; m < 4; ++m) _Pragma("unroll") for (int n = 0; n < 2; ++n) _Pragma("unroll") for (int k = 0; k < 2; ++k) \
        acc[ai][bj][m][n] = __builtin_amdgcn_mfma_f32_16x16x32_bf16(Bt[n][k], At[m][k], acc[ai][bj][m][n], 0, 0, 0); __builtin_amdgcn_s_setprio(0); } while (0)
#define PG8_WAIT_V(n) asm volatile("s_waitcnt vmcnt(" #n ")" ::: "memory")
#define PG8_WAIT_L(n) asm volatile("s_waitcnt lgkmcnt(" #n ")" ::: "memory")
#define PG8_BAR __builtin_amdgcn_s_barrier()
#define PG8_SCHED __builtin_amdgcn_sched_barrier(0)
    Unit cur, nxt; int ui = 0;
    if (!S.next(0, cur)) return;
    f32x4 acc[2][2][4][2];
#pragma unroll
    for (int a = 0; a < 2; ++a)
#pragma unroll
        for (int b = 0; b < 2; ++b)
#pragma unroll
            for (int m = 0; m < 4; ++m)
#pragma unroll
                for (int n = 0; n < 2; ++n) acc[a][b][m][n] = (f32x4){0.f, 0.f, 0.f, 0.f};
    bf16x8 At[4][2], B0[2][2], B1[2][2];
    const char* cA = (const char*)g.A + (size_t)cur.pm * tstep; const char* cB = (const char*)g.Bt + (size_t)cur.pn * tstep;
    S.a_ready(cur);
    PG8_STAGE(PG8_SB(0, 0), cB, voffB); PG8_STAGE(PG8_SA(0, 0), cA, voffA); PG8_STAGE(PG8_SB(0, 1), cB + hstep, voffB); PG8_STAGE(PG8_SA(0, 1), cA + hstep, voffA);
    if (wr == 1) PG8_BAR;
    PG8_WAIT_V(4); PG8_BAR;
    PG8_STAGE(PG8_SB(1, 0), cB + kstep, voffB); PG8_STAGE(PG8_SA(1, 0), cA + kstep, voffA); PG8_STAGE(PG8_SB(1, 1), cB + hstep + kstep, voffB);
    PG8_WAIT_V(6); PG8_BAR;
    for (;;) {
        const bool has_next = S.next(ui + 1, nxt);
        const char* nA = has_next ? (const char*)g.A + (size_t)nxt.pm * tstep : cA; const char* nB = has_next ? (const char*)g.Bt + (size_t)nxt.pn * tstep : cB;
        for (int t = 0; t < nt; t += 2) {
            const bool last = (t == nt - 2);
            const char* a1 = cA + (size_t)(t + 1) * kstep;
            const char* a2 = last ? nA : cA + (size_t)(t + 2) * kstep; const char* b2 = last ? nB : cB + (size_t)(t + 2) * kstep;
            const char* a3 = a2 + kstep; const char* b3 = b2 + kstep;
            if (last && has_next) S.a_ready(nxt);
            PG8_LDB(B0, 0, 0); PG8_SCHED; PG8_LDA(At, 0, 0); PG8_STAGE(PG8_SA(1, 1), a1 + hstep, voffA);
            PG8_WAIT_L(8); PG8_BAR; PG8_WAIT_L(0); PG8_MMA(0, 0, At, B0); PG8_BAR; PG8_SCHED;
            PG8_LDB(B1, 0, 1); PG8_STAGE(PG8_SB(0, 0), b2, voffB);
            PG8_BAR; PG8_WAIT_L(0); PG8_MMA(0, 1, At, B1); PG8_BAR;
            PG8_LDA(At, 0, 1); PG8_STAGE(PG8_SA(0, 0), a2, voffA);
            PG8_BAR; PG8_WAIT_L(0); PG8_MMA(1, 0, At, B0); PG8_BAR; PG8_SCHED;
            PG8_STAGE(PG8_SB(0, 1), b2 + hstep, voffB);
            PG8_WAIT_V(6); PG8_BAR; PG8_MMA(1, 1, At, B1); PG8_BAR;
            PG8_LDB(B0, 1, 0); PG8_SCHED; PG8_LDA(At, 1, 0); PG8_STAGE(PG8_SA(0, 1), a2 + hstep, voffA);
            PG8_WAIT_L(8); PG8_BAR; PG8_WAIT_L(0); PG8_MMA(0, 0, At, B0); PG8_BAR; PG8_SCHED;
            PG8_LDB(B1, 1, 1); PG8_STAGE(PG8_SB(1, 0), b3, voffB);
            PG8_BAR; PG8_WAIT_L(0); PG8_MMA(0, 1, At, B1); PG8_BAR;
            PG8_LDA(At, 1, 1); PG8_STAGE(PG8_SA(1, 0), a3, voffA);
            PG8_BAR; PG8_WAIT_L(0); PG8_MMA(1, 0, At, B0); PG8_BAR; PG8_SCHED;
            PG8_STAGE(PG8_SB(1, 1), b3 + hstep, voffB);
            PG8_WAIT_V(6); PG8_BAR; PG8_MMA(1, 1, At, B1); PG8_BAR;
        }
        if constexpr (!Epi::AFTER_DRAIN) { E(acc, cur, wr, wc, fr, fq); S.done(cur); }
        if (!has_next) break;
#pragma unroll
        for (int a = 0; a < 2; ++a)
#pragma unroll
            for (int b = 0; b < 2; ++b)
#pragma unroll
                for (int m = 0; m < 4; ++m)
#pragma unroll
                    for (int n = 0; n < 2; ++n) acc[a][b][m][n] = (f32x4){0.f, 0.f, 0.f, 0.f};
        cur = nxt; cA = nA; cB = nB; ++ui;
    }
    PG8_WAIT_V(0);
    if (wr == 0) PG8_BAR;
    PG8_BAR;
    if constexpr (Epi::AFTER_DRAIN) { E.fused(acc, cur, wr, wc, fr, fq, lds, wid, lane); S.done(cur); }
#undef PG8_SA
#undef PG8_SB
#undef PG8_STAGE
#undef PG8_LDA
#undef PG8_LDB
#undef PG8_MMA
#undef PG8_WAIT_V
#undef PG8_WAIT_L
#undef PG8_BAR
#undef PG8_SCHED
}
}

__host__ __device__ __forceinline__ int cmap_in(int F) { return (F & ~255) + 128 * ((F >> 5) & 1) + 32 * ((F >> 6) & 3) + (F & 31); }
struct EpiInprojMF {
    static constexpr bool PERM = true, AFTER_DRAIN = false;
    bf16_t* P; const float* rinv; const float* bias_f; const float2* rope; const float* qg; const float* kg;
    __device__ __forceinline__ void operator()(const pg8::f32x4 (&acc)[2][2][4][2], const pg8::Unit& u, int wr, int wc, int fr, int fq) const {
        typedef pg8::f32x4 f32x4;
        const int type = u.pn >> 1, head = 4 * (u.pn & 1) + wc, fb = 256 * u.pn + 64 * wc;
        const size_t PSZ = (size_t)T * 512;
        bf16_t* rowmaj = P + (size_t)type * PSZ;
        bf16_t* transp = P + (size_t)(type == 1 ? 7 : (type == 2 ? 8 : 9)) * PSZ;
        const bool want_t = false && (type == 1 || type == 2 || type == 6);
        f32x4 bv[2][2], gv[2][2];
        const float* gsrc = (type == 4) ? qg : kg;
#pragma unroll
        for (int bj = 0; bj < 2; ++bj)
#pragma unroll
            for (int n = 0; n < 2; ++n) { bv[bj][n] = *(const f32x4*)(bias_f + fb + 32 * bj + 8 * fq + 4 * n); gv[bj][n] = *(const f32x4*)(gsrc + 32 * bj + 8 * fq + 4 * n); }
#pragma unroll
        for (int ai = 0; ai < 2; ++ai)
#pragma unroll
            for (int m = 0; m < 4; ++m) {
                const int t = u.pm * 256 + ai * 128 + wr * 64 + m * 16 + fr;
                const float r = rinv[t];
                f32x4 v[2][2];
#pragma unroll
                for (int bj = 0; bj < 2; ++bj)
#pragma unroll
                    for (int n = 0; n < 2; ++n) v[bj][n] = acc[ai][bj][m][n] * r + bv[bj][n];
                if (type <= 1) {
                    const float sc = (type == 1) ? 0.125f : 1.f;
                    const f32x4* rp = (const f32x4*)(rope + (size_t)t * 32 + 8 * fq);
#pragma unroll
                    for (int n = 0; n < 2; ++n) {
                        const f32x4 cs0 = rp[2 * n], cs1 = rp[2 * n + 1];
                        const float cc[4] = {cs0[0], cs0[2], cs1[0], cs1[2]}, sn[4] = {cs0[1], cs0[3], cs1[1], cs1[3]};
#pragma unroll
                        for (int j = 0; j < 4; ++j) { const float x1 = v[0][n][j], x2 = v[1][n][j]; v[0][n][j] = (x1 * cc[j] - x2 * sn[j]) * sc; v[1][n][j] = (x2 * cc[j] + x1 * sn[j]) * sc; }
                    }
                } else if (type == 3) {
#pragma unroll
                    for (int bj = 0; bj < 2; ++bj)
#pragma unroll
                        for (int n = 0; n < 2; ++n)
#pragma unroll
                            for (int j = 0; j < 4; ++j) { const float x = v[bj][n][j]; v[bj][n][j] = x / (1.f + __expf(-x)); }
                } else if (type == 4 || type == 5) {
                    float ss = 0.f;
#pragma unroll
                    for (int bj = 0; bj < 2; ++bj)
#pragma unroll
                        for (int n = 0; n < 2; ++n)
#pragma unroll
                            for (int j = 0; j < 4; ++j) ss += v[bj][n][j] * v[bj][n][j];
                    ss += __shfl_xor(ss, 16); ss += __shfl_xor(ss, 32);
                    const float rn = (1.0f / sqrtf(ss * (1.f / 64.f) + EPS)) * ((type == 4) ? 0.125f : 1.f);
#pragma unroll
                    for (int bj = 0; bj < 2; ++bj)
#pragma unroll
                        for (int n = 0; n < 2; ++n) v[bj][n] = v[bj][n] * rn * gv[bj][n];
                }
#pragma unroll
                for (int bj = 0; bj < 2; ++bj) {
                    pg8::u32x4 w; w.x = pg8::cvt_pk_bf16(v[bj][0][0], v[bj][0][1]); w.y = pg8::cvt_pk_bf16(v[bj][0][2], v[bj][0][3]);
                    w.z = pg8::cvt_pk_bf16(v[bj][1][0], v[bj][1][1]); w.w = pg8::cvt_pk_bf16(v[bj][1][2], v[bj][1][3]);
                    *(pg8::u32x4*)(rowmaj + (size_t)t * 512 + head * 64 + 32 * bj + 8 * fq) = w;
                    if (want_t) {
                        const unsigned ww[4] = {w.x, w.y, w.z, w.w};
#pragma unroll
                        for (int q = 0; q < 8; ++q) transp[(size_t)(head * 64 + 32 * bj + 8 * fq + q) * T + t] = (bf16_t)((ww[q >> 1] >> (16 * (q & 1))) & 0xffffu);
                    }
                }
            }
    }
};


struct EpiOutprojMF {
    static constexpr bool PERM = false, AFTER_DRAIN = false;
    const float* x; const float* gate1; float* x1; bf16_t* x1b; float* part2;
    __device__ __forceinline__ void operator()(const pg8::f32x4 (&acc)[2][2][4][2], const pg8::Unit& u, int wr, int wc, int fr, int fq) const {
        typedef pg8::f32x4 f32x4;
        const int col0 = u.pn * 256 + wc * 32 + 4 * fq;
        f32x4 gv[2][2];
#pragma unroll
        for (int bj = 0; bj < 2; ++bj)
#pragma unroll
            for (int n = 0; n < 2; ++n) gv[bj][n] = *(const f32x4*)(gate1 + col0 + bj * 128 + n * 16);
#pragma unroll
        for (int ai = 0; ai < 2; ++ai)
#pragma unroll
            for (int m = 0; m < 4; ++m) {
                const int row = u.pm * 256 + ai * 128 + wr * 64 + m * 16 + fr; const size_t off = (size_t)row * D + col0;
                float ss = 0.f;
#pragma unroll
                for (int bj = 0; bj < 2; ++bj)
#pragma unroll
                    for (int n = 0; n < 2; ++n) {
                        const f32x4 xv = *(const f32x4*)(x + off + bj * 128 + n * 16);
                        const f32x4 o = xv + gv[bj][n] * acc[ai][bj][m][n];
                        *(f32x4*)(x1 + off + bj * 128 + n * 16) = o;
                        pg8::u32x2 w; w.x = pg8::cvt_pk_bf16(o[0], o[1]); w.y = pg8::cvt_pk_bf16(o[2], o[3]);
                        *(pg8::u32x2*)(x1b + off + bj * 128 + n * 16) = w;
                        ss += o[0] * o[0] + o[1] * o[1] + o[2] * o[2] + o[3] * o[3];
                    }
                ss += __shfl_xor(ss, 16); ss += __shfl_xor(ss, 32);
                if (fq == 0) part2[(size_t)row * 16 + u.pn * 4 + wc] = ss;
            }
    }
};
struct EpiScoresMF {
    static constexpr bool PERM = false, AFTER_DRAIN = false;
    const float* part2; const float* bias_q; float* scores;
    __device__ __forceinline__ void operator()(const pg8::f32x4 (&acc)[2][2][4][2], const pg8::Unit& u, int wr, int wc, int fr, int fq) const {
        typedef pg8::f32x4 f32x4;
        const int col0 = u.pn * 256 + wc * 32 + 4 * fq;
        f32x4 bv[2][2];
#pragma unroll
        for (int bj = 0; bj < 2; ++bj)
#pragma unroll
            for (int n = 0; n < 2; ++n) bv[bj][n] = *(const f32x4*)(bias_q + col0 + bj * 128 + n * 16);
#pragma unroll
        for (int ai = 0; ai < 2; ++ai)
#pragma unroll
            for (int m = 0; m < 4; ++m) {
                const int row = u.pm * 256 + ai * 128 + wr * 64 + m * 16 + fr;
                const f32x4* pp = (const f32x4*)(part2 + (size_t)row * 16);
                const f32x4 p0 = pp[0], p1 = pp[1], p2 = pp[2], p3 = pp[3];
                const float ssum = ((p0[0] + p0[1]) + (p0[2] + p0[3])) + ((p1[0] + p1[1]) + (p1[2] + p1[3])) + ((p2[0] + p2[1]) + (p2[2] + p2[3])) + ((p3[0] + p3[1]) + (p3[2] + p3[3]));
                const float r = 1.0f / sqrtf(ssum * (1.0f / D) + EPS);
                float* rowp = scores + (size_t)row * 2048 + col0;
#pragma unroll
                for (int bj = 0; bj < 2; ++bj)
#pragma unroll
                    for (int n = 0; n < 2; ++n) *(f32x4*)(rowp + bj * 128 + n * 16) = acc[ai][bj][m][n] * r + bv[bj][n];
            }
    }
};

__device__ __forceinline__ unsigned pk2(float lo, float hi) { return (unsigned)f2bf(lo) | ((unsigned)f2bf(hi) << 16); }
template <bool FOLD, bool CMAP>
__device__ __forceinline__ void transpose_item(const float* W, int K, int N, bf16_t* WT, float* scr, int item, int lane, const float* sg, const float* sm) {
    const int nblk = N / 32, kb = item / nblk, nb = item % nblk, k0 = 64 * kb, n0 = 32 * nb;
#pragma unroll 8
    for (int i = 0; i < 32; ++i) { const int kk = 2 * i + (lane >> 5); float w = W[(size_t)(k0 + kk) * N + n0 + (lane & 31)];
        if (FOLD) w *= sg[k0 + kk] * (1.f + sm[k0 + kk]);
        scr[kk * 33 + (lane & 31)] = w; }
    asm volatile("s_waitcnt lgkmcnt(0)" ::: "memory");
    const int c = lane & 7, r0 = CMAP ? cmap_in(n0) : n0;
#pragma unroll
    for (int j = 0; j < 4; ++j) { const int n = (lane >> 3) + 8 * j; const float* s = scr + (8 * c) * 33 + n;
        pg8::u32x4 o; o.x = pk2(s[0 * 33], s[1 * 33]); o.y = pk2(s[2 * 33], s[3 * 33]); o.z = pk2(s[4 * 33], s[5 * 33]); o.w = pk2(s[6 * 33], s[7 * 33]);
        *(pg8::u32x4*)(WT + (size_t)(r0 + n) * K + k0 + 8 * c) = o; }
    asm volatile("s_waitcnt lgkmcnt(0)" ::: "memory");
}
template <int NC4, class VF>
__device__ __forceinline__ void gemv_cols(unsigned char* lds, const VF vf, const float* W, const int N, const int u, float* dst, const float* add) {
    constexpr int RG = 512 / NC4;
    float (*red)[NC4 * 4] = (float (*)[NC4 * 4])lds;
    const int tid = threadIdx.x, c4 = tid % NC4, rg = tid / NC4;
    if (rg < RG) {
        float4 acc = {0.f, 0.f, 0.f, 0.f};
        for (int r = rg; r < 1024; r += RG) { const float s = vf(r); const float4 w = *(const float4*)(W + (size_t)r * N + u * NC4 * 4 + c4 * 4);
            acc.x += s * w.x; acc.y += s * w.y; acc.z += s * w.z; acc.w += s * w.w; }
        red[rg][c4 * 4 + 0] = acc.x; red[rg][c4 * 4 + 1] = acc.y; red[rg][c4 * 4 + 2] = acc.z; red[rg][c4 * 4 + 3] = acc.w;
    }
    __syncthreads();
    if (tid < NC4 * 4) { float s = 0.f; for (int i = 0; i < RG; ++i) s += red[i][tid]; dst[u * NC4 * 4 + tid] = s + (add ? add[u * NC4 * 4 + tid] : 0.f); }
    __syncthreads();
}
struct VfSilu { const float* c; __device__ __forceinline__ float operator()(int r) const { const float v = c[r]; return v / (1.f + expf(-v)); } };
struct VfVec { const float* v; __device__ __forceinline__ float operator()(int r) const { return v[r]; } };

__device__ __forceinline__ void ins16(float (&s)[16], float x) {
#pragma unroll
    for (int i = 15; i >= 1; --i) s[i] = __builtin_amdgcn_fmed3f(s[i - 1], s[i], x);
    s[0] = fmaxf(s[0], x);
}

struct Params {
    const float *x, *c; const int* pos; const float *ada_w, *ada_b, *g1, *g2, *w_in, *rgain, *qg, *kg, *og, *w_out, *wq, *sk, *down, *up;
    float* out; unsigned char* ws; RopeC rc; RetC rt;
};

__global__ void __launch_bounds__(512) mk_fwd(Params p) {
    extern __shared__ __attribute__((aligned(16))) unsigned char lds[];
    const int tid = threadIdx.x, lane = tid & 63, wave = tid >> 6, bid = blockIdx.x, G = gridDim.x;
    unsigned char* ws = p.ws;
    float* mod = (float*)(ws + OFF_MOD); float* rinv1 = (float*)(ws + OFF_RINV1); float2* rope = (float2*)(ws + OFF_ROPE);
    bf16_t* P = (bf16_t*)(ws + OFF_P); float* kv = (float*)(ws + OFF_KV); float* st = (float*)(ws + OFF_ST); bf16_t* ycat = (bf16_t*)(ws + OFF_YCAT);
    bf16_t* xb = (bf16_t*)(ws + OFF_XB); bf16_t* Win_t = (bf16_t*)(ws + OFF_WINT); float* bias_f = (float*)(ws + OFF_BIASF);
    bf16_t* Weff_t = (bf16_t*)(ws + OFF_WEFFT); bf16_t* Wout_t = (bf16_t*)(ws + OFF_WOUTT); float* bias_q = (float*)(ws + OFF_BIASQ);
    float* part2 = (float*)(ws + OFF_PART2); bf16_t* x1b = (bf16_t*)(ws + OFF_X1B); unsigned short* ids = (unsigned short*)(ws + OFF_IDS); unsigned char* q8 = ws + OFF_Q8; float* qsc = (float*)(ws + OFF_QSC); float* gates = (float*)(ws + OFF_GATES); float* scores = (float*)(ws + OFF_SCORES);
    const size_t PS = (size_t)T * 512;
    const bf16_t *Qr = P, *Kr = P + PS, *Vr = P + 2 * PS, *Gr = P + 3 * PS, *Qs = P + 4 * PS, *Ks = P + 5 * PS, *Vs = P + 6 * PS;
    float* out = p.out;

    if (tid < 4) ((LAS unsigned*)((LAS unsigned char*)lds + LDS_ST_OFF))[tid] = 0u;
    __syncthreads();
    XcdBarrier bar = xcd_barrier_post((unsigned*)(ws + OFF_CTL), (volatile LAS unsigned*)((LAS unsigned char*)lds + LDS_ST_OFF));

    for (int u = bid; u < 256; u += G) gemv_cols<6>(lds, VfSilu{p.c}, p.ada_w, 6144, u, mod, p.ada_b);
    for (int row = bid * 8 + wave; row < T; row += G * 8) {
        const float4* xp = (const float4*)(p.x + (size_t)row * D);
        uint2* xo = (uint2*)(xb + (size_t)row * D);
        float s = 0.f;
#pragma unroll
        for (int j = 0; j < 4; ++j) { const float4 v = xp[lane + 64 * j]; s += v.x * v.x + v.y * v.y + v.z * v.z + v.w * v.w; xo[lane + 64 * j] = make_uint2(pk2(v.x, v.y), pk2(v.z, v.w)); }
#pragma unroll
        for (int o = 32; o > 0; o >>= 1) s += __shfl_xor(s, o);
        if (lane == 0) rinv1[row] = 1.0f / sqrtf(s * (1.0f / D) + EPS);
    }
    for (int idx = bid * 512 + tid; idx < T * 32; idx += G * 512) {
        const int t = idx >> 5, i = idx & 31;
        double rev = (double)p.pos[t] * p.rc.f[i];
        rev -= floor(rev);
        float s, c; sincospif((float)(2.0 * rev), &s, &c);
        rope[idx] = make_float2(c, s);
    }
    for (int row = bid * 8 + wave; row < 32768; row += G * 8) {
        const int isup = row >> 14, e = row & 16383;
        const float4* sp = (const float4*)((isup ? p.up : p.down) + (size_t)e * 1024 + lane * 16);
        float4 v[4]; float mx = 0.f;
#pragma unroll
        for (int q = 0; q < 4; ++q) { v[q] = sp[q]; mx = fmaxf(mx, fmaxf(fmaxf(fabsf(v[q].x), fabsf(v[q].y)), fmaxf(fabsf(v[q].z), fabsf(v[q].w)))); }
#pragma unroll
        for (int o = 32; o > 0; o >>= 1) mx = fmaxf(mx, __shfl_xor(mx, o));
        const float s = (mx > 0.f) ? exp2f(floorf(log2f(256.f / mx))) : 1.f;
        uint4 w; unsigned* wp = (unsigned*)&w;
#pragma unroll
        for (int q = 0; q < 4; ++q) { int pk = __builtin_amdgcn_cvt_pk_fp8_f32(v[q].x * s, v[q].y * s, 0, false); pk = __builtin_amdgcn_cvt_pk_fp8_f32(v[q].z * s, v[q].w * s, pk, true); wp[q] = (unsigned)pk; }
        *(uint4*)(q8 + (size_t)isup * (16u << 20) + ((size_t)(lane >> 3) * 16384 + e) * 128 + (lane & 7) * 16) = w;
        if (lane == 0) qsc[row] = 1.0f / s;
    }
    {
        float* scr = (float*)(lds + wave * 16384);
        for (int it = bid * 8 + wave; it < 16 * 32; it += G * 8) transpose_item<false, false>(p.w_out, 1024, 1024, Wout_t, scr, it, lane, nullptr, nullptr);
    }
    xcd_barrier(bar);

    {
        float* scr = (float*)(lds + wave * 16384);
        for (int it = bid * 8 + wave; it < 16 * 112; it += G * 8) transpose_item<true, true>(p.w_in, 1024, 3584, Win_t, scr, it, lane, p.g1, mod + 1024);
        __syncthreads();
        for (int u = bid; u < 128; u += G) gemv_cols<7>(lds, VfVec{mod}, p.w_in, 3584, u, bias_f, nullptr);
        for (int U = bid; U < 256; U += G) {
            const int hp = U >> 4, k0 = (U & 15) * 8;
            float (*sks)[128] = (float (*)[128])lds; float* redb = (float*)(lds + 4096);
            for (int e = tid; e < 1024; e += 512) sks[e >> 7][e & 127] = p.sk[((size_t)hp * 128 + k0 + (e >> 7)) * 128 + (e & 127)];
            __syncthreads();
            float bsum[8];
#pragma unroll
            for (int kk = 0; kk < 8; ++kk) bsum[kk] = 0.f;
            for (int rr = 0; rr < 2; ++rr) {
                const int i = tid + 512 * rr;
                const float4* a4 = (const float4*)(p.wq + (size_t)i * 2048 + hp * 128);
                float acc[8];
#pragma unroll
                for (int kk = 0; kk < 8; ++kk) acc[kk] = 0.f;
                for (int c4 = 0; c4 < 32; ++c4) { const float4 a = a4[c4];
#pragma unroll
                    for (int kk = 0; kk < 8; ++kk) { const float4 b = *(const float4*)&sks[kk][4 * c4]; acc[kk] += a.x * b.x + a.y * b.y + a.z * b.z + a.w * b.w; } }
                const float s2 = p.g2[i] * (1.f + mod[4096 + i]), sh = mod[3072 + i];
#pragma unroll
                for (int kk = 0; kk < 8; ++kk) { Weff_t[(size_t)(hp * 128 + k0 + kk) * 1024 + i] = f2bf(acc[kk] * s2); bsum[kk] += sh * acc[kk]; }
            }
#pragma unroll
            for (int kk = 0; kk < 8; ++kk) { float v = bsum[kk];
#pragma unroll
                for (int o = 32; o > 0; o >>= 1) v += __shfl_xor(v, o);
                if (lane == 0) redb[wave * 8 + kk] = v; }
            __syncthreads();
            if (tid < 8) { float s = 0.f; for (int w = 0; w < 8; ++w) s += redb[w * 8 + tid]; bias_q[hp * 128 + k0 + tid] = s; }
            __syncthreads();
        }
    }
    xcd_barrier(bar);

    {
        pg8::Gemm g{xb, Win_t, T, 3584, 1024}; pg8::StaticOrder S; S.init(T, 3584, G, bid);
        EpiInprojMF E{P, rinv1, bias_f, rope, p.qg, p.kg};
        pg8::gemm_phase<EpiInprojMF, pg8::StaticOrder>((PG8_LAS unsigned char*)lds, g, S, E);
    }
    xcd_barrier(bar);

    for (int U = bid; U < 1024; U += G) {
        float (*ks)[64] = (float (*)[64])lds; float (*vs)[64] = (float (*)[64])(lds + 32768);
        const int n = U >> 3, h = U & 7;
        for (int e = tid; e < 128 * 64; e += 512) { const int j = e >> 6, d = e & 63; const size_t g = (size_t)(n * 128 + j) * 512 + h * 64 + d;
            ks[j][d] = bf2f(Kr[g]) * exp2f((float)(127 - j) * p.rt.lg2[h]); vs[j][d] = bf2f(Vr[g]); }
        __syncthreads();
        if (tid < 256) {
            const int d = tid >> 2, e0 = (tid & 3) * 16;
            float acc[16];
#pragma unroll
            for (int q = 0; q < 16; ++q) acc[q] = 0.f;
            for (int j = 0; j < 128; ++j) { const float kk = ks[j][d];
#pragma unroll
                for (int q = 0; q < 16; ++q) acc[q] += kk * vs[j][e0 + q]; }
#pragma unroll
            for (int q = 0; q < 16; ++q) kv[((size_t)(n * 8 + h) * 64 + d) * 64 + e0 + q] = acc[q];
        }
        __syncthreads();
    }
    for (int u = bid * 8 + wave; u < 2048; u += G * 8) {
        const int h = u & 7, t = (u >> 3) * 64 + lane;
        float q[64], acc[64];
        {
            const uint4* qp = (const uint4*)(Qs + (size_t)t * 512 + h * 64);
#pragma unroll
            for (int c = 0; c < 8; ++c) { const uint4 w4 = qp[c]; const unsigned w[4] = {w4.x, w4.y, w4.z, w4.w};
#pragma unroll
                for (int k = 0; k < 4; ++k) { q[c * 8 + 2 * k] = __uint_as_float(w[k] << 16); q[c * 8 + 2 * k + 1] = __uint_as_float(w[k] & 0xffff0000u); } }
        }
#pragma unroll
        for (int d = 0; d < 64; ++d) acc[d] = 0.f;
        float R = 0.f;
        for (int s = t - 1; s >= 0; --s) {
            if (R > 88.f) break;
            const uint4* kp = (const uint4*)(Ks + (size_t)s * 512 + h * 64);
            float z = 0.f;
#pragma unroll
            for (int c = 0; c < 8; ++c) { const uint4 w4 = kp[c]; const unsigned w[4] = {w4.x, w4.y, w4.z, w4.w};
#pragma unroll
                for (int k = 0; k < 4; ++k) { z += q[c * 8 + 2 * k] * __uint_as_float(w[k] << 16); z += q[c * 8 + 2 * k + 1] * __uint_as_float(w[k] & 0xffff0000u); } }
            const float sp = fmaxf(z, 0.f) + log1pf(expf(-fabsf(z)));
            const float wgt = expf(z - sp - R);
            const uint4* vp = (const uint4*)(Vs + (size_t)s * 512 + h * 64);
#pragma unroll
            for (int c = 0; c < 8; ++c) { const uint4 w4 = vp[c]; const unsigned w[4] = {w4.x, w4.y, w4.z, w4.w};
#pragma unroll
                for (int k = 0; k < 4; ++k) { acc[c * 8 + 2 * k] += wgt * __uint_as_float(w[k] << 16); acc[c * 8 + 2 * k + 1] += wgt * __uint_as_float(w[k] & 0xffff0000u); } }
            R += sp;
        }
        float ss = 0.f;
#pragma unroll
        for (int d = 0; d < 64; ++d) ss += acc[d] * acc[d];
        const float r = 1.0f / sqrtf(ss * (1.f / 64.f) + EPS);
#pragma unroll
        for (int d = 0; d < 64; ++d) ycat[(size_t)t * 1024 + 512 + h * 64 + d] = f2bf(acc[d] * r * p.og[d]);
    }
    xcd_barrier(bar);

    for (int idx = bid * 512 + tid; idx < 32768; idx += G * 512) {
        const int h = idx >> 12;
        const float cd = exp2f(128.f * p.rt.lg2[h]);
        float s = 0.f;
        for (int n = 0; n < 128; ++n) { st[(size_t)n * 32768 + idx] = s; s = cd * s + kv[(size_t)n * 32768 + idx]; }
    }
    xcd_barrier(bar);

    for (int U = bid; U < 1024; U += G) {
        float (*ks)[64] = (float (*)[64])lds; float (*vs)[64] = (float (*)[64])(lds + 32768); float (*ss)[64] = (float (*)[64])(lds + 65536);
        const int n = U >> 3, h = U & 7;
        for (int e = tid; e < 128 * 64; e += 512) { const int j = e >> 6, d = e & 63; const size_t g = (size_t)(n * 128 + j) * 512 + h * 64 + d; ks[j][d] = bf2f(Kr[g]); vs[j][d] = bf2f(Vr[g]); }
        for (int e = tid; e < 4096; e += 512) ss[e >> 6][e & 63] = st[(size_t)(n * 8 + h) * 4096 + e];
        __syncthreads();
        if (tid < 128) {
            const int i = tid, t = n * 128 + i;
            float q[64], acc[64];
#pragma unroll
            for (int d = 0; d < 64; ++d) { q[d] = bf2f(Qr[(size_t)t * 512 + h * 64 + d]); acc[d] = 0.f; }
            const float lg = p.rt.lg2[h];
            const float xi = exp2f((float)(i + 1) * lg);
#pragma unroll
            for (int d = 0; d < 64; ++d) { const float qd = q[d] * xi;
#pragma unroll
                for (int e = 0; e < 64; ++e) acc[e] += qd * ss[d][e]; }
            for (int j = 0; j <= i; ++j) {
                float s = 0.f;
#pragma unroll
                for (int d = 0; d < 64; ++d) s += q[d] * ks[j][d];
                s *= exp2f((float)(i - j) * lg);
#pragma unroll
                for (int e = 0; e < 64; ++e) acc[e] += s * vs[j][e];
            }
            float mean = 0.f;
#pragma unroll
            for (int e = 0; e < 64; ++e) mean += acc[e];
            mean *= (1.f / 64.f);
            float var = 0.f;
#pragma unroll
            for (int e = 0; e < 64; ++e) { const float dlt = acc[e] - mean; var += dlt * dlt; }
            const float r = 1.0f / sqrtf(var * (1.f / 64.f) + EPS);
#pragma unroll
            for (int e = 0; e < 64; ++e) ycat[(size_t)t * 1024 + h * 64 + e] = f2bf((acc[e] - mean) * r * p.rgain[h * 64 + e] * bf2f(Gr[(size_t)t * 512 + h * 64 + e]));
        }
        __syncthreads();
    }
    xcd_barrier(bar);

    {
        pg8::Gemm g{ycat, Wout_t, T, 1024, 1024}; pg8::StaticOrder S; S.init(T, 1024, G, bid);
        EpiOutprojMF E{p.x, mod + 2048, out, x1b, part2};
        pg8::gemm_phase<EpiOutprojMF, pg8::StaticOrder>((PG8_LAS unsigned char*)lds, g, S, E);
    }
    xcd_barrier(bar);

    {
        pg8::Gemm g{x1b, Weff_t, T, 2048, 1024}; pg8::StaticOrder S; S.init(T, 2048, G, bid);
        EpiScoresMF E{part2, bias_q, scores};
        pg8::gemm_phase<EpiScoresMF, pg8::StaticOrder>((PG8_LAS unsigned char*)lds, g, S, E);
    }
    xcd_barrier(bar);

    for (int idx = bid * 512 + tid; idx < T * 8; idx += G * 512) {
        const int t = idx >> 3, h = idx & 7;
        const float* sc = scores + (size_t)t * 2048 + h * 256;
        float s0[16], s1[16], tl[16];
#pragma unroll
        for (int i = 0; i < 16; ++i) { s0[i] = -INFINITY; s1[i] = -INFINITY; tl[i] = -INFINITY; }
        for (int k = 0; k < 128; k += 4) {
            const float4 v = *(const float4*)(sc + k);
            ins16(s0, __uint_as_float((__float_as_uint(v.x) & 0xFFFFFF80u) | (unsigned)(k + 0)));
            ins16(s0, __uint_as_float((__float_as_uint(v.y) & 0xFFFFFF80u) | (unsigned)(k + 1)));
            ins16(s0, __uint_as_float((__float_as_uint(v.z) & 0xFFFFFF80u) | (unsigned)(k + 2)));
            ins16(s0, __uint_as_float((__float_as_uint(v.w) & 0xFFFFFF80u) | (unsigned)(k + 3)));
        }
        for (int k = 0; k < 128; k += 4) {
            const float4 v = *(const float4*)(sc + 128 + k);
            ins16(s1, __uint_as_float((__float_as_uint(v.x) & 0xFFFFFF80u) | (unsigned)(k + 0)));
            ins16(s1, __uint_as_float((__float_as_uint(v.y) & 0xFFFFFF80u) | (unsigned)(k + 1)));
            ins16(s1, __uint_as_float((__float_as_uint(v.z) & 0xFFFFFF80u) | (unsigned)(k + 2)));
            ins16(s1, __uint_as_float((__float_as_uint(v.w) & 0xFFFFFF80u) | (unsigned)(k + 3)));
        }
#pragma unroll
        for (int a = 0; a < 16; ++a)
#pragma unroll
            for (int b = 0; b < 16; ++b)
                if ((a + 1) * (b + 1) <= 16) {
                    const float v = __uint_as_float(__float_as_uint(s0[a]) & 0xFFFFFF80u) + __uint_as_float(__float_as_uint(s1[b]) & 0xFFFFFF80u);
                    ins16(tl, __uint_as_float((__float_as_uint(v) & 0xFFFFFF00u) | (unsigned)(a * 16 + b)));
                }
        float ev[16]; float sum = 0.f;
        const float mx = __uint_as_float(__float_as_uint(tl[0]) & 0xFFFFFF00u);
#pragma unroll
        for (int j = 0; j < 16; ++j) { ev[j] = expf(__uint_as_float(__float_as_uint(tl[j]) & 0xFFFFFF00u) - mx); sum += ev[j]; }
        const float inv = 1.f / sum;
#pragma unroll
        for (int j = 0; j < 16; ++j) {
            const unsigned code = __float_as_uint(tl[j]) & 0xFFu; const int a = (int)(code >> 4), b = (int)(code & 15u);
            int i0 = 0, i1 = 0;
#pragma unroll
            for (int k = 0; k < 16; ++k) { i0 = (a == k) ? (int)(__float_as_uint(s0[k]) & 0x7Fu) : i0; i1 = (b == k) ? (int)(__float_as_uint(s1[k]) & 0x7Fu) : i1; }
            ids[(size_t)t * 128 + h * 16 + j] = (unsigned short)(i0 * 128 + i1);
            gates[(size_t)t * 128 + h * 16 + j] = ev[j] * inv;
        }
    }
    xcd_barrier(bar);

    {
        constexpr int IDS_LD = 136, ACT_LD = 136;
        const float* scale2 = mod + 4096; const float* shift2 = mod + 3072; const float* gate2 = mod + 5120;
        unsigned short* ids_l = (unsigned short*)lds; float* act_l = (float*)(lds + 32768);
        const int t0 = bid * 64, tt = lane >> 3, sub = lane & 7, tl = wave * 8 + tt, t = t0 + tl;
        for (int e = tid; e < 1024; e += 512) { const int r = e >> 4, c8 = e & 15; *(uint4*)(ids_l + r * IDS_LD + c8 * 8) = *(const uint4*)(ids + (size_t)(t0 + r) * 128 + c8 * 8); }
        for (int e = tid; e < 64 * ACT_LD; e += 512) act_l[e] = 0.f;
        __syncthreads();
        float ri;
        { const float4* pp = (const float4*)(part2 + (size_t)t * 16); const float4 p0 = pp[0], p1 = pp[1], p2 = pp[2], p3 = pp[3];
          const float ssum = ((p0.x + p0.y) + (p0.z + p0.w)) + ((p1.x + p1.y) + (p1.z + p1.w)) + ((p2.x + p2.y) + (p2.z + p2.w)) + ((p3.x + p3.y) + (p3.z + p3.w));
          ri = 1.0f / sqrtf(ssum * (1.0f / D) + EPS); }
        const unsigned short* myids = ids_l + tl * IDS_LD;
        float* myact = act_l + tl * ACT_LD;
        const bool s4 = (sub & 4) != 0, s2 = (sub & 2) != 0, s1 = (sub & 1) != 0;
        for (int c = 0; c < 8; ++c) {
            float hv[16];
            const int col = 128 * c + 16 * sub;
#pragma unroll
            for (int q = 0; q < 4; ++q) {
                const float4 xv = *(const float4*)(out + (size_t)t * D + col + 4 * q);
                const float4 g = *(const float4*)(p.g2 + col + 4 * q), sc = *(const float4*)(scale2 + col + 4 * q), sh = *(const float4*)(shift2 + col + 4 * q);
                hv[4 * q + 0] = xv.x * ri * g.x * (1.f + sc.x) + sh.x; hv[4 * q + 1] = xv.y * ri * g.y * (1.f + sc.y) + sh.y;
                hv[4 * q + 2] = xv.z * ri * g.z * (1.f + sc.z) + sh.z; hv[4 * q + 3] = xv.w * ri * g.w * (1.f + sc.w) + sh.w;
            }
            const unsigned char* base = q8 + (size_t)c * (16384 * 128) + sub * 16;
#pragma unroll 2
            for (int jb = 0; jb < 16; ++jb) {
                const uint4 idv = *(const uint4*)(myids + 8 * jb); const unsigned idw[4] = {idv.x, idv.y, idv.z, idv.w};
                uint4 w[8];
#pragma unroll
                for (int k = 0; k < 8; ++k) { const unsigned id = (idw[k >> 1] >> (16 * (k & 1))) & 0xffffu; w[k] = *(const uint4*)(base + (size_t)id * 128); }
                float pd[8];
#pragma unroll
                for (int k = 0; k < 8; ++k) {
                    const unsigned ww[4] = {w[k].x, w[k].y, w[k].z, w[k].w};
                    float s = 0.f;
#pragma unroll
                    for (int m = 0; m < 4; ++m) { const auto lo = __builtin_amdgcn_cvt_pk_f32_fp8((int)ww[m], false); const auto hi = __builtin_amdgcn_cvt_pk_f32_fp8((int)ww[m], true);
                        s += hv[4 * m] * lo[0] + hv[4 * m + 1] * lo[1] + hv[4 * m + 2] * hi[0] + hv[4 * m + 3] * hi[1]; }
                    pd[k] = s;
                }
                float r4[4], r2[2];
#pragma unroll
                for (int k = 0; k < 4; ++k) { const float snd = s4 ? pd[k] : pd[k + 4], kp = s4 ? pd[k + 4] : pd[k]; r4[k] = kp + __shfl_xor(snd, 4); }
#pragma unroll
                for (int k = 0; k < 2; ++k) { const float snd = s2 ? r4[k] : r4[k + 2], kp = s2 ? r4[k + 2] : r4[k]; r2[k] = kp + __shfl_xor(snd, 2); }
                const float snd = s1 ? r2[0] : r2[1], kp = s1 ? r2[1] : r2[0];
                myact[8 * jb + sub] += kp + __shfl_xor(snd, 1);
            }
        }
        for (int jb = 0; jb < 16; ++jb) {
            const int j = 8 * jb + sub; const unsigned id = myids[j];
            const float a = myact[j] * qsc[id];
            const float av = fabsf(a), tq = 1.0f / (av * 0.2316418882f + 1.0f);
            float ql = tq * 0.5307027145f + (-0.7265760135f); ql = ql * tq + 0.7107068705f; ql = ql * tq + (-0.142248368f); ql = ql * tq + 0.127414796f; ql = ql * tq;
            const float mm = a * (ql * exp2f(a * a * (-0.72134752044f)));
            const float ge = (a < 0.f) ? mm : (a - mm);
            myact[j] = ge * gates[(size_t)t * 128 + j] * qsc[16384 + id];
        }
        __syncthreads();
        for (int c = 0; c < 8; ++c) {
            float o[16];
#pragma unroll
            for (int q = 0; q < 16; ++q) o[q] = 0.f;
            const int col = 128 * c + 16 * sub;
            const unsigned char* base = q8 + (16u << 20) + (size_t)c * (16384 * 128) + sub * 16;
#pragma unroll 2
            for (int jb = 0; jb < 16; ++jb) {
                const uint4 idv = *(const uint4*)(myids + 8 * jb); const unsigned idw[4] = {idv.x, idv.y, idv.z, idv.w};
                const float4 a0 = *(const float4*)(myact + 8 * jb), a1 = *(const float4*)(myact + 8 * jb + 4);
                const float av[8] = {a0.x, a0.y, a0.z, a0.w, a1.x, a1.y, a1.z, a1.w};
                uint4 w[8];
#pragma unroll
                for (int k = 0; k < 8; ++k) { const unsigned id = (idw[k >> 1] >> (16 * (k & 1))) & 0xffffu; w[k] = *(const uint4*)(base + (size_t)id * 128); }
#pragma unroll
                for (int k = 0; k < 8; ++k) {
                    const unsigned ww[4] = {w[k].x, w[k].y, w[k].z, w[k].w};
#pragma unroll
                    for (int m = 0; m < 4; ++m) { const auto lo = __builtin_amdgcn_cvt_pk_f32_fp8((int)ww[m], false); const auto hi = __builtin_amdgcn_cvt_pk_f32_fp8((int)ww[m], true);
                        o[4 * m] += av[k] * lo[0]; o[4 * m + 1] += av[k] * lo[1]; o[4 * m + 2] += av[k] * hi[0]; o[4 * m + 3] += av[k] * hi[1]; }
                }
            }
#pragma unroll
            for (int q = 0; q < 4; ++q) {
                float* op = out + (size_t)t * D + col + 4 * q;
                const float4 xv = *(const float4*)op; const float4 gt = *(const float4*)(gate2 + col + 4 * q);
                float4 r; r.x = xv.x + gt.x * o[4 * q]; r.y = xv.y + gt.y * o[4 * q + 1]; r.z = xv.z + gt.z * o[4 * q + 2]; r.w = xv.w + gt.w * o[4 * q + 3];
                *(float4*)op = r;
            }
        }
    }
}
}

extern "C" void kernel_launch(void* const* d_in, const int* in_sizes, int n_in, void* d_out, int out_size, void* d_ws, size_t ws_size, hipStream_t stream) {
    static int grid = 0;
    if (grid == 0) {
        int dev = 0, cus = 0, per_cu = 0;
        (void)hipGetDevice(&dev);
        (void)hipDeviceGetAttribute(&cus, hipDeviceAttributeMultiprocessorCount, dev);
        (void)hipFuncSetAttribute((const void*)mk_fwd, hipFuncAttributeMaxDynamicSharedMemorySize, LDS_BYTES);
        (void)hipOccupancyMaxActiveBlocksPerMultiprocessor(&per_cu, (const void*)mk_fwd, 512, LDS_BYTES);
        if (per_cu < 1 || cus != 256) { fprintf(stderr, "kernel_launch: needs 256 CUs with one resident workgroup each (cus %d, per_cu %d)\n", cus, per_cu); grid = -1; }
        else grid = cus;
    }
    if (grid < 0) return;
    (void)hipMemsetAsync((char*)d_ws + OFF_CTL, 0, CTL_BYTES, stream);
    Params p{};
    p.x = (const float*)d_in[0]; p.c = (const float*)d_in[1]; p.pos = (const int*)d_in[2]; p.ada_w = (const float*)d_in[3]; p.ada_b = (const float*)d_in[4];
    p.g1 = (const float*)d_in[5]; p.g2 = (const float*)d_in[6]; p.w_in = (const float*)d_in[7]; p.rgain = (const float*)d_in[8]; p.qg = (const float*)d_in[9];
    p.kg = (const float*)d_in[10]; p.og = (const float*)d_in[11]; p.w_out = (const float*)d_in[12]; p.wq = (const float*)d_in[13]; p.sk = (const float*)d_in[14];
    p.down = (const float*)d_in[15]; p.up = (const float*)d_in[16]; p.out = (float*)d_out; p.ws = (unsigned char*)d_ws;
    for (int i = 0; i < 32; ++i) p.rc.f[i] = pow(10000.0, -(double)i / 32.0) / 6.283185307179586476925;
    for (int h = 0; h < 8; ++h) p.rt.lg2[h] = (float)(log1p(-pow(2.0, -5.0 - h)) / log(2.0));
    void* args[] = {&p};
    hipError_t e = hipLaunchCooperativeKernel((const void*)mk_fwd, dim3(grid), dim3(512), args, LDS_BYTES, stream);
    if (e != hipSuccess) fprintf(stderr, "kernel_launch: cooperative launch failed: %s (grid %d)\n", hipGetErrorString(e), grid);
}
```

```cpp
#include <hip/hip_runtime.h>
#include <stdint.h>
#include <math.h>
#include <cstdio>

namespace {
constexpr int T = 16384, D = 1024;
constexpr float EPS = 1e-6f;
typedef unsigned short bf16_t;
#define LAS __attribute__((address_space(3)))

__device__ __forceinline__ float bf2f(bf16_t b) { return __uint_as_float(((unsigned)b) << 16); }
__device__ __forceinline__ bf16_t f2bf(float f) { unsigned u = __float_as_uint(f); u += 0x7fffu + ((u >> 16) & 1u); return (bf16_t)(u >> 16); }
__device__ __forceinline__ int vzero() { int z = 0; asm volatile("" : "+v"(z)); return z; }

__device__ __forceinline__ float lg2_head(int h) {
    const float x = __uint_as_float((unsigned)(127 - 5 - h) << 23);
    const float s = x * (1.f + x * (0.5f + x * (0.33333334f + x * (0.25f + x * (0.2f + x * 0.16666667f)))));
    return -s * 1.44269504089f;
}
struct RopeC { double f[32]; };
struct RetC { float lg2[8]; };

constexpr size_t MiB = 1u << 20;
constexpr size_t OFF_CTL = 0;
constexpr size_t CTL_BYTES = 64 * 1024;
constexpr size_t OFF_MOD = 64 * 1024, OFF_RINV1 = 128 * 1024, OFF_RINV2 = 192 * 1024, OFF_BIASF = 256 * 1024, OFF_ROPE = 1 * MiB;
constexpr size_t OFF_WINT = 6 * MiB;
constexpr size_t OFF_XB = 16 * MiB;
constexpr size_t OFF_YCAT = 16 * MiB;
constexpr size_t OFF_P = 48 * MiB;
constexpr size_t OFF_KV = 208 * MiB, OFF_ST = 224 * MiB;
constexpr size_t OFF_WEFFT = 240 * MiB;
constexpr size_t OFF_WOUTT = 13 * MiB;
constexpr size_t OFF_BIASQ = 272 * 1024;
constexpr size_t OFF_PART2 = 5 * MiB;
constexpr size_t OFF_X1B = 208 * MiB;
constexpr size_t OFF_SCORES = 48 * MiB;
constexpr size_t OFF_IDS = 244 * MiB, OFF_GATES = 248 * MiB;
constexpr size_t OFF_Q8 = 176 * MiB;
constexpr size_t OFF_QSC = 320 * 1024;
constexpr int LDS_BYTES = 147456;
constexpr int LDS_ST_OFF = LDS_BYTES - 16;

#define XB_TMO      128
#define XB_XCNT(j)  (256  + 64 * (j))
#define XB_XSUB(j)  (1280 + 64 * (j))
#define XB_XGEN(j)  (2304 + 64 * (j))
#define XB_TOP      3328
#define XB_TOPGEN   3392
#define XCD_BAR_WORDS 3456
#define XB_SPIN_CAP (1u << 20)
__device__ __forceinline__ unsigned xb_ld(unsigned* p)              { return __hip_atomic_load(p, __ATOMIC_RELAXED, __HIP_MEMORY_SCOPE_AGENT); }
__device__ __forceinline__ unsigned xb_add(unsigned* p, unsigned v) { return __hip_atomic_fetch_add(p, v, __ATOMIC_RELAXED, __HIP_MEMORY_SCOPE_AGENT); }
__device__ __forceinline__ unsigned xb_xcc_id() { return (unsigned)__builtin_amdgcn_s_getreg((3 << 11) | 20) & 0xFu; }
#define XB_SPIN(cond, bar) do { unsigned _sp = 0; while (cond) { __builtin_amdgcn_s_sleep(1); \
    if ((++_sp & 255u) == 0u) { if (xb_ld(&(bar)[XB_TMO])) break; if (_sp > XB_SPIN_CAP) { atomicAdd(&(bar)[XB_TMO], 1u); break; } } } } while (0)
struct XcdBarrier { unsigned* bar; unsigned x; volatile LAS unsigned* st; };
__device__ __forceinline__ XcdBarrier xcd_barrier_post(unsigned* bar, volatile LAS unsigned* st) {
    XcdBarrier b; b.bar = bar; b.x = xb_xcc_id(); b.st = st;
    if (threadIdx.x == 0) (void)xb_add(&bar[XB_XCNT(b.x)], 1u);
    return b;
}
__device__ __forceinline__ void xcd_barrier_complete(unsigned* bar, unsigned x, unsigned& nloc, unsigned& nx) {
    const unsigned G = gridDim.x * gridDim.y * gridDim.z;
    unsigned sum, cnt, mine, sp = 0u;
    for (;;) {
        sum = 0u; cnt = 0u; mine = 0u;
#pragma unroll
        for (unsigned j = 0; j < 16; ++j) { const unsigned c = xb_ld(&bar[XB_XCNT(j)]); sum += c; cnt += (c > 0u) ? 1u : 0u; mine = (j == x) ? c : mine; }
        if (sum == G) break;
        __builtin_amdgcn_s_sleep(1);
        if ((++sp & 255u) == 0u) { if (xb_ld(&bar[XB_TMO])) break; if (sp > XB_SPIN_CAP) { atomicAdd(&bar[XB_TMO], 1u); break; } }
    }
    nloc = mine > 0u ? mine : 1u; nx = cnt > 0u ? cnt : 1u;
}
__device__ __forceinline__ void xcd_barrier(const XcdBarrier& b) {
    asm volatile("s_waitcnt vmcnt(0)" ::: "memory");
    __syncthreads();
    if (threadIdx.x == 0) {
        unsigned* bar = b.bar;
        __builtin_amdgcn_s_waitcnt(0);
        unsigned nloc = b.st[0], nx = b.st[1];
        if (nloc == 0u) { xcd_barrier_complete(bar, b.x, nloc, nx); b.st[0] = nloc; b.st[1] = nx; }
        const unsigned old = xb_add(&bar[XB_XSUB(b.x)], 1u);
        const unsigned gen = old / nloc;
        if (old + 1u == (gen + 1u) * nloc) {
            __builtin_amdgcn_fence(__ATOMIC_RELEASE, "agent");
            asm volatile("s_waitcnt vmcnt(0)" ::: "memory");
            const unsigned og = xb_add(&bar[XB_TOP], 1u);
            const unsigned tg = og / nx;
            if (og + 1u == (tg + 1u) * nx) xb_add(&bar[XB_TOPGEN], 1u);
            else XB_SPIN(xb_ld(&bar[XB_TOPGEN]) == tg, bar);
            __builtin_amdgcn_fence(__ATOMIC_ACQUIRE, "agent");
            xb_add(&bar[XB_XGEN(b.x)], 1u);
            asm volatile("s_waitcnt vmcnt(0)" ::: "memory");
        } else {
            XB_SPIN(xb_ld(&bar[XB_XGEN(b.x)]) == gen, bar);
            __builtin_amdgcn_fence(__ATOMIC_ACQUIRE, "agent");
            asm volatile("s_waitcnt vmcnt(0)" ::: "memory");
        }
    }
    __syncthreads();
}

struct ALoadNorm {
    const float* x; const float* rinv; const float* gain; const float* mscale; const float* mshift;
    __device__ __forceinline__ float operator()(int t, int i) const { return x[(size_t)t * D + i] * rinv[t] * gain[i] * (1.f + mscale[i]) + mshift[i]; }
};
struct ALoadBf16 {
    const bf16_t* a;
    __device__ __forceinline__ float operator()(int t, int i) const { return bf2f(a[(size_t)t * D + i]); }
};
struct EpiInproj {
    bf16_t* P; const float2* rope; const float* qg; const float* kg;
    __device__ __forceinline__ void operator()(float (*Cs)[65], int m0, int n0, int tid) const {
        const int type = n0 / 512, head = (n0 % 512) / 64, tl = tid >> 2, part = tid & 3, t = m0 + tl;
        bf16_t* out = P + (size_t)type * T * 512 + (size_t)t * 512 + head * 64;
        const float* row = Cs[tl];
        if (type <= 1) {
            const float sc = type == 1 ? 0.125f : 1.f;
            for (int q = 0; q < 8; ++q) { const int d = part * 8 + q; const float2 cs = rope[t * 32 + d]; const float x1 = row[d], x2 = row[d + 32];
                out[d] = f2bf((x1 * cs.x - x2 * cs.y) * sc); out[d + 32] = f2bf((x2 * cs.x + x1 * cs.y) * sc); }
        } else if (type == 2 || type == 6) {
            for (int q = 0; q < 16; ++q) { const int d = part * 16 + q; out[d] = f2bf(row[d]); }
        } else if (type == 3) {
            for (int q = 0; q < 16; ++q) { const int d = part * 16 + q; const float v = row[d]; out[d] = f2bf(v / (1.f + expf(-v))); }
        } else {
            float ss = 0.f; for (int d = 0; d < 64; ++d) ss += row[d] * row[d];
            const float r = 1.0f / sqrtf(ss * (1.f / 64.f) + EPS);
            const float* g = type == 4 ? qg : kg; const float sc = type == 4 ? 0.125f : 1.f;
            for (int q = 0; q < 16; ++q) { const int d = part * 16 + q; out[d] = f2bf(row[d] * r * g[d] * sc); }
        }
    }
};
struct EpiOutproj {
    const float* x; const float* gate1; float* x1;
    __device__ __forceinline__ void operator()(float (*Cs)[65], int m0, int n0, int tid) const {
        for (int e = tid; e < 4096; e += 256) { const int r = e >> 6, c = e & 63; const size_t o = (size_t)(m0 + r) * D + n0 + c; x1[o] = x[o] + gate1[n0 + c] * Cs[r][c]; }
    }
};
struct EpiStore {
    float* out; int ld;
    __device__ __forceinline__ void operator()(float (*Cs)[65], int m0, int n0, int tid) const {
        for (int e = tid; e < 4096; e += 256) { const int r = e >> 6, c = e & 63; out[(size_t)(m0 + r) * ld + n0 + c] = Cs[r][c]; }
    }
};
template <class AL, class Epi>
__device__ __forceinline__ void gemm_naive_phase(unsigned char* lds, const AL al, const float* B, const int N, const Epi epi, const int bid, const int G) {
    const int half = threadIdx.x >> 8, tid = threadIdx.x & 255, tx = tid & 15, ty = tid >> 4;
    float (*As)[68] = (float (*)[68])(lds + half * 25344);
    float (*Bs)[68] = (float (*)[68])(lds + half * 25344 + 4352);
    float (*Cs)[65] = (float (*)[65])(lds + half * 25344 + 8704);
    const int NT = N / 64, units = NT * (T / 64);
    for (int U0 = 0; U0 < units; U0 += 2 * G) {
        const int U = U0 + 2 * bid + half;
        const int m0 = (U / NT) * 64, n0 = (U % NT) * 64;
        float acc[4][4];
#pragma unroll
        for (int i = 0; i < 4; ++i)
#pragma unroll
            for (int j = 0; j < 4; ++j) acc[i][j] = 0.f;
        for (int k0 = 0; k0 < 1024; k0 += 16) {
#pragma unroll
            for (int i = 0; i < 4; ++i) { const int r = (tid >> 4) + 16 * i, c = tid & 15; As[c][r] = al(m0 + r, k0 + c); }
#pragma unroll
            for (int i = 0; i < 4; ++i) { const int r = (tid >> 6) + 4 * i, c = tid & 63; Bs[r][c] = B[(size_t)(k0 + r) * N + n0 + c]; }
            __syncthreads();
#pragma unroll
            for (int kk = 0; kk < 16; ++kk) {
                float a[4], b[4];
#pragma unroll
                for (int i = 0; i < 4; ++i) { a[i] = As[kk][ty * 4 + i]; b[i] = Bs[kk][tx * 4 + i]; }
#pragma unroll
                for (int i = 0; i < 4; ++i)
#pragma unroll
                    for (int j = 0; j < 4; ++j) acc[i][j] += a[i] * b[j];
            }
            __syncthreads();
        }
#pragma unroll
        for (int i = 0; i < 4; ++i)
#pragma unroll
            for (int j = 0; j < 4; ++j) Cs[ty * 4 + i][tx * 4 + j] = acc[i][j];
        __syncthreads();
        epi(Cs, m0, n0, tid);
        __syncthreads();
    }
}


namespace pg8 {
#define PG8_LAS __attribute__((address_space(3)))
typedef short bf16x8 __attribute__((ext_vector_type(8)));
typedef float f32x4 __attribute__((ext_vector_type(4)));
typedef unsigned u32x4 __attribute__((ext_vector_type(4)));
typedef unsigned u32x2 __attribute__((ext_vector_type(2)));
constexpr int BM = 256, BK = 64, HALF = 128, HTB = HALF * BK * 2, STAGE_BYTES = 8 * HTB, NXCD = 8, WGM = 8;
__host__ __device__ __forceinline__ int lds_byte(int r, int c) { const int st = (r >> 4) * 2 + (c >> 5), rr = r & 15, cc = c & 31, ob = rr * 64 + cc * 2; return st * 1024 + (ob ^ (((ob >> 9) & 1) << 5)); }
__host__ __device__ __forceinline__ void stage_rc(int b, int& R, int& C) { const int st = b / 1024, sb = b % 1024, swz = sb ^ (((sb >> 9) & 1) << 5); R = (st >> 1) * 16 + swz / 64; C = (st & 1) * 32 + (swz % 64) / 2; }
__host__ __device__ __forceinline__ int perm32(int rho) { const int n = rho >> 4, i = rho & 15; return 8 * (i >> 2) + 4 * n + (i & 3); }
struct Unit { int pm, pn; };
struct Gemm { const bf16_t* A; const bf16_t* Bt; int M, N, K; };
struct StaticOrder {
    int nM, nN, nwg, G, c;
    __host__ __device__ void init(int M, int N, int G_, int c_) { nM = M / BM; nN = N / BM; nwg = nM * nN; G = G_; c = c_; }
    __host__ __device__ bool next(int i, Unit& u) const {
        const long L = (long)i * G + c; if (L >= nwg) return false;
        int wgid = (int)L; { const int q = nwg / NXCD, r = nwg % NXCD, xcd = wgid % NXCD, off = wgid / NXCD; wgid = (xcd < r ? xcd * (q + 1) : r * (q + 1) + (xcd - r) * q) + off; }
        const int nig = WGM * nN, gid = wgid / nig, fm = gid * WGM, gsz = (nM - fm) < WGM ? (nM - fm) : WGM;
        u.pm = fm + ((wgid % nig) % gsz); u.pn = (wgid % nig) / gsz; return true;
    }
    __device__ __forceinline__ void a_ready(const Unit&) const {}
    __device__ __forceinline__ void done(const Unit&) const {}
};
__device__ __forceinline__ unsigned cvt_pk_bf16(float lo, float hi) { unsigned r; asm volatile("v_cvt_pk_bf16_f32 %0, %1, %2" : "=v"(r) : "v"(lo), "v"(hi)); return r; }

template <class Epi, class Sched>
__device__ __forceinline__ void gemm_phase(PG8_LAS unsigned char* lds, const Gemm g, const Sched& S, const Epi& E) {
    int tid_ = threadIdx.x; asm volatile("" : "+v"(tid_));
    const int tid = tid_, wid = __builtin_amdgcn_readfirstlane(tid >> 6), lane = tid & 63, wr = wid >> 2, wc = wid & 3, fr = lane & 15, fq = lane >> 4;
    const int K = g.K, nt = K / BK;
    unsigned voffA[2], voffB[2];
#pragma unroll
    for (int i = 0; i < 2; ++i) { int R, C; stage_rc(tid * 16 + i * 8192, R, C); const int Rb = Epi::PERM ? ((R & ~31) + perm32(R & 31)) : R;
        voffA[i] = (unsigned)(R * K + C) * 2u; voffB[i] = (unsigned)(Rb * K + C) * 2u; }
    const size_t kstep = (size_t)(BK * 2);
    const size_t hstep = (size_t)HALF * K * 2;
    const size_t tstep = 2 * hstep;
    const unsigned ldsw = (unsigned)wid * 1024u;
    const int aoff = lds_byte(wr * 64 + fr, fq * 8), boff = lds_byte(wc * 32 + fr, fq * 8);
#define PG8_SA(b, h) (((b) * 2 + (h)) * HTB)
#define PG8_SB(b, h) ((4 + (b) * 2 + (h)) * HTB)
#define PG8_STAGE(bufoff, gbase, voff) do { _Pragma("unroll") for (int _i = 0; _i < 2; ++_i) \
        __builtin_amdgcn_global_load_lds((const unsigned*)((const char*)(gbase) + (voff)[_i]), (PG8_LAS unsigned*)(lds + (bufoff) + ldsw + _i * 8192), 16, 0, 0); } while (0)
#define PG8_LDA(dst, b, h) do { _Pragma("unroll") for (int m = 0; m < 4; ++m) _Pragma("unroll") for (int k = 0; k < 2; ++k) dst[m][k] = *(const PG8_LAS bf16x8*)(lds + PG8_SA(b, h) + aoff + m * 2048 + k * 1024); } while (0)
#define PG8_LDB(dst, b, h) do { _Pragma("unroll") for (int n = 0; n < 2; ++n) _Pragma("unroll") for (int k = 0; k < 2; ++k) dst[n][k] = *(const PG8_LAS bf16x8*)(lds + PG8_SB(b, h) + boff + n * 2048 + k * 1024); } while (0)
#define PG8_MMA(ai, bj, At, Bt) do { __builtin_amdgcn_s_setprio(1); _Pragma("unroll") for (int m = 0; m < 4; ++m) _Pragma("unroll") for (int n = 0; n < 2; ++n) _Pragma("unroll") for (int k = 0; k < 2; ++k) \
        acc[ai][bj][m][n] = __builtin_amdgcn_mfma_f32_16x16x32_bf16(Bt[n][k], At[m][k], acc[ai][bj][m][n], 0, 0, 0); __builtin_amdgcn_s_setprio(0); } while (0)
#define PG8_WAIT_V(n) asm volatile("s_waitcnt vmcnt(" #n ")" ::: "memory")
#define PG8_WAIT_L(n) asm volatile("s_waitcnt lgkmcnt(" #n ")" ::: "memory")
#define PG8_BAR __builtin_amdgcn_s_barrier()
#define PG8_SCHED __builtin_amdgcn_sched_barrier(0)
    Unit cur, nxt; int ui = 0;
    if (!S.next(0, cur)) return;
    f32x4 acc[2][2][4][2];
#pragma unroll
    for (int a = 0; a < 2; ++a)
#pragma unroll
        for (int b = 0; b < 2; ++b)
#pragma unroll
            for (int m = 0; m < 4; ++m)
#pragma unroll
                for (int n = 0; n < 2; ++n) acc[a][b][m][n] = (f32x4){0.f, 0.f, 0.f, 0.f};
    bf16x8 At[4][2], B0[2][2], B1[2][2];
    const char* cA = (const char*)g.A + (size_t)cur.pm * tstep; const char* cB = (const char*)g.Bt + (size_t)cur.pn * tstep;
    S.a_ready(cur);
    PG8_STAGE(PG8_SB(0, 0), cB, voffB); PG8_STAGE(PG8_SA(0, 0), cA, voffA); PG8_STAGE(PG8_SB(0, 1), cB + hstep, voffB); PG8_STAGE(PG8_SA(0, 1), cA + hstep, voffA);
    if (wr == 1) PG8_BAR;
    PG8_WAIT_V(4); PG8_BAR;
    PG8_STAGE(PG8_SB(1, 0), cB + kstep, voffB); PG8_STAGE(PG8_SA(1, 0), cA + kstep, voffA); PG8_STAGE(PG8_SB(1, 1), cB + hstep + kstep, voffB);
    PG8_WAIT_V(6); PG8_BAR;
    for (;;) {
        const bool has_next = S.next(ui + 1, nxt);
        const char* nA = has_next ? (const char*)g.A + (size_t)nxt.pm * tstep : cA; const char* nB = has_next ? (const char*)g.Bt + (size_t)nxt.pn * tstep : cB;
        for (int t = 0; t < nt; t += 2) {
            const bool last = (t == nt - 2);
            const char* a1 = cA + (size_t)(t + 1) * kstep;
            const char* a2 = last ? nA : cA + (size_t)(t + 2) * kstep; const char* b2 = last ? nB : cB + (size_t)(t + 2) * kstep;
            const char* a3 = a2 + kstep; const char* b3 = b2 + kstep;
            if (last && has_next) S.a_ready(nxt);
            PG8_LDB(B0, 0, 0); PG8_SCHED; PG8_LDA(At, 0, 0); PG8_STAGE(PG8_SA(1, 1), a1 + hstep, voffA);
            PG8_WAIT_L(8); PG8_BAR; PG8_WAIT_L(0); PG8_MMA(0, 0, At, B0); PG8_BAR; PG8_SCHED;
            PG8_LDB(B1, 0, 1); PG8_STAGE(PG8_SB(0, 0), b2, voffB);
            PG8_BAR; PG8_WAIT_L(0); PG8_MMA(0, 1, At, B1); PG8_BAR;
            PG8_LDA(At, 0, 1); PG8_STAGE(PG8_SA(0, 0), a2, voffA);
            PG8_BAR; PG8_WAIT_L(0); PG8_MMA(1, 0, At, B0); PG8_BAR; PG8_SCHED;
            PG8_STAGE(PG8_SB(0, 1), b2 + hstep, voffB);
            PG8_WAIT_V(6); PG8_BAR; PG8_MMA(1, 1, At, B1); PG8_BAR;
            PG8_LDB(B0, 1, 0); PG8_SCHED; PG8_LDA(At, 1, 0); PG8_STAGE(PG8_SA(0, 1), a2 + hstep, voffA);
            PG8_WAIT_L(8); PG8_BAR; PG8_WAIT_L(0); PG8_MMA(0, 0, At, B0); PG8_BAR; PG8_SCHED;
            PG8_LDB(B1, 1, 1); PG8_STAGE(PG8_SB(1, 0), b3, voffB);
            PG8_BAR; PG8_WAIT_L(0); PG8_MMA(0, 1, At, B1); PG8_BAR;
            PG8_LDA(At, 1, 1); PG8_STAGE(PG8_SA(1, 0), a3, voffA);
            PG8_BAR; PG8_WAIT_L(0); PG8_MMA(1, 0, At, B0); PG8_BAR; PG8_SCHED;
            PG8_STAGE(PG8_SB(1, 1), b3 + hstep, voffB);
            PG8_WAIT_V(6); PG8_BAR; PG8_MMA(1, 1, At, B1); PG8_BAR;
        }
        if constexpr (!Epi::AFTER_DRAIN) { E(acc, cur, wr, wc, fr, fq); S.done(cur); }
        if (!has_next) break;
#pragma unroll
        for (int a = 0; a < 2; ++a)
#pragma unroll
            for (int b = 0; b < 2; ++b)
#pragma unroll
                for (int m = 0; m < 4; ++m)
#pragma unroll
                    for (int n = 0; n < 2; ++n) acc[a][b][m][n] = (f32x4){0.f, 0.f, 0.f, 0.f};
        cur = nxt; cA = nA; cB = nB; ++ui;
    }
    PG8_WAIT_V(0);
    if (wr == 0) PG8_BAR;
    PG8_BAR;
    if constexpr (Epi::AFTER_DRAIN) { E.fused(acc, cur, wr, wc, fr, fq, lds, wid, lane); S.done(cur); }
#undef PG8_SA
#undef PG8_SB
#undef PG8_STAGE
#undef PG8_LDA
#undef PG8_LDB
#undef PG8_MMA
#undef PG8_WAIT_V
#undef PG8_WAIT_L
#undef PG8_BAR
#undef PG8_SCHED
}
}

__host__ __device__ __forceinline__ int cmap_in(int F) { return (F & ~255) + 128 * ((F >> 5) & 1) + 32 * ((F >> 6) & 3) + (F & 31); }
struct EpiInprojMF {
    static constexpr bool PERM = true, AFTER_DRAIN = false;
    bf16_t* P; const float* rinv; const float* bias_f; const float2* rope; const float* qg; const float* kg;
    __device__ __forceinline__ void operator()(const pg8::f32x4 (&acc)[2][2][4][2], const pg8::Unit& u, int wr, int wc, int fr, int fq) const {
        typedef pg8::f32x4 f32x4;
        asm volatile("" : "+v"(fr), "+v"(fq));
        const int type = u.pn >> 1, head = 4 * (u.pn & 1) + wc, fb = 256 * u.pn + 64 * wc;
        const size_t PSZ = (size_t)T * 512;
        const int rslot = (type == 0) ? 0 : (type == 1) ? 1 : (type == 3) ? 2 : (type == 4) ? 3 : 4;
        bf16_t* rowmaj = P + (size_t)rslot * PSZ;
        bf16_t* transp = P + (size_t)(type == 1 ? 5 : (type == 2 ? 6 : 7)) * PSZ;
        const bool want_t = (type == 1 || type == 2 || type == 6), want_r = !(type == 2 || type == 6);
        const float lgh = lg2_head(head);
        f32x4 bv[2][2], gv[2][2];
        const float* gsrc = (type == 4) ? qg : kg;
#pragma unroll
        for (int bj = 0; bj < 2; ++bj)
#pragma unroll
            for (int n = 0; n < 2; ++n) { bv[bj][n] = *(const f32x4*)(bias_f + fb + 32 * bj + 8 * fq + 4 * n); gv[bj][n] = *(const f32x4*)(gsrc + 32 * bj + 8 * fq + 4 * n); }
#pragma unroll
        for (int ai = 0; ai < 2; ++ai)
#pragma unroll
            for (int m = 0; m < 4; ++m) {
                const int t = u.pm * 256 + ai * 128 + wr * 64 + m * 16 + fr;
                const float r = rinv[t];
                f32x4 v[2][2];
#pragma unroll
                for (int bj = 0; bj < 2; ++bj)
#pragma unroll
                    for (int n = 0; n < 2; ++n) v[bj][n] = acc[ai][bj][m][n] * r + bv[bj][n];
                if (type <= 1) {
                    const float sc = (type == 1) ? 0.125f : 1.f;
                    const f32x4* rp = (const f32x4*)(rope + (size_t)t * 32 + 8 * fq);
#pragma unroll
                    for (int n = 0; n < 2; ++n) {
                        const f32x4 cs0 = rp[2 * n], cs1 = rp[2 * n + 1];
                        const float cc[4] = {cs0[0], cs0[2], cs1[0], cs1[2]}, sn[4] = {cs0[1], cs0[3], cs1[1], cs1[3]};
#pragma unroll
                        for (int j = 0; j < 4; ++j) { const float x1 = v[0][n][j], x2 = v[1][n][j]; v[0][n][j] = (x1 * cc[j] - x2 * sn[j]) * sc; v[1][n][j] = (x2 * cc[j] + x1 * sn[j]) * sc; }
                    }
                } else if (type == 3) {
#pragma unroll
                    for (int bj = 0; bj < 2; ++bj)
#pragma unroll
                        for (int n = 0; n < 2; ++n)
#pragma unroll
                            for (int j = 0; j < 4; ++j) { const float x = v[bj][n][j]; v[bj][n][j] = x / (1.f + __expf(-x)); }
                } else if (type == 4 || type == 5) {
                    float ss = 0.f;
#pragma unroll
                    for (int bj = 0; bj < 2; ++bj)
#pragma unroll
                        for (int n = 0; n < 2; ++n)
#pragma unroll
                            for (int j = 0; j < 4; ++j) ss += v[bj][n][j] * v[bj][n][j];
                    ss += __shfl_xor(ss, 16); ss += __shfl_xor(ss, 32);
                    const float rn = (1.0f / sqrtf(ss * (1.f / 64.f) + EPS)) * ((type == 4) ? 0.125f : 1.f);
#pragma unroll
                    for (int bj = 0; bj < 2; ++bj)
#pragma unroll
                        for (int n = 0; n < 2; ++n) v[bj][n] = v[bj][n] * rn * gv[bj][n];
                }
#pragma unroll
                for (int bj = 0; bj < 2; ++bj) {
                    pg8::u32x4 w; w.x = pg8::cvt_pk_bf16(v[bj][0][0], v[bj][0][1]); w.y = pg8::cvt_pk_bf16(v[bj][0][2], v[bj][0][3]);
                    w.z = pg8::cvt_pk_bf16(v[bj][1][0], v[bj][1][1]); w.w = pg8::cvt_pk_bf16(v[bj][1][2], v[bj][1][3]);
                    if (want_r) *(pg8::u32x4*)(rowmaj + (size_t)t * 512 + head * 64 + 32 * bj + 8 * fq) = w;
                    if (want_t) {
                        if (type == 1) {
                            const float zeta = exp2f((float)(127 - (t & 127)) * lgh);
                            w.x = pg8::cvt_pk_bf16(v[bj][0][0] * zeta, v[bj][0][1] * zeta); w.y = pg8::cvt_pk_bf16(v[bj][0][2] * zeta, v[bj][0][3] * zeta);
                            w.z = pg8::cvt_pk_bf16(v[bj][1][0] * zeta, v[bj][1][1] * zeta); w.w = pg8::cvt_pk_bf16(v[bj][1][2] * zeta, v[bj][1][3] * zeta);
                        }
                        const unsigned ww[4] = {w.x, w.y, w.z, w.w};
#pragma unroll
                        for (int q = 0; q < 8; ++q) transp[(size_t)(head * 64 + 32 * bj + 8 * fq + q) * T + t] = (bf16_t)((ww[q >> 1] >> (16 * (q & 1))) & 0xffffu);
                    }
                }
            }
    }
};


struct EpiOutprojMF {
    static constexpr bool PERM = false, AFTER_DRAIN = false;
    const float* x; const float* gate1; float* x1; bf16_t* x1b; float* part2;
    __device__ __forceinline__ void operator()(const pg8::f32x4 (&acc)[2][2][4][2], const pg8::Unit& u, int wr, int wc, int fr, int fq) const {
        typedef pg8::f32x4 f32x4;
        asm volatile("" : "+v"(fr), "+v"(fq));
        const int col0 = u.pn * 256 + wc * 32 + 4 * fq;
        f32x4 gv[2][2];
#pragma unroll
        for (int bj = 0; bj < 2; ++bj)
#pragma unroll
            for (int n = 0; n < 2; ++n) gv[bj][n] = *(const f32x4*)(gate1 + col0 + bj * 128 + n * 16);
#pragma unroll
        for (int ai = 0; ai < 2; ++ai)
#pragma unroll
            for (int m = 0; m < 4; ++m) {
                const int row = u.pm * 256 + ai * 128 + wr * 64 + m * 16 + fr; const size_t off = (size_t)row * D + col0;
                float ss = 0.f;
#pragma unroll
                for (int bj = 0; bj < 2; ++bj)
#pragma unroll
                    for (int n = 0; n < 2; ++n) {
                        const f32x4 xv = *(const f32x4*)(x + off + bj * 128 + n * 16);
                        const f32x4 o = xv + gv[bj][n] * acc[ai][bj][m][n];
                        *(f32x4*)(x1 + off + bj * 128 + n * 16) = o;
                        pg8::u32x2 w; w.x = pg8::cvt_pk_bf16(o[0], o[1]); w.y = pg8::cvt_pk_bf16(o[2], o[3]);
                        *(pg8::u32x2*)(x1b + off + bj * 128 + n * 16) = w;
                        ss += o[0] * o[0] + o[1] * o[1] + o[2] * o[2] + o[3] * o[3];
                    }
                ss += __shfl_xor(ss, 16); ss += __shfl_xor(ss, 32);
                if (fq == 0) part2[(size_t)row * 16 + u.pn * 4 + wc] = ss;
            }
    }
};
struct EpiScoresMF {
    static constexpr bool PERM = false, AFTER_DRAIN = false;
    const float* part2; const float* bias_q; float* scores;
    __device__ __forceinline__ void operator()(const pg8::f32x4 (&acc)[2][2][4][2], const pg8::Unit& u, int wr, int wc, int fr, int fq) const {
        typedef pg8::f32x4 f32x4;
        asm volatile("" : "+v"(fr), "+v"(fq));
        const int col0 = u.pn * 256 + wc * 32 + 4 * fq;
        f32x4 bv[2][2];
#pragma unroll
        for (int bj = 0; bj < 2; ++bj)
#pragma unroll
            for (int n = 0; n < 2; ++n) bv[bj][n] = *(const f32x4*)(bias_q + col0 + bj * 128 + n * 16);
#pragma unroll
        for (int ai = 0; ai < 2; ++ai)
#pragma unroll
            for (int m = 0; m < 4; ++m) {
                const int row = u.pm * 256 + ai * 128 + wr * 64 + m * 16 + fr;
                const f32x4* pp = (const f32x4*)(part2 + (size_t)row * 16);
                const f32x4 p0 = pp[0], p1 = pp[1], p2 = pp[2], p3 = pp[3];
                const float ssum = ((p0[0] + p0[1]) + (p0[2] + p0[3])) + ((p1[0] + p1[1]) + (p1[2] + p1[3])) + ((p2[0] + p2[1]) + (p2[2] + p2[3])) + ((p3[0] + p3[1]) + (p3[2] + p3[3]));
                const float r = 1.0f / sqrtf(ssum * (1.0f / D) + EPS);
                float* rowp = scores + (size_t)row * 2048 + col0;
#pragma unroll
                for (int bj = 0; bj < 2; ++bj)
#pragma unroll
                    for (int n = 0; n < 2; ++n) *(f32x4*)(rowp + bj * 128 + n * 16) = acc[ai][bj][m][n] * r + bv[bj][n];
            }
    }
};

__device__ __forceinline__ unsigned pk2(float lo, float hi) { return (unsigned)f2bf(lo) | ((unsigned)f2bf(hi) << 16); }
template <bool FOLD, bool CMAP>
__device__ __forceinline__ void transpose_item(const float* W, int K, int N, bf16_t* WT, float* scr, int item, int lane, const float* sg, const float* sm) {
    const int nblk = N / 32, kb = item / nblk, nb = item % nblk, k0 = 64 * kb, n0 = 32 * nb;
#pragma unroll 8
    for (int i = 0; i < 32; ++i) { const int kk = 2 * i + (lane >> 5); float w = W[(size_t)(k0 + kk) * N + n0 + (lane & 31)];
        if (FOLD) w *= sg[k0 + kk] * (1.f + sm[k0 + kk]);
        scr[kk * 33 + (lane & 31)] = w; }
    asm volatile("s_waitcnt lgkmcnt(0)" ::: "memory");
    const int c = lane & 7, r0 = CMAP ? cmap_in(n0) : n0;
#pragma unroll
    for (int j = 0; j < 4; ++j) { const int n = (lane >> 3) + 8 * j; const float* s = scr + (8 * c) * 33 + n;
        pg8::u32x4 o; o.x = pk2(s[0 * 33], s[1 * 33]); o.y = pk2(s[2 * 33], s[3 * 33]); o.z = pk2(s[4 * 33], s[5 * 33]); o.w = pk2(s[6 * 33], s[7 * 33]);
        *(pg8::u32x4*)(WT + (size_t)(r0 + n) * K + k0 + 8 * c) = o; }
    asm volatile("s_waitcnt lgkmcnt(0)" ::: "memory");
}
template <int NC4, class VF>
__device__ __forceinline__ void gemv_cols(unsigned char* lds, const VF vf, const float* W, const int N, const int u, float* dst, const float* add) {
    constexpr int RG = 512 / NC4;
    float (*red)[NC4 * 4] = (float (*)[NC4 * 4])lds;
    const int tid = threadIdx.x, c4 = tid % NC4, rg = tid / NC4;
    if (rg < RG) {
        float4 acc = {0.f, 0.f, 0.f, 0.f};
        for (int r = rg; r < 1024; r += RG) { const float s = vf(r); const float4 w = *(const float4*)(W + (size_t)r * N + u * NC4 * 4 + c4 * 4);
            acc.x += s * w.x; acc.y += s * w.y; acc.z += s * w.z; acc.w += s * w.w; }
        red[rg][c4 * 4 + 0] = acc.x; red[rg][c4 * 4 + 1] = acc.y; red[rg][c4 * 4 + 2] = acc.z; red[rg][c4 * 4 + 3] = acc.w;
    }
    __syncthreads();
    if (tid < NC4 * 4) { float s = 0.f; for (int i = 0; i < RG; ++i) s += red[i][tid]; dst[u * NC4 * 4 + tid] = s + (add ? add[u * NC4 * 4 + tid] : 0.f); }
    __syncthreads();
}
struct VfSilu { const float* c; __device__ __forceinline__ float operator()(int r) const { const float v = c[r]; return v / (1.f + expf(-v)); } };
struct VfVec { const float* v; __device__ __forceinline__ float operator()(int r) const { return v[r]; } };


typedef float f32x16 __attribute__((ext_vector_type(16)));
typedef pg8::bf16x8 bf16x8;
#define MFMA32(a, b, c) __builtin_amdgcn_mfma_f32_32x32x16_bf16((a), (b), (c), 0, 0, 0)
__device__ __forceinline__ bf16x8 pack_frag(const f32x16& v, int s) {
    pg8::u32x4 w;
    w.x = pg8::cvt_pk_bf16(v[8 * s + 0], v[8 * s + 1]); w.y = pg8::cvt_pk_bf16(v[8 * s + 2], v[8 * s + 3]);
    w.z = pg8::cvt_pk_bf16(v[8 * s + 4], v[8 * s + 5]); w.w = pg8::cvt_pk_bf16(v[8 * s + 6], v[8 * s + 7]);
    return __builtin_bit_cast(bf16x8, w);
}
__device__ __forceinline__ bf16x8 load_tfrag(const bf16_t* rowp, int tok) {
    const uint2 a = *(const uint2*)(rowp + tok), b = *(const uint2*)(rowp + tok + 8);
    pg8::u32x4 w; w.x = a.x; w.y = a.y; w.z = b.x; w.w = b.y;
    return __builtin_bit_cast(bf16x8, w);
}

__device__ __forceinline__ void ins16(float (&s)[16], float x) {
#pragma unroll
    for (int i = 15; i >= 1; --i) s[i] = __builtin_amdgcn_fmed3f(s[i - 1], s[i], x);
    s[0] = fmaxf(s[0], x);
}

struct Params {
    const float *x, *c; const int* pos; const float *ada_w, *ada_b, *g1, *g2, *w_in, *rgain, *qg, *kg, *og, *w_out, *wq, *sk, *down, *up;
    float* out; unsigned char* ws; RopeC rc;
};

__global__ void __launch_bounds__(512) mk_fwd(Params p) {
    extern __shared__ __attribute__((aligned(16))) unsigned char lds[];
    const int tid = threadIdx.x, lane = tid & 63, wave = tid >> 6, bid = blockIdx.x, G = gridDim.x;
    unsigned char* ws = p.ws;
    float* mod = (float*)(ws + OFF_MOD); float* rinv1 = (float*)(ws + OFF_RINV1); float2* rope = (float2*)(ws + OFF_ROPE);
    bf16_t* P = (bf16_t*)(ws + OFF_P); float* kv = (float*)(ws + OFF_KV); bf16_t* stT = (bf16_t*)(ws + OFF_ST); bf16_t* ycat = (bf16_t*)(ws + OFF_YCAT);
    bf16_t* xb = (bf16_t*)(ws + OFF_XB); bf16_t* Win_t = (bf16_t*)(ws + OFF_WINT); float* bias_f = (float*)(ws + OFF_BIASF);
    bf16_t* Weff_t = (bf16_t*)(ws + OFF_WEFFT); bf16_t* Wout_t = (bf16_t*)(ws + OFF_WOUTT); float* bias_q = (float*)(ws + OFF_BIASQ);
    float* part2 = (float*)(ws + OFF_PART2); bf16_t* x1b = (bf16_t*)(ws + OFF_X1B); unsigned short* ids = (unsigned short*)(ws + OFF_IDS); unsigned char* q8 = ws + OFF_Q8; float* qsc = (float*)(ws + OFF_QSC); float* gates = (float*)(ws + OFF_GATES); float* scores = (float*)(ws + OFF_SCORES);
    const size_t PS = (size_t)T * 512;
    const bf16_t *Qr = P, *Kr = P + PS, *Gr = P + 2 * PS, *Qs = P + 3 * PS, *Ks = P + 4 * PS, *KrT = P + 5 * PS, *VrT = P + 6 * PS, *VsT = P + 7 * PS;
    float* out = p.out;

    if (tid < 4) ((LAS unsigned*)((LAS unsigned char*)lds + LDS_ST_OFF))[tid] = 0u;
    __syncthreads();
    XcdBarrier bar = xcd_barrier_post((unsigned*)(ws + OFF_CTL), (volatile LAS unsigned*)((LAS unsigned char*)lds + LDS_ST_OFF));

    for (int u = bid; u < 256; u += G) gemv_cols<6>(lds, VfSilu{p.c}, p.ada_w, 6144, u, mod, p.ada_b);
    for (int row = bid * 8 + wave; row < T; row += G * 8) {
        const float4* xp = (const float4*)(p.x + (size_t)row * D);
        uint2* xo = (uint2*)(xb + (size_t)row * D);
        float s = 0.f;
#pragma unroll
        for (int j = 0; j < 4; ++j) { const float4 v = xp[lane + 64 * j]; s += v.x * v.x + v.y * v.y + v.z * v.z + v.w * v.w; xo[lane + 64 * j] = make_uint2(pk2(v.x, v.y), pk2(v.z, v.w)); }
#pragma unroll
        for (int o = 32; o > 0; o >>= 1) s += __shfl_xor(s, o);
        if (lane == 0) rinv1[row] = 1.0f / sqrtf(s * (1.0f / D) + EPS);
    }
    for (int idx = bid * 512 + tid; idx < T * 32; idx += G * 512) {
        const int t = idx >> 5, i = idx & 31;
        double rev = (double)p.pos[t] * p.rc.f[i];
        rev -= floor(rev);
        float s, c; sincospif((float)(2.0 * rev), &s, &c);
        rope[idx] = make_float2(c, s);
    }
    for (int row = bid * 8 + wave; row < 32768; row += G * 8) {
        const int isup = row >> 14, e = row & 16383;
        const float4* sp = (const float4*)((isup ? p.up : p.down) + (size_t)e * 1024 + lane * 16);
        float4 v[4]; float mx = 0.f;
#pragma unroll
        for (int q = 0; q < 4; ++q) { v[q] = sp[q]; mx = fmaxf(mx, fmaxf(fmaxf(fabsf(v[q].x), fabsf(v[q].y)), fmaxf(fabsf(v[q].z), fabsf(v[q].w)))); }
#pragma unroll
        for (int o = 32; o > 0; o >>= 1) mx = fmaxf(mx, __shfl_xor(mx, o));
        const float s = (mx > 0.f) ? exp2f(floorf(log2f(256.f / mx))) : 1.f;
        uint4 w; unsigned* wp = (unsigned*)&w;
#pragma unroll
        for (int q = 0; q < 4; ++q) { int pk = __builtin_amdgcn_cvt_pk_fp8_f32(v[q].x * s, v[q].y * s, 0, false); pk = __builtin_amdgcn_cvt_pk_fp8_f32(v[q].z * s, v[q].w * s, pk, true); wp[q] = (unsigned)pk; }
        *(uint4*)(q8 + (size_t)isup * (16u << 20) + ((size_t)(lane >> 3) * 16384 + e) * 128 + (lane & 7) * 16) = w;
        if (lane == 0) qsc[row] = 1.0f / s;
    }
    {
        float* scr = (float*)(lds + wave * 16384);
        for (int it = bid * 8 + wave; it < 16 * 32; it += G * 8) transpose_item<false, false>(p.w_out, 1024, 1024, Wout_t, scr, it, lane, nullptr, nullptr);
    }
    xcd_barrier(bar);

    {
        float* scr = (float*)(lds + wave * 16384);
        for (int it = bid * 8 + wave; it < 16 * 112; it += G * 8) transpose_item<true, true>(p.w_in, 1024, 3584, Win_t, scr, it, lane, p.g1, mod + 1024);
        __syncthreads();
        for (int u = bid; u < 128; u += G) gemv_cols<7>(lds, VfVec{mod}, p.w_in, 3584, u, bias_f, nullptr);
        for (int U = bid; U < 256; U += G) {
            const int hp = U >> 4, k0 = (U & 15) * 8;
            float (*sks)[128] = (float (*)[128])lds; float* redb = (float*)(lds + 4096);
            for (int e = tid; e < 1024; e += 512) sks[e >> 7][e & 127] = p.sk[((size_t)hp * 128 + k0 + (e >> 7)) * 128 + (e & 127)];
            __syncthreads();
            float bsum[8];
#pragma unroll
            for (int kk = 0; kk < 8; ++kk) bsum[kk] = 0.f;
            for (int rr = 0; rr < 2; ++rr) {
                const int i = tid + 512 * rr;
                const float4* a4 = (const float4*)(p.wq + (size_t)i * 2048 + hp * 128);
                float acc[8];
#pragma unroll
                for (int kk = 0; kk < 8; ++kk) acc[kk] = 0.f;
                for (int c4 = 0; c4 < 32; ++c4) { const float4 a = a4[c4];
#pragma unroll
                    for (int kk = 0; kk < 8; ++kk) { const float4 b = *(const float4*)&sks[kk][4 * c4]; acc[kk] += a.x * b.x + a.y * b.y + a.z * b.z + a.w * b.w; } }
                const float s2 = p.g2[i] * (1.f + mod[4096 + i]), sh = mod[3072 + i];
#pragma unroll
                for (int kk = 0; kk < 8; ++kk) { Weff_t[(size_t)(hp * 128 + k0 + kk) * 1024 + i] = f2bf(acc[kk] * s2); bsum[kk] += sh * acc[kk]; }
            }
#pragma unroll
            for (int kk = 0; kk < 8; ++kk) { float v = bsum[kk];
#pragma unroll
                for (int o = 32; o > 0; o >>= 1) v += __shfl_xor(v, o);
                if (lane == 0) redb[wave * 8 + kk] = v; }
            __syncthreads();
            if (tid < 8) { float s = 0.f; for (int w = 0; w < 8; ++w) s += redb[w * 8 + tid]; bias_q[hp * 128 + k0 + tid] = s; }
            __syncthreads();
        }
    }
    xcd_barrier(bar);

    {
        pg8::Gemm g{xb, Win_t, T, 3584, 1024}; pg8::StaticOrder S; S.init(T, 3584, G, bid);
        EpiInprojMF E{P, rinv1, bias_f, rope, p.qg, p.kg};
        pg8::gemm_phase<EpiInprojMF, pg8::StaticOrder>((PG8_LAS unsigned char*)lds, g, S, E);
    }
    xcd_barrier(bar);

    {
        const int gw = bid * 8 + wave, NGW = G * 8, l31 = lane & 31, hf = lane >> 5;
        for (int U = gw; U < 1024; U += NGW) {
            const int n = U >> 3, h = U & 7;
            f32x16 C[2][2];
#pragma unroll
            for (int a = 0; a < 2; ++a)
#pragma unroll
                for (int b = 0; b < 2; ++b)
#pragma unroll
                    for (int r = 0; r < 16; ++r) C[a][b][r] = 0.f;
            const bf16_t* vrow = VrT + (size_t)(h * 64 + l31) * T + n * 128 + 8 * hf;
            const bf16_t* krow = KrT + (size_t)(h * 64 + l31) * T + n * 128 + 8 * hf;
#pragma unroll 2
            for (int s = 0; s < 8; ++s) {
                bf16x8 Af[2], Bf[2];
#pragma unroll
                for (int a = 0; a < 2; ++a) { Af[a] = *(const bf16x8*)(vrow + (size_t)a * 32 * T + 16 * s); Bf[a] = *(const bf16x8*)(krow + (size_t)a * 32 * T + 16 * s); }
#pragma unroll
                for (int a = 0; a < 2; ++a)
#pragma unroll
                    for (int b = 0; b < 2; ++b) C[a][b] = MFMA32(Af[a], Bf[b], C[a][b]);
            }
            float* dst = kv + (size_t)(n * 8 + h) * 4096;
#pragma unroll
            for (int a = 0; a < 2; ++a)
#pragma unroll
                for (int b = 0; b < 2; ++b)
#pragma unroll
                    for (int r = 0; r < 16; ++r) dst[(32 * a + (r & 3) + 8 * (r >> 2) + 4 * hf) * 64 + 32 * b + l31] = C[a][b][r];
        }
        bf16x8 Tri[2];
        {
            pg8::u32x4 w0, w1; unsigned* p0 = (unsigned*)&w0; unsigned* p1 = (unsigned*)&w1;
#pragma unroll
            for (int e2 = 0; e2 < 4; ++e2) {
                unsigned a0 = 0, a1 = 0;
#pragma unroll
                for (int q = 0; q < 2; ++q) { const int e = 2 * e2 + q, ip = 8 * (e >> 2) + 4 * hf + (e & 3);
                    a0 |= ((ip > l31) ? 0x3F80u : 0u) << (16 * q); a1 |= ((16 + ip > l31) ? 0x3F80u : 0u) << (16 * q); }
                p0[e2] = a0; p1[e2] = a1;
            }
            Tri[0] = __builtin_bit_cast(bf16x8, w0); Tri[1] = __builtin_bit_cast(bf16x8, w1);
        }
        for (int U = gw; U < 4096; U += NGW) {
            const int h = U & 7, qt = U >> 3, q0 = qt * 32;
            bf16x8 Qf[4];
#pragma unroll
            for (int s = 0; s < 4; ++s) Qf[s] = *(const bf16x8*)(Qs + (size_t)(q0 + l31) * 512 + h * 64 + 16 * s + 8 * hf);
            f32x16 O[2];
#pragma unroll
            for (int r = 0; r < 16; ++r) { O[0][r] = 0.f; O[1][r] = 0.f; }
            float carry = 0.f;
            const bf16_t* vrow = VsT + (size_t)(h * 64 + l31) * T + 4 * hf;
            for (int kb = qt; kb >= 0; --kb) {
                bf16x8 Kf[4], Vf[2][2];
#pragma unroll
                for (int s = 0; s < 4; ++s) Kf[s] = *(const bf16x8*)(Ks + (size_t)(kb * 32 + l31) * 512 + h * 64 + 16 * s + 8 * hf);
#pragma unroll
                for (int s = 0; s < 2; ++s)
#pragma unroll
                    for (int dt = 0; dt < 2; ++dt) Vf[s][dt] = load_tfrag(vrow + (size_t)dt * 32 * T, kb * 32 + 16 * s);
                f32x16 S;
#pragma unroll
                for (int r = 0; r < 16; ++r) S[r] = 0.f;
#pragma unroll
                for (int s = 0; s < 4; ++s) S = MFMA32(Kf[s], Qf[s], S);
                const bool diag = (kb == qt);
                f32x16 sp, lb, lo;
                float csum = 0.f;
#pragma unroll
                for (int r = 0; r < 16; ++r) {
                    const int i = (r & 3) + 8 * (r >> 2) + 4 * hf;
                    const bool valid = !diag || (i < l31);
                    const float z = S[r];
                    const float l1p = __builtin_amdgcn_logf(1.0f + __builtin_amdgcn_exp2f(-fabsf(z) * 1.44269504089f)) * 0.69314718056f;
                    const float spv = valid ? (fmaxf(z, 0.f) + l1p) : 0.f;
                    sp[r] = spv; lb[r] = fminf(z, 0.f) - l1p; csum += spv;
                }
                f32x16 Rt;
#pragma unroll
                for (int r = 0; r < 16; ++r) Rt[r] = carry;
#pragma unroll
                for (int s = 0; s < 2; ++s) {
                    pg8::u32x4 wh;
                    wh.x = pg8::cvt_pk_bf16(sp[8 * s + 0], sp[8 * s + 1]); wh.y = pg8::cvt_pk_bf16(sp[8 * s + 2], sp[8 * s + 3]);
                    wh.z = pg8::cvt_pk_bf16(sp[8 * s + 4], sp[8 * s + 5]); wh.w = pg8::cvt_pk_bf16(sp[8 * s + 6], sp[8 * s + 7]);
                    const unsigned whh[4] = {wh.x, wh.y, wh.z, wh.w};
#pragma unroll
                    for (int e2 = 0; e2 < 4; ++e2) { lo[8 * s + 2 * e2] = sp[8 * s + 2 * e2] - __uint_as_float(whh[e2] << 16); lo[8 * s + 2 * e2 + 1] = sp[8 * s + 2 * e2 + 1] - __uint_as_float(whh[e2] & 0xffff0000u); }
                    Rt = MFMA32(Tri[s], __builtin_bit_cast(bf16x8, wh), Rt);
                    Rt = MFMA32(Tri[s], pack_frag(lo, s), Rt);
                }
                f32x16 wv;
#pragma unroll
                for (int r = 0; r < 16; ++r) {
                    const int i = (r & 3) + 8 * (r >> 2) + 4 * hf;
                    const bool valid = !diag || (i < l31);
                    wv[r] = valid ? __builtin_amdgcn_exp2f((lb[r] - Rt[r]) * 1.44269504089f) : 0.f;
                }
#pragma unroll
                for (int s = 0; s < 2; ++s) { const bf16x8 wp = pack_frag(wv, s);
#pragma unroll
                    for (int dt = 0; dt < 2; ++dt) O[dt] = MFMA32(Vf[s][dt], wp, O[dt]); }
                csum += __shfl_xor(csum, 32);
                carry += csum;
                if (__all(carry > 88.f)) break;
            }
            float ss = 0.f;
#pragma unroll
            for (int r = 0; r < 16; ++r) ss += O[0][r] * O[0][r] + O[1][r] * O[1][r];
            ss += __shfl_xor(ss, 32);
            const float rn = 1.0f / sqrtf(ss * (1.f / 64.f) + EPS);
            bf16_t* orow = ycat + (size_t)(q0 + l31) * 1024 + 512 + h * 64;
#pragma unroll
            for (int dt = 0; dt < 2; ++dt)
#pragma unroll
                for (int g4 = 0; g4 < 4; ++g4) {
                    const int d = 32 * dt + 8 * g4 + 4 * hf;
                    const float4 gn = *(const float4*)(p.og + d);
                    uint2 w; w.x = pg8::cvt_pk_bf16(O[dt][4 * g4] * rn * gn.x, O[dt][4 * g4 + 1] * rn * gn.y); w.y = pg8::cvt_pk_bf16(O[dt][4 * g4 + 2] * rn * gn.z, O[dt][4 * g4 + 3] * rn * gn.w);
                    *(uint2*)(orow + d) = w;
                }
        }
    }
    xcd_barrier(bar);

    for (int idx = bid * 512 + tid; idx < 32768; idx += G * 512) {
        const int h = idx >> 12;
        const float cd = exp2f(128.f * lg2_head(h));
        float s = 0.f;
#pragma unroll 8
        for (int n = 0; n < 128; ++n) { stT[(size_t)n * 32768 + idx] = f2bf(s); s = cd * s + kv[(size_t)n * 32768 + idx]; }
    }
    xcd_barrier(bar);

    {
        const int gw = bid * 8 + wave, NGW = G * 8, l31 = lane & 31, hf = lane >> 5;
        for (int W2 = gw; W2 < 2048; W2 += NGW) {
            const int nh = W2 >> 1, n = nh >> 3, h = nh & 7;
            const float lg = lg2_head(h);
#pragma unroll 1
            for (int pass = 0; pass < 2; ++pass) {
                const int qt = (W2 & 1) ? (pass ? 2 : 1) : (pass ? 3 : 0);
                const int il = qt * 32 + l31, tq = n * 128 + il;
                bf16x8 Qf[4];
#pragma unroll
                for (int s = 0; s < 4; ++s) Qf[s] = *(const bf16x8*)(Qr + (size_t)tq * 512 + h * 64 + 16 * s + 8 * hf);
                f32x16 O[2];
#pragma unroll
                for (int r = 0; r < 16; ++r) { O[0][r] = 0.f; O[1][r] = 0.f; }
                const bf16_t* srow = stT + (size_t)nh * 4096 + (size_t)l31 * 64 + 8 * hf;
#pragma unroll
                for (int s = 0; s < 4; ++s)
#pragma unroll
                    for (int dt = 0; dt < 2; ++dt) O[dt] = MFMA32(*(const bf16x8*)(srow + dt * 32 * 64 + 16 * s), Qf[s], O[dt]);
                const float xi = exp2f((float)(il + 1) * lg);
#pragma unroll
                for (int r = 0; r < 16; ++r) { O[0][r] *= xi; O[1][r] *= xi; }
                const bf16_t* vrow = VrT + (size_t)(h * 64 + l31) * T + n * 128 + 4 * hf;
                for (int jb = 0; jb <= qt; ++jb) {
                    bf16x8 Kf[4], Vf[2][2];
#pragma unroll
                    for (int s = 0; s < 4; ++s) Kf[s] = *(const bf16x8*)(Kr + (size_t)(n * 128 + jb * 32 + l31) * 512 + h * 64 + 16 * s + 8 * hf);
#pragma unroll
                    for (int s = 0; s < 2; ++s)
#pragma unroll
                        for (int dt = 0; dt < 2; ++dt) Vf[s][dt] = load_tfrag(vrow + (size_t)dt * 32 * T, jb * 32 + 16 * s);
                    f32x16 S;
#pragma unroll
                    for (int r = 0; r < 16; ++r) S[r] = 0.f;
#pragma unroll
                    for (int s = 0; s < 4; ++s) S = MFMA32(Kf[s], Qf[s], S);
#pragma unroll
                    for (int r = 0; r < 16; ++r) {
                        const int jl = jb * 32 + (r & 3) + 8 * (r >> 2) + 4 * hf, dl = il - jl;
                        S[r] = (dl >= 0) ? S[r] * __builtin_amdgcn_exp2f((float)dl * lg) : 0.f;
                    }
#pragma unroll
                    for (int s = 0; s < 2; ++s) { const bf16x8 wp = pack_frag(S, s);
#pragma unroll
                        for (int dt = 0; dt < 2; ++dt) O[dt] = MFMA32(Vf[s][dt], wp, O[dt]); }
                }
                float sm = 0.f;
#pragma unroll
                for (int r = 0; r < 16; ++r) sm += O[0][r] + O[1][r];
                sm += __shfl_xor(sm, 32);
                const float mean = sm * (1.f / 64.f);
                float vs = 0.f;
#pragma unroll
                for (int r = 0; r < 16; ++r) { const float d0 = O[0][r] - mean, d1 = O[1][r] - mean; vs += d0 * d0 + d1 * d1; }
                vs += __shfl_xor(vs, 32);
                const float rstd = 1.0f / sqrtf(vs * (1.f / 64.f) + EPS);
                bf16_t* orow = ycat + (size_t)tq * 1024 + h * 64;
                const bf16_t* grow = Gr + (size_t)tq * 512 + h * 64;
#pragma unroll
                for (int dt = 0; dt < 2; ++dt)
#pragma unroll
                    for (int g4 = 0; g4 < 4; ++g4) {
                        const int e = 32 * dt + 8 * g4 + 4 * hf;
                        const float4 gn = *(const float4*)(p.rgain + h * 64 + e);
                        const uint2 gg = *(const uint2*)(grow + e);
                        const float g0 = __uint_as_float(gg.x << 16), g1 = __uint_as_float(gg.x & 0xffff0000u), g2v = __uint_as_float(gg.y << 16), g3 = __uint_as_float(gg.y & 0xffff0000u);
                        uint2 w;
                        w.x = pg8::cvt_pk_bf16((O[dt][4 * g4] - mean) * rstd * gn.x * g0, (O[dt][4 * g4 + 1] - mean) * rstd * gn.y * g1);
                        w.y = pg8::cvt_pk_bf16((O[dt][4 * g4 + 2] - mean) * rstd * gn.z * g2v, (O[dt][4 * g4 + 3] - mean) * rstd * gn.w * g3);
                        *(uint2*)(orow + e) = w;
                    }
            }
        }
    }
    xcd_barrier(bar);

    {
        pg8::Gemm g{ycat, Wout_t, T, 1024, 1024}; pg8::StaticOrder S; S.init(T, 1024, G, bid);
        EpiOutprojMF E{p.x, mod + 2048, out, x1b, part2};
        pg8::gemm_phase<EpiOutprojMF, pg8::StaticOrder>((PG8_LAS unsigned char*)lds, g, S, E);
    }
    xcd_barrier(bar);

    {
        pg8::Gemm g{x1b, Weff_t, T, 2048, 1024}; pg8::StaticOrder S; S.init(T, 2048, G, bid);
        EpiScoresMF E{part2, bias_q, scores};
        pg8::gemm_phase<EpiScoresMF, pg8::StaticOrder>((PG8_LAS unsigned char*)lds, g, S, E);
    }
    xcd_barrier(bar);

    for (int idx = bid * 512 + tid; idx < T * 8; idx += G * 512) {
        const int t = idx >> 3, h = idx & 7;
        const float* sc = scores + (size_t)t * 2048 + h * 256;
        float s0[16], s1[16], tl[16];
#pragma unroll
        for (int i = 0; i < 16; ++i) { s0[i] = -INFINITY; s1[i] = -INFINITY; tl[i] = -INFINITY; }
        for (int k = 0; k < 128; k += 4) {
            const float4 v = *(const float4*)(sc + k);
            ins16(s0, __uint_as_float((__float_as_uint(v.x) & 0xFFFFFF80u) | (unsigned)(k + 0)));
            ins16(s0, __uint_as_float((__float_as_uint(v.y) & 0xFFFFFF80u) | (unsigned)(k + 1)));
            ins16(s0, __uint_as_float((__float_as_uint(v.z) & 0xFFFFFF80u) | (unsigned)(k + 2)));
            ins16(s0, __uint_as_float((__float_as_uint(v.w) & 0xFFFFFF80u) | (unsigned)(k + 3)));
        }
        for (int k = 0; k < 128; k += 4) {
            const float4 v = *(const float4*)(sc + 128 + k);
            ins16(s1, __uint_as_float((__float_as_uint(v.x) & 0xFFFFFF80u) | (unsigned)(k + 0)));
            ins16(s1, __uint_as_float((__float_as_uint(v.y) & 0xFFFFFF80u) | (unsigned)(k + 1)));
            ins16(s1, __uint_as_float((__float_as_uint(v.z) & 0xFFFFFF80u) | (unsigned)(k + 2)));
            ins16(s1, __uint_as_float((__float_as_uint(v.w) & 0xFFFFFF80u) | (unsigned)(k + 3)));
        }
#pragma unroll
        for (int a = 0; a < 16; ++a)
#pragma unroll
            for (int b = 0; b < 16; ++b)
                if ((a + 1) * (b + 1) <= 16) {
                    const float v = __uint_as_float(__float_as_uint(s0[a]) & 0xFFFFFF80u) + __uint_as_float(__float_as_uint(s1[b]) & 0xFFFFFF80u);
                    ins16(tl, __uint_as_float((__float_as_uint(v) & 0xFFFFFF00u) | (unsigned)(a * 16 + b)));
                }
        float ev[16]; float sum = 0.f;
        const float mx = __uint_as_float(__float_as_uint(tl[0]) & 0xFFFFFF00u);
#pragma unroll
        for (int j = 0; j < 16; ++j) { ev[j] = expf(__uint_as_float(__float_as_uint(tl[j]) & 0xFFFFFF00u) - mx); sum += ev[j]; }
        const float inv = 1.f / sum;
#pragma unroll
        for (int j = 0; j < 16; ++j) {
            const unsigned code = __float_as_uint(tl[j]) & 0xFFu; const int a = (int)(code >> 4), b = (int)(code & 15u);
            int i0 = 0, i1 = 0;
#pragma unroll
            for (int k = 0; k < 16; ++k) { i0 = (a == k) ? (int)(__float_as_uint(s0[k]) & 0x7Fu) : i0; i1 = (b == k) ? (int)(__float_as_uint(s1[k]) & 0x7Fu) : i1; }
            ids[(size_t)t * 128 + h * 16 + j] = (unsigned short)(i0 * 128 + i1);
            gates[(size_t)t * 128 + h * 16 + j] = ev[j] * inv;
        }
    }
    xcd_barrier(bar);

    {
        constexpr int IDS_LD = 136, ACT_LD = 136;
        const float* scale2 = mod + 4096; const float* shift2 = mod + 3072; const float* gate2 = mod + 5120;
        unsigned short* ids_l = (unsigned short*)lds; float* act_l = (float*)(lds + 32768);
        const int t0 = bid * 64, tt = lane >> 3, sub = lane & 7, tl = wave * 8 + tt, t = t0 + tl;
        for (int e = tid; e < 1024; e += 512) { const int r = e >> 4, c8 = e & 15; *(uint4*)(ids_l + r * IDS_LD + c8 * 8) = *(const uint4*)(ids + (size_t)(t0 + r) * 128 + c8 * 8); }
        for (int e = tid; e < 64 * ACT_LD; e += 512) act_l[e] = 0.f;
        __syncthreads();
        float ri;
        { const float4* pp = (const float4*)(part2 + (size_t)t * 16); const float4 p0 = pp[0], p1 = pp[1], p2 = pp[2], p3 = pp[3];
          const float ssum = ((p0.x + p0.y) + (p0.z + p0.w)) + ((p1.x + p1.y) + (p1.z + p1.w)) + ((p2.x + p2.y) + (p2.z + p2.w)) + ((p3.x + p3.y) + (p3.z + p3.w));
          ri = 1.0f / sqrtf(ssum * (1.0f / D) + EPS); }
        const unsigned short* myids = ids_l + tl * IDS_LD;
        float* myact = act_l + tl * ACT_LD;
        const bool s4 = (sub & 4) != 0, s2 = (sub & 2) != 0, s1 = (sub & 1) != 0;
        for (int c = 0; c < 8; ++c) {
            float hv[16];
            const int col = 128 * c + 16 * sub;
#pragma unroll
            for (int q = 0; q < 4; ++q) {
                const float4 xv = *(const float4*)(out + (size_t)t * D + col + 4 * q);
                const float4 g = *(const float4*)(p.g2 + col + 4 * q), sc = *(const float4*)(scale2 + col + 4 * q), sh = *(const float4*)(shift2 + col + 4 * q);
                hv[4 * q + 0] = xv.x * ri * g.x * (1.f + sc.x) + sh.x; hv[4 * q + 1] = xv.y * ri * g.y * (1.f + sc.y) + sh.y;
                hv[4 * q + 2] = xv.z * ri * g.z * (1.f + sc.z) + sh.z; hv[4 * q + 3] = xv.w * ri * g.w * (1.f + sc.w) + sh.w;
            }
            const unsigned char* base = q8 + (size_t)c * (16384 * 128) + sub * 16;
#pragma unroll 2
            for (int jb = 0; jb < 16; ++jb) {
                const uint4 idv = *(const uint4*)(myids + 8 * jb); const unsigned idw[4] = {idv.x, idv.y, idv.z, idv.w};
                uint4 w[8];
#pragma unroll
                for (int k = 0; k < 8; ++k) { const unsigned id = (idw[k >> 1] >> (16 * (k & 1))) & 0xffffu; w[k] = *(const uint4*)(base + (size_t)id * 128); }
                float pd[8];
#pragma unroll
                for (int k = 0; k < 8; ++k) {
                    const unsigned ww[4] = {w[k].x, w[k].y, w[k].z, w[k].w};
                    float s = 0.f;
#pragma unroll
                    for (int m = 0; m < 4; ++m) { const auto lo = __builtin_amdgcn_cvt_pk_f32_fp8((int)ww[m], false); const auto hi = __builtin_amdgcn_cvt_pk_f32_fp8((int)ww[m], true);
                        s += hv[4 * m] * lo[0] + hv[4 * m + 1] * lo[1] + hv[4 * m + 2] * hi[0] + hv[4 * m + 3] * hi[1]; }
                    pd[k] = s;
                }
                float r4[4], r2[2];
#pragma unroll
                for (int k = 0; k < 4; ++k) { const float snd = s4 ? pd[k] : pd[k + 4], kp = s4 ? pd[k + 4] : pd[k]; r4[k] = kp + __shfl_xor(snd, 4); }
#pragma unroll
                for (int k = 0; k < 2; ++k) { const float snd = s2 ? r4[k] : r4[k + 2], kp = s2 ? r4[k + 2] : r4[k]; r2[k] = kp + __shfl_xor(snd, 2); }
                const float snd = s1 ? r2[0] : r2[1], kp = s1 ? r2[1] : r2[0];
                myact[8 * jb + sub] += kp + __shfl_xor(snd, 1);
            }
        }
        for (int jb = 0; jb < 16; ++jb) {
            const int j = 8 * jb + sub; const unsigned id = myids[j];
            const float a = myact[j] * qsc[id];
            const float av = fabsf(a), tq = 1.0f / (av * 0.2316418882f + 1.0f);
            float ql = tq * 0.5307027145f + (-0.7265760135f); ql = ql * tq + 0.7107068705f; ql = ql * tq + (-0.142248368f); ql = ql * tq + 0.127414796f; ql = ql * tq;
            const float mm = a * (ql * exp2f(a * a * (-0.72134752044f)));
            const float ge = (a < 0.f) ? mm : (a - mm);
            myact[j] = ge * gates[(size_t)t * 128 + j] * qsc[16384 + id];
        }
        __syncthreads();
        for (int c = 0; c < 8; ++c) {
            float o[16];
#pragma unroll
            for (int q = 0; q < 16; ++q) o[q] = 0.f;
            const int col = 128 * c + 16 * sub;
            const unsigned char* base = q8 + (16u << 20) + (size_t)c * (16384 * 128) + sub * 16;
#pragma unroll 2
            for (int jb = 0; jb < 16; ++jb) {
                const uint4 idv = *(const uint4*)(myids + 8 * jb); const unsigned idw[4] = {idv.x, idv.y, idv.z, idv.w};
                const float4 a0 = *(const float4*)(myact + 8 * jb), a1 = *(const float4*)(myact + 8 * jb + 4);
                const float av[8] = {a0.x, a0.y, a0.z, a0.w, a1.x, a1.y, a1.z, a1.w};
                uint4 w[8];
#pragma unroll
                for (int k = 0; k < 8; ++k) { const unsigned id = (idw[k >> 1] >> (16 * (k & 1))) & 0xffffu; w[k] = *(const uint4*)(base + (size_t)id * 128); }
#pragma unroll
                for (int k = 0; k < 8; ++k) {
                    const unsigned ww[4] = {w[k].x, w[k].y, w[k].z, w[k].w};
#pragma unroll
                    for (int m = 0; m < 4; ++m) { const auto lo = __builtin_amdgcn_cvt_pk_f32_fp8((int)ww[m], false); const auto hi = __builtin_amdgcn_cvt_pk_f32_fp8((int)ww[m], true);
                        o[4 * m] += av[k] * lo[0]; o[4 * m + 1] += av[k] * lo[1]; o[4 * m + 2] += av[k] * hi[0]; o[4 * m + 3] += av[k] * hi[1]; }
                }
            }
#pragma unroll
            for (int q = 0; q < 4; ++q) {
                float* op = out + (size_t)t * D + col + 4 * q;
                const float4 xv = *(const float4*)op; const float4 gt = *(const float4*)(gate2 + col + 4 * q);
                float4 r; r.x = xv.x + gt.x * o[4 * q]; r.y = xv.y + gt.y * o[4 * q + 1]; r.z = xv.z + gt.z * o[4 * q + 2]; r.w = xv.w + gt.w * o[4 * q + 3];
                *(float4*)op = r;
            }
        }
    }
}
}

extern "C" void kernel_launch(void* const* d_in, const int* in_sizes, int n_in, void* d_out, int out_size, void* d_ws, size_t ws_size, hipStream_t stream) {
    static int grid = 0;
    if (grid == 0) {
        int dev = 0, cus = 0, per_cu = 0;
        (void)hipGetDevice(&dev);
        (void)hipDeviceGetAttribute(&cus, hipDeviceAttributeMultiprocessorCount, dev);
        (void)hipFuncSetAttribute((const void*)mk_fwd, hipFuncAttributeMaxDynamicSharedMemorySize, LDS_BYTES);
        (void)hipOccupancyMaxActiveBlocksPerMultiprocessor(&per_cu, (const void*)mk_fwd, 512, LDS_BYTES);
        if (per_cu < 1 || cus != 256) { fprintf(stderr, "kernel_launch: needs 256 CUs with one resident workgroup each (cus %d, per_cu %d)\n", cus, per_cu); grid = -1; }
        else grid = cus;
    }
    if (grid < 0) return;
    (void)hipMemsetAsync((char*)d_ws + OFF_CTL, 0, CTL_BYTES, stream);
    Params p{};
    p.x = (const float*)d_in[0]; p.c = (const float*)d_in[1]; p.pos = (const int*)d_in[2]; p.ada_w = (const float*)d_in[3]; p.ada_b = (const float*)d_in[4];
    p.g1 = (const float*)d_in[5]; p.g2 = (const float*)d_in[6]; p.w_in = (const float*)d_in[7]; p.rgain = (const float*)d_in[8]; p.qg = (const float*)d_in[9];
    p.kg = (const float*)d_in[10]; p.og = (const float*)d_in[11]; p.w_out = (const float*)d_in[12]; p.wq = (const float*)d_in[13]; p.sk = (const float*)d_in[14];
    p.down = (const float*)d_in[15]; p.up = (const float*)d_in[16]; p.out = (float*)d_out; p.ws = (unsigned char*)d_ws;
    for (int i = 0; i < 32; ++i) p.rc.f[i] = pow(10000.0, -(double)i / 32.0) / 6.283185307179586476925;
    void* args[] = {&p};
    hipError_t e = hipLaunchCooperativeKernel((const void*)mk_fwd, dim3(grid), dim3(512), args, LDS_BYTES, stream);
    if (e != hipSuccess) fprintf(stderr, "kernel_launch: cooperative launch failed: %s (grid %d)\n", hipGetErrorString(e), grid);
}
```

```cpp
#include <hip/hip_runtime.h>
#include <stdint.h>
#include <math.h>
#include <cstdio>
#include <cstring>

namespace {
constexpr int T = 16384, D = 1024;
constexpr float EPS = 1e-6f;
typedef unsigned short bf16_t;
#define LAS __attribute__((address_space(3)))

__device__ __forceinline__ float bf2f(bf16_t b) { return __uint_as_float(((unsigned)b) << 16); }
__device__ __forceinline__ bf16_t f2bf(float f) { unsigned u = __float_as_uint(f); u += 0x7fffu + ((u >> 16) & 1u); return (bf16_t)(u >> 16); }
__device__ __forceinline__ float4 ld_nt4(const float* p) { typedef float f4v __attribute__((ext_vector_type(4))); const f4v v = __builtin_nontemporal_load((const f4v*)p); return make_float4(v[0], v[1], v[2], v[3]); }
__device__ __forceinline__ int vzero() { int z = 0; asm volatile("" : "+v"(z)); return z; }

__device__ __forceinline__ float lg2_head(int h) {
    const float x = __uint_as_float((unsigned)(127 - 5 - h) << 23);
    const float s = x * (1.f + x * (0.5f + x * (0.33333334f + x * (0.25f + x * (0.2f + x * 0.16666667f)))));
    return -s * 1.44269504089f;
}
struct RopeC { float fh[32], fl[32]; };
struct RetC { float lg2[8]; };

constexpr size_t MiB = 1u << 20;
constexpr size_t OFF_CTL = 0;
constexpr size_t CTL_BYTES = 64 * 1024;
constexpr size_t OFF_MOD = 64 * 1024, OFF_RINV1 = 128 * 1024, OFF_RINV2 = 192 * 1024, OFF_BIASF = 256 * 1024, OFF_ROPE = 1 * MiB;
constexpr size_t OFF_WINT = 6 * MiB;
constexpr size_t OFF_XB = 16 * MiB;
constexpr size_t OFF_YCAT = 16 * MiB;
constexpr size_t OFF_P = 48 * MiB;
constexpr size_t OFF_KV = 208 * MiB, OFF_ST = 224 * MiB;
constexpr size_t OFF_WEFFT = 240 * MiB;
constexpr size_t OFF_WOUTT = 13 * MiB;
constexpr size_t OFF_BIASQ = 272 * 1024;
constexpr size_t OFF_PART2 = 5 * MiB;
constexpr size_t OFF_X1B = 208 * MiB;
constexpr size_t OFF_SCORES = 48 * MiB;
constexpr size_t OFF_X1 = 48 * MiB;
constexpr size_t OFF_IDS = 244 * MiB, OFF_GATES = 248 * MiB;
constexpr size_t OFF_Q8 = 176 * MiB;
constexpr size_t OFF_QSC = 320 * 1024;
constexpr int LDS_BYTES = 163840;
constexpr int LDS_ST_OFF = LDS_BYTES - 16;

#define XB_TMO      128
#define XB_XCNT(j)  (256  + 64 * (j))
#define XB_XSUB(j)  (1280 + 64 * (j))
#define XB_XGEN(j)  (2304 + 64 * (j))
#define XB_TOP      3328
#define XB_TOPGEN   3392
#define XCD_BAR_WORDS 3456
#define XB_SPIN_CAP (1u << 20)
__device__ __forceinline__ unsigned xb_ld(unsigned* p)              { return __hip_atomic_load(p, __ATOMIC_RELAXED, __HIP_MEMORY_SCOPE_AGENT); }
__device__ __forceinline__ unsigned xb_add(unsigned* p, unsigned v) { return __hip_atomic_fetch_add(p, v, __ATOMIC_RELAXED, __HIP_MEMORY_SCOPE_AGENT); }
__device__ __forceinline__ unsigned xb_xcc_id() { return (unsigned)__builtin_amdgcn_s_getreg((3 << 11) | 20) & 0xFu; }
#define XB_SPIN(cond, bar) do { unsigned _sp = 0; while (cond) { __builtin_amdgcn_s_sleep(1); \
    if ((++_sp & 255u) == 0u) { if (xb_ld(&(bar)[XB_TMO])) break; if (_sp > XB_SPIN_CAP) { atomicAdd(&(bar)[XB_TMO], 1u); break; } } } } while (0)
struct XcdBarrier { unsigned* bar; unsigned x; volatile LAS unsigned* st; };
__device__ __forceinline__ XcdBarrier xcd_barrier_post(unsigned* bar, volatile LAS unsigned* st) {
    XcdBarrier b; b.bar = bar; b.x = xb_xcc_id(); b.st = st;
    if (threadIdx.x == 0) (void)xb_add(&bar[XB_XCNT(b.x)], 1u);
    return b;
}
__device__ __forceinline__ void xcd_barrier_complete(unsigned* bar, unsigned x, unsigned& nloc, unsigned& nx) {
    const unsigned G = gridDim.x * gridDim.y * gridDim.z;
    unsigned sum, cnt, mine, sp = 0u;
    for (;;) {
        sum = 0u; cnt = 0u; mine = 0u;
#pragma unroll
        for (unsigned j = 0; j < 16; ++j) { const unsigned c = xb_ld(&bar[XB_XCNT(j)]); sum += c; cnt += (c > 0u) ? 1u : 0u; mine = (j == x) ? c : mine; }
        if (sum == G) break;
        __builtin_amdgcn_s_sleep(1);
        if ((++sp & 255u) == 0u) { if (xb_ld(&bar[XB_TMO])) break; if (sp > XB_SPIN_CAP) { atomicAdd(&bar[XB_TMO], 1u); break; } }
    }
    nloc = mine > 0u ? mine : 1u; nx = cnt > 0u ? cnt : 1u;
}
__device__ __forceinline__ void xcd_barrier(const XcdBarrier& b) {
    asm volatile("s_waitcnt vmcnt(0)" ::: "memory");
    __syncthreads();
    if (threadIdx.x == 0) {
        unsigned* bar = b.bar;
        __builtin_amdgcn_s_waitcnt(0);
        unsigned nloc = b.st[0], nx = b.st[1];
        if (nloc == 0u) { xcd_barrier_complete(bar, b.x, nloc, nx); b.st[0] = nloc; b.st[1] = nx; }
        const unsigned old = xb_add(&bar[XB_XSUB(b.x)], 1u);
        const unsigned gen = old / nloc;
        if (old + 1u == (gen + 1u) * nloc) {
            __builtin_amdgcn_fence(__ATOMIC_RELEASE, "agent");
            asm volatile("s_waitcnt vmcnt(0)" ::: "memory");
            const unsigned og = xb_add(&bar[XB_TOP], 1u);
            const unsigned tg = og / nx;
            if (og + 1u == (tg + 1u) * nx) xb_add(&bar[XB_TOPGEN], 1u);
            else XB_SPIN(xb_ld(&bar[XB_TOPGEN]) == tg, bar);
            __builtin_amdgcn_fence(__ATOMIC_ACQUIRE, "agent");
            xb_add(&bar[XB_XGEN(b.x)], 1u);
            asm volatile("s_waitcnt vmcnt(0)" ::: "memory");
        } else {
            XB_SPIN(xb_ld(&bar[XB_XGEN(b.x)]) == gen, bar);
            __builtin_amdgcn_fence(__ATOMIC_ACQUIRE, "agent");
            asm volatile("s_waitcnt vmcnt(0)" ::: "memory");
        }
    }
    __syncthreads();
}

struct ALoadNorm {
    const float* x; const float* rinv; const float* gain; const float* mscale; const float* mshift;
    __device__ __forceinline__ float operator()(int t, int i) const { return x[(size_t)t * D + i] * rinv[t] * gain[i] * (1.f + mscale[i]) + mshift[i]; }
};
struct ALoadBf16 {
    const bf16_t* a;
    __device__ __forceinline__ float operator()(int t, int i) const { return bf2f(a[(size_t)t * D + i]); }
};
struct EpiInproj {
    bf16_t* P; const float2* rope; const float* qg; const float* kg;
    __device__ __forceinline__ void operator()(float (*Cs)[65], int m0, int n0, int tid) const {
        const int type = n0 / 512, head = (n0 % 512) / 64, tl = tid >> 2, part = tid & 3, t = m0 + tl;
        bf16_t* out = P + (size_t)type * T * 512 + (size_t)t * 512 + head * 64;
        const float* row = Cs[tl];
        if (type <= 1) {
            const float sc = type == 1 ? 0.125f : 1.f;
            for (int q = 0; q < 8; ++q) { const int d = part * 8 + q; const float2 cs = rope[t * 32 + d]; const float x1 = row[d], x2 = row[d + 32];
                out[d] = f2bf((x1 * cs.x - x2 * cs.y) * sc); out[d + 32] = f2bf((x2 * cs.x + x1 * cs.y) * sc); }
        } else if (type == 2 || type == 6) {
            for (int q = 0; q < 16; ++q) { const int d = part * 16 + q; out[d] = f2bf(row[d]); }
        } else if (type == 3) {
            for (int q = 0; q < 16; ++q) { const int d = part * 16 + q; const float v = row[d]; out[d] = f2bf(v / (1.f + expf(-v))); }
        } else {
            float ss = 0.f; for (int d = 0; d < 64; ++d) ss += row[d] * row[d];
            const float r = 1.0f / sqrtf(ss * (1.f / 64.f) + EPS);
            const float* g = type == 4 ? qg : kg; const float sc = type == 4 ? 0.125f : 1.f;
            for (int q = 0; q < 16; ++q) { const int d = part * 16 + q; out[d] = f2bf(row[d] * r * g[d] * sc); }
        }
    }
};
struct EpiOutproj {
    const float* x; const float* gate1; float* x1;
    __device__ __forceinline__ void operator()(float (*Cs)[65], int m0, int n0, int tid) const {
        for (int e = tid; e < 4096; e += 256) { const int r = e >> 6, c = e & 63; const size_t o = (size_t)(m0 + r) * D + n0 + c; x1[o] = x[o] + gate1[n0 + c] * Cs[r][c]; }
    }
};
struct EpiStore {
    float* out; int ld;
    __device__ __forceinline__ void operator()(float (*Cs)[65], int m0, int n0, int tid) const {
        for (int e = tid; e < 4096; e += 256) { const int r = e >> 6, c = e & 63; out[(size_t)(m0 + r) * ld + n0 + c] = Cs[r][c]; }
    }
};
template <class AL, class Epi>
__device__ __forceinline__ void gemm_naive_phase(unsigned char* lds, const AL al, const float* B, const int N, const Epi epi, const int bid, const int G) {
    const int half = threadIdx.x >> 8, tid = threadIdx.x & 255, tx = tid & 15, ty = tid >> 4;
    float (*As)[68] = (float (*)[68])(lds + half * 25344);
    float (*Bs)[68] = (float (*)[68])(lds + half * 25344 + 4352);
    float (*Cs)[65] = (float (*)[65])(lds + half * 25344 + 8704);
    const int NT = N / 64, units = NT * (T / 64);
    for (int U0 = 0; U0 < units; U0 += 2 * G) {
        const int U = U0 + 2 * bid + half;
        const int m0 = (U / NT) * 64, n0 = (U % NT) * 64;
        float acc[4][4];
#pragma unroll
        for (int i = 0; i < 4; ++i)
#pragma unroll
            for (int j = 0; j < 4; ++j) acc[i][j] = 0.f;
        for (int k0 = 0; k0 < 1024; k0 += 16) {
#pragma unroll
            for (int i = 0; i < 4; ++i) { const int r = (tid >> 4) + 16 * i, c = tid & 15; As[c][r] = al(m0 + r, k0 + c); }
#pragma unroll
            for (int i = 0; i < 4; ++i) { const int r = (tid >> 6) + 4 * i, c = tid & 63; Bs[r][c] = B[(size_t)(k0 + r) * N + n0 + c]; }
            __syncthreads();
#pragma unroll
            for (int kk = 0; kk < 16; ++kk) {
                float a[4], b[4];
#pragma unroll
                for (int i = 0; i < 4; ++i) { a[i] = As[kk][ty * 4 + i]; b[i] = Bs[kk][tx * 4 + i]; }
#pragma unroll
                for (int i = 0; i < 4; ++i)
#pragma unroll
                    for (int j = 0; j < 4; ++j) acc[i][j] += a[i] * b[j];
            }
            __syncthreads();
        }
#pragma unroll
        for (int i = 0; i < 4; ++i)
#pragma unroll
            for (int j = 0; j < 4; ++j) Cs[ty * 4 + i][tx * 4 + j] = acc[i][j];
        __syncthreads();
        epi(Cs, m0, n0, tid);
        __syncthreads();
    }
}


namespace pg8 {
#define PG8_LAS __attribute__((address_space(3)))
typedef short bf16x8 __attribute__((ext_vector_type(8)));
typedef float f32x4 __attribute__((ext_vector_type(4)));
typedef unsigned u32x4 __attribute__((ext_vector_type(4)));
typedef unsigned u32x2 __attribute__((ext_vector_type(2)));
constexpr int BM = 256, BK = 64, HALF = 128, HTB = HALF * BK * 2, STAGE_BYTES = 8 * HTB, NXCD = 8, WGM = 8;
__host__ __device__ __forceinline__ int lds_byte(int r, int c) { const int st = (r >> 4) * 2 + (c >> 5), rr = r & 15, cc = c & 31, ob = rr * 64 + cc * 2; return st * 1024 + (ob ^ (((ob >> 9) & 1) << 5)); }
__host__ __device__ __forceinline__ void stage_rc(int b, int& R, int& C) { const int st = b / 1024, sb = b % 1024, swz = sb ^ (((sb >> 9) & 1) << 5); R = (st >> 1) * 16 + swz / 64; C = (st & 1) * 32 + (swz % 64) / 2; }
__host__ __device__ __forceinline__ int perm32(int rho) { const int n = rho >> 4, i = rho & 15; return 8 * (i >> 2) + 4 * n + (i & 3); }
struct Unit { int pm, pn; };
struct Gemm { const bf16_t* A; const bf16_t* Bt; int M, N, K; };
struct StaticOrder {
    int nM, nN, nwg, G, c;
    __host__ __device__ void init(int M, int N, int G_, int c_) { nM = M / BM; nN = N / BM; nwg = nM * nN; G = G_; c = c_; }
    __host__ __device__ bool next(int i, Unit& u) const {
        const long L = (long)i * G + c; if (L >= nwg) return false;
        int wgid = (int)L; { const int q = nwg / NXCD, r = nwg % NXCD, xcd = wgid % NXCD, off = wgid / NXCD; wgid = (xcd < r ? xcd * (q + 1) : r * (q + 1) + (xcd - r) * q) + off; }
        const int nig = WGM * nN, gid = wgid / nig, fm = gid * WGM, gsz = (nM - fm) < WGM ? (nM - fm) : WGM;
        u.pm = fm + ((wgid % nig) % gsz); u.pn = (wgid % nig) / gsz; return true;
    }
    __device__ __forceinline__ void a_ready(const Unit&) const {}
    __device__ __forceinline__ void done(const Unit&) const {}
};
__device__ __forceinline__ unsigned cvt_pk_bf16(float lo, float hi) { unsigned r; asm volatile("v_cvt_pk_bf16_f32 %0, %1, %2" : "=v"(r) : "v"(lo), "v"(hi)); return r; }

template <class Epi, class Sched>
__device__ __forceinline__ void gemm_phase(PG8_LAS unsigned char* lds, const Gemm g, const Sched& S, const Epi& E) {
    int tid_ = threadIdx.x; asm volatile("" : "+v"(tid_));
    const int tid = tid_, wid = __builtin_amdgcn_readfirstlane(tid >> 6), lane = tid & 63, wr = wid >> 2, wc = wid & 3, fr = lane & 15, fq = lane >> 4;
    const int K = g.K, nt = K / BK;
    unsigned voffA[2], voffB[2];
#pragma unroll
    for (int i = 0; i < 2; ++i) { int R, C; stage_rc(tid * 16 + i * 8192, R, C); const int Rb = Epi::PERM ? ((R & ~31) + perm32(R & 31)) : R;
        voffA[i] = (unsigned)(R * K + C) * 2u; voffB[i] = (unsigned)(Rb * K + C) * 2u; }
    const size_t kstep = (size_t)(BK * 2);
    const size_t hstep = (size_t)HALF * K * 2;
    const size_t tstep = 2 * hstep;
    const unsigned ldsw = (unsigned)wid * 1024u;
    const int aoff = lds_byte(wr * 64 + fr, fq * 8), boff = lds_byte(wc * 32 + fr, fq * 8);
#define PG8_SA(b, h) (((b) * 2 + (h)) * HTB)
#define PG8_SB(b, h) ((4 + (b) * 2 + (h)) * HTB)
#define PG8_STAGE(bufoff, gbase, voff) do { _Pragma("unroll") for (int _i = 0; _i < 2; ++_i) \
        __builtin_amdgcn_global_load_lds((const unsigned*)((const char*)(gbase) + (voff)[_i]), (PG8_LAS unsigned*)(lds + (bufoff) + ldsw + _i * 8192), 16, 0, 0); } while (0)
#define PG8_LDA(dst, b, h) do { _Pragma("unroll") for (int m = 0; m < 4; ++m) _Pragma("unroll") for (int k = 0; k < 2; ++k) dst[m][k] = *(const PG8_LAS bf16x8*)(lds + PG8_SA(b, h) + aoff + m * 2048 + k * 1024); } while (0)
#define PG8_LDB(dst, b, h) do { _Pragma("unroll") for (int n = 0; n < 2; ++n) _Pragma("unroll") for (int k = 0; k < 2; ++k) dst[n][k] = *(const PG8_LAS bf16x8*)(lds + PG8_SB(b, h) + boff + n * 2048 + k * 1024); } while (0)
#define PG8_MMA(ai, bj, At, Bt) do { __builtin_amdgcn_s_setprio(1); _Pragma("unroll") for (int m = 0; m < 4; ++m) _Pragma("unroll") for (int n = 0; n < 2; ++n) _Pragma("unroll") for (int k = 0; k < 2; ++k) \
        acc[ai][bj][m][n] = __builtin_amdgcn_mfma_f32_16x16x32_bf16(Bt[n][k], At[m][k], acc[ai][bj][m][n], 0, 0, 0); __builtin_amdgcn_s_setprio(0); } while (0)
#define PG8_WAIT_V(n) asm volatile("s_waitcnt vmcnt(" #n ")" ::: "memory")
#define PG8_WAIT_L(n) asm volatile("s_waitcnt lgkmcnt(" #n ")" ::: "memory")
#define PG8_BAR __builtin_amdgcn_s_barrier()
#define PG8_SCHED __builtin_amdgcn_sched_barrier(0)
    Unit cur, nxt; int ui = 0;
    if (!S.next(0, cur)) return;
    f32x4 acc[2][2][4][2];
#pragma unroll
    for (int a = 0; a < 2; ++a)
#pragma unroll
        for (int b = 0; b < 2; ++b)
#pragma unroll
            for (int m = 0; m < 4; ++m)
#pragma unroll
                for (int n = 0; n < 2; ++n) acc[a][b][m][n] = (f32x4){0.f, 0.f, 0.f, 0.f};
    bf16x8 At[4][2], B0[2][2], B1[2][2];
    const char* cA = (const char*)g.A + (size_t)cur.pm * tstep; const char* cB = (const char*)g.Bt + (size_t)cur.pn * tstep;
    S.a_ready(cur);
    PG8_STAGE(PG8_SB(0, 0), cB, voffB); PG8_STAGE(PG8_SA(0, 0), cA, voffA); PG8_STAGE(PG8_SB(0, 1), cB + hstep, voffB); PG8_STAGE(PG8_SA(0, 1), cA + hstep, voffA);
    if (wr == 1) PG8_BAR;
    PG8_WAIT_V(4); PG8_BAR;
    PG8_STAGE(PG8_SB(1, 0), cB + kstep, voffB); PG8_STAGE(PG8_SA(1, 0), cA + kstep, voffA); PG8_STAGE(PG8_SB(1, 1), cB + hstep + kstep, voffB);
    PG8_WAIT_V(6); PG8_BAR;
    for (;;) {
        const bool has_next = S.next(ui + 1, nxt);
        const char* nA = has_next ? (const char*)g.A + (size_t)nxt.pm * tstep : cA; const char* nB = has_next ? (const char*)g.Bt + (size_t)nxt.pn * tstep : cB;
        for (int t = 0; t < nt; t += 2) {
            const bool last = (t == nt - 2);
            const char* a1 = cA + (size_t)(t + 1) * kstep;
            const char* a2 = last ? nA : cA + (size_t)(t + 2) * kstep; const char* b2 = last ? nB : cB + (size_t)(t + 2) * kstep;
            const char* a3 = a2 + kstep; const char* b3 = b2 + kstep;
            if (last && has_next) S.a_ready(nxt);
            PG8_LDB(B0, 0, 0); PG8_SCHED; PG8_LDA(At, 0, 0); PG8_STAGE(PG8_SA(1, 1), a1 + hstep, voffA);
            PG8_WAIT_L(8); PG8_BAR; PG8_WAIT_L(0); PG8_MMA(0, 0, At, B0); PG8_BAR; PG8_SCHED;
            PG8_LDB(B1, 0, 1); PG8_STAGE(PG8_SB(0, 0), b2, voffB);
            PG8_BAR; PG8_WAIT_L(0); PG8_MMA(0, 1, At, B1); PG8_BAR;
            PG8_LDA(At, 0, 1); PG8_STAGE(PG8_SA(0, 0), a2, voffA);
            PG8_BAR; PG8_WAIT_L(0); PG8_MMA(1, 0, At, B0); PG8_BAR; PG8_SCHED;
            PG8_STAGE(PG8_SB(0, 1), b2 + hstep, voffB);
            PG8_WAIT_V(6); PG8_BAR; PG8_MMA(1, 1, At, B1); PG8_BAR;
            PG8_LDB(B0, 1, 0); PG8_SCHED; PG8_LDA(At, 1, 0); PG8_STAGE(PG8_SA(0, 1), a2 + hstep, voffA);
            PG8_WAIT_L(8); PG8_BAR; PG8_WAIT_L(0); PG8_MMA(0, 0, At, B0); PG8_BAR; PG8_SCHED;
            PG8_LDB(B1, 1, 1); PG8_STAGE(PG8_SB(1, 0), b3, voffB);
            PG8_BAR; PG8_WAIT_L(0); PG8_MMA(0, 1, At, B1); PG8_BAR;
            PG8_LDA(At, 1, 1); PG8_STAGE(PG8_SA(1, 0), a3, voffA);
            PG8_BAR; PG8_WAIT_L(0); PG8_MMA(1, 0, At, B0); PG8_BAR; PG8_SCHED;
            PG8_STAGE(PG8_SB(1, 1), b3 + hstep, voffB);
            PG8_WAIT_V(6); PG8_BAR; PG8_MMA(1, 1, At, B1); PG8_BAR;
        }
        if constexpr (!Epi::AFTER_DRAIN) { E(acc, cur, wr, wc, fr, fq); S.done(cur); }
        if (!has_next) break;
#pragma unroll
        for (int a = 0; a < 2; ++a)
#pragma unroll
            for (int b = 0; b < 2; ++b)
#pragma unroll
                for (int m = 0; m < 4; ++m)
#pragma unroll
                    for (int n = 0; n < 2; ++n) acc[a][b][m][n] = (f32x4){0.f, 0.f, 0.f, 0.f};
        cur = nxt; cA = nA; cB = nB; ++ui;
    }
    PG8_WAIT_V(0);
    if (wr == 0) PG8_BAR;
    PG8_BAR;
    if constexpr (Epi::AFTER_DRAIN) { E.fused(acc, cur, wr, wc, fr, fq, lds, wid, lane); S.done(cur); }
#undef PG8_SA
#undef PG8_SB
#undef PG8_STAGE
#undef PG8_LDA
#undef PG8_LDB
#undef PG8_MMA
#undef PG8_WAIT_V
#undef PG8_WAIT_L
#undef PG8_BAR
#undef PG8_SCHED
}
}

__host__ __device__ __forceinline__ int cmap_in(int F) { return (F & ~255) + 128 * ((F >> 5) & 1) + 32 * ((F >> 6) & 3) + (F & 31); }
struct EpiInprojMF {
    static constexpr bool PERM = true, AFTER_DRAIN = false;
    bf16_t* P; const float* rinv; const float* bias_f; const int* pos; const float* ftab; const float* qg; const float* kg;
    __device__ __forceinline__ void operator()(const pg8::f32x4 (&acc)[2][2][4][2], const pg8::Unit& u, int wr, int wc, int fr, int fq) const {
        typedef pg8::f32x4 f32x4;
        asm volatile("" : "+v"(fr), "+v"(fq));
        const int type = u.pn >> 1, head = 4 * (u.pn & 1) + wc, fb = 256 * u.pn + 64 * wc;
        const size_t PSZ = (size_t)T * 512;
        const int rslot = (type == 0) ? 0 : (type == 1) ? 1 : (type == 3) ? 2 : (type == 4) ? 3 : 4;
        bf16_t* rowmaj = P + (size_t)rslot * PSZ;
        bf16_t* transp = P + (size_t)(type == 1 ? 5 : (type == 2 ? 6 : 7)) * PSZ;
        const bool want_t = (type == 1 || type == 2 || type == 6), want_r = !(type == 2 || type == 6);
        const float lgh = lg2_head(head);
        const int t0 = u.pm * 256 + wr * 64 + fr;
        float rv[8], pf[8];
        f32x4 bv[2][2], gv[2][2], fh[2], fl[2];
#pragma unroll
        for (int ai = 0; ai < 2; ++ai)
#pragma unroll
            for (int m = 0; m < 4; ++m) { const int t = t0 + ai * 128 + m * 16; rv[ai * 4 + m] = rinv[t]; pf[ai * 4 + m] = (float)pos[t]; }
        const float* gsrc = (type == 4) ? qg : kg;
#pragma unroll
        for (int bj = 0; bj < 2; ++bj)
#pragma unroll
            for (int n = 0; n < 2; ++n) { bv[bj][n] = *(const f32x4*)(bias_f + fb + 32 * bj + 8 * fq + 4 * n); gv[bj][n] = *(const f32x4*)(gsrc + 32 * bj + 8 * fq + 4 * n); }
#pragma unroll
        for (int n = 0; n < 2; ++n) { fh[n] = *(const f32x4*)(ftab + 8 * fq + 4 * n); fl[n] = *(const f32x4*)(ftab + 32 + 8 * fq + 4 * n); }
#pragma unroll
        for (int ai = 0; ai < 2; ++ai)
#pragma unroll
            for (int m = 0; m < 4; ++m) {
                const int t = t0 + ai * 128 + m * 16;
                const float r = rv[ai * 4 + m];
                f32x4 v[2][2];
#pragma unroll
                for (int bj = 0; bj < 2; ++bj)
#pragma unroll
                    for (int n = 0; n < 2; ++n) v[bj][n] = acc[ai][bj][m][n] * r + bv[bj][n];
                if (type <= 1) {
                    const float sc = (type == 1) ? 0.125f : 1.f, pp = pf[ai * 4 + m];
#pragma unroll
                    for (int n = 0; n < 2; ++n)
#pragma unroll
                        for (int j = 0; j < 4; ++j) {
                            const float rev = __builtin_amdgcn_fractf(__builtin_amdgcn_fractf(pp * fh[n][j]) + pp * fl[n][j]);
                            const float cs = __builtin_amdgcn_cosf(rev) * sc, sn = __builtin_amdgcn_sinf(rev) * sc;
                            const float x1 = v[0][n][j], x2 = v[1][n][j]; v[0][n][j] = x1 * cs - x2 * sn; v[1][n][j] = x2 * cs + x1 * sn;
                        }
                } else if (type == 3) {
#pragma unroll
                    for (int bj = 0; bj < 2; ++bj)
#pragma unroll
                        for (int n = 0; n < 2; ++n)
#pragma unroll
                            for (int j = 0; j < 4; ++j) { const float x = v[bj][n][j]; v[bj][n][j] = x / (1.f + __expf(-x)); }
                } else if (type == 4 || type == 5) {
                    float ss = 0.f;
#pragma unroll
                    for (int bj = 0; bj < 2; ++bj)
#pragma unroll
                        for (int n = 0; n < 2; ++n)
#pragma unroll
                            for (int j = 0; j < 4; ++j) ss += v[bj][n][j] * v[bj][n][j];
                    ss += __shfl_xor(ss, 16); ss += __shfl_xor(ss, 32);
                    const float rn = (1.0f / sqrtf(ss * (1.f / 64.f) + EPS)) * ((type == 4) ? 0.125f : 1.f);
#pragma unroll
                    for (int bj = 0; bj < 2; ++bj)
#pragma unroll
                        for (int n = 0; n < 2; ++n) v[bj][n] = v[bj][n] * rn * gv[bj][n];
                }
#pragma unroll
                for (int bj = 0; bj < 2; ++bj) {
                    pg8::u32x4 w; w.x = pg8::cvt_pk_bf16(v[bj][0][0], v[bj][0][1]); w.y = pg8::cvt_pk_bf16(v[bj][0][2], v[bj][0][3]);
                    w.z = pg8::cvt_pk_bf16(v[bj][1][0], v[bj][1][1]); w.w = pg8::cvt_pk_bf16(v[bj][1][2], v[bj][1][3]);
                    if (want_r) *(pg8::u32x4*)(rowmaj + (size_t)t * 512 + head * 64 + 32 * bj + 8 * fq) = w;
                    if (want_t) {
                        if (type == 1) {
                            const float zeta = exp2f((float)(127 - (t & 127)) * lgh);
                            w.x = pg8::cvt_pk_bf16(v[bj][0][0] * zeta, v[bj][0][1] * zeta); w.y = pg8::cvt_pk_bf16(v[bj][0][2] * zeta, v[bj][0][3] * zeta);
                            w.z = pg8::cvt_pk_bf16(v[bj][1][0] * zeta, v[bj][1][1] * zeta); w.w = pg8::cvt_pk_bf16(v[bj][1][2] * zeta, v[bj][1][3] * zeta);
                        }
                        const unsigned ww[4] = {w.x, w.y, w.z, w.w};
#pragma unroll
                        for (int q = 0; q < 8; ++q) transp[(size_t)(head * 64 + 32 * bj + 8 * fq + q) * T + t] = (bf16_t)((ww[q >> 1] >> (16 * (q & 1))) & 0xffffu);
                    }
                }
            }
    }
};

struct EpiOutprojMF {
    static constexpr bool PERM = false, AFTER_DRAIN = false;
    const float* x; const float* gate1; float* x1; bf16_t* x1b; float* part2;
    __device__ __forceinline__ void operator()(const pg8::f32x4 (&acc)[2][2][4][2], const pg8::Unit& u, int wr, int wc, int fr, int fq) const {
        typedef pg8::f32x4 f32x4;
        asm volatile("" : "+v"(fr), "+v"(fq));
        const int col0 = u.pn * 256 + wc * 32 + 4 * fq, row0 = u.pm * 256 + wr * 64 + fr;
        f32x4 gv[2][2], xv[2][2][2];
#pragma unroll
        for (int bj = 0; bj < 2; ++bj)
#pragma unroll
            for (int n = 0; n < 2; ++n) { gv[bj][n] = *(const f32x4*)(gate1 + col0 + bj * 128 + n * 16); xv[0][bj][n] = *(const f32x4*)(x + (size_t)row0 * D + col0 + bj * 128 + n * 16); }
#pragma unroll
        for (int idx = 0; idx < 8; ++idx) {
            const int ai = idx >> 2, m = idx & 3, row = row0 + ai * 128 + m * 16; const size_t off = (size_t)row * D + col0;
            if (idx < 7) { const int ai2 = (idx + 1) >> 2, m2 = (idx + 1) & 3; const size_t off2 = (size_t)(row0 + ai2 * 128 + m2 * 16) * D + col0;
#pragma unroll
                for (int bj = 0; bj < 2; ++bj)
#pragma unroll
                    for (int n = 0; n < 2; ++n) xv[(idx + 1) & 1][bj][n] = *(const f32x4*)(x + off2 + bj * 128 + n * 16); }
            float ss = 0.f;
#pragma unroll
            for (int bj = 0; bj < 2; ++bj)
#pragma unroll
                for (int n = 0; n < 2; ++n) {
                    const f32x4 o = xv[idx & 1][bj][n] + gv[bj][n] * acc[ai][bj][m][n];
                    *(f32x4*)(x1 + off + bj * 128 + n * 16) = o;
                    pg8::u32x2 w; w.x = pg8::cvt_pk_bf16(o[0], o[1]); w.y = pg8::cvt_pk_bf16(o[2], o[3]);
                    *(pg8::u32x2*)(x1b + off + bj * 128 + n * 16) = w;
                    ss += o[0] * o[0] + o[1] * o[1] + o[2] * o[2] + o[3] * o[3];
                }
            ss += __shfl_xor(ss, 16); ss += __shfl_xor(ss, 32);
            if (fq == 0) part2[(size_t)row * 16 + u.pn * 4 + wc] = ss;
        }
    }
};
struct EpiScoresMF {
    static constexpr bool PERM = false, AFTER_DRAIN = false;
    const float* part2; const float* bias_q; float* scores;
    __device__ __forceinline__ void operator()(const pg8::f32x4 (&acc)[2][2][4][2], const pg8::Unit& u, int wr, int wc, int fr, int fq) const {
        typedef pg8::f32x4 f32x4;
        asm volatile("" : "+v"(fr), "+v"(fq));
        const int col0 = u.pn * 256 + wc * 32 + 4 * fq;
        f32x4 bv[2][2];
#pragma unroll
        for (int bj = 0; bj < 2; ++bj)
#pragma unroll
            for (int n = 0; n < 2; ++n) bv[bj][n] = *(const f32x4*)(bias_q + col0 + bj * 128 + n * 16);
#pragma unroll
        for (int ai = 0; ai < 2; ++ai)
#pragma unroll
            for (int m = 0; m < 4; ++m) {
                const int row = u.pm * 256 + ai * 128 + wr * 64 + m * 16 + fr;
                const f32x4* pp = (const f32x4*)(part2 + (size_t)row * 16);
                const f32x4 p0 = pp[0], p1 = pp[1], p2 = pp[2], p3 = pp[3];
                const float ssum = ((p0[0] + p0[1]) + (p0[2] + p0[3])) + ((p1[0] + p1[1]) + (p1[2] + p1[3])) + ((p2[0] + p2[1]) + (p2[2] + p2[3])) + ((p3[0] + p3[1]) + (p3[2] + p3[3]));
                const float r = 1.0f / sqrtf(ssum * (1.0f / D) + EPS);
                float* rowp = scores + (size_t)row * 2048 + col0;
#pragma unroll
                for (int bj = 0; bj < 2; ++bj)
#pragma unroll
                    for (int n = 0; n < 2; ++n) *(f32x4*)(rowp + bj * 128 + n * 16) = acc[ai][bj][m][n] * r + bv[bj][n];
            }
    }
};

__device__ __forceinline__ unsigned pk2(float lo, float hi) { return (unsigned)f2bf(lo) | ((unsigned)f2bf(hi) << 16); }
template <bool FOLD, bool CMAP>
__device__ __forceinline__ void transpose_item(const float* W, int K, int N, bf16_t* WT, float* scr, int item, int lane, const float* sg, const float* sm) {
    const int nblk = N / 32, kb = item / nblk, nb = item % nblk, k0 = 64 * kb, n0 = 32 * nb;
#pragma unroll 8
    for (int i = 0; i < 32; ++i) { const int kk = 2 * i + (lane >> 5); float w = W[(size_t)(k0 + kk) * N + n0 + (lane & 31)];
        if (FOLD) w *= sg[k0 + kk] * (1.f + sm[k0 + kk]);
        scr[kk * 33 + (lane & 31)] = w; }
    asm volatile("s_waitcnt lgkmcnt(0)" ::: "memory");
    const int c = lane & 7, r0 = CMAP ? cmap_in(n0) : n0;
#pragma unroll
    for (int j = 0; j < 4; ++j) { const int n = (lane >> 3) + 8 * j; const float* s = scr + (8 * c) * 33 + n;
        pg8::u32x4 o; o.x = pk2(s[0 * 33], s[1 * 33]); o.y = pk2(s[2 * 33], s[3 * 33]); o.z = pk2(s[4 * 33], s[5 * 33]); o.w = pk2(s[6 * 33], s[7 * 33]);
        *(pg8::u32x4*)(WT + (size_t)(r0 + n) * K + k0 + 8 * c) = o; }
    asm volatile("s_waitcnt lgkmcnt(0)" ::: "memory");
}
template <int NC4, class VF>
__device__ __forceinline__ void gemv_cols(unsigned char* lds, const VF vf, const float* W, const int N, const int u, float* dst, const float* add) {
    constexpr int RG = 512 / NC4;
    float (*red)[NC4 * 4] = (float (*)[NC4 * 4])lds;
    const int tid = threadIdx.x, c4 = tid % NC4, rg = tid / NC4;
    if (rg < RG) {
        float4 acc = {0.f, 0.f, 0.f, 0.f};
        for (int r = rg; r < 1024; r += RG) { const float s = vf(r); const float4 w = *(const float4*)(W + (size_t)r * N + u * NC4 * 4 + c4 * 4);
            acc.x += s * w.x; acc.y += s * w.y; acc.z += s * w.z; acc.w += s * w.w; }
        red[rg][c4 * 4 + 0] = acc.x; red[rg][c4 * 4 + 1] = acc.y; red[rg][c4 * 4 + 2] = acc.z; red[rg][c4 * 4 + 3] = acc.w;
    }
    __syncthreads();
    if (tid < NC4 * 4) { float s = 0.f; for (int i = 0; i < RG; ++i) s += red[i][tid]; dst[u * NC4 * 4 + tid] = s + (add ? add[u * NC4 * 4 + tid] : 0.f); }
    __syncthreads();
}
struct VfSilu { const float* c; __device__ __forceinline__ float operator()(int r) const { const float v = c[r]; return v / (1.f + expf(-v)); } };
struct VfVec { const float* v; __device__ __forceinline__ float operator()(int r) const { return v[r]; } };


typedef float f32x16 __attribute__((ext_vector_type(16)));
typedef pg8::bf16x8 bf16x8;
#define MFMA32(a, b, c) __builtin_amdgcn_mfma_f32_32x32x16_bf16((a), (b), (c), 0, 0, 0)
__device__ __forceinline__ bf16x8 pack_frag(const f32x16& v, int s) {
    pg8::u32x4 w;
    w.x = pg8::cvt_pk_bf16(v[8 * s + 0], v[8 * s + 1]); w.y = pg8::cvt_pk_bf16(v[8 * s + 2], v[8 * s + 3]);
    w.z = pg8::cvt_pk_bf16(v[8 * s + 4], v[8 * s + 5]); w.w = pg8::cvt_pk_bf16(v[8 * s + 6], v[8 * s + 7]);
    return __builtin_bit_cast(bf16x8, w);
}
__device__ __forceinline__ bf16x8 load_tfrag(const bf16_t* rowp, int tok) {
    const uint2 a = *(const uint2*)(rowp + tok), b = *(const uint2*)(rowp + tok + 8);
    pg8::u32x4 w; w.x = a.x; w.y = a.y; w.z = b.x; w.w = b.y;
    return __builtin_bit_cast(bf16x8, w);
}

__device__ __forceinline__ void ins16(float (&s)[16], float x) {
#pragma unroll
    for (int i = 15; i >= 1; --i) s[i] = __builtin_amdgcn_fmed3f(s[i - 1], s[i], x);
    s[0] = fmaxf(s[0], x);
}


__device__ __forceinline__ void peer_route(const float (&s0)[16], const float (&s1)[16], unsigned short* idp, float* gp) {
    float tl[16];
#pragma unroll
    for (int i = 0; i < 16; ++i) tl[i] = -INFINITY;
#pragma unroll
    for (int a = 0; a < 16; ++a)
#pragma unroll
        for (int b = 0; b < 16; ++b)
            if ((a + 1) * (b + 1) <= 16) {
                const float v = __uint_as_float(__float_as_uint(s0[a]) & 0xFFFFFF80u) + __uint_as_float(__float_as_uint(s1[b]) & 0xFFFFFF80u);
                ins16(tl, __uint_as_float((__float_as_uint(v) & 0xFFFFFF00u) | (unsigned)(a * 16 + b)));
            }
    float ev[16]; float sum = 0.f;
    const float mx = __uint_as_float(__float_as_uint(tl[0]) & 0xFFFFFF00u);
#pragma unroll
    for (int j = 0; j < 16; ++j) { ev[j] = __expf(__uint_as_float(__float_as_uint(tl[j]) & 0xFFFFFF00u) - mx); sum += ev[j]; }
    const float inv = 1.f / sum;
    unsigned idw[8];
#pragma unroll
    for (int j = 0; j < 16; ++j) {
        const unsigned code = __float_as_uint(tl[j]) & 0xFFu; const int a = (int)(code >> 4), b = (int)(code & 15u);
        unsigned i0 = 0, i1 = 0;
#pragma unroll
        for (int k = 0; k < 16; ++k) { i0 = (a == k) ? (__float_as_uint(s0[k]) & 0x7Fu) : i0; i1 = (b == k) ? (__float_as_uint(s1[k]) & 0x7Fu) : i1; }
        const unsigned id = i0 * 128u + i1;
        if (j & 1) idw[j >> 1] |= id << 16; else idw[j >> 1] = id;
        ev[j] *= inv;
    }
    *(uint4*)idp = make_uint4(idw[0], idw[1], idw[2], idw[3]); *(uint4*)(idp + 8) = make_uint4(idw[4], idw[5], idw[6], idw[7]);
#pragma unroll
    for (int q = 0; q < 4; ++q) *(float4*)(gp + 4 * q) = make_float4(ev[4 * q], ev[4 * q + 1], ev[4 * q + 2], ev[4 * q + 3]);
}

struct OneUnitOrder {
    pg8::StaticOrder base; int round;
    __device__ __forceinline__ bool next(int i, pg8::Unit& u) const { if (i != 0) return false; return base.next(round, u); }
    __device__ __forceinline__ void a_ready(const pg8::Unit&) const {}
    __device__ __forceinline__ void done(const pg8::Unit&) const {}
};
struct EpiTopkMF {
    static constexpr bool PERM = false, AFTER_DRAIN = true;
    const float* part2; const float* bias_q; unsigned short* ids; float* gates;
    __device__ __forceinline__ void operator()(const pg8::f32x4 (&)[2][2][4][2], const pg8::Unit&, int, int, int, int) const {}
    __device__ __forceinline__ void fused(pg8::f32x4 (&acc)[2][2][4][2], const pg8::Unit& u, int wr, int wc, int fr, int fq, PG8_LAS unsigned char* lds, int wid, int lane) const {
        typedef pg8::f32x4 f32x4;
        constexpr int SLD = 260;
        PG8_LAS float* SC = (PG8_LAS float*)lds; PG8_LAS float* MG = (PG8_LAS float*)(lds + 128 * SLD * 4);
        const int tid = wid * 64 + lane, tok = tid & 255, hk = tid >> 8;
        float rinv[2][4];
#pragma unroll
        for (int ai = 0; ai < 2; ++ai)
#pragma unroll
            for (int m = 0; m < 4; ++m) {
                const int row = u.pm * 256 + ai * 128 + wr * 64 + m * 16 + fr;
                const f32x4* pp = (const f32x4*)(part2 + (size_t)row * 16);
                const f32x4 p0 = pp[0], p1 = pp[1], p2 = pp[2], p3 = pp[3];
                const float ssum = ((p0[0] + p0[1]) + (p0[2] + p0[3])) + ((p1[0] + p1[1]) + (p1[2] + p1[3])) + ((p2[0] + p2[1]) + (p2[2] + p2[3])) + ((p3[0] + p3[1]) + (p3[2] + p3[3]));
                rinv[ai][m] = 1.0f / sqrtf(ssum * (1.0f / D) + EPS);
            }
        float s0[16], s1[16];
#pragma unroll
        for (int p = 0; p < 2; ++p) {
            f32x4 bv[2];
#pragma unroll
            for (int n = 0; n < 2; ++n) bv[n] = *(const f32x4*)(bias_q + u.pn * 256 + p * 128 + wc * 32 + n * 16 + 4 * fq);
#pragma unroll
            for (int ai = 0; ai < 2; ++ai)
#pragma unroll
                for (int m = 0; m < 4; ++m)
#pragma unroll
                    for (int n = 0; n < 2; ++n)
#pragma unroll
                        for (int j = 0; j < 4; ++j)
                            SC[(32 * wc + 16 * n + 4 * fq + j) * SLD + (128 * ai + 64 * wr + 16 * m + fr)] = acc[ai][p][m][n][j] * rinv[ai][m] + bv[n][j];
            __syncthreads();
            float sl[16];
#pragma unroll
            for (int i = 0; i < 16; ++i) sl[i] = -INFINITY;
#pragma unroll 8
            for (int k = 0; k < 64; ++k) { const int key = 64 * hk + k; const float x = SC[key * SLD + tok]; ins16(sl, __uint_as_float((__float_as_uint(x) & 0xFFFFFF80u) | (unsigned)key)); }
            if (hk) {
#pragma unroll
                for (int i = 0; i < 16; ++i) MG[i * 256 + tok] = sl[i];
            }
            __syncthreads();
            if (!hk) {
#pragma unroll
                for (int i = 0; i < 16; ++i) ins16(sl, MG[i * 256 + tok]);
            }
#pragma unroll
            for (int i = 0; i < 16; ++i) { if (p == 0) s0[i] = sl[i]; else s1[i] = sl[i]; }
            __syncthreads();
        }
        if (!hk) { const size_t t = (size_t)u.pm * 256 + tok; peer_route(s0, s1, ids + t * 128 + u.pn * 16, gates + t * 128 + u.pn * 16); }
    }
};

struct Params {
    const float *x, *c; const int* pos; const float *ada_w, *ada_b, *g1, *g2, *w_in, *rgain, *qg, *kg, *og, *w_out, *wq, *sk, *down, *up;
    float* out; unsigned char* ws; RopeC rc;
};

__global__ void __launch_bounds__(512) mk_fwd(Params p) {
    extern __shared__ __attribute__((aligned(16))) unsigned char lds[];
    const int tid = threadIdx.x, lane = tid & 63, wave = tid >> 6, bid = blockIdx.x, G = gridDim.x;
    unsigned char* ws = p.ws;
    float* mod = (float*)(ws + OFF_MOD); float* rinv1 = (float*)(ws + OFF_RINV1); float* ftab = (float*)(ws + OFF_ROPE);
    bf16_t* P = (bf16_t*)(ws + OFF_P); float* kv = (float*)(ws + OFF_KV); bf16_t* stT = (bf16_t*)(ws + OFF_ST); bf16_t* ycat = (bf16_t*)(ws + OFF_YCAT);
    bf16_t* xb = (bf16_t*)(ws + OFF_XB); bf16_t* Win_t = (bf16_t*)(ws + OFF_WINT); float* bias_f = (float*)(ws + OFF_BIASF);
    bf16_t* Weff_t = (bf16_t*)(ws + OFF_WEFFT); bf16_t* Wout_t = (bf16_t*)(ws + OFF_WOUTT); float* bias_q = (float*)(ws + OFF_BIASQ);
    float* part2 = (float*)(ws + OFF_PART2); bf16_t* x1b = (bf16_t*)(ws + OFF_X1B); unsigned short* ids = (unsigned short*)(ws + OFF_IDS); unsigned char* q8 = ws + OFF_Q8; float* qsc = (float*)(ws + OFF_QSC); float* gates = (float*)(ws + OFF_GATES);
    const size_t PS = (size_t)T * 512;
    const bf16_t *Qr = P, *Kr = P + PS, *Gr = P + 2 * PS, *Qs = P + 3 * PS, *Ks = P + 4 * PS, *KrT = P + 5 * PS, *VrT = P + 6 * PS, *VsT = P + 7 * PS;
    float* out = p.out; float* x1 = (float*)(ws + OFF_X1);

    if (tid < 4) ((LAS unsigned*)((LAS unsigned char*)lds + LDS_ST_OFF))[tid] = 0u;
    __syncthreads();
    XcdBarrier bar = xcd_barrier_post((unsigned*)(ws + OFF_CTL), (volatile LAS unsigned*)((LAS unsigned char*)lds + LDS_ST_OFF));

    for (int u = bid; u < 256; u += G) gemv_cols<6>(lds, VfSilu{p.c}, p.ada_w, 6144, u, mod, p.ada_b);
    for (int row0 = (bid * 8 + wave) * 2; row0 < T; row0 += G * 16) {
        float4 v[2][4];
#pragma unroll
        for (int rr = 0; rr < 2; ++rr)
#pragma unroll
            for (int j = 0; j < 4; ++j) v[rr][j] = ld_nt4(p.x + (size_t)(row0 + rr) * D + (lane + 64 * j) * 4);
#pragma unroll
        for (int rr = 0; rr < 2; ++rr) {
            uint2* xo = (uint2*)(xb + (size_t)(row0 + rr) * D);
            float s = 0.f;
#pragma unroll
            for (int j = 0; j < 4; ++j) { const float4 q = v[rr][j]; s += q.x * q.x + q.y * q.y + q.z * q.z + q.w * q.w; xo[lane + 64 * j] = make_uint2(pk2(q.x, q.y), pk2(q.z, q.w)); }
#pragma unroll
            for (int o = 32; o > 0; o >>= 1) s += __shfl_xor(s, o);
            if (lane == 0) rinv1[row0 + rr] = 1.0f / sqrtf(s * (1.0f / D) + EPS);
        }
    }
    if (bid == 0 && tid == 0) {
#pragma unroll
        for (int i = 0; i < 32; ++i) { ftab[i] = p.rc.fh[i]; ftab[32 + i] = p.rc.fl[i]; }
    }
    {
        float* scr = (float*)(lds + wave * 16384);
        for (int it = bid * 8 + wave; it < 16 * 32; it += G * 8) transpose_item<false, false>(p.w_out, 1024, 1024, Wout_t, scr, it, lane, nullptr, nullptr);
    }
    xcd_barrier(bar);

    {
        float* scr = (float*)(lds + wave * 16384);
        for (int it = bid * 8 + wave; it < 16 * 112; it += G * 8) transpose_item<true, true>(p.w_in, 1024, 3584, Win_t, scr, it, lane, p.g1, mod + 1024);
        __syncthreads();
        for (int u = bid; u < 128; u += G) gemv_cols<7>(lds, VfVec{mod}, p.w_in, 3584, u, bias_f, nullptr);
        for (int U = bid; U < 256; U += G) {
            const int hp = U >> 4, k0 = (U & 15) * 8;
            float (*sks)[128] = (float (*)[128])lds; float* redb = (float*)(lds + 4096);
            for (int e = tid; e < 1024; e += 512) sks[e >> 7][e & 127] = p.sk[((size_t)hp * 128 + k0 + (e >> 7)) * 128 + (e & 127)];
            __syncthreads();
            float bsum[8];
#pragma unroll
            for (int kk = 0; kk < 8; ++kk) bsum[kk] = 0.f;
            for (int rr = 0; rr < 2; ++rr) {
                const int i = tid + 512 * rr;
                const float4* a4 = (const float4*)(p.wq + (size_t)i * 2048 + hp * 128);
                float acc[8];
#pragma unroll
                for (int kk = 0; kk < 8; ++kk) acc[kk] = 0.f;
                for (int c4 = 0; c4 < 32; ++c4) { const float4 a = a4[c4];
#pragma unroll
                    for (int kk = 0; kk < 8; ++kk) { const float4 b = *(const float4*)&sks[kk][4 * c4]; acc[kk] += a.x * b.x + a.y * b.y + a.z * b.z + a.w * b.w; } }
                const float s2 = p.g2[i] * (1.f + mod[4096 + i]), sh = mod[3072 + i];
#pragma unroll
                for (int kk = 0; kk < 8; ++kk) { Weff_t[(size_t)(hp * 128 + k0 + kk) * 1024 + i] = f2bf(acc[kk] * s2); bsum[kk] += sh * acc[kk]; }
            }
#pragma unroll
            for (int kk = 0; kk < 8; ++kk) { float v = bsum[kk];
#pragma unroll
                for (int o = 32; o > 0; o >>= 1) v += __shfl_xor(v, o);
                if (lane == 0) redb[wave * 8 + kk] = v; }
            __syncthreads();
            if (tid < 8) { float s = 0.f; for (int w = 0; w < 8; ++w) s += redb[w * 8 + tid]; bias_q[hp * 128 + k0 + tid] = s; }
            __syncthreads();
        }
    }
    xcd_barrier(bar);

    {
        pg8::Gemm g{xb, Win_t, T, 3584, 1024}; pg8::StaticOrder S; S.init(T, 3584, G, bid);
        EpiInprojMF E{P, rinv1, bias_f, p.pos, ftab, p.qg, p.kg};
        pg8::gemm_phase<EpiInprojMF, pg8::StaticOrder>((PG8_LAS unsigned char*)lds, g, S, E);
    }
    xcd_barrier(bar);

    {
        const int gw = __builtin_amdgcn_readfirstlane(bid * 8 + wave), NGW = G * 8, l31 = lane & 31, hf = lane >> 5;
        for (int U = gw; U < 1024; U += NGW) {
            const int n = U >> 3, h = U & 7;
            f32x16 C[2][2];
#pragma unroll
            for (int a = 0; a < 2; ++a)
#pragma unroll
                for (int b = 0; b < 2; ++b)
#pragma unroll
                    for (int r = 0; r < 16; ++r) C[a][b][r] = 0.f;
            const bf16_t* vrow = VrT + (size_t)(h * 64 + l31) * T + n * 128 + 8 * hf;
            const bf16_t* krow = KrT + (size_t)(h * 64 + l31) * T + n * 128 + 8 * hf;
#pragma unroll 2
            for (int s = 0; s < 8; ++s) {
                bf16x8 Af[2], Bf[2];
#pragma unroll
                for (int a = 0; a < 2; ++a) { Af[a] = *(const bf16x8*)(vrow + (size_t)a * 32 * T + 16 * s); Bf[a] = *(const bf16x8*)(krow + (size_t)a * 32 * T + 16 * s); }
#pragma unroll
                for (int a = 0; a < 2; ++a)
#pragma unroll
                    for (int b = 0; b < 2; ++b) C[a][b] = MFMA32(Af[a], Bf[b], C[a][b]);
            }
            float* dst = kv + (size_t)(n * 8 + h) * 4096;
#pragma unroll
            for (int a = 0; a < 2; ++a)
#pragma unroll
                for (int b = 0; b < 2; ++b)
#pragma unroll
                    for (int r = 0; r < 16; ++r) dst[(32 * a + (r & 3) + 8 * (r >> 2) + 4 * hf) * 64 + 32 * b + l31] = C[a][b][r];
        }
        bf16x8 Tri[2];
        {
            pg8::u32x4 w0, w1; unsigned* p0 = (unsigned*)&w0; unsigned* p1 = (unsigned*)&w1;
#pragma unroll
            for (int e2 = 0; e2 < 4; ++e2) {
                unsigned a0 = 0, a1 = 0;
#pragma unroll
                for (int q = 0; q < 2; ++q) { const int e = 2 * e2 + q, ip = 8 * (e >> 2) + 4 * hf + (e & 3);
                    a0 |= ((ip > l31) ? 0x3F80u : 0u) << (16 * q); a1 |= ((16 + ip > l31) ? 0x3F80u : 0u) << (16 * q); }
                p0[e2] = a0; p1[e2] = a1;
            }
            Tri[0] = __builtin_bit_cast(bf16x8, w0); Tri[1] = __builtin_bit_cast(bf16x8, w1);
        }
        for (int U = gw; U < 4096; U += NGW) {
            const int h = U & 7, qt = U >> 3, q0 = qt * 32;
            bf16x8 Qf[4];
#pragma unroll
            for (int s = 0; s < 4; ++s) Qf[s] = *(const bf16x8*)(Qs + (size_t)(q0 + l31) * 512 + h * 64 + 16 * s + 8 * hf);
            f32x16 O[2];
#pragma unroll
            for (int r = 0; r < 16; ++r) { O[0][r] = 0.f; O[1][r] = 0.f; }
            float carry = 0.f;
            const bf16_t* vrow = VsT + (size_t)(h * 64 + l31) * T + 4 * hf;
            bf16x8 Kn[4], Vn[2][2];
#pragma unroll
            for (int s = 0; s < 4; ++s) Kn[s] = *(const bf16x8*)(Ks + (size_t)(qt * 32 + l31) * 512 + h * 64 + 16 * s + 8 * hf);
#pragma unroll
            for (int s = 0; s < 2; ++s)
#pragma unroll
                for (int dt = 0; dt < 2; ++dt) Vn[s][dt] = load_tfrag(vrow + (size_t)dt * 32 * T, qt * 32 + 16 * s);
            for (int kb = qt; kb >= 0; --kb) {
                bf16x8 Kf[4], Vf[2][2];
#pragma unroll
                for (int s = 0; s < 4; ++s) Kf[s] = Kn[s];
#pragma unroll
                for (int s = 0; s < 2; ++s)
#pragma unroll
                    for (int dt = 0; dt < 2; ++dt) Vf[s][dt] = Vn[s][dt];
                {
                    const int kbn = (kb > 0) ? kb - 1 : 0;
#pragma unroll
                    for (int s = 0; s < 4; ++s) Kn[s] = *(const bf16x8*)(Ks + (size_t)(kbn * 32 + l31) * 512 + h * 64 + 16 * s + 8 * hf);
#pragma unroll
                    for (int s = 0; s < 2; ++s)
#pragma unroll
                        for (int dt = 0; dt < 2; ++dt) Vn[s][dt] = load_tfrag(vrow + (size_t)dt * 32 * T, kbn * 32 + 16 * s);
                }
                f32x16 S;
#pragma unroll
                for (int r = 0; r < 16; ++r) S[r] = 0.f;
#pragma unroll
                for (int s = 0; s < 4; ++s) S = MFMA32(Kf[s], Qf[s], S);
                const bool diag = (kb == qt);
                f32x16 sp, lb, lo;
                float csum = 0.f;
#pragma unroll
                for (int r = 0; r < 16; ++r) {
                    const int i = (r & 3) + 8 * (r >> 2) + 4 * hf;
                    const bool valid = !diag || (i < l31);
                    const float z = S[r];
                    const float l1p = __builtin_amdgcn_logf(1.0f + __builtin_amdgcn_exp2f(-fabsf(z) * 1.44269504089f)) * 0.69314718056f;
                    const float spv = valid ? (fmaxf(z, 0.f) + l1p) : 0.f;
                    sp[r] = spv; lb[r] = fminf(z, 0.f) - l1p; csum += spv;
                }
                f32x16 Rt;
#pragma unroll
                for (int r = 0; r < 16; ++r) Rt[r] = carry;
#pragma unroll
                for (int s = 0; s < 2; ++s) {
                    pg8::u32x4 wh;
                    wh.x = pg8::cvt_pk_bf16(sp[8 * s + 0], sp[8 * s + 1]); wh.y = pg8::cvt_pk_bf16(sp[8 * s + 2], sp[8 * s + 3]);
                    wh.z = pg8::cvt_pk_bf16(sp[8 * s + 4], sp[8 * s + 5]); wh.w = pg8::cvt_pk_bf16(sp[8 * s + 6], sp[8 * s + 7]);
                    const unsigned whh[4] = {wh.x, wh.y, wh.z, wh.w};
#pragma unroll
                    for (int e2 = 0; e2 < 4; ++e2) { lo[8 * s + 2 * e2] = sp[8 * s + 2 * e2] - __uint_as_float(whh[e2] << 16); lo[8 * s + 2 * e2 + 1] = sp[8 * s + 2 * e2 + 1] - __uint_as_float(whh[e2] & 0xffff0000u); }
                    Rt = MFMA32(Tri[s], __builtin_bit_cast(bf16x8, wh), Rt);
                    Rt = MFMA32(Tri[s], pack_frag(lo, s), Rt);
                }
                f32x16 wv;
#pragma unroll
                for (int r = 0; r < 16; ++r) {
                    const int i = (r & 3) + 8 * (r >> 2) + 4 * hf;
                    const bool valid = !diag || (i < l31);
                    wv[r] = valid ? __builtin_amdgcn_exp2f((lb[r] - Rt[r]) * 1.44269504089f) : 0.f;
                }
#pragma unroll
                for (int s = 0; s < 2; ++s) { const bf16x8 wp = pack_frag(wv, s);
#pragma unroll
                    for (int dt = 0; dt < 2; ++dt) O[dt] = MFMA32(Vf[s][dt], wp, O[dt]); }
                csum += __shfl_xor(csum, 32);
                carry += csum;
                if (__all(carry > 88.f)) break;
            }
            float ss = 0.f;
#pragma unroll
            for (int r = 0; r < 16; ++r) ss += O[0][r] * O[0][r] + O[1][r] * O[1][r];
            ss += __shfl_xor(ss, 32);
            const float rn = 1.0f / sqrtf(ss * (1.f / 64.f) + EPS);
            bf16_t* orow = ycat + (size_t)(q0 + l31) * 1024 + 512 + h * 64;
#pragma unroll
            for (int dt = 0; dt < 2; ++dt)
#pragma unroll
                for (int g4 = 0; g4 < 4; ++g4) {
                    const int d = 32 * dt + 8 * g4 + 4 * hf;
                    const float4 gn = *(const float4*)(p.og + d);
                    uint2 w; w.x = pg8::cvt_pk_bf16(O[dt][4 * g4] * rn * gn.x, O[dt][4 * g4 + 1] * rn * gn.y); w.y = pg8::cvt_pk_bf16(O[dt][4 * g4 + 2] * rn * gn.z, O[dt][4 * g4 + 3] * rn * gn.w);
                    *(uint2*)(orow + d) = w;
                }
        }
    }
    xcd_barrier(bar);

    {
        {
            const int nconv = (G > 64) ? (G - 64) * 8 : G * 8, cw = (G > 64) ? (bid - 64) * 8 + wave : bid * 8 + wave;
            if (cw >= 0) for (int row0 = cw * 2; row0 < 32768; row0 += nconv * 2) {
                float4 v[2][4]; float mx[2] = {0.f, 0.f};
#pragma unroll
                for (int rr = 0; rr < 2; ++rr) {
                    const int row = row0 + rr, isup = row >> 14, e = row & 16383;
                    const float* sp = (isup ? p.up : p.down) + (size_t)e * 1024 + lane * 16;
#pragma unroll
                    for (int q = 0; q < 4; ++q) v[rr][q] = ld_nt4(sp + 4 * q);
                }
#pragma unroll
                for (int rr = 0; rr < 2; ++rr) {
#pragma unroll
                    for (int q = 0; q < 4; ++q) mx[rr] = fmaxf(mx[rr], fmaxf(fmaxf(fabsf(v[rr][q].x), fabsf(v[rr][q].y)), fmaxf(fabsf(v[rr][q].z), fabsf(v[rr][q].w))));
#pragma unroll
                    for (int o = 32; o > 0; o >>= 1) mx[rr] = fmaxf(mx[rr], __shfl_xor(mx[rr], o));
                    const int row = row0 + rr, isup = row >> 14, e = row & 16383;
                    const float s = (mx[rr] > 0.f) ? exp2f(floorf(log2f(256.f / mx[rr]))) : 1.f;
                    uint4 w; unsigned* wp = (unsigned*)&w;
#pragma unroll
                    for (int q = 0; q < 4; ++q) { int pk = __builtin_amdgcn_cvt_pk_fp8_f32(v[rr][q].x * s, v[rr][q].y * s, 0, false); pk = __builtin_amdgcn_cvt_pk_fp8_f32(v[rr][q].z * s, v[rr][q].w * s, pk, true); wp[q] = (unsigned)pk; }
                    *(uint4*)(q8 + (size_t)isup * (16u << 20) + ((size_t)(lane >> 3) * 16384 + e) * 128 + (lane & 7) * 16) = w;
                    if (lane == 0) qsc[row] = 1.0f / s;
                }
            }
        }
    }
    for (int idx = bid * 512 + tid; idx < 32768; idx += G * 512) {
        const int h = idx >> 12;
        const float cd = exp2f(128.f * lg2_head(h));
        float s = 0.f;
        for (int n0 = 0; n0 < 128; n0 += 32) {
            float kvv[32];
#pragma unroll
            for (int q = 0; q < 32; ++q) kvv[q] = kv[(size_t)(n0 + q) * 32768 + idx];
#pragma unroll
            for (int q = 0; q < 32; ++q) { stT[(size_t)(n0 + q) * 32768 + idx] = f2bf(s); s = cd * s + kvv[q]; }
        }
    }
    xcd_barrier(bar);

    {
        const int gw = __builtin_amdgcn_readfirstlane(bid * 8 + wave), NGW = G * 8, l31 = lane & 31, hf = lane >> 5;
        for (int W2 = gw; W2 < 2048; W2 += NGW) {
            const int nh = W2 >> 1, n = nh >> 3, h = nh & 7;
            const float lg = lg2_head(h);
#pragma unroll 1
            for (int pass = 0; pass < 2; ++pass) {
                const int qt = (W2 & 1) ? (pass ? 2 : 1) : (pass ? 3 : 0);
                const int il = qt * 32 + l31, tq = n * 128 + il;
                bf16x8 Qf[4];
#pragma unroll
                for (int s = 0; s < 4; ++s) Qf[s] = *(const bf16x8*)(Qr + (size_t)tq * 512 + h * 64 + 16 * s + 8 * hf);
                f32x16 O[2];
#pragma unroll
                for (int r = 0; r < 16; ++r) { O[0][r] = 0.f; O[1][r] = 0.f; }
                const bf16_t* srow = stT + (size_t)nh * 4096 + (size_t)l31 * 64 + 8 * hf;
#pragma unroll
                for (int s = 0; s < 4; ++s)
#pragma unroll
                    for (int dt = 0; dt < 2; ++dt) O[dt] = MFMA32(*(const bf16x8*)(srow + dt * 32 * 64 + 16 * s), Qf[s], O[dt]);
                const float xi = exp2f((float)(il + 1) * lg);
#pragma unroll
                for (int r = 0; r < 16; ++r) { O[0][r] *= xi; O[1][r] *= xi; }
                const bf16_t* vrow = VrT + (size_t)(h * 64 + l31) * T + n * 128 + 4 * hf;
                bf16x8 Kn[4], Vn[2][2];
#pragma unroll
                for (int s = 0; s < 4; ++s) Kn[s] = *(const bf16x8*)(Kr + (size_t)(n * 128 + l31) * 512 + h * 64 + 16 * s + 8 * hf);
#pragma unroll
                for (int s = 0; s < 2; ++s)
#pragma unroll
                    for (int dt = 0; dt < 2; ++dt) Vn[s][dt] = load_tfrag(vrow + (size_t)dt * 32 * T, 16 * s);
                for (int jb = 0; jb <= qt; ++jb) {
                    bf16x8 Kf[4], Vf[2][2];
#pragma unroll
                    for (int s = 0; s < 4; ++s) Kf[s] = Kn[s];
#pragma unroll
                    for (int s = 0; s < 2; ++s)
#pragma unroll
                        for (int dt = 0; dt < 2; ++dt) Vf[s][dt] = Vn[s][dt];
                    {
                        const int jn = (jb < qt) ? jb + 1 : jb;
#pragma unroll
                        for (int s = 0; s < 4; ++s) Kn[s] = *(const bf16x8*)(Kr + (size_t)(n * 128 + jn * 32 + l31) * 512 + h * 64 + 16 * s + 8 * hf);
#pragma unroll
                        for (int s = 0; s < 2; ++s)
#pragma unroll
                            for (int dt = 0; dt < 2; ++dt) Vn[s][dt] = load_tfrag(vrow + (size_t)dt * 32 * T, jn * 32 + 16 * s);
                    }
                    f32x16 S;
#pragma unroll
                    for (int r = 0; r < 16; ++r) S[r] = 0.f;
#pragma unroll
                    for (int s = 0; s < 4; ++s) S = MFMA32(Kf[s], Qf[s], S);
#pragma unroll
                    for (int r = 0; r < 16; ++r) {
                        const int jl = jb * 32 + (r & 3) + 8 * (r >> 2) + 4 * hf, dl = il - jl;
                        S[r] = (dl >= 0) ? S[r] * __builtin_amdgcn_exp2f((float)dl * lg) : 0.f;
                    }
#pragma unroll
                    for (int s = 0; s < 2; ++s) { const bf16x8 wp = pack_frag(S, s);
#pragma unroll
                        for (int dt = 0; dt < 2; ++dt) O[dt] = MFMA32(Vf[s][dt], wp, O[dt]); }
                }
                float sm = 0.f;
#pragma unroll
                for (int r = 0; r < 16; ++r) sm += O[0][r] + O[1][r];
                sm += __shfl_xor(sm, 32);
                const float mean = sm * (1.f / 64.f);
                float vs = 0.f;
#pragma unroll
                for (int r = 0; r < 16; ++r) { const float d0 = O[0][r] - mean, d1 = O[1][r] - mean; vs += d0 * d0 + d1 * d1; }
                vs += __shfl_xor(vs, 32);
                const float rstd = 1.0f / sqrtf(vs * (1.f / 64.f) + EPS);
                bf16_t* orow = ycat + (size_t)tq * 1024 + h * 64;
                const bf16_t* grow = Gr + (size_t)tq * 512 + h * 64;
#pragma unroll
                for (int dt = 0; dt < 2; ++dt)
#pragma unroll
                    for (int g4 = 0; g4 < 4; ++g4) {
                        const int e = 32 * dt + 8 * g4 + 4 * hf;
                        const float4 gn = *(const float4*)(p.rgain + h * 64 + e);
                        const uint2 gg = *(const uint2*)(grow + e);
                        const float g0 = __uint_as_float(gg.x << 16), g1 = __uint_as_float(gg.x & 0xffff0000u), g2v = __uint_as_float(gg.y << 16), g3 = __uint_as_float(gg.y & 0xffff0000u);
                        uint2 w;
                        w.x = pg8::cvt_pk_bf16((O[dt][4 * g4] - mean) * rstd * gn.x * g0, (O[dt][4 * g4 + 1] - mean) * rstd * gn.y * g1);
                        w.y = pg8::cvt_pk_bf16((O[dt][4 * g4 + 2] - mean) * rstd * gn.z * g2v, (O[dt][4 * g4 + 3] - mean) * rstd * gn.w * g3);
                        *(uint2*)(orow + e) = w;
                    }
            }
        }
    }
    xcd_barrier(bar);

    {
        pg8::Gemm g{ycat, Wout_t, T, 1024, 1024}; pg8::StaticOrder S; S.init(T, 1024, G, bid);
        EpiOutprojMF E{p.x, mod + 2048, x1, x1b, part2};
        pg8::gemm_phase<EpiOutprojMF, pg8::StaticOrder>((PG8_LAS unsigned char*)lds, g, S, E);
    }
    xcd_barrier(bar);

    for (int round = 0; round < 2; ++round) {
        pg8::Gemm g{x1b, Weff_t, T, 2048, 1024}; OneUnitOrder S; S.base.init(T, 2048, G, bid); S.round = round;
        EpiTopkMF E{part2, bias_q, ids, gates};
        pg8::gemm_phase<EpiTopkMF, OneUnitOrder>((PG8_LAS unsigned char*)lds, g, S, E);
    }
    xcd_barrier(bar);

    {
        constexpr int IDS_LD = 136, ACT_LD = 136;
        const float* scale2 = mod + 4096; const float* shift2 = mod + 3072; const float* gate2 = mod + 5120;
        unsigned short* ids_l = (unsigned short*)lds; float* act_l = (float*)(lds + 32768);
        const int t0 = bid * 64, tt = lane >> 3, sub = lane & 7, tl = wave * 8 + tt, t = t0 + tl;
        for (int e = tid; e < 1024; e += 512) { const int r = e >> 4, c8 = e & 15; *(uint4*)(ids_l + r * IDS_LD + c8 * 8) = *(const uint4*)(ids + (size_t)(t0 + r) * 128 + c8 * 8); }
        for (int e = tid; e < 64 * ACT_LD; e += 512) act_l[e] = 0.f;
        __syncthreads();
        float ri;
        { const float4* pp = (const float4*)(part2 + (size_t)t * 16); const float4 p0 = pp[0], p1 = pp[1], p2 = pp[2], p3 = pp[3];
          const float ssum = ((p0.x + p0.y) + (p0.z + p0.w)) + ((p1.x + p1.y) + (p1.z + p1.w)) + ((p2.x + p2.y) + (p2.z + p2.w)) + ((p3.x + p3.y) + (p3.z + p3.w));
          ri = 1.0f / sqrtf(ssum * (1.0f / D) + EPS); }
        const unsigned short* myids = ids_l + tl * IDS_LD;
        float* myact = act_l + tl * ACT_LD;
        const bool s4 = (sub & 4) != 0, s2 = (sub & 2) != 0, s1 = (sub & 1) != 0;
        const unsigned suboff = (unsigned)sub * 16u;
        typedef float f32x2 __attribute__((ext_vector_type(2)));
#define P9_LOAD(W, JB) do { const uint4 idv_ = *(const uint4*)(myids + 8 * (JB)); const unsigned idw_[4] = {idv_.x, idv_.y, idv_.z, idv_.w}; \
        _Pragma("unroll") for (int k_ = 0; k_ < 8; ++k_) { const unsigned id_ = (idw_[k_ >> 1] >> (16 * (k_ & 1))) & 0xffffu; W[k_] = *(const uint4*)(sbase + (id_ * 128u + suboff)); } } while (0)
#define P9_DOWN(W, JB) do { float pd_[8]; \
        _Pragma("unroll") for (int k_ = 0; k_ < 8; ++k_) { const unsigned ww_[4] = {W[k_].x, W[k_].y, W[k_].z, W[k_].w}; f32x2 s_ = {0.f, 0.f}, u_ = {0.f, 0.f}; \
            _Pragma("unroll") for (int m_ = 0; m_ < 4; ++m_) { const f32x2 lo_ = __builtin_amdgcn_cvt_pk_f32_fp8((int)ww_[m_], false), hi_ = __builtin_amdgcn_cvt_pk_f32_fp8((int)ww_[m_], true); \
                s_ = lo_ * hp[2 * m_] + s_; u_ = hi_ * hp[2 * m_ + 1] + u_; } \
            s_ = s_ + u_; pd_[k_] = s_[0] + s_[1]; } \
        float r4_[4], r2_[2]; \
        _Pragma("unroll") for (int k_ = 0; k_ < 4; ++k_) { const float snd_ = s4 ? pd_[k_] : pd_[k_ + 4], kp_ = s4 ? pd_[k_ + 4] : pd_[k_]; r4_[k_] = kp_ + __shfl_xor(snd_, 4); } \
        _Pragma("unroll") for (int k_ = 0; k_ < 2; ++k_) { const float snd_ = s2 ? r4_[k_] : r4_[k_ + 2], kp_ = s2 ? r4_[k_ + 2] : r4_[k_]; r2_[k_] = kp_ + __shfl_xor(snd_, 2); } \
        { const float snd_ = s1 ? r2_[0] : r2_[1], kp_ = s1 ? r2_[1] : r2_[0]; myact[8 * (JB) + sub] += kp_ + __shfl_xor(snd_, 1); } } while (0)
#define P9_UP(W, JB) do { const float4 a0_ = *(const float4*)(myact + 8 * (JB)), a1_ = *(const float4*)(myact + 8 * (JB) + 4); \
        const float av_[8] = {a0_.x, a0_.y, a0_.z, a0_.w, a1_.x, a1_.y, a1_.z, a1_.w}; \
        _Pragma("unroll") for (int k_ = 0; k_ < 8; ++k_) { const unsigned ww_[4] = {W[k_].x, W[k_].y, W[k_].z, W[k_].w}; \
            _Pragma("unroll") for (int m_ = 0; m_ < 4; ++m_) { const f32x2 lo_ = __builtin_amdgcn_cvt_pk_f32_fp8((int)ww_[m_], false), hi_ = __builtin_amdgcn_cvt_pk_f32_fp8((int)ww_[m_], true); \
                o2[2 * m_] = lo_ * av_[k_] + o2[2 * m_]; o2[2 * m_ + 1] = hi_ * av_[k_] + o2[2 * m_ + 1]; } } } while (0)
        for (int c = 0; c < 8; ++c) {
            f32x2 hp[8];
            const int col = 128 * c + 16 * sub;
#pragma unroll
            for (int q = 0; q < 4; ++q) {
                const float4 xv = *(const float4*)(x1 + (size_t)t * D + col + 4 * q);
                const float4 g = *(const float4*)(p.g2 + col + 4 * q), sc = *(const float4*)(scale2 + col + 4 * q), sh = *(const float4*)(shift2 + col + 4 * q);
                hp[2 * q][0] = xv.x * ri * g.x * (1.f + sc.x) + sh.x; hp[2 * q][1] = xv.y * ri * g.y * (1.f + sc.y) + sh.y;
                hp[2 * q + 1][0] = xv.z * ri * g.z * (1.f + sc.z) + sh.z; hp[2 * q + 1][1] = xv.w * ri * g.w * (1.f + sc.w) + sh.w;
            }
            const unsigned char* sbase = q8 + (size_t)c * (16384 * 128);
            uint4 wA[8], wB[8];
            P9_LOAD(wA, 0);
#pragma unroll 1
            for (int jb = 0; jb < 16; jb += 2) {
                P9_LOAD(wB, jb + 1);
                P9_DOWN(wA, jb);
                if (jb + 2 < 16) P9_LOAD(wA, jb + 2);
                P9_DOWN(wB, jb + 1);
            }
        }
        for (int jb = 0; jb < 16; ++jb) {
            const int j = 8 * jb + sub; const unsigned id = myids[j];
            const float a = myact[j] * qsc[id];
            const float av = fabsf(a), tq = 1.0f / (av * 0.2316418882f + 1.0f);
            float ql = tq * 0.5307027145f + (-0.7265760135f); ql = ql * tq + 0.7107068705f; ql = ql * tq + (-0.142248368f); ql = ql * tq + 0.127414796f; ql = ql * tq;
            const float mm = a * (ql * exp2f(a * a * (-0.72134752044f)));
            const float ge = (a < 0.f) ? mm : (a - mm);
            myact[j] = ge * gates[(size_t)t * 128 + j] * qsc[16384 + id];
        }
        __syncthreads();
        for (int c = 0; c < 8; ++c) {
            f32x2 o2[8];
#pragma unroll
            for (int q = 0; q < 8; ++q) o2[q] = (f32x2){0.f, 0.f};
            const int col = 128 * c + 16 * sub;
            const unsigned char* sbase = q8 + (16u << 20) + (size_t)c * (16384 * 128);
            uint4 wA[8], wB[8];
            P9_LOAD(wA, 0);
#pragma unroll 1
            for (int jb = 0; jb < 16; jb += 2) {
                P9_LOAD(wB, jb + 1);
                P9_UP(wA, jb);
                if (jb + 2 < 16) P9_LOAD(wA, jb + 2);
                P9_UP(wB, jb + 1);
            }
#pragma unroll
            for (int q = 0; q < 4; ++q) {
                float* op = out + (size_t)t * D + col + 4 * q;
                const float4 xv = *(const float4*)(x1 + (size_t)t * D + col + 4 * q); const float4 gt = *(const float4*)(gate2 + col + 4 * q);
                float4 r; r.x = xv.x + gt.x * o2[2 * q][0]; r.y = xv.y + gt.y * o2[2 * q][1]; r.z = xv.z + gt.z * o2[2 * q + 1][0]; r.w = xv.w + gt.w * o2[2 * q + 1][1];
                *(float4*)op = r;
            }
        }
#undef P9_LOAD
#undef P9_DOWN
#undef P9_UP
    }
}
}

extern "C" void kernel_launch(void* const* d_in, const int* in_sizes, int n_in, void* d_out, int out_size, void* d_ws, size_t ws_size, hipStream_t stream) {
    static int grid = 0;
    if (grid == 0) {
        int dev = 0, cus = 0, per_cu = 0;
        (void)hipGetDevice(&dev);
        (void)hipDeviceGetAttribute(&cus, hipDeviceAttributeMultiprocessorCount, dev);
        (void)hipFuncSetAttribute((const void*)mk_fwd, hipFuncAttributeMaxDynamicSharedMemorySize, LDS_BYTES);
        (void)hipOccupancyMaxActiveBlocksPerMultiprocessor(&per_cu, (const void*)mk_fwd, 512, LDS_BYTES);
        if (per_cu < 1 || cus != 256) { fprintf(stderr, "kernel_launch: needs 256 CUs with one resident workgroup each (cus %d, per_cu %d)\n", cus, per_cu); grid = -1; }
        else grid = cus;
    }
    if (grid < 0) return;
    (void)hipMemsetAsync((char*)d_ws + OFF_CTL, 0, CTL_BYTES, stream);
    Params p{};
    p.x = (const float*)d_in[0]; p.c = (const float*)d_in[1]; p.pos = (const int*)d_in[2]; p.ada_w = (const float*)d_in[3]; p.ada_b = (const float*)d_in[4];
    p.g1 = (const float*)d_in[5]; p.g2 = (const float*)d_in[6]; p.w_in = (const float*)d_in[7]; p.rgain = (const float*)d_in[8]; p.qg = (const float*)d_in[9];
    p.kg = (const float*)d_in[10]; p.og = (const float*)d_in[11]; p.w_out = (const float*)d_in[12]; p.wq = (const float*)d_in[13]; p.sk = (const float*)d_in[14];
    p.down = (const float*)d_in[15]; p.up = (const float*)d_in[16]; p.out = (float*)d_out; p.ws = (unsigned char*)d_ws;
    for (int i = 0; i < 32; ++i) {
        const double f = pow(10000.0, -(double)i / 32.0) / 6.283185307179586476925;
        float fh = (float)f; unsigned ub; memcpy(&ub, &fh, 4); ub &= 0xFFFFC000u; memcpy(&fh, &ub, 4);
        p.rc.fh[i] = fh; p.rc.fl[i] = (float)(f - (double)fh);
    }
    void* args[] = {&p};
    hipError_t e = hipLaunchCooperativeKernel((const void*)mk_fwd, dim3(grid), dim3(512), args, LDS_BYTES, stream);
    if (e != hipSuccess) fprintf(stderr, "kernel_launch: cooperative launch failed: %s (grid %d)\n", hipGetErrorString(e), grid);
}
```

```cpp
#include <hip/hip_runtime.h>
#include <stdint.h>
#include <math.h>
#include <cstdio>
#include <cstring>

namespace {
constexpr int T = 16384, D = 1024;
constexpr float EPS = 1e-6f;
typedef unsigned short bf16_t;
#define LAS __attribute__((address_space(3)))

__device__ __forceinline__ float bf2f(bf16_t b) { return __uint_as_float(((unsigned)b) << 16); }
__device__ __forceinline__ bf16_t f2bf(float f) { unsigned u = __float_as_uint(f); u += 0x7fffu + ((u >> 16) & 1u); return (bf16_t)(u >> 16); }
__device__ __forceinline__ float4 ld_nt4(const float* p) { typedef float f4v __attribute__((ext_vector_type(4))); const f4v v = __builtin_nontemporal_load((const f4v*)p); return make_float4(v[0], v[1], v[2], v[3]); }
__device__ __forceinline__ int vzero() { int z = 0; asm volatile("" : "+v"(z)); return z; }

__device__ __forceinline__ float lg2_head(int h) {
    const float x = __uint_as_float((unsigned)(127 - 5 - h) << 23);
    const float s = x * (1.f + x * (0.5f + x * (0.33333334f + x * (0.25f + x * (0.2f + x * 0.16666667f)))));
    return -s * 1.44269504089f;
}
struct RopeC { float fh[32], fl[32]; };
struct RetC { float lg2[8]; };

constexpr size_t MiB = 1u << 20;
constexpr size_t OFF_CTL = 0;
constexpr size_t CTL_BYTES = 64 * 1024;
constexpr size_t OFF_MOD = 64 * 1024, OFF_RINV1 = 128 * 1024, OFF_RINV2 = 192 * 1024, OFF_BIASF = 256 * 1024, OFF_ROPE = 1 * MiB;
constexpr size_t OFF_WINT = 6 * MiB;
constexpr size_t OFF_XB = 16 * MiB;
constexpr size_t OFF_YCAT = 16 * MiB;
constexpr size_t OFF_P = 48 * MiB;
constexpr size_t OFF_KV = 208 * MiB, OFF_ST = 224 * MiB;
constexpr size_t OFF_WEFFT = 240 * MiB;
constexpr size_t OFF_WOUTT = 13 * MiB;
constexpr size_t OFF_BIASQ = 272 * 1024;
constexpr size_t OFF_BQPART = 448 * 1024;
constexpr size_t OFF_PART2 = 5 * MiB;
constexpr size_t OFF_X1B = 208 * MiB;
constexpr size_t OFF_SCORES = 48 * MiB;
constexpr size_t OFF_X1 = 48 * MiB;
constexpr size_t OFF_IDS = 244 * MiB, OFF_GATES = 248 * MiB;
constexpr size_t OFF_Q8 = 176 * MiB;
constexpr size_t OFF_QSC = 320 * 1024;
constexpr int CONV_SPLIT = 0;
constexpr int LDS_BYTES = 163840;
constexpr int LDS_ST_OFF = LDS_BYTES - 16;

#define XB_TMO      128
#define XB_XCNT(j)  (256  + 64 * (j))
#define XB_XSUB(j)  (1280 + 64 * (j))
#define XB_XGEN(j)  (2304 + 64 * (j))
#define XB_TOP      3328
#define XB_TOPGEN   3392
#define XCD_BAR_WORDS 3456
#define XB_SPIN_CAP (1u << 20)
__device__ __forceinline__ unsigned xb_ld(unsigned* p)              { return __hip_atomic_load(p, __ATOMIC_RELAXED, __HIP_MEMORY_SCOPE_AGENT); }
__device__ __forceinline__ unsigned xb_add(unsigned* p, unsigned v) { return __hip_atomic_fetch_add(p, v, __ATOMIC_RELAXED, __HIP_MEMORY_SCOPE_AGENT); }
__device__ __forceinline__ unsigned xb_xcc_id() { return (unsigned)__builtin_amdgcn_s_getreg((3 << 11) | 20) & 0xFu; }
#define XB_SPIN(cond, bar) do { unsigned _sp = 0; while (cond) { __builtin_amdgcn_s_sleep(1); \
    if ((++_sp & 255u) == 0u) { if (xb_ld(&(bar)[XB_TMO])) break; if (_sp > XB_SPIN_CAP) { atomicAdd(&(bar)[XB_TMO], 1u); break; } } } } while (0)
struct XcdBarrier { unsigned* bar; unsigned x; volatile LAS unsigned* st; };
__device__ __forceinline__ XcdBarrier xcd_barrier_post(unsigned* bar, volatile LAS unsigned* st) {
    XcdBarrier b; b.bar = bar; b.x = xb_xcc_id(); b.st = st;
    if (threadIdx.x == 0) (void)xb_add(&bar[XB_XCNT(b.x)], 1u);
    return b;
}
__device__ __forceinline__ void xcd_barrier_complete(unsigned* bar, unsigned x, unsigned& nloc, unsigned& nx) {
    const unsigned G = gridDim.x * gridDim.y * gridDim.z;
    unsigned sum, cnt, mine, sp = 0u;
    for (;;) {
        sum = 0u; cnt = 0u; mine = 0u;
#pragma unroll
        for (unsigned j = 0; j < 16; ++j) { const unsigned c = xb_ld(&bar[XB_XCNT(j)]); sum += c; cnt += (c > 0u) ? 1u : 0u; mine = (j == x) ? c : mine; }
        if (sum == G) break;
        __builtin_amdgcn_s_sleep(1);
        if ((++sp & 255u) == 0u) { if (xb_ld(&bar[XB_TMO])) break; if (sp > XB_SPIN_CAP) { atomicAdd(&bar[XB_TMO], 1u); break; } }
    }
    nloc = mine > 0u ? mine : 1u; nx = cnt > 0u ? cnt : 1u;
}
__device__ __forceinline__ void xcd_barrier(const XcdBarrier& b) {
    asm volatile("s_waitcnt vmcnt(0)" ::: "memory");
    __syncthreads();
    if (threadIdx.x == 0) {
        unsigned* bar = b.bar;
        __builtin_amdgcn_s_waitcnt(0);
        unsigned nloc = b.st[0], nx = b.st[1];
        if (nloc == 0u) { xcd_barrier_complete(bar, b.x, nloc, nx); b.st[0] = nloc; b.st[1] = nx; }
        const unsigned old = xb_add(&bar[XB_XSUB(b.x)], 1u);
        const unsigned gen = old / nloc;
        if (old + 1u == (gen + 1u) * nloc) {
            __builtin_amdgcn_fence(__ATOMIC_RELEASE, "agent");
            asm volatile("s_waitcnt vmcnt(0)" ::: "memory");
            const unsigned og = xb_add(&bar[XB_TOP], 1u);
            const unsigned tg = og / nx;
            if (og + 1u == (tg + 1u) * nx) xb_add(&bar[XB_TOPGEN], 1u);
            else XB_SPIN(xb_ld(&bar[XB_TOPGEN]) == tg, bar);
            __builtin_amdgcn_fence(__ATOMIC_ACQUIRE, "agent");
            xb_add(&bar[XB_XGEN(b.x)], 1u);
            asm volatile("s_waitcnt vmcnt(0)" ::: "memory");
        } else {
            XB_SPIN(xb_ld(&bar[XB_XGEN(b.x)]) == gen, bar);
            __builtin_amdgcn_fence(__ATOMIC_ACQUIRE, "agent");
            asm volatile("s_waitcnt vmcnt(0)" ::: "memory");
        }
    }
    __syncthreads();
}

struct ALoadNorm {
    const float* x; const float* rinv; const float* gain; const float* mscale; const float* mshift;
    __device__ __forceinline__ float operator()(int t, int i) const { return x[(size_t)t * D + i] * rinv[t] * gain[i] * (1.f + mscale[i]) + mshift[i]; }
};
struct ALoadBf16 {
    const bf16_t* a;
    __device__ __forceinline__ float operator()(int t, int i) const { return bf2f(a[(size_t)t * D + i]); }
};
struct EpiInproj {
    bf16_t* P; const float2* rope; const float* qg; const float* kg;
    __device__ __forceinline__ void operator()(float (*Cs)[65], int m0, int n0, int tid) const {
        const int type = n0 / 512, head = (n0 % 512) / 64, tl = tid >> 2, part = tid & 3, t = m0 + tl;
        bf16_t* out = P + (size_t)type * T * 512 + (size_t)t * 512 + head * 64;
        const float* row = Cs[tl];
        if (type <= 1) {
            const float sc = type == 1 ? 0.125f : 1.f;
            for (int q = 0; q < 8; ++q) { const int d = part * 8 + q; const float2 cs = rope[t * 32 + d]; const float x1 = row[d], x2 = row[d + 32];
                out[d] = f2bf((x1 * cs.x - x2 * cs.y) * sc); out[d + 32] = f2bf((x2 * cs.x + x1 * cs.y) * sc); }
        } else if (type == 2 || type == 6) {
            for (int q = 0; q < 16; ++q) { const int d = part * 16 + q; out[d] = f2bf(row[d]); }
        } else if (type == 3) {
            for (int q = 0; q < 16; ++q) { const int d = part * 16 + q; const float v = row[d]; out[d] = f2bf(v / (1.f + expf(-v))); }
        } else {
            float ss = 0.f; for (int d = 0; d < 64; ++d) ss += row[d] * row[d];
            const float r = 1.0f / sqrtf(ss * (1.f / 64.f) + EPS);
            const float* g = type == 4 ? qg : kg; const float sc = type == 4 ? 0.125f : 1.f;
            for (int q = 0; q < 16; ++q) { const int d = part * 16 + q; out[d] = f2bf(row[d] * r * g[d] * sc); }
        }
    }
};
struct EpiOutproj {
    const float* x; const float* gate1; float* x1;
    __device__ __forceinline__ void operator()(float (*Cs)[65], int m0, int n0, int tid) const {
        for (int e = tid; e < 4096; e += 256) { const int r = e >> 6, c = e & 63; const size_t o = (size_t)(m0 + r) * D + n0 + c; x1[o] = x[o] + gate1[n0 + c] * Cs[r][c]; }
    }
};
struct EpiStore {
    float* out; int ld;
    __device__ __forceinline__ void operator()(float (*Cs)[65], int m0, int n0, int tid) const {
        for (int e = tid; e < 4096; e += 256) { const int r = e >> 6, c = e & 63; out[(size_t)(m0 + r) * ld + n0 + c] = Cs[r][c]; }
    }
};
template <class AL, class Epi>
__device__ __forceinline__ void gemm_naive_phase(unsigned char* lds, const AL al, const float* B, const int N, const Epi epi, const int bid, const int G) {
    const int half = threadIdx.x >> 8, tid = threadIdx.x & 255, tx = tid & 15, ty = tid >> 4;
    float (*As)[68] = (float (*)[68])(lds + half * 25344);
    float (*Bs)[68] = (float (*)[68])(lds + half * 25344 + 4352);
    float (*Cs)[65] = (float (*)[65])(lds + half * 25344 + 8704);
    const int NT = N / 64, units = NT * (T / 64);
    for (int U0 = 0; U0 < units; U0 += 2 * G) {
        const int U = U0 + 2 * bid + half;
        const int m0 = (U / NT) * 64, n0 = (U % NT) * 64;
        float acc[4][4];
#pragma unroll
        for (int i = 0; i < 4; ++i)
#pragma unroll
            for (int j = 0; j < 4; ++j) acc[i][j] = 0.f;
        for (int k0 = 0; k0 < 1024; k0 += 16) {
#pragma unroll
            for (int i = 0; i < 4; ++i) { const int r = (tid >> 4) + 16 * i, c = tid & 15; As[c][r] = al(m0 + r, k0 + c); }
#pragma unroll
            for (int i = 0; i < 4; ++i) { const int r = (tid >> 6) + 4 * i, c = tid & 63; Bs[r][c] = B[(size_t)(k0 + r) * N + n0 + c]; }
            __syncthreads();
#pragma unroll
            for (int kk = 0; kk < 16; ++kk) {
                float a[4], b[4];
#pragma unroll
                for (int i = 0; i < 4; ++i) { a[i] = As[kk][ty * 4 + i]; b[i] = Bs[kk][tx * 4 + i]; }
#pragma unroll
                for (int i = 0; i < 4; ++i)
#pragma unroll
                    for (int j = 0; j < 4; ++j) acc[i][j] += a[i] * b[j];
            }
            __syncthreads();
        }
#pragma unroll
        for (int i = 0; i < 4; ++i)
#pragma unroll
            for (int j = 0; j < 4; ++j) Cs[ty * 4 + i][tx * 4 + j] = acc[i][j];
        __syncthreads();
        epi(Cs, m0, n0, tid);
        __syncthreads();
    }
}


namespace pg8 {
#define PG8_LAS __attribute__((address_space(3)))
typedef short bf16x8 __attribute__((ext_vector_type(8)));
typedef float f32x4 __attribute__((ext_vector_type(4)));
typedef unsigned u32x4 __attribute__((ext_vector_type(4)));
typedef unsigned u32x2 __attribute__((ext_vector_type(2)));
constexpr int BM = 256, BK = 64, HALF = 128, HTB = HALF * BK * 2, STAGE_BYTES = 8 * HTB, NXCD = 8, WGM = 8;
__host__ __device__ __forceinline__ int lds_byte(int r, int c) { const int st = (r >> 4) * 2 + (c >> 5), rr = r & 15, cc = c & 31, ob = rr * 64 + cc * 2; return st * 1024 + (ob ^ (((ob >> 9) & 1) << 5)); }
__host__ __device__ __forceinline__ void stage_rc(int b, int& R, int& C) { const int st = b / 1024, sb = b % 1024, swz = sb ^ (((sb >> 9) & 1) << 5); R = (st >> 1) * 16 + swz / 64; C = (st & 1) * 32 + (swz % 64) / 2; }
__host__ __device__ __forceinline__ int perm32(int rho) { const int n = rho >> 4, i = rho & 15; return 8 * (i >> 2) + 4 * n + (i & 3); }
struct Unit { int pm, pn; };
struct Gemm { const bf16_t* A; const bf16_t* Bt; int M, N, K; };
struct StaticOrder {
    int nM, nN, nwg, G, c;
    __host__ __device__ void init(int M, int N, int G_, int c_) { nM = M / BM; nN = N / BM; nwg = nM * nN; G = G_; c = c_; }
    __host__ __device__ bool next(int i, Unit& u) const {
        const long L = (long)i * G + c; if (L >= nwg) return false;
        int wgid = (int)L; { const int q = nwg / NXCD, r = nwg % NXCD, xcd = wgid % NXCD, off = wgid / NXCD; wgid = (xcd < r ? xcd * (q + 1) : r * (q + 1) + (xcd - r) * q) + off; }
        const int nig = WGM * nN, gid = wgid / nig, fm = gid * WGM, gsz = (nM - fm) < WGM ? (nM - fm) : WGM;
        u.pm = fm + ((wgid % nig) % gsz); u.pn = (wgid % nig) / gsz; return true;
    }
    __device__ __forceinline__ void a_ready(const Unit&) const {}
    __device__ __forceinline__ void done(const Unit&) const {}
};
__device__ __forceinline__ unsigned cvt_pk_bf16(float lo, float hi) { unsigned r; asm volatile("v_cvt_pk_bf16_f32 %0, %1, %2" : "=v"(r) : "v"(lo), "v"(hi)); return r; }

template <class Epi, class Sched>
__device__ __forceinline__ void gemm_phase(PG8_LAS unsigned char* lds, const Gemm g, const Sched& S, const Epi& E) {
    int tid_ = threadIdx.x; asm volatile("" : "+v"(tid_));
    const int tid = tid_, wid = __builtin_amdgcn_readfirstlane(tid >> 6), lane = tid & 63, wr = wid >> 2, wc = wid & 3, fr = lane & 15, fq = lane >> 4;
    const int K = g.K, nt = K / BK;
    unsigned voffA[2], voffB[2];
#pragma unroll
    for (int i = 0; i < 2; ++i) { int R, C; stage_rc(tid * 16 + i * 8192, R, C); const int Rb = Epi::PERM ? ((R & ~31) + perm32(R & 31)) : R;
        voffA[i] = (unsigned)(R * K + C) * 2u; voffB[i] = (unsigned)(Rb * K + C) * 2u; }
    const size_t kstep = (size_t)(BK * 2);
    const size_t hstep = (size_t)HALF * K * 2;
    const size_t tstep = 2 * hstep;
    const unsigned ldsw = (unsigned)wid * 1024u;
    const int aoff = lds_byte(wr * 64 + fr, fq * 8), boff = lds_byte(wc * 32 + fr, fq * 8);
#define PG8_SA(b, h) (((b) * 2 + (h)) * HTB)
#define PG8_SB(b, h) ((4 + (b) * 2 + (h)) * HTB)
#define PG8_STAGE(bufoff, gbase, voff) do { _Pragma("unroll") for (int _i = 0; _i < 2; ++_i) \
        __builtin_amdgcn_global_load_lds((const unsigned*)((const char*)(gbase) + (voff)[_i]), (PG8_LAS unsigned*)(lds + (bufoff) + ldsw + _i * 8192), 16, 0, 0); } while (0)
#define PG8_LDA(dst, b, h) do { _Pragma("unroll") for (int m = 0; m < 4; ++m) _Pragma("unroll") for (int k = 0; k < 2; ++k) dst[m][k] = *(const PG8_LAS bf16x8*)(lds + PG8_SA(b, h) + aoff + m * 2048 + k * 1024); } while (0)
#define PG8_LDB(dst, b, h) do { _Pragma("unroll") for (int n = 0; n < 2; ++n) _Pragma("unroll") for (int k = 0; k < 2; ++k) dst[n][k] = *(const PG8_LAS bf16x8*)(lds + PG8_SB(b, h) + boff + n * 2048 + k * 1024); } while (0)
#define PG8_MMA(ai, bj, At, Bt) do { __builtin_amdgcn_s_setprio(1); _Pragma("unroll") for (int m = 0; m < 4; ++m) _Pragma("unroll") for (int n = 0; n < 2; ++n) _Pragma("unroll") for (int k = 0; k < 2; ++k) \
        acc[ai][bj][m][n] = __builtin_amdgcn_mfma_f32_16x16x32_bf16(Bt[n][k], At[m][k], acc[ai][bj][m][n], 0, 0, 0); __builtin_amdgcn_s_setprio(0); } while (0)
#define PG8_WAIT_V(n) asm volatile("s_waitcnt vmcnt(" #n ")" ::: "memory")
#define PG8_WAIT_L(n) asm volatile("s_waitcnt lgkmcnt(" #n ")" ::: "memory")
#define PG8_BAR __builtin_amdgcn_s_barrier()
#define PG8_SCHED __builtin_amdgcn_sched_barrier(0)
    Unit cur, nxt; int ui = 0;
    if (!S.next(0, cur)) return;
    f32x4 acc[2][2][4][2];
#pragma unroll
    for (int a = 0; a < 2; ++a)
#pragma unroll
        for (int b = 0; b < 2; ++b)
#pragma unroll
            for (int m = 0; m < 4; ++m)
#pragma unroll
                for (int n = 0; n < 2; ++n) acc[a][b][m][n] = (f32x4){0.f, 0.f, 0.f, 0.f};
    bf16x8 At[4][2], B0[2][2], B1[2][2];
    const char* cA = (const char*)g.A + (size_t)cur.pm * tstep; const char* cB = (const char*)g.Bt + (size_t)cur.pn * tstep;
    S.a_ready(cur);
    PG8_STAGE(PG8_SB(0, 0), cB, voffB); PG8_STAGE(PG8_SA(0, 0), cA, voffA); PG8_STAGE(PG8_SB(0, 1), cB + hstep, voffB); PG8_STAGE(PG8_SA(0, 1), cA + hstep, voffA);
    if (wr == 1) PG8_BAR;
    PG8_WAIT_V(4); PG8_BAR;
    PG8_STAGE(PG8_SB(1, 0), cB + kstep, voffB); PG8_STAGE(PG8_SA(1, 0), cA + kstep, voffA); PG8_STAGE(PG8_SB(1, 1), cB + hstep + kstep, voffB);
    PG8_WAIT_V(6); PG8_BAR;
    for (;;) {
        const bool has_next = S.next(ui + 1, nxt);
        const char* nA = has_next ? (const char*)g.A + (size_t)nxt.pm * tstep : cA; const char* nB = has_next ? (const char*)g.Bt + (size_t)nxt.pn * tstep : cB;
        for (int t = 0; t < nt; t += 2) {
            const bool last = (t == nt - 2);
            const char* a1 = cA + (size_t)(t + 1) * kstep;
            const char* a2 = last ? nA : cA + (size_t)(t + 2) * kstep; const char* b2 = last ? nB : cB + (size_t)(t + 2) * kstep;
            const char* a3 = a2 + kstep; const char* b3 = b2 + kstep;
            if (last && has_next) S.a_ready(nxt);
            PG8_LDB(B0, 0, 0); PG8_SCHED; PG8_LDA(At, 0, 0); PG8_STAGE(PG8_SA(1, 1), a1 + hstep, voffA);
            PG8_WAIT_L(8); PG8_BAR; PG8_WAIT_L(0); PG8_MMA(0, 0, At, B0); PG8_BAR; PG8_SCHED;
            PG8_LDB(B1, 0, 1); PG8_STAGE(PG8_SB(0, 0), b2, voffB);
            PG8_BAR; PG8_WAIT_L(0); PG8_MMA(0, 1, At, B1); PG8_BAR;
            PG8_LDA(At, 0, 1); PG8_STAGE(PG8_SA(0, 0), a2, voffA);
            PG8_BAR; PG8_WAIT_L(0); PG8_MMA(1, 0, At, B0); PG8_BAR; PG8_SCHED;
            PG8_STAGE(PG8_SB(0, 1), b2 + hstep, voffB);
            PG8_WAIT_V(6); PG8_BAR; PG8_MMA(1, 1, At, B1); PG8_BAR;
            PG8_LDB(B0, 1, 0); PG8_SCHED; PG8_LDA(At, 1, 0); PG8_STAGE(PG8_SA(0, 1), a2 + hstep, voffA);
            PG8_WAIT_L(8); PG8_BAR; PG8_WAIT_L(0); PG8_MMA(0, 0, At, B0); PG8_BAR; PG8_SCHED;
            PG8_LDB(B1, 1, 1); PG8_STAGE(PG8_SB(1, 0), b3, voffB);
            PG8_BAR; PG8_WAIT_L(0); PG8_MMA(0, 1, At, B1); PG8_BAR;
            PG8_LDA(At, 1, 1); PG8_STAGE(PG8_SA(1, 0), a3, voffA);
            PG8_BAR; PG8_WAIT_L(0); PG8_MMA(1, 0, At, B0); PG8_BAR; PG8_SCHED;
            PG8_STAGE(PG8_SB(1, 1), b3 + hstep, voffB);
            PG8_WAIT_V(6); PG8_BAR; PG8_MMA(1, 1, At, B1); PG8_BAR;
        }
        if constexpr (!Epi::AFTER_DRAIN) { E(acc, cur, wr, wc, fr, fq); S.done(cur); }
        if (!has_next) break;
#pragma unroll
        for (int a = 0; a < 2; ++a)
#pragma unroll
            for (int b = 0; b < 2; ++b)
#pragma unroll
                for (int m = 0; m < 4; ++m)
#pragma unroll
                    for (int n = 0; n < 2; ++n) acc[a][b][m][n] = (f32x4){0.f, 0.f, 0.f, 0.f};
        cur = nxt; cA = nA; cB = nB; ++ui;
    }
    PG8_WAIT_V(0);
    if (wr == 0) PG8_BAR;
    PG8_BAR;
    if constexpr (Epi::AFTER_DRAIN) { E.fused(acc, cur, wr, wc, fr, fq, lds, wid, lane); S.done(cur); }
#undef PG8_SA
#undef PG8_SB
#undef PG8_STAGE
#undef PG8_LDA
#undef PG8_LDB
#undef PG8_MMA
#undef PG8_WAIT_V
#undef PG8_WAIT_L
#undef PG8_BAR
#undef PG8_SCHED
}
}

__host__ __device__ __forceinline__ int cmap_in(int F) { return (F & ~255) + 128 * ((F >> 5) & 1) + 32 * ((F >> 6) & 3) + (F & 31); }
struct EpiInprojMF {
    static constexpr bool PERM = true, AFTER_DRAIN = false;
    bf16_t* P; const float* rinv; const float* bias_f; const int* pos; const float* ftab; const float* qg; const float* kg;
    __device__ __forceinline__ void operator()(const pg8::f32x4 (&acc)[2][2][4][2], const pg8::Unit& u, int wr, int wc, int fr, int fq) const {
        typedef pg8::f32x4 f32x4;
        asm volatile("" : "+v"(fr), "+v"(fq));
        const int type = u.pn >> 1, head = 4 * (u.pn & 1) + wc, fb = 256 * u.pn + 64 * wc;
        const size_t PSZ = (size_t)T * 512;
        const int rslot = (type == 0) ? 0 : (type == 1) ? 1 : (type == 2) ? 6 : (type == 3) ? 2 : (type == 4) ? 3 : (type == 5) ? 4 : 7;
        bf16_t* rowmaj = P + (size_t)rslot * PSZ;
        const int t0 = u.pm * 256 + wr * 64 + fr;
        float rv[8], pf[8];
        f32x4 bv[2][2], gv[2][2], fh[2], fl[2];
#pragma unroll
        for (int ai = 0; ai < 2; ++ai)
#pragma unroll
            for (int m = 0; m < 4; ++m) { const int t = t0 + ai * 128 + m * 16; rv[ai * 4 + m] = rinv[t]; pf[ai * 4 + m] = (float)pos[t]; }
        const float* gsrc = (type == 4) ? qg : kg;
#pragma unroll
        for (int bj = 0; bj < 2; ++bj)
#pragma unroll
            for (int n = 0; n < 2; ++n) { bv[bj][n] = *(const f32x4*)(bias_f + fb + 32 * bj + 8 * fq + 4 * n); gv[bj][n] = *(const f32x4*)(gsrc + 32 * bj + 8 * fq + 4 * n); }
#pragma unroll
        for (int n = 0; n < 2; ++n) { fh[n] = *(const f32x4*)(ftab + 8 * fq + 4 * n); fl[n] = *(const f32x4*)(ftab + 32 + 8 * fq + 4 * n); }
#pragma unroll
        for (int ai = 0; ai < 2; ++ai)
#pragma unroll
            for (int m = 0; m < 4; ++m) {
                const int t = t0 + ai * 128 + m * 16;
                const float r = rv[ai * 4 + m];
                f32x4 v[2][2];
#pragma unroll
                for (int bj = 0; bj < 2; ++bj)
#pragma unroll
                    for (int n = 0; n < 2; ++n) v[bj][n] = acc[ai][bj][m][n] * r + bv[bj][n];
                if (type <= 1) {
                    const float sc = (type == 1) ? 0.125f : 1.f, pp = pf[ai * 4 + m];
#pragma unroll
                    for (int n = 0; n < 2; ++n)
#pragma unroll
                        for (int j = 0; j < 4; ++j) {
                            const float rev = __builtin_amdgcn_fractf(__builtin_amdgcn_fractf(pp * fh[n][j]) + pp * fl[n][j]);
                            const float cs = __builtin_amdgcn_cosf(rev) * sc, sn = __builtin_amdgcn_sinf(rev) * sc;
                            const float x1 = v[0][n][j], x2 = v[1][n][j]; v[0][n][j] = x1 * cs - x2 * sn; v[1][n][j] = x2 * cs + x1 * sn;
                        }
                } else if (type == 3) {
#pragma unroll
                    for (int bj = 0; bj < 2; ++bj)
#pragma unroll
                        for (int n = 0; n < 2; ++n)
#pragma unroll
                            for (int j = 0; j < 4; ++j) { const float x = v[bj][n][j]; v[bj][n][j] = x / (1.f + __expf(-x)); }
                } else if (type == 4 || type == 5) {
                    float ss = 0.f;
#pragma unroll
                    for (int bj = 0; bj < 2; ++bj)
#pragma unroll
                        for (int n = 0; n < 2; ++n)
#pragma unroll
                            for (int j = 0; j < 4; ++j) ss += v[bj][n][j] * v[bj][n][j];
                    ss += __shfl_xor(ss, 16); ss += __shfl_xor(ss, 32);
                    const float rn = (1.0f / sqrtf(ss * (1.f / 64.f) + EPS)) * ((type == 4) ? 0.125f * 1.44269504089f : 1.f);
#pragma unroll
                    for (int bj = 0; bj < 2; ++bj)
#pragma unroll
                        for (int n = 0; n < 2; ++n) v[bj][n] = v[bj][n] * rn * gv[bj][n];
                }
#pragma unroll
                for (int bj = 0; bj < 2; ++bj) {
                    pg8::u32x4 w; w.x = pg8::cvt_pk_bf16(v[bj][0][0], v[bj][0][1]); w.y = pg8::cvt_pk_bf16(v[bj][0][2], v[bj][0][3]);
                    w.z = pg8::cvt_pk_bf16(v[bj][1][0], v[bj][1][1]); w.w = pg8::cvt_pk_bf16(v[bj][1][2], v[bj][1][3]);
                    *(pg8::u32x4*)(rowmaj + (size_t)t * 512 + head * 64 + 32 * bj + 8 * fq) = w;
                }
            }
    }
};

struct EpiOutprojMF {
    static constexpr bool PERM = false, AFTER_DRAIN = false;
    const float* x; const float* gate1; float* x1; bf16_t* x1b; float* part2;
    __device__ __forceinline__ void operator()(const pg8::f32x4 (&acc)[2][2][4][2], const pg8::Unit& u, int wr, int wc, int fr, int fq) const {
        typedef pg8::f32x4 f32x4;
        asm volatile("" : "+v"(fr), "+v"(fq));
        const int col0 = u.pn * 256 + wc * 32 + 4 * fq, row0 = u.pm * 256 + wr * 64 + fr;
        f32x4 gv[2][2], xv[2][2][2];
#pragma unroll
        for (int bj = 0; bj < 2; ++bj)
#pragma unroll
            for (int n = 0; n < 2; ++n) { gv[bj][n] = *(const f32x4*)(gate1 + col0 + bj * 128 + n * 16); xv[0][bj][n] = *(const f32x4*)(x + (size_t)row0 * D + col0 + bj * 128 + n * 16); }
#pragma unroll
        for (int idx = 0; idx < 8; ++idx) {
            const int ai = idx >> 2, m = idx & 3, row = row0 + ai * 128 + m * 16; const size_t off = (size_t)row * D + col0;
            if (idx < 7) { const int ai2 = (idx + 1) >> 2, m2 = (idx + 1) & 3; const size_t off2 = (size_t)(row0 + ai2 * 128 + m2 * 16) * D + col0;
#pragma unroll
                for (int bj = 0; bj < 2; ++bj)
#pragma unroll
                    for (int n = 0; n < 2; ++n) xv[(idx + 1) & 1][bj][n] = *(const f32x4*)(x + off2 + bj * 128 + n * 16); }
            float ss = 0.f;
#pragma unroll
            for (int bj = 0; bj < 2; ++bj)
#pragma unroll
                for (int n = 0; n < 2; ++n) {
                    const f32x4 o = xv[idx & 1][bj][n] + gv[bj][n] * acc[ai][bj][m][n];
                    *(f32x4*)(x1 + off + bj * 128 + n * 16) = o;
                    pg8::u32x2 w; w.x = pg8::cvt_pk_bf16(o[0], o[1]); w.y = pg8::cvt_pk_bf16(o[2], o[3]);
                    *(pg8::u32x2*)(x1b + off + bj * 128 + n * 16) = w;
                    ss += o[0] * o[0] + o[1] * o[1] + o[2] * o[2] + o[3] * o[3];
                }
            ss += __shfl_xor(ss, 16); ss += __shfl_xor(ss, 32);
            if (fq == 0) part2[(size_t)row * 16 + u.pn * 4 + wc] = ss;
        }
    }
};
struct EpiScoresMF {
    static constexpr bool PERM = false, AFTER_DRAIN = false;
    const float* part2; const float* bias_q; float* scores;
    __device__ __forceinline__ void operator()(const pg8::f32x4 (&acc)[2][2][4][2], const pg8::Unit& u, int wr, int wc, int fr, int fq) const {
        typedef pg8::f32x4 f32x4;
        asm volatile("" : "+v"(fr), "+v"(fq));
        const int col0 = u.pn * 256 + wc * 32 + 4 * fq;
        f32x4 bv[2][2];
#pragma unroll
        for (int bj = 0; bj < 2; ++bj)
#pragma unroll
            for (int n = 0; n < 2; ++n) bv[bj][n] = *(const f32x4*)(bias_q + col0 + bj * 128 + n * 16);
#pragma unroll
        for (int ai = 0; ai < 2; ++ai)
#pragma unroll
            for (int m = 0; m < 4; ++m) {
                const int row = u.pm * 256 + ai * 128 + wr * 64 + m * 16 + fr;
                const f32x4* pp = (const f32x4*)(part2 + (size_t)row * 16);
                const f32x4 p0 = pp[0], p1 = pp[1], p2 = pp[2], p3 = pp[3];
                const float ssum = ((p0[0] + p0[1]) + (p0[2] + p0[3])) + ((p1[0] + p1[1]) + (p1[2] + p1[3])) + ((p2[0] + p2[1]) + (p2[2] + p2[3])) + ((p3[0] + p3[1]) + (p3[2] + p3[3]));
                const float r = 1.0f / sqrtf(ssum * (1.0f / D) + EPS);
                float* rowp = scores + (size_t)row * 2048 + col0;
#pragma unroll
                for (int bj = 0; bj < 2; ++bj)
#pragma unroll
                    for (int n = 0; n < 2; ++n) *(f32x4*)(rowp + bj * 128 + n * 16) = acc[ai][bj][m][n] * r + bv[bj][n];
            }
    }
};

__device__ __forceinline__ unsigned pk2(float lo, float hi) { return (unsigned)f2bf(lo) | ((unsigned)f2bf(hi) << 16); }
template <bool FOLD, bool CMAP>
__device__ __forceinline__ void transpose_item(const float* W, int K, int N, bf16_t* WT, float* scr, int item, int lane, const float* sg, const float* sm) {
    const int nblk = N / 32, kb = item / nblk, nb = item % nblk, k0 = 64 * kb, n0 = 32 * nb;
#pragma unroll 8
    for (int i = 0; i < 32; ++i) { const int kk = 2 * i + (lane >> 5); float w = W[(size_t)(k0 + kk) * N + n0 + (lane & 31)];
        if (FOLD) w *= sg[k0 + kk] * (1.f + sm[k0 + kk]);
        scr[kk * 33 + (lane & 31)] = w; }
    asm volatile("s_waitcnt lgkmcnt(0)" ::: "memory");
    const int c = lane & 7, r0 = CMAP ? cmap_in(n0) : n0;
#pragma unroll
    for (int j = 0; j < 4; ++j) { const int n = (lane >> 3) + 8 * j; const float* s = scr + (8 * c) * 33 + n;
        pg8::u32x4 o; o.x = pk2(s[0 * 33], s[1 * 33]); o.y = pk2(s[2 * 33], s[3 * 33]); o.z = pk2(s[4 * 33], s[5 * 33]); o.w = pk2(s[6 * 33], s[7 * 33]);
        *(pg8::u32x4*)(WT + (size_t)(r0 + n) * K + k0 + 8 * c) = o; }
    asm volatile("s_waitcnt lgkmcnt(0)" ::: "memory");
}
template <int NC4, class VF>
__device__ __forceinline__ void gemv_cols(unsigned char* lds, const VF vf, const float* W, const int N, const int u, float* dst, const float* add) {
    constexpr int RG = 512 / NC4;
    float (*red)[NC4 * 4] = (float (*)[NC4 * 4])lds;
    const int tid = threadIdx.x, c4 = tid % NC4, rg = tid / NC4;
    if (rg < RG) {
        float4 acc = {0.f, 0.f, 0.f, 0.f};
        for (int r = rg; r < 1024; r += RG) { const float s = vf(r); const float4 w = *(const float4*)(W + (size_t)r * N + u * NC4 * 4 + c4 * 4);
            acc.x += s * w.x; acc.y += s * w.y; acc.z += s * w.z; acc.w += s * w.w; }
        red[rg][c4 * 4 + 0] = acc.x; red[rg][c4 * 4 + 1] = acc.y; red[rg][c4 * 4 + 2] = acc.z; red[rg][c4 * 4 + 3] = acc.w;
    }
    __syncthreads();
    if (tid < NC4 * 4) { float s = 0.f; for (int i = 0; i < RG; ++i) s += red[i][tid]; dst[u * NC4 * 4 + tid] = s + (add ? add[u * NC4 * 4 + tid] : 0.f); }
    __syncthreads();
}
struct VfSilu { const float* c; __device__ __forceinline__ float operator()(int r) const { const float v = c[r]; return v / (1.f + expf(-v)); } };
struct VfVec { const float* v; __device__ __forceinline__ float operator()(int r) const { return v[r]; } };


typedef float f32x16 __attribute__((ext_vector_type(16)));
typedef pg8::bf16x8 bf16x8;
#define MFMA32(a, b, c) __builtin_amdgcn_mfma_f32_32x32x16_bf16((a), (b), (c), 0, 0, 0)
__device__ __forceinline__ bf16x8 pack_frag(const f32x16& v, int s) {
    pg8::u32x4 w;
    w.x = pg8::cvt_pk_bf16(v[8 * s + 0], v[8 * s + 1]); w.y = pg8::cvt_pk_bf16(v[8 * s + 2], v[8 * s + 3]);
    w.z = pg8::cvt_pk_bf16(v[8 * s + 4], v[8 * s + 5]); w.w = pg8::cvt_pk_bf16(v[8 * s + 6], v[8 * s + 7]);
    return __builtin_bit_cast(bf16x8, w);
}
__device__ __forceinline__ bf16x8 load_tfrag(const bf16_t* rowp, int tok) {
    const uint2 a = *(const uint2*)(rowp + tok), b = *(const uint2*)(rowp + tok + 8);
    pg8::u32x4 w; w.x = a.x; w.y = a.y; w.z = b.x; w.w = b.y;
    return __builtin_bit_cast(bf16x8, w);
}


__device__ __forceinline__ bf16x8 tr_frag(const unsigned char* a0, int rows2) {
    typedef short s16x4 __attribute__((ext_vector_type(4)));
    typedef __attribute__((address_space(3))) s16x4 lds_s16x4;
    const s16x4 lo = __builtin_amdgcn_ds_read_tr16_b64_v4i16((lds_s16x4*)a0);
    const s16x4 hi = __builtin_amdgcn_ds_read_tr16_b64_v4i16((lds_s16x4*)(a0 + rows2 * 144));
    const uint2 l2 = __builtin_bit_cast(uint2, lo), h2 = __builtin_bit_cast(uint2, hi);
    pg8::u32x4 fw; fw.x = l2.x; fw.y = l2.y; fw.z = h2.x; fw.w = h2.y;
    return __builtin_bit_cast(bf16x8, fw);
}

__device__ __forceinline__ void ins16(float (&s)[16], float x) {
#pragma unroll
    for (int i = 15; i >= 1; --i) s[i] = __builtin_amdgcn_fmed3f(s[i - 1], s[i], x);
    s[0] = fmaxf(s[0], x);
}


__device__ __forceinline__ void peer_route(const float (&s0)[16], const float (&s1)[16], unsigned short* idp, float* gp) {
    float tl[16];
#pragma unroll
    for (int i = 0; i < 16; ++i) tl[i] = -INFINITY;
#pragma unroll
    for (int a = 0; a < 16; ++a)
#pragma unroll
        for (int b = 0; b < 16; ++b)
            if ((a + 1) * (b + 1) <= 16) {
                const float v = __uint_as_float(__float_as_uint(s0[a]) & 0xFFFFFF80u) + __uint_as_float(__float_as_uint(s1[b]) & 0xFFFFFF80u);
                ins16(tl, __uint_as_float((__float_as_uint(v) & 0xFFFFFF00u) | (unsigned)(a * 16 + b)));
            }
    float ev[16]; float sum = 0.f;
    const float mx = __uint_as_float(__float_as_uint(tl[0]) & 0xFFFFFF00u);
#pragma unroll
    for (int j = 0; j < 16; ++j) { ev[j] = __expf(__uint_as_float(__float_as_uint(tl[j]) & 0xFFFFFF00u) - mx); sum += ev[j]; }
    const float inv = 1.f / sum;
    unsigned idw[8];
#pragma unroll
    for (int j = 0; j < 16; ++j) {
        const unsigned code = __float_as_uint(tl[j]) & 0xFFu; const int a = (int)(code >> 4), b = (int)(code & 15u);
        unsigned i0 = 0, i1 = 0;
#pragma unroll
        for (int k = 0; k < 16; ++k) { i0 = (a == k) ? (__float_as_uint(s0[k]) & 0x7Fu) : i0; i1 = (b == k) ? (__float_as_uint(s1[k]) & 0x7Fu) : i1; }
        const unsigned id = i0 * 128u + i1;
        if (j & 1) idw[j >> 1] |= id << 16; else idw[j >> 1] = id;
        ev[j] *= inv;
    }
    *(uint4*)idp = make_uint4(idw[0], idw[1], idw[2], idw[3]); *(uint4*)(idp + 8) = make_uint4(idw[4], idw[5], idw[6], idw[7]);
#pragma unroll
    for (int q = 0; q < 4; ++q) *(float4*)(gp + 4 * q) = make_float4(ev[4 * q], ev[4 * q + 1], ev[4 * q + 2], ev[4 * q + 3]);
}

struct OneUnitOrder {
    pg8::StaticOrder base; int round;
    __device__ __forceinline__ bool next(int i, pg8::Unit& u) const { if (i != 0) return false; return base.next(round, u); }
    __device__ __forceinline__ void a_ready(const pg8::Unit&) const {}
    __device__ __forceinline__ void done(const pg8::Unit&) const {}
};
struct EpiTopkMF {
    static constexpr bool PERM = false, AFTER_DRAIN = true;
    const float* part2; const float* bias_q; unsigned short* ids; float* gates;
    __device__ __forceinline__ void operator()(const pg8::f32x4 (&)[2][2][4][2], const pg8::Unit&, int, int, int, int) const {}
    __device__ __forceinline__ void fused(pg8::f32x4 (&acc)[2][2][4][2], const pg8::Unit& u, int wr, int wc, int fr, int fq, PG8_LAS unsigned char* lds, int wid, int lane) const {
        typedef pg8::f32x4 f32x4;
        constexpr int SLD = 260;
        PG8_LAS float* SC = (PG8_LAS float*)lds; PG8_LAS float* MG = (PG8_LAS float*)(lds + 128 * SLD * 4);
        const int tid = wid * 64 + lane, tok = tid & 255, hk = tid >> 8;
        float rinv[2][4];
#pragma unroll
        for (int ai = 0; ai < 2; ++ai)
#pragma unroll
            for (int m = 0; m < 4; ++m) {
                const int row = u.pm * 256 + ai * 128 + wr * 64 + m * 16 + fr;
                const f32x4* pp = (const f32x4*)(part2 + (size_t)row * 16);
                const f32x4 p0 = pp[0], p1 = pp[1], p2 = pp[2], p3 = pp[3];
                const float ssum = ((p0[0] + p0[1]) + (p0[2] + p0[3])) + ((p1[0] + p1[1]) + (p1[2] + p1[3])) + ((p2[0] + p2[1]) + (p2[2] + p2[3])) + ((p3[0] + p3[1]) + (p3[2] + p3[3]));
                rinv[ai][m] = 1.0f / sqrtf(ssum * (1.0f / D) + EPS);
            }
        float sl[16], mine[16];
#pragma unroll
        for (int p = 0; p < 2; ++p) {
            f32x4 bv[2];
#pragma unroll
            for (int n = 0; n < 2; ++n) bv[n] = *(const f32x4*)(bias_q + u.pn * 256 + p * 128 + wc * 32 + n * 16 + 4 * fq);
#pragma unroll
            for (int ai = 0; ai < 2; ++ai)
#pragma unroll
                for (int m = 0; m < 4; ++m)
#pragma unroll
                    for (int n = 0; n < 2; ++n)
#pragma unroll
                        for (int j = 0; j < 4; ++j)
                            SC[(32 * wc + 16 * n + 4 * fq + j) * SLD + (128 * ai + 64 * wr + 16 * m + fr)] = acc[ai][p][m][n][j] * rinv[ai][m] + bv[n][j];
            __syncthreads();
#pragma unroll
            for (int i = 0; i < 16; ++i) sl[i] = -INFINITY;
#pragma unroll 8
            for (int k = 0; k < 64; ++k) { const int key = 64 * hk + k; const float x = SC[key * SLD + tok]; ins16(sl, __uint_as_float((__float_as_uint(x) & 0xFFFFFF80u) | (unsigned)key)); }
            if (hk != p) {
#pragma unroll
                for (int i = 0; i < 16; ++i) MG[i * 256 + tok] = sl[i];
            }
            __syncthreads();
            if (hk == p) {
#pragma unroll
                for (int i = 0; i < 16; ++i) ins16(sl, MG[i * 256 + tok]);
#pragma unroll
                for (int i = 0; i < 16; ++i) mine[i] = sl[i];
            }
            __syncthreads();
        }
        PG8_LAS float* X1 = SC; PG8_LAS float* TL = SC + 4096; PG8_LAS unsigned* I0 = (PG8_LAS unsigned*)(SC + 8192); PG8_LAS unsigned* I1 = (PG8_LAS unsigned*)(SC + 12288);
        if (hk) {
#pragma unroll
            for (int i = 0; i < 16; ++i) { X1[i * 256 + tok] = mine[i]; I1[i * 256 + tok] = __float_as_uint(mine[i]) & 0x7Fu; }
        } else {
#pragma unroll
            for (int i = 0; i < 16; ++i) I0[i * 256 + tok] = __float_as_uint(mine[i]) & 0x7Fu;
        }
        __syncthreads();
        if (!hk) {
            float s1m[16], tl[16];
#pragma unroll
            for (int i = 0; i < 16; ++i) { s1m[i] = __uint_as_float(__float_as_uint(X1[i * 256 + tok]) & 0xFFFFFF80u); mine[i] = __uint_as_float(__float_as_uint(mine[i]) & 0xFFFFFF80u); tl[i] = -INFINITY; }
#pragma unroll
            for (int a2 = 0; a2 < 16; ++a2)
#pragma unroll
                for (int b2 = 0; b2 < 16; ++b2)
                    if ((a2 + 1) * (b2 + 1) <= 16) ins16(tl, __uint_as_float((__float_as_uint(mine[a2] + s1m[b2]) & 0xFFFFFF00u) | (unsigned)(a2 * 16 + b2)));
#pragma unroll
            for (int i = 0; i < 16; ++i) TL[i * 256 + tok] = tl[i];
        }
        __syncthreads();
        if (hk) {
            float ev[16]; float sum = 0.f; unsigned cd[16];
#pragma unroll
            for (int j = 0; j < 16; ++j) { const unsigned bits = __float_as_uint(TL[j * 256 + tok]); cd[j] = bits & 0xFFu; ev[j] = __uint_as_float(bits & 0xFFFFFF00u); }
            const float mx = ev[0];
#pragma unroll
            for (int j = 0; j < 16; ++j) { ev[j] = __expf(ev[j] - mx); sum += ev[j]; }
            const float inv = 1.f / sum;
            unsigned idw[8];
#pragma unroll
            for (int j = 0; j < 16; ++j) {
                const unsigned id = I0[(cd[j] >> 4) * 256 + tok] * 128u + I1[(cd[j] & 15u) * 256 + tok];
                if (j & 1) idw[j >> 1] |= id << 16; else idw[j >> 1] = id;
                ev[j] *= inv;
            }
            const size_t t = (size_t)u.pm * 256 + tok;
            unsigned short* idp = ids + t * 128 + u.pn * 16; float* gp = gates + t * 128 + u.pn * 16;
            *(uint4*)idp = make_uint4(idw[0], idw[1], idw[2], idw[3]); *(uint4*)(idp + 8) = make_uint4(idw[4], idw[5], idw[6], idw[7]);
#pragma unroll
            for (int q = 0; q < 4; ++q) *(float4*)(gp + 4 * q) = make_float4(ev[4 * q], ev[4 * q + 1], ev[4 * q + 2], ev[4 * q + 3]);
        }
        __syncthreads();
    }
};


__device__ __forceinline__ void convert_tables(const float* down, const float* up, unsigned char* q8, unsigned char* qexp, int lane, int cw, int nconv, int r0, int r1) {
    for (int row0 = r0 + cw * 2; row0 < r1; row0 += nconv * 2) {
        float4 v[2][4]; float mx[2] = {0.f, 0.f};
#pragma unroll
        for (int rr = 0; rr < 2; ++rr) {
            const int row = row0 + rr, isup = row >> 14, e = row & 16383;
            const float* sp = (isup ? up : down) + (size_t)e * 1024 + lane * 4;
#pragma unroll
            for (int q = 0; q < 4; ++q) v[rr][q] = ld_nt4(sp + 256 * q);
        }
#pragma unroll
        for (int rr = 0; rr < 2; ++rr) {
#pragma unroll
            for (int q = 0; q < 4; ++q) mx[rr] = fmaxf(mx[rr], fmaxf(fmaxf(fabsf(v[rr][q].x), fabsf(v[rr][q].y)), fmaxf(fabsf(v[rr][q].z), fabsf(v[rr][q].w))));
#pragma unroll
            for (int o = 32; o > 0; o >>= 1) mx[rr] = fmaxf(mx[rr], __shfl_xor(mx[rr], o));
            const int row = row0 + rr, isup = row >> 14, e = row & 16383;
            const float s = (mx[rr] > 0.f) ? exp2f(floorf(log2f(256.f / mx[rr]))) : 1.f;
#pragma unroll
            for (int q = 0; q < 4; ++q) {
                int pk = __builtin_amdgcn_cvt_pk_fp8_f32(v[rr][q].x * s, v[rr][q].y * s, 0, false); pk = __builtin_amdgcn_cvt_pk_fp8_f32(v[rr][q].z * s, v[rr][q].w * s, pk, true);
                *(unsigned*)(q8 + (size_t)isup * (16u << 20) + ((size_t)(2 * q + (lane >> 5)) * 16384 + e) * 128 + (lane & 7) * 16 + ((lane & 31) >> 3) * 4) = (unsigned)pk;
            }
            if (lane == 0) qexp[row] = (unsigned char)((__float_as_uint(1.0f / s) >> 23) & 0xffu);
        }
    }
}

struct Params {
    const float *x, *c; const int* pos; const float *ada_w, *ada_b, *g1, *g2, *w_in, *rgain, *qg, *kg, *og, *w_out, *wq, *sk, *down, *up;
    float* out; unsigned char* ws; RopeC rc;
};

__global__ void __launch_bounds__(512) mk_fwd(Params p) {
    extern __shared__ __attribute__((aligned(16))) unsigned char lds[];
    const int tid = threadIdx.x, lane = tid & 63, wave = tid >> 6, bid = blockIdx.x, G = gridDim.x;
    unsigned char* ws = p.ws;
    float* mod = (float*)(ws + OFF_MOD); float* rinv1 = (float*)(ws + OFF_RINV1); float* ftab = (float*)(ws + OFF_ROPE);
    bf16_t* P = (bf16_t*)(ws + OFF_P); float* kv = (float*)(ws + OFF_KV); bf16_t* stT = (bf16_t*)(ws + OFF_ST); bf16_t* ycat = (bf16_t*)(ws + OFF_YCAT);
    bf16_t* xb = (bf16_t*)(ws + OFF_XB); bf16_t* Win_t = (bf16_t*)(ws + OFF_WINT); float* bias_f = (float*)(ws + OFF_BIASF);
    bf16_t* Weff_t = (bf16_t*)(ws + OFF_WEFFT); bf16_t* Wout_t = (bf16_t*)(ws + OFF_WOUTT); float* bias_q = (float*)(ws + OFF_BIASQ); float* bq_part = (float*)(ws + OFF_BQPART);
    float* part2 = (float*)(ws + OFF_PART2); bf16_t* x1b = (bf16_t*)(ws + OFF_X1B); unsigned short* ids = (unsigned short*)(ws + OFF_IDS); unsigned char* q8 = ws + OFF_Q8; unsigned char* qexp = ws + OFF_QSC; float* gates = (float*)(ws + OFF_GATES);
    const size_t PS = (size_t)T * 512;
    const bf16_t *Qr = P, *Kr = P + PS, *Gr = P + 2 * PS, *Qs = P + 3 * PS, *Ks = P + 4 * PS, *Vr = P + 6 * PS, *Vs = P + 7 * PS;
    float* out = p.out; float* x1 = (float*)(ws + OFF_X1);

    if (tid < 4) ((LAS unsigned*)((LAS unsigned char*)lds + LDS_ST_OFF))[tid] = 0u;
    __syncthreads();
    XcdBarrier bar = xcd_barrier_post((unsigned*)(ws + OFF_CTL), (volatile LAS unsigned*)((LAS unsigned char*)lds + LDS_ST_OFF));

    for (int u = bid; u < 256; u += G) gemv_cols<6>(lds, VfSilu{p.c}, p.ada_w, 6144, u, mod, p.ada_b);
    for (int row0 = (bid * 8 + wave) * 2; row0 < T; row0 += G * 16) {
        float4 v[2][4];
#pragma unroll
        for (int rr = 0; rr < 2; ++rr)
#pragma unroll
            for (int j = 0; j < 4; ++j) v[rr][j] = ld_nt4(p.x + (size_t)(row0 + rr) * D + (lane + 64 * j) * 4);
#pragma unroll
        for (int rr = 0; rr < 2; ++rr) {
            uint2* xo = (uint2*)(xb + (size_t)(row0 + rr) * D);
            float s = 0.f;
#pragma unroll
            for (int j = 0; j < 4; ++j) { const float4 q = v[rr][j]; s += q.x * q.x + q.y * q.y + q.z * q.z + q.w * q.w; xo[lane + 64 * j] = make_uint2(pk2(q.x, q.y), pk2(q.z, q.w)); }
#pragma unroll
            for (int o = 32; o > 0; o >>= 1) s += __shfl_xor(s, o);
            if (lane == 0) rinv1[row0 + rr] = 1.0f / sqrtf(s * (1.0f / D) + EPS);
        }
    }
    if (bid == 0 && tid == 0) {
#pragma unroll
        for (int i = 0; i < 32; ++i) { ftab[i] = p.rc.fh[i]; ftab[32 + i] = p.rc.fl[i]; }
    }
    xcd_barrier(bar);

    {
        float* scr = (float*)(lds + wave * 16384);
        for (int it = bid * 8 + wave; it < 16 * 112; it += G * 8) transpose_item<true, true>(p.w_in, 1024, 3584, Win_t, scr, it, lane, p.g1, mod + 1024);
        __syncthreads();
        for (int u = bid; u < 128; u += G) gemv_cols<7>(lds, VfVec{mod}, p.w_in, 3584, u, bias_f, nullptr);
    }
    xcd_barrier(bar);

    {
        pg8::Gemm g{xb, Win_t, T, 3584, 1024}; pg8::StaticOrder S; S.init(T, 3584, G, bid);
        EpiInprojMF E{P, rinv1, bias_f, p.pos, ftab, p.qg, p.kg};
        pg8::gemm_phase<EpiInprojMF, pg8::StaticOrder>((PG8_LAS unsigned char*)lds, g, S, E);
        const int nidle = (G > 128) ? G - 128 : G, ib = (G > 128) ? bid - 128 : bid;
        {
            float* scr = (float*)(lds + wave * 16384);
            if (ib >= 0) for (int it = ib * 8 + wave; it < 16 * 32; it += nidle * 8) transpose_item<false, false>(p.w_out, 1024, 1024, Wout_t, scr, it, lane, nullptr, nullptr);
            __syncthreads();
        }
        if (ib >= 0 && ib < 128) {
            const int hp = ib >> 3, blk = ib & 7;
            float* skT = (float*)lds; float* wqs = (float*)(lds + 65536);
            for (int e = tid; e < 16384; e += 512) { const int k = e >> 7, c = e & 127; skT[c * 128 + k] = p.sk[((size_t)hp * 128 + k) * 128 + c]; }
            float bacc[16];
#pragma unroll
            for (int j = 0; j < 16; ++j) bacc[j] = 0.f;
            for (int rbk = 0; rbk < 2; ++rbk) {
                const int i0 = (blk * 2 + rbk) * 64;
                __syncthreads();
                for (int e = tid; e < 8192; e += 512) { const int r = e >> 7, c = e & 127; wqs[r * 129 + c] = p.wq[(size_t)(i0 + r) * 2048 + hp * 128 + c]; }
                __syncthreads();
                float acc[16];
#pragma unroll
                for (int j = 0; j < 16; ++j) acc[j] = 0.f;
                const float* wrow = wqs + lane * 129; const float* skc = skT + 16 * wave;
#pragma unroll 4
                for (int c = 0; c < 128; ++c) {
                    const float av = wrow[c];
                    const float4 b0 = *(const float4*)(skc + c * 128), b1 = *(const float4*)(skc + c * 128 + 4), b2 = *(const float4*)(skc + c * 128 + 8), b3 = *(const float4*)(skc + c * 128 + 12);
                    acc[0] += av * b0.x; acc[1] += av * b0.y; acc[2] += av * b0.z; acc[3] += av * b0.w; acc[4] += av * b1.x; acc[5] += av * b1.y; acc[6] += av * b1.z; acc[7] += av * b1.w;
                    acc[8] += av * b2.x; acc[9] += av * b2.y; acc[10] += av * b2.z; acc[11] += av * b2.w; acc[12] += av * b3.x; acc[13] += av * b3.y; acc[14] += av * b3.z; acc[15] += av * b3.w;
                }
                const int i = i0 + lane;
                const float s2v = p.g2[i] * (1.f + mod[4096 + i]), sh = mod[3072 + i];
#pragma unroll
                for (int j = 0; j < 16; ++j) { Weff_t[(size_t)(hp * 128 + 16 * wave + j) * 1024 + i] = f2bf(acc[j] * s2v); bacc[j] += sh * acc[j]; }
            }
#pragma unroll
            for (int j = 0; j < 16; ++j) { float v = bacc[j];
#pragma unroll
                for (int o = 32; o > 0; o >>= 1) v += __shfl_xor(v, o);
                if (lane == 0) bq_part[(size_t)blk * 2048 + hp * 128 + 16 * wave + j] = v; }
            __syncthreads();
        }
        if (ib >= 0) convert_tables(p.down, p.up, q8, qexp, lane, ib * 8 + wave, nidle * 8, 0, CONV_SPLIT);
    }
    xcd_barrier(bar);

    {
        const int gw = __builtin_amdgcn_readfirstlane(bid * 8 + wave), NGW = G * 8, l31 = lane & 31, hf = lane >> 5;
        const int wv0 = __builtin_amdgcn_readfirstlane(wave);
        for (int U = gw; U < 1024; U += NGW) {
            const int n = U >> 3, h = U & 7;
            f32x16 C[2][2];
#pragma unroll
            for (int a = 0; a < 2; ++a)
#pragma unroll
                for (int b = 0; b < 2; ++b)
#pragma unroll
                    for (int r = 0; r < 16; ++r) C[a][b][r] = 0.f;
            unsigned char* Kt = lds + wv0 * 9216; unsigned char* Vt = Kt + 4608;
            const int r8 = lane >> 3, pc = lane & 7, trq = (lane & 15) >> 2, trp = lane & 3, trd = (lane >> 4) & 1;
            const char* kbase = (const char*)(Kr + (size_t)n * 128 * 512 + h * 64); const char* vbase = (const char*)(Vr + (size_t)n * 128 * 512 + h * 64);
            const unsigned loff = (unsigned)(r8 * 512 + pc * 8) * 2u;
            const float lg = lg2_head(h);
            pg8::u32x4 gK[4], gV[4];
#pragma unroll
            for (int i = 0; i < 4; ++i) { gK[i] = *(const pg8::u32x4*)(kbase + (loff + i * 8192u)); gV[i] = *(const pg8::u32x4*)(vbase + (loff + i * 8192u)); }
            for (int sb4 = 0; sb4 < 4; ++sb4) {
#pragma unroll
                for (int i = 0; i < 4; ++i) { *(pg8::u32x4*)(Kt + (8 * i + r8) * 144 + pc * 16) = gK[i]; *(pg8::u32x4*)(Vt + (8 * i + r8) * 144 + pc * 16) = gV[i]; }
                { const int sn = (sb4 < 3) ? sb4 + 1 : sb4;
#pragma unroll
                  for (int i = 0; i < 4; ++i) { gK[i] = *(const pg8::u32x4*)(kbase + (size_t)sn * 32768 + (loff + i * 8192u)); gV[i] = *(const pg8::u32x4*)(vbase + (size_t)sn * 32768 + (loff + i * 8192u)); } }
#pragma unroll
                for (int s = 0; s < 2; ++s) {
                    bf16x8 Af[2], Bf[2];
#pragma unroll
                    for (int a = 0; a < 2; ++a) {
                        Af[a] = tr_frag(Vt + (16 * s + 8 * hf + trq) * 144 + (32 * a + 16 * trd + 4 * trp) * 2, 4);
                        const bf16x8 kraw = tr_frag(Kt + (16 * s + 8 * hf + trq) * 144 + (32 * a + 16 * trd + 4 * trp) * 2, 4);
                        const pg8::u32x4 kw = __builtin_bit_cast(pg8::u32x4, kraw); const unsigned kk[4] = {kw.x, kw.y, kw.z, kw.w};
                        pg8::u32x4 o; unsigned* op = (unsigned*)&o;
#pragma unroll
                        for (int e2 = 0; e2 < 4; ++e2) {
                            const int j0 = 32 * sb4 + 16 * s + 8 * hf + 2 * e2;
                            const float z0 = __builtin_amdgcn_exp2f((float)(127 - j0) * lg), z1 = __builtin_amdgcn_exp2f((float)(126 - j0) * lg);
                            op[e2] = pg8::cvt_pk_bf16(__uint_as_float(kk[e2] << 16) * z0, __uint_as_float(kk[e2] & 0xffff0000u) * z1);
                        }
                        Bf[a] = __builtin_bit_cast(bf16x8, o);
                    }
#pragma unroll
                    for (int a = 0; a < 2; ++a)
#pragma unroll
                        for (int b = 0; b < 2; ++b) C[a][b] = MFMA32(Af[a], Bf[b], C[a][b]);
                }
            }
            float* dst = kv + (size_t)(n * 8 + h) * 4096;
#pragma unroll
            for (int a = 0; a < 2; ++a)
#pragma unroll
                for (int b = 0; b < 2; ++b)
#pragma unroll
                    for (int r = 0; r < 16; ++r) dst[(32 * a + (r & 3) + 8 * (r >> 2) + 4 * hf) * 64 + 32 * b + l31] = C[a][b][r];
        }
        bf16x8 Tri[2];
        {
            pg8::u32x4 w0, w1; unsigned* p0 = (unsigned*)&w0; unsigned* p1 = (unsigned*)&w1;
#pragma unroll
            for (int e2 = 0; e2 < 4; ++e2) {
                unsigned a0 = 0, a1 = 0;
#pragma unroll
                for (int q = 0; q < 2; ++q) { const int e = 2 * e2 + q, ip = 8 * (e >> 2) + 4 * hf + (e & 3);
                    a0 |= ((ip > l31) ? 0x3F80u : 0u) << (16 * q); a1 |= ((16 + ip > l31) ? 0x3F80u : 0u) << (16 * q); }
                p0[e2] = a0; p1[e2] = a1;
            }
            Tri[0] = __builtin_bit_cast(bf16x8, w0); Tri[1] = __builtin_bit_cast(bf16x8, w1);
        }
        const bool sb_local = (G % 8 == 0) && (4096 % G == 0) && ((4096 / G) % 8 == 0);
        const int sb_per_wave = sb_local ? 4096 / G / 8 : (4096 + NGW - 1 - gw) / NGW;
        const int wv = __builtin_amdgcn_readfirstlane(wave);
        for (int ps = 0; ps < sb_per_wave; ++ps) {
            const int U = sb_local ? 0 : gw + ps * NGW;
            const int h = sb_local ? (bid & 7) : (U & 7), qt = sb_local ? (bid >> 3) * (4096 / G) + ps * 8 + wv : (U >> 3), q0 = qt * 32;
            f32x16 O[2];
#pragma unroll
            for (int r = 0; r < 16; ++r) { O[0][r] = 0.f; O[1][r] = 0.f; }
            float carry = 0.f;
            unsigned char* Kt = lds + wv * 9216; unsigned char* Vt = Kt + 4608;
            const int r8 = lane >> 3, pc = lane & 7;
            const char* kbase = (const char*)(Ks + h * 64); const char* vbase = (const char*)(Vs + h * 64);
            const unsigned loff = (unsigned)(r8 * 512 + pc * 8) * 2u;
            pg8::u32x4 gK[4], gV[4];
            bf16x8 Qf[4];
            {
                const char* qbase = (const char*)(Qs + h * 64);
#pragma unroll
                for (int i = 0; i < 4; ++i) gK[i] = *(const pg8::u32x4*)(qbase + (size_t)qt * 32768 + (loff + i * 8192u));
#pragma unroll
                for (int i = 0; i < 4; ++i) *(pg8::u32x4*)(Kt + (8 * i + r8) * 144 + pc * 16) = gK[i];
#pragma unroll
                for (int s = 0; s < 4; ++s) Qf[s] = *(const bf16x8*)(Kt + l31 * 144 + 32 * s + 16 * hf);
            }
#pragma unroll
            for (int i = 0; i < 4; ++i) { gK[i] = *(const pg8::u32x4*)(kbase + (size_t)qt * 32768 + (loff + i * 8192u)); gV[i] = *(const pg8::u32x4*)(vbase + (size_t)qt * 32768 + (loff + i * 8192u)); }
            const int trq = (lane & 15) >> 2, trp = lane & 3, trd = (lane >> 4) & 1;
            for (int kb = qt; kb >= 0; --kb) {
#pragma unroll
                for (int i = 0; i < 4; ++i) { *(pg8::u32x4*)(Kt + (8 * i + r8) * 144 + pc * 16) = gK[i]; *(pg8::u32x4*)(Vt + (8 * i + r8) * 144 + pc * 16) = gV[i]; }
                {
                    const int kbn = (kb > 0) ? kb - 1 : 0;
#pragma unroll
                    for (int i = 0; i < 4; ++i) { gK[i] = *(const pg8::u32x4*)(kbase + (size_t)kbn * 32768 + (loff + i * 8192u)); gV[i] = *(const pg8::u32x4*)(vbase + (size_t)kbn * 32768 + (loff + i * 8192u)); }
                }
                bf16x8 Kf[4], Vf[2][2];
#pragma unroll
                for (int s = 0; s < 4; ++s) Kf[s] = *(const bf16x8*)(Kt + l31 * 144 + 32 * s + 16 * hf);
#pragma unroll
                for (int s = 0; s < 2; ++s)
#pragma unroll
                    for (int dt = 0; dt < 2; ++dt) {
                        Vf[s][dt] = tr_frag(Vt + (16 * s + 4 * hf + trq) * 144 + (32 * dt + 16 * trd + 4 * trp) * 2, 8);
                    }
                f32x16 S;
#pragma unroll
                for (int r = 0; r < 16; ++r) S[r] = 0.f;
#pragma unroll
                for (int s = 0; s < 4; ++s) S = MFMA32(Kf[s], Qf[s], S);
                const bool diag = (kb == qt);
                f32x16 sp, lb;
                float csum = 0.f;
                if (diag) {
#pragma unroll
                    for (int r = 0; r < 16; ++r) {
                        const int i = (r & 3) + 8 * (r >> 2) + 4 * hf;
                        const float z = S[r];
                        const float l1p = __builtin_amdgcn_logf(1.0f + __builtin_amdgcn_exp2f(-fabsf(z)));
                        const float spv = (i < l31) ? (fmaxf(z, 0.f) + l1p) : 0.f;
                        sp[r] = spv; lb[r] = (i < l31) ? (fminf(z, 0.f) - l1p) : -INFINITY; csum += spv;
                    }
                } else {
#pragma unroll
                    for (int r = 0; r < 16; ++r) {
                        const float z = S[r];
                        const float l1p = __builtin_amdgcn_logf(1.0f + __builtin_amdgcn_exp2f(-fabsf(z)));
                        const float spv = fmaxf(z, 0.f) + l1p;
                        sp[r] = spv; lb[r] = fminf(z, 0.f) - l1p; csum += spv;
                    }
                }
                f32x16 Rt;
#pragma unroll
                for (int r = 0; r < 16; ++r) Rt[r] = carry;
#pragma unroll
                for (int s = 0; s < 2; ++s) Rt = MFMA32(Tri[s], pack_frag(sp, s), Rt);
                f32x16 wv;
#pragma unroll
                for (int r = 0; r < 16; ++r) wv[r] = __builtin_amdgcn_exp2f(lb[r] - Rt[r]);
#pragma unroll
                for (int s = 0; s < 2; ++s) { const bf16x8 wp = pack_frag(wv, s);
#pragma unroll
                    for (int dt = 0; dt < 2; ++dt) O[dt] = MFMA32(Vf[s][dt], wp, O[dt]); }
                csum += __shfl_xor(csum, 32);
                carry += csum;
                if (__all(carry > 127.f)) break;
            }
            float ss = 0.f;
#pragma unroll
            for (int r = 0; r < 16; ++r) ss += O[0][r] * O[0][r] + O[1][r] * O[1][r];
            ss += __shfl_xor(ss, 32);
            const float rn = 1.0f / sqrtf(ss * (1.f / 64.f) + EPS);
#pragma unroll
            for (int dt = 0; dt < 2; ++dt)
#pragma unroll
                for (int g4 = 0; g4 < 4; ++g4) {
                    const int d = 32 * dt + 8 * g4 + 4 * hf;
                    const float4 gn = *(const float4*)(p.og + d);
                    uint2 w; w.x = pg8::cvt_pk_bf16(O[dt][4 * g4] * rn * gn.x, O[dt][4 * g4 + 1] * rn * gn.y); w.y = pg8::cvt_pk_bf16(O[dt][4 * g4 + 2] * rn * gn.z, O[dt][4 * g4 + 3] * rn * gn.w);
                    *(uint2*)(Kt + l31 * 144 + d * 2) = w;
                }
#pragma unroll
            for (int i = 0; i < 4; ++i) *(pg8::u32x4*)(ycat + (size_t)(q0 + 8 * i + r8) * 1024 + 512 + h * 64 + pc * 8) = *(const pg8::u32x4*)(Kt + (8 * i + r8) * 144 + pc * 16);
        }
    }
    xcd_barrier(bar);

    if (bid == 255 % G) for (int n = tid; n < 2048; n += 512) { float s = 0.f;
#pragma unroll
        for (int b8 = 0; b8 < 8; ++b8) s += bq_part[(size_t)b8 * 2048 + n];
        bias_q[n] = s; }
    if (G > 64 && bid >= 64) convert_tables(p.down, p.up, q8, qexp, lane, (bid - 64) * 8 + wave, (G - 64) * 8, CONV_SPLIT, 32768);
    else if (G <= 64) convert_tables(p.down, p.up, q8, qexp, lane, bid * 8 + wave, G * 8, CONV_SPLIT, 32768);
    for (int idx = bid * 512 + tid; idx < 32768; idx += G * 512) {
        const int h = idx >> 12;
        const float cd = exp2f(128.f * lg2_head(h));
        float s = 0.f;
        for (int n0 = 0; n0 < 128; n0 += 32) {
            float kvv[32];
#pragma unroll
            for (int q = 0; q < 32; ++q) kvv[q] = kv[(size_t)(n0 + q) * 32768 + idx];
#pragma unroll
            for (int q = 0; q < 32; ++q) { stT[(size_t)(n0 + q) * 32768 + idx] = f2bf(s); s = cd * s + kvv[q]; }
        }
    }
    xcd_barrier(bar);

    {
        const int gw = __builtin_amdgcn_readfirstlane(bid * 8 + wave), NGW = G * 8, l31 = lane & 31, hf = lane >> 5;
        const int wv4 = __builtin_amdgcn_readfirstlane(wave);
        for (int W2 = gw; W2 < 2048; W2 += NGW) {
            const int nh = W2 >> 1, n = nh >> 3, h = nh & 7;
            const float lg = lg2_head(h);
#pragma unroll 1
            for (int pass = 0; pass < 2; ++pass) {
                const int qt = (W2 & 1) ? (pass ? 2 : 1) : (pass ? 3 : 0);
                const int il = qt * 32 + l31, tq = n * 128 + il;
                unsigned char* Kt = lds + wv4 * 9216; unsigned char* Vt = Kt + 4608;
                const int r8 = lane >> 3, pc = lane & 7, trq = (lane & 15) >> 2, trp = lane & 3, trd = (lane >> 4) & 1;
                const unsigned loff = (unsigned)(r8 * 512 + pc * 8) * 2u;
                pg8::u32x4 gK[4], gV[4];
                bf16x8 Qf[4];
                {
                    const char* qbase = (const char*)(Qr + (size_t)(n * 128 + qt * 32) * 512 + h * 64);
                    const char* sbase = (const char*)(stT + (size_t)nh * 4096) + (unsigned)(r8 * 64 + pc * 8) * 2u;
#pragma unroll
                    for (int i = 0; i < 4; ++i) gK[i] = *(const pg8::u32x4*)(qbase + (loff + i * 8192u));
#pragma unroll
                    for (int i = 0; i < 4; ++i) *(pg8::u32x4*)(Kt + (8 * i + r8) * 144 + pc * 16) = gK[i];
#pragma unroll
                    for (int s = 0; s < 4; ++s) Qf[s] = *(const bf16x8*)(Kt + l31 * 144 + 32 * s + 16 * hf);
#pragma unroll
                    for (int i = 0; i < 4; ++i) { gK[i] = *(const pg8::u32x4*)(sbase + i * 1024u); gV[i] = *(const pg8::u32x4*)(sbase + 4096u + i * 1024u); }
#pragma unroll
                    for (int i = 0; i < 4; ++i) { *(pg8::u32x4*)(Kt + (8 * i + r8) * 144 + pc * 16) = gK[i]; *(pg8::u32x4*)(Kt + (32 + 8 * i + r8) * 144 + pc * 16) = gV[i]; }
                }
                f32x16 O[2];
#pragma unroll
                for (int r = 0; r < 16; ++r) { O[0][r] = 0.f; O[1][r] = 0.f; }
#pragma unroll
                for (int s = 0; s < 4; ++s)
#pragma unroll
                    for (int dt = 0; dt < 2; ++dt) O[dt] = MFMA32(*(const bf16x8*)(Kt + (32 * dt + l31) * 144 + 32 * s + 16 * hf), Qf[s], O[dt]);
                const float xi = exp2f((float)(il + 1) * lg);
#pragma unroll
                for (int r = 0; r < 16; ++r) { O[0][r] *= xi; O[1][r] *= xi; }
                const char* kbase = (const char*)(Kr + (size_t)n * 128 * 512 + h * 64); const char* vbase = (const char*)(Vr + (size_t)n * 128 * 512 + h * 64);
#pragma unroll
                for (int i = 0; i < 4; ++i) { gK[i] = *(const pg8::u32x4*)(kbase + (loff + i * 8192u)); gV[i] = *(const pg8::u32x4*)(vbase + (loff + i * 8192u)); }
                for (int jb = 0; jb <= qt; ++jb) {
#pragma unroll
                    for (int i = 0; i < 4; ++i) { *(pg8::u32x4*)(Kt + (8 * i + r8) * 144 + pc * 16) = gK[i]; *(pg8::u32x4*)(Vt + (8 * i + r8) * 144 + pc * 16) = gV[i]; }
                    { const int jn = (jb < qt) ? jb + 1 : jb;
#pragma unroll
                      for (int i = 0; i < 4; ++i) { gK[i] = *(const pg8::u32x4*)(kbase + (size_t)jn * 32768 + (loff + i * 8192u)); gV[i] = *(const pg8::u32x4*)(vbase + (size_t)jn * 32768 + (loff + i * 8192u)); } }
                    bf16x8 Kf[4], Vf[2][2];
#pragma unroll
                    for (int s = 0; s < 4; ++s) Kf[s] = *(const bf16x8*)(Kt + l31 * 144 + 32 * s + 16 * hf);
#pragma unroll
                    for (int s = 0; s < 2; ++s)
#pragma unroll
                        for (int dt = 0; dt < 2; ++dt) Vf[s][dt] = tr_frag(Vt + (16 * s + 4 * hf + trq) * 144 + (32 * dt + 16 * trd + 4 * trp) * 2, 8);
                    f32x16 S;
#pragma unroll
                    for (int r = 0; r < 16; ++r) S[r] = 0.f;
#pragma unroll
                    for (int s = 0; s < 4; ++s) S = MFMA32(Kf[s], Qf[s], S);
#pragma unroll
                    for (int r = 0; r < 16; ++r) {
                        const int jl = jb * 32 + (r & 3) + 8 * (r >> 2) + 4 * hf, dl = il - jl;
                        S[r] = (dl >= 0) ? S[r] * __builtin_amdgcn_exp2f((float)dl * lg) : 0.f;
                    }
#pragma unroll
                    for (int s = 0; s < 2; ++s) { const bf16x8 wp = pack_frag(S, s);
#pragma unroll
                        for (int dt = 0; dt < 2; ++dt) O[dt] = MFMA32(Vf[s][dt], wp, O[dt]); }
                }
                float sm = 0.f;
#pragma unroll
                for (int r = 0; r < 16; ++r) sm += O[0][r] + O[1][r];
                sm += __shfl_xor(sm, 32);
                const float mean = sm * (1.f / 64.f);
                float vs = 0.f;
#pragma unroll
                for (int r = 0; r < 16; ++r) { const float d0 = O[0][r] - mean, d1 = O[1][r] - mean; vs += d0 * d0 + d1 * d1; }
                vs += __shfl_xor(vs, 32);
                const float rstd = 1.0f / sqrtf(vs * (1.f / 64.f) + EPS);
                {
                    const char* gbase = (const char*)(Gr + (size_t)(n * 128 + qt * 32) * 512 + h * 64);
#pragma unroll
                    for (int i = 0; i < 4; ++i) gV[i] = *(const pg8::u32x4*)(gbase + (loff + i * 8192u));
#pragma unroll
                    for (int i = 0; i < 4; ++i) *(pg8::u32x4*)(Vt + (8 * i + r8) * 144 + pc * 16) = gV[i];
                }
#pragma unroll
                for (int dt = 0; dt < 2; ++dt)
#pragma unroll
                    for (int g4 = 0; g4 < 4; ++g4) {
                        const int e = 32 * dt + 8 * g4 + 4 * hf;
                        const float4 gn = *(const float4*)(p.rgain + h * 64 + e);
                        const uint2 gg = *(const uint2*)(Vt + l31 * 144 + e * 2);
                        const float g0 = __uint_as_float(gg.x << 16), g1 = __uint_as_float(gg.x & 0xffff0000u), g2v = __uint_as_float(gg.y << 16), g3 = __uint_as_float(gg.y & 0xffff0000u);
                        uint2 w;
                        w.x = pg8::cvt_pk_bf16((O[dt][4 * g4] - mean) * rstd * gn.x * g0, (O[dt][4 * g4 + 1] - mean) * rstd * gn.y * g1);
                        w.y = pg8::cvt_pk_bf16((O[dt][4 * g4 + 2] - mean) * rstd * gn.z * g2v, (O[dt][4 * g4 + 3] - mean) * rstd * gn.w * g3);
                        *(uint2*)(Kt + l31 * 144 + e * 2) = w;
                    }
#pragma unroll
                for (int i = 0; i < 4; ++i) *(pg8::u32x4*)(ycat + (size_t)(n * 128 + qt * 32 + 8 * i + r8) * 1024 + h * 64 + pc * 8) = *(const pg8::u32x4*)(Kt + (8 * i + r8) * 144 + pc * 16);
            }
        }
    }
    xcd_barrier(bar);

    {
        pg8::Gemm g{ycat, Wout_t, T, 1024, 1024}; pg8::StaticOrder S; S.init(T, 1024, G, bid);
        EpiOutprojMF E{p.x, mod + 2048, x1, x1b, part2};
        pg8::gemm_phase<EpiOutprojMF, pg8::StaticOrder>((PG8_LAS unsigned char*)lds, g, S, E);
    }
    xcd_barrier(bar);

    for (int round = 0; round < 2; ++round) {
        pg8::Gemm g{x1b, Weff_t, T, 2048, 1024}; OneUnitOrder S; S.base.init(T, 2048, G, bid); S.round = round;
        EpiTopkMF E{part2, bias_q, ids, gates};
        pg8::gemm_phase<EpiTopkMF, OneUnitOrder>((PG8_LAS unsigned char*)lds, g, S, E);
    }
    xcd_barrier(bar);

    {
        constexpr int IDS_LD = 136, ACT_LD = 136;
        const float* scale2 = mod + 4096; const float* shift2 = mod + 3072; const float* gate2 = mod + 5120;
        unsigned short* ids_l = (unsigned short*)lds; float* act_l = (float*)(lds + 32768); unsigned char* qe_l = lds + 32768 + 36864;
        const int t0 = bid * 64, tt = lane >> 3, sub = lane & 7, tl = wave * 8 + tt, t = t0 + tl;
        for (int e = tid; e < 1024; e += 512) { const int r = e >> 4, c8 = e & 15; *(uint4*)(ids_l + r * IDS_LD + c8 * 8) = *(const uint4*)(ids + (size_t)(t0 + r) * 128 + c8 * 8); }
        for (int e = tid; e < 64 * ACT_LD; e += 512) act_l[e] = 0.f;
        for (int e = tid; e < 2048; e += 512) ((uint4*)qe_l)[e] = ((const uint4*)qexp)[e];
        __syncthreads();
        float ri;
        { const float4* pp = (const float4*)(part2 + (size_t)t * 16); const float4 p0 = pp[0], p1 = pp[1], p2 = pp[2], p3 = pp[3];
          const float ssum = ((p0.x + p0.y) + (p0.z + p0.w)) + ((p1.x + p1.y) + (p1.z + p1.w)) + ((p2.x + p2.y) + (p2.z + p2.w)) + ((p3.x + p3.y) + (p3.z + p3.w));
          ri = 1.0f / sqrtf(ssum * (1.0f / D) + EPS); }
        const unsigned short* myids = ids_l + tl * IDS_LD;
        float* myact = act_l + tl * ACT_LD;
        const bool s4 = (sub & 4) != 0, s2 = (sub & 2) != 0, s1 = (sub & 1) != 0;
        const unsigned suboff = (unsigned)sub * 16u;
        typedef float f32x2 __attribute__((ext_vector_type(2)));
#define P9_LOAD(W, JB) do { const uint4 idv_ = *(const uint4*)(myids + 8 * (JB)); const unsigned idw_[4] = {idv_.x, idv_.y, idv_.z, idv_.w}; \
        _Pragma("unroll") for (int k_ = 0; k_ < 8; ++k_) { const unsigned id_ = (idw_[k_ >> 1] >> (16 * (k_ & 1))) & 0xffffu; W[k_] = *(const uint4*)(sbase + (id_ * 128u + suboff)); } } while (0)
#define P9_DOWN(W, JB) do { float pd_[8]; \
        _Pragma("unroll") for (int k_ = 0; k_ < 8; ++k_) { const unsigned ww_[4] = {W[k_].x, W[k_].y, W[k_].z, W[k_].w}; f32x2 s_ = {0.f, 0.f}, u_ = {0.f, 0.f}; \
            _Pragma("unroll") for (int m_ = 0; m_ < 4; ++m_) { const f32x2 lo_ = __builtin_amdgcn_cvt_pk_f32_fp8((int)ww_[m_], false), hi_ = __builtin_amdgcn_cvt_pk_f32_fp8((int)ww_[m_], true); \
                s_ = lo_ * hp[2 * m_] + s_; u_ = hi_ * hp[2 * m_ + 1] + u_; } \
            s_ = s_ + u_; pd_[k_] = s_[0] + s_[1]; } \
        float r4_[4], r2_[2]; \
        _Pragma("unroll") for (int k_ = 0; k_ < 4; ++k_) { const float snd_ = s4 ? pd_[k_] : pd_[k_ + 4], kp_ = s4 ? pd_[k_ + 4] : pd_[k_]; r4_[k_] = kp_ + __shfl_xor(snd_, 4); } \
        _Pragma("unroll") for (int k_ = 0; k_ < 2; ++k_) { const float snd_ = s2 ? r4_[k_] : r4_[k_ + 2], kp_ = s2 ? r4_[k_ + 2] : r4_[k_]; r2_[k_] = kp_ + __shfl_xor(snd_, 2); } \
        { const float snd_ = s1 ? r2_[0] : r2_[1], kp_ = s1 ? r2_[1] : r2_[0]; myact[8 * (JB) + sub] += kp_ + __shfl_xor(snd_, 1); } } while (0)
#define P9_UP(W, JB) do { const float4 a0_ = *(const float4*)(myact + 8 * (JB)), a1_ = *(const float4*)(myact + 8 * (JB) + 4); \
        const float av_[8] = {a0_.x, a0_.y, a0_.z, a0_.w, a1_.x, a1_.y, a1_.z, a1_.w}; \
        _Pragma("unroll") for (int k_ = 0; k_ < 8; ++k_) { const unsigned ww_[4] = {W[k_].x, W[k_].y, W[k_].z, W[k_].w}; \
            _Pragma("unroll") for (int m_ = 0; m_ < 4; ++m_) { const f32x2 lo_ = __builtin_amdgcn_cvt_pk_f32_fp8((int)ww_[m_], false), hi_ = __builtin_amdgcn_cvt_pk_f32_fp8((int)ww_[m_], true); \
                o2[2 * m_] = lo_ * av_[k_] + o2[2 * m_]; o2[2 * m_ + 1] = hi_ * av_[k_] + o2[2 * m_ + 1]; } } } while (0)
        for (int c = 0; c < 8; ++c) {
            f32x2 hp[8];
            const int col = 128 * c + 4 * sub;
#pragma unroll
            for (int q = 0; q < 4; ++q) {
                const float4 xv = *(const float4*)(x1 + (size_t)t * D + col + 32 * q);
                const float4 g = *(const float4*)(p.g2 + col + 32 * q), sc = *(const float4*)(scale2 + col + 32 * q), sh = *(const float4*)(shift2 + col + 32 * q);
                hp[2 * q][0] = xv.x * ri * g.x * (1.f + sc.x) + sh.x; hp[2 * q][1] = xv.y * ri * g.y * (1.f + sc.y) + sh.y;
                hp[2 * q + 1][0] = xv.z * ri * g.z * (1.f + sc.z) + sh.z; hp[2 * q + 1][1] = xv.w * ri * g.w * (1.f + sc.w) + sh.w;
            }
            const unsigned char* sbase = q8 + (size_t)c * (16384 * 128);
            uint4 wA[8], wB[8];
            P9_LOAD(wA, 0);
#pragma unroll 1
            for (int jb = 0; jb < 16; jb += 2) {
                P9_LOAD(wB, jb + 1);
                P9_DOWN(wA, jb);
                if (jb + 2 < 16) P9_LOAD(wA, jb + 2);
                P9_DOWN(wB, jb + 1);
            }
        }
        for (int jb = 0; jb < 16; ++jb) {
            const int j = 8 * jb + sub; const unsigned id = myids[j];
            const float a = myact[j] * __uint_as_float((unsigned)qe_l[id] << 23);
            const float av = fabsf(a), tq = 1.0f / (av * 0.2316418882f + 1.0f);
            float ql = tq * 0.5307027145f + (-0.7265760135f); ql = ql * tq + 0.7107068705f; ql = ql * tq + (-0.142248368f); ql = ql * tq + 0.127414796f; ql = ql * tq;
            const float mm = a * (ql * exp2f(a * a * (-0.72134752044f)));
            const float ge = (a < 0.f) ? mm : (a - mm);
            myact[j] = ge * gates[(size_t)t * 128 + j] * __uint_as_float((unsigned)qe_l[16384 + id] << 23);
        }
        __syncthreads();
        for (int c = 0; c < 8; ++c) {
            f32x2 o2[8];
#pragma unroll
            for (int q = 0; q < 8; ++q) o2[q] = (f32x2){0.f, 0.f};
            const int col = 128 * c + 4 * sub;
            const unsigned char* sbase = q8 + (16u << 20) + (size_t)c * (16384 * 128);
            uint4 wA[8], wB[8];
            P9_LOAD(wA, 0);
#pragma unroll 1
            for (int jb = 0; jb < 16; jb += 2) {
                P9_LOAD(wB, jb + 1);
                P9_UP(wA, jb);
                if (jb + 2 < 16) P9_LOAD(wA, jb + 2);
                P9_UP(wB, jb + 1);
            }
#pragma unroll
            for (int q = 0; q < 4; ++q) {
                float* op = out + (size_t)t * D + col + 32 * q;
                const float4 xv = *(const float4*)(x1 + (size_t)t * D + col + 32 * q); const float4 gt = *(const float4*)(gate2 + col + 32 * q);
                float4 r; r.x = xv.x + gt.x * o2[2 * q][0]; r.y = xv.y + gt.y * o2[2 * q][1]; r.z = xv.z + gt.z * o2[2 * q + 1][0]; r.w = xv.w + gt.w * o2[2 * q + 1][1];
                *(float4*)op = r;
            }
        }
#undef P9_LOAD
#undef P9_DOWN
#undef P9_UP
    }
}
}

extern "C" void kernel_launch(void* const* d_in, const int* in_sizes, int n_in, void* d_out, int out_size, void* d_ws, size_t ws_size, hipStream_t stream) {
    static int grid = 0;
    if (grid == 0) {
        int dev = 0, cus = 0, per_cu = 0;
        (void)hipGetDevice(&dev);
        (void)hipDeviceGetAttribute(&cus, hipDeviceAttributeMultiprocessorCount, dev);
        (void)hipFuncSetAttribute((const void*)mk_fwd, hipFuncAttributeMaxDynamicSharedMemorySize, LDS_BYTES);
        (void)hipOccupancyMaxActiveBlocksPerMultiprocessor(&per_cu, (const void*)mk_fwd, 512, LDS_BYTES);
        if (per_cu < 1 || cus != 256) { fprintf(stderr, "kernel_launch: needs 256 CUs with one resident workgroup each (cus %d, per_cu %d)\n", cus, per_cu); grid = -1; }
        else grid = cus;
    }
    if (grid < 0) return;
    (void)hipMemsetAsync((char*)d_ws + OFF_CTL, 0, CTL_BYTES, stream);
    Params p{};
    p.x = (const float*)d_in[0]; p.c = (const float*)d_in[1]; p.pos = (const int*)d_in[2]; p.ada_w = (const float*)d_in[3]; p.ada_b = (const float*)d_in[4];
    p.g1 = (const float*)d_in[5]; p.g2 = (const float*)d_in[6]; p.w_in = (const float*)d_in[7]; p.rgain = (const float*)d_in[8]; p.qg = (const float*)d_in[9];
    p.kg = (const float*)d_in[10]; p.og = (const float*)d_in[11]; p.w_out = (const float*)d_in[12]; p.wq = (const float*)d_in[13]; p.sk = (const float*)d_in[14];
    p.down = (const float*)d_in[15]; p.up = (const float*)d_in[16]; p.out = (float*)d_out; p.ws = (unsigned char*)d_ws;
    for (int i = 0; i < 32; ++i) {
        const double f = pow(10000.0, -(double)i / 32.0) / 6.283185307179586476925;
        float fh = (float)f; unsigned ub; memcpy(&ub, &fh, 4); ub &= 0xFFFFC000u; memcpy(&fh, &ub, 4);
        p.rc.fh[i] = fh; p.rc.fl[i] = (float)(f - (double)fh);
    }
    void* args[] = {&p};
    hipError_t e = hipLaunchCooperativeKernel((const void*)mk_fwd, dim3(grid), dim3(512), args, LDS_BYTES, stream);
    if (e != hipSuccess) fprintf(stderr, "kernel_launch: cooperative launch failed: %s (grid %d)\n", hipGetErrorString(e), grid);
}
```

```cpp
#include <hip/hip_runtime.h>
#include <stdint.h>
#include <math.h>
#include <cstdio>
#include <cstring>

namespace {
constexpr int T = 16384, D = 1024;
constexpr float EPS = 1e-6f;
typedef unsigned short bf16_t;
#define LAS __attribute__((address_space(3)))

__device__ __forceinline__ float bf2f(bf16_t b) { return __uint_as_float(((unsigned)b) << 16); }
__device__ __forceinline__ bf16_t f2bf(float f) { unsigned u = __float_as_uint(f); u += 0x7fffu + ((u >> 16) & 1u); return (bf16_t)(u >> 16); }
__device__ __forceinline__ float4 ld_nt4(const float* p) { typedef float f4v __attribute__((ext_vector_type(4))); const f4v v = __builtin_nontemporal_load((const f4v*)p); return make_float4(v[0], v[1], v[2], v[3]); }

__device__ __forceinline__ float lg2_head(int h) {
    const float x = __uint_as_float((unsigned)(127 - 5 - h) << 23);
    const float s = x * (1.f + x * (0.5f + x * (0.33333334f + x * (0.25f + x * (0.2f + x * 0.16666667f)))));
    return -s * 1.44269504089f;
}
struct RopeC { float fh[32], fl[32]; };
struct RetC { float lg2[8]; };

constexpr size_t MiB = 1u << 20;
constexpr size_t OFF_CTL = 0;
constexpr size_t CTL_BYTES = 64 * 1024;
constexpr size_t OFF_MOD = 64 * 1024, OFF_RINV1 = 128 * 1024, OFF_BIASF = 256 * 1024, OFF_ROPE = 1 * MiB;
constexpr size_t OFF_WINT = 6 * MiB;
constexpr size_t OFF_XB = 16 * MiB;
constexpr size_t OFF_YCAT = 16 * MiB;
constexpr size_t OFF_P = 48 * MiB;
constexpr size_t OFF_KV = 208 * MiB, OFF_ST = 224 * MiB;
constexpr size_t OFF_WEFFT = 240 * MiB;
constexpr size_t OFF_WOUTT = 13 * MiB;
constexpr size_t OFF_BIASQ = 272 * 1024;
constexpr size_t OFF_BQPART = 448 * 1024;
constexpr size_t OFF_PART2 = 5 * MiB;
constexpr size_t OFF_X1B = 208 * MiB;
constexpr size_t OFF_X1 = 48 * MiB;
constexpr size_t OFF_IDS = 244 * MiB, OFF_GATES = 248 * MiB;
constexpr size_t OFF_Q8 = 176 * MiB;
constexpr size_t OFF_QSC = 320 * 1024;
constexpr int CONV_SPLIT = 0;
constexpr int LDS_BYTES = 163840;
constexpr int LDS_ST_OFF = LDS_BYTES - 16;

#define XB_TMO      128
#define XB_XCNT(j)  (256  + 64 * (j))
#define XB_XSUB(j)  (1280 + 64 * (j))
#define XB_XGEN(j)  (2304 + 64 * (j))
#define XB_TOP      3328
#define XB_TOPGEN   3392
#define XCD_BAR_WORDS 3456
#define XB_SPIN_CAP (1u << 20)
__device__ __forceinline__ unsigned xb_ld(unsigned* p)              { return __hip_atomic_load(p, __ATOMIC_RELAXED, __HIP_MEMORY_SCOPE_AGENT); }
__device__ __forceinline__ unsigned xb_add(unsigned* p, unsigned v) { return __hip_atomic_fetch_add(p, v, __ATOMIC_RELAXED, __HIP_MEMORY_SCOPE_AGENT); }
__device__ __forceinline__ unsigned xb_xcc_id() { return (unsigned)__builtin_amdgcn_s_getreg((3 << 11) | 20) & 0xFu; }
#define XB_SPIN(cond, bar) do { unsigned _sp = 0; while (cond) { __builtin_amdgcn_s_sleep(1); \
    if ((++_sp & 255u) == 0u) { if (xb_ld(&(bar)[XB_TMO])) break; if (_sp > XB_SPIN_CAP) { atomicAdd(&(bar)[XB_TMO], 1u); break; } } } } while (0)
struct XcdBarrier { unsigned* bar; unsigned x; volatile LAS unsigned* st; };
__device__ __forceinline__ XcdBarrier xcd_barrier_post(unsigned* bar, volatile LAS unsigned* st) {
    XcdBarrier b; b.bar = bar; b.x = xb_xcc_id(); b.st = st;
    if (threadIdx.x == 0) (void)xb_add(&bar[XB_XCNT(b.x)], 1u);
    return b;
}
__device__ __forceinline__ void xcd_barrier_complete(unsigned* bar, unsigned x, unsigned& nloc, unsigned& nx) {
    const unsigned G = gridDim.x * gridDim.y * gridDim.z;
    unsigned sum, cnt, mine, sp = 0u;
    for (;;) {
        sum = 0u; cnt = 0u; mine = 0u;
#pragma unroll
        for (unsigned j = 0; j < 16; ++j) { const unsigned c = xb_ld(&bar[XB_XCNT(j)]); sum += c; cnt += (c > 0u) ? 1u : 0u; mine = (j == x) ? c : mine; }
        if (sum == G) break;
        __builtin_amdgcn_s_sleep(1);
        if ((++sp & 255u) == 0u) { if (xb_ld(&bar[XB_TMO])) break; if (sp > XB_SPIN_CAP) { atomicAdd(&bar[XB_TMO], 1u); break; } }
    }
    nloc = mine > 0u ? mine : 1u; nx = cnt > 0u ? cnt : 1u;
}
__device__ __forceinline__ void xcd_barrier(const XcdBarrier& b) {
    asm volatile("s_waitcnt vmcnt(0)" ::: "memory");
    __syncthreads();
    if (threadIdx.x == 0) {
        unsigned* bar = b.bar;
        __builtin_amdgcn_s_waitcnt(0);
        unsigned nloc = b.st[0], nx = b.st[1];
        if (nloc == 0u) { xcd_barrier_complete(bar, b.x, nloc, nx); b.st[0] = nloc; b.st[1] = nx; }
        const unsigned old = xb_add(&bar[XB_XSUB(b.x)], 1u);
        const unsigned gen = old / nloc;
        if (old + 1u == (gen + 1u) * nloc) {
            __builtin_amdgcn_fence(__ATOMIC_RELEASE, "agent");
            asm volatile("s_waitcnt vmcnt(0)" ::: "memory");
            const unsigned og = xb_add(&bar[XB_TOP], 1u);
            const unsigned tg = og / nx;
            if (og + 1u == (tg + 1u) * nx) xb_add(&bar[XB_TOPGEN], 1u);
            else XB_SPIN(xb_ld(&bar[XB_TOPGEN]) == tg, bar);
            __builtin_amdgcn_fence(__ATOMIC_ACQUIRE, "agent");
            xb_add(&bar[XB_XGEN(b.x)], 1u);
            asm volatile("s_waitcnt vmcnt(0)" ::: "memory");
        } else {
            XB_SPIN(xb_ld(&bar[XB_XGEN(b.x)]) == gen, bar);
            __builtin_amdgcn_fence(__ATOMIC_ACQUIRE, "agent");
            asm volatile("s_waitcnt vmcnt(0)" ::: "memory");
        }
    }
    __syncthreads();
}


namespace pg8 {
#define PG8_LAS __attribute__((address_space(3)))
typedef short bf16x8 __attribute__((ext_vector_type(8)));
typedef float f32x4 __attribute__((ext_vector_type(4)));
typedef unsigned u32x4 __attribute__((ext_vector_type(4)));
typedef unsigned u32x2 __attribute__((ext_vector_type(2)));
constexpr int BM = 256, BK = 64, HALF = 128, HTB = HALF * BK * 2, STAGE_BYTES = 8 * HTB, NXCD = 8, WGM = 8;
__host__ __device__ __forceinline__ int lds_byte(int r, int c) { const int st = (r >> 4) * 2 + (c >> 5), rr = r & 15, cc = c & 31, ob = rr * 64 + cc * 2; return st * 1024 + (ob ^ (((ob >> 9) & 1) << 5)); }
__host__ __device__ __forceinline__ void stage_rc(int b, int& R, int& C) { const int st = b / 1024, sb = b % 1024, swz = sb ^ (((sb >> 9) & 1) << 5); R = (st >> 1) * 16 + swz / 64; C = (st & 1) * 32 + (swz % 64) / 2; }
__host__ __device__ __forceinline__ int perm32(int rho) { const int n = rho >> 4, i = rho & 15; return 8 * (i >> 2) + 4 * n + (i & 3); }
struct Unit { int pm, pn; };
struct Gemm { const bf16_t* A; const bf16_t* Bt; int M, N, K; };
struct StaticOrder {
    int nM, nN, nwg, G, c;
    __host__ __device__ void init(int M, int N, int G_, int c_) { nM = M / BM; nN = N / BM; nwg = nM * nN; G = G_; c = c_; }
    __host__ __device__ bool next(int i, Unit& u) const {
        const long L = (long)i * G + c; if (L >= nwg) return false;
        int wgid = (int)L; { const int q = nwg / NXCD, r = nwg % NXCD, xcd = wgid % NXCD, off = wgid / NXCD; wgid = (xcd < r ? xcd * (q + 1) : r * (q + 1) + (xcd - r) * q) + off; }
        const int nig = WGM * nN, gid = wgid / nig, fm = gid * WGM, gsz = (nM - fm) < WGM ? (nM - fm) : WGM;
        u.pm = fm + ((wgid % nig) % gsz); u.pn = (wgid % nig) / gsz; return true;
    }
    __device__ __forceinline__ void a_ready(const Unit&) const {}
    __device__ __forceinline__ void done(const Unit&) const {}
};
__device__ __forceinline__ unsigned cvt_pk_bf16(float lo, float hi) { unsigned r; asm volatile("v_cvt_pk_bf16_f32 %0, %1, %2" : "=v"(r) : "v"(lo), "v"(hi)); return r; }

template <class Epi, class Sched>
__device__ __forceinline__ void gemm_phase(PG8_LAS unsigned char* lds, const Gemm g, const Sched& S, const Epi& E) {
    int tid_ = threadIdx.x; asm volatile("" : "+v"(tid_));
    const int tid = tid_, wid = __builtin_amdgcn_readfirstlane(tid >> 6), lane = tid & 63, wr = wid >> 2, wc = wid & 3, fr = lane & 15, fq = lane >> 4;
    const int K = g.K, nt = K / BK;
    unsigned voffA[2], voffB[2];
#pragma unroll
    for (int i = 0; i < 2; ++i) { int R, C; stage_rc(tid * 16 + i * 8192, R, C); const int Rb = Epi::PERM ? ((R & ~31) + perm32(R & 31)) : R;
        voffA[i] = (unsigned)(R * K + C) * 2u; voffB[i] = (unsigned)(Rb * K + C) * 2u; }
    const size_t kstep = (size_t)(BK * 2);
    const size_t hstep = (size_t)HALF * K * 2;
    const size_t tstep = 2 * hstep;
    const unsigned ldsw = (unsigned)wid * 1024u;
    const int aoff = lds_byte(wr * 64 + fr, fq * 8), boff = lds_byte(wc * 32 + fr, fq * 8);
#define PG8_SA(b, h) (((b) * 2 + (h)) * HTB)
#define PG8_SB(b, h) ((4 + (b) * 2 + (h)) * HTB)
#define PG8_STAGE(bufoff, gbase, voff) do { _Pragma("unroll") for (int _i = 0; _i < 2; ++_i) \
        __builtin_amdgcn_global_load_lds((const unsigned*)((const char*)(gbase) + (voff)[_i]), (PG8_LAS unsigned*)(lds + (bufoff) + ldsw + _i * 8192), 16, 0, 0); } while (0)
#define PG8_LDA(dst, b, h) do { _Pragma("unroll") for (int m = 0; m < 4; ++m) _Pragma("unroll") for (int k = 0; k < 2; ++k) dst[m][k] = *(const PG8_LAS bf16x8*)(lds + PG8_SA(b, h) + aoff + m * 2048 + k * 1024); } while (0)
#define PG8_LDB(dst, b, h) do { _Pragma("unroll") for (int n = 0; n < 2; ++n) _Pragma("unroll") for (int k = 0; k < 2; ++k) dst[n][k] = *(const PG8_LAS bf16x8*)(lds + PG8_SB(b, h) + boff + n * 2048 + k * 1024); } while (0)
#define PG8_MMA(ai, bj, At, Bt) do { __builtin_amdgcn_s_setprio(1); _Pragma("unroll") for (int m = 0; m < 4; ++m) _Pragma("unroll") for (int n = 0; n < 2; ++n) _Pragma("unroll") for (int k = 0; k < 2; ++k) \
        acc[ai][bj][m][n] = __builtin_amdgcn_mfma_f32_16x16x32_bf16(Bt[n][k], At[m][k], acc[ai][bj][m][n], 0, 0, 0); __builtin_amdgcn_s_setprio(0); } while (0)
#define PG8_WAIT_V(n) asm volatile("s_waitcnt vmcnt(" #n ")" ::: "memory")
#define PG8_WAIT_L(n) asm volatile("s_waitcnt lgkmcnt(" #n ")" ::: "memory")
#define PG8_BAR __builtin_amdgcn_s_barrier()
#define PG8_SCHED __builtin_amdgcn_sched_barrier(0)
    Unit cur, nxt; int ui = 0;
    if (!S.next(0, cur)) return;
    f32x4 acc[2][2][4][2];
#pragma unroll
    for (int a = 0; a < 2; ++a)
#pragma unroll
        for (int b = 0; b < 2; ++b)
#pragma unroll
            for (int m = 0; m < 4; ++m)
#pragma unroll
                for (int n = 0; n < 2; ++n) acc[a][b][m][n] = (f32x4){0.f, 0.f, 0.f, 0.f};
    bf16x8 At[4][2], B0[2][2], B1[2][2];
    const char* cA = (const char*)g.A + (size_t)cur.pm * tstep; const char* cB = (const char*)g.Bt + (size_t)cur.pn * tstep;
    S.a_ready(cur);
    PG8_STAGE(PG8_SB(0, 0), cB, voffB); PG8_STAGE(PG8_SA(0, 0), cA, voffA); PG8_STAGE(PG8_SB(0, 1), cB + hstep, voffB); PG8_STAGE(PG8_SA(0, 1), cA + hstep, voffA);
    if (wr == 1) PG8_BAR;
    PG8_WAIT_V(4); PG8_BAR;
    PG8_STAGE(PG8_SB(1, 0), cB + kstep, voffB); PG8_STAGE(PG8_SA(1, 0), cA + kstep, voffA); PG8_STAGE(PG8_SB(1, 1), cB + hstep + kstep, voffB);
    PG8_WAIT_V(6); PG8_BAR;
    for (;;) {
        const bool has_next = S.next(ui + 1, nxt);
        const char* nA = has_next ? (const char*)g.A + (size_t)nxt.pm * tstep : cA; const char* nB = has_next ? (const char*)g.Bt + (size_t)nxt.pn * tstep : cB;
        for (int t = 0; t < nt; t += 2) {
            const bool last = (t == nt - 2);
            const char* a1 = cA + (size_t)(t + 1) * kstep;
            const char* a2 = last ? nA : cA + (size_t)(t + 2) * kstep; const char* b2 = last ? nB : cB + (size_t)(t + 2) * kstep;
            const char* a3 = a2 + kstep; const char* b3 = b2 + kstep;
            if (last && has_next) S.a_ready(nxt);
            PG8_LDB(B0, 0, 0); PG8_SCHED; PG8_LDA(At, 0, 0); PG8_STAGE(PG8_SA(1, 1), a1 + hstep, voffA);
            PG8_WAIT_L(8); PG8_BAR; PG8_WAIT_L(0); PG8_MMA(0, 0, At, B0); PG8_BAR; PG8_SCHED;
            PG8_LDB(B1, 0, 1); PG8_STAGE(PG8_SB(0, 0), b2, voffB);
            PG8_BAR; PG8_WAIT_L(0); PG8_MMA(0, 1, At, B1); PG8_BAR;
            PG8_LDA(At, 0, 1); PG8_STAGE(PG8_SA(0, 0), a2, voffA);
            PG8_BAR; PG8_WAIT_L(0); PG8_MMA(1, 0, At, B0); PG8_BAR; PG8_SCHED;
            PG8_STAGE(PG8_SB(0, 1), b2 + hstep, voffB);
            PG8_WAIT_V(6); PG8_BAR; PG8_MMA(1, 1, At, B1); PG8_BAR;
            PG8_LDB(B0, 1, 0); PG8_SCHED; PG8_LDA(At, 1, 0); PG8_STAGE(PG8_SA(0, 1), a2 + hstep, voffA);
            PG8_WAIT_L(8); PG8_BAR; PG8_WAIT_L(0); PG8_MMA(0, 0, At, B0); PG8_BAR; PG8_SCHED;
            PG8_LDB(B1, 1, 1); PG8_STAGE(PG8_SB(1, 0), b3, voffB);
            PG8_BAR; PG8_WAIT_L(0); PG8_MMA(0, 1, At, B1); PG8_BAR;
            PG8_LDA(At, 1, 1); PG8_STAGE(PG8_SA(1, 0), a3, voffA);
            PG8_BAR; PG8_WAIT_L(0); PG8_MMA(1, 0, At, B0); PG8_BAR; PG8_SCHED;
            PG8_STAGE(PG8_SB(1, 1), b3 + hstep, voffB);
            PG8_WAIT_V(6); PG8_BAR; PG8_MMA(1, 1, At, B1); PG8_BAR;
        }
        if constexpr (!Epi::AFTER_DRAIN) { E(acc, cur, wr, wc, fr, fq); S.done(cur); }
        if (!has_next) break;
#pragma unroll
        for (int a = 0; a < 2; ++a)
#pragma unroll
            for (int b = 0; b < 2; ++b)
#pragma unroll
                for (int m = 0; m < 4; ++m)
#pragma unroll
                    for (int n = 0; n < 2; ++n) acc[a][b][m][n] = (f32x4){0.f, 0.f, 0.f, 0.f};
        cur = nxt; cA = nA; cB = nB; ++ui;
    }
    PG8_WAIT_V(0);
    if (wr == 0) PG8_BAR;
    PG8_BAR;
    if constexpr (Epi::AFTER_DRAIN) { E.fused(acc, cur, wr, wc, fr, fq, lds, wid, lane); S.done(cur); }
#undef PG8_SA
#undef PG8_SB
#undef PG8_STAGE
#undef PG8_LDA
#undef PG8_LDB
#undef PG8_MMA
#undef PG8_WAIT_V
#undef PG8_WAIT_L
#undef PG8_BAR
#undef PG8_SCHED
}
}

__host__ __device__ __forceinline__ int cmap_in(int F) { return (F & ~255) + 128 * ((F >> 5) & 1) + 32 * ((F >> 6) & 3) + (F & 31); }
struct EpiInprojMF {
    static constexpr bool PERM = true, AFTER_DRAIN = false;
    bf16_t* P; const float* rinv; const float* bias_f; const int* pos; const float* ftab; const float* qg; const float* kg;
    __device__ __forceinline__ void operator()(const pg8::f32x4 (&acc)[2][2][4][2], const pg8::Unit& u, int wr, int wc, int fr, int fq) const {
        typedef pg8::f32x4 f32x4;
        asm volatile("" : "+v"(fr), "+v"(fq));
        const int type = u.pn >> 1, head = 4 * (u.pn & 1) + wc, fb = 256 * u.pn + 64 * wc;
        const size_t PSZ = (size_t)T * 512;
        const int rslot = (type == 0) ? 0 : (type == 1) ? 1 : (type == 2) ? 6 : (type == 3) ? 2 : (type == 4) ? 3 : (type == 5) ? 4 : 7;
        bf16_t* rowmaj = P + (size_t)rslot * PSZ;
        const int t0 = u.pm * 256 + wr * 64 + fr;
        float rv[8], pf[8];
        f32x4 bv[2][2], gv[2][2], fh[2], fl[2];
#pragma unroll
        for (int ai = 0; ai < 2; ++ai)
#pragma unroll
            for (int m = 0; m < 4; ++m) rv[ai * 4 + m] = rinv[t0 + ai * 128 + m * 16];
#pragma unroll
        for (int bj = 0; bj < 2; ++bj)
#pragma unroll
            for (int n = 0; n < 2; ++n) bv[bj][n] = *(const f32x4*)(bias_f + fb + 32 * bj + 8 * fq + 4 * n);
        if (type <= 1) {
#pragma unroll
            for (int q = 0; q < 8; ++q) pf[q] = (float)pos[t0 + (q >> 2) * 128 + (q & 3) * 16];
#pragma unroll
            for (int n = 0; n < 2; ++n) { fh[n] = *(const f32x4*)(ftab + 8 * fq + 4 * n); fl[n] = *(const f32x4*)(ftab + 32 + 8 * fq + 4 * n); }
        } else if (type == 4 || type == 5) {
            const float* gsrc = (type == 4) ? qg : kg;
#pragma unroll
            for (int bj = 0; bj < 2; ++bj)
#pragma unroll
                for (int n = 0; n < 2; ++n) gv[bj][n] = *(const f32x4*)(gsrc + 32 * bj + 8 * fq + 4 * n);
        }
#pragma unroll
        for (int ai = 0; ai < 2; ++ai)
#pragma unroll
            for (int m = 0; m < 4; ++m) {
                const int t = t0 + ai * 128 + m * 16;
                const float r = rv[ai * 4 + m];
                f32x4 v[2][2];
#pragma unroll
                for (int bj = 0; bj < 2; ++bj)
#pragma unroll
                    for (int n = 0; n < 2; ++n) v[bj][n] = acc[ai][bj][m][n] * r + bv[bj][n];
                if (type <= 1) {
                    const float sc = (type == 1) ? 0.125f : 1.f, pp = pf[ai * 4 + m];
#pragma unroll
                    for (int n = 0; n < 2; ++n)
#pragma unroll
                        for (int j = 0; j < 4; ++j) {
                            const float rev = __builtin_amdgcn_fractf(__builtin_amdgcn_fractf(pp * fh[n][j]) + pp * fl[n][j]);
                            const float cs = __builtin_amdgcn_cosf(rev) * sc, sn = __builtin_amdgcn_sinf(rev) * sc;
                            const float x1 = v[0][n][j], x2 = v[1][n][j]; v[0][n][j] = x1 * cs - x2 * sn; v[1][n][j] = x2 * cs + x1 * sn;
                        }
                } else if (type == 3) {
#pragma unroll
                    for (int bj = 0; bj < 2; ++bj)
#pragma unroll
                        for (int n = 0; n < 2; ++n)
#pragma unroll
                            for (int j = 0; j < 4; ++j) { const float x = v[bj][n][j]; v[bj][n][j] = x / (1.f + __expf(-x)); }
                } else if (type == 4 || type == 5) {
                    float ss = 0.f;
#pragma unroll
                    for (int bj = 0; bj < 2; ++bj)
#pragma unroll
                        for (int n = 0; n < 2; ++n)
#pragma unroll
                            for (int j = 0; j < 4; ++j) ss += v[bj][n][j] * v[bj][n][j];
                    ss += __shfl_xor(ss, 16); ss += __shfl_xor(ss, 32);
                    const float rn = (1.0f / sqrtf(ss * (1.f / 64.f) + EPS)) * ((type == 4) ? 0.125f * 1.44269504089f : 1.f);
#pragma unroll
                    for (int bj = 0; bj < 2; ++bj)
#pragma unroll
                        for (int n = 0; n < 2; ++n) v[bj][n] = v[bj][n] * rn * gv[bj][n];
                }
#pragma unroll
                for (int bj = 0; bj < 2; ++bj) {
                    pg8::u32x4 w; w.x = pg8::cvt_pk_bf16(v[bj][0][0], v[bj][0][1]); w.y = pg8::cvt_pk_bf16(v[bj][0][2], v[bj][0][3]);
                    w.z = pg8::cvt_pk_bf16(v[bj][1][0], v[bj][1][1]); w.w = pg8::cvt_pk_bf16(v[bj][1][2], v[bj][1][3]);
                    *(pg8::u32x4*)(rowmaj + (size_t)t * 512 + head * 64 + 32 * bj + 8 * fq) = w;
                }
            }
    }
};

struct EpiOutprojMF {
    static constexpr bool PERM = false, AFTER_DRAIN = true;
    const float* x; const float* gate1; float* x1; bf16_t* x1b; float* part2;
    __device__ __forceinline__ void operator()(const pg8::f32x4 (&)[2][2][4][2], const pg8::Unit&, int, int, int, int) const {}
    __device__ __forceinline__ void fused(pg8::f32x4 (&acc)[2][2][4][2], const pg8::Unit& u, int wr, int wc, int fr, int fq, PG8_LAS unsigned char* lds, int wid, int lane) const {
        typedef pg8::f32x4 f32x4;
        asm volatile("" : "+v"(fr), "+v"(fq), "+v"(lane));
        constexpr int LD = 260;
        PG8_LAS float* TL = (PG8_LAS float*)lds;
        const int colw = wc * 32 + 4 * fq;
        f32x4 gv[2][2];
#pragma unroll
        for (int bj = 0; bj < 2; ++bj)
#pragma unroll
            for (int n = 0; n < 2; ++n) gv[bj][n] = *(const f32x4*)(gate1 + u.pn * 256 + colw + bj * 128 + n * 16);
#pragma unroll
        for (int ai = 0; ai < 2; ++ai) {
#pragma unroll
            for (int m = 0; m < 4; ++m)
#pragma unroll
                for (int bj = 0; bj < 2; ++bj)
#pragma unroll
                    for (int n = 0; n < 2; ++n) *(PG8_LAS f32x4*)(TL + (64 * wr + 16 * m + fr) * LD + colw + bj * 128 + n * 16) = gv[bj][n] * acc[ai][bj][m][n];
            __syncthreads();
            f32x4 xv[2];
            const size_t rowbase = (size_t)(u.pm * 256 + ai * 128 + 16 * wid) * D + u.pn * 256 + 4 * lane;
            xv[0] = *(const f32x4*)(x + rowbase);
#pragma unroll
            for (int r = 0; r < 16; ++r) {
                if (r < 15) xv[(r + 1) & 1] = *(const f32x4*)(x + rowbase + (size_t)(r + 1) * D);
                const f32x4 g = *(PG8_LAS f32x4*)(TL + (16 * wid + r) * LD + 4 * lane);
                const f32x4 o = xv[r & 1] + g;
                *(f32x4*)(x1 + rowbase + (size_t)r * D) = o;
                pg8::u32x2 w; w.x = pg8::cvt_pk_bf16(o[0], o[1]); w.y = pg8::cvt_pk_bf16(o[2], o[3]);
                *(pg8::u32x2*)(x1b + rowbase + (size_t)r * D) = w;
                float ss = o[0] * o[0] + o[1] * o[1] + o[2] * o[2] + o[3] * o[3];
#pragma unroll
                for (int o2 = 32; o2 > 0; o2 >>= 1) ss += __shfl_xor(ss, o2);
                if (lane < 4) part2[(size_t)(u.pm * 256 + ai * 128 + 16 * wid + r) * 16 + u.pn * 4 + lane] = (lane == 0) ? ss : 0.f;
            }
            __syncthreads();
        }
    }
};

__device__ __forceinline__ unsigned pk2(float lo, float hi) { return (unsigned)f2bf(lo) | ((unsigned)f2bf(hi) << 16); }
template <bool FOLD, bool CMAP>
__device__ __forceinline__ void transpose_item(const float* W, int K, int N, bf16_t* WT, float* scr, int item, int lane, const float* sg, const float* sm) {
    const int nblk = N / 32, kb = item / nblk, nb = item % nblk, k0 = 64 * kb, n0 = 32 * nb;
#pragma unroll 8
    for (int i = 0; i < 32; ++i) { const int kk = 2 * i + (lane >> 5); float w = W[(size_t)(k0 + kk) * N + n0 + (lane & 31)];
        if (FOLD) w *= sg[k0 + kk] * (1.f + sm[k0 + kk]);
        scr[kk * 33 + (lane & 31)] = w; }
    asm volatile("s_waitcnt lgkmcnt(0)" ::: "memory");
    const int c = lane & 7, r0 = CMAP ? cmap_in(n0) : n0;
#pragma unroll
    for (int j = 0; j < 4; ++j) { const int n = (lane >> 3) + 8 * j; const float* s = scr + (8 * c) * 33 + n;
        pg8::u32x4 o; o.x = pk2(s[0 * 33], s[1 * 33]); o.y = pk2(s[2 * 33], s[3 * 33]); o.z = pk2(s[4 * 33], s[5 * 33]); o.w = pk2(s[6 * 33], s[7 * 33]);
        *(pg8::u32x4*)(WT + (size_t)(r0 + n) * K + k0 + 8 * c) = o; }
    asm volatile("s_waitcnt lgkmcnt(0)" ::: "memory");
}
template <int NC4, class VF>
__device__ __forceinline__ void gemv_cols(unsigned char* lds, const VF vf, const float* W, const int N, const int u, float* dst, const float* add) {
    constexpr int RG = 512 / NC4;
    float (*red)[NC4 * 4] = (float (*)[NC4 * 4])lds;
    const int tid = threadIdx.x, c4 = tid % NC4, rg = tid / NC4;
    if (rg < RG) {
        float4 acc = {0.f, 0.f, 0.f, 0.f};
        for (int r = rg; r < 1024; r += RG) { const float s = vf(r); const float4 w = *(const float4*)(W + (size_t)r * N + u * NC4 * 4 + c4 * 4);
            acc.x += s * w.x; acc.y += s * w.y; acc.z += s * w.z; acc.w += s * w.w; }
        red[rg][c4 * 4 + 0] = acc.x; red[rg][c4 * 4 + 1] = acc.y; red[rg][c4 * 4 + 2] = acc.z; red[rg][c4 * 4 + 3] = acc.w;
    }
    __syncthreads();
    if (tid < NC4 * 4) { float s = 0.f; for (int i = 0; i < RG; ++i) s += red[i][tid]; dst[u * NC4 * 4 + tid] = s + (add ? add[u * NC4 * 4 + tid] : 0.f); }
    __syncthreads();
}
struct VfSilu { const float* c; __device__ __forceinline__ float operator()(int r) const { const float v = c[r]; return v / (1.f + expf(-v)); } };
struct VfVec { const float* v; __device__ __forceinline__ float operator()(int r) const { return v[r]; } };


typedef float f32x16 __attribute__((ext_vector_type(16)));
typedef pg8::bf16x8 bf16x8;
#define MFMA32(a, b, c) __builtin_amdgcn_mfma_f32_32x32x16_bf16((a), (b), (c), 0, 0, 0)
__device__ __forceinline__ bf16x8 pack_frag(const f32x16& v, int s) {
    pg8::u32x4 w;
    w.x = pg8::cvt_pk_bf16(v[8 * s + 0], v[8 * s + 1]); w.y = pg8::cvt_pk_bf16(v[8 * s + 2], v[8 * s + 3]);
    w.z = pg8::cvt_pk_bf16(v[8 * s + 4], v[8 * s + 5]); w.w = pg8::cvt_pk_bf16(v[8 * s + 6], v[8 * s + 7]);
    return __builtin_bit_cast(bf16x8, w);
}
__device__ __forceinline__ bf16x8 load_tfrag(const bf16_t* rowp, int tok) {
    const uint2 a = *(const uint2*)(rowp + tok), b = *(const uint2*)(rowp + tok + 8);
    pg8::u32x4 w; w.x = a.x; w.y = a.y; w.z = b.x; w.w = b.y;
    return __builtin_bit_cast(bf16x8, w);
}


__device__ __forceinline__ bf16x8 tr_frag(const unsigned char* a0, int rows2) {
    typedef short s16x4 __attribute__((ext_vector_type(4)));
    typedef __attribute__((address_space(3))) s16x4 lds_s16x4;
    const s16x4 lo = __builtin_amdgcn_ds_read_tr16_b64_v4i16((lds_s16x4*)a0);
    const s16x4 hi = __builtin_amdgcn_ds_read_tr16_b64_v4i16((lds_s16x4*)(a0 + rows2 * 144));
    const uint2 l2 = __builtin_bit_cast(uint2, lo), h2 = __builtin_bit_cast(uint2, hi);
    pg8::u32x4 fw; fw.x = l2.x; fw.y = l2.y; fw.z = h2.x; fw.w = h2.y;
    return __builtin_bit_cast(bf16x8, fw);
}

__device__ __forceinline__ void ins16(float (&s)[16], float x) {
#pragma unroll
    for (int i = 15; i >= 1; --i) s[i] = __builtin_amdgcn_fmed3f(s[i - 1], s[i], x);
    s[0] = fmaxf(s[0], x);
}


struct OneUnitOrder {
    pg8::StaticOrder base; int round;
    __device__ __forceinline__ bool next(int i, pg8::Unit& u) const { if (i != 0) return false; return base.next(round, u); }
    __device__ __forceinline__ void a_ready(const pg8::Unit&) const {}
    __device__ __forceinline__ void done(const pg8::Unit&) const {}
};
struct EpiTopkMF {
    static constexpr bool PERM = false, AFTER_DRAIN = true;
    const float* part2; const float* bias_q; unsigned short* ids; float* gates;
    __device__ __forceinline__ void operator()(const pg8::f32x4 (&)[2][2][4][2], const pg8::Unit&, int, int, int, int) const {}
    __device__ __forceinline__ void fused(pg8::f32x4 (&acc)[2][2][4][2], const pg8::Unit& u, int wr, int wc, int fr, int fq, PG8_LAS unsigned char* lds, int wid, int lane) const {
        typedef pg8::f32x4 f32x4;
        constexpr int SLD = 260;
        PG8_LAS float* SC = (PG8_LAS float*)lds; PG8_LAS float* MG = (PG8_LAS float*)(lds + 128 * SLD * 4);
        const int tid = wid * 64 + lane, tok = tid & 255, hk = tid >> 8;
        float rinv[2][4];
#pragma unroll
        for (int ai = 0; ai < 2; ++ai)
#pragma unroll
            for (int m = 0; m < 4; ++m) {
                const int row = u.pm * 256 + ai * 128 + wr * 64 + m * 16 + fr;
                const f32x4* pp = (const f32x4*)(part2 + (size_t)row * 16);
                const f32x4 p0 = pp[0], p1 = pp[1], p2 = pp[2], p3 = pp[3];
                const float ssum = ((p0[0] + p0[1]) + (p0[2] + p0[3])) + ((p1[0] + p1[1]) + (p1[2] + p1[3])) + ((p2[0] + p2[1]) + (p2[2] + p2[3])) + ((p3[0] + p3[1]) + (p3[2] + p3[3]));
                rinv[ai][m] = 1.0f / sqrtf(ssum * (1.0f / D) + EPS);
            }
        float sl[16], mine[16];
#pragma unroll
        for (int p = 0; p < 2; ++p) {
            f32x4 bv[2];
#pragma unroll
            for (int n = 0; n < 2; ++n) bv[n] = *(const f32x4*)(bias_q + u.pn * 256 + p * 128 + wc * 32 + n * 16 + 4 * fq);
#pragma unroll
            for (int ai = 0; ai < 2; ++ai)
#pragma unroll
                for (int m = 0; m < 4; ++m)
#pragma unroll
                    for (int n = 0; n < 2; ++n)
#pragma unroll
                        for (int j = 0; j < 4; ++j)
                            SC[(32 * wc + 16 * n + 4 * fq + j) * SLD + (128 * ai + 64 * wr + 16 * m + fr)] = acc[ai][p][m][n][j] * rinv[ai][m] + bv[n][j];
            __syncthreads();
#pragma unroll
            for (int i = 0; i < 16; ++i) sl[i] = -INFINITY;
#pragma unroll 8
            for (int k = 0; k < 64; ++k) { const int key = 64 * hk + k; const float x = SC[key * SLD + tok]; ins16(sl, __uint_as_float((__float_as_uint(x) & 0xFFFFFF80u) | (unsigned)key)); }
            if (hk != p) {
#pragma unroll
                for (int i = 0; i < 16; ++i) MG[i * 256 + tok] = sl[i];
            }
            __syncthreads();
            if (hk == p) {
#pragma unroll
                for (int i = 0; i < 16; ++i) ins16(sl, MG[i * 256 + tok]);
#pragma unroll
                for (int i = 0; i < 16; ++i) mine[i] = sl[i];
            }
            __syncthreads();
        }
        PG8_LAS float* X1 = SC; PG8_LAS float* TL = SC + 4096; PG8_LAS unsigned* I0 = (PG8_LAS unsigned*)(SC + 8192); PG8_LAS unsigned* I1 = (PG8_LAS unsigned*)(SC + 12288);
        if (hk) {
#pragma unroll
            for (int i = 0; i < 16; ++i) { X1[i * 256 + tok] = mine[i]; I1[i * 256 + tok] = __float_as_uint(mine[i]) & 0x7Fu; }
        } else {
#pragma unroll
            for (int i = 0; i < 16; ++i) I0[i * 256 + tok] = __float_as_uint(mine[i]) & 0x7Fu;
        }
        __syncthreads();
        if (!hk) {
            float s1m[16], tl[16];
#pragma unroll
            for (int i = 0; i < 16; ++i) { s1m[i] = __uint_as_float(__float_as_uint(X1[i * 256 + tok]) & 0xFFFFFF80u); mine[i] = __uint_as_float(__float_as_uint(mine[i]) & 0xFFFFFF80u); tl[i] = -INFINITY; }
#pragma unroll
            for (int a2 = 0; a2 < 16; ++a2)
#pragma unroll
                for (int b2 = 0; b2 < 16; ++b2)
                    if ((a2 + 1) * (b2 + 1) <= 16) ins16(tl, __uint_as_float((__float_as_uint(mine[a2] + s1m[b2]) & 0xFFFFFF00u) | (unsigned)(a2 * 16 + b2)));
#pragma unroll
            for (int i = 0; i < 16; ++i) TL[i * 256 + tok] = tl[i];
        }
        __syncthreads();
        if (hk) {
            float ev[16]; float sum = 0.f; unsigned cd[16];
#pragma unroll
            for (int j = 0; j < 16; ++j) { const unsigned bits = __float_as_uint(TL[j * 256 + tok]); cd[j] = bits & 0xFFu; ev[j] = __uint_as_float(bits & 0xFFFFFF00u); }
            const float mx = ev[0];
#pragma unroll
            for (int j = 0; j < 16; ++j) { ev[j] = __expf(ev[j] - mx); sum += ev[j]; }
            const float inv = 1.f / sum;
            unsigned idw[8];
#pragma unroll
            for (int j = 0; j < 16; ++j) {
                const unsigned id = I0[(cd[j] >> 4) * 256 + tok] * 128u + I1[(cd[j] & 15u) * 256 + tok];
                if (j & 1) idw[j >> 1] |= id << 16; else idw[j >> 1] = id;
                ev[j] *= inv;
            }
            const size_t t = (size_t)u.pm * 256 + tok;
            unsigned short* idp = ids + t * 128 + u.pn * 16; float* gp = gates + t * 128 + u.pn * 16;
            *(uint4*)idp = make_uint4(idw[0], idw[1], idw[2], idw[3]); *(uint4*)(idp + 8) = make_uint4(idw[4], idw[5], idw[6], idw[7]);
#pragma unroll
            for (int q = 0; q < 4; ++q) *(float4*)(gp + 4 * q) = make_float4(ev[4 * q], ev[4 * q + 1], ev[4 * q + 2], ev[4 * q + 3]);
        }
        __syncthreads();
    }
};


__device__ __forceinline__ void convert_tables(const float* down, const float* up, unsigned char* q8, unsigned char* qexp, int lane, int cw, int nconv, int r0, int r1) {
    for (int row0 = r0 + cw * 2; row0 < r1; row0 += nconv * 2) {
        float4 v[2][4]; float mx[2] = {0.f, 0.f};
#pragma unroll
        for (int rr = 0; rr < 2; ++rr) {
            const int row = row0 + rr, isup = row >> 14, e = row & 16383;
            const float* sp = (isup ? up : down) + (size_t)e * 1024 + lane * 4;
#pragma unroll
            for (int q = 0; q < 4; ++q) v[rr][q] = ld_nt4(sp + 256 * q);
        }
#pragma unroll
        for (int rr = 0; rr < 2; ++rr) {
#pragma unroll
            for (int q = 0; q < 4; ++q) mx[rr] = fmaxf(mx[rr], fmaxf(fmaxf(fabsf(v[rr][q].x), fabsf(v[rr][q].y)), fmaxf(fabsf(v[rr][q].z), fabsf(v[rr][q].w))));
#pragma unroll
            for (int o = 32; o > 0; o >>= 1) mx[rr] = fmaxf(mx[rr], __shfl_xor(mx[rr], o));
            const int row = row0 + rr, isup = row >> 14, e = row & 16383;
            const float s = (mx[rr] > 0.f) ? exp2f(floorf(log2f(256.f / mx[rr]))) : 1.f;
#pragma unroll
            for (int q = 0; q < 4; ++q) {
                int pk = __builtin_amdgcn_cvt_pk_fp8_f32(v[rr][q].x * s, v[rr][q].y * s, 0, false); pk = __builtin_amdgcn_cvt_pk_fp8_f32(v[rr][q].z * s, v[rr][q].w * s, pk, true);
                *(unsigned*)(q8 + (size_t)isup * (16u << 20) + ((size_t)(2 * q + (lane >> 5)) * 16384 + e) * 128 + (lane & 7) * 16 + ((lane & 31) >> 3) * 4) = (unsigned)pk;
            }
            if (lane == 0) qexp[row] = (unsigned char)((__float_as_uint(1.0f / s) >> 23) & 0xffu);
        }
    }
}

struct Params {
    const float *x, *c; const int* pos; const float *ada_w, *ada_b, *g1, *g2, *w_in, *rgain, *qg, *kg, *og, *w_out, *wq, *sk, *down, *up;
    float* out; unsigned char* ws; RopeC rc;
};

__global__ void __launch_bounds__(512) mk_fwd(Params p) {
    extern __shared__ __attribute__((aligned(16))) unsigned char lds[];
    const int tid = threadIdx.x, lane = tid & 63, wave = tid >> 6, bid = blockIdx.x, G = gridDim.x;
    unsigned char* ws = p.ws;
    float* mod = (float*)(ws + OFF_MOD); float* rinv1 = (float*)(ws + OFF_RINV1); float* ftab = (float*)(ws + OFF_ROPE);
    bf16_t* P = (bf16_t*)(ws + OFF_P); float* kv = (float*)(ws + OFF_KV); bf16_t* stT = (bf16_t*)(ws + OFF_ST); bf16_t* ycat = (bf16_t*)(ws + OFF_YCAT);
    bf16_t* xb = (bf16_t*)(ws + OFF_XB); bf16_t* Win_t = (bf16_t*)(ws + OFF_WINT); float* bias_f = (float*)(ws + OFF_BIASF);
    bf16_t* Weff_t = (bf16_t*)(ws + OFF_WEFFT); bf16_t* Wout_t = (bf16_t*)(ws + OFF_WOUTT); float* bias_q = (float*)(ws + OFF_BIASQ); float* bq_part = (float*)(ws + OFF_BQPART);
    float* part2 = (float*)(ws + OFF_PART2); bf16_t* x1b = (bf16_t*)(ws + OFF_X1B); unsigned short* ids = (unsigned short*)(ws + OFF_IDS); unsigned char* q8 = ws + OFF_Q8; unsigned char* qexp = ws + OFF_QSC; float* gates = (float*)(ws + OFF_GATES);
    const size_t PS = (size_t)T * 512;
    const bf16_t *Qr = P, *Kr = P + PS, *Gr = P + 2 * PS, *Qs = P + 3 * PS, *Ks = P + 4 * PS, *Vr = P + 6 * PS, *Vs = P + 7 * PS;
    float* out = p.out; float* x1 = (float*)(ws + OFF_X1);

    if (tid < 4) ((LAS unsigned*)((LAS unsigned char*)lds + LDS_ST_OFF))[tid] = 0u;
    __syncthreads();
    XcdBarrier bar = xcd_barrier_post((unsigned*)(ws + OFF_CTL), (volatile LAS unsigned*)((LAS unsigned char*)lds + LDS_ST_OFF));

    for (int u = bid; u < 256; u += G) gemv_cols<6>(lds, VfSilu{p.c}, p.ada_w, 6144, u, mod, p.ada_b);
    for (int row0 = (bid * 8 + wave) * 2; row0 < T; row0 += G * 16) {
        float4 v[2][4];
#pragma unroll
        for (int rr = 0; rr < 2; ++rr)
#pragma unroll
            for (int j = 0; j < 4; ++j) v[rr][j] = ld_nt4(p.x + (size_t)(row0 + rr) * D + (lane + 64 * j) * 4);
#pragma unroll
        for (int rr = 0; rr < 2; ++rr) {
            uint2* xo = (uint2*)(xb + (size_t)(row0 + rr) * D);
            float s = 0.f;
#pragma unroll
            for (int j = 0; j < 4; ++j) { const float4 q = v[rr][j]; s += q.x * q.x + q.y * q.y + q.z * q.z + q.w * q.w; xo[lane + 64 * j] = make_uint2(pk2(q.x, q.y), pk2(q.z, q.w)); }
#pragma unroll
            for (int o = 32; o > 0; o >>= 1) s += __shfl_xor(s, o);
            if (lane == 0) rinv1[row0 + rr] = 1.0f / sqrtf(s * (1.0f / D) + EPS);
        }
    }
    if (bid == 0 && tid == 0) {
#pragma unroll
        for (int i = 0; i < 32; ++i) { ftab[i] = p.rc.fh[i]; ftab[32 + i] = p.rc.fl[i]; }
    }
    xcd_barrier(bar);

    {
        float* scr = (float*)(lds + wave * 16384);
        for (int it = bid * 8 + wave; it < 16 * 112; it += G * 8) transpose_item<true, true>(p.w_in, 1024, 3584, Win_t, scr, it, lane, p.g1, mod + 1024);
        __syncthreads();
        for (int u = bid; u < 128; u += G) gemv_cols<7>(lds, VfVec{mod}, p.w_in, 3584, u, bias_f, nullptr);
    }
    xcd_barrier(bar);

    {
        pg8::Gemm g{xb, Win_t, T, 3584, 1024}; pg8::StaticOrder S; S.init(T, 3584, G, bid);
        EpiInprojMF E{P, rinv1, bias_f, p.pos, ftab, p.qg, p.kg};
        pg8::gemm_phase<EpiInprojMF, pg8::StaticOrder>((PG8_LAS unsigned char*)lds, g, S, E);
        const int nidle = (G > 128) ? G - 128 : G, ib = (G > 128) ? bid - 128 : bid;
        {
            float* scr = (float*)(lds + wave * 16384);
            if (ib >= 0) for (int it = ib * 8 + wave; it < 16 * 32; it += nidle * 8) transpose_item<false, false>(p.w_out, 1024, 1024, Wout_t, scr, it, lane, nullptr, nullptr);
            __syncthreads();
        }
        if (ib >= 0 && ib < 128) {
            const int hp = ib >> 3, blk = ib & 7;
            float* skT = (float*)lds; float* wqs = (float*)(lds + 65536);
            for (int e = tid; e < 16384; e += 512) { const int k = e >> 7, c = e & 127; skT[c * 128 + k] = p.sk[((size_t)hp * 128 + k) * 128 + c]; }
            float bacc[16];
#pragma unroll
            for (int j = 0; j < 16; ++j) bacc[j] = 0.f;
            for (int rbk = 0; rbk < 2; ++rbk) {
                const int i0 = (blk * 2 + rbk) * 64;
                __syncthreads();
                for (int e = tid; e < 8192; e += 512) { const int r = e >> 7, c = e & 127; wqs[r * 129 + c] = p.wq[(size_t)(i0 + r) * 2048 + hp * 128 + c]; }
                __syncthreads();
                float acc[16];
#pragma unroll
                for (int j = 0; j < 16; ++j) acc[j] = 0.f;
                const float* wrow = wqs + lane * 129; const float* skc = skT + 16 * wave;
#pragma unroll 4
                for (int c = 0; c < 128; ++c) {
                    const float av = wrow[c];
                    const float4 b0 = *(const float4*)(skc + c * 128), b1 = *(const float4*)(skc + c * 128 + 4), b2 = *(const float4*)(skc + c * 128 + 8), b3 = *(const float4*)(skc + c * 128 + 12);
                    acc[0] += av * b0.x; acc[1] += av * b0.y; acc[2] += av * b0.z; acc[3] += av * b0.w; acc[4] += av * b1.x; acc[5] += av * b1.y; acc[6] += av * b1.z; acc[7] += av * b1.w;
                    acc[8] += av * b2.x; acc[9] += av * b2.y; acc[10] += av * b2.z; acc[11] += av * b2.w; acc[12] += av * b3.x; acc[13] += av * b3.y; acc[14] += av * b3.z; acc[15] += av * b3.w;
                }
                const int i = i0 + lane;
                const float s2v = p.g2[i] * (1.f + mod[4096 + i]), sh = mod[3072 + i];
#pragma unroll
                for (int j = 0; j < 16; ++j) { Weff_t[(size_t)(hp * 128 + 16 * wave + j) * 1024 + i] = f2bf(acc[j] * s2v); bacc[j] += sh * acc[j]; }
            }
#pragma unroll
            for (int j = 0; j < 16; ++j) { float v = bacc[j];
#pragma unroll
                for (int o = 32; o > 0; o >>= 1) v += __shfl_xor(v, o);
                if (lane == 0) bq_part[(size_t)blk * 2048 + hp * 128 + 16 * wave + j] = v; }
            __syncthreads();
        }
        if (ib >= 0) convert_tables(p.down, p.up, q8, qexp, lane, ib * 8 + wave, nidle * 8, 0, CONV_SPLIT);
    }
    xcd_barrier(bar);

    {
        const int gw = __builtin_amdgcn_readfirstlane(bid * 8 + wave), NGW = G * 8, l31 = lane & 31, hf = lane >> 5;
        const int wv0 = __builtin_amdgcn_readfirstlane(wave);
        for (int U = gw; U < 1024; U += NGW) {
            const int n = U >> 3, h = U & 7;
            f32x16 C[2][2];
#pragma unroll
            for (int a = 0; a < 2; ++a)
#pragma unroll
                for (int b = 0; b < 2; ++b)
#pragma unroll
                    for (int r = 0; r < 16; ++r) C[a][b][r] = 0.f;
            unsigned char* Kt = lds + wv0 * 9216; unsigned char* Vt = Kt + 4608;
            const int r8 = lane >> 3, pc = lane & 7, trq = (lane & 15) >> 2, trp = lane & 3, trd = (lane >> 4) & 1;
            const char* kbase = (const char*)(Kr + (size_t)n * 128 * 512 + h * 64); const char* vbase = (const char*)(Vr + (size_t)n * 128 * 512 + h * 64);
            const unsigned loff = (unsigned)(r8 * 512 + pc * 8) * 2u;
            const float lg = lg2_head(h);
            pg8::u32x4 gK[4], gV[4];
#pragma unroll
            for (int i = 0; i < 4; ++i) { gK[i] = *(const pg8::u32x4*)(kbase + (loff + i * 8192u)); gV[i] = *(const pg8::u32x4*)(vbase + (loff + i * 8192u)); }
            for (int sb4 = 0; sb4 < 4; ++sb4) {
#pragma unroll
                for (int i = 0; i < 4; ++i) { *(pg8::u32x4*)(Kt + (8 * i + r8) * 144 + pc * 16) = gK[i]; *(pg8::u32x4*)(Vt + (8 * i + r8) * 144 + pc * 16) = gV[i]; }
                { const int sn = (sb4 < 3) ? sb4 + 1 : sb4;
#pragma unroll
                  for (int i = 0; i < 4; ++i) { gK[i] = *(const pg8::u32x4*)(kbase + (size_t)sn * 32768 + (loff + i * 8192u)); gV[i] = *(const pg8::u32x4*)(vbase + (size_t)sn * 32768 + (loff + i * 8192u)); } }
#pragma unroll
                for (int s = 0; s < 2; ++s) {
                    bf16x8 Af[2], Bf[2];
#pragma unroll
                    for (int a = 0; a < 2; ++a) {
                        Af[a] = tr_frag(Vt + (16 * s + 8 * hf + trq) * 144 + (32 * a + 16 * trd + 4 * trp) * 2, 4);
                        const bf16x8 kraw = tr_frag(Kt + (16 * s + 8 * hf + trq) * 144 + (32 * a + 16 * trd + 4 * trp) * 2, 4);
                        const pg8::u32x4 kw = __builtin_bit_cast(pg8::u32x4, kraw); const unsigned kk[4] = {kw.x, kw.y, kw.z, kw.w};
                        pg8::u32x4 o; unsigned* op = (unsigned*)&o;
#pragma unroll
                        for (int e2 = 0; e2 < 4; ++e2) {
                            const int j0 = 32 * sb4 + 16 * s + 8 * hf + 2 * e2;
                            const float z0 = __builtin_amdgcn_exp2f((float)(127 - j0) * lg), z1 = __builtin_amdgcn_exp2f((float)(126 - j0) * lg);
                            op[e2] = pg8::cvt_pk_bf16(__uint_as_float(kk[e2] << 16) * z0, __uint_as_float(kk[e2] & 0xffff0000u) * z1);
                        }
                        Bf[a] = __builtin_bit_cast(bf16x8, o);
                    }
#pragma unroll
                    for (int a = 0; a < 2; ++a)
#pragma unroll
                        for (int b = 0; b < 2; ++b) C[a][b] = MFMA32(Af[a], Bf[b], C[a][b]);
                }
            }
            float* dst = kv + (size_t)(n * 8 + h) * 4096;
#pragma unroll
            for (int a = 0; a < 2; ++a)
#pragma unroll
                for (int b = 0; b < 2; ++b)
#pragma unroll
                    for (int r = 0; r < 16; ++r) dst[(32 * a + (r & 3) + 8 * (r >> 2) + 4 * hf) * 64 + 32 * b + l31] = C[a][b][r];
        }
        bf16x8 Tri[2];
        {
            pg8::u32x4 w0, w1; unsigned* p0 = (unsigned*)&w0; unsigned* p1 = (unsigned*)&w1;
#pragma unroll
            for (int e2 = 0; e2 < 4; ++e2) {
                unsigned a0 = 0, a1 = 0;
#pragma unroll
                for (int q = 0; q < 2; ++q) { const int e = 2 * e2 + q, ip = 8 * (e >> 2) + 4 * hf + (e & 3);
                    a0 |= ((ip > l31) ? 0x3F80u : 0u) << (16 * q); a1 |= ((16 + ip > l31) ? 0x3F80u : 0u) << (16 * q); }
                p0[e2] = a0; p1[e2] = a1;
            }
            Tri[0] = __builtin_bit_cast(bf16x8, w0); Tri[1] = __builtin_bit_cast(bf16x8, w1);
        }
        const bool sb_local = (G % 8 == 0) && (4096 % G == 0) && ((4096 / G) % 8 == 0);
        const int sb_per_wave = sb_local ? 4096 / G / 8 : (4096 + NGW - 1 - gw) / NGW;
        const int wv = __builtin_amdgcn_readfirstlane(wave);
        for (int ps = 0; ps < sb_per_wave; ++ps) {
            const int U = sb_local ? 0 : gw + ps * NGW;
            const int h = sb_local ? (bid & 7) : (U & 7), qt = sb_local ? (bid >> 3) * (4096 / G) + ps * 8 + wv : (U >> 3), q0 = qt * 32;
            f32x16 O[2];
#pragma unroll
            for (int r = 0; r < 16; ++r) { O[0][r] = 0.f; O[1][r] = 0.f; }
            float carry = 0.f;
            unsigned char* Kt = lds + wv * 9216; unsigned char* Vt = Kt + 4608;
            const int r8 = lane >> 3, pc = lane & 7;
            const char* kbase = (const char*)(Ks + h * 64); const char* vbase = (const char*)(Vs + h * 64);
            const unsigned loff = (unsigned)(r8 * 512 + pc * 8) * 2u;
            pg8::u32x4 gK[4], gV[4];
            bf16x8 Qf[4];
            {
                const char* qbase = (const char*)(Qs + h * 64);
#pragma unroll
                for (int i = 0; i < 4; ++i) gK[i] = *(const pg8::u32x4*)(qbase + (size_t)qt * 32768 + (loff + i * 8192u));
#pragma unroll
                for (int i = 0; i < 4; ++i) *(pg8::u32x4*)(Kt + (8 * i + r8) * 144 + pc * 16) = gK[i];
#pragma unroll
                for (int s = 0; s < 4; ++s) Qf[s] = *(const bf16x8*)(Kt + l31 * 144 + 32 * s + 16 * hf);
            }
#pragma unroll
            for (int i = 0; i < 4; ++i) { gK[i] = *(const pg8::u32x4*)(kbase + (size_t)qt * 32768 + (loff + i * 8192u)); gV[i] = *(const pg8::u32x4*)(vbase + (size_t)qt * 32768 + (loff + i * 8192u)); }
            const int trq = (lane & 15) >> 2, trp = lane & 3, trd = (lane >> 4) & 1;
            for (int kb = qt; kb >= 0; --kb) {
#pragma unroll
                for (int i = 0; i < 4; ++i) { *(pg8::u32x4*)(Kt + (8 * i + r8) * 144 + pc * 16) = gK[i]; *(pg8::u32x4*)(Vt + (8 * i + r8) * 144 + pc * 16) = gV[i]; }
                {
                    const int kbn = (kb > 0) ? kb - 1 : 0;
#pragma unroll
                    for (int i = 0; i < 4; ++i) { gK[i] = *(const pg8::u32x4*)(kbase + (size_t)kbn * 32768 + (loff + i * 8192u)); gV[i] = *(const pg8::u32x4*)(vbase + (size_t)kbn * 32768 + (loff + i * 8192u)); }
                }
                bf16x8 Kf[4], Vf[2][2];
#pragma unroll
                for (int s = 0; s < 4; ++s) Kf[s] = *(const bf16x8*)(Kt + l31 * 144 + 32 * s + 16 * hf);
#pragma unroll
                for (int s = 0; s < 2; ++s)
#pragma unroll
                    for (int dt = 0; dt < 2; ++dt) {
                        Vf[s][dt] = tr_frag(Vt + (16 * s + 4 * hf + trq) * 144 + (32 * dt + 16 * trd + 4 * trp) * 2, 8);
                    }
                f32x16 S;
#pragma unroll
                for (int r = 0; r < 16; ++r) S[r] = 0.f;
#pragma unroll
                for (int s = 0; s < 4; ++s) S = MFMA32(Kf[s], Qf[s], S);
                const bool diag = (kb == qt);
                f32x16 sp, lb;
                float csum = 0.f;
                if (diag) {
#pragma unroll
                    for (int r = 0; r < 16; ++r) {
                        const int i = (r & 3) + 8 * (r >> 2) + 4 * hf;
                        const float z = S[r];
                        const float l1p = __builtin_amdgcn_logf(1.0f + __builtin_amdgcn_exp2f(-fabsf(z)));
                        const float spv = (i < l31) ? (fmaxf(z, 0.f) + l1p) : 0.f;
                        sp[r] = spv; lb[r] = (i < l31) ? (fminf(z, 0.f) - l1p) : -INFINITY; csum += spv;
                    }
                } else {
#pragma unroll
                    for (int r = 0; r < 16; ++r) {
                        const float z = S[r];
                        const float l1p = __builtin_amdgcn_logf(1.0f + __builtin_amdgcn_exp2f(-fabsf(z)));
                        const float spv = fmaxf(z, 0.f) + l1p;
                        sp[r] = spv; lb[r] = fminf(z, 0.f) - l1p; csum += spv;
                    }
                }
                f32x16 Rt;
#pragma unroll
                for (int r = 0; r < 16; ++r) Rt[r] = carry;
#pragma unroll
                for (int s = 0; s < 2; ++s) Rt = MFMA32(Tri[s], pack_frag(sp, s), Rt);
                f32x16 wv;
#pragma unroll
                for (int r = 0; r < 16; ++r) wv[r] = __builtin_amdgcn_exp2f(lb[r] - Rt[r]);
#pragma unroll
                for (int s = 0; s < 2; ++s) { const bf16x8 wp = pack_frag(wv, s);
#pragma unroll
                    for (int dt = 0; dt < 2; ++dt) O[dt] = MFMA32(Vf[s][dt], wp, O[dt]); }
                csum += __shfl_xor(csum, 32);
                carry += csum;
                if (__all(carry > 127.f)) break;
            }
            float ss = 0.f;
#pragma unroll
            for (int r = 0; r < 16; ++r) ss += O[0][r] * O[0][r] + O[1][r] * O[1][r];
            ss += __shfl_xor(ss, 32);
            const float rn = 1.0f / sqrtf(ss * (1.f / 64.f) + EPS);
#pragma unroll
            for (int dt = 0; dt < 2; ++dt)
#pragma unroll
                for (int g4 = 0; g4 < 4; ++g4) {
                    const int d = 32 * dt + 8 * g4 + 4 * hf;
                    const float4 gn = *(const float4*)(p.og + d);
                    uint2 w; w.x = pg8::cvt_pk_bf16(O[dt][4 * g4] * rn * gn.x, O[dt][4 * g4 + 1] * rn * gn.y); w.y = pg8::cvt_pk_bf16(O[dt][4 * g4 + 2] * rn * gn.z, O[dt][4 * g4 + 3] * rn * gn.w);
                    *(uint2*)(Kt + l31 * 144 + d * 2) = w;
                }
#pragma unroll
            for (int i = 0; i < 4; ++i) *(pg8::u32x4*)(ycat + (size_t)(q0 + 8 * i + r8) * 1024 + 512 + h * 64 + pc * 8) = *(const pg8::u32x4*)(Kt + (8 * i + r8) * 144 + pc * 16);
        }
    }
    xcd_barrier(bar);

    if (bid == 255 % G) for (int n = tid; n < 2048; n += 512) { float s = 0.f;
#pragma unroll
        for (int b8 = 0; b8 < 8; ++b8) s += bq_part[(size_t)b8 * 2048 + n];
        bias_q[n] = s; }
    if (G > 64 && bid >= 64) convert_tables(p.down, p.up, q8, qexp, lane, (bid - 64) * 8 + wave, (G - 64) * 8, CONV_SPLIT, 32768);
    else if (G <= 64) convert_tables(p.down, p.up, q8, qexp, lane, bid * 8 + wave, G * 8, CONV_SPLIT, 32768);
    for (int idx = bid * 512 + tid; idx < 32768; idx += G * 512) {
        const int h = idx >> 12;
        const float cd = exp2f(128.f * lg2_head(h));
        float s = 0.f;
        for (int n0 = 0; n0 < 128; n0 += 32) {
            float kvv[32];
#pragma unroll
            for (int q = 0; q < 32; ++q) kvv[q] = kv[(size_t)(n0 + q) * 32768 + idx];
#pragma unroll
            for (int q = 0; q < 32; ++q) { stT[(size_t)(n0 + q) * 32768 + idx] = f2bf(s); s = cd * s + kvv[q]; }
        }
    }
    xcd_barrier(bar);

    {
        const int gw = __builtin_amdgcn_readfirstlane(bid * 8 + wave), NGW = G * 8, l31 = lane & 31, hf = lane >> 5;
        const int wv4 = __builtin_amdgcn_readfirstlane(wave);
        for (int W2 = gw; W2 < 2048; W2 += NGW) {
            const int nh = W2 >> 1, n = nh >> 3, h = nh & 7;
            const float lg = lg2_head(h);
#pragma unroll 1
            for (int pass = 0; pass < 2; ++pass) {
                const int qt = (W2 & 1) ? (pass ? 2 : 1) : (pass ? 3 : 0);
                const int il = qt * 32 + l31, tq = n * 128 + il;
                unsigned char* Kt = lds + wv4 * 9216; unsigned char* Vt = Kt + 4608;
                const int r8 = lane >> 3, pc = lane & 7, trq = (lane & 15) >> 2, trp = lane & 3, trd = (lane >> 4) & 1;
                const unsigned loff = (unsigned)(r8 * 512 + pc * 8) * 2u;
                pg8::u32x4 gK[4], gV[4];
                bf16x8 Qf[4];
                {
                    const char* qbase = (const char*)(Qr + (size_t)(n * 128 + qt * 32) * 512 + h * 64);
                    const char* sbase = (const char*)(stT + (size_t)nh * 4096) + (unsigned)(r8 * 64 + pc * 8) * 2u;
#pragma unroll
                    for (int i = 0; i < 4; ++i) gK[i] = *(const pg8::u32x4*)(qbase + (loff + i * 8192u));
#pragma unroll
                    for (int i = 0; i < 4; ++i) *(pg8::u32x4*)(Kt + (8 * i + r8) * 144 + pc * 16) = gK[i];
#pragma unroll
                    for (int s = 0; s < 4; ++s) Qf[s] = *(const bf16x8*)(Kt + l31 * 144 + 32 * s + 16 * hf);
#pragma unroll
                    for (int i = 0; i < 4; ++i) { gK[i] = *(const pg8::u32x4*)(sbase + i * 1024u); gV[i] = *(const pg8::u32x4*)(sbase + 4096u + i * 1024u); }
#pragma unroll
                    for (int i = 0; i < 4; ++i) { *(pg8::u32x4*)(Kt + (8 * i + r8) * 144 + pc * 16) = gK[i]; *(pg8::u32x4*)(Kt + (32 + 8 * i + r8) * 144 + pc * 16) = gV[i]; }
                }
                f32x16 O[2];
#pragma unroll
                for (int r = 0; r < 16; ++r) { O[0][r] = 0.f; O[1][r] = 0.f; }
#pragma unroll
                for (int s = 0; s < 4; ++s)
#pragma unroll
                    for (int dt = 0; dt < 2; ++dt) O[dt] = MFMA32(*(const bf16x8*)(Kt + (32 * dt + l31) * 144 + 32 * s + 16 * hf), Qf[s], O[dt]);
                const float xi = exp2f((float)(il + 1) * lg);
#pragma unroll
                for (int r = 0; r < 16; ++r) { O[0][r] *= xi; O[1][r] *= xi; }
                const char* kbase = (const char*)(Kr + (size_t)n * 128 * 512 + h * 64); const char* vbase = (const char*)(Vr + (size_t)n * 128 * 512 + h * 64);
#pragma unroll
                for (int i = 0; i < 4; ++i) { gK[i] = *(const pg8::u32x4*)(kbase + (loff + i * 8192u)); gV[i] = *(const pg8::u32x4*)(vbase + (loff + i * 8192u)); }
                for (int jb = 0; jb <= qt; ++jb) {
#pragma unroll
                    for (int i = 0; i < 4; ++i) { *(pg8::u32x4*)(Kt + (8 * i + r8) * 144 + pc * 16) = gK[i]; *(pg8::u32x4*)(Vt + (8 * i + r8) * 144 + pc * 16) = gV[i]; }
                    { const int jn = (jb < qt) ? jb + 1 : jb;
#pragma unroll
                      for (int i = 0; i < 4; ++i) { gK[i] = *(const pg8::u32x4*)(kbase + (size_t)jn * 32768 + (loff + i * 8192u)); gV[i] = *(const pg8::u32x4*)(vbase + (size_t)jn * 32768 + (loff + i * 8192u)); } }
                    bf16x8 Kf[4], Vf[2][2];
#pragma unroll
                    for (int s = 0; s < 4; ++s) Kf[s] = *(const bf16x8*)(Kt + l31 * 144 + 32 * s + 16 * hf);
#pragma unroll
                    for (int s = 0; s < 2; ++s)
#pragma unroll
                        for (int dt = 0; dt < 2; ++dt) Vf[s][dt] = tr_frag(Vt + (16 * s + 4 * hf + trq) * 144 + (32 * dt + 16 * trd + 4 * trp) * 2, 8);
                    f32x16 S;
#pragma unroll
                    for (int r = 0; r < 16; ++r) S[r] = 0.f;
#pragma unroll
                    for (int s = 0; s < 4; ++s) S = MFMA32(Kf[s], Qf[s], S);
#pragma unroll
                    for (int r = 0; r < 16; ++r) {
                        const int jl = jb * 32 + (r & 3) + 8 * (r >> 2) + 4 * hf, dl = il - jl;
                        S[r] = (dl >= 0) ? S[r] * __builtin_amdgcn_exp2f((float)dl * lg) : 0.f;
                    }
#pragma unroll
                    for (int s = 0; s < 2; ++s) { const bf16x8 wp = pack_frag(S, s);
#pragma unroll
                        for (int dt = 0; dt < 2; ++dt) O[dt] = MFMA32(Vf[s][dt], wp, O[dt]); }
                }
                float sm = 0.f;
#pragma unroll
                for (int r = 0; r < 16; ++r) sm += O[0][r] + O[1][r];
                sm += __shfl_xor(sm, 32);
                const float mean = sm * (1.f / 64.f);
                float vs = 0.f;
#pragma unroll
                for (int r = 0; r < 16; ++r) { const float d0 = O[0][r] - mean, d1 = O[1][r] - mean; vs += d0 * d0 + d1 * d1; }
                vs += __shfl_xor(vs, 32);
                const float rstd = 1.0f / sqrtf(vs * (1.f / 64.f) + EPS);
                {
                    const char* gbase = (const char*)(Gr + (size_t)(n * 128 + qt * 32) * 512 + h * 64);
#pragma unroll
                    for (int i = 0; i < 4; ++i) gV[i] = *(const pg8::u32x4*)(gbase + (loff + i * 8192u));
#pragma unroll
                    for (int i = 0; i < 4; ++i) *(pg8::u32x4*)(Vt + (8 * i + r8) * 144 + pc * 16) = gV[i];
                }
#pragma unroll
                for (int dt = 0; dt < 2; ++dt)
#pragma unroll
                    for (int g4 = 0; g4 < 4; ++g4) {
                        const int e = 32 * dt + 8 * g4 + 4 * hf;
                        const float4 gn = *(const float4*)(p.rgain + h * 64 + e);
                        const uint2 gg = *(const uint2*)(Vt + l31 * 144 + e * 2);
                        const float g0 = __uint_as_float(gg.x << 16), g1 = __uint_as_float(gg.x & 0xffff0000u), g2v = __uint_as_float(gg.y << 16), g3 = __uint_as_float(gg.y & 0xffff0000u);
                        uint2 w;
                        w.x = pg8::cvt_pk_bf16((O[dt][4 * g4] - mean) * rstd * gn.x * g0, (O[dt][4 * g4 + 1] - mean) * rstd * gn.y * g1);
                        w.y = pg8::cvt_pk_bf16((O[dt][4 * g4 + 2] - mean) * rstd * gn.z * g2v, (O[dt][4 * g4 + 3] - mean) * rstd * gn.w * g3);
                        *(uint2*)(Kt + l31 * 144 + e * 2) = w;
                    }
#pragma unroll
                for (int i = 0; i < 4; ++i) *(pg8::u32x4*)(ycat + (size_t)(n * 128 + qt * 32 + 8 * i + r8) * 1024 + h * 64 + pc * 8) = *(const pg8::u32x4*)(Kt + (8 * i + r8) * 144 + pc * 16);
            }
        }
    }
    xcd_barrier(bar);

    {
        pg8::Gemm g{ycat, Wout_t, T, 1024, 1024}; pg8::StaticOrder S; S.init(T, 1024, G, bid);
        EpiOutprojMF E{p.x, mod + 2048, x1, x1b, part2};
        pg8::gemm_phase<EpiOutprojMF, pg8::StaticOrder>((PG8_LAS unsigned char*)lds, g, S, E);
    }
    xcd_barrier(bar);

    for (int round = 0; round < 2; ++round) {
        pg8::Gemm g{x1b, Weff_t, T, 2048, 1024}; OneUnitOrder S; S.base.init(T, 2048, G, bid); S.round = round;
        EpiTopkMF E{part2, bias_q, ids, gates};
        pg8::gemm_phase<EpiTopkMF, OneUnitOrder>((PG8_LAS unsigned char*)lds, g, S, E);
    }
    xcd_barrier(bar);

    {
        constexpr int IDS_LD = 136, ACT_LD = 136;
        const float* scale2 = mod + 4096; const float* shift2 = mod + 3072; const float* gate2 = mod + 5120;
        unsigned short* ids_l = (unsigned short*)lds; float* act_l = (float*)(lds + 32768); unsigned char* qe_l = lds + 32768 + 36864;
        const int t0 = bid * 64, tt = lane >> 3, sub = lane & 7, tl = wave * 8 + tt, t = t0 + tl;
        for (int e = tid; e < 1024; e += 512) { const int r = e >> 4, c8 = e & 15; *(uint4*)(ids_l + r * IDS_LD + c8 * 8) = *(const uint4*)(ids + (size_t)(t0 + r) * 128 + c8 * 8); }
        for (int e = tid; e < 64 * ACT_LD; e += 512) act_l[e] = 0.f;
        for (int e = tid; e < 2048; e += 512) ((uint4*)qe_l)[e] = ((const uint4*)qexp)[e];
        __syncthreads();
        float ri;
        { const float4* pp = (const float4*)(part2 + (size_t)t * 16); const float4 p0 = pp[0], p1 = pp[1], p2 = pp[2], p3 = pp[3];
          const float ssum = ((p0.x + p0.y) + (p0.z + p0.w)) + ((p1.x + p1.y) + (p1.z + p1.w)) + ((p2.x + p2.y) + (p2.z + p2.w)) + ((p3.x + p3.y) + (p3.z + p3.w));
          ri = 1.0f / sqrtf(ssum * (1.0f / D) + EPS); }
        const unsigned short* myids = ids_l + tl * IDS_LD;
        float* myact = act_l + tl * ACT_LD;
        const bool s4 = (sub & 4) != 0, s2 = (sub & 2) != 0, s1 = (sub & 1) != 0;
        const unsigned suboff = (unsigned)sub * 16u;
        typedef float f32x2 __attribute__((ext_vector_type(2)));
#define P9_LOAD(W, JB) do { const uint4 idv_ = *(const uint4*)(myids + 8 * (JB)); const unsigned idw_[4] = {idv_.x, idv_.y, idv_.z, idv_.w}; \
        _Pragma("unroll") for (int k_ = 0; k_ < 8; ++k_) { const unsigned id_ = (idw_[k_ >> 1] >> (16 * (k_ & 1))) & 0xffffu; W[k_] = *(const uint4*)(sbase + (id_ * 128u + suboff)); } } while (0)
#define P9_DOWN(W, JB) do { float pd_[8]; \
        _Pragma("unroll") for (int k_ = 0; k_ < 8; ++k_) { const unsigned ww_[4] = {W[k_].x, W[k_].y, W[k_].z, W[k_].w}; f32x2 s_ = {0.f, 0.f}, u_ = {0.f, 0.f}; \
            _Pragma("unroll") for (int m_ = 0; m_ < 4; ++m_) { const f32x2 lo_ = __builtin_amdgcn_cvt_pk_f32_fp8((int)ww_[m_], false), hi_ = __builtin_amdgcn_cvt_pk_f32_fp8((int)ww_[m_], true); \
                s_ = lo_ * hp[2 * m_] + s_; u_ = hi_ * hp[2 * m_ + 1] + u_; } \
            s_ = s_ + u_; pd_[k_] = s_[0] + s_[1]; } \
        float r4_[4], r2_[2]; \
        _Pragma("unroll") for (int k_ = 0; k_ < 4; ++k_) { const float snd_ = s4 ? pd_[k_] : pd_[k_ + 4], kp_ = s4 ? pd_[k_ + 4] : pd_[k_]; r4_[k_] = kp_ + __shfl_xor(snd_, 4); } \
        _Pragma("unroll") for (int k_ = 0; k_ < 2; ++k_) { const float snd_ = s2 ? r4_[k_] : r4_[k_ + 2], kp_ = s2 ? r4_[k_ + 2] : r4_[k_]; r2_[k_] = kp_ + __shfl_xor(snd_, 2); } \
        { const float snd_ = s1 ? r2_[0] : r2_[1], kp_ = s1 ? r2_[1] : r2_[0]; myact[8 * (JB) + sub] += kp_ + __shfl_xor(snd_, 1); } } while (0)
#define P9_UP(W, JB) do { const float4 a0_ = *(const float4*)(myact + 8 * (JB)), a1_ = *(const float4*)(myact + 8 * (JB) + 4); \
        const float av_[8] = {a0_.x, a0_.y, a0_.z, a0_.w, a1_.x, a1_.y, a1_.z, a1_.w}; \
        _Pragma("unroll") for (int k_ = 0; k_ < 8; ++k_) { const unsigned ww_[4] = {W[k_].x, W[k_].y, W[k_].z, W[k_].w}; \
            _Pragma("unroll") for (int m_ = 0; m_ < 4; ++m_) { const f32x2 lo_ = __builtin_amdgcn_cvt_pk_f32_fp8((int)ww_[m_], false), hi_ = __builtin_amdgcn_cvt_pk_f32_fp8((int)ww_[m_], true); \
                o2[2 * m_] = lo_ * av_[k_] + o2[2 * m_]; o2[2 * m_ + 1] = hi_ * av_[k_] + o2[2 * m_ + 1]; } } } while (0)
        for (int c = 0; c < 8; ++c) {
            f32x2 hp[8];
            const int col = 128 * c + 4 * sub;
#pragma unroll
            for (int q = 0; q < 4; ++q) {
                const float4 xv = *(const float4*)(x1 + (size_t)t * D + col + 32 * q);
                const float4 g = *(const float4*)(p.g2 + col + 32 * q), sc = *(const float4*)(scale2 + col + 32 * q), sh = *(const float4*)(shift2 + col + 32 * q);
                hp[2 * q][0] = xv.x * ri * g.x * (1.f + sc.x) + sh.x; hp[2 * q][1] = xv.y * ri * g.y * (1.f + sc.y) + sh.y;
                hp[2 * q + 1][0] = xv.z * ri * g.z * (1.f + sc.z) + sh.z; hp[2 * q + 1][1] = xv.w * ri * g.w * (1.f + sc.w) + sh.w;
            }
            const unsigned char* sbase = q8 + (size_t)c * (16384 * 128);
            uint4 wA[8], wB[8];
            P9_LOAD(wA, 0);
#pragma unroll 1
            for (int jb = 0; jb < 16; jb += 2) {
                P9_LOAD(wB, jb + 1);
                P9_DOWN(wA, jb);
                if (jb + 2 < 16) P9_LOAD(wA, jb + 2);
                P9_DOWN(wB, jb + 1);
            }
        }
        for (int jb = 0; jb < 16; ++jb) {
            const int j = 8 * jb + sub; const unsigned id = myids[j];
            const float a = myact[j] * __uint_as_float((unsigned)qe_l[id] << 23);
            const float av = fabsf(a), tq = 1.0f / (av * 0.2316418882f + 1.0f);
            float ql = tq * 0.5307027145f + (-0.7265760135f); ql = ql * tq + 0.7107068705f; ql = ql * tq + (-0.142248368f); ql = ql * tq + 0.127414796f; ql = ql * tq;
            const float mm = a * (ql * exp2f(a * a * (-0.72134752044f)));
            const float ge = (a < 0.f) ? mm : (a - mm);
            myact[j] = ge * gates[(size_t)t * 128 + j] * __uint_as_float((unsigned)qe_l[16384 + id] << 23);
        }
        __syncthreads();
        for (int c = 0; c < 8; ++c) {
            f32x2 o2[8];
#pragma unroll
            for (int q = 0; q < 8; ++q) o2[q] = (f32x2){0.f, 0.f};
            const int col = 128 * c + 4 * sub;
            const unsigned char* sbase = q8 + (16u << 20) + (size_t)c * (16384 * 128);
            uint4 wA[8], wB[8];
            P9_LOAD(wA, 0);
#pragma unroll 1
            for (int jb = 0; jb < 16; jb += 2) {
                P9_LOAD(wB, jb + 1);
                P9_UP(wA, jb);
                if (jb + 2 < 16) P9_LOAD(wA, jb + 2);
                P9_UP(wB, jb + 1);
            }
#pragma unroll
            for (int q = 0; q < 4; ++q) {
                float* op = out + (size_t)t * D + col + 32 * q;
                const float4 xv = *(const float4*)(x1 + (size_t)t * D + col + 32 * q); const float4 gt = *(const float4*)(gate2 + col + 32 * q);
                float4 r; r.x = xv.x + gt.x * o2[2 * q][0]; r.y = xv.y + gt.y * o2[2 * q][1]; r.z = xv.z + gt.z * o2[2 * q + 1][0]; r.w = xv.w + gt.w * o2[2 * q + 1][1];
                *(float4*)op = r;
            }
        }
#undef P9_LOAD
#undef P9_DOWN
#undef P9_UP
    }
}
}

extern "C" void kernel_launch(void* const* d_in, const int* in_sizes, int n_in, void* d_out, int out_size, void* d_ws, size_t ws_size, hipStream_t stream) {
    static int grid = 0;
    if (grid == 0) {
        int dev = 0, cus = 0, per_cu = 0;
        (void)hipGetDevice(&dev);
        (void)hipDeviceGetAttribute(&cus, hipDeviceAttributeMultiprocessorCount, dev);
        (void)hipFuncSetAttribute((const void*)mk_fwd, hipFuncAttributeMaxDynamicSharedMemorySize, LDS_BYTES);
        (void)hipOccupancyMaxActiveBlocksPerMultiprocessor(&per_cu, (const void*)mk_fwd, 512, LDS_BYTES);
        if (per_cu < 1 || cus != 256) { fprintf(stderr, "kernel_launch: needs 256 CUs with one resident workgroup each (cus %d, per_cu %d)\n", cus, per_cu); grid = -1; }
        else grid = cus;
    }
    if (grid < 0) return;
    (void)hipMemsetAsync((char*)d_ws + OFF_CTL, 0, CTL_BYTES, stream);
    Params p{};
    p.x = (const float*)d_in[0]; p.c = (const float*)d_in[1]; p.pos = (const int*)d_in[2]; p.ada_w = (const float*)d_in[3]; p.ada_b = (const float*)d_in[4];
    p.g1 = (const float*)d_in[5]; p.g2 = (const float*)d_in[6]; p.w_in = (const float*)d_in[7]; p.rgain = (const float*)d_in[8]; p.qg = (const float*)d_in[9];
    p.kg = (const float*)d_in[10]; p.og = (const float*)d_in[11]; p.w_out = (const float*)d_in[12]; p.wq = (const float*)d_in[13]; p.sk = (const float*)d_in[14];
    p.down = (const float*)d_in[15]; p.up = (const float*)d_in[16]; p.out = (float*)d_out; p.ws = (unsigned char*)d_ws;
    for (int i = 0; i < 32; ++i) {
        const double f = pow(10000.0, -(double)i / 32.0) / 6.283185307179586476925;
        float fh = (float)f; unsigned ub; memcpy(&ub, &fh, 4); ub &= 0xFFFFC000u; memcpy(&fh, &ub, 4);
        p.rc.fh[i] = fh; p.rc.fl[i] = (float)(f - (double)fh);
    }
    void* args[] = {&p};
    hipError_t e = hipLaunchCooperativeKernel((const void*)mk_fwd, dim3(grid), dim3(512), args, LDS_BYTES, stream);
    if (e != hipSuccess) fprintf(stderr, "kernel_launch: cooperative launch failed: %s (grid %d)\n", hipGetErrorString(e), grid);
}
```

```cpp
#include <hip/hip_runtime.h>
#include <stdint.h>
#include <math.h>
#include <cstdio>
#include <cstring>

namespace {
constexpr int T = 16384, D = 1024;
constexpr float EPS = 1e-6f;
typedef unsigned short bf16_t;
#define LAS __attribute__((address_space(3)))

__device__ __forceinline__ float bf2f(bf16_t b) { return __uint_as_float(((unsigned)b) << 16); }
__device__ __forceinline__ bf16_t f2bf(float f) { unsigned u = __float_as_uint(f); u += 0x7fffu + ((u >> 16) & 1u); return (bf16_t)(u >> 16); }
__device__ __forceinline__ float4 ld_nt4(const float* p) { typedef float f4v __attribute__((ext_vector_type(4))); const f4v v = __builtin_nontemporal_load((const f4v*)p); return make_float4(v[0], v[1], v[2], v[3]); }

__device__ __forceinline__ float lg2_head(int h) {
    const float x = __uint_as_float((unsigned)(127 - 5 - h) << 23);
    const float s = x * (1.f + x * (0.5f + x * (0.33333334f + x * (0.25f + x * (0.2f + x * 0.16666667f)))));
    return -s * 1.44269504089f;
}
struct RopeC { float fh[32], fl[32]; };
struct RetC { float lg2[8]; };

constexpr size_t MiB = 1u << 20;
constexpr size_t OFF_CTL = 0;
constexpr size_t CTL_BYTES = 64 * 1024;
constexpr size_t OFF_MOD = 64 * 1024, OFF_RINV1 = 128 * 1024, OFF_BIASF = 256 * 1024, OFF_ROPE = 1 * MiB;
constexpr size_t OFF_WINT = 6 * MiB;
constexpr size_t OFF_XB = 16 * MiB;
constexpr size_t OFF_YCAT = 16 * MiB;
constexpr size_t OFF_P = 48 * MiB;
constexpr size_t OFF_KV = 208 * MiB, OFF_ST = 224 * MiB;
constexpr size_t OFF_WEFFT = 240 * MiB;
constexpr size_t OFF_WOUTT = 13 * MiB;
constexpr size_t OFF_BIASQ = 272 * 1024;
constexpr size_t OFF_BQPART = 448 * 1024;
constexpr size_t OFF_PART2 = 5 * MiB;
constexpr size_t OFF_X1B = 208 * MiB;
constexpr size_t OFF_X1 = 48 * MiB;
constexpr size_t OFF_IDS = 244 * MiB, OFF_GATES = 248 * MiB;
constexpr size_t OFF_Q8 = 176 * MiB;
constexpr size_t OFF_QSC = 320 * 1024;
constexpr int CONV_SPLIT = 0;
constexpr int LDS_BYTES = 163840;
constexpr int LDS_ST_OFF = LDS_BYTES - 16;

#define XB_TMO      128
#define XB_XCNT(j)  (256  + 64 * (j))
#define XB_XSUB(j)  (1280 + 64 * (j))
#define XB_XGEN(j)  (2304 + 64 * (j))
#define XB_TOP      3328
#define XB_TOPGEN   3392
#define XCD_BAR_WORDS 3456
#define XB_SPIN_CAP (1u << 20)
__device__ __forceinline__ unsigned xb_ld(unsigned* p)              { return __hip_atomic_load(p, __ATOMIC_RELAXED, __HIP_MEMORY_SCOPE_AGENT); }
__device__ __forceinline__ unsigned xb_add(unsigned* p, unsigned v) { return __hip_atomic_fetch_add(p, v, __ATOMIC_RELAXED, __HIP_MEMORY_SCOPE_AGENT); }
__device__ __forceinline__ unsigned xb_xcc_id() { return (unsigned)__builtin_amdgcn_s_getreg((3 << 11) | 20) & 0xFu; }
#define XB_SPIN(cond, bar) do { unsigned _sp = 0; while (cond) { __builtin_amdgcn_s_sleep(1); \
    if ((++_sp & 255u) == 0u) { if (xb_ld(&(bar)[XB_TMO])) break; if (_sp > XB_SPIN_CAP) { atomicAdd(&(bar)[XB_TMO], 1u); break; } } } } while (0)
struct XcdBarrier { unsigned* bar; unsigned x; volatile LAS unsigned* st; };
__device__ __forceinline__ XcdBarrier xcd_barrier_post(unsigned* bar, volatile LAS unsigned* st) {
    XcdBarrier b; b.bar = bar; b.x = xb_xcc_id(); b.st = st;
    if (threadIdx.x == 0) (void)xb_add(&bar[XB_XCNT(b.x)], 1u);
    return b;
}
__device__ __forceinline__ void xcd_barrier_complete(unsigned* bar, unsigned x, unsigned& nloc, unsigned& nx) {
    const unsigned G = gridDim.x * gridDim.y * gridDim.z;
    unsigned sum, cnt, mine, sp = 0u;
    for (;;) {
        sum = 0u; cnt = 0u; mine = 0u;
#pragma unroll
        for (unsigned j = 0; j < 16; ++j) { const unsigned c = xb_ld(&bar[XB_XCNT(j)]); sum += c; cnt += (c > 0u) ? 1u : 0u; mine = (j == x) ? c : mine; }
        if (sum == G) break;
        __builtin_amdgcn_s_sleep(1);
        if ((++sp & 255u) == 0u) { if (xb_ld(&bar[XB_TMO])) break; if (sp > XB_SPIN_CAP) { atomicAdd(&bar[XB_TMO], 1u); break; } }
    }
    nloc = mine > 0u ? mine : 1u; nx = cnt > 0u ? cnt : 1u;
}
__device__ __forceinline__ void xcd_barrier(const XcdBarrier& b) {
    asm volatile("s_waitcnt vmcnt(0)" ::: "memory");
    __syncthreads();
    if (threadIdx.x == 0) {
        unsigned* bar = b.bar;
        __builtin_amdgcn_s_waitcnt(0);
        unsigned nloc = b.st[0], nx = b.st[1];
        if (nloc == 0u) { xcd_barrier_complete(bar, b.x, nloc, nx); b.st[0] = nloc; b.st[1] = nx; }
        const unsigned old = xb_add(&bar[XB_XSUB(b.x)], 1u);
        const unsigned gen = old / nloc;
        if (old + 1u == (gen + 1u) * nloc) {
            __builtin_amdgcn_fence(__ATOMIC_RELEASE, "agent");
            asm volatile("s_waitcnt vmcnt(0)" ::: "memory");
            const unsigned og = xb_add(&bar[XB_TOP], 1u);
            const unsigned tg = og / nx;
            if (og + 1u == (tg + 1u) * nx) xb_add(&bar[XB_TOPGEN], 1u);
            else XB_SPIN(xb_ld(&bar[XB_TOPGEN]) == tg, bar);
            __builtin_amdgcn_fence(__ATOMIC_ACQUIRE, "agent");
            xb_add(&bar[XB_XGEN(b.x)], 1u);
            asm volatile("s_waitcnt vmcnt(0)" ::: "memory");
        } else {
            XB_SPIN(xb_ld(&bar[XB_XGEN(b.x)]) == gen, bar);
            __builtin_amdgcn_fence(__ATOMIC_ACQUIRE, "agent");
            asm volatile("s_waitcnt vmcnt(0)" ::: "memory");
        }
    }
    __syncthreads();
}


namespace pg8 {
#define PG8_LAS __attribute__((address_space(3)))
typedef short bf16x8 __attribute__((ext_vector_type(8)));
typedef float f32x4 __attribute__((ext_vector_type(4)));
typedef unsigned u32x4 __attribute__((ext_vector_type(4)));
typedef unsigned u32x2 __attribute__((ext_vector_type(2)));
constexpr int BM = 256, BK = 64, HALF = 128, HTB = HALF * BK * 2, STAGE_BYTES = 8 * HTB, NXCD = 8, WGM = 8;
__host__ __device__ __forceinline__ int lds_byte(int r, int c) { const int st = (r >> 4) * 2 + (c >> 5), rr = r & 15, cc = c & 31, ob = rr * 64 + cc * 2; return st * 1024 + (ob ^ (((ob >> 9) & 1) << 5)); }
__host__ __device__ __forceinline__ void stage_rc(int b, int& R, int& C) { const int st = b / 1024, sb = b % 1024, swz = sb ^ (((sb >> 9) & 1) << 5); R = (st >> 1) * 16 + swz / 64; C = (st & 1) * 32 + (swz % 64) / 2; }
__host__ __device__ __forceinline__ int perm32(int rho) { const int n = rho >> 4, i = rho & 15; return 8 * (i >> 2) + 4 * n + (i & 3); }
struct Unit { int pm, pn; };
struct Gemm { const bf16_t* A; const bf16_t* Bt; int M, N, K; };
struct StaticOrder {
    int nM, nN, nwg, G, c;
    __host__ __device__ void init(int M, int N, int G_, int c_) { nM = M / BM; nN = N / BM; nwg = nM * nN; G = G_; c = c_; }
    __host__ __device__ bool next(int i, Unit& u) const {
        const long L = (long)i * G + c; if (L >= nwg) return false;
        int wgid = (int)L; { const int q = nwg / NXCD, r = nwg % NXCD, xcd = wgid % NXCD, off = wgid / NXCD; wgid = (xcd < r ? xcd * (q + 1) : r * (q + 1) + (xcd - r) * q) + off; }
        const int nig = WGM * nN, gid = wgid / nig, fm = gid * WGM, gsz = (nM - fm) < WGM ? (nM - fm) : WGM;
        u.pm = fm + ((wgid % nig) % gsz); u.pn = (wgid % nig) / gsz; return true;
    }
    __device__ __forceinline__ void a_ready(const Unit&) const {}
    __device__ __forceinline__ void done(const Unit&) const {}
};
__device__ __forceinline__ unsigned cvt_pk_bf16(float lo, float hi) { unsigned r; asm volatile("v_cvt_pk_bf16_f32 %0, %1, %2" : "=v"(r) : "v"(lo), "v"(hi)); return r; }

template <class Epi, class Sched>
__device__ __forceinline__ void gemm_phase(PG8_LAS unsigned char* lds, const Gemm g, const Sched& S, const Epi& E) {
    int tid_ = threadIdx.x; asm volatile("" : "+v"(tid_));
    const int tid = tid_, wid = __builtin_amdgcn_readfirstlane(tid >> 6), lane = tid & 63, wr = wid >> 2, wc = wid & 3, fr = lane & 15, fq = lane >> 4;
    const int K = g.K, nt = K / BK;
    unsigned voffA[2], voffB[2];
#pragma unroll
    for (int i = 0; i < 2; ++i) { int R, C; stage_rc(tid * 16 + i * 8192, R, C); const int Rb = Epi::PERM ? ((R & ~31) + perm32(R & 31)) : R;
        voffA[i] = (unsigned)(R * K + C) * 2u; voffB[i] = (unsigned)(Rb * K + C) * 2u; }
    const size_t kstep = (size_t)(BK * 2);
    const size_t hstep = (size_t)HALF * K * 2;
    const size_t tstep = 2 * hstep;
    const unsigned ldsw = (unsigned)wid * 1024u;
    const int aoff = lds_byte(wr * 64 + fr, fq * 8), boff = lds_byte(wc * 32 + fr, fq * 8);
#define PG8_SA(b, h) (((b) * 2 + (h)) * HTB)
#define PG8_SB(b, h) ((4 + (b) * 2 + (h)) * HTB)
#define PG8_STAGE(bufoff, gbase, voff) do { _Pragma("unroll") for (int _i = 0; _i < 2; ++_i) \
        __builtin_amdgcn_global_load_lds((const unsigned*)((const char*)(gbase) + (voff)[_i]), (PG8_LAS unsigned*)(lds + (bufoff) + ldsw + _i * 8192), 16, 0, 0); } while (0)
#define PG8_LDA(dst, b, h) do { _Pragma("unroll") for (int m = 0; m < 4; ++m) _Pragma("unroll") for (int k = 0; k < 2; ++k) dst[m][k] = *(const PG8_LAS bf16x8*)(lds + PG8_SA(b, h) + aoff + m * 2048 + k * 1024); } while (0)
#define PG8_LDB(dst, b, h) do { _Pragma("unroll") for (int n = 0; n < 2; ++n) _Pragma("unroll") for (int k = 0; k < 2; ++k) dst[n][k] = *(const PG8_LAS bf16x8*)(lds + PG8_SB(b, h) + boff + n * 2048 + k * 1024); } while (0)
#define PG8_MMA(ai, bj, At, Bt) do { __builtin_amdgcn_s_setprio(1); _Pragma("unroll") for (int m = 0; m < 4; ++m) _Pragma("unroll") for (int n = 0; n < 2; ++n) _Pragma("unroll") for (int k = 0; k < 2; ++k) \
        acc[ai][bj][m][n] = __builtin_amdgcn_mfma_f32_16x16x32_bf16(Bt[n][k], At[m][k], acc[ai][bj][m][n], 0, 0, 0); __builtin_amdgcn_s_setprio(0); } while (0)
#define PG8_WAIT_V(n) asm volatile("s_waitcnt vmcnt(" #n ")" ::: "memory")
#define PG8_WAIT_L(n) asm volatile("s_waitcnt lgkmcnt(" #n ")" ::: "memory")
#define PG8_BAR __builtin_amdgcn_s_barrier()
#define PG8_SCHED __builtin_amdgcn_sched_barrier(0)
    Unit cur, nxt; int ui = 0;
    if (!S.next(0, cur)) return;
    f32x4 acc[2][2][4][2];
#pragma unroll
    for (int a = 0; a < 2; ++a)
#pragma unroll
        for (int b = 0; b < 2; ++b)
#pragma unroll
            for (int m = 0; m < 4; ++m)
#pragma unroll
                for (int n = 0; n < 2; ++n) acc[a][b][m][n] = (f32x4){0.f, 0.f, 0.f, 0.f};
    bf16x8 At[4][2], B0[2][2], B1[2][2];
    const char* cA = (const char*)g.A + (size_t)cur.pm * tstep; const char* cB = (const char*)g.Bt + (size_t)cur.pn * tstep;
    S.a_ready(cur);
    PG8_STAGE(PG8_SB(0, 0), cB, voffB); PG8_STAGE(PG8_SA(0, 0), cA, voffA); PG8_STAGE(PG8_SB(0, 1), cB + hstep, voffB); PG8_STAGE(PG8_SA(0, 1), cA + hstep, voffA);
    if (wr == 1) PG8_BAR;
    PG8_WAIT_V(4); PG8_BAR;
    PG8_STAGE(PG8_SB(1, 0), cB + kstep, voffB); PG8_STAGE(PG8_SA(1, 0), cA + kstep, voffA); PG8_STAGE(PG8_SB(1, 1), cB + hstep + kstep, voffB);
    PG8_WAIT_V(6); PG8_BAR;
    for (;;) {
        const bool has_next = S.next(ui + 1, nxt);
        const char* nA = has_next ? (const char*)g.A + (size_t)nxt.pm * tstep : cA; const char* nB = has_next ? (const char*)g.Bt + (size_t)nxt.pn * tstep : cB;
        for (int t = 0; t < nt; t += 2) {
            const bool last = (t == nt - 2);
            const char* a1 = cA + (size_t)(t + 1) * kstep;
            const char* a2 = last ? nA : cA + (size_t)(t + 2) * kstep; const char* b2 = last ? nB : cB + (size_t)(t + 2) * kstep;
            const char* a3 = a2 + kstep; const char* b3 = b2 + kstep;
            if (last && has_next) S.a_ready(nxt);
            PG8_LDB(B0, 0, 0); PG8_SCHED; PG8_LDA(At, 0, 0); PG8_STAGE(PG8_SA(1, 1), a1 + hstep, voffA);
            PG8_WAIT_L(8); PG8_BAR; PG8_WAIT_L(0); PG8_MMA(0, 0, At, B0); PG8_BAR; PG8_SCHED;
            PG8_LDB(B1, 0, 1); PG8_STAGE(PG8_SB(0, 0), b2, voffB);
            PG8_BAR; PG8_WAIT_L(0); PG8_MMA(0, 1, At, B1); PG8_BAR;
            PG8_LDA(At, 0, 1); PG8_STAGE(PG8_SA(0, 0), a2, voffA);
            PG8_BAR; PG8_WAIT_L(0); PG8_MMA(1, 0, At, B0); PG8_BAR; PG8_SCHED;
            PG8_STAGE(PG8_SB(0, 1), b2 + hstep, voffB);
            PG8_WAIT_V(6); PG8_BAR; PG8_MMA(1, 1, At, B1); PG8_BAR;
            PG8_LDB(B0, 1, 0); PG8_SCHED; PG8_LDA(At, 1, 0); PG8_STAGE(PG8_SA(0, 1), a2 + hstep, voffA);
            PG8_WAIT_L(8); PG8_BAR; PG8_WAIT_L(0); PG8_MMA(0, 0, At, B0); PG8_BAR; PG8_SCHED;
            PG8_LDB(B1, 1, 1); PG8_STAGE(PG8_SB(1, 0), b3, voffB);
            PG8_BAR; PG8_WAIT_L(0); PG8_MMA(0, 1, At, B1); PG8_BAR;
            PG8_LDA(At, 1, 1); PG8_STAGE(PG8_SA(1, 0), a3, voffA);
            PG8_BAR; PG8_WAIT_L(0); PG8_MMA(1, 0, At, B0); PG8_BAR; PG8_SCHED;
            PG8_STAGE(PG8_SB(1, 1), b3 + hstep, voffB);
            PG8_WAIT_V(6); PG8_BAR; PG8_MMA(1, 1, At, B1); PG8_BAR;
        }
        if constexpr (!Epi::AFTER_DRAIN) { E(acc, cur, wr, wc, fr, fq); S.done(cur); }
        if (!has_next) break;
#pragma unroll
        for (int a = 0; a < 2; ++a)
#pragma unroll
            for (int b = 0; b < 2; ++b)
#pragma unroll
                for (int m = 0; m < 4; ++m)
#pragma unroll
                    for (int n = 0; n < 2; ++n) acc[a][b][m][n] = (f32x4){0.f, 0.f, 0.f, 0.f};
        cur = nxt; cA = nA; cB = nB; ++ui;
    }
    PG8_WAIT_V(0);
    if (wr == 0) PG8_BAR;
    PG8_BAR;
    if constexpr (Epi::AFTER_DRAIN) { E.fused(acc, cur, wr, wc, fr, fq, lds, wid, lane); S.done(cur); }
#undef PG8_SA
#undef PG8_SB
#undef PG8_STAGE
#undef PG8_LDA
#undef PG8_LDB
#undef PG8_MMA
#undef PG8_WAIT_V
#undef PG8_WAIT_L
#undef PG8_BAR
#undef PG8_SCHED
}
}

__host__ __device__ __forceinline__ int cmap_in(int F) { return (F & ~255) + 128 * ((F >> 5) & 1) + 32 * ((F >> 6) & 3) + (F & 31); }
struct EpiInprojMF {
    static constexpr bool PERM = true, AFTER_DRAIN = false;
    bf16_t* P; const float* rinv; const float* bias_f; const int* pos; const float* ftab; const float* qg; const float* kg;
    __device__ __forceinline__ void operator()(const pg8::f32x4 (&acc)[2][2][4][2], const pg8::Unit& u, int wr, int wc, int fr, int fq) const {
        typedef pg8::f32x4 f32x4;
        asm volatile("" : "+v"(fr), "+v"(fq));
        const int type = u.pn >> 1, head = 4 * (u.pn & 1) + wc, fb = 256 * u.pn + 64 * wc;
        const size_t PSZ = (size_t)T * 512;
        const int rslot = (type == 0) ? 0 : (type == 1) ? 1 : (type == 2) ? 6 : (type == 3) ? 2 : (type == 4) ? 3 : (type == 5) ? 4 : 7;
        bf16_t* rowmaj = P + (size_t)rslot * PSZ;
        const int t0 = u.pm * 256 + wr * 64 + fr;
        f32x4 bv[2][2], gv[2][2], fh[2], fl[2];
#pragma unroll
        for (int bj = 0; bj < 2; ++bj)
#pragma unroll
            for (int n = 0; n < 2; ++n) bv[bj][n] = *(const f32x4*)(bias_f + fb + 32 * bj + 8 * fq + 4 * n);
        if (type <= 1) {
#pragma unroll
            for (int n = 0; n < 2; ++n) { fh[n] = *(const f32x4*)(ftab + 8 * fq + 4 * n); fl[n] = *(const f32x4*)(ftab + 32 + 8 * fq + 4 * n); }
        } else if (type == 4 || type == 5) {
            const float* gsrc = (type == 4) ? qg : kg;
#pragma unroll
            for (int bj = 0; bj < 2; ++bj)
#pragma unroll
                for (int n = 0; n < 2; ++n) gv[bj][n] = *(const f32x4*)(gsrc + 32 * bj + 8 * fq + 4 * n);
        }
#pragma unroll
        for (int ai = 0; ai < 2; ++ai) {
            float rv[4], pf[4];
#pragma unroll
            for (int m = 0; m < 4; ++m) { rv[m] = rinv[t0 + ai * 128 + m * 16]; pf[m] = (float)pos[t0 + ai * 128 + m * 16]; }
            asm volatile("" : "+v"(rv[0]), "+v"(rv[1]), "+v"(rv[2]), "+v"(rv[3]), "+v"(pf[0]), "+v"(pf[1]), "+v"(pf[2]), "+v"(pf[3]));
#pragma unroll
            for (int m = 0; m < 4; ++m) {
                const int t = t0 + ai * 128 + m * 16;
                const float r = rv[m];
                f32x4 v[2][2];
#pragma unroll
                for (int bj = 0; bj < 2; ++bj)
#pragma unroll
                    for (int n = 0; n < 2; ++n) v[bj][n] = acc[ai][bj][m][n] * r + bv[bj][n];
                if (type <= 1) {
                    const float sc = (type == 1) ? 0.125f : 1.f, pp = pf[m];
#pragma unroll
                    for (int n = 0; n < 2; ++n)
#pragma unroll
                        for (int j = 0; j < 4; ++j) {
                            const float rev = __builtin_amdgcn_fractf(__builtin_amdgcn_fractf(pp * fh[n][j]) + pp * fl[n][j]);
                            const float cs = __builtin_amdgcn_cosf(rev) * sc, sn = __builtin_amdgcn_sinf(rev) * sc;
                            const float x1 = v[0][n][j], x2 = v[1][n][j]; v[0][n][j] = x1 * cs - x2 * sn; v[1][n][j] = x2 * cs + x1 * sn;
                        }
                } else if (type == 3) {
#pragma unroll
                    for (int bj = 0; bj < 2; ++bj)
#pragma unroll
                        for (int n = 0; n < 2; ++n)
#pragma unroll
                            for (int j = 0; j < 4; ++j) { const float x = v[bj][n][j]; v[bj][n][j] = x / (1.f + __expf(-x)); }
                } else if (type == 4 || type == 5) {
                    float ss = 0.f;
#pragma unroll
                    for (int bj = 0; bj < 2; ++bj)
#pragma unroll
                        for (int n = 0; n < 2; ++n)
#pragma unroll
                            for (int j = 0; j < 4; ++j) ss += v[bj][n][j] * v[bj][n][j];
                    ss += __shfl_xor(ss, 16); ss += __shfl_xor(ss, 32);
                    const float rn = (1.0f / sqrtf(ss * (1.f / 64.f) + EPS)) * ((type == 4) ? 0.125f * 1.44269504089f : 1.f);
#pragma unroll
                    for (int bj = 0; bj < 2; ++bj)
#pragma unroll
                        for (int n = 0; n < 2; ++n) v[bj][n] = v[bj][n] * rn * gv[bj][n];
                }
#pragma unroll
                for (int bj = 0; bj < 2; ++bj) {
                    pg8::u32x4 w; w.x = pg8::cvt_pk_bf16(v[bj][0][0], v[bj][0][1]); w.y = pg8::cvt_pk_bf16(v[bj][0][2], v[bj][0][3]);
                    w.z = pg8::cvt_pk_bf16(v[bj][1][0], v[bj][1][1]); w.w = pg8::cvt_pk_bf16(v[bj][1][2], v[bj][1][3]);
                    *(pg8::u32x4*)(rowmaj + (size_t)t * 512 + head * 64 + 32 * bj + 8 * fq) = w;
                }
            }
        }
    }
};

struct EpiOutprojMF {
    static constexpr bool PERM = false, AFTER_DRAIN = true;
    const float* x; const float* gate1; float* x1; bf16_t* x1b; float* part2;
    __device__ __forceinline__ void operator()(const pg8::f32x4 (&)[2][2][4][2], const pg8::Unit&, int, int, int, int) const {}
    __device__ __forceinline__ void fused(pg8::f32x4 (&acc)[2][2][4][2], const pg8::Unit& u, int wr, int wc, int fr, int fq, PG8_LAS unsigned char* lds, int wid, int lane) const {
        typedef pg8::f32x4 f32x4;
        asm volatile("" : "+v"(fr), "+v"(fq), "+v"(lane));
        constexpr int LD = 260;
        PG8_LAS float* TL = (PG8_LAS float*)lds;
        const int colw = wc * 32 + 4 * fq;
        f32x4 gv[2][2];
#pragma unroll
        for (int bj = 0; bj < 2; ++bj)
#pragma unroll
            for (int n = 0; n < 2; ++n) gv[bj][n] = *(const f32x4*)(gate1 + u.pn * 256 + colw + bj * 128 + n * 16);
#pragma unroll
        for (int ai = 0; ai < 2; ++ai) {
#pragma unroll
            for (int m = 0; m < 4; ++m)
#pragma unroll
                for (int bj = 0; bj < 2; ++bj)
#pragma unroll
                    for (int n = 0; n < 2; ++n) *(PG8_LAS f32x4*)(TL + (64 * wr + 16 * m + fr) * LD + colw + bj * 128 + n * 16) = gv[bj][n] * acc[ai][bj][m][n];
            __syncthreads();
            f32x4 xv[2];
            const size_t rowbase = (size_t)(u.pm * 256 + ai * 128 + 16 * wid) * D + u.pn * 256 + 4 * lane;
            xv[0] = *(const f32x4*)(x + rowbase);
#pragma unroll
            for (int r = 0; r < 16; ++r) {
                if (r < 15) xv[(r + 1) & 1] = *(const f32x4*)(x + rowbase + (size_t)(r + 1) * D);
                const f32x4 g = *(PG8_LAS f32x4*)(TL + (16 * wid + r) * LD + 4 * lane);
                const f32x4 o = xv[r & 1] + g;
                *(f32x4*)(x1 + rowbase + (size_t)r * D) = o;
                pg8::u32x2 w; w.x = pg8::cvt_pk_bf16(o[0], o[1]); w.y = pg8::cvt_pk_bf16(o[2], o[3]);
                *(pg8::u32x2*)(x1b + rowbase + (size_t)r * D) = w;
                float ss = o[0] * o[0] + o[1] * o[1] + o[2] * o[2] + o[3] * o[3];
#pragma unroll
                for (int o2 = 32; o2 > 0; o2 >>= 1) ss += __shfl_xor(ss, o2);
                if (lane < 4) part2[(size_t)(u.pm * 256 + ai * 128 + 16 * wid + r) * 16 + u.pn * 4 + lane] = (lane == 0) ? ss : 0.f;
            }
            __syncthreads();
        }
    }
};

__device__ __forceinline__ unsigned pk2(float lo, float hi) { return (unsigned)f2bf(lo) | ((unsigned)f2bf(hi) << 16); }
template <bool FOLD, bool CMAP>
__device__ __forceinline__ void transpose_item(const float* W, int K, int N, bf16_t* WT, float* scr, int item, int lane, const float* sg, const float* sm) {
    const int nblk = N / 32, kb = item / nblk, nb = item % nblk, k0 = 64 * kb, n0 = 32 * nb;
    float4 v[8]; float f[8];
#pragma unroll
    for (int i = 0; i < 8; ++i) { const int kk = 8 * i + (lane >> 3); v[i] = *(const float4*)(W + (size_t)(k0 + kk) * N + n0 + 4 * (lane & 7));
        f[i] = FOLD ? sg[k0 + kk] * (1.f + sm[k0 + kk]) : 1.f; }
#pragma unroll
    for (int i = 0; i < 8; ++i) { const int kk = 8 * i + (lane >> 3); float* d = scr + kk * 33 + 4 * (lane & 7);
        d[0] = v[i].x * f[i]; d[1] = v[i].y * f[i]; d[2] = v[i].z * f[i]; d[3] = v[i].w * f[i]; }
    asm volatile("s_waitcnt lgkmcnt(0)" ::: "memory");
    const int c = lane & 7, r0 = CMAP ? cmap_in(n0) : n0;
#pragma unroll
    for (int j = 0; j < 4; ++j) { const int n = (lane >> 3) + 8 * j; const float* s = scr + (8 * c) * 33 + n;
        pg8::u32x4 o; o.x = pk2(s[0 * 33], s[1 * 33]); o.y = pk2(s[2 * 33], s[3 * 33]); o.z = pk2(s[4 * 33], s[5 * 33]); o.w = pk2(s[6 * 33], s[7 * 33]);
        *(pg8::u32x4*)(WT + (size_t)(r0 + n) * K + k0 + 8 * c) = o; }
    asm volatile("s_waitcnt lgkmcnt(0)" ::: "memory");
}
template <int NC4, class VF>
__device__ __forceinline__ void gemv_cols(unsigned char* lds, const VF vf, const float* W, const int N, const int u, float* dst, const float* add) {
    constexpr int RG = 512 / NC4;
    float (*red)[NC4 * 4] = (float (*)[NC4 * 4])lds;
    const int tid = threadIdx.x, c4 = tid % NC4, rg = tid / NC4;
    if (rg < RG) {
        float4 acc = {0.f, 0.f, 0.f, 0.f};
        for (int r = rg; r < 1024; r += RG) { const float s = vf(r); const float4 w = *(const float4*)(W + (size_t)r * N + u * NC4 * 4 + c4 * 4);
            acc.x += s * w.x; acc.y += s * w.y; acc.z += s * w.z; acc.w += s * w.w; }
        red[rg][c4 * 4 + 0] = acc.x; red[rg][c4 * 4 + 1] = acc.y; red[rg][c4 * 4 + 2] = acc.z; red[rg][c4 * 4 + 3] = acc.w;
    }
    __syncthreads();
    if (tid < NC4 * 4) { float s = 0.f; for (int i = 0; i < RG; ++i) s += red[i][tid]; dst[u * NC4 * 4 + tid] = s + (add ? add[u * NC4 * 4 + tid] : 0.f); }
    __syncthreads();
}
struct VfSilu { const float* c; __device__ __forceinline__ float operator()(int r) const { const float v = c[r]; return v / (1.f + expf(-v)); } };
struct VfVec { const float* v; __device__ __forceinline__ float operator()(int r) const { return v[r]; } };


typedef float f32x16 __attribute__((ext_vector_type(16)));
typedef pg8::bf16x8 bf16x8;
#define MFMA32(a, b, c) __builtin_amdgcn_mfma_f32_32x32x16_bf16((a), (b), (c), 0, 0, 0)
__device__ __forceinline__ bf16x8 pack_frag(const f32x16& v, int s) {
    pg8::u32x4 w;
    w.x = pg8::cvt_pk_bf16(v[8 * s + 0], v[8 * s + 1]); w.y = pg8::cvt_pk_bf16(v[8 * s + 2], v[8 * s + 3]);
    w.z = pg8::cvt_pk_bf16(v[8 * s + 4], v[8 * s + 5]); w.w = pg8::cvt_pk_bf16(v[8 * s + 6], v[8 * s + 7]);
    return __builtin_bit_cast(bf16x8, w);
}
__device__ __forceinline__ bf16x8 load_tfrag(const bf16_t* rowp, int tok) {
    const uint2 a = *(const uint2*)(rowp + tok), b = *(const uint2*)(rowp + tok + 8);
    pg8::u32x4 w; w.x = a.x; w.y = a.y; w.z = b.x; w.w = b.y;
    return __builtin_bit_cast(bf16x8, w);
}


__device__ __forceinline__ bf16x8 tr_frag(const unsigned char* a0, int rows2) {
    typedef short s16x4 __attribute__((ext_vector_type(4)));
    typedef __attribute__((address_space(3))) s16x4 lds_s16x4;
    const s16x4 lo = __builtin_amdgcn_ds_read_tr16_b64_v4i16((lds_s16x4*)a0);
    const s16x4 hi = __builtin_amdgcn_ds_read_tr16_b64_v4i16((lds_s16x4*)(a0 + rows2 * 144));
    const uint2 l2 = __builtin_bit_cast(uint2, lo), h2 = __builtin_bit_cast(uint2, hi);
    pg8::u32x4 fw; fw.x = l2.x; fw.y = l2.y; fw.z = h2.x; fw.w = h2.y;
    return __builtin_bit_cast(bf16x8, fw);
}

__device__ __forceinline__ void ins16(float (&s)[16], float x) {
#pragma unroll
    for (int i = 15; i >= 1; --i) s[i] = __builtin_amdgcn_fmed3f(s[i - 1], s[i], x);
    s[0] = fmaxf(s[0], x);
}


struct OneUnitOrder {
    pg8::StaticOrder base; int round;
    __device__ __forceinline__ bool next(int i, pg8::Unit& u) const { if (i != 0) return false; return base.next(round, u); }
    __device__ __forceinline__ void a_ready(const pg8::Unit&) const {}
    __device__ __forceinline__ void done(const pg8::Unit&) const {}
};
struct EpiTopkMF {
    static constexpr bool PERM = false, AFTER_DRAIN = true;
    const float* part2; const float* bias_q; unsigned short* ids; float* gates;
    __device__ __forceinline__ void operator()(const pg8::f32x4 (&)[2][2][4][2], const pg8::Unit&, int, int, int, int) const {}
    __device__ __forceinline__ void fused(pg8::f32x4 (&acc)[2][2][4][2], const pg8::Unit& u, int wr, int wc, int fr, int fq, PG8_LAS unsigned char* lds, int wid, int lane) const {
        typedef pg8::f32x4 f32x4;
        constexpr int SLD = 260;
        PG8_LAS float* SC = (PG8_LAS float*)lds; PG8_LAS float* MG = (PG8_LAS float*)(lds + 128 * SLD * 4);
        const int tid = wid * 64 + lane, tok = tid & 255, hk = tid >> 8;
        float rinv[2][4];
#pragma unroll
        for (int ai = 0; ai < 2; ++ai)
#pragma unroll
            for (int m = 0; m < 4; ++m) {
                const int row = u.pm * 256 + ai * 128 + wr * 64 + m * 16 + fr;
                const f32x4* pp = (const f32x4*)(part2 + (size_t)row * 16);
                const f32x4 p0 = pp[0], p1 = pp[1], p2 = pp[2], p3 = pp[3];
                const float ssum = ((p0[0] + p0[1]) + (p0[2] + p0[3])) + ((p1[0] + p1[1]) + (p1[2] + p1[3])) + ((p2[0] + p2[1]) + (p2[2] + p2[3])) + ((p3[0] + p3[1]) + (p3[2] + p3[3]));
                rinv[ai][m] = 1.0f / sqrtf(ssum * (1.0f / D) + EPS);
            }
        float sl[16], mine[16];
#pragma unroll
        for (int p = 0; p < 2; ++p) {
            f32x4 bv[2];
#pragma unroll
            for (int n = 0; n < 2; ++n) bv[n] = *(const f32x4*)(bias_q + u.pn * 256 + p * 128 + wc * 32 + n * 16 + 4 * fq);
#pragma unroll
            for (int ai = 0; ai < 2; ++ai)
#pragma unroll
                for (int m = 0; m < 4; ++m)
#pragma unroll
                    for (int n = 0; n < 2; ++n)
#pragma unroll
                        for (int j = 0; j < 4; ++j)
                            SC[(32 * wc + 16 * n + 4 * fq + j) * SLD + (128 * ai + 64 * wr + 16 * m + fr)] = acc[ai][p][m][n][j] * rinv[ai][m] + bv[n][j];
            __syncthreads();
#pragma unroll
            for (int i = 0; i < 16; ++i) sl[i] = -INFINITY;
#pragma unroll 8
            for (int k = 0; k < 64; ++k) { const int key = 64 * hk + k; const float x = SC[key * SLD + tok]; ins16(sl, __uint_as_float((__float_as_uint(x) & 0xFFFFFF80u) | (unsigned)key)); }
            if (hk != p) {
#pragma unroll
                for (int i = 0; i < 16; ++i) MG[i * 256 + tok] = sl[i];
            }
            __syncthreads();
            if (hk == p) {
#pragma unroll
                for (int i = 0; i < 16; ++i) ins16(sl, MG[i * 256 + tok]);
#pragma unroll
                for (int i = 0; i < 16; ++i) mine[i] = sl[i];
            }
            __syncthreads();
        }
        PG8_LAS float* X1 = SC; PG8_LAS float* TL = SC + 4096; PG8_LAS unsigned* I0 = (PG8_LAS unsigned*)(SC + 8192); PG8_LAS unsigned* I1 = (PG8_LAS unsigned*)(SC + 12288);
        if (hk) {
#pragma unroll
            for (int i = 0; i < 16; ++i) { X1[i * 256 + tok] = mine[i]; I1[i * 256 + tok] = __float_as_uint(mine[i]) & 0x7Fu; }
        } else {
#pragma unroll
            for (int i = 0; i < 16; ++i) I0[i * 256 + tok] = __float_as_uint(mine[i]) & 0x7Fu;
        }
        __syncthreads();
        if (!hk) {
            float s1m[16], tl[16];
#pragma unroll
            for (int i = 0; i < 16; ++i) { s1m[i] = __uint_as_float(__float_as_uint(X1[i * 256 + tok]) & 0xFFFFFF80u); mine[i] = __uint_as_float(__float_as_uint(mine[i]) & 0xFFFFFF80u); tl[i] = -INFINITY; }
#pragma unroll
            for (int a2 = 0; a2 < 16; ++a2)
#pragma unroll
                for (int b2 = 0; b2 < 16; ++b2)
                    if ((a2 + 1) * (b2 + 1) <= 16) ins16(tl, __uint_as_float((__float_as_uint(mine[a2] + s1m[b2]) & 0xFFFFFF00u) | (unsigned)(a2 * 16 + b2)));
#pragma unroll
            for (int i = 0; i < 16; ++i) TL[i * 256 + tok] = tl[i];
        }
        __syncthreads();
        if (hk) {
            float ev[16]; float sum = 0.f; unsigned cd[16];
#pragma unroll
            for (int j = 0; j < 16; ++j) { const unsigned bits = __float_as_uint(TL[j * 256 + tok]); cd[j] = bits & 0xFFu; ev[j] = __uint_as_float(bits & 0xFFFFFF00u); }
            const float mx = ev[0];
#pragma unroll
            for (int j = 0; j < 16; ++j) { ev[j] = __expf(ev[j] - mx); sum += ev[j]; }
            const float inv = 1.f / sum;
            unsigned idw[8];
#pragma unroll
            for (int j = 0; j < 16; ++j) {
                const unsigned id = I0[(cd[j] >> 4) * 256 + tok] * 128u + I1[(cd[j] & 15u) * 256 + tok];
                if (j & 1) idw[j >> 1] |= id << 16; else idw[j >> 1] = id;
                ev[j] *= inv;
            }
            const size_t t = (size_t)u.pm * 256 + tok;
            unsigned short* idp = ids + t * 128 + u.pn * 16; float* gp = gates + t * 128 + u.pn * 16;
            *(uint4*)idp = make_uint4(idw[0], idw[1], idw[2], idw[3]); *(uint4*)(idp + 8) = make_uint4(idw[4], idw[5], idw[6], idw[7]);
#pragma unroll
            for (int q = 0; q < 4; ++q) *(float4*)(gp + 4 * q) = make_float4(ev[4 * q], ev[4 * q + 1], ev[4 * q + 2], ev[4 * q + 3]);
        }
        __syncthreads();
    }
};


__device__ __forceinline__ void convert_tables(const float* down, const float* up, unsigned char* q8, unsigned char* qexp, int lane, int cw, int nconv, int r0, int r1) {
    for (int row0 = r0 + cw * 2; row0 < r1; row0 += nconv * 2) {
        float4 v[2][4]; float mx[2] = {0.f, 0.f};
#pragma unroll
        for (int rr = 0; rr < 2; ++rr) {
            const int row = row0 + rr, isup = row >> 14, e = row & 16383;
            const float* sp = (isup ? up : down) + (size_t)e * 1024 + lane * 4;
#pragma unroll
            for (int q = 0; q < 4; ++q) v[rr][q] = ld_nt4(sp + 256 * q);
        }
#pragma unroll
        for (int rr = 0; rr < 2; ++rr) {
#pragma unroll
            for (int q = 0; q < 4; ++q) mx[rr] = fmaxf(mx[rr], fmaxf(fmaxf(fabsf(v[rr][q].x), fabsf(v[rr][q].y)), fmaxf(fabsf(v[rr][q].z), fabsf(v[rr][q].w))));
#pragma unroll
            for (int o = 32; o > 0; o >>= 1) mx[rr] = fmaxf(mx[rr], __shfl_xor(mx[rr], o));
            const int row = row0 + rr, isup = row >> 14, e = row & 16383;
            const float s = (mx[rr] > 0.f) ? exp2f(floorf(log2f(256.f / mx[rr]))) : 1.f;
#pragma unroll
            for (int q = 0; q < 4; ++q) {
                int pk = __builtin_amdgcn_cvt_pk_fp8_f32(v[rr][q].x * s, v[rr][q].y * s, 0, false); pk = __builtin_amdgcn_cvt_pk_fp8_f32(v[rr][q].z * s, v[rr][q].w * s, pk, true);
                *(unsigned*)(q8 + (size_t)isup * (16u << 20) + ((size_t)(2 * q + (lane >> 5)) * 16384 + e) * 128 + (lane & 7) * 16 + ((lane & 31) >> 3) * 4) = (unsigned)pk;
            }
            if (lane == 0) qexp[row] = (unsigned char)((__float_as_uint(1.0f / s) >> 23) & 0xffu);
        }
    }
}

struct Params {
    const float *x, *c; const int* pos; const float *ada_w, *ada_b, *g1, *g2, *w_in, *rgain, *qg, *kg, *og, *w_out, *wq, *sk, *down, *up;
    float* out; unsigned char* ws; RopeC rc;
};

__global__ void __launch_bounds__(512) mk_fwd(Params p) {
    extern __shared__ __attribute__((aligned(16))) unsigned char lds[];
    const int tid = threadIdx.x, lane = tid & 63, wave = tid >> 6, bid = blockIdx.x, G = gridDim.x;
    unsigned char* ws = p.ws;
    float* mod = (float*)(ws + OFF_MOD); float* rinv1 = (float*)(ws + OFF_RINV1); float* ftab = (float*)(ws + OFF_ROPE);
    bf16_t* P = (bf16_t*)(ws + OFF_P); float* kv = (float*)(ws + OFF_KV); bf16_t* stT = (bf16_t*)(ws + OFF_ST); bf16_t* ycat = (bf16_t*)(ws + OFF_YCAT);
    bf16_t* xb = (bf16_t*)(ws + OFF_XB); bf16_t* Win_t = (bf16_t*)(ws + OFF_WINT); float* bias_f = (float*)(ws + OFF_BIASF);
    bf16_t* Weff_t = (bf16_t*)(ws + OFF_WEFFT); bf16_t* Wout_t = (bf16_t*)(ws + OFF_WOUTT); float* bias_q = (float*)(ws + OFF_BIASQ); float* bq_part = (float*)(ws + OFF_BQPART);
    float* part2 = (float*)(ws + OFF_PART2); bf16_t* x1b = (bf16_t*)(ws + OFF_X1B); unsigned short* ids = (unsigned short*)(ws + OFF_IDS); unsigned char* q8 = ws + OFF_Q8; unsigned char* qexp = ws + OFF_QSC; float* gates = (float*)(ws + OFF_GATES);
    const size_t PS = (size_t)T * 512;
    const bf16_t *Qr = P, *Kr = P + PS, *Gr = P + 2 * PS, *Qs = P + 3 * PS, *Ks = P + 4 * PS, *Vr = P + 6 * PS, *Vs = P + 7 * PS;
    float* out = p.out; float* x1 = (float*)(ws + OFF_X1);

    if (tid < 4) ((LAS unsigned*)((LAS unsigned char*)lds + LDS_ST_OFF))[tid] = 0u;
    __syncthreads();
    XcdBarrier bar = xcd_barrier_post((unsigned*)(ws + OFF_CTL), (volatile LAS unsigned*)((LAS unsigned char*)lds + LDS_ST_OFF));

    for (int u = bid; u < 256; u += G) gemv_cols<6>(lds, VfSilu{p.c}, p.ada_w, 6144, u, mod, p.ada_b);
    for (int row0 = (bid * 8 + wave) * 2; row0 < T; row0 += G * 16) {
        float4 v[2][4];
#pragma unroll
        for (int rr = 0; rr < 2; ++rr)
#pragma unroll
            for (int j = 0; j < 4; ++j) v[rr][j] = ld_nt4(p.x + (size_t)(row0 + rr) * D + (lane + 64 * j) * 4);
#pragma unroll
        for (int rr = 0; rr < 2; ++rr) {
            uint2* xo = (uint2*)(xb + (size_t)(row0 + rr) * D);
            float s = 0.f;
#pragma unroll
            for (int j = 0; j < 4; ++j) { const float4 q = v[rr][j]; s += q.x * q.x + q.y * q.y + q.z * q.z + q.w * q.w; xo[lane + 64 * j] = make_uint2(pk2(q.x, q.y), pk2(q.z, q.w)); }
#pragma unroll
            for (int o = 32; o > 0; o >>= 1) s += __shfl_xor(s, o);
            if (lane == 0) rinv1[row0 + rr] = 1.0f / sqrtf(s * (1.0f / D) + EPS);
        }
    }
    if (bid == 0 && tid == 0) {
#pragma unroll
        for (int i = 0; i < 32; ++i) { ftab[i] = p.rc.fh[i]; ftab[32 + i] = p.rc.fl[i]; }
    }
    xcd_barrier(bar);

    {
        float* scr = (float*)(lds + wave * 16384);
        for (int it = bid * 8 + wave; it < 16 * 112; it += G * 8) transpose_item<true, true>(p.w_in, 1024, 3584, Win_t, scr, it, lane, p.g1, mod + 1024);
        __syncthreads();
        for (int u = bid; u < 128; u += G) gemv_cols<7>(lds, VfVec{mod}, p.w_in, 3584, u, bias_f, nullptr);
    }
    xcd_barrier(bar);

    {
        pg8::Gemm g{xb, Win_t, T, 3584, 1024}; pg8::StaticOrder S; S.init(T, 3584, G, bid);
        EpiInprojMF E{P, rinv1, bias_f, p.pos, ftab, p.qg, p.kg};
        pg8::gemm_phase<EpiInprojMF, pg8::StaticOrder>((PG8_LAS unsigned char*)lds, g, S, E);
        const int nidle = (G > 128) ? G - 128 : G, ib = (G > 128) ? bid - 128 : bid;
        {
            float* scr = (float*)(lds + wave * 16384);
            if (ib >= 0) for (int it = ib * 8 + wave; it < 16 * 32; it += nidle * 8) transpose_item<false, false>(p.w_out, 1024, 1024, Wout_t, scr, it, lane, nullptr, nullptr);
            __syncthreads();
        }
        if (ib >= 0 && ib < 128) {
            const int hp = ib >> 3, blk = ib & 7;
            float* skT = (float*)lds; float* wqs = (float*)(lds + 69632);
            for (int e = tid; e < 16384; e += 512) { const int k = e >> 7, c = e & 127; skT[c * 132 + k] = p.sk[((size_t)hp * 128 + k) * 128 + c]; }
            float bacc[16];
#pragma unroll
            for (int j = 0; j < 16; ++j) bacc[j] = 0.f;
            for (int rbk = 0; rbk < 2; ++rbk) {
                const int i0 = (blk * 2 + rbk) * 64;
                __syncthreads();
                for (int e = tid; e < 8192; e += 512) { const int r = e >> 7, c = e & 127; wqs[r * 129 + c] = p.wq[(size_t)(i0 + r) * 2048 + hp * 128 + c]; }
                __syncthreads();
                float acc[16];
#pragma unroll
                for (int j = 0; j < 16; ++j) acc[j] = 0.f;
                const float* wrow = wqs + lane * 129; const float* skc = skT + 16 * wave;
#pragma unroll 4
                for (int c = 0; c < 128; ++c) {
                    const float av = wrow[c];
                    const float4 b0 = *(const float4*)(skc + c * 132), b1 = *(const float4*)(skc + c * 132 + 4), b2 = *(const float4*)(skc + c * 132 + 8), b3 = *(const float4*)(skc + c * 132 + 12);
                    acc[0] += av * b0.x; acc[1] += av * b0.y; acc[2] += av * b0.z; acc[3] += av * b0.w; acc[4] += av * b1.x; acc[5] += av * b1.y; acc[6] += av * b1.z; acc[7] += av * b1.w;
                    acc[8] += av * b2.x; acc[9] += av * b2.y; acc[10] += av * b2.z; acc[11] += av * b2.w; acc[12] += av * b3.x; acc[13] += av * b3.y; acc[14] += av * b3.z; acc[15] += av * b3.w;
                }
                const int i = i0 + lane;
                const float s2v = p.g2[i] * (1.f + mod[4096 + i]), sh = mod[3072 + i];
#pragma unroll
                for (int j = 0; j < 16; ++j) { Weff_t[(size_t)(hp * 128 + 16 * wave + j) * 1024 + i] = f2bf(acc[j] * s2v); bacc[j] += sh * acc[j]; }
            }
#pragma unroll
            for (int j = 0; j < 16; ++j) { float v = bacc[j];
#pragma unroll
                for (int o = 32; o > 0; o >>= 1) v += __shfl_xor(v, o);
                if (lane == 0) bq_part[(size_t)blk * 2048 + hp * 128 + 16 * wave + j] = v; }
            __syncthreads();
        }
        if (ib >= 0) convert_tables(p.down, p.up, q8, qexp, lane, ib * 8 + wave, nidle * 8, 0, CONV_SPLIT);
    }
    xcd_barrier(bar);

    {
        const int gw = __builtin_amdgcn_readfirstlane(bid * 8 + wave), NGW = G * 8, l31 = lane & 31, hf = lane >> 5;
        const int wv0 = __builtin_amdgcn_readfirstlane(wave);
        for (int U = gw; U < 1024; U += NGW) {
            const int n = U >> 3, h = U & 7;
            f32x16 C[2][2];
#pragma unroll
            for (int a = 0; a < 2; ++a)
#pragma unroll
                for (int b = 0; b < 2; ++b)
#pragma unroll
                    for (int r = 0; r < 16; ++r) C[a][b][r] = 0.f;
            unsigned char* Kt = lds + wv0 * 9216; unsigned char* Vt = Kt + 4608;
            const int r8 = lane >> 3, pc = lane & 7, trq = (lane & 15) >> 2, trp = lane & 3, trd = (lane >> 4) & 1;
            const char* kbase = (const char*)(Kr + (size_t)n * 128 * 512 + h * 64); const char* vbase = (const char*)(Vr + (size_t)n * 128 * 512 + h * 64);
            const unsigned loff = (unsigned)(r8 * 512 + pc * 8) * 2u;
            const float lg = lg2_head(h);
            pg8::u32x4 gK[4], gV[4];
#pragma unroll
            for (int i = 0; i < 4; ++i) { gK[i] = *(const pg8::u32x4*)(kbase + (loff + i * 8192u)); gV[i] = *(const pg8::u32x4*)(vbase + (loff + i * 8192u)); }
            for (int sb4 = 0; sb4 < 4; ++sb4) {
#pragma unroll
                for (int i = 0; i < 4; ++i) { *(pg8::u32x4*)(Kt + (8 * i + r8) * 144 + pc * 16) = gK[i]; *(pg8::u32x4*)(Vt + (8 * i + r8) * 144 + pc * 16) = gV[i]; }
                { const int sn = (sb4 < 3) ? sb4 + 1 : sb4;
#pragma unroll
                  for (int i = 0; i < 4; ++i) { gK[i] = *(const pg8::u32x4*)(kbase + (size_t)sn * 32768 + (loff + i * 8192u)); gV[i] = *(const pg8::u32x4*)(vbase + (size_t)sn * 32768 + (loff + i * 8192u)); } }
#pragma unroll
                for (int s = 0; s < 2; ++s) {
                    bf16x8 Af[2], Bf[2];
#pragma unroll
                    for (int a = 0; a < 2; ++a) {
                        Af[a] = tr_frag(Vt + (16 * s + 8 * hf + trq) * 144 + (32 * a + 16 * trd + 4 * trp) * 2, 4);
                        const bf16x8 kraw = tr_frag(Kt + (16 * s + 8 * hf + trq) * 144 + (32 * a + 16 * trd + 4 * trp) * 2, 4);
                        const pg8::u32x4 kw = __builtin_bit_cast(pg8::u32x4, kraw); const unsigned kk[4] = {kw.x, kw.y, kw.z, kw.w};
                        pg8::u32x4 o; unsigned* op = (unsigned*)&o;
#pragma unroll
                        for (int e2 = 0; e2 < 4; ++e2) {
                            const int j0 = 32 * sb4 + 16 * s + 8 * hf + 2 * e2;
                            const float z0 = __builtin_amdgcn_exp2f((float)(127 - j0) * lg), z1 = __builtin_amdgcn_exp2f((float)(126 - j0) * lg);
                            op[e2] = pg8::cvt_pk_bf16(__uint_as_float(kk[e2] << 16) * z0, __uint_as_float(kk[e2] & 0xffff0000u) * z1);
                        }
                        Bf[a] = __builtin_bit_cast(bf16x8, o);
                    }
#pragma unroll
                    for (int a = 0; a < 2; ++a)
#pragma unroll
                        for (int b = 0; b < 2; ++b) C[a][b] = MFMA32(Af[a], Bf[b], C[a][b]);
                }
            }
            float* dst = kv + (size_t)(n * 8 + h) * 4096;
#pragma unroll
            for (int a = 0; a < 2; ++a)
#pragma unroll
                for (int b = 0; b < 2; ++b)
#pragma unroll
                    for (int r = 0; r < 16; ++r) dst[(32 * a + (r & 3) + 8 * (r >> 2) + 4 * hf) * 64 + 32 * b + l31] = C[a][b][r];
        }
        bf16x8 Tri[2];
        {
            pg8::u32x4 w0, w1; unsigned* p0 = (unsigned*)&w0; unsigned* p1 = (unsigned*)&w1;
#pragma unroll
            for (int e2 = 0; e2 < 4; ++e2) {
                unsigned a0 = 0, a1 = 0;
#pragma unroll
                for (int q = 0; q < 2; ++q) { const int e = 2 * e2 + q, ip = 8 * (e >> 2) + 4 * hf + (e & 3);
                    a0 |= ((ip > l31) ? 0x3F80u : 0u) << (16 * q); a1 |= ((16 + ip > l31) ? 0x3F80u : 0u) << (16 * q); }
                p0[e2] = a0; p1[e2] = a1;
            }
            Tri[0] = __builtin_bit_cast(bf16x8, w0); Tri[1] = __builtin_bit_cast(bf16x8, w1);
        }
        const bool sb_local = (G % 8 == 0) && (4096 % G == 0) && ((4096 / G) % 8 == 0);
        const int sb_per_wave = sb_local ? 4096 / G / 8 : (4096 + NGW - 1 - gw) / NGW;
        const int wv = __builtin_amdgcn_readfirstlane(wave);
        for (int ps = 0; ps < sb_per_wave; ++ps) {
            const int U = sb_local ? 0 : gw + ps * NGW;
            const int h = sb_local ? (bid & 7) : (U & 7), qt = sb_local ? (bid >> 3) * (4096 / G) + ps * 8 + wv : (U >> 3), q0 = qt * 32;
            f32x16 O[2];
#pragma unroll
            for (int r = 0; r < 16; ++r) { O[0][r] = 0.f; O[1][r] = 0.f; }
            float carry = 0.f;
            unsigned char* Kt = lds + wv * 9216; unsigned char* Vt = Kt + 4608;
            const int r8 = lane >> 3, pc = lane & 7;
            const char* kbase = (const char*)(Ks + h * 64); const char* vbase = (const char*)(Vs + h * 64);
            const unsigned loff = (unsigned)(r8 * 512 + pc * 8) * 2u;
            pg8::u32x4 gK[4], gV[4];
            bf16x8 Qf[4];
            {
                const char* qbase = (const char*)(Qs + h * 64);
#pragma unroll
                for (int i = 0; i < 4; ++i) gK[i] = *(const pg8::u32x4*)(qbase + (size_t)qt * 32768 + (loff + i * 8192u));
#pragma unroll
                for (int i = 0; i < 4; ++i) *(pg8::u32x4*)(Kt + (8 * i + r8) * 144 + pc * 16) = gK[i];
#pragma unroll
                for (int s = 0; s < 4; ++s) Qf[s] = *(const bf16x8*)(Kt + l31 * 144 + 32 * s + 16 * hf);
            }
#pragma unroll
            for (int i = 0; i < 4; ++i) { gK[i] = *(const pg8::u32x4*)(kbase + (size_t)qt * 32768 + (loff + i * 8192u)); gV[i] = *(const pg8::u32x4*)(vbase + (size_t)qt * 32768 + (loff + i * 8192u)); }
            const int trq = (lane & 15) >> 2, trp = lane & 3, trd = (lane >> 4) & 1;
            for (int kb = qt; kb >= 0; --kb) {
#pragma unroll
                for (int i = 0; i < 4; ++i) { *(pg8::u32x4*)(Kt + (8 * i + r8) * 144 + pc * 16) = gK[i]; *(pg8::u32x4*)(Vt + (8 * i + r8) * 144 + pc * 16) = gV[i]; }
                {
                    const int kbn = (kb > 0) ? kb - 1 : 0;
#pragma unroll
                    for (int i = 0; i < 4; ++i) { gK[i] = *(const pg8::u32x4*)(kbase + (size_t)kbn * 32768 + (loff + i * 8192u)); gV[i] = *(const pg8::u32x4*)(vbase + (size_t)kbn * 32768 + (loff + i * 8192u)); }
                }
                bf16x8 Kf[4], Vf[2][2];
#pragma unroll
                for (int s = 0; s < 4; ++s) Kf[s] = *(const bf16x8*)(Kt + l31 * 144 + 32 * s + 16 * hf);
#pragma unroll
                for (int s = 0; s < 2; ++s)
#pragma unroll
                    for (int dt = 0; dt < 2; ++dt) {
                        Vf[s][dt] = tr_frag(Vt + (16 * s + 4 * hf + trq) * 144 + (32 * dt + 16 * trd + 4 * trp) * 2, 8);
                    }
                f32x16 S;
#pragma unroll
                for (int r = 0; r < 16; ++r) S[r] = 0.f;
#pragma unroll
                for (int s = 0; s < 4; ++s) S = MFMA32(Kf[s], Qf[s], S);
                const bool diag = (kb == qt);
                f32x16 sp, lb;
                float csum = 0.f;
                if (diag) {
#pragma unroll
                    for (int r = 0; r < 16; ++r) {
                        const int i = (r & 3) + 8 * (r >> 2) + 4 * hf;
                        const float z = S[r];
                        const float l1p = __builtin_amdgcn_logf(1.0f + __builtin_amdgcn_exp2f(-fabsf(z)));
                        const float spv = (i < l31) ? (fmaxf(z, 0.f) + l1p) : 0.f;
                        sp[r] = spv; lb[r] = (i < l31) ? (fminf(z, 0.f) - l1p) : -INFINITY; csum += spv;
                    }
                } else {
#pragma unroll
                    for (int r = 0; r < 16; ++r) {
                        const float z = S[r];
                        const float l1p = __builtin_amdgcn_logf(1.0f + __builtin_amdgcn_exp2f(-fabsf(z)));
                        const float spv = fmaxf(z, 0.f) + l1p;
                        sp[r] = spv; lb[r] = fminf(z, 0.f) - l1p; csum += spv;
                    }
                }
                f32x16 Rt;
#pragma unroll
                for (int r = 0; r < 16; ++r) Rt[r] = carry;
#pragma unroll
                for (int s = 0; s < 2; ++s) Rt = MFMA32(Tri[s], pack_frag(sp, s), Rt);
                f32x16 wv;
#pragma unroll
                for (int r = 0; r < 16; ++r) wv[r] = __builtin_amdgcn_exp2f(lb[r] - Rt[r]);
#pragma unroll
                for (int s = 0; s < 2; ++s) { const bf16x8 wp = pack_frag(wv, s);
#pragma unroll
                    for (int dt = 0; dt < 2; ++dt) O[dt] = MFMA32(Vf[s][dt], wp, O[dt]); }
                csum += __shfl_xor(csum, 32);
                carry += csum;
                if (__all(carry > 127.f)) break;
            }
            float ss = 0.f;
#pragma unroll
            for (int r = 0; r < 16; ++r) ss += O[0][r] * O[0][r] + O[1][r] * O[1][r];
            ss += __shfl_xor(ss, 32);
            const float rn = 1.0f / sqrtf(ss * (1.f / 64.f) + EPS);
#pragma unroll
            for (int dt = 0; dt < 2; ++dt)
#pragma unroll
                for (int g4 = 0; g4 < 4; ++g4) {
                    const int d = 32 * dt + 8 * g4 + 4 * hf;
                    const float4 gn = *(const float4*)(p.og + d);
                    uint2 w; w.x = pg8::cvt_pk_bf16(O[dt][4 * g4] * rn * gn.x, O[dt][4 * g4 + 1] * rn * gn.y); w.y = pg8::cvt_pk_bf16(O[dt][4 * g4 + 2] * rn * gn.z, O[dt][4 * g4 + 3] * rn * gn.w);
                    *(uint2*)(Kt + l31 * 144 + d * 2) = w;
                }
#pragma unroll
            for (int i = 0; i < 4; ++i) *(pg8::u32x4*)(ycat + (size_t)(q0 + 8 * i + r8) * 1024 + 512 + h * 64 + pc * 8) = *(const pg8::u32x4*)(Kt + (8 * i + r8) * 144 + pc * 16);
        }
    }
    xcd_barrier(bar);

    if (bid == 255 % G) for (int n = tid; n < 2048; n += 512) { float s = 0.f;
#pragma unroll
        for (int b8 = 0; b8 < 8; ++b8) s += bq_part[(size_t)b8 * 2048 + n];
        bias_q[n] = s; }
    if (G > 64 && bid >= 64) convert_tables(p.down, p.up, q8, qexp, lane, (bid - 64) * 8 + wave, (G - 64) * 8, CONV_SPLIT, 32768);
    else if (G <= 64) convert_tables(p.down, p.up, q8, qexp, lane, bid * 8 + wave, G * 8, CONV_SPLIT, 32768);
    for (int idx = bid * 512 + tid; idx < 32768; idx += G * 512) {
        const int h = idx >> 12;
        const float cd = exp2f(128.f * lg2_head(h));
        float s = 0.f;
        for (int n0 = 0; n0 < 128; n0 += 32) {
            float kvv[32];
#pragma unroll
            for (int q = 0; q < 32; ++q) kvv[q] = kv[(size_t)(n0 + q) * 32768 + idx];
#pragma unroll
            for (int q = 0; q < 32; ++q) { stT[(size_t)(n0 + q) * 32768 + idx] = f2bf(s); s = cd * s + kvv[q]; }
        }
    }
    xcd_barrier(bar);

    {
        const int gw = __builtin_amdgcn_readfirstlane(bid * 8 + wave), NGW = G * 8, l31 = lane & 31, hf = lane >> 5;
        const int wv4 = __builtin_amdgcn_readfirstlane(wave);
        for (int W2 = gw; W2 < 2048; W2 += NGW) {
            const int nh = W2 >> 1, n = nh >> 3, h = nh & 7;
            const float lg = lg2_head(h);
#pragma unroll 1
            for (int pass = 0; pass < 2; ++pass) {
                const int qt = (W2 & 1) ? (pass ? 2 : 1) : (pass ? 3 : 0);
                const int il = qt * 32 + l31, tq = n * 128 + il;
                unsigned char* Kt = lds + wv4 * 9216; unsigned char* Vt = Kt + 4608;
                const int r8 = lane >> 3, pc = lane & 7, trq = (lane & 15) >> 2, trp = lane & 3, trd = (lane >> 4) & 1;
                const unsigned loff = (unsigned)(r8 * 512 + pc * 8) * 2u;
                pg8::u32x4 gK[4], gV[4];
                bf16x8 Qf[4];
                {
                    const char* qbase = (const char*)(Qr + (size_t)(n * 128 + qt * 32) * 512 + h * 64);
                    const char* sbase = (const char*)(stT + (size_t)nh * 4096) + (unsigned)(r8 * 64 + pc * 8) * 2u;
#pragma unroll
                    for (int i = 0; i < 4; ++i) gK[i] = *(const pg8::u32x4*)(qbase + (loff + i * 8192u));
#pragma unroll
                    for (int i = 0; i < 4; ++i) *(pg8::u32x4*)(Kt + (8 * i + r8) * 144 + pc * 16) = gK[i];
#pragma unroll
                    for (int s = 0; s < 4; ++s) Qf[s] = *(const bf16x8*)(Kt + l31 * 144 + 32 * s + 16 * hf);
#pragma unroll
                    for (int i = 0; i < 4; ++i) { gK[i] = *(const pg8::u32x4*)(sbase + i * 1024u); gV[i] = *(const pg8::u32x4*)(sbase + 4096u + i * 1024u); }
#pragma unroll
                    for (int i = 0; i < 4; ++i) { *(pg8::u32x4*)(Kt + (8 * i + r8) * 144 + pc * 16) = gK[i]; *(pg8::u32x4*)(Kt + (32 + 8 * i + r8) * 144 + pc * 16) = gV[i]; }
                }
                f32x16 O[2];
#pragma unroll
                for (int r = 0; r < 16; ++r) { O[0][r] = 0.f; O[1][r] = 0.f; }
#pragma unroll
                for (int s = 0; s < 4; ++s)
#pragma unroll
                    for (int dt = 0; dt < 2; ++dt) O[dt] = MFMA32(*(const bf16x8*)(Kt + (32 * dt + l31) * 144 + 32 * s + 16 * hf), Qf[s], O[dt]);
                const float xi = exp2f((float)(il + 1) * lg);
#pragma unroll
                for (int r = 0; r < 16; ++r) { O[0][r] *= xi; O[1][r] *= xi; }
                const char* kbase = (const char*)(Kr + (size_t)n * 128 * 512 + h * 64); const char* vbase = (const char*)(Vr + (size_t)n * 128 * 512 + h * 64);
#pragma unroll
                for (int i = 0; i < 4; ++i) { gK[i] = *(const pg8::u32x4*)(kbase + (loff + i * 8192u)); gV[i] = *(const pg8::u32x4*)(vbase + (loff + i * 8192u)); }
                for (int jb = 0; jb <= qt; ++jb) {
#pragma unroll
                    for (int i = 0; i < 4; ++i) { *(pg8::u32x4*)(Kt + (8 * i + r8) * 144 + pc * 16) = gK[i]; *(pg8::u32x4*)(Vt + (8 * i + r8) * 144 + pc * 16) = gV[i]; }
                    { const int jn = (jb < qt) ? jb + 1 : jb;
#pragma unroll
                      for (int i = 0; i < 4; ++i) { gK[i] = *(const pg8::u32x4*)(kbase + (size_t)jn * 32768 + (loff + i * 8192u)); gV[i] = *(const pg8::u32x4*)(vbase + (size_t)jn * 32768 + (loff + i * 8192u)); } }
                    bf16x8 Kf[4], Vf[2][2];
#pragma unroll
                    for (int s = 0; s < 4; ++s) Kf[s] = *(const bf16x8*)(Kt + l31 * 144 + 32 * s + 16 * hf);
#pragma unroll
                    for (int s = 0; s < 2; ++s)
#pragma unroll
                        for (int dt = 0; dt < 2; ++dt) Vf[s][dt] = tr_frag(Vt + (16 * s + 4 * hf + trq) * 144 + (32 * dt + 16 * trd + 4 * trp) * 2, 8);
                    f32x16 S;
#pragma unroll
                    for (int r = 0; r < 16; ++r) S[r] = 0.f;
#pragma unroll
                    for (int s = 0; s < 4; ++s) S = MFMA32(Kf[s], Qf[s], S);
#pragma unroll
                    for (int r = 0; r < 16; ++r) {
                        const int jl = jb * 32 + (r & 3) + 8 * (r >> 2) + 4 * hf, dl = il - jl;
                        S[r] = (dl >= 0) ? S[r] * __builtin_amdgcn_exp2f((float)dl * lg) : 0.f;
                    }
#pragma unroll
                    for (int s = 0; s < 2; ++s) { const bf16x8 wp = pack_frag(S, s);
#pragma unroll
                        for (int dt = 0; dt < 2; ++dt) O[dt] = MFMA32(Vf[s][dt], wp, O[dt]); }
                }
                float sm = 0.f;
#pragma unroll
                for (int r = 0; r < 16; ++r) sm += O[0][r] + O[1][r];
                sm += __shfl_xor(sm, 32);
                const float mean = sm * (1.f / 64.f);
                float vs = 0.f;
#pragma unroll
                for (int r = 0; r < 16; ++r) { const float d0 = O[0][r] - mean, d1 = O[1][r] - mean; vs += d0 * d0 + d1 * d1; }
                vs += __shfl_xor(vs, 32);
                const float rstd = 1.0f / sqrtf(vs * (1.f / 64.f) + EPS);
                {
                    const char* gbase = (const char*)(Gr + (size_t)(n * 128 + qt * 32) * 512 + h * 64);
#pragma unroll
                    for (int i = 0; i < 4; ++i) gV[i] = *(const pg8::u32x4*)(gbase + (loff + i * 8192u));
#pragma unroll
                    for (int i = 0; i < 4; ++i) *(pg8::u32x4*)(Vt + (8 * i + r8) * 144 + pc * 16) = gV[i];
                }
#pragma unroll
                for (int dt = 0; dt < 2; ++dt)
#pragma unroll
                    for (int g4 = 0; g4 < 4; ++g4) {
                        const int e = 32 * dt + 8 * g4 + 4 * hf;
                        const float4 gn = *(const float4*)(p.rgain + h * 64 + e);
                        const uint2 gg = *(const uint2*)(Vt + l31 * 144 + e * 2);
                        const float g0 = __uint_as_float(gg.x << 16), g1 = __uint_as_float(gg.x & 0xffff0000u), g2v = __uint_as_float(gg.y << 16), g3 = __uint_as_float(gg.y & 0xffff0000u);
                        uint2 w;
                        w.x = pg8::cvt_pk_bf16((O[dt][4 * g4] - mean) * rstd * gn.x * g0, (O[dt][4 * g4 + 1] - mean) * rstd * gn.y * g1);
                        w.y = pg8::cvt_pk_bf16((O[dt][4 * g4 + 2] - mean) * rstd * gn.z * g2v, (O[dt][4 * g4 + 3] - mean) * rstd * gn.w * g3);
                        *(uint2*)(Kt + l31 * 144 + e * 2) = w;
                    }
#pragma unroll
                for (int i = 0; i < 4; ++i) *(pg8::u32x4*)(ycat + (size_t)(n * 128 + qt * 32 + 8 * i + r8) * 1024 + h * 64 + pc * 8) = *(const pg8::u32x4*)(Kt + (8 * i + r8) * 144 + pc * 16);
            }
        }
    }
    xcd_barrier(bar);

    {
        pg8::Gemm g{ycat, Wout_t, T, 1024, 1024}; pg8::StaticOrder S; S.init(T, 1024, G, bid);
        EpiOutprojMF E{p.x, mod + 2048, x1, x1b, part2};
        pg8::gemm_phase<EpiOutprojMF, pg8::StaticOrder>((PG8_LAS unsigned char*)lds, g, S, E);
    }
    xcd_barrier(bar);

    for (int round = 0; round < 2; ++round) {
        pg8::Gemm g{x1b, Weff_t, T, 2048, 1024}; OneUnitOrder S; S.base.init(T, 2048, G, bid); S.round = round;
        EpiTopkMF E{part2, bias_q, ids, gates};
        pg8::gemm_phase<EpiTopkMF, OneUnitOrder>((PG8_LAS unsigned char*)lds, g, S, E);
    }
    xcd_barrier(bar);

    {
        constexpr int IDS_LD = 136, ACT_LD = 136;
        const float* scale2 = mod + 4096; const float* shift2 = mod + 3072; const float* gate2 = mod + 5120;
        unsigned short* ids_l = (unsigned short*)lds; float* act_l = (float*)(lds + 32768); unsigned char* qe_l = lds + 32768 + 36864;
        const int t0 = bid * 64, tt = lane >> 3, sub = lane & 7, tl = wave * 8 + tt, t = t0 + tl;
        for (int e = tid; e < 1024; e += 512) { const int r = e >> 4, c8 = e & 15; *(uint4*)(ids_l + r * IDS_LD + c8 * 8) = *(const uint4*)(ids + (size_t)(t0 + r) * 128 + c8 * 8); }
        for (int e = tid; e < 64 * ACT_LD; e += 512) act_l[e] = 0.f;
        for (int e = tid; e < 2048; e += 512) ((uint4*)qe_l)[e] = ((const uint4*)qexp)[e];
        __syncthreads();
        float ri;
        { const float4* pp = (const float4*)(part2 + (size_t)t * 16); const float4 p0 = pp[0], p1 = pp[1], p2 = pp[2], p3 = pp[3];
          const float ssum = ((p0.x + p0.y) + (p0.z + p0.w)) + ((p1.x + p1.y) + (p1.z + p1.w)) + ((p2.x + p2.y) + (p2.z + p2.w)) + ((p3.x + p3.y) + (p3.z + p3.w));
          ri = 1.0f / sqrtf(ssum * (1.0f / D) + EPS); }
        const unsigned short* myids = ids_l + tl * IDS_LD;
        float* myact = act_l + tl * ACT_LD;
        const bool s4 = (sub & 4) != 0, s2 = (sub & 2) != 0, s1 = (sub & 1) != 0;
        const unsigned suboff = (unsigned)sub * 16u;
        typedef float f32x2 __attribute__((ext_vector_type(2)));
#define P9_LOAD(W, JB) do { const uint4 idv_ = *(const uint4*)(myids + 8 * (JB)); const unsigned idw_[4] = {idv_.x, idv_.y, idv_.z, idv_.w}; \
        _Pragma("unroll") for (int k_ = 0; k_ < 8; ++k_) { const unsigned id_ = (idw_[k_ >> 1] >> (16 * (k_ & 1))) & 0xffffu; W[k_] = *(const uint4*)(sbase + (id_ * 128u + suboff)); } } while (0)
#define P9_DOWN(W, JB) do { float pd_[8]; \
        _Pragma("unroll") for (int k_ = 0; k_ < 8; ++k_) { const unsigned ww_[4] = {W[k_].x, W[k_].y, W[k_].z, W[k_].w}; f32x2 s_ = {0.f, 0.f}, u_ = {0.f, 0.f}; \
            _Pragma("unroll") for (int m_ = 0; m_ < 4; ++m_) { const f32x2 lo_ = __builtin_amdgcn_cvt_pk_f32_fp8((int)ww_[m_], false), hi_ = __builtin_amdgcn_cvt_pk_f32_fp8((int)ww_[m_], true); \
                s_ = lo_ * hp[2 * m_] + s_; u_ = hi_ * hp[2 * m_ + 1] + u_; } \
            s_ = s_ + u_; pd_[k_] = s_[0] + s_[1]; } \
        float r4_[4], r2_[2]; \
        _Pragma("unroll") for (int k_ = 0; k_ < 4; ++k_) { const float snd_ = s4 ? pd_[k_] : pd_[k_ + 4], kp_ = s4 ? pd_[k_ + 4] : pd_[k_]; r4_[k_] = kp_ + __shfl_xor(snd_, 4); } \
        _Pragma("unroll") for (int k_ = 0; k_ < 2; ++k_) { const float snd_ = s2 ? r4_[k_] : r4_[k_ + 2], kp_ = s2 ? r4_[k_ + 2] : r4_[k_]; r2_[k_] = kp_ + __shfl_xor(snd_, 2); } \
        { const float snd_ = s1 ? r2_[0] : r2_[1], kp_ = s1 ? r2_[1] : r2_[0]; myact[8 * (JB) + sub] += kp_ + __shfl_xor(snd_, 1); } } while (0)
#define P9_UP(W, JB) do { const float4 a0_ = *(const float4*)(myact + 8 * (JB)), a1_ = *(const float4*)(myact + 8 * (JB) + 4); \
        const float av_[8] = {a0_.x, a0_.y, a0_.z, a0_.w, a1_.x, a1_.y, a1_.z, a1_.w}; \
        _Pragma("unroll") for (int k_ = 0; k_ < 8; ++k_) { const unsigned ww_[4] = {W[k_].x, W[k_].y, W[k_].z, W[k_].w}; \
            _Pragma("unroll") for (int m_ = 0; m_ < 4; ++m_) { const f32x2 lo_ = __builtin_amdgcn_cvt_pk_f32_fp8((int)ww_[m_], false), hi_ = __builtin_amdgcn_cvt_pk_f32_fp8((int)ww_[m_], true); \
                o2[2 * m_] = lo_ * av_[k_] + o2[2 * m_]; o2[2 * m_ + 1] = hi_ * av_[k_] + o2[2 * m_ + 1]; } } } while (0)
        for (int c = 0; c < 8; ++c) {
            f32x2 hp[8];
            const int col = 128 * c + 4 * sub;
#pragma unroll
            for (int q = 0; q < 4; ++q) {
                const float4 xv = *(const float4*)(x1 + (size_t)t * D + col + 32 * q);
                const float4 g = *(const float4*)(p.g2 + col + 32 * q), sc = *(const float4*)(scale2 + col + 32 * q), sh = *(const float4*)(shift2 + col + 32 * q);
                hp[2 * q][0] = xv.x * ri * g.x * (1.f + sc.x) + sh.x; hp[2 * q][1] = xv.y * ri * g.y * (1.f + sc.y) + sh.y;
                hp[2 * q + 1][0] = xv.z * ri * g.z * (1.f + sc.z) + sh.z; hp[2 * q + 1][1] = xv.w * ri * g.w * (1.f + sc.w) + sh.w;
            }
            const unsigned char* sbase = q8 + (size_t)c * (16384 * 128);
            uint4 wA[8], wB[8];
            P9_LOAD(wA, 0);
#pragma unroll 1
            for (int jb = 0; jb < 16; jb += 2) {
                P9_LOAD(wB, jb + 1);
                P9_DOWN(wA, jb);
                if (jb + 2 < 16) P9_LOAD(wA, jb + 2);
                P9_DOWN(wB, jb + 1);
            }
        }
        for (int jb = 0; jb < 16; ++jb) {
            const int j = 8 * jb + sub; const unsigned id = myids[j];
            const float a = myact[j] * __uint_as_float((unsigned)qe_l[id] << 23);
            const float av = fabsf(a), tq = 1.0f / (av * 0.2316418882f + 1.0f);
            float ql = tq * 0.5307027145f + (-0.7265760135f); ql = ql * tq + 0.7107068705f; ql = ql * tq + (-0.142248368f); ql = ql * tq + 0.127414796f; ql = ql * tq;
            const float mm = a * (ql * exp2f(a * a * (-0.72134752044f)));
            const float ge = (a < 0.f) ? mm : (a - mm);
            myact[j] = ge * gates[(size_t)t * 128 + j] * __uint_as_float((unsigned)qe_l[16384 + id] << 23);
        }
        __syncthreads();
        for (int c = 0; c < 8; ++c) {
            f32x2 o2[8];
#pragma unroll
            for (int q = 0; q < 8; ++q) o2[q] = (f32x2){0.f, 0.f};
            const int col = 128 * c + 4 * sub;
            const unsigned char* sbase = q8 + (16u << 20) + (size_t)c * (16384 * 128);
            uint4 wA[8], wB[8];
            P9_LOAD(wA, 0);
#pragma unroll 1
            for (int jb = 0; jb < 16; jb += 2) {
                P9_LOAD(wB, jb + 1);
                P9_UP(wA, jb);
                if (jb + 2 < 16) P9_LOAD(wA, jb + 2);
                P9_UP(wB, jb + 1);
            }
#pragma unroll
            for (int q = 0; q < 4; ++q) {
                float* op = out + (size_t)t * D + col + 32 * q;
                const float4 xv = *(const float4*)(x1 + (size_t)t * D + col + 32 * q); const float4 gt = *(const float4*)(gate2 + col + 32 * q);
                float4 r; r.x = xv.x + gt.x * o2[2 * q][0]; r.y = xv.y + gt.y * o2[2 * q][1]; r.z = xv.z + gt.z * o2[2 * q + 1][0]; r.w = xv.w + gt.w * o2[2 * q + 1][1];
                *(float4*)op = r;
            }
        }
#undef P9_LOAD
#undef P9_DOWN
#undef P9_UP
    }
}
}

extern "C" void kernel_launch(void* const* d_in, const int* in_sizes, int n_in, void* d_out, int out_size, void* d_ws, size_t ws_size, hipStream_t stream) {
    static int grid = 0;
    if (grid == 0) {
        int dev = 0, cus = 0, per_cu = 0;
        (void)hipGetDevice(&dev);
        (void)hipDeviceGetAttribute(&cus, hipDeviceAttributeMultiprocessorCount, dev);
        (void)hipFuncSetAttribute((const void*)mk_fwd, hipFuncAttributeMaxDynamicSharedMemorySize, LDS_BYTES);
        (void)hipOccupancyMaxActiveBlocksPerMultiprocessor(&per_cu, (const void*)mk_fwd, 512, LDS_BYTES);
        if (per_cu < 1 || cus != 256) { fprintf(stderr, "kernel_launch: needs 256 CUs with one resident workgroup each (cus %d, per_cu %d)\n", cus, per_cu); grid = -1; }
        else grid = cus;
    }
    if (grid < 0) return;
    (void)hipMemsetAsync((char*)d_ws + OFF_CTL, 0, CTL_BYTES, stream);
    Params p{};
    p.x = (const float*)d_in[0]; p.c = (const float*)d_in[1]; p.pos = (const int*)d_in[2]; p.ada_w = (const float*)d_in[3]; p.ada_b = (const float*)d_in[4];
    p.g1 = (const float*)d_in[5]; p.g2 = (const float*)d_in[6]; p.w_in = (const float*)d_in[7]; p.rgain = (const float*)d_in[8]; p.qg = (const float*)d_in[9];
    p.kg = (const float*)d_in[10]; p.og = (const float*)d_in[11]; p.w_out = (const float*)d_in[12]; p.wq = (const float*)d_in[13]; p.sk = (const float*)d_in[14];
    p.down = (const float*)d_in[15]; p.up = (const float*)d_in[16]; p.out = (float*)d_out; p.ws = (unsigned char*)d_ws;
    for (int i = 0; i < 32; ++i) {
        const double f = pow(10000.0, -(double)i / 32.0) / 6.283185307179586476925;
        float fh = (float)f; unsigned ub; memcpy(&ub, &fh, 4); ub &= 0xFFFFC000u; memcpy(&fh, &ub, 4);
        p.rc.fh[i] = fh; p.rc.fl[i] = (float)(f - (double)fh);
    }
    void* args[] = {&p};
    hipError_t e = hipLaunchCooperativeKernel((const void*)mk_fwd, dim3(grid), dim3(512), args, LDS_BYTES, stream);
    if (e != hipSuccess) fprintf(stderr, "kernel_launch: cooperative launch failed: %s (grid %d)\n", hipGetErrorString(e), grid);
}
```

```cpp
#include <hip/hip_runtime.h>
#include <stdint.h>
#include <math.h>
#include <cstdio>
#include <cstring>

namespace {
constexpr int T = 16384, D = 1024;
constexpr float EPS = 1e-6f;
typedef unsigned short bf16_t;
#define LAS __attribute__((address_space(3)))

__device__ __forceinline__ float bf2f(bf16_t b) { return __uint_as_float(((unsigned)b) << 16); }
__device__ __forceinline__ bf16_t f2bf(float f) { unsigned u = __float_as_uint(f); u += 0x7fffu + ((u >> 16) & 1u); return (bf16_t)(u >> 16); }
__device__ __forceinline__ float4 ld_nt4(const float* p) { typedef float f4v __attribute__((ext_vector_type(4))); const f4v v = __builtin_nontemporal_load((const f4v*)p); return make_float4(v[0], v[1], v[2], v[3]); }

__device__ __forceinline__ float lg2_head(int h) {
    const float x = __uint_as_float((unsigned)(127 - 5 - h) << 23);
    const float s = x * (1.f + x * (0.5f + x * (0.33333334f + x * (0.25f + x * (0.2f + x * 0.16666667f)))));
    return -s * 1.44269504089f;
}
struct RopeC { float fh[32], fl[32]; };
struct RetC { float lg2[8]; };

constexpr size_t MiB = 1u << 20;
constexpr size_t OFF_CTL = 0;
constexpr size_t CTL_BYTES = 64 * 1024;
constexpr size_t OFF_MOD = 64 * 1024, OFF_RINV1 = 128 * 1024, OFF_BIASF = 256 * 1024, OFF_ROPE = 1 * MiB;
constexpr size_t OFF_WINT = 6 * MiB;
constexpr size_t OFF_XB = 16 * MiB;
constexpr size_t OFF_YCAT = 16 * MiB;
constexpr size_t OFF_P = 48 * MiB;
constexpr size_t OFF_KV = 208 * MiB, OFF_ST = 224 * MiB;
constexpr size_t OFF_WEFFT = 240 * MiB;
constexpr size_t OFF_WOUTT = 13 * MiB;
constexpr size_t OFF_BIASQ = 272 * 1024;
constexpr size_t OFF_DSC = 512 * 1024;
constexpr size_t OFF_BQPART = 448 * 1024;
constexpr size_t OFF_PART2 = 5 * MiB;
constexpr size_t OFF_X1B = 208 * MiB;
constexpr size_t OFF_X1 = 48 * MiB;
constexpr size_t OFF_IDS = 244 * MiB, OFF_GATES = 248 * MiB;
constexpr size_t OFF_Q8 = 176 * MiB;
constexpr size_t OFF_QSC = 320 * 1024;
constexpr int CONV_SPLIT = 0;
constexpr int LDS_BYTES = 163840;
constexpr int LDS_ST_OFF = LDS_BYTES - 16;

#define XB_TMO      128
#define XB_XCNT(j)  (256  + 64 * (j))
#define XB_XSUB(j)  (1280 + 64 * (j))
#define XB_XGEN(j)  (2304 + 64 * (j))
#define XB_TOP      3328
#define XB_TOPGEN   3392
#define XCD_BAR_WORDS 3456
#define XB_SPIN_CAP (1u << 20)
__device__ __forceinline__ unsigned xb_ld(unsigned* p)              { return __hip_atomic_load(p, __ATOMIC_RELAXED, __HIP_MEMORY_SCOPE_AGENT); }
__device__ __forceinline__ unsigned xb_add(unsigned* p, unsigned v) { return __hip_atomic_fetch_add(p, v, __ATOMIC_RELAXED, __HIP_MEMORY_SCOPE_AGENT); }
__device__ __forceinline__ unsigned xb_xcc_id() { return (unsigned)__builtin_amdgcn_s_getreg((3 << 11) | 20) & 0xFu; }
#define XB_SPIN(cond, bar) do { unsigned _sp = 0; while (cond) { __builtin_amdgcn_s_sleep(1); \
    if ((++_sp & 255u) == 0u) { if (xb_ld(&(bar)[XB_TMO])) break; if (_sp > XB_SPIN_CAP) { atomicAdd(&(bar)[XB_TMO], 1u); break; } } } } while (0)
struct XcdBarrier { unsigned* bar; unsigned x; volatile LAS unsigned* st; };
__device__ __forceinline__ XcdBarrier xcd_barrier_post(unsigned* bar, volatile LAS unsigned* st) {
    XcdBarrier b; b.bar = bar; b.x = xb_xcc_id(); b.st = st;
    if (threadIdx.x == 0) (void)xb_add(&bar[XB_XCNT(b.x)], 1u);
    return b;
}
__device__ __forceinline__ void xcd_barrier_complete(unsigned* bar, unsigned x, unsigned& nloc, unsigned& nx) {
    const unsigned G = gridDim.x * gridDim.y * gridDim.z;
    unsigned sum, cnt, mine, sp = 0u;
    for (;;) {
        sum = 0u; cnt = 0u; mine = 0u;
#pragma unroll
        for (unsigned j = 0; j < 16; ++j) { const unsigned c = xb_ld(&bar[XB_XCNT(j)]); sum += c; cnt += (c > 0u) ? 1u : 0u; mine = (j == x) ? c : mine; }
        if (sum == G) break;
        __builtin_amdgcn_s_sleep(1);
        if ((++sp & 255u) == 0u) { if (xb_ld(&bar[XB_TMO])) break; if (sp > XB_SPIN_CAP) { atomicAdd(&bar[XB_TMO], 1u); break; } }
    }
    nloc = mine > 0u ? mine : 1u; nx = cnt > 0u ? cnt : 1u;
}
__device__ __forceinline__ void xcd_barrier(const XcdBarrier& b) {
    asm volatile("s_waitcnt vmcnt(0)" ::: "memory");
    __syncthreads();
    if (threadIdx.x == 0) {
        unsigned* bar = b.bar;
        __builtin_amdgcn_s_waitcnt(0);
        unsigned nloc = b.st[0], nx = b.st[1];
        if (nloc == 0u) { xcd_barrier_complete(bar, b.x, nloc, nx); b.st[0] = nloc; b.st[1] = nx; }
        const unsigned old = xb_add(&bar[XB_XSUB(b.x)], 1u);
        const unsigned gen = old / nloc;
        if (old + 1u == (gen + 1u) * nloc) {
            __builtin_amdgcn_fence(__ATOMIC_RELEASE, "agent");
            asm volatile("s_waitcnt vmcnt(0)" ::: "memory");
            const unsigned og = xb_add(&bar[XB_TOP], 1u);
            const unsigned tg = og / nx;
            if (og + 1u == (tg + 1u) * nx) xb_add(&bar[XB_TOPGEN], 1u);
            else XB_SPIN(xb_ld(&bar[XB_TOPGEN]) == tg, bar);
            __builtin_amdgcn_fence(__ATOMIC_ACQUIRE, "agent");
            xb_add(&bar[XB_XGEN(b.x)], 1u);
            asm volatile("s_waitcnt vmcnt(0)" ::: "memory");
        } else {
            XB_SPIN(xb_ld(&bar[XB_XGEN(b.x)]) == gen, bar);
            __builtin_amdgcn_fence(__ATOMIC_ACQUIRE, "agent");
            asm volatile("s_waitcnt vmcnt(0)" ::: "memory");
        }
    }
    __syncthreads();
}


namespace pg8 {
#define PG8_LAS __attribute__((address_space(3)))
typedef short bf16x8 __attribute__((ext_vector_type(8)));
typedef float f32x4 __attribute__((ext_vector_type(4)));
typedef unsigned u32x4 __attribute__((ext_vector_type(4)));
typedef unsigned u32x2 __attribute__((ext_vector_type(2)));
constexpr int BM = 256, BK = 64, HALF = 128, HTB = HALF * BK * 2, STAGE_BYTES = 8 * HTB, NXCD = 8, WGM = 8;
__host__ __device__ __forceinline__ int lds_byte(int r, int c) { const int st = (r >> 4) * 2 + (c >> 5), rr = r & 15, cc = c & 31, ob = rr * 64 + cc * 2; return st * 1024 + (ob ^ (((ob >> 9) & 1) << 5)); }
__host__ __device__ __forceinline__ void stage_rc(int b, int& R, int& C) { const int st = b / 1024, sb = b % 1024, swz = sb ^ (((sb >> 9) & 1) << 5); R = (st >> 1) * 16 + swz / 64; C = (st & 1) * 32 + (swz % 64) / 2; }
__host__ __device__ __forceinline__ int perm32(int rho) { const int n = rho >> 4, i = rho & 15; return 8 * (i >> 2) + 4 * n + (i & 3); }
struct Unit { int pm, pn; };
struct Gemm { const bf16_t* A; const bf16_t* Bt; int M, N, K; };
struct StaticOrder {
    int nM, nN, nwg, G, c;
    __host__ __device__ void init(int M, int N, int G_, int c_) { nM = M / BM; nN = N / BM; nwg = nM * nN; G = G_; c = c_; }
    __host__ __device__ bool next(int i, Unit& u) const {
        const long L = (long)i * G + c; if (L >= nwg) return false;
        int wgid = (int)L; { const int q = nwg / NXCD, r = nwg % NXCD, xcd = wgid % NXCD, off = wgid / NXCD; wgid = (xcd < r ? xcd * (q + 1) : r * (q + 1) + (xcd - r) * q) + off; }
        const int nig = WGM * nN, gid = wgid / nig, fm = gid * WGM, gsz = (nM - fm) < WGM ? (nM - fm) : WGM;
        u.pm = fm + ((wgid % nig) % gsz); u.pn = (wgid % nig) / gsz; return true;
    }
    __device__ __forceinline__ void a_ready(const Unit&) const {}
    __device__ __forceinline__ void done(const Unit&) const {}
};
__device__ __forceinline__ unsigned cvt_pk_bf16(float lo, float hi) { unsigned r; asm volatile("v_cvt_pk_bf16_f32 %0, %1, %2" : "=v"(r) : "v"(lo), "v"(hi)); return r; }

template <class Epi, class Sched>
__device__ __forceinline__ void gemm_phase(PG8_LAS unsigned char* lds, const Gemm g, const Sched& S, const Epi& E) {
    int tid_ = threadIdx.x; asm volatile("" : "+v"(tid_));
    const int tid = tid_, wid = __builtin_amdgcn_readfirstlane(tid >> 6), lane = tid & 63, wr = wid >> 2, wc = wid & 3, fr = lane & 15, fq = lane >> 4;
    const int K = g.K, nt = K / BK;
    unsigned voffA[2], voffB[2];
#pragma unroll
    for (int i = 0; i < 2; ++i) { int R, C; stage_rc(tid * 16 + i * 8192, R, C); const int Rb = Epi::PERM ? ((R & ~31) + perm32(R & 31)) : R;
        voffA[i] = (unsigned)(R * K + C) * 2u; voffB[i] = (unsigned)(Rb * K + C) * 2u; }
    const size_t kstep = (size_t)(BK * 2);
    const size_t hstep = (size_t)HALF * K * 2;
    const size_t tstep = 2 * hstep;
    const unsigned ldsw = (unsigned)wid * 1024u;
    const int aoff = lds_byte(wr * 64 + fr, fq * 8), boff = lds_byte(wc * 32 + fr, fq * 8);
#define PG8_SA(b, h) (((b) * 2 + (h)) * HTB)
#define PG8_SB(b, h) ((4 + (b) * 2 + (h)) * HTB)
#define PG8_STAGE(bufoff, gbase, voff) do { _Pragma("unroll") for (int _i = 0; _i < 2; ++_i) \
        __builtin_amdgcn_global_load_lds((const unsigned*)((const char*)(gbase) + (voff)[_i]), (PG8_LAS unsigned*)(lds + (bufoff) + ldsw + _i * 8192), 16, 0, 0); } while (0)
#define PG8_LDA(dst, b, h) do { _Pragma("unroll") for (int m = 0; m < 4; ++m) _Pragma("unroll") for (int k = 0; k < 2; ++k) dst[m][k] = *(const PG8_LAS bf16x8*)(lds + PG8_SA(b, h) + aoff + m * 2048 + k * 1024); } while (0)
#define PG8_LDB(dst, b, h) do { _Pragma("unroll") for (int n = 0; n < 2; ++n) _Pragma("unroll") for (int k = 0; k < 2; ++k) dst[n][k] = *(const PG8_LAS bf16x8*)(lds + PG8_SB(b, h) + boff + n * 2048 + k * 1024); } while (0)
#define PG8_MMA(ai, bj, At, Bt) do { __builtin_amdgcn_s_setprio(1); _Pragma("unroll") for (int m = 0; m < 4; ++m) _Pragma("unroll") for (int n = 0; n < 2; ++n) _Pragma("unroll") for (int k = 0; k < 2; ++k) \
        acc[ai][bj][m][n] = __builtin_amdgcn_mfma_f32_16x16x32_bf16(Bt[n][k], At[m][k], acc[ai][bj][m][n], 0, 0, 0); __builtin_amdgcn_s_setprio(0); } while (0)
#define PG8_WAIT_V(n) asm volatile("s_waitcnt vmcnt(" #n ")" ::: "memory")
#define PG8_WAIT_L(n) asm volatile("s_waitcnt lgkmcnt(" #n ")" ::: "memory")
#define PG8_BAR __builtin_amdgcn_s_barrier()
#define PG8_SCHED __builtin_amdgcn_sched_barrier(0)
    Unit cur, nxt; int ui = 0;
    if (!S.next(0, cur)) return;
    f32x4 acc[2][2][4][2];
#pragma unroll
    for (int a = 0; a < 2; ++a)
#pragma unroll
        for (int b = 0; b < 2; ++b)
#pragma unroll
            for (int m = 0; m < 4; ++m)
#pragma unroll
                for (int n = 0; n < 2; ++n) acc[a][b][m][n] = (f32x4){0.f, 0.f, 0.f, 0.f};
    bf16x8 At[4][2], B0[2][2], B1[2][2];
    const char* cA = (const char*)g.A + (size_t)cur.pm * tstep; const char* cB = (const char*)g.Bt + (size_t)cur.pn * tstep;
    S.a_ready(cur);
    PG8_STAGE(PG8_SB(0, 0), cB, voffB); PG8_STAGE(PG8_SA(0, 0), cA, voffA); PG8_STAGE(PG8_SB(0, 1), cB + hstep, voffB); PG8_STAGE(PG8_SA(0, 1), cA + hstep, voffA);
    if (wr == 1) PG8_BAR;
    PG8_WAIT_V(4); PG8_BAR;
    PG8_STAGE(PG8_SB(1, 0), cB + kstep, voffB); PG8_STAGE(PG8_SA(1, 0), cA + kstep, voffA); PG8_STAGE(PG8_SB(1, 1), cB + hstep + kstep, voffB);
    PG8_WAIT_V(6); PG8_BAR;
    for (;;) {
        const bool has_next = S.next(ui + 1, nxt);
        const char* nA = has_next ? (const char*)g.A + (size_t)nxt.pm * tstep : cA; const char* nB = has_next ? (const char*)g.Bt + (size_t)nxt.pn * tstep : cB;
        for (int t = 0; t < nt; t += 2) {
            const bool last = (t == nt - 2);
            const char* a1 = cA + (size_t)(t + 1) * kstep;
            const char* a2 = last ? nA : cA + (size_t)(t + 2) * kstep; const char* b2 = last ? nB : cB + (size_t)(t + 2) * kstep;
            const char* a3 = a2 + kstep; const char* b3 = b2 + kstep;
            if (last && has_next) S.a_ready(nxt);
            PG8_LDB(B0, 0, 0); PG8_SCHED; PG8_LDA(At, 0, 0); PG8_STAGE(PG8_SA(1, 1), a1 + hstep, voffA);
            PG8_WAIT_L(8); PG8_BAR; PG8_WAIT_L(0); PG8_MMA(0, 0, At, B0); PG8_BAR; PG8_SCHED;
            PG8_LDB(B1, 0, 1); PG8_STAGE(PG8_SB(0, 0), b2, voffB);
            PG8_BAR; PG8_WAIT_L(0); PG8_MMA(0, 1, At, B1); PG8_BAR;
            PG8_LDA(At, 0, 1); PG8_STAGE(PG8_SA(0, 0), a2, voffA);
            PG8_BAR; PG8_WAIT_L(0); PG8_MMA(1, 0, At, B0); PG8_BAR; PG8_SCHED;
            PG8_STAGE(PG8_SB(0, 1), b2 + hstep, voffB);
            PG8_WAIT_V(6); PG8_BAR; PG8_MMA(1, 1, At, B1); PG8_BAR;
            PG8_LDB(B0, 1, 0); PG8_SCHED; PG8_LDA(At, 1, 0); PG8_STAGE(PG8_SA(0, 1), a2 + hstep, voffA);
            PG8_WAIT_L(8); PG8_BAR; PG8_WAIT_L(0); PG8_MMA(0, 0, At, B0); PG8_BAR; PG8_SCHED;
            PG8_LDB(B1, 1, 1); PG8_STAGE(PG8_SB(1, 0), b3, voffB);
            PG8_BAR; PG8_WAIT_L(0); PG8_MMA(0, 1, At, B1); PG8_BAR;
            PG8_LDA(At, 1, 1); PG8_STAGE(PG8_SA(1, 0), a3, voffA);
            PG8_BAR; PG8_WAIT_L(0); PG8_MMA(1, 0, At, B0); PG8_BAR; PG8_SCHED;
            PG8_STAGE(PG8_SB(1, 1), b3 + hstep, voffB);
            PG8_WAIT_V(6); PG8_BAR; PG8_MMA(1, 1, At, B1); PG8_BAR;
        }
        if constexpr (!Epi::AFTER_DRAIN) { E(acc, cur, wr, wc, fr, fq); S.done(cur); }
        if (!has_next) break;
#pragma unroll
        for (int a = 0; a < 2; ++a)
#pragma unroll
            for (int b = 0; b < 2; ++b)
#pragma unroll
                for (int m = 0; m < 4; ++m)
#pragma unroll
                    for (int n = 0; n < 2; ++n) acc[a][b][m][n] = (f32x4){0.f, 0.f, 0.f, 0.f};
        cur = nxt; cA = nA; cB = nB; ++ui;
    }
    PG8_WAIT_V(0);
    if (wr == 0) PG8_BAR;
    PG8_BAR;
    if constexpr (Epi::AFTER_DRAIN) { E.fused(acc, cur, wr, wc, fr, fq, lds, wid, lane); S.done(cur); }
#undef PG8_SA
#undef PG8_SB
#undef PG8_STAGE
#undef PG8_LDA
#undef PG8_LDB
#undef PG8_MMA
#undef PG8_WAIT_V
#undef PG8_WAIT_L
#undef PG8_BAR
#undef PG8_SCHED
}
}

__host__ __device__ __forceinline__ int cmap_in(int F) { return (F & ~255) + 128 * ((F >> 5) & 1) + 32 * ((F >> 6) & 3) + (F & 31); }
struct EpiInprojMF {
    static constexpr bool PERM = true, AFTER_DRAIN = false;
    bf16_t* P; const float* rinv; const float* bias_f; const int* pos; const float* ftab; const float* qg; const float* kg;
    __device__ __forceinline__ void operator()(const pg8::f32x4 (&acc)[2][2][4][2], const pg8::Unit& u, int wr, int wc, int fr, int fq) const {
        typedef pg8::f32x4 f32x4;
        asm volatile("" : "+v"(fr), "+v"(fq));
        const int type = u.pn >> 1, head = 4 * (u.pn & 1) + wc, fb = 256 * u.pn + 64 * wc;
        const size_t PSZ = (size_t)T * 512;
        const int rslot = (type == 0) ? 0 : (type == 1) ? 1 : (type == 2) ? 6 : (type == 3) ? 2 : (type == 4) ? 3 : (type == 5) ? 4 : 7;
        bf16_t* rowmaj = P + (size_t)rslot * PSZ;
        const int t0 = u.pm * 256 + wr * 64 + fr;
        f32x4 bv[2][2], gv[2][2], fh[2], fl[2];
#pragma unroll
        for (int bj = 0; bj < 2; ++bj)
#pragma unroll
            for (int n = 0; n < 2; ++n) bv[bj][n] = *(const f32x4*)(bias_f + fb + 32 * bj + 8 * fq + 4 * n);
        if (type <= 1) {
#pragma unroll
            for (int n = 0; n < 2; ++n) { fh[n] = *(const f32x4*)(ftab + 8 * fq + 4 * n); fl[n] = *(const f32x4*)(ftab + 32 + 8 * fq + 4 * n); }
        } else if (type == 4 || type == 5) {
            const float* gsrc = (type == 4) ? qg : kg;
#pragma unroll
            for (int bj = 0; bj < 2; ++bj)
#pragma unroll
                for (int n = 0; n < 2; ++n) gv[bj][n] = *(const f32x4*)(gsrc + 32 * bj + 8 * fq + 4 * n);
        }
#pragma unroll
        for (int ai = 0; ai < 2; ++ai) {
            float rv[4], pf[4];
#pragma unroll
            for (int m = 0; m < 4; ++m) { rv[m] = rinv[t0 + ai * 128 + m * 16]; pf[m] = (float)pos[t0 + ai * 128 + m * 16]; }
            asm volatile("" : "+v"(rv[0]), "+v"(rv[1]), "+v"(rv[2]), "+v"(rv[3]), "+v"(pf[0]), "+v"(pf[1]), "+v"(pf[2]), "+v"(pf[3]));
#pragma unroll
            for (int m = 0; m < 4; ++m) {
                const int t = t0 + ai * 128 + m * 16;
                const float r = rv[m];
                f32x4 v[2][2];
#pragma unroll
                for (int bj = 0; bj < 2; ++bj)
#pragma unroll
                    for (int n = 0; n < 2; ++n) v[bj][n] = acc[ai][bj][m][n] * r + bv[bj][n];
                if (type <= 1) {
                    const float sc = (type == 1) ? 0.125f : 1.f, pp = pf[m];
#pragma unroll
                    for (int n = 0; n < 2; ++n)
#pragma unroll
                        for (int j = 0; j < 4; ++j) {
                            const float rev = __builtin_amdgcn_fractf(__builtin_amdgcn_fractf(pp * fh[n][j]) + pp * fl[n][j]);
                            const float cs = __builtin_amdgcn_cosf(rev) * sc, sn = __builtin_amdgcn_sinf(rev) * sc;
                            const float x1 = v[0][n][j], x2 = v[1][n][j]; v[0][n][j] = x1 * cs - x2 * sn; v[1][n][j] = x2 * cs + x1 * sn;
                        }
                } else if (type == 3) {
#pragma unroll
                    for (int bj = 0; bj < 2; ++bj)
#pragma unroll
                        for (int n = 0; n < 2; ++n)
#pragma unroll
                            for (int j = 0; j < 4; ++j) { const float x = v[bj][n][j]; v[bj][n][j] = x / (1.f + __expf(-x)); }
                } else if (type == 4 || type == 5) {
                    float ss = 0.f;
#pragma unroll
                    for (int bj = 0; bj < 2; ++bj)
#pragma unroll
                        for (int n = 0; n < 2; ++n)
#pragma unroll
                            for (int j = 0; j < 4; ++j) ss += v[bj][n][j] * v[bj][n][j];
                    ss += __shfl_xor(ss, 16); ss += __shfl_xor(ss, 32);
                    const float rn = (1.0f / sqrtf(ss * (1.f / 64.f) + EPS)) * ((type == 4) ? 0.125f * 1.44269504089f : 1.f);
#pragma unroll
                    for (int bj = 0; bj < 2; ++bj)
#pragma unroll
                        for (int n = 0; n < 2; ++n) v[bj][n] = v[bj][n] * rn * gv[bj][n];
                }
#pragma unroll
                for (int bj = 0; bj < 2; ++bj) {
                    pg8::u32x4 w; w.x = pg8::cvt_pk_bf16(v[bj][0][0], v[bj][0][1]); w.y = pg8::cvt_pk_bf16(v[bj][0][2], v[bj][0][3]);
                    w.z = pg8::cvt_pk_bf16(v[bj][1][0], v[bj][1][1]); w.w = pg8::cvt_pk_bf16(v[bj][1][2], v[bj][1][3]);
                    *(pg8::u32x4*)(rowmaj + (size_t)t * 512 + head * 64 + 32 * bj + 8 * fq) = w;
                }
            }
        }
    }
};

struct EpiOutprojMF {
    static constexpr bool PERM = false, AFTER_DRAIN = true;
    const float* x; const float* gate1; float* x1; bf16_t* x1b; float* part2;
    __device__ __forceinline__ void operator()(const pg8::f32x4 (&)[2][2][4][2], const pg8::Unit&, int, int, int, int) const {}
    __device__ __forceinline__ void fused(pg8::f32x4 (&acc)[2][2][4][2], const pg8::Unit& u, int wr, int wc, int fr, int fq, PG8_LAS unsigned char* lds, int wid, int lane) const {
        typedef pg8::f32x4 f32x4;
        asm volatile("" : "+v"(fr), "+v"(fq), "+v"(lane));
        constexpr int LD = 260;
        PG8_LAS float* TL = (PG8_LAS float*)lds;
        const int colw = wc * 32 + 4 * fq;
        f32x4 gv[2][2];
#pragma unroll
        for (int bj = 0; bj < 2; ++bj)
#pragma unroll
            for (int n = 0; n < 2; ++n) gv[bj][n] = *(const f32x4*)(gate1 + u.pn * 256 + colw + bj * 128 + n * 16);
#pragma unroll
        for (int ai = 0; ai < 2; ++ai) {
#pragma unroll
            for (int m = 0; m < 4; ++m)
#pragma unroll
                for (int bj = 0; bj < 2; ++bj)
#pragma unroll
                    for (int n = 0; n < 2; ++n) *(PG8_LAS f32x4*)(TL + (64 * wr + 16 * m + fr) * LD + colw + bj * 128 + n * 16) = gv[bj][n] * acc[ai][bj][m][n];
            __syncthreads();
            f32x4 xv[2];
            const size_t rowbase = (size_t)(u.pm * 256 + ai * 128 + 16 * wid) * D + u.pn * 256 + 4 * lane;
            xv[0] = *(const f32x4*)(x + rowbase);
#pragma unroll
            for (int r = 0; r < 16; ++r) {
                if (r < 15) xv[(r + 1) & 1] = *(const f32x4*)(x + rowbase + (size_t)(r + 1) * D);
                const f32x4 g = *(PG8_LAS f32x4*)(TL + (16 * wid + r) * LD + 4 * lane);
                const f32x4 o = xv[r & 1] + g;
                *(f32x4*)(x1 + rowbase + (size_t)r * D) = o;
                pg8::u32x2 w; w.x = pg8::cvt_pk_bf16(o[0], o[1]); w.y = pg8::cvt_pk_bf16(o[2], o[3]);
                *(pg8::u32x2*)(x1b + rowbase + (size_t)r * D) = w;
                float ss = o[0] * o[0] + o[1] * o[1] + o[2] * o[2] + o[3] * o[3];
#pragma unroll
                for (int o2 = 32; o2 > 0; o2 >>= 1) ss += __shfl_xor(ss, o2);
                if (lane < 4) part2[(size_t)(u.pm * 256 + ai * 128 + 16 * wid + r) * 16 + u.pn * 4 + lane] = (lane == 0) ? ss : 0.f;
            }
            __syncthreads();
        }
    }
};

__device__ __forceinline__ unsigned pk2(float lo, float hi) { return (unsigned)f2bf(lo) | ((unsigned)f2bf(hi) << 16); }
template <bool FOLD, bool CMAP>
__device__ __forceinline__ void transpose_item(const float* W, int K, int N, bf16_t* WT, float* scr, int item, int lane, const float* sg, const float* sm) {
    const int nblk = N / 32, kb = item / nblk, nb = item % nblk, k0 = 64 * kb, n0 = 32 * nb;
    float4 v[8]; float f[8];
#pragma unroll
    for (int i = 0; i < 8; ++i) { const int kk = 8 * i + (lane >> 3); v[i] = *(const float4*)(W + (size_t)(k0 + kk) * N + n0 + 4 * (lane & 7));
        f[i] = FOLD ? sg[k0 + kk] * (1.f + sm[k0 + kk]) : 1.f; }
#pragma unroll
    for (int i = 0; i < 8; ++i) { const int kk = 8 * i + (lane >> 3); float* d = scr + kk * 33 + 4 * (lane & 7);
        d[0] = v[i].x * f[i]; d[1] = v[i].y * f[i]; d[2] = v[i].z * f[i]; d[3] = v[i].w * f[i]; }
    asm volatile("s_waitcnt lgkmcnt(0)" ::: "memory");
    const int c = lane & 7, r0 = CMAP ? cmap_in(n0) : n0;
#pragma unroll
    for (int j = 0; j < 4; ++j) { const int n = (lane >> 3) + 8 * j; const float* s = scr + (8 * c) * 33 + n;
        pg8::u32x4 o; o.x = pk2(s[0 * 33], s[1 * 33]); o.y = pk2(s[2 * 33], s[3 * 33]); o.z = pk2(s[4 * 33], s[5 * 33]); o.w = pk2(s[6 * 33], s[7 * 33]);
        *(pg8::u32x4*)(WT + (size_t)(r0 + n) * K + k0 + 8 * c) = o; }
    asm volatile("s_waitcnt lgkmcnt(0)" ::: "memory");
}
template <int NC4, class VF>
__device__ __forceinline__ void gemv_cols(unsigned char* lds, const VF vf, const float* W, const int N, const int u, float* dst, const float* add) {
    constexpr int RG = 512 / NC4;
    float (*red)[NC4 * 4] = (float (*)[NC4 * 4])lds;
    const int tid = threadIdx.x, c4 = tid % NC4, rg = tid / NC4;
    if (rg < RG) {
        float4 acc = {0.f, 0.f, 0.f, 0.f};
        for (int r = rg; r < 1024; r += RG) { const float s = vf(r); const float4 w = *(const float4*)(W + (size_t)r * N + u * NC4 * 4 + c4 * 4);
            acc.x += s * w.x; acc.y += s * w.y; acc.z += s * w.z; acc.w += s * w.w; }
        red[rg][c4 * 4 + 0] = acc.x; red[rg][c4 * 4 + 1] = acc.y; red[rg][c4 * 4 + 2] = acc.z; red[rg][c4 * 4 + 3] = acc.w;
    }
    __syncthreads();
    if (tid < NC4 * 4) { float s = 0.f; for (int i = 0; i < RG; ++i) s += red[i][tid]; dst[u * NC4 * 4 + tid] = s + (add ? add[u * NC4 * 4 + tid] : 0.f); }
    __syncthreads();
}
struct VfSilu { const float* c; __device__ __forceinline__ float operator()(int r) const { const float v = c[r]; return v / (1.f + expf(-v)); } };
struct VfVec { const float* v; __device__ __forceinline__ float operator()(int r) const { return v[r]; } };


typedef float f32x16 __attribute__((ext_vector_type(16)));
typedef pg8::bf16x8 bf16x8;
#define MFMA32(a, b, c) __builtin_amdgcn_mfma_f32_32x32x16_bf16((a), (b), (c), 0, 0, 0)
__device__ __forceinline__ bf16x8 pack_frag(const f32x16& v, int s) {
    pg8::u32x4 w;
    w.x = pg8::cvt_pk_bf16(v[8 * s + 0], v[8 * s + 1]); w.y = pg8::cvt_pk_bf16(v[8 * s + 2], v[8 * s + 3]);
    w.z = pg8::cvt_pk_bf16(v[8 * s + 4], v[8 * s + 5]); w.w = pg8::cvt_pk_bf16(v[8 * s + 6], v[8 * s + 7]);
    return __builtin_bit_cast(bf16x8, w);
}
__device__ __forceinline__ bf16x8 load_tfrag(const bf16_t* rowp, int tok) {
    const uint2 a = *(const uint2*)(rowp + tok), b = *(const uint2*)(rowp + tok + 8);
    pg8::u32x4 w; w.x = a.x; w.y = a.y; w.z = b.x; w.w = b.y;
    return __builtin_bit_cast(bf16x8, w);
}


__device__ __forceinline__ bf16x8 tr_frag(const unsigned char* a0, int rows2) {
    typedef short s16x4 __attribute__((ext_vector_type(4)));
    typedef __attribute__((address_space(3))) s16x4 lds_s16x4;
    const s16x4 lo = __builtin_amdgcn_ds_read_tr16_b64_v4i16((lds_s16x4*)a0);
    const s16x4 hi = __builtin_amdgcn_ds_read_tr16_b64_v4i16((lds_s16x4*)(a0 + rows2 * 144));
    const uint2 l2 = __builtin_bit_cast(uint2, lo), h2 = __builtin_bit_cast(uint2, hi);
    pg8::u32x4 fw; fw.x = l2.x; fw.y = l2.y; fw.z = h2.x; fw.w = h2.y;
    return __builtin_bit_cast(bf16x8, fw);
}

__device__ __forceinline__ void ins16(float (&s)[16], float x) {
#pragma unroll
    for (int i = 15; i >= 1; --i) s[i] = __builtin_amdgcn_fmed3f(s[i - 1], s[i], x);
    s[0] = fmaxf(s[0], x);
}


struct OneUnitOrder {
    pg8::StaticOrder base; int round;
    __device__ __forceinline__ bool next(int i, pg8::Unit& u) const { if (i != 0) return false; return base.next(round, u); }
    __device__ __forceinline__ void a_ready(const pg8::Unit&) const {}
    __device__ __forceinline__ void done(const pg8::Unit&) const {}
};
struct EpiTopkMF {
    static constexpr bool PERM = false, AFTER_DRAIN = true;
    const float* part2; const float* bias_q; unsigned short* ids; float* gates;
    __device__ __forceinline__ void operator()(const pg8::f32x4 (&)[2][2][4][2], const pg8::Unit&, int, int, int, int) const {}
    __device__ __forceinline__ void fused(pg8::f32x4 (&acc)[2][2][4][2], const pg8::Unit& u, int wr, int wc, int fr, int fq, PG8_LAS unsigned char* lds, int wid, int lane) const {
        typedef pg8::f32x4 f32x4;
        constexpr int SLD = 260;
        PG8_LAS float* SC = (PG8_LAS float*)lds; PG8_LAS float* MG = (PG8_LAS float*)(lds + 128 * SLD * 4);
        const int tid = wid * 64 + lane, tok = tid & 255, hk = tid >> 8;
        float rinv[2][4];
#pragma unroll
        for (int ai = 0; ai < 2; ++ai)
#pragma unroll
            for (int m = 0; m < 4; ++m) {
                const int row = u.pm * 256 + ai * 128 + wr * 64 + m * 16 + fr;
                const f32x4* pp = (const f32x4*)(part2 + (size_t)row * 16);
                const f32x4 p0 = pp[0], p1 = pp[1], p2 = pp[2], p3 = pp[3];
                const float ssum = ((p0[0] + p0[1]) + (p0[2] + p0[3])) + ((p1[0] + p1[1]) + (p1[2] + p1[3])) + ((p2[0] + p2[1]) + (p2[2] + p2[3])) + ((p3[0] + p3[1]) + (p3[2] + p3[3]));
                rinv[ai][m] = 1.0f / sqrtf(ssum * (1.0f / D) + EPS);
            }
        float sl[16], mine[16];
#pragma unroll
        for (int p = 0; p < 2; ++p) {
            f32x4 bv[2];
#pragma unroll
            for (int n = 0; n < 2; ++n) bv[n] = *(const f32x4*)(bias_q + u.pn * 256 + p * 128 + wc * 32 + n * 16 + 4 * fq);
#pragma unroll
            for (int ai = 0; ai < 2; ++ai)
#pragma unroll
                for (int m = 0; m < 4; ++m)
#pragma unroll
                    for (int n = 0; n < 2; ++n)
#pragma unroll
                        for (int j = 0; j < 4; ++j)
                            SC[(32 * wc + 16 * n + 4 * fq + j) * SLD + (128 * ai + 64 * wr + 16 * m + fr)] = acc[ai][p][m][n][j] * rinv[ai][m] + bv[n][j];
            __syncthreads();
#pragma unroll
            for (int i = 0; i < 16; ++i) sl[i] = -INFINITY;
#pragma unroll 8
            for (int k = 0; k < 64; ++k) { const int key = 64 * hk + k; const float x = SC[key * SLD + tok]; ins16(sl, __uint_as_float((__float_as_uint(x) & 0xFFFFFF80u) | (unsigned)key)); }
            if (hk != p) {
#pragma unroll
                for (int i = 0; i < 16; ++i) MG[i * 256 + tok] = sl[i];
            }
            __syncthreads();
            if (hk == p) {
#pragma unroll
                for (int i = 0; i < 16; ++i) ins16(sl, MG[i * 256 + tok]);
#pragma unroll
                for (int i = 0; i < 16; ++i) mine[i] = sl[i];
            }
            __syncthreads();
        }
        PG8_LAS float* X1 = SC; PG8_LAS float* TL = SC + 4096; PG8_LAS unsigned* I0 = (PG8_LAS unsigned*)(SC + 8192); PG8_LAS unsigned* I1 = (PG8_LAS unsigned*)(SC + 12288);
        if (hk) {
#pragma unroll
            for (int i = 0; i < 16; ++i) { X1[i * 256 + tok] = mine[i]; I1[i * 256 + tok] = __float_as_uint(mine[i]) & 0x7Fu; }
        } else {
#pragma unroll
            for (int i = 0; i < 16; ++i) I0[i * 256 + tok] = __float_as_uint(mine[i]) & 0x7Fu;
        }
        __syncthreads();
        if (!hk) {
            float s1m[16], tl[16];
#pragma unroll
            for (int i = 0; i < 16; ++i) { s1m[i] = __uint_as_float(__float_as_uint(X1[i * 256 + tok]) & 0xFFFFFF80u); mine[i] = __uint_as_float(__float_as_uint(mine[i]) & 0xFFFFFF80u); tl[i] = -INFINITY; }
#pragma unroll
            for (int a2 = 0; a2 < 16; ++a2)
#pragma unroll
                for (int b2 = 0; b2 < 16; ++b2)
                    if ((a2 + 1) * (b2 + 1) <= 16) ins16(tl, __uint_as_float((__float_as_uint(mine[a2] + s1m[b2]) & 0xFFFFFF00u) | (unsigned)(a2 * 16 + b2)));
#pragma unroll
            for (int i = 0; i < 16; ++i) TL[i * 256 + tok] = tl[i];
        }
        __syncthreads();
        if (hk) {
            float ev[16]; float sum = 0.f; unsigned cd[16];
#pragma unroll
            for (int j = 0; j < 16; ++j) { const unsigned bits = __float_as_uint(TL[j * 256 + tok]); cd[j] = bits & 0xFFu; ev[j] = __uint_as_float(bits & 0xFFFFFF00u); }
            const float mx = ev[0];
#pragma unroll
            for (int j = 0; j < 16; ++j) { ev[j] = __expf(ev[j] - mx); sum += ev[j]; }
            const float inv = 1.f / sum;
            unsigned idw[8];
#pragma unroll
            for (int j = 0; j < 16; ++j) {
                const unsigned id = I0[(cd[j] >> 4) * 256 + tok] * 128u + I1[(cd[j] & 15u) * 256 + tok];
                if (j & 1) idw[j >> 1] |= id << 16; else idw[j >> 1] = id;
                ev[j] *= inv;
            }
            const size_t t = (size_t)u.pm * 256 + tok;
            unsigned short* idp = ids + t * 128 + u.pn * 16; float* gp = gates + t * 128 + u.pn * 16;
            *(uint4*)idp = make_uint4(idw[0], idw[1], idw[2], idw[3]); *(uint4*)(idp + 8) = make_uint4(idw[4], idw[5], idw[6], idw[7]);
#pragma unroll
            for (int q = 0; q < 4; ++q) *(float4*)(gp + 4 * q) = make_float4(ev[4 * q], ev[4 * q + 1], ev[4 * q + 2], ev[4 * q + 3]);
        }
        __syncthreads();
    }
};


__device__ __forceinline__ void convert_tables(const float* down, const float* up, unsigned char* q8, unsigned char* qexp, float* dsc, int lane, int cw, int nconv, int r0, int r1) {
    for (int row0 = r0 + cw * 2; row0 < r1; row0 += nconv * 2) {
        float4 v[2][4];
#pragma unroll
        for (int rr = 0; rr < 2; ++rr) {
            const int row = row0 + rr, isup = row >> 14, e = row & 16383;
            const float* sp = (isup ? up : down) + (size_t)e * 1024 + lane * 4;
#pragma unroll
            for (int q = 0; q < 4; ++q) v[rr][q] = ld_nt4(sp + 256 * q);
        }
#pragma unroll
        for (int rr = 0; rr < 2; ++rr) {
            const int row = row0 + rr, isup = row >> 14, e = row & 16383;
            if (isup) {
                float mx = 0.f;
#pragma unroll
                for (int q = 0; q < 4; ++q) mx = fmaxf(mx, fmaxf(fmaxf(fabsf(v[rr][q].x), fabsf(v[rr][q].y)), fmaxf(fabsf(v[rr][q].z), fabsf(v[rr][q].w))));
#pragma unroll
                for (int o = 32; o > 0; o >>= 1) mx = fmaxf(mx, __shfl_xor(mx, o));
                const float s = (mx > 0.f) ? exp2f(floorf(log2f(256.f / mx))) : 1.f;
#pragma unroll
                for (int q = 0; q < 4; ++q) {
                    int pk = __builtin_amdgcn_cvt_pk_fp8_f32(v[rr][q].x * s, v[rr][q].y * s, 0, false); pk = __builtin_amdgcn_cvt_pk_fp8_f32(v[rr][q].z * s, v[rr][q].w * s, pk, true);
                    *(unsigned*)(q8 + (16u << 20) + ((size_t)(2 * q + (lane >> 5)) * 16384 + e) * 128 + (lane & 7) * 16 + ((lane & 31) >> 3) * 4) = (unsigned)pk;
                }
                if (lane == 0) qexp[e] = (unsigned char)((__float_as_uint(1.0f / s) >> 23) & 0xffu);
            } else {
                float ss = 0.f;
#pragma unroll
                for (int q = 0; q < 4; ++q) ss += v[rr][q].x * v[rr][q].x + v[rr][q].y * v[rr][q].y + v[rr][q].z * v[rr][q].z + v[rr][q].w * v[rr][q].w;
#pragma unroll
                for (int o = 32; o > 0; o >>= 1) ss += __shfl_xor(ss, o);
                const float sigma = sqrtf(ss * (1.0f / 1024.0f));
                const float s = (sigma > 0.f) ? 7.5f / (2.6f * sigma) : 1.f;
#pragma unroll
                for (int q = 0; q < 4; ++q) {
                    const int n0 = (int)fminf(fmaxf(__builtin_rintf(v[rr][q].x * s), -8.f), 7.f) + 8, n1 = (int)fminf(fmaxf(__builtin_rintf(v[rr][q].y * s), -8.f), 7.f) + 8;
                    const int n2 = (int)fminf(fmaxf(__builtin_rintf(v[rr][q].z * s), -8.f), 7.f) + 8, n3 = (int)fminf(fmaxf(__builtin_rintf(v[rr][q].w * s), -8.f), 7.f) + 8;
                    *(unsigned short*)(q8 + ((size_t)q * 16384 + e) * 128 + (lane & 7) * 16 + (lane >> 3) * 2) = (unsigned short)(n0 | (n1 << 4) | (n2 << 8) | (n3 << 12));
                }
                if (lane == 0) dsc[e] = 1.0f / s;
            }
        }
    }
}

struct Params {
    const float *x, *c; const int* pos; const float *ada_w, *ada_b, *g1, *g2, *w_in, *rgain, *qg, *kg, *og, *w_out, *wq, *sk, *down, *up;
    float* out; unsigned char* ws; RopeC rc;
};

__global__ void __launch_bounds__(512) mk_fwd(Params p) {
    extern __shared__ __attribute__((aligned(16))) unsigned char lds[];
    const int tid = threadIdx.x, lane = tid & 63, wave = tid >> 6, bid = blockIdx.x, G = gridDim.x;
    unsigned char* ws = p.ws;
    float* mod = (float*)(ws + OFF_MOD); float* rinv1 = (float*)(ws + OFF_RINV1); float* ftab = (float*)(ws + OFF_ROPE);
    bf16_t* P = (bf16_t*)(ws + OFF_P); float* kv = (float*)(ws + OFF_KV); bf16_t* stT = (bf16_t*)(ws + OFF_ST); bf16_t* ycat = (bf16_t*)(ws + OFF_YCAT);
    bf16_t* xb = (bf16_t*)(ws + OFF_XB); bf16_t* Win_t = (bf16_t*)(ws + OFF_WINT); float* bias_f = (float*)(ws + OFF_BIASF);
    bf16_t* Weff_t = (bf16_t*)(ws + OFF_WEFFT); bf16_t* Wout_t = (bf16_t*)(ws + OFF_WOUTT); float* bias_q = (float*)(ws + OFF_BIASQ); float* bq_part = (float*)(ws + OFF_BQPART);
    float* part2 = (float*)(ws + OFF_PART2); bf16_t* x1b = (bf16_t*)(ws + OFF_X1B); unsigned short* ids = (unsigned short*)(ws + OFF_IDS); unsigned char* q8 = ws + OFF_Q8; unsigned char* qexp = ws + OFF_QSC; float* dsc = (float*)(ws + OFF_DSC); float* gates = (float*)(ws + OFF_GATES);
    const size_t PS = (size_t)T * 512;
    const bf16_t *Qr = P, *Kr = P + PS, *Gr = P + 2 * PS, *Qs = P + 3 * PS, *Ks = P + 4 * PS, *Vr = P + 6 * PS, *Vs = P + 7 * PS;
    float* out = p.out; float* x1 = (float*)(ws + OFF_X1);

    if (tid < 4) ((LAS unsigned*)((LAS unsigned char*)lds + LDS_ST_OFF))[tid] = 0u;
    __syncthreads();
    XcdBarrier bar = xcd_barrier_post((unsigned*)(ws + OFF_CTL), (volatile LAS unsigned*)((LAS unsigned char*)lds + LDS_ST_OFF));

    for (int u = bid; u < 256; u += G) gemv_cols<6>(lds, VfSilu{p.c}, p.ada_w, 6144, u, mod, p.ada_b);
    for (int row0 = (bid * 8 + wave) * 2; row0 < T; row0 += G * 16) {
        float4 v[2][4];
#pragma unroll
        for (int rr = 0; rr < 2; ++rr)
#pragma unroll
            for (int j = 0; j < 4; ++j) v[rr][j] = ld_nt4(p.x + (size_t)(row0 + rr) * D + (lane + 64 * j) * 4);
#pragma unroll
        for (int rr = 0; rr < 2; ++rr) {
            uint2* xo = (uint2*)(xb + (size_t)(row0 + rr) * D);
            float s = 0.f;
#pragma unroll
            for (int j = 0; j < 4; ++j) { const float4 q = v[rr][j]; s += q.x * q.x + q.y * q.y + q.z * q.z + q.w * q.w; xo[lane + 64 * j] = make_uint2(pk2(q.x, q.y), pk2(q.z, q.w)); }
#pragma unroll
            for (int o = 32; o > 0; o >>= 1) s += __shfl_xor(s, o);
            if (lane == 0) rinv1[row0 + rr] = 1.0f / sqrtf(s * (1.0f / D) + EPS);
        }
    }
    if (bid == 0 && tid == 0) {
#pragma unroll
        for (int i = 0; i < 32; ++i) { ftab[i] = p.rc.fh[i]; ftab[32 + i] = p.rc.fl[i]; }
    }
    xcd_barrier(bar);

    {
        float* scr = (float*)(lds + wave * 16384);
        for (int it = bid * 8 + wave; it < 16 * 112; it += G * 8) transpose_item<true, true>(p.w_in, 1024, 3584, Win_t, scr, it, lane, p.g1, mod + 1024);
        __syncthreads();
        for (int u = bid; u < 128; u += G) gemv_cols<7>(lds, VfVec{mod}, p.w_in, 3584, u, bias_f, nullptr);
    }
    xcd_barrier(bar);

    {
        pg8::Gemm g{xb, Win_t, T, 3584, 1024}; pg8::StaticOrder S; S.init(T, 3584, G, bid);
        EpiInprojMF E{P, rinv1, bias_f, p.pos, ftab, p.qg, p.kg};
        pg8::gemm_phase<EpiInprojMF, pg8::StaticOrder>((PG8_LAS unsigned char*)lds, g, S, E);
        const int nidle = (G > 128) ? G - 128 : G, ib = (G > 128) ? bid - 128 : bid;
        {
            float* scr = (float*)(lds + wave * 16384);
            if (ib >= 0) for (int it = ib * 8 + wave; it < 16 * 32; it += nidle * 8) transpose_item<false, false>(p.w_out, 1024, 1024, Wout_t, scr, it, lane, nullptr, nullptr);
            __syncthreads();
        }
        if (ib >= 0 && ib < 128) {
            const int hp = ib >> 3, blk = ib & 7;
            float* skT = (float*)lds; float* wqs = (float*)(lds + 69632);
            for (int e = tid; e < 16384; e += 512) { const int k = e >> 7, c = e & 127; skT[c * 132 + k] = p.sk[((size_t)hp * 128 + k) * 128 + c]; }
            float bacc[16];
#pragma unroll
            for (int j = 0; j < 16; ++j) bacc[j] = 0.f;
            for (int rbk = 0; rbk < 2; ++rbk) {
                const int i0 = (blk * 2 + rbk) * 64;
                __syncthreads();
                for (int e = tid; e < 8192; e += 512) { const int r = e >> 7, c = e & 127; wqs[r * 129 + c] = p.wq[(size_t)(i0 + r) * 2048 + hp * 128 + c]; }
                __syncthreads();
                float acc[16];
#pragma unroll
                for (int j = 0; j < 16; ++j) acc[j] = 0.f;
                const float* wrow = wqs + lane * 129; const float* skc = skT + 16 * wave;
#pragma unroll 4
                for (int c = 0; c < 128; ++c) {
                    const float av = wrow[c];
                    const float4 b0 = *(const float4*)(skc + c * 132), b1 = *(const float4*)(skc + c * 132 + 4), b2 = *(const float4*)(skc + c * 132 + 8), b3 = *(const float4*)(skc + c * 132 + 12);
                    acc[0] += av * b0.x; acc[1] += av * b0.y; acc[2] += av * b0.z; acc[3] += av * b0.w; acc[4] += av * b1.x; acc[5] += av * b1.y; acc[6] += av * b1.z; acc[7] += av * b1.w;
                    acc[8] += av * b2.x; acc[9] += av * b2.y; acc[10] += av * b2.z; acc[11] += av * b2.w; acc[12] += av * b3.x; acc[13] += av * b3.y; acc[14] += av * b3.z; acc[15] += av * b3.w;
                }
                const int i = i0 + lane;
                const float s2v = p.g2[i] * (1.f + mod[4096 + i]), sh = mod[3072 + i];
#pragma unroll
                for (int j = 0; j < 16; ++j) { Weff_t[(size_t)(hp * 128 + 16 * wave + j) * 1024 + i] = f2bf(acc[j] * s2v); bacc[j] += sh * acc[j]; }
            }
#pragma unroll
            for (int j = 0; j < 16; ++j) { float v = bacc[j];
#pragma unroll
                for (int o = 32; o > 0; o >>= 1) v += __shfl_xor(v, o);
                if (lane == 0) bq_part[(size_t)blk * 2048 + hp * 128 + 16 * wave + j] = v; }
            __syncthreads();
        }
        if (ib >= 0) convert_tables(p.down, p.up, q8, qexp, dsc, lane, ib * 8 + wave, nidle * 8, 0, CONV_SPLIT);
    }
    xcd_barrier(bar);

    {
        const int gw = __builtin_amdgcn_readfirstlane(bid * 8 + wave), NGW = G * 8, l31 = lane & 31, hf = lane >> 5;
        const int wv0 = __builtin_amdgcn_readfirstlane(wave);
        for (int U = gw; U < 1024; U += NGW) {
            const int n = U >> 3, h = U & 7;
            f32x16 C[2][2];
#pragma unroll
            for (int a = 0; a < 2; ++a)
#pragma unroll
                for (int b = 0; b < 2; ++b)
#pragma unroll
                    for (int r = 0; r < 16; ++r) C[a][b][r] = 0.f;
            unsigned char* Kt = lds + wv0 * 9216; unsigned char* Vt = Kt + 4608;
            const int r8 = lane >> 3, pc = lane & 7, trq = (lane & 15) >> 2, trp = lane & 3, trd = (lane >> 4) & 1;
            const char* kbase = (const char*)(Kr + (size_t)n * 128 * 512 + h * 64); const char* vbase = (const char*)(Vr + (size_t)n * 128 * 512 + h * 64);
            const unsigned loff = (unsigned)(r8 * 512 + pc * 8) * 2u;
            const float lg = lg2_head(h);
            pg8::u32x4 gK[4], gV[4];
#pragma unroll
            for (int i = 0; i < 4; ++i) { gK[i] = *(const pg8::u32x4*)(kbase + (loff + i * 8192u)); gV[i] = *(const pg8::u32x4*)(vbase + (loff + i * 8192u)); }
            for (int sb4 = 0; sb4 < 4; ++sb4) {
#pragma unroll
                for (int i = 0; i < 4; ++i) { *(pg8::u32x4*)(Kt + (8 * i + r8) * 144 + pc * 16) = gK[i]; *(pg8::u32x4*)(Vt + (8 * i + r8) * 144 + pc * 16) = gV[i]; }
                { const int sn = (sb4 < 3) ? sb4 + 1 : sb4;
#pragma unroll
                  for (int i = 0; i < 4; ++i) { gK[i] = *(const pg8::u32x4*)(kbase + (size_t)sn * 32768 + (loff + i * 8192u)); gV[i] = *(const pg8::u32x4*)(vbase + (size_t)sn * 32768 + (loff + i * 8192u)); } }
#pragma unroll
                for (int s = 0; s < 2; ++s) {
                    bf16x8 Af[2], Bf[2];
#pragma unroll
                    for (int a = 0; a < 2; ++a) {
                        Af[a] = tr_frag(Vt + (16 * s + 8 * hf + trq) * 144 + (32 * a + 16 * trd + 4 * trp) * 2, 4);
                        const bf16x8 kraw = tr_frag(Kt + (16 * s + 8 * hf + trq) * 144 + (32 * a + 16 * trd + 4 * trp) * 2, 4);
                        const pg8::u32x4 kw = __builtin_bit_cast(pg8::u32x4, kraw); const unsigned kk[4] = {kw.x, kw.y, kw.z, kw.w};
                        pg8::u32x4 o; unsigned* op = (unsigned*)&o;
#pragma unroll
                        for (int e2 = 0; e2 < 4; ++e2) {
                            const int j0 = 32 * sb4 + 16 * s + 8 * hf + 2 * e2;
                            const float z0 = __builtin_amdgcn_exp2f((float)(127 - j0) * lg), z1 = __builtin_amdgcn_exp2f((float)(126 - j0) * lg);
                            op[e2] = pg8::cvt_pk_bf16(__uint_as_float(kk[e2] << 16) * z0, __uint_as_float(kk[e2] & 0xffff0000u) * z1);
                        }
                        Bf[a] = __builtin_bit_cast(bf16x8, o);
                    }
#pragma unroll
                    for (int a = 0; a < 2; ++a)
#pragma unroll
                        for (int b = 0; b < 2; ++b) C[a][b] = MFMA32(Af[a], Bf[b], C[a][b]);
                }
            }
            float* dst = kv + (size_t)(n * 8 + h) * 4096;
#pragma unroll
            for (int a = 0; a < 2; ++a)
#pragma unroll
                for (int b = 0; b < 2; ++b)
#pragma unroll
                    for (int r = 0; r < 16; ++r) dst[(32 * a + (r & 3) + 8 * (r >> 2) + 4 * hf) * 64 + 32 * b + l31] = C[a][b][r];
        }
        bf16x8 Tri[2];
        {
            pg8::u32x4 w0, w1; unsigned* p0 = (unsigned*)&w0; unsigned* p1 = (unsigned*)&w1;
#pragma unroll
            for (int e2 = 0; e2 < 4; ++e2) {
                unsigned a0 = 0, a1 = 0;
#pragma unroll
                for (int q = 0; q < 2; ++q) { const int e = 2 * e2 + q, ip = 8 * (e >> 2) + 4 * hf + (e & 3);
                    a0 |= ((ip > l31) ? 0x3F80u : 0u) << (16 * q); a1 |= ((16 + ip > l31) ? 0x3F80u : 0u) << (16 * q); }
                p0[e2] = a0; p1[e2] = a1;
            }
            Tri[0] = __builtin_bit_cast(bf16x8, w0); Tri[1] = __builtin_bit_cast(bf16x8, w1);
        }
        const bool sb_local = (G % 8 == 0) && (4096 % G == 0) && ((4096 / G) % 8 == 0);
        const int sb_per_wave = sb_local ? 4096 / G / 8 : (4096 + NGW - 1 - gw) / NGW;
        const int wv = __builtin_amdgcn_readfirstlane(wave);
        for (int ps = 0; ps < sb_per_wave; ++ps) {
            const int U = sb_local ? 0 : gw + ps * NGW;
            const int h = sb_local ? (bid & 7) : (U & 7), qt = sb_local ? (bid >> 3) * (4096 / G) + ps * 8 + wv : (U >> 3), q0 = qt * 32;
            f32x16 O[2];
#pragma unroll
            for (int r = 0; r < 16; ++r) { O[0][r] = 0.f; O[1][r] = 0.f; }
            float carry = 0.f;
            unsigned char* Kt = lds + wv * 9216; unsigned char* Vt = Kt + 4608;
            const int r8 = lane >> 3, pc = lane & 7;
            const char* kbase = (const char*)(Ks + h * 64); const char* vbase = (const char*)(Vs + h * 64);
            const unsigned loff = (unsigned)(r8 * 512 + pc * 8) * 2u;
            pg8::u32x4 gK[4], gV[4];
            bf16x8 Qf[4];
            {
                const char* qbase = (const char*)(Qs + h * 64);
#pragma unroll
                for (int i = 0; i < 4; ++i) gK[i] = *(const pg8::u32x4*)(qbase + (size_t)qt * 32768 + (loff + i * 8192u));
#pragma unroll
                for (int i = 0; i < 4; ++i) *(pg8::u32x4*)(Kt + (8 * i + r8) * 144 + pc * 16) = gK[i];
#pragma unroll
                for (int s = 0; s < 4; ++s) Qf[s] = *(const bf16x8*)(Kt + l31 * 144 + 32 * s + 16 * hf);
            }
#pragma unroll
            for (int i = 0; i < 4; ++i) { gK[i] = *(const pg8::u32x4*)(kbase + (size_t)qt * 32768 + (loff + i * 8192u)); gV[i] = *(const pg8::u32x4*)(vbase + (size_t)qt * 32768 + (loff + i * 8192u)); }
            const int trq = (lane & 15) >> 2, trp = lane & 3, trd = (lane >> 4) & 1;
            for (int kb = qt; kb >= 0; --kb) {
#pragma unroll
                for (int i = 0; i < 4; ++i) { *(pg8::u32x4*)(Kt + (8 * i + r8) * 144 + pc * 16) = gK[i]; *(pg8::u32x4*)(Vt + (8 * i + r8) * 144 + pc * 16) = gV[i]; }
                {
                    const int kbn = (kb > 0) ? kb - 1 : 0;
#pragma unroll
                    for (int i = 0; i < 4; ++i) { gK[i] = *(const pg8::u32x4*)(kbase + (size_t)kbn * 32768 + (loff + i * 8192u)); gV[i] = *(const pg8::u32x4*)(vbase + (size_t)kbn * 32768 + (loff + i * 8192u)); }
                }
                bf16x8 Kf[4], Vf[2][2];
#pragma unroll
                for (int s = 0; s < 4; ++s) Kf[s] = *(const bf16x8*)(Kt + l31 * 144 + 32 * s + 16 * hf);
#pragma unroll
                for (int s = 0; s < 2; ++s)
#pragma unroll
                    for (int dt = 0; dt < 2; ++dt) {
                        Vf[s][dt] = tr_frag(Vt + (16 * s + 4 * hf + trq) * 144 + (32 * dt + 16 * trd + 4 * trp) * 2, 8);
                    }
                f32x16 S;
#pragma unroll
                for (int r = 0; r < 16; ++r) S[r] = 0.f;
#pragma unroll
                for (int s = 0; s < 4; ++s) S = MFMA32(Kf[s], Qf[s], S);
                const bool diag = (kb == qt);
                f32x16 sp, lb;
                float csum = 0.f;
                if (diag) {
#pragma unroll
                    for (int r = 0; r < 16; ++r) {
                        const int i = (r & 3) + 8 * (r >> 2) + 4 * hf;
                        const float z = S[r];
                        const float l1p = __builtin_amdgcn_logf(1.0f + __builtin_amdgcn_exp2f(-fabsf(z)));
                        const float spv = (i < l31) ? (fmaxf(z, 0.f) + l1p) : 0.f;
                        sp[r] = spv; lb[r] = (i < l31) ? (fminf(z, 0.f) - l1p) : -INFINITY; csum += spv;
                    }
                } else {
#pragma unroll
                    for (int r = 0; r < 16; ++r) {
                        const float z = S[r];
                        const float l1p = __builtin_amdgcn_logf(1.0f + __builtin_amdgcn_exp2f(-fabsf(z)));
                        const float spv = fmaxf(z, 0.f) + l1p;
                        sp[r] = spv; lb[r] = fminf(z, 0.f) - l1p; csum += spv;
                    }
                }
                f32x16 Rt;
#pragma unroll
                for (int r = 0; r < 16; ++r) Rt[r] = carry;
#pragma unroll
                for (int s = 0; s < 2; ++s) Rt = MFMA32(Tri[s], pack_frag(sp, s), Rt);
                f32x16 wv;
#pragma unroll
                for (int r = 0; r < 16; ++r) wv[r] = __builtin_amdgcn_exp2f(lb[r] - Rt[r]);
#pragma unroll
                for (int s = 0; s < 2; ++s) { const bf16x8 wp = pack_frag(wv, s);
#pragma unroll
                    for (int dt = 0; dt < 2; ++dt) O[dt] = MFMA32(Vf[s][dt], wp, O[dt]); }
                csum += __shfl_xor(csum, 32);
                carry += csum;
                if (__all(carry > 127.f)) break;
            }
            float ss = 0.f;
#pragma unroll
            for (int r = 0; r < 16; ++r) ss += O[0][r] * O[0][r] + O[1][r] * O[1][r];
            ss += __shfl_xor(ss, 32);
            const float rn = 1.0f / sqrtf(ss * (1.f / 64.f) + EPS);
#pragma unroll
            for (int dt = 0; dt < 2; ++dt)
#pragma unroll
                for (int g4 = 0; g4 < 4; ++g4) {
                    const int d = 32 * dt + 8 * g4 + 4 * hf;
                    const float4 gn = *(const float4*)(p.og + d);
                    uint2 w; w.x = pg8::cvt_pk_bf16(O[dt][4 * g4] * rn * gn.x, O[dt][4 * g4 + 1] * rn * gn.y); w.y = pg8::cvt_pk_bf16(O[dt][4 * g4 + 2] * rn * gn.z, O[dt][4 * g4 + 3] * rn * gn.w);
                    *(uint2*)(Kt + l31 * 144 + d * 2) = w;
                }
#pragma unroll
            for (int i = 0; i < 4; ++i) *(pg8::u32x4*)(ycat + (size_t)(q0 + 8 * i + r8) * 1024 + 512 + h * 64 + pc * 8) = *(const pg8::u32x4*)(Kt + (8 * i + r8) * 144 + pc * 16);
        }
    }
    xcd_barrier(bar);

    if (bid == 255 % G) for (int n = tid; n < 2048; n += 512) { float s = 0.f;
#pragma unroll
        for (int b8 = 0; b8 < 8; ++b8) s += bq_part[(size_t)b8 * 2048 + n];
        bias_q[n] = s; }
    if (G > 64 && bid >= 64) convert_tables(p.down, p.up, q8, qexp, dsc, lane, (bid - 64) * 8 + wave, (G - 64) * 8, CONV_SPLIT, 32768);
    else if (G <= 64) convert_tables(p.down, p.up, q8, qexp, dsc, lane, bid * 8 + wave, G * 8, CONV_SPLIT, 32768);
    for (int idx = bid * 512 + tid; idx < 32768; idx += G * 512) {
        const int h = idx >> 12;
        const float cd = exp2f(128.f * lg2_head(h));
        float s = 0.f;
        for (int n0 = 0; n0 < 128; n0 += 32) {
            float kvv[32];
#pragma unroll
            for (int q = 0; q < 32; ++q) kvv[q] = kv[(size_t)(n0 + q) * 32768 + idx];
#pragma unroll
            for (int q = 0; q < 32; ++q) { stT[(size_t)(n0 + q) * 32768 + idx] = f2bf(s); s = cd * s + kvv[q]; }
        }
    }
    xcd_barrier(bar);

    {
        const int gw = __builtin_amdgcn_readfirstlane(bid * 8 + wave), NGW = G * 8, l31 = lane & 31, hf = lane >> 5;
        const int wv4 = __builtin_amdgcn_readfirstlane(wave);
        for (int W2 = gw; W2 < 2048; W2 += NGW) {
            const int nh = W2 >> 1, n = nh >> 3, h = nh & 7;
            const float lg = lg2_head(h);
#pragma unroll 1
            for (int pass = 0; pass < 2; ++pass) {
                const int qt = (W2 & 1) ? (pass ? 2 : 1) : (pass ? 3 : 0);
                const int il = qt * 32 + l31, tq = n * 128 + il;
                unsigned char* Kt = lds + wv4 * 9216; unsigned char* Vt = Kt + 4608;
                const int r8 = lane >> 3, pc = lane & 7, trq = (lane & 15) >> 2, trp = lane & 3, trd = (lane >> 4) & 1;
                const unsigned loff = (unsigned)(r8 * 512 + pc * 8) * 2u;
                pg8::u32x4 gK[4], gV[4];
                bf16x8 Qf[4];
                {
                    const char* qbase = (const char*)(Qr + (size_t)(n * 128 + qt * 32) * 512 + h * 64);
                    const char* sbase = (const char*)(stT + (size_t)nh * 4096) + (unsigned)(r8 * 64 + pc * 8) * 2u;
#pragma unroll
                    for (int i = 0; i < 4; ++i) gK[i] = *(const pg8::u32x4*)(qbase + (loff + i * 8192u));
#pragma unroll
                    for (int i = 0; i < 4; ++i) *(pg8::u32x4*)(Kt + (8 * i + r8) * 144 + pc * 16) = gK[i];
#pragma unroll
                    for (int s = 0; s < 4; ++s) Qf[s] = *(const bf16x8*)(Kt + l31 * 144 + 32 * s + 16 * hf);
#pragma unroll
                    for (int i = 0; i < 4; ++i) { gK[i] = *(const pg8::u32x4*)(sbase + i * 1024u); gV[i] = *(const pg8::u32x4*)(sbase + 4096u + i * 1024u); }
#pragma unroll
                    for (int i = 0; i < 4; ++i) { *(pg8::u32x4*)(Kt + (8 * i + r8) * 144 + pc * 16) = gK[i]; *(pg8::u32x4*)(Kt + (32 + 8 * i + r8) * 144 + pc * 16) = gV[i]; }
                }
                f32x16 O[2];
#pragma unroll
                for (int r = 0; r < 16; ++r) { O[0][r] = 0.f; O[1][r] = 0.f; }
#pragma unroll
                for (int s = 0; s < 4; ++s)
#pragma unroll
                    for (int dt = 0; dt < 2; ++dt) O[dt] = MFMA32(*(const bf16x8*)(Kt + (32 * dt + l31) * 144 + 32 * s + 16 * hf), Qf[s], O[dt]);
                const float xi = exp2f((float)(il + 1) * lg);
#pragma unroll
                for (int r = 0; r < 16; ++r) { O[0][r] *= xi; O[1][r] *= xi; }
                const char* kbase = (const char*)(Kr + (size_t)n * 128 * 512 + h * 64); const char* vbase = (const char*)(Vr + (size_t)n * 128 * 512 + h * 64);
#pragma unroll
                for (int i = 0; i < 4; ++i) { gK[i] = *(const pg8::u32x4*)(kbase + (loff + i * 8192u)); gV[i] = *(const pg8::u32x4*)(vbase + (loff + i * 8192u)); }
                for (int jb = 0; jb <= qt; ++jb) {
#pragma unroll
                    for (int i = 0; i < 4; ++i) { *(pg8::u32x4*)(Kt + (8 * i + r8) * 144 + pc * 16) = gK[i]; *(pg8::u32x4*)(Vt + (8 * i + r8) * 144 + pc * 16) = gV[i]; }
                    { const int jn = (jb < qt) ? jb + 1 : jb;
#pragma unroll
                      for (int i = 0; i < 4; ++i) { gK[i] = *(const pg8::u32x4*)(kbase + (size_t)jn * 32768 + (loff + i * 8192u)); gV[i] = *(const pg8::u32x4*)(vbase + (size_t)jn * 32768 + (loff + i * 8192u)); } }
                    bf16x8 Kf[4], Vf[2][2];
#pragma unroll
                    for (int s = 0; s < 4; ++s) Kf[s] = *(const bf16x8*)(Kt + l31 * 144 + 32 * s + 16 * hf);
#pragma unroll
                    for (int s = 0; s < 2; ++s)
#pragma unroll
                        for (int dt = 0; dt < 2; ++dt) Vf[s][dt] = tr_frag(Vt + (16 * s + 4 * hf + trq) * 144 + (32 * dt + 16 * trd + 4 * trp) * 2, 8);
                    f32x16 S;
#pragma unroll
                    for (int r = 0; r < 16; ++r) S[r] = 0.f;
#pragma unroll
                    for (int s = 0; s < 4; ++s) S = MFMA32(Kf[s], Qf[s], S);
#pragma unroll
                    for (int r = 0; r < 16; ++r) {
                        const int jl = jb * 32 + (r & 3) + 8 * (r >> 2) + 4 * hf, dl = il - jl;
                        S[r] = (dl >= 0) ? S[r] * __builtin_amdgcn_exp2f((float)dl * lg) : 0.f;
                    }
#pragma unroll
                    for (int s = 0; s < 2; ++s) { const bf16x8 wp = pack_frag(S, s);
#pragma unroll
                        for (int dt = 0; dt < 2; ++dt) O[dt] = MFMA32(Vf[s][dt], wp, O[dt]); }
                }
                float sm = 0.f;
#pragma unroll
                for (int r = 0; r < 16; ++r) sm += O[0][r] + O[1][r];
                sm += __shfl_xor(sm, 32);
                const float mean = sm * (1.f / 64.f);
                float vs = 0.f;
#pragma unroll
                for (int r = 0; r < 16; ++r) { const float d0 = O[0][r] - mean, d1 = O[1][r] - mean; vs += d0 * d0 + d1 * d1; }
                vs += __shfl_xor(vs, 32);
                const float rstd = 1.0f / sqrtf(vs * (1.f / 64.f) + EPS);
                {
                    const char* gbase = (const char*)(Gr + (size_t)(n * 128 + qt * 32) * 512 + h * 64);
#pragma unroll
                    for (int i = 0; i < 4; ++i) gV[i] = *(const pg8::u32x4*)(gbase + (loff + i * 8192u));
#pragma unroll
                    for (int i = 0; i < 4; ++i) *(pg8::u32x4*)(Vt + (8 * i + r8) * 144 + pc * 16) = gV[i];
                }
#pragma unroll
                for (int dt = 0; dt < 2; ++dt)
#pragma unroll
                    for (int g4 = 0; g4 < 4; ++g4) {
                        const int e = 32 * dt + 8 * g4 + 4 * hf;
                        const float4 gn = *(const float4*)(p.rgain + h * 64 + e);
                        const uint2 gg = *(const uint2*)(Vt + l31 * 144 + e * 2);
                        const float g0 = __uint_as_float(gg.x << 16), g1 = __uint_as_float(gg.x & 0xffff0000u), g2v = __uint_as_float(gg.y << 16), g3 = __uint_as_float(gg.y & 0xffff0000u);
                        uint2 w;
                        w.x = pg8::cvt_pk_bf16((O[dt][4 * g4] - mean) * rstd * gn.x * g0, (O[dt][4 * g4 + 1] - mean) * rstd * gn.y * g1);
                        w.y = pg8::cvt_pk_bf16((O[dt][4 * g4 + 2] - mean) * rstd * gn.z * g2v, (O[dt][4 * g4 + 3] - mean) * rstd * gn.w * g3);
                        *(uint2*)(Kt + l31 * 144 + e * 2) = w;
                    }
#pragma unroll
                for (int i = 0; i < 4; ++i) *(pg8::u32x4*)(ycat + (size_t)(n * 128 + qt * 32 + 8 * i + r8) * 1024 + h * 64 + pc * 8) = *(const pg8::u32x4*)(Kt + (8 * i + r8) * 144 + pc * 16);
            }
        }
    }
    xcd_barrier(bar);

    {
        pg8::Gemm g{ycat, Wout_t, T, 1024, 1024}; pg8::StaticOrder S; S.init(T, 1024, G, bid);
        EpiOutprojMF E{p.x, mod + 2048, x1, x1b, part2};
        pg8::gemm_phase<EpiOutprojMF, pg8::StaticOrder>((PG8_LAS unsigned char*)lds, g, S, E);
    }
    xcd_barrier(bar);

    for (int round = 0; round < 2; ++round) {
        pg8::Gemm g{x1b, Weff_t, T, 2048, 1024}; OneUnitOrder S; S.base.init(T, 2048, G, bid); S.round = round;
        EpiTopkMF E{part2, bias_q, ids, gates};
        pg8::gemm_phase<EpiTopkMF, OneUnitOrder>((PG8_LAS unsigned char*)lds, g, S, E);
    }
    xcd_barrier(bar);

    {
        constexpr int IDS_LD = 136, ACT_LD = 136;
        const float* scale2 = mod + 4096; const float* shift2 = mod + 3072; const float* gate2 = mod + 5120;
        unsigned short* ids_l = (unsigned short*)lds; float* act_l = (float*)(lds + 32768); unsigned char* qe_l = lds + 69632;
        float* ds_l = (float*)(lds + 86016);
        const int t0 = bid * 64, tt = lane >> 3, sub = lane & 7, tl = wave * 8 + tt, t = t0 + tl;
        for (int e = tid; e < 1024; e += 512) { const int r = e >> 4, c8 = e & 15; *(uint4*)(ids_l + r * IDS_LD + c8 * 8) = *(const uint4*)(ids + (size_t)(t0 + r) * 128 + c8 * 8); }
        for (int e = tid; e < 64 * ACT_LD; e += 512) act_l[e] = 0.f;
        for (int e = tid; e < 1024; e += 512) ((uint4*)qe_l)[e] = ((const uint4*)qexp)[e];
        for (int e = tid; e < 4096; e += 512) ((uint4*)ds_l)[e] = ((const uint4*)dsc)[e];
        __syncthreads();
        float ri;
        { const float4* pp = (const float4*)(part2 + (size_t)t * 16); const float4 p0 = pp[0], p1 = pp[1], p2 = pp[2], p3 = pp[3];
          const float ssum = ((p0.x + p0.y) + (p0.z + p0.w)) + ((p1.x + p1.y) + (p1.z + p1.w)) + ((p2.x + p2.y) + (p2.z + p2.w)) + ((p3.x + p3.y) + (p3.z + p3.w));
          ri = 1.0f / sqrtf(ssum * (1.0f / D) + EPS); }
        const unsigned short* myids = ids_l + tl * IDS_LD;
        float* myact = act_l + tl * ACT_LD; int* myacc = (int*)myact;
        const bool s4 = (sub & 4) != 0, s2 = (sub & 2) != 0, s1 = (sub & 1) != 0;
        const unsigned suboff = (unsigned)sub * 16u;
        typedef float f32x2 __attribute__((ext_vector_type(2)));
        float hmax = 0.f;
        for (int c = 0; c < 4; ++c)
#pragma unroll
            for (int q = 0; q < 8; ++q) {
                const int col = 256 * c + 4 * sub + 32 * q;
                const float4 xv = *(const float4*)(x1 + (size_t)t * D + col);
                const float4 g = *(const float4*)(p.g2 + col), sc = *(const float4*)(scale2 + col), sh = *(const float4*)(shift2 + col);
                hmax = fmaxf(hmax, fmaxf(fmaxf(fabsf(xv.x * ri * g.x * (1.f + sc.x) + sh.x), fabsf(xv.y * ri * g.y * (1.f + sc.y) + sh.y)),
                                         fmaxf(fabsf(xv.z * ri * g.z * (1.f + sc.z) + sh.z), fabsf(xv.w * ri * g.w * (1.f + sc.w) + sh.w))));
            }
        hmax = fmaxf(hmax, __shfl_xor(hmax, 1)); hmax = fmaxf(hmax, __shfl_xor(hmax, 2)); hmax = fmaxf(hmax, __shfl_xor(hmax, 4));
        const float hinv = (hmax > 0.f) ? 127.0f / hmax : 0.f, hscale = hmax * (1.0f / 127.0f);
#define P9_LOAD(W, JB) do { const uint4 idv_ = *(const uint4*)(myids + 8 * (JB)); const unsigned idw_[4] = {idv_.x, idv_.y, idv_.z, idv_.w}; \
        _Pragma("unroll") for (int k_ = 0; k_ < 8; ++k_) { const unsigned id_ = (idw_[k_ >> 1] >> (16 * (k_ & 1))) & 0xffffu; W[k_] = *(const uint4*)(sbase + (id_ * 128u + suboff)); } } while (0)
#define P9_DOWN4(W, JB) do { int pd_[8]; \
        _Pragma("unroll") for (int k_ = 0; k_ < 8; ++k_) { const unsigned ww_[4] = {W[k_].x, W[k_].y, W[k_].z, W[k_].w}; int a0_ = 0, a1_ = 0; \
            _Pragma("unroll") for (int m_ = 0; m_ < 4; ++m_) { a0_ = __builtin_amdgcn_sdot4(hpe[m_], (int)(ww_[m_] & 0x0F0F0F0Fu), a0_, false); a1_ = __builtin_amdgcn_sdot4(hpo[m_], (int)((ww_[m_] >> 4) & 0x0F0F0F0Fu), a1_, false); } \
            pd_[k_] = a0_ + a1_ - hoff; } \
        int r4_[4], r2_[2]; \
        _Pragma("unroll") for (int k_ = 0; k_ < 4; ++k_) { const int snd_ = s4 ? pd_[k_] : pd_[k_ + 4], kp_ = s4 ? pd_[k_ + 4] : pd_[k_]; r4_[k_] = kp_ + __shfl_xor(snd_, 4); } \
        _Pragma("unroll") for (int k_ = 0; k_ < 2; ++k_) { const int snd_ = s2 ? r4_[k_] : r4_[k_ + 2], kp_ = s2 ? r4_[k_ + 2] : r4_[k_]; r2_[k_] = kp_ + __shfl_xor(snd_, 2); } \
        { const int snd_ = s1 ? r2_[0] : r2_[1], kp_ = s1 ? r2_[1] : r2_[0]; myacc[8 * (JB) + sub] += kp_ + __shfl_xor(snd_, 1); } } while (0)
        for (int c = 0; c < 4; ++c) {
            int hq[8][4];
#pragma unroll
            for (int q = 0; q < 8; ++q) {
                const int col = 256 * c + 4 * sub + 32 * q;
                const float4 xv = *(const float4*)(x1 + (size_t)t * D + col);
                const float4 g = *(const float4*)(p.g2 + col), sc = *(const float4*)(scale2 + col), sh = *(const float4*)(shift2 + col);
                hq[q][0] = (int)__builtin_rintf((xv.x * ri * g.x * (1.f + sc.x) + sh.x) * hinv); hq[q][1] = (int)__builtin_rintf((xv.y * ri * g.y * (1.f + sc.y) + sh.y) * hinv);
                hq[q][2] = (int)__builtin_rintf((xv.z * ri * g.z * (1.f + sc.z) + sh.z) * hinv); hq[q][3] = (int)__builtin_rintf((xv.w * ri * g.w * (1.f + sc.w) + sh.w) * hinv);
            }
            int hpe[4], hpo[4], hoff = 0;
#pragma unroll
            for (int m = 0; m < 4; ++m) {
                hpe[m] = (hq[2 * m][0] & 255) | ((hq[2 * m][2] & 255) << 8) | ((hq[2 * m + 1][0] & 255) << 16) | ((hq[2 * m + 1][2] & 255) << 24);
                hpo[m] = (hq[2 * m][1] & 255) | ((hq[2 * m][3] & 255) << 8) | ((hq[2 * m + 1][1] & 255) << 16) | ((hq[2 * m + 1][3] & 255) << 24);
            }
#pragma unroll
            for (int q = 0; q < 8; ++q) hoff += (hq[q][0] + hq[q][1]) + (hq[q][2] + hq[q][3]);
            hoff *= 8;
            const unsigned char* sbase = q8 + (size_t)c * (16384 * 128);
            uint4 wA[8], wB[8];
            P9_LOAD(wA, 0);
#pragma unroll 1
            for (int jb = 0; jb < 16; jb += 2) {
                P9_LOAD(wB, jb + 1);
                P9_DOWN4(wA, jb);
                if (jb + 2 < 16) P9_LOAD(wA, jb + 2);
                P9_DOWN4(wB, jb + 1);
            }
        }
#undef P9_DOWN4
#define P9_UP(W, JB) do { const float4 a0_ = *(const float4*)(myact + 8 * (JB)), a1_ = *(const float4*)(myact + 8 * (JB) + 4); \
        const float av_[8] = {a0_.x, a0_.y, a0_.z, a0_.w, a1_.x, a1_.y, a1_.z, a1_.w}; \
        _Pragma("unroll") for (int k_ = 0; k_ < 8; ++k_) { const unsigned ww_[4] = {W[k_].x, W[k_].y, W[k_].z, W[k_].w}; \
            _Pragma("unroll") for (int m_ = 0; m_ < 4; ++m_) { const f32x2 lo_ = __builtin_amdgcn_cvt_pk_f32_fp8((int)ww_[m_], false), hi_ = __builtin_amdgcn_cvt_pk_f32_fp8((int)ww_[m_], true); \
                o2[2 * m_] = lo_ * av_[k_] + o2[2 * m_]; o2[2 * m_ + 1] = hi_ * av_[k_] + o2[2 * m_ + 1]; } } } while (0)
        for (int jb = 0; jb < 16; ++jb) {
            const int j = 8 * jb + sub; const unsigned id = myids[j];
            const float a = (float)myacc[j] * ds_l[id] * hscale;
            const float av = fabsf(a), tq = 1.0f / (av * 0.2316418882f + 1.0f);
            float ql = tq * 0.5307027145f + (-0.7265760135f); ql = ql * tq + 0.7107068705f; ql = ql * tq + (-0.142248368f); ql = ql * tq + 0.127414796f; ql = ql * tq;
            const float mm = a * (ql * exp2f(a * a * (-0.72134752044f)));
            const float ge = (a < 0.f) ? mm : (a - mm);
            myact[j] = ge * gates[(size_t)t * 128 + j] * __uint_as_float((unsigned)qe_l[id] << 23);
        }
        __syncthreads();
        for (int c = 0; c < 8; ++c) {
            f32x2 o2[8];
#pragma unroll
            for (int q = 0; q < 8; ++q) o2[q] = (f32x2){0.f, 0.f};
            const int col = 128 * c + 4 * sub;
            const unsigned char* sbase = q8 + (16u << 20) + (size_t)c * (16384 * 128);
            uint4 wA[8], wB[8];
            P9_LOAD(wA, 0);
#pragma unroll 1
            for (int jb = 0; jb < 16; jb += 2) {
                P9_LOAD(wB, jb + 1);
                P9_UP(wA, jb);
                if (jb + 2 < 16) P9_LOAD(wA, jb + 2);
                P9_UP(wB, jb + 1);
            }
#pragma unroll
            for (int q = 0; q < 4; ++q) {
                float* op = out + (size_t)t * D + col + 32 * q;
                const float4 xv = *(const float4*)(x1 + (size_t)t * D + col + 32 * q); const float4 gt = *(const float4*)(gate2 + col + 32 * q);
                float4 r; r.x = xv.x + gt.x * o2[2 * q][0]; r.y = xv.y + gt.y * o2[2 * q][1]; r.z = xv.z + gt.z * o2[2 * q + 1][0]; r.w = xv.w + gt.w * o2[2 * q + 1][1];
                *(float4*)op = r;
            }
        }
#undef P9_LOAD
#undef P9_UP
    }
}
}

extern "C" void kernel_launch(void* const* d_in, const int* in_sizes, int n_in, void* d_out, int out_size, void* d_ws, size_t ws_size, hipStream_t stream) {
    static int grid = 0;
    if (grid == 0) {
        int dev = 0, cus = 0, per_cu = 0;
        (void)hipGetDevice(&dev);
        (void)hipDeviceGetAttribute(&cus, hipDeviceAttributeMultiprocessorCount, dev);
        (void)hipFuncSetAttribute((const void*)mk_fwd, hipFuncAttributeMaxDynamicSharedMemorySize, LDS_BYTES);
        (void)hipOccupancyMaxActiveBlocksPerMultiprocessor(&per_cu, (const void*)mk_fwd, 512, LDS_BYTES);
        if (per_cu < 1 || cus != 256) { fprintf(stderr, "kernel_launch: needs 256 CUs with one resident workgroup each (cus %d, per_cu %d)\n", cus, per_cu); grid = -1; }
        else grid = cus;
    }
    if (grid < 0) return;
    (void)hipMemsetAsync((char*)d_ws + OFF_CTL, 0, CTL_BYTES, stream);
    Params p{};
    p.x = (const float*)d_in[0]; p.c = (const float*)d_in[1]; p.pos = (const int*)d_in[2]; p.ada_w = (const float*)d_in[3]; p.ada_b = (const float*)d_in[4];
    p.g1 = (const float*)d_in[5]; p.g2 = (const float*)d_in[6]; p.w_in = (const float*)d_in[7]; p.rgain = (const float*)d_in[8]; p.qg = (const float*)d_in[9];
    p.kg = (const float*)d_in[10]; p.og = (const float*)d_in[11]; p.w_out = (const float*)d_in[12]; p.wq = (const float*)d_in[13]; p.sk = (const float*)d_in[14];
    p.down = (const float*)d_in[15]; p.up = (const float*)d_in[16]; p.out = (float*)d_out; p.ws = (unsigned char*)d_ws;
    for (int i = 0; i < 32; ++i) {
        const double f = pow(10000.0, -(double)i / 32.0) / 6.283185307179586476925;
        float fh = (float)f; unsigned ub; memcpy(&ub, &fh, 4); ub &= 0xFFFFC000u; memcpy(&fh, &ub, 4);
        p.rc.fh[i] = fh; p.rc.fl[i] = (float)(f - (double)fh);
    }
    void* args[] = {&p};
    hipError_t e = hipLaunchCooperativeKernel((const void*)mk_fwd, dim3(grid), dim3(512), args, LDS_BYTES, stream);
    if (e != hipSuccess) fprintf(stderr, "kernel_launch: cooperative launch failed: %s (grid %d)\n", hipGetErrorString(e), grid);
}
```

```cpp
#include <hip/hip_runtime.h>
#include <stdint.h>
#include <math.h>
#include <cstdio>
#include <cstring>

namespace {
constexpr int T = 16384, D = 1024;
constexpr float EPS = 1e-6f;
typedef unsigned short bf16_t;
#define LAS __attribute__((address_space(3)))

__device__ __forceinline__ float bf2f(bf16_t b) { return __uint_as_float(((unsigned)b) << 16); }
__device__ __forceinline__ bf16_t f2bf(float f) { unsigned u = __float_as_uint(f); u += 0x7fffu + ((u >> 16) & 1u); return (bf16_t)(u >> 16); }
__device__ __forceinline__ float4 ld_nt4(const float* p) { typedef float f4v __attribute__((ext_vector_type(4))); const f4v v = __builtin_nontemporal_load((const f4v*)p); return make_float4(v[0], v[1], v[2], v[3]); }

__device__ __forceinline__ float lg2_head(int h) {
    const float x = __uint_as_float((unsigned)(127 - 5 - h) << 23);
    const float s = x * (1.f + x * (0.5f + x * (0.33333334f + x * (0.25f + x * (0.2f + x * 0.16666667f)))));
    return -s * 1.44269504089f;
}
struct RopeC { float fh[32], fl[32]; };
struct RetC { float lg2[8]; };

constexpr size_t MiB = 1u << 20;
constexpr size_t OFF_CTL = 0;
constexpr size_t CTL_BYTES = 64 * 1024;
constexpr size_t OFF_MOD = 64 * 1024, OFF_RINV1 = 128 * 1024, OFF_BIASF = 256 * 1024, OFF_ROPE = 1 * MiB;
constexpr size_t OFF_WINT = 6 * MiB;
constexpr size_t OFF_XB = 16 * MiB;
constexpr size_t OFF_YCAT = 16 * MiB;
constexpr size_t OFF_P = 48 * MiB;
constexpr size_t OFF_KV = 208 * MiB, OFF_ST = 224 * MiB;
constexpr size_t OFF_WEFFT = 240 * MiB;
constexpr size_t OFF_WOUTT = 13 * MiB;
constexpr size_t OFF_BIASQ = 272 * 1024;
constexpr size_t OFF_DSC = 512 * 1024;
constexpr size_t OFF_BQPART = 448 * 1024;
constexpr size_t OFF_PART2 = 5 * MiB;
constexpr size_t OFF_X1B = 208 * MiB;
constexpr size_t OFF_X1 = 48 * MiB;
constexpr size_t OFF_IDS = 244 * MiB, OFF_GATES = 248 * MiB;
constexpr size_t OFF_Q8 = 176 * MiB;
constexpr size_t OFF_QSC = 320 * 1024;
constexpr int CONV_SPLIT = 0;
constexpr int LDS_BYTES = 163840;
constexpr int LDS_ST_OFF = LDS_BYTES - 16;

#define XB_TMO      128
#define XB_XCNT(j)  (256  + 64 * (j))
#define XB_XSUB(j)  (1280 + 64 * (j))
#define XB_XGEN(j)  (2304 + 64 * (j))
#define XB_TOP      3328
#define XB_TOPGEN   3392
#define XCD_BAR_WORDS 3456
#define XB_SPIN_CAP (1u << 20)
__device__ __forceinline__ unsigned xb_ld(unsigned* p)              { return __hip_atomic_load(p, __ATOMIC_RELAXED, __HIP_MEMORY_SCOPE_AGENT); }
__device__ __forceinline__ unsigned xb_add(unsigned* p, unsigned v) { return __hip_atomic_fetch_add(p, v, __ATOMIC_RELAXED, __HIP_MEMORY_SCOPE_AGENT); }
__device__ __forceinline__ unsigned xb_xcc_id() { return (unsigned)__builtin_amdgcn_s_getreg((3 << 11) | 20) & 0xFu; }
#define XB_SPIN(cond, bar) do { unsigned _sp = 0; while (cond) { __builtin_amdgcn_s_sleep(1); \
    if ((++_sp & 255u) == 0u) { if (xb_ld(&(bar)[XB_TMO])) break; if (_sp > XB_SPIN_CAP) { atomicAdd(&(bar)[XB_TMO], 1u); break; } } } } while (0)
struct XcdBarrier { unsigned* bar; unsigned x; volatile LAS unsigned* st; };
__device__ __forceinline__ XcdBarrier xcd_barrier_post(unsigned* bar, volatile LAS unsigned* st) {
    XcdBarrier b; b.bar = bar; b.x = xb_xcc_id(); b.st = st;
    if (threadIdx.x == 0) (void)xb_add(&bar[XB_XCNT(b.x)], 1u);
    return b;
}
__device__ __forceinline__ void xcd_barrier_complete(unsigned* bar, unsigned x, unsigned& nloc, unsigned& nx) {
    const unsigned G = gridDim.x * gridDim.y * gridDim.z;
    unsigned sum, cnt, mine, sp = 0u;
    for (;;) {
        sum = 0u; cnt = 0u; mine = 0u;
#pragma unroll
        for (unsigned j = 0; j < 16; ++j) { const unsigned c = xb_ld(&bar[XB_XCNT(j)]); sum += c; cnt += (c > 0u) ? 1u : 0u; mine = (j == x) ? c : mine; }
        if (sum == G) break;
        __builtin_amdgcn_s_sleep(1);
        if ((++sp & 255u) == 0u) { if (xb_ld(&bar[XB_TMO])) break; if (sp > XB_SPIN_CAP) { atomicAdd(&bar[XB_TMO], 1u); break; } }
    }
    nloc = mine > 0u ? mine : 1u; nx = cnt > 0u ? cnt : 1u;
}
__device__ __forceinline__ void xcd_barrier(const XcdBarrier& b) {
    asm volatile("s_waitcnt vmcnt(0)" ::: "memory");
    __syncthreads();
    if (threadIdx.x == 0) {
        unsigned* bar = b.bar;
        __builtin_amdgcn_s_waitcnt(0);
        unsigned nloc = b.st[0], nx = b.st[1];
        if (nloc == 0u) { xcd_barrier_complete(bar, b.x, nloc, nx); b.st[0] = nloc; b.st[1] = nx; }
        const unsigned old = xb_add(&bar[XB_XSUB(b.x)], 1u);
        const unsigned gen = old / nloc;
        if (old + 1u == (gen + 1u) * nloc) {
            __builtin_amdgcn_fence(__ATOMIC_RELEASE, "agent");
            asm volatile("s_waitcnt vmcnt(0)" ::: "memory");
            const unsigned og = xb_add(&bar[XB_TOP], 1u);
            const unsigned tg = og / nx;
            if (og + 1u == (tg + 1u) * nx) xb_add(&bar[XB_TOPGEN], 1u);
            else XB_SPIN(xb_ld(&bar[XB_TOPGEN]) == tg, bar);
            __builtin_amdgcn_fence(__ATOMIC_ACQUIRE, "agent");
            xb_add(&bar[XB_XGEN(b.x)], 1u);
            asm volatile("s_waitcnt vmcnt(0)" ::: "memory");
        } else {
            XB_SPIN(xb_ld(&bar[XB_XGEN(b.x)]) == gen, bar);
            __builtin_amdgcn_fence(__ATOMIC_ACQUIRE, "agent");
            asm volatile("s_waitcnt vmcnt(0)" ::: "memory");
        }
    }
    __syncthreads();
}


namespace pg8 {
#define PG8_LAS __attribute__((address_space(3)))
typedef short bf16x8 __attribute__((ext_vector_type(8)));
typedef float f32x4 __attribute__((ext_vector_type(4)));
typedef unsigned u32x4 __attribute__((ext_vector_type(4)));
typedef unsigned u32x2 __attribute__((ext_vector_type(2)));
constexpr int BM = 256, BK = 64, HALF = 128, HTB = HALF * BK * 2, STAGE_BYTES = 8 * HTB, NXCD = 8, WGM = 8;
__host__ __device__ __forceinline__ int lds_byte(int r, int c) { const int st = (r >> 4) * 2 + (c >> 5), rr = r & 15, cc = c & 31, ob = rr * 64 + cc * 2; return st * 1024 + (ob ^ (((ob >> 9) & 1) << 5)); }
__host__ __device__ __forceinline__ void stage_rc(int b, int& R, int& C) { const int st = b / 1024, sb = b % 1024, swz = sb ^ (((sb >> 9) & 1) << 5); R = (st >> 1) * 16 + swz / 64; C = (st & 1) * 32 + (swz % 64) / 2; }
__host__ __device__ __forceinline__ int perm32(int rho) { const int n = rho >> 4, i = rho & 15; return 8 * (i >> 2) + 4 * n + (i & 3); }
struct Unit { int pm, pn; };
struct Gemm { const bf16_t* A; const bf16_t* Bt; int M, N, K; };
struct StaticOrder {
    int nM, nN, nwg, G, c;
    __host__ __device__ void init(int M, int N, int G_, int c_) { nM = M / BM; nN = N / BM; nwg = nM * nN; G = G_; c = c_; }
    __host__ __device__ bool next(int i, Unit& u) const {
        const long L = (long)i * G + c; if (L >= nwg) return false;
        int wgid = (int)L; { const int q = nwg / NXCD, r = nwg % NXCD, xcd = wgid % NXCD, off = wgid / NXCD; wgid = (xcd < r ? xcd * (q + 1) : r * (q + 1) + (xcd - r) * q) + off; }
        const int nig = WGM * nN, gid = wgid / nig, fm = gid * WGM, gsz = (nM - fm) < WGM ? (nM - fm) : WGM;
        u.pm = fm + ((wgid % nig) % gsz); u.pn = (wgid % nig) / gsz; return true;
    }
    __device__ __forceinline__ void a_ready(const Unit&) const {}
    __device__ __forceinline__ void done(const Unit&) const {}
};
__device__ __forceinline__ unsigned cvt_pk_bf16(float lo, float hi) { unsigned r; asm volatile("v_cvt_pk_bf16_f32 %0, %1, %2" : "=v"(r) : "v"(lo), "v"(hi)); return r; }

template <class Epi, class Sched>
__device__ __forceinline__ void gemm_phase(PG8_LAS unsigned char* lds, const Gemm g, const Sched& S, const Epi& E) {
    int tid_ = threadIdx.x; asm volatile("" : "+v"(tid_));
    const int tid = tid_, wid = __builtin_amdgcn_readfirstlane(tid >> 6), lane = tid & 63, wr = wid >> 2, wc = wid & 3, fr = lane & 15, fq = lane >> 4;
    const int K = g.K, nt = K / BK;
    unsigned voffA[2], voffB[2];
#pragma unroll
    for (int i = 0; i < 2; ++i) { int R, C; stage_rc(tid * 16 + i * 8192, R, C); const int Rb = Epi::PERM ? ((R & ~31) + perm32(R & 31)) : R;
        voffA[i] = (unsigned)(R * K + C) * 2u; voffB[i] = (unsigned)(Rb * K + C) * 2u; }
    const size_t kstep = (size_t)(BK * 2);
    const size_t hstep = (size_t)HALF * K * 2;
    const size_t tstep = 2 * hstep;
    const unsigned ldsw = (unsigned)wid * 1024u;
    const int aoff = lds_byte(wr * 64 + fr, fq * 8), boff = lds_byte(wc * 32 + fr, fq * 8);
#define PG8_SA(b, h) (((b) * 2 + (h)) * HTB)
#define PG8_SB(b, h) ((4 + (b) * 2 + (h)) * HTB)
#define PG8_STAGE(bufoff, gbase, voff) do { _Pragma("unroll") for (int _i = 0; _i < 2; ++_i) \
        __builtin_amdgcn_global_load_lds((const unsigned*)((const char*)(gbase) + (voff)[_i]), (PG8_LAS unsigned*)(lds + (bufoff) + ldsw + _i * 8192), 16, 0, 0); } while (0)
#define PG8_LDA(dst, b, h) do { _Pragma("unroll") for (int m = 0; m < 4; ++m) _Pragma("unroll") for (int k = 0; k < 2; ++k) dst[m][k] = *(const PG8_LAS bf16x8*)(lds + PG8_SA(b, h) + aoff + m * 2048 + k * 1024); } while (0)
#define PG8_LDB(dst, b, h) do { _Pragma("unroll") for (int n = 0; n < 2; ++n) _Pragma("unroll") for (int k = 0; k < 2; ++k) dst[n][k] = *(const PG8_LAS bf16x8*)(lds + PG8_SB(b, h) + boff + n * 2048 + k * 1024); } while (0)
#define PG8_MMA(ai, bj, At, Bt) do { __builtin_amdgcn_s_setprio(1); _Pragma("unroll") for (int m = 0; m < 4; ++m) _Pragma("unroll") for (int n = 0; n < 2; ++n) _Pragma("unroll") for (int k = 0; k < 2; ++k) \
        acc[ai][bj][m][n] = __builtin_amdgcn_mfma_f32_16x16x32_bf16(Bt[n][k], At[m][k], acc[ai][bj][m][n], 0, 0, 0); __builtin_amdgcn_s_setprio(0); } while (0)
#define PG8_WAIT_V(n) asm volatile("s_waitcnt vmcnt(" #n ")" ::: "memory")
#define PG8_WAIT_L(n) asm volatile("s_waitcnt lgkmcnt(" #n ")" ::: "memory")
#define PG8_BAR __builtin_amdgcn_s_barrier()
#define PG8_SCHED __builtin_amdgcn_sched_barrier(0)
    Unit cur, nxt; int ui = 0;
    if (!S.next(0, cur)) return;
    f32x4 acc[2][2][4][2];
#pragma unroll
    for (int a = 0; a < 2; ++a)
#pragma unroll
        for (int b = 0; b < 2; ++b)
#pragma unroll
            for (int m = 0; m < 4; ++m)
#pragma unroll
                for (int n = 0; n < 2; ++n) acc[a][b][m][n] = (f32x4){0.f, 0.f, 0.f, 0.f};
    bf16x8 At[4][2], B0[2][2], B1[2][2];
    const char* cA = (const char*)g.A + (size_t)cur.pm * tstep; const char* cB = (const char*)g.Bt + (size_t)cur.pn * tstep;
    S.a_ready(cur);
    PG8_STAGE(PG8_SB(0, 0), cB, voffB); PG8_STAGE(PG8_SA(0, 0), cA, voffA); PG8_STAGE(PG8_SB(0, 1), cB + hstep, voffB); PG8_STAGE(PG8_SA(0, 1), cA + hstep, voffA);
    if (wr == 1) PG8_BAR;
    PG8_WAIT_V(4); PG8_BAR;
    PG8_STAGE(PG8_SB(1, 0), cB + kstep, voffB); PG8_STAGE(PG8_SA(1, 0), cA + kstep, voffA); PG8_STAGE(PG8_SB(1, 1), cB + hstep + kstep, voffB);
    PG8_WAIT_V(6); PG8_BAR;
    for (;;) {
        const bool has_next = S.next(ui + 1, nxt);
        const char* nA = has_next ? (const char*)g.A + (size_t)nxt.pm * tstep : cA; const char* nB = has_next ? (const char*)g.Bt + (size_t)nxt.pn * tstep : cB;
        for (int t = 0; t < nt; t += 2) {
            const bool last = (t == nt - 2);
            const char* a1 = cA + (size_t)(t + 1) * kstep;
            const char* a2 = last ? nA : cA + (size_t)(t + 2) * kstep; const char* b2 = last ? nB : cB + (size_t)(t + 2) * kstep;
            const char* a3 = a2 + kstep; const char* b3 = b2 + kstep;
            if (last && has_next) S.a_ready(nxt);
            PG8_LDB(B0, 0, 0); PG8_SCHED; PG8_LDA(At, 0, 0); PG8_STAGE(PG8_SA(1, 1), a1 + hstep, voffA);
            PG8_WAIT_L(8); PG8_BAR; PG8_WAIT_L(0); PG8_MMA(0, 0, At, B0); PG8_BAR; PG8_SCHED;
            PG8_LDB(B1, 0, 1); PG8_STAGE(PG8_SB(0, 0), b2, voffB);
            PG8_BAR; PG8_WAIT_L(0); PG8_MMA(0, 1, At, B1); PG8_BAR;
            PG8_LDA(At, 0, 1); PG8_STAGE(PG8_SA(0, 0), a2, voffA);
            PG8_BAR; PG8_WAIT_L(0); PG8_MMA(1, 0, At, B0); PG8_BAR; PG8_SCHED;
            PG8_STAGE(PG8_SB(0, 1), b2 + hstep, voffB);
            PG8_WAIT_V(6); PG8_BAR; PG8_MMA(1, 1, At, B1); PG8_BAR;
            PG8_LDB(B0, 1, 0); PG8_SCHED; PG8_LDA(At, 1, 0); PG8_STAGE(PG8_SA(0, 1), a2 + hstep, voffA);
            PG8_WAIT_L(8); PG8_BAR; PG8_WAIT_L(0); PG8_MMA(0, 0, At, B0); PG8_BAR; PG8_SCHED;
            PG8_LDB(B1, 1, 1); PG8_STAGE(PG8_SB(1, 0), b3, voffB);
            PG8_BAR; PG8_WAIT_L(0); PG8_MMA(0, 1, At, B1); PG8_BAR;
            PG8_LDA(At, 1, 1); PG8_STAGE(PG8_SA(1, 0), a3, voffA);
            PG8_BAR; PG8_WAIT_L(0); PG8_MMA(1, 0, At, B0); PG8_BAR; PG8_SCHED;
            PG8_STAGE(PG8_SB(1, 1), b3 + hstep, voffB);
            PG8_WAIT_V(6); PG8_BAR; PG8_MMA(1, 1, At, B1); PG8_BAR;
        }
        if constexpr (!Epi::AFTER_DRAIN) { E(acc, cur, wr, wc, fr, fq); S.done(cur); }
        if (!has_next) break;
#pragma unroll
        for (int a = 0; a < 2; ++a)
#pragma unroll
            for (int b = 0; b < 2; ++b)
#pragma unroll
                for (int m = 0; m < 4; ++m)
#pragma unroll
                    for (int n = 0; n < 2; ++n) acc[a][b][m][n] = (f32x4){0.f, 0.f, 0.f, 0.f};
        cur = nxt; cA = nA; cB = nB; ++ui;
    }
    PG8_WAIT_V(0);
    if (wr == 0) PG8_BAR;
    PG8_BAR;
    if constexpr (Epi::AFTER_DRAIN) { E.fused(acc, cur, wr, wc, fr, fq, lds, wid, lane); S.done(cur); }
#undef PG8_SA
#undef PG8_SB
#undef PG8_STAGE
#undef PG8_LDA
#undef PG8_LDB
#undef PG8_MMA
#undef PG8_WAIT_V
#undef PG8_WAIT_L
#undef PG8_BAR
#undef PG8_SCHED
}
}

__host__ __device__ __forceinline__ int cmap_in(int F) { return (F & ~255) + 128 * ((F >> 5) & 1) + 32 * ((F >> 6) & 3) + (F & 31); }
struct EpiInprojMF {
    static constexpr bool PERM = true, AFTER_DRAIN = false;
    bf16_t* P; const float* rinv; const float* bias_f; const int* pos; const float* ftab; const float* qg; const float* kg;
    __device__ __forceinline__ void operator()(const pg8::f32x4 (&acc)[2][2][4][2], const pg8::Unit& u, int wr, int wc, int fr, int fq) const {
        typedef pg8::f32x4 f32x4;
        asm volatile("" : "+v"(fr), "+v"(fq));
        const int type = u.pn >> 1, head = 4 * (u.pn & 1) + wc, fb = 256 * u.pn + 64 * wc;
        const size_t PSZ = (size_t)T * 512;
        const int rslot = (type == 0) ? 0 : (type == 1) ? 1 : (type == 2) ? 6 : (type == 3) ? 2 : (type == 4) ? 3 : (type == 5) ? 4 : 7;
        bf16_t* rowmaj = P + (size_t)rslot * PSZ;
        const int t0 = u.pm * 256 + wr * 64 + fr;
        f32x4 bv[2][2], gv[2][2], fh[2], fl[2];
#pragma unroll
        for (int bj = 0; bj < 2; ++bj)
#pragma unroll
            for (int n = 0; n < 2; ++n) bv[bj][n] = *(const f32x4*)(bias_f + fb + 32 * bj + 8 * fq + 4 * n);
        if (type <= 1) {
#pragma unroll
            for (int n = 0; n < 2; ++n) { fh[n] = *(const f32x4*)(ftab + 8 * fq + 4 * n); fl[n] = *(const f32x4*)(ftab + 32 + 8 * fq + 4 * n); }
        } else if (type == 4 || type == 5) {
            const float* gsrc = (type == 4) ? qg : kg;
#pragma unroll
            for (int bj = 0; bj < 2; ++bj)
#pragma unroll
                for (int n = 0; n < 2; ++n) gv[bj][n] = *(const f32x4*)(gsrc + 32 * bj + 8 * fq + 4 * n);
        }
#pragma unroll
        for (int ai = 0; ai < 2; ++ai) {
            float rv[4], pf[4];
#pragma unroll
            for (int m = 0; m < 4; ++m) { rv[m] = rinv[t0 + ai * 128 + m * 16]; pf[m] = (float)pos[t0 + ai * 128 + m * 16]; }
            asm volatile("" : "+v"(rv[0]), "+v"(rv[1]), "+v"(rv[2]), "+v"(rv[3]), "+v"(pf[0]), "+v"(pf[1]), "+v"(pf[2]), "+v"(pf[3]));
#pragma unroll
            for (int m = 0; m < 4; ++m) {
                const int t = t0 + ai * 128 + m * 16;
                const float r = rv[m];
                f32x4 v[2][2];
#pragma unroll
                for (int bj = 0; bj < 2; ++bj)
#pragma unroll
                    for (int n = 0; n < 2; ++n) v[bj][n] = acc[ai][bj][m][n] * r + bv[bj][n];
                if (type <= 1) {
                    const float sc = (type == 1) ? 0.125f : 1.f, pp = pf[m];
#pragma unroll
                    for (int n = 0; n < 2; ++n)
#pragma unroll
                        for (int j = 0; j < 4; ++j) {
                            const float rev = __builtin_amdgcn_fractf(__builtin_amdgcn_fractf(pp * fh[n][j]) + pp * fl[n][j]);
                            const float cs = __builtin_amdgcn_cosf(rev) * sc, sn = __builtin_amdgcn_sinf(rev) * sc;
                            const float x1 = v[0][n][j], x2 = v[1][n][j]; v[0][n][j] = x1 * cs - x2 * sn; v[1][n][j] = x2 * cs + x1 * sn;
                        }
                } else if (type == 3) {
#pragma unroll
                    for (int bj = 0; bj < 2; ++bj)
#pragma unroll
                        for (int n = 0; n < 2; ++n)
#pragma unroll
                            for (int j = 0; j < 4; ++j) { const float x = v[bj][n][j]; v[bj][n][j] = x / (1.f + __expf(-x)); }
                } else if (type == 4 || type == 5) {
                    float ss = 0.f;
#pragma unroll
                    for (int bj = 0; bj < 2; ++bj)
#pragma unroll
                        for (int n = 0; n < 2; ++n)
#pragma unroll
                            for (int j = 0; j < 4; ++j) ss += v[bj][n][j] * v[bj][n][j];
                    ss += __shfl_xor(ss, 16); ss += __shfl_xor(ss, 32);
                    const float rn = (1.0f / sqrtf(ss * (1.f / 64.f) + EPS)) * ((type == 4) ? 0.125f * 1.44269504089f : 1.f);
#pragma unroll
                    for (int bj = 0; bj < 2; ++bj)
#pragma unroll
                        for (int n = 0; n < 2; ++n) v[bj][n] = v[bj][n] * rn * gv[bj][n];
                }
#pragma unroll
                for (int bj = 0; bj < 2; ++bj) {
                    pg8::u32x4 w; w.x = pg8::cvt_pk_bf16(v[bj][0][0], v[bj][0][1]); w.y = pg8::cvt_pk_bf16(v[bj][0][2], v[bj][0][3]);
                    w.z = pg8::cvt_pk_bf16(v[bj][1][0], v[bj][1][1]); w.w = pg8::cvt_pk_bf16(v[bj][1][2], v[bj][1][3]);
                    *(pg8::u32x4*)(rowmaj + (size_t)t * 512 + head * 64 + 32 * bj + 8 * fq) = w;
                }
            }
        }
    }
};

struct EpiOutprojMF {
    static constexpr bool PERM = false, AFTER_DRAIN = true;
    const float* x; const float* gate1; float* x1; bf16_t* x1b; float* part2;
    __device__ __forceinline__ void operator()(const pg8::f32x4 (&)[2][2][4][2], const pg8::Unit&, int, int, int, int) const {}
    __device__ __forceinline__ void fused(pg8::f32x4 (&acc)[2][2][4][2], const pg8::Unit& u, int wr, int wc, int fr, int fq, PG8_LAS unsigned char* lds, int wid, int lane) const {
        typedef pg8::f32x4 f32x4;
        asm volatile("" : "+v"(fr), "+v"(fq), "+v"(lane));
        constexpr int LD = 260;
        PG8_LAS float* TL = (PG8_LAS float*)lds;
        const int colw = wc * 32 + 4 * fq;
        f32x4 gv[2][2];
#pragma unroll
        for (int bj = 0; bj < 2; ++bj)
#pragma unroll
            for (int n = 0; n < 2; ++n) gv[bj][n] = *(const f32x4*)(gate1 + u.pn * 256 + colw + bj * 128 + n * 16);
#pragma unroll
        for (int ai = 0; ai < 2; ++ai) {
#pragma unroll
            for (int m = 0; m < 4; ++m)
#pragma unroll
                for (int bj = 0; bj < 2; ++bj)
#pragma unroll
                    for (int n = 0; n < 2; ++n) *(PG8_LAS f32x4*)(TL + (64 * wr + 16 * m + fr) * LD + colw + bj * 128 + n * 16) = gv[bj][n] * acc[ai][bj][m][n];
            __syncthreads();
            f32x4 xv[2];
            const size_t rowbase = (size_t)(u.pm * 256 + ai * 128 + 16 * wid) * D + u.pn * 256 + 4 * lane;
            xv[0] = *(const f32x4*)(x + rowbase);
#pragma unroll
            for (int r = 0; r < 16; ++r) {
                if (r < 15) xv[(r + 1) & 1] = *(const f32x4*)(x + rowbase + (size_t)(r + 1) * D);
                const f32x4 g = *(PG8_LAS f32x4*)(TL + (16 * wid + r) * LD + 4 * lane);
                const f32x4 o = xv[r & 1] + g;
                *(f32x4*)(x1 + rowbase + (size_t)r * D) = o;
                pg8::u32x2 w; w.x = pg8::cvt_pk_bf16(o[0], o[1]); w.y = pg8::cvt_pk_bf16(o[2], o[3]);
                *(pg8::u32x2*)(x1b + rowbase + (size_t)r * D) = w;
                float ss = o[0] * o[0] + o[1] * o[1] + o[2] * o[2] + o[3] * o[3];
#pragma unroll
                for (int o2 = 32; o2 > 0; o2 >>= 1) ss += __shfl_xor(ss, o2);
                if (lane < 4) part2[(size_t)(u.pm * 256 + ai * 128 + 16 * wid + r) * 16 + u.pn * 4 + lane] = (lane == 0) ? ss : 0.f;
            }
            __syncthreads();
        }
    }
};

__device__ __forceinline__ unsigned pk2(float lo, float hi) { return (unsigned)f2bf(lo) | ((unsigned)f2bf(hi) << 16); }
template <bool FOLD, bool CMAP>
__device__ __forceinline__ void transpose_item(const float* W, int K, int N, bf16_t* WT, float* scr, int item, int lane, const float* sg, const float* sm) {
    const int nblk = N / 32, kb = item / nblk, nb = item % nblk, k0 = 64 * kb, n0 = 32 * nb;
    float4 v[8]; float f[8];
#pragma unroll
    for (int i = 0; i < 8; ++i) { const int kk = 8 * i + (lane >> 3); v[i] = *(const float4*)(W + (size_t)(k0 + kk) * N + n0 + 4 * (lane & 7));
        f[i] = FOLD ? sg[k0 + kk] * (1.f + sm[k0 + kk]) : 1.f; }
#pragma unroll
    for (int i = 0; i < 8; ++i) { const int kk = 8 * i + (lane >> 3); float* d = scr + kk * 33 + 4 * (lane & 7);
        d[0] = v[i].x * f[i]; d[1] = v[i].y * f[i]; d[2] = v[i].z * f[i]; d[3] = v[i].w * f[i]; }
    asm volatile("s_waitcnt lgkmcnt(0)" ::: "memory");
    const int c = lane & 7, r0 = CMAP ? cmap_in(n0) : n0;
#pragma unroll
    for (int j = 0; j < 4; ++j) { const int n = (lane >> 3) + 8 * j; const float* s = scr + (8 * c) * 33 + n;
        pg8::u32x4 o; o.x = pk2(s[0 * 33], s[1 * 33]); o.y = pk2(s[2 * 33], s[3 * 33]); o.z = pk2(s[4 * 33], s[5 * 33]); o.w = pk2(s[6 * 33], s[7 * 33]);
        *(pg8::u32x4*)(WT + (size_t)(r0 + n) * K + k0 + 8 * c) = o; }
    asm volatile("s_waitcnt lgkmcnt(0)" ::: "memory");
}
template <int NC4, class VF>
__device__ __forceinline__ void gemv_cols(unsigned char* lds, const VF vf, const float* W, const int N, const int u, float* dst, const float* add) {
    constexpr int RG = 512 / NC4;
    float (*red)[NC4 * 4] = (float (*)[NC4 * 4])lds;
    const int tid = threadIdx.x, c4 = tid % NC4, rg = tid / NC4;
    if (rg < RG) {
        float4 acc = {0.f, 0.f, 0.f, 0.f};
        for (int r = rg; r < 1024; r += RG) { const float s = vf(r); const float4 w = *(const float4*)(W + (size_t)r * N + u * NC4 * 4 + c4 * 4);
            acc.x += s * w.x; acc.y += s * w.y; acc.z += s * w.z; acc.w += s * w.w; }
        red[rg][c4 * 4 + 0] = acc.x; red[rg][c4 * 4 + 1] = acc.y; red[rg][c4 * 4 + 2] = acc.z; red[rg][c4 * 4 + 3] = acc.w;
    }
    __syncthreads();
    if (tid < NC4 * 4) { float s = 0.f; for (int i = 0; i < RG; ++i) s += red[i][tid]; dst[u * NC4 * 4 + tid] = s + (add ? add[u * NC4 * 4 + tid] : 0.f); }
    __syncthreads();
}
struct VfSilu { const float* c; __device__ __forceinline__ float operator()(int r) const { const float v = c[r]; return v / (1.f + expf(-v)); } };
struct VfVec { const float* v; __device__ __forceinline__ float operator()(int r) const { return v[r]; } };


typedef float f32x16 __attribute__((ext_vector_type(16)));
typedef pg8::bf16x8 bf16x8;
#define MFMA32(a, b, c) __builtin_amdgcn_mfma_f32_32x32x16_bf16((a), (b), (c), 0, 0, 0)
__device__ __forceinline__ bf16x8 pack_frag(const f32x16& v, int s) {
    pg8::u32x4 w;
    w.x = pg8::cvt_pk_bf16(v[8 * s + 0], v[8 * s + 1]); w.y = pg8::cvt_pk_bf16(v[8 * s + 2], v[8 * s + 3]);
    w.z = pg8::cvt_pk_bf16(v[8 * s + 4], v[8 * s + 5]); w.w = pg8::cvt_pk_bf16(v[8 * s + 6], v[8 * s + 7]);
    return __builtin_bit_cast(bf16x8, w);
}
__device__ __forceinline__ bf16x8 load_tfrag(const bf16_t* rowp, int tok) {
    const uint2 a = *(const uint2*)(rowp + tok), b = *(const uint2*)(rowp + tok + 8);
    pg8::u32x4 w; w.x = a.x; w.y = a.y; w.z = b.x; w.w = b.y;
    return __builtin_bit_cast(bf16x8, w);
}


__device__ __forceinline__ bf16x8 tr_frag(const unsigned char* a0, int rows2) {
    typedef short s16x4 __attribute__((ext_vector_type(4)));
    typedef __attribute__((address_space(3))) s16x4 lds_s16x4;
    const s16x4 lo = __builtin_amdgcn_ds_read_tr16_b64_v4i16((lds_s16x4*)a0);
    const s16x4 hi = __builtin_amdgcn_ds_read_tr16_b64_v4i16((lds_s16x4*)(a0 + rows2 * 144));
    const uint2 l2 = __builtin_bit_cast(uint2, lo), h2 = __builtin_bit_cast(uint2, hi);
    pg8::u32x4 fw; fw.x = l2.x; fw.y = l2.y; fw.z = h2.x; fw.w = h2.y;
    return __builtin_bit_cast(bf16x8, fw);
}

__device__ __forceinline__ void ins16(float (&s)[16], float x) {
#pragma unroll
    for (int i = 15; i >= 1; --i) s[i] = __builtin_amdgcn_fmed3f(s[i - 1], s[i], x);
    s[0] = fmaxf(s[0], x);
}


struct OneUnitOrder {
    pg8::StaticOrder base; int round;
    __device__ __forceinline__ bool next(int i, pg8::Unit& u) const { if (i != 0) return false; return base.next(round, u); }
    __device__ __forceinline__ void a_ready(const pg8::Unit&) const {}
    __device__ __forceinline__ void done(const pg8::Unit&) const {}
};
struct EpiTopkMF {
    static constexpr bool PERM = false, AFTER_DRAIN = true;
    const float* part2; const float* bias_q; unsigned short* ids; float* gates;
    __device__ __forceinline__ void operator()(const pg8::f32x4 (&)[2][2][4][2], const pg8::Unit&, int, int, int, int) const {}
    __device__ __forceinline__ void fused(pg8::f32x4 (&acc)[2][2][4][2], const pg8::Unit& u, int wr, int wc, int fr, int fq, PG8_LAS unsigned char* lds, int wid, int lane) const {
        typedef pg8::f32x4 f32x4;
        constexpr int SLD = 260;
        PG8_LAS float* SC = (PG8_LAS float*)lds; PG8_LAS float* MG = (PG8_LAS float*)(lds + 128 * SLD * 4);
        const int tid = wid * 64 + lane, tok = tid & 255, hk = tid >> 8;
        float rinv[2][4];
#pragma unroll
        for (int ai = 0; ai < 2; ++ai)
#pragma unroll
            for (int m = 0; m < 4; ++m) {
                const int row = u.pm * 256 + ai * 128 + wr * 64 + m * 16 + fr;
                const f32x4* pp = (const f32x4*)(part2 + (size_t)row * 16);
                const f32x4 p0 = pp[0], p1 = pp[1], p2 = pp[2], p3 = pp[3];
                const float ssum = ((p0[0] + p0[1]) + (p0[2] + p0[3])) + ((p1[0] + p1[1]) + (p1[2] + p1[3])) + ((p2[0] + p2[1]) + (p2[2] + p2[3])) + ((p3[0] + p3[1]) + (p3[2] + p3[3]));
                rinv[ai][m] = 1.0f / sqrtf(ssum * (1.0f / D) + EPS);
            }
        float sl[16], mine[16];
#pragma unroll
        for (int p = 0; p < 2; ++p) {
            f32x4 bv[2];
#pragma unroll
            for (int n = 0; n < 2; ++n) bv[n] = *(const f32x4*)(bias_q + u.pn * 256 + p * 128 + wc * 32 + n * 16 + 4 * fq);
#pragma unroll
            for (int ai = 0; ai < 2; ++ai)
#pragma unroll
                for (int m = 0; m < 4; ++m)
#pragma unroll
                    for (int n = 0; n < 2; ++n)
#pragma unroll
                        for (int j = 0; j < 4; ++j)
                            SC[(32 * wc + 16 * n + 4 * fq + j) * SLD + (128 * ai + 64 * wr + 16 * m + fr)] = acc[ai][p][m][n][j] * rinv[ai][m] + bv[n][j];
            __syncthreads();
#pragma unroll
            for (int i = 0; i < 16; ++i) sl[i] = -INFINITY;
#pragma unroll 8
            for (int k = 0; k < 64; ++k) { const int key = 64 * hk + k; const float x = SC[key * SLD + tok]; ins16(sl, __uint_as_float((__float_as_uint(x) & 0xFFFFFF80u) | (unsigned)key)); }
            if (hk != p) {
#pragma unroll
                for (int i = 0; i < 16; ++i) MG[i * 256 + tok] = sl[i];
            }
            __syncthreads();
            if (hk == p) {
#pragma unroll
                for (int i = 0; i < 16; ++i) ins16(sl, MG[i * 256 + tok]);
#pragma unroll
                for (int i = 0; i < 16; ++i) mine[i] = sl[i];
            }
            __syncthreads();
        }
        PG8_LAS float* X1 = SC; PG8_LAS float* TL = SC + 4096; PG8_LAS unsigned* I0 = (PG8_LAS unsigned*)(SC + 8192); PG8_LAS unsigned* I1 = (PG8_LAS unsigned*)(SC + 12288);
        if (hk) {
#pragma unroll
            for (int i = 0; i < 16; ++i) { X1[i * 256 + tok] = mine[i]; I1[i * 256 + tok] = __float_as_uint(mine[i]) & 0x7Fu; }
        } else {
#pragma unroll
            for (int i = 0; i < 16; ++i) I0[i * 256 + tok] = __float_as_uint(mine[i]) & 0x7Fu;
        }
        __syncthreads();
        if (!hk) {
            float s1m[16], tl[16];
#pragma unroll
            for (int i = 0; i < 16; ++i) { s1m[i] = __uint_as_float(__float_as_uint(X1[i * 256 + tok]) & 0xFFFFFF80u); mine[i] = __uint_as_float(__float_as_uint(mine[i]) & 0xFFFFFF80u); tl[i] = -INFINITY; }
#pragma unroll
            for (int a2 = 0; a2 < 16; ++a2)
#pragma unroll
                for (int b2 = 0; b2 < 16; ++b2)
                    if ((a2 + 1) * (b2 + 1) <= 16) ins16(tl, __uint_as_float((__float_as_uint(mine[a2] + s1m[b2]) & 0xFFFFFF00u) | (unsigned)(a2 * 16 + b2)));
#pragma unroll
            for (int i = 0; i < 16; ++i) TL[i * 256 + tok] = tl[i];
        }
        __syncthreads();
        if (hk) {
            float ev[16]; float sum = 0.f; unsigned cd[16];
#pragma unroll
            for (int j = 0; j < 16; ++j) { const unsigned bits = __float_as_uint(TL[j * 256 + tok]); cd[j] = bits & 0xFFu; ev[j] = __uint_as_float(bits & 0xFFFFFF00u); }
            const float mx = ev[0];
#pragma unroll
            for (int j = 0; j < 16; ++j) { ev[j] = __expf(ev[j] - mx); sum += ev[j]; }
            const float inv = 1.f / sum;
            unsigned idw[8];
#pragma unroll
            for (int j = 0; j < 16; ++j) {
                const unsigned id = I0[(cd[j] >> 4) * 256 + tok] * 128u + I1[(cd[j] & 15u) * 256 + tok];
                if (j & 1) idw[j >> 1] |= id << 16; else idw[j >> 1] = id;
                ev[j] *= inv;
            }
            const size_t t = (size_t)u.pm * 256 + tok;
            unsigned short* idp = ids + t * 128 + u.pn * 16; float* gp = gates + t * 128 + u.pn * 16;
            *(uint4*)idp = make_uint4(idw[0], idw[1], idw[2], idw[3]); *(uint4*)(idp + 8) = make_uint4(idw[4], idw[5], idw[6], idw[7]);
#pragma unroll
            for (int q = 0; q < 4; ++q) *(float4*)(gp + 4 * q) = make_float4(ev[4 * q], ev[4 * q + 1], ev[4 * q + 2], ev[4 * q + 3]);
        }
        __syncthreads();
    }
};


__device__ __forceinline__ void convert_tables(const float* down, const float* up, unsigned char* q8, unsigned char* qexp, float* dsc, int lane, int cw, int nconv, int r0, int r1) {
    for (int row0 = r0 + cw * 2; row0 < r1; row0 += nconv * 2) {
        float4 v[2][4];
#pragma unroll
        for (int rr = 0; rr < 2; ++rr) {
            const int row = row0 + rr, isup = row >> 14, e = row & 16383;
            const float* sp = (isup ? up : down) + (size_t)e * 1024 + lane * 4;
#pragma unroll
            for (int q = 0; q < 4; ++q) v[rr][q] = ld_nt4(sp + 256 * q);
        }
#pragma unroll
        for (int rr = 0; rr < 2; ++rr) {
            const int row = row0 + rr, isup = row >> 14, e = row & 16383;
            {
                float ss = 0.f;
#pragma unroll
                for (int q = 0; q < 4; ++q) ss += v[rr][q].x * v[rr][q].x + v[rr][q].y * v[rr][q].y + v[rr][q].z * v[rr][q].z + v[rr][q].w * v[rr][q].w;
#pragma unroll
                for (int o = 32; o > 0; o >>= 1) ss += __shfl_xor(ss, o);
                const float sigma = sqrtf(ss * (1.0f / 1024.0f));
                const float s = (sigma > 0.f) ? 7.5f / (2.6f * sigma) : 1.f;
#pragma unroll
                for (int q = 0; q < 4; ++q) {
                    const int n0 = (int)fminf(fmaxf(__builtin_rintf(v[rr][q].x * s), -8.f), 7.f) + 8, n1 = (int)fminf(fmaxf(__builtin_rintf(v[rr][q].y * s), -8.f), 7.f) + 8;
                    const int n2 = (int)fminf(fmaxf(__builtin_rintf(v[rr][q].z * s), -8.f), 7.f) + 8, n3 = (int)fminf(fmaxf(__builtin_rintf(v[rr][q].w * s), -8.f), 7.f) + 8;
                    const int h1 = isup ? ((n1 - 8) & 15) : n1, h3 = isup ? ((n3 - 8) & 15) : n3;
                    *(unsigned short*)(q8 + (size_t)isup * (8u << 20) + ((size_t)q * 16384 + e) * 128 + (lane & 7) * 16 + (lane >> 3) * 2) = (unsigned short)(n0 | (h1 << 4) | (n2 << 8) | (h3 << 12));
                }
                if (lane == 0) dsc[row] = 1.0f / s;
            }
        }
    }
}

struct Params {
    const float *x, *c; const int* pos; const float *ada_w, *ada_b, *g1, *g2, *w_in, *rgain, *qg, *kg, *og, *w_out, *wq, *sk, *down, *up;
    float* out; unsigned char* ws; RopeC rc;
};

__global__ void __launch_bounds__(512) mk_fwd(Params p) {
    extern __shared__ __attribute__((aligned(16))) unsigned char lds[];
    const int tid = threadIdx.x, lane = tid & 63, wave = tid >> 6, bid = blockIdx.x, G = gridDim.x;
    unsigned char* ws = p.ws;
    float* mod = (float*)(ws + OFF_MOD); float* rinv1 = (float*)(ws + OFF_RINV1); float* ftab = (float*)(ws + OFF_ROPE);
    bf16_t* P = (bf16_t*)(ws + OFF_P); float* kv = (float*)(ws + OFF_KV); bf16_t* stT = (bf16_t*)(ws + OFF_ST); bf16_t* ycat = (bf16_t*)(ws + OFF_YCAT);
    bf16_t* xb = (bf16_t*)(ws + OFF_XB); bf16_t* Win_t = (bf16_t*)(ws + OFF_WINT); float* bias_f = (float*)(ws + OFF_BIASF);
    bf16_t* Weff_t = (bf16_t*)(ws + OFF_WEFFT); bf16_t* Wout_t = (bf16_t*)(ws + OFF_WOUTT); float* bias_q = (float*)(ws + OFF_BIASQ); float* bq_part = (float*)(ws + OFF_BQPART);
    float* part2 = (float*)(ws + OFF_PART2); bf16_t* x1b = (bf16_t*)(ws + OFF_X1B); unsigned short* ids = (unsigned short*)(ws + OFF_IDS); unsigned char* q8 = ws + OFF_Q8; unsigned char* qexp = ws + OFF_QSC; float* dsc = (float*)(ws + OFF_DSC); float* gates = (float*)(ws + OFF_GATES);
    const size_t PS = (size_t)T * 512;
    const bf16_t *Qr = P, *Kr = P + PS, *Gr = P + 2 * PS, *Qs = P + 3 * PS, *Ks = P + 4 * PS, *Vr = P + 6 * PS, *Vs = P + 7 * PS;
    float* out = p.out; float* x1 = (float*)(ws + OFF_X1);

    if (tid < 4) ((LAS unsigned*)((LAS unsigned char*)lds + LDS_ST_OFF))[tid] = 0u;
    __syncthreads();
    XcdBarrier bar = xcd_barrier_post((unsigned*)(ws + OFF_CTL), (volatile LAS unsigned*)((LAS unsigned char*)lds + LDS_ST_OFF));

    for (int u = bid; u < 256; u += G) gemv_cols<6>(lds, VfSilu{p.c}, p.ada_w, 6144, u, mod, p.ada_b);
    for (int row0 = (bid * 8 + wave) * 2; row0 < T; row0 += G * 16) {
        float4 v[2][4];
#pragma unroll
        for (int rr = 0; rr < 2; ++rr)
#pragma unroll
            for (int j = 0; j < 4; ++j) v[rr][j] = ld_nt4(p.x + (size_t)(row0 + rr) * D + (lane + 64 * j) * 4);
#pragma unroll
        for (int rr = 0; rr < 2; ++rr) {
            uint2* xo = (uint2*)(xb + (size_t)(row0 + rr) * D);
            float s = 0.f;
#pragma unroll
            for (int j = 0; j < 4; ++j) { const float4 q = v[rr][j]; s += q.x * q.x + q.y * q.y + q.z * q.z + q.w * q.w; xo[lane + 64 * j] = make_uint2(pk2(q.x, q.y), pk2(q.z, q.w)); }
#pragma unroll
            for (int o = 32; o > 0; o >>= 1) s += __shfl_xor(s, o);
            if (lane == 0) rinv1[row0 + rr] = 1.0f / sqrtf(s * (1.0f / D) + EPS);
        }
    }
    if (bid == 0 && tid == 0) {
#pragma unroll
        for (int i = 0; i < 32; ++i) { ftab[i] = p.rc.fh[i]; ftab[32 + i] = p.rc.fl[i]; }
    }
    xcd_barrier(bar);

    {
        float* scr = (float*)(lds + wave * 16384);
        for (int it = bid * 8 + wave; it < 16 * 112; it += G * 8) transpose_item<true, true>(p.w_in, 1024, 3584, Win_t, scr, it, lane, p.g1, mod + 1024);
        __syncthreads();
        for (int u = bid; u < 128; u += G) gemv_cols<7>(lds, VfVec{mod}, p.w_in, 3584, u, bias_f, nullptr);
    }
    xcd_barrier(bar);

    {
        pg8::Gemm g{xb, Win_t, T, 3584, 1024}; pg8::StaticOrder S; S.init(T, 3584, G, bid);
        EpiInprojMF E{P, rinv1, bias_f, p.pos, ftab, p.qg, p.kg};
        pg8::gemm_phase<EpiInprojMF, pg8::StaticOrder>((PG8_LAS unsigned char*)lds, g, S, E);
        const int nidle = (G > 128) ? G - 128 : G, ib = (G > 128) ? bid - 128 : bid;
        {
            float* scr = (float*)(lds + wave * 16384);
            if (ib >= 0) for (int it = ib * 8 + wave; it < 16 * 32; it += nidle * 8) transpose_item<false, false>(p.w_out, 1024, 1024, Wout_t, scr, it, lane, nullptr, nullptr);
            __syncthreads();
        }
        if (ib >= 0 && ib < 128) {
            const int hp = ib >> 3, blk = ib & 7;
            float* skT = (float*)lds; float* wqs = (float*)(lds + 69632);
            for (int e = tid; e < 16384; e += 512) { const int k = e >> 7, c = e & 127; skT[c * 132 + k] = p.sk[((size_t)hp * 128 + k) * 128 + c]; }
            float bacc[16];
#pragma unroll
            for (int j = 0; j < 16; ++j) bacc[j] = 0.f;
            for (int rbk = 0; rbk < 2; ++rbk) {
                const int i0 = (blk * 2 + rbk) * 64;
                __syncthreads();
                for (int e = tid; e < 8192; e += 512) { const int r = e >> 7, c = e & 127; wqs[r * 129 + c] = p.wq[(size_t)(i0 + r) * 2048 + hp * 128 + c]; }
                __syncthreads();
                float acc[16];
#pragma unroll
                for (int j = 0; j < 16; ++j) acc[j] = 0.f;
                const float* wrow = wqs + lane * 129; const float* skc = skT + 16 * wave;
#pragma unroll 4
                for (int c = 0; c < 128; ++c) {
                    const float av = wrow[c];
                    const float4 b0 = *(const float4*)(skc + c * 132), b1 = *(const float4*)(skc + c * 132 + 4), b2 = *(const float4*)(skc + c * 132 + 8), b3 = *(const float4*)(skc + c * 132 + 12);
                    acc[0] += av * b0.x; acc[1] += av * b0.y; acc[2] += av * b0.z; acc[3] += av * b0.w; acc[4] += av * b1.x; acc[5] += av * b1.y; acc[6] += av * b1.z; acc[7] += av * b1.w;
                    acc[8] += av * b2.x; acc[9] += av * b2.y; acc[10] += av * b2.z; acc[11] += av * b2.w; acc[12] += av * b3.x; acc[13] += av * b3.y; acc[14] += av * b3.z; acc[15] += av * b3.w;
                }
                const int i = i0 + lane;
                const float s2v = p.g2[i] * (1.f + mod[4096 + i]), sh = mod[3072 + i];
#pragma unroll
                for (int j = 0; j < 16; ++j) { Weff_t[(size_t)(hp * 128 + 16 * wave + j) * 1024 + i] = f2bf(acc[j] * s2v); bacc[j] += sh * acc[j]; }
            }
#pragma unroll
            for (int j = 0; j < 16; ++j) { float v = bacc[j];
#pragma unroll
                for (int o = 32; o > 0; o >>= 1) v += __shfl_xor(v, o);
                if (lane == 0) bq_part[(size_t)blk * 2048 + hp * 128 + 16 * wave + j] = v; }
            __syncthreads();
        }
        if (ib >= 0) convert_tables(p.down, p.up, q8, qexp, dsc, lane, ib * 8 + wave, nidle * 8, 0, CONV_SPLIT);
    }
    xcd_barrier(bar);

    {
        const int gw = __builtin_amdgcn_readfirstlane(bid * 8 + wave), NGW = G * 8, l31 = lane & 31, hf = lane >> 5;
        const int wv0 = __builtin_amdgcn_readfirstlane(wave);
        for (int U = gw; U < 1024; U += NGW) {
            const int n = U >> 3, h = U & 7;
            f32x16 C[2][2];
#pragma unroll
            for (int a = 0; a < 2; ++a)
#pragma unroll
                for (int b = 0; b < 2; ++b)
#pragma unroll
                    for (int r = 0; r < 16; ++r) C[a][b][r] = 0.f;
            unsigned char* Kt = lds + wv0 * 9216; unsigned char* Vt = Kt + 4608;
            const int r8 = lane >> 3, pc = lane & 7, trq = (lane & 15) >> 2, trp = lane & 3, trd = (lane >> 4) & 1;
            const char* kbase = (const char*)(Kr + (size_t)n * 128 * 512 + h * 64); const char* vbase = (const char*)(Vr + (size_t)n * 128 * 512 + h * 64);
            const unsigned loff = (unsigned)(r8 * 512 + pc * 8) * 2u;
            const float lg = lg2_head(h);
            pg8::u32x4 gK[4], gV[4];
#pragma unroll
            for (int i = 0; i < 4; ++i) { gK[i] = *(const pg8::u32x4*)(kbase + (loff + i * 8192u)); gV[i] = *(const pg8::u32x4*)(vbase + (loff + i * 8192u)); }
            for (int sb4 = 0; sb4 < 4; ++sb4) {
#pragma unroll
                for (int i = 0; i < 4; ++i) { *(pg8::u32x4*)(Kt + (8 * i + r8) * 144 + pc * 16) = gK[i]; *(pg8::u32x4*)(Vt + (8 * i + r8) * 144 + pc * 16) = gV[i]; }
                { const int sn = (sb4 < 3) ? sb4 + 1 : sb4;
#pragma unroll
                  for (int i = 0; i < 4; ++i) { gK[i] = *(const pg8::u32x4*)(kbase + (size_t)sn * 32768 + (loff + i * 8192u)); gV[i] = *(const pg8::u32x4*)(vbase + (size_t)sn * 32768 + (loff + i * 8192u)); } }
#pragma unroll
                for (int s = 0; s < 2; ++s) {
                    bf16x8 Af[2], Bf[2];
#pragma unroll
                    for (int a = 0; a < 2; ++a) {
                        Af[a] = tr_frag(Vt + (16 * s + 8 * hf + trq) * 144 + (32 * a + 16 * trd + 4 * trp) * 2, 4);
                        const bf16x8 kraw = tr_frag(Kt + (16 * s + 8 * hf + trq) * 144 + (32 * a + 16 * trd + 4 * trp) * 2, 4);
                        const pg8::u32x4 kw = __builtin_bit_cast(pg8::u32x4, kraw); const unsigned kk[4] = {kw.x, kw.y, kw.z, kw.w};
                        pg8::u32x4 o; unsigned* op = (unsigned*)&o;
#pragma unroll
                        for (int e2 = 0; e2 < 4; ++e2) {
                            const int j0 = 32 * sb4 + 16 * s + 8 * hf + 2 * e2;
                            const float z0 = __builtin_amdgcn_exp2f((float)(127 - j0) * lg), z1 = __builtin_amdgcn_exp2f((float)(126 - j0) * lg);
                            op[e2] = pg8::cvt_pk_bf16(__uint_as_float(kk[e2] << 16) * z0, __uint_as_float(kk[e2] & 0xffff0000u) * z1);
                        }
                        Bf[a] = __builtin_bit_cast(bf16x8, o);
                    }
#pragma unroll
                    for (int a = 0; a < 2; ++a)
#pragma unroll
                        for (int b = 0; b < 2; ++b) C[a][b] = MFMA32(Af[a], Bf[b], C[a][b]);
                }
            }
            float* dst = kv + (size_t)(n * 8 + h) * 4096;
#pragma unroll
            for (int a = 0; a < 2; ++a)
#pragma unroll
                for (int b = 0; b < 2; ++b)
#pragma unroll
                    for (int r = 0; r < 16; ++r) dst[(32 * a + (r & 3) + 8 * (r >> 2) + 4 * hf) * 64 + 32 * b + l31] = C[a][b][r];
        }
        bf16x8 Tri[2];
        {
            pg8::u32x4 w0, w1; unsigned* p0 = (unsigned*)&w0; unsigned* p1 = (unsigned*)&w1;
#pragma unroll
            for (int e2 = 0; e2 < 4; ++e2) {
                unsigned a0 = 0, a1 = 0;
#pragma unroll
                for (int q = 0; q < 2; ++q) { const int e = 2 * e2 + q, ip = 8 * (e >> 2) + 4 * hf + (e & 3);
                    a0 |= ((ip > l31) ? 0x3F80u : 0u) << (16 * q); a1 |= ((16 + ip > l31) ? 0x3F80u : 0u) << (16 * q); }
                p0[e2] = a0; p1[e2] = a1;
            }
            Tri[0] = __builtin_bit_cast(bf16x8, w0); Tri[1] = __builtin_bit_cast(bf16x8, w1);
        }
        const bool sb_local = (G % 8 == 0) && (4096 % G == 0) && ((4096 / G) % 8 == 0);
        const int sb_per_wave = sb_local ? 4096 / G / 8 : (4096 + NGW - 1 - gw) / NGW;
        const int wv = __builtin_amdgcn_readfirstlane(wave);
        for (int ps = 0; ps < sb_per_wave; ++ps) {
            const int U = sb_local ? 0 : gw + ps * NGW;
            const int h = sb_local ? (bid & 7) : (U & 7), qt = sb_local ? (bid >> 3) * (4096 / G) + ps * 8 + wv : (U >> 3), q0 = qt * 32;
            f32x16 O[2];
#pragma unroll
            for (int r = 0; r < 16; ++r) { O[0][r] = 0.f; O[1][r] = 0.f; }
            float carry = 0.f;
            unsigned char* Kt = lds + wv * 9216; unsigned char* Vt = Kt + 4608;
            const int r8 = lane >> 3, pc = lane & 7;
            const char* kbase = (const char*)(Ks + h * 64); const char* vbase = (const char*)(Vs + h * 64);
            const unsigned loff = (unsigned)(r8 * 512 + pc * 8) * 2u;
            pg8::u32x4 gK[4], gV[4];
            bf16x8 Qf[4];
            {
                const char* qbase = (const char*)(Qs + h * 64);
#pragma unroll
                for (int i = 0; i < 4; ++i) gK[i] = *(const pg8::u32x4*)(qbase + (size_t)qt * 32768 + (loff + i * 8192u));
#pragma unroll
                for (int i = 0; i < 4; ++i) *(pg8::u32x4*)(Kt + (8 * i + r8) * 144 + pc * 16) = gK[i];
#pragma unroll
                for (int s = 0; s < 4; ++s) Qf[s] = *(const bf16x8*)(Kt + l31 * 144 + 32 * s + 16 * hf);
            }
#pragma unroll
            for (int i = 0; i < 4; ++i) { gK[i] = *(const pg8::u32x4*)(kbase + (size_t)qt * 32768 + (loff + i * 8192u)); gV[i] = *(const pg8::u32x4*)(vbase + (size_t)qt * 32768 + (loff + i * 8192u)); }
            const int trq = (lane & 15) >> 2, trp = lane & 3, trd = (lane >> 4) & 1;
            for (int kb = qt; kb >= 0; --kb) {
#pragma unroll
                for (int i = 0; i < 4; ++i) { *(pg8::u32x4*)(Kt + (8 * i + r8) * 144 + pc * 16) = gK[i]; *(pg8::u32x4*)(Vt + (8 * i + r8) * 144 + pc * 16) = gV[i]; }
                {
                    const int kbn = (kb > 0) ? kb - 1 : 0;
#pragma unroll
                    for (int i = 0; i < 4; ++i) { gK[i] = *(const pg8::u32x4*)(kbase + (size_t)kbn * 32768 + (loff + i * 8192u)); gV[i] = *(const pg8::u32x4*)(vbase + (size_t)kbn * 32768 + (loff + i * 8192u)); }
                }
                bf16x8 Kf[4], Vf[2][2];
#pragma unroll
                for (int s = 0; s < 4; ++s) Kf[s] = *(const bf16x8*)(Kt + l31 * 144 + 32 * s + 16 * hf);
#pragma unroll
                for (int s = 0; s < 2; ++s)
#pragma unroll
                    for (int dt = 0; dt < 2; ++dt) {
                        Vf[s][dt] = tr_frag(Vt + (16 * s + 4 * hf + trq) * 144 + (32 * dt + 16 * trd + 4 * trp) * 2, 8);
                    }
                f32x16 S;
#pragma unroll
                for (int r = 0; r < 16; ++r) S[r] = 0.f;
#pragma unroll
                for (int s = 0; s < 4; ++s) S = MFMA32(Kf[s], Qf[s], S);
                const bool diag = (kb == qt);
                f32x16 sp, lb;
                float csum = 0.f;
                if (diag) {
#pragma unroll
                    for (int r = 0; r < 16; ++r) {
                        const int i = (r & 3) + 8 * (r >> 2) + 4 * hf;
                        const float z = S[r];
                        const float l1p = __builtin_amdgcn_logf(1.0f + __builtin_amdgcn_exp2f(-fabsf(z)));
                        const float spv = (i < l31) ? (fmaxf(z, 0.f) + l1p) : 0.f;
                        sp[r] = spv; lb[r] = (i < l31) ? (fminf(z, 0.f) - l1p) : -INFINITY; csum += spv;
                    }
                } else {
#pragma unroll
                    for (int r = 0; r < 16; ++r) {
                        const float z = S[r];
                        const float l1p = __builtin_amdgcn_logf(1.0f + __builtin_amdgcn_exp2f(-fabsf(z)));
                        const float spv = fmaxf(z, 0.f) + l1p;
                        sp[r] = spv; lb[r] = fminf(z, 0.f) - l1p; csum += spv;
                    }
                }
                f32x16 Rt;
#pragma unroll
                for (int r = 0; r < 16; ++r) Rt[r] = carry;
#pragma unroll
                for (int s = 0; s < 2; ++s) Rt = MFMA32(Tri[s], pack_frag(sp, s), Rt);
                f32x16 wv;
#pragma unroll
                for (int r = 0; r < 16; ++r) wv[r] = __builtin_amdgcn_exp2f(lb[r] - Rt[r]);
#pragma unroll
                for (int s = 0; s < 2; ++s) { const bf16x8 wp = pack_frag(wv, s);
#pragma unroll
                    for (int dt = 0; dt < 2; ++dt) O[dt] = MFMA32(Vf[s][dt], wp, O[dt]); }
                csum += __shfl_xor(csum, 32);
                carry += csum;
                if (__all(carry > 127.f)) break;
            }
            float ss = 0.f;
#pragma unroll
            for (int r = 0; r < 16; ++r) ss += O[0][r] * O[0][r] + O[1][r] * O[1][r];
            ss += __shfl_xor(ss, 32);
            const float rn = 1.0f / sqrtf(ss * (1.f / 64.f) + EPS);
#pragma unroll
            for (int dt = 0; dt < 2; ++dt)
#pragma unroll
                for (int g4 = 0; g4 < 4; ++g4) {
                    const int d = 32 * dt + 8 * g4 + 4 * hf;
                    const float4 gn = *(const float4*)(p.og + d);
                    uint2 w; w.x = pg8::cvt_pk_bf16(O[dt][4 * g4] * rn * gn.x, O[dt][4 * g4 + 1] * rn * gn.y); w.y = pg8::cvt_pk_bf16(O[dt][4 * g4 + 2] * rn * gn.z, O[dt][4 * g4 + 3] * rn * gn.w);
                    *(uint2*)(Kt + l31 * 144 + d * 2) = w;
                }
#pragma unroll
            for (int i = 0; i < 4; ++i) *(pg8::u32x4*)(ycat + (size_t)(q0 + 8 * i + r8) * 1024 + 512 + h * 64 + pc * 8) = *(const pg8::u32x4*)(Kt + (8 * i + r8) * 144 + pc * 16);
        }
    }
    xcd_barrier(bar);

    if (bid == 255 % G) for (int n = tid; n < 2048; n += 512) { float s = 0.f;
#pragma unroll
        for (int b8 = 0; b8 < 8; ++b8) s += bq_part[(size_t)b8 * 2048 + n];
        bias_q[n] = s; }
    if (G > 64 && bid >= 64) convert_tables(p.down, p.up, q8, qexp, dsc, lane, (bid - 64) * 8 + wave, (G - 64) * 8, CONV_SPLIT, 32768);
    else if (G <= 64) convert_tables(p.down, p.up, q8, qexp, dsc, lane, bid * 8 + wave, G * 8, CONV_SPLIT, 32768);
    for (int idx = bid * 512 + tid; idx < 32768; idx += G * 512) {
        const int h = idx >> 12;
        const float cd = exp2f(128.f * lg2_head(h));
        float s = 0.f;
        for (int n0 = 0; n0 < 128; n0 += 32) {
            float kvv[32];
#pragma unroll
            for (int q = 0; q < 32; ++q) kvv[q] = kv[(size_t)(n0 + q) * 32768 + idx];
#pragma unroll
            for (int q = 0; q < 32; ++q) { stT[(size_t)(n0 + q) * 32768 + idx] = f2bf(s); s = cd * s + kvv[q]; }
        }
    }
    xcd_barrier(bar);

    {
        const int gw = __builtin_amdgcn_readfirstlane(bid * 8 + wave), NGW = G * 8, l31 = lane & 31, hf = lane >> 5;
        const int wv4 = __builtin_amdgcn_readfirstlane(wave);
        for (int W2 = gw; W2 < 2048; W2 += NGW) {
            const int nh = W2 >> 1, n = nh >> 3, h = nh & 7;
            const float lg = lg2_head(h);
#pragma unroll 1
            for (int pass = 0; pass < 2; ++pass) {
                const int qt = (W2 & 1) ? (pass ? 2 : 1) : (pass ? 3 : 0);
                const int il = qt * 32 + l31, tq = n * 128 + il;
                unsigned char* Kt = lds + wv4 * 9216; unsigned char* Vt = Kt + 4608;
                const int r8 = lane >> 3, pc = lane & 7, trq = (lane & 15) >> 2, trp = lane & 3, trd = (lane >> 4) & 1;
                const unsigned loff = (unsigned)(r8 * 512 + pc * 8) * 2u;
                pg8::u32x4 gK[4], gV[4];
                bf16x8 Qf[4];
                {
                    const char* qbase = (const char*)(Qr + (size_t)(n * 128 + qt * 32) * 512 + h * 64);
                    const char* sbase = (const char*)(stT + (size_t)nh * 4096) + (unsigned)(r8 * 64 + pc * 8) * 2u;
#pragma unroll
                    for (int i = 0; i < 4; ++i) gK[i] = *(const pg8::u32x4*)(qbase + (loff + i * 8192u));
#pragma unroll
                    for (int i = 0; i < 4; ++i) *(pg8::u32x4*)(Kt + (8 * i + r8) * 144 + pc * 16) = gK[i];
#pragma unroll
                    for (int s = 0; s < 4; ++s) Qf[s] = *(const bf16x8*)(Kt + l31 * 144 + 32 * s + 16 * hf);
#pragma unroll
                    for (int i = 0; i < 4; ++i) { gK[i] = *(const pg8::u32x4*)(sbase + i * 1024u); gV[i] = *(const pg8::u32x4*)(sbase + 4096u + i * 1024u); }
#pragma unroll
                    for (int i = 0; i < 4; ++i) { *(pg8::u32x4*)(Kt + (8 * i + r8) * 144 + pc * 16) = gK[i]; *(pg8::u32x4*)(Kt + (32 + 8 * i + r8) * 144 + pc * 16) = gV[i]; }
                }
                f32x16 O[2];
#pragma unroll
                for (int r = 0; r < 16; ++r) { O[0][r] = 0.f; O[1][r] = 0.f; }
#pragma unroll
                for (int s = 0; s < 4; ++s)
#pragma unroll
                    for (int dt = 0; dt < 2; ++dt) O[dt] = MFMA32(*(const bf16x8*)(Kt + (32 * dt + l31) * 144 + 32 * s + 16 * hf), Qf[s], O[dt]);
                const float xi = exp2f((float)(il + 1) * lg);
#pragma unroll
                for (int r = 0; r < 16; ++r) { O[0][r] *= xi; O[1][r] *= xi; }
                const char* kbase = (const char*)(Kr + (size_t)n * 128 * 512 + h * 64); const char* vbase = (const char*)(Vr + (size_t)n * 128 * 512 + h * 64);
#pragma unroll
                for (int i = 0; i < 4; ++i) { gK[i] = *(const pg8::u32x4*)(kbase + (loff + i * 8192u)); gV[i] = *(const pg8::u32x4*)(vbase + (loff + i * 8192u)); }
                for (int jb = 0; jb <= qt; ++jb) {
#pragma unroll
                    for (int i = 0; i < 4; ++i) { *(pg8::u32x4*)(Kt + (8 * i + r8) * 144 + pc * 16) = gK[i]; *(pg8::u32x4*)(Vt + (8 * i + r8) * 144 + pc * 16) = gV[i]; }
                    { const int jn = (jb < qt) ? jb + 1 : jb;
#pragma unroll
                      for (int i = 0; i < 4; ++i) { gK[i] = *(const pg8::u32x4*)(kbase + (size_t)jn * 32768 + (loff + i * 8192u)); gV[i] = *(const pg8::u32x4*)(vbase + (size_t)jn * 32768 + (loff + i * 8192u)); } }
                    bf16x8 Kf[4], Vf[2][2];
#pragma unroll
                    for (int s = 0; s < 4; ++s) Kf[s] = *(const bf16x8*)(Kt + l31 * 144 + 32 * s + 16 * hf);
#pragma unroll
                    for (int s = 0; s < 2; ++s)
#pragma unroll
                        for (int dt = 0; dt < 2; ++dt) Vf[s][dt] = tr_frag(Vt + (16 * s + 4 * hf + trq) * 144 + (32 * dt + 16 * trd + 4 * trp) * 2, 8);
                    f32x16 S;
#pragma unroll
                    for (int r = 0; r < 16; ++r) S[r] = 0.f;
#pragma unroll
                    for (int s = 0; s < 4; ++s) S = MFMA32(Kf[s], Qf[s], S);
#pragma unroll
                    for (int r = 0; r < 16; ++r) {
                        const int jl = jb * 32 + (r & 3) + 8 * (r >> 2) + 4 * hf, dl = il - jl;
                        S[r] = (dl >= 0) ? S[r] * __builtin_amdgcn_exp2f((float)dl * lg) : 0.f;
                    }
#pragma unroll
                    for (int s = 0; s < 2; ++s) { const bf16x8 wp = pack_frag(S, s);
#pragma unroll
                        for (int dt = 0; dt < 2; ++dt) O[dt] = MFMA32(Vf[s][dt], wp, O[dt]); }
                }
                float sm = 0.f;
#pragma unroll
                for (int r = 0; r < 16; ++r) sm += O[0][r] + O[1][r];
                sm += __shfl_xor(sm, 32);
                const float mean = sm * (1.f / 64.f);
                float vs = 0.f;
#pragma unroll
                for (int r = 0; r < 16; ++r) { const float d0 = O[0][r] - mean, d1 = O[1][r] - mean; vs += d0 * d0 + d1 * d1; }
                vs += __shfl_xor(vs, 32);
                const float rstd = 1.0f / sqrtf(vs * (1.f / 64.f) + EPS);
                {
                    const char* gbase = (const char*)(Gr + (size_t)(n * 128 + qt * 32) * 512 + h * 64);
#pragma unroll
                    for (int i = 0; i < 4; ++i) gV[i] = *(const pg8::u32x4*)(gbase + (loff + i * 8192u));
#pragma unroll
                    for (int i = 0; i < 4; ++i) *(pg8::u32x4*)(Vt + (8 * i + r8) * 144 + pc * 16) = gV[i];
                }
#pragma unroll
                for (int dt = 0; dt < 2; ++dt)
#pragma unroll
                    for (int g4 = 0; g4 < 4; ++g4) {
                        const int e = 32 * dt + 8 * g4 + 4 * hf;
                        const float4 gn = *(const float4*)(p.rgain + h * 64 + e);
                        const uint2 gg = *(const uint2*)(Vt + l31 * 144 + e * 2);
                        const float g0 = __uint_as_float(gg.x << 16), g1 = __uint_as_float(gg.x & 0xffff0000u), g2v = __uint_as_float(gg.y << 16), g3 = __uint_as_float(gg.y & 0xffff0000u);
                        uint2 w;
                        w.x = pg8::cvt_pk_bf16((O[dt][4 * g4] - mean) * rstd * gn.x * g0, (O[dt][4 * g4 + 1] - mean) * rstd * gn.y * g1);
                        w.y = pg8::cvt_pk_bf16((O[dt][4 * g4 + 2] - mean) * rstd * gn.z * g2v, (O[dt][4 * g4 + 3] - mean) * rstd * gn.w * g3);
                        *(uint2*)(Kt + l31 * 144 + e * 2) = w;
                    }
#pragma unroll
                for (int i = 0; i < 4; ++i) *(pg8::u32x4*)(ycat + (size_t)(n * 128 + qt * 32 + 8 * i + r8) * 1024 + h * 64 + pc * 8) = *(const pg8::u32x4*)(Kt + (8 * i + r8) * 144 + pc * 16);
            }
        }
    }
    xcd_barrier(bar);

    {
        pg8::Gemm g{ycat, Wout_t, T, 1024, 1024}; pg8::StaticOrder S; S.init(T, 1024, G, bid);
        EpiOutprojMF E{p.x, mod + 2048, x1, x1b, part2};
        pg8::gemm_phase<EpiOutprojMF, pg8::StaticOrder>((PG8_LAS unsigned char*)lds, g, S, E);
    }
    xcd_barrier(bar);

    for (int round = 0; round < 2; ++round) {
        pg8::Gemm g{x1b, Weff_t, T, 2048, 1024}; OneUnitOrder S; S.base.init(T, 2048, G, bid); S.round = round;
        EpiTopkMF E{part2, bias_q, ids, gates};
        pg8::gemm_phase<EpiTopkMF, OneUnitOrder>((PG8_LAS unsigned char*)lds, g, S, E);
    }
    xcd_barrier(bar);

    {
        constexpr int IDS_LD = 136, ACT_LD = 136;
        const float* scale2 = mod + 4096; const float* shift2 = mod + 3072; const float* gate2 = mod + 5120;
        unsigned short* ids_l = (unsigned short*)lds; float* act_l = (float*)(lds + 32768); unsigned char* qe_l = lds + 69632;
        float* ds_l = (float*)(lds + 86016);
        const int t0 = bid * 64, tt = lane >> 3, sub = lane & 7, tl = wave * 8 + tt, t = t0 + tl;
        for (int e = tid; e < 1024; e += 512) { const int r = e >> 4, c8 = e & 15; *(uint4*)(ids_l + r * IDS_LD + c8 * 8) = *(const uint4*)(ids + (size_t)(t0 + r) * 128 + c8 * 8); }
        for (int e = tid; e < 64 * ACT_LD; e += 512) act_l[e] = 0.f;
        for (int e = tid; e < 1024; e += 512) ((uint4*)qe_l)[e] = ((const uint4*)qexp)[e];
        for (int e = tid; e < 4096; e += 512) ((uint4*)ds_l)[e] = ((const uint4*)dsc)[e];
        __syncthreads();
        float ri;
        { const float4* pp = (const float4*)(part2 + (size_t)t * 16); const float4 p0 = pp[0], p1 = pp[1], p2 = pp[2], p3 = pp[3];
          const float ssum = ((p0.x + p0.y) + (p0.z + p0.w)) + ((p1.x + p1.y) + (p1.z + p1.w)) + ((p2.x + p2.y) + (p2.z + p2.w)) + ((p3.x + p3.y) + (p3.z + p3.w));
          ri = 1.0f / sqrtf(ssum * (1.0f / D) + EPS); }
        const unsigned short* myids = ids_l + tl * IDS_LD;
        float* myact = act_l + tl * ACT_LD; int* myacc = (int*)myact;
        const bool s4 = (sub & 4) != 0, s2 = (sub & 2) != 0, s1 = (sub & 1) != 0;
        const unsigned suboff = (unsigned)sub * 16u;
        typedef float f32x2 __attribute__((ext_vector_type(2)));
        float hmax = 0.f;
        for (int c = 0; c < 4; ++c)
#pragma unroll
            for (int q = 0; q < 8; ++q) {
                const int col = 256 * c + 4 * sub + 32 * q;
                const float4 xv = *(const float4*)(x1 + (size_t)t * D + col);
                const float4 g = *(const float4*)(p.g2 + col), sc = *(const float4*)(scale2 + col), sh = *(const float4*)(shift2 + col);
                hmax = fmaxf(hmax, fmaxf(fmaxf(fabsf(xv.x * ri * g.x * (1.f + sc.x) + sh.x), fabsf(xv.y * ri * g.y * (1.f + sc.y) + sh.y)),
                                         fmaxf(fabsf(xv.z * ri * g.z * (1.f + sc.z) + sh.z), fabsf(xv.w * ri * g.w * (1.f + sc.w) + sh.w))));
            }
        hmax = fmaxf(hmax, __shfl_xor(hmax, 1)); hmax = fmaxf(hmax, __shfl_xor(hmax, 2)); hmax = fmaxf(hmax, __shfl_xor(hmax, 4));
        const float hinv = (hmax > 0.f) ? 127.0f / hmax : 0.f, hscale = hmax * (1.0f / 127.0f);
#define P9_LOAD(W, JB) do { const uint4 idv_ = *(const uint4*)(myids + 8 * (JB)); const unsigned idw_[4] = {idv_.x, idv_.y, idv_.z, idv_.w}; \
        _Pragma("unroll") for (int k_ = 0; k_ < 8; ++k_) { const unsigned id_ = (idw_[k_ >> 1] >> (16 * (k_ & 1))) & 0xffffu; W[k_] = *(const uint4*)(sbase + (id_ * 128u + suboff)); } } while (0)
#define P9_DOWN4(W, JB) do { int pd_[8]; \
        _Pragma("unroll") for (int k_ = 0; k_ < 8; ++k_) { const unsigned ww_[4] = {W[k_].x, W[k_].y, W[k_].z, W[k_].w}; int a0_ = 0, a1_ = 0; \
            _Pragma("unroll") for (int m_ = 0; m_ < 4; ++m_) { a0_ = __builtin_amdgcn_sdot4(hpe[m_], (int)(ww_[m_] & 0x0F0F0F0Fu), a0_, false); a1_ = __builtin_amdgcn_sdot4(hpo[m_], (int)((ww_[m_] >> 4) & 0x0F0F0F0Fu), a1_, false); } \
            pd_[k_] = a0_ + a1_ - hoff; } \
        int r4_[4], r2_[2]; \
        _Pragma("unroll") for (int k_ = 0; k_ < 4; ++k_) { const int snd_ = s4 ? pd_[k_] : pd_[k_ + 4], kp_ = s4 ? pd_[k_ + 4] : pd_[k_]; r4_[k_] = kp_ + __shfl_xor(snd_, 4); } \
        _Pragma("unroll") for (int k_ = 0; k_ < 2; ++k_) { const int snd_ = s2 ? r4_[k_] : r4_[k_ + 2], kp_ = s2 ? r4_[k_ + 2] : r4_[k_]; r2_[k_] = kp_ + __shfl_xor(snd_, 2); } \
        { const int snd_ = s1 ? r2_[0] : r2_[1], kp_ = s1 ? r2_[1] : r2_[0]; myacc[8 * (JB) + sub] += kp_ + __shfl_xor(snd_, 1); } } while (0)
        for (int c = 0; c < 4; ++c) {
            int hq[8][4];
#pragma unroll
            for (int q = 0; q < 8; ++q) {
                const int col = 256 * c + 4 * sub + 32 * q;
                const float4 xv = *(const float4*)(x1 + (size_t)t * D + col);
                const float4 g = *(const float4*)(p.g2 + col), sc = *(const float4*)(scale2 + col), sh = *(const float4*)(shift2 + col);
                hq[q][0] = (int)__builtin_rintf((xv.x * ri * g.x * (1.f + sc.x) + sh.x) * hinv); hq[q][1] = (int)__builtin_rintf((xv.y * ri * g.y * (1.f + sc.y) + sh.y) * hinv);
                hq[q][2] = (int)__builtin_rintf((xv.z * ri * g.z * (1.f + sc.z) + sh.z) * hinv); hq[q][3] = (int)__builtin_rintf((xv.w * ri * g.w * (1.f + sc.w) + sh.w) * hinv);
            }
            int hpe[4], hpo[4], hoff = 0;
#pragma unroll
            for (int m = 0; m < 4; ++m) {
                hpe[m] = (hq[2 * m][0] & 255) | ((hq[2 * m][2] & 255) << 8) | ((hq[2 * m + 1][0] & 255) << 16) | ((hq[2 * m + 1][2] & 255) << 24);
                hpo[m] = (hq[2 * m][1] & 255) | ((hq[2 * m][3] & 255) << 8) | ((hq[2 * m + 1][1] & 255) << 16) | ((hq[2 * m + 1][3] & 255) << 24);
            }
#pragma unroll
            for (int q = 0; q < 8; ++q) hoff += (hq[q][0] + hq[q][1]) + (hq[q][2] + hq[q][3]);
            hoff *= 8;
            const unsigned char* sbase = q8 + (size_t)c * (16384 * 128);
            uint4 wA[8], wB[8];
            P9_LOAD(wA, 0);
#pragma unroll 1
            for (int jb = 0; jb < 16; jb += 2) {
                P9_LOAD(wB, jb + 1);
                P9_DOWN4(wA, jb);
                if (jb + 2 < 16) P9_LOAD(wA, jb + 2);
                P9_DOWN4(wB, jb + 1);
            }
        }
#undef P9_DOWN4
        signed char* aq_l = (signed char*)(lds + 151552);
        float avv[16]; float amax = 0.f;
#pragma unroll
        for (int jb = 0; jb < 16; ++jb) {
            const int j = 8 * jb + sub; const unsigned id = myids[j];
            const float a = (float)myacc[j] * ds_l[id] * hscale;
            const float av = fabsf(a), tq = 1.0f / (av * 0.2316418882f + 1.0f);
            float ql = tq * 0.5307027145f + (-0.7265760135f); ql = ql * tq + 0.7107068705f; ql = ql * tq + (-0.142248368f); ql = ql * tq + 0.127414796f; ql = ql * tq;
            const float mm = a * (ql * exp2f(a * a * (-0.72134752044f)));
            const float ge = (a < 0.f) ? mm : (a - mm);
            avv[jb] = ge * gates[(size_t)t * 128 + j] * dsc[16384 + id];
            amax = fmaxf(amax, fabsf(avv[jb]));
        }
        amax = fmaxf(amax, __shfl_xor(amax, 1)); amax = fmaxf(amax, __shfl_xor(amax, 2)); amax = fmaxf(amax, __shfl_xor(amax, 4));
        const float ainv = (amax > 0.f) ? 127.0f / amax : 0.f, ascale = amax * (1.0f / 127.0f);
        int aqsum = 0;
#pragma unroll
        for (int jb = 0; jb < 16; ++jb) { const int aqv = (int)__builtin_rintf(avv[jb] * ainv); aq_l[tl * 128 + 8 * jb + sub] = (signed char)aqv; aqsum += aqv; }
        aqsum += __shfl_xor(aqsum, 1); aqsum += __shfl_xor(aqsum, 2); aqsum += __shfl_xor(aqsum, 4);
        __syncthreads();
#define P9_PERM(HI, LO, SEL) __builtin_amdgcn_perm((HI), (LO), (SEL))
#define P9_T4(E0, E1, E2, E3, T0, T1, T2, T3) do { const unsigned p0_ = P9_PERM(E1, E0, 0x05010400u), p1_ = P9_PERM(E1, E0, 0x07030602u), p2_ = P9_PERM(E3, E2, 0x05010400u), p3_ = P9_PERM(E3, E2, 0x07030602u); \
        T0 = P9_PERM(p2_, p0_, 0x05040100u); T1 = P9_PERM(p2_, p0_, 0x07060302u); T2 = P9_PERM(p3_, p1_, 0x05040100u); T3 = P9_PERM(p3_, p1_, 0x07060302u); } while (0)
#define P9_UP4(W, JB) do { const uint2 aq8_ = *(const uint2*)(aq_l + tl * 128 + 8 * (JB)); const int aq4_[2] = {(int)aq8_.x, (int)aq8_.y}; \
        _Pragma("unroll") for (int g_ = 0; g_ < 2; ++g_) { \
            _Pragma("unroll") for (int m_ = 0; m_ < 4; ++m_) { \
                const unsigned w0_ = ((const unsigned*)&W[4 * g_ + 0])[m_], w1_ = ((const unsigned*)&W[4 * g_ + 1])[m_], w2_ = ((const unsigned*)&W[4 * g_ + 2])[m_], w3_ = ((const unsigned*)&W[4 * g_ + 3])[m_]; \
                unsigned t_[4]; \
                P9_T4(w0_, w1_, w2_, w3_, t_[0], t_[1], t_[2], t_[3]); \
                _Pragma("unroll") for (int k_ = 0; k_ < 4; ++k_) { \
                    oraw[4 * m_ + k_] = __builtin_amdgcn_sdot4(aq4_[g_], (int)t_[k_], oraw[4 * m_ + k_], false); \
                    olo[4 * m_ + k_] = __builtin_amdgcn_sdot4(aq4_[g_], (int)(t_[k_] & 0x0F0F0F0Fu), olo[4 * m_ + k_], false); } } } } while (0)
        for (int c = 0; c < 4; ++c) {
            int oraw[16], olo[16];
#pragma unroll
            for (int q = 0; q < 16; ++q) { oraw[q] = 0; olo[q] = 0; }
            const unsigned char* sbase = q8 + (8u << 20) + (size_t)c * (16384 * 128);
            uint4 wA[8], wB[8];
            P9_LOAD(wA, 0);
#pragma unroll 1
            for (int jb = 0; jb < 16; jb += 2) {
                P9_LOAD(wB, jb + 1);
                P9_UP4(wA, jb);
                if (jb + 2 < 16) P9_LOAD(wA, jb + 2);
                P9_UP4(wB, jb + 1);
            }
#pragma unroll
            for (int q = 0; q < 8; ++q) {
                const int col = 256 * c + 4 * sub + 32 * q;
                float* op = out + (size_t)t * D + col;
                const float4 xv = *(const float4*)(x1 + (size_t)t * D + col); const float4 gt = *(const float4*)(gate2 + col);
                const int m = q >> 1, k0 = 2 * (q & 1);
                const int v0 = olo[4 * m + k0] - 8 * aqsum, v1 = (oraw[4 * m + k0] - olo[4 * m + k0]) >> 4, v2 = olo[4 * m + k0 + 1] - 8 * aqsum, v3 = (oraw[4 * m + k0 + 1] - olo[4 * m + k0 + 1]) >> 4;
                float4 r;
                r.x = xv.x + gt.x * ((float)v0 * ascale); r.y = xv.y + gt.y * ((float)v1 * ascale); r.z = xv.z + gt.z * ((float)v2 * ascale); r.w = xv.w + gt.w * ((float)v3 * ascale);
                *(float4*)op = r;
            }
        }
#undef P9_LOAD
#undef P9_UP4
#undef P9_T4
#undef P9_PERM
    }
}
}

extern "C" void kernel_launch(void* const* d_in, const int* in_sizes, int n_in, void* d_out, int out_size, void* d_ws, size_t ws_size, hipStream_t stream) {
    static int grid = 0;
    if (grid == 0) {
        int dev = 0, cus = 0, per_cu = 0;
        (void)hipGetDevice(&dev);
        (void)hipDeviceGetAttribute(&cus, hipDeviceAttributeMultiprocessorCount, dev);
        (void)hipFuncSetAttribute((const void*)mk_fwd, hipFuncAttributeMaxDynamicSharedMemorySize, LDS_BYTES);
        (void)hipOccupancyMaxActiveBlocksPerMultiprocessor(&per_cu, (const void*)mk_fwd, 512, LDS_BYTES);
        if (per_cu < 1 || cus != 256) { fprintf(stderr, "kernel_launch: needs 256 CUs with one resident workgroup each (cus %d, per_cu %d)\n", cus, per_cu); grid = -1; }
        else grid = cus;
    }
    if (grid < 0) return;
    (void)hipMemsetAsync((char*)d_ws + OFF_CTL, 0, CTL_BYTES, stream);
    Params p{};
    p.x = (const float*)d_in[0]; p.c = (const float*)d_in[1]; p.pos = (const int*)d_in[2]; p.ada_w = (const float*)d_in[3]; p.ada_b = (const float*)d_in[4];
    p.g1 = (const float*)d_in[5]; p.g2 = (const float*)d_in[6]; p.w_in = (const float*)d_in[7]; p.rgain = (const float*)d_in[8]; p.qg = (const float*)d_in[9];
    p.kg = (const float*)d_in[10]; p.og = (const float*)d_in[11]; p.w_out = (const float*)d_in[12]; p.wq = (const float*)d_in[13]; p.sk = (const float*)d_in[14];
    p.down = (const float*)d_in[15]; p.up = (const float*)d_in[16]; p.out = (float*)d_out; p.ws = (unsigned char*)d_ws;
    for (int i = 0; i < 32; ++i) {
        const double f = pow(10000.0, -(double)i / 32.0) / 6.283185307179586476925;
        float fh = (float)f; unsigned ub; memcpy(&ub, &fh, 4); ub &= 0xFFFFC000u; memcpy(&fh, &ub, 4);
        p.rc.fh[i] = fh; p.rc.fl[i] = (float)(f - (double)fh);
    }
    void* args[] = {&p};
    hipError_t e = hipLaunchCooperativeKernel((const void*)mk_fwd, dim3(grid), dim3(512), args, LDS_BYTES, stream);
    if (e != hipSuccess) fprintf(stderr, "kernel_launch: cooperative launch failed: %s (grid %d)\n", hipGetErrorString(e), grid);
}
```

```cpp
#include <hip/hip_runtime.h>
#include <stdint.h>
#include <math.h>
#include <cstdio>
#include <cstring>

namespace {
constexpr int T = 16384, D = 1024;
constexpr float EPS = 1e-6f;
typedef unsigned short bf16_t;
#define LAS __attribute__((address_space(3)))

__device__ __forceinline__ float bf2f(bf16_t b) { return __uint_as_float(((unsigned)b) << 16); }
__device__ __forceinline__ bf16_t f2bf(float f) { unsigned u = __float_as_uint(f); u += 0x7fffu + ((u >> 16) & 1u); return (bf16_t)(u >> 16); }
__device__ __forceinline__ float4 ld_nt4(const float* p) { typedef float f4v __attribute__((ext_vector_type(4))); const f4v v = __builtin_nontemporal_load((const f4v*)p); return make_float4(v[0], v[1], v[2], v[3]); }

__device__ __forceinline__ float lg2_head(int h) {
    const float x = __uint_as_float((unsigned)(127 - 5 - h) << 23);
    const float s = x * (1.f + x * (0.5f + x * (0.33333334f + x * (0.25f + x * (0.2f + x * 0.16666667f)))));
    return -s * 1.44269504089f;
}
struct RopeC { float fh[32], fl[32]; };
struct RetC { float lg2[8]; };

constexpr size_t MiB = 1u << 20;
constexpr size_t OFF_CTL = 0;
constexpr size_t CTL_BYTES = 64 * 1024;
constexpr size_t OFF_MOD = 64 * 1024, OFF_RINV1 = 128 * 1024, OFF_BIASF = 256 * 1024, OFF_ROPE = 1 * MiB;
constexpr size_t OFF_WINT = 6 * MiB;
constexpr size_t OFF_XB = 16 * MiB;
constexpr size_t OFF_YCAT = 16 * MiB;
constexpr size_t OFF_P = 48 * MiB;
constexpr size_t OFF_KV = 208 * MiB, OFF_ST = 224 * MiB;
constexpr size_t OFF_WEFFT = 240 * MiB;
constexpr size_t OFF_WOUTT = 13 * MiB;
constexpr size_t OFF_BIASQ = 272 * 1024;
constexpr size_t OFF_DSC = 512 * 1024;
constexpr size_t OFF_BQPART = 448 * 1024;
constexpr size_t OFF_PART2 = 5 * MiB;
constexpr size_t OFF_X1B = 208 * MiB;
constexpr size_t OFF_X1 = 48 * MiB;
constexpr size_t OFF_IDS = 244 * MiB, OFF_GATES = 248 * MiB;
constexpr size_t OFF_Q8 = 176 * MiB;
constexpr int CONV_SPLIT = 0;
constexpr int LDS_BYTES = 163840;
constexpr int LDS_ST_OFF = LDS_BYTES - 16;

#define XB_TMO      128
#define XB_XCNT(j)  (256  + 64 * (j))
#define XB_XSUB(j)  (1280 + 64 * (j))
#define XB_XGEN(j)  (2304 + 64 * (j))
#define XB_TOP      3328
#define XB_TOPGEN   3392
#define XCD_BAR_WORDS 3456
#define XB_SPIN_CAP (1u << 20)
__device__ __forceinline__ unsigned xb_ld(unsigned* p)              { return __hip_atomic_load(p, __ATOMIC_RELAXED, __HIP_MEMORY_SCOPE_AGENT); }
__device__ __forceinline__ unsigned xb_add(unsigned* p, unsigned v) { return __hip_atomic_fetch_add(p, v, __ATOMIC_RELAXED, __HIP_MEMORY_SCOPE_AGENT); }
__device__ __forceinline__ unsigned xb_xcc_id() { return (unsigned)__builtin_amdgcn_s_getreg((3 << 11) | 20) & 0xFu; }
#define XB_SPIN(cond, bar) do { unsigned _sp = 0; while (cond) { __builtin_amdgcn_s_sleep(1); \
    if ((++_sp & 255u) == 0u) { if (xb_ld(&(bar)[XB_TMO])) break; if (_sp > XB_SPIN_CAP) { atomicAdd(&(bar)[XB_TMO], 1u); break; } } } } while (0)
struct XcdBarrier { unsigned* bar; unsigned x; volatile LAS unsigned* st; };
__device__ __forceinline__ XcdBarrier xcd_barrier_post(unsigned* bar, volatile LAS unsigned* st) {
    XcdBarrier b; b.bar = bar; b.x = xb_xcc_id(); b.st = st;
    if (threadIdx.x == 0) (void)xb_add(&bar[XB_XCNT(b.x)], 1u);
    return b;
}
__device__ __forceinline__ void xcd_barrier_complete(unsigned* bar, unsigned x, unsigned& nloc, unsigned& nx) {
    const unsigned G = gridDim.x * gridDim.y * gridDim.z;
    unsigned sum, cnt, mine, sp = 0u;
    for (;;) {
        sum = 0u; cnt = 0u; mine = 0u;
#pragma unroll
        for (unsigned j = 0; j < 16; ++j) { const unsigned c = xb_ld(&bar[XB_XCNT(j)]); sum += c; cnt += (c > 0u) ? 1u : 0u; mine = (j == x) ? c : mine; }
        if (sum == G) break;
        __builtin_amdgcn_s_sleep(1);
        if ((++sp & 255u) == 0u) { if (xb_ld(&bar[XB_TMO])) break; if (sp > XB_SPIN_CAP) { atomicAdd(&bar[XB_TMO], 1u); break; } }
    }
    nloc = mine > 0u ? mine : 1u; nx = cnt > 0u ? cnt : 1u;
}
__device__ __forceinline__ void xcd_barrier(const XcdBarrier& b) {
    asm volatile("s_waitcnt vmcnt(0)" ::: "memory");
    __syncthreads();
    if (threadIdx.x == 0) {
        unsigned* bar = b.bar;
        __builtin_amdgcn_s_waitcnt(0);
        unsigned nloc = b.st[0], nx = b.st[1];
        if (nloc == 0u) { xcd_barrier_complete(bar, b.x, nloc, nx); b.st[0] = nloc; b.st[1] = nx; }
        const unsigned old = xb_add(&bar[XB_XSUB(b.x)], 1u);
        const unsigned gen = old / nloc;
        if (old + 1u == (gen + 1u) * nloc) {
            __builtin_amdgcn_fence(__ATOMIC_RELEASE, "agent");
            asm volatile("s_waitcnt vmcnt(0)" ::: "memory");
            const unsigned og = xb_add(&bar[XB_TOP], 1u);
            const unsigned tg = og / nx;
            if (og + 1u == (tg + 1u) * nx) xb_add(&bar[XB_TOPGEN], 1u);
            else XB_SPIN(xb_ld(&bar[XB_TOPGEN]) == tg, bar);
            __builtin_amdgcn_fence(__ATOMIC_ACQUIRE, "agent");
            xb_add(&bar[XB_XGEN(b.x)], 1u);
            asm volatile("s_waitcnt vmcnt(0)" ::: "memory");
        } else {
            XB_SPIN(xb_ld(&bar[XB_XGEN(b.x)]) == gen, bar);
            __builtin_amdgcn_fence(__ATOMIC_ACQUIRE, "agent");
            asm volatile("s_waitcnt vmcnt(0)" ::: "memory");
        }
    }
    __syncthreads();
}


namespace pg8 {
#define PG8_LAS __attribute__((address_space(3)))
typedef short bf16x8 __attribute__((ext_vector_type(8)));
typedef float f32x4 __attribute__((ext_vector_type(4)));
typedef unsigned u32x4 __attribute__((ext_vector_type(4)));
typedef unsigned u32x2 __attribute__((ext_vector_type(2)));
constexpr int BM = 256, BK = 64, HALF = 128, HTB = HALF * BK * 2, STAGE_BYTES = 8 * HTB, NXCD = 8, WGM = 8;
__host__ __device__ __forceinline__ int lds_byte(int r, int c) { const int st = (r >> 4) * 2 + (c >> 5), rr = r & 15, cc = c & 31, ob = rr * 64 + cc * 2; return st * 1024 + (ob ^ (((ob >> 9) & 1) << 5)); }
__host__ __device__ __forceinline__ void stage_rc(int b, int& R, int& C) { const int st = b / 1024, sb = b % 1024, swz = sb ^ (((sb >> 9) & 1) << 5); R = (st >> 1) * 16 + swz / 64; C = (st & 1) * 32 + (swz % 64) / 2; }
__host__ __device__ __forceinline__ int perm32(int rho) { const int n = rho >> 4, i = rho & 15; return 8 * (i >> 2) + 4 * n + (i & 3); }
struct Unit { int pm, pn; };
struct Gemm { const bf16_t* A; const bf16_t* Bt; int M, N, K; };
struct StaticOrder {
    int nM, nN, nwg, G, c;
    __host__ __device__ void init(int M, int N, int G_, int c_) { nM = M / BM; nN = N / BM; nwg = nM * nN; G = G_; c = c_; }
    __host__ __device__ bool next(int i, Unit& u) const {
        const long L = (long)i * G + c; if (L >= nwg) return false;
        int wgid = (int)L; { const int q = nwg / NXCD, r = nwg % NXCD, xcd = wgid % NXCD, off = wgid / NXCD; wgid = (xcd < r ? xcd * (q + 1) : r * (q + 1) + (xcd - r) * q) + off; }
        const int nig = WGM * nN, gid = wgid / nig, fm = gid * WGM, gsz = (nM - fm) < WGM ? (nM - fm) : WGM;
        u.pm = fm + ((wgid % nig) % gsz); u.pn = (wgid % nig) / gsz; return true;
    }
    __device__ __forceinline__ void a_ready(const Unit&) const {}
    __device__ __forceinline__ void done(const Unit&) const {}
};
__device__ __forceinline__ unsigned cvt_pk_bf16(float lo, float hi) { unsigned r; asm volatile("v_cvt_pk_bf16_f32 %0, %1, %2" : "=v"(r) : "v"(lo), "v"(hi)); return r; }

template <class Epi, class Sched>
__device__ __forceinline__ void gemm_phase(PG8_LAS unsigned char* lds, const Gemm g, const Sched& S, const Epi& E) {
    int tid_ = threadIdx.x; asm volatile("" : "+v"(tid_));
    const int tid = tid_, wid = __builtin_amdgcn_readfirstlane(tid >> 6), lane = tid & 63, wr = wid >> 2, wc = wid & 3, fr = lane & 15, fq = lane >> 4;
    const int K = g.K, nt = K / BK;
    unsigned voffA[2], voffB[2];
#pragma unroll
    for (int i = 0; i < 2; ++i) { int R, C; stage_rc(tid * 16 + i * 8192, R, C); const int Rb = Epi::PERM ? ((R & ~31) + perm32(R & 31)) : R;
        voffA[i] = (unsigned)(R * K + C) * 2u; voffB[i] = (unsigned)(Rb * K + C) * 2u; }
    const size_t kstep = (size_t)(BK * 2);
    const size_t hstep = (size_t)HALF * K * 2;
    const size_t tstep = 2 * hstep;
    const unsigned ldsw = (unsigned)wid * 1024u;
    const int aoff = lds_byte(wr * 64 + fr, fq * 8), boff = lds_byte(wc * 32 + fr, fq * 8);
#define PG8_SA(b, h) (((b) * 2 + (h)) * HTB)
#define PG8_SB(b, h) ((4 + (b) * 2 + (h)) * HTB)
#define PG8_STAGE(bufoff, gbase, voff) do { _Pragma("unroll") for (int _i = 0; _i < 2; ++_i) \
        __builtin_amdgcn_global_load_lds((const unsigned*)((const char*)(gbase) + (voff)[_i]), (PG8_LAS unsigned*)(lds + (bufoff) + ldsw + _i * 8192), 16, 0, 0); } while (0)
#define PG8_LDA(dst, b, h) do { _Pragma("unroll") for (int m = 0; m < 4; ++m) _Pragma("unroll") for (int k = 0; k < 2; ++k) dst[m][k] = *(const PG8_LAS bf16x8*)(lds + PG8_SA(b, h) + aoff + m * 2048 + k * 1024); } while (0)
#define PG8_LDB(dst, b, h) do { _Pragma("unroll") for (int n = 0; n < 2; ++n) _Pragma("unroll") for (int k = 0; k < 2; ++k) dst[n][k] = *(const PG8_LAS bf16x8*)(lds + PG8_SB(b, h) + boff + n * 2048 + k * 1024); } while (0)
#define PG8_MMA(ai, bj, At, Bt) do { __builtin_amdgcn_s_setprio(1); _Pragma("unroll") for (int m = 0; m < 4; ++m) _Pragma("unroll") for (int n = 0; n < 2; ++n) _Pragma("unroll") for (int k = 0; k < 2; ++k) \
        acc[ai][bj][m][n] = __builtin_amdgcn_mfma_f32_16x16x32_bf16(Bt[n][k], At[m][k], acc[ai][bj][m][n], 0, 0, 0); __builtin_amdgcn_s_setprio(0); } while (0)
#define PG8_WAIT_V(n) asm volatile("s_waitcnt vmcnt(" #n ")" ::: "memory")
#define PG8_WAIT_L(n) asm volatile("s_waitcnt lgkmcnt(" #n ")" ::: "memory")
#define PG8_BAR __builtin_amdgcn_s_barrier()
#define PG8_SCHED __builtin_amdgcn_sched_barrier(0)
    Unit cur, nxt; int ui = 0;
    if (!S.next(0, cur)) return;
    f32x4 acc[2][2][4][2];
#pragma unroll
    for (int a = 0; a < 2; ++a)
#pragma unroll
        for (int b = 0; b < 2; ++b)
#pragma unroll
            for (int m = 0; m < 4; ++m)
#pragma unroll
                for (int n = 0; n < 2; ++n) acc[a][b][m][n] = (f32x4){0.f, 0.f, 0.f, 0.f};
    bf16x8 At[4][2], B0[2][2], B1[2][2];
    const char* cA = (const char*)g.A + (size_t)cur.pm * tstep; const char* cB = (const char*)g.Bt + (size_t)cur.pn * tstep;
    S.a_ready(cur);
    PG8_STAGE(PG8_SB(0, 0), cB, voffB); PG8_STAGE(PG8_SA(0, 0), cA, voffA); PG8_STAGE(PG8_SB(0, 1), cB + hstep, voffB); PG8_STAGE(PG8_SA(0, 1), cA + hstep, voffA);
    if (wr == 1) PG8_BAR;
    PG8_WAIT_V(4); PG8_BAR;
    PG8_STAGE(PG8_SB(1, 0), cB + kstep, voffB); PG8_STAGE(PG8_SA(1, 0), cA + kstep, voffA); PG8_STAGE(PG8_SB(1, 1), cB + hstep + kstep, voffB);
    PG8_WAIT_V(6); PG8_BAR;
    for (;;) {
        const bool has_next = S.next(ui + 1, nxt);
        const char* nA = has_next ? (const char*)g.A + (size_t)nxt.pm * tstep : cA; const char* nB = has_next ? (const char*)g.Bt + (size_t)nxt.pn * tstep : cB;
        for (int t = 0; t < nt; t += 2) {
            const bool last = (t == nt - 2);
            const char* a1 = cA + (size_t)(t + 1) * kstep;
            const char* a2 = last ? nA : cA + (size_t)(t + 2) * kstep; const char* b2 = last ? nB : cB + (size_t)(t + 2) * kstep;
            const char* a3 = a2 + kstep; const char* b3 = b2 + kstep;
            if (last && has_next) S.a_ready(nxt);
            PG8_LDB(B0, 0, 0); PG8_SCHED; PG8_LDA(At, 0, 0); PG8_STAGE(PG8_SA(1, 1), a1 + hstep, voffA);
            PG8_WAIT_L(8); PG8_BAR; PG8_WAIT_L(0); PG8_MMA(0, 0, At, B0); PG8_BAR; PG8_SCHED;
            PG8_LDB(B1, 0, 1); PG8_STAGE(PG8_SB(0, 0), b2, voffB);
            PG8_BAR; PG8_WAIT_L(0); PG8_MMA(0, 1, At, B1); PG8_BAR;
            PG8_LDA(At, 0, 1); PG8_STAGE(PG8_SA(0, 0), a2, voffA);
            PG8_BAR; PG8_WAIT_L(0); PG8_MMA(1, 0, At, B0); PG8_BAR; PG8_SCHED;
            PG8_STAGE(PG8_SB(0, 1), b2 + hstep, voffB);
            PG8_WAIT_V(6); PG8_BAR; PG8_MMA(1, 1, At, B1); PG8_BAR;
            PG8_LDB(B0, 1, 0); PG8_SCHED; PG8_LDA(At, 1, 0); PG8_STAGE(PG8_SA(0, 1), a2 + hstep, voffA);
            PG8_WAIT_L(8); PG8_BAR; PG8_WAIT_L(0); PG8_MMA(0, 0, At, B0); PG8_BAR; PG8_SCHED;
            PG8_LDB(B1, 1, 1); PG8_STAGE(PG8_SB(1, 0), b3, voffB);
            PG8_BAR; PG8_WAIT_L(0); PG8_MMA(0, 1, At, B1); PG8_BAR;
            PG8_LDA(At, 1, 1); PG8_STAGE(PG8_SA(1, 0), a3, voffA);
            PG8_BAR; PG8_WAIT_L(0); PG8_MMA(1, 0, At, B0); PG8_BAR; PG8_SCHED;
            PG8_STAGE(PG8_SB(1, 1), b3 + hstep, voffB);
            PG8_WAIT_V(6); PG8_BAR; PG8_MMA(1, 1, At, B1); PG8_BAR;
        }
        if constexpr (!Epi::AFTER_DRAIN) { E(acc, cur, wr, wc, fr, fq); S.done(cur); }
        if (!has_next) break;
#pragma unroll
        for (int a = 0; a < 2; ++a)
#pragma unroll
            for (int b = 0; b < 2; ++b)
#pragma unroll
                for (int m = 0; m < 4; ++m)
#pragma unroll
                    for (int n = 0; n < 2; ++n) acc[a][b][m][n] = (f32x4){0.f, 0.f, 0.f, 0.f};
        cur = nxt; cA = nA; cB = nB; ++ui;
    }
    PG8_WAIT_V(0);
    if (wr == 0) PG8_BAR;
    PG8_BAR;
    if constexpr (Epi::AFTER_DRAIN) { E.fused(acc, cur, wr, wc, fr, fq, lds, wid, lane); S.done(cur); }
#undef PG8_SA
#undef PG8_SB
#undef PG8_STAGE
#undef PG8_LDA
#undef PG8_LDB
#undef PG8_MMA
#undef PG8_WAIT_V
#undef PG8_WAIT_L
#undef PG8_BAR
#undef PG8_SCHED
}
}

__host__ __device__ __forceinline__ int cmap_in(int F) { return (F & ~255) + 128 * ((F >> 5) & 1) + 32 * ((F >> 6) & 3) + (F & 31); }
struct EpiInprojMF {
    static constexpr bool PERM = true, AFTER_DRAIN = false;
    bf16_t* P; const float* rinv; const float* bias_f; const int* pos; const float* ftab; const float* qg; const float* kg;
    __device__ __forceinline__ void operator()(const pg8::f32x4 (&acc)[2][2][4][2], const pg8::Unit& u, int wr, int wc, int fr, int fq) const {
        typedef pg8::f32x4 f32x4;
        asm volatile("" : "+v"(fr), "+v"(fq));
        const int type = u.pn >> 1, head = 4 * (u.pn & 1) + wc, fb = 256 * u.pn + 64 * wc;
        const size_t PSZ = (size_t)T * 512;
        const int rslot = (type == 0) ? 0 : (type == 1) ? 1 : (type == 2) ? 6 : (type == 3) ? 2 : (type == 4) ? 3 : (type == 5) ? 4 : 7;
        bf16_t* rowmaj = P + (size_t)rslot * PSZ;
        const int t0 = u.pm * 256 + wr * 64 + fr;
        f32x4 bv[2][2], gv[2][2], fh[2], fl[2];
#pragma unroll
        for (int bj = 0; bj < 2; ++bj)
#pragma unroll
            for (int n = 0; n < 2; ++n) bv[bj][n] = *(const f32x4*)(bias_f + fb + 32 * bj + 8 * fq + 4 * n);
        if (type <= 1) {
#pragma unroll
            for (int n = 0; n < 2; ++n) { fh[n] = *(const f32x4*)(ftab + 8 * fq + 4 * n); fl[n] = *(const f32x4*)(ftab + 32 + 8 * fq + 4 * n); }
        } else if (type == 4 || type == 5) {
            const float* gsrc = (type == 4) ? qg : kg;
#pragma unroll
            for (int bj = 0; bj < 2; ++bj)
#pragma unroll
                for (int n = 0; n < 2; ++n) gv[bj][n] = *(const f32x4*)(gsrc + 32 * bj + 8 * fq + 4 * n);
        }
#pragma unroll
        for (int ai = 0; ai < 2; ++ai) {
            float rv[4], pf[4];
#pragma unroll
            for (int m = 0; m < 4; ++m) { rv[m] = rinv[t0 + ai * 128 + m * 16]; pf[m] = (float)pos[t0 + ai * 128 + m * 16]; }
            asm volatile("" : "+v"(rv[0]), "+v"(rv[1]), "+v"(rv[2]), "+v"(rv[3]), "+v"(pf[0]), "+v"(pf[1]), "+v"(pf[2]), "+v"(pf[3]));
#pragma unroll
            for (int m = 0; m < 4; ++m) {
                const int t = t0 + ai * 128 + m * 16;
                const float r = rv[m];
                f32x4 v[2][2];
#pragma unroll
                for (int bj = 0; bj < 2; ++bj)
#pragma unroll
                    for (int n = 0; n < 2; ++n) v[bj][n] = acc[ai][bj][m][n] * r + bv[bj][n];
                if (type <= 1) {
                    const float sc = (type == 1) ? 0.125f : 1.f, pp = pf[m];
#pragma unroll
                    for (int n = 0; n < 2; ++n)
#pragma unroll
                        for (int j = 0; j < 4; ++j) {
                            const float rev = __builtin_amdgcn_fractf(__builtin_amdgcn_fractf(pp * fh[n][j]) + pp * fl[n][j]);
                            const float cs = __builtin_amdgcn_cosf(rev) * sc, sn = __builtin_amdgcn_sinf(rev) * sc;
                            const float x1 = v[0][n][j], x2 = v[1][n][j]; v[0][n][j] = x1 * cs - x2 * sn; v[1][n][j] = x2 * cs + x1 * sn;
                        }
                } else if (type == 3) {
#pragma unroll
                    for (int bj = 0; bj < 2; ++bj)
#pragma unroll
                        for (int n = 0; n < 2; ++n)
#pragma unroll
                            for (int j = 0; j < 4; ++j) { const float x = v[bj][n][j]; v[bj][n][j] = x / (1.f + __expf(-x)); }
                } else if (type == 4 || type == 5) {
                    float ss = 0.f;
#pragma unroll
                    for (int bj = 0; bj < 2; ++bj)
#pragma unroll
                        for (int n = 0; n < 2; ++n)
#pragma unroll
                            for (int j = 0; j < 4; ++j) ss += v[bj][n][j] * v[bj][n][j];
                    ss += __shfl_xor(ss, 16); ss += __shfl_xor(ss, 32);
                    const float rn = (1.0f / sqrtf(ss * (1.f / 64.f) + EPS)) * ((type == 4) ? 0.125f * 1.44269504089f : 1.f);
#pragma unroll
                    for (int bj = 0; bj < 2; ++bj)
#pragma unroll
                        for (int n = 0; n < 2; ++n) v[bj][n] = v[bj][n] * rn * gv[bj][n];
                }
#pragma unroll
                for (int bj = 0; bj < 2; ++bj) {
                    pg8::u32x4 w; w.x = pg8::cvt_pk_bf16(v[bj][0][0], v[bj][0][1]); w.y = pg8::cvt_pk_bf16(v[bj][0][2], v[bj][0][3]);
                    w.z = pg8::cvt_pk_bf16(v[bj][1][0], v[bj][1][1]); w.w = pg8::cvt_pk_bf16(v[bj][1][2], v[bj][1][3]);
                    *(pg8::u32x4*)(rowmaj + (size_t)t * 512 + head * 64 + 32 * bj + 8 * fq) = w;
                }
            }
        }
    }
};

struct EpiOutprojMF {
    static constexpr bool PERM = false, AFTER_DRAIN = true;
    const float* x; const float* gate1; float* x1; bf16_t* x1b; float* part2;
    __device__ __forceinline__ void operator()(const pg8::f32x4 (&)[2][2][4][2], const pg8::Unit&, int, int, int, int) const {}
    __device__ __forceinline__ void fused(pg8::f32x4 (&acc)[2][2][4][2], const pg8::Unit& u, int wr, int wc, int fr, int fq, PG8_LAS unsigned char* lds, int wid, int lane) const {
        typedef pg8::f32x4 f32x4;
        asm volatile("" : "+v"(fr), "+v"(fq), "+v"(lane));
        constexpr int LD = 260;
        PG8_LAS float* TL = (PG8_LAS float*)lds;
        const int colw = wc * 32 + 4 * fq;
        f32x4 gv[2][2];
#pragma unroll
        for (int bj = 0; bj < 2; ++bj)
#pragma unroll
            for (int n = 0; n < 2; ++n) gv[bj][n] = *(const f32x4*)(gate1 + u.pn * 256 + colw + bj * 128 + n * 16);
#pragma unroll
        for (int ai = 0; ai < 2; ++ai) {
#pragma unroll
            for (int m = 0; m < 4; ++m)
#pragma unroll
                for (int bj = 0; bj < 2; ++bj)
#pragma unroll
                    for (int n = 0; n < 2; ++n) *(PG8_LAS f32x4*)(TL + (64 * wr + 16 * m + fr) * LD + colw + bj * 128 + n * 16) = gv[bj][n] * acc[ai][bj][m][n];
            __syncthreads();
            f32x4 xv[2];
            const size_t rowbase = (size_t)(u.pm * 256 + ai * 128 + 16 * wid) * D + u.pn * 256 + 4 * lane;
            xv[0] = *(const f32x4*)(x + rowbase);
#pragma unroll
            for (int r = 0; r < 16; ++r) {
                if (r < 15) xv[(r + 1) & 1] = *(const f32x4*)(x + rowbase + (size_t)(r + 1) * D);
                const f32x4 g = *(PG8_LAS f32x4*)(TL + (16 * wid + r) * LD + 4 * lane);
                const f32x4 o = xv[r & 1] + g;
                *(f32x4*)(x1 + rowbase + (size_t)r * D) = o;
                pg8::u32x2 w; w.x = pg8::cvt_pk_bf16(o[0], o[1]); w.y = pg8::cvt_pk_bf16(o[2], o[3]);
                *(pg8::u32x2*)(x1b + rowbase + (size_t)r * D) = w;
                float ss = o[0] * o[0] + o[1] * o[1] + o[2] * o[2] + o[3] * o[3];
#pragma unroll
                for (int o2 = 32; o2 > 0; o2 >>= 1) ss += __shfl_xor(ss, o2);
                if (lane < 4) part2[(size_t)(u.pm * 256 + ai * 128 + 16 * wid + r) * 16 + u.pn * 4 + lane] = (lane == 0) ? ss : 0.f;
            }
            __syncthreads();
        }
    }
};

__device__ __forceinline__ unsigned pk2(float lo, float hi) { return (unsigned)f2bf(lo) | ((unsigned)f2bf(hi) << 16); }
template <bool FOLD, bool CMAP>
__device__ __forceinline__ void transpose_item(const float* W, int K, int N, bf16_t* WT, float* scr, int item, int lane, const float* sg, const float* sm) {
    const int nblk = N / 32, kb = item / nblk, nb = item % nblk, k0 = 64 * kb, n0 = 32 * nb;
    float4 v[8]; float f[8];
#pragma unroll
    for (int i = 0; i < 8; ++i) { const int kk = 8 * i + (lane >> 3); v[i] = *(const float4*)(W + (size_t)(k0 + kk) * N + n0 + 4 * (lane & 7));
        f[i] = FOLD ? sg[k0 + kk] * (1.f + sm[k0 + kk]) : 1.f; }
#pragma unroll
    for (int i = 0; i < 8; ++i) { const int kk = 8 * i + (lane >> 3); float* d = scr + kk * 33 + 4 * (lane & 7);
        d[0] = v[i].x * f[i]; d[1] = v[i].y * f[i]; d[2] = v[i].z * f[i]; d[3] = v[i].w * f[i]; }
    asm volatile("s_waitcnt lgkmcnt(0)" ::: "memory");
    const int c = lane & 7, r0 = CMAP ? cmap_in(n0) : n0;
#pragma unroll
    for (int j = 0; j < 4; ++j) { const int n = (lane >> 3) + 8 * j; const float* s = scr + (8 * c) * 33 + n;
        pg8::u32x4 o; o.x = pk2(s[0 * 33], s[1 * 33]); o.y = pk2(s[2 * 33], s[3 * 33]); o.z = pk2(s[4 * 33], s[5 * 33]); o.w = pk2(s[6 * 33], s[7 * 33]);
        *(pg8::u32x4*)(WT + (size_t)(r0 + n) * K + k0 + 8 * c) = o; }
    asm volatile("s_waitcnt lgkmcnt(0)" ::: "memory");
}
template <int NC4, class VF>
__device__ __forceinline__ void gemv_cols(unsigned char* lds, const VF vf, const float* W, const int N, const int u, float* dst, const float* add) {
    constexpr int RG = 512 / NC4;
    float (*red)[NC4 * 4] = (float (*)[NC4 * 4])lds;
    const int tid = threadIdx.x, c4 = tid % NC4, rg = tid / NC4;
    if (rg < RG) {
        float4 acc = {0.f, 0.f, 0.f, 0.f};
        for (int r = rg; r < 1024; r += RG) { const float s = vf(r); const float4 w = *(const float4*)(W + (size_t)r * N + u * NC4 * 4 + c4 * 4);
            acc.x += s * w.x; acc.y += s * w.y; acc.z += s * w.z; acc.w += s * w.w; }
        red[rg][c4 * 4 + 0] = acc.x; red[rg][c4 * 4 + 1] = acc.y; red[rg][c4 * 4 + 2] = acc.z; red[rg][c4 * 4 + 3] = acc.w;
    }
    __syncthreads();
    if (tid < NC4 * 4) { float s = 0.f; for (int i = 0; i < RG; ++i) s += red[i][tid]; dst[u * NC4 * 4 + tid] = s + (add ? add[u * NC4 * 4 + tid] : 0.f); }
    __syncthreads();
}
struct VfSilu { const float* c; __device__ __forceinline__ float operator()(int r) const { const float v = c[r]; return v / (1.f + expf(-v)); } };
struct VfVec { const float* v; __device__ __forceinline__ float operator()(int r) const { return v[r]; } };


typedef float f32x16 __attribute__((ext_vector_type(16)));
typedef pg8::bf16x8 bf16x8;
#define MFMA32(a, b, c) __builtin_amdgcn_mfma_f32_32x32x16_bf16((a), (b), (c), 0, 0, 0)
__device__ __forceinline__ bf16x8 pack_frag(const f32x16& v, int s) {
    pg8::u32x4 w;
    w.x = pg8::cvt_pk_bf16(v[8 * s + 0], v[8 * s + 1]); w.y = pg8::cvt_pk_bf16(v[8 * s + 2], v[8 * s + 3]);
    w.z = pg8::cvt_pk_bf16(v[8 * s + 4], v[8 * s + 5]); w.w = pg8::cvt_pk_bf16(v[8 * s + 6], v[8 * s + 7]);
    return __builtin_bit_cast(bf16x8, w);
}
__device__ __forceinline__ bf16x8 load_tfrag(const bf16_t* rowp, int tok) {
    const uint2 a = *(const uint2*)(rowp + tok), b = *(const uint2*)(rowp + tok + 8);
    pg8::u32x4 w; w.x = a.x; w.y = a.y; w.z = b.x; w.w = b.y;
    return __builtin_bit_cast(bf16x8, w);
}


__device__ __forceinline__ bf16x8 tr_frag(const unsigned char* a0, int rows2) {
    typedef short s16x4 __attribute__((ext_vector_type(4)));
    typedef __attribute__((address_space(3))) s16x4 lds_s16x4;
    const s16x4 lo = __builtin_amdgcn_ds_read_tr16_b64_v4i16((lds_s16x4*)a0);
    const s16x4 hi = __builtin_amdgcn_ds_read_tr16_b64_v4i16((lds_s16x4*)(a0 + rows2 * 144));
    const uint2 l2 = __builtin_bit_cast(uint2, lo), h2 = __builtin_bit_cast(uint2, hi);
    pg8::u32x4 fw; fw.x = l2.x; fw.y = l2.y; fw.z = h2.x; fw.w = h2.y;
    return __builtin_bit_cast(bf16x8, fw);
}

__device__ __forceinline__ void ins16(float (&s)[16], float x) {
#pragma unroll
    for (int i = 15; i >= 1; --i) s[i] = __builtin_amdgcn_fmed3f(s[i - 1], s[i], x);
    s[0] = fmaxf(s[0], x);
}


struct OneUnitOrder {
    pg8::StaticOrder base; int round;
    __device__ __forceinline__ bool next(int i, pg8::Unit& u) const { if (i != 0) return false; return base.next(round, u); }
    __device__ __forceinline__ void a_ready(const pg8::Unit&) const {}
    __device__ __forceinline__ void done(const pg8::Unit&) const {}
};
struct EpiTopkMF {
    static constexpr bool PERM = false, AFTER_DRAIN = true;
    const float* part2; const float* bias_q; unsigned short* ids; float* gates;
    __device__ __forceinline__ void operator()(const pg8::f32x4 (&)[2][2][4][2], const pg8::Unit&, int, int, int, int) const {}
    __device__ __forceinline__ void fused(pg8::f32x4 (&acc)[2][2][4][2], const pg8::Unit& u, int wr, int wc, int fr, int fq, PG8_LAS unsigned char* lds, int wid, int lane) const {
        typedef pg8::f32x4 f32x4;
        constexpr int SLD = 260;
        PG8_LAS float* SC = (PG8_LAS float*)lds; PG8_LAS float* MG = (PG8_LAS float*)(lds + 128 * SLD * 4);
        const int tid = wid * 64 + lane, tok = tid & 255, hk = tid >> 8;
        float rinv[2][4];
#pragma unroll
        for (int ai = 0; ai < 2; ++ai)
#pragma unroll
            for (int m = 0; m < 4; ++m) {
                const int row = u.pm * 256 + ai * 128 + wr * 64 + m * 16 + fr;
                const f32x4* pp = (const f32x4*)(part2 + (size_t)row * 16);
                const f32x4 p0 = pp[0], p1 = pp[1], p2 = pp[2], p3 = pp[3];
                const float ssum = ((p0[0] + p0[1]) + (p0[2] + p0[3])) + ((p1[0] + p1[1]) + (p1[2] + p1[3])) + ((p2[0] + p2[1]) + (p2[2] + p2[3])) + ((p3[0] + p3[1]) + (p3[2] + p3[3]));
                rinv[ai][m] = 1.0f / sqrtf(ssum * (1.0f / D) + EPS);
            }
        float sl[16], mine[16];
#pragma unroll
        for (int p = 0; p < 2; ++p) {
            f32x4 bv[2];
#pragma unroll
            for (int n = 0; n < 2; ++n) bv[n] = *(const f32x4*)(bias_q + u.pn * 256 + p * 128 + wc * 32 + n * 16 + 4 * fq);
#pragma unroll
            for (int ai = 0; ai < 2; ++ai)
#pragma unroll
                for (int m = 0; m < 4; ++m)
#pragma unroll
                    for (int n = 0; n < 2; ++n)
#pragma unroll
                        for (int j = 0; j < 4; ++j)
                            SC[(32 * wc + 16 * n + 4 * fq + j) * SLD + (128 * ai + 64 * wr + 16 * m + fr)] = acc[ai][p][m][n][j] * rinv[ai][m] + bv[n][j];
            __syncthreads();
#pragma unroll
            for (int i = 0; i < 16; ++i) sl[i] = -INFINITY;
#pragma unroll 8
            for (int k = 0; k < 64; ++k) { const int key = 64 * hk + k; const float x = SC[key * SLD + tok]; ins16(sl, __uint_as_float((__float_as_uint(x) & 0xFFFFFF80u) | (unsigned)key)); }
            if (hk != p) {
#pragma unroll
                for (int i = 0; i < 16; ++i) MG[i * 256 + tok] = sl[i];
            }
            __syncthreads();
            if (hk == p) {
#pragma unroll
                for (int i = 0; i < 16; ++i) ins16(sl, MG[i * 256 + tok]);
#pragma unroll
                for (int i = 0; i < 16; ++i) mine[i] = sl[i];
            }
            __syncthreads();
        }
        PG8_LAS float* X1 = SC; PG8_LAS float* TL = SC + 4096; PG8_LAS unsigned* I0 = (PG8_LAS unsigned*)(SC + 8192); PG8_LAS unsigned* I1 = (PG8_LAS unsigned*)(SC + 12288);
        if (hk) {
#pragma unroll
            for (int i = 0; i < 16; ++i) { X1[i * 256 + tok] = mine[i]; I1[i * 256 + tok] = __float_as_uint(mine[i]) & 0x7Fu; }
        } else {
#pragma unroll
            for (int i = 0; i < 16; ++i) I0[i * 256 + tok] = __float_as_uint(mine[i]) & 0x7Fu;
        }
        __syncthreads();
        if (!hk) {
            float s1m[16], tl[16];
#pragma unroll
            for (int i = 0; i < 16; ++i) { s1m[i] = __uint_as_float(__float_as_uint(X1[i * 256 + tok]) & 0xFFFFFF80u); mine[i] = __uint_as_float(__float_as_uint(mine[i]) & 0xFFFFFF80u); tl[i] = -INFINITY; }
#pragma unroll
            for (int a2 = 0; a2 < 16; ++a2)
#pragma unroll
                for (int b2 = 0; b2 < 16; ++b2)
                    if ((a2 + 1) * (b2 + 1) <= 16) ins16(tl, __uint_as_float((__float_as_uint(mine[a2] + s1m[b2]) & 0xFFFFFF00u) | (unsigned)(a2 * 16 + b2)));
#pragma unroll
            for (int i = 0; i < 16; ++i) TL[i * 256 + tok] = tl[i];
        }
        __syncthreads();
        if (hk) {
            float ev[16]; float sum = 0.f; unsigned cd[16];
#pragma unroll
            for (int j = 0; j < 16; ++j) { const unsigned bits = __float_as_uint(TL[j * 256 + tok]); cd[j] = bits & 0xFFu; ev[j] = __uint_as_float(bits & 0xFFFFFF00u); }
            const float mx = ev[0];
#pragma unroll
            for (int j = 0; j < 16; ++j) { ev[j] = __expf(ev[j] - mx); sum += ev[j]; }
            const float inv = 1.f / sum;
            unsigned idw[8];
#pragma unroll
            for (int j = 0; j < 16; ++j) {
                const unsigned id = I0[(cd[j] >> 4) * 256 + tok] * 128u + I1[(cd[j] & 15u) * 256 + tok];
                if (j & 1) idw[j >> 1] |= id << 16; else idw[j >> 1] = id;
                ev[j] *= inv;
            }
            const size_t t = (size_t)u.pm * 256 + tok;
            unsigned short* idp = ids + t * 128 + u.pn * 16; float* gp = gates + t * 128 + u.pn * 16;
            *(uint4*)idp = make_uint4(idw[0], idw[1], idw[2], idw[3]); *(uint4*)(idp + 8) = make_uint4(idw[4], idw[5], idw[6], idw[7]);
#pragma unroll
            for (int q = 0; q < 4; ++q) *(float4*)(gp + 4 * q) = make_float4(ev[4 * q], ev[4 * q + 1], ev[4 * q + 2], ev[4 * q + 3]);
        }
        __syncthreads();
    }
};


__device__ __forceinline__ void convert_tables(const float* down, const float* up, unsigned char* q8, bf16_t* dsc, int lane, int cw, int nconv, int r0, int r1) {
    for (int row0 = r0 + cw * 2; row0 < r1; row0 += nconv * 2) {
        float4 v[2][4];
#pragma unroll
        for (int rr = 0; rr < 2; ++rr) {
            const int row = row0 + rr, isup = row >> 14, e = row & 16383;
            const float* sp = (isup ? up : down) + (size_t)e * 1024 + lane * 4;
#pragma unroll
            for (int q = 0; q < 4; ++q) v[rr][q] = ld_nt4(sp + 256 * q);
        }
#pragma unroll
        for (int rr = 0; rr < 2; ++rr) {
            const int row = row0 + rr, isup = row >> 14, e = row & 16383;
            {
                float ss = 0.f;
#pragma unroll
                for (int q = 0; q < 4; ++q) ss += v[rr][q].x * v[rr][q].x + v[rr][q].y * v[rr][q].y + v[rr][q].z * v[rr][q].z + v[rr][q].w * v[rr][q].w;
#pragma unroll
                for (int o = 32; o > 0; o >>= 1) ss += __shfl_xor(ss, o);
                const float sigma = sqrtf(ss * (1.0f / 1024.0f));
                const float s = (sigma > 0.f) ? 7.5f / (2.6f * sigma) : 1.f;
#pragma unroll
                for (int q = 0; q < 4; ++q) {
                    const int n0 = (int)fminf(fmaxf(__builtin_rintf(v[rr][q].x * s), -8.f), 7.f) + 8, n1 = (int)fminf(fmaxf(__builtin_rintf(v[rr][q].y * s), -8.f), 7.f) + 8;
                    const int n2 = (int)fminf(fmaxf(__builtin_rintf(v[rr][q].z * s), -8.f), 7.f) + 8, n3 = (int)fminf(fmaxf(__builtin_rintf(v[rr][q].w * s), -8.f), 7.f) + 8;
                    const int h1 = isup ? ((n1 - 8) & 15) : n1, h3 = isup ? ((n3 - 8) & 15) : n3;
                    *(unsigned short*)(q8 + (size_t)isup * (8u << 20) + ((size_t)q * 16384 + e) * 128 + (lane & 7) * 16 + (lane >> 3) * 2) = (unsigned short)(n0 | (h1 << 4) | (n2 << 8) | (h3 << 12));
                }
                if (lane == 0) dsc[row] = f2bf(1.0f / s);
            }
        }
    }
}

struct Params {
    const float *x, *c; const int* pos; const float *ada_w, *ada_b, *g1, *g2, *w_in, *rgain, *qg, *kg, *og, *w_out, *wq, *sk, *down, *up;
    float* out; unsigned char* ws; RopeC rc;
};

__global__ void __launch_bounds__(512) mk_fwd(Params p) {
    extern __shared__ __attribute__((aligned(16))) unsigned char lds[];
    const int tid = threadIdx.x, lane = tid & 63, wave = tid >> 6, bid = blockIdx.x, G = gridDim.x;
    unsigned char* ws = p.ws;
    float* mod = (float*)(ws + OFF_MOD); float* rinv1 = (float*)(ws + OFF_RINV1); float* ftab = (float*)(ws + OFF_ROPE);
    bf16_t* P = (bf16_t*)(ws + OFF_P); float* kv = (float*)(ws + OFF_KV); bf16_t* stT = (bf16_t*)(ws + OFF_ST); bf16_t* ycat = (bf16_t*)(ws + OFF_YCAT);
    bf16_t* xb = (bf16_t*)(ws + OFF_XB); bf16_t* Win_t = (bf16_t*)(ws + OFF_WINT); float* bias_f = (float*)(ws + OFF_BIASF);
    bf16_t* Weff_t = (bf16_t*)(ws + OFF_WEFFT); bf16_t* Wout_t = (bf16_t*)(ws + OFF_WOUTT); float* bias_q = (float*)(ws + OFF_BIASQ); float* bq_part = (float*)(ws + OFF_BQPART);
    float* part2 = (float*)(ws + OFF_PART2); bf16_t* x1b = (bf16_t*)(ws + OFF_X1B); unsigned short* ids = (unsigned short*)(ws + OFF_IDS); unsigned char* q8 = ws + OFF_Q8; bf16_t* dsc = (bf16_t*)(ws + OFF_DSC); float* gates = (float*)(ws + OFF_GATES);
    const size_t PS = (size_t)T * 512;
    const bf16_t *Qr = P, *Kr = P + PS, *Gr = P + 2 * PS, *Qs = P + 3 * PS, *Ks = P + 4 * PS, *Vr = P + 6 * PS, *Vs = P + 7 * PS;
    float* out = p.out; float* x1 = (float*)(ws + OFF_X1);

    if (tid < 4) ((LAS unsigned*)((LAS unsigned char*)lds + LDS_ST_OFF))[tid] = 0u;
    __syncthreads();
    XcdBarrier bar = xcd_barrier_post((unsigned*)(ws + OFF_CTL), (volatile LAS unsigned*)((LAS unsigned char*)lds + LDS_ST_OFF));

    for (int u = bid; u < 256; u += G) gemv_cols<6>(lds, VfSilu{p.c}, p.ada_w, 6144, u, mod, p.ada_b);
    for (int row0 = (bid * 8 + wave) * 2; row0 < T; row0 += G * 16) {
        float4 v[2][4];
#pragma unroll
        for (int rr = 0; rr < 2; ++rr)
#pragma unroll
            for (int j = 0; j < 4; ++j) v[rr][j] = ld_nt4(p.x + (size_t)(row0 + rr) * D + (lane + 64 * j) * 4);
#pragma unroll
        for (int rr = 0; rr < 2; ++rr) {
            uint2* xo = (uint2*)(xb + (size_t)(row0 + rr) * D);
            float s = 0.f;
#pragma unroll
            for (int j = 0; j < 4; ++j) { const float4 q = v[rr][j]; s += q.x * q.x + q.y * q.y + q.z * q.z + q.w * q.w; xo[lane + 64 * j] = make_uint2(pk2(q.x, q.y), pk2(q.z, q.w)); }
#pragma unroll
            for (int o = 32; o > 0; o >>= 1) s += __shfl_xor(s, o);
            if (lane == 0) rinv1[row0 + rr] = 1.0f / sqrtf(s * (1.0f / D) + EPS);
        }
    }
    if (bid == 0 && tid == 0) {
#pragma unroll
        for (int i = 0; i < 32; ++i) { ftab[i] = p.rc.fh[i]; ftab[32 + i] = p.rc.fl[i]; }
    }
    xcd_barrier(bar);

    {
        float* scr = (float*)(lds + wave * 16384);
        for (int it = bid * 8 + wave; it < 16 * 112; it += G * 8) transpose_item<true, true>(p.w_in, 1024, 3584, Win_t, scr, it, lane, p.g1, mod + 1024);
        __syncthreads();
        for (int u = bid; u < 128; u += G) gemv_cols<7>(lds, VfVec{mod}, p.w_in, 3584, u, bias_f, nullptr);
    }
    xcd_barrier(bar);

    {
        pg8::Gemm g{xb, Win_t, T, 3584, 1024}; pg8::StaticOrder S; S.init(T, 3584, G, bid);
        EpiInprojMF E{P, rinv1, bias_f, p.pos, ftab, p.qg, p.kg};
        pg8::gemm_phase<EpiInprojMF, pg8::StaticOrder>((PG8_LAS unsigned char*)lds, g, S, E);
        const int nidle = (G > 128) ? G - 128 : G, ib = (G > 128) ? bid - 128 : bid;
        {
            float* scr = (float*)(lds + wave * 16384);
            if (ib >= 0) for (int it = ib * 8 + wave; it < 16 * 32; it += nidle * 8) transpose_item<false, false>(p.w_out, 1024, 1024, Wout_t, scr, it, lane, nullptr, nullptr);
            __syncthreads();
        }
        if (ib >= 0 && ib < 128) {
            const int hp = ib >> 3, blk = ib & 7;
            float* skT = (float*)lds; float* wqs = (float*)(lds + 69632);
            for (int e = tid; e < 16384; e += 512) { const int k = e >> 7, c = e & 127; skT[c * 132 + k] = p.sk[((size_t)hp * 128 + k) * 128 + c]; }
            float bacc[16];
#pragma unroll
            for (int j = 0; j < 16; ++j) bacc[j] = 0.f;
            for (int rbk = 0; rbk < 2; ++rbk) {
                const int i0 = (blk * 2 + rbk) * 64;
                __syncthreads();
                for (int e = tid; e < 8192; e += 512) { const int r = e >> 7, c = e & 127; wqs[r * 129 + c] = p.wq[(size_t)(i0 + r) * 2048 + hp * 128 + c]; }
                __syncthreads();
                float acc[16];
#pragma unroll
                for (int j = 0; j < 16; ++j) acc[j] = 0.f;
                const float* wrow = wqs + lane * 129; const float* skc = skT + 16 * wave;
#pragma unroll 4
                for (int c = 0; c < 128; ++c) {
                    const float av = wrow[c];
                    const float4 b0 = *(const float4*)(skc + c * 132), b1 = *(const float4*)(skc + c * 132 + 4), b2 = *(const float4*)(skc + c * 132 + 8), b3 = *(const float4*)(skc + c * 132 + 12);
                    acc[0] += av * b0.x; acc[1] += av * b0.y; acc[2] += av * b0.z; acc[3] += av * b0.w; acc[4] += av * b1.x; acc[5] += av * b1.y; acc[6] += av * b1.z; acc[7] += av * b1.w;
                    acc[8] += av * b2.x; acc[9] += av * b2.y; acc[10] += av * b2.z; acc[11] += av * b2.w; acc[12] += av * b3.x; acc[13] += av * b3.y; acc[14] += av * b3.z; acc[15] += av * b3.w;
                }
                const int i = i0 + lane;
                const float s2v = p.g2[i] * (1.f + mod[4096 + i]), sh = mod[3072 + i];
#pragma unroll
                for (int j = 0; j < 16; ++j) { Weff_t[(size_t)(hp * 128 + 16 * wave + j) * 1024 + i] = f2bf(acc[j] * s2v); bacc[j] += sh * acc[j]; }
            }
#pragma unroll
            for (int j = 0; j < 16; ++j) { float v = bacc[j];
#pragma unroll
                for (int o = 32; o > 0; o >>= 1) v += __shfl_xor(v, o);
                if (lane == 0) bq_part[(size_t)blk * 2048 + hp * 128 + 16 * wave + j] = v; }
            __syncthreads();
        }
        if (ib >= 0) convert_tables(p.down, p.up, q8, dsc, lane, ib * 8 + wave, nidle * 8, 0, CONV_SPLIT);
    }
    xcd_barrier(bar);

    {
        const int gw = __builtin_amdgcn_readfirstlane(bid * 8 + wave), NGW = G * 8, l31 = lane & 31, hf = lane >> 5;
        const int wv0 = __builtin_amdgcn_readfirstlane(wave);
        for (int U = gw; U < 1024; U += NGW) {
            const int n = U >> 3, h = U & 7;
            f32x16 C[2][2];
#pragma unroll
            for (int a = 0; a < 2; ++a)
#pragma unroll
                for (int b = 0; b < 2; ++b)
#pragma unroll
                    for (int r = 0; r < 16; ++r) C[a][b][r] = 0.f;
            unsigned char* Kt = lds + wv0 * 9216; unsigned char* Vt = Kt + 4608;
            const int r8 = lane >> 3, pc = lane & 7, trq = (lane & 15) >> 2, trp = lane & 3, trd = (lane >> 4) & 1;
            const char* kbase = (const char*)(Kr + (size_t)n * 128 * 512 + h * 64); const char* vbase = (const char*)(Vr + (size_t)n * 128 * 512 + h * 64);
            const unsigned loff = (unsigned)(r8 * 512 + pc * 8) * 2u;
            const float lg = lg2_head(h);
            pg8::u32x4 gK[4], gV[4];
#pragma unroll
            for (int i = 0; i < 4; ++i) { gK[i] = *(const pg8::u32x4*)(kbase + (loff + i * 8192u)); gV[i] = *(const pg8::u32x4*)(vbase + (loff + i * 8192u)); }
            for (int sb4 = 0; sb4 < 4; ++sb4) {
#pragma unroll
                for (int i = 0; i < 4; ++i) { *(pg8::u32x4*)(Kt + (8 * i + r8) * 144 + pc * 16) = gK[i]; *(pg8::u32x4*)(Vt + (8 * i + r8) * 144 + pc * 16) = gV[i]; }
                { const int sn = (sb4 < 3) ? sb4 + 1 : sb4;
#pragma unroll
                  for (int i = 0; i < 4; ++i) { gK[i] = *(const pg8::u32x4*)(kbase + (size_t)sn * 32768 + (loff + i * 8192u)); gV[i] = *(const pg8::u32x4*)(vbase + (size_t)sn * 32768 + (loff + i * 8192u)); } }
#pragma unroll
                for (int s = 0; s < 2; ++s) {
                    bf16x8 Af[2], Bf[2];
#pragma unroll
                    for (int a = 0; a < 2; ++a) {
                        Af[a] = tr_frag(Vt + (16 * s + 8 * hf + trq) * 144 + (32 * a + 16 * trd + 4 * trp) * 2, 4);
                        const bf16x8 kraw = tr_frag(Kt + (16 * s + 8 * hf + trq) * 144 + (32 * a + 16 * trd + 4 * trp) * 2, 4);
                        const pg8::u32x4 kw = __builtin_bit_cast(pg8::u32x4, kraw); const unsigned kk[4] = {kw.x, kw.y, kw.z, kw.w};
                        pg8::u32x4 o; unsigned* op = (unsigned*)&o;
#pragma unroll
                        for (int e2 = 0; e2 < 4; ++e2) {
                            const int j0 = 32 * sb4 + 16 * s + 8 * hf + 2 * e2;
                            const float z0 = __builtin_amdgcn_exp2f((float)(127 - j0) * lg), z1 = __builtin_amdgcn_exp2f((float)(126 - j0) * lg);
                            op[e2] = pg8::cvt_pk_bf16(__uint_as_float(kk[e2] << 16) * z0, __uint_as_float(kk[e2] & 0xffff0000u) * z1);
                        }
                        Bf[a] = __builtin_bit_cast(bf16x8, o);
                    }
#pragma unroll
                    for (int a = 0; a < 2; ++a)
#pragma unroll
                        for (int b = 0; b < 2; ++b) C[a][b] = MFMA32(Af[a], Bf[b], C[a][b]);
                }
            }
            float* dst = kv + (size_t)(n * 8 + h) * 4096;
#pragma unroll
            for (int a = 0; a < 2; ++a)
#pragma unroll
                for (int b = 0; b < 2; ++b)
#pragma unroll
                    for (int r = 0; r < 16; ++r) dst[(32 * a + (r & 3) + 8 * (r >> 2) + 4 * hf) * 64 + 32 * b + l31] = C[a][b][r];
        }
        bf16x8 Tri[2];
        {
            pg8::u32x4 w0, w1; unsigned* p0 = (unsigned*)&w0; unsigned* p1 = (unsigned*)&w1;
#pragma unroll
            for (int e2 = 0; e2 < 4; ++e2) {
                unsigned a0 = 0, a1 = 0;
#pragma unroll
                for (int q = 0; q < 2; ++q) { const int e = 2 * e2 + q, ip = 8 * (e >> 2) + 4 * hf + (e & 3);
                    a0 |= ((ip > l31) ? 0x3F80u : 0u) << (16 * q); a1 |= ((16 + ip > l31) ? 0x3F80u : 0u) << (16 * q); }
                p0[e2] = a0; p1[e2] = a1;
            }
            Tri[0] = __builtin_bit_cast(bf16x8, w0); Tri[1] = __builtin_bit_cast(bf16x8, w1);
        }
        const bool sb_local = (G % 8 == 0) && (4096 % G == 0) && ((4096 / G) % 8 == 0);
        const int sb_per_wave = sb_local ? 4096 / G / 8 : (4096 + NGW - 1 - gw) / NGW;
        const int wv = __builtin_amdgcn_readfirstlane(wave);
        for (int ps = 0; ps < sb_per_wave; ++ps) {
            const int U = sb_local ? 0 : gw + ps * NGW;
            const int h = sb_local ? (bid & 7) : (U & 7), qt = sb_local ? (bid >> 3) * (4096 / G) + ps * 8 + wv : (U >> 3), q0 = qt * 32;
            f32x16 O[2];
#pragma unroll
            for (int r = 0; r < 16; ++r) { O[0][r] = 0.f; O[1][r] = 0.f; }
            float carry = 0.f;
            unsigned char* Kt = lds + wv * 9216; unsigned char* Vt = Kt + 4608;
            const int r8 = lane >> 3, pc = lane & 7;
            const char* kbase = (const char*)(Ks + h * 64); const char* vbase = (const char*)(Vs + h * 64);
            const unsigned loff = (unsigned)(r8 * 512 + pc * 8) * 2u;
            pg8::u32x4 gK[4], gV[4];
            bf16x8 Qf[4];
            {
                const char* qbase = (const char*)(Qs + h * 64);
#pragma unroll
                for (int i = 0; i < 4; ++i) gK[i] = *(const pg8::u32x4*)(qbase + (size_t)qt * 32768 + (loff + i * 8192u));
#pragma unroll
                for (int i = 0; i < 4; ++i) *(pg8::u32x4*)(Kt + (8 * i + r8) * 144 + pc * 16) = gK[i];
#pragma unroll
                for (int s = 0; s < 4; ++s) Qf[s] = *(const bf16x8*)(Kt + l31 * 144 + 32 * s + 16 * hf);
            }
#pragma unroll
            for (int i = 0; i < 4; ++i) { gK[i] = *(const pg8::u32x4*)(kbase + (size_t)qt * 32768 + (loff + i * 8192u)); gV[i] = *(const pg8::u32x4*)(vbase + (size_t)qt * 32768 + (loff + i * 8192u)); }
            const int trq = (lane & 15) >> 2, trp = lane & 3, trd = (lane >> 4) & 1;
            for (int kb = qt; kb >= 0; --kb) {
#pragma unroll
                for (int i = 0; i < 4; ++i) { *(pg8::u32x4*)(Kt + (8 * i + r8) * 144 + pc * 16) = gK[i]; *(pg8::u32x4*)(Vt + (8 * i + r8) * 144 + pc * 16) = gV[i]; }
                {
                    const int kbn = (kb > 0) ? kb - 1 : 0;
#pragma unroll
                    for (int i = 0; i < 4; ++i) { gK[i] = *(const pg8::u32x4*)(kbase + (size_t)kbn * 32768 + (loff + i * 8192u)); gV[i] = *(const pg8::u32x4*)(vbase + (size_t)kbn * 32768 + (loff + i * 8192u)); }
                }
                bf16x8 Kf[4], Vf[2][2];
#pragma unroll
                for (int s = 0; s < 4; ++s) Kf[s] = *(const bf16x8*)(Kt + l31 * 144 + 32 * s + 16 * hf);
#pragma unroll
                for (int s = 0; s < 2; ++s)
#pragma unroll
                    for (int dt = 0; dt < 2; ++dt) {
                        Vf[s][dt] = tr_frag(Vt + (16 * s + 4 * hf + trq) * 144 + (32 * dt + 16 * trd + 4 * trp) * 2, 8);
                    }
                f32x16 S;
#pragma unroll
                for (int r = 0; r < 16; ++r) S[r] = 0.f;
#pragma unroll
                for (int s = 0; s < 4; ++s) S = MFMA32(Kf[s], Qf[s], S);
                const bool diag = (kb == qt);
                f32x16 sp, lb;
                float csum = 0.f;
                if (diag) {
#pragma unroll
                    for (int r = 0; r < 16; ++r) {
                        const int i = (r & 3) + 8 * (r >> 2) + 4 * hf;
                        const float z = S[r];
                        const float l1p = __builtin_amdgcn_logf(1.0f + __builtin_amdgcn_exp2f(-fabsf(z)));
                        const float spv = (i < l31) ? (fmaxf(z, 0.f) + l1p) : 0.f;
                        sp[r] = spv; lb[r] = (i < l31) ? (fminf(z, 0.f) - l1p) : -INFINITY; csum += spv;
                    }
                } else {
#pragma unroll
                    for (int r = 0; r < 16; ++r) {
                        const float z = S[r];
                        const float l1p = __builtin_amdgcn_logf(1.0f + __builtin_amdgcn_exp2f(-fabsf(z)));
                        const float spv = fmaxf(z, 0.f) + l1p;
                        sp[r] = spv; lb[r] = fminf(z, 0.f) - l1p; csum += spv;
                    }
                }
                f32x16 Rt;
#pragma unroll
                for (int r = 0; r < 16; ++r) Rt[r] = carry;
#pragma unroll
                for (int s = 0; s < 2; ++s) Rt = MFMA32(Tri[s], pack_frag(sp, s), Rt);
                f32x16 wv;
#pragma unroll
                for (int r = 0; r < 16; ++r) wv[r] = __builtin_amdgcn_exp2f(lb[r] - Rt[r]);
#pragma unroll
                for (int s = 0; s < 2; ++s) { const bf16x8 wp = pack_frag(wv, s);
#pragma unroll
                    for (int dt = 0; dt < 2; ++dt) O[dt] = MFMA32(Vf[s][dt], wp, O[dt]); }
                csum += __shfl_xor(csum, 32);
                carry += csum;
                if (__all(carry > 127.f)) break;
            }
            float ss = 0.f;
#pragma unroll
            for (int r = 0; r < 16; ++r) ss += O[0][r] * O[0][r] + O[1][r] * O[1][r];
            ss += __shfl_xor(ss, 32);
            const float rn = 1.0f / sqrtf(ss * (1.f / 64.f) + EPS);
#pragma unroll
            for (int dt = 0; dt < 2; ++dt)
#pragma unroll
                for (int g4 = 0; g4 < 4; ++g4) {
                    const int d = 32 * dt + 8 * g4 + 4 * hf;
                    const float4 gn = *(const float4*)(p.og + d);
                    uint2 w; w.x = pg8::cvt_pk_bf16(O[dt][4 * g4] * rn * gn.x, O[dt][4 * g4 + 1] * rn * gn.y); w.y = pg8::cvt_pk_bf16(O[dt][4 * g4 + 2] * rn * gn.z, O[dt][4 * g4 + 3] * rn * gn.w);
                    *(uint2*)(Kt + l31 * 144 + d * 2) = w;
                }
#pragma unroll
            for (int i = 0; i < 4; ++i) *(pg8::u32x4*)(ycat + (size_t)(q0 + 8 * i + r8) * 1024 + 512 + h * 64 + pc * 8) = *(const pg8::u32x4*)(Kt + (8 * i + r8) * 144 + pc * 16);
        }
    }
    xcd_barrier(bar);

    if (bid == 255 % G) for (int n = tid; n < 2048; n += 512) { float s = 0.f;
#pragma unroll
        for (int b8 = 0; b8 < 8; ++b8) s += bq_part[(size_t)b8 * 2048 + n];
        bias_q[n] = s; }
    if (G > 64 && bid >= 64) convert_tables(p.down, p.up, q8, dsc, lane, (bid - 64) * 8 + wave, (G - 64) * 8, CONV_SPLIT, 32768);
    else if (G <= 64) convert_tables(p.down, p.up, q8, dsc, lane, bid * 8 + wave, G * 8, CONV_SPLIT, 32768);
    for (int idx = bid * 512 + tid; idx < 32768; idx += G * 512) {
        const int h = idx >> 12;
        const float cd = exp2f(128.f * lg2_head(h));
        float s = 0.f;
        for (int n0 = 0; n0 < 128; n0 += 32) {
            float kvv[32];
#pragma unroll
            for (int q = 0; q < 32; ++q) kvv[q] = kv[(size_t)(n0 + q) * 32768 + idx];
#pragma unroll
            for (int q = 0; q < 32; ++q) { stT[(size_t)(n0 + q) * 32768 + idx] = f2bf(s); s = cd * s + kvv[q]; }
        }
    }
    xcd_barrier(bar);

    {
        const int gw = __builtin_amdgcn_readfirstlane(bid * 8 + wave), NGW = G * 8, l31 = lane & 31, hf = lane >> 5;
        const int wv4 = __builtin_amdgcn_readfirstlane(wave);
        for (int W2 = gw; W2 < 2048; W2 += NGW) {
            const int nh = W2 >> 1, n = nh >> 3, h = nh & 7;
            const float lg = lg2_head(h);
#pragma unroll 1
            for (int pass = 0; pass < 2; ++pass) {
                const int qt = (W2 & 1) ? (pass ? 2 : 1) : (pass ? 3 : 0);
                const int il = qt * 32 + l31, tq = n * 128 + il;
                unsigned char* Kt = lds + wv4 * 9216; unsigned char* Vt = Kt + 4608;
                const int r8 = lane >> 3, pc = lane & 7, trq = (lane & 15) >> 2, trp = lane & 3, trd = (lane >> 4) & 1;
                const unsigned loff = (unsigned)(r8 * 512 + pc * 8) * 2u;
                pg8::u32x4 gK[4], gV[4];
                bf16x8 Qf[4];
                {
                    const char* qbase = (const char*)(Qr + (size_t)(n * 128 + qt * 32) * 512 + h * 64);
                    const char* sbase = (const char*)(stT + (size_t)nh * 4096) + (unsigned)(r8 * 64 + pc * 8) * 2u;
#pragma unroll
                    for (int i = 0; i < 4; ++i) gK[i] = *(const pg8::u32x4*)(qbase + (loff + i * 8192u));
#pragma unroll
                    for (int i = 0; i < 4; ++i) *(pg8::u32x4*)(Kt + (8 * i + r8) * 144 + pc * 16) = gK[i];
#pragma unroll
                    for (int s = 0; s < 4; ++s) Qf[s] = *(const bf16x8*)(Kt + l31 * 144 + 32 * s + 16 * hf);
#pragma unroll
                    for (int i = 0; i < 4; ++i) { gK[i] = *(const pg8::u32x4*)(sbase + i * 1024u); gV[i] = *(const pg8::u32x4*)(sbase + 4096u + i * 1024u); }
#pragma unroll
                    for (int i = 0; i < 4; ++i) { *(pg8::u32x4*)(Kt + (8 * i + r8) * 144 + pc * 16) = gK[i]; *(pg8::u32x4*)(Kt + (32 + 8 * i + r8) * 144 + pc * 16) = gV[i]; }
                }
                f32x16 O[2];
#pragma unroll
                for (int r = 0; r < 16; ++r) { O[0][r] = 0.f; O[1][r] = 0.f; }
#pragma unroll
                for (int s = 0; s < 4; ++s)
#pragma unroll
                    for (int dt = 0; dt < 2; ++dt) O[dt] = MFMA32(*(const bf16x8*)(Kt + (32 * dt + l31) * 144 + 32 * s + 16 * hf), Qf[s], O[dt]);
                const float xi = exp2f((float)(il + 1) * lg);
#pragma unroll
                for (int r = 0; r < 16; ++r) { O[0][r] *= xi; O[1][r] *= xi; }
                const char* kbase = (const char*)(Kr + (size_t)n * 128 * 512 + h * 64); const char* vbase = (const char*)(Vr + (size_t)n * 128 * 512 + h * 64);
#pragma unroll
                for (int i = 0; i < 4; ++i) { gK[i] = *(const pg8::u32x4*)(kbase + (loff + i * 8192u)); gV[i] = *(const pg8::u32x4*)(vbase + (loff + i * 8192u)); }
                for (int jb = 0; jb <= qt; ++jb) {
#pragma unroll
                    for (int i = 0; i < 4; ++i) { *(pg8::u32x4*)(Kt + (8 * i + r8) * 144 + pc * 16) = gK[i]; *(pg8::u32x4*)(Vt + (8 * i + r8) * 144 + pc * 16) = gV[i]; }
                    { const int jn = (jb < qt) ? jb + 1 : jb;
#pragma unroll
                      for (int i = 0; i < 4; ++i) { gK[i] = *(const pg8::u32x4*)(kbase + (size_t)jn * 32768 + (loff + i * 8192u)); gV[i] = *(const pg8::u32x4*)(vbase + (size_t)jn * 32768 + (loff + i * 8192u)); } }
                    bf16x8 Kf[4], Vf[2][2];
#pragma unroll
                    for (int s = 0; s < 4; ++s) Kf[s] = *(const bf16x8*)(Kt + l31 * 144 + 32 * s + 16 * hf);
#pragma unroll
                    for (int s = 0; s < 2; ++s)
#pragma unroll
                        for (int dt = 0; dt < 2; ++dt) Vf[s][dt] = tr_frag(Vt + (16 * s + 4 * hf + trq) * 144 + (32 * dt + 16 * trd + 4 * trp) * 2, 8);
                    f32x16 S;
#pragma unroll
                    for (int r = 0; r < 16; ++r) S[r] = 0.f;
#pragma unroll
                    for (int s = 0; s < 4; ++s) S = MFMA32(Kf[s], Qf[s], S);
#pragma unroll
                    for (int r = 0; r < 16; ++r) {
                        const int jl = jb * 32 + (r & 3) + 8 * (r >> 2) + 4 * hf, dl = il - jl;
                        S[r] = (dl >= 0) ? S[r] * __builtin_amdgcn_exp2f((float)dl * lg) : 0.f;
                    }
#pragma unroll
                    for (int s = 0; s < 2; ++s) { const bf16x8 wp = pack_frag(S, s);
#pragma unroll
                        for (int dt = 0; dt < 2; ++dt) O[dt] = MFMA32(Vf[s][dt], wp, O[dt]); }
                }
                float sm = 0.f;
#pragma unroll
                for (int r = 0; r < 16; ++r) sm += O[0][r] + O[1][r];
                sm += __shfl_xor(sm, 32);
                const float mean = sm * (1.f / 64.f);
                float vs = 0.f;
#pragma unroll
                for (int r = 0; r < 16; ++r) { const float d0 = O[0][r] - mean, d1 = O[1][r] - mean; vs += d0 * d0 + d1 * d1; }
                vs += __shfl_xor(vs, 32);
                const float rstd = 1.0f / sqrtf(vs * (1.f / 64.f) + EPS);
                {
                    const char* gbase = (const char*)(Gr + (size_t)(n * 128 + qt * 32) * 512 + h * 64);
#pragma unroll
                    for (int i = 0; i < 4; ++i) gV[i] = *(const pg8::u32x4*)(gbase + (loff + i * 8192u));
#pragma unroll
                    for (int i = 0; i < 4; ++i) *(pg8::u32x4*)(Vt + (8 * i + r8) * 144 + pc * 16) = gV[i];
                }
#pragma unroll
                for (int dt = 0; dt < 2; ++dt)
#pragma unroll
                    for (int g4 = 0; g4 < 4; ++g4) {
                        const int e = 32 * dt + 8 * g4 + 4 * hf;
                        const float4 gn = *(const float4*)(p.rgain + h * 64 + e);
                        const uint2 gg = *(const uint2*)(Vt + l31 * 144 + e * 2);
                        const float g0 = __uint_as_float(gg.x << 16), g1 = __uint_as_float(gg.x & 0xffff0000u), g2v = __uint_as_float(gg.y << 16), g3 = __uint_as_float(gg.y & 0xffff0000u);
                        uint2 w;
                        w.x = pg8::cvt_pk_bf16((O[dt][4 * g4] - mean) * rstd * gn.x * g0, (O[dt][4 * g4 + 1] - mean) * rstd * gn.y * g1);
                        w.y = pg8::cvt_pk_bf16((O[dt][4 * g4 + 2] - mean) * rstd * gn.z * g2v, (O[dt][4 * g4 + 3] - mean) * rstd * gn.w * g3);
                        *(uint2*)(Kt + l31 * 144 + e * 2) = w;
                    }
#pragma unroll
                for (int i = 0; i < 4; ++i) *(pg8::u32x4*)(ycat + (size_t)(n * 128 + qt * 32 + 8 * i + r8) * 1024 + h * 64 + pc * 8) = *(const pg8::u32x4*)(Kt + (8 * i + r8) * 144 + pc * 16);
            }
        }
    }
    xcd_barrier(bar);

    {
        pg8::Gemm g{ycat, Wout_t, T, 1024, 1024}; pg8::StaticOrder S; S.init(T, 1024, G, bid);
        EpiOutprojMF E{p.x, mod + 2048, x1, x1b, part2};
        pg8::gemm_phase<EpiOutprojMF, pg8::StaticOrder>((PG8_LAS unsigned char*)lds, g, S, E);
    }
    xcd_barrier(bar);

    for (int round = 0; round < 2; ++round) {
        pg8::Gemm g{x1b, Weff_t, T, 2048, 1024}; OneUnitOrder S; S.base.init(T, 2048, G, bid); S.round = round;
        EpiTopkMF E{part2, bias_q, ids, gates};
        pg8::gemm_phase<EpiTopkMF, OneUnitOrder>((PG8_LAS unsigned char*)lds, g, S, E);
    }
    xcd_barrier(bar);

    {
        constexpr int IDS_LD = 136, ACT_LD = 136;
        const float* scale2 = mod + 4096; const float* shift2 = mod + 3072; const float* gate2 = mod + 5120;
        unsigned short* ids_l = (unsigned short*)lds; float* act_l = (float*)(lds + 32768);
        bf16_t* ds_l = (bf16_t*)(lds + 69632);
        const int t0 = bid * 64, tt = lane >> 3, sub = lane & 7, tl = wave * 8 + tt, t = t0 + tl;
        for (int e = tid; e < 1024; e += 512) { const int r = e >> 4, c8 = e & 15; *(uint4*)(ids_l + r * IDS_LD + c8 * 8) = *(const uint4*)(ids + (size_t)(t0 + r) * 128 + c8 * 8); }
        for (int e = tid; e < 64 * ACT_LD; e += 512) act_l[e] = 0.f;
        for (int e = tid; e < 4096; e += 512) ((uint4*)ds_l)[e] = ((const uint4*)dsc)[e];
        __syncthreads();
        float ri;
        { const float4* pp = (const float4*)(part2 + (size_t)t * 16); const float4 p0 = pp[0], p1 = pp[1], p2 = pp[2], p3 = pp[3];
          const float ssum = ((p0.x + p0.y) + (p0.z + p0.w)) + ((p1.x + p1.y) + (p1.z + p1.w)) + ((p2.x + p2.y) + (p2.z + p2.w)) + ((p3.x + p3.y) + (p3.z + p3.w));
          ri = 1.0f / sqrtf(ssum * (1.0f / D) + EPS); }
        const unsigned short* myids = ids_l + tl * IDS_LD;
        float* myact = act_l + tl * ACT_LD; int* myacc = (int*)myact;
        const bool s4 = (sub & 4) != 0, s2 = (sub & 2) != 0, s1 = (sub & 1) != 0;
        const unsigned suboff = (unsigned)sub * 16u;
        typedef float f32x2 __attribute__((ext_vector_type(2)));
        float hmax = 0.f;
        for (int c = 0; c < 4; ++c)
#pragma unroll
            for (int q = 0; q < 8; ++q) {
                const int col = 256 * c + 4 * sub + 32 * q;
                const float4 xv = *(const float4*)(x1 + (size_t)t * D + col);
                const float4 g = *(const float4*)(p.g2 + col), sc = *(const float4*)(scale2 + col), sh = *(const float4*)(shift2 + col);
                hmax = fmaxf(hmax, fmaxf(fmaxf(fabsf(xv.x * ri * g.x * (1.f + sc.x) + sh.x), fabsf(xv.y * ri * g.y * (1.f + sc.y) + sh.y)),
                                         fmaxf(fabsf(xv.z * ri * g.z * (1.f + sc.z) + sh.z), fabsf(xv.w * ri * g.w * (1.f + sc.w) + sh.w))));
            }
        hmax = fmaxf(hmax, __shfl_xor(hmax, 1)); hmax = fmaxf(hmax, __shfl_xor(hmax, 2)); hmax = fmaxf(hmax, __shfl_xor(hmax, 4));
        const float hinv = (hmax > 0.f) ? 127.0f / hmax : 0.f, hscale = hmax * (1.0f / 127.0f);
#define P9_LOAD(W, JB) do { const uint4 idv_ = *(const uint4*)(myids + 8 * (JB)); const unsigned idw_[4] = {idv_.x, idv_.y, idv_.z, idv_.w}; \
        _Pragma("unroll") for (int k_ = 0; k_ < 8; ++k_) { const unsigned id_ = (idw_[k_ >> 1] >> (16 * (k_ & 1))) & 0xffffu; W[k_] = *(const uint4*)(sbase + (id_ * 128u + suboff)); } } while (0)
#define P9_DOWN4(W, JB) do { int pd_[8]; \
        _Pragma("unroll") for (int k_ = 0; k_ < 8; ++k_) { const unsigned ww_[4] = {W[k_].x, W[k_].y, W[k_].z, W[k_].w}; int a0_ = 0, a1_ = 0; \
            _Pragma("unroll") for (int m_ = 0; m_ < 4; ++m_) { a0_ = __builtin_amdgcn_sdot4(hpe[m_], (int)(ww_[m_] & 0x0F0F0F0Fu), a0_, false); a1_ = __builtin_amdgcn_sdot4(hpo[m_], (int)((ww_[m_] >> 4) & 0x0F0F0F0Fu), a1_, false); } \
            pd_[k_] = a0_ + a1_ - hoff; } \
        int r4_[4], r2_[2]; \
        _Pragma("unroll") for (int k_ = 0; k_ < 4; ++k_) { const int snd_ = s4 ? pd_[k_] : pd_[k_ + 4], kp_ = s4 ? pd_[k_ + 4] : pd_[k_]; r4_[k_] = kp_ + __shfl_xor(snd_, 4); } \
        _Pragma("unroll") for (int k_ = 0; k_ < 2; ++k_) { const int snd_ = s2 ? r4_[k_] : r4_[k_ + 2], kp_ = s2 ? r4_[k_ + 2] : r4_[k_]; r2_[k_] = kp_ + __shfl_xor(snd_, 2); } \
        { const int snd_ = s1 ? r2_[0] : r2_[1], kp_ = s1 ? r2_[1] : r2_[0]; myacc[8 * (JB) + sub] += kp_ + __shfl_xor(snd_, 1); } } while (0)
        for (int c = 0; c < 4; ++c) {
            int hq[8][4];
#pragma unroll
            for (int q = 0; q < 8; ++q) {
                const int col = 256 * c + 4 * sub + 32 * q;
                const float4 xv = *(const float4*)(x1 + (size_t)t * D + col);
                const float4 g = *(const float4*)(p.g2 + col), sc = *(const float4*)(scale2 + col), sh = *(const float4*)(shift2 + col);
                hq[q][0] = (int)__builtin_rintf((xv.x * ri * g.x * (1.f + sc.x) + sh.x) * hinv); hq[q][1] = (int)__builtin_rintf((xv.y * ri * g.y * (1.f + sc.y) + sh.y) * hinv);
                hq[q][2] = (int)__builtin_rintf((xv.z * ri * g.z * (1.f + sc.z) + sh.z) * hinv); hq[q][3] = (int)__builtin_rintf((xv.w * ri * g.w * (1.f + sc.w) + sh.w) * hinv);
            }
            int hpe[4], hpo[4], hoff = 0;
#pragma unroll
            for (int m = 0; m < 4; ++m) {
                hpe[m] = (hq[2 * m][0] & 255) | ((hq[2 * m][2] & 255) << 8) | ((hq[2 * m + 1][0] & 255) << 16) | ((hq[2 * m + 1][2] & 255) << 24);
                hpo[m] = (hq[2 * m][1] & 255) | ((hq[2 * m][3] & 255) << 8) | ((hq[2 * m + 1][1] & 255) << 16) | ((hq[2 * m + 1][3] & 255) << 24);
            }
#pragma unroll
            for (int q = 0; q < 8; ++q) hoff += (hq[q][0] + hq[q][1]) + (hq[q][2] + hq[q][3]);
            hoff *= 8;
            const unsigned char* sbase = q8 + (size_t)c * (16384 * 128);
            uint4 wA[8], wB[8];
            P9_LOAD(wA, 0);
#pragma unroll 1
            for (int jb = 0; jb < 16; jb += 2) {
                P9_LOAD(wB, jb + 1);
                P9_DOWN4(wA, jb);
                if (jb + 2 < 16) P9_LOAD(wA, jb + 2);
                P9_DOWN4(wB, jb + 1);
            }
        }
#undef P9_DOWN4
        signed char* aq_l = (signed char*)(lds + 135168);
        float avv[16]; float amax = 0.f;
#pragma unroll
        for (int jb = 0; jb < 16; ++jb) {
            const int j = 8 * jb + sub; const unsigned id = myids[j];
            const float a = (float)myacc[j] * bf2f(ds_l[id]) * hscale;
            const float av = fabsf(a), tq = 1.0f / (av * 0.2316418882f + 1.0f);
            float ql = tq * 0.5307027145f + (-0.7265760135f); ql = ql * tq + 0.7107068705f; ql = ql * tq + (-0.142248368f); ql = ql * tq + 0.127414796f; ql = ql * tq;
            const float mm = a * (ql * exp2f(a * a * (-0.72134752044f)));
            const float ge = (a < 0.f) ? mm : (a - mm);
            avv[jb] = ge * gates[(size_t)t * 128 + j] * bf2f(ds_l[16384 + id]);
            amax = fmaxf(amax, fabsf(avv[jb]));
        }
        amax = fmaxf(amax, __shfl_xor(amax, 1)); amax = fmaxf(amax, __shfl_xor(amax, 2)); amax = fmaxf(amax, __shfl_xor(amax, 4));
        const float ainv = (amax > 0.f) ? 127.0f / amax : 0.f, ascale = amax * (1.0f / 127.0f);
        int aqsum = 0;
#pragma unroll
        for (int jb = 0; jb < 16; ++jb) { const int aqv = (int)__builtin_rintf(avv[jb] * ainv); aq_l[tl * 128 + 8 * jb + sub] = (signed char)aqv; aqsum += aqv; }
        aqsum += __shfl_xor(aqsum, 1); aqsum += __shfl_xor(aqsum, 2); aqsum += __shfl_xor(aqsum, 4);
        __syncthreads();
#define P9_PERM(HI, LO, SEL) __builtin_amdgcn_perm((HI), (LO), (SEL))
#define P9_T4(E0, E1, E2, E3, T0, T1, T2, T3) do { const unsigned p0_ = P9_PERM(E1, E0, 0x05010400u), p1_ = P9_PERM(E1, E0, 0x07030602u), p2_ = P9_PERM(E3, E2, 0x05010400u), p3_ = P9_PERM(E3, E2, 0x07030602u); \
        T0 = P9_PERM(p2_, p0_, 0x05040100u); T1 = P9_PERM(p2_, p0_, 0x07060302u); T2 = P9_PERM(p3_, p1_, 0x05040100u); T3 = P9_PERM(p3_, p1_, 0x07060302u); } while (0)
#define P9_UP4(W, JB) do { const uint2 aq8_ = *(const uint2*)(aq_l + tl * 128 + 8 * (JB)); const int aq4_[2] = {(int)aq8_.x, (int)aq8_.y}; \
        _Pragma("unroll") for (int g_ = 0; g_ < 2; ++g_) { \
            _Pragma("unroll") for (int m_ = 0; m_ < 4; ++m_) { \
                const unsigned w0_ = ((const unsigned*)&W[4 * g_ + 0])[m_], w1_ = ((const unsigned*)&W[4 * g_ + 1])[m_], w2_ = ((const unsigned*)&W[4 * g_ + 2])[m_], w3_ = ((const unsigned*)&W[4 * g_ + 3])[m_]; \
                unsigned t_[4]; \
                P9_T4(w0_, w1_, w2_, w3_, t_[0], t_[1], t_[2], t_[3]); \
                _Pragma("unroll") for (int k_ = 0; k_ < 4; ++k_) { \
                    oraw[4 * m_ + k_] = __builtin_amdgcn_sdot4(aq4_[g_], (int)t_[k_], oraw[4 * m_ + k_], false); \
                    olo[4 * m_ + k_] = __builtin_amdgcn_sdot4(aq4_[g_], (int)(t_[k_] & 0x0F0F0F0Fu), olo[4 * m_ + k_], false); } } } } while (0)
        for (int c = 0; c < 4; ++c) {
            int oraw[16], olo[16];
#pragma unroll
            for (int q = 0; q < 16; ++q) { oraw[q] = 0; olo[q] = 0; }
            const unsigned char* sbase = q8 + (8u << 20) + (size_t)c * (16384 * 128);
            uint4 wA[8], wB[8];
            P9_LOAD(wA, 0);
#pragma unroll 1
            for (int jb = 0; jb < 16; jb += 2) {
                P9_LOAD(wB, jb + 1);
                P9_UP4(wA, jb);
                if (jb + 2 < 16) P9_LOAD(wA, jb + 2);
                P9_UP4(wB, jb + 1);
            }
#pragma unroll
            for (int q = 0; q < 8; ++q) {
                const int col = 256 * c + 4 * sub + 32 * q;
                float* op = out + (size_t)t * D + col;
                const float4 xv = *(const float4*)(x1 + (size_t)t * D + col); const float4 gt = *(const float4*)(gate2 + col);
                const int m = q >> 1, k0 = 2 * (q & 1);
                const int v0 = olo[4 * m + k0] - 8 * aqsum, v1 = (oraw[4 * m + k0] - olo[4 * m + k0]) >> 4, v2 = olo[4 * m + k0 + 1] - 8 * aqsum, v3 = (oraw[4 * m + k0 + 1] - olo[4 * m + k0 + 1]) >> 4;
                float4 r;
                r.x = xv.x + gt.x * ((float)v0 * ascale); r.y = xv.y + gt.y * ((float)v1 * ascale); r.z = xv.z + gt.z * ((float)v2 * ascale); r.w = xv.w + gt.w * ((float)v3 * ascale);
                *(float4*)op = r;
            }
        }
#undef P9_LOAD
#undef P9_UP4
#undef P9_T4
#undef P9_PERM
    }
}
}

extern "C" void kernel_launch(void* const* d_in, const int* in_sizes, int n_in, void* d_out, int out_size, void* d_ws, size_t ws_size, hipStream_t stream) {
    static int grid = 0;
    if (grid == 0) {
        int dev = 0, cus = 0, per_cu = 0;
        (void)hipGetDevice(&dev);
        (void)hipDeviceGetAttribute(&cus, hipDeviceAttributeMultiprocessorCount, dev);
        (void)hipFuncSetAttribute((const void*)mk_fwd, hipFuncAttributeMaxDynamicSharedMemorySize, LDS_BYTES);
        (void)hipOccupancyMaxActiveBlocksPerMultiprocessor(&per_cu, (const void*)mk_fwd, 512, LDS_BYTES);
        if (per_cu < 1 || cus != 256) { fprintf(stderr, "kernel_launch: needs 256 CUs with one resident workgroup each (cus %d, per_cu %d)\n", cus, per_cu); grid = -1; }
        else grid = cus;
    }
    if (grid < 0) return;
    (void)hipMemsetAsync((char*)d_ws + OFF_CTL, 0, CTL_BYTES, stream);
    Params p{};
    p.x = (const float*)d_in[0]; p.c = (const float*)d_in[1]; p.pos = (const int*)d_in[2]; p.ada_w = (const float*)d_in[3]; p.ada_b = (const float*)d_in[4];
    p.g1 = (const float*)d_in[5]; p.g2 = (const float*)d_in[6]; p.w_in = (const float*)d_in[7]; p.rgain = (const float*)d_in[8]; p.qg = (const float*)d_in[9];
    p.kg = (const float*)d_in[10]; p.og = (const float*)d_in[11]; p.w_out = (const float*)d_in[12]; p.wq = (const float*)d_in[13]; p.sk = (const float*)d_in[14];
    p.down = (const float*)d_in[15]; p.up = (const float*)d_in[16]; p.out = (float*)d_out; p.ws = (unsigned char*)d_ws;
    for (int i = 0; i < 32; ++i) {
        const double f = pow(10000.0, -(double)i / 32.0) / 6.283185307179586476925;
        float fh = (float)f; unsigned ub; memcpy(&ub, &fh, 4); ub &= 0xFFFFC000u; memcpy(&fh, &ub, 4);
        p.rc.fh[i] = fh; p.rc.fl[i] = (float)(f - (double)fh);
    }
    void* args[] = {&p};
    hipError_t e = hipLaunchCooperativeKernel((const void*)mk_fwd, dim3(grid), dim3(512), args, LDS_BYTES, stream);
    if (e != hipSuccess) fprintf(stderr, "kernel_launch: cooperative launch failed: %s (grid %d)\n", hipGetErrorString(e), grid);
}
```

```cpp
#include <hip/hip_runtime.h>
#include <stdint.h>
#include <math.h>
#include <cstdio>
#include <cstring>

namespace {
constexpr int T = 16384, D = 1024;
constexpr float EPS = 1e-6f;
typedef unsigned short bf16_t;
#define LAS __attribute__((address_space(3)))

__device__ __forceinline__ float bf2f(bf16_t b) { return __uint_as_float(((unsigned)b) << 16); }
__device__ __forceinline__ bf16_t f2bf(float f) { unsigned u = __float_as_uint(f); u += 0x7fffu + ((u >> 16) & 1u); return (bf16_t)(u >> 16); }
__device__ __forceinline__ float4 ld_nt4(const float* p) { typedef float f4v __attribute__((ext_vector_type(4))); const f4v v = __builtin_nontemporal_load((const f4v*)p); return make_float4(v[0], v[1], v[2], v[3]); }

__device__ __forceinline__ float lg2_head(int h) {
    const float x = __uint_as_float((unsigned)(127 - 5 - h) << 23);
    const float s = x * (1.f + x * (0.5f + x * (0.33333334f + x * (0.25f + x * (0.2f + x * 0.16666667f)))));
    return -s * 1.44269504089f;
}
struct RopeC { float fh[32], fl[32]; };
struct RetC { float lg2[8]; };

constexpr size_t MiB = 1u << 20;
constexpr size_t OFF_CTL = 0;
constexpr size_t CTL_BYTES = 64 * 1024;
constexpr size_t OFF_MOD = 64 * 1024, OFF_RINV1 = 128 * 1024, OFF_BIASF = 256 * 1024, OFF_ROPE = 1 * MiB;
constexpr size_t OFF_WINT = 6 * MiB;
constexpr size_t OFF_XB = 16 * MiB;
constexpr size_t OFF_YCAT = 160 * MiB;
constexpr size_t OFF_P = 48 * MiB;
constexpr size_t OFF_KV = 208 * MiB, OFF_ST = 224 * MiB;
constexpr size_t OFF_WEFFT = 240 * MiB;
constexpr size_t OFF_WOUTT = 13 * MiB;
constexpr size_t OFF_BIASQ = 272 * 1024;
constexpr size_t OFF_DSC = 512 * 1024;
constexpr size_t OFF_BQPART = 448 * 1024;
constexpr size_t OFF_PART2 = 5 * MiB;
constexpr size_t OFF_X1B = 208 * MiB;
constexpr size_t OFF_IDS = 244 * MiB, OFF_GATES = 248 * MiB;
constexpr size_t OFF_Q8 = 192 * MiB;
constexpr int CONV_SPLIT = 0;
constexpr int LDS_BYTES = 163840;
constexpr int LDS_ST_OFF = LDS_BYTES - 16;

#define XB_TMO      128
#define XB_XCNT(j)  (256  + 64 * (j))
#define XB_XSUB(j)  (1280 + 64 * (j))
#define XB_XGEN(j)  (2304 + 64 * (j))
#define XB_TOP      3328
#define XB_TOPGEN   3392
#define XCD_BAR_WORDS 3456
#define XB_SPIN_CAP (1u << 20)
__device__ __forceinline__ unsigned xb_ld(unsigned* p)              { return __hip_atomic_load(p, __ATOMIC_RELAXED, __HIP_MEMORY_SCOPE_AGENT); }
__device__ __forceinline__ unsigned xb_add(unsigned* p, unsigned v) { return __hip_atomic_fetch_add(p, v, __ATOMIC_RELAXED, __HIP_MEMORY_SCOPE_AGENT); }
__device__ __forceinline__ unsigned xb_xcc_id() { return (unsigned)__builtin_amdgcn_s_getreg((3 << 11) | 20) & 0xFu; }
#define XB_SPIN(cond, bar) do { unsigned _sp = 0; while (cond) { __builtin_amdgcn_s_sleep(1); \
    if ((++_sp & 255u) == 0u) { if (xb_ld(&(bar)[XB_TMO])) break; if (_sp > XB_SPIN_CAP) { atomicAdd(&(bar)[XB_TMO], 1u); break; } } } } while (0)
struct XcdBarrier { unsigned* bar; unsigned x; volatile LAS unsigned* st; };
__device__ __forceinline__ XcdBarrier xcd_barrier_post(unsigned* bar, volatile LAS unsigned* st) {
    XcdBarrier b; b.bar = bar; b.x = xb_xcc_id(); b.st = st;
    if (threadIdx.x == 0) (void)xb_add(&bar[XB_XCNT(b.x)], 1u);
    return b;
}
__device__ __forceinline__ void xcd_barrier_complete(unsigned* bar, unsigned x, unsigned& nloc, unsigned& nx) {
    const unsigned G = gridDim.x * gridDim.y * gridDim.z;
    unsigned sum, cnt, mine, sp = 0u;
    for (;;) {
        sum = 0u; cnt = 0u; mine = 0u;
#pragma unroll
        for (unsigned j = 0; j < 16; ++j) { const unsigned c = xb_ld(&bar[XB_XCNT(j)]); sum += c; cnt += (c > 0u) ? 1u : 0u; mine = (j == x) ? c : mine; }
        if (sum == G) break;
        __builtin_amdgcn_s_sleep(1);
        if ((++sp & 255u) == 0u) { if (xb_ld(&bar[XB_TMO])) break; if (sp > XB_SPIN_CAP) { atomicAdd(&bar[XB_TMO], 1u); break; } }
    }
    nloc = mine > 0u ? mine : 1u; nx = cnt > 0u ? cnt : 1u;
}
__device__ __forceinline__ void xcd_barrier(const XcdBarrier& b) {
    asm volatile("s_waitcnt vmcnt(0)" ::: "memory");
    __syncthreads();
    if (threadIdx.x == 0) {
        unsigned* bar = b.bar;
        __builtin_amdgcn_s_waitcnt(0);
        unsigned nloc = b.st[0], nx = b.st[1];
        if (nloc == 0u) { xcd_barrier_complete(bar, b.x, nloc, nx); b.st[0] = nloc; b.st[1] = nx; }
        const unsigned old = xb_add(&bar[XB_XSUB(b.x)], 1u);
        const unsigned gen = old / nloc;
        if (old + 1u == (gen + 1u) * nloc) {
            __builtin_amdgcn_fence(__ATOMIC_RELEASE, "agent");
            asm volatile("s_waitcnt vmcnt(0)" ::: "memory");
            const unsigned og = xb_add(&bar[XB_TOP], 1u);
            const unsigned tg = og / nx;
            if (og + 1u == (tg + 1u) * nx) xb_add(&bar[XB_TOPGEN], 1u);
            else XB_SPIN(xb_ld(&bar[XB_TOPGEN]) == tg, bar);
            __builtin_amdgcn_fence(__ATOMIC_ACQUIRE, "agent");
            xb_add(&bar[XB_XGEN(b.x)], 1u);
            asm volatile("s_waitcnt vmcnt(0)" ::: "memory");
        } else {
            XB_SPIN(xb_ld(&bar[XB_XGEN(b.x)]) == gen, bar);
            __builtin_amdgcn_fence(__ATOMIC_ACQUIRE, "agent");
            asm volatile("s_waitcnt vmcnt(0)" ::: "memory");
        }
    }
    __syncthreads();
}


namespace pg8 {
#define PG8_LAS __attribute__((address_space(3)))
typedef short bf16x8 __attribute__((ext_vector_type(8)));
typedef float f32x4 __attribute__((ext_vector_type(4)));
typedef unsigned u32x4 __attribute__((ext_vector_type(4)));
typedef unsigned u32x2 __attribute__((ext_vector_type(2)));
constexpr int BM = 256, BK = 64, HALF = 128, HTB = HALF * BK * 2, STAGE_BYTES = 8 * HTB, NXCD = 8, WGM = 8;
__host__ __device__ __forceinline__ int lds_byte(int r, int c) { const int st = (r >> 4) * 2 + (c >> 5), rr = r & 15, cc = c & 31, ob = rr * 64 + cc * 2; return st * 1024 + (ob ^ (((ob >> 9) & 1) << 5)); }
__host__ __device__ __forceinline__ void stage_rc(int b, int& R, int& C) { const int st = b / 1024, sb = b % 1024, swz = sb ^ (((sb >> 9) & 1) << 5); R = (st >> 1) * 16 + swz / 64; C = (st & 1) * 32 + (swz % 64) / 2; }
__host__ __device__ __forceinline__ int perm32(int rho) { const int n = rho >> 4, i = rho & 15; return 8 * (i >> 2) + 4 * n + (i & 3); }
struct Unit { int pm, pn; };
struct Gemm { const bf16_t* A; const bf16_t* Bt; int M, N, K; };
struct StaticOrder {
    int nM, nN, nwg, G, c;
    __host__ __device__ void init(int M, int N, int G_, int c_) { nM = M / BM; nN = N / BM; nwg = nM * nN; G = G_; c = c_; }
    __host__ __device__ bool next(int i, Unit& u) const {
        const long L = (long)i * G + c; if (L >= nwg) return false;
        int wgid = (int)L; { const int q = nwg / NXCD, r = nwg % NXCD, xcd = wgid % NXCD, off = wgid / NXCD; wgid = (xcd < r ? xcd * (q + 1) : r * (q + 1) + (xcd - r) * q) + off; }
        const int nig = WGM * nN, gid = wgid / nig, fm = gid * WGM, gsz = (nM - fm) < WGM ? (nM - fm) : WGM;
        u.pm = fm + ((wgid % nig) % gsz); u.pn = (wgid % nig) / gsz; return true;
    }
    __device__ __forceinline__ void a_ready(const Unit&) const {}
    __device__ __forceinline__ void done(const Unit&) const {}
};
__device__ __forceinline__ unsigned cvt_pk_bf16(float lo, float hi) { unsigned r; asm volatile("v_cvt_pk_bf16_f32 %0, %1, %2" : "=v"(r) : "v"(lo), "v"(hi)); return r; }

template <class Epi, class Sched>
__device__ __forceinline__ void gemm_phase(PG8_LAS unsigned char* lds, const Gemm g, const Sched& S, const Epi& E) {
    int tid_ = threadIdx.x; asm volatile("" : "+v"(tid_));
    const int tid = tid_, wid = __builtin_amdgcn_readfirstlane(tid >> 6), lane = tid & 63, wr = wid >> 2, wc = wid & 3, fr = lane & 15, fq = lane >> 4;
    const int K = g.K, nt = K / BK;
    unsigned voffA[2], voffB[2];
#pragma unroll
    for (int i = 0; i < 2; ++i) { int R, C; stage_rc(tid * 16 + i * 8192, R, C); const int Rb = Epi::PERM ? ((R & ~31) + perm32(R & 31)) : R;
        voffA[i] = (unsigned)(R * K + C) * 2u; voffB[i] = (unsigned)(Rb * K + C) * 2u; }
    const size_t kstep = (size_t)(BK * 2);
    const size_t hstep = (size_t)HALF * K * 2;
    const size_t tstep = 2 * hstep;
    const unsigned ldsw = (unsigned)wid * 1024u;
    const int aoff = lds_byte(wr * 64 + fr, fq * 8), boff = lds_byte(wc * 32 + fr, fq * 8);
#define PG8_SA(b, h) (((b) * 2 + (h)) * HTB)
#define PG8_SB(b, h) ((4 + (b) * 2 + (h)) * HTB)
#define PG8_STAGE(bufoff, gbase, voff) do { _Pragma("unroll") for (int _i = 0; _i < 2; ++_i) \
        __builtin_amdgcn_global_load_lds((const unsigned*)((const char*)(gbase) + (voff)[_i]), (PG8_LAS unsigned*)(lds + (bufoff) + ldsw + _i * 8192), 16, 0, 0); } while (0)
#define PG8_LDA(dst, b, h) do { _Pragma("unroll") for (int m = 0; m < 4; ++m) _Pragma("unroll") for (int k = 0; k < 2; ++k) dst[m][k] = *(const PG8_LAS bf16x8*)(lds + PG8_SA(b, h) + aoff + m * 2048 + k * 1024); } while (0)
#define PG8_LDB(dst, b, h) do { _Pragma("unroll") for (int n = 0; n < 2; ++n) _Pragma("unroll") for (int k = 0; k < 2; ++k) dst[n][k] = *(const PG8_LAS bf16x8*)(lds + PG8_SB(b, h) + boff + n * 2048 + k * 1024); } while (0)
#define PG8_MMA(ai, bj, At, Bt) do { __builtin_amdgcn_s_setprio(1); _Pragma("unroll") for (int m = 0; m < 4; ++m) _Pragma("unroll") for (int n = 0; n < 2; ++n) _Pragma("unroll") for (int k = 0; k < 2; ++k) \
        acc[ai][bj][m][n] = __builtin_amdgcn_mfma_f32_16x16x32_bf16(Bt[n][k], At[m][k], acc[ai][bj][m][n], 0, 0, 0); __builtin_amdgcn_s_setprio(0); } while (0)
#define PG8_WAIT_V(n) asm volatile("s_waitcnt vmcnt(" #n ")" ::: "memory")
#define PG8_WAIT_L(n) asm volatile("s_waitcnt lgkmcnt(" #n ")" ::: "memory")
#define PG8_BAR __builtin_amdgcn_s_barrier()
#define PG8_SCHED __builtin_amdgcn_sched_barrier(0)
    Unit cur, nxt; int ui = 0;
    if (!S.next(0, cur)) return;
    f32x4 acc[2][2][4][2];
#pragma unroll
    for (int a = 0; a < 2; ++a)
#pragma unroll
        for (int b = 0; b < 2; ++b)
#pragma unroll
            for (int m = 0; m < 4; ++m)
#pragma unroll
                for (int n = 0; n < 2; ++n) acc[a][b][m][n] = (f32x4){0.f, 0.f, 0.f, 0.f};
    bf16x8 At[4][2], B0[2][2], B1[2][2];
    const char* cA = (const char*)g.A + (size_t)cur.pm * tstep; const char* cB = (const char*)g.Bt + (size_t)cur.pn * tstep;
    S.a_ready(cur);
    PG8_STAGE(PG8_SB(0, 0), cB, voffB); PG8_STAGE(PG8_SA(0, 0), cA, voffA); PG8_STAGE(PG8_SB(0, 1), cB + hstep, voffB); PG8_STAGE(PG8_SA(0, 1), cA + hstep, voffA);
    if (wr == 1) PG8_BAR;
    PG8_WAIT_V(4); PG8_BAR;
    PG8_STAGE(PG8_SB(1, 0), cB + kstep, voffB); PG8_STAGE(PG8_SA(1, 0), cA + kstep, voffA); PG8_STAGE(PG8_SB(1, 1), cB + hstep + kstep, voffB);
    PG8_WAIT_V(6); PG8_BAR;
    for (;;) {
        const bool has_next = S.next(ui + 1, nxt);
        const char* nA = has_next ? (const char*)g.A + (size_t)nxt.pm * tstep : cA; const char* nB = has_next ? (const char*)g.Bt + (size_t)nxt.pn * tstep : cB;
        for (int t = 0; t < nt; t += 2) {
            const bool last = (t == nt - 2);
            const char* a1 = cA + (size_t)(t + 1) * kstep;
            const char* a2 = last ? nA : cA + (size_t)(t + 2) * kstep; const char* b2 = last ? nB : cB + (size_t)(t + 2) * kstep;
            const char* a3 = a2 + kstep; const char* b3 = b2 + kstep;
            if (last && has_next) S.a_ready(nxt);
            PG8_LDB(B0, 0, 0); PG8_SCHED; PG8_LDA(At, 0, 0); PG8_STAGE(PG8_SA(1, 1), a1 + hstep, voffA);
            PG8_WAIT_L(8); PG8_BAR; PG8_WAIT_L(0); PG8_MMA(0, 0, At, B0); PG8_BAR; PG8_SCHED;
            PG8_LDB(B1, 0, 1); PG8_STAGE(PG8_SB(0, 0), b2, voffB);
            PG8_BAR; PG8_WAIT_L(0); PG8_MMA(0, 1, At, B1); PG8_BAR;
            PG8_LDA(At, 0, 1); PG8_STAGE(PG8_SA(0, 0), a2, voffA);
            PG8_BAR; PG8_WAIT_L(0); PG8_MMA(1, 0, At, B0); PG8_BAR; PG8_SCHED;
            PG8_STAGE(PG8_SB(0, 1), b2 + hstep, voffB);
            PG8_WAIT_V(6); PG8_BAR; PG8_MMA(1, 1, At, B1); PG8_BAR;
            PG8_LDB(B0, 1, 0); PG8_SCHED; PG8_LDA(At, 1, 0); PG8_STAGE(PG8_SA(0, 1), a2 + hstep, voffA);
            PG8_WAIT_L(8); PG8_BAR; PG8_WAIT_L(0); PG8_MMA(0, 0, At, B0); PG8_BAR; PG8_SCHED;
            PG8_LDB(B1, 1, 1); PG8_STAGE(PG8_SB(1, 0), b3, voffB);
            PG8_BAR; PG8_WAIT_L(0); PG8_MMA(0, 1, At, B1); PG8_BAR;
            PG8_LDA(At, 1, 1); PG8_STAGE(PG8_SA(1, 0), a3, voffA);
            PG8_BAR; PG8_WAIT_L(0); PG8_MMA(1, 0, At, B0); PG8_BAR; PG8_SCHED;
            PG8_STAGE(PG8_SB(1, 1), b3 + hstep, voffB);
            PG8_WAIT_V(6); PG8_BAR; PG8_MMA(1, 1, At, B1); PG8_BAR;
        }
        if constexpr (!Epi::AFTER_DRAIN) { E(acc, cur, wr, wc, fr, fq); S.done(cur); }
        if (!has_next) break;
#pragma unroll
        for (int a = 0; a < 2; ++a)
#pragma unroll
            for (int b = 0; b < 2; ++b)
#pragma unroll
                for (int m = 0; m < 4; ++m)
#pragma unroll
                    for (int n = 0; n < 2; ++n) acc[a][b][m][n] = (f32x4){0.f, 0.f, 0.f, 0.f};
        cur = nxt; cA = nA; cB = nB; ++ui;
    }
    PG8_WAIT_V(0);
    if (wr == 0) PG8_BAR;
    PG8_BAR;
    if constexpr (Epi::AFTER_DRAIN) { E.fused(acc, cur, wr, wc, fr, fq, lds, wid, lane); S.done(cur); }
#undef PG8_SA
#undef PG8_SB
#undef PG8_STAGE
#undef PG8_LDA
#undef PG8_LDB
#undef PG8_MMA
#undef PG8_WAIT_V
#undef PG8_WAIT_L
#undef PG8_BAR
#undef PG8_SCHED
}
}

__host__ __device__ __forceinline__ int cmap_in(int F) { return (F & ~255) + 128 * ((F >> 5) & 1) + 32 * ((F >> 6) & 3) + (F & 31); }
struct EpiInprojMF {
    static constexpr bool PERM = true, AFTER_DRAIN = false;
    bf16_t* P; const float* rinv; const float* bias_f; const int* pos; const float* ftab; const float* qg; const float* kg;
    __device__ __forceinline__ void operator()(const pg8::f32x4 (&acc)[2][2][4][2], const pg8::Unit& u, int wr, int wc, int fr, int fq) const {
        typedef pg8::f32x4 f32x4;
        asm volatile("" : "+v"(fr), "+v"(fq));
        const int type = u.pn >> 1, head = 4 * (u.pn & 1) + wc, fb = 256 * u.pn + 64 * wc;
        const size_t PSZ = (size_t)T * 512;
        const int rslot = (type == 0) ? 0 : (type == 1) ? 1 : (type == 2) ? 5 : (type == 3) ? 2 : (type == 4) ? 3 : (type == 5) ? 4 : 6;
        bf16_t* rowmaj = P + (size_t)rslot * PSZ;
        const int t0 = u.pm * 256 + wr * 64 + fr;
        f32x4 bv[2][2], gv[2][2], fh[2], fl[2];
#pragma unroll
        for (int bj = 0; bj < 2; ++bj)
#pragma unroll
            for (int n = 0; n < 2; ++n) bv[bj][n] = *(const f32x4*)(bias_f + fb + 32 * bj + 8 * fq + 4 * n);
        if (type <= 1) {
#pragma unroll
            for (int n = 0; n < 2; ++n) { fh[n] = *(const f32x4*)(ftab + 8 * fq + 4 * n); fl[n] = *(const f32x4*)(ftab + 32 + 8 * fq + 4 * n); }
        } else if (type == 4 || type == 5) {
            const float* gsrc = (type == 4) ? qg : kg;
#pragma unroll
            for (int bj = 0; bj < 2; ++bj)
#pragma unroll
                for (int n = 0; n < 2; ++n) gv[bj][n] = *(const f32x4*)(gsrc + 32 * bj + 8 * fq + 4 * n);
        }
#pragma unroll
        for (int ai = 0; ai < 2; ++ai) {
            float rv[4], pf[4];
#pragma unroll
            for (int m = 0; m < 4; ++m) { rv[m] = rinv[t0 + ai * 128 + m * 16]; pf[m] = (float)pos[t0 + ai * 128 + m * 16]; }
            asm volatile("" : "+v"(rv[0]), "+v"(rv[1]), "+v"(rv[2]), "+v"(rv[3]), "+v"(pf[0]), "+v"(pf[1]), "+v"(pf[2]), "+v"(pf[3]));
#pragma unroll
            for (int m = 0; m < 4; ++m) {
                const int t = t0 + ai * 128 + m * 16;
                const float r = rv[m];
                f32x4 v[2][2];
#pragma unroll
                for (int bj = 0; bj < 2; ++bj)
#pragma unroll
                    for (int n = 0; n < 2; ++n) v[bj][n] = acc[ai][bj][m][n] * r + bv[bj][n];
                if (type <= 1) {
                    const float sc = (type == 1) ? 0.125f : 1.f, pp = pf[m];
#pragma unroll
                    for (int n = 0; n < 2; ++n)
#pragma unroll
                        for (int j = 0; j < 4; ++j) {
                            const float rev = __builtin_amdgcn_fractf(__builtin_amdgcn_fractf(pp * fh[n][j]) + pp * fl[n][j]);
                            const float cs = __builtin_amdgcn_cosf(rev) * sc, sn = __builtin_amdgcn_sinf(rev) * sc;
                            const float x1 = v[0][n][j], x2 = v[1][n][j]; v[0][n][j] = x1 * cs - x2 * sn; v[1][n][j] = x2 * cs + x1 * sn;
                        }
                } else if (type == 3) {
#pragma unroll
                    for (int bj = 0; bj < 2; ++bj)
#pragma unroll
                        for (int n = 0; n < 2; ++n)
#pragma unroll
                            for (int j = 0; j < 4; ++j) { const float x = v[bj][n][j]; v[bj][n][j] = x / (1.f + __expf(-x)); }
                } else if (type == 4 || type == 5) {
                    float ss = 0.f;
#pragma unroll
                    for (int bj = 0; bj < 2; ++bj)
#pragma unroll
                        for (int n = 0; n < 2; ++n)
#pragma unroll
                            for (int j = 0; j < 4; ++j) ss += v[bj][n][j] * v[bj][n][j];
                    ss += __shfl_xor(ss, 16); ss += __shfl_xor(ss, 32);
                    const float rn = (1.0f / sqrtf(ss * (1.f / 64.f) + EPS)) * ((type == 4) ? 0.125f * 1.44269504089f : 1.f);
#pragma unroll
                    for (int bj = 0; bj < 2; ++bj)
#pragma unroll
                        for (int n = 0; n < 2; ++n) v[bj][n] = v[bj][n] * rn * gv[bj][n];
                }
#pragma unroll
                for (int bj = 0; bj < 2; ++bj) {
                    pg8::u32x4 w; w.x = pg8::cvt_pk_bf16(v[bj][0][0], v[bj][0][1]); w.y = pg8::cvt_pk_bf16(v[bj][0][2], v[bj][0][3]);
                    w.z = pg8::cvt_pk_bf16(v[bj][1][0], v[bj][1][1]); w.w = pg8::cvt_pk_bf16(v[bj][1][2], v[bj][1][3]);
                    *(pg8::u32x4*)(rowmaj + (size_t)t * 512 + head * 64 + 32 * bj + 8 * fq) = w;
                }
            }
        }
    }
};

struct EpiOutprojMF {
    static constexpr bool PERM = false, AFTER_DRAIN = true;
    const bf16_t* xb; const float* gate1; bf16_t* x1b; float* part2;
    __device__ __forceinline__ void operator()(const pg8::f32x4 (&)[2][2][4][2], const pg8::Unit&, int, int, int, int) const {}
    __device__ __forceinline__ void fused(pg8::f32x4 (&acc)[2][2][4][2], const pg8::Unit& u, int wr, int wc, int fr, int fq, PG8_LAS unsigned char* lds, int wid, int lane) const {
        typedef pg8::f32x4 f32x4;
        asm volatile("" : "+v"(fr), "+v"(fq), "+v"(lane));
        constexpr int LD = 260;
        PG8_LAS float* TL = (PG8_LAS float*)lds;
        const int colw = wc * 32 + 4 * fq;
        f32x4 gv[2][2];
#pragma unroll
        for (int bj = 0; bj < 2; ++bj)
#pragma unroll
            for (int n = 0; n < 2; ++n) gv[bj][n] = *(const f32x4*)(gate1 + u.pn * 256 + colw + bj * 128 + n * 16);
#pragma unroll
        for (int ai = 0; ai < 2; ++ai) {
#pragma unroll
            for (int m = 0; m < 4; ++m)
#pragma unroll
                for (int bj = 0; bj < 2; ++bj)
#pragma unroll
                    for (int n = 0; n < 2; ++n) *(PG8_LAS f32x4*)(TL + (64 * wr + 16 * m + fr) * LD + colw + bj * 128 + n * 16) = gv[bj][n] * acc[ai][bj][m][n];
            __syncthreads();
            pg8::u32x2 xv[2];
            const size_t rowbase = (size_t)(u.pm * 256 + ai * 128 + 16 * wid) * D + u.pn * 256 + 4 * lane;
            xv[0] = *(const pg8::u32x2*)(xb + rowbase);
#pragma unroll
            for (int r = 0; r < 16; ++r) {
                if (r < 15) xv[(r + 1) & 1] = *(const pg8::u32x2*)(xb + rowbase + (size_t)(r + 1) * D);
                const f32x4 g = *(PG8_LAS f32x4*)(TL + (16 * wid + r) * LD + 4 * lane);
                const pg8::u32x2 xw = xv[r & 1];
                f32x4 o; o[0] = __uint_as_float(xw.x << 16) + g[0]; o[1] = __uint_as_float(xw.x & 0xffff0000u) + g[1]; o[2] = __uint_as_float(xw.y << 16) + g[2]; o[3] = __uint_as_float(xw.y & 0xffff0000u) + g[3];
                pg8::u32x2 w; w.x = pg8::cvt_pk_bf16(o[0], o[1]); w.y = pg8::cvt_pk_bf16(o[2], o[3]);
                *(pg8::u32x2*)(x1b + rowbase + (size_t)r * D) = w;
                float ss = o[0] * o[0] + o[1] * o[1] + o[2] * o[2] + o[3] * o[3];
#pragma unroll
                for (int o2 = 32; o2 > 0; o2 >>= 1) ss += __shfl_xor(ss, o2);
                if (lane < 4) part2[(size_t)(u.pm * 256 + ai * 128 + 16 * wid + r) * 16 + u.pn * 4 + lane] = (lane == 0) ? ss : 0.f;
            }
            __syncthreads();
        }
    }
};

__device__ __forceinline__ unsigned pk2(float lo, float hi) { return (unsigned)f2bf(lo) | ((unsigned)f2bf(hi) << 16); }
template <bool FOLD, bool CMAP>
__device__ __forceinline__ void transpose_item(const float* W, int K, int N, bf16_t* WT, float* scr, int item, int lane, const float* sg, const float* sm) {
    const int nblk = N / 32, kb = item / nblk, nb = item % nblk, k0 = 64 * kb, n0 = 32 * nb;
    float4 v[8]; float f[8];
#pragma unroll
    for (int i = 0; i < 8; ++i) { const int kk = 8 * i + (lane >> 3); v[i] = *(const float4*)(W + (size_t)(k0 + kk) * N + n0 + 4 * (lane & 7));
        f[i] = FOLD ? sg[k0 + kk] * (1.f + sm[k0 + kk]) : 1.f; }
#pragma unroll
    for (int i = 0; i < 8; ++i) { const int kk = 8 * i + (lane >> 3); float* d = scr + kk * 33 + 4 * (lane & 7);
        d[0] = v[i].x * f[i]; d[1] = v[i].y * f[i]; d[2] = v[i].z * f[i]; d[3] = v[i].w * f[i]; }
    asm volatile("s_waitcnt lgkmcnt(0)" ::: "memory");
    const int c = lane & 7, r0 = CMAP ? cmap_in(n0) : n0;
#pragma unroll
    for (int j = 0; j < 4; ++j) { const int n = (lane >> 3) + 8 * j; const float* s = scr + (8 * c) * 33 + n;
        pg8::u32x4 o; o.x = pk2(s[0 * 33], s[1 * 33]); o.y = pk2(s[2 * 33], s[3 * 33]); o.z = pk2(s[4 * 33], s[5 * 33]); o.w = pk2(s[6 * 33], s[7 * 33]);
        *(pg8::u32x4*)(WT + (size_t)(r0 + n) * K + k0 + 8 * c) = o; }
    asm volatile("s_waitcnt lgkmcnt(0)" ::: "memory");
}
template <int NC4, class VF>
__device__ __forceinline__ void gemv_cols(unsigned char* lds, const VF vf, const float* W, const int N, const int u, float* dst, const float* add) {
    constexpr int RG = 512 / NC4;
    float (*red)[NC4 * 4] = (float (*)[NC4 * 4])lds;
    const int tid = threadIdx.x, c4 = tid % NC4, rg = tid / NC4;
    if (rg < RG) {
        float4 acc = {0.f, 0.f, 0.f, 0.f};
        for (int r = rg; r < 1024; r += RG) { const float s = vf(r); const float4 w = *(const float4*)(W + (size_t)r * N + u * NC4 * 4 + c4 * 4);
            acc.x += s * w.x; acc.y += s * w.y; acc.z += s * w.z; acc.w += s * w.w; }
        red[rg][c4 * 4 + 0] = acc.x; red[rg][c4 * 4 + 1] = acc.y; red[rg][c4 * 4 + 2] = acc.z; red[rg][c4 * 4 + 3] = acc.w;
    }
    __syncthreads();
    if (tid < NC4 * 4) { float s = 0.f; for (int i = 0; i < RG; ++i) s += red[i][tid]; dst[u * NC4 * 4 + tid] = s + (add ? add[u * NC4 * 4 + tid] : 0.f); }
    __syncthreads();
}
struct VfSilu { const float* c; __device__ __forceinline__ float operator()(int r) const { const float v = c[r]; return v / (1.f + expf(-v)); } };
struct VfVec { const float* v; __device__ __forceinline__ float operator()(int r) const { return v[r]; } };


typedef float f32x16 __attribute__((ext_vector_type(16)));
typedef pg8::bf16x8 bf16x8;
#define MFMA32(a, b, c) __builtin_amdgcn_mfma_f32_32x32x16_bf16((a), (b), (c), 0, 0, 0)
__device__ __forceinline__ bf16x8 pack_frag(const f32x16& v, int s) {
    pg8::u32x4 w;
    w.x = pg8::cvt_pk_bf16(v[8 * s + 0], v[8 * s + 1]); w.y = pg8::cvt_pk_bf16(v[8 * s + 2], v[8 * s + 3]);
    w.z = pg8::cvt_pk_bf16(v[8 * s + 4], v[8 * s + 5]); w.w = pg8::cvt_pk_bf16(v[8 * s + 6], v[8 * s + 7]);
    return __builtin_bit_cast(bf16x8, w);
}
__device__ __forceinline__ bf16x8 load_tfrag(const bf16_t* rowp, int tok) {
    const uint2 a = *(const uint2*)(rowp + tok), b = *(const uint2*)(rowp + tok + 8);
    pg8::u32x4 w; w.x = a.x; w.y = a.y; w.z = b.x; w.w = b.y;
    return __builtin_bit_cast(bf16x8, w);
}


__device__ __forceinline__ bf16x8 tr_frag(const unsigned char* a0, int rows2) {
    typedef short s16x4 __attribute__((ext_vector_type(4)));
    typedef __attribute__((address_space(3))) s16x4 lds_s16x4;
    const s16x4 lo = __builtin_amdgcn_ds_read_tr16_b64_v4i16((lds_s16x4*)a0);
    const s16x4 hi = __builtin_amdgcn_ds_read_tr16_b64_v4i16((lds_s16x4*)(a0 + rows2 * 144));
    const uint2 l2 = __builtin_bit_cast(uint2, lo), h2 = __builtin_bit_cast(uint2, hi);
    pg8::u32x4 fw; fw.x = l2.x; fw.y = l2.y; fw.z = h2.x; fw.w = h2.y;
    return __builtin_bit_cast(bf16x8, fw);
}

__device__ __forceinline__ void ins16(float (&s)[16], float x) {
#pragma unroll
    for (int i = 15; i >= 1; --i) s[i] = __builtin_amdgcn_fmed3f(s[i - 1], s[i], x);
    s[0] = fmaxf(s[0], x);
}


struct OneUnitOrder {
    pg8::StaticOrder base; int round;
    __device__ __forceinline__ bool next(int i, pg8::Unit& u) const { if (i != 0) return false; return base.next(round, u); }
    __device__ __forceinline__ void a_ready(const pg8::Unit&) const {}
    __device__ __forceinline__ void done(const pg8::Unit&) const {}
};
struct EpiTopkMF {
    static constexpr bool PERM = false, AFTER_DRAIN = true;
    const float* part2; const float* bias_q; unsigned short* ids; float* gates;
    __device__ __forceinline__ void operator()(const pg8::f32x4 (&)[2][2][4][2], const pg8::Unit&, int, int, int, int) const {}
    __device__ __forceinline__ void fused(pg8::f32x4 (&acc)[2][2][4][2], const pg8::Unit& u, int wr, int wc, int fr, int fq, PG8_LAS unsigned char* lds, int wid, int lane) const {
        typedef pg8::f32x4 f32x4;
        constexpr int SLD = 260;
        PG8_LAS float* SC = (PG8_LAS float*)lds; PG8_LAS float* MG = (PG8_LAS float*)(lds + 128 * SLD * 4);
        const int tid = wid * 64 + lane, tok = tid & 255, hk = tid >> 8;
        float rinv[2][4];
#pragma unroll
        for (int ai = 0; ai < 2; ++ai)
#pragma unroll
            for (int m = 0; m < 4; ++m) {
                const int row = u.pm * 256 + ai * 128 + wr * 64 + m * 16 + fr;
                const f32x4* pp = (const f32x4*)(part2 + (size_t)row * 16);
                const f32x4 p0 = pp[0], p1 = pp[1], p2 = pp[2], p3 = pp[3];
                const float ssum = ((p0[0] + p0[1]) + (p0[2] + p0[3])) + ((p1[0] + p1[1]) + (p1[2] + p1[3])) + ((p2[0] + p2[1]) + (p2[2] + p2[3])) + ((p3[0] + p3[1]) + (p3[2] + p3[3]));
                rinv[ai][m] = 1.0f / sqrtf(ssum * (1.0f / D) + EPS);
            }
        float sl[16], mine[16];
#pragma unroll
        for (int p = 0; p < 2; ++p) {
            f32x4 bv[2];
#pragma unroll
            for (int n = 0; n < 2; ++n) bv[n] = *(const f32x4*)(bias_q + u.pn * 256 + p * 128 + wc * 32 + n * 16 + 4 * fq);
#pragma unroll
            for (int ai = 0; ai < 2; ++ai)
#pragma unroll
                for (int m = 0; m < 4; ++m)
#pragma unroll
                    for (int n = 0; n < 2; ++n)
#pragma unroll
                        for (int j = 0; j < 4; ++j)
                            SC[(32 * wc + 16 * n + 4 * fq + j) * SLD + (128 * ai + 64 * wr + 16 * m + fr)] = acc[ai][p][m][n][j] * rinv[ai][m] + bv[n][j];
            __syncthreads();
#pragma unroll
            for (int i = 0; i < 16; ++i) sl[i] = -INFINITY;
#pragma unroll 8
            for (int k = 0; k < 64; ++k) { const int key = 64 * hk + k; const float x = SC[key * SLD + tok]; ins16(sl, __uint_as_float((__float_as_uint(x) & 0xFFFFFF80u) | (unsigned)key)); }
            if (hk != p) {
#pragma unroll
                for (int i = 0; i < 16; ++i) MG[i * 256 + tok] = sl[i];
            }
            __syncthreads();
            if (hk == p) {
#pragma unroll
                for (int i = 0; i < 16; ++i) ins16(sl, MG[i * 256 + tok]);
#pragma unroll
                for (int i = 0; i < 16; ++i) mine[i] = sl[i];
            }
            __syncthreads();
        }
        PG8_LAS float* X1 = SC; PG8_LAS float* TL = SC + 4096; PG8_LAS unsigned* I0 = (PG8_LAS unsigned*)(SC + 8192); PG8_LAS unsigned* I1 = (PG8_LAS unsigned*)(SC + 12288);
        if (hk) {
#pragma unroll
            for (int i = 0; i < 16; ++i) { X1[i * 256 + tok] = mine[i]; I1[i * 256 + tok] = __float_as_uint(mine[i]) & 0x7Fu; }
        } else {
#pragma unroll
            for (int i = 0; i < 16; ++i) I0[i * 256 + tok] = __float_as_uint(mine[i]) & 0x7Fu;
        }
        __syncthreads();
        if (!hk) {
            float s1m[16], tl[16];
#pragma unroll
            for (int i = 0; i < 16; ++i) { s1m[i] = __uint_as_float(__float_as_uint(X1[i * 256 + tok]) & 0xFFFFFF80u); mine[i] = __uint_as_float(__float_as_uint(mine[i]) & 0xFFFFFF80u); tl[i] = -INFINITY; }
#pragma unroll
            for (int a2 = 0; a2 < 16; ++a2)
#pragma unroll
                for (int b2 = 0; b2 < 16; ++b2)
                    if ((a2 + 1) * (b2 + 1) <= 16) ins16(tl, __uint_as_float((__float_as_uint(mine[a2] + s1m[b2]) & 0xFFFFFF00u) | (unsigned)(a2 * 16 + b2)));
#pragma unroll
            for (int i = 0; i < 16; ++i) TL[i * 256 + tok] = tl[i];
        }
        __syncthreads();
        if (hk) {
            float ev[16]; float sum = 0.f; unsigned cd[16];
#pragma unroll
            for (int j = 0; j < 16; ++j) { const unsigned bits = __float_as_uint(TL[j * 256 + tok]); cd[j] = bits & 0xFFu; ev[j] = __uint_as_float(bits & 0xFFFFFF00u); }
            const float mx = ev[0];
#pragma unroll
            for (int j = 0; j < 16; ++j) { ev[j] = __expf(ev[j] - mx); sum += ev[j]; }
            const float inv = 1.f / sum;
            unsigned idw[8];
#pragma unroll
            for (int j = 0; j < 16; ++j) {
                const unsigned id = I0[(cd[j] >> 4) * 256 + tok] * 128u + I1[(cd[j] & 15u) * 256 + tok];
                if (j & 1) idw[j >> 1] |= id << 16; else idw[j >> 1] = id;
                ev[j] *= inv;
            }
            const size_t t = (size_t)u.pm * 256 + tok;
            unsigned short* idp = ids + t * 128 + u.pn * 16; float* gp = gates + t * 128 + u.pn * 16;
            *(uint4*)idp = make_uint4(idw[0], idw[1], idw[2], idw[3]); *(uint4*)(idp + 8) = make_uint4(idw[4], idw[5], idw[6], idw[7]);
#pragma unroll
            for (int q = 0; q < 4; ++q) *(float4*)(gp + 4 * q) = make_float4(ev[4 * q], ev[4 * q + 1], ev[4 * q + 2], ev[4 * q + 3]);
        }
        __syncthreads();
    }
};


__device__ __forceinline__ void convert_tables(const float* down, const float* up, unsigned char* q8, bf16_t* dsc, int lane, int cw, int nconv, int r0, int r1) {
    for (int row0 = r0 + cw * 2; row0 < r1; row0 += nconv * 2) {
        float4 v[2][4];
#pragma unroll
        for (int rr = 0; rr < 2; ++rr) {
            const int row = row0 + rr, isup = row >> 14, e = row & 16383;
            const float* sp = (isup ? up : down) + (size_t)e * 1024 + lane * 4;
#pragma unroll
            for (int q = 0; q < 4; ++q) v[rr][q] = ld_nt4(sp + 256 * q);
        }
#pragma unroll
        for (int rr = 0; rr < 2; ++rr) {
            const int row = row0 + rr, isup = row >> 14, e = row & 16383;
            {
                float ss = 0.f;
#pragma unroll
                for (int q = 0; q < 4; ++q) ss += v[rr][q].x * v[rr][q].x + v[rr][q].y * v[rr][q].y + v[rr][q].z * v[rr][q].z + v[rr][q].w * v[rr][q].w;
#pragma unroll
                for (int o = 32; o > 0; o >>= 1) ss += __shfl_xor(ss, o);
                const float sigma = sqrtf(ss * (1.0f / 1024.0f));
                const float s = (sigma > 0.f) ? 7.5f / (2.6f * sigma) : 1.f;
#pragma unroll
                for (int q = 0; q < 4; ++q) {
                    const int n0 = (int)fminf(fmaxf(__builtin_rintf(v[rr][q].x * s), -8.f), 7.f) + 8, n1 = (int)fminf(fmaxf(__builtin_rintf(v[rr][q].y * s), -8.f), 7.f) + 8;
                    const int n2 = (int)fminf(fmaxf(__builtin_rintf(v[rr][q].z * s), -8.f), 7.f) + 8, n3 = (int)fminf(fmaxf(__builtin_rintf(v[rr][q].w * s), -8.f), 7.f) + 8;
                    const int h1 = isup ? ((n1 - 8) & 15) : n1, h3 = isup ? ((n3 - 8) & 15) : n3;
                    *(unsigned short*)(q8 + (size_t)isup * (8u << 20) + ((size_t)q * 16384 + e) * 128 + (lane & 7) * 16 + (lane >> 3) * 2) = (unsigned short)(n0 | (h1 << 4) | (n2 << 8) | (h3 << 12));
                }
                if (lane == 0) dsc[row] = f2bf(1.0f / s);
            }
        }
    }
}

struct Params {
    const float *x, *c; const int* pos; const float *ada_w, *ada_b, *g1, *g2, *w_in, *rgain, *qg, *kg, *og, *w_out, *wq, *sk, *down, *up;
    float* out; unsigned char* ws; RopeC rc;
};

__global__ void __launch_bounds__(512) mk_fwd(Params p) {
    extern __shared__ __attribute__((aligned(16))) unsigned char lds[];
    const int tid = threadIdx.x, lane = tid & 63, wave = tid >> 6, bid = blockIdx.x, G = gridDim.x;
    unsigned char* ws = p.ws;
    float* mod = (float*)(ws + OFF_MOD); float* rinv1 = (float*)(ws + OFF_RINV1); float* ftab = (float*)(ws + OFF_ROPE);
    bf16_t* P = (bf16_t*)(ws + OFF_P); float* kv = (float*)(ws + OFF_KV); bf16_t* stT = (bf16_t*)(ws + OFF_ST); bf16_t* ycat = (bf16_t*)(ws + OFF_YCAT);
    bf16_t* xb = (bf16_t*)(ws + OFF_XB); bf16_t* Win_t = (bf16_t*)(ws + OFF_WINT); float* bias_f = (float*)(ws + OFF_BIASF);
    bf16_t* Weff_t = (bf16_t*)(ws + OFF_WEFFT); bf16_t* Wout_t = (bf16_t*)(ws + OFF_WOUTT); float* bias_q = (float*)(ws + OFF_BIASQ); float* bq_part = (float*)(ws + OFF_BQPART);
    float* part2 = (float*)(ws + OFF_PART2); bf16_t* x1b = (bf16_t*)(ws + OFF_X1B); unsigned short* ids = (unsigned short*)(ws + OFF_IDS); unsigned char* q8 = ws + OFF_Q8; bf16_t* dsc = (bf16_t*)(ws + OFF_DSC); float* gates = (float*)(ws + OFF_GATES);
    const size_t PS = (size_t)T * 512;
    const bf16_t *Qr = P, *Kr = P + PS, *Gr = P + 2 * PS, *Qs = P + 3 * PS, *Ks = P + 4 * PS, *Vr = P + 5 * PS, *Vs = P + 6 * PS;
    float* out = p.out;

    if (tid < 4) ((LAS unsigned*)((LAS unsigned char*)lds + LDS_ST_OFF))[tid] = 0u;
    __syncthreads();
    XcdBarrier bar = xcd_barrier_post((unsigned*)(ws + OFF_CTL), (volatile LAS unsigned*)((LAS unsigned char*)lds + LDS_ST_OFF));

    for (int u = bid; u < 256; u += G) gemv_cols<6>(lds, VfSilu{p.c}, p.ada_w, 6144, u, mod, p.ada_b);
    for (int row0 = (bid * 8 + wave) * 2; row0 < T; row0 += G * 16) {
        float4 v[2][4];
#pragma unroll
        for (int rr = 0; rr < 2; ++rr)
#pragma unroll
            for (int j = 0; j < 4; ++j) v[rr][j] = ld_nt4(p.x + (size_t)(row0 + rr) * D + (lane + 64 * j) * 4);
#pragma unroll
        for (int rr = 0; rr < 2; ++rr) {
            uint2* xo = (uint2*)(xb + (size_t)(row0 + rr) * D);
            float s = 0.f;
#pragma unroll
            for (int j = 0; j < 4; ++j) { const float4 q = v[rr][j]; s += q.x * q.x + q.y * q.y + q.z * q.z + q.w * q.w; xo[lane + 64 * j] = make_uint2(pk2(q.x, q.y), pk2(q.z, q.w)); }
#pragma unroll
            for (int o = 32; o > 0; o >>= 1) s += __shfl_xor(s, o);
            if (lane == 0) rinv1[row0 + rr] = 1.0f / sqrtf(s * (1.0f / D) + EPS);
        }
    }
    if (bid == 0 && tid == 0) {
#pragma unroll
        for (int i = 0; i < 32; ++i) { ftab[i] = p.rc.fh[i]; ftab[32 + i] = p.rc.fl[i]; }
    }
    xcd_barrier(bar);

    {
        float* scr = (float*)(lds + wave * 16384);
        for (int it = bid * 8 + wave; it < 16 * 112; it += G * 8) transpose_item<true, true>(p.w_in, 1024, 3584, Win_t, scr, it, lane, p.g1, mod + 1024);
        __syncthreads();
        for (int u = bid; u < 128; u += G) gemv_cols<7>(lds, VfVec{mod}, p.w_in, 3584, u, bias_f, nullptr);
    }
    xcd_barrier(bar);

    {
        pg8::Gemm g{xb, Win_t, T, 3584, 1024}; pg8::StaticOrder S; S.init(T, 3584, G, bid);
        EpiInprojMF E{P, rinv1, bias_f, p.pos, ftab, p.qg, p.kg};
        pg8::gemm_phase<EpiInprojMF, pg8::StaticOrder>((PG8_LAS unsigned char*)lds, g, S, E);
        const int nidle = (G > 128) ? G - 128 : G, ib = (G > 128) ? bid - 128 : bid;
        {
            float* scr = (float*)(lds + wave * 16384);
            if (ib >= 0) for (int it = ib * 8 + wave; it < 16 * 32; it += nidle * 8) transpose_item<false, false>(p.w_out, 1024, 1024, Wout_t, scr, it, lane, nullptr, nullptr);
            __syncthreads();
        }
        if (ib >= 0 && ib < 128) {
            const int hp = ib >> 3, blk = ib & 7;
            float* skT = (float*)lds; float* wqs = (float*)(lds + 69632);
            for (int e = tid; e < 16384; e += 512) { const int k = e >> 7, c = e & 127; skT[c * 132 + k] = p.sk[((size_t)hp * 128 + k) * 128 + c]; }
            float bacc[16];
#pragma unroll
            for (int j = 0; j < 16; ++j) bacc[j] = 0.f;
            for (int rbk = 0; rbk < 2; ++rbk) {
                const int i0 = (blk * 2 + rbk) * 64;
                __syncthreads();
                for (int e = tid; e < 8192; e += 512) { const int r = e >> 7, c = e & 127; wqs[r * 129 + c] = p.wq[(size_t)(i0 + r) * 2048 + hp * 128 + c]; }
                __syncthreads();
                float acc[16];
#pragma unroll
                for (int j = 0; j < 16; ++j) acc[j] = 0.f;
                const float* wrow = wqs + lane * 129; const float* skc = skT + 16 * wave;
#pragma unroll 4
                for (int c = 0; c < 128; ++c) {
                    const float av = wrow[c];
                    const float4 b0 = *(const float4*)(skc + c * 132), b1 = *(const float4*)(skc + c * 132 + 4), b2 = *(const float4*)(skc + c * 132 + 8), b3 = *(const float4*)(skc + c * 132 + 12);
                    acc[0] += av * b0.x; acc[1] += av * b0.y; acc[2] += av * b0.z; acc[3] += av * b0.w; acc[4] += av * b1.x; acc[5] += av * b1.y; acc[6] += av * b1.z; acc[7] += av * b1.w;
                    acc[8] += av * b2.x; acc[9] += av * b2.y; acc[10] += av * b2.z; acc[11] += av * b2.w; acc[12] += av * b3.x; acc[13] += av * b3.y; acc[14] += av * b3.z; acc[15] += av * b3.w;
                }
                const int i = i0 + lane;
                const float s2v = p.g2[i] * (1.f + mod[4096 + i]), sh = mod[3072 + i];
#pragma unroll
                for (int j = 0; j < 16; ++j) { Weff_t[(size_t)(hp * 128 + 16 * wave + j) * 1024 + i] = f2bf(acc[j] * s2v); bacc[j] += sh * acc[j]; }
            }
#pragma unroll
            for (int j = 0; j < 16; ++j) { float v = bacc[j];
#pragma unroll
                for (int o = 32; o > 0; o >>= 1) v += __shfl_xor(v, o);
                if (lane == 0) bq_part[(size_t)blk * 2048 + hp * 128 + 16 * wave + j] = v; }
            __syncthreads();
        }
        if (ib >= 0) convert_tables(p.down, p.up, q8, dsc, lane, ib * 8 + wave, nidle * 8, 0, CONV_SPLIT);
    }
    xcd_barrier(bar);

    {
        const int gw = __builtin_amdgcn_readfirstlane(bid * 8 + wave), NGW = G * 8, l31 = lane & 31, hf = lane >> 5;
        const int wv0 = __builtin_amdgcn_readfirstlane(wave);
        for (int U = gw; U < 1024; U += NGW) {
            const int n = U >> 3, h = U & 7;
            f32x16 C[2][2];
#pragma unroll
            for (int a = 0; a < 2; ++a)
#pragma unroll
                for (int b = 0; b < 2; ++b)
#pragma unroll
                    for (int r = 0; r < 16; ++r) C[a][b][r] = 0.f;
            unsigned char* Kt = lds + wv0 * 9216; unsigned char* Vt = Kt + 4608;
            const int r8 = lane >> 3, pc = lane & 7, trq = (lane & 15) >> 2, trp = lane & 3, trd = (lane >> 4) & 1;
            const char* kbase = (const char*)(Kr + (size_t)n * 128 * 512 + h * 64); const char* vbase = (const char*)(Vr + (size_t)n * 128 * 512 + h * 64);
            const unsigned loff = (unsigned)(r8 * 512 + pc * 8) * 2u;
            const float lg = lg2_head(h);
            pg8::u32x4 gK[4], gV[4];
#pragma unroll
            for (int i = 0; i < 4; ++i) { gK[i] = *(const pg8::u32x4*)(kbase + (loff + i * 8192u)); gV[i] = *(const pg8::u32x4*)(vbase + (loff + i * 8192u)); }
            for (int sb4 = 0; sb4 < 4; ++sb4) {
#pragma unroll
                for (int i = 0; i < 4; ++i) { *(pg8::u32x4*)(Kt + (8 * i + r8) * 144 + pc * 16) = gK[i]; *(pg8::u32x4*)(Vt + (8 * i + r8) * 144 + pc * 16) = gV[i]; }
                { const int sn = (sb4 < 3) ? sb4 + 1 : sb4;
#pragma unroll
                  for (int i = 0; i < 4; ++i) { gK[i] = *(const pg8::u32x4*)(kbase + (size_t)sn * 32768 + (loff + i * 8192u)); gV[i] = *(const pg8::u32x4*)(vbase + (size_t)sn * 32768 + (loff + i * 8192u)); } }
#pragma unroll
                for (int s = 0; s < 2; ++s) {
                    bf16x8 Af[2], Bf[2];
#pragma unroll
                    for (int a = 0; a < 2; ++a) {
                        Af[a] = tr_frag(Vt + (16 * s + 8 * hf + trq) * 144 + (32 * a + 16 * trd + 4 * trp) * 2, 4);
                        const bf16x8 kraw = tr_frag(Kt + (16 * s + 8 * hf + trq) * 144 + (32 * a + 16 * trd + 4 * trp) * 2, 4);
                        const pg8::u32x4 kw = __builtin_bit_cast(pg8::u32x4, kraw); const unsigned kk[4] = {kw.x, kw.y, kw.z, kw.w};
                        pg8::u32x4 o; unsigned* op = (unsigned*)&o;
#pragma unroll
                        for (int e2 = 0; e2 < 4; ++e2) {
                            const int j0 = 32 * sb4 + 16 * s + 8 * hf + 2 * e2;
                            const float z0 = __builtin_amdgcn_exp2f((float)(127 - j0) * lg), z1 = __builtin_amdgcn_exp2f((float)(126 - j0) * lg);
                            op[e2] = pg8::cvt_pk_bf16(__uint_as_float(kk[e2] << 16) * z0, __uint_as_float(kk[e2] & 0xffff0000u) * z1);
                        }
                        Bf[a] = __builtin_bit_cast(bf16x8, o);
                    }
#pragma unroll
                    for (int a = 0; a < 2; ++a)
#pragma unroll
                        for (int b = 0; b < 2; ++b) C[a][b] = MFMA32(Af[a], Bf[b], C[a][b]);
                }
            }
            float* dst = kv + (size_t)(n * 8 + h) * 4096;
#pragma unroll
            for (int a = 0; a < 2; ++a)
#pragma unroll
                for (int b = 0; b < 2; ++b)
#pragma unroll
                    for (int r = 0; r < 16; ++r) dst[(32 * a + (r & 3) + 8 * (r >> 2) + 4 * hf) * 64 + 32 * b + l31] = C[a][b][r];
        }
        bf16x8 Tri[2];
        {
            pg8::u32x4 w0, w1; unsigned* p0 = (unsigned*)&w0; unsigned* p1 = (unsigned*)&w1;
#pragma unroll
            for (int e2 = 0; e2 < 4; ++e2) {
                unsigned a0 = 0, a1 = 0;
#pragma unroll
                for (int q = 0; q < 2; ++q) { const int e = 2 * e2 + q, ip = 8 * (e >> 2) + 4 * hf + (e & 3);
                    a0 |= ((ip > l31) ? 0x3F80u : 0u) << (16 * q); a1 |= ((16 + ip > l31) ? 0x3F80u : 0u) << (16 * q); }
                p0[e2] = a0; p1[e2] = a1;
            }
            Tri[0] = __builtin_bit_cast(bf16x8, w0); Tri[1] = __builtin_bit_cast(bf16x8, w1);
        }
        const bool sb_local = (G % 8 == 0) && (4096 % G == 0) && ((4096 / G) % 8 == 0);
        const int sb_per_wave = sb_local ? 4096 / G / 8 : (4096 + NGW - 1 - gw) / NGW;
        const int wv = __builtin_amdgcn_readfirstlane(wave);
        for (int ps = 0; ps < sb_per_wave; ++ps) {
            const int U = sb_local ? 0 : gw + ps * NGW;
            const int h = sb_local ? (bid & 7) : (U & 7), qt = sb_local ? (bid >> 3) * (4096 / G) + ps * 8 + wv : (U >> 3), q0 = qt * 32;
            f32x16 O[2];
#pragma unroll
            for (int r = 0; r < 16; ++r) { O[0][r] = 0.f; O[1][r] = 0.f; }
            float carry = 0.f;
            unsigned char* Kt = lds + wv * 9216; unsigned char* Vt = Kt + 4608;
            const int r8 = lane >> 3, pc = lane & 7;
            const char* kbase = (const char*)(Ks + h * 64); const char* vbase = (const char*)(Vs + h * 64);
            const unsigned loff = (unsigned)(r8 * 512 + pc * 8) * 2u;
            pg8::u32x4 gK[4], gV[4];
            bf16x8 Qf[4];
            {
                const char* qbase = (const char*)(Qs + h * 64);
#pragma unroll
                for (int i = 0; i < 4; ++i) gK[i] = *(const pg8::u32x4*)(qbase + (size_t)qt * 32768 + (loff + i * 8192u));
#pragma unroll
                for (int i = 0; i < 4; ++i) *(pg8::u32x4*)(Kt + (8 * i + r8) * 144 + pc * 16) = gK[i];
#pragma unroll
                for (int s = 0; s < 4; ++s) Qf[s] = *(const bf16x8*)(Kt + l31 * 144 + 32 * s + 16 * hf);
            }
#pragma unroll
            for (int i = 0; i < 4; ++i) { gK[i] = *(const pg8::u32x4*)(kbase + (size_t)qt * 32768 + (loff + i * 8192u)); gV[i] = *(const pg8::u32x4*)(vbase + (size_t)qt * 32768 + (loff + i * 8192u)); }
            const int trq = (lane & 15) >> 2, trp = lane & 3, trd = (lane >> 4) & 1;
            for (int kb = qt; kb >= 0; --kb) {
#pragma unroll
                for (int i = 0; i < 4; ++i) { *(pg8::u32x4*)(Kt + (8 * i + r8) * 144 + pc * 16) = gK[i]; *(pg8::u32x4*)(Vt + (8 * i + r8) * 144 + pc * 16) = gV[i]; }
                {
                    const int kbn = (kb > 0) ? kb - 1 : 0;
#pragma unroll
                    for (int i = 0; i < 4; ++i) { gK[i] = *(const pg8::u32x4*)(kbase + (size_t)kbn * 32768 + (loff + i * 8192u)); gV[i] = *(const pg8::u32x4*)(vbase + (size_t)kbn * 32768 + (loff + i * 8192u)); }
                }
                bf16x8 Kf[4], Vf[2][2];
#pragma unroll
                for (int s = 0; s < 4; ++s) Kf[s] = *(const bf16x8*)(Kt + l31 * 144 + 32 * s + 16 * hf);
#pragma unroll
                for (int s = 0; s < 2; ++s)
#pragma unroll
                    for (int dt = 0; dt < 2; ++dt) {
                        Vf[s][dt] = tr_frag(Vt + (16 * s + 4 * hf + trq) * 144 + (32 * dt + 16 * trd + 4 * trp) * 2, 8);
                    }
                f32x16 S;
#pragma unroll
                for (int r = 0; r < 16; ++r) S[r] = 0.f;
#pragma unroll
                for (int s = 0; s < 4; ++s) S = MFMA32(Kf[s], Qf[s], S);
                const bool diag = (kb == qt);
                f32x16 sp, lb;
                float csum = 0.f;
                if (diag) {
#pragma unroll
                    for (int r = 0; r < 16; ++r) {
                        const int i = (r & 3) + 8 * (r >> 2) + 4 * hf;
                        const float z = S[r];
                        const float l1p = __builtin_amdgcn_logf(1.0f + __builtin_amdgcn_exp2f(-fabsf(z)));
                        const float spv = (i < l31) ? (fmaxf(z, 0.f) + l1p) : 0.f;
                        sp[r] = spv; lb[r] = (i < l31) ? (fminf(z, 0.f) - l1p) : -INFINITY; csum += spv;
                    }
                } else {
#pragma unroll
                    for (int r = 0; r < 16; ++r) {
                        const float z = S[r];
                        const float l1p = __builtin_amdgcn_logf(1.0f + __builtin_amdgcn_exp2f(-fabsf(z)));
                        const float spv = fmaxf(z, 0.f) + l1p;
                        sp[r] = spv; lb[r] = fminf(z, 0.f) - l1p; csum += spv;
                    }
                }
                f32x16 Rt;
#pragma unroll
                for (int r = 0; r < 16; ++r) Rt[r] = carry;
#pragma unroll
                for (int s = 0; s < 2; ++s) Rt = MFMA32(Tri[s], pack_frag(sp, s), Rt);
                f32x16 wv;
#pragma unroll
                for (int r = 0; r < 16; ++r) wv[r] = __builtin_amdgcn_exp2f(lb[r] - Rt[r]);
#pragma unroll
                for (int s = 0; s < 2; ++s) { const bf16x8 wp = pack_frag(wv, s);
#pragma unroll
                    for (int dt = 0; dt < 2; ++dt) O[dt] = MFMA32(Vf[s][dt], wp, O[dt]); }
                csum += __shfl_xor(csum, 32);
                carry += csum;
                if (__all(carry > 127.f)) break;
            }
            float ss = 0.f;
#pragma unroll
            for (int r = 0; r < 16; ++r) ss += O[0][r] * O[0][r] + O[1][r] * O[1][r];
            ss += __shfl_xor(ss, 32);
            const float rn = 1.0f / sqrtf(ss * (1.f / 64.f) + EPS);
#pragma unroll
            for (int dt = 0; dt < 2; ++dt)
#pragma unroll
                for (int g4 = 0; g4 < 4; ++g4) {
                    const int d = 32 * dt + 8 * g4 + 4 * hf;
                    const float4 gn = *(const float4*)(p.og + d);
                    uint2 w; w.x = pg8::cvt_pk_bf16(O[dt][4 * g4] * rn * gn.x, O[dt][4 * g4 + 1] * rn * gn.y); w.y = pg8::cvt_pk_bf16(O[dt][4 * g4 + 2] * rn * gn.z, O[dt][4 * g4 + 3] * rn * gn.w);
                    *(uint2*)(Kt + l31 * 144 + d * 2) = w;
                }
#pragma unroll
            for (int i = 0; i < 4; ++i) *(pg8::u32x4*)(ycat + (size_t)(q0 + 8 * i + r8) * 1024 + 512 + h * 64 + pc * 8) = *(const pg8::u32x4*)(Kt + (8 * i + r8) * 144 + pc * 16);
        }
    }
    xcd_barrier(bar);

    if (bid == 255 % G) for (int n = tid; n < 2048; n += 512) { float s = 0.f;
#pragma unroll
        for (int b8 = 0; b8 < 8; ++b8) s += bq_part[(size_t)b8 * 2048 + n];
        bias_q[n] = s; }
    if (G > 64 && bid >= 64) convert_tables(p.down, p.up, q8, dsc, lane, (bid - 64) * 8 + wave, (G - 64) * 8, CONV_SPLIT, 32768);
    else if (G <= 64) convert_tables(p.down, p.up, q8, dsc, lane, bid * 8 + wave, G * 8, CONV_SPLIT, 32768);
    for (int idx = bid * 512 + tid; idx < 32768; idx += G * 512) {
        const int h = idx >> 12;
        const float cd = exp2f(128.f * lg2_head(h));
        float s = 0.f;
        for (int n0 = 0; n0 < 128; n0 += 32) {
            float kvv[32];
#pragma unroll
            for (int q = 0; q < 32; ++q) kvv[q] = kv[(size_t)(n0 + q) * 32768 + idx];
#pragma unroll
            for (int q = 0; q < 32; ++q) { stT[(size_t)(n0 + q) * 32768 + idx] = f2bf(s); s = cd * s + kvv[q]; }
        }
    }
    xcd_barrier(bar);

    {
        const int gw = __builtin_amdgcn_readfirstlane(bid * 8 + wave), NGW = G * 8, l31 = lane & 31, hf = lane >> 5;
        const int wv4 = __builtin_amdgcn_readfirstlane(wave);
        for (int W2 = gw; W2 < 2048; W2 += NGW) {
            const int nh = W2 >> 1, n = nh >> 3, h = nh & 7;
            const float lg = lg2_head(h);
#pragma unroll 1
            for (int pass = 0; pass < 2; ++pass) {
                const int qt = (W2 & 1) ? (pass ? 2 : 1) : (pass ? 3 : 0);
                const int il = qt * 32 + l31, tq = n * 128 + il;
                unsigned char* Kt = lds + wv4 * 9216; unsigned char* Vt = Kt + 4608;
                const int r8 = lane >> 3, pc = lane & 7, trq = (lane & 15) >> 2, trp = lane & 3, trd = (lane >> 4) & 1;
                const unsigned loff = (unsigned)(r8 * 512 + pc * 8) * 2u;
                pg8::u32x4 gK[4], gV[4];
                bf16x8 Qf[4];
                {
                    const char* qbase = (const char*)(Qr + (size_t)(n * 128 + qt * 32) * 512 + h * 64);
                    const char* sbase = (const char*)(stT + (size_t)nh * 4096) + (unsigned)(r8 * 64 + pc * 8) * 2u;
#pragma unroll
                    for (int i = 0; i < 4; ++i) gK[i] = *(const pg8::u32x4*)(qbase + (loff + i * 8192u));
#pragma unroll
                    for (int i = 0; i < 4; ++i) *(pg8::u32x4*)(Kt + (8 * i + r8) * 144 + pc * 16) = gK[i];
#pragma unroll
                    for (int s = 0; s < 4; ++s) Qf[s] = *(const bf16x8*)(Kt + l31 * 144 + 32 * s + 16 * hf);
#pragma unroll
                    for (int i = 0; i < 4; ++i) { gK[i] = *(const pg8::u32x4*)(sbase + i * 1024u); gV[i] = *(const pg8::u32x4*)(sbase + 4096u + i * 1024u); }
#pragma unroll
                    for (int i = 0; i < 4; ++i) { *(pg8::u32x4*)(Kt + (8 * i + r8) * 144 + pc * 16) = gK[i]; *(pg8::u32x4*)(Kt + (32 + 8 * i + r8) * 144 + pc * 16) = gV[i]; }
                }
                f32x16 O[2];
#pragma unroll
                for (int r = 0; r < 16; ++r) { O[0][r] = 0.f; O[1][r] = 0.f; }
#pragma unroll
                for (int s = 0; s < 4; ++s)
#pragma unroll
                    for (int dt = 0; dt < 2; ++dt) O[dt] = MFMA32(*(const bf16x8*)(Kt + (32 * dt + l31) * 144 + 32 * s + 16 * hf), Qf[s], O[dt]);
                const float xi = exp2f((float)(il + 1) * lg);
#pragma unroll
                for (int r = 0; r < 16; ++r) { O[0][r] *= xi; O[1][r] *= xi; }
                const char* kbase = (const char*)(Kr + (size_t)n * 128 * 512 + h * 64); const char* vbase = (const char*)(Vr + (size_t)n * 128 * 512 + h * 64);
#pragma unroll
                for (int i = 0; i < 4; ++i) { gK[i] = *(const pg8::u32x4*)(kbase + (loff + i * 8192u)); gV[i] = *(const pg8::u32x4*)(vbase + (loff + i * 8192u)); }
                for (int jb = 0; jb <= qt; ++jb) {
#pragma unroll
                    for (int i = 0; i < 4; ++i) { *(pg8::u32x4*)(Kt + (8 * i + r8) * 144 + pc * 16) = gK[i]; *(pg8::u32x4*)(Vt + (8 * i + r8) * 144 + pc * 16) = gV[i]; }
                    { const int jn = (jb < qt) ? jb + 1 : jb;
#pragma unroll
                      for (int i = 0; i < 4; ++i) { gK[i] = *(const pg8::u32x4*)(kbase + (size_t)jn * 32768 + (loff + i * 8192u)); gV[i] = *(const pg8::u32x4*)(vbase + (size_t)jn * 32768 + (loff + i * 8192u)); } }
                    bf16x8 Kf[4], Vf[2][2];
#pragma unroll
                    for (int s = 0; s < 4; ++s) Kf[s] = *(const bf16x8*)(Kt + l31 * 144 + 32 * s + 16 * hf);
#pragma unroll
                    for (int s = 0; s < 2; ++s)
#pragma unroll
                        for (int dt = 0; dt < 2; ++dt) Vf[s][dt] = tr_frag(Vt + (16 * s + 4 * hf + trq) * 144 + (32 * dt + 16 * trd + 4 * trp) * 2, 8);
                    f32x16 S;
#pragma unroll
                    for (int r = 0; r < 16; ++r) S[r] = 0.f;
#pragma unroll
                    for (int s = 0; s < 4; ++s) S = MFMA32(Kf[s], Qf[s], S);
#pragma unroll
                    for (int r = 0; r < 16; ++r) {
                        const int jl = jb * 32 + (r & 3) + 8 * (r >> 2) + 4 * hf, dl = il - jl;
                        S[r] = (dl >= 0) ? S[r] * __builtin_amdgcn_exp2f((float)dl * lg) : 0.f;
                    }
#pragma unroll
                    for (int s = 0; s < 2; ++s) { const bf16x8 wp = pack_frag(S, s);
#pragma unroll
                        for (int dt = 0; dt < 2; ++dt) O[dt] = MFMA32(Vf[s][dt], wp, O[dt]); }
                }
                float sm = 0.f;
#pragma unroll
                for (int r = 0; r < 16; ++r) sm += O[0][r] + O[1][r];
                sm += __shfl_xor(sm, 32);
                const float mean = sm * (1.f / 64.f);
                float vs = 0.f;
#pragma unroll
                for (int r = 0; r < 16; ++r) { const float d0 = O[0][r] - mean, d1 = O[1][r] - mean; vs += d0 * d0 + d1 * d1; }
                vs += __shfl_xor(vs, 32);
                const float rstd = 1.0f / sqrtf(vs * (1.f / 64.f) + EPS);
                {
                    const char* gbase = (const char*)(Gr + (size_t)(n * 128 + qt * 32) * 512 + h * 64);
#pragma unroll
                    for (int i = 0; i < 4; ++i) gV[i] = *(const pg8::u32x4*)(gbase + (loff + i * 8192u));
#pragma unroll
                    for (int i = 0; i < 4; ++i) *(pg8::u32x4*)(Vt + (8 * i + r8) * 144 + pc * 16) = gV[i];
                }
#pragma unroll
                for (int dt = 0; dt < 2; ++dt)
#pragma unroll
                    for (int g4 = 0; g4 < 4; ++g4) {
                        const int e = 32 * dt + 8 * g4 + 4 * hf;
                        const float4 gn = *(const float4*)(p.rgain + h * 64 + e);
                        const uint2 gg = *(const uint2*)(Vt + l31 * 144 + e * 2);
                        const float g0 = __uint_as_float(gg.x << 16), g1 = __uint_as_float(gg.x & 0xffff0000u), g2v = __uint_as_float(gg.y << 16), g3 = __uint_as_float(gg.y & 0xffff0000u);
                        uint2 w;
                        w.x = pg8::cvt_pk_bf16((O[dt][4 * g4] - mean) * rstd * gn.x * g0, (O[dt][4 * g4 + 1] - mean) * rstd * gn.y * g1);
                        w.y = pg8::cvt_pk_bf16((O[dt][4 * g4 + 2] - mean) * rstd * gn.z * g2v, (O[dt][4 * g4 + 3] - mean) * rstd * gn.w * g3);
                        *(uint2*)(Kt + l31 * 144 + e * 2) = w;
                    }
#pragma unroll
                for (int i = 0; i < 4; ++i) *(pg8::u32x4*)(ycat + (size_t)(n * 128 + qt * 32 + 8 * i + r8) * 1024 + h * 64 + pc * 8) = *(const pg8::u32x4*)(Kt + (8 * i + r8) * 144 + pc * 16);
            }
        }
    }
    xcd_barrier(bar);

    {
        pg8::Gemm g{ycat, Wout_t, T, 1024, 1024}; pg8::StaticOrder S; S.init(T, 1024, G, bid);
        EpiOutprojMF E{xb, mod + 2048, x1b, part2};
        pg8::gemm_phase<EpiOutprojMF, pg8::StaticOrder>((PG8_LAS unsigned char*)lds, g, S, E);
    }
    xcd_barrier(bar);

    for (int round = 0; round < 2; ++round) {
        pg8::Gemm g{x1b, Weff_t, T, 2048, 1024}; OneUnitOrder S; S.base.init(T, 2048, G, bid); S.round = round;
        EpiTopkMF E{part2, bias_q, ids, gates};
        pg8::gemm_phase<EpiTopkMF, OneUnitOrder>((PG8_LAS unsigned char*)lds, g, S, E);
    }
    xcd_barrier(bar);

    {
        constexpr int IDS_LD = 136, ACT_LD = 136;
        const float* scale2 = mod + 4096; const float* shift2 = mod + 3072; const float* gate2 = mod + 5120;
        unsigned short* ids_l = (unsigned short*)lds; float* act_l = (float*)(lds + 32768);
        bf16_t* ds_l = (bf16_t*)(lds + 69632);
        const int t0 = bid * 64, tt = lane >> 3, sub = lane & 7, tl = wave * 8 + tt, t = t0 + tl;
        for (int e = tid; e < 1024; e += 512) { const int r = e >> 4, c8 = e & 15; *(uint4*)(ids_l + r * IDS_LD + c8 * 8) = *(const uint4*)(ids + (size_t)(t0 + r) * 128 + c8 * 8); }
        for (int e = tid; e < 64 * ACT_LD; e += 512) act_l[e] = 0.f;
        for (int e = tid; e < 4096; e += 512) ((uint4*)ds_l)[e] = ((const uint4*)dsc)[e];
        __syncthreads();
        float ri;
        { const float4* pp = (const float4*)(part2 + (size_t)t * 16); const float4 p0 = pp[0], p1 = pp[1], p2 = pp[2], p3 = pp[3];
          const float ssum = ((p0.x + p0.y) + (p0.z + p0.w)) + ((p1.x + p1.y) + (p1.z + p1.w)) + ((p2.x + p2.y) + (p2.z + p2.w)) + ((p3.x + p3.y) + (p3.z + p3.w));
          ri = 1.0f / sqrtf(ssum * (1.0f / D) + EPS); }
        const unsigned short* myids = ids_l + tl * IDS_LD;
        float* myact = act_l + tl * ACT_LD; int* myacc = (int*)myact;
        const bool s4 = (sub & 4) != 0, s2 = (sub & 2) != 0, s1 = (sub & 1) != 0;
        const unsigned suboff = (unsigned)sub * 16u;
        typedef float f32x2 __attribute__((ext_vector_type(2)));
        float hmax = 0.f;
        for (int c = 0; c < 4; ++c)
#pragma unroll
            for (int q = 0; q < 8; ++q) {
                const int col = 256 * c + 4 * sub + 32 * q;
                const uint2 xw = *(const uint2*)(x1b + (size_t)t * D + col); const float4 xv = make_float4(__uint_as_float(xw.x << 16), __uint_as_float(xw.x & 0xffff0000u), __uint_as_float(xw.y << 16), __uint_as_float(xw.y & 0xffff0000u));
                const float4 g = *(const float4*)(p.g2 + col), sc = *(const float4*)(scale2 + col), sh = *(const float4*)(shift2 + col);
                hmax = fmaxf(hmax, fmaxf(fmaxf(fabsf(xv.x * ri * g.x * (1.f + sc.x) + sh.x), fabsf(xv.y * ri * g.y * (1.f + sc.y) + sh.y)),
                                         fmaxf(fabsf(xv.z * ri * g.z * (1.f + sc.z) + sh.z), fabsf(xv.w * ri * g.w * (1.f + sc.w) + sh.w))));
            }
        hmax = fmaxf(hmax, __shfl_xor(hmax, 1)); hmax = fmaxf(hmax, __shfl_xor(hmax, 2)); hmax = fmaxf(hmax, __shfl_xor(hmax, 4));
        const float hinv = (hmax > 0.f) ? 127.0f / hmax : 0.f, hscale = hmax * (1.0f / 127.0f);
#define P9_LOAD(W, JB) do { const uint4 idv_ = *(const uint4*)(myids + 8 * (JB)); const unsigned idw_[4] = {idv_.x, idv_.y, idv_.z, idv_.w}; \
        _Pragma("unroll") for (int k_ = 0; k_ < 8; ++k_) { const unsigned id_ = (idw_[k_ >> 1] >> (16 * (k_ & 1))) & 0xffffu; W[k_] = *(const uint4*)(sbase + (id_ * 128u + suboff)); } } while (0)
#define P9_DOWN4(W, JB) do { int pd_[8]; \
        _Pragma("unroll") for (int k_ = 0; k_ < 8; ++k_) { const unsigned ww_[4] = {W[k_].x, W[k_].y, W[k_].z, W[k_].w}; int a0_ = 0, a1_ = 0; \
            _Pragma("unroll") for (int m_ = 0; m_ < 4; ++m_) { a0_ = __builtin_amdgcn_sdot4(hpe[m_], (int)(ww_[m_] & 0x0F0F0F0Fu), a0_, false); a1_ = __builtin_amdgcn_sdot4(hpo[m_], (int)((ww_[m_] >> 4) & 0x0F0F0F0Fu), a1_, false); } \
            pd_[k_] = a0_ + a1_ - hoff; } \
        int r4_[4], r2_[2]; \
        _Pragma("unroll") for (int k_ = 0; k_ < 4; ++k_) { const int snd_ = s4 ? pd_[k_] : pd_[k_ + 4], kp_ = s4 ? pd_[k_ + 4] : pd_[k_]; r4_[k_] = kp_ + __shfl_xor(snd_, 4); } \
        _Pragma("unroll") for (int k_ = 0; k_ < 2; ++k_) { const int snd_ = s2 ? r4_[k_] : r4_[k_ + 2], kp_ = s2 ? r4_[k_ + 2] : r4_[k_]; r2_[k_] = kp_ + __shfl_xor(snd_, 2); } \
        { const int snd_ = s1 ? r2_[0] : r2_[1], kp_ = s1 ? r2_[1] : r2_[0]; myacc[8 * (JB) + sub] += kp_ + __shfl_xor(snd_, 1); } } while (0)
        for (int c = 0; c < 4; ++c) {
            int hq[8][4];
#pragma unroll
            for (int q = 0; q < 8; ++q) {
                const int col = 256 * c + 4 * sub + 32 * q;
                const uint2 xw = *(const uint2*)(x1b + (size_t)t * D + col); const float4 xv = make_float4(__uint_as_float(xw.x << 16), __uint_as_float(xw.x & 0xffff0000u), __uint_as_float(xw.y << 16), __uint_as_float(xw.y & 0xffff0000u));
                const float4 g = *(const float4*)(p.g2 + col), sc = *(const float4*)(scale2 + col), sh = *(const float4*)(shift2 + col);
                hq[q][0] = (int)__builtin_rintf((xv.x * ri * g.x * (1.f + sc.x) + sh.x) * hinv); hq[q][1] = (int)__builtin_rintf((xv.y * ri * g.y * (1.f + sc.y) + sh.y) * hinv);
                hq[q][2] = (int)__builtin_rintf((xv.z * ri * g.z * (1.f + sc.z) + sh.z) * hinv); hq[q][3] = (int)__builtin_rintf((xv.w * ri * g.w * (1.f + sc.w) + sh.w) * hinv);
            }
            int hpe[4], hpo[4], hoff = 0;
#pragma unroll
            for (int m = 0; m < 4; ++m) {
                hpe[m] = (hq[2 * m][0] & 255) | ((hq[2 * m][2] & 255) << 8) | ((hq[2 * m + 1][0] & 255) << 16) | ((hq[2 * m + 1][2] & 255) << 24);
                hpo[m] = (hq[2 * m][1] & 255) | ((hq[2 * m][3] & 255) << 8) | ((hq[2 * m + 1][1] & 255) << 16) | ((hq[2 * m + 1][3] & 255) << 24);
            }
#pragma unroll
            for (int q = 0; q < 8; ++q) hoff += (hq[q][0] + hq[q][1]) + (hq[q][2] + hq[q][3]);
            hoff *= 8;
            const unsigned char* sbase = q8 + (size_t)c * (16384 * 128);
            uint4 wA[8], wB[8];
            P9_LOAD(wA, 0);
#pragma unroll 1
            for (int jb = 0; jb < 16; jb += 2) {
                P9_LOAD(wB, jb + 1);
                P9_DOWN4(wA, jb);
                if (jb + 2 < 16) P9_LOAD(wA, jb + 2);
                P9_DOWN4(wB, jb + 1);
            }
        }
#undef P9_DOWN4
        signed char* aq_l = (signed char*)(lds + 135168);
        float avv[16]; float amax = 0.f;
#pragma unroll
        for (int jb = 0; jb < 16; ++jb) {
            const int j = 8 * jb + sub; const unsigned id = myids[j];
            const float a = (float)myacc[j] * bf2f(ds_l[id]) * hscale;
            const float av = fabsf(a), tq = 1.0f / (av * 0.2316418882f + 1.0f);
            float ql = tq * 0.5307027145f + (-0.7265760135f); ql = ql * tq + 0.7107068705f; ql = ql * tq + (-0.142248368f); ql = ql * tq + 0.127414796f; ql = ql * tq;
            const float mm = a * (ql * exp2f(a * a * (-0.72134752044f)));
            const float ge = (a < 0.f) ? mm : (a - mm);
            avv[jb] = ge * gates[(size_t)t * 128 + j] * bf2f(ds_l[16384 + id]);
            amax = fmaxf(amax, fabsf(avv[jb]));
        }
        amax = fmaxf(amax, __shfl_xor(amax, 1)); amax = fmaxf(amax, __shfl_xor(amax, 2)); amax = fmaxf(amax, __shfl_xor(amax, 4));
        const float ainv = (amax > 0.f) ? 127.0f / amax : 0.f, ascale = amax * (1.0f / 127.0f);
        int aqsum = 0;
#pragma unroll
        for (int jb = 0; jb < 16; ++jb) { const int aqv = (int)__builtin_rintf(avv[jb] * ainv); aq_l[tl * 128 + 8 * jb + sub] = (signed char)aqv; aqsum += aqv; }
        aqsum += __shfl_xor(aqsum, 1); aqsum += __shfl_xor(aqsum, 2); aqsum += __shfl_xor(aqsum, 4);
        __syncthreads();
#define P9_PERM(HI, LO, SEL) __builtin_amdgcn_perm((HI), (LO), (SEL))
#define P9_T4(E0, E1, E2, E3, T0, T1, T2, T3) do { const unsigned p0_ = P9_PERM(E1, E0, 0x05010400u), p1_ = P9_PERM(E1, E0, 0x07030602u), p2_ = P9_PERM(E3, E2, 0x05010400u), p3_ = P9_PERM(E3, E2, 0x07030602u); \
        T0 = P9_PERM(p2_, p0_, 0x05040100u); T1 = P9_PERM(p2_, p0_, 0x07060302u); T2 = P9_PERM(p3_, p1_, 0x05040100u); T3 = P9_PERM(p3_, p1_, 0x07060302u); } while (0)
#define P9_UP4(W, JB) do { const uint2 aq8_ = *(const uint2*)(aq_l + tl * 128 + 8 * (JB)); const int aq4_[2] = {(int)aq8_.x, (int)aq8_.y}; \
        _Pragma("unroll") for (int g_ = 0; g_ < 2; ++g_) { \
            _Pragma("unroll") for (int m_ = 0; m_ < 4; ++m_) { \
                const unsigned w0_ = ((const unsigned*)&W[4 * g_ + 0])[m_], w1_ = ((const unsigned*)&W[4 * g_ + 1])[m_], w2_ = ((const unsigned*)&W[4 * g_ + 2])[m_], w3_ = ((const unsigned*)&W[4 * g_ + 3])[m_]; \
                unsigned t_[4]; \
                P9_T4(w0_, w1_, w2_, w3_, t_[0], t_[1], t_[2], t_[3]); \
                _Pragma("unroll") for (int k_ = 0; k_ < 4; ++k_) { \
                    oraw[4 * m_ + k_] = __builtin_amdgcn_sdot4(aq4_[g_], (int)t_[k_], oraw[4 * m_ + k_], false); \
                    olo[4 * m_ + k_] = __builtin_amdgcn_sdot4(aq4_[g_], (int)(t_[k_] & 0x0F0F0F0Fu), olo[4 * m_ + k_], false); } } } } while (0)
        for (int c = 0; c < 4; ++c) {
            int oraw[16], olo[16];
#pragma unroll
            for (int q = 0; q < 16; ++q) { oraw[q] = 0; olo[q] = 0; }
            const unsigned char* sbase = q8 + (8u << 20) + (size_t)c * (16384 * 128);
            uint4 wA[8], wB[8];
            P9_LOAD(wA, 0);
#pragma unroll 1
            for (int jb = 0; jb < 16; jb += 2) {
                P9_LOAD(wB, jb + 1);
                P9_UP4(wA, jb);
                if (jb + 2 < 16) P9_LOAD(wA, jb + 2);
                P9_UP4(wB, jb + 1);
            }
#pragma unroll
            for (int q = 0; q < 8; ++q) {
                const int col = 256 * c + 4 * sub + 32 * q;
                float* op = out + (size_t)t * D + col;
                const uint2 xw = *(const uint2*)(x1b + (size_t)t * D + col); const float4 xv = make_float4(__uint_as_float(xw.x << 16), __uint_as_float(xw.x & 0xffff0000u), __uint_as_float(xw.y << 16), __uint_as_float(xw.y & 0xffff0000u)); const float4 gt = *(const float4*)(gate2 + col);
                const int m = q >> 1, k0 = 2 * (q & 1);
                const int v0 = olo[4 * m + k0] - 8 * aqsum, v1 = (oraw[4 * m + k0] - olo[4 * m + k0]) >> 4, v2 = olo[4 * m + k0 + 1] - 8 * aqsum, v3 = (oraw[4 * m + k0 + 1] - olo[4 * m + k0 + 1]) >> 4;
                float4 r;
                r.x = xv.x + gt.x * ((float)v0 * ascale); r.y = xv.y + gt.y * ((float)v1 * ascale); r.z = xv.z + gt.z * ((float)v2 * ascale); r.w = xv.w + gt.w * ((float)v3 * ascale);
                *(float4*)op = r;
            }
        }
#undef P9_LOAD
#undef P9_UP4
#undef P9_T4
#undef P9_PERM
    }
}
}

extern "C" void kernel_launch(void* const* d_in, const int* in_sizes, int n_in, void* d_out, int out_size, void* d_ws, size_t ws_size, hipStream_t stream) {
    static int grid = 0;
    if (grid == 0) {
        int dev = 0, cus = 0, per_cu = 0;
        (void)hipGetDevice(&dev);
        (void)hipDeviceGetAttribute(&cus, hipDeviceAttributeMultiprocessorCount, dev);
        (void)hipFuncSetAttribute((const void*)mk_fwd, hipFuncAttributeMaxDynamicSharedMemorySize, LDS_BYTES);
        (void)hipOccupancyMaxActiveBlocksPerMultiprocessor(&per_cu, (const void*)mk_fwd, 512, LDS_BYTES);
        if (per_cu < 1 || cus != 256) { fprintf(stderr, "kernel_launch: needs 256 CUs with one resident workgroup each (cus %d, per_cu %d)\n", cus, per_cu); grid = -1; }
        else grid = cus;
    }
    if (grid < 0) return;
    (void)hipMemsetAsync((char*)d_ws + OFF_CTL, 0, CTL_BYTES, stream);
    Params p{};
    p.x = (const float*)d_in[0]; p.c = (const float*)d_in[1]; p.pos = (const int*)d_in[2]; p.ada_w = (const float*)d_in[3]; p.ada_b = (const float*)d_in[4];
    p.g1 = (const float*)d_in[5]; p.g2 = (const float*)d_in[6]; p.w_in = (const float*)d_in[7]; p.rgain = (const float*)d_in[8]; p.qg = (const float*)d_in[9];
    p.kg = (const float*)d_in[10]; p.og = (const float*)d_in[11]; p.w_out = (const float*)d_in[12]; p.wq = (const float*)d_in[13]; p.sk = (const float*)d_in[14];
    p.down = (const float*)d_in[15]; p.up = (const float*)d_in[16]; p.out = (float*)d_out; p.ws = (unsigned char*)d_ws;
    for (int i = 0; i < 32; ++i) {
        const double f = pow(10000.0, -(double)i / 32.0) / 6.283185307179586476925;
        float fh = (float)f; unsigned ub; memcpy(&ub, &fh, 4); ub &= 0xFFFFC000u; memcpy(&fh, &ub, 4);
        p.rc.fh[i] = fh; p.rc.fl[i] = (float)(f - (double)fh);
    }
    void* args[] = {&p};
    hipError_t e = hipLaunchCooperativeKernel((const void*)mk_fwd, dim3(grid), dim3(512), args, LDS_BYTES, stream);
    if (e != hipSuccess) fprintf(stderr, "kernel_launch: cooperative launch failed: %s (grid %d)\n", hipGetErrorString(e), grid);
}
```

```cpp
#include <hip/hip_runtime.h>
#include <stdint.h>
#include <math.h>
#include <cstdio>
#include <cstring>

namespace {
constexpr int T = 16384, D = 1024;
constexpr float EPS = 1e-6f;
typedef unsigned short bf16_t;
#define LAS __attribute__((address_space(3)))

__device__ __forceinline__ float bf2f(bf16_t b) { return __uint_as_float(((unsigned)b) << 16); }
__device__ __forceinline__ bf16_t f2bf(float f) { unsigned u = __float_as_uint(f); u += 0x7fffu + ((u >> 16) & 1u); return (bf16_t)(u >> 16); }
__device__ __forceinline__ float4 ld_nt4(const float* p) { typedef float f4v __attribute__((ext_vector_type(4))); const f4v v = __builtin_nontemporal_load((const f4v*)p); return make_float4(v[0], v[1], v[2], v[3]); }

__device__ __forceinline__ float lg2_head(int h) {
    const float x = __uint_as_float((unsigned)(127 - 5 - h) << 23);
    const float s = x * (1.f + x * (0.5f + x * (0.33333334f + x * (0.25f + x * (0.2f + x * 0.16666667f)))));
    return -s * 1.44269504089f;
}
struct RopeC { float fh[32], fl[32]; };
struct RetC { float lg2[8]; };

constexpr size_t MiB = 1u << 20;
constexpr size_t OFF_CTL = 0;
constexpr size_t CTL_BYTES = 64 * 1024;
constexpr size_t OFF_MOD = 64 * 1024, OFF_RINV1 = 128 * 1024, OFF_BIASF = 256 * 1024, OFF_ROPE = 1 * MiB;
constexpr size_t OFF_WINT = 6 * MiB;
constexpr size_t OFF_XB = 16 * MiB;
constexpr size_t OFF_YCAT = 160 * MiB;
constexpr size_t OFF_P = 48 * MiB;
constexpr size_t OFF_KV = 208 * MiB, OFF_ST = 224 * MiB;
constexpr size_t OFF_WEFFT = 240 * MiB;
constexpr size_t OFF_WOUTT = 13 * MiB;
constexpr size_t OFF_BIASQ = 272 * 1024;
constexpr size_t OFF_DSC = 512 * 1024;
constexpr size_t OFF_BQPART = 448 * 1024;
constexpr size_t OFF_PART2 = 5 * MiB;
constexpr size_t OFF_X1B = 208 * MiB;
constexpr size_t OFF_IDS = 244 * MiB, OFF_GATES = 248 * MiB;
constexpr size_t OFF_Q8 = 192 * MiB;
constexpr int CONV_SPLIT = 0;
constexpr int LDS_BYTES = 163840;
constexpr int LDS_ST_OFF = LDS_BYTES - 16;

#define XB_TMO      128
#define XB_XCNT(j)  (256  + 64 * (j))
#define XB_XSUB(j)  (1280 + 64 * (j))
#define XB_XGEN(j)  (2304 + 64 * (j))
#define XB_TOP      3328
#define XB_TOPGEN   3392
#define XCD_BAR_WORDS 3456
#define XB_SPIN_CAP (1u << 20)
__device__ __forceinline__ unsigned xb_ld(unsigned* p)              { return __hip_atomic_load(p, __ATOMIC_RELAXED, __HIP_MEMORY_SCOPE_AGENT); }
__device__ __forceinline__ unsigned xb_add(unsigned* p, unsigned v) { return __hip_atomic_fetch_add(p, v, __ATOMIC_RELAXED, __HIP_MEMORY_SCOPE_AGENT); }
__device__ __forceinline__ unsigned xb_xcc_id() { return (unsigned)__builtin_amdgcn_s_getreg((3 << 11) | 20) & 0xFu; }
#define XB_SPIN(cond, bar) do { unsigned _sp = 0; while (cond) { __builtin_amdgcn_s_sleep(1); \
    if ((++_sp & 255u) == 0u) { if (xb_ld(&(bar)[XB_TMO])) break; if (_sp > XB_SPIN_CAP) { atomicAdd(&(bar)[XB_TMO], 1u); break; } } } } while (0)
struct XcdBarrier { unsigned* bar; unsigned x; volatile LAS unsigned* st; };
__device__ __forceinline__ XcdBarrier xcd_barrier_post(unsigned* bar, volatile LAS unsigned* st) {
    XcdBarrier b; b.bar = bar; b.x = xb_xcc_id(); b.st = st;
    if (threadIdx.x == 0) (void)xb_add(&bar[XB_XCNT(b.x)], 1u);
    return b;
}
__device__ __forceinline__ void xcd_barrier_complete(unsigned* bar, unsigned x, unsigned& nloc, unsigned& nx) {
    const unsigned G = gridDim.x * gridDim.y * gridDim.z;
    unsigned sum, cnt, mine, sp = 0u;
    for (;;) {
        sum = 0u; cnt = 0u; mine = 0u;
#pragma unroll
        for (unsigned j = 0; j < 16; ++j) { const unsigned c = xb_ld(&bar[XB_XCNT(j)]); sum += c; cnt += (c > 0u) ? 1u : 0u; mine = (j == x) ? c : mine; }
        if (sum == G) break;
        __builtin_amdgcn_s_sleep(1);
        if ((++sp & 255u) == 0u) { if (xb_ld(&bar[XB_TMO])) break; if (sp > XB_SPIN_CAP) { atomicAdd(&bar[XB_TMO], 1u); break; } }
    }
    nloc = mine > 0u ? mine : 1u; nx = cnt > 0u ? cnt : 1u;
}
__device__ __forceinline__ void xcd_barrier(const XcdBarrier& b) {
    asm volatile("s_waitcnt vmcnt(0)" ::: "memory");
    __syncthreads();
    if (threadIdx.x == 0) {
        unsigned* bar = b.bar;
        __builtin_amdgcn_s_waitcnt(0);
        unsigned nloc = b.st[0], nx = b.st[1];
        if (nloc == 0u) { xcd_barrier_complete(bar, b.x, nloc, nx); b.st[0] = nloc; b.st[1] = nx; }
        const unsigned old = xb_add(&bar[XB_XSUB(b.x)], 1u);
        const unsigned gen = old / nloc;
        if (old + 1u == (gen + 1u) * nloc) {
            __builtin_amdgcn_fence(__ATOMIC_RELEASE, "agent");
            asm volatile("s_waitcnt vmcnt(0)" ::: "memory");
            const unsigned og = xb_add(&bar[XB_TOP], 1u);
            const unsigned tg = og / nx;
            if (og + 1u == (tg + 1u) * nx) xb_add(&bar[XB_TOPGEN], 1u);
            else XB_SPIN(xb_ld(&bar[XB_TOPGEN]) == tg, bar);
            __builtin_amdgcn_fence(__ATOMIC_ACQUIRE, "agent");
            xb_add(&bar[XB_XGEN(b.x)], 1u);
            asm volatile("s_waitcnt vmcnt(0)" ::: "memory");
        } else {
            XB_SPIN(xb_ld(&bar[XB_XGEN(b.x)]) == gen, bar);
            __builtin_amdgcn_fence(__ATOMIC_ACQUIRE, "agent");
            asm volatile("s_waitcnt vmcnt(0)" ::: "memory");
        }
    }
    __syncthreads();
}


namespace pg8 {
#define PG8_LAS __attribute__((address_space(3)))
typedef short bf16x8 __attribute__((ext_vector_type(8)));
typedef float f32x4 __attribute__((ext_vector_type(4)));
typedef unsigned u32x4 __attribute__((ext_vector_type(4)));
typedef unsigned u32x2 __attribute__((ext_vector_type(2)));
constexpr int BM = 256, BK = 64, HALF = 128, HTB = HALF * BK * 2, STAGE_BYTES = 8 * HTB, NXCD = 8, WGM = 8;
__host__ __device__ __forceinline__ int lds_byte(int r, int c) { const int st = (r >> 4) * 2 + (c >> 5), rr = r & 15, cc = c & 31, ob = rr * 64 + cc * 2; return st * 1024 + (ob ^ (((ob >> 9) & 1) << 5)); }
__host__ __device__ __forceinline__ void stage_rc(int b, int& R, int& C) { const int st = b / 1024, sb = b % 1024, swz = sb ^ (((sb >> 9) & 1) << 5); R = (st >> 1) * 16 + swz / 64; C = (st & 1) * 32 + (swz % 64) / 2; }
__host__ __device__ __forceinline__ int perm32(int rho) { const int n = rho >> 4, i = rho & 15; return 8 * (i >> 2) + 4 * n + (i & 3); }
struct Unit { int pm, pn; };
struct Gemm { const bf16_t* A; const bf16_t* Bt; int M, N, K; };
struct StaticOrder {
    int nM, nN, nwg, G, c;
    __host__ __device__ void init(int M, int N, int G_, int c_) { nM = M / BM; nN = N / BM; nwg = nM * nN; G = G_; c = c_; }
    __host__ __device__ bool next(int i, Unit& u) const {
        const long L = (long)i * G + c; if (L >= nwg) return false;
        int wgid = (int)L; { const int q = nwg / NXCD, r = nwg % NXCD, xcd = wgid % NXCD, off = wgid / NXCD; wgid = (xcd < r ? xcd * (q + 1) : r * (q + 1) + (xcd - r) * q) + off; }
        const int nig = WGM * nN, gid = wgid / nig, fm = gid * WGM, gsz = (nM - fm) < WGM ? (nM - fm) : WGM;
        u.pm = fm + ((wgid % nig) % gsz); u.pn = (wgid % nig) / gsz; return true;
    }
    __device__ __forceinline__ void a_ready(const Unit&) const {}
    __device__ __forceinline__ void done(const Unit&) const {}
};
__device__ __forceinline__ unsigned cvt_pk_bf16(float lo, float hi) { unsigned r; asm volatile("v_cvt_pk_bf16_f32 %0, %1, %2" : "=v"(r) : "v"(lo), "v"(hi)); return r; }

template <class Epi, class Sched>
__device__ __forceinline__ void gemm_phase(PG8_LAS unsigned char* lds, const Gemm g, const Sched& S, const Epi& E) {
    int tid_ = threadIdx.x; asm volatile("" : "+v"(tid_));
    const int tid = tid_, wid = __builtin_amdgcn_readfirstlane(tid >> 6), lane = tid & 63, wr = wid >> 2, wc = wid & 3, fr = lane & 15, fq = lane >> 4;
    const int K = g.K, nt = K / BK;
    unsigned voffA[2], voffB[2];
#pragma unroll
    for (int i = 0; i < 2; ++i) { int R, C; stage_rc(tid * 16 + i * 8192, R, C); const int Rb = Epi::PERM ? ((R & ~31) + perm32(R & 31)) : R;
        voffA[i] = (unsigned)(R * K + C) * 2u; voffB[i] = (unsigned)(Rb * K + C) * 2u; }
    const size_t kstep = (size_t)(BK * 2);
    const size_t hstep = (size_t)HALF * K * 2;
    const size_t tstep = 2 * hstep;
    const unsigned ldsw = (unsigned)wid * 1024u;
    const int aoff = lds_byte(wr * 64 + fr, fq * 8), boff = lds_byte(wc * 32 + fr, fq * 8);
#define PG8_SA(b, h) (((b) * 2 + (h)) * HTB)
#define PG8_SB(b, h) ((4 + (b) * 2 + (h)) * HTB)
#define PG8_STAGE(bufoff, gbase, voff) do { _Pragma("unroll") for (int _i = 0; _i < 2; ++_i) \
        __builtin_amdgcn_global_load_lds((const unsigned*)((const char*)(gbase) + (voff)[_i]), (PG8_LAS unsigned*)(lds + (bufoff) + ldsw + _i * 8192), 16, 0, 0); } while (0)
#define PG8_LDA(dst, b, h) do { _Pragma("unroll") for (int m = 0; m < 4; ++m) _Pragma("unroll") for (int k = 0; k < 2; ++k) dst[m][k] = *(const PG8_LAS bf16x8*)(lds + PG8_SA(b, h) + aoff + m * 2048 + k * 1024); } while (0)
#define PG8_LDB(dst, b, h) do { _Pragma("unroll") for (int n = 0; n < 2; ++n) _Pragma("unroll") for (int k = 0; k < 2; ++k) dst[n][k] = *(const PG8_LAS bf16x8*)(lds + PG8_SB(b, h) + boff + n * 2048 + k * 1024); } while (0)
#define PG8_MMA(ai, bj, At, Bt) do { __builtin_amdgcn_s_setprio(1); _Pragma("unroll") for (int m = 0; m < 4; ++m) _Pragma("unroll") for (int n = 0; n < 2; ++n) _Pragma("unroll") for (int k = 0; k < 2; ++k) \
        acc[ai][bj][m][n] = __builtin_amdgcn_mfma_f32_16x16x32_bf16(Bt[n][k], At[m][k], acc[ai][bj][m][n], 0, 0, 0); __builtin_amdgcn_s_setprio(0); } while (0)
#define PG8_WAIT_V(n) asm volatile("s_waitcnt vmcnt(" #n ")" ::: "memory")
#define PG8_WAIT_L(n) asm volatile("s_waitcnt lgkmcnt(" #n ")" ::: "memory")
#define PG8_BAR __builtin_amdgcn_s_barrier()
#define PG8_SCHED __builtin_amdgcn_sched_barrier(0)
    Unit cur, nxt; int ui = 0;
    if (!S.next(0, cur)) return;
    f32x4 acc[2][2][4][2];
#pragma unroll
    for (int a = 0; a < 2; ++a)
#pragma unroll
        for (int b = 0; b < 2; ++b)
#pragma unroll
            for (int m = 0; m < 4; ++m)
#pragma unroll
                for (int n = 0; n < 2; ++n) acc[a][b][m][n] = (f32x4){0.f, 0.f, 0.f, 0.f};
    bf16x8 At[4][2], B0[2][2], B1[2][2];
    const char* cA = (const char*)g.A + (size_t)cur.pm * tstep; const char* cB = (const char*)g.Bt + (size_t)cur.pn * tstep;
    S.a_ready(cur);
    PG8_STAGE(PG8_SB(0, 0), cB, voffB); PG8_STAGE(PG8_SA(0, 0), cA, voffA); PG8_STAGE(PG8_SB(0, 1), cB + hstep, voffB); PG8_STAGE(PG8_SA(0, 1), cA + hstep, voffA);
    if (wr == 1) PG8_BAR;
    PG8_WAIT_V(4); PG8_BAR;
    PG8_STAGE(PG8_SB(1, 0), cB + kstep, voffB); PG8_STAGE(PG8_SA(1, 0), cA + kstep, voffA); PG8_STAGE(PG8_SB(1, 1), cB + hstep + kstep, voffB);
    PG8_WAIT_V(6); PG8_BAR;
    for (;;) {
        const bool has_next = S.next(ui + 1, nxt);
        const char* nA = has_next ? (const char*)g.A + (size_t)nxt.pm * tstep : cA; const char* nB = has_next ? (const char*)g.Bt + (size_t)nxt.pn * tstep : cB;
        for (int t = 0; t < nt; t += 2) {
            const bool last = (t == nt - 2);
            const char* a1 = cA + (size_t)(t + 1) * kstep;
            const char* a2 = last ? nA : cA + (size_t)(t + 2) * kstep; const char* b2 = last ? nB : cB + (size_t)(t + 2) * kstep;
            const char* a3 = a2 + kstep; const char* b3 = b2 + kstep;
            if (last && has_next) S.a_ready(nxt);
            PG8_LDB(B0, 0, 0); PG8_SCHED; PG8_LDA(At, 0, 0); PG8_STAGE(PG8_SA(1, 1), a1 + hstep, voffA);
            PG8_WAIT_L(8); PG8_BAR; PG8_WAIT_L(0); PG8_MMA(0, 0, At, B0); PG8_BAR; PG8_SCHED;
            PG8_LDB(B1, 0, 1); PG8_STAGE(PG8_SB(0, 0), b2, voffB);
            PG8_BAR; PG8_WAIT_L(0); PG8_MMA(0, 1, At, B1); PG8_BAR;
            PG8_LDA(At, 0, 1); PG8_STAGE(PG8_SA(0, 0), a2, voffA);
            PG8_BAR; PG8_WAIT_L(0); PG8_MMA(1, 0, At, B0); PG8_BAR; PG8_SCHED;
            PG8_STAGE(PG8_SB(0, 1), b2 + hstep, voffB);
            PG8_WAIT_V(6); PG8_BAR; PG8_MMA(1, 1, At, B1); PG8_BAR;
            PG8_LDB(B0, 1, 0); PG8_SCHED; PG8_LDA(At, 1, 0); PG8_STAGE(PG8_SA(0, 1), a2 + hstep, voffA);
            PG8_WAIT_L(8); PG8_BAR; PG8_WAIT_L(0); PG8_MMA(0, 0, At, B0); PG8_BAR; PG8_SCHED;
            PG8_LDB(B1, 1, 1); PG8_STAGE(PG8_SB(1, 0), b3, voffB);
            PG8_BAR; PG8_WAIT_L(0); PG8_MMA(0, 1, At, B1); PG8_BAR;
            PG8_LDA(At, 1, 1); PG8_STAGE(PG8_SA(1, 0), a3, voffA);
            PG8_BAR; PG8_WAIT_L(0); PG8_MMA(1, 0, At, B0); PG8_BAR; PG8_SCHED;
            PG8_STAGE(PG8_SB(1, 1), b3 + hstep, voffB);
            PG8_WAIT_V(6); PG8_BAR; PG8_MMA(1, 1, At, B1); PG8_BAR;
        }
        if constexpr (!Epi::AFTER_DRAIN) { E(acc, cur, wr, wc, fr, fq); S.done(cur); }
        if (!has_next) break;
#pragma unroll
        for (int a = 0; a < 2; ++a)
#pragma unroll
            for (int b = 0; b < 2; ++b)
#pragma unroll
                for (int m = 0; m < 4; ++m)
#pragma unroll
                    for (int n = 0; n < 2; ++n) acc[a][b][m][n] = (f32x4){0.f, 0.f, 0.f, 0.f};
        cur = nxt; cA = nA; cB = nB; ++ui;
    }
    PG8_WAIT_V(0);
    if (wr == 0) PG8_BAR;
    PG8_BAR;
    if constexpr (Epi::AFTER_DRAIN) { E.fused(acc, cur, wr, wc, fr, fq, lds, wid, lane); S.done(cur); }
#undef PG8_SA
#undef PG8_SB
#undef PG8_STAGE
#undef PG8_LDA
#undef PG8_LDB
#undef PG8_MMA
#undef PG8_WAIT_V
#undef PG8_WAIT_L
#undef PG8_BAR
#undef PG8_SCHED
}
}

__host__ __device__ __forceinline__ int cmap_in(int F) { return (F & ~255) + 128 * ((F >> 5) & 1) + 32 * ((F >> 6) & 3) + (F & 31); }
struct EpiInprojMF {
    static constexpr bool PERM = true, AFTER_DRAIN = false;
    bf16_t* P; const float* rinv; const float* bias_f; const int* pos; const float* ftab; const float* qg; const float* kg;
    __device__ __forceinline__ void operator()(const pg8::f32x4 (&acc)[2][2][4][2], const pg8::Unit& u, int wr, int wc, int fr, int fq) const {
        typedef pg8::f32x4 f32x4;
        asm volatile("" : "+v"(fr), "+v"(fq));
        const int type = u.pn >> 1, head = 4 * (u.pn & 1) + wc, fb = 256 * u.pn + 64 * wc;
        const size_t PSZ = (size_t)T * 512;
        const int rslot = (type == 0) ? 0 : (type == 1) ? 1 : (type == 2) ? 5 : (type == 3) ? 2 : (type == 4) ? 3 : (type == 5) ? 4 : 6;
        bf16_t* rowmaj = P + (size_t)rslot * PSZ;
        const int t0 = u.pm * 256 + wr * 64 + fr;
        f32x4 bv[2][2], gv[2][2], fh[2], fl[2];
#pragma unroll
        for (int bj = 0; bj < 2; ++bj)
#pragma unroll
            for (int n = 0; n < 2; ++n) bv[bj][n] = *(const f32x4*)(bias_f + fb + 32 * bj + 8 * fq + 4 * n);
        if (type <= 1) {
#pragma unroll
            for (int n = 0; n < 2; ++n) { fh[n] = *(const f32x4*)(ftab + 8 * fq + 4 * n); fl[n] = *(const f32x4*)(ftab + 32 + 8 * fq + 4 * n); }
        } else if (type == 4 || type == 5) {
            const float* gsrc = (type == 4) ? qg : kg;
#pragma unroll
            for (int bj = 0; bj < 2; ++bj)
#pragma unroll
                for (int n = 0; n < 2; ++n) gv[bj][n] = *(const f32x4*)(gsrc + 32 * bj + 8 * fq + 4 * n);
        }
#pragma unroll
        for (int ai = 0; ai < 2; ++ai) {
            float rv[4], pf[4];
#pragma unroll
            for (int m = 0; m < 4; ++m) { rv[m] = rinv[t0 + ai * 128 + m * 16]; pf[m] = (float)pos[t0 + ai * 128 + m * 16]; }
            asm volatile("" : "+v"(rv[0]), "+v"(rv[1]), "+v"(rv[2]), "+v"(rv[3]), "+v"(pf[0]), "+v"(pf[1]), "+v"(pf[2]), "+v"(pf[3]));
#pragma unroll
            for (int m = 0; m < 4; ++m) {
                const int t = t0 + ai * 128 + m * 16;
                const float r = rv[m];
                f32x4 v[2][2];
#pragma unroll
                for (int bj = 0; bj < 2; ++bj)
#pragma unroll
                    for (int n = 0; n < 2; ++n) v[bj][n] = acc[ai][bj][m][n] * r + bv[bj][n];
                if (type <= 1) {
                    const float sc = (type == 1) ? 0.125f : 1.f, pp = pf[m];
#pragma unroll
                    for (int n = 0; n < 2; ++n)
#pragma unroll
                        for (int j = 0; j < 4; ++j) {
                            const float rev = __builtin_amdgcn_fractf(__builtin_amdgcn_fractf(pp * fh[n][j]) + pp * fl[n][j]);
                            const float cs = __builtin_amdgcn_cosf(rev) * sc, sn = __builtin_amdgcn_sinf(rev) * sc;
                            const float x1 = v[0][n][j], x2 = v[1][n][j]; v[0][n][j] = x1 * cs - x2 * sn; v[1][n][j] = x2 * cs + x1 * sn;
                        }
                } else if (type == 3) {
#pragma unroll
                    for (int bj = 0; bj < 2; ++bj)
#pragma unroll
                        for (int n = 0; n < 2; ++n)
#pragma unroll
                            for (int j = 0; j < 4; ++j) { const float x = v[bj][n][j]; v[bj][n][j] = x / (1.f + __expf(-x)); }
                } else if (type == 4 || type == 5) {
                    float ss = 0.f;
#pragma unroll
                    for (int bj = 0; bj < 2; ++bj)
#pragma unroll
                        for (int n = 0; n < 2; ++n)
#pragma unroll
                            for (int j = 0; j < 4; ++j) ss += v[bj][n][j] * v[bj][n][j];
                    ss += __shfl_xor(ss, 16); ss += __shfl_xor(ss, 32);
                    const float rn = (1.0f / sqrtf(ss * (1.f / 64.f) + EPS)) * ((type == 4) ? 0.125f * 1.44269504089f : 1.f);
#pragma unroll
                    for (int bj = 0; bj < 2; ++bj)
#pragma unroll
                        for (int n = 0; n < 2; ++n) v[bj][n] = v[bj][n] * rn * gv[bj][n];
                }
#pragma unroll
                for (int bj = 0; bj < 2; ++bj) {
                    pg8::u32x4 w; w.x = pg8::cvt_pk_bf16(v[bj][0][0], v[bj][0][1]); w.y = pg8::cvt_pk_bf16(v[bj][0][2], v[bj][0][3]);
                    w.z = pg8::cvt_pk_bf16(v[bj][1][0], v[bj][1][1]); w.w = pg8::cvt_pk_bf16(v[bj][1][2], v[bj][1][3]);
                    *(pg8::u32x4*)(rowmaj + (size_t)t * 512 + head * 64 + 32 * bj + 8 * fq) = w;
                }
            }
        }
    }
};

struct EpiOutprojMF {
    static constexpr bool PERM = false, AFTER_DRAIN = true;
    const bf16_t* xb; const float* gate1; bf16_t* x1b; float* part2;
    __device__ __forceinline__ void operator()(const pg8::f32x4 (&)[2][2][4][2], const pg8::Unit&, int, int, int, int) const {}
    __device__ __forceinline__ void fused(pg8::f32x4 (&acc)[2][2][4][2], const pg8::Unit& u, int wr, int wc, int fr, int fq, PG8_LAS unsigned char* lds, int wid, int lane) const {
        typedef pg8::f32x4 f32x4;
        asm volatile("" : "+v"(fr), "+v"(fq), "+v"(lane));
        constexpr int LD = 260;
        PG8_LAS float* TL = (PG8_LAS float*)lds;
        const int colw = wc * 32 + 4 * fq;
        f32x4 gv[2][2];
#pragma unroll
        for (int bj = 0; bj < 2; ++bj)
#pragma unroll
            for (int n = 0; n < 2; ++n) gv[bj][n] = *(const f32x4*)(gate1 + u.pn * 256 + colw + bj * 128 + n * 16);
#pragma unroll
        for (int ai = 0; ai < 2; ++ai) {
#pragma unroll
            for (int m = 0; m < 4; ++m)
#pragma unroll
                for (int bj = 0; bj < 2; ++bj)
#pragma unroll
                    for (int n = 0; n < 2; ++n) *(PG8_LAS f32x4*)(TL + (64 * wr + 16 * m + fr) * LD + colw + bj * 128 + n * 16) = gv[bj][n] * acc[ai][bj][m][n];
            __syncthreads();
            pg8::u32x2 xv[2];
            const size_t rowbase = (size_t)(u.pm * 256 + ai * 128 + 16 * wid) * D + u.pn * 256 + 4 * lane;
            xv[0] = *(const pg8::u32x2*)(xb + rowbase);
#pragma unroll
            for (int r = 0; r < 16; ++r) {
                if (r < 15) xv[(r + 1) & 1] = *(const pg8::u32x2*)(xb + rowbase + (size_t)(r + 1) * D);
                const f32x4 g = *(PG8_LAS f32x4*)(TL + (16 * wid + r) * LD + 4 * lane);
                const pg8::u32x2 xw = xv[r & 1];
                f32x4 o; o[0] = __uint_as_float(xw.x << 16) + g[0]; o[1] = __uint_as_float(xw.x & 0xffff0000u) + g[1]; o[2] = __uint_as_float(xw.y << 16) + g[2]; o[3] = __uint_as_float(xw.y & 0xffff0000u) + g[3];
                pg8::u32x2 w; w.x = pg8::cvt_pk_bf16(o[0], o[1]); w.y = pg8::cvt_pk_bf16(o[2], o[3]);
                *(pg8::u32x2*)(x1b + rowbase + (size_t)r * D) = w;
                float ss = o[0] * o[0] + o[1] * o[1] + o[2] * o[2] + o[3] * o[3];
#pragma unroll
                for (int o2 = 32; o2 > 0; o2 >>= 1) ss += __shfl_xor(ss, o2);
                if (lane < 4) part2[(size_t)(u.pm * 256 + ai * 128 + 16 * wid + r) * 16 + u.pn * 4 + lane] = (lane == 0) ? ss : 0.f;
            }
            __syncthreads();
        }
    }
};

__device__ __forceinline__ unsigned pk2(float lo, float hi) { return (unsigned)f2bf(lo) | ((unsigned)f2bf(hi) << 16); }
template <bool FOLD, bool CMAP>
__device__ __forceinline__ void transpose_item(const float* W, int K, int N, bf16_t* WT, float* scr, int item, int lane, const float* sg, const float* sm) {
    const int nblk = N / 32, kb = item / nblk, nb = item % nblk, k0 = 64 * kb, n0 = 32 * nb;
    float4 v[8]; float f[8];
#pragma unroll
    for (int i = 0; i < 8; ++i) { const int kk = 8 * i + (lane >> 3); v[i] = *(const float4*)(W + (size_t)(k0 + kk) * N + n0 + 4 * (lane & 7));
        f[i] = FOLD ? sg[k0 + kk] * (1.f + sm[k0 + kk]) : 1.f; }
#pragma unroll
    for (int i = 0; i < 8; ++i) { const int kk = 8 * i + (lane >> 3); float* d = scr + kk * 33 + 4 * (lane & 7);
        d[0] = v[i].x * f[i]; d[1] = v[i].y * f[i]; d[2] = v[i].z * f[i]; d[3] = v[i].w * f[i]; }
    asm volatile("s_waitcnt lgkmcnt(0)" ::: "memory");
    const int c = lane & 7, r0 = CMAP ? cmap_in(n0) : n0;
#pragma unroll
    for (int j = 0; j < 4; ++j) { const int n = (lane >> 3) + 8 * j; const float* s = scr + (8 * c) * 33 + n;
        pg8::u32x4 o; o.x = pk2(s[0 * 33], s[1 * 33]); o.y = pk2(s[2 * 33], s[3 * 33]); o.z = pk2(s[4 * 33], s[5 * 33]); o.w = pk2(s[6 * 33], s[7 * 33]);
        *(pg8::u32x4*)(WT + (size_t)(r0 + n) * K + k0 + 8 * c) = o; }
    asm volatile("s_waitcnt lgkmcnt(0)" ::: "memory");
}
template <int NC4, class VF>
__device__ __forceinline__ void gemv_cols(unsigned char* lds, const VF vf, const float* W, const int N, const int u, float* dst, const float* add) {
    constexpr int RG = 512 / NC4;
    float (*red)[NC4 * 4] = (float (*)[NC4 * 4])lds;
    const int tid = threadIdx.x, c4 = tid % NC4, rg = tid / NC4;
    if (rg < RG) {
        float4 acc = {0.f, 0.f, 0.f, 0.f};
        for (int r = rg; r < 1024; r += RG) { const float s = vf(r); const float4 w = *(const float4*)(W + (size_t)r * N + u * NC4 * 4 + c4 * 4);
            acc.x += s * w.x; acc.y += s * w.y; acc.z += s * w.z; acc.w += s * w.w; }
        red[rg][c4 * 4 + 0] = acc.x; red[rg][c4 * 4 + 1] = acc.y; red[rg][c4 * 4 + 2] = acc.z; red[rg][c4 * 4 + 3] = acc.w;
    }
    __syncthreads();
    if (tid < NC4 * 4) { float s = 0.f; for (int i = 0; i < RG; ++i) s += red[i][tid]; dst[u * NC4 * 4 + tid] = s + (add ? add[u * NC4 * 4 + tid] : 0.f); }
    __syncthreads();
}
struct VfSilu { const float* c; __device__ __forceinline__ float operator()(int r) const { const float v = c[r]; return v / (1.f + expf(-v)); } };
struct VfVec { const float* v; __device__ __forceinline__ float operator()(int r) const { return v[r]; } };


typedef float f32x16 __attribute__((ext_vector_type(16)));
typedef pg8::bf16x8 bf16x8;
#define MFMA32(a, b, c) __builtin_amdgcn_mfma_f32_32x32x16_bf16((a), (b), (c), 0, 0, 0)
__device__ __forceinline__ bf16x8 pack_frag(const f32x16& v, int s) {
    pg8::u32x4 w;
    w.x = pg8::cvt_pk_bf16(v[8 * s + 0], v[8 * s + 1]); w.y = pg8::cvt_pk_bf16(v[8 * s + 2], v[8 * s + 3]);
    w.z = pg8::cvt_pk_bf16(v[8 * s + 4], v[8 * s + 5]); w.w = pg8::cvt_pk_bf16(v[8 * s + 6], v[8 * s + 7]);
    return __builtin_bit_cast(bf16x8, w);
}
__device__ __forceinline__ bf16x8 load_tfrag(const bf16_t* rowp, int tok) {
    const uint2 a = *(const uint2*)(rowp + tok), b = *(const uint2*)(rowp + tok + 8);
    pg8::u32x4 w; w.x = a.x; w.y = a.y; w.z = b.x; w.w = b.y;
    return __builtin_bit_cast(bf16x8, w);
}


__device__ __forceinline__ bf16x8 tr_frag(const unsigned char* a0, int rows2) {
    typedef short s16x4 __attribute__((ext_vector_type(4)));
    typedef __attribute__((address_space(3))) s16x4 lds_s16x4;
    const s16x4 lo = __builtin_amdgcn_ds_read_tr16_b64_v4i16((lds_s16x4*)a0);
    const s16x4 hi = __builtin_amdgcn_ds_read_tr16_b64_v4i16((lds_s16x4*)(a0 + rows2 * 144));
    const uint2 l2 = __builtin_bit_cast(uint2, lo), h2 = __builtin_bit_cast(uint2, hi);
    pg8::u32x4 fw; fw.x = l2.x; fw.y = l2.y; fw.z = h2.x; fw.w = h2.y;
    return __builtin_bit_cast(bf16x8, fw);
}

__device__ __forceinline__ void ins16(float (&s)[16], float x) {
#pragma unroll
    for (int i = 15; i >= 1; --i) s[i] = __builtin_amdgcn_fmed3f(s[i - 1], s[i], x);
    s[0] = fmaxf(s[0], x);
}


struct OneUnitOrder {
    pg8::StaticOrder base; int round;
    __device__ __forceinline__ bool next(int i, pg8::Unit& u) const { if (i != 0) return false; return base.next(round, u); }
    __device__ __forceinline__ void a_ready(const pg8::Unit&) const {}
    __device__ __forceinline__ void done(const pg8::Unit&) const {}
};
struct EpiTopkMF {
    static constexpr bool PERM = false, AFTER_DRAIN = true;
    const float* part2; const float* bias_q; unsigned short* ids; float* gates;
    __device__ __forceinline__ void operator()(const pg8::f32x4 (&)[2][2][4][2], const pg8::Unit&, int, int, int, int) const {}
    __device__ __forceinline__ void fused(pg8::f32x4 (&acc)[2][2][4][2], const pg8::Unit& u, int wr, int wc, int fr, int fq, PG8_LAS unsigned char* lds, int wid, int lane) const {
        typedef pg8::f32x4 f32x4;
        constexpr int SLD = 260;
        PG8_LAS float* SC = (PG8_LAS float*)lds; PG8_LAS float* MG = (PG8_LAS float*)(lds + 128 * SLD * 4);
        const int tid = wid * 64 + lane, tok = tid & 255, hk = tid >> 8;
        float rinv[2][4];
#pragma unroll
        for (int ai = 0; ai < 2; ++ai)
#pragma unroll
            for (int m = 0; m < 4; ++m) {
                const int row = u.pm * 256 + ai * 128 + wr * 64 + m * 16 + fr;
                const f32x4* pp = (const f32x4*)(part2 + (size_t)row * 16);
                const f32x4 p0 = pp[0], p1 = pp[1], p2 = pp[2], p3 = pp[3];
                const float ssum = ((p0[0] + p0[1]) + (p0[2] + p0[3])) + ((p1[0] + p1[1]) + (p1[2] + p1[3])) + ((p2[0] + p2[1]) + (p2[2] + p2[3])) + ((p3[0] + p3[1]) + (p3[2] + p3[3]));
                rinv[ai][m] = 1.0f / sqrtf(ssum * (1.0f / D) + EPS);
            }
        float sl[16], mine[16];
#pragma unroll
        for (int p = 0; p < 2; ++p) {
            f32x4 bv[2];
#pragma unroll
            for (int n = 0; n < 2; ++n) bv[n] = *(const f32x4*)(bias_q + u.pn * 256 + p * 128 + wc * 32 + n * 16 + 4 * fq);
#pragma unroll
            for (int ai = 0; ai < 2; ++ai)
#pragma unroll
                for (int m = 0; m < 4; ++m)
#pragma unroll
                    for (int n = 0; n < 2; ++n)
#pragma unroll
                        for (int j = 0; j < 4; ++j)
                            SC[(32 * wc + 16 * n + 4 * fq + j) * SLD + (128 * ai + 64 * wr + 16 * m + fr)] = acc[ai][p][m][n][j] * rinv[ai][m] + bv[n][j];
            __syncthreads();
#pragma unroll
            for (int i = 0; i < 16; ++i) sl[i] = -INFINITY;
#pragma unroll 8
            for (int k = 0; k < 64; ++k) { const int key = 64 * hk + k; const float x = SC[key * SLD + tok]; ins16(sl, __uint_as_float((__float_as_uint(x) & 0xFFFFFF80u) | (unsigned)key)); }
            if (hk != p) {
#pragma unroll
                for (int i = 0; i < 16; ++i) MG[i * 256 + tok] = sl[i];
            }
            __syncthreads();
            if (hk == p) {
#pragma unroll
                for (int i = 0; i < 16; ++i) ins16(sl, MG[i * 256 + tok]);
#pragma unroll
                for (int i = 0; i < 16; ++i) mine[i] = sl[i];
            }
            __syncthreads();
        }
        PG8_LAS float* X1 = SC; PG8_LAS float* TL = SC + 4096; PG8_LAS unsigned* I0 = (PG8_LAS unsigned*)(SC + 8192); PG8_LAS unsigned* I1 = (PG8_LAS unsigned*)(SC + 12288);
        if (hk) {
#pragma unroll
            for (int i = 0; i < 16; ++i) { X1[i * 256 + tok] = mine[i]; I1[i * 256 + tok] = __float_as_uint(mine[i]) & 0x7Fu; }
        } else {
#pragma unroll
            for (int i = 0; i < 16; ++i) I0[i * 256 + tok] = __float_as_uint(mine[i]) & 0x7Fu;
        }
        __syncthreads();
        if (!hk) {
            float s1m[16], tl[16];
#pragma unroll
            for (int i = 0; i < 16; ++i) { s1m[i] = __uint_as_float(__float_as_uint(X1[i * 256 + tok]) & 0xFFFFFF80u); mine[i] = __uint_as_float(__float_as_uint(mine[i]) & 0xFFFFFF80u); tl[i] = -INFINITY; }
#pragma unroll
            for (int a2 = 0; a2 < 16; ++a2)
#pragma unroll
                for (int b2 = 0; b2 < 16; ++b2)
                    if ((a2 + 1) * (b2 + 1) <= 16) ins16(tl, __uint_as_float((__float_as_uint(mine[a2] + s1m[b2]) & 0xFFFFFF00u) | (unsigned)(a2 * 16 + b2)));
#pragma unroll
            for (int i = 0; i < 16; ++i) TL[i * 256 + tok] = tl[i];
        }
        __syncthreads();
        if (hk) {
            float ev[16]; float sum = 0.f; unsigned cd[16];
#pragma unroll
            for (int j = 0; j < 16; ++j) { const unsigned bits = __float_as_uint(TL[j * 256 + tok]); cd[j] = bits & 0xFFu; ev[j] = __uint_as_float(bits & 0xFFFFFF00u); }
            const float mx = ev[0];
#pragma unroll
            for (int j = 0; j < 16; ++j) { ev[j] = __expf(ev[j] - mx); sum += ev[j]; }
            const float inv = 1.f / sum;
            unsigned idw[8];
#pragma unroll
            for (int j = 0; j < 16; ++j) {
                const unsigned id = I0[(cd[j] >> 4) * 256 + tok] * 128u + I1[(cd[j] & 15u) * 256 + tok];
                if (j & 1) idw[j >> 1] |= id << 16; else idw[j >> 1] = id;
                ev[j] *= inv;
            }
            const size_t t = (size_t)u.pm * 256 + tok;
            unsigned short* idp = ids + t * 128 + u.pn * 16; float* gp = gates + t * 128 + u.pn * 16;
            *(uint4*)idp = make_uint4(idw[0], idw[1], idw[2], idw[3]); *(uint4*)(idp + 8) = make_uint4(idw[4], idw[5], idw[6], idw[7]);
#pragma unroll
            for (int q = 0; q < 4; ++q) *(float4*)(gp + 4 * q) = make_float4(ev[4 * q], ev[4 * q + 1], ev[4 * q + 2], ev[4 * q + 3]);
        }
        __syncthreads();
    }
};


__device__ __forceinline__ void convert_tables(const float* down, const float* up, unsigned char* q8, bf16_t* dsc, int lane, int cw, int nconv, int r0, int r1) {
    for (int row0 = r0 + cw * 2; row0 < r1; row0 += nconv * 2) {
        float4 v[2][4];
#pragma unroll
        for (int rr = 0; rr < 2; ++rr) {
            const int row = row0 + rr, isup = row >> 14, e = row & 16383;
            const float* sp = (isup ? up : down) + (size_t)e * 1024 + lane * 4;
#pragma unroll
            for (int q = 0; q < 4; ++q) v[rr][q] = ld_nt4(sp + 256 * q);
        }
#pragma unroll
        for (int rr = 0; rr < 2; ++rr) {
            const int row = row0 + rr, isup = row >> 14, e = row & 16383;
            {
                float ss = 0.f;
#pragma unroll
                for (int q = 0; q < 4; ++q) ss += v[rr][q].x * v[rr][q].x + v[rr][q].y * v[rr][q].y + v[rr][q].z * v[rr][q].z + v[rr][q].w * v[rr][q].w;
#pragma unroll
                for (int o = 32; o > 0; o >>= 1) ss += __shfl_xor(ss, o);
                const float sigma = sqrtf(ss * (1.0f / 1024.0f));
                const float s = (sigma > 0.f) ? 7.5f / (2.6f * sigma) : 1.f;
#pragma unroll
                for (int q = 0; q < 4; ++q) {
                    const int n0 = (int)fminf(fmaxf(__builtin_rintf(v[rr][q].x * s), -8.f), 7.f) + 8, n1 = (int)fminf(fmaxf(__builtin_rintf(v[rr][q].y * s), -8.f), 7.f) + 8;
                    const int n2 = (int)fminf(fmaxf(__builtin_rintf(v[rr][q].z * s), -8.f), 7.f) + 8, n3 = (int)fminf(fmaxf(__builtin_rintf(v[rr][q].w * s), -8.f), 7.f) + 8;
                    const int h1 = isup ? ((n1 - 8) & 15) : n1, h3 = isup ? ((n3 - 8) & 15) : n3;
                    *(unsigned short*)(q8 + (size_t)isup * (8u << 20) + ((size_t)q * 16384 + e) * 128 + (lane & 7) * 16 + (lane >> 3) * 2) = (unsigned short)(n0 | (h1 << 4) | (n2 << 8) | (h3 << 12));
                }
                if (lane == 0) dsc[row] = f2bf(1.0f / s);
            }
        }
    }
}

struct Params {
    const float *x, *c; const int* pos; const float *ada_w, *ada_b, *g1, *g2, *w_in, *rgain, *qg, *kg, *og, *w_out, *wq, *sk, *down, *up;
    float* out; unsigned char* ws; RopeC rc;
};

__global__ void __launch_bounds__(512) mk_fwd(Params p) {
    extern __shared__ __attribute__((aligned(16))) unsigned char lds[];
    const int tid = threadIdx.x, lane = tid & 63, wave = tid >> 6, bid = blockIdx.x, G = gridDim.x;
    unsigned char* ws = p.ws;
    float* mod = (float*)(ws + OFF_MOD); float* rinv1 = (float*)(ws + OFF_RINV1); float* ftab = (float*)(ws + OFF_ROPE);
    bf16_t* P = (bf16_t*)(ws + OFF_P); float* kv = (float*)(ws + OFF_KV); bf16_t* stT = (bf16_t*)(ws + OFF_ST); bf16_t* ycat = (bf16_t*)(ws + OFF_YCAT);
    bf16_t* xb = (bf16_t*)(ws + OFF_XB); bf16_t* Win_t = (bf16_t*)(ws + OFF_WINT); float* bias_f = (float*)(ws + OFF_BIASF);
    bf16_t* Weff_t = (bf16_t*)(ws + OFF_WEFFT); bf16_t* Wout_t = (bf16_t*)(ws + OFF_WOUTT); float* bias_q = (float*)(ws + OFF_BIASQ); float* bq_part = (float*)(ws + OFF_BQPART);
    float* part2 = (float*)(ws + OFF_PART2); bf16_t* x1b = (bf16_t*)(ws + OFF_X1B); unsigned short* ids = (unsigned short*)(ws + OFF_IDS); unsigned char* q8 = ws + OFF_Q8; bf16_t* dsc = (bf16_t*)(ws + OFF_DSC); float* gates = (float*)(ws + OFF_GATES);
    const size_t PS = (size_t)T * 512;
    const bf16_t *Qr = P, *Kr = P + PS, *Gr = P + 2 * PS, *Qs = P + 3 * PS, *Ks = P + 4 * PS, *Vr = P + 5 * PS, *Vs = P + 6 * PS;
    float* out = p.out;

    if (tid < 4) ((LAS unsigned*)((LAS unsigned char*)lds + LDS_ST_OFF))[tid] = 0u;
    __syncthreads();
    XcdBarrier bar = xcd_barrier_post((unsigned*)(ws + OFF_CTL), (volatile LAS unsigned*)((LAS unsigned char*)lds + LDS_ST_OFF));

    for (int u = bid; u < 256; u += G) gemv_cols<6>(lds, VfSilu{p.c}, p.ada_w, 6144, u, mod, p.ada_b);
    for (int row0 = (bid * 8 + wave) * 2; row0 < T; row0 += G * 16) {
        float4 v[2][4];
#pragma unroll
        for (int rr = 0; rr < 2; ++rr)
#pragma unroll
            for (int j = 0; j < 4; ++j) v[rr][j] = ld_nt4(p.x + (size_t)(row0 + rr) * D + (lane + 64 * j) * 4);
#pragma unroll
        for (int rr = 0; rr < 2; ++rr) {
            uint2* xo = (uint2*)(xb + (size_t)(row0 + rr) * D);
            float s = 0.f;
#pragma unroll
            for (int j = 0; j < 4; ++j) { const float4 q = v[rr][j]; s += q.x * q.x + q.y * q.y + q.z * q.z + q.w * q.w; xo[lane + 64 * j] = make_uint2(pk2(q.x, q.y), pk2(q.z, q.w)); }
#pragma unroll
            for (int o = 32; o > 0; o >>= 1) s += __shfl_xor(s, o);
            if (lane == 0) rinv1[row0 + rr] = 1.0f / sqrtf(s * (1.0f / D) + EPS);
        }
    }
    if (bid == 0 && tid == 0) {
#pragma unroll
        for (int i = 0; i < 32; ++i) { ftab[i] = p.rc.fh[i]; ftab[32 + i] = p.rc.fl[i]; }
    }
    xcd_barrier(bar);

    {
        float* scr = (float*)(lds + wave * 16384);
        for (int it = bid * 8 + wave; it < 16 * 112; it += G * 8) transpose_item<true, true>(p.w_in, 1024, 3584, Win_t, scr, it, lane, p.g1, mod + 1024);
        __syncthreads();
        for (int u = bid; u < 128; u += G) gemv_cols<7>(lds, VfVec{mod}, p.w_in, 3584, u, bias_f, nullptr);
    }
    xcd_barrier(bar);

    {
        pg8::Gemm g{xb, Win_t, T, 3584, 1024}; pg8::StaticOrder S; S.init(T, 3584, G, bid);
        EpiInprojMF E{P, rinv1, bias_f, p.pos, ftab, p.qg, p.kg};
        pg8::gemm_phase<EpiInprojMF, pg8::StaticOrder>((PG8_LAS unsigned char*)lds, g, S, E);
        const int nidle = (G > 128) ? G - 128 : G, ib = (G > 128) ? bid - 128 : bid;
        {
            float* scr = (float*)(lds + wave * 16384);
            if (ib >= 0) for (int it = ib * 8 + wave; it < 16 * 32; it += nidle * 8) transpose_item<false, false>(p.w_out, 1024, 1024, Wout_t, scr, it, lane, nullptr, nullptr);
            __syncthreads();
        }
        if (ib >= 0 && ib < 128) {
            const int hp = ib >> 3, blk = ib & 7;
            float* skT = (float*)lds; float* wqs = (float*)(lds + 69632);
            for (int e = tid; e < 16384; e += 512) { const int k = e >> 7, c = e & 127; skT[c * 132 + k] = p.sk[((size_t)hp * 128 + k) * 128 + c]; }
            float bacc[16];
#pragma unroll
            for (int j = 0; j < 16; ++j) bacc[j] = 0.f;
            for (int rbk = 0; rbk < 2; ++rbk) {
                const int i0 = (blk * 2 + rbk) * 64;
                __syncthreads();
                for (int e = tid; e < 8192; e += 512) { const int r = e >> 7, c = e & 127; wqs[r * 129 + c] = p.wq[(size_t)(i0 + r) * 2048 + hp * 128 + c]; }
                __syncthreads();
                float acc[16];
#pragma unroll
                for (int j = 0; j < 16; ++j) acc[j] = 0.f;
                const float* wrow = wqs + lane * 129; const float* skc = skT + 16 * wave;
#pragma unroll 4
                for (int c = 0; c < 128; ++c) {
                    const float av = wrow[c];
                    const float4 b0 = *(const float4*)(skc + c * 132), b1 = *(const float4*)(skc + c * 132 + 4), b2 = *(const float4*)(skc + c * 132 + 8), b3 = *(const float4*)(skc + c * 132 + 12);
                    acc[0] += av * b0.x; acc[1] += av * b0.y; acc[2] += av * b0.z; acc[3] += av * b0.w; acc[4] += av * b1.x; acc[5] += av * b1.y; acc[6] += av * b1.z; acc[7] += av * b1.w;
                    acc[8] += av * b2.x; acc[9] += av * b2.y; acc[10] += av * b2.z; acc[11] += av * b2.w; acc[12] += av * b3.x; acc[13] += av * b3.y; acc[14] += av * b3.z; acc[15] += av * b3.w;
                }
                const int i = i0 + lane;
                const float s2v = p.g2[i] * (1.f + mod[4096 + i]), sh = mod[3072 + i];
#pragma unroll
                for (int j = 0; j < 16; ++j) { Weff_t[(size_t)(hp * 128 + 16 * wave + j) * 1024 + i] = f2bf(acc[j] * s2v); bacc[j] += sh * acc[j]; }
            }
#pragma unroll
            for (int j = 0; j < 16; ++j) { float v = bacc[j];
#pragma unroll
                for (int o = 32; o > 0; o >>= 1) v += __shfl_xor(v, o);
                if (lane == 0) bq_part[(size_t)blk * 2048 + hp * 128 + 16 * wave + j] = v; }
            __syncthreads();
        }
        if (ib >= 0) convert_tables(p.down, p.up, q8, dsc, lane, ib * 8 + wave, nidle * 8, 0, CONV_SPLIT);
    }
    xcd_barrier(bar);

    {
        const int gw = __builtin_amdgcn_readfirstlane(bid * 8 + wave), NGW = G * 8, l31 = lane & 31, hf = lane >> 5;
        const int wv0 = __builtin_amdgcn_readfirstlane(wave);
        for (int U = gw; U < 1024; U += NGW) {
            const int n = U >> 3, h = U & 7;
            f32x16 C[2][2];
#pragma unroll
            for (int a = 0; a < 2; ++a)
#pragma unroll
                for (int b = 0; b < 2; ++b)
#pragma unroll
                    for (int r = 0; r < 16; ++r) C[a][b][r] = 0.f;
            unsigned char* Kt = lds + wv0 * 9216; unsigned char* Vt = Kt + 4608;
            const int r8 = lane >> 3, pc = lane & 7, trq = (lane & 15) >> 2, trp = lane & 3, trd = (lane >> 4) & 1;
            const char* kbase = (const char*)(Kr + (size_t)n * 128 * 512 + h * 64); const char* vbase = (const char*)(Vr + (size_t)n * 128 * 512 + h * 64);
            const unsigned loff = (unsigned)(r8 * 512 + pc * 8) * 2u;
            const float lg = lg2_head(h);
            pg8::u32x4 gK[4], gV[4];
#pragma unroll
            for (int i = 0; i < 4; ++i) { gK[i] = *(const pg8::u32x4*)(kbase + (loff + i * 8192u)); gV[i] = *(const pg8::u32x4*)(vbase + (loff + i * 8192u)); }
            for (int sb4 = 0; sb4 < 4; ++sb4) {
#pragma unroll
                for (int i = 0; i < 4; ++i) { *(pg8::u32x4*)(Kt + (8 * i + r8) * 144 + pc * 16) = gK[i]; *(pg8::u32x4*)(Vt + (8 * i + r8) * 144 + pc * 16) = gV[i]; }
                { const int sn = (sb4 < 3) ? sb4 + 1 : sb4;
#pragma unroll
                  for (int i = 0; i < 4; ++i) { gK[i] = *(const pg8::u32x4*)(kbase + (size_t)sn * 32768 + (loff + i * 8192u)); gV[i] = *(const pg8::u32x4*)(vbase + (size_t)sn * 32768 + (loff + i * 8192u)); } }
#pragma unroll
                for (int s = 0; s < 2; ++s) {
                    bf16x8 Af[2], Bf[2];
#pragma unroll
                    for (int a = 0; a < 2; ++a) {
                        Af[a] = tr_frag(Vt + (16 * s + 8 * hf + trq) * 144 + (32 * a + 16 * trd + 4 * trp) * 2, 4);
                        const bf16x8 kraw = tr_frag(Kt + (16 * s + 8 * hf + trq) * 144 + (32 * a + 16 * trd + 4 * trp) * 2, 4);
                        const pg8::u32x4 kw = __builtin_bit_cast(pg8::u32x4, kraw); const unsigned kk[4] = {kw.x, kw.y, kw.z, kw.w};
                        pg8::u32x4 o; unsigned* op = (unsigned*)&o;
#pragma unroll
                        for (int e2 = 0; e2 < 4; ++e2) {
                            const int j0 = 32 * sb4 + 16 * s + 8 * hf + 2 * e2;
                            const float z0 = __builtin_amdgcn_exp2f((float)(127 - j0) * lg), z1 = __builtin_amdgcn_exp2f((float)(126 - j0) * lg);
                            op[e2] = pg8::cvt_pk_bf16(__uint_as_float(kk[e2] << 16) * z0, __uint_as_float(kk[e2] & 0xffff0000u) * z1);
                        }
                        Bf[a] = __builtin_bit_cast(bf16x8, o);
                    }
#pragma unroll
                    for (int a = 0; a < 2; ++a)
#pragma unroll
                        for (int b = 0; b < 2; ++b) C[a][b] = MFMA32(Af[a], Bf[b], C[a][b]);
                }
            }
            float* dst = kv + (size_t)(n * 8 + h) * 4096;
#pragma unroll
            for (int a = 0; a < 2; ++a)
#pragma unroll
                for (int b = 0; b < 2; ++b)
#pragma unroll
                    for (int r = 0; r < 16; ++r) dst[(32 * a + (r & 3) + 8 * (r >> 2) + 4 * hf) * 64 + 32 * b + l31] = C[a][b][r];
        }
        bf16x8 Tri[2];
        {
            pg8::u32x4 w0, w1; unsigned* p0 = (unsigned*)&w0; unsigned* p1 = (unsigned*)&w1;
#pragma unroll
            for (int e2 = 0; e2 < 4; ++e2) {
                unsigned a0 = 0, a1 = 0;
#pragma unroll
                for (int q = 0; q < 2; ++q) { const int e = 2 * e2 + q, ip = 8 * (e >> 2) + 4 * hf + (e & 3);
                    a0 |= ((ip > l31) ? 0x3F80u : 0u) << (16 * q); a1 |= ((16 + ip > l31) ? 0x3F80u : 0u) << (16 * q); }
                p0[e2] = a0; p1[e2] = a1;
            }
            Tri[0] = __builtin_bit_cast(bf16x8, w0); Tri[1] = __builtin_bit_cast(bf16x8, w1);
        }
        const bool sb_local = (G % 8 == 0) && (4096 % G == 0) && ((4096 / G) % 8 == 0);
        const int sb_per_wave = sb_local ? 4096 / G / 8 : (4096 + NGW - 1 - gw) / NGW;
        const int wv = __builtin_amdgcn_readfirstlane(wave);
        for (int ps = 0; ps < sb_per_wave; ++ps) {
            const int U = sb_local ? 0 : gw + ps * NGW;
            const int h = sb_local ? (bid & 7) : (U & 7), qt = sb_local ? (bid >> 3) * (4096 / G) + ps * 8 + wv : (U >> 3), q0 = qt * 32;
            f32x16 O[2];
#pragma unroll
            for (int r = 0; r < 16; ++r) { O[0][r] = 0.f; O[1][r] = 0.f; }
            float carry = 0.f;
            unsigned char* Kt = lds + wv * 9216; unsigned char* Vt = Kt + 4608;
            const int r8 = lane >> 3, pc = lane & 7;
            const char* kbase = (const char*)(Ks + h * 64); const char* vbase = (const char*)(Vs + h * 64);
            const unsigned loff = (unsigned)(r8 * 512 + pc * 8) * 2u;
            pg8::u32x4 gK[4], gV[4];
            bf16x8 Qf[4];
            {
                const char* qbase = (const char*)(Qs + h * 64);
#pragma unroll
                for (int i = 0; i < 4; ++i) gK[i] = *(const pg8::u32x4*)(qbase + (size_t)qt * 32768 + (loff + i * 8192u));
#pragma unroll
                for (int i = 0; i < 4; ++i) *(pg8::u32x4*)(Kt + (8 * i + r8) * 144 + pc * 16) = gK[i];
#pragma unroll
                for (int s = 0; s < 4; ++s) Qf[s] = *(const bf16x8*)(Kt + l31 * 144 + 32 * s + 16 * hf);
            }
#pragma unroll
            for (int i = 0; i < 4; ++i) { gK[i] = *(const pg8::u32x4*)(kbase + (size_t)qt * 32768 + (loff + i * 8192u)); gV[i] = *(const pg8::u32x4*)(vbase + (size_t)qt * 32768 + (loff + i * 8192u)); }
            const int trq = (lane & 15) >> 2, trp = lane & 3, trd = (lane >> 4) & 1;
            for (int kb = qt; kb >= 0; --kb) {
#pragma unroll
                for (int i = 0; i < 4; ++i) { *(pg8::u32x4*)(Kt + (8 * i + r8) * 144 + pc * 16) = gK[i]; *(pg8::u32x4*)(Vt + (8 * i + r8) * 144 + pc * 16) = gV[i]; }
                {
                    const int kbn = (kb > 0) ? kb - 1 : 0;
#pragma unroll
                    for (int i = 0; i < 4; ++i) { gK[i] = *(const pg8::u32x4*)(kbase + (size_t)kbn * 32768 + (loff + i * 8192u)); gV[i] = *(const pg8::u32x4*)(vbase + (size_t)kbn * 32768 + (loff + i * 8192u)); }
                }
                bf16x8 Kf[4], Vf[2][2];
#pragma unroll
                for (int s = 0; s < 4; ++s) Kf[s] = *(const bf16x8*)(Kt + l31 * 144 + 32 * s + 16 * hf);
#pragma unroll
                for (int s = 0; s < 2; ++s)
#pragma unroll
                    for (int dt = 0; dt < 2; ++dt) {
                        Vf[s][dt] = tr_frag(Vt + (16 * s + 4 * hf + trq) * 144 + (32 * dt + 16 * trd + 4 * trp) * 2, 8);
                    }
                f32x16 S;
#pragma unroll
                for (int r = 0; r < 16; ++r) S[r] = 0.f;
#pragma unroll
                for (int s = 0; s < 4; ++s) S = MFMA32(Kf[s], Qf[s], S);
                const bool diag = (kb == qt);
                f32x16 sp, lb;
                float csum = 0.f;
                if (diag) {
#pragma unroll
                    for (int r = 0; r < 16; ++r) {
                        const int i = (r & 3) + 8 * (r >> 2) + 4 * hf;
                        const float z = S[r];
                        const float l1p = __builtin_amdgcn_logf(1.0f + __builtin_amdgcn_exp2f(-fabsf(z)));
                        const float spv = (i < l31) ? (fmaxf(z, 0.f) + l1p) : 0.f;
                        sp[r] = spv; lb[r] = (i < l31) ? (fminf(z, 0.f) - l1p) : -INFINITY; csum += spv;
                    }
                } else {
#pragma unroll
                    for (int r = 0; r < 16; ++r) {
                        const float z = S[r];
                        const float l1p = __builtin_amdgcn_logf(1.0f + __builtin_amdgcn_exp2f(-fabsf(z)));
                        const float spv = fmaxf(z, 0.f) + l1p;
                        sp[r] = spv; lb[r] = fminf(z, 0.f) - l1p; csum += spv;
                    }
                }
                f32x16 Rt;
#pragma unroll
                for (int r = 0; r < 16; ++r) Rt[r] = carry;
#pragma unroll
                for (int s = 0; s < 2; ++s) Rt = MFMA32(Tri[s], pack_frag(sp, s), Rt);
                f32x16 wv;
#pragma unroll
                for (int r = 0; r < 16; ++r) wv[r] = __builtin_amdgcn_exp2f(lb[r] - Rt[r]);
#pragma unroll
                for (int s = 0; s < 2; ++s) { const bf16x8 wp = pack_frag(wv, s);
#pragma unroll
                    for (int dt = 0; dt < 2; ++dt) O[dt] = MFMA32(Vf[s][dt], wp, O[dt]); }
                csum += __shfl_xor(csum, 32);
                carry += csum;
                if (__all(carry > 127.f)) break;
            }
            float ss = 0.f;
#pragma unroll
            for (int r = 0; r < 16; ++r) ss += O[0][r] * O[0][r] + O[1][r] * O[1][r];
            ss += __shfl_xor(ss, 32);
            const float rn = 1.0f / sqrtf(ss * (1.f / 64.f) + EPS);
#pragma unroll
            for (int dt = 0; dt < 2; ++dt)
#pragma unroll
                for (int g4 = 0; g4 < 4; ++g4) {
                    const int d = 32 * dt + 8 * g4 + 4 * hf;
                    const float4 gn = *(const float4*)(p.og + d);
                    uint2 w; w.x = pg8::cvt_pk_bf16(O[dt][4 * g4] * rn * gn.x, O[dt][4 * g4 + 1] * rn * gn.y); w.y = pg8::cvt_pk_bf16(O[dt][4 * g4 + 2] * rn * gn.z, O[dt][4 * g4 + 3] * rn * gn.w);
                    *(uint2*)(Kt + l31 * 144 + d * 2) = w;
                }
#pragma unroll
            for (int i = 0; i < 4; ++i) *(pg8::u32x4*)(ycat + (size_t)(q0 + 8 * i + r8) * 1024 + 512 + h * 64 + pc * 8) = *(const pg8::u32x4*)(Kt + (8 * i + r8) * 144 + pc * 16);
        }
    }
    xcd_barrier(bar);

    if (bid == 255 % G) for (int n = tid; n < 2048; n += 512) { float s = 0.f;
#pragma unroll
        for (int b8 = 0; b8 < 8; ++b8) s += bq_part[(size_t)b8 * 2048 + n];
        bias_q[n] = s; }
    if (G > 64 && bid >= 64) convert_tables(p.down, p.up, q8, dsc, lane, (bid - 64) * 8 + wave, (G - 64) * 8, CONV_SPLIT, 32768);
    else if (G <= 64) convert_tables(p.down, p.up, q8, dsc, lane, bid * 8 + wave, G * 8, CONV_SPLIT, 32768);
    for (int idx = bid * 512 + tid; idx < 32768; idx += G * 512) {
        const int h = idx >> 12;
        const float cd = exp2f(128.f * lg2_head(h));
        float s = 0.f;
        for (int n0 = 0; n0 < 128; n0 += 32) {
            float kvv[32];
#pragma unroll
            for (int q = 0; q < 32; ++q) kvv[q] = kv[(size_t)(n0 + q) * 32768 + idx];
#pragma unroll
            for (int q = 0; q < 32; ++q) { stT[(size_t)(n0 + q) * 32768 + idx] = f2bf(s); s = cd * s + kvv[q]; }
        }
    }
    xcd_barrier(bar);

    {
        const int gw = __builtin_amdgcn_readfirstlane(bid * 8 + wave), NGW = G * 8, l31 = lane & 31, hf = lane >> 5;
        const int wv4 = __builtin_amdgcn_readfirstlane(wave);
        for (int W2 = gw; W2 < 2048; W2 += NGW) {
            const int nh = W2 >> 1, n = nh >> 3, h = nh & 7;
            const float lg = lg2_head(h);
#pragma unroll 1
            for (int pass = 0; pass < 2; ++pass) {
                const int qt = (W2 & 1) ? (pass ? 2 : 1) : (pass ? 3 : 0);
                const int il = qt * 32 + l31, tq = n * 128 + il;
                unsigned char* Kt = lds + wv4 * 9216; unsigned char* Vt = Kt + 4608;
                const int r8 = lane >> 3, pc = lane & 7, trq = (lane & 15) >> 2, trp = lane & 3, trd = (lane >> 4) & 1;
                const unsigned loff = (unsigned)(r8 * 512 + pc * 8) * 2u;
                pg8::u32x4 gK[4], gV[4];
                bf16x8 Qf[4];
                {
                    const char* qbase = (const char*)(Qr + (size_t)(n * 128 + qt * 32) * 512 + h * 64);
                    const char* sbase = (const char*)(stT + (size_t)nh * 4096) + (unsigned)(r8 * 64 + pc * 8) * 2u;
#pragma unroll
                    for (int i = 0; i < 4; ++i) gK[i] = *(const pg8::u32x4*)(qbase + (loff + i * 8192u));
#pragma unroll
                    for (int i = 0; i < 4; ++i) *(pg8::u32x4*)(Kt + (8 * i + r8) * 144 + pc * 16) = gK[i];
#pragma unroll
                    for (int s = 0; s < 4; ++s) Qf[s] = *(const bf16x8*)(Kt + l31 * 144 + 32 * s + 16 * hf);
#pragma unroll
                    for (int i = 0; i < 4; ++i) { gK[i] = *(const pg8::u32x4*)(sbase + i * 1024u); gV[i] = *(const pg8::u32x4*)(sbase + 4096u + i * 1024u); }
#pragma unroll
                    for (int i = 0; i < 4; ++i) { *(pg8::u32x4*)(Kt + (8 * i + r8) * 144 + pc * 16) = gK[i]; *(pg8::u32x4*)(Kt + (32 + 8 * i + r8) * 144 + pc * 16) = gV[i]; }
                }
                f32x16 O[2];
#pragma unroll
                for (int r = 0; r < 16; ++r) { O[0][r] = 0.f; O[1][r] = 0.f; }
#pragma unroll
                for (int s = 0; s < 4; ++s)
#pragma unroll
                    for (int dt = 0; dt < 2; ++dt) O[dt] = MFMA32(*(const bf16x8*)(Kt + (32 * dt + l31) * 144 + 32 * s + 16 * hf), Qf[s], O[dt]);
                const float xi = exp2f((float)(il + 1) * lg);
#pragma unroll
                for (int r = 0; r < 16; ++r) { O[0][r] *= xi; O[1][r] *= xi; }
                const char* kbase = (const char*)(Kr + (size_t)n * 128 * 512 + h * 64); const char* vbase = (const char*)(Vr + (size_t)n * 128 * 512 + h * 64);
#pragma unroll
                for (int i = 0; i < 4; ++i) { gK[i] = *(const pg8::u32x4*)(kbase + (loff + i * 8192u)); gV[i] = *(const pg8::u32x4*)(vbase + (loff + i * 8192u)); }
                for (int jb = 0; jb <= qt; ++jb) {
#pragma unroll
                    for (int i = 0; i < 4; ++i) { *(pg8::u32x4*)(Kt + (8 * i + r8) * 144 + pc * 16) = gK[i]; *(pg8::u32x4*)(Vt + (8 * i + r8) * 144 + pc * 16) = gV[i]; }
                    { const int jn = (jb < qt) ? jb + 1 : jb;
#pragma unroll
                      for (int i = 0; i < 4; ++i) { gK[i] = *(const pg8::u32x4*)(kbase + (size_t)jn * 32768 + (loff + i * 8192u)); gV[i] = *(const pg8::u32x4*)(vbase + (size_t)jn * 32768 + (loff + i * 8192u)); } }
                    bf16x8 Kf[4], Vf[2][2];
#pragma unroll
                    for (int s = 0; s < 4; ++s) Kf[s] = *(const bf16x8*)(Kt + l31 * 144 + 32 * s + 16 * hf);
#pragma unroll
                    for (int s = 0; s < 2; ++s)
#pragma unroll
                        for (int dt = 0; dt < 2; ++dt) Vf[s][dt] = tr_frag(Vt + (16 * s + 4 * hf + trq) * 144 + (32 * dt + 16 * trd + 4 * trp) * 2, 8);
                    f32x16 S;
#pragma unroll
                    for (int r = 0; r < 16; ++r) S[r] = 0.f;
#pragma unroll
                    for (int s = 0; s < 4; ++s) S = MFMA32(Kf[s], Qf[s], S);
#pragma unroll
                    for (int r = 0; r < 16; ++r) {
                        const int jl = jb * 32 + (r & 3) + 8 * (r >> 2) + 4 * hf, dl = il - jl;
                        S[r] = (dl >= 0) ? S[r] * __builtin_amdgcn_exp2f((float)dl * lg) : 0.f;
                    }
#pragma unroll
                    for (int s = 0; s < 2; ++s) { const bf16x8 wp = pack_frag(S, s);
#pragma unroll
                        for (int dt = 0; dt < 2; ++dt) O[dt] = MFMA32(Vf[s][dt], wp, O[dt]); }
                }
                float sm = 0.f;
#pragma unroll
                for (int r = 0; r < 16; ++r) sm += O[0][r] + O[1][r];
                sm += __shfl_xor(sm, 32);
                const float mean = sm * (1.f / 64.f);
                float vs = 0.f;
#pragma unroll
                for (int r = 0; r < 16; ++r) { const float d0 = O[0][r] - mean, d1 = O[1][r] - mean; vs += d0 * d0 + d1 * d1; }
                vs += __shfl_xor(vs, 32);
                const float rstd = 1.0f / sqrtf(vs * (1.f / 64.f) + EPS);
                {
                    const char* gbase = (const char*)(Gr + (size_t)(n * 128 + qt * 32) * 512 + h * 64);
#pragma unroll
                    for (int i = 0; i < 4; ++i) gV[i] = *(const pg8::u32x4*)(gbase + (loff + i * 8192u));
#pragma unroll
                    for (int i = 0; i < 4; ++i) *(pg8::u32x4*)(Vt + (8 * i + r8) * 144 + pc * 16) = gV[i];
                }
#pragma unroll
                for (int dt = 0; dt < 2; ++dt)
#pragma unroll
                    for (int g4 = 0; g4 < 4; ++g4) {
                        const int e = 32 * dt + 8 * g4 + 4 * hf;
                        const float4 gn = *(const float4*)(p.rgain + h * 64 + e);
                        const uint2 gg = *(const uint2*)(Vt + l31 * 144 + e * 2);
                        const float g0 = __uint_as_float(gg.x << 16), g1 = __uint_as_float(gg.x & 0xffff0000u), g2v = __uint_as_float(gg.y << 16), g3 = __uint_as_float(gg.y & 0xffff0000u);
                        uint2 w;
                        w.x = pg8::cvt_pk_bf16((O[dt][4 * g4] - mean) * rstd * gn.x * g0, (O[dt][4 * g4 + 1] - mean) * rstd * gn.y * g1);
                        w.y = pg8::cvt_pk_bf16((O[dt][4 * g4 + 2] - mean) * rstd * gn.z * g2v, (O[dt][4 * g4 + 3] - mean) * rstd * gn.w * g3);
                        *(uint2*)(Kt + l31 * 144 + e * 2) = w;
                    }
#pragma unroll
                for (int i = 0; i < 4; ++i) *(pg8::u32x4*)(ycat + (size_t)(n * 128 + qt * 32 + 8 * i + r8) * 1024 + h * 64 + pc * 8) = *(const pg8::u32x4*)(Kt + (8 * i + r8) * 144 + pc * 16);
            }
        }
    }
    xcd_barrier(bar);

    {
        pg8::Gemm g{ycat, Wout_t, T, 1024, 1024}; pg8::StaticOrder S; S.init(T, 1024, G, bid);
        EpiOutprojMF E{xb, mod + 2048, x1b, part2};
        pg8::gemm_phase<EpiOutprojMF, pg8::StaticOrder>((PG8_LAS unsigned char*)lds, g, S, E);
    }
    xcd_barrier(bar);

    for (int round = 0; round < 2; ++round) {
        pg8::Gemm g{x1b, Weff_t, T, 2048, 1024}; OneUnitOrder S; S.base.init(T, 2048, G, bid); S.round = round;
        EpiTopkMF E{part2, bias_q, ids, gates};
        pg8::gemm_phase<EpiTopkMF, OneUnitOrder>((PG8_LAS unsigned char*)lds, g, S, E);
    }
    xcd_barrier(bar);

    {
        constexpr int IDS_LD = 136, ACT_LD = 136;
        const float* scale2 = mod + 4096; const float* shift2 = mod + 3072; const float* gate2 = mod + 5120;
        unsigned short* ids_l = (unsigned short*)lds; float* act_l = (float*)(lds + 32768);
        bf16_t* ds_l = (bf16_t*)(lds + 69632);
        const int t0 = bid * 64, tt = lane >> 3, sub = lane & 7, tl = wave * 8 + tt, t = t0 + tl;
        for (int e = tid; e < 1024; e += 512) { const int r = e >> 4, c8 = e & 15; *(uint4*)(ids_l + r * IDS_LD + c8 * 8) = *(const uint4*)(ids + (size_t)(t0 + r) * 128 + c8 * 8); }
        for (int e = tid; e < 64 * ACT_LD; e += 512) act_l[e] = 0.f;
        for (int e = tid; e < 4096; e += 512) ((uint4*)ds_l)[e] = ((const uint4*)dsc)[e];
        float* s2_l = (float*)(lds + 143360); float* sh2_l = s2_l + 1024; float* gt2_l = s2_l + 2048;
        for (int e = tid; e < 1024; e += 512) { s2_l[e] = p.g2[e] * (1.f + scale2[e]); sh2_l[e] = shift2[e]; gt2_l[e] = gate2[e]; }
        __syncthreads();
        float ri;
        { const float4* pp = (const float4*)(part2 + (size_t)t * 16); const float4 p0 = pp[0], p1 = pp[1], p2 = pp[2], p3 = pp[3];
          const float ssum = ((p0.x + p0.y) + (p0.z + p0.w)) + ((p1.x + p1.y) + (p1.z + p1.w)) + ((p2.x + p2.y) + (p2.z + p2.w)) + ((p3.x + p3.y) + (p3.z + p3.w));
          ri = 1.0f / sqrtf(ssum * (1.0f / D) + EPS); }
        const unsigned short* myids = ids_l + tl * IDS_LD;
        float* myact = act_l + tl * ACT_LD;
        const bool s4 = (sub & 4) != 0, s2 = (sub & 2) != 0, s1 = (sub & 1) != 0;
        const unsigned suboff = (unsigned)sub * 16u;
        typedef float f32x2 __attribute__((ext_vector_type(2)));
#define P9_LOAD(W, JB) do { const uint4 idv_ = *(const uint4*)(myids + 8 * (JB)); const unsigned idw_[4] = {idv_.x, idv_.y, idv_.z, idv_.w}; \
        _Pragma("unroll") for (int k_ = 0; k_ < 8; ++k_) { const unsigned id_ = (idw_[k_ >> 1] >> (16 * (k_ & 1))) & 0xffffu; W[k_] = *(const uint4*)(sbase + (id_ * 128u + suboff)); } } while (0)
#define P9_DOWN4(W, JB) do { int pd_[8]; \
        _Pragma("unroll") for (int k_ = 0; k_ < 8; ++k_) { const unsigned ww_[4] = {W[k_].x, W[k_].y, W[k_].z, W[k_].w}; int a0_ = 0, a1_ = 0; \
            _Pragma("unroll") for (int m_ = 0; m_ < 4; ++m_) { a0_ = __builtin_amdgcn_sdot4(hpe[m_], (int)(ww_[m_] & 0x0F0F0F0Fu), a0_, false); a1_ = __builtin_amdgcn_sdot4(hpo[m_], (int)((ww_[m_] >> 4) & 0x0F0F0F0Fu), a1_, false); } \
            pd_[k_] = a0_ + a1_ - hoff; } \
        int r4_[4], r2_[2]; \
        _Pragma("unroll") for (int k_ = 0; k_ < 4; ++k_) { const int snd_ = s4 ? pd_[k_] : pd_[k_ + 4], kp_ = s4 ? pd_[k_ + 4] : pd_[k_]; r4_[k_] = kp_ + __shfl_xor(snd_, 4); } \
        _Pragma("unroll") for (int k_ = 0; k_ < 2; ++k_) { const int snd_ = s2 ? r4_[k_] : r4_[k_ + 2], kp_ = s2 ? r4_[k_ + 2] : r4_[k_]; r2_[k_] = kp_ + __shfl_xor(snd_, 2); } \
        { const int snd_ = s1 ? r2_[0] : r2_[1], kp_ = s1 ? r2_[1] : r2_[0]; myact[8 * (JB) + sub] += (float)(kp_ + __shfl_xor(snd_, 1)) * hscale; } } while (0)
        for (int c = 0; c < 4; ++c) {
            float hf[8][4]; float hmax = 0.f;
#pragma unroll
            for (int q = 0; q < 8; ++q) {
                const int col = 256 * c + 4 * sub + 32 * q;
                const uint2 xw = *(const uint2*)(x1b + (size_t)t * D + col);
                const float4 sv = *(const float4*)(s2_l + col), sh = *(const float4*)(sh2_l + col);
                hf[q][0] = __uint_as_float(xw.x << 16) * ri * sv.x + sh.x; hf[q][1] = __uint_as_float(xw.x & 0xffff0000u) * ri * sv.y + sh.y;
                hf[q][2] = __uint_as_float(xw.y << 16) * ri * sv.z + sh.z; hf[q][3] = __uint_as_float(xw.y & 0xffff0000u) * ri * sv.w + sh.w;
                hmax = fmaxf(hmax, fmaxf(fmaxf(fabsf(hf[q][0]), fabsf(hf[q][1])), fmaxf(fabsf(hf[q][2]), fabsf(hf[q][3]))));
            }
            hmax = fmaxf(hmax, __shfl_xor(hmax, 1)); hmax = fmaxf(hmax, __shfl_xor(hmax, 2)); hmax = fmaxf(hmax, __shfl_xor(hmax, 4));
            const float hinv = (hmax > 0.f) ? 127.0f / hmax : 0.f, hscale = hmax * (1.0f / 127.0f);
            int hq[8][4];
#pragma unroll
            for (int q = 0; q < 8; ++q)
#pragma unroll
                for (int j = 0; j < 4; ++j) hq[q][j] = (int)__builtin_rintf(hf[q][j] * hinv);
            int hpe[4], hpo[4], hoff = 0;
#pragma unroll
            for (int m = 0; m < 4; ++m) {
                hpe[m] = (hq[2 * m][0] & 255) | ((hq[2 * m][2] & 255) << 8) | ((hq[2 * m + 1][0] & 255) << 16) | ((hq[2 * m + 1][2] & 255) << 24);
                hpo[m] = (hq[2 * m][1] & 255) | ((hq[2 * m][3] & 255) << 8) | ((hq[2 * m + 1][1] & 255) << 16) | ((hq[2 * m + 1][3] & 255) << 24);
            }
#pragma unroll
            for (int q = 0; q < 8; ++q) hoff += (hq[q][0] + hq[q][1]) + (hq[q][2] + hq[q][3]);
            hoff *= 8;
            const unsigned char* sbase = q8 + (size_t)c * (16384 * 128);
            uint4 wA[8], wB[8];
            P9_LOAD(wA, 0);
#pragma unroll 1
            for (int jb = 0; jb < 16; jb += 2) {
                P9_LOAD(wB, jb + 1);
                P9_DOWN4(wA, jb);
                if (jb + 2 < 16) P9_LOAD(wA, jb + 2);
                P9_DOWN4(wB, jb + 1);
            }
        }
#undef P9_DOWN4
        signed char* aq_l = (signed char*)(lds + 135168);
        float avv[16]; float amax = 0.f;
#pragma unroll
        for (int jb = 0; jb < 16; ++jb) {
            const int j = 8 * jb + sub; const unsigned id = myids[j];
            const float a = myact[j] * bf2f(ds_l[id]);
            const float av = fabsf(a), tq = 1.0f / (av * 0.2316418882f + 1.0f);
            float ql = tq * 0.5307027145f + (-0.7265760135f); ql = ql * tq + 0.7107068705f; ql = ql * tq + (-0.142248368f); ql = ql * tq + 0.127414796f; ql = ql * tq;
            const float mm = a * (ql * exp2f(a * a * (-0.72134752044f)));
            const float ge = (a < 0.f) ? mm : (a - mm);
            avv[jb] = ge * gates[(size_t)t * 128 + j] * bf2f(ds_l[16384 + id]);
            amax = fmaxf(amax, fabsf(avv[jb]));
        }
        amax = fmaxf(amax, __shfl_xor(amax, 1)); amax = fmaxf(amax, __shfl_xor(amax, 2)); amax = fmaxf(amax, __shfl_xor(amax, 4));
        const float ainv = (amax > 0.f) ? 127.0f / amax : 0.f, ascale = amax * (1.0f / 127.0f);
        int aqsum = 0;
#pragma unroll
        for (int jb = 0; jb < 16; ++jb) { const int aqv = (int)__builtin_rintf(avv[jb] * ainv); aq_l[tl * 128 + 8 * jb + sub] = (signed char)aqv; aqsum += aqv; }
        aqsum += __shfl_xor(aqsum, 1); aqsum += __shfl_xor(aqsum, 2); aqsum += __shfl_xor(aqsum, 4);
        __syncthreads();
#define P9_PERM(HI, LO, SEL) __builtin_amdgcn_perm((HI), (LO), (SEL))
#define P9_T4(E0, E1, E2, E3, T0, T1, T2, T3) do { const unsigned p0_ = P9_PERM(E1, E0, 0x05010400u), p1_ = P9_PERM(E1, E0, 0x07030602u), p2_ = P9_PERM(E3, E2, 0x05010400u), p3_ = P9_PERM(E3, E2, 0x07030602u); \
        T0 = P9_PERM(p2_, p0_, 0x05040100u); T1 = P9_PERM(p2_, p0_, 0x07060302u); T2 = P9_PERM(p3_, p1_, 0x05040100u); T3 = P9_PERM(p3_, p1_, 0x07060302u); } while (0)
#define P9_UP4(W, JB) do { const uint2 aq8_ = *(const uint2*)(aq_l + tl * 128 + 8 * (JB)); const int aq4_[2] = {(int)aq8_.x, (int)aq8_.y}; \
        _Pragma("unroll") for (int g_ = 0; g_ < 2; ++g_) { \
            _Pragma("unroll") for (int m_ = 0; m_ < 4; ++m_) { \
                const unsigned w0_ = ((const unsigned*)&W[4 * g_ + 0])[m_], w1_ = ((const unsigned*)&W[4 * g_ + 1])[m_], w2_ = ((const unsigned*)&W[4 * g_ + 2])[m_], w3_ = ((const unsigned*)&W[4 * g_ + 3])[m_]; \
                unsigned t_[4]; \
                P9_T4(w0_, w1_, w2_, w3_, t_[0], t_[1], t_[2], t_[3]); \
                _Pragma("unroll") for (int k_ = 0; k_ < 4; ++k_) { \
                    oraw[4 * m_ + k_] = __builtin_amdgcn_sdot4(aq4_[g_], (int)t_[k_], oraw[4 * m_ + k_], false); \
                    olo[4 * m_ + k_] = __builtin_amdgcn_sdot4(aq4_[g_], (int)(t_[k_] & 0x0F0F0F0Fu), olo[4 * m_ + k_], false); } } } } while (0)
        for (int c = 0; c < 4; ++c) {
            int oraw[16], olo[16];
#pragma unroll
            for (int q = 0; q < 16; ++q) { oraw[q] = 0; olo[q] = 0; }
            const unsigned char* sbase = q8 + (8u << 20) + (size_t)c * (16384 * 128);
            uint4 wA[8], wB[8];
            P9_LOAD(wA, 0);
#pragma unroll 1
            for (int jb = 0; jb < 16; jb += 2) {
                P9_LOAD(wB, jb + 1);
                P9_UP4(wA, jb);
                if (jb + 2 < 16) P9_LOAD(wA, jb + 2);
                P9_UP4(wB, jb + 1);
            }
#pragma unroll
            for (int q = 0; q < 8; ++q) {
                const int col = 256 * c + 4 * sub + 32 * q;
                float* op = out + (size_t)t * D + col;
                const uint2 xw = *(const uint2*)(x1b + (size_t)t * D + col); const float4 xv = make_float4(__uint_as_float(xw.x << 16), __uint_as_float(xw.x & 0xffff0000u), __uint_as_float(xw.y << 16), __uint_as_float(xw.y & 0xffff0000u)); const float4 gt = *(const float4*)(gt2_l + col);
                const int m = q >> 1, k0 = 2 * (q & 1);
                const int v0 = olo[4 * m + k0] - 8 * aqsum, v1 = (oraw[4 * m + k0] - olo[4 * m + k0]) >> 4, v2 = olo[4 * m + k0 + 1] - 8 * aqsum, v3 = (oraw[4 * m + k0 + 1] - olo[4 * m + k0 + 1]) >> 4;
                float4 r;
                r.x = xv.x + gt.x * ((float)v0 * ascale); r.y = xv.y + gt.y * ((float)v1 * ascale); r.z = xv.z + gt.z * ((float)v2 * ascale); r.w = xv.w + gt.w * ((float)v3 * ascale);
                *(float4*)op = r;
            }
        }
#undef P9_LOAD
#undef P9_UP4
#undef P9_T4
#undef P9_PERM
    }
}
}

extern "C" void kernel_launch(void* const* d_in, const int* in_sizes, int n_in, void* d_out, int out_size, void* d_ws, size_t ws_size, hipStream_t stream) {
    static int grid = 0;
    if (grid == 0) {
        int dev = 0, cus = 0, per_cu = 0;
        (void)hipGetDevice(&dev);
        (void)hipDeviceGetAttribute(&cus, hipDeviceAttributeMultiprocessorCount, dev);
        (void)hipFuncSetAttribute((const void*)mk_fwd, hipFuncAttributeMaxDynamicSharedMemorySize, LDS_BYTES);
        (void)hipOccupancyMaxActiveBlocksPerMultiprocessor(&per_cu, (const void*)mk_fwd, 512, LDS_BYTES);
        if (per_cu < 1 || cus != 256) { fprintf(stderr, "kernel_launch: needs 256 CUs with one resident workgroup each (cus %d, per_cu %d)\n", cus, per_cu); grid = -1; }
        else grid = cus;
    }
    if (grid < 0) return;
    (void)hipMemsetAsync((char*)d_ws + OFF_CTL, 0, CTL_BYTES, stream);
    Params p{};
    p.x = (const float*)d_in[0]; p.c = (const float*)d_in[1]; p.pos = (const int*)d_in[2]; p.ada_w = (const float*)d_in[3]; p.ada_b = (const float*)d_in[4];
    p.g1 = (const float*)d_in[5]; p.g2 = (const float*)d_in[6]; p.w_in = (const float*)d_in[7]; p.rgain = (const float*)d_in[8]; p.qg = (const float*)d_in[9];
    p.kg = (const float*)d_in[10]; p.og = (const float*)d_in[11]; p.w_out = (const float*)d_in[12]; p.wq = (const float*)d_in[13]; p.sk = (const float*)d_in[14];
    p.down = (const float*)d_in[15]; p.up = (const float*)d_in[16]; p.out = (float*)d_out; p.ws = (unsigned char*)d_ws;
    for (int i = 0; i < 32; ++i) {
        const double f = pow(10000.0, -(double)i / 32.0) / 6.283185307179586476925;
        float fh = (float)f; unsigned ub; memcpy(&ub, &fh, 4); ub &= 0xFFFFC000u; memcpy(&fh, &ub, 4);
        p.rc.fh[i] = fh; p.rc.fl[i] = (float)(f - (double)fh);
    }
    void* args[] = {&p};
    hipError_t e = hipLaunchCooperativeKernel((const void*)mk_fwd, dim3(grid), dim3(512), args, LDS_BYTES, stream);
    if (e != hipSuccess) fprintf(stderr, "kernel_launch: cooperative launch failed: %s (grid %d)\n", hipGetErrorString(e), grid);
}
```

```cpp
#include <hip/hip_runtime.h>
#include <stdint.h>
#include <math.h>
#include <cstdio>
#include <cstring>

namespace {
constexpr int T = 16384, D = 1024;
constexpr float EPS = 1e-6f;
typedef unsigned short bf16_t;
#define LAS __attribute__((address_space(3)))

__device__ __forceinline__ float bf2f(bf16_t b) { return __uint_as_float(((unsigned)b) << 16); }
__device__ __forceinline__ bf16_t f2bf(float f) { unsigned u = __float_as_uint(f); u += 0x7fffu + ((u >> 16) & 1u); return (bf16_t)(u >> 16); }
__device__ __forceinline__ float4 ld_nt4(const float* p) { typedef float f4v __attribute__((ext_vector_type(4))); const f4v v = __builtin_nontemporal_load((const f4v*)p); return make_float4(v[0], v[1], v[2], v[3]); }

__device__ __forceinline__ float lg2_head(int h) {
    const float x = __uint_as_float((unsigned)(127 - 5 - h) << 23);
    const float s = x * (1.f + x * (0.5f + x * (0.33333334f + x * (0.25f + x * (0.2f + x * 0.16666667f)))));
    return -s * 1.44269504089f;
}
struct RopeC { float fh[32], fl[32]; };
struct RetC { float lg2[8]; };

constexpr size_t MiB = 1u << 20;
constexpr size_t OFF_CTL = 0;
constexpr size_t CTL_BYTES = 64 * 1024;
constexpr size_t OFF_MOD = 64 * 1024, OFF_RINV1 = 128 * 1024, OFF_BIASF = 256 * 1024, OFF_ROPE = 1 * MiB;
constexpr size_t OFF_WINT = 6 * MiB;
constexpr size_t OFF_XB = 16 * MiB;
constexpr size_t OFF_YCAT = 160 * MiB;
constexpr size_t OFF_P = 48 * MiB;
constexpr size_t OFF_KV = 208 * MiB, OFF_ST = 224 * MiB;
constexpr size_t OFF_WEFFT = 240 * MiB;
constexpr size_t OFF_WOUTT = 13 * MiB;
constexpr size_t OFF_BIASQ = 272 * 1024;
constexpr size_t OFF_SWF = 320 * 1024;
constexpr size_t OFF_XQ = 160 * MiB;
constexpr size_t OFF_DSC = 512 * 1024;
constexpr size_t OFF_BQPART = 448 * 1024;
constexpr size_t OFF_PART2 = 5 * MiB;
constexpr size_t OFF_X1B = 208 * MiB;
constexpr size_t OFF_IDS = 244 * MiB, OFF_GATES = 248 * MiB;
constexpr size_t OFF_Q8 = 192 * MiB;
constexpr int CONV_SPLIT = 0;
constexpr int LDS_BYTES = 163840;
constexpr int LDS_ST_OFF = LDS_BYTES - 16;

#define XB_TMO      128
#define XB_XCNT(j)  (256  + 64 * (j))
#define XB_XSUB(j)  (1280 + 64 * (j))
#define XB_XGEN(j)  (2304 + 64 * (j))
#define XB_TOP      3328
#define XB_TOPGEN   3392
#define XCD_BAR_WORDS 3456
#define XB_SPIN_CAP (1u << 20)
__device__ __forceinline__ unsigned xb_ld(unsigned* p)              { return __hip_atomic_load(p, __ATOMIC_RELAXED, __HIP_MEMORY_SCOPE_AGENT); }
__device__ __forceinline__ unsigned xb_add(unsigned* p, unsigned v) { return __hip_atomic_fetch_add(p, v, __ATOMIC_RELAXED, __HIP_MEMORY_SCOPE_AGENT); }
__device__ __forceinline__ unsigned xb_xcc_id() { return (unsigned)__builtin_amdgcn_s_getreg((3 << 11) | 20) & 0xFu; }
#define XB_SPIN(cond, bar) do { unsigned _sp = 0; while (cond) { __builtin_amdgcn_s_sleep(1); \
    if ((++_sp & 255u) == 0u) { if (xb_ld(&(bar)[XB_TMO])) break; if (_sp > XB_SPIN_CAP) { atomicAdd(&(bar)[XB_TMO], 1u); break; } } } } while (0)
struct XcdBarrier { unsigned* bar; unsigned x; volatile LAS unsigned* st; };
__device__ __forceinline__ XcdBarrier xcd_barrier_post(unsigned* bar, volatile LAS unsigned* st) {
    XcdBarrier b; b.bar = bar; b.x = xb_xcc_id(); b.st = st;
    if (threadIdx.x == 0) (void)xb_add(&bar[XB_XCNT(b.x)], 1u);
    return b;
}
__device__ __forceinline__ void xcd_barrier_complete(unsigned* bar, unsigned x, unsigned& nloc, unsigned& nx) {
    const unsigned G = gridDim.x * gridDim.y * gridDim.z;
    unsigned sum, cnt, mine, sp = 0u;
    for (;;) {
        sum = 0u; cnt = 0u; mine = 0u;
#pragma unroll
        for (unsigned j = 0; j < 16; ++j) { const unsigned c = xb_ld(&bar[XB_XCNT(j)]); sum += c; cnt += (c > 0u) ? 1u : 0u; mine = (j == x) ? c : mine; }
        if (sum == G) break;
        __builtin_amdgcn_s_sleep(1);
        if ((++sp & 255u) == 0u) { if (xb_ld(&bar[XB_TMO])) break; if (sp > XB_SPIN_CAP) { atomicAdd(&bar[XB_TMO], 1u); break; } }
    }
    nloc = mine > 0u ? mine : 1u; nx = cnt > 0u ? cnt : 1u;
}
__device__ __forceinline__ void xcd_barrier(const XcdBarrier& b) {
    asm volatile("s_waitcnt vmcnt(0)" ::: "memory");
    __syncthreads();
    if (threadIdx.x == 0) {
        unsigned* bar = b.bar;
        __builtin_amdgcn_s_waitcnt(0);
        unsigned nloc = b.st[0], nx = b.st[1];
        if (nloc == 0u) { xcd_barrier_complete(bar, b.x, nloc, nx); b.st[0] = nloc; b.st[1] = nx; }
        const unsigned old = xb_add(&bar[XB_XSUB(b.x)], 1u);
        const unsigned gen = old / nloc;
        if (old + 1u == (gen + 1u) * nloc) {
            __builtin_amdgcn_fence(__ATOMIC_RELEASE, "agent");
            asm volatile("s_waitcnt vmcnt(0)" ::: "memory");
            const unsigned og = xb_add(&bar[XB_TOP], 1u);
            const unsigned tg = og / nx;
            if (og + 1u == (tg + 1u) * nx) xb_add(&bar[XB_TOPGEN], 1u);
            else XB_SPIN(xb_ld(&bar[XB_TOPGEN]) == tg, bar);
            __builtin_amdgcn_fence(__ATOMIC_ACQUIRE, "agent");
            xb_add(&bar[XB_XGEN(b.x)], 1u);
            asm volatile("s_waitcnt vmcnt(0)" ::: "memory");
        } else {
            XB_SPIN(xb_ld(&bar[XB_XGEN(b.x)]) == gen, bar);
            __builtin_amdgcn_fence(__ATOMIC_ACQUIRE, "agent");
            asm volatile("s_waitcnt vmcnt(0)" ::: "memory");
        }
    }
    __syncthreads();
}


namespace pg8 {
#define PG8_LAS __attribute__((address_space(3)))
typedef short bf16x8 __attribute__((ext_vector_type(8)));
typedef float f32x4 __attribute__((ext_vector_type(4)));
typedef unsigned u32x4 __attribute__((ext_vector_type(4)));
typedef unsigned u32x2 __attribute__((ext_vector_type(2)));
constexpr int BM = 256, BK = 64, HALF = 128, HTB = HALF * BK * 2, STAGE_BYTES = 8 * HTB, NXCD = 8, WGM = 8;
__host__ __device__ __forceinline__ int lds_byte(int r, int c) { const int st = (r >> 4) * 2 + (c >> 5), rr = r & 15, cc = c & 31, ob = rr * 64 + cc * 2; return st * 1024 + (ob ^ (((ob >> 9) & 1) << 5)); }
__host__ __device__ __forceinline__ void stage_rc(int b, int& R, int& C) { const int st = b / 1024, sb = b % 1024, swz = sb ^ (((sb >> 9) & 1) << 5); R = (st >> 1) * 16 + swz / 64; C = (st & 1) * 32 + (swz % 64) / 2; }
__host__ __device__ __forceinline__ int perm32(int rho) { const int n = rho >> 4, i = rho & 15; return 8 * (i >> 2) + 4 * n + (i & 3); }
struct Unit { int pm, pn; };
struct Gemm { const bf16_t* A; const bf16_t* Bt; int M, N, K; };
struct StaticOrder {
    int nM, nN, nwg, G, c;
    __host__ __device__ void init(int M, int N, int G_, int c_) { nM = M / BM; nN = N / BM; nwg = nM * nN; G = G_; c = c_; }
    __host__ __device__ bool next(int i, Unit& u) const {
        const long L = (long)i * G + c; if (L >= nwg) return false;
        int wgid = (int)L; { const int q = nwg / NXCD, r = nwg % NXCD, xcd = wgid % NXCD, off = wgid / NXCD; wgid = (xcd < r ? xcd * (q + 1) : r * (q + 1) + (xcd - r) * q) + off; }
        const int nig = WGM * nN, gid = wgid / nig, fm = gid * WGM, gsz = (nM - fm) < WGM ? (nM - fm) : WGM;
        u.pm = fm + ((wgid % nig) % gsz); u.pn = (wgid % nig) / gsz; return true;
    }
    __device__ __forceinline__ void a_ready(const Unit&) const {}
    __device__ __forceinline__ void done(const Unit&) const {}
};
__device__ __forceinline__ unsigned cvt_pk_bf16(float lo, float hi) { unsigned r; asm volatile("v_cvt_pk_bf16_f32 %0, %1, %2" : "=v"(r) : "v"(lo), "v"(hi)); return r; }

typedef int i32x4 __attribute__((ext_vector_type(4)));
template <bool I8>
__device__ __forceinline__ f32x4 mma16(const bf16x8 b, const bf16x8 a, const f32x4 c) {
    if constexpr (I8) return __builtin_bit_cast(f32x4, __builtin_amdgcn_mfma_i32_16x16x64_i8(__builtin_bit_cast(i32x4, b), __builtin_bit_cast(i32x4, a), __builtin_bit_cast(i32x4, c), 0, 0, 0));
    else return __builtin_amdgcn_mfma_f32_16x16x32_bf16(b, a, c, 0, 0, 0);
}
template <class Epi, class Sched, bool I8 = false>
__device__ __forceinline__ void gemm_phase(PG8_LAS unsigned char* lds, const Gemm g, const Sched& S, const Epi& E) {
    int tid_ = threadIdx.x; asm volatile("" : "+v"(tid_));
    const int tid = tid_, wid = __builtin_amdgcn_readfirstlane(tid >> 6), lane = tid & 63, wr = wid >> 2, wc = wid & 3, fr = lane & 15, fq = lane >> 4;
    const int K = g.K, nt = K / BK;
    unsigned voffA[2], voffB[2];
#pragma unroll
    for (int i = 0; i < 2; ++i) { int R, C; stage_rc(tid * 16 + i * 8192, R, C); const int Rb = Epi::PERM ? ((R & ~31) + perm32(R & 31)) : R;
        voffA[i] = (unsigned)(R * K + C) * 2u; voffB[i] = (unsigned)(Rb * K + C) * 2u; }
    const size_t kstep = (size_t)(BK * 2);
    const size_t hstep = (size_t)HALF * K * 2;
    const size_t tstep = 2 * hstep;
    const unsigned ldsw = (unsigned)wid * 1024u;
    const int aoff = lds_byte(wr * 64 + fr, fq * 8), boff = lds_byte(wc * 32 + fr, fq * 8);
#define PG8_SA(b, h) (((b) * 2 + (h)) * HTB)
#define PG8_SB(b, h) ((4 + (b) * 2 + (h)) * HTB)
#define PG8_STAGE(bufoff, gbase, voff) do { _Pragma("unroll") for (int _i = 0; _i < 2; ++_i) \
        __builtin_amdgcn_global_load_lds((const unsigned*)((const char*)(gbase) + (voff)[_i]), (PG8_LAS unsigned*)(lds + (bufoff) + ldsw + _i * 8192), 16, 0, 0); } while (0)
#define PG8_LDA(dst, b, h) do { _Pragma("unroll") for (int m = 0; m < 4; ++m) _Pragma("unroll") for (int k = 0; k < 2; ++k) dst[m][k] = *(const PG8_LAS bf16x8*)(lds + PG8_SA(b, h) + aoff + m * 2048 + k * 1024); } while (0)
#define PG8_LDB(dst, b, h) do { _Pragma("unroll") for (int n = 0; n < 2; ++n) _Pragma("unroll") for (int k = 0; k < 2; ++k) dst[n][k] = *(const PG8_LAS bf16x8*)(lds + PG8_SB(b, h) + boff + n * 2048 + k * 1024); } while (0)
#define PG8_MMA(ai, bj, At, Bt) do { __builtin_amdgcn_s_setprio(1); _Pragma("unroll") for (int m = 0; m < 4; ++m) _Pragma("unroll") for (int n = 0; n < 2; ++n) _Pragma("unroll") for (int k = 0; k < 2; ++k) \
        acc[ai][bj][m][n] = mma16<I8>(Bt[n][k], At[m][k], acc[ai][bj][m][n]); __builtin_amdgcn_s_setprio(0); } while (0)
#define PG8_WAIT_V(n) asm volatile("s_waitcnt vmcnt(" #n ")" ::: "memory")
#define PG8_WAIT_L(n) asm volatile("s_waitcnt lgkmcnt(" #n ")" ::: "memory")
#define PG8_BAR __builtin_amdgcn_s_barrier()
#define PG8_SCHED __builtin_amdgcn_sched_barrier(0)
    Unit cur, nxt; int ui = 0;
    if (!S.next(0, cur)) return;
    f32x4 acc[2][2][4][2];
#pragma unroll
    for (int a = 0; a < 2; ++a)
#pragma unroll
        for (int b = 0; b < 2; ++b)
#pragma unroll
            for (int m = 0; m < 4; ++m)
#pragma unroll
                for (int n = 0; n < 2; ++n) acc[a][b][m][n] = (f32x4){0.f, 0.f, 0.f, 0.f};
    bf16x8 At[4][2], B0[2][2], B1[2][2];
    const char* cA = (const char*)g.A + (size_t)cur.pm * tstep; const char* cB = (const char*)g.Bt + (size_t)cur.pn * tstep;
    S.a_ready(cur);
    PG8_STAGE(PG8_SB(0, 0), cB, voffB); PG8_STAGE(PG8_SA(0, 0), cA, voffA); PG8_STAGE(PG8_SB(0, 1), cB + hstep, voffB); PG8_STAGE(PG8_SA(0, 1), cA + hstep, voffA);
    if (wr == 1) PG8_BAR;
    PG8_WAIT_V(4); PG8_BAR;
    PG8_STAGE(PG8_SB(1, 0), cB + kstep, voffB); PG8_STAGE(PG8_SA(1, 0), cA + kstep, voffA); PG8_STAGE(PG8_SB(1, 1), cB + hstep + kstep, voffB);
    PG8_WAIT_V(6); PG8_BAR;
    for (;;) {
        const bool has_next = S.next(ui + 1, nxt);
        const char* nA = has_next ? (const char*)g.A + (size_t)nxt.pm * tstep : cA; const char* nB = has_next ? (const char*)g.Bt + (size_t)nxt.pn * tstep : cB;
        for (int t = 0; t < nt; t += 2) {
            const bool last = (t == nt - 2);
            const char* a1 = cA + (size_t)(t + 1) * kstep;
            const char* a2 = last ? nA : cA + (size_t)(t + 2) * kstep; const char* b2 = last ? nB : cB + (size_t)(t + 2) * kstep;
            const char* a3 = a2 + kstep; const char* b3 = b2 + kstep;
            if (last && has_next) S.a_ready(nxt);
            PG8_LDB(B0, 0, 0); PG8_SCHED; PG8_LDA(At, 0, 0); PG8_STAGE(PG8_SA(1, 1), a1 + hstep, voffA);
            PG8_WAIT_L(8); PG8_BAR; PG8_WAIT_L(0); PG8_MMA(0, 0, At, B0); PG8_BAR; PG8_SCHED;
            PG8_LDB(B1, 0, 1); PG8_STAGE(PG8_SB(0, 0), b2, voffB);
            PG8_BAR; PG8_WAIT_L(0); PG8_MMA(0, 1, At, B1); PG8_BAR;
            PG8_LDA(At, 0, 1); PG8_STAGE(PG8_SA(0, 0), a2, voffA);
            PG8_BAR; PG8_WAIT_L(0); PG8_MMA(1, 0, At, B0); PG8_BAR; PG8_SCHED;
            PG8_STAGE(PG8_SB(0, 1), b2 + hstep, voffB);
            PG8_WAIT_V(6); PG8_BAR; PG8_MMA(1, 1, At, B1); PG8_BAR;
            PG8_LDB(B0, 1, 0); PG8_SCHED; PG8_LDA(At, 1, 0); PG8_STAGE(PG8_SA(0, 1), a2 + hstep, voffA);
            PG8_WAIT_L(8); PG8_BAR; PG8_WAIT_L(0); PG8_MMA(0, 0, At, B0); PG8_BAR; PG8_SCHED;
            PG8_LDB(B1, 1, 1); PG8_STAGE(PG8_SB(1, 0), b3, voffB);
            PG8_BAR; PG8_WAIT_L(0); PG8_MMA(0, 1, At, B1); PG8_BAR;
            PG8_LDA(At, 1, 1); PG8_STAGE(PG8_SA(1, 0), a3, voffA);
            PG8_BAR; PG8_WAIT_L(0); PG8_MMA(1, 0, At, B0); PG8_BAR; PG8_SCHED;
            PG8_STAGE(PG8_SB(1, 1), b3 + hstep, voffB);
            PG8_WAIT_V(6); PG8_BAR; PG8_MMA(1, 1, At, B1); PG8_BAR;
        }
        if constexpr (!Epi::AFTER_DRAIN) { E(acc, cur, wr, wc, fr, fq); S.done(cur); }
        if (!has_next) break;
#pragma unroll
        for (int a = 0; a < 2; ++a)
#pragma unroll
            for (int b = 0; b < 2; ++b)
#pragma unroll
                for (int m = 0; m < 4; ++m)
#pragma unroll
                    for (int n = 0; n < 2; ++n) acc[a][b][m][n] = (f32x4){0.f, 0.f, 0.f, 0.f};
        cur = nxt; cA = nA; cB = nB; ++ui;
    }
    PG8_WAIT_V(0);
    if (wr == 0) PG8_BAR;
    PG8_BAR;
    if constexpr (Epi::AFTER_DRAIN) { E.fused(acc, cur, wr, wc, fr, fq, lds, wid, lane); S.done(cur); }
#undef PG8_SA
#undef PG8_SB
#undef PG8_STAGE
#undef PG8_LDA
#undef PG8_LDB
#undef PG8_MMA
#undef PG8_WAIT_V
#undef PG8_WAIT_L
#undef PG8_BAR
#undef PG8_SCHED
}
}

__host__ __device__ __forceinline__ int cmap_in(int F) { return (F & ~255) + 128 * ((F >> 5) & 1) + 32 * ((F >> 6) & 3) + (F & 31); }
struct EpiInprojMF {
    static constexpr bool PERM = true, AFTER_DRAIN = false;
    bf16_t* P; const float* rinv; const float* bias_f; const int* pos; const float* ftab; const float* qg; const float* kg; const float* swf;
    __device__ __forceinline__ void operator()(pg8::f32x4 (&acc)[2][2][4][2], const pg8::Unit& u, int wr, int wc, int fr, int fq) const {
        typedef pg8::f32x4 f32x4;
        asm volatile("" : "+v"(fr), "+v"(fq));
        const int type = u.pn >> 1, head = 4 * (u.pn & 1) + wc, fb = 256 * u.pn + 64 * wc;
        {
            f32x4 sw[2][2];
#pragma unroll
            for (int bj = 0; bj < 2; ++bj)
#pragma unroll
                for (int n = 0; n < 2; ++n) sw[bj][n] = *(const f32x4*)(swf + fb + 32 * bj + 8 * fq + 4 * n);
#pragma unroll
            for (int ai = 0; ai < 2; ++ai)
#pragma unroll
                for (int bj = 0; bj < 2; ++bj)
#pragma unroll
                    for (int m = 0; m < 4; ++m)
#pragma unroll
                        for (int n = 0; n < 2; ++n) {
                            const pg8::i32x4 iv = __builtin_bit_cast(pg8::i32x4, acc[ai][bj][m][n]);
                            f32x4 fv; fv[0] = (float)iv[0]; fv[1] = (float)iv[1]; fv[2] = (float)iv[2]; fv[3] = (float)iv[3];
                            acc[ai][bj][m][n] = fv * sw[bj][n];
                        }
        }
        const size_t PSZ = (size_t)T * 512;
        const int rslot = (type == 0) ? 0 : (type == 1) ? 1 : (type == 2) ? 5 : (type == 3) ? 2 : (type == 4) ? 3 : (type == 5) ? 4 : 6;
        bf16_t* rowmaj = P + (size_t)rslot * PSZ;
        const int t0 = u.pm * 256 + wr * 64 + fr;
        f32x4 bv[2][2], gv[2][2], fh[2], fl[2];
#pragma unroll
        for (int bj = 0; bj < 2; ++bj)
#pragma unroll
            for (int n = 0; n < 2; ++n) bv[bj][n] = *(const f32x4*)(bias_f + fb + 32 * bj + 8 * fq + 4 * n);
        if (type <= 1) {
#pragma unroll
            for (int n = 0; n < 2; ++n) { fh[n] = *(const f32x4*)(ftab + 8 * fq + 4 * n); fl[n] = *(const f32x4*)(ftab + 32 + 8 * fq + 4 * n); }
        } else if (type == 4 || type == 5) {
            const float* gsrc = (type == 4) ? qg : kg;
#pragma unroll
            for (int bj = 0; bj < 2; ++bj)
#pragma unroll
                for (int n = 0; n < 2; ++n) gv[bj][n] = *(const f32x4*)(gsrc + 32 * bj + 8 * fq + 4 * n);
        }
#pragma unroll
        for (int ai = 0; ai < 2; ++ai) {
            float rv[4], pf[4];
#pragma unroll
            for (int m = 0; m < 4; ++m) { rv[m] = rinv[t0 + ai * 128 + m * 16]; pf[m] = (float)pos[t0 + ai * 128 + m * 16]; }
            asm volatile("" : "+v"(rv[0]), "+v"(rv[1]), "+v"(rv[2]), "+v"(rv[3]), "+v"(pf[0]), "+v"(pf[1]), "+v"(pf[2]), "+v"(pf[3]));
#pragma unroll
            for (int m = 0; m < 4; ++m) {
                const int t = t0 + ai * 128 + m * 16;
                const float r = rv[m];
                f32x4 v[2][2];
#pragma unroll
                for (int bj = 0; bj < 2; ++bj)
#pragma unroll
                    for (int n = 0; n < 2; ++n) v[bj][n] = acc[ai][bj][m][n] * r + bv[bj][n];
                if (type <= 1) {
                    const float sc = (type == 1) ? 0.125f : 1.f, pp = pf[m];
#pragma unroll
                    for (int n = 0; n < 2; ++n)
#pragma unroll
                        for (int j = 0; j < 4; ++j) {
                            const float rev = __builtin_amdgcn_fractf(__builtin_amdgcn_fractf(pp * fh[n][j]) + pp * fl[n][j]);
                            const float cs = __builtin_amdgcn_cosf(rev) * sc, sn = __builtin_amdgcn_sinf(rev) * sc;
                            const float x1 = v[0][n][j], x2 = v[1][n][j]; v[0][n][j] = x1 * cs - x2 * sn; v[1][n][j] = x2 * cs + x1 * sn;
                        }
                } else if (type == 3) {
#pragma unroll
                    for (int bj = 0; bj < 2; ++bj)
#pragma unroll
                        for (int n = 0; n < 2; ++n)
#pragma unroll
                            for (int j = 0; j < 4; ++j) { const float x = v[bj][n][j]; v[bj][n][j] = x / (1.f + __expf(-x)); }
                } else if (type == 4 || type == 5) {
                    float ss = 0.f;
#pragma unroll
                    for (int bj = 0; bj < 2; ++bj)
#pragma unroll
                        for (int n = 0; n < 2; ++n)
#pragma unroll
                            for (int j = 0; j < 4; ++j) ss += v[bj][n][j] * v[bj][n][j];
                    ss += __shfl_xor(ss, 16); ss += __shfl_xor(ss, 32);
                    const float rn = (1.0f / sqrtf(ss * (1.f / 64.f) + EPS)) * ((type == 4) ? 0.125f * 1.44269504089f : 1.f);
#pragma unroll
                    for (int bj = 0; bj < 2; ++bj)
#pragma unroll
                        for (int n = 0; n < 2; ++n) v[bj][n] = v[bj][n] * rn * gv[bj][n];
                }
#pragma unroll
                for (int bj = 0; bj < 2; ++bj) {
                    pg8::u32x4 w; w.x = pg8::cvt_pk_bf16(v[bj][0][0], v[bj][0][1]); w.y = pg8::cvt_pk_bf16(v[bj][0][2], v[bj][0][3]);
                    w.z = pg8::cvt_pk_bf16(v[bj][1][0], v[bj][1][1]); w.w = pg8::cvt_pk_bf16(v[bj][1][2], v[bj][1][3]);
                    *(pg8::u32x4*)(rowmaj + (size_t)t * 512 + head * 64 + 32 * bj + 8 * fq) = w;
                }
            }
        }
    }
};

struct EpiOutprojMF {
    static constexpr bool PERM = false, AFTER_DRAIN = true;
    const bf16_t* xb; const float* gate1; bf16_t* x1b; float* part2;
    __device__ __forceinline__ void operator()(const pg8::f32x4 (&)[2][2][4][2], const pg8::Unit&, int, int, int, int) const {}
    __device__ __forceinline__ void fused(pg8::f32x4 (&acc)[2][2][4][2], const pg8::Unit& u, int wr, int wc, int fr, int fq, PG8_LAS unsigned char* lds, int wid, int lane) const {
        typedef pg8::f32x4 f32x4;
        asm volatile("" : "+v"(fr), "+v"(fq), "+v"(lane));
        constexpr int LD = 260;
        PG8_LAS float* TL = (PG8_LAS float*)lds;
        const int colw = wc * 32 + 4 * fq;
        f32x4 gv[2][2];
#pragma unroll
        for (int bj = 0; bj < 2; ++bj)
#pragma unroll
            for (int n = 0; n < 2; ++n) gv[bj][n] = *(const f32x4*)(gate1 + u.pn * 256 + colw + bj * 128 + n * 16);
#pragma unroll
        for (int ai = 0; ai < 2; ++ai) {
#pragma unroll
            for (int m = 0; m < 4; ++m)
#pragma unroll
                for (int bj = 0; bj < 2; ++bj)
#pragma unroll
                    for (int n = 0; n < 2; ++n) *(PG8_LAS f32x4*)(TL + (64 * wr + 16 * m + fr) * LD + colw + bj * 128 + n * 16) = gv[bj][n] * acc[ai][bj][m][n];
            __syncthreads();
            pg8::u32x2 xv[2];
            const size_t rowbase = (size_t)(u.pm * 256 + ai * 128 + 16 * wid) * D + u.pn * 256 + 4 * lane;
            xv[0] = *(const pg8::u32x2*)(xb + rowbase);
#pragma unroll
            for (int r = 0; r < 16; ++r) {
                if (r < 15) xv[(r + 1) & 1] = *(const pg8::u32x2*)(xb + rowbase + (size_t)(r + 1) * D);
                const f32x4 g = *(PG8_LAS f32x4*)(TL + (16 * wid + r) * LD + 4 * lane);
                const pg8::u32x2 xw = xv[r & 1];
                f32x4 o; o[0] = __uint_as_float(xw.x << 16) + g[0]; o[1] = __uint_as_float(xw.x & 0xffff0000u) + g[1]; o[2] = __uint_as_float(xw.y << 16) + g[2]; o[3] = __uint_as_float(xw.y & 0xffff0000u) + g[3];
                pg8::u32x2 w; w.x = pg8::cvt_pk_bf16(o[0], o[1]); w.y = pg8::cvt_pk_bf16(o[2], o[3]);
                *(pg8::u32x2*)(x1b + rowbase + (size_t)r * D) = w;
                float ss = o[0] * o[0] + o[1] * o[1] + o[2] * o[2] + o[3] * o[3];
#pragma unroll
                for (int o2 = 32; o2 > 0; o2 >>= 1) ss += __shfl_xor(ss, o2);
                if (lane < 4) part2[(size_t)(u.pm * 256 + ai * 128 + 16 * wid + r) * 16 + u.pn * 4 + lane] = (lane == 0) ? ss : 0.f;
            }
            __syncthreads();
        }
    }
};

__device__ __forceinline__ unsigned pk2(float lo, float hi) { return (unsigned)f2bf(lo) | ((unsigned)f2bf(hi) << 16); }
template <bool FOLD, bool CMAP>
__device__ __forceinline__ void transpose_item(const float* W, int K, int N, bf16_t* WT, float* scr, int item, int lane, const float* sg, const float* sm) {
    const int nblk = N / 32, kb = item / nblk, nb = item % nblk, k0 = 64 * kb, n0 = 32 * nb;
    float4 v[8]; float f[8];
#pragma unroll
    for (int i = 0; i < 8; ++i) { const int kk = 8 * i + (lane >> 3); v[i] = *(const float4*)(W + (size_t)(k0 + kk) * N + n0 + 4 * (lane & 7));
        f[i] = FOLD ? sg[k0 + kk] * (1.f + sm[k0 + kk]) : 1.f; }
#pragma unroll
    for (int i = 0; i < 8; ++i) { const int kk = 8 * i + (lane >> 3); float* d = scr + kk * 33 + 4 * (lane & 7);
        d[0] = v[i].x * f[i]; d[1] = v[i].y * f[i]; d[2] = v[i].z * f[i]; d[3] = v[i].w * f[i]; }
    asm volatile("s_waitcnt lgkmcnt(0)" ::: "memory");
    const int c = lane & 7, r0 = CMAP ? cmap_in(n0) : n0;
#pragma unroll
    for (int j = 0; j < 4; ++j) { const int n = (lane >> 3) + 8 * j; const float* s = scr + (8 * c) * 33 + n;
        pg8::u32x4 o; o.x = pk2(s[0 * 33], s[1 * 33]); o.y = pk2(s[2 * 33], s[3 * 33]); o.z = pk2(s[4 * 33], s[5 * 33]); o.w = pk2(s[6 * 33], s[7 * 33]);
        *(pg8::u32x4*)(WT + (size_t)(r0 + n) * K + k0 + 8 * c) = o; }
    asm volatile("s_waitcnt lgkmcnt(0)" ::: "memory");
}
template <int NC4, class VF>
__device__ __forceinline__ void gemv_cols(unsigned char* lds, const VF vf, const float* W, const int N, const int u, float* dst, const float* add) {
    constexpr int RG = 512 / NC4;
    float (*red)[NC4 * 4] = (float (*)[NC4 * 4])lds;
    const int tid = threadIdx.x, c4 = tid % NC4, rg = tid / NC4;
    if (rg < RG) {
        float4 acc = {0.f, 0.f, 0.f, 0.f};
        for (int r = rg; r < 1024; r += RG) { const float s = vf(r); const float4 w = *(const float4*)(W + (size_t)r * N + u * NC4 * 4 + c4 * 4);
            acc.x += s * w.x; acc.y += s * w.y; acc.z += s * w.z; acc.w += s * w.w; }
        red[rg][c4 * 4 + 0] = acc.x; red[rg][c4 * 4 + 1] = acc.y; red[rg][c4 * 4 + 2] = acc.z; red[rg][c4 * 4 + 3] = acc.w;
    }
    __syncthreads();
    if (tid < NC4 * 4) { float s = 0.f; for (int i = 0; i < RG; ++i) s += red[i][tid]; dst[u * NC4 * 4 + tid] = s + (add ? add[u * NC4 * 4 + tid] : 0.f); }
    __syncthreads();
}
struct VfSilu { const float* c; __device__ __forceinline__ float operator()(int r) const { const float v = c[r]; return v / (1.f + expf(-v)); } };
struct VfVec { const float* v; __device__ __forceinline__ float operator()(int r) const { return v[r]; } };


typedef float f32x16 __attribute__((ext_vector_type(16)));
typedef pg8::bf16x8 bf16x8;
#define MFMA32(a, b, c) __builtin_amdgcn_mfma_f32_32x32x16_bf16((a), (b), (c), 0, 0, 0)
__device__ __forceinline__ bf16x8 pack_frag(const f32x16& v, int s) {
    pg8::u32x4 w;
    w.x = pg8::cvt_pk_bf16(v[8 * s + 0], v[8 * s + 1]); w.y = pg8::cvt_pk_bf16(v[8 * s + 2], v[8 * s + 3]);
    w.z = pg8::cvt_pk_bf16(v[8 * s + 4], v[8 * s + 5]); w.w = pg8::cvt_pk_bf16(v[8 * s + 6], v[8 * s + 7]);
    return __builtin_bit_cast(bf16x8, w);
}
__device__ __forceinline__ bf16x8 load_tfrag(const bf16_t* rowp, int tok) {
    const uint2 a = *(const uint2*)(rowp + tok), b = *(const uint2*)(rowp + tok + 8);
    pg8::u32x4 w; w.x = a.x; w.y = a.y; w.z = b.x; w.w = b.y;
    return __builtin_bit_cast(bf16x8, w);
}


__device__ __forceinline__ bf16x8 tr_frag(const unsigned char* a0, int rows2) {
    typedef short s16x4 __attribute__((ext_vector_type(4)));
    typedef __attribute__((address_space(3))) s16x4 lds_s16x4;
    const s16x4 lo = __builtin_amdgcn_ds_read_tr16_b64_v4i16((lds_s16x4*)a0);
    const s16x4 hi = __builtin_amdgcn_ds_read_tr16_b64_v4i16((lds_s16x4*)(a0 + rows2 * 144));
    const uint2 l2 = __builtin_bit_cast(uint2, lo), h2 = __builtin_bit_cast(uint2, hi);
    pg8::u32x4 fw; fw.x = l2.x; fw.y = l2.y; fw.z = h2.x; fw.w = h2.y;
    return __builtin_bit_cast(bf16x8, fw);
}

__device__ __forceinline__ void ins16(float (&s)[16], float x) {
#pragma unroll
    for (int i = 15; i >= 1; --i) s[i] = __builtin_amdgcn_fmed3f(s[i - 1], s[i], x);
    s[0] = fmaxf(s[0], x);
}


struct OneUnitOrder {
    pg8::StaticOrder base; int round;
    __device__ __forceinline__ bool next(int i, pg8::Unit& u) const { if (i != 0) return false; return base.next(round, u); }
    __device__ __forceinline__ void a_ready(const pg8::Unit&) const {}
    __device__ __forceinline__ void done(const pg8::Unit&) const {}
};
struct EpiTopkMF {
    static constexpr bool PERM = false, AFTER_DRAIN = true;
    const float* part2; const float* bias_q; unsigned short* ids; float* gates;
    __device__ __forceinline__ void operator()(const pg8::f32x4 (&)[2][2][4][2], const pg8::Unit&, int, int, int, int) const {}
    __device__ __forceinline__ void fused(pg8::f32x4 (&acc)[2][2][4][2], const pg8::Unit& u, int wr, int wc, int fr, int fq, PG8_LAS unsigned char* lds, int wid, int lane) const {
        typedef pg8::f32x4 f32x4;
        constexpr int SLD = 260;
        PG8_LAS float* SC = (PG8_LAS float*)lds; PG8_LAS float* MG = (PG8_LAS float*)(lds + 128 * SLD * 4);
        const int tid = wid * 64 + lane, tok = tid & 255, hk = tid >> 8;
        float rinv[2][4];
#pragma unroll
        for (int ai = 0; ai < 2; ++ai)
#pragma unroll
            for (int m = 0; m < 4; ++m) {
                const int row = u.pm * 256 + ai * 128 + wr * 64 + m * 16 + fr;
                const f32x4* pp = (const f32x4*)(part2 + (size_t)row * 16);
                const f32x4 p0 = pp[0], p1 = pp[1], p2 = pp[2], p3 = pp[3];
                const float ssum = ((p0[0] + p0[1]) + (p0[2] + p0[3])) + ((p1[0] + p1[1]) + (p1[2] + p1[3])) + ((p2[0] + p2[1]) + (p2[2] + p2[3])) + ((p3[0] + p3[1]) + (p3[2] + p3[3]));
                rinv[ai][m] = 1.0f / sqrtf(ssum * (1.0f / D) + EPS);
            }
        float sl[16], mine[16];
#pragma unroll
        for (int p = 0; p < 2; ++p) {
            f32x4 bv[2];
#pragma unroll
            for (int n = 0; n < 2; ++n) bv[n] = *(const f32x4*)(bias_q + u.pn * 256 + p * 128 + wc * 32 + n * 16 + 4 * fq);
#pragma unroll
            for (int ai = 0; ai < 2; ++ai)
#pragma unroll
                for (int m = 0; m < 4; ++m)
#pragma unroll
                    for (int n = 0; n < 2; ++n)
#pragma unroll
                        for (int j = 0; j < 4; ++j)
                            SC[(32 * wc + 16 * n + 4 * fq + j) * SLD + (128 * ai + 64 * wr + 16 * m + fr)] = acc[ai][p][m][n][j] * rinv[ai][m] + bv[n][j];
            __syncthreads();
#pragma unroll
            for (int i = 0; i < 16; ++i) sl[i] = -INFINITY;
#pragma unroll 8
            for (int k = 0; k < 64; ++k) { const int key = 64 * hk + k; const float x = SC[key * SLD + tok]; ins16(sl, __uint_as_float((__float_as_uint(x) & 0xFFFFFF80u) | (unsigned)key)); }
            if (hk != p) {
#pragma unroll
                for (int i = 0; i < 16; ++i) MG[i * 256 + tok] = sl[i];
            }
            __syncthreads();
            if (hk == p) {
#pragma unroll
                for (int i = 0; i < 16; ++i) ins16(sl, MG[i * 256 + tok]);
#pragma unroll
                for (int i = 0; i < 16; ++i) mine[i] = sl[i];
            }
            __syncthreads();
        }
        PG8_LAS float* X1 = SC; PG8_LAS float* TL = SC + 4096; PG8_LAS unsigned* I0 = (PG8_LAS unsigned*)(SC + 8192); PG8_LAS unsigned* I1 = (PG8_LAS unsigned*)(SC + 12288);
        if (hk) {
#pragma unroll
            for (int i = 0; i < 16; ++i) { X1[i * 256 + tok] = mine[i]; I1[i * 256 + tok] = __float_as_uint(mine[i]) & 0x7Fu; }
        } else {
#pragma unroll
            for (int i = 0; i < 16; ++i) I0[i * 256 + tok] = __float_as_uint(mine[i]) & 0x7Fu;
        }
        __syncthreads();
        if (!hk) {
            float s1m[16], tl[16];
#pragma unroll
            for (int i = 0; i < 16; ++i) { s1m[i] = __uint_as_float(__float_as_uint(X1[i * 256 + tok]) & 0xFFFFFF80u); mine[i] = __uint_as_float(__float_as_uint(mine[i]) & 0xFFFFFF80u); tl[i] = -INFINITY; }
#pragma unroll
            for (int a2 = 0; a2 < 16; ++a2)
#pragma unroll
                for (int b2 = 0; b2 < 16; ++b2)
                    if ((a2 + 1) * (b2 + 1) <= 16) ins16(tl, __uint_as_float((__float_as_uint(mine[a2] + s1m[b2]) & 0xFFFFFF00u) | (unsigned)(a2 * 16 + b2)));
#pragma unroll
            for (int i = 0; i < 16; ++i) TL[i * 256 + tok] = tl[i];
        }
        __syncthreads();
        if (hk) {
            float ev[16]; float sum = 0.f; unsigned cd[16];
#pragma unroll
            for (int j = 0; j < 16; ++j) { const unsigned bits = __float_as_uint(TL[j * 256 + tok]); cd[j] = bits & 0xFFu; ev[j] = __uint_as_float(bits & 0xFFFFFF00u); }
            const float mx = ev[0];
#pragma unroll
            for (int j = 0; j < 16; ++j) { ev[j] = __expf(ev[j] - mx); sum += ev[j]; }
            const float inv = 1.f / sum;
            unsigned idw[8];
#pragma unroll
            for (int j = 0; j < 16; ++j) {
                const unsigned id = I0[(cd[j] >> 4) * 256 + tok] * 128u + I1[(cd[j] & 15u) * 256 + tok];
                if (j & 1) idw[j >> 1] |= id << 16; else idw[j >> 1] = id;
                ev[j] *= inv;
            }
            const size_t t = (size_t)u.pm * 256 + tok;
            unsigned short* idp = ids + t * 128 + u.pn * 16; float* gp = gates + t * 128 + u.pn * 16;
            *(uint4*)idp = make_uint4(idw[0], idw[1], idw[2], idw[3]); *(uint4*)(idp + 8) = make_uint4(idw[4], idw[5], idw[6], idw[7]);
#pragma unroll
            for (int q = 0; q < 4; ++q) *(float4*)(gp + 4 * q) = make_float4(ev[4 * q], ev[4 * q + 1], ev[4 * q + 2], ev[4 * q + 3]);
        }
        __syncthreads();
    }
};


__device__ __forceinline__ void convert_tables(const float* down, const float* up, unsigned char* q8, bf16_t* dsc, int lane, int cw, int nconv, int r0, int r1) {
    for (int row0 = r0 + cw * 2; row0 < r1; row0 += nconv * 2) {
        float4 v[2][4];
#pragma unroll
        for (int rr = 0; rr < 2; ++rr) {
            const int row = row0 + rr, isup = row >> 14, e = row & 16383;
            const float* sp = (isup ? up : down) + (size_t)e * 1024 + lane * 4;
#pragma unroll
            for (int q = 0; q < 4; ++q) v[rr][q] = ld_nt4(sp + 256 * q);
        }
#pragma unroll
        for (int rr = 0; rr < 2; ++rr) {
            const int row = row0 + rr, isup = row >> 14, e = row & 16383;
            {
                float ss = 0.f;
#pragma unroll
                for (int q = 0; q < 4; ++q) ss += v[rr][q].x * v[rr][q].x + v[rr][q].y * v[rr][q].y + v[rr][q].z * v[rr][q].z + v[rr][q].w * v[rr][q].w;
#pragma unroll
                for (int o = 32; o > 0; o >>= 1) ss += __shfl_xor(ss, o);
                const float sigma = sqrtf(ss * (1.0f / 1024.0f));
                const float s = (sigma > 0.f) ? 7.5f / (2.6f * sigma) : 1.f;
#pragma unroll
                for (int q = 0; q < 4; ++q) {
                    const int n0 = (int)fminf(fmaxf(__builtin_rintf(v[rr][q].x * s), -8.f), 7.f) + 8, n1 = (int)fminf(fmaxf(__builtin_rintf(v[rr][q].y * s), -8.f), 7.f) + 8;
                    const int n2 = (int)fminf(fmaxf(__builtin_rintf(v[rr][q].z * s), -8.f), 7.f) + 8, n3 = (int)fminf(fmaxf(__builtin_rintf(v[rr][q].w * s), -8.f), 7.f) + 8;
                    const int h1 = isup ? ((n1 - 8) & 15) : n1, h3 = isup ? ((n3 - 8) & 15) : n3;
                    *(unsigned short*)(q8 + (size_t)isup * (8u << 20) + ((size_t)q * 16384 + e) * 128 + (lane & 7) * 16 + (lane >> 3) * 2) = (unsigned short)(n0 | (h1 << 4) | (n2 << 8) | (h3 << 12));
                }
                if (lane == 0) dsc[row] = f2bf(1.0f / s);
            }
        }
    }
}

struct Params {
    const float *x, *c; const int* pos; const float *ada_w, *ada_b, *g1, *g2, *w_in, *rgain, *qg, *kg, *og, *w_out, *wq, *sk, *down, *up;
    float* out; unsigned char* ws; RopeC rc;
};

__global__ void __launch_bounds__(512) mk_fwd(Params p) {
    extern __shared__ __attribute__((aligned(16))) unsigned char lds[];
    const int tid = threadIdx.x, lane = tid & 63, bid = blockIdx.x, G = gridDim.x; int wave = tid >> 6;
    unsigned char* ws = p.ws;
    float* mod = (float*)(ws + OFF_MOD); float* rinv1 = (float*)(ws + OFF_RINV1); float* ftab = (float*)(ws + OFF_ROPE);
    bf16_t* P = (bf16_t*)(ws + OFF_P); float* kv = (float*)(ws + OFF_KV); bf16_t* stT = (bf16_t*)(ws + OFF_ST); bf16_t* ycat = (bf16_t*)(ws + OFF_YCAT);
    bf16_t* xb = (bf16_t*)(ws + OFF_XB); bf16_t* Win_t = (bf16_t*)(ws + OFF_WINT); float* bias_f = (float*)(ws + OFF_BIASF);
    unsigned char* xq = ws + OFF_XQ; float* swf = (float*)(ws + OFF_SWF);
    bf16_t* Weff_t = (bf16_t*)(ws + OFF_WEFFT); bf16_t* Wout_t = (bf16_t*)(ws + OFF_WOUTT); float* bias_q = (float*)(ws + OFF_BIASQ); float* bq_part = (float*)(ws + OFF_BQPART);
    float* part2 = (float*)(ws + OFF_PART2); bf16_t* x1b = (bf16_t*)(ws + OFF_X1B); unsigned short* ids = (unsigned short*)(ws + OFF_IDS); unsigned char* q8 = ws + OFF_Q8; bf16_t* dsc = (bf16_t*)(ws + OFF_DSC); float* gates = (float*)(ws + OFF_GATES);
    const size_t PS = (size_t)T * 512;
    const bf16_t *Qr = P, *Kr = P + PS, *Gr = P + 2 * PS, *Qs = P + 3 * PS, *Ks = P + 4 * PS, *Vr = P + 5 * PS, *Vs = P + 6 * PS;
    float* out = p.out;

    if (tid < 4) ((LAS unsigned*)((LAS unsigned char*)lds + LDS_ST_OFF))[tid] = 0u;
    __syncthreads();
    XcdBarrier bar = xcd_barrier_post((unsigned*)(ws + OFF_CTL), (volatile LAS unsigned*)((LAS unsigned char*)lds + LDS_ST_OFF));

    for (int u = bid; u < 256; u += G) gemv_cols<6>(lds, VfSilu{p.c}, p.ada_w, 6144, u, mod, p.ada_b);
    for (int row0 = (bid * 8 + wave) * 2; row0 < T; row0 += G * 16) {
        float4 v[2][4];
#pragma unroll
        for (int rr = 0; rr < 2; ++rr)
#pragma unroll
            for (int j = 0; j < 4; ++j) v[rr][j] = ld_nt4(p.x + (size_t)(row0 + rr) * D + (lane + 64 * j) * 4);
#pragma unroll
        for (int rr = 0; rr < 2; ++rr) {
            uint2* xo = (uint2*)(xb + (size_t)(row0 + rr) * D);
            float s = 0.f, am = 0.f;
#pragma unroll
            for (int j = 0; j < 4; ++j) { const float4 q = v[rr][j]; s += q.x * q.x + q.y * q.y + q.z * q.z + q.w * q.w;
                am = fmaxf(fmaxf(am, fmaxf(fabsf(q.x), fabsf(q.y))), fmaxf(fabsf(q.z), fabsf(q.w))); xo[lane + 64 * j] = make_uint2(pk2(q.x, q.y), pk2(q.z, q.w)); }
#pragma unroll
            for (int o = 32; o > 0; o >>= 1) { s += __shfl_xor(s, o); am = fmaxf(am, __shfl_xor(am, o)); }
            const float qs = (am > 0.f) ? 127.f / am : 0.f;
            unsigned* xqo = (unsigned*)(xq + (size_t)(row0 + rr) * D);
#pragma unroll
            for (int j = 0; j < 4; ++j) { const float4 q = v[rr][j];
                const unsigned b0 = __float_as_uint(fmaf(q.x, qs, 12582912.f)), b1 = __float_as_uint(fmaf(q.y, qs, 12582912.f)), b2 = __float_as_uint(fmaf(q.z, qs, 12582912.f)), b3 = __float_as_uint(fmaf(q.w, qs, 12582912.f));
                xqo[lane + 64 * j] = (b0 & 255u) | ((b1 & 255u) << 8) | ((b2 & 255u) << 16) | (b3 << 24); }
            if (lane == 0) rinv1[row0 + rr] = (1.0f / sqrtf(s * (1.0f / D) + EPS)) * (am * (1.f / 127.f));
        }
    }
    if (bid == 0 && tid == 0) {
#pragma unroll
        for (int i = 0; i < 32; ++i) { ftab[i] = p.rc.fh[i]; ftab[32 + i] = p.rc.fl[i]; }
    }
    xcd_barrier(bar);

    {
        for (int nb = bid; nb < 112; nb += G) {
            const int n0 = 32 * nb, r8 = lane >> 3, c = lane & 7, kw = 128 * wave;
            float* cm = (float*)(lds + 8 * 4608);
            unsigned* tl = (unsigned*)(lds + wave * 4608);
            float4 v[16];
#pragma unroll
            for (int i = 0; i < 16; ++i) { const int kk = 32 * (i >> 2) + 4 * r8 + (i & 3); v[i] = *(const float4*)(p.w_in + (size_t)(kw + kk) * 3584 + n0 + 4 * c); }
            float4 mx = {0.f, 0.f, 0.f, 0.f};
#pragma unroll
            for (int i = 0; i < 16; ++i) { const int kk = 32 * (i >> 2) + 4 * r8 + (i & 3); const float f = p.g1[kw + kk] * (1.f + mod[1024 + kw + kk]);
                v[i].x *= f; v[i].y *= f; v[i].z *= f; v[i].w *= f;
                mx.x = fmaxf(mx.x, fabsf(v[i].x)); mx.y = fmaxf(mx.y, fabsf(v[i].y)); mx.z = fmaxf(mx.z, fabsf(v[i].z)); mx.w = fmaxf(mx.w, fabsf(v[i].w)); }
#pragma unroll
            for (int o = 8; o < 64; o <<= 1) { mx.x = fmaxf(mx.x, __shfl_xor(mx.x, o)); mx.y = fmaxf(mx.y, __shfl_xor(mx.y, o)); mx.z = fmaxf(mx.z, __shfl_xor(mx.z, o)); mx.w = fmaxf(mx.w, __shfl_xor(mx.w, o)); }
            if (lane < 8) *(float4*)(cm + wave * 32 + 4 * c) = mx;
            __syncthreads();
#pragma unroll
            for (int w2 = 0; w2 < 8; ++w2) { const float4 o = *(const float4*)(cm + w2 * 32 + 4 * c); mx.x = fmaxf(mx.x, o.x); mx.y = fmaxf(mx.y, o.y); mx.z = fmaxf(mx.z, o.z); mx.w = fmaxf(mx.w, o.w); }
            if (wave == 0 && lane < 8) *(float4*)(swf + n0 + 4 * c) = make_float4(mx.x * (1.f / 127.f), mx.y * (1.f / 127.f), mx.z * (1.f / 127.f), mx.w * (1.f / 127.f));
            const float qx = (mx.x > 0.f) ? 127.f / mx.x : 0.f, qy = (mx.y > 0.f) ? 127.f / mx.y : 0.f, qz = (mx.z > 0.f) ? 127.f / mx.z : 0.f, qw = (mx.w > 0.f) ? 127.f / mx.w : 0.f;
#pragma unroll
            for (int a = 0; a < 4; ++a) {
                unsigned d[4];
#pragma unroll
                for (int j = 0; j < 4; ++j) {
                    const float qq = (j == 0) ? qx : (j == 1) ? qy : (j == 2) ? qz : qw;
                    unsigned w = 0;
#pragma unroll
                    for (int b = 0; b < 4; ++b) { const float4 t = v[4 * a + b]; const float e = (j == 0) ? t.x : (j == 1) ? t.y : (j == 2) ? t.z : t.w;
                        w |= (__float_as_uint(fmaf(e, qq, 12582912.f)) & 255u) << (8 * b); }
                    d[j] = w;
                }
#pragma unroll
                for (int j = 0; j < 4; ++j) tl[(4 * c + j) * 34 + 8 * a + r8] = d[j];
            }
            asm volatile("s_waitcnt lgkmcnt(0)" ::: "memory");
            const int rb = cmap_in(n0);
#pragma unroll
            for (int jj = 0; jj < 4; ++jj) { const int q = lane + 64 * jj, n = q >> 3, ch = q & 7;
                const uint2 lo = *(const uint2*)(tl + n * 34 + 4 * ch), hi = *(const uint2*)(tl + n * 34 + 4 * ch + 2);
                pg8::u32x4 o; o.x = lo.x; o.y = lo.y; o.z = hi.x; o.w = hi.y;
                *(pg8::u32x4*)((unsigned char*)Win_t + (size_t)(rb + n) * 1024 + kw + 16 * ch) = o; }
            __syncthreads();
        }
        for (int u = bid - 128; u >= 0 && u < 128; u += G) gemv_cols<7>(lds, VfVec{mod}, p.w_in, 3584, u, bias_f, nullptr);
    }
    xcd_barrier(bar);

    {
        pg8::Gemm g{(const bf16_t*)xq, Win_t, T, 3584, 512}; pg8::StaticOrder S; S.init(T, 3584, G, bid);
        EpiInprojMF E{P, rinv1, bias_f, p.pos, ftab, p.qg, p.kg, swf};
        pg8::gemm_phase<EpiInprojMF, pg8::StaticOrder, true>((PG8_LAS unsigned char*)lds, g, S, E);
        const int nidle = (G > 128) ? G - 128 : G, ib = (G > 128) ? bid - 128 : bid;
        {
            float* scr = (float*)(lds + wave * 16384);
            if (ib >= 0) for (int it = ib * 8 + wave; it < 16 * 32; it += nidle * 8) transpose_item<false, false>(p.w_out, 1024, 1024, Wout_t, scr, it, lane, nullptr, nullptr);
            __syncthreads();
        }
        if (ib >= 0 && ib < 128) {
            const int hp = ib >> 3, blk = ib & 7;
            float* skT = (float*)lds; float* wqs = (float*)(lds + 69632);
            for (int e = tid; e < 16384; e += 512) { const int k = e >> 7, c = e & 127; skT[c * 132 + k] = p.sk[((size_t)hp * 128 + k) * 128 + c]; }
            float bacc[16];
#pragma unroll
            for (int j = 0; j < 16; ++j) bacc[j] = 0.f;
            for (int rbk = 0; rbk < 2; ++rbk) {
                const int i0 = (blk * 2 + rbk) * 64;
                __syncthreads();
                for (int e = tid; e < 8192; e += 512) { const int r = e >> 7, c = e & 127; wqs[r * 129 + c] = p.wq[(size_t)(i0 + r) * 2048 + hp * 128 + c]; }
                __syncthreads();
                float acc[16];
#pragma unroll
                for (int j = 0; j < 16; ++j) acc[j] = 0.f;
                const float* wrow = wqs + lane * 129; const float* skc = skT + 16 * wave;
#pragma unroll 4
                for (int c = 0; c < 128; ++c) {
                    const float av = wrow[c];
                    const float4 b0 = *(const float4*)(skc + c * 132), b1 = *(const float4*)(skc + c * 132 + 4), b2 = *(const float4*)(skc + c * 132 + 8), b3 = *(const float4*)(skc + c * 132 + 12);
                    acc[0] += av * b0.x; acc[1] += av * b0.y; acc[2] += av * b0.z; acc[3] += av * b0.w; acc[4] += av * b1.x; acc[5] += av * b1.y; acc[6] += av * b1.z; acc[7] += av * b1.w;
                    acc[8] += av * b2.x; acc[9] += av * b2.y; acc[10] += av * b2.z; acc[11] += av * b2.w; acc[12] += av * b3.x; acc[13] += av * b3.y; acc[14] += av * b3.z; acc[15] += av * b3.w;
                }
                const int i = i0 + lane;
                const float s2v = p.g2[i] * (1.f + mod[4096 + i]), sh = mod[3072 + i];
#pragma unroll
                for (int j = 0; j < 16; ++j) { Weff_t[(size_t)(hp * 128 + 16 * wave + j) * 1024 + i] = f2bf(acc[j] * s2v); bacc[j] += sh * acc[j]; }
            }
#pragma unroll
            for (int j = 0; j < 16; ++j) { float v = bacc[j];
#pragma unroll
                for (int o = 32; o > 0; o >>= 1) v += __shfl_xor(v, o);
                if (lane == 0) bq_part[(size_t)blk * 2048 + hp * 128 + 16 * wave + j] = v; }
            __syncthreads();
        }
        if (ib >= 0) convert_tables(p.down, p.up, q8, dsc, lane, ib * 8 + wave, nidle * 8, 0, CONV_SPLIT);
    }
    xcd_barrier(bar);
    wave = threadIdx.x >> 6; asm volatile("" : "+v"(wave));

    {
        const int gw = __builtin_amdgcn_readfirstlane(bid * 8 + wave), NGW = G * 8, l31 = lane & 31, hf = lane >> 5;
        const int wv0 = __builtin_amdgcn_readfirstlane(wave);
        for (int U = gw; U < 1024; U += NGW) {
            const int n = U >> 3, h = U & 7;
            f32x16 C[2][2];
#pragma unroll
            for (int a = 0; a < 2; ++a)
#pragma unroll
                for (int b = 0; b < 2; ++b)
#pragma unroll
                    for (int r = 0; r < 16; ++r) C[a][b][r] = 0.f;
            unsigned char* Kt = lds + wv0 * 9216; unsigned char* Vt = Kt + 4608;
            const int r8 = lane >> 3, pc = lane & 7, trq = (lane & 15) >> 2, trp = lane & 3, trd = (lane >> 4) & 1;
            const char* kbase = (const char*)(Kr + (size_t)n * 128 * 512 + h * 64); const char* vbase = (const char*)(Vr + (size_t)n * 128 * 512 + h * 64);
            const unsigned loff = (unsigned)(r8 * 512 + pc * 8) * 2u;
            const float lg = lg2_head(h);
            pg8::u32x4 gK[4], gV[4];
#pragma unroll
            for (int i = 0; i < 4; ++i) { gK[i] = *(const pg8::u32x4*)(kbase + (loff + i * 8192u)); gV[i] = *(const pg8::u32x4*)(vbase + (loff + i * 8192u)); }
            for (int sb4 = 0; sb4 < 4; ++sb4) {
#pragma unroll
                for (int i = 0; i < 4; ++i) { *(pg8::u32x4*)(Kt + (8 * i + r8) * 144 + pc * 16) = gK[i]; *(pg8::u32x4*)(Vt + (8 * i + r8) * 144 + pc * 16) = gV[i]; }
                { const int sn = (sb4 < 3) ? sb4 + 1 : sb4;
#pragma unroll
                  for (int i = 0; i < 4; ++i) { gK[i] = *(const pg8::u32x4*)(kbase + (size_t)sn * 32768 + (loff + i * 8192u)); gV[i] = *(const pg8::u32x4*)(vbase + (size_t)sn * 32768 + (loff + i * 8192u)); } }
#pragma unroll
                for (int s = 0; s < 2; ++s) {
                    bf16x8 Af[2], Bf[2];
#pragma unroll
                    for (int a = 0; a < 2; ++a) {
                        Af[a] = tr_frag(Vt + (16 * s + 8 * hf + trq) * 144 + (32 * a + 16 * trd + 4 * trp) * 2, 4);
                        const bf16x8 kraw = tr_frag(Kt + (16 * s + 8 * hf + trq) * 144 + (32 * a + 16 * trd + 4 * trp) * 2, 4);
                        const pg8::u32x4 kw = __builtin_bit_cast(pg8::u32x4, kraw); const unsigned kk[4] = {kw.x, kw.y, kw.z, kw.w};
                        pg8::u32x4 o; unsigned* op = (unsigned*)&o;
#pragma unroll
                        for (int e2 = 0; e2 < 4; ++e2) {
                            const int j0 = 32 * sb4 + 16 * s + 8 * hf + 2 * e2;
                            const float z0 = __builtin_amdgcn_exp2f((float)(127 - j0) * lg), z1 = __builtin_amdgcn_exp2f((float)(126 - j0) * lg);
                            op[e2] = pg8::cvt_pk_bf16(__uint_as_float(kk[e2] << 16) * z0, __uint_as_float(kk[e2] & 0xffff0000u) * z1);
                        }
                        Bf[a] = __builtin_bit_cast(bf16x8, o);
                    }
#pragma unroll
                    for (int a = 0; a < 2; ++a)
#pragma unroll
                        for (int b = 0; b < 2; ++b) C[a][b] = MFMA32(Af[a], Bf[b], C[a][b]);
                }
            }
            float* dst = kv + (size_t)(n * 8 + h) * 4096;
#pragma unroll
            for (int a = 0; a < 2; ++a)
#pragma unroll
                for (int b = 0; b < 2; ++b)
#pragma unroll
                    for (int r = 0; r < 16; ++r) dst[(32 * a + (r & 3) + 8 * (r >> 2) + 4 * hf) * 64 + 32 * b + l31] = C[a][b][r];
        }
        bf16x8 Tri[2];
        {
            pg8::u32x4 w0, w1; unsigned* p0 = (unsigned*)&w0; unsigned* p1 = (unsigned*)&w1;
#pragma unroll
            for (int e2 = 0; e2 < 4; ++e2) {
                unsigned a0 = 0, a1 = 0;
#pragma unroll
                for (int q = 0; q < 2; ++q) { const int e = 2 * e2 + q, ip = 8 * (e >> 2) + 4 * hf + (e & 3);
                    a0 |= ((ip > l31) ? 0x3F80u : 0u) << (16 * q); a1 |= ((16 + ip > l31) ? 0x3F80u : 0u) << (16 * q); }
                p0[e2] = a0; p1[e2] = a1;
            }
            Tri[0] = __builtin_bit_cast(bf16x8, w0); Tri[1] = __builtin_bit_cast(bf16x8, w1);
        }
        const bool sb_local = (G % 8 == 0) && (4096 % G == 0) && ((4096 / G) % 8 == 0);
        const int sb_per_wave = sb_local ? 4096 / G / 8 : (4096 + NGW - 1 - gw) / NGW;
        const int wv = __builtin_amdgcn_readfirstlane(wave);
        for (int ps = 0; ps < sb_per_wave; ++ps) {
            const int U = sb_local ? 0 : gw + ps * NGW;
            const int h = sb_local ? (bid & 7) : (U & 7), qt = sb_local ? (bid >> 3) * (4096 / G) + ps * 8 + wv : (U >> 3), q0 = qt * 32;
            f32x16 O[2];
#pragma unroll
            for (int r = 0; r < 16; ++r) { O[0][r] = 0.f; O[1][r] = 0.f; }
            float carry = 0.f;
            unsigned char* Kt = lds + wv * 9216; unsigned char* Vt = Kt + 4608;
            const int r8 = lane >> 3, pc = lane & 7;
            const char* kbase = (const char*)(Ks + h * 64); const char* vbase = (const char*)(Vs + h * 64);
            const unsigned loff = (unsigned)(r8 * 512 + pc * 8) * 2u;
            pg8::u32x4 gK[4], gV[4];
            bf16x8 Qf[4];
            {
                const char* qbase = (const char*)(Qs + h * 64);
#pragma unroll
                for (int i = 0; i < 4; ++i) gK[i] = *(const pg8::u32x4*)(qbase + (size_t)qt * 32768 + (loff + i * 8192u));
#pragma unroll
                for (int i = 0; i < 4; ++i) *(pg8::u32x4*)(Kt + (8 * i + r8) * 144 + pc * 16) = gK[i];
#pragma unroll
                for (int s = 0; s < 4; ++s) Qf[s] = *(const bf16x8*)(Kt + l31 * 144 + 32 * s + 16 * hf);
            }
#pragma unroll
            for (int i = 0; i < 4; ++i) { gK[i] = *(const pg8::u32x4*)(kbase + (size_t)qt * 32768 + (loff + i * 8192u)); gV[i] = *(const pg8::u32x4*)(vbase + (size_t)qt * 32768 + (loff + i * 8192u)); }
            const int trq = (lane & 15) >> 2, trp = lane & 3, trd = (lane >> 4) & 1;
            for (int kb = qt; kb >= 0; --kb) {
#pragma unroll
                for (int i = 0; i < 4; ++i) { *(pg8::u32x4*)(Kt + (8 * i + r8) * 144 + pc * 16) = gK[i]; *(pg8::u32x4*)(Vt + (8 * i + r8) * 144 + pc * 16) = gV[i]; }
                {
                    const int kbn = (kb > 0) ? kb - 1 : 0;
#pragma unroll
                    for (int i = 0; i < 4; ++i) { gK[i] = *(const pg8::u32x4*)(kbase + (size_t)kbn * 32768 + (loff + i * 8192u)); gV[i] = *(const pg8::u32x4*)(vbase + (size_t)kbn * 32768 + (loff + i * 8192u)); }
                }
                bf16x8 Kf[4], Vf[2][2];
#pragma unroll
                for (int s = 0; s < 4; ++s) Kf[s] = *(const bf16x8*)(Kt + l31 * 144 + 32 * s + 16 * hf);
#pragma unroll
                for (int s = 0; s < 2; ++s)
#pragma unroll
                    for (int dt = 0; dt < 2; ++dt) {
                        Vf[s][dt] = tr_frag(Vt + (16 * s + 4 * hf + trq) * 144 + (32 * dt + 16 * trd + 4 * trp) * 2, 8);
                    }
                f32x16 S;
#pragma unroll
                for (int r = 0; r < 16; ++r) S[r] = 0.f;
#pragma unroll
                for (int s = 0; s < 4; ++s) S = MFMA32(Kf[s], Qf[s], S);
                const bool diag = (kb == qt);
                f32x16 sp, lb;
                float csum = 0.f;
                if (diag) {
#pragma unroll
                    for (int r = 0; r < 16; ++r) {
                        const int i = (r & 3) + 8 * (r >> 2) + 4 * hf;
                        const float z = S[r];
                        const float l1p = __builtin_amdgcn_logf(1.0f + __builtin_amdgcn_exp2f(-fabsf(z)));
                        const float spv = (i < l31) ? (fmaxf(z, 0.f) + l1p) : 0.f;
                        sp[r] = spv; lb[r] = (i < l31) ? (fminf(z, 0.f) - l1p) : -INFINITY; csum += spv;
                    }
                } else {
#pragma unroll
                    for (int r = 0; r < 16; ++r) {
                        const float z = S[r];
                        const float l1p = __builtin_amdgcn_logf(1.0f + __builtin_amdgcn_exp2f(-fabsf(z)));
                        const float spv = fmaxf(z, 0.f) + l1p;
                        sp[r] = spv; lb[r] = fminf(z, 0.f) - l1p; csum += spv;
                    }
                }
                f32x16 Rt;
#pragma unroll
                for (int r = 0; r < 16; ++r) Rt[r] = carry;
#pragma unroll
                for (int s = 0; s < 2; ++s) Rt = MFMA32(Tri[s], pack_frag(sp, s), Rt);
                f32x16 wv;
#pragma unroll
                for (int r = 0; r < 16; ++r) wv[r] = __builtin_amdgcn_exp2f(lb[r] - Rt[r]);
#pragma unroll
                for (int s = 0; s < 2; ++s) { const bf16x8 wp = pack_frag(wv, s);
#pragma unroll
                    for (int dt = 0; dt < 2; ++dt) O[dt] = MFMA32(Vf[s][dt], wp, O[dt]); }
                csum += __shfl_xor(csum, 32);
                carry += csum;
                if (__all(carry > 127.f)) break;
            }
            float ss = 0.f;
#pragma unroll
            for (int r = 0; r < 16; ++r) ss += O[0][r] * O[0][r] + O[1][r] * O[1][r];
            ss += __shfl_xor(ss, 32);
            const float rn = 1.0f / sqrtf(ss * (1.f / 64.f) + EPS);
#pragma unroll
            for (int dt = 0; dt < 2; ++dt)
#pragma unroll
                for (int g4 = 0; g4 < 4; ++g4) {
                    const int d = 32 * dt + 8 * g4 + 4 * hf;
                    const float4 gn = *(const float4*)(p.og + d);
                    uint2 w; w.x = pg8::cvt_pk_bf16(O[dt][4 * g4] * rn * gn.x, O[dt][4 * g4 + 1] * rn * gn.y); w.y = pg8::cvt_pk_bf16(O[dt][4 * g4 + 2] * rn * gn.z, O[dt][4 * g4 + 3] * rn * gn.w);
                    *(uint2*)(Kt + l31 * 144 + d * 2) = w;
                }
#pragma unroll
            for (int i = 0; i < 4; ++i) *(pg8::u32x4*)(ycat + (size_t)(q0 + 8 * i + r8) * 1024 + 512 + h * 64 + pc * 8) = *(const pg8::u32x4*)(Kt + (8 * i + r8) * 144 + pc * 16);
        }
    }
    xcd_barrier(bar);

    if (bid == 255 % G) for (int n = tid; n < 2048; n += 512) { float s = 0.f;
#pragma unroll
        for (int b8 = 0; b8 < 8; ++b8) s += bq_part[(size_t)b8 * 2048 + n];
        bias_q[n] = s; }
    if (G > 64 && bid >= 64) convert_tables(p.down, p.up, q8, dsc, lane, (bid - 64) * 8 + wave, (G - 64) * 8, CONV_SPLIT, 32768);
    else if (G <= 64) convert_tables(p.down, p.up, q8, dsc, lane, bid * 8 + wave, G * 8, CONV_SPLIT, 32768);
    for (int idx = bid * 512 + tid; idx < 32768; idx += G * 512) {
        const int h = idx >> 12;
        const float cd = exp2f(128.f * lg2_head(h));
        float s = 0.f;
        for (int n0 = 0; n0 < 128; n0 += 32) {
            float kvv[32];
#pragma unroll
            for (int q = 0; q < 32; ++q) kvv[q] = kv[(size_t)(n0 + q) * 32768 + idx];
#pragma unroll
            for (int q = 0; q < 32; ++q) { stT[(size_t)(n0 + q) * 32768 + idx] = f2bf(s); s = cd * s + kvv[q]; }
        }
    }
    xcd_barrier(bar);

    {
        const int gw = __builtin_amdgcn_readfirstlane(bid * 8 + wave), NGW = G * 8, l31 = lane & 31, hf = lane >> 5;
        const int wv4 = __builtin_amdgcn_readfirstlane(wave);
        for (int W2 = gw; W2 < 2048; W2 += NGW) {
            const int nh = W2 >> 1, n = nh >> 3, h = nh & 7;
            const float lg = lg2_head(h);
#pragma unroll 1
            for (int pass = 0; pass < 2; ++pass) {
                const int qt = (W2 & 1) ? (pass ? 2 : 1) : (pass ? 3 : 0);
                const int il = qt * 32 + l31, tq = n * 128 + il;
                unsigned char* Kt = lds + wv4 * 9216; unsigned char* Vt = Kt + 4608;
                const int r8 = lane >> 3, pc = lane & 7, trq = (lane & 15) >> 2, trp = lane & 3, trd = (lane >> 4) & 1;
                const unsigned loff = (unsigned)(r8 * 512 + pc * 8) * 2u;
                pg8::u32x4 gK[4], gV[4];
                bf16x8 Qf[4];
                {
                    const char* qbase = (const char*)(Qr + (size_t)(n * 128 + qt * 32) * 512 + h * 64);
                    const char* sbase = (const char*)(stT + (size_t)nh * 4096) + (unsigned)(r8 * 64 + pc * 8) * 2u;
#pragma unroll
                    for (int i = 0; i < 4; ++i) gK[i] = *(const pg8::u32x4*)(qbase + (loff + i * 8192u));
#pragma unroll
                    for (int i = 0; i < 4; ++i) *(pg8::u32x4*)(Kt + (8 * i + r8) * 144 + pc * 16) = gK[i];
#pragma unroll
                    for (int s = 0; s < 4; ++s) Qf[s] = *(const bf16x8*)(Kt + l31 * 144 + 32 * s + 16 * hf);
#pragma unroll
                    for (int i = 0; i < 4; ++i) { gK[i] = *(const pg8::u32x4*)(sbase + i * 1024u); gV[i] = *(const pg8::u32x4*)(sbase + 4096u + i * 1024u); }
#pragma unroll
                    for (int i = 0; i < 4; ++i) { *(pg8::u32x4*)(Kt + (8 * i + r8) * 144 + pc * 16) = gK[i]; *(pg8::u32x4*)(Kt + (32 + 8 * i + r8) * 144 + pc * 16) = gV[i]; }
                }
                f32x16 O[2];
#pragma unroll
                for (int r = 0; r < 16; ++r) { O[0][r] = 0.f; O[1][r] = 0.f; }
#pragma unroll
                for (int s = 0; s < 4; ++s)
#pragma unroll
                    for (int dt = 0; dt < 2; ++dt) O[dt] = MFMA32(*(const bf16x8*)(Kt + (32 * dt + l31) * 144 + 32 * s + 16 * hf), Qf[s], O[dt]);
                const float xi = exp2f((float)(il + 1) * lg);
#pragma unroll
                for (int r = 0; r < 16; ++r) { O[0][r] *= xi; O[1][r] *= xi; }
                const char* kbase = (const char*)(Kr + (size_t)n * 128 * 512 + h * 64); const char* vbase = (const char*)(Vr + (size_t)n * 128 * 512 + h * 64);
#pragma unroll
                for (int i = 0; i < 4; ++i) { gK[i] = *(const pg8::u32x4*)(kbase + (loff + i * 8192u)); gV[i] = *(const pg8::u32x4*)(vbase + (loff + i * 8192u)); }
                for (int jb = 0; jb <= qt; ++jb) {
#pragma unroll
                    for (int i = 0; i < 4; ++i) { *(pg8::u32x4*)(Kt + (8 * i + r8) * 144 + pc * 16) = gK[i]; *(pg8::u32x4*)(Vt + (8 * i + r8) * 144 + pc * 16) = gV[i]; }
                    { const int jn = (jb < qt) ? jb + 1 : jb;
#pragma unroll
                      for (int i = 0; i < 4; ++i) { gK[i] = *(const pg8::u32x4*)(kbase + (size_t)jn * 32768 + (loff + i * 8192u)); gV[i] = *(const pg8::u32x4*)(vbase + (size_t)jn * 32768 + (loff + i * 8192u)); } }
                    bf16x8 Kf[4], Vf[2][2];
#pragma unroll
                    for (int s = 0; s < 4; ++s) Kf[s] = *(const bf16x8*)(Kt + l31 * 144 + 32 * s + 16 * hf);
#pragma unroll
                    for (int s = 0; s < 2; ++s)
#pragma unroll
                        for (int dt = 0; dt < 2; ++dt) Vf[s][dt] = tr_frag(Vt + (16 * s + 4 * hf + trq) * 144 + (32 * dt + 16 * trd + 4 * trp) * 2, 8);
                    f32x16 S;
#pragma unroll
                    for (int r = 0; r < 16; ++r) S[r] = 0.f;
#pragma unroll
                    for (int s = 0; s < 4; ++s) S = MFMA32(Kf[s], Qf[s], S);
#pragma unroll
                    for (int r = 0; r < 16; ++r) {
                        const int jl = jb * 32 + (r & 3) + 8 * (r >> 2) + 4 * hf, dl = il - jl;
                        S[r] = (dl >= 0) ? S[r] * __builtin_amdgcn_exp2f((float)dl * lg) : 0.f;
                    }
#pragma unroll
                    for (int s = 0; s < 2; ++s) { const bf16x8 wp = pack_frag(S, s);
#pragma unroll
                        for (int dt = 0; dt < 2; ++dt) O[dt] = MFMA32(Vf[s][dt], wp, O[dt]); }
                }
                float sm = 0.f;
#pragma unroll
                for (int r = 0; r < 16; ++r) sm += O[0][r] + O[1][r];
                sm += __shfl_xor(sm, 32);
                const float mean = sm * (1.f / 64.f);
                float vs = 0.f;
#pragma unroll
                for (int r = 0; r < 16; ++r) { const float d0 = O[0][r] - mean, d1 = O[1][r] - mean; vs += d0 * d0 + d1 * d1; }
                vs += __shfl_xor(vs, 32);
                const float rstd = 1.0f / sqrtf(vs * (1.f / 64.f) + EPS);
                {
                    const char* gbase = (const char*)(Gr + (size_t)(n * 128 + qt * 32) * 512 + h * 64);
#pragma unroll
                    for (int i = 0; i < 4; ++i) gV[i] = *(const pg8::u32x4*)(gbase + (loff + i * 8192u));
#pragma unroll
                    for (int i = 0; i < 4; ++i) *(pg8::u32x4*)(Vt + (8 * i + r8) * 144 + pc * 16) = gV[i];
                }
#pragma unroll
                for (int dt = 0; dt < 2; ++dt)
#pragma unroll
                    for (int g4 = 0; g4 < 4; ++g4) {
                        const int e = 32 * dt + 8 * g4 + 4 * hf;
                        const float4 gn = *(const float4*)(p.rgain + h * 64 + e);
                        const uint2 gg = *(const uint2*)(Vt + l31 * 144 + e * 2);
                        const float g0 = __uint_as_float(gg.x << 16), g1 = __uint_as_float(gg.x & 0xffff0000u), g2v = __uint_as_float(gg.y << 16), g3 = __uint_as_float(gg.y & 0xffff0000u);
                        uint2 w;
                        w.x = pg8::cvt_pk_bf16((O[dt][4 * g4] - mean) * rstd * gn.x * g0, (O[dt][4 * g4 + 1] - mean) * rstd * gn.y * g1);
                        w.y = pg8::cvt_pk_bf16((O[dt][4 * g4 + 2] - mean) * rstd * gn.z * g2v, (O[dt][4 * g4 + 3] - mean) * rstd * gn.w * g3);
                        *(uint2*)(Kt + l31 * 144 + e * 2) = w;
                    }
#pragma unroll
                for (int i = 0; i < 4; ++i) *(pg8::u32x4*)(ycat + (size_t)(n * 128 + qt * 32 + 8 * i + r8) * 1024 + h * 64 + pc * 8) = *(const pg8::u32x4*)(Kt + (8 * i + r8) * 144 + pc * 16);
            }
        }
    }
    xcd_barrier(bar);

    {
        pg8::Gemm g{ycat, Wout_t, T, 1024, 1024}; pg8::StaticOrder S; S.init(T, 1024, G, bid);
        EpiOutprojMF E{xb, mod + 2048, x1b, part2};
        pg8::gemm_phase<EpiOutprojMF, pg8::StaticOrder>((PG8_LAS unsigned char*)lds, g, S, E);
    }
    xcd_barrier(bar);

    for (int round = 0; round < 2; ++round) {
        pg8::Gemm g{x1b, Weff_t, T, 2048, 1024}; OneUnitOrder S; S.base.init(T, 2048, G, bid); S.round = round;
        EpiTopkMF E{part2, bias_q, ids, gates};
        pg8::gemm_phase<EpiTopkMF, OneUnitOrder>((PG8_LAS unsigned char*)lds, g, S, E);
    }
    xcd_barrier(bar);

    {
        constexpr int IDS_LD = 136, ACT_LD = 136;
        const float* scale2 = mod + 4096; const float* shift2 = mod + 3072; const float* gate2 = mod + 5120;
        unsigned short* ids_l = (unsigned short*)lds; float* act_l = (float*)(lds + 32768);
        bf16_t* ds_l = (bf16_t*)(lds + 69632);
        const int t0 = bid * 64, tt = lane >> 3, sub = lane & 7, tl = wave * 8 + tt, t = t0 + tl;
        for (int e = tid; e < 1024; e += 512) { const int r = e >> 4, c8 = e & 15; *(uint4*)(ids_l + r * IDS_LD + c8 * 8) = *(const uint4*)(ids + (size_t)(t0 + r) * 128 + c8 * 8); }
        for (int e = tid; e < 64 * ACT_LD; e += 512) act_l[e] = 0.f;
        for (int e = tid; e < 4096; e += 512) ((uint4*)ds_l)[e] = ((const uint4*)dsc)[e];
        float* s2_l = (float*)(lds + 143360); float* sh2_l = s2_l + 1024; float* gt2_l = s2_l + 2048;
        for (int e = tid; e < 1024; e += 512) { s2_l[e] = p.g2[e] * (1.f + scale2[e]); sh2_l[e] = shift2[e]; gt2_l[e] = gate2[e]; }
        __syncthreads();
        float ri;
        { const float4* pp = (const float4*)(part2 + (size_t)t * 16); const float4 p0 = pp[0], p1 = pp[1], p2 = pp[2], p3 = pp[3];
          const float ssum = ((p0.x + p0.y) + (p0.z + p0.w)) + ((p1.x + p1.y) + (p1.z + p1.w)) + ((p2.x + p2.y) + (p2.z + p2.w)) + ((p3.x + p3.y) + (p3.z + p3.w));
          ri = 1.0f / sqrtf(ssum * (1.0f / D) + EPS); }
        const unsigned short* myids = ids_l + tl * IDS_LD;
        float* myact = act_l + tl * ACT_LD;
        const bool s4 = (sub & 4) != 0, s2 = (sub & 2) != 0, s1 = (sub & 1) != 0;
        const unsigned suboff = (unsigned)sub * 16u;
        typedef float f32x2 __attribute__((ext_vector_type(2)));
#define P9_LOAD(W, JB) do { const uint4 idv_ = *(const uint4*)(myids + 8 * (JB)); const unsigned idw_[4] = {idv_.x, idv_.y, idv_.z, idv_.w}; \
        _Pragma("unroll") for (int k_ = 0; k_ < 8; ++k_) { const unsigned id_ = (idw_[k_ >> 1] >> (16 * (k_ & 1))) & 0xffffu; W[k_] = *(const uint4*)(sbase + (id_ * 128u + suboff)); } } while (0)
#define P9_DOWN4(W, JB) do { int pd_[8]; \
        _Pragma("unroll") for (int k_ = 0; k_ < 8; ++k_) { const unsigned ww_[4] = {W[k_].x, W[k_].y, W[k_].z, W[k_].w}; int a0_ = 0, a1_ = 0; \
            _Pragma("unroll") for (int m_ = 0; m_ < 4; ++m_) { a0_ = __builtin_amdgcn_sdot4(hpe[m_], (int)(ww_[m_] & 0x0F0F0F0Fu), a0_, false); a1_ = __builtin_amdgcn_sdot4(hpo[m_], (int)((ww_[m_] >> 4) & 0x0F0F0F0Fu), a1_, false); } \
            pd_[k_] = a0_ + a1_ - hoff; } \
        int r4_[4], r2_[2]; \
        _Pragma("unroll") for (int k_ = 0; k_ < 4; ++k_) { const int snd_ = s4 ? pd_[k_] : pd_[k_ + 4], kp_ = s4 ? pd_[k_ + 4] : pd_[k_]; r4_[k_] = kp_ + __shfl_xor(snd_, 4); } \
        _Pragma("unroll") for (int k_ = 0; k_ < 2; ++k_) { const int snd_ = s2 ? r4_[k_] : r4_[k_ + 2], kp_ = s2 ? r4_[k_ + 2] : r4_[k_]; r2_[k_] = kp_ + __shfl_xor(snd_, 2); } \
        { const int snd_ = s1 ? r2_[0] : r2_[1], kp_ = s1 ? r2_[1] : r2_[0]; myact[8 * (JB) + sub] += (float)(kp_ + __shfl_xor(snd_, 1)) * hscale; } } while (0)
        for (int c = 0; c < 4; ++c) {
            float hf[8][4]; float hmax = 0.f;
#pragma unroll
            for (int q = 0; q < 8; ++q) {
                const int col = 256 * c + 4 * sub + 32 * q;
                const uint2 xw = *(const uint2*)(x1b + (size_t)t * D + col);
                const float4 sv = *(const float4*)(s2_l + col), sh = *(const float4*)(sh2_l + col);
                hf[q][0] = __uint_as_float(xw.x << 16) * ri * sv.x + sh.x; hf[q][1] = __uint_as_float(xw.x & 0xffff0000u) * ri * sv.y + sh.y;
                hf[q][2] = __uint_as_float(xw.y << 16) * ri * sv.z + sh.z; hf[q][3] = __uint_as_float(xw.y & 0xffff0000u) * ri * sv.w + sh.w;
                hmax = fmaxf(hmax, fmaxf(fmaxf(fabsf(hf[q][0]), fabsf(hf[q][1])), fmaxf(fabsf(hf[q][2]), fabsf(hf[q][3]))));
            }
            hmax = fmaxf(hmax, __shfl_xor(hmax, 1)); hmax = fmaxf(hmax, __shfl_xor(hmax, 2)); hmax = fmaxf(hmax, __shfl_xor(hmax, 4));
            const float hinv = (hmax > 0.f) ? 127.0f / hmax : 0.f, hscale = hmax * (1.0f / 127.0f);
            int hq[8][4];
#pragma unroll
            for (int q = 0; q < 8; ++q)
#pragma unroll
                for (int j = 0; j < 4; ++j) hq[q][j] = (int)__builtin_rintf(hf[q][j] * hinv);
            int hpe[4], hpo[4], hoff = 0;
#pragma unroll
            for (int m = 0; m < 4; ++m) {
                hpe[m] = (hq[2 * m][0] & 255) | ((hq[2 * m][2] & 255) << 8) | ((hq[2 * m + 1][0] & 255) << 16) | ((hq[2 * m + 1][2] & 255) << 24);
                hpo[m] = (hq[2 * m][1] & 255) | ((hq[2 * m][3] & 255) << 8) | ((hq[2 * m + 1][1] & 255) << 16) | ((hq[2 * m + 1][3] & 255) << 24);
            }
#pragma unroll
            for (int q = 0; q < 8; ++q) hoff += (hq[q][0] + hq[q][1]) + (hq[q][2] + hq[q][3]);
            hoff *= 8;
            const unsigned char* sbase = q8 + (size_t)c * (16384 * 128);
            uint4 wA[8], wB[8];
            P9_LOAD(wA, 0);
#pragma unroll 1
            for (int jb = 0; jb < 16; jb += 2) {
                P9_LOAD(wB, jb + 1);
                P9_DOWN4(wA, jb);
                if (jb + 2 < 16) P9_LOAD(wA, jb + 2);
                P9_DOWN4(wB, jb + 1);
            }
        }
#undef P9_DOWN4
        signed char* aq_l = (signed char*)(lds + 135168);
        float avv[16]; float amax = 0.f;
#pragma unroll
        for (int jb = 0; jb < 16; ++jb) {
            const int j = 8 * jb + sub; const unsigned id = myids[j];
            const float a = myact[j] * bf2f(ds_l[id]);
            const float av = fabsf(a), tq = 1.0f / (av * 0.2316418882f + 1.0f);
            float ql = tq * 0.5307027145f + (-0.7265760135f); ql = ql * tq + 0.7107068705f; ql = ql * tq + (-0.142248368f); ql = ql * tq + 0.127414796f; ql = ql * tq;
            const float mm = a * (ql * exp2f(a * a * (-0.72134752044f)));
            const float ge = (a < 0.f) ? mm : (a - mm);
            avv[jb] = ge * gates[(size_t)t * 128 + j] * bf2f(ds_l[16384 + id]);
            amax = fmaxf(amax, fabsf(avv[jb]));
        }
        amax = fmaxf(amax, __shfl_xor(amax, 1)); amax = fmaxf(amax, __shfl_xor(amax, 2)); amax = fmaxf(amax, __shfl_xor(amax, 4));
        const float ainv = (amax > 0.f) ? 127.0f / amax : 0.f, ascale = amax * (1.0f / 127.0f);
        int aqsum = 0;
#pragma unroll
        for (int jb = 0; jb < 16; ++jb) { const int aqv = (int)__builtin_rintf(avv[jb] * ainv); aq_l[tl * 128 + 8 * jb + sub] = (signed char)aqv; aqsum += aqv; }
        aqsum += __shfl_xor(aqsum, 1); aqsum += __shfl_xor(aqsum, 2); aqsum += __shfl_xor(aqsum, 4);
        __syncthreads();
#define P9_PERM(HI, LO, SEL) __builtin_amdgcn_perm((HI), (LO), (SEL))
#define P9_T4(E0, E1, E2, E3, T0, T1, T2, T3) do { const unsigned p0_ = P9_PERM(E1, E0, 0x05010400u), p1_ = P9_PERM(E1, E0, 0x07030602u), p2_ = P9_PERM(E3, E2, 0x05010400u), p3_ = P9_PERM(E3, E2, 0x07030602u); \
        T0 = P9_PERM(p2_, p0_, 0x05040100u); T1 = P9_PERM(p2_, p0_, 0x07060302u); T2 = P9_PERM(p3_, p1_, 0x05040100u); T3 = P9_PERM(p3_, p1_, 0x07060302u); } while (0)
#define P9_UP4(W, JB) do { const uint2 aq8_ = *(const uint2*)(aq_l + tl * 128 + 8 * (JB)); const int aq4_[2] = {(int)aq8_.x, (int)aq8_.y}; \
        _Pragma("unroll") for (int g_ = 0; g_ < 2; ++g_) { \
            _Pragma("unroll") for (int m_ = 0; m_ < 4; ++m_) { \
                const unsigned w0_ = ((const unsigned*)&W[4 * g_ + 0])[m_], w1_ = ((const unsigned*)&W[4 * g_ + 1])[m_], w2_ = ((const unsigned*)&W[4 * g_ + 2])[m_], w3_ = ((const unsigned*)&W[4 * g_ + 3])[m_]; \
                unsigned t_[4]; \
                P9_T4(w0_, w1_, w2_, w3_, t_[0], t_[1], t_[2], t_[3]); \
                _Pragma("unroll") for (int k_ = 0; k_ < 4; ++k_) { \
                    oraw[4 * m_ + k_] = __builtin_amdgcn_sdot4(aq4_[g_], (int)t_[k_], oraw[4 * m_ + k_], false); \
                    olo[4 * m_ + k_] = __builtin_amdgcn_sdot4(aq4_[g_], (int)(t_[k_] & 0x0F0F0F0Fu), olo[4 * m_ + k_], false); } } } } while (0)
        for (int c = 0; c < 4; ++c) {
            int oraw[16], olo[16];
#pragma unroll
            for (int q = 0; q < 16; ++q) { oraw[q] = 0; olo[q] = 0; }
            const unsigned char* sbase = q8 + (8u << 20) + (size_t)c * (16384 * 128);
            uint4 wA[8], wB[8];
            P9_LOAD(wA, 0);
#pragma unroll 1
            for (int jb = 0; jb < 16; jb += 2) {
                P9_LOAD(wB, jb + 1);
                P9_UP4(wA, jb);
                if (jb + 2 < 16) P9_LOAD(wA, jb + 2);
                P9_UP4(wB, jb + 1);
            }
#pragma unroll
            for (int q = 0; q < 8; ++q) {
                const int col = 256 * c + 4 * sub + 32 * q;
                float* op = out + (size_t)t * D + col;
                const uint2 xw = *(const uint2*)(x1b + (size_t)t * D + col); const float4 xv = make_float4(__uint_as_float(xw.x << 16), __uint_as_float(xw.x & 0xffff0000u), __uint_as_float(xw.y << 16), __uint_as_float(xw.y & 0xffff0000u)); const float4 gt = *(const float4*)(gt2_l + col);
                const int m = q >> 1, k0 = 2 * (q & 1);
                const int v0 = olo[4 * m + k0] - 8 * aqsum, v1 = (oraw[4 * m + k0] - olo[4 * m + k0]) >> 4, v2 = olo[4 * m + k0 + 1] - 8 * aqsum, v3 = (oraw[4 * m + k0 + 1] - olo[4 * m + k0 + 1]) >> 4;
                float4 r;
                r.x = xv.x + gt.x * ((float)v0 * ascale); r.y = xv.y + gt.y * ((float)v1 * ascale); r.z = xv.z + gt.z * ((float)v2 * ascale); r.w = xv.w + gt.w * ((float)v3 * ascale);
                *(float4*)op = r;
            }
        }
#undef P9_LOAD
#undef P9_UP4
#undef P9_T4
#undef P9_PERM
    }
}
}

extern "C" void kernel_launch(void* const* d_in, const int* in_sizes, int n_in, void* d_out, int out_size, void* d_ws, size_t ws_size, hipStream_t stream) {
    static int grid = 0;
    if (grid == 0) {
        int dev = 0, cus = 0, per_cu = 0;
        (void)hipGetDevice(&dev);
        (void)hipDeviceGetAttribute(&cus, hipDeviceAttributeMultiprocessorCount, dev);
        (void)hipFuncSetAttribute((const void*)mk_fwd, hipFuncAttributeMaxDynamicSharedMemorySize, LDS_BYTES);
        (void)hipOccupancyMaxActiveBlocksPerMultiprocessor(&per_cu, (const void*)mk_fwd, 512, LDS_BYTES);
        if (per_cu < 1 || cus != 256) { fprintf(stderr, "kernel_launch: needs 256 CUs with one resident workgroup each (cus %d, per_cu %d)\n", cus, per_cu); grid = -1; }
        else grid = cus;
    }
    if (grid < 0) return;
    (void)hipMemsetAsync((char*)d_ws + OFF_CTL, 0, CTL_BYTES, stream);
    Params p{};
    p.x = (const float*)d_in[0]; p.c = (const float*)d_in[1]; p.pos = (const int*)d_in[2]; p.ada_w = (const float*)d_in[3]; p.ada_b = (const float*)d_in[4];
    p.g1 = (const float*)d_in[5]; p.g2 = (const float*)d_in[6]; p.w_in = (const float*)d_in[7]; p.rgain = (const float*)d_in[8]; p.qg = (const float*)d_in[9];
    p.kg = (const float*)d_in[10]; p.og = (const float*)d_in[11]; p.w_out = (const float*)d_in[12]; p.wq = (const float*)d_in[13]; p.sk = (const float*)d_in[14];
    p.down = (const float*)d_in[15]; p.up = (const float*)d_in[16]; p.out = (float*)d_out; p.ws = (unsigned char*)d_ws;
    for (int i = 0; i < 32; ++i) {
        const double f = pow(10000.0, -(double)i / 32.0) / 6.283185307179586476925;
        float fh = (float)f; unsigned ub; memcpy(&ub, &fh, 4); ub &= 0xFFFFC000u; memcpy(&fh, &ub, 4);
        p.rc.fh[i] = fh; p.rc.fl[i] = (float)(f - (double)fh);
    }
    void* args[] = {&p};
    hipError_t e = hipLaunchCooperativeKernel((const void*)mk_fwd, dim3(grid), dim3(512), args, LDS_BYTES, stream);
    if (e != hipSuccess) fprintf(stderr, "kernel_launch: cooperative launch failed: %s (grid %d)\n", hipGetErrorString(e), grid);
}
```

```cpp
#include <hip/hip_runtime.h>
#include <stdint.h>
#include <math.h>
#include <cstdio>
#include <cstring>

namespace {
constexpr int T = 16384, D = 1024;
constexpr float EPS = 1e-6f;
typedef unsigned short bf16_t;
#define LAS __attribute__((address_space(3)))

__device__ __forceinline__ float bf2f(bf16_t b) { return __uint_as_float(((unsigned)b) << 16); }
__device__ __forceinline__ bf16_t f2bf(float f) { unsigned u = __float_as_uint(f); u += 0x7fffu + ((u >> 16) & 1u); return (bf16_t)(u >> 16); }
__device__ __forceinline__ float4 ld_nt4(const float* p) { typedef float f4v __attribute__((ext_vector_type(4))); const f4v v = __builtin_nontemporal_load((const f4v*)p); return make_float4(v[0], v[1], v[2], v[3]); }

__device__ __forceinline__ float lg2_head(int h) {
    const float x = __uint_as_float((unsigned)(127 - 5 - h) << 23);
    const float s = x * (1.f + x * (0.5f + x * (0.33333334f + x * (0.25f + x * (0.2f + x * 0.16666667f)))));
    return -s * 1.44269504089f;
}
struct RopeC { float fh[32], fl[32]; };
struct RetC { float lg2[8]; };

constexpr size_t MiB = 1u << 20;
constexpr size_t OFF_CTL = 0;
constexpr size_t CTL_BYTES = 64 * 1024;
constexpr size_t OFF_MOD = 64 * 1024, OFF_RINV1 = 128 * 1024, OFF_BIASF = 256 * 1024, OFF_ROPE = 1 * MiB;
constexpr size_t OFF_WINT = 6 * MiB;
constexpr size_t OFF_XB = 16 * MiB;
constexpr size_t OFF_YCAT = 160 * MiB;
constexpr size_t OFF_P = 48 * MiB;
constexpr size_t OFF_KV = 208 * MiB, OFF_ST = 224 * MiB;
constexpr size_t OFF_WEFFT = 240 * MiB;
constexpr size_t OFF_WOUTT = 13 * MiB;
constexpr size_t OFF_BIASQ = 272 * 1024;
constexpr size_t OFF_SWF = 320 * 1024;
constexpr size_t OFF_XQ = 160 * MiB;
constexpr size_t OFF_DSC = 512 * 1024;
constexpr size_t OFF_BQPART = 576 * 1024;
constexpr size_t OFF_PART2 = 5 * MiB;
constexpr size_t OFF_X1B = 208 * MiB;
constexpr size_t OFF_IDS = 244 * MiB, OFF_GATES = 248 * MiB;
constexpr size_t OFF_Q8 = 192 * MiB;
constexpr int CONV_SPLIT = 0;
constexpr int LDS_BYTES = 163840;
constexpr int LDS_ST_OFF = LDS_BYTES - 16;

#define XB_TMO      128
#define XB_XCNT(j)  (256  + 64 * (j))
#define XB_XSUB(j)  (1280 + 64 * (j))
#define XB_XGEN(j)  (2304 + 64 * (j))
#define XB_TOP      3328
#define XB_TOPGEN   3392
#define XCD_BAR_WORDS 3456
#define XB_SPIN_CAP (1u << 20)
__device__ __forceinline__ unsigned xb_ld(unsigned* p)              { return __hip_atomic_load(p, __ATOMIC_RELAXED, __HIP_MEMORY_SCOPE_AGENT); }
__device__ __forceinline__ unsigned xb_add(unsigned* p, unsigned v) { return __hip_atomic_fetch_add(p, v, __ATOMIC_RELAXED, __HIP_MEMORY_SCOPE_AGENT); }
__device__ __forceinline__ unsigned xb_xcc_id() { return (unsigned)__builtin_amdgcn_s_getreg((3 << 11) | 20) & 0xFu; }
#define XB_SPIN(cond, bar) do { unsigned _sp = 0; while (cond) { __builtin_amdgcn_s_sleep(1); \
    if ((++_sp & 255u) == 0u) { if (xb_ld(&(bar)[XB_TMO])) break; if (_sp > XB_SPIN_CAP) { atomicAdd(&(bar)[XB_TMO], 1u); break; } } } } while (0)
struct XcdBarrier { unsigned* bar; unsigned x; volatile LAS unsigned* st; };
__device__ __forceinline__ XcdBarrier xcd_barrier_post(unsigned* bar, volatile LAS unsigned* st) {
    XcdBarrier b; b.bar = bar; b.x = xb_xcc_id(); b.st = st;
    if (threadIdx.x == 0) (void)xb_add(&bar[XB_XCNT(b.x)], 1u);
    return b;
}
__device__ __forceinline__ void xcd_barrier_complete(unsigned* bar, unsigned x, unsigned& nloc, unsigned& nx) {
    const unsigned G = gridDim.x * gridDim.y * gridDim.z;
    unsigned sum, cnt, mine, sp = 0u;
    for (;;) {
        sum = 0u; cnt = 0u; mine = 0u;
#pragma unroll
        for (unsigned j = 0; j < 16; ++j) { const unsigned c = xb_ld(&bar[XB_XCNT(j)]); sum += c; cnt += (c > 0u) ? 1u : 0u; mine = (j == x) ? c : mine; }
        if (sum == G) break;
        __builtin_amdgcn_s_sleep(1);
        if ((++sp & 255u) == 0u) { if (xb_ld(&bar[XB_TMO])) break; if (sp > XB_SPIN_CAP) { atomicAdd(&bar[XB_TMO], 1u); break; } }
    }
    nloc = mine > 0u ? mine : 1u; nx = cnt > 0u ? cnt : 1u;
}
__device__ __forceinline__ void xcd_barrier(const XcdBarrier& b) {
    asm volatile("s_waitcnt vmcnt(0)" ::: "memory");
    __syncthreads();
    if (threadIdx.x == 0) {
        unsigned* bar = b.bar;
        __builtin_amdgcn_s_waitcnt(0);
        unsigned nloc = b.st[0], nx = b.st[1];
        if (nloc == 0u) { xcd_barrier_complete(bar, b.x, nloc, nx); b.st[0] = nloc; b.st[1] = nx; }
        const unsigned old = xb_add(&bar[XB_XSUB(b.x)], 1u);
        const unsigned gen = old / nloc;
        if (old + 1u == (gen + 1u) * nloc) {
            __builtin_amdgcn_fence(__ATOMIC_RELEASE, "agent");
            asm volatile("s_waitcnt vmcnt(0)" ::: "memory");
            const unsigned og = xb_add(&bar[XB_TOP], 1u);
            const unsigned tg = og / nx;
            if (og + 1u == (tg + 1u) * nx) xb_add(&bar[XB_TOPGEN], 1u);
            else XB_SPIN(xb_ld(&bar[XB_TOPGEN]) == tg, bar);
            __builtin_amdgcn_fence(__ATOMIC_ACQUIRE, "agent");
            xb_add(&bar[XB_XGEN(b.x)], 1u);
            asm volatile("s_waitcnt vmcnt(0)" ::: "memory");
        } else {
            XB_SPIN(xb_ld(&bar[XB_XGEN(b.x)]) == gen, bar);
            __builtin_amdgcn_fence(__ATOMIC_ACQUIRE, "agent");
            asm volatile("s_waitcnt vmcnt(0)" ::: "memory");
        }
    }
    __syncthreads();
}


namespace pg8 {
#define PG8_LAS __attribute__((address_space(3)))
typedef short bf16x8 __attribute__((ext_vector_type(8)));
typedef float f32x4 __attribute__((ext_vector_type(4)));
typedef unsigned u32x4 __attribute__((ext_vector_type(4)));
typedef unsigned u32x2 __attribute__((ext_vector_type(2)));
constexpr int BM = 256, BK = 64, HALF = 128, HTB = HALF * BK * 2, STAGE_BYTES = 8 * HTB, NXCD = 8, WGM = 8;
__host__ __device__ __forceinline__ int lds_byte(int r, int c) { const int st = (r >> 4) * 2 + (c >> 5), rr = r & 15, cc = c & 31, ob = rr * 64 + cc * 2; return st * 1024 + (ob ^ (((ob >> 9) & 1) << 5)); }
__host__ __device__ __forceinline__ void stage_rc(int b, int& R, int& C) { const int st = b / 1024, sb = b % 1024, swz = sb ^ (((sb >> 9) & 1) << 5); R = (st >> 1) * 16 + swz / 64; C = (st & 1) * 32 + (swz % 64) / 2; }
__host__ __device__ __forceinline__ int perm32(int rho) { const int n = rho >> 4, i = rho & 15; return 8 * (i >> 2) + 4 * n + (i & 3); }
struct Unit { int pm, pn; };
struct Gemm { const bf16_t* A; const bf16_t* Bt; int M, N, K; };
struct StaticOrder {
    int nM, nN, nwg, G, c;
    __host__ __device__ void init(int M, int N, int G_, int c_) { nM = M / BM; nN = N / BM; nwg = nM * nN; G = G_; c = c_; }
    __host__ __device__ bool next(int i, Unit& u) const {
        const long L = (long)i * G + c; if (L >= nwg) return false;
        int wgid = (int)L; { const int q = nwg / NXCD, r = nwg % NXCD, xcd = wgid % NXCD, off = wgid / NXCD; wgid = (xcd < r ? xcd * (q + 1) : r * (q + 1) + (xcd - r) * q) + off; }
        const int nig = WGM * nN, gid = wgid / nig, fm = gid * WGM, gsz = (nM - fm) < WGM ? (nM - fm) : WGM;
        u.pm = fm + ((wgid % nig) % gsz); u.pn = (wgid % nig) / gsz; return true;
    }
    __device__ __forceinline__ void a_ready(const Unit&) const {}
    __device__ __forceinline__ void done(const Unit&) const {}
};
__device__ __forceinline__ unsigned cvt_pk_bf16(float lo, float hi) { unsigned r; asm volatile("v_cvt_pk_bf16_f32 %0, %1, %2" : "=v"(r) : "v"(lo), "v"(hi)); return r; }

typedef int i32x4 __attribute__((ext_vector_type(4)));
template <bool I8>
__device__ __forceinline__ f32x4 mma16(const bf16x8 b, const bf16x8 a, const f32x4 c) {
    if constexpr (I8) return __builtin_bit_cast(f32x4, __builtin_amdgcn_mfma_i32_16x16x64_i8(__builtin_bit_cast(i32x4, b), __builtin_bit_cast(i32x4, a), __builtin_bit_cast(i32x4, c), 0, 0, 0));
    else return __builtin_amdgcn_mfma_f32_16x16x32_bf16(b, a, c, 0, 0, 0);
}
template <class Epi, class Sched, bool I8 = false>
__device__ __forceinline__ void gemm_phase(PG8_LAS unsigned char* lds, const Gemm g, const Sched& S, const Epi& E) {
    int tid_ = threadIdx.x; asm volatile("" : "+v"(tid_));
    const int tid = tid_, wid = __builtin_amdgcn_readfirstlane(tid >> 6), lane = tid & 63, wr = wid >> 2, wc = wid & 3, fr = lane & 15, fq = lane >> 4;
    const int K = g.K, nt = K / BK;
    unsigned voffA[2], voffB[2];
#pragma unroll
    for (int i = 0; i < 2; ++i) { int R, C; stage_rc(tid * 16 + i * 8192, R, C); const int Rb = Epi::PERM ? ((R & ~31) + perm32(R & 31)) : R;
        voffA[i] = (unsigned)(R * K + C) * 2u; voffB[i] = (unsigned)(Rb * K + C) * 2u; }
    const size_t kstep = (size_t)(BK * 2);
    const size_t hstep = (size_t)HALF * K * 2;
    const size_t tstep = 2 * hstep;
    const unsigned ldsw = (unsigned)wid * 1024u;
    const int aoff = lds_byte(wr * 64 + fr, fq * 8), boff = lds_byte(wc * 32 + fr, fq * 8);
#define PG8_SA(b, h) (((b) * 2 + (h)) * HTB)
#define PG8_SB(b, h) ((4 + (b) * 2 + (h)) * HTB)
#define PG8_STAGE(bufoff, gbase, voff) do { _Pragma("unroll") for (int _i = 0; _i < 2; ++_i) \
        __builtin_amdgcn_global_load_lds((const unsigned*)((const char*)(gbase) + (voff)[_i]), (PG8_LAS unsigned*)(lds + (bufoff) + ldsw + _i * 8192), 16, 0, 0); } while (0)
#define PG8_LDA(dst, b, h) do { _Pragma("unroll") for (int m = 0; m < 4; ++m) _Pragma("unroll") for (int k = 0; k < 2; ++k) dst[m][k] = *(const PG8_LAS bf16x8*)(lds + PG8_SA(b, h) + aoff + m * 2048 + k * 1024); } while (0)
#define PG8_LDB(dst, b, h) do { _Pragma("unroll") for (int n = 0; n < 2; ++n) _Pragma("unroll") for (int k = 0; k < 2; ++k) dst[n][k] = *(const PG8_LAS bf16x8*)(lds + PG8_SB(b, h) + boff + n * 2048 + k * 1024); } while (0)
#define PG8_MMA(ai, bj, At, Bt) do { __builtin_amdgcn_s_setprio(1); _Pragma("unroll") for (int m = 0; m < 4; ++m) _Pragma("unroll") for (int n = 0; n < 2; ++n) _Pragma("unroll") for (int k = 0; k < 2; ++k) \
        acc[ai][bj][m][n] = mma16<I8>(Bt[n][k], At[m][k], acc[ai][bj][m][n]); __builtin_amdgcn_s_setprio(0); } while (0)
#define PG8_WAIT_V(n) asm volatile("s_waitcnt vmcnt(" #n ")" ::: "memory")
#define PG8_WAIT_L(n) asm volatile("s_waitcnt lgkmcnt(" #n ")" ::: "memory")
#define PG8_BAR __builtin_amdgcn_s_barrier()
#define PG8_SCHED __builtin_amdgcn_sched_barrier(0)
    Unit cur, nxt; int ui = 0;
    if (!S.next(0, cur)) return;
    f32x4 acc[2][2][4][2];
#pragma unroll
    for (int a = 0; a < 2; ++a)
#pragma unroll
        for (int b = 0; b < 2; ++b)
#pragma unroll
            for (int m = 0; m < 4; ++m)
#pragma unroll
                for (int n = 0; n < 2; ++n) acc[a][b][m][n] = (f32x4){0.f, 0.f, 0.f, 0.f};
    bf16x8 At[4][2], B0[2][2], B1[2][2];
    const char* cA = (const char*)g.A + (size_t)cur.pm * tstep; const char* cB = (const char*)g.Bt + (size_t)cur.pn * tstep;
    S.a_ready(cur);
    PG8_STAGE(PG8_SB(0, 0), cB, voffB); PG8_STAGE(PG8_SA(0, 0), cA, voffA); PG8_STAGE(PG8_SB(0, 1), cB + hstep, voffB); PG8_STAGE(PG8_SA(0, 1), cA + hstep, voffA);
    if (wr == 1) PG8_BAR;
    PG8_WAIT_V(4); PG8_BAR;
    PG8_STAGE(PG8_SB(1, 0), cB + kstep, voffB); PG8_STAGE(PG8_SA(1, 0), cA + kstep, voffA); PG8_STAGE(PG8_SB(1, 1), cB + hstep + kstep, voffB);
    PG8_WAIT_V(6); PG8_BAR;
    for (;;) {
        const bool has_next = S.next(ui + 1, nxt);
        const char* nA = has_next ? (const char*)g.A + (size_t)nxt.pm * tstep : cA; const char* nB = has_next ? (const char*)g.Bt + (size_t)nxt.pn * tstep : cB;
        for (int t = 0; t < nt; t += 2) {
            const bool last = (t == nt - 2);
            const char* a1 = cA + (size_t)(t + 1) * kstep;
            const char* a2 = last ? nA : cA + (size_t)(t + 2) * kstep; const char* b2 = last ? nB : cB + (size_t)(t + 2) * kstep;
            const char* a3 = a2 + kstep; const char* b3 = b2 + kstep;
            if (last && has_next) S.a_ready(nxt);
            PG8_LDB(B0, 0, 0); PG8_SCHED; PG8_LDA(At, 0, 0); PG8_STAGE(PG8_SA(1, 1), a1 + hstep, voffA);
            PG8_WAIT_L(8); PG8_BAR; PG8_WAIT_L(0); PG8_MMA(0, 0, At, B0); PG8_BAR; PG8_SCHED;
            PG8_LDB(B1, 0, 1); PG8_STAGE(PG8_SB(0, 0), b2, voffB);
            PG8_BAR; PG8_WAIT_L(0); PG8_MMA(0, 1, At, B1); PG8_BAR;
            PG8_LDA(At, 0, 1); PG8_STAGE(PG8_SA(0, 0), a2, voffA);
            PG8_BAR; PG8_WAIT_L(0); PG8_MMA(1, 0, At, B0); PG8_BAR; PG8_SCHED;
            PG8_STAGE(PG8_SB(0, 1), b2 + hstep, voffB);
            PG8_WAIT_V(6); PG8_BAR; PG8_MMA(1, 1, At, B1); PG8_BAR;
            PG8_LDB(B0, 1, 0); PG8_SCHED; PG8_LDA(At, 1, 0); PG8_STAGE(PG8_SA(0, 1), a2 + hstep, voffA);
            PG8_WAIT_L(8); PG8_BAR; PG8_WAIT_L(0); PG8_MMA(0, 0, At, B0); PG8_BAR; PG8_SCHED;
            PG8_LDB(B1, 1, 1); PG8_STAGE(PG8_SB(1, 0), b3, voffB);
            PG8_BAR; PG8_WAIT_L(0); PG8_MMA(0, 1, At, B1); PG8_BAR;
            PG8_LDA(At, 1, 1); PG8_STAGE(PG8_SA(1, 0), a3, voffA);
            PG8_BAR; PG8_WAIT_L(0); PG8_MMA(1, 0, At, B0); PG8_BAR; PG8_SCHED;
            PG8_STAGE(PG8_SB(1, 1), b3 + hstep, voffB);
            PG8_WAIT_V(6); PG8_BAR; PG8_MMA(1, 1, At, B1); PG8_BAR;
        }
        if constexpr (!Epi::AFTER_DRAIN) { E(acc, cur, wr, wc, fr, fq); S.done(cur); }
        if (!has_next) break;
#pragma unroll
        for (int a = 0; a < 2; ++a)
#pragma unroll
            for (int b = 0; b < 2; ++b)
#pragma unroll
                for (int m = 0; m < 4; ++m)
#pragma unroll
                    for (int n = 0; n < 2; ++n) acc[a][b][m][n] = (f32x4){0.f, 0.f, 0.f, 0.f};
        cur = nxt; cA = nA; cB = nB; ++ui;
    }
    PG8_WAIT_V(0);
    if (wr == 0) PG8_BAR;
    PG8_BAR;
    if constexpr (Epi::AFTER_DRAIN) { E.fused(acc, cur, wr, wc, fr, fq, lds, wid, lane); S.done(cur); }
#undef PG8_SA
#undef PG8_SB
#undef PG8_STAGE
#undef PG8_LDA
#undef PG8_LDB
#undef PG8_MMA
#undef PG8_WAIT_V
#undef PG8_WAIT_L
#undef PG8_BAR
#undef PG8_SCHED
}
}

__host__ __device__ __forceinline__ int cmap_in(int F) { return (F & ~255) + 128 * ((F >> 5) & 1) + 32 * ((F >> 6) & 3) + (F & 31); }
struct EpiInprojMF {
    static constexpr bool PERM = true, AFTER_DRAIN = false;
    bf16_t* P; const float* rinv; const float* bias_f; const int* pos; const float* ftab; const float* qg; const float* kg; const float* swf;
    __device__ __forceinline__ void operator()(pg8::f32x4 (&acc)[2][2][4][2], const pg8::Unit& u, int wr, int wc, int fr, int fq) const {
        typedef pg8::f32x4 f32x4;
        asm volatile("" : "+v"(fr), "+v"(fq));
        const int type = u.pn >> 1, head = 4 * (u.pn & 1) + wc, fb = 256 * u.pn + 64 * wc;
        {
            f32x4 sw[2][2];
#pragma unroll
            for (int bj = 0; bj < 2; ++bj)
#pragma unroll
                for (int n = 0; n < 2; ++n) sw[bj][n] = *(const f32x4*)(swf + fb + 32 * bj + 8 * fq + 4 * n);
#pragma unroll
            for (int ai = 0; ai < 2; ++ai)
#pragma unroll
                for (int bj = 0; bj < 2; ++bj)
#pragma unroll
                    for (int m = 0; m < 4; ++m)
#pragma unroll
                        for (int n = 0; n < 2; ++n) {
                            const pg8::i32x4 iv = __builtin_bit_cast(pg8::i32x4, acc[ai][bj][m][n]);
                            f32x4 fv; fv[0] = (float)iv[0]; fv[1] = (float)iv[1]; fv[2] = (float)iv[2]; fv[3] = (float)iv[3];
                            acc[ai][bj][m][n] = fv * sw[bj][n];
                        }
        }
        const size_t PSZ = (size_t)T * 512;
        const int rslot = (type == 0) ? 0 : (type == 1) ? 1 : (type == 2) ? 5 : (type == 3) ? 2 : (type == 4) ? 3 : (type == 5) ? 4 : 6;
        bf16_t* rowmaj = P + (size_t)rslot * PSZ;
        const int t0 = u.pm * 256 + wr * 64 + fr;
        f32x4 bv[2][2], gv[2][2], fh[2], fl[2];
#pragma unroll
        for (int bj = 0; bj < 2; ++bj)
#pragma unroll
            for (int n = 0; n < 2; ++n) bv[bj][n] = *(const f32x4*)(bias_f + fb + 32 * bj + 8 * fq + 4 * n);
        if (type <= 1) {
#pragma unroll
            for (int n = 0; n < 2; ++n) { fh[n] = *(const f32x4*)(ftab + 8 * fq + 4 * n); fl[n] = *(const f32x4*)(ftab + 32 + 8 * fq + 4 * n); }
        } else if (type == 4 || type == 5) {
            const float* gsrc = (type == 4) ? qg : kg;
#pragma unroll
            for (int bj = 0; bj < 2; ++bj)
#pragma unroll
                for (int n = 0; n < 2; ++n) gv[bj][n] = *(const f32x4*)(gsrc + 32 * bj + 8 * fq + 4 * n);
        }
#pragma unroll
        for (int ai = 0; ai < 2; ++ai) {
            float rv[4], pf[4];
#pragma unroll
            for (int m = 0; m < 4; ++m) { rv[m] = rinv[t0 + ai * 128 + m * 16]; pf[m] = (float)pos[t0 + ai * 128 + m * 16]; }
            asm volatile("" : "+v"(rv[0]), "+v"(rv[1]), "+v"(rv[2]), "+v"(rv[3]), "+v"(pf[0]), "+v"(pf[1]), "+v"(pf[2]), "+v"(pf[3]));
#pragma unroll
            for (int m = 0; m < 4; ++m) {
                const int t = t0 + ai * 128 + m * 16;
                const float r = rv[m];
                f32x4 v[2][2];
#pragma unroll
                for (int bj = 0; bj < 2; ++bj)
#pragma unroll
                    for (int n = 0; n < 2; ++n) v[bj][n] = acc[ai][bj][m][n] * r + bv[bj][n];
                if (type <= 1) {
                    const float sc = (type == 1) ? 0.125f : 1.f, pp = pf[m];
#pragma unroll
                    for (int n = 0; n < 2; ++n)
#pragma unroll
                        for (int j = 0; j < 4; ++j) {
                            const float rev = __builtin_amdgcn_fractf(__builtin_amdgcn_fractf(pp * fh[n][j]) + pp * fl[n][j]);
                            const float cs = __builtin_amdgcn_cosf(rev) * sc, sn = __builtin_amdgcn_sinf(rev) * sc;
                            const float x1 = v[0][n][j], x2 = v[1][n][j]; v[0][n][j] = x1 * cs - x2 * sn; v[1][n][j] = x2 * cs + x1 * sn;
                        }
                } else if (type == 3) {
#pragma unroll
                    for (int bj = 0; bj < 2; ++bj)
#pragma unroll
                        for (int n = 0; n < 2; ++n)
#pragma unroll
                            for (int j = 0; j < 4; ++j) { const float x = v[bj][n][j]; v[bj][n][j] = x / (1.f + __expf(-x)); }
                } else if (type == 4 || type == 5) {
                    float ss = 0.f;
#pragma unroll
                    for (int bj = 0; bj < 2; ++bj)
#pragma unroll
                        for (int n = 0; n < 2; ++n)
#pragma unroll
                            for (int j = 0; j < 4; ++j) ss += v[bj][n][j] * v[bj][n][j];
                    ss += __shfl_xor(ss, 16); ss += __shfl_xor(ss, 32);
                    const float rn = (1.0f / sqrtf(ss * (1.f / 64.f) + EPS)) * ((type == 4) ? 0.125f * 1.44269504089f : 1.f);
#pragma unroll
                    for (int bj = 0; bj < 2; ++bj)
#pragma unroll
                        for (int n = 0; n < 2; ++n) v[bj][n] = v[bj][n] * rn * gv[bj][n];
                }
#pragma unroll
                for (int bj = 0; bj < 2; ++bj) {
                    pg8::u32x4 w; w.x = pg8::cvt_pk_bf16(v[bj][0][0], v[bj][0][1]); w.y = pg8::cvt_pk_bf16(v[bj][0][2], v[bj][0][3]);
                    w.z = pg8::cvt_pk_bf16(v[bj][1][0], v[bj][1][1]); w.w = pg8::cvt_pk_bf16(v[bj][1][2], v[bj][1][3]);
                    *(pg8::u32x4*)(rowmaj + (size_t)t * 512 + head * 64 + 32 * bj + 8 * fq) = w;
                }
            }
        }
    }
};

struct EpiOutprojMF {
    static constexpr bool PERM = false, AFTER_DRAIN = true;
    const bf16_t* xb; const float* gate1; bf16_t* x1b; float* part2;
    __device__ __forceinline__ void operator()(const pg8::f32x4 (&)[2][2][4][2], const pg8::Unit&, int, int, int, int) const {}
    __device__ __forceinline__ void fused(pg8::f32x4 (&acc)[2][2][4][2], const pg8::Unit& u, int wr, int wc, int fr, int fq, PG8_LAS unsigned char* lds, int wid, int lane) const {
        typedef pg8::f32x4 f32x4;
        asm volatile("" : "+v"(fr), "+v"(fq), "+v"(lane));
        constexpr int LD = 260;
        PG8_LAS float* TL = (PG8_LAS float*)lds;
        const int colw = wc * 32 + 4 * fq;
        f32x4 gv[2][2];
#pragma unroll
        for (int bj = 0; bj < 2; ++bj)
#pragma unroll
            for (int n = 0; n < 2; ++n) gv[bj][n] = *(const f32x4*)(gate1 + u.pn * 256 + colw + bj * 128 + n * 16);
#pragma unroll
        for (int ai = 0; ai < 2; ++ai) {
#pragma unroll
            for (int m = 0; m < 4; ++m)
#pragma unroll
                for (int bj = 0; bj < 2; ++bj)
#pragma unroll
                    for (int n = 0; n < 2; ++n) *(PG8_LAS f32x4*)(TL + (64 * wr + 16 * m + fr) * LD + colw + bj * 128 + n * 16) = gv[bj][n] * acc[ai][bj][m][n];
            __syncthreads();
            pg8::u32x2 xv[2];
            const size_t rowbase = (size_t)(u.pm * 256 + ai * 128 + 16 * wid) * D + u.pn * 256 + 4 * lane;
            xv[0] = *(const pg8::u32x2*)(xb + rowbase);
#pragma unroll
            for (int r = 0; r < 16; ++r) {
                if (r < 15) xv[(r + 1) & 1] = *(const pg8::u32x2*)(xb + rowbase + (size_t)(r + 1) * D);
                const f32x4 g = *(PG8_LAS f32x4*)(TL + (16 * wid + r) * LD + 4 * lane);
                const pg8::u32x2 xw = xv[r & 1];
                f32x4 o; o[0] = __uint_as_float(xw.x << 16) + g[0]; o[1] = __uint_as_float(xw.x & 0xffff0000u) + g[1]; o[2] = __uint_as_float(xw.y << 16) + g[2]; o[3] = __uint_as_float(xw.y & 0xffff0000u) + g[3];
                pg8::u32x2 w; w.x = pg8::cvt_pk_bf16(o[0], o[1]); w.y = pg8::cvt_pk_bf16(o[2], o[3]);
                *(pg8::u32x2*)(x1b + rowbase + (size_t)r * D) = w;
                float ss = o[0] * o[0] + o[1] * o[1] + o[2] * o[2] + o[3] * o[3];
#pragma unroll
                for (int o2 = 32; o2 > 0; o2 >>= 1) ss += __shfl_xor(ss, o2);
                if (lane < 4) part2[(size_t)(u.pm * 256 + ai * 128 + 16 * wid + r) * 16 + u.pn * 4 + lane] = (lane == 0) ? ss : 0.f;
            }
            __syncthreads();
        }
    }
};

__device__ __forceinline__ unsigned pk2(float lo, float hi) { return (unsigned)f2bf(lo) | ((unsigned)f2bf(hi) << 16); }
template <bool FOLD, bool CMAP>
__device__ __forceinline__ void transpose_item(const float* W, int K, int N, bf16_t* WT, float* scr, int item, int lane, const float* sg, const float* sm) {
    const int nblk = N / 32, kb = item / nblk, nb = item % nblk, k0 = 64 * kb, n0 = 32 * nb;
    float4 v[8]; float f[8];
#pragma unroll
    for (int i = 0; i < 8; ++i) { const int kk = 8 * i + (lane >> 3); v[i] = *(const float4*)(W + (size_t)(k0 + kk) * N + n0 + 4 * (lane & 7));
        f[i] = FOLD ? sg[k0 + kk] * (1.f + sm[k0 + kk]) : 1.f; }
#pragma unroll
    for (int i = 0; i < 8; ++i) { const int kk = 8 * i + (lane >> 3); float* d = scr + kk * 33 + 4 * (lane & 7);
        d[0] = v[i].x * f[i]; d[1] = v[i].y * f[i]; d[2] = v[i].z * f[i]; d[3] = v[i].w * f[i]; }
    asm volatile("s_waitcnt lgkmcnt(0)" ::: "memory");
    const int c = lane & 7, r0 = CMAP ? cmap_in(n0) : n0;
#pragma unroll
    for (int j = 0; j < 4; ++j) { const int n = (lane >> 3) + 8 * j; const float* s = scr + (8 * c) * 33 + n;
        pg8::u32x4 o; o.x = pk2(s[0 * 33], s[1 * 33]); o.y = pk2(s[2 * 33], s[3 * 33]); o.z = pk2(s[4 * 33], s[5 * 33]); o.w = pk2(s[6 * 33], s[7 * 33]);
        *(pg8::u32x4*)(WT + (size_t)(r0 + n) * K + k0 + 8 * c) = o; }
    asm volatile("s_waitcnt lgkmcnt(0)" ::: "memory");
}
template <int NC4, class VF>
__device__ __forceinline__ void gemv_cols(unsigned char* lds, const VF vf, const float* W, const int N, const int u, float* dst, const float* add) {
    constexpr int RG = 512 / NC4;
    float (*red)[NC4 * 4] = (float (*)[NC4 * 4])lds;
    const int tid = threadIdx.x, c4 = tid % NC4, rg = tid / NC4;
    if (rg < RG) {
        float4 acc = {0.f, 0.f, 0.f, 0.f};
        for (int r = rg; r < 1024; r += RG) { const float s = vf(r); const float4 w = *(const float4*)(W + (size_t)r * N + u * NC4 * 4 + c4 * 4);
            acc.x += s * w.x; acc.y += s * w.y; acc.z += s * w.z; acc.w += s * w.w; }
        red[rg][c4 * 4 + 0] = acc.x; red[rg][c4 * 4 + 1] = acc.y; red[rg][c4 * 4 + 2] = acc.z; red[rg][c4 * 4 + 3] = acc.w;
    }
    __syncthreads();
    if (tid < NC4 * 4) { float s = 0.f; for (int i = 0; i < RG; ++i) s += red[i][tid]; dst[u * NC4 * 4 + tid] = s + (add ? add[u * NC4 * 4 + tid] : 0.f); }
    __syncthreads();
}
struct VfSilu { const float* c; __device__ __forceinline__ float operator()(int r) const { const float v = c[r]; return v / (1.f + expf(-v)); } };
struct VfVec { const float* v; __device__ __forceinline__ float operator()(int r) const { return v[r]; } };


typedef float f32x16 __attribute__((ext_vector_type(16)));
typedef pg8::bf16x8 bf16x8;
#define MFMA32(a, b, c) __builtin_amdgcn_mfma_f32_32x32x16_bf16((a), (b), (c), 0, 0, 0)
__device__ __forceinline__ bf16x8 pack_frag(const f32x16& v, int s) {
    pg8::u32x4 w;
    w.x = pg8::cvt_pk_bf16(v[8 * s + 0], v[8 * s + 1]); w.y = pg8::cvt_pk_bf16(v[8 * s + 2], v[8 * s + 3]);
    w.z = pg8::cvt_pk_bf16(v[8 * s + 4], v[8 * s + 5]); w.w = pg8::cvt_pk_bf16(v[8 * s + 6], v[8 * s + 7]);
    return __builtin_bit_cast(bf16x8, w);
}
__device__ __forceinline__ bf16x8 load_tfrag(const bf16_t* rowp, int tok) {
    const uint2 a = *(const uint2*)(rowp + tok), b = *(const uint2*)(rowp + tok + 8);
    pg8::u32x4 w; w.x = a.x; w.y = a.y; w.z = b.x; w.w = b.y;
    return __builtin_bit_cast(bf16x8, w);
}


__device__ __forceinline__ bf16x8 tr_frag(const unsigned char* a0, int rows2) {
    typedef short s16x4 __attribute__((ext_vector_type(4)));
    typedef __attribute__((address_space(3))) s16x4 lds_s16x4;
    const s16x4 lo = __builtin_amdgcn_ds_read_tr16_b64_v4i16((lds_s16x4*)a0);
    const s16x4 hi = __builtin_amdgcn_ds_read_tr16_b64_v4i16((lds_s16x4*)(a0 + rows2 * 144));
    const uint2 l2 = __builtin_bit_cast(uint2, lo), h2 = __builtin_bit_cast(uint2, hi);
    pg8::u32x4 fw; fw.x = l2.x; fw.y = l2.y; fw.z = h2.x; fw.w = h2.y;
    return __builtin_bit_cast(bf16x8, fw);
}

__device__ __forceinline__ void ins16(float (&s)[16], float x) {
#pragma unroll
    for (int i = 15; i >= 1; --i) s[i] = __builtin_amdgcn_fmed3f(s[i - 1], s[i], x);
    s[0] = fmaxf(s[0], x);
}


struct OneUnitOrder {
    pg8::StaticOrder base; int round;
    __device__ __forceinline__ bool next(int i, pg8::Unit& u) const { if (i != 0) return false; return base.next(round, u); }
    __device__ __forceinline__ void a_ready(const pg8::Unit&) const {}
    __device__ __forceinline__ void done(const pg8::Unit&) const {}
};
struct EpiTopkMF {
    static constexpr bool PERM = false, AFTER_DRAIN = true;
    const float* part2; const float* bias_q; unsigned short* ids; float* gates;
    __device__ __forceinline__ void operator()(const pg8::f32x4 (&)[2][2][4][2], const pg8::Unit&, int, int, int, int) const {}
    __device__ __forceinline__ void fused(pg8::f32x4 (&acc)[2][2][4][2], const pg8::Unit& u, int wr, int wc, int fr, int fq, PG8_LAS unsigned char* lds, int wid, int lane) const {
        typedef pg8::f32x4 f32x4;
        constexpr int SLD = 260;
        PG8_LAS float* SC = (PG8_LAS float*)lds; PG8_LAS float* MG = (PG8_LAS float*)(lds + 128 * SLD * 4);
        const int tid = wid * 64 + lane, tok = tid & 255, hk = tid >> 8;
        float rinv[2][4];
#pragma unroll
        for (int ai = 0; ai < 2; ++ai)
#pragma unroll
            for (int m = 0; m < 4; ++m) {
                const int row = u.pm * 256 + ai * 128 + wr * 64 + m * 16 + fr;
                const f32x4* pp = (const f32x4*)(part2 + (size_t)row * 16);
                const f32x4 p0 = pp[0], p1 = pp[1], p2 = pp[2], p3 = pp[3];
                const float ssum = ((p0[0] + p0[1]) + (p0[2] + p0[3])) + ((p1[0] + p1[1]) + (p1[2] + p1[3])) + ((p2[0] + p2[1]) + (p2[2] + p2[3])) + ((p3[0] + p3[1]) + (p3[2] + p3[3]));
                rinv[ai][m] = 1.0f / sqrtf(ssum * (1.0f / D) + EPS);
            }
        float sl[16], mine[16];
#pragma unroll
        for (int p = 0; p < 2; ++p) {
            f32x4 bv[2];
#pragma unroll
            for (int n = 0; n < 2; ++n) bv[n] = *(const f32x4*)(bias_q + u.pn * 256 + p * 128 + wc * 32 + n * 16 + 4 * fq);
#pragma unroll
            for (int ai = 0; ai < 2; ++ai)
#pragma unroll
                for (int m = 0; m < 4; ++m)
#pragma unroll
                    for (int n = 0; n < 2; ++n)
#pragma unroll
                        for (int j = 0; j < 4; ++j)
                            SC[(32 * wc + 16 * n + 4 * fq + j) * SLD + (128 * ai + 64 * wr + 16 * m + fr)] = acc[ai][p][m][n][j] * rinv[ai][m] + bv[n][j];
            __syncthreads();
#pragma unroll
            for (int i = 0; i < 16; ++i) sl[i] = -INFINITY;
#pragma unroll 8
            for (int k = 0; k < 64; ++k) { const int key = 64 * hk + k; const float x = SC[key * SLD + tok]; ins16(sl, __uint_as_float((__float_as_uint(x) & 0xFFFFFF80u) | (unsigned)key)); }
            if (hk != p) {
#pragma unroll
                for (int i = 0; i < 16; ++i) MG[i * 256 + tok] = sl[i];
            }
            __syncthreads();
            if (hk == p) {
#pragma unroll
                for (int i = 0; i < 16; ++i) ins16(sl, MG[i * 256 + tok]);
#pragma unroll
                for (int i = 0; i < 16; ++i) mine[i] = sl[i];
            }
            __syncthreads();
        }
        PG8_LAS float* X1 = SC; PG8_LAS float* TL = SC + 4096; PG8_LAS unsigned* I0 = (PG8_LAS unsigned*)(SC + 8192); PG8_LAS unsigned* I1 = (PG8_LAS unsigned*)(SC + 12288);
        if (hk) {
#pragma unroll
            for (int i = 0; i < 16; ++i) { X1[i * 256 + tok] = mine[i]; I1[i * 256 + tok] = __float_as_uint(mine[i]) & 0x7Fu; }
        } else {
#pragma unroll
            for (int i = 0; i < 16; ++i) I0[i * 256 + tok] = __float_as_uint(mine[i]) & 0x7Fu;
        }
        __syncthreads();
        if (!hk) {
            float s1m[16], tl[16];
#pragma unroll
            for (int i = 0; i < 16; ++i) { s1m[i] = __uint_as_float(__float_as_uint(X1[i * 256 + tok]) & 0xFFFFFF80u); mine[i] = __uint_as_float(__float_as_uint(mine[i]) & 0xFFFFFF80u); tl[i] = -INFINITY; }
#pragma unroll
            for (int a2 = 0; a2 < 16; ++a2)
#pragma unroll
                for (int b2 = 0; b2 < 16; ++b2)
                    if ((a2 + 1) * (b2 + 1) <= 16) ins16(tl, __uint_as_float((__float_as_uint(mine[a2] + s1m[b2]) & 0xFFFFFF00u) | (unsigned)(a2 * 16 + b2)));
#pragma unroll
            for (int i = 0; i < 16; ++i) TL[i * 256 + tok] = tl[i];
        }
        __syncthreads();
        if (hk) {
            float ev[16]; float sum = 0.f; unsigned cd[16];
#pragma unroll
            for (int j = 0; j < 16; ++j) { const unsigned bits = __float_as_uint(TL[j * 256 + tok]); cd[j] = bits & 0xFFu; ev[j] = __uint_as_float(bits & 0xFFFFFF00u); }
            const float mx = ev[0];
#pragma unroll
            for (int j = 0; j < 16; ++j) { ev[j] = __expf(ev[j] - mx); sum += ev[j]; }
            const float inv = 1.f / sum;
            unsigned idw[8];
#pragma unroll
            for (int j = 0; j < 16; ++j) {
                const unsigned id = I0[(cd[j] >> 4) * 256 + tok] * 128u + I1[(cd[j] & 15u) * 256 + tok];
                if (j & 1) idw[j >> 1] |= id << 16; else idw[j >> 1] = id;
                ev[j] *= inv;
            }
            const size_t t = (size_t)u.pm * 256 + tok;
            unsigned short* idp = ids + t * 128 + u.pn * 16; float* gp = gates + t * 128 + u.pn * 16;
            *(uint4*)idp = make_uint4(idw[0], idw[1], idw[2], idw[3]); *(uint4*)(idp + 8) = make_uint4(idw[4], idw[5], idw[6], idw[7]);
#pragma unroll
            for (int q = 0; q < 4; ++q) *(float4*)(gp + 4 * q) = make_float4(ev[4 * q], ev[4 * q + 1], ev[4 * q + 2], ev[4 * q + 3]);
        }
        __syncthreads();
    }
};


__device__ __forceinline__ void convert_tables(const float* down, const float* up, unsigned char* q8, bf16_t* dsc, int lane, int cw, int nconv, int r0, int r1) {
    for (int row0 = r0 + cw * 2; row0 < r1; row0 += nconv * 2) {
        float4 v[2][4];
#pragma unroll
        for (int rr = 0; rr < 2; ++rr) {
            const int row = row0 + rr, isup = row >> 14, e = row & 16383;
            const float* sp = (isup ? up : down) + (size_t)e * 1024 + lane * 4;
#pragma unroll
            for (int q = 0; q < 4; ++q) v[rr][q] = ld_nt4(sp + 256 * q);
        }
#pragma unroll
        for (int rr = 0; rr < 2; ++rr) {
            const int row = row0 + rr, isup = row >> 14, e = row & 16383;
            {
                float ss = 0.f;
#pragma unroll
                for (int q = 0; q < 4; ++q) ss += v[rr][q].x * v[rr][q].x + v[rr][q].y * v[rr][q].y + v[rr][q].z * v[rr][q].z + v[rr][q].w * v[rr][q].w;
#pragma unroll
                for (int o = 32; o > 0; o >>= 1) ss += __shfl_xor(ss, o);
                const float sigma = sqrtf(ss * (1.0f / 1024.0f));
                const float s = (sigma > 0.f) ? 7.5f / (2.6f * sigma) : 1.f;
#pragma unroll
                for (int q = 0; q < 4; ++q) {
                    const int n0 = (int)fminf(fmaxf(__builtin_rintf(v[rr][q].x * s), -8.f), 7.f) + 8, n1 = (int)fminf(fmaxf(__builtin_rintf(v[rr][q].y * s), -8.f), 7.f) + 8;
                    const int n2 = (int)fminf(fmaxf(__builtin_rintf(v[rr][q].z * s), -8.f), 7.f) + 8, n3 = (int)fminf(fmaxf(__builtin_rintf(v[rr][q].w * s), -8.f), 7.f) + 8;
                    const int h1 = isup ? ((n1 - 8) & 15) : n1, h3 = isup ? ((n3 - 8) & 15) : n3;
                    *(unsigned short*)(q8 + (size_t)isup * (8u << 20) + ((size_t)q * 16384 + e) * 128 + (lane & 7) * 16 + (lane >> 3) * 2) = (unsigned short)(n0 | (h1 << 4) | (n2 << 8) | (h3 << 12));
                }
                if (lane == 0) dsc[row] = f2bf(1.0f / s);
            }
        }
    }
}

struct Params {
    const float *x, *c; const int* pos; const float *ada_w, *ada_b, *g1, *g2, *w_in, *rgain, *qg, *kg, *og, *w_out, *wq, *sk, *down, *up;
    float* out; unsigned char* ws; RopeC rc;
};

__global__ void __launch_bounds__(512) mk_fwd(Params p) {
    extern __shared__ __attribute__((aligned(16))) unsigned char lds[];
    const int tid = threadIdx.x, lane = tid & 63, bid = blockIdx.x, G = gridDim.x; int wave = tid >> 6;
    unsigned char* ws = p.ws;
    float* mod = (float*)(ws + OFF_MOD); float* rinv1 = (float*)(ws + OFF_RINV1); float* ftab = (float*)(ws + OFF_ROPE);
    bf16_t* P = (bf16_t*)(ws + OFF_P); float* kv = (float*)(ws + OFF_KV); bf16_t* stT = (bf16_t*)(ws + OFF_ST); bf16_t* ycat = (bf16_t*)(ws + OFF_YCAT);
    bf16_t* xb = (bf16_t*)(ws + OFF_XB); bf16_t* Win_t = (bf16_t*)(ws + OFF_WINT); float* bias_f = (float*)(ws + OFF_BIASF);
    unsigned char* xq = ws + OFF_XQ; float* swf = (float*)(ws + OFF_SWF);
    bf16_t* Weff_t = (bf16_t*)(ws + OFF_WEFFT); bf16_t* Wout_t = (bf16_t*)(ws + OFF_WOUTT); float* bias_q = (float*)(ws + OFF_BIASQ); float* bq_part = (float*)(ws + OFF_BQPART);
    float* part2 = (float*)(ws + OFF_PART2); bf16_t* x1b = (bf16_t*)(ws + OFF_X1B); unsigned short* ids = (unsigned short*)(ws + OFF_IDS); unsigned char* q8 = ws + OFF_Q8; bf16_t* dsc = (bf16_t*)(ws + OFF_DSC); float* gates = (float*)(ws + OFF_GATES);
    const size_t PS = (size_t)T * 512;
    const bf16_t *Qr = P, *Kr = P + PS, *Gr = P + 2 * PS, *Qs = P + 3 * PS, *Ks = P + 4 * PS, *Vr = P + 5 * PS, *Vs = P + 6 * PS;
    float* out = p.out;

    if (tid < 4) ((LAS unsigned*)((LAS unsigned char*)lds + LDS_ST_OFF))[tid] = 0u;
    __syncthreads();
    XcdBarrier bar = xcd_barrier_post((unsigned*)(ws + OFF_CTL), (volatile LAS unsigned*)((LAS unsigned char*)lds + LDS_ST_OFF));

    for (int u = bid; u < 256; u += G) gemv_cols<6>(lds, VfSilu{p.c}, p.ada_w, 6144, u, mod, p.ada_b);
    for (int row0 = (bid * 8 + wave) * 2; row0 < T; row0 += G * 16) {
        float4 v[2][4];
#pragma unroll
        for (int rr = 0; rr < 2; ++rr)
#pragma unroll
            for (int j = 0; j < 4; ++j) v[rr][j] = ld_nt4(p.x + (size_t)(row0 + rr) * D + (lane + 64 * j) * 4);
#pragma unroll
        for (int rr = 0; rr < 2; ++rr) {
            uint2* xo = (uint2*)(xb + (size_t)(row0 + rr) * D);
            float s = 0.f, am = 0.f;
#pragma unroll
            for (int j = 0; j < 4; ++j) { const float4 q = v[rr][j]; s += q.x * q.x + q.y * q.y + q.z * q.z + q.w * q.w;
                am = fmaxf(fmaxf(am, fmaxf(fabsf(q.x), fabsf(q.y))), fmaxf(fabsf(q.z), fabsf(q.w))); xo[lane + 64 * j] = make_uint2(pk2(q.x, q.y), pk2(q.z, q.w)); }
#pragma unroll
            for (int o = 32; o > 0; o >>= 1) { s += __shfl_xor(s, o); am = fmaxf(am, __shfl_xor(am, o)); }
            const float qs = (am > 0.f) ? 127.f / am : 0.f;
            unsigned* xqo = (unsigned*)(xq + (size_t)(row0 + rr) * D);
#pragma unroll
            for (int j = 0; j < 4; ++j) { const float4 q = v[rr][j];
                const unsigned b0 = __float_as_uint(fmaf(q.x, qs, 12582912.f)), b1 = __float_as_uint(fmaf(q.y, qs, 12582912.f)), b2 = __float_as_uint(fmaf(q.z, qs, 12582912.f)), b3 = __float_as_uint(fmaf(q.w, qs, 12582912.f));
                xqo[lane + 64 * j] = (b0 & 255u) | ((b1 & 255u) << 8) | ((b2 & 255u) << 16) | (b3 << 24); }
            if (lane == 0) rinv1[row0 + rr] = (1.0f / sqrtf(s * (1.0f / D) + EPS)) * (am * (1.f / 127.f));
        }
    }
    if (bid == 0 && tid == 0) {
#pragma unroll
        for (int i = 0; i < 32; ++i) { ftab[i] = p.rc.fh[i]; ftab[32 + i] = p.rc.fl[i]; }
    }
    xcd_barrier(bar);

    {
        for (int nb = bid; nb < 112; nb += G) {
            const int n0 = 32 * nb, r8 = lane >> 3, c = lane & 7, kw = 128 * wave;
            float* cm = (float*)(lds + 8 * 4608);
            unsigned* tl = (unsigned*)(lds + wave * 4608);
            float4 v[16];
#pragma unroll
            for (int i = 0; i < 16; ++i) { const int kk = 32 * (i >> 2) + 4 * r8 + (i & 3); v[i] = *(const float4*)(p.w_in + (size_t)(kw + kk) * 3584 + n0 + 4 * c); }
            float4 mx = {0.f, 0.f, 0.f, 0.f};
#pragma unroll
            for (int i = 0; i < 16; ++i) { const int kk = 32 * (i >> 2) + 4 * r8 + (i & 3); const float f = p.g1[kw + kk] * (1.f + mod[1024 + kw + kk]);
                v[i].x *= f; v[i].y *= f; v[i].z *= f; v[i].w *= f;
                mx.x = fmaxf(mx.x, fabsf(v[i].x)); mx.y = fmaxf(mx.y, fabsf(v[i].y)); mx.z = fmaxf(mx.z, fabsf(v[i].z)); mx.w = fmaxf(mx.w, fabsf(v[i].w)); }
#pragma unroll
            for (int o = 8; o < 64; o <<= 1) { mx.x = fmaxf(mx.x, __shfl_xor(mx.x, o)); mx.y = fmaxf(mx.y, __shfl_xor(mx.y, o)); mx.z = fmaxf(mx.z, __shfl_xor(mx.z, o)); mx.w = fmaxf(mx.w, __shfl_xor(mx.w, o)); }
            if (lane < 8) *(float4*)(cm + wave * 32 + 4 * c) = mx;
            __syncthreads();
#pragma unroll
            for (int w2 = 0; w2 < 8; ++w2) { const float4 o = *(const float4*)(cm + w2 * 32 + 4 * c); mx.x = fmaxf(mx.x, o.x); mx.y = fmaxf(mx.y, o.y); mx.z = fmaxf(mx.z, o.z); mx.w = fmaxf(mx.w, o.w); }
            if (wave == 0 && lane < 8) *(float4*)(swf + n0 + 4 * c) = make_float4(mx.x * (1.f / 127.f), mx.y * (1.f / 127.f), mx.z * (1.f / 127.f), mx.w * (1.f / 127.f));
            const float qx = (mx.x > 0.f) ? 127.f / mx.x : 0.f, qy = (mx.y > 0.f) ? 127.f / mx.y : 0.f, qz = (mx.z > 0.f) ? 127.f / mx.z : 0.f, qw = (mx.w > 0.f) ? 127.f / mx.w : 0.f;
#pragma unroll
            for (int a = 0; a < 4; ++a) {
                unsigned d[4];
#pragma unroll
                for (int j = 0; j < 4; ++j) {
                    const float qq = (j == 0) ? qx : (j == 1) ? qy : (j == 2) ? qz : qw;
                    unsigned w = 0;
#pragma unroll
                    for (int b = 0; b < 4; ++b) { const float4 t = v[4 * a + b]; const float e = (j == 0) ? t.x : (j == 1) ? t.y : (j == 2) ? t.z : t.w;
                        w |= (__float_as_uint(fmaf(e, qq, 12582912.f)) & 255u) << (8 * b); }
                    d[j] = w;
                }
#pragma unroll
                for (int j = 0; j < 4; ++j) tl[(4 * c + j) * 34 + 8 * a + r8] = d[j];
            }
            asm volatile("s_waitcnt lgkmcnt(0)" ::: "memory");
            const int rb = cmap_in(n0);
#pragma unroll
            for (int jj = 0; jj < 4; ++jj) { const int q = lane + 64 * jj, n = q >> 3, ch = q & 7;
                const uint2 lo = *(const uint2*)(tl + n * 34 + 4 * ch), hi = *(const uint2*)(tl + n * 34 + 4 * ch + 2);
                pg8::u32x4 o; o.x = lo.x; o.y = lo.y; o.z = hi.x; o.w = hi.y;
                *(pg8::u32x4*)((unsigned char*)Win_t + (size_t)(rb + n) * 1024 + kw + 16 * ch) = o; }
            __syncthreads();
        }
        for (int u = bid - 128; u >= 0 && u < 128; u += G) gemv_cols<7>(lds, VfVec{mod}, p.w_in, 3584, u, bias_f, nullptr);
    }
    xcd_barrier(bar);

    {
        pg8::Gemm g{(const bf16_t*)xq, Win_t, T, 3584, 512}; pg8::StaticOrder S; S.init(T, 3584, G, bid);
        EpiInprojMF E{P, rinv1, bias_f, p.pos, ftab, p.qg, p.kg, swf};
        pg8::gemm_phase<EpiInprojMF, pg8::StaticOrder, true>((PG8_LAS unsigned char*)lds, g, S, E);
        const int nidle = (G > 128) ? G - 128 : G, ib = (G > 128) ? bid - 128 : bid;
        {
            float* scr = (float*)(lds + wave * 16384);
            if (ib >= 0) for (int it = ib * 8 + wave; it < 16 * 32; it += nidle * 8) transpose_item<false, false>(p.w_out, 1024, 1024, Wout_t, scr, it, lane, nullptr, nullptr);
            __syncthreads();
        }
        if (ib >= 0) for (int wu = ib; wu < 256; wu += nidle) {
            const int hp = wu >> 4, blk = wu & 15, i0 = blk * 64;
            __syncthreads();
            unsigned char* Wt = lds; unsigned char* St = lds + 64 * 272; float* bred = (float*)(lds + 64 * 272 + 128 * 272);
            for (int e4 = tid; e4 < 2048; e4 += 512) { const int r = e4 >> 5, c4 = e4 & 31; const float4 v = *(const float4*)(p.wq + (size_t)(i0 + r) * 2048 + hp * 128 + 4 * c4);
                *(uint2*)(Wt + r * 272 + c4 * 8) = make_uint2(pk2(v.x, v.y), pk2(v.z, v.w)); }
            for (int e4 = tid; e4 < 4096; e4 += 512) { const int r = e4 >> 5, c4 = e4 & 31; const float4 v = *(const float4*)(p.sk + ((size_t)hp * 128 + r) * 128 + 4 * c4);
                *(uint2*)(St + r * 272 + c4 * 8) = make_uint2(pk2(v.x, v.y), pk2(v.z, v.w)); }
            __syncthreads();
            const int rt = wave >> 2, ct = wave & 3, l31 = lane & 31, hf = lane >> 5;
            f32x16 C;
#pragma unroll
            for (int r = 0; r < 16; ++r) C[r] = 0.f;
#pragma unroll
            for (int s8 = 0; s8 < 8; ++s8) C = MFMA32(*(const bf16x8*)(Wt + (32 * rt + l31) * 272 + (16 * s8 + 8 * hf) * 2), *(const bf16x8*)(St + (32 * ct + l31) * 272 + (16 * s8 + 8 * hf) * 2), C);
            float bsum = 0.f;
            bf16_t* wcol = Weff_t + (size_t)(hp * 128 + 32 * ct + l31) * 1024 + i0 + 32 * rt + 4 * hf;
#pragma unroll
            for (int g4 = 0; g4 < 4; ++g4) {
                const int i = i0 + 32 * rt + 8 * g4 + 4 * hf;
                const float4 gg = *(const float4*)(p.g2 + i), sc = *(const float4*)(mod + 4096 + i), sh = *(const float4*)(mod + 3072 + i);
                const float c0 = C[4 * g4], c1 = C[4 * g4 + 1], c2 = C[4 * g4 + 2], c3 = C[4 * g4 + 3];
                bsum += sh.x * c0 + sh.y * c1 + sh.z * c2 + sh.w * c3;
                *(uint2*)(wcol + 8 * g4) = make_uint2(pk2(c0 * gg.x * (1.f + sc.x), c1 * gg.y * (1.f + sc.y)), pk2(c2 * gg.z * (1.f + sc.z), c3 * gg.w * (1.f + sc.w)));
            }
            bsum += __shfl_xor(bsum, 32);
            if (hf == 0) bred[rt * 128 + 32 * ct + l31] = bsum;
            __syncthreads();
            if (tid < 128) bq_part[(size_t)blk * 2048 + hp * 128 + tid] = bred[tid] + bred[128 + tid];
        }
        __syncthreads();
        if (ib >= 0) convert_tables(p.down, p.up, q8, dsc, lane, ib * 8 + wave, nidle * 8, 0, CONV_SPLIT);
    }
    xcd_barrier(bar);
    wave = threadIdx.x >> 6; asm volatile("" : "+v"(wave));

    {
        const int gw = __builtin_amdgcn_readfirstlane(bid * 8 + wave), NGW = G * 8, l31 = lane & 31, hf = lane >> 5;
        const int wv0 = __builtin_amdgcn_readfirstlane(wave);
        for (int U = gw; U < 1024; U += NGW) {
            const int n = U >> 3, h = U & 7;
            f32x16 C[2][2];
#pragma unroll
            for (int a = 0; a < 2; ++a)
#pragma unroll
                for (int b = 0; b < 2; ++b)
#pragma unroll
                    for (int r = 0; r < 16; ++r) C[a][b][r] = 0.f;
            unsigned char* Kt = lds + wv0 * 9216; unsigned char* Vt = Kt + 4608;
            const int r8 = lane >> 3, pc = lane & 7, trq = (lane & 15) >> 2, trp = lane & 3, trd = (lane >> 4) & 1;
            const char* kbase = (const char*)(Kr + (size_t)n * 128 * 512 + h * 64); const char* vbase = (const char*)(Vr + (size_t)n * 128 * 512 + h * 64);
            const unsigned loff = (unsigned)(r8 * 512 + pc * 8) * 2u;
            const float lg = lg2_head(h);
            pg8::u32x4 gK[4], gV[4];
#pragma unroll
            for (int i = 0; i < 4; ++i) { gK[i] = *(const pg8::u32x4*)(kbase + (loff + i * 8192u)); gV[i] = *(const pg8::u32x4*)(vbase + (loff + i * 8192u)); }
            for (int sb4 = 0; sb4 < 4; ++sb4) {
#pragma unroll
                for (int i = 0; i < 4; ++i) { *(pg8::u32x4*)(Kt + (8 * i + r8) * 144 + pc * 16) = gK[i]; *(pg8::u32x4*)(Vt + (8 * i + r8) * 144 + pc * 16) = gV[i]; }
                { const int sn = (sb4 < 3) ? sb4 + 1 : sb4;
#pragma unroll
                  for (int i = 0; i < 4; ++i) { gK[i] = *(const pg8::u32x4*)(kbase + (size_t)sn * 32768 + (loff + i * 8192u)); gV[i] = *(const pg8::u32x4*)(vbase + (size_t)sn * 32768 + (loff + i * 8192u)); } }
#pragma unroll
                for (int s = 0; s < 2; ++s) {
                    bf16x8 Af[2], Bf[2];
#pragma unroll
                    for (int a = 0; a < 2; ++a) {
                        Af[a] = tr_frag(Vt + (16 * s + 8 * hf + trq) * 144 + (32 * a + 16 * trd + 4 * trp) * 2, 4);
                        const bf16x8 kraw = tr_frag(Kt + (16 * s + 8 * hf + trq) * 144 + (32 * a + 16 * trd + 4 * trp) * 2, 4);
                        const pg8::u32x4 kw = __builtin_bit_cast(pg8::u32x4, kraw); const unsigned kk[4] = {kw.x, kw.y, kw.z, kw.w};
                        pg8::u32x4 o; unsigned* op = (unsigned*)&o;
#pragma unroll
                        for (int e2 = 0; e2 < 4; ++e2) {
                            const int j0 = 32 * sb4 + 16 * s + 8 * hf + 2 * e2;
                            const float z0 = __builtin_amdgcn_exp2f((float)(127 - j0) * lg), z1 = __builtin_amdgcn_exp2f((float)(126 - j0) * lg);
                            op[e2] = pg8::cvt_pk_bf16(__uint_as_float(kk[e2] << 16) * z0, __uint_as_float(kk[e2] & 0xffff0000u) * z1);
                        }
                        Bf[a] = __builtin_bit_cast(bf16x8, o);
                    }
#pragma unroll
                    for (int a = 0; a < 2; ++a)
#pragma unroll
                        for (int b = 0; b < 2; ++b) C[a][b] = MFMA32(Af[a], Bf[b], C[a][b]);
                }
            }
            float* dst = kv + (size_t)(n * 8 + h) * 4096;
#pragma unroll
            for (int a = 0; a < 2; ++a)
#pragma unroll
                for (int b = 0; b < 2; ++b)
#pragma unroll
                    for (int r = 0; r < 16; ++r) dst[(32 * a + (r & 3) + 8 * (r >> 2) + 4 * hf) * 64 + 32 * b + l31] = C[a][b][r];
        }
        bf16x8 Tri[2];
        {
            pg8::u32x4 w0, w1; unsigned* p0 = (unsigned*)&w0; unsigned* p1 = (unsigned*)&w1;
#pragma unroll
            for (int e2 = 0; e2 < 4; ++e2) {
                unsigned a0 = 0, a1 = 0;
#pragma unroll
                for (int q = 0; q < 2; ++q) { const int e = 2 * e2 + q, ip = 8 * (e >> 2) + 4 * hf + (e & 3);
                    a0 |= ((ip > l31) ? 0x3F80u : 0u) << (16 * q); a1 |= ((16 + ip > l31) ? 0x3F80u : 0u) << (16 * q); }
                p0[e2] = a0; p1[e2] = a1;
            }
            Tri[0] = __builtin_bit_cast(bf16x8, w0); Tri[1] = __builtin_bit_cast(bf16x8, w1);
        }
        const bool sb_local = (G % 8 == 0) && (4096 % G == 0) && ((4096 / G) % 8 == 0);
        const int sb_per_wave = sb_local ? 4096 / G / 8 : (4096 + NGW - 1 - gw) / NGW;
        const int wv = __builtin_amdgcn_readfirstlane(wave);
        for (int ps = 0; ps < sb_per_wave; ++ps) {
            const int U = sb_local ? 0 : gw + ps * NGW;
            const int h = sb_local ? (bid & 7) : (U & 7), qt = sb_local ? (bid >> 3) * (4096 / G) + ps * 8 + wv : (U >> 3), q0 = qt * 32;
            f32x16 O[2];
#pragma unroll
            for (int r = 0; r < 16; ++r) { O[0][r] = 0.f; O[1][r] = 0.f; }
            float carry = 0.f;
            unsigned char* Kt = lds + wv * 9216; unsigned char* Vt = Kt + 4608;
            const int r8 = lane >> 3, pc = lane & 7;
            const char* kbase = (const char*)(Ks + h * 64); const char* vbase = (const char*)(Vs + h * 64);
            const unsigned loff = (unsigned)(r8 * 512 + pc * 8) * 2u;
            pg8::u32x4 gK[4], gV[4];
            bf16x8 Qf[4];
            {
                const char* qbase = (const char*)(Qs + h * 64);
#pragma unroll
                for (int i = 0; i < 4; ++i) gK[i] = *(const pg8::u32x4*)(qbase + (size_t)qt * 32768 + (loff + i * 8192u));
#pragma unroll
                for (int i = 0; i < 4; ++i) *(pg8::u32x4*)(Kt + (8 * i + r8) * 144 + pc * 16) = gK[i];
#pragma unroll
                for (int s = 0; s < 4; ++s) Qf[s] = *(const bf16x8*)(Kt + l31 * 144 + 32 * s + 16 * hf);
            }
#pragma unroll
            for (int i = 0; i < 4; ++i) { gK[i] = *(const pg8::u32x4*)(kbase + (size_t)qt * 32768 + (loff + i * 8192u)); gV[i] = *(const pg8::u32x4*)(vbase + (size_t)qt * 32768 + (loff + i * 8192u)); }
            const int trq = (lane & 15) >> 2, trp = lane & 3, trd = (lane >> 4) & 1;
            for (int kb = qt; kb >= 0; --kb) {
#pragma unroll
                for (int i = 0; i < 4; ++i) { *(pg8::u32x4*)(Kt + (8 * i + r8) * 144 + pc * 16) = gK[i]; *(pg8::u32x4*)(Vt + (8 * i + r8) * 144 + pc * 16) = gV[i]; }
                {
                    const int kbn = (kb > 0) ? kb - 1 : 0;
#pragma unroll
                    for (int i = 0; i < 4; ++i) { gK[i] = *(const pg8::u32x4*)(kbase + (size_t)kbn * 32768 + (loff + i * 8192u)); gV[i] = *(const pg8::u32x4*)(vbase + (size_t)kbn * 32768 + (loff + i * 8192u)); }
                }
                bf16x8 Kf[4], Vf[2][2];
#pragma unroll
                for (int s = 0; s < 4; ++s) Kf[s] = *(const bf16x8*)(Kt + l31 * 144 + 32 * s + 16 * hf);
#pragma unroll
                for (int s = 0; s < 2; ++s)
#pragma unroll
                    for (int dt = 0; dt < 2; ++dt) {
                        Vf[s][dt] = tr_frag(Vt + (16 * s + 4 * hf + trq) * 144 + (32 * dt + 16 * trd + 4 * trp) * 2, 8);
                    }
                f32x16 S;
#pragma unroll
                for (int r = 0; r < 16; ++r) S[r] = 0.f;
#pragma unroll
                for (int s = 0; s < 4; ++s) S = MFMA32(Kf[s], Qf[s], S);
                const bool diag = (kb == qt);
                f32x16 sp, lb;
                float csum = 0.f;
                if (diag) {
#pragma unroll
                    for (int r = 0; r < 16; ++r) {
                        const int i = (r & 3) + 8 * (r >> 2) + 4 * hf;
                        const float z = S[r];
                        const float l1p = __builtin_amdgcn_logf(1.0f + __builtin_amdgcn_exp2f(-fabsf(z)));
                        const float spv = (i < l31) ? (fmaxf(z, 0.f) + l1p) : 0.f;
                        sp[r] = spv; lb[r] = (i < l31) ? (fminf(z, 0.f) - l1p) : -INFINITY; csum += spv;
                    }
                } else {
#pragma unroll
                    for (int r = 0; r < 16; ++r) {
                        const float z = S[r];
                        const float l1p = __builtin_amdgcn_logf(1.0f + __builtin_amdgcn_exp2f(-fabsf(z)));
                        const float spv = fmaxf(z, 0.f) + l1p;
                        sp[r] = spv; lb[r] = fminf(z, 0.f) - l1p; csum += spv;
                    }
                }
                f32x16 Rt;
#pragma unroll
                for (int r = 0; r < 16; ++r) Rt[r] = carry;
#pragma unroll
                for (int s = 0; s < 2; ++s) Rt = MFMA32(Tri[s], pack_frag(sp, s), Rt);
                f32x16 wv;
#pragma unroll
                for (int r = 0; r < 16; ++r) wv[r] = __builtin_amdgcn_exp2f(lb[r] - Rt[r]);
#pragma unroll
                for (int s = 0; s < 2; ++s) { const bf16x8 wp = pack_frag(wv, s);
#pragma unroll
                    for (int dt = 0; dt < 2; ++dt) O[dt] = MFMA32(Vf[s][dt], wp, O[dt]); }
                csum += __shfl_xor(csum, 32);
                carry += csum;
                if (__all(carry > 127.f)) break;
            }
            float ss = 0.f;
#pragma unroll
            for (int r = 0; r < 16; ++r) ss += O[0][r] * O[0][r] + O[1][r] * O[1][r];
            ss += __shfl_xor(ss, 32);
            const float rn = 1.0f / sqrtf(ss * (1.f / 64.f) + EPS);
#pragma unroll
            for (int dt = 0; dt < 2; ++dt)
#pragma unroll
                for (int g4 = 0; g4 < 4; ++g4) {
                    const int d = 32 * dt + 8 * g4 + 4 * hf;
                    const float4 gn = *(const float4*)(p.og + d);
                    uint2 w; w.x = pg8::cvt_pk_bf16(O[dt][4 * g4] * rn * gn.x, O[dt][4 * g4 + 1] * rn * gn.y); w.y = pg8::cvt_pk_bf16(O[dt][4 * g4 + 2] * rn * gn.z, O[dt][4 * g4 + 3] * rn * gn.w);
                    *(uint2*)(Kt + l31 * 144 + d * 2) = w;
                }
#pragma unroll
            for (int i = 0; i < 4; ++i) *(pg8::u32x4*)(ycat + (size_t)(q0 + 8 * i + r8) * 1024 + 512 + h * 64 + pc * 8) = *(const pg8::u32x4*)(Kt + (8 * i + r8) * 144 + pc * 16);
        }
    }
    xcd_barrier(bar);

    if (bid == 255 % G) for (int n = tid; n < 2048; n += 512) { float s = 0.f;
#pragma unroll
        for (int b8 = 0; b8 < 16; ++b8) s += bq_part[(size_t)b8 * 2048 + n];
        bias_q[n] = s; }
    if (G > 64 && bid >= 64) convert_tables(p.down, p.up, q8, dsc, lane, (bid - 64) * 8 + wave, (G - 64) * 8, CONV_SPLIT, 32768);
    else if (G <= 64) convert_tables(p.down, p.up, q8, dsc, lane, bid * 8 + wave, G * 8, CONV_SPLIT, 32768);
    for (int idx = bid * 512 + tid; idx < 32768; idx += G * 512) {
        const int h = idx >> 12;
        const float cd = exp2f(128.f * lg2_head(h));
        float s = 0.f;
        for (int n0 = 0; n0 < 128; n0 += 32) {
            float kvv[32];
#pragma unroll
            for (int q = 0; q < 32; ++q) kvv[q] = kv[(size_t)(n0 + q) * 32768 + idx];
#pragma unroll
            for (int q = 0; q < 32; ++q) { stT[(size_t)(n0 + q) * 32768 + idx] = f2bf(s); s = cd * s + kvv[q]; }
        }
    }
    xcd_barrier(bar);

    {
        const int gw = __builtin_amdgcn_readfirstlane(bid * 8 + wave), NGW = G * 8, l31 = lane & 31, hf = lane >> 5;
        const int wv4 = __builtin_amdgcn_readfirstlane(wave);
        for (int W2 = gw; W2 < 2048; W2 += NGW) {
            const int nh = W2 >> 1, n = nh >> 3, h = nh & 7;
            const float lg = lg2_head(h);
#pragma unroll 1
            for (int pass = 0; pass < 2; ++pass) {
                const int qt = (W2 & 1) ? (pass ? 2 : 1) : (pass ? 3 : 0);
                const int il = qt * 32 + l31, tq = n * 128 + il;
                unsigned char* Kt = lds + wv4 * 9216; unsigned char* Vt = Kt + 4608;
                const int r8 = lane >> 3, pc = lane & 7, trq = (lane & 15) >> 2, trp = lane & 3, trd = (lane >> 4) & 1;
                const unsigned loff = (unsigned)(r8 * 512 + pc * 8) * 2u;
                pg8::u32x4 gK[4], gV[4];
                bf16x8 Qf[4];
                {
                    const char* qbase = (const char*)(Qr + (size_t)(n * 128 + qt * 32) * 512 + h * 64);
                    const char* sbase = (const char*)(stT + (size_t)nh * 4096) + (unsigned)(r8 * 64 + pc * 8) * 2u;
#pragma unroll
                    for (int i = 0; i < 4; ++i) gK[i] = *(const pg8::u32x4*)(qbase + (loff + i * 8192u));
#pragma unroll
                    for (int i = 0; i < 4; ++i) *(pg8::u32x4*)(Kt + (8 * i + r8) * 144 + pc * 16) = gK[i];
#pragma unroll
                    for (int s = 0; s < 4; ++s) Qf[s] = *(const bf16x8*)(Kt + l31 * 144 + 32 * s + 16 * hf);
#pragma unroll
                    for (int i = 0; i < 4; ++i) { gK[i] = *(const pg8::u32x4*)(sbase + i * 1024u); gV[i] = *(const pg8::u32x4*)(sbase + 4096u + i * 1024u); }
#pragma unroll
                    for (int i = 0; i < 4; ++i) { *(pg8::u32x4*)(Kt + (8 * i + r8) * 144 + pc * 16) = gK[i]; *(pg8::u32x4*)(Kt + (32 + 8 * i + r8) * 144 + pc * 16) = gV[i]; }
                }
                f32x16 O[2];
#pragma unroll
                for (int r = 0; r < 16; ++r) { O[0][r] = 0.f; O[1][r] = 0.f; }
#pragma unroll
                for (int s = 0; s < 4; ++s)
#pragma unroll
                    for (int dt = 0; dt < 2; ++dt) O[dt] = MFMA32(*(const bf16x8*)(Kt + (32 * dt + l31) * 144 + 32 * s + 16 * hf), Qf[s], O[dt]);
                const float xi = exp2f((float)(il + 1) * lg);
#pragma unroll
                for (int r = 0; r < 16; ++r) { O[0][r] *= xi; O[1][r] *= xi; }
                const char* kbase = (const char*)(Kr + (size_t)n * 128 * 512 + h * 64); const char* vbase = (const char*)(Vr + (size_t)n * 128 * 512 + h * 64);
#pragma unroll
                for (int i = 0; i < 4; ++i) { gK[i] = *(const pg8::u32x4*)(kbase + (loff + i * 8192u)); gV[i] = *(const pg8::u32x4*)(vbase + (loff + i * 8192u)); }
                for (int jb = 0; jb <= qt; ++jb) {
#pragma unroll
                    for (int i = 0; i < 4; ++i) { *(pg8::u32x4*)(Kt + (8 * i + r8) * 144 + pc * 16) = gK[i]; *(pg8::u32x4*)(Vt + (8 * i + r8) * 144 + pc * 16) = gV[i]; }
                    { const int jn = (jb < qt) ? jb + 1 : jb;
#pragma unroll
                      for (int i = 0; i < 4; ++i) { gK[i] = *(const pg8::u32x4*)(kbase + (size_t)jn * 32768 + (loff + i * 8192u)); gV[i] = *(const pg8::u32x4*)(vbase + (size_t)jn * 32768 + (loff + i * 8192u)); } }
                    bf16x8 Kf[4], Vf[2][2];
#pragma unroll
                    for (int s = 0; s < 4; ++s) Kf[s] = *(const bf16x8*)(Kt + l31 * 144 + 32 * s + 16 * hf);
#pragma unroll
                    for (int s = 0; s < 2; ++s)
#pragma unroll
                        for (int dt = 0; dt < 2; ++dt) Vf[s][dt] = tr_frag(Vt + (16 * s + 4 * hf + trq) * 144 + (32 * dt + 16 * trd + 4 * trp) * 2, 8);
                    f32x16 S;
#pragma unroll
                    for (int r = 0; r < 16; ++r) S[r] = 0.f;
#pragma unroll
                    for (int s = 0; s < 4; ++s) S = MFMA32(Kf[s], Qf[s], S);
#pragma unroll
                    for (int r = 0; r < 16; ++r) {
                        const int jl = jb * 32 + (r & 3) + 8 * (r >> 2) + 4 * hf, dl = il - jl;
                        S[r] = (dl >= 0) ? S[r] * __builtin_amdgcn_exp2f((float)dl * lg) : 0.f;
                    }
#pragma unroll
                    for (int s = 0; s < 2; ++s) { const bf16x8 wp = pack_frag(S, s);
#pragma unroll
                        for (int dt = 0; dt < 2; ++dt) O[dt] = MFMA32(Vf[s][dt], wp, O[dt]); }
                }
                float sm = 0.f;
#pragma unroll
                for (int r = 0; r < 16; ++r) sm += O[0][r] + O[1][r];
                sm += __shfl_xor(sm, 32);
                const float mean = sm * (1.f / 64.f);
                float vs = 0.f;
#pragma unroll
                for (int r = 0; r < 16; ++r) { const float d0 = O[0][r] - mean, d1 = O[1][r] - mean; vs += d0 * d0 + d1 * d1; }
                vs += __shfl_xor(vs, 32);
                const float rstd = 1.0f / sqrtf(vs * (1.f / 64.f) + EPS);
                {
                    const char* gbase = (const char*)(Gr + (size_t)(n * 128 + qt * 32) * 512 + h * 64);
#pragma unroll
                    for (int i = 0; i < 4; ++i) gV[i] = *(const pg8::u32x4*)(gbase + (loff + i * 8192u));
#pragma unroll
                    for (int i = 0; i < 4; ++i) *(pg8::u32x4*)(Vt + (8 * i + r8) * 144 + pc * 16) = gV[i];
                }
#pragma unroll
                for (int dt = 0; dt < 2; ++dt)
#pragma unroll
                    for (int g4 = 0; g4 < 4; ++g4) {
                        const int e = 32 * dt + 8 * g4 + 4 * hf;
                        const float4 gn = *(const float4*)(p.rgain + h * 64 + e);
                        const uint2 gg = *(const uint2*)(Vt + l31 * 144 + e * 2);
                        const float g0 = __uint_as_float(gg.x << 16), g1 = __uint_as_float(gg.x & 0xffff0000u), g2v = __uint_as_float(gg.y << 16), g3 = __uint_as_float(gg.y & 0xffff0000u);
                        uint2 w;
                        w.x = pg8::cvt_pk_bf16((O[dt][4 * g4] - mean) * rstd * gn.x * g0, (O[dt][4 * g4 + 1] - mean) * rstd * gn.y * g1);
                        w.y = pg8::cvt_pk_bf16((O[dt][4 * g4 + 2] - mean) * rstd * gn.z * g2v, (O[dt][4 * g4 + 3] - mean) * rstd * gn.w * g3);
                        *(uint2*)(Kt + l31 * 144 + e * 2) = w;
                    }
#pragma unroll
                for (int i = 0; i < 4; ++i) *(pg8::u32x4*)(ycat + (size_t)(n * 128 + qt * 32 + 8 * i + r8) * 1024 + h * 64 + pc * 8) = *(const pg8::u32x4*)(Kt + (8 * i + r8) * 144 + pc * 16);
            }
        }
    }
    xcd_barrier(bar);

    {
        pg8::Gemm g{ycat, Wout_t, T, 1024, 1024}; pg8::StaticOrder S; S.init(T, 1024, G, bid);
        EpiOutprojMF E{xb, mod + 2048, x1b, part2};
        pg8::gemm_phase<EpiOutprojMF, pg8::StaticOrder>((PG8_LAS unsigned char*)lds, g, S, E);
    }
    xcd_barrier(bar);

    for (int round = 0; round < 2; ++round) {
        pg8::Gemm g{x1b, Weff_t, T, 2048, 1024}; OneUnitOrder S; S.base.init(T, 2048, G, bid); S.round = round;
        EpiTopkMF E{part2, bias_q, ids, gates};
        pg8::gemm_phase<EpiTopkMF, OneUnitOrder>((PG8_LAS unsigned char*)lds, g, S, E);
    }
    xcd_barrier(bar);

    {
        constexpr int IDS_LD = 136, ACT_LD = 136;
        const float* scale2 = mod + 4096; const float* shift2 = mod + 3072; const float* gate2 = mod + 5120;
        unsigned short* ids_l = (unsigned short*)lds; float* act_l = (float*)(lds + 32768);
        bf16_t* ds_l = (bf16_t*)(lds + 69632);
        const int t0 = bid * 64, tt = lane >> 3, sub = lane & 7, tl = wave * 8 + tt, t = t0 + tl;
        for (int e = tid; e < 1024; e += 512) { const int r = e >> 4, c8 = e & 15; *(uint4*)(ids_l + r * IDS_LD + c8 * 8) = *(const uint4*)(ids + (size_t)(t0 + r) * 128 + c8 * 8); }
        for (int e = tid; e < 64 * ACT_LD; e += 512) act_l[e] = 0.f;
        for (int e = tid; e < 4096; e += 512) ((uint4*)ds_l)[e] = ((const uint4*)dsc)[e];
        float* s2_l = (float*)(lds + 143360); float* sh2_l = s2_l + 1024; float* gt2_l = s2_l + 2048;
        for (int e = tid; e < 1024; e += 512) { s2_l[e] = p.g2[e] * (1.f + scale2[e]); sh2_l[e] = shift2[e]; gt2_l[e] = gate2[e]; }
        __syncthreads();
        float ri;
        { const float4* pp = (const float4*)(part2 + (size_t)t * 16); const float4 p0 = pp[0], p1 = pp[1], p2 = pp[2], p3 = pp[3];
          const float ssum = ((p0.x + p0.y) + (p0.z + p0.w)) + ((p1.x + p1.y) + (p1.z + p1.w)) + ((p2.x + p2.y) + (p2.z + p2.w)) + ((p3.x + p3.y) + (p3.z + p3.w));
          ri = 1.0f / sqrtf(ssum * (1.0f / D) + EPS); }
        const unsigned short* myids = ids_l + tl * IDS_LD;
        float* myact = act_l + tl * ACT_LD;
        const bool s4 = (sub & 4) != 0, s2 = (sub & 2) != 0, s1 = (sub & 1) != 0;
        const unsigned suboff = (unsigned)sub * 16u;
        typedef float f32x2 __attribute__((ext_vector_type(2)));
#define P9_LOAD(W, JB) do { const uint4 idv_ = *(const uint4*)(myids + 8 * (JB)); const unsigned idw_[4] = {idv_.x, idv_.y, idv_.z, idv_.w}; \
        _Pragma("unroll") for (int k_ = 0; k_ < 8; ++k_) { const unsigned id_ = (idw_[k_ >> 1] >> (16 * (k_ & 1))) & 0xffffu; W[k_] = *(const uint4*)(sbase + (id_ * 128u + suboff)); } } while (0)
#define P9_DOWN4(W, JB) do { int pd_[8]; \
        _Pragma("unroll") for (int k_ = 0; k_ < 8; ++k_) { const unsigned ww_[4] = {W[k_].x, W[k_].y, W[k_].z, W[k_].w}; int a0_ = 0, a1_ = 0; \
            _Pragma("unroll") for (int m_ = 0; m_ < 4; ++m_) { a0_ = __builtin_amdgcn_sdot4(hpe[m_], (int)(ww_[m_] & 0x0F0F0F0Fu), a0_, false); a1_ = __builtin_amdgcn_sdot4(hpo[m_], (int)((ww_[m_] >> 4) & 0x0F0F0F0Fu), a1_, false); } \
            pd_[k_] = a0_ + a1_ - hoff; } \
        int r4_[4], r2_[2]; \
        _Pragma("unroll") for (int k_ = 0; k_ < 4; ++k_) { const int snd_ = s4 ? pd_[k_] : pd_[k_ + 4], kp_ = s4 ? pd_[k_ + 4] : pd_[k_]; r4_[k_] = kp_ + __shfl_xor(snd_, 4); } \
        _Pragma("unroll") for (int k_ = 0; k_ < 2; ++k_) { const int snd_ = s2 ? r4_[k_] : r4_[k_ + 2], kp_ = s2 ? r4_[k_ + 2] : r4_[k_]; r2_[k_] = kp_ + __shfl_xor(snd_, 2); } \
        { const int snd_ = s1 ? r2_[0] : r2_[1], kp_ = s1 ? r2_[1] : r2_[0]; myact[8 * (JB) + sub] += (float)(kp_ + __shfl_xor(snd_, 1)) * hscale; } } while (0)
        for (int c = 0; c < 4; ++c) {
            float hf[8][4]; float hmax = 0.f;
#pragma unroll
            for (int q = 0; q < 8; ++q) {
                const int col = 256 * c + 4 * sub + 32 * q;
                const uint2 xw = *(const uint2*)(x1b + (size_t)t * D + col);
                const float4 sv = *(const float4*)(s2_l + col), sh = *(const float4*)(sh2_l + col);
                hf[q][0] = __uint_as_float(xw.x << 16) * ri * sv.x + sh.x; hf[q][1] = __uint_as_float(xw.x & 0xffff0000u) * ri * sv.y + sh.y;
                hf[q][2] = __uint_as_float(xw.y << 16) * ri * sv.z + sh.z; hf[q][3] = __uint_as_float(xw.y & 0xffff0000u) * ri * sv.w + sh.w;
                hmax = fmaxf(hmax, fmaxf(fmaxf(fabsf(hf[q][0]), fabsf(hf[q][1])), fmaxf(fabsf(hf[q][2]), fabsf(hf[q][3]))));
            }
            hmax = fmaxf(hmax, __shfl_xor(hmax, 1)); hmax = fmaxf(hmax, __shfl_xor(hmax, 2)); hmax = fmaxf(hmax, __shfl_xor(hmax, 4));
            const float hinv = (hmax > 0.f) ? 127.0f / hmax : 0.f, hscale = hmax * (1.0f / 127.0f);
            int hq[8][4];
#pragma unroll
            for (int q = 0; q < 8; ++q)
#pragma unroll
                for (int j = 0; j < 4; ++j) hq[q][j] = (int)__builtin_rintf(hf[q][j] * hinv);
            int hpe[4], hpo[4], hoff = 0;
#pragma unroll
            for (int m = 0; m < 4; ++m) {
                hpe[m] = (hq[2 * m][0] & 255) | ((hq[2 * m][2] & 255) << 8) | ((hq[2 * m + 1][0] & 255) << 16) | ((hq[2 * m + 1][2] & 255) << 24);
                hpo[m] = (hq[2 * m][1] & 255) | ((hq[2 * m][3] & 255) << 8) | ((hq[2 * m + 1][1] & 255) << 16) | ((hq[2 * m + 1][3] & 255) << 24);
            }
#pragma unroll
            for (int q = 0; q < 8; ++q) hoff += (hq[q][0] + hq[q][1]) + (hq[q][2] + hq[q][3]);
            hoff *= 8;
            const unsigned char* sbase = q8 + (size_t)c * (16384 * 128);
            uint4 wA[8], wB[8];
            P9_LOAD(wA, 0);
#pragma unroll 1
            for (int jb = 0; jb < 16; jb += 2) {
                P9_LOAD(wB, jb + 1);
                P9_DOWN4(wA, jb);
                if (jb + 2 < 16) P9_LOAD(wA, jb + 2);
                P9_DOWN4(wB, jb + 1);
            }
        }
#undef P9_DOWN4
        signed char* aq_l = (signed char*)(lds + 135168);
        float avv[16]; float amax = 0.f;
#pragma unroll
        for (int jb = 0; jb < 16; ++jb) {
            const int j = 8 * jb + sub; const unsigned id = myids[j];
            const float a = myact[j] * bf2f(ds_l[id]);
            const float av = fabsf(a), tq = 1.0f / (av * 0.2316418882f + 1.0f);
            float ql = tq * 0.5307027145f + (-0.7265760135f); ql = ql * tq + 0.7107068705f; ql = ql * tq + (-0.142248368f); ql = ql * tq + 0.127414796f; ql = ql * tq;
            const float mm = a * (ql * exp2f(a * a * (-0.72134752044f)));
            const float ge = (a < 0.f) ? mm : (a - mm);
            avv[jb] = ge * gates[(size_t)t * 128 + j] * bf2f(ds_l[16384 + id]);
            amax = fmaxf(amax, fabsf(avv[jb]));
        }
        amax = fmaxf(amax, __shfl_xor(amax, 1)); amax = fmaxf(amax, __shfl_xor(amax, 2)); amax = fmaxf(amax, __shfl_xor(amax, 4));
        const float ainv = (amax > 0.f) ? 127.0f / amax : 0.f, ascale = amax * (1.0f / 127.0f);
        int aqsum = 0;
#pragma unroll
        for (int jb = 0; jb < 16; ++jb) { const int aqv = (int)__builtin_rintf(avv[jb] * ainv); aq_l[tl * 128 + 8 * jb + sub] = (signed char)aqv; aqsum += aqv; }
        aqsum += __shfl_xor(aqsum, 1); aqsum += __shfl_xor(aqsum, 2); aqsum += __shfl_xor(aqsum, 4);
        __syncthreads();
#define P9_PERM(HI, LO, SEL) __builtin_amdgcn_perm((HI), (LO), (SEL))
#define P9_T4(E0, E1, E2, E3, T0, T1, T2, T3) do { const unsigned p0_ = P9_PERM(E1, E0, 0x05010400u), p1_ = P9_PERM(E1, E0, 0x07030602u), p2_ = P9_PERM(E3, E2, 0x05010400u), p3_ = P9_PERM(E3, E2, 0x07030602u); \
        T0 = P9_PERM(p2_, p0_, 0x05040100u); T1 = P9_PERM(p2_, p0_, 0x07060302u); T2 = P9_PERM(p3_, p1_, 0x05040100u); T3 = P9_PERM(p3_, p1_, 0x07060302u); } while (0)
#define P9_UP4(W, JB) do { const uint2 aq8_ = *(const uint2*)(aq_l + tl * 128 + 8 * (JB)); const int aq4_[2] = {(int)aq8_.x, (int)aq8_.y}; \
        _Pragma("unroll") for (int g_ = 0; g_ < 2; ++g_) { \
            _Pragma("unroll") for (int m_ = 0; m_ < 4; ++m_) { \
                const unsigned w0_ = ((const unsigned*)&W[4 * g_ + 0])[m_], w1_ = ((const unsigned*)&W[4 * g_ + 1])[m_], w2_ = ((const unsigned*)&W[4 * g_ + 2])[m_], w3_ = ((const unsigned*)&W[4 * g_ + 3])[m_]; \
                unsigned t_[4]; \
                P9_T4(w0_, w1_, w2_, w3_, t_[0], t_[1], t_[2], t_[3]); \
                _Pragma("unroll") for (int k_ = 0; k_ < 4; ++k_) { \
                    oraw[4 * m_ + k_] = __builtin_amdgcn_sdot4(aq4_[g_], (int)t_[k_], oraw[4 * m_ + k_], false); \
                    olo[4 * m_ + k_] = __builtin_amdgcn_sdot4(aq4_[g_], (int)(t_[k_] & 0x0F0F0F0Fu), olo[4 * m_ + k_], false); } } } } while (0)
        for (int c = 0; c < 4; ++c) {
            int oraw[16], olo[16];
#pragma unroll
            for (int q = 0; q < 16; ++q) { oraw[q] = 0; olo[q] = 0; }
            const unsigned char* sbase = q8 + (8u << 20) + (size_t)c * (16384 * 128);
            uint4 wA[8], wB[8];
            P9_LOAD(wA, 0);
#pragma unroll 1
            for (int jb = 0; jb < 16; jb += 2) {
                P9_LOAD(wB, jb + 1);
                P9_UP4(wA, jb);
                if (jb + 2 < 16) P9_LOAD(wA, jb + 2);
                P9_UP4(wB, jb + 1);
            }
#pragma unroll
            for (int q = 0; q < 8; ++q) {
                const int col = 256 * c + 4 * sub + 32 * q;
                float* op = out + (size_t)t * D + col;
                const uint2 xw = *(const uint2*)(x1b + (size_t)t * D + col); const float4 xv = make_float4(__uint_as_float(xw.x << 16), __uint_as_float(xw.x & 0xffff0000u), __uint_as_float(xw.y << 16), __uint_as_float(xw.y & 0xffff0000u)); const float4 gt = *(const float4*)(gt2_l + col);
                const int m = q >> 1, k0 = 2 * (q & 1);
                const int v0 = olo[4 * m + k0] - 8 * aqsum, v1 = (oraw[4 * m + k0] - olo[4 * m + k0]) >> 4, v2 = olo[4 * m + k0 + 1] - 8 * aqsum, v3 = (oraw[4 * m + k0 + 1] - olo[4 * m + k0 + 1]) >> 4;
                float4 r;
                r.x = xv.x + gt.x * ((float)v0 * ascale); r.y = xv.y + gt.y * ((float)v1 * ascale); r.z = xv.z + gt.z * ((float)v2 * ascale); r.w = xv.w + gt.w * ((float)v3 * ascale);
                *(float4*)op = r;
            }
        }
#undef P9_LOAD
#undef P9_UP4
#undef P9_T4
#undef P9_PERM
    }
}
}

extern "C" void kernel_launch(void* const* d_in, const int* in_sizes, int n_in, void* d_out, int out_size, void* d_ws, size_t ws_size, hipStream_t stream) {
    static int grid = 0;
    if (grid == 0) {
        int dev = 0, cus = 0, per_cu = 0;
        (void)hipGetDevice(&dev);
        (void)hipDeviceGetAttribute(&cus, hipDeviceAttributeMultiprocessorCount, dev);
        (void)hipFuncSetAttribute((const void*)mk_fwd, hipFuncAttributeMaxDynamicSharedMemorySize, LDS_BYTES);
        (void)hipOccupancyMaxActiveBlocksPerMultiprocessor(&per_cu, (const void*)mk_fwd, 512, LDS_BYTES);
        if (per_cu < 1 || cus != 256) { fprintf(stderr, "kernel_launch: needs 256 CUs with one resident workgroup each (cus %d, per_cu %d)\n", cus, per_cu); grid = -1; }
        else grid = cus;
    }
    if (grid < 0) return;
    (void)hipMemsetAsync((char*)d_ws + OFF_CTL, 0, CTL_BYTES, stream);
    Params p{};
    p.x = (const float*)d_in[0]; p.c = (const float*)d_in[1]; p.pos = (const int*)d_in[2]; p.ada_w = (const float*)d_in[3]; p.ada_b = (const float*)d_in[4];
    p.g1 = (const float*)d_in[5]; p.g2 = (const float*)d_in[6]; p.w_in = (const float*)d_in[7]; p.rgain = (const float*)d_in[8]; p.qg = (const float*)d_in[9];
    p.kg = (const float*)d_in[10]; p.og = (const float*)d_in[11]; p.w_out = (const float*)d_in[12]; p.wq = (const float*)d_in[13]; p.sk = (const float*)d_in[14];
    p.down = (const float*)d_in[15]; p.up = (const float*)d_in[16]; p.out = (float*)d_out; p.ws = (unsigned char*)d_ws;
    for (int i = 0; i < 32; ++i) {
        const double f = pow(10000.0, -(double)i / 32.0) / 6.283185307179586476925;
        float fh = (float)f; unsigned ub; memcpy(&ub, &fh, 4); ub &= 0xFFFFC000u; memcpy(&fh, &ub, 4);
        p.rc.fh[i] = fh; p.rc.fl[i] = (float)(f - (double)fh);
    }
    void* args[] = {&p};
    hipError_t e = hipLaunchCooperativeKernel((const void*)mk_fwd, dim3(grid), dim3(512), args, LDS_BYTES, stream);
    if (e != hipSuccess) fprintf(stderr, "kernel_launch: cooperative launch failed: %s (grid %d)\n", hipGetErrorString(e), grid);
}
```

```cpp
#include <hip/hip_runtime.h>
#include <stdint.h>
#include <math.h>
#include <cstdio>
#include <cstring>

namespace {
constexpr int T = 16384, D = 1024;
constexpr float EPS = 1e-6f;
typedef unsigned short bf16_t;
#define LAS __attribute__((address_space(3)))

__device__ __forceinline__ float bf2f(bf16_t b) { return __uint_as_float(((unsigned)b) << 16); }
__device__ __forceinline__ bf16_t f2bf(float f) { unsigned u = __float_as_uint(f); u += 0x7fffu + ((u >> 16) & 1u); return (bf16_t)(u >> 16); }
__device__ __forceinline__ float4 ld_nt4(const float* p) { typedef float f4v __attribute__((ext_vector_type(4))); const f4v v = __builtin_nontemporal_load((const f4v*)p); return make_float4(v[0], v[1], v[2], v[3]); }

__device__ __forceinline__ float lg2_head(int h) {
    const float x = __uint_as_float((unsigned)(127 - 5 - h) << 23);
    const float s = x * (1.f + x * (0.5f + x * (0.33333334f + x * (0.25f + x * (0.2f + x * 0.16666667f)))));
    return -s * 1.44269504089f;
}
struct RopeC { float fh[32], fl[32]; };
struct RetC { float lg2[8]; };

constexpr size_t MiB = 1u << 20;
constexpr size_t OFF_CTL = 0;
constexpr size_t CTL_BYTES = 64 * 1024;
constexpr size_t OFF_MOD = 64 * 1024, OFF_RINV1 = 128 * 1024, OFF_BIASF = 256 * 1024, OFF_ROPE = 1 * MiB;
constexpr size_t OFF_WINT = 6 * MiB;
constexpr size_t OFF_XB = 16 * MiB;
constexpr size_t OFF_YCAT = 160 * MiB;
constexpr size_t OFF_P = 48 * MiB;
constexpr size_t OFF_KV = 208 * MiB, OFF_ST = 224 * MiB;
constexpr size_t OFF_WEFFT = 240 * MiB;
constexpr size_t OFF_WOUTT = 13 * MiB;
constexpr size_t OFF_BIASQ = 272 * 1024;
constexpr size_t OFF_SWF = 320 * 1024;
constexpr size_t OFF_XQ = 160 * MiB;
constexpr size_t OFF_DSC = 512 * 1024;
constexpr size_t OFF_BQPART = 576 * 1024;
constexpr size_t OFF_PART2 = 5 * MiB;
constexpr size_t OFF_X1B = 208 * MiB;
constexpr size_t OFF_IDS = 244 * MiB, OFF_GATES = 248 * MiB;
constexpr size_t OFF_Q8 = 192 * MiB;
constexpr int CONV_SPLIT = 0;
constexpr int LDS_BYTES = 163840;
constexpr int LDS_ST_OFF = LDS_BYTES - 16;

#define XB_TMO      128
#define XB_XCNT(j)  (256  + 64 * (j))
#define XB_XSUB(j)  (1280 + 64 * (j))
#define XB_XGEN(j)  (2304 + 64 * (j))
#define XB_TOP      3328
#define XB_TOPGEN   3392
#define XCD_BAR_WORDS 3456
#define XB_SPIN_CAP (1u << 20)
__device__ __forceinline__ unsigned xb_ld(unsigned* p)              { return __hip_atomic_load(p, __ATOMIC_RELAXED, __HIP_MEMORY_SCOPE_AGENT); }
__device__ __forceinline__ unsigned xb_add(unsigned* p, unsigned v) { return __hip_atomic_fetch_add(p, v, __ATOMIC_RELAXED, __HIP_MEMORY_SCOPE_AGENT); }
__device__ __forceinline__ unsigned xb_xcc_id() { return (unsigned)__builtin_amdgcn_s_getreg((3 << 11) | 20) & 0xFu; }
#define XB_SPIN(cond, bar) do { unsigned _sp = 0; while (cond) { __builtin_amdgcn_s_sleep(1); \
    if ((++_sp & 255u) == 0u) { if (xb_ld(&(bar)[XB_TMO])) break; if (_sp > XB_SPIN_CAP) { atomicAdd(&(bar)[XB_TMO], 1u); break; } } } } while (0)
struct XcdBarrier { unsigned* bar; unsigned x; volatile LAS unsigned* st; };
__device__ __forceinline__ XcdBarrier xcd_barrier_post(unsigned* bar, volatile LAS unsigned* st) {
    XcdBarrier b; b.bar = bar; b.x = xb_xcc_id(); b.st = st;
    if (threadIdx.x == 0) (void)xb_add(&bar[XB_XCNT(b.x)], 1u);
    return b;
}
__device__ __forceinline__ void xcd_barrier_complete(unsigned* bar, unsigned x, unsigned& nloc, unsigned& nx) {
    const unsigned G = gridDim.x * gridDim.y * gridDim.z;
    unsigned sum, cnt, mine, sp = 0u;
    for (;;) {
        sum = 0u; cnt = 0u; mine = 0u;
#pragma unroll
        for (unsigned j = 0; j < 16; ++j) { const unsigned c = xb_ld(&bar[XB_XCNT(j)]); sum += c; cnt += (c > 0u) ? 1u : 0u; mine = (j == x) ? c : mine; }
        if (sum == G) break;
        __builtin_amdgcn_s_sleep(1);
        if ((++sp & 255u) == 0u) { if (xb_ld(&bar[XB_TMO])) break; if (sp > XB_SPIN_CAP) { atomicAdd(&bar[XB_TMO], 1u); break; } }
    }
    nloc = mine > 0u ? mine : 1u; nx = cnt > 0u ? cnt : 1u;
}
__device__ __forceinline__ void xcd_barrier(const XcdBarrier& b) {
    asm volatile("s_waitcnt vmcnt(0)" ::: "memory");
    __syncthreads();
    if (threadIdx.x == 0) {
        unsigned* bar = b.bar;
        __builtin_amdgcn_s_waitcnt(0);
        unsigned nloc = b.st[0], nx = b.st[1];
        if (nloc == 0u) { xcd_barrier_complete(bar, b.x, nloc, nx); b.st[0] = nloc; b.st[1] = nx; }
        const unsigned old = xb_add(&bar[XB_XSUB(b.x)], 1u);
        const unsigned gen = old / nloc;
        if (old + 1u == (gen + 1u) * nloc) {
            __builtin_amdgcn_fence(__ATOMIC_RELEASE, "agent");
            asm volatile("s_waitcnt vmcnt(0)" ::: "memory");
            const unsigned og = xb_add(&bar[XB_TOP], 1u);
            const unsigned tg = og / nx;
            if (og + 1u == (tg + 1u) * nx) xb_add(&bar[XB_TOPGEN], 1u);
            else XB_SPIN(xb_ld(&bar[XB_TOPGEN]) == tg, bar);
            __builtin_amdgcn_fence(__ATOMIC_ACQUIRE, "agent");
            xb_add(&bar[XB_XGEN(b.x)], 1u);
            asm volatile("s_waitcnt vmcnt(0)" ::: "memory");
        } else {
            XB_SPIN(xb_ld(&bar[XB_XGEN(b.x)]) == gen, bar);
            __builtin_amdgcn_fence(__ATOMIC_ACQUIRE, "agent");
            asm volatile("s_waitcnt vmcnt(0)" ::: "memory");
        }
    }
    __syncthreads();
}


namespace pg8 {
#define PG8_LAS __attribute__((address_space(3)))
typedef short bf16x8 __attribute__((ext_vector_type(8)));
typedef float f32x4 __attribute__((ext_vector_type(4)));
typedef unsigned u32x4 __attribute__((ext_vector_type(4)));
typedef unsigned u32x2 __attribute__((ext_vector_type(2)));
constexpr int BM = 256, BK = 64, HALF = 128, HTB = HALF * BK * 2, STAGE_BYTES = 8 * HTB, NXCD = 8, WGM = 8;
__host__ __device__ __forceinline__ int lds_byte(int r, int c) { const int st = (r >> 4) * 2 + (c >> 5), rr = r & 15, cc = c & 31, ob = rr * 64 + cc * 2; return st * 1024 + (ob ^ (((ob >> 9) & 1) << 5)); }
__host__ __device__ __forceinline__ void stage_rc(int b, int& R, int& C) { const int st = b / 1024, sb = b % 1024, swz = sb ^ (((sb >> 9) & 1) << 5); R = (st >> 1) * 16 + swz / 64; C = (st & 1) * 32 + (swz % 64) / 2; }
__host__ __device__ __forceinline__ int perm32(int rho) { const int n = rho >> 4, i = rho & 15; return 8 * (i >> 2) + 4 * n + (i & 3); }
struct Unit { int pm, pn; };
struct Gemm { const bf16_t* A; const bf16_t* Bt; int M, N, K; };
struct StaticOrder {
    int nM, nN, nwg, G, c;
    __host__ __device__ void init(int M, int N, int G_, int c_) { nM = M / BM; nN = N / BM; nwg = nM * nN; G = G_; c = c_; }
    __host__ __device__ bool next(int i, Unit& u) const {
        const long L = (long)i * G + c; if (L >= nwg) return false;
        int wgid = (int)L; { const int q = nwg / NXCD, r = nwg % NXCD, xcd = wgid % NXCD, off = wgid / NXCD; wgid = (xcd < r ? xcd * (q + 1) : r * (q + 1) + (xcd - r) * q) + off; }
        const int nig = WGM * nN, gid = wgid / nig, fm = gid * WGM, gsz = (nM - fm) < WGM ? (nM - fm) : WGM;
        u.pm = fm + ((wgid % nig) % gsz); u.pn = (wgid % nig) / gsz; return true;
    }
    __device__ __forceinline__ void a_ready(const Unit&) const {}
    __device__ __forceinline__ void done(const Unit&) const {}
};
__device__ __forceinline__ unsigned cvt_pk_bf16(float lo, float hi) { unsigned r; asm volatile("v_cvt_pk_bf16_f32 %0, %1, %2" : "=v"(r) : "v"(lo), "v"(hi)); return r; }

typedef int i32x4 __attribute__((ext_vector_type(4)));
template <bool I8>
__device__ __forceinline__ f32x4 mma16(const bf16x8 b, const bf16x8 a, const f32x4 c) {
    if constexpr (I8) return __builtin_bit_cast(f32x4, __builtin_amdgcn_mfma_i32_16x16x64_i8(__builtin_bit_cast(i32x4, b), __builtin_bit_cast(i32x4, a), __builtin_bit_cast(i32x4, c), 0, 0, 0));
    else return __builtin_amdgcn_mfma_f32_16x16x32_bf16(b, a, c, 0, 0, 0);
}
template <class Epi, class Sched, bool I8 = false>
__device__ __forceinline__ void gemm_phase(PG8_LAS unsigned char* lds, const Gemm g, const Sched& S, const Epi& E) {
    int tid_ = threadIdx.x; asm volatile("" : "+v"(tid_));
    const int tid = tid_, wid = __builtin_amdgcn_readfirstlane(tid >> 6), lane = tid & 63, wr = wid >> 2, wc = wid & 3, fr = lane & 15, fq = lane >> 4;
    const int K = g.K, nt = K / BK;
    unsigned voffA[2], voffB[2];
#pragma unroll
    for (int i = 0; i < 2; ++i) { int R, C; stage_rc(tid * 16 + i * 8192, R, C); const int Rb = Epi::PERM ? ((R & ~31) + perm32(R & 31)) : R;
        voffA[i] = (unsigned)(R * K + C) * 2u; voffB[i] = (unsigned)(Rb * K + C) * 2u; }
    const size_t kstep = (size_t)(BK * 2);
    const size_t hstep = (size_t)HALF * K * 2;
    const size_t tstep = 2 * hstep;
    const unsigned ldsw = (unsigned)wid * 1024u;
    const int aoff = lds_byte(wr * 64 + fr, fq * 8), boff = lds_byte(wc * 32 + fr, fq * 8);
#define PG8_SA(b, h) (((b) * 2 + (h)) * HTB)
#define PG8_SB(b, h) ((4 + (b) * 2 + (h)) * HTB)
#define PG8_STAGE(bufoff, gbase, voff) do { _Pragma("unroll") for (int _i = 0; _i < 2; ++_i) \
        __builtin_amdgcn_global_load_lds((const unsigned*)((const char*)(gbase) + (voff)[_i]), (PG8_LAS unsigned*)(lds + (bufoff) + ldsw + _i * 8192), 16, 0, 0); } while (0)
#define PG8_LDA(dst, b, h) do { _Pragma("unroll") for (int m = 0; m < 4; ++m) _Pragma("unroll") for (int k = 0; k < 2; ++k) dst[m][k] = *(const PG8_LAS bf16x8*)(lds + PG8_SA(b, h) + aoff + m * 2048 + k * 1024); } while (0)
#define PG8_LDB(dst, b, h) do { _Pragma("unroll") for (int n = 0; n < 2; ++n) _Pragma("unroll") for (int k = 0; k < 2; ++k) dst[n][k] = *(const PG8_LAS bf16x8*)(lds + PG8_SB(b, h) + boff + n * 2048 + k * 1024); } while (0)
#define PG8_MMA(ai, bj, At, Bt) do { __builtin_amdgcn_s_setprio(1); _Pragma("unroll") for (int m = 0; m < 4; ++m) _Pragma("unroll") for (int n = 0; n < 2; ++n) _Pragma("unroll") for (int k = 0; k < 2; ++k) \
        acc[ai][bj][m][n] = mma16<I8>(Bt[n][k], At[m][k], acc[ai][bj][m][n]); __builtin_amdgcn_s_setprio(0); } while (0)
#define PG8_WAIT_V(n) asm volatile("s_waitcnt vmcnt(" #n ")" ::: "memory")
#define PG8_WAIT_L(n) asm volatile("s_waitcnt lgkmcnt(" #n ")" ::: "memory")
#define PG8_BAR __builtin_amdgcn_s_barrier()
#define PG8_SCHED __builtin_amdgcn_sched_barrier(0)
    Unit cur, nxt; int ui = 0;
    if (!S.next(0, cur)) return;
    f32x4 acc[2][2][4][2];
#pragma unroll
    for (int a = 0; a < 2; ++a)
#pragma unroll
        for (int b = 0; b < 2; ++b)
#pragma unroll
            for (int m = 0; m < 4; ++m)
#pragma unroll
                for (int n = 0; n < 2; ++n) acc[a][b][m][n] = (f32x4){0.f, 0.f, 0.f, 0.f};
    bf16x8 At[4][2], B0[2][2], B1[2][2];
    const char* cA = (const char*)g.A + (size_t)cur.pm * tstep; const char* cB = (const char*)g.Bt + (size_t)cur.pn * tstep;
    S.a_ready(cur);
    PG8_STAGE(PG8_SB(0, 0), cB, voffB); PG8_STAGE(PG8_SA(0, 0), cA, voffA); PG8_STAGE(PG8_SB(0, 1), cB + hstep, voffB); PG8_STAGE(PG8_SA(0, 1), cA + hstep, voffA);
    if (wr == 1) PG8_BAR;
    PG8_WAIT_V(4); PG8_BAR;
    PG8_STAGE(PG8_SB(1, 0), cB + kstep, voffB); PG8_STAGE(PG8_SA(1, 0), cA + kstep, voffA); PG8_STAGE(PG8_SB(1, 1), cB + hstep + kstep, voffB);
    PG8_WAIT_V(6); PG8_BAR;
    for (;;) {
        const bool has_next = S.next(ui + 1, nxt);
        const char* nA = has_next ? (const char*)g.A + (size_t)nxt.pm * tstep : cA; const char* nB = has_next ? (const char*)g.Bt + (size_t)nxt.pn * tstep : cB;
        for (int t = 0; t < nt; t += 2) {
            const bool last = (t == nt - 2);
            const char* a1 = cA + (size_t)(t + 1) * kstep;
            const char* a2 = last ? nA : cA + (size_t)(t + 2) * kstep; const char* b2 = last ? nB : cB + (size_t)(t + 2) * kstep;
            const char* a3 = a2 + kstep; const char* b3 = b2 + kstep;
            if (last && has_next) S.a_ready(nxt);
            PG8_LDB(B0, 0, 0); PG8_SCHED; PG8_LDA(At, 0, 0); PG8_STAGE(PG8_SA(1, 1), a1 + hstep, voffA);
            PG8_WAIT_L(8); PG8_BAR; PG8_WAIT_L(0); PG8_MMA(0, 0, At, B0); PG8_BAR; PG8_SCHED;
            PG8_LDB(B1, 0, 1); PG8_STAGE(PG8_SB(0, 0), b2, voffB);
            PG8_BAR; PG8_WAIT_L(0); PG8_MMA(0, 1, At, B1); PG8_BAR;
            PG8_LDA(At, 0, 1); PG8_STAGE(PG8_SA(0, 0), a2, voffA);
            PG8_BAR; PG8_WAIT_L(0); PG8_MMA(1, 0, At, B0); PG8_BAR; PG8_SCHED;
            PG8_STAGE(PG8_SB(0, 1), b2 + hstep, voffB);
            PG8_WAIT_V(6); PG8_BAR; PG8_MMA(1, 1, At, B1); PG8_BAR;
            PG8_LDB(B0, 1, 0); PG8_SCHED; PG8_LDA(At, 1, 0); PG8_STAGE(PG8_SA(0, 1), a2 + hstep, voffA);
            PG8_WAIT_L(8); PG8_BAR; PG8_WAIT_L(0); PG8_MMA(0, 0, At, B0); PG8_BAR; PG8_SCHED;
            PG8_LDB(B1, 1, 1); PG8_STAGE(PG8_SB(1, 0), b3, voffB);
            PG8_BAR; PG8_WAIT_L(0); PG8_MMA(0, 1, At, B1); PG8_BAR;
            PG8_LDA(At, 1, 1); PG8_STAGE(PG8_SA(1, 0), a3, voffA);
            PG8_BAR; PG8_WAIT_L(0); PG8_MMA(1, 0, At, B0); PG8_BAR; PG8_SCHED;
            PG8_STAGE(PG8_SB(1, 1), b3 + hstep, voffB);
            PG8_WAIT_V(6); PG8_BAR; PG8_MMA(1, 1, At, B1); PG8_BAR;
        }
        if constexpr (!Epi::AFTER_DRAIN) { E(acc, cur, wr, wc, fr, fq); S.done(cur); }
        if (!has_next) break;
#pragma unroll
        for (int a = 0; a < 2; ++a)
#pragma unroll
            for (int b = 0; b < 2; ++b)
#pragma unroll
                for (int m = 0; m < 4; ++m)
#pragma unroll
                    for (int n = 0; n < 2; ++n) acc[a][b][m][n] = (f32x4){0.f, 0.f, 0.f, 0.f};
        cur = nxt; cA = nA; cB = nB; ++ui;
    }
    PG8_WAIT_V(0);
    if (wr == 0) PG8_BAR;
    PG8_BAR;
    if constexpr (Epi::AFTER_DRAIN) { E.fused(acc, cur, wr, wc, fr, fq, lds, wid, lane); S.done(cur); }
#undef PG8_SA
#undef PG8_SB
#undef PG8_STAGE
#undef PG8_LDA
#undef PG8_LDB
#undef PG8_MMA
#undef PG8_WAIT_V
#undef PG8_WAIT_L
#undef PG8_BAR
#undef PG8_SCHED
}
}

__host__ __device__ __forceinline__ int cmap_in(int F) { return (F & ~255) + 128 * ((F >> 5) & 1) + 32 * ((F >> 6) & 3) + (F & 31); }
struct EpiInprojMF {
    static constexpr bool PERM = true, AFTER_DRAIN = false;
    bf16_t* P; const float* rinv; const float* bias_f; const int* pos; const float* ftab; const float* qg; const float* kg; const float* swf;
    __device__ __forceinline__ void operator()(pg8::f32x4 (&acc)[2][2][4][2], const pg8::Unit& u, int wr, int wc, int fr, int fq) const {
        typedef pg8::f32x4 f32x4;
        asm volatile("" : "+v"(fr), "+v"(fq));
        const int type = u.pn >> 1, head = 4 * (u.pn & 1) + wc, fb = 256 * u.pn + 64 * wc;
        {
            f32x4 sw[2][2];
#pragma unroll
            for (int bj = 0; bj < 2; ++bj)
#pragma unroll
                for (int n = 0; n < 2; ++n) sw[bj][n] = *(const f32x4*)(swf + fb + 32 * bj + 8 * fq + 4 * n);
#pragma unroll
            for (int ai = 0; ai < 2; ++ai)
#pragma unroll
                for (int bj = 0; bj < 2; ++bj)
#pragma unroll
                    for (int m = 0; m < 4; ++m)
#pragma unroll
                        for (int n = 0; n < 2; ++n) {
                            const pg8::i32x4 iv = __builtin_bit_cast(pg8::i32x4, acc[ai][bj][m][n]);
                            f32x4 fv; fv[0] = (float)iv[0]; fv[1] = (float)iv[1]; fv[2] = (float)iv[2]; fv[3] = (float)iv[3];
                            acc[ai][bj][m][n] = fv * sw[bj][n];
                        }
        }
        const size_t PSZ = (size_t)T * 512;
        const int rslot = (type == 0) ? 0 : (type == 1) ? 1 : (type == 2) ? 5 : (type == 3) ? 2 : (type == 4) ? 3 : (type == 5) ? 4 : 6;
        bf16_t* rowmaj = P + (size_t)rslot * PSZ;
        const int t0 = u.pm * 256 + wr * 64 + fr;
        f32x4 bv[2][2], gv[2][2], fh[2], fl[2];
#pragma unroll
        for (int bj = 0; bj < 2; ++bj)
#pragma unroll
            for (int n = 0; n < 2; ++n) bv[bj][n] = *(const f32x4*)(bias_f + fb + 32 * bj + 8 * fq + 4 * n);
        if (type <= 1) {
#pragma unroll
            for (int n = 0; n < 2; ++n) { fh[n] = *(const f32x4*)(ftab + 8 * fq + 4 * n); fl[n] = *(const f32x4*)(ftab + 32 + 8 * fq + 4 * n); }
        } else if (type == 4 || type == 5) {
            const float* gsrc = (type == 4) ? qg : kg;
#pragma unroll
            for (int bj = 0; bj < 2; ++bj)
#pragma unroll
                for (int n = 0; n < 2; ++n) gv[bj][n] = *(const f32x4*)(gsrc + 32 * bj + 8 * fq + 4 * n);
        }
#pragma unroll
        for (int ai = 0; ai < 2; ++ai) {
            float rv[4], pf[4];
#pragma unroll
            for (int m = 0; m < 4; ++m) { rv[m] = rinv[t0 + ai * 128 + m * 16]; pf[m] = (float)pos[t0 + ai * 128 + m * 16]; }
            asm volatile("" : "+v"(rv[0]), "+v"(rv[1]), "+v"(rv[2]), "+v"(rv[3]), "+v"(pf[0]), "+v"(pf[1]), "+v"(pf[2]), "+v"(pf[3]));
#pragma unroll
            for (int m = 0; m < 4; ++m) {
                const int t = t0 + ai * 128 + m * 16;
                const float r = rv[m];
                f32x4 v[2][2];
#pragma unroll
                for (int bj = 0; bj < 2; ++bj)
#pragma unroll
                    for (int n = 0; n < 2; ++n) v[bj][n] = acc[ai][bj][m][n] * r + bv[bj][n];
                if (type <= 1) {
                    const float sc = (type == 1) ? 0.125f : 1.f, pp = pf[m];
#pragma unroll
                    for (int n = 0; n < 2; ++n)
#pragma unroll
                        for (int j = 0; j < 4; ++j) {
                            const float rev = __builtin_amdgcn_fractf(__builtin_amdgcn_fractf(pp * fh[n][j]) + pp * fl[n][j]);
                            const float cs = __builtin_amdgcn_cosf(rev) * sc, sn = __builtin_amdgcn_sinf(rev) * sc;
                            const float x1 = v[0][n][j], x2 = v[1][n][j]; v[0][n][j] = x1 * cs - x2 * sn; v[1][n][j] = x2 * cs + x1 * sn;
                        }
                } else if (type == 3) {
#pragma unroll
                    for (int bj = 0; bj < 2; ++bj)
#pragma unroll
                        for (int n = 0; n < 2; ++n)
#pragma unroll
                            for (int j = 0; j < 4; ++j) { const float x = v[bj][n][j]; v[bj][n][j] = x / (1.f + __expf(-x)); }
                } else if (type == 4 || type == 5) {
                    float ss = 0.f;
#pragma unroll
                    for (int bj = 0; bj < 2; ++bj)
#pragma unroll
                        for (int n = 0; n < 2; ++n)
#pragma unroll
                            for (int j = 0; j < 4; ++j) ss += v[bj][n][j] * v[bj][n][j];
                    ss += __shfl_xor(ss, 16); ss += __shfl_xor(ss, 32);
                    const float rn = (1.0f / sqrtf(ss * (1.f / 64.f) + EPS)) * ((type == 4) ? 0.125f * 1.44269504089f : 1.f);
#pragma unroll
                    for (int bj = 0; bj < 2; ++bj)
#pragma unroll
                        for (int n = 0; n < 2; ++n) v[bj][n] = v[bj][n] * rn * gv[bj][n];
                }
#pragma unroll
                for (int bj = 0; bj < 2; ++bj) {
                    pg8::u32x4 w; w.x = pg8::cvt_pk_bf16(v[bj][0][0], v[bj][0][1]); w.y = pg8::cvt_pk_bf16(v[bj][0][2], v[bj][0][3]);
                    w.z = pg8::cvt_pk_bf16(v[bj][1][0], v[bj][1][1]); w.w = pg8::cvt_pk_bf16(v[bj][1][2], v[bj][1][3]);
                    *(pg8::u32x4*)(rowmaj + (size_t)t * 512 + head * 64 + 32 * bj + 8 * fq) = w;
                }
            }
        }
    }
};

struct EpiOutprojMF {
    static constexpr bool PERM = false, AFTER_DRAIN = true;
    const float* xf; const float* gate1; bf16_t* x1b; float* part2;
    __device__ __forceinline__ void operator()(const pg8::f32x4 (&)[2][2][4][2], const pg8::Unit&, int, int, int, int) const {}
    __device__ __forceinline__ void fused(pg8::f32x4 (&acc)[2][2][4][2], const pg8::Unit& u, int wr, int wc, int fr, int fq, PG8_LAS unsigned char* lds, int wid, int lane) const {
        typedef pg8::f32x4 f32x4;
        asm volatile("" : "+v"(fr), "+v"(fq), "+v"(lane));
        constexpr int LD = 260;
        PG8_LAS float* TL = (PG8_LAS float*)lds;
        const int colw = wc * 32 + 4 * fq;
        f32x4 gv[2][2];
#pragma unroll
        for (int bj = 0; bj < 2; ++bj)
#pragma unroll
            for (int n = 0; n < 2; ++n) gv[bj][n] = *(const f32x4*)(gate1 + u.pn * 256 + colw + bj * 128 + n * 16);
#pragma unroll
        for (int ai = 0; ai < 2; ++ai) {
            f32x4 xv[16];
            const size_t rowbase = (size_t)(u.pm * 256 + ai * 128 + 16 * wid) * D + u.pn * 256 + 4 * lane;
#pragma unroll
            for (int r = 0; r < 16; ++r) xv[r] = __builtin_nontemporal_load((const f32x4*)(xf + rowbase + (size_t)r * D));
#pragma unroll
            for (int m = 0; m < 4; ++m)
#pragma unroll
                for (int bj = 0; bj < 2; ++bj)
#pragma unroll
                    for (int n = 0; n < 2; ++n) *(PG8_LAS f32x4*)(TL + (64 * wr + 16 * m + fr) * LD + colw + bj * 128 + n * 16) = gv[bj][n] * acc[ai][bj][m][n];
            __syncthreads();
            float ssr[16];
#pragma unroll
            for (int r = 0; r < 16; ++r) {
                const f32x4 g = *(PG8_LAS f32x4*)(TL + (16 * wid + r) * LD + 4 * lane);
                const f32x4 o = xv[r] + g;
                pg8::u32x2 w; w.x = pg8::cvt_pk_bf16(o[0], o[1]); w.y = pg8::cvt_pk_bf16(o[2], o[3]);
                *(pg8::u32x2*)(x1b + rowbase + (size_t)r * D) = w;
                ssr[r] = o[0] * o[0] + o[1] * o[1] + o[2] * o[2] + o[3] * o[3];
            }
            {
                const bool b5 = lane & 32, b4 = lane & 16, b3 = lane & 8, b2 = lane & 4;
                float w8[8], w4[4], w2[2], w1;
#pragma unroll
                for (int i = 0; i < 8; ++i) w8[i] = (b5 ? ssr[8 + i] : ssr[i]) + __shfl_xor(b5 ? ssr[i] : ssr[8 + i], 32);
#pragma unroll
                for (int i = 0; i < 4; ++i) w4[i] = (b4 ? w8[4 + i] : w8[i]) + __shfl_xor(b4 ? w8[i] : w8[4 + i], 16);
#pragma unroll
                for (int i = 0; i < 2; ++i) w2[i] = (b3 ? w4[2 + i] : w4[i]) + __shfl_xor(b3 ? w4[i] : w4[2 + i], 8);
                w1 = (b2 ? w2[1] : w2[0]) + __shfl_xor(b2 ? w2[0] : w2[1], 4);
                w1 += __shfl_xor(w1, 2); w1 += __shfl_xor(w1, 1);
                part2[(size_t)(u.pm * 256 + ai * 128 + 16 * wid + (lane >> 2)) * 16 + u.pn * 4 + (lane & 3)] = ((lane & 3) == 0) ? w1 : 0.f;
            }
            __syncthreads();
        }
    }
};

__device__ __forceinline__ unsigned pk2(float lo, float hi) { return (unsigned)f2bf(lo) | ((unsigned)f2bf(hi) << 16); }
template <bool FOLD, bool CMAP>
__device__ __forceinline__ void transpose_item(const float* W, int K, int N, bf16_t* WT, float* scr, int item, int lane, const float* sg, const float* sm) {
    const int nblk = N / 32, kb = item / nblk, nb = item % nblk, k0 = 64 * kb, n0 = 32 * nb;
    float4 v[8]; float f[8];
#pragma unroll
    for (int i = 0; i < 8; ++i) { const int kk = 8 * i + (lane >> 3); v[i] = *(const float4*)(W + (size_t)(k0 + kk) * N + n0 + 4 * (lane & 7));
        f[i] = FOLD ? sg[k0 + kk] * (1.f + sm[k0 + kk]) : 1.f; }
#pragma unroll
    for (int i = 0; i < 8; ++i) { const int kk = 8 * i + (lane >> 3); float* d = scr + kk * 33 + 4 * (lane & 7);
        d[0] = v[i].x * f[i]; d[1] = v[i].y * f[i]; d[2] = v[i].z * f[i]; d[3] = v[i].w * f[i]; }
    asm volatile("s_waitcnt lgkmcnt(0)" ::: "memory");
    const int c = lane & 7, r0 = CMAP ? cmap_in(n0) : n0;
#pragma unroll
    for (int j = 0; j < 4; ++j) { const int n = (lane >> 3) + 8 * j; const float* s = scr + (8 * c) * 33 + n;
        pg8::u32x4 o; o.x = pk2(s[0 * 33], s[1 * 33]); o.y = pk2(s[2 * 33], s[3 * 33]); o.z = pk2(s[4 * 33], s[5 * 33]); o.w = pk2(s[6 * 33], s[7 * 33]);
        *(pg8::u32x4*)(WT + (size_t)(r0 + n) * K + k0 + 8 * c) = o; }
    asm volatile("s_waitcnt lgkmcnt(0)" ::: "memory");
}
template <int NC4, class VF>
__device__ __forceinline__ void gemv_cols(unsigned char* lds, const VF vf, const float* W, const int N, const int u, float* dst, const float* add) {
    constexpr int RG = 512 / NC4;
    float (*red)[NC4 * 4] = (float (*)[NC4 * 4])lds;
    const int tid = threadIdx.x, c4 = tid % NC4, rg = tid / NC4;
    if (rg < RG) {
        float4 acc = {0.f, 0.f, 0.f, 0.f};
        for (int r = rg; r < 1024; r += RG) { const float s = vf(r); const float4 w = *(const float4*)(W + (size_t)r * N + u * NC4 * 4 + c4 * 4);
            acc.x += s * w.x; acc.y += s * w.y; acc.z += s * w.z; acc.w += s * w.w; }
        red[rg][c4 * 4 + 0] = acc.x; red[rg][c4 * 4 + 1] = acc.y; red[rg][c4 * 4 + 2] = acc.z; red[rg][c4 * 4 + 3] = acc.w;
    }
    __syncthreads();
    if (tid < NC4 * 4) { float s = 0.f; for (int i = 0; i < RG; ++i) s += red[i][tid]; dst[u * NC4 * 4 + tid] = s + (add ? add[u * NC4 * 4 + tid] : 0.f); }
    __syncthreads();
}
struct VfSilu { const float* c; __device__ __forceinline__ float operator()(int r) const { const float v = c[r]; return v / (1.f + expf(-v)); } };
struct VfVec { const float* v; __device__ __forceinline__ float operator()(int r) const { return v[r]; } };


typedef float f32x16 __attribute__((ext_vector_type(16)));
typedef pg8::bf16x8 bf16x8;
#define MFMA32(a, b, c) __builtin_amdgcn_mfma_f32_32x32x16_bf16((a), (b), (c), 0, 0, 0)
__device__ __forceinline__ bf16x8 pack_frag(const f32x16& v, int s) {
    pg8::u32x4 w;
    w.x = pg8::cvt_pk_bf16(v[8 * s + 0], v[8 * s + 1]); w.y = pg8::cvt_pk_bf16(v[8 * s + 2], v[8 * s + 3]);
    w.z = pg8::cvt_pk_bf16(v[8 * s + 4], v[8 * s + 5]); w.w = pg8::cvt_pk_bf16(v[8 * s + 6], v[8 * s + 7]);
    return __builtin_bit_cast(bf16x8, w);
}
__device__ __forceinline__ bf16x8 load_tfrag(const bf16_t* rowp, int tok) {
    const uint2 a = *(const uint2*)(rowp + tok), b = *(const uint2*)(rowp + tok + 8);
    pg8::u32x4 w; w.x = a.x; w.y = a.y; w.z = b.x; w.w = b.y;
    return __builtin_bit_cast(bf16x8, w);
}


__device__ __forceinline__ bf16x8 tr_frag(const unsigned char* a0, int rows2) {
    typedef short s16x4 __attribute__((ext_vector_type(4)));
    typedef __attribute__((address_space(3))) s16x4 lds_s16x4;
    const s16x4 lo = __builtin_amdgcn_ds_read_tr16_b64_v4i16((lds_s16x4*)a0);
    const s16x4 hi = __builtin_amdgcn_ds_read_tr16_b64_v4i16((lds_s16x4*)(a0 + rows2 * 144));
    const uint2 l2 = __builtin_bit_cast(uint2, lo), h2 = __builtin_bit_cast(uint2, hi);
    pg8::u32x4 fw; fw.x = l2.x; fw.y = l2.y; fw.z = h2.x; fw.w = h2.y;
    return __builtin_bit_cast(bf16x8, fw);
}

__device__ __forceinline__ void ins16(float (&s)[16], float x) {
#pragma unroll
    for (int i = 15; i >= 1; --i) s[i] = __builtin_amdgcn_fmed3f(s[i - 1], s[i], x);
    s[0] = fmaxf(s[0], x);
}


struct OneUnitOrder {
    pg8::StaticOrder base; int round;
    __device__ __forceinline__ bool next(int i, pg8::Unit& u) const { if (i != 0) return false; return base.next(round, u); }
    __device__ __forceinline__ void a_ready(const pg8::Unit&) const {}
    __device__ __forceinline__ void done(const pg8::Unit&) const {}
};
struct EpiTopkMF {
    static constexpr bool PERM = false, AFTER_DRAIN = true;
    const float* part2; const float* bias_q; unsigned short* ids; float* gates;
    __device__ __forceinline__ void operator()(const pg8::f32x4 (&)[2][2][4][2], const pg8::Unit&, int, int, int, int) const {}
    __device__ __forceinline__ void fused(pg8::f32x4 (&acc)[2][2][4][2], const pg8::Unit& u, int wr, int wc, int fr, int fq, PG8_LAS unsigned char* lds, int wid, int lane) const {
        typedef pg8::f32x4 f32x4;
        constexpr int SLD = 260;
        PG8_LAS float* SC = (PG8_LAS float*)lds; PG8_LAS float* MG = (PG8_LAS float*)(lds + 128 * SLD * 4);
        const int tid = wid * 64 + lane, tok = tid & 255, hk = tid >> 8;
        float rinv[2][4];
#pragma unroll
        for (int ai = 0; ai < 2; ++ai)
#pragma unroll
            for (int m = 0; m < 4; ++m) {
                const int row = u.pm * 256 + ai * 128 + wr * 64 + m * 16 + fr;
                const f32x4* pp = (const f32x4*)(part2 + (size_t)row * 16);
                const f32x4 p0 = pp[0], p1 = pp[1], p2 = pp[2], p3 = pp[3];
                const float ssum = ((p0[0] + p0[1]) + (p0[2] + p0[3])) + ((p1[0] + p1[1]) + (p1[2] + p1[3])) + ((p2[0] + p2[1]) + (p2[2] + p2[3])) + ((p3[0] + p3[1]) + (p3[2] + p3[3]));
                rinv[ai][m] = 1.0f / sqrtf(ssum * (1.0f / D) + EPS);
            }
        float sl[16], mine[16];
#pragma unroll
        for (int p = 0; p < 2; ++p) {
            f32x4 bv[2];
#pragma unroll
            for (int n = 0; n < 2; ++n) bv[n] = *(const f32x4*)(bias_q + u.pn * 256 + p * 128 + wc * 32 + n * 16 + 4 * fq);
#pragma unroll
            for (int ai = 0; ai < 2; ++ai)
#pragma unroll
                for (int m = 0; m < 4; ++m)
#pragma unroll
                    for (int n = 0; n < 2; ++n)
#pragma unroll
                        for (int j = 0; j < 4; ++j)
                            SC[(32 * wc + 16 * n + 4 * fq + j) * SLD + (128 * ai + 64 * wr + 16 * m + fr)] = acc[ai][p][m][n][j] * rinv[ai][m] + bv[n][j];
            __syncthreads();
#pragma unroll
            for (int i = 0; i < 16; ++i) sl[i] = -INFINITY;
#pragma unroll 8
            for (int k = 0; k < 64; ++k) { const int key = 64 * hk + k; const float x = SC[key * SLD + tok]; ins16(sl, __uint_as_float((__float_as_uint(x) & 0xFFFFFF80u) | (unsigned)key)); }
            if (hk != p) {
#pragma unroll
                for (int i = 0; i < 16; ++i) MG[i * 256 + tok] = sl[i];
            }
            __syncthreads();
            if (hk == p) {
#pragma unroll
                for (int i = 0; i < 16; ++i) ins16(sl, MG[i * 256 + tok]);
#pragma unroll
                for (int i = 0; i < 16; ++i) mine[i] = sl[i];
            }
            __syncthreads();
        }
        PG8_LAS float* X1 = SC; PG8_LAS float* TL = SC + 4096; PG8_LAS unsigned* I0 = (PG8_LAS unsigned*)(SC + 8192); PG8_LAS unsigned* I1 = (PG8_LAS unsigned*)(SC + 12288);
        if (hk) {
#pragma unroll
            for (int i = 0; i < 16; ++i) { X1[i * 256 + tok] = mine[i]; I1[i * 256 + tok] = __float_as_uint(mine[i]) & 0x7Fu; }
        } else {
#pragma unroll
            for (int i = 0; i < 16; ++i) I0[i * 256 + tok] = __float_as_uint(mine[i]) & 0x7Fu;
        }
        __syncthreads();
        if (!hk) {
            float s1m[16], tl[16];
#pragma unroll
            for (int i = 0; i < 16; ++i) { s1m[i] = __uint_as_float(__float_as_uint(X1[i * 256 + tok]) & 0xFFFFFF80u); mine[i] = __uint_as_float(__float_as_uint(mine[i]) & 0xFFFFFF80u); tl[i] = -INFINITY; }
#pragma unroll
            for (int a2 = 0; a2 < 16; ++a2)
#pragma unroll
                for (int b2 = 0; b2 < 16; ++b2)
                    if ((a2 + 1) * (b2 + 1) <= 16) ins16(tl, __uint_as_float((__float_as_uint(mine[a2] + s1m[b2]) & 0xFFFFFF00u) | (unsigned)(a2 * 16 + b2)));
#pragma unroll
            for (int i = 0; i < 16; ++i) TL[i * 256 + tok] = tl[i];
        }
        __syncthreads();
        if (hk) {
            float ev[16]; float sum = 0.f; unsigned cd[16];
#pragma unroll
            for (int j = 0; j < 16; ++j) { const unsigned bits = __float_as_uint(TL[j * 256 + tok]); cd[j] = bits & 0xFFu; ev[j] = __uint_as_float(bits & 0xFFFFFF00u); }
            const float mx = ev[0];
#pragma unroll
            for (int j = 0; j < 16; ++j) { ev[j] = __expf(ev[j] - mx); sum += ev[j]; }
            const float inv = 1.f / sum;
            unsigned idw[8];
#pragma unroll
            for (int j = 0; j < 16; ++j) {
                const unsigned id = I0[(cd[j] >> 4) * 256 + tok] * 128u + I1[(cd[j] & 15u) * 256 + tok];
                if (j & 1) idw[j >> 1] |= id << 16; else idw[j >> 1] = id;
                ev[j] *= inv;
            }
            const size_t t = (size_t)u.pm * 256 + tok;
            unsigned short* idp = ids + t * 128 + u.pn * 16; float* gp = gates + t * 128 + u.pn * 16;
            *(uint4*)idp = make_uint4(idw[0], idw[1], idw[2], idw[3]); *(uint4*)(idp + 8) = make_uint4(idw[4], idw[5], idw[6], idw[7]);
#pragma unroll
            for (int q = 0; q < 4; ++q) *(float4*)(gp + 4 * q) = make_float4(ev[4 * q], ev[4 * q + 1], ev[4 * q + 2], ev[4 * q + 3]);
        }
        __syncthreads();
    }
};


__device__ __forceinline__ void convert_tables(const float* down, const float* up, unsigned char* q8, bf16_t* dsc, int lane, int cw, int nconv, int r0, int r1) {
    for (int row0 = r0 + cw * 2; row0 < r1; row0 += nconv * 2) {
        float4 v[2][4];
#pragma unroll
        for (int rr = 0; rr < 2; ++rr) {
            const int row = row0 + rr, isup = row >> 14, e = row & 16383;
            const float* sp = (isup ? up : down) + (size_t)e * 1024 + lane * 4;
#pragma unroll
            for (int q = 0; q < 4; ++q) v[rr][q] = ld_nt4(sp + 256 * q);
        }
#pragma unroll
        for (int rr = 0; rr < 2; ++rr) {
            const int row = row0 + rr, isup = row >> 14, e = row & 16383;
            {
                float ss = 0.f;
#pragma unroll
                for (int q = 0; q < 4; ++q) ss += v[rr][q].x * v[rr][q].x + v[rr][q].y * v[rr][q].y + v[rr][q].z * v[rr][q].z + v[rr][q].w * v[rr][q].w;
#pragma unroll
                for (int o = 32; o > 0; o >>= 1) ss += __shfl_xor(ss, o);
                const float sigma = sqrtf(ss * (1.0f / 1024.0f));
                const float s = (sigma > 0.f) ? 7.5f / (2.6f * sigma) : 1.f;
#pragma unroll
                for (int q = 0; q < 4; ++q) {
                    const int n0 = (int)fminf(fmaxf(__builtin_rintf(v[rr][q].x * s), -8.f), 7.f) + 8, n1 = (int)fminf(fmaxf(__builtin_rintf(v[rr][q].y * s), -8.f), 7.f) + 8;
                    const int n2 = (int)fminf(fmaxf(__builtin_rintf(v[rr][q].z * s), -8.f), 7.f) + 8, n3 = (int)fminf(fmaxf(__builtin_rintf(v[rr][q].w * s), -8.f), 7.f) + 8;
                    const int h1 = isup ? ((n1 - 8) & 15) : n1, h3 = isup ? ((n3 - 8) & 15) : n3;
                    *(unsigned short*)(q8 + (size_t)isup * (8u << 20) + ((size_t)q * 16384 + e) * 128 + (lane & 7) * 16 + (lane >> 3) * 2) = (unsigned short)(n0 | (h1 << 4) | (n2 << 8) | (h3 << 12));
                }
                if (lane == 0) dsc[row] = f2bf(1.0f / s);
            }
        }
    }
}

struct Params {
    const float *x, *c; const int* pos; const float *ada_w, *ada_b, *g1, *g2, *w_in, *rgain, *qg, *kg, *og, *w_out, *wq, *sk, *down, *up;
    float* out; unsigned char* ws; RopeC rc;
};

__global__ void __launch_bounds__(512) mk_fwd(Params p) {
    extern __shared__ __attribute__((aligned(16))) unsigned char lds[];
    const int tid = threadIdx.x, lane = tid & 63, bid = blockIdx.x, G = gridDim.x; int wave = tid >> 6;
    unsigned char* ws = p.ws;
    float* mod = (float*)(ws + OFF_MOD); float* rinv1 = (float*)(ws + OFF_RINV1); float* ftab = (float*)(ws + OFF_ROPE);
    bf16_t* P = (bf16_t*)(ws + OFF_P); float* kv = (float*)(ws + OFF_KV); bf16_t* stT = (bf16_t*)(ws + OFF_ST); bf16_t* ycat = (bf16_t*)(ws + OFF_YCAT);
    bf16_t* Win_t = (bf16_t*)(ws + OFF_WINT); float* bias_f = (float*)(ws + OFF_BIASF);
    unsigned char* xq = ws + OFF_XQ; float* swf = (float*)(ws + OFF_SWF);
    bf16_t* Weff_t = (bf16_t*)(ws + OFF_WEFFT); bf16_t* Wout_t = (bf16_t*)(ws + OFF_WOUTT); float* bias_q = (float*)(ws + OFF_BIASQ); float* bq_part = (float*)(ws + OFF_BQPART);
    float* part2 = (float*)(ws + OFF_PART2); bf16_t* x1b = (bf16_t*)(ws + OFF_X1B); unsigned short* ids = (unsigned short*)(ws + OFF_IDS); unsigned char* q8 = ws + OFF_Q8; bf16_t* dsc = (bf16_t*)(ws + OFF_DSC); float* gates = (float*)(ws + OFF_GATES);
    const size_t PS = (size_t)T * 512;
    const bf16_t *Qr = P, *Kr = P + PS, *Gr = P + 2 * PS, *Qs = P + 3 * PS, *Ks = P + 4 * PS, *Vr = P + 5 * PS, *Vs = P + 6 * PS;
    float* out = p.out;

    if (tid < 4) ((LAS unsigned*)((LAS unsigned char*)lds + LDS_ST_OFF))[tid] = 0u;
    __syncthreads();
    XcdBarrier bar = xcd_barrier_post((unsigned*)(ws + OFF_CTL), (volatile LAS unsigned*)((LAS unsigned char*)lds + LDS_ST_OFF));

    for (int u = bid; u < 256; u += G) gemv_cols<6>(lds, VfSilu{p.c}, p.ada_w, 6144, u, mod, p.ada_b);
    for (int row0 = (bid * 8 + wave) * 2; row0 < T; row0 += G * 16) {
        float4 v[2][4];
#pragma unroll
        for (int rr = 0; rr < 2; ++rr)
#pragma unroll
            for (int j = 0; j < 4; ++j) v[rr][j] = ld_nt4(p.x + (size_t)(row0 + rr) * D + (lane + 64 * j) * 4);
#pragma unroll
        for (int rr = 0; rr < 2; ++rr) {
            float s = 0.f, am = 0.f;
#pragma unroll
            for (int j = 0; j < 4; ++j) { const float4 q = v[rr][j]; s += q.x * q.x + q.y * q.y + q.z * q.z + q.w * q.w;
                am = fmaxf(fmaxf(am, fmaxf(fabsf(q.x), fabsf(q.y))), fmaxf(fabsf(q.z), fabsf(q.w))); }
#pragma unroll
            for (int o = 32; o > 0; o >>= 1) { s += __shfl_xor(s, o); am = fmaxf(am, __shfl_xor(am, o)); }
            const float qs = (am > 0.f) ? 127.f / am : 0.f;
            unsigned* xqo = (unsigned*)(xq + (size_t)(row0 + rr) * D);
#pragma unroll
            for (int j = 0; j < 4; ++j) { const float4 q = v[rr][j];
                const unsigned b0 = __float_as_uint(fmaf(q.x, qs, 12582912.f)), b1 = __float_as_uint(fmaf(q.y, qs, 12582912.f)), b2 = __float_as_uint(fmaf(q.z, qs, 12582912.f)), b3 = __float_as_uint(fmaf(q.w, qs, 12582912.f));
                xqo[lane + 64 * j] = (b0 & 255u) | ((b1 & 255u) << 8) | ((b2 & 255u) << 16) | (b3 << 24); }
            if (lane == 0) rinv1[row0 + rr] = (1.0f / sqrtf(s * (1.0f / D) + EPS)) * (am * (1.f / 127.f));
        }
    }
    if (bid == 0 && tid == 0) {
#pragma unroll
        for (int i = 0; i < 32; ++i) { ftab[i] = p.rc.fh[i]; ftab[32 + i] = p.rc.fl[i]; }
    }
    xcd_barrier(bar);

    {
        for (int nb = bid; nb < 112; nb += G) {
            const int n0 = 32 * nb, r8 = lane >> 3, c = lane & 7, kw = 128 * wave;
            float* cm = (float*)(lds + 8 * 4608);
            unsigned* tl = (unsigned*)(lds + wave * 4608);
            float4 v[16];
#pragma unroll
            for (int i = 0; i < 16; ++i) { const int kk = 32 * (i >> 2) + 4 * r8 + (i & 3); v[i] = *(const float4*)(p.w_in + (size_t)(kw + kk) * 3584 + n0 + 4 * c); }
            float4 mx = {0.f, 0.f, 0.f, 0.f};
#pragma unroll
            for (int i = 0; i < 16; ++i) { const int kk = 32 * (i >> 2) + 4 * r8 + (i & 3); const float f = p.g1[kw + kk] * (1.f + mod[1024 + kw + kk]);
                v[i].x *= f; v[i].y *= f; v[i].z *= f; v[i].w *= f;
                mx.x = fmaxf(mx.x, fabsf(v[i].x)); mx.y = fmaxf(mx.y, fabsf(v[i].y)); mx.z = fmaxf(mx.z, fabsf(v[i].z)); mx.w = fmaxf(mx.w, fabsf(v[i].w)); }
#pragma unroll
            for (int o = 8; o < 64; o <<= 1) { mx.x = fmaxf(mx.x, __shfl_xor(mx.x, o)); mx.y = fmaxf(mx.y, __shfl_xor(mx.y, o)); mx.z = fmaxf(mx.z, __shfl_xor(mx.z, o)); mx.w = fmaxf(mx.w, __shfl_xor(mx.w, o)); }
            if (lane < 8) *(float4*)(cm + wave * 32 + 4 * c) = mx;
            __syncthreads();
#pragma unroll
            for (int w2 = 0; w2 < 8; ++w2) { const float4 o = *(const float4*)(cm + w2 * 32 + 4 * c); mx.x = fmaxf(mx.x, o.x); mx.y = fmaxf(mx.y, o.y); mx.z = fmaxf(mx.z, o.z); mx.w = fmaxf(mx.w, o.w); }
            if (wave == 0 && lane < 8) *(float4*)(swf + n0 + 4 * c) = make_float4(mx.x * (1.f / 127.f), mx.y * (1.f / 127.f), mx.z * (1.f / 127.f), mx.w * (1.f / 127.f));
            const float qx = (mx.x > 0.f) ? 127.f / mx.x : 0.f, qy = (mx.y > 0.f) ? 127.f / mx.y : 0.f, qz = (mx.z > 0.f) ? 127.f / mx.z : 0.f, qw = (mx.w > 0.f) ? 127.f / mx.w : 0.f;
#pragma unroll
            for (int a = 0; a < 4; ++a) {
                unsigned d[4];
#pragma unroll
                for (int j = 0; j < 4; ++j) {
                    const float qq = (j == 0) ? qx : (j == 1) ? qy : (j == 2) ? qz : qw;
                    unsigned w = 0;
#pragma unroll
                    for (int b = 0; b < 4; ++b) { const float4 t = v[4 * a + b]; const float e = (j == 0) ? t.x : (j == 1) ? t.y : (j == 2) ? t.z : t.w;
                        w |= (__float_as_uint(fmaf(e, qq, 12582912.f)) & 255u) << (8 * b); }
                    d[j] = w;
                }
#pragma unroll
                for (int j = 0; j < 4; ++j) tl[(4 * c + j) * 34 + 8 * a + r8] = d[j];
            }
            asm volatile("s_waitcnt lgkmcnt(0)" ::: "memory");
            const int rb = cmap_in(n0);
#pragma unroll
            for (int jj = 0; jj < 4; ++jj) { const int q = lane + 64 * jj, n = q >> 3, ch = q & 7;
                const uint2 lo = *(const uint2*)(tl + n * 34 + 4 * ch), hi = *(const uint2*)(tl + n * 34 + 4 * ch + 2);
                pg8::u32x4 o; o.x = lo.x; o.y = lo.y; o.z = hi.x; o.w = hi.y;
                *(pg8::u32x4*)((unsigned char*)Win_t + (size_t)(rb + n) * 1024 + kw + 16 * ch) = o; }
            __syncthreads();
        }
        for (int u = bid - 128; u >= 0 && u < 128; u += G) gemv_cols<7>(lds, VfVec{mod}, p.w_in, 3584, u, bias_f, nullptr);
    }
    xcd_barrier(bar);

    {
        pg8::Gemm g{(const bf16_t*)xq, Win_t, T, 3584, 512}; pg8::StaticOrder S; S.init(T, 3584, G, bid);
        EpiInprojMF E{P, rinv1, bias_f, p.pos, ftab, p.qg, p.kg, swf};
        pg8::gemm_phase<EpiInprojMF, pg8::StaticOrder, true>((PG8_LAS unsigned char*)lds, g, S, E);
        const int nidle = (G > 128) ? G - 128 : G, ib = (G > 128) ? bid - 128 : bid;
        {
            float* scr = (float*)(lds + wave * 16384);
            if (ib >= 0) for (int it = ib * 8 + wave; it < 16 * 32; it += nidle * 8) transpose_item<false, false>(p.w_out, 1024, 1024, Wout_t, scr, it, lane, nullptr, nullptr);
            __syncthreads();
        }
        if (ib >= 0) for (int wu = ib; wu < 256; wu += nidle) {
            const int hp = wu >> 4, blk = wu & 15, i0 = blk * 64;
            __syncthreads();
            unsigned char* Wt = lds; unsigned char* St = lds + 64 * 272; float* bred = (float*)(lds + 64 * 272 + 128 * 272);
            for (int e4 = tid; e4 < 2048; e4 += 512) { const int r = e4 >> 5, c4 = e4 & 31; const float4 v = *(const float4*)(p.wq + (size_t)(i0 + r) * 2048 + hp * 128 + 4 * c4);
                *(uint2*)(Wt + r * 272 + c4 * 8) = make_uint2(pk2(v.x, v.y), pk2(v.z, v.w)); }
            for (int e4 = tid; e4 < 4096; e4 += 512) { const int r = e4 >> 5, c4 = e4 & 31; const float4 v = *(const float4*)(p.sk + ((size_t)hp * 128 + r) * 128 + 4 * c4);
                *(uint2*)(St + r * 272 + c4 * 8) = make_uint2(pk2(v.x, v.y), pk2(v.z, v.w)); }
            __syncthreads();
            const int rt = wave >> 2, ct = wave & 3, l31 = lane & 31, hf = lane >> 5;
            f32x16 C;
#pragma unroll
            for (int r = 0; r < 16; ++r) C[r] = 0.f;
#pragma unroll
            for (int s8 = 0; s8 < 8; ++s8) C = MFMA32(*(const bf16x8*)(Wt + (32 * rt + l31) * 272 + (16 * s8 + 8 * hf) * 2), *(const bf16x8*)(St + (32 * ct + l31) * 272 + (16 * s8 + 8 * hf) * 2), C);
            float bsum = 0.f;
            bf16_t* wcol = Weff_t + (size_t)(hp * 128 + 32 * ct + l31) * 1024 + i0 + 32 * rt + 4 * hf;
#pragma unroll
            for (int g4 = 0; g4 < 4; ++g4) {
                const int i = i0 + 32 * rt + 8 * g4 + 4 * hf;
                const float4 gg = *(const float4*)(p.g2 + i), sc = *(const float4*)(mod + 4096 + i), sh = *(const float4*)(mod + 3072 + i);
                const float c0 = C[4 * g4], c1 = C[4 * g4 + 1], c2 = C[4 * g4 + 2], c3 = C[4 * g4 + 3];
                bsum += sh.x * c0 + sh.y * c1 + sh.z * c2 + sh.w * c3;
                *(uint2*)(wcol + 8 * g4) = make_uint2(pk2(c0 * gg.x * (1.f + sc.x), c1 * gg.y * (1.f + sc.y)), pk2(c2 * gg.z * (1.f + sc.z), c3 * gg.w * (1.f + sc.w)));
            }
            bsum += __shfl_xor(bsum, 32);
            if (hf == 0) bred[rt * 128 + 32 * ct + l31] = bsum;
            __syncthreads();
            if (tid < 128) bq_part[(size_t)blk * 2048 + hp * 128 + tid] = bred[tid] + bred[128 + tid];
        }
        __syncthreads();
        if (ib >= 0) convert_tables(p.down, p.up, q8, dsc, lane, ib * 8 + wave, nidle * 8, 0, CONV_SPLIT);
    }
    xcd_barrier(bar);
    wave = threadIdx.x >> 6; asm volatile("" : "+v"(wave));

    {
        const int gw = __builtin_amdgcn_readfirstlane(bid * 8 + wave), NGW = G * 8, l31 = lane & 31, hf = lane >> 5;
        const int wv0 = __builtin_amdgcn_readfirstlane(wave);
        for (int U = gw; U < 1024; U += NGW) {
            const int n = U >> 3, h = U & 7;
            f32x16 C[2][2];
#pragma unroll
            for (int a = 0; a < 2; ++a)
#pragma unroll
                for (int b = 0; b < 2; ++b)
#pragma unroll
                    for (int r = 0; r < 16; ++r) C[a][b][r] = 0.f;
            unsigned char* Kt = lds + wv0 * 9216; unsigned char* Vt = Kt + 4608;
            const int r8 = lane >> 3, pc = lane & 7, trq = (lane & 15) >> 2, trp = lane & 3, trd = (lane >> 4) & 1;
            const char* kbase = (const char*)(Kr + (size_t)n * 128 * 512 + h * 64); const char* vbase = (const char*)(Vr + (size_t)n * 128 * 512 + h * 64);
            const unsigned loff = (unsigned)(r8 * 512 + pc * 8) * 2u;
            const float lg = lg2_head(h);
            pg8::u32x4 gK[4], gV[4];
#pragma unroll
            for (int i = 0; i < 4; ++i) { gK[i] = *(const pg8::u32x4*)(kbase + (loff + i * 8192u)); gV[i] = *(const pg8::u32x4*)(vbase + (loff + i * 8192u)); }
            for (int sb4 = 0; sb4 < 4; ++sb4) {
#pragma unroll
                for (int i = 0; i < 4; ++i) { *(pg8::u32x4*)(Kt + (8 * i + r8) * 144 + pc * 16) = gK[i]; *(pg8::u32x4*)(Vt + (8 * i + r8) * 144 + pc * 16) = gV[i]; }
                { const int sn = (sb4 < 3) ? sb4 + 1 : sb4;
#pragma unroll
                  for (int i = 0; i < 4; ++i) { gK[i] = *(const pg8::u32x4*)(kbase + (size_t)sn * 32768 + (loff + i * 8192u)); gV[i] = *(const pg8::u32x4*)(vbase + (size_t)sn * 32768 + (loff + i * 8192u)); } }
#pragma unroll
                for (int s = 0; s < 2; ++s) {
                    bf16x8 Af[2], Bf[2];
#pragma unroll
                    for (int a = 0; a < 2; ++a) {
                        Af[a] = tr_frag(Vt + (16 * s + 8 * hf + trq) * 144 + (32 * a + 16 * trd + 4 * trp) * 2, 4);
                        const bf16x8 kraw = tr_frag(Kt + (16 * s + 8 * hf + trq) * 144 + (32 * a + 16 * trd + 4 * trp) * 2, 4);
                        const pg8::u32x4 kw = __builtin_bit_cast(pg8::u32x4, kraw); const unsigned kk[4] = {kw.x, kw.y, kw.z, kw.w};
                        pg8::u32x4 o; unsigned* op = (unsigned*)&o;
#pragma unroll
                        for (int e2 = 0; e2 < 4; ++e2) {
                            const int j0 = 32 * sb4 + 16 * s + 8 * hf + 2 * e2;
                            const float z0 = __builtin_amdgcn_exp2f((float)(127 - j0) * lg), z1 = __builtin_amdgcn_exp2f((float)(126 - j0) * lg);
                            op[e2] = pg8::cvt_pk_bf16(__uint_as_float(kk[e2] << 16) * z0, __uint_as_float(kk[e2] & 0xffff0000u) * z1);
                        }
                        Bf[a] = __builtin_bit_cast(bf16x8, o);
                    }
#pragma unroll
                    for (int a = 0; a < 2; ++a)
#pragma unroll
                        for (int b = 0; b < 2; ++b) C[a][b] = MFMA32(Af[a], Bf[b], C[a][b]);
                }
            }
            float* dst = kv + (size_t)(n * 8 + h) * 4096;
#pragma unroll
            for (int a = 0; a < 2; ++a)
#pragma unroll
                for (int b = 0; b < 2; ++b)
#pragma unroll
                    for (int r = 0; r < 16; ++r) dst[(32 * a + (r & 3) + 8 * (r >> 2) + 4 * hf) * 64 + 32 * b + l31] = C[a][b][r];
        }
        bf16x8 Tri[2];
        {
            pg8::u32x4 w0, w1; unsigned* p0 = (unsigned*)&w0; unsigned* p1 = (unsigned*)&w1;
#pragma unroll
            for (int e2 = 0; e2 < 4; ++e2) {
                unsigned a0 = 0, a1 = 0;
#pragma unroll
                for (int q = 0; q < 2; ++q) { const int e = 2 * e2 + q, ip = 8 * (e >> 2) + 4 * hf + (e & 3);
                    a0 |= ((ip > l31) ? 0x3F80u : 0u) << (16 * q); a1 |= ((16 + ip > l31) ? 0x3F80u : 0u) << (16 * q); }
                p0[e2] = a0; p1[e2] = a1;
            }
            Tri[0] = __builtin_bit_cast(bf16x8, w0); Tri[1] = __builtin_bit_cast(bf16x8, w1);
        }
        const bool sb_local = (G % 8 == 0) && (4096 % G == 0) && ((4096 / G) % 8 == 0);
        const int sb_per_wave = sb_local ? 4096 / G / 8 : (4096 + NGW - 1 - gw) / NGW;
        const int wv = __builtin_amdgcn_readfirstlane(wave);
        for (int ps = 0; ps < sb_per_wave; ++ps) {
            const int U = sb_local ? 0 : gw + ps * NGW;
            const int h = sb_local ? (bid & 7) : (U & 7), qt = sb_local ? (bid >> 3) * (4096 / G) + ps * 8 + wv : (U >> 3), q0 = qt * 32;
            f32x16 O[2];
#pragma unroll
            for (int r = 0; r < 16; ++r) { O[0][r] = 0.f; O[1][r] = 0.f; }
            float carry = 0.f;
            unsigned char* Kt = lds + wv * 9216; unsigned char* Vt = Kt + 4608;
            const int r8 = lane >> 3, pc = lane & 7;
            const char* kbase = (const char*)(Ks + h * 64); const char* vbase = (const char*)(Vs + h * 64);
            const unsigned loff = (unsigned)(r8 * 512 + pc * 8) * 2u;
            pg8::u32x4 gK[4], gV[4];
            bf16x8 Qf[4];
            {
                const char* qbase = (const char*)(Qs + h * 64);
#pragma unroll
                for (int i = 0; i < 4; ++i) gK[i] = *(const pg8::u32x4*)(qbase + (size_t)qt * 32768 + (loff + i * 8192u));
#pragma unroll
                for (int i = 0; i < 4; ++i) *(pg8::u32x4*)(Kt + (8 * i + r8) * 144 + pc * 16) = gK[i];
#pragma unroll
                for (int s = 0; s < 4; ++s) Qf[s] = *(const bf16x8*)(Kt + l31 * 144 + 32 * s + 16 * hf);
            }
#pragma unroll
            for (int i = 0; i < 4; ++i) { gK[i] = *(const pg8::u32x4*)(kbase + (size_t)qt * 32768 + (loff + i * 8192u)); gV[i] = *(const pg8::u32x4*)(vbase + (size_t)qt * 32768 + (loff + i * 8192u)); }
            const int trq = (lane & 15) >> 2, trp = lane & 3, trd = (lane >> 4) & 1;
            for (int kb = qt; kb >= 0; --kb) {
#pragma unroll
                for (int i = 0; i < 4; ++i) { *(pg8::u32x4*)(Kt + (8 * i + r8) * 144 + pc * 16) = gK[i]; *(pg8::u32x4*)(Vt + (8 * i + r8) * 144 + pc * 16) = gV[i]; }
                {
                    const int kbn = (kb > 0) ? kb - 1 : 0;
#pragma unroll
                    for (int i = 0; i < 4; ++i) { gK[i] = *(const pg8::u32x4*)(kbase + (size_t)kbn * 32768 + (loff + i * 8192u)); gV[i] = *(const pg8::u32x4*)(vbase + (size_t)kbn * 32768 + (loff + i * 8192u)); }
                }
                bf16x8 Kf[4], Vf[2][2];
#pragma unroll
                for (int s = 0; s < 4; ++s) Kf[s] = *(const bf16x8*)(Kt + l31 * 144 + 32 * s + 16 * hf);
#pragma unroll
                for (int s = 0; s < 2; ++s)
#pragma unroll
                    for (int dt = 0; dt < 2; ++dt) {
                        Vf[s][dt] = tr_frag(Vt + (16 * s + 4 * hf + trq) * 144 + (32 * dt + 16 * trd + 4 * trp) * 2, 8);
                    }
                f32x16 S;
#pragma unroll
                for (int r = 0; r < 16; ++r) S[r] = 0.f;
#pragma unroll
                for (int s = 0; s < 4; ++s) S = MFMA32(Kf[s], Qf[s], S);
                const bool diag = (kb == qt);
                f32x16 sp, lb;
                float csum = 0.f;
                if (diag) {
#pragma unroll
                    for (int r = 0; r < 16; ++r) {
                        const int i = (r & 3) + 8 * (r >> 2) + 4 * hf;
                        const float z = S[r];
                        const float l1p = __builtin_amdgcn_logf(1.0f + __builtin_amdgcn_exp2f(-fabsf(z)));
                        const float spv = (i < l31) ? (fmaxf(z, 0.f) + l1p) : 0.f;
                        sp[r] = spv; lb[r] = (i < l31) ? (fminf(z, 0.f) - l1p) : -INFINITY; csum += spv;
                    }
                } else {
#pragma unroll
                    for (int r = 0; r < 16; ++r) {
                        const float z = S[r];
                        const float l1p = __builtin_amdgcn_logf(1.0f + __builtin_amdgcn_exp2f(-fabsf(z)));
                        const float spv = fmaxf(z, 0.f) + l1p;
                        sp[r] = spv; lb[r] = fminf(z, 0.f) - l1p; csum += spv;
                    }
                }
                f32x16 Rt;
#pragma unroll
                for (int r = 0; r < 16; ++r) Rt[r] = carry;
#pragma unroll
                for (int s = 0; s < 2; ++s) Rt = MFMA32(Tri[s], pack_frag(sp, s), Rt);
                f32x16 wv;
#pragma unroll
                for (int r = 0; r < 16; ++r) wv[r] = __builtin_amdgcn_exp2f(lb[r] - Rt[r]);
#pragma unroll
                for (int s = 0; s < 2; ++s) { const bf16x8 wp = pack_frag(wv, s);
#pragma unroll
                    for (int dt = 0; dt < 2; ++dt) O[dt] = MFMA32(Vf[s][dt], wp, O[dt]); }
                csum += __shfl_xor(csum, 32);
                carry += csum;
                if (__all(carry > 127.f)) break;
            }
            float ss = 0.f;
#pragma unroll
            for (int r = 0; r < 16; ++r) ss += O[0][r] * O[0][r] + O[1][r] * O[1][r];
            ss += __shfl_xor(ss, 32);
            const float rn = 1.0f / sqrtf(ss * (1.f / 64.f) + EPS);
#pragma unroll
            for (int dt = 0; dt < 2; ++dt)
#pragma unroll
                for (int g4 = 0; g4 < 4; ++g4) {
                    const int d = 32 * dt + 8 * g4 + 4 * hf;
                    const float4 gn = *(const float4*)(p.og + d);
                    uint2 w; w.x = pg8::cvt_pk_bf16(O[dt][4 * g4] * rn * gn.x, O[dt][4 * g4 + 1] * rn * gn.y); w.y = pg8::cvt_pk_bf16(O[dt][4 * g4 + 2] * rn * gn.z, O[dt][4 * g4 + 3] * rn * gn.w);
                    *(uint2*)(Kt + l31 * 144 + d * 2) = w;
                }
#pragma unroll
            for (int i = 0; i < 4; ++i) *(pg8::u32x4*)(ycat + (size_t)(q0 + 8 * i + r8) * 1024 + 512 + h * 64 + pc * 8) = *(const pg8::u32x4*)(Kt + (8 * i + r8) * 144 + pc * 16);
        }
    }
    xcd_barrier(bar);

    if (bid == 255 % G) for (int n = tid; n < 2048; n += 512) { float s = 0.f;
#pragma unroll
        for (int b8 = 0; b8 < 16; ++b8) s += bq_part[(size_t)b8 * 2048 + n];
        bias_q[n] = s; }
    if (G > 64 && bid >= 64) convert_tables(p.down, p.up, q8, dsc, lane, (bid - 64) * 8 + wave, (G - 64) * 8, CONV_SPLIT, 32768);
    else if (G <= 64) convert_tables(p.down, p.up, q8, dsc, lane, bid * 8 + wave, G * 8, CONV_SPLIT, 32768);
    for (int idx = bid * 512 + tid; idx < 32768; idx += G * 512) {
        const int h = idx >> 12;
        const float cd = exp2f(128.f * lg2_head(h));
        float s = 0.f;
        for (int n0 = 0; n0 < 128; n0 += 32) {
            float kvv[32];
#pragma unroll
            for (int q = 0; q < 32; ++q) kvv[q] = kv[(size_t)(n0 + q) * 32768 + idx];
#pragma unroll
            for (int q = 0; q < 32; ++q) { stT[(size_t)(n0 + q) * 32768 + idx] = f2bf(s); s = cd * s + kvv[q]; }
        }
    }
    xcd_barrier(bar);

    {
        const int gw = __builtin_amdgcn_readfirstlane(bid * 8 + wave), NGW = G * 8, l31 = lane & 31, hf = lane >> 5;
        const int wv4 = __builtin_amdgcn_readfirstlane(wave);
        for (int W2 = gw; W2 < 2048; W2 += NGW) {
            const int nh = W2 >> 1, n = nh >> 3, h = nh & 7;
            const float lg = lg2_head(h);
#pragma unroll 1
            for (int pass = 0; pass < 2; ++pass) {
                const int qt = (W2 & 1) ? (pass ? 2 : 1) : (pass ? 3 : 0);
                const int il = qt * 32 + l31, tq = n * 128 + il;
                unsigned char* Kt = lds + wv4 * 9216; unsigned char* Vt = Kt + 4608;
                const int r8 = lane >> 3, pc = lane & 7, trq = (lane & 15) >> 2, trp = lane & 3, trd = (lane >> 4) & 1;
                const unsigned loff = (unsigned)(r8 * 512 + pc * 8) * 2u;
                pg8::u32x4 gK[4], gV[4];
                bf16x8 Qf[4];
                {
                    const char* qbase = (const char*)(Qr + (size_t)(n * 128 + qt * 32) * 512 + h * 64);
                    const char* sbase = (const char*)(stT + (size_t)nh * 4096) + (unsigned)(r8 * 64 + pc * 8) * 2u;
#pragma unroll
                    for (int i = 0; i < 4; ++i) gK[i] = *(const pg8::u32x4*)(qbase + (loff + i * 8192u));
#pragma unroll
                    for (int i = 0; i < 4; ++i) *(pg8::u32x4*)(Kt + (8 * i + r8) * 144 + pc * 16) = gK[i];
#pragma unroll
                    for (int s = 0; s < 4; ++s) Qf[s] = *(const bf16x8*)(Kt + l31 * 144 + 32 * s + 16 * hf);
#pragma unroll
                    for (int i = 0; i < 4; ++i) { gK[i] = *(const pg8::u32x4*)(sbase + i * 1024u); gV[i] = *(const pg8::u32x4*)(sbase + 4096u + i * 1024u); }
#pragma unroll
                    for (int i = 0; i < 4; ++i) { *(pg8::u32x4*)(Kt + (8 * i + r8) * 144 + pc * 16) = gK[i]; *(pg8::u32x4*)(Kt + (32 + 8 * i + r8) * 144 + pc * 16) = gV[i]; }
                }
                f32x16 O[2];
#pragma unroll
                for (int r = 0; r < 16; ++r) { O[0][r] = 0.f; O[1][r] = 0.f; }
#pragma unroll
                for (int s = 0; s < 4; ++s)
#pragma unroll
                    for (int dt = 0; dt < 2; ++dt) O[dt] = MFMA32(*(const bf16x8*)(Kt + (32 * dt + l31) * 144 + 32 * s + 16 * hf), Qf[s], O[dt]);
                const float xi = exp2f((float)(il + 1) * lg);
#pragma unroll
                for (int r = 0; r < 16; ++r) { O[0][r] *= xi; O[1][r] *= xi; }
                const char* kbase = (const char*)(Kr + (size_t)n * 128 * 512 + h * 64); const char* vbase = (const char*)(Vr + (size_t)n * 128 * 512 + h * 64);
#pragma unroll
                for (int i = 0; i < 4; ++i) { gK[i] = *(const pg8::u32x4*)(kbase + (loff + i * 8192u)); gV[i] = *(const pg8::u32x4*)(vbase + (loff + i * 8192u)); }
                for (int jb = 0; jb <= qt; ++jb) {
#pragma unroll
                    for (int i = 0; i < 4; ++i) { *(pg8::u32x4*)(Kt + (8 * i + r8) * 144 + pc * 16) = gK[i]; *(pg8::u32x4*)(Vt + (8 * i + r8) * 144 + pc * 16) = gV[i]; }
                    { const int jn = (jb < qt) ? jb + 1 : jb;
#pragma unroll
                      for (int i = 0; i < 4; ++i) { gK[i] = *(const pg8::u32x4*)(kbase + (size_t)jn * 32768 + (loff + i * 8192u)); gV[i] = *(const pg8::u32x4*)(vbase + (size_t)jn * 32768 + (loff + i * 8192u)); } }
                    bf16x8 Kf[4], Vf[2][2];
#pragma unroll
                    for (int s = 0; s < 4; ++s) Kf[s] = *(const bf16x8*)(Kt + l31 * 144 + 32 * s + 16 * hf);
#pragma unroll
                    for (int s = 0; s < 2; ++s)
#pragma unroll
                        for (int dt = 0; dt < 2; ++dt) Vf[s][dt] = tr_frag(Vt + (16 * s + 4 * hf + trq) * 144 + (32 * dt + 16 * trd + 4 * trp) * 2, 8);
                    f32x16 S;
#pragma unroll
                    for (int r = 0; r < 16; ++r) S[r] = 0.f;
#pragma unroll
                    for (int s = 0; s < 4; ++s) S = MFMA32(Kf[s], Qf[s], S);
#pragma unroll
                    for (int r = 0; r < 16; ++r) {
                        const int jl = jb * 32 + (r & 3) + 8 * (r >> 2) + 4 * hf, dl = il - jl;
                        S[r] = (dl >= 0) ? S[r] * __builtin_amdgcn_exp2f((float)dl * lg) : 0.f;
                    }
#pragma unroll
                    for (int s = 0; s < 2; ++s) { const bf16x8 wp = pack_frag(S, s);
#pragma unroll
                        for (int dt = 0; dt < 2; ++dt) O[dt] = MFMA32(Vf[s][dt], wp, O[dt]); }
                }
                float sm = 0.f;
#pragma unroll
                for (int r = 0; r < 16; ++r) sm += O[0][r] + O[1][r];
                sm += __shfl_xor(sm, 32);
                const float mean = sm * (1.f / 64.f);
                float vs = 0.f;
#pragma unroll
                for (int r = 0; r < 16; ++r) { const float d0 = O[0][r] - mean, d1 = O[1][r] - mean; vs += d0 * d0 + d1 * d1; }
                vs += __shfl_xor(vs, 32);
                const float rstd = 1.0f / sqrtf(vs * (1.f / 64.f) + EPS);
                {
                    const char* gbase = (const char*)(Gr + (size_t)(n * 128 + qt * 32) * 512 + h * 64);
#pragma unroll
                    for (int i = 0; i < 4; ++i) gV[i] = *(const pg8::u32x4*)(gbase + (loff + i * 8192u));
#pragma unroll
                    for (int i = 0; i < 4; ++i) *(pg8::u32x4*)(Vt + (8 * i + r8) * 144 + pc * 16) = gV[i];
                }
#pragma unroll
                for (int dt = 0; dt < 2; ++dt)
#pragma unroll
                    for (int g4 = 0; g4 < 4; ++g4) {
                        const int e = 32 * dt + 8 * g4 + 4 * hf;
                        const float4 gn = *(const float4*)(p.rgain + h * 64 + e);
                        const uint2 gg = *(const uint2*)(Vt + l31 * 144 + e * 2);
                        const float g0 = __uint_as_float(gg.x << 16), g1 = __uint_as_float(gg.x & 0xffff0000u), g2v = __uint_as_float(gg.y << 16), g3 = __uint_as_float(gg.y & 0xffff0000u);
                        uint2 w;
                        w.x = pg8::cvt_pk_bf16((O[dt][4 * g4] - mean) * rstd * gn.x * g0, (O[dt][4 * g4 + 1] - mean) * rstd * gn.y * g1);
                        w.y = pg8::cvt_pk_bf16((O[dt][4 * g4 + 2] - mean) * rstd * gn.z * g2v, (O[dt][4 * g4 + 3] - mean) * rstd * gn.w * g3);
                        *(uint2*)(Kt + l31 * 144 + e * 2) = w;
                    }
#pragma unroll
                for (int i = 0; i < 4; ++i) *(pg8::u32x4*)(ycat + (size_t)(n * 128 + qt * 32 + 8 * i + r8) * 1024 + h * 64 + pc * 8) = *(const pg8::u32x4*)(Kt + (8 * i + r8) * 144 + pc * 16);
            }
        }
    }
    xcd_barrier(bar);

    {
        pg8::Gemm g{ycat, Wout_t, T, 1024, 1024}; pg8::StaticOrder S; S.init(T, 1024, G, bid);
        EpiOutprojMF E{p.x, mod + 2048, x1b, part2};
        pg8::gemm_phase<EpiOutprojMF, pg8::StaticOrder>((PG8_LAS unsigned char*)lds, g, S, E);
    }
    xcd_barrier(bar);

    for (int round = 0; round < 2; ++round) {
        pg8::Gemm g{x1b, Weff_t, T, 2048, 1024}; OneUnitOrder S; S.base.init(T, 2048, G, bid); S.round = round;
        EpiTopkMF E{part2, bias_q, ids, gates};
        pg8::gemm_phase<EpiTopkMF, OneUnitOrder>((PG8_LAS unsigned char*)lds, g, S, E);
    }
    xcd_barrier(bar);

    {
        constexpr int IDS_LD = 136, ACT_LD = 136;
        const float* scale2 = mod + 4096; const float* shift2 = mod + 3072; const float* gate2 = mod + 5120;
        unsigned short* ids_l = (unsigned short*)lds; float* act_l = (float*)(lds + 32768);
        bf16_t* ds_l = (bf16_t*)(lds + 69632);
        const int t0 = bid * 64, tt = lane >> 3, sub = lane & 7, tl = wave * 8 + tt, t = t0 + tl;
        for (int e = tid; e < 1024; e += 512) { const int r = e >> 4, c8 = e & 15; *(uint4*)(ids_l + r * IDS_LD + c8 * 8) = *(const uint4*)(ids + (size_t)(t0 + r) * 128 + c8 * 8); }
        for (int e = tid; e < 64 * ACT_LD; e += 512) act_l[e] = 0.f;
        for (int e = tid; e < 4096; e += 512) ((uint4*)ds_l)[e] = ((const uint4*)dsc)[e];
        float* s2_l = (float*)(lds + 143360); float* sh2_l = s2_l + 1024; float* gt2_l = s2_l + 2048;
        for (int e = tid; e < 1024; e += 512) { s2_l[e] = p.g2[e] * (1.f + scale2[e]); sh2_l[e] = shift2[e]; gt2_l[e] = gate2[e]; }
        __syncthreads();
        float ri;
        { const float4* pp = (const float4*)(part2 + (size_t)t * 16); const float4 p0 = pp[0], p1 = pp[1], p2 = pp[2], p3 = pp[3];
          const float ssum = ((p0.x + p0.y) + (p0.z + p0.w)) + ((p1.x + p1.y) + (p1.z + p1.w)) + ((p2.x + p2.y) + (p2.z + p2.w)) + ((p3.x + p3.y) + (p3.z + p3.w));
          ri = 1.0f / sqrtf(ssum * (1.0f / D) + EPS); }
        const unsigned short* myids = ids_l + tl * IDS_LD;
        float* myact = act_l + tl * ACT_LD;
        const bool s4 = (sub & 4) != 0, s2 = (sub & 2) != 0, s1 = (sub & 1) != 0;
        const unsigned suboff = (unsigned)sub * 16u;
        typedef float f32x2 __attribute__((ext_vector_type(2)));
#define P9_LOAD(W, JB) do { const uint4 idv_ = *(const uint4*)(myids + 8 * (JB)); const unsigned idw_[4] = {idv_.x, idv_.y, idv_.z, idv_.w}; \
        _Pragma("unroll") for (int k_ = 0; k_ < 8; ++k_) { const unsigned id_ = (idw_[k_ >> 1] >> (16 * (k_ & 1))) & 0xffffu; W[k_] = *(const uint4*)(sbase + (id_ * 128u + suboff)); } } while (0)
#define P9_DOWN4(W, JB) do { int pd_[8]; \
        _Pragma("unroll") for (int k_ = 0; k_ < 8; ++k_) { const unsigned ww_[4] = {W[k_].x, W[k_].y, W[k_].z, W[k_].w}; int a0_ = 0, a1_ = 0; \
            _Pragma("unroll") for (int m_ = 0; m_ < 4; ++m_) { a0_ = __builtin_amdgcn_sdot4(hpe[m_], (int)(ww_[m_] & 0x0F0F0F0Fu), a0_, false); a1_ = __builtin_amdgcn_sdot4(hpo[m_], (int)((ww_[m_] >> 4) & 0x0F0F0F0Fu), a1_, false); } \
            pd_[k_] = a0_ + a1_ - hoff; } \
        int r4_[4], r2_[2]; \
        _Pragma("unroll") for (int k_ = 0; k_ < 4; ++k_) { const int snd_ = s4 ? pd_[k_] : pd_[k_ + 4], kp_ = s4 ? pd_[k_ + 4] : pd_[k_]; r4_[k_] = kp_ + __shfl_xor(snd_, 4); } \
        _Pragma("unroll") for (int k_ = 0; k_ < 2; ++k_) { const int snd_ = s2 ? r4_[k_] : r4_[k_ + 2], kp_ = s2 ? r4_[k_ + 2] : r4_[k_]; r2_[k_] = kp_ + __shfl_xor(snd_, 2); } \
        { const int snd_ = s1 ? r2_[0] : r2_[1], kp_ = s1 ? r2_[1] : r2_[0]; myact[8 * (JB) + sub] += (float)(kp_ + __shfl_xor(snd_, 1)) * hscale; } } while (0)
        for (int c = 0; c < 4; ++c) {
            float hf[8][4]; float hmax = 0.f;
#pragma unroll
            for (int q = 0; q < 8; ++q) {
                const int col = 256 * c + 4 * sub + 32 * q;
                const uint2 xw = *(const uint2*)(x1b + (size_t)t * D + col);
                const float4 sv = *(const float4*)(s2_l + col), sh = *(const float4*)(sh2_l + col);
                hf[q][0] = __uint_as_float(xw.x << 16) * ri * sv.x + sh.x; hf[q][1] = __uint_as_float(xw.x & 0xffff0000u) * ri * sv.y + sh.y;
                hf[q][2] = __uint_as_float(xw.y << 16) * ri * sv.z + sh.z; hf[q][3] = __uint_as_float(xw.y & 0xffff0000u) * ri * sv.w + sh.w;
                hmax = fmaxf(hmax, fmaxf(fmaxf(fabsf(hf[q][0]), fabsf(hf[q][1])), fmaxf(fabsf(hf[q][2]), fabsf(hf[q][3]))));
            }
            hmax = fmaxf(hmax, __shfl_xor(hmax, 1)); hmax = fmaxf(hmax, __shfl_xor(hmax, 2)); hmax = fmaxf(hmax, __shfl_xor(hmax, 4));
            const float hinv = (hmax > 0.f) ? 127.0f / hmax : 0.f, hscale = hmax * (1.0f / 127.0f);
            int hq[8][4];
#pragma unroll
            for (int q = 0; q < 8; ++q)
#pragma unroll
                for (int j = 0; j < 4; ++j) hq[q][j] = (int)__builtin_rintf(hf[q][j] * hinv);
            int hpe[4], hpo[4], hoff = 0;
#pragma unroll
            for (int m = 0; m < 4; ++m) {
                hpe[m] = (hq[2 * m][0] & 255) | ((hq[2 * m][2] & 255) << 8) | ((hq[2 * m + 1][0] & 255) << 16) | ((hq[2 * m + 1][2] & 255) << 24);
                hpo[m] = (hq[2 * m][1] & 255) | ((hq[2 * m][3] & 255) << 8) | ((hq[2 * m + 1][1] & 255) << 16) | ((hq[2 * m + 1][3] & 255) << 24);
            }
#pragma unroll
            for (int q = 0; q < 8; ++q) hoff += (hq[q][0] + hq[q][1]) + (hq[q][2] + hq[q][3]);
            hoff *= 8;
            const unsigned char* sbase = q8 + (size_t)c * (16384 * 128);
            uint4 wA[8], wB[8];
            P9_LOAD(wA, 0);
#pragma unroll 1
            for (int jb = 0; jb < 16; jb += 2) {
                P9_LOAD(wB, jb + 1);
                P9_DOWN4(wA, jb);
                if (jb + 2 < 16) P9_LOAD(wA, jb + 2);
                P9_DOWN4(wB, jb + 1);
            }
        }
#undef P9_DOWN4
        signed char* aq_l = (signed char*)(lds + 135168);
        float avv[16]; float amax = 0.f;
#pragma unroll
        for (int jb = 0; jb < 16; ++jb) {
            const int j = 8 * jb + sub; const unsigned id = myids[j];
            const float a = myact[j] * bf2f(ds_l[id]);
            const float av = fabsf(a), tq = 1.0f / (av * 0.2316418882f + 1.0f);
            float ql = tq * 0.5307027145f + (-0.7265760135f); ql = ql * tq + 0.7107068705f; ql = ql * tq + (-0.142248368f); ql = ql * tq + 0.127414796f; ql = ql * tq;
            const float mm = a * (ql * exp2f(a * a * (-0.72134752044f)));
            const float ge = (a < 0.f) ? mm : (a - mm);
            avv[jb] = ge * gates[(size_t)t * 128 + j] * bf2f(ds_l[16384 + id]);
            amax = fmaxf(amax, fabsf(avv[jb]));
        }
        amax = fmaxf(amax, __shfl_xor(amax, 1)); amax = fmaxf(amax, __shfl_xor(amax, 2)); amax = fmaxf(amax, __shfl_xor(amax, 4));
        const float ainv = (amax > 0.f) ? 127.0f / amax : 0.f, ascale = amax * (1.0f / 127.0f);
        int aqsum = 0;
#pragma unroll
        for (int jb = 0; jb < 16; ++jb) { const int aqv = (int)__builtin_rintf(avv[jb] * ainv); aq_l[tl * 128 + 8 * jb + sub] = (signed char)aqv; aqsum += aqv; }
        aqsum += __shfl_xor(aqsum, 1); aqsum += __shfl_xor(aqsum, 2); aqsum += __shfl_xor(aqsum, 4);
        __syncthreads();
#define P9_PERM(HI, LO, SEL) __builtin_amdgcn_perm((HI), (LO), (SEL))
#define P9_T4(E0, E1, E2, E3, T0, T1, T2, T3) do { const unsigned p0_ = P9_PERM(E1, E0, 0x05010400u), p1_ = P9_PERM(E1, E0, 0x07030602u), p2_ = P9_PERM(E3, E2, 0x05010400u), p3_ = P9_PERM(E3, E2, 0x07030602u); \
        T0 = P9_PERM(p2_, p0_, 0x05040100u); T1 = P9_PERM(p2_, p0_, 0x07060302u); T2 = P9_PERM(p3_, p1_, 0x05040100u); T3 = P9_PERM(p3_, p1_, 0x07060302u); } while (0)
#define P9_UP4(W, JB) do { const uint2 aq8_ = *(const uint2*)(aq_l + tl * 128 + 8 * (JB)); const int aq4_[2] = {(int)aq8_.x, (int)aq8_.y}; \
        _Pragma("unroll") for (int g_ = 0; g_ < 2; ++g_) { \
            _Pragma("unroll") for (int m_ = 0; m_ < 4; ++m_) { \
                const unsigned w0_ = ((const unsigned*)&W[4 * g_ + 0])[m_], w1_ = ((const unsigned*)&W[4 * g_ + 1])[m_], w2_ = ((const unsigned*)&W[4 * g_ + 2])[m_], w3_ = ((const unsigned*)&W[4 * g_ + 3])[m_]; \
                unsigned t_[4]; \
                P9_T4(w0_, w1_, w2_, w3_, t_[0], t_[1], t_[2], t_[3]); \
                _Pragma("unroll") for (int k_ = 0; k_ < 4; ++k_) { \
                    oraw[4 * m_ + k_] = __builtin_amdgcn_sdot4(aq4_[g_], (int)t_[k_], oraw[4 * m_ + k_], false); \
                    olo[4 * m_ + k_] = __builtin_amdgcn_sdot4(aq4_[g_], (int)(t_[k_] & 0x0F0F0F0Fu), olo[4 * m_ + k_], false); } } } } while (0)
        for (int c = 0; c < 4; ++c) {
            int oraw[16], olo[16];
#pragma unroll
            for (int q = 0; q < 16; ++q) { oraw[q] = 0; olo[q] = 0; }
            const unsigned char* sbase = q8 + (8u << 20) + (size_t)c * (16384 * 128);
            uint4 wA[8], wB[8];
            P9_LOAD(wA, 0);
#pragma unroll 1
            for (int jb = 0; jb < 16; jb += 2) {
                P9_LOAD(wB, jb + 1);
                P9_UP4(wA, jb);
                if (jb + 2 < 16) P9_LOAD(wA, jb + 2);
                P9_UP4(wB, jb + 1);
            }
#pragma unroll
            for (int q = 0; q < 8; ++q) {
                const int col = 256 * c + 4 * sub + 32 * q;
                float* op = out + (size_t)t * D + col;
                const uint2 xw = *(const uint2*)(x1b + (size_t)t * D + col); const float4 xv = make_float4(__uint_as_float(xw.x << 16), __uint_as_float(xw.x & 0xffff0000u), __uint_as_float(xw.y << 16), __uint_as_float(xw.y & 0xffff0000u)); const float4 gt = *(const float4*)(gt2_l + col);
                const int m = q >> 1, k0 = 2 * (q & 1);
                const int v0 = olo[4 * m + k0] - 8 * aqsum, v1 = (oraw[4 * m + k0] - olo[4 * m + k0]) >> 4, v2 = olo[4 * m + k0 + 1] - 8 * aqsum, v3 = (oraw[4 * m + k0 + 1] - olo[4 * m + k0 + 1]) >> 4;
                float4 r;
                r.x = xv.x + gt.x * ((float)v0 * ascale); r.y = xv.y + gt.y * ((float)v1 * ascale); r.z = xv.z + gt.z * ((float)v2 * ascale); r.w = xv.w + gt.w * ((float)v3 * ascale);
                *(float4*)op = r;
            }
        }
#undef P9_LOAD
#undef P9_UP4
#undef P9_T4
#undef P9_PERM
    }
}
}

extern "C" void kernel_launch(void* const* d_in, const int* in_sizes, int n_in, void* d_out, int out_size, void* d_ws, size_t ws_size, hipStream_t stream) {
    static int grid = 0;
    if (grid == 0) {
        int dev = 0, cus = 0, per_cu = 0;
        (void)hipGetDevice(&dev);
        (void)hipDeviceGetAttribute(&cus, hipDeviceAttributeMultiprocessorCount, dev);
        (void)hipFuncSetAttribute((const void*)mk_fwd, hipFuncAttributeMaxDynamicSharedMemorySize, LDS_BYTES);
        (void)hipOccupancyMaxActiveBlocksPerMultiprocessor(&per_cu, (const void*)mk_fwd, 512, LDS_BYTES);
        if (per_cu < 1 || cus != 256) { fprintf(stderr, "kernel_launch: needs 256 CUs with one resident workgroup each (cus %d, per_cu %d)\n", cus, per_cu); grid = -1; }
        else grid = cus;
    }
    if (grid < 0) return;
    (void)hipMemsetAsync((char*)d_ws + OFF_CTL, 0, CTL_BYTES, stream);
    Params p{};
    p.x = (const float*)d_in[0]; p.c = (const float*)d_in[1]; p.pos = (const int*)d_in[2]; p.ada_w = (const float*)d_in[3]; p.ada_b = (const float*)d_in[4];
    p.g1 = (const float*)d_in[5]; p.g2 = (const float*)d_in[6]; p.w_in = (const float*)d_in[7]; p.rgain = (const float*)d_in[8]; p.qg = (const float*)d_in[9];
    p.kg = (const float*)d_in[10]; p.og = (const float*)d_in[11]; p.w_out = (const float*)d_in[12]; p.wq = (const float*)d_in[13]; p.sk = (const float*)d_in[14];
    p.down = (const float*)d_in[15]; p.up = (const float*)d_in[16]; p.out = (float*)d_out; p.ws = (unsigned char*)d_ws;
    for (int i = 0; i < 32; ++i) {
        const double f = pow(10000.0, -(double)i / 32.0) / 6.283185307179586476925;
        float fh = (float)f; unsigned ub; memcpy(&ub, &fh, 4); ub &= 0xFFFFC000u; memcpy(&fh, &ub, 4);
        p.rc.fh[i] = fh; p.rc.fl[i] = (float)(f - (double)fh);
    }
    void* args[] = {&p};
    hipError_t e = hipLaunchCooperativeKernel((const void*)mk_fwd, dim3(grid), dim3(512), args, LDS_BYTES, stream);
    if (e != hipSuccess) fprintf(stderr, "kernel_launch: cooperative launch failed: %s (grid %d)\n", hipGetErrorString(e), grid);
}
```

```cpp
#include <hip/hip_runtime.h>
#include <stdint.h>
#include <math.h>
#include <cstdio>
#include <cstring>

namespace {
constexpr int T = 16384, D = 1024;
constexpr float EPS = 1e-6f;
typedef unsigned short bf16_t;
#define LAS __attribute__((address_space(3)))

__device__ __forceinline__ float bf2f(bf16_t b) { return __uint_as_float(((unsigned)b) << 16); }
__device__ __forceinline__ bf16_t f2bf(float f) { unsigned u = __float_as_uint(f); u += 0x7fffu + ((u >> 16) & 1u); return (bf16_t)(u >> 16); }
__device__ __forceinline__ float4 ld_nt4(const float* p) { typedef float f4v __attribute__((ext_vector_type(4))); const f4v v = __builtin_nontemporal_load((const f4v*)p); return make_float4(v[0], v[1], v[2], v[3]); }

__device__ __forceinline__ float lg2_head(int h) {
    const float x = __uint_as_float((unsigned)(127 - 5 - h) << 23);
    const float s = x * (1.f + x * (0.5f + x * (0.33333334f + x * (0.25f + x * (0.2f + x * 0.16666667f)))));
    return -s * 1.44269504089f;
}
struct RopeC { float fh[32], fl[32]; };
struct RetC { float lg2[8]; };

constexpr size_t MiB = 1u << 20;
constexpr size_t OFF_CTL = 0;
constexpr size_t CTL_BYTES = 64 * 1024;
constexpr size_t OFF_MOD = 64 * 1024, OFF_RINV1 = 128 * 1024, OFF_BIASF = 256 * 1024, OFF_ROPE = 1 * MiB;
constexpr size_t OFF_WINT = 6 * MiB;
constexpr size_t OFF_XB = 16 * MiB;
constexpr size_t OFF_YCAT = 160 * MiB;
constexpr size_t OFF_P = 48 * MiB;
constexpr size_t OFF_KV = 208 * MiB, OFF_ST = 224 * MiB;
constexpr size_t OFF_WEFFT = 240 * MiB;
constexpr size_t OFF_WOUTT = 13 * MiB;
constexpr size_t OFF_BIASQ = 272 * 1024;
constexpr size_t OFF_SWF = 320 * 1024;
constexpr size_t OFF_SQ = 336 * 1024;
constexpr size_t OFF_PMAX = 2 * MiB;
constexpr size_t OFF_RINV2Q = 3 * MiB;
constexpr size_t OFF_WEFFQ = 10 * MiB;
constexpr size_t OFF_X1Q = 16 * MiB;
constexpr int CTL_CNT = 4096, CTL_CMAX = 8192;
constexpr size_t OFF_XQ = 160 * MiB;
constexpr size_t OFF_DSC = 512 * 1024;
constexpr size_t OFF_BQPART = 576 * 1024;
constexpr size_t OFF_PART2 = 5 * MiB;
constexpr size_t OFF_X1B = 208 * MiB;
constexpr size_t OFF_IDS = 244 * MiB, OFF_GATES = 248 * MiB;
constexpr size_t OFF_Q8 = 192 * MiB;
constexpr int CONV_SPLIT = 0;
constexpr int LDS_BYTES = 163840;
constexpr int LDS_ST_OFF = LDS_BYTES - 16;

#define XB_TMO      128
#define XB_XCNT(j)  (256  + 64 * (j))
#define XB_XSUB(j)  (1280 + 64 * (j))
#define XB_XGEN(j)  (2304 + 64 * (j))
#define XB_TOP      3328
#define XB_TOPGEN   3392
#define XCD_BAR_WORDS 3456
#define XB_SPIN_CAP (1u << 20)
__device__ __forceinline__ unsigned xb_ld(unsigned* p)              { return __hip_atomic_load(p, __ATOMIC_RELAXED, __HIP_MEMORY_SCOPE_AGENT); }
__device__ __forceinline__ unsigned xb_add(unsigned* p, unsigned v) { return __hip_atomic_fetch_add(p, v, __ATOMIC_RELAXED, __HIP_MEMORY_SCOPE_AGENT); }
__device__ __forceinline__ unsigned xb_xcc_id() { return (unsigned)__builtin_amdgcn_s_getreg((3 << 11) | 20) & 0xFu; }
#define XB_SPIN(cond, bar) do { unsigned _sp = 0; while (cond) { __builtin_amdgcn_s_sleep(1); \
    if ((++_sp & 255u) == 0u) { if (xb_ld(&(bar)[XB_TMO])) break; if (_sp > XB_SPIN_CAP) { atomicAdd(&(bar)[XB_TMO], 1u); break; } } } } while (0)
struct XcdBarrier { unsigned* bar; unsigned x; volatile LAS unsigned* st; };
__device__ __forceinline__ XcdBarrier xcd_barrier_post(unsigned* bar, volatile LAS unsigned* st) {
    XcdBarrier b; b.bar = bar; b.x = xb_xcc_id(); b.st = st;
    if (threadIdx.x == 0) (void)xb_add(&bar[XB_XCNT(b.x)], 1u);
    return b;
}
__device__ __forceinline__ void xcd_barrier_complete(unsigned* bar, unsigned x, unsigned& nloc, unsigned& nx) {
    const unsigned G = gridDim.x * gridDim.y * gridDim.z;
    unsigned sum, cnt, mine, sp = 0u;
    for (;;) {
        sum = 0u; cnt = 0u; mine = 0u;
#pragma unroll
        for (unsigned j = 0; j < 16; ++j) { const unsigned c = xb_ld(&bar[XB_XCNT(j)]); sum += c; cnt += (c > 0u) ? 1u : 0u; mine = (j == x) ? c : mine; }
        if (sum == G) break;
        __builtin_amdgcn_s_sleep(1);
        if ((++sp & 255u) == 0u) { if (xb_ld(&bar[XB_TMO])) break; if (sp > XB_SPIN_CAP) { atomicAdd(&bar[XB_TMO], 1u); break; } }
    }
    nloc = mine > 0u ? mine : 1u; nx = cnt > 0u ? cnt : 1u;
}
__device__ __forceinline__ void xcd_barrier(const XcdBarrier& b) {
    asm volatile("s_waitcnt vmcnt(0)" ::: "memory");
    __syncthreads();
    if (threadIdx.x == 0) {
        unsigned* bar = b.bar;
        __builtin_amdgcn_s_waitcnt(0);
        unsigned nloc = b.st[0], nx = b.st[1];
        if (nloc == 0u) { xcd_barrier_complete(bar, b.x, nloc, nx); b.st[0] = nloc; b.st[1] = nx; }
        const unsigned old = xb_add(&bar[XB_XSUB(b.x)], 1u);
        const unsigned gen = old / nloc;
        if (old + 1u == (gen + 1u) * nloc) {
            __builtin_amdgcn_fence(__ATOMIC_RELEASE, "agent");
            asm volatile("s_waitcnt vmcnt(0)" ::: "memory");
            const unsigned og = xb_add(&bar[XB_TOP], 1u);
            const unsigned tg = og / nx;
            if (og + 1u == (tg + 1u) * nx) xb_add(&bar[XB_TOPGEN], 1u);
            else XB_SPIN(xb_ld(&bar[XB_TOPGEN]) == tg, bar);
            __builtin_amdgcn_fence(__ATOMIC_ACQUIRE, "agent");
            xb_add(&bar[XB_XGEN(b.x)], 1u);
            asm volatile("s_waitcnt vmcnt(0)" ::: "memory");
        } else {
            XB_SPIN(xb_ld(&bar[XB_XGEN(b.x)]) == gen, bar);
            __builtin_amdgcn_fence(__ATOMIC_ACQUIRE, "agent");
            asm volatile("s_waitcnt vmcnt(0)" ::: "memory");
        }
    }
    __syncthreads();
}


namespace pg8 {
#define PG8_LAS __attribute__((address_space(3)))
typedef short bf16x8 __attribute__((ext_vector_type(8)));
typedef float f32x4 __attribute__((ext_vector_type(4)));
typedef unsigned u32x4 __attribute__((ext_vector_type(4)));
typedef unsigned u32x2 __attribute__((ext_vector_type(2)));
constexpr int BM = 256, BK = 64, HALF = 128, HTB = HALF * BK * 2, STAGE_BYTES = 8 * HTB, NXCD = 8, WGM = 8;
__host__ __device__ __forceinline__ int lds_byte(int r, int c) { const int st = (r >> 4) * 2 + (c >> 5), rr = r & 15, cc = c & 31, ob = rr * 64 + cc * 2; return st * 1024 + (ob ^ (((ob >> 9) & 1) << 5)); }
__host__ __device__ __forceinline__ void stage_rc(int b, int& R, int& C) { const int st = b / 1024, sb = b % 1024, swz = sb ^ (((sb >> 9) & 1) << 5); R = (st >> 1) * 16 + swz / 64; C = (st & 1) * 32 + (swz % 64) / 2; }
__host__ __device__ __forceinline__ int perm32(int rho) { const int n = rho >> 4, i = rho & 15; return 8 * (i >> 2) + 4 * n + (i & 3); }
struct Unit { int pm, pn; };
struct Gemm { const bf16_t* A; const bf16_t* Bt; int M, N, K; };
struct StaticOrder {
    int nM, nN, nwg, G, c;
    __host__ __device__ void init(int M, int N, int G_, int c_) { nM = M / BM; nN = N / BM; nwg = nM * nN; G = G_; c = c_; }
    __host__ __device__ bool next(int i, Unit& u) const {
        const long L = (long)i * G + c; if (L >= nwg) return false;
        int wgid = (int)L; { const int q = nwg / NXCD, r = nwg % NXCD, xcd = wgid % NXCD, off = wgid / NXCD; wgid = (xcd < r ? xcd * (q + 1) : r * (q + 1) + (xcd - r) * q) + off; }
        const int nig = WGM * nN, gid = wgid / nig, fm = gid * WGM, gsz = (nM - fm) < WGM ? (nM - fm) : WGM;
        u.pm = fm + ((wgid % nig) % gsz); u.pn = (wgid % nig) / gsz; return true;
    }
    __device__ __forceinline__ void a_ready(const Unit&) const {}
    __device__ __forceinline__ void done(const Unit&) const {}
};
__device__ __forceinline__ unsigned cvt_pk_bf16(float lo, float hi) { unsigned r; asm volatile("v_cvt_pk_bf16_f32 %0, %1, %2" : "=v"(r) : "v"(lo), "v"(hi)); return r; }

typedef int i32x4 __attribute__((ext_vector_type(4)));
template <bool I8>
__device__ __forceinline__ f32x4 mma16(const bf16x8 b, const bf16x8 a, const f32x4 c) {
    if constexpr (I8) return __builtin_bit_cast(f32x4, __builtin_amdgcn_mfma_i32_16x16x64_i8(__builtin_bit_cast(i32x4, b), __builtin_bit_cast(i32x4, a), __builtin_bit_cast(i32x4, c), 0, 0, 0));
    else return __builtin_amdgcn_mfma_f32_16x16x32_bf16(b, a, c, 0, 0, 0);
}
template <class Epi, class Sched, bool I8 = false>
__device__ __forceinline__ void gemm_phase(PG8_LAS unsigned char* lds, const Gemm g, const Sched& S, const Epi& E) {
    int tid_ = threadIdx.x; asm volatile("" : "+v"(tid_));
    const int tid = tid_, wid = __builtin_amdgcn_readfirstlane(tid >> 6), lane = tid & 63, wr = wid >> 2, wc = wid & 3, fr = lane & 15, fq = lane >> 4;
    const int K = g.K, nt = K / BK;
    unsigned voffA[2], voffB[2];
#pragma unroll
    for (int i = 0; i < 2; ++i) { int R, C; stage_rc(tid * 16 + i * 8192, R, C); const int Rb = Epi::PERM ? ((R & ~31) + perm32(R & 31)) : R;
        voffA[i] = (unsigned)(R * K + C) * 2u; voffB[i] = (unsigned)(Rb * K + C) * 2u; }
    const size_t kstep = (size_t)(BK * 2);
    const size_t hstep = (size_t)HALF * K * 2;
    const size_t tstep = 2 * hstep;
    const unsigned ldsw = (unsigned)wid * 1024u;
    const int aoff = lds_byte(wr * 64 + fr, fq * 8), boff = lds_byte(wc * 32 + fr, fq * 8);
#define PG8_SA(b, h) (((b) * 2 + (h)) * HTB)
#define PG8_SB(b, h) ((4 + (b) * 2 + (h)) * HTB)
#define PG8_STAGE(bufoff, gbase, voff) do { _Pragma("unroll") for (int _i = 0; _i < 2; ++_i) \
        __builtin_amdgcn_global_load_lds((const unsigned*)((const char*)(gbase) + (voff)[_i]), (PG8_LAS unsigned*)(lds + (bufoff) + ldsw + _i * 8192), 16, 0, 0); } while (0)
#define PG8_LDA(dst, b, h) do { _Pragma("unroll") for (int m = 0; m < 4; ++m) _Pragma("unroll") for (int k = 0; k < 2; ++k) dst[m][k] = *(const PG8_LAS bf16x8*)(lds + PG8_SA(b, h) + aoff + m * 2048 + k * 1024); } while (0)
#define PG8_LDB(dst, b, h) do { _Pragma("unroll") for (int n = 0; n < 2; ++n) _Pragma("unroll") for (int k = 0; k < 2; ++k) dst[n][k] = *(const PG8_LAS bf16x8*)(lds + PG8_SB(b, h) + boff + n * 2048 + k * 1024); } while (0)
#define PG8_MMA(ai, bj, At, Bt) do { __builtin_amdgcn_s_setprio(1); _Pragma("unroll") for (int m = 0; m < 4; ++m) _Pragma("unroll") for (int n = 0; n < 2; ++n) _Pragma("unroll") for (int k = 0; k < 2; ++k) \
        acc[ai][bj][m][n] = mma16<I8>(Bt[n][k], At[m][k], acc[ai][bj][m][n]); __builtin_amdgcn_s_setprio(0); } while (0)
#define PG8_WAIT_V(n) asm volatile("s_waitcnt vmcnt(" #n ")" ::: "memory")
#define PG8_WAIT_L(n) asm volatile("s_waitcnt lgkmcnt(" #n ")" ::: "memory")
#define PG8_BAR __builtin_amdgcn_s_barrier()
#define PG8_SCHED __builtin_amdgcn_sched_barrier(0)
    Unit cur, nxt; int ui = 0;
    if (!S.next(0, cur)) return;
    f32x4 acc[2][2][4][2];
#pragma unroll
    for (int a = 0; a < 2; ++a)
#pragma unroll
        for (int b = 0; b < 2; ++b)
#pragma unroll
            for (int m = 0; m < 4; ++m)
#pragma unroll
                for (int n = 0; n < 2; ++n) acc[a][b][m][n] = (f32x4){0.f, 0.f, 0.f, 0.f};
    bf16x8 At[4][2], B0[2][2], B1[2][2];
    const char* cA = (const char*)g.A + (size_t)cur.pm * tstep; const char* cB = (const char*)g.Bt + (size_t)cur.pn * tstep;
    S.a_ready(cur);
    PG8_STAGE(PG8_SB(0, 0), cB, voffB); PG8_STAGE(PG8_SA(0, 0), cA, voffA); PG8_STAGE(PG8_SB(0, 1), cB + hstep, voffB); PG8_STAGE(PG8_SA(0, 1), cA + hstep, voffA);
    if (wr == 1) PG8_BAR;
    PG8_WAIT_V(4); PG8_BAR;
    PG8_STAGE(PG8_SB(1, 0), cB + kstep, voffB); PG8_STAGE(PG8_SA(1, 0), cA + kstep, voffA); PG8_STAGE(PG8_SB(1, 1), cB + hstep + kstep, voffB);
    PG8_WAIT_V(6); PG8_BAR;
    for (;;) {
        const bool has_next = S.next(ui + 1, nxt);
        const char* nA = has_next ? (const char*)g.A + (size_t)nxt.pm * tstep : cA; const char* nB = has_next ? (const char*)g.Bt + (size_t)nxt.pn * tstep : cB;
        for (int t = 0; t < nt; t += 2) {
            const bool last = (t == nt - 2);
            const char* a1 = cA + (size_t)(t + 1) * kstep;
            const char* a2 = last ? nA : cA + (size_t)(t + 2) * kstep; const char* b2 = last ? nB : cB + (size_t)(t + 2) * kstep;
            const char* a3 = a2 + kstep; const char* b3 = b2 + kstep;
            if (last && has_next) S.a_ready(nxt);
            PG8_LDB(B0, 0, 0); PG8_SCHED; PG8_LDA(At, 0, 0); PG8_STAGE(PG8_SA(1, 1), a1 + hstep, voffA);
            PG8_WAIT_L(8); PG8_BAR; PG8_WAIT_L(0); PG8_MMA(0, 0, At, B0); PG8_BAR; PG8_SCHED;
            PG8_LDB(B1, 0, 1); PG8_STAGE(PG8_SB(0, 0), b2, voffB);
            PG8_BAR; PG8_WAIT_L(0); PG8_MMA(0, 1, At, B1); PG8_BAR;
            PG8_LDA(At, 0, 1); PG8_STAGE(PG8_SA(0, 0), a2, voffA);
            PG8_BAR; PG8_WAIT_L(0); PG8_MMA(1, 0, At, B0); PG8_BAR; PG8_SCHED;
            PG8_STAGE(PG8_SB(0, 1), b2 + hstep, voffB);
            PG8_WAIT_V(6); PG8_BAR; PG8_MMA(1, 1, At, B1); PG8_BAR;
            PG8_LDB(B0, 1, 0); PG8_SCHED; PG8_LDA(At, 1, 0); PG8_STAGE(PG8_SA(0, 1), a2 + hstep, voffA);
            PG8_WAIT_L(8); PG8_BAR; PG8_WAIT_L(0); PG8_MMA(0, 0, At, B0); PG8_BAR; PG8_SCHED;
            PG8_LDB(B1, 1, 1); PG8_STAGE(PG8_SB(1, 0), b3, voffB);
            PG8_BAR; PG8_WAIT_L(0); PG8_MMA(0, 1, At, B1); PG8_BAR;
            PG8_LDA(At, 1, 1); PG8_STAGE(PG8_SA(1, 0), a3, voffA);
            PG8_BAR; PG8_WAIT_L(0); PG8_MMA(1, 0, At, B0); PG8_BAR; PG8_SCHED;
            PG8_STAGE(PG8_SB(1, 1), b3 + hstep, voffB);
            PG8_WAIT_V(6); PG8_BAR; PG8_MMA(1, 1, At, B1); PG8_BAR;
        }
        if constexpr (!Epi::AFTER_DRAIN) { E(acc, cur, wr, wc, fr, fq); S.done(cur); }
        if (!has_next) break;
#pragma unroll
        for (int a = 0; a < 2; ++a)
#pragma unroll
            for (int b = 0; b < 2; ++b)
#pragma unroll
                for (int m = 0; m < 4; ++m)
#pragma unroll
                    for (int n = 0; n < 2; ++n) acc[a][b][m][n] = (f32x4){0.f, 0.f, 0.f, 0.f};
        cur = nxt; cA = nA; cB = nB; ++ui;
    }
    PG8_WAIT_V(0);
    if (wr == 0) PG8_BAR;
    PG8_BAR;
    if constexpr (Epi::AFTER_DRAIN) { E.fused(acc, cur, wr, wc, fr, fq, lds, wid, lane); S.done(cur); }
#undef PG8_SA
#undef PG8_SB
#undef PG8_STAGE
#undef PG8_LDA
#undef PG8_LDB
#undef PG8_MMA
#undef PG8_WAIT_V
#undef PG8_WAIT_L
#undef PG8_BAR
#undef PG8_SCHED
}
}

__host__ __device__ __forceinline__ int cmap_in(int F) { return (F & ~255) + 128 * ((F >> 5) & 1) + 32 * ((F >> 6) & 3) + (F & 31); }
struct EpiInprojMF {
    static constexpr bool PERM = true, AFTER_DRAIN = false;
    bf16_t* P; const float* rinv; const float* bias_f; const int* pos; const float* ftab; const float* qg; const float* kg; const float* swf;
    __device__ __forceinline__ void operator()(pg8::f32x4 (&acc)[2][2][4][2], const pg8::Unit& u, int wr, int wc, int fr, int fq) const {
        typedef pg8::f32x4 f32x4;
        asm volatile("" : "+v"(fr), "+v"(fq));
        const int type = u.pn >> 1, head = 4 * (u.pn & 1) + wc, fb = 256 * u.pn + 64 * wc;
        {
            f32x4 sw[2][2];
#pragma unroll
            for (int bj = 0; bj < 2; ++bj)
#pragma unroll
                for (int n = 0; n < 2; ++n) sw[bj][n] = *(const f32x4*)(swf + fb + 32 * bj + 8 * fq + 4 * n);
#pragma unroll
            for (int ai = 0; ai < 2; ++ai)
#pragma unroll
                for (int bj = 0; bj < 2; ++bj)
#pragma unroll
                    for (int m = 0; m < 4; ++m)
#pragma unroll
                        for (int n = 0; n < 2; ++n) {
                            const pg8::i32x4 iv = __builtin_bit_cast(pg8::i32x4, acc[ai][bj][m][n]);
                            f32x4 fv; fv[0] = (float)iv[0]; fv[1] = (float)iv[1]; fv[2] = (float)iv[2]; fv[3] = (float)iv[3];
                            acc[ai][bj][m][n] = fv * sw[bj][n];
                        }
        }
        const size_t PSZ = (size_t)T * 512;
        const int rslot = (type == 0) ? 0 : (type == 1) ? 1 : (type == 2) ? 5 : (type == 3) ? 2 : (type == 4) ? 3 : (type == 5) ? 4 : 6;
        bf16_t* rowmaj = P + (size_t)rslot * PSZ;
        const int t0 = u.pm * 256 + wr * 64 + fr;
        f32x4 bv[2][2], gv[2][2], fh[2], fl[2];
#pragma unroll
        for (int bj = 0; bj < 2; ++bj)
#pragma unroll
            for (int n = 0; n < 2; ++n) bv[bj][n] = *(const f32x4*)(bias_f + fb + 32 * bj + 8 * fq + 4 * n);
        if (type <= 1) {
#pragma unroll
            for (int n = 0; n < 2; ++n) { fh[n] = *(const f32x4*)(ftab + 8 * fq + 4 * n); fl[n] = *(const f32x4*)(ftab + 32 + 8 * fq + 4 * n); }
        } else if (type == 4 || type == 5) {
            const float* gsrc = (type == 4) ? qg : kg;
#pragma unroll
            for (int bj = 0; bj < 2; ++bj)
#pragma unroll
                for (int n = 0; n < 2; ++n) gv[bj][n] = *(const f32x4*)(gsrc + 32 * bj + 8 * fq + 4 * n);
        }
#pragma unroll
        for (int ai = 0; ai < 2; ++ai) {
            float rv[4], pf[4];
#pragma unroll
            for (int m = 0; m < 4; ++m) { rv[m] = rinv[t0 + ai * 128 + m * 16]; pf[m] = (float)pos[t0 + ai * 128 + m * 16]; }
            asm volatile("" : "+v"(rv[0]), "+v"(rv[1]), "+v"(rv[2]), "+v"(rv[3]), "+v"(pf[0]), "+v"(pf[1]), "+v"(pf[2]), "+v"(pf[3]));
#pragma unroll
            for (int m = 0; m < 4; ++m) {
                const int t = t0 + ai * 128 + m * 16;
                const float r = rv[m];
                f32x4 v[2][2];
#pragma unroll
                for (int bj = 0; bj < 2; ++bj)
#pragma unroll
                    for (int n = 0; n < 2; ++n) v[bj][n] = acc[ai][bj][m][n] * r + bv[bj][n];
                if (type <= 1) {
                    const float sc = (type == 1) ? 0.125f : 1.f, pp = pf[m];
#pragma unroll
                    for (int n = 0; n < 2; ++n)
#pragma unroll
                        for (int j = 0; j < 4; ++j) {
                            const float rev = __builtin_amdgcn_fractf(__builtin_amdgcn_fractf(pp * fh[n][j]) + pp * fl[n][j]);
                            const float cs = __builtin_amdgcn_cosf(rev) * sc, sn = __builtin_amdgcn_sinf(rev) * sc;
                            const float x1 = v[0][n][j], x2 = v[1][n][j]; v[0][n][j] = x1 * cs - x2 * sn; v[1][n][j] = x2 * cs + x1 * sn;
                        }
                } else if (type == 3) {
#pragma unroll
                    for (int bj = 0; bj < 2; ++bj)
#pragma unroll
                        for (int n = 0; n < 2; ++n)
#pragma unroll
                            for (int j = 0; j < 4; ++j) { const float x = v[bj][n][j]; v[bj][n][j] = x / (1.f + __expf(-x)); }
                } else if (type == 4 || type == 5) {
                    float ss = 0.f;
#pragma unroll
                    for (int bj = 0; bj < 2; ++bj)
#pragma unroll
                        for (int n = 0; n < 2; ++n)
#pragma unroll
                            for (int j = 0; j < 4; ++j) ss += v[bj][n][j] * v[bj][n][j];
                    ss += __shfl_xor(ss, 16); ss += __shfl_xor(ss, 32);
                    const float rn = (1.0f / sqrtf(ss * (1.f / 64.f) + EPS)) * ((type == 4) ? 0.125f * 1.44269504089f : 1.f);
#pragma unroll
                    for (int bj = 0; bj < 2; ++bj)
#pragma unroll
                        for (int n = 0; n < 2; ++n) v[bj][n] = v[bj][n] * rn * gv[bj][n];
                }
#pragma unroll
                for (int bj = 0; bj < 2; ++bj) {
                    pg8::u32x4 w; w.x = pg8::cvt_pk_bf16(v[bj][0][0], v[bj][0][1]); w.y = pg8::cvt_pk_bf16(v[bj][0][2], v[bj][0][3]);
                    w.z = pg8::cvt_pk_bf16(v[bj][1][0], v[bj][1][1]); w.w = pg8::cvt_pk_bf16(v[bj][1][2], v[bj][1][3]);
                    *(pg8::u32x4*)(rowmaj + (size_t)t * 512 + head * 64 + 32 * bj + 8 * fq) = w;
                }
            }
        }
    }
};

struct EpiOutprojMF {
    static constexpr bool PERM = false, AFTER_DRAIN = true;
    const float* xf; const float* gate1; bf16_t* x1b; float* part2;
    float* pmax; unsigned char* x1q; float* rinv2q; unsigned* ctl;
    __device__ __forceinline__ void operator()(const pg8::f32x4 (&)[2][2][4][2], const pg8::Unit&, int, int, int, int) const {}
    __device__ __forceinline__ void fused(pg8::f32x4 (&acc)[2][2][4][2], const pg8::Unit& u, int wr, int wc, int fr, int fq, PG8_LAS unsigned char* lds, int wid, int lane) const {
        typedef pg8::f32x4 f32x4;
        asm volatile("" : "+v"(fr), "+v"(fq), "+v"(lane));
        constexpr int LD = 260;
        PG8_LAS float* TL = (PG8_LAS float*)lds;
        const int colw = wc * 32 + 4 * fq;
        f32x4 gv[2][2];
#pragma unroll
        for (int bj = 0; bj < 2; ++bj)
#pragma unroll
            for (int n = 0; n < 2; ++n) gv[bj][n] = *(const f32x4*)(gate1 + u.pn * 256 + colw + bj * 128 + n * 16);
        pg8::u32x2 ow[2][16];
#pragma unroll
        for (int ai = 0; ai < 2; ++ai) {
            f32x4 xv[16];
            const size_t rowbase = (size_t)(u.pm * 256 + ai * 128 + 16 * wid) * D + u.pn * 256 + 4 * lane;
#pragma unroll
            for (int r = 0; r < 16; ++r) xv[r] = __builtin_nontemporal_load((const f32x4*)(xf + rowbase + (size_t)r * D));
#pragma unroll
            for (int m = 0; m < 4; ++m)
#pragma unroll
                for (int bj = 0; bj < 2; ++bj)
#pragma unroll
                    for (int n = 0; n < 2; ++n) *(PG8_LAS f32x4*)(TL + (64 * wr + 16 * m + fr) * LD + colw + bj * 128 + n * 16) = gv[bj][n] * acc[ai][bj][m][n];
            __syncthreads();
            float ssr[16], amr[16];
#pragma unroll
            for (int r = 0; r < 16; ++r) {
                const f32x4 g = *(PG8_LAS f32x4*)(TL + (16 * wid + r) * LD + 4 * lane);
                const f32x4 o = xv[r] + g;
                pg8::u32x2 w; w.x = pg8::cvt_pk_bf16(o[0], o[1]); w.y = pg8::cvt_pk_bf16(o[2], o[3]);
                *(pg8::u32x2*)(x1b + rowbase + (size_t)r * D) = w;
                ow[ai][r] = w;
                ssr[r] = o[0] * o[0] + o[1] * o[1] + o[2] * o[2] + o[3] * o[3];
                amr[r] = fmaxf(fmaxf(__uint_as_float((w.x << 16) & 0x7fffffffu), __uint_as_float(w.x & 0x7fff0000u)), fmaxf(__uint_as_float((w.y << 16) & 0x7fffffffu), __uint_as_float(w.y & 0x7fff0000u)));
            }
            {
                const bool b5 = lane & 32, b4 = lane & 16, b3 = lane & 8, b2 = lane & 4;
                float w8[8], w4[4], w2[2], w1;
#pragma unroll
                for (int i = 0; i < 8; ++i) w8[i] = (b5 ? ssr[8 + i] : ssr[i]) + __shfl_xor(b5 ? ssr[i] : ssr[8 + i], 32);
#pragma unroll
                for (int i = 0; i < 4; ++i) w4[i] = (b4 ? w8[4 + i] : w8[i]) + __shfl_xor(b4 ? w8[i] : w8[4 + i], 16);
#pragma unroll
                for (int i = 0; i < 2; ++i) w2[i] = (b3 ? w4[2 + i] : w4[i]) + __shfl_xor(b3 ? w4[i] : w4[2 + i], 8);
                w1 = (b2 ? w2[1] : w2[0]) + __shfl_xor(b2 ? w2[0] : w2[1], 4);
                w1 += __shfl_xor(w1, 2); w1 += __shfl_xor(w1, 1);
                part2[(size_t)(u.pm * 256 + ai * 128 + 16 * wid + (lane >> 2)) * 16 + u.pn * 4 + (lane & 3)] = ((lane & 3) == 0) ? w1 : 0.f;
#pragma unroll
                for (int i = 0; i < 8; ++i) w8[i] = fmaxf(b5 ? amr[8 + i] : amr[i], __shfl_xor(b5 ? amr[i] : amr[8 + i], 32));
#pragma unroll
                for (int i = 0; i < 4; ++i) w4[i] = fmaxf(b4 ? w8[4 + i] : w8[i], __shfl_xor(b4 ? w8[i] : w8[4 + i], 16));
#pragma unroll
                for (int i = 0; i < 2; ++i) w2[i] = fmaxf(b3 ? w4[2 + i] : w4[i], __shfl_xor(b3 ? w4[i] : w4[2 + i], 8));
                w1 = fmaxf(b2 ? w2[1] : w2[0], __shfl_xor(b2 ? w2[0] : w2[1], 4));
                w1 = fmaxf(w1, __shfl_xor(w1, 2)); w1 = fmaxf(w1, __shfl_xor(w1, 1));
                if ((lane & 3) == 0) pmax[(size_t)(u.pm * 256 + ai * 128 + 16 * wid + (lane >> 2)) * 4 + u.pn] = w1;
            }
            __syncthreads();
        }
        asm volatile("s_waitcnt vmcnt(0)" ::: "memory");
        __syncthreads();
        if (wid == 0 && lane == 0) {
            unsigned* c = ctl + CTL_CNT + 16 * u.pm;
            __builtin_amdgcn_fence(__ATOMIC_RELEASE, "agent");
            asm volatile("s_waitcnt vmcnt(0)" ::: "memory");
            (void)xb_add(c, 1u);
            XB_SPIN(xb_ld(c) < 4u, ctl);
            __builtin_amdgcn_fence(__ATOMIC_ACQUIRE, "agent");
        }
        __syncthreads();
        float qsl = 0.f;
        {
            const int row = u.pm * 256 + (lane >> 4 & 1) * 128 + 16 * wid + (lane & 15);
            const f32x4* pp = (const f32x4*)(part2 + (size_t)row * 16);
            const f32x4 p0 = pp[0], p1 = pp[1], p2 = pp[2], p3 = pp[3], pm4 = *(const f32x4*)(pmax + (size_t)row * 4);
            const float ssum = ((p0[0] + p0[1]) + (p0[2] + p0[3])) + ((p1[0] + p1[1]) + (p1[2] + p1[3])) + ((p2[0] + p2[1]) + (p2[2] + p2[3])) + ((p3[0] + p3[1]) + (p3[2] + p3[3]));
            const float am = fmaxf(fmaxf(pm4[0], pm4[1]), fmaxf(pm4[2], pm4[3]));
            qsl = (am > 0.f) ? 127.f / am : 0.f;
            if (u.pn == 0 && lane < 32) rinv2q[row] = (1.0f / sqrtf(ssum * (1.0f / D) + EPS)) * (am * (1.f / 127.f));
        }
#pragma unroll
        for (int ai = 0; ai < 2; ++ai)
#pragma unroll
            for (int r = 0; r < 16; ++r) {
                const float qs = __builtin_bit_cast(float, __builtin_amdgcn_readlane(__builtin_bit_cast(int, qsl), ai * 16 + r));
                const pg8::u32x2 w = ow[ai][r];
                const unsigned b0 = __float_as_uint(fmaf(__uint_as_float(w.x << 16), qs, 12582912.f)), b1 = __float_as_uint(fmaf(__uint_as_float(w.x & 0xffff0000u), qs, 12582912.f));
                const unsigned b2 = __float_as_uint(fmaf(__uint_as_float(w.y << 16), qs, 12582912.f)), b3 = __float_as_uint(fmaf(__uint_as_float(w.y & 0xffff0000u), qs, 12582912.f));
                *(unsigned*)(x1q + (size_t)(u.pm * 256 + ai * 128 + 16 * wid + r) * D + u.pn * 256 + 4 * lane) = (b0 & 255u) | ((b1 & 255u) << 8) | ((b2 & 255u) << 16) | (b3 << 24);
            }
    }
};

__device__ __forceinline__ unsigned pk2(float lo, float hi) { return (unsigned)f2bf(lo) | ((unsigned)f2bf(hi) << 16); }
template <bool FOLD, bool CMAP>
__device__ __forceinline__ void transpose_item(const float* W, int K, int N, bf16_t* WT, float* scr, int item, int lane, const float* sg, const float* sm) {
    const int nblk = N / 32, kb = item / nblk, nb = item % nblk, k0 = 64 * kb, n0 = 32 * nb;
    float4 v[8]; float f[8];
#pragma unroll
    for (int i = 0; i < 8; ++i) { const int kk = 8 * i + (lane >> 3); v[i] = *(const float4*)(W + (size_t)(k0 + kk) * N + n0 + 4 * (lane & 7));
        f[i] = FOLD ? sg[k0 + kk] * (1.f + sm[k0 + kk]) : 1.f; }
#pragma unroll
    for (int i = 0; i < 8; ++i) { const int kk = 8 * i + (lane >> 3); float* d = scr + kk * 33 + 4 * (lane & 7);
        d[0] = v[i].x * f[i]; d[1] = v[i].y * f[i]; d[2] = v[i].z * f[i]; d[3] = v[i].w * f[i]; }
    asm volatile("s_waitcnt lgkmcnt(0)" ::: "memory");
    const int c = lane & 7, r0 = CMAP ? cmap_in(n0) : n0;
#pragma unroll
    for (int j = 0; j < 4; ++j) { const int n = (lane >> 3) + 8 * j; const float* s = scr + (8 * c) * 33 + n;
        pg8::u32x4 o; o.x = pk2(s[0 * 33], s[1 * 33]); o.y = pk2(s[2 * 33], s[3 * 33]); o.z = pk2(s[4 * 33], s[5 * 33]); o.w = pk2(s[6 * 33], s[7 * 33]);
        *(pg8::u32x4*)(WT + (size_t)(r0 + n) * K + k0 + 8 * c) = o; }
    asm volatile("s_waitcnt lgkmcnt(0)" ::: "memory");
}
template <int NC4, class VF>
__device__ __forceinline__ void gemv_cols(unsigned char* lds, const VF vf, const float* W, const int N, const int u, float* dst, const float* add) {
    constexpr int RG = 512 / NC4;
    float (*red)[NC4 * 4] = (float (*)[NC4 * 4])lds;
    const int tid = threadIdx.x, c4 = tid % NC4, rg = tid / NC4;
    if (rg < RG) {
        float4 acc = {0.f, 0.f, 0.f, 0.f};
        for (int r = rg; r < 1024; r += RG) { const float s = vf(r); const float4 w = *(const float4*)(W + (size_t)r * N + u * NC4 * 4 + c4 * 4);
            acc.x += s * w.x; acc.y += s * w.y; acc.z += s * w.z; acc.w += s * w.w; }
        red[rg][c4 * 4 + 0] = acc.x; red[rg][c4 * 4 + 1] = acc.y; red[rg][c4 * 4 + 2] = acc.z; red[rg][c4 * 4 + 3] = acc.w;
    }
    __syncthreads();
    if (tid < NC4 * 4) { float s = 0.f; for (int i = 0; i < RG; ++i) s += red[i][tid]; dst[u * NC4 * 4 + tid] = s + (add ? add[u * NC4 * 4 + tid] : 0.f); }
    __syncthreads();
}
struct VfSilu { const float* c; __device__ __forceinline__ float operator()(int r) const { const float v = c[r]; return v / (1.f + expf(-v)); } };
struct VfVec { const float* v; __device__ __forceinline__ float operator()(int r) const { return v[r]; } };


typedef float f32x16 __attribute__((ext_vector_type(16)));
typedef pg8::bf16x8 bf16x8;
#define MFMA32(a, b, c) __builtin_amdgcn_mfma_f32_32x32x16_bf16((a), (b), (c), 0, 0, 0)
__device__ __forceinline__ bf16x8 pack_frag(const f32x16& v, int s) {
    pg8::u32x4 w;
    w.x = pg8::cvt_pk_bf16(v[8 * s + 0], v[8 * s + 1]); w.y = pg8::cvt_pk_bf16(v[8 * s + 2], v[8 * s + 3]);
    w.z = pg8::cvt_pk_bf16(v[8 * s + 4], v[8 * s + 5]); w.w = pg8::cvt_pk_bf16(v[8 * s + 6], v[8 * s + 7]);
    return __builtin_bit_cast(bf16x8, w);
}
__device__ __forceinline__ bf16x8 load_tfrag(const bf16_t* rowp, int tok) {
    const uint2 a = *(const uint2*)(rowp + tok), b = *(const uint2*)(rowp + tok + 8);
    pg8::u32x4 w; w.x = a.x; w.y = a.y; w.z = b.x; w.w = b.y;
    return __builtin_bit_cast(bf16x8, w);
}


__device__ __forceinline__ bf16x8 tr_frag(const unsigned char* a0, int rows2) {
    typedef short s16x4 __attribute__((ext_vector_type(4)));
    typedef __attribute__((address_space(3))) s16x4 lds_s16x4;
    const s16x4 lo = __builtin_amdgcn_ds_read_tr16_b64_v4i16((lds_s16x4*)a0);
    const s16x4 hi = __builtin_amdgcn_ds_read_tr16_b64_v4i16((lds_s16x4*)(a0 + rows2 * 144));
    const uint2 l2 = __builtin_bit_cast(uint2, lo), h2 = __builtin_bit_cast(uint2, hi);
    pg8::u32x4 fw; fw.x = l2.x; fw.y = l2.y; fw.z = h2.x; fw.w = h2.y;
    return __builtin_bit_cast(bf16x8, fw);
}

__device__ __forceinline__ void ins16(float (&s)[16], float x) {
#pragma unroll
    for (int i = 15; i >= 1; --i) s[i] = __builtin_amdgcn_fmed3f(s[i - 1], s[i], x);
    s[0] = fmaxf(s[0], x);
}


struct OneUnitOrder {
    pg8::StaticOrder base; int round;
    __device__ __forceinline__ bool next(int i, pg8::Unit& u) const { if (i != 0) return false; return base.next(round, u); }
    __device__ __forceinline__ void a_ready(const pg8::Unit&) const {}
    __device__ __forceinline__ void done(const pg8::Unit&) const {}
};
struct EpiTopkMF {
    static constexpr bool PERM = false, AFTER_DRAIN = true;
    const float* rinv2q; const float* sq; const float* bias_q; unsigned short* ids; float* gates;
    __device__ __forceinline__ void operator()(const pg8::f32x4 (&)[2][2][4][2], const pg8::Unit&, int, int, int, int) const {}
    __device__ __forceinline__ void fused(pg8::f32x4 (&acc)[2][2][4][2], const pg8::Unit& u, int wr, int wc, int fr, int fq, PG8_LAS unsigned char* lds, int wid, int lane) const {
        typedef pg8::f32x4 f32x4;
        constexpr int SLD = 260;
        PG8_LAS float* SC = (PG8_LAS float*)lds; PG8_LAS float* MG = (PG8_LAS float*)(lds + 128 * SLD * 4);
        const int tid = wid * 64 + lane, tok = tid & 255, hk = tid >> 8;
        float rinv[2][4];
#pragma unroll
        for (int ai = 0; ai < 2; ++ai)
#pragma unroll
            for (int m = 0; m < 4; ++m) {
                const int row = u.pm * 256 + ai * 128 + wr * 64 + m * 16 + fr;
                rinv[ai][m] = rinv2q[row];
            }
        float sl[16], mine[16];
#pragma unroll
        for (int p = 0; p < 2; ++p) {
            f32x4 bv[2], sv[2];
#pragma unroll
            for (int n = 0; n < 2; ++n) { bv[n] = *(const f32x4*)(bias_q + u.pn * 256 + p * 128 + wc * 32 + n * 16 + 4 * fq); sv[n] = *(const f32x4*)(sq + u.pn * 256 + p * 128 + wc * 32 + n * 16 + 4 * fq); }
#pragma unroll
            for (int ai = 0; ai < 2; ++ai)
#pragma unroll
                for (int m = 0; m < 4; ++m)
#pragma unroll
                    for (int n = 0; n < 2; ++n)
#pragma unroll
                        for (int j = 0; j < 4; ++j)
                            SC[(32 * wc + 16 * n + 4 * fq + j) * SLD + (128 * ai + 64 * wr + 16 * m + fr)] = (float)__builtin_bit_cast(pg8::i32x4, acc[ai][p][m][n])[j] * (rinv[ai][m] * sv[n][j]) + bv[n][j];
            __syncthreads();
#pragma unroll
            for (int i = 0; i < 16; ++i) sl[i] = -INFINITY;
#pragma unroll 8
            for (int k = 0; k < 64; ++k) { const int key = 64 * hk + k; const float x = SC[key * SLD + tok]; ins16(sl, __uint_as_float((__float_as_uint(x) & 0xFFFFFF80u) | (unsigned)key)); }
            if (hk != p) {
#pragma unroll
                for (int i = 0; i < 16; ++i) MG[i * 256 + tok] = sl[i];
            }
            __syncthreads();
            if (hk == p) {
#pragma unroll
                for (int i = 0; i < 16; ++i) ins16(sl, MG[i * 256 + tok]);
#pragma unroll
                for (int i = 0; i < 16; ++i) mine[i] = sl[i];
            }
            __syncthreads();
        }
        PG8_LAS float* X1 = SC; PG8_LAS float* TL = SC + 4096; PG8_LAS unsigned* I0 = (PG8_LAS unsigned*)(SC + 8192); PG8_LAS unsigned* I1 = (PG8_LAS unsigned*)(SC + 12288);
        if (hk) {
#pragma unroll
            for (int i = 0; i < 16; ++i) { X1[i * 256 + tok] = mine[i]; I1[i * 256 + tok] = __float_as_uint(mine[i]) & 0x7Fu; }
        } else {
#pragma unroll
            for (int i = 0; i < 16; ++i) I0[i * 256 + tok] = __float_as_uint(mine[i]) & 0x7Fu;
        }
        __syncthreads();
        if (!hk) {
            float s1m[16], tl[16];
#pragma unroll
            for (int i = 0; i < 16; ++i) { s1m[i] = __uint_as_float(__float_as_uint(X1[i * 256 + tok]) & 0xFFFFFF80u); mine[i] = __uint_as_float(__float_as_uint(mine[i]) & 0xFFFFFF80u); tl[i] = -INFINITY; }
#pragma unroll
            for (int a2 = 0; a2 < 16; ++a2)
#pragma unroll
                for (int b2 = 0; b2 < 16; ++b2)
                    if ((a2 + 1) * (b2 + 1) <= 16) ins16(tl, __uint_as_float((__float_as_uint(mine[a2] + s1m[b2]) & 0xFFFFFF00u) | (unsigned)(a2 * 16 + b2)));
#pragma unroll
            for (int i = 0; i < 16; ++i) TL[i * 256 + tok] = tl[i];
        }
        __syncthreads();
        if (hk) {
            float ev[16]; float sum = 0.f; unsigned cd[16];
#pragma unroll
            for (int j = 0; j < 16; ++j) { const unsigned bits = __float_as_uint(TL[j * 256 + tok]); cd[j] = bits & 0xFFu; ev[j] = __uint_as_float(bits & 0xFFFFFF00u); }
            const float mx = ev[0];
#pragma unroll
            for (int j = 0; j < 16; ++j) { ev[j] = __expf(ev[j] - mx); sum += ev[j]; }
            const float inv = 1.f / sum;
            unsigned idw[8];
#pragma unroll
            for (int j = 0; j < 16; ++j) {
                const unsigned id = I0[(cd[j] >> 4) * 256 + tok] * 128u + I1[(cd[j] & 15u) * 256 + tok];
                if (j & 1) idw[j >> 1] |= id << 16; else idw[j >> 1] = id;
                ev[j] *= inv;
            }
            const size_t t = (size_t)u.pm * 256 + tok;
            unsigned short* idp = ids + t * 128 + u.pn * 16; float* gp = gates + t * 128 + u.pn * 16;
            *(uint4*)idp = make_uint4(idw[0], idw[1], idw[2], idw[3]); *(uint4*)(idp + 8) = make_uint4(idw[4], idw[5], idw[6], idw[7]);
#pragma unroll
            for (int q = 0; q < 4; ++q) *(float4*)(gp + 4 * q) = make_float4(ev[4 * q], ev[4 * q + 1], ev[4 * q + 2], ev[4 * q + 3]);
        }
        __syncthreads();
    }
};


__device__ __forceinline__ void convert_tables(const float* down, const float* up, unsigned char* q8, bf16_t* dsc, int lane, int cw, int nconv, int r0, int r1) {
    for (int row0 = r0 + cw * 2; row0 < r1; row0 += nconv * 2) {
        float4 v[2][4];
#pragma unroll
        for (int rr = 0; rr < 2; ++rr) {
            const int row = row0 + rr, isup = row >> 14, e = row & 16383;
            const float* sp = (isup ? up : down) + (size_t)e * 1024 + lane * 4;
#pragma unroll
            for (int q = 0; q < 4; ++q) v[rr][q] = ld_nt4(sp + 256 * q);
        }
#pragma unroll
        for (int rr = 0; rr < 2; ++rr) {
            const int row = row0 + rr, isup = row >> 14, e = row & 16383;
            {
                float ss = 0.f;
#pragma unroll
                for (int q = 0; q < 4; ++q) ss += v[rr][q].x * v[rr][q].x + v[rr][q].y * v[rr][q].y + v[rr][q].z * v[rr][q].z + v[rr][q].w * v[rr][q].w;
#pragma unroll
                for (int o = 32; o > 0; o >>= 1) ss += __shfl_xor(ss, o);
                const float sigma = sqrtf(ss * (1.0f / 1024.0f));
                const float s = (sigma > 0.f) ? 7.5f / (2.6f * sigma) : 1.f;
#pragma unroll
                for (int q = 0; q < 4; ++q) {
                    const int n0 = (int)fminf(fmaxf(__builtin_rintf(v[rr][q].x * s), -8.f), 7.f) + 8, n1 = (int)fminf(fmaxf(__builtin_rintf(v[rr][q].y * s), -8.f), 7.f) + 8;
                    const int n2 = (int)fminf(fmaxf(__builtin_rintf(v[rr][q].z * s), -8.f), 7.f) + 8, n3 = (int)fminf(fmaxf(__builtin_rintf(v[rr][q].w * s), -8.f), 7.f) + 8;
                    const int h1 = isup ? ((n1 - 8) & 15) : n1, h3 = isup ? ((n3 - 8) & 15) : n3;
                    *(unsigned short*)(q8 + (size_t)isup * (8u << 20) + ((size_t)q * 16384 + e) * 128 + (lane & 7) * 16 + (lane >> 3) * 2) = (unsigned short)(n0 | (h1 << 4) | (n2 << 8) | (h3 << 12));
                }
                if (lane == 0) dsc[row] = f2bf(1.0f / s);
            }
        }
    }
}

struct Params {
    const float *x, *c; const int* pos; const float *ada_w, *ada_b, *g1, *g2, *w_in, *rgain, *qg, *kg, *og, *w_out, *wq, *sk, *down, *up;
    float* out; unsigned char* ws; RopeC rc;
};

__global__ void __launch_bounds__(512) mk_fwd(Params p) {
    extern __shared__ __attribute__((aligned(16))) unsigned char lds[];
    const int tid = threadIdx.x, lane = tid & 63, bid = blockIdx.x, G = gridDim.x; int wave = tid >> 6;
    unsigned char* ws = p.ws;
    float* mod = (float*)(ws + OFF_MOD); float* rinv1 = (float*)(ws + OFF_RINV1); float* ftab = (float*)(ws + OFF_ROPE);
    bf16_t* P = (bf16_t*)(ws + OFF_P); float* kv = (float*)(ws + OFF_KV); bf16_t* stT = (bf16_t*)(ws + OFF_ST); bf16_t* ycat = (bf16_t*)(ws + OFF_YCAT);
    bf16_t* Win_t = (bf16_t*)(ws + OFF_WINT); float* bias_f = (float*)(ws + OFF_BIASF);
    unsigned char* xq = ws + OFF_XQ; float* swf = (float*)(ws + OFF_SWF);
    float* sq = (float*)(ws + OFF_SQ); float* pmax = (float*)(ws + OFF_PMAX); float* rinv2q = (float*)(ws + OFF_RINV2Q); unsigned char* Weffq_t = ws + OFF_WEFFQ; unsigned char* x1q = ws + OFF_X1Q;
    unsigned* ctl = (unsigned*)(ws + OFF_CTL);
    bf16_t* Weff_t = (bf16_t*)(ws + OFF_WEFFT); bf16_t* Wout_t = (bf16_t*)(ws + OFF_WOUTT); float* bias_q = (float*)(ws + OFF_BIASQ); float* bq_part = (float*)(ws + OFF_BQPART);
    float* part2 = (float*)(ws + OFF_PART2); bf16_t* x1b = (bf16_t*)(ws + OFF_X1B); unsigned short* ids = (unsigned short*)(ws + OFF_IDS); unsigned char* q8 = ws + OFF_Q8; bf16_t* dsc = (bf16_t*)(ws + OFF_DSC); float* gates = (float*)(ws + OFF_GATES);
    const size_t PS = (size_t)T * 512;
    const bf16_t *Qr = P, *Kr = P + PS, *Gr = P + 2 * PS, *Qs = P + 3 * PS, *Ks = P + 4 * PS, *Vr = P + 5 * PS, *Vs = P + 6 * PS;
    float* out = p.out;

    if (tid < 4) ((LAS unsigned*)((LAS unsigned char*)lds + LDS_ST_OFF))[tid] = 0u;
    __syncthreads();
    XcdBarrier bar = xcd_barrier_post((unsigned*)(ws + OFF_CTL), (volatile LAS unsigned*)((LAS unsigned char*)lds + LDS_ST_OFF));

    for (int u = bid; u < 256; u += G) gemv_cols<6>(lds, VfSilu{p.c}, p.ada_w, 6144, u, mod, p.ada_b);
    for (int row0 = (bid * 8 + wave) * 2; row0 < T; row0 += G * 16) {
        float4 v[2][4];
#pragma unroll
        for (int rr = 0; rr < 2; ++rr)
#pragma unroll
            for (int j = 0; j < 4; ++j) v[rr][j] = ld_nt4(p.x + (size_t)(row0 + rr) * D + (lane + 64 * j) * 4);
#pragma unroll
        for (int rr = 0; rr < 2; ++rr) {
            float s = 0.f, am = 0.f;
#pragma unroll
            for (int j = 0; j < 4; ++j) { const float4 q = v[rr][j]; s += q.x * q.x + q.y * q.y + q.z * q.z + q.w * q.w;
                am = fmaxf(fmaxf(am, fmaxf(fabsf(q.x), fabsf(q.y))), fmaxf(fabsf(q.z), fabsf(q.w))); }
#pragma unroll
            for (int o = 32; o > 0; o >>= 1) { s += __shfl_xor(s, o); am = fmaxf(am, __shfl_xor(am, o)); }
            const float qs = (am > 0.f) ? 127.f / am : 0.f;
            unsigned* xqo = (unsigned*)(xq + (size_t)(row0 + rr) * D);
#pragma unroll
            for (int j = 0; j < 4; ++j) { const float4 q = v[rr][j];
                const unsigned b0 = __float_as_uint(fmaf(q.x, qs, 12582912.f)), b1 = __float_as_uint(fmaf(q.y, qs, 12582912.f)), b2 = __float_as_uint(fmaf(q.z, qs, 12582912.f)), b3 = __float_as_uint(fmaf(q.w, qs, 12582912.f));
                xqo[lane + 64 * j] = (b0 & 255u) | ((b1 & 255u) << 8) | ((b2 & 255u) << 16) | (b3 << 24); }
            if (lane == 0) rinv1[row0 + rr] = (1.0f / sqrtf(s * (1.0f / D) + EPS)) * (am * (1.f / 127.f));
        }
    }
    if (bid == 0 && tid == 0) {
#pragma unroll
        for (int i = 0; i < 32; ++i) { ftab[i] = p.rc.fh[i]; ftab[32 + i] = p.rc.fl[i]; }
    }
    xcd_barrier(bar);

    {
        for (int nb = bid; nb < 112; nb += G) {
            const int n0 = 32 * nb, r8 = lane >> 3, c = lane & 7, kw = 128 * wave;
            float* cm = (float*)(lds + 8 * 4608);
            unsigned* tl = (unsigned*)(lds + wave * 4608);
            float4 v[16];
#pragma unroll
            for (int i = 0; i < 16; ++i) { const int kk = 32 * (i >> 2) + 4 * r8 + (i & 3); v[i] = *(const float4*)(p.w_in + (size_t)(kw + kk) * 3584 + n0 + 4 * c); }
            float4 mx = {0.f, 0.f, 0.f, 0.f};
#pragma unroll
            for (int i = 0; i < 16; ++i) { const int kk = 32 * (i >> 2) + 4 * r8 + (i & 3); const float f = p.g1[kw + kk] * (1.f + mod[1024 + kw + kk]);
                v[i].x *= f; v[i].y *= f; v[i].z *= f; v[i].w *= f;
                mx.x = fmaxf(mx.x, fabsf(v[i].x)); mx.y = fmaxf(mx.y, fabsf(v[i].y)); mx.z = fmaxf(mx.z, fabsf(v[i].z)); mx.w = fmaxf(mx.w, fabsf(v[i].w)); }
#pragma unroll
            for (int o = 8; o < 64; o <<= 1) { mx.x = fmaxf(mx.x, __shfl_xor(mx.x, o)); mx.y = fmaxf(mx.y, __shfl_xor(mx.y, o)); mx.z = fmaxf(mx.z, __shfl_xor(mx.z, o)); mx.w = fmaxf(mx.w, __shfl_xor(mx.w, o)); }
            if (lane < 8) *(float4*)(cm + wave * 32 + 4 * c) = mx;
            __syncthreads();
#pragma unroll
            for (int w2 = 0; w2 < 8; ++w2) { const float4 o = *(const float4*)(cm + w2 * 32 + 4 * c); mx.x = fmaxf(mx.x, o.x); mx.y = fmaxf(mx.y, o.y); mx.z = fmaxf(mx.z, o.z); mx.w = fmaxf(mx.w, o.w); }
            if (wave == 0 && lane < 8) *(float4*)(swf + n0 + 4 * c) = make_float4(mx.x * (1.f / 127.f), mx.y * (1.f / 127.f), mx.z * (1.f / 127.f), mx.w * (1.f / 127.f));
            const float qx = (mx.x > 0.f) ? 127.f / mx.x : 0.f, qy = (mx.y > 0.f) ? 127.f / mx.y : 0.f, qz = (mx.z > 0.f) ? 127.f / mx.z : 0.f, qw = (mx.w > 0.f) ? 127.f / mx.w : 0.f;
#pragma unroll
            for (int a = 0; a < 4; ++a) {
                unsigned d[4];
#pragma unroll
                for (int j = 0; j < 4; ++j) {
                    const float qq = (j == 0) ? qx : (j == 1) ? qy : (j == 2) ? qz : qw;
                    unsigned w = 0;
#pragma unroll
                    for (int b = 0; b < 4; ++b) { const float4 t = v[4 * a + b]; const float e = (j == 0) ? t.x : (j == 1) ? t.y : (j == 2) ? t.z : t.w;
                        w |= (__float_as_uint(fmaf(e, qq, 12582912.f)) & 255u) << (8 * b); }
                    d[j] = w;
                }
#pragma unroll
                for (int j = 0; j < 4; ++j) tl[(4 * c + j) * 34 + 8 * a + r8] = d[j];
            }
            asm volatile("s_waitcnt lgkmcnt(0)" ::: "memory");
            const int rb = cmap_in(n0);
#pragma unroll
            for (int jj = 0; jj < 4; ++jj) { const int q = lane + 64 * jj, n = q >> 3, ch = q & 7;
                const uint2 lo = *(const uint2*)(tl + n * 34 + 4 * ch), hi = *(const uint2*)(tl + n * 34 + 4 * ch + 2);
                pg8::u32x4 o; o.x = lo.x; o.y = lo.y; o.z = hi.x; o.w = hi.y;
                *(pg8::u32x4*)((unsigned char*)Win_t + (size_t)(rb + n) * 1024 + kw + 16 * ch) = o; }
            __syncthreads();
        }
        for (int u = bid - 128; u >= 0 && u < 128; u += G) gemv_cols<7>(lds, VfVec{mod}, p.w_in, 3584, u, bias_f, nullptr);
    }
    xcd_barrier(bar);

    {
        pg8::Gemm g{(const bf16_t*)xq, Win_t, T, 3584, 512}; pg8::StaticOrder S; S.init(T, 3584, G, bid);
        EpiInprojMF E{P, rinv1, bias_f, p.pos, ftab, p.qg, p.kg, swf};
        pg8::gemm_phase<EpiInprojMF, pg8::StaticOrder, true>((PG8_LAS unsigned char*)lds, g, S, E);
        const int nidle = (G > 128) ? G - 128 : G, ib = (G > 128) ? bid - 128 : bid;
        {
            float* scr = (float*)(lds + wave * 16384);
            if (ib >= 0) for (int it = ib * 8 + wave; it < 16 * 32; it += nidle * 8) transpose_item<false, false>(p.w_out, 1024, 1024, Wout_t, scr, it, lane, nullptr, nullptr);
            __syncthreads();
        }
        if (ib >= 0) for (int wu = ib; wu < 256; wu += nidle) {
            const int hp = wu >> 4, blk = wu & 15, i0 = blk * 64;
            __syncthreads();
            unsigned char* Wt = lds; unsigned char* St = lds + 64 * 272; float* bred = (float*)(lds + 64 * 272 + 128 * 272);
            for (int e4 = tid; e4 < 2048; e4 += 512) { const int r = e4 >> 5, c4 = e4 & 31; const float4 v = *(const float4*)(p.wq + (size_t)(i0 + r) * 2048 + hp * 128 + 4 * c4);
                *(uint2*)(Wt + r * 272 + c4 * 8) = make_uint2(pk2(v.x, v.y), pk2(v.z, v.w)); }
            for (int e4 = tid; e4 < 4096; e4 += 512) { const int r = e4 >> 5, c4 = e4 & 31; const float4 v = *(const float4*)(p.sk + ((size_t)hp * 128 + r) * 128 + 4 * c4);
                *(uint2*)(St + r * 272 + c4 * 8) = make_uint2(pk2(v.x, v.y), pk2(v.z, v.w)); }
            __syncthreads();
            const int rt = wave >> 2, ct = wave & 3, l31 = lane & 31, hf = lane >> 5;
            f32x16 C;
#pragma unroll
            for (int r = 0; r < 16; ++r) C[r] = 0.f;
#pragma unroll
            for (int s8 = 0; s8 < 8; ++s8) C = MFMA32(*(const bf16x8*)(Wt + (32 * rt + l31) * 272 + (16 * s8 + 8 * hf) * 2), *(const bf16x8*)(St + (32 * ct + l31) * 272 + (16 * s8 + 8 * hf) * 2), C);
            float bsum = 0.f; unsigned amx = 0u;
            bf16_t* wcol = Weff_t + (size_t)(hp * 128 + 32 * ct + l31) * 1024 + i0 + 32 * rt + 4 * hf;
#pragma unroll
            for (int g4 = 0; g4 < 4; ++g4) {
                const int i = i0 + 32 * rt + 8 * g4 + 4 * hf;
                const float4 gg = *(const float4*)(p.g2 + i), sc = *(const float4*)(mod + 4096 + i), sh = *(const float4*)(mod + 3072 + i);
                const float c0 = C[4 * g4], c1 = C[4 * g4 + 1], c2 = C[4 * g4 + 2], c3 = C[4 * g4 + 3];
                bsum += sh.x * c0 + sh.y * c1 + sh.z * c2 + sh.w * c3;
                const uint2 wv = make_uint2(pk2(c0 * gg.x * (1.f + sc.x), c1 * gg.y * (1.f + sc.y)), pk2(c2 * gg.z * (1.f + sc.z), c3 * gg.w * (1.f + sc.w)));
                *(uint2*)(wcol + 8 * g4) = wv;
                amx = max(max(amx, (wv.x << 16) & 0x7fffffffu), max(wv.x & 0x7fff0000u, max((wv.y << 16) & 0x7fffffffu, wv.y & 0x7fff0000u)));
            }
            amx = max(amx, (unsigned)__shfl_xor((int)amx, 32));
            if (hf == 0) (void)__hip_atomic_fetch_max(ctl + CTL_CMAX + hp * 128 + 32 * ct + l31, amx, __ATOMIC_RELAXED, __HIP_MEMORY_SCOPE_AGENT);
            bsum += __shfl_xor(bsum, 32);
            if (hf == 0) bred[rt * 128 + 32 * ct + l31] = bsum;
            __syncthreads();
            if (tid < 128) bq_part[(size_t)blk * 2048 + hp * 128 + tid] = bred[tid] + bred[128 + tid];
        }
        __syncthreads();
        if (ib >= 0) convert_tables(p.down, p.up, q8, dsc, lane, ib * 8 + wave, nidle * 8, 0, CONV_SPLIT);
    }
    xcd_barrier(bar);
    wave = threadIdx.x >> 6; asm volatile("" : "+v"(wave));

    {
        const int gw = __builtin_amdgcn_readfirstlane(bid * 8 + wave), NGW = G * 8, l31 = lane & 31, hf = lane >> 5;
        const int wv0 = __builtin_amdgcn_readfirstlane(wave);
        for (int U = gw; U < 1024; U += NGW) {
            const int n = U >> 3, h = U & 7;
            f32x16 C[2][2];
#pragma unroll
            for (int a = 0; a < 2; ++a)
#pragma unroll
                for (int b = 0; b < 2; ++b)
#pragma unroll
                    for (int r = 0; r < 16; ++r) C[a][b][r] = 0.f;
            unsigned char* Kt = lds + wv0 * 9216; unsigned char* Vt = Kt + 4608;
            const int r8 = lane >> 3, pc = lane & 7, trq = (lane & 15) >> 2, trp = lane & 3, trd = (lane >> 4) & 1;
            const char* kbase = (const char*)(Kr + (size_t)n * 128 * 512 + h * 64); const char* vbase = (const char*)(Vr + (size_t)n * 128 * 512 + h * 64);
            const unsigned loff = (unsigned)(r8 * 512 + pc * 8) * 2u;
            const float lg = lg2_head(h);
            pg8::u32x4 gK[4], gV[4];
#pragma unroll
            for (int i = 0; i < 4; ++i) { gK[i] = *(const pg8::u32x4*)(kbase + (loff + i * 8192u)); gV[i] = *(const pg8::u32x4*)(vbase + (loff + i * 8192u)); }
            for (int sb4 = 0; sb4 < 4; ++sb4) {
#pragma unroll
                for (int i = 0; i < 4; ++i) { *(pg8::u32x4*)(Kt + (8 * i + r8) * 144 + pc * 16) = gK[i]; *(pg8::u32x4*)(Vt + (8 * i + r8) * 144 + pc * 16) = gV[i]; }
                { const int sn = (sb4 < 3) ? sb4 + 1 : sb4;
#pragma unroll
                  for (int i = 0; i < 4; ++i) { gK[i] = *(const pg8::u32x4*)(kbase + (size_t)sn * 32768 + (loff + i * 8192u)); gV[i] = *(const pg8::u32x4*)(vbase + (size_t)sn * 32768 + (loff + i * 8192u)); } }
#pragma unroll
                for (int s = 0; s < 2; ++s) {
                    bf16x8 Af[2], Bf[2];
#pragma unroll
                    for (int a = 0; a < 2; ++a) {
                        Af[a] = tr_frag(Vt + (16 * s + 8 * hf + trq) * 144 + (32 * a + 16 * trd + 4 * trp) * 2, 4);
                        const bf16x8 kraw = tr_frag(Kt + (16 * s + 8 * hf + trq) * 144 + (32 * a + 16 * trd + 4 * trp) * 2, 4);
                        const pg8::u32x4 kw = __builtin_bit_cast(pg8::u32x4, kraw); const unsigned kk[4] = {kw.x, kw.y, kw.z, kw.w};
                        pg8::u32x4 o; unsigned* op = (unsigned*)&o;
#pragma unroll
                        for (int e2 = 0; e2 < 4; ++e2) {
                            const int j0 = 32 * sb4 + 16 * s + 8 * hf + 2 * e2;
                            const float z0 = __builtin_amdgcn_exp2f((float)(127 - j0) * lg), z1 = __builtin_amdgcn_exp2f((float)(126 - j0) * lg);
                            op[e2] = pg8::cvt_pk_bf16(__uint_as_float(kk[e2] << 16) * z0, __uint_as_float(kk[e2] & 0xffff0000u) * z1);
                        }
                        Bf[a] = __builtin_bit_cast(bf16x8, o);
                    }
#pragma unroll
                    for (int a = 0; a < 2; ++a)
#pragma unroll
                        for (int b = 0; b < 2; ++b) C[a][b] = MFMA32(Af[a], Bf[b], C[a][b]);
                }
            }
            float* dst = kv + (size_t)(n * 8 + h) * 4096;
#pragma unroll
            for (int a = 0; a < 2; ++a)
#pragma unroll
                for (int b = 0; b < 2; ++b)
#pragma unroll
                    for (int r = 0; r < 16; ++r) dst[(32 * a + (r & 3) + 8 * (r >> 2) + 4 * hf) * 64 + 32 * b + l31] = C[a][b][r];
        }
        bf16x8 Tri[2];
        {
            pg8::u32x4 w0, w1; unsigned* p0 = (unsigned*)&w0; unsigned* p1 = (unsigned*)&w1;
#pragma unroll
            for (int e2 = 0; e2 < 4; ++e2) {
                unsigned a0 = 0, a1 = 0;
#pragma unroll
                for (int q = 0; q < 2; ++q) { const int e = 2 * e2 + q, ip = 8 * (e >> 2) + 4 * hf + (e & 3);
                    a0 |= ((ip > l31) ? 0x3F80u : 0u) << (16 * q); a1 |= ((16 + ip > l31) ? 0x3F80u : 0u) << (16 * q); }
                p0[e2] = a0; p1[e2] = a1;
            }
            Tri[0] = __builtin_bit_cast(bf16x8, w0); Tri[1] = __builtin_bit_cast(bf16x8, w1);
        }
        const bool sb_local = (G % 8 == 0) && (4096 % G == 0) && ((4096 / G) % 8 == 0);
        const int sb_per_wave = sb_local ? 4096 / G / 8 : (4096 + NGW - 1 - gw) / NGW;
        const int wv = __builtin_amdgcn_readfirstlane(wave);
        for (int ps = 0; ps < sb_per_wave; ++ps) {
            const int U = sb_local ? 0 : gw + ps * NGW;
            const int h = sb_local ? (bid & 7) : (U & 7), qt = sb_local ? (bid >> 3) * (4096 / G) + ps * 8 + wv : (U >> 3), q0 = qt * 32;
            f32x16 O[2];
#pragma unroll
            for (int r = 0; r < 16; ++r) { O[0][r] = 0.f; O[1][r] = 0.f; }
            float carry = 0.f;
            unsigned char* Kt = lds + wv * 9216; unsigned char* Vt = Kt + 4608;
            const int r8 = lane >> 3, pc = lane & 7;
            const char* kbase = (const char*)(Ks + h * 64); const char* vbase = (const char*)(Vs + h * 64);
            const unsigned loff = (unsigned)(r8 * 512 + pc * 8) * 2u;
            pg8::u32x4 gK[4], gV[4];
            bf16x8 Qf[4];
            {
                const char* qbase = (const char*)(Qs + h * 64);
#pragma unroll
                for (int i = 0; i < 4; ++i) gK[i] = *(const pg8::u32x4*)(qbase + (size_t)qt * 32768 + (loff + i * 8192u));
#pragma unroll
                for (int i = 0; i < 4; ++i) *(pg8::u32x4*)(Kt + (8 * i + r8) * 144 + pc * 16) = gK[i];
#pragma unroll
                for (int s = 0; s < 4; ++s) Qf[s] = *(const bf16x8*)(Kt + l31 * 144 + 32 * s + 16 * hf);
            }
#pragma unroll
            for (int i = 0; i < 4; ++i) { gK[i] = *(const pg8::u32x4*)(kbase + (size_t)qt * 32768 + (loff + i * 8192u)); gV[i] = *(const pg8::u32x4*)(vbase + (size_t)qt * 32768 + (loff + i * 8192u)); }
            const int trq = (lane & 15) >> 2, trp = lane & 3, trd = (lane >> 4) & 1;
            for (int kb = qt; kb >= 0; --kb) {
#pragma unroll
                for (int i = 0; i < 4; ++i) { *(pg8::u32x4*)(Kt + (8 * i + r8) * 144 + pc * 16) = gK[i]; *(pg8::u32x4*)(Vt + (8 * i + r8) * 144 + pc * 16) = gV[i]; }
                {
                    const int kbn = (kb > 0) ? kb - 1 : 0;
#pragma unroll
                    for (int i = 0; i < 4; ++i) { gK[i] = *(const pg8::u32x4*)(kbase + (size_t)kbn * 32768 + (loff + i * 8192u)); gV[i] = *(const pg8::u32x4*)(vbase + (size_t)kbn * 32768 + (loff + i * 8192u)); }
                }
                bf16x8 Kf[4], Vf[2][2];
#pragma unroll
                for (int s = 0; s < 4; ++s) Kf[s] = *(const bf16x8*)(Kt + l31 * 144 + 32 * s + 16 * hf);
#pragma unroll
                for (int s = 0; s < 2; ++s)
#pragma unroll
                    for (int dt = 0; dt < 2; ++dt) {
                        Vf[s][dt] = tr_frag(Vt + (16 * s + 4 * hf + trq) * 144 + (32 * dt + 16 * trd + 4 * trp) * 2, 8);
                    }
                f32x16 S;
#pragma unroll
                for (int r = 0; r < 16; ++r) S[r] = 0.f;
#pragma unroll
                for (int s = 0; s < 4; ++s) S = MFMA32(Kf[s], Qf[s], S);
                const bool diag = (kb == qt);
                f32x16 sp, lb;
                float csum = 0.f;
                if (diag) {
#pragma unroll
                    for (int r = 0; r < 16; ++r) {
                        const int i = (r & 3) + 8 * (r >> 2) + 4 * hf;
                        const float z = S[r];
                        const float l1p = __builtin_amdgcn_logf(1.0f + __builtin_amdgcn_exp2f(-fabsf(z)));
                        const float spv = (i < l31) ? (fmaxf(z, 0.f) + l1p) : 0.f;
                        sp[r] = spv; lb[r] = (i < l31) ? (fminf(z, 0.f) - l1p) : -INFINITY; csum += spv;
                    }
                } else {
#pragma unroll
                    for (int r = 0; r < 16; ++r) {
                        const float z = S[r];
                        const float l1p = __builtin_amdgcn_logf(1.0f + __builtin_amdgcn_exp2f(-fabsf(z)));
                        const float spv = fmaxf(z, 0.f) + l1p;
                        sp[r] = spv; lb[r] = fminf(z, 0.f) - l1p; csum += spv;
                    }
                }
                f32x16 Rt;
#pragma unroll
                for (int r = 0; r < 16; ++r) Rt[r] = carry;
#pragma unroll
                for (int s = 0; s < 2; ++s) Rt = MFMA32(Tri[s], pack_frag(sp, s), Rt);
                f32x16 wv;
#pragma unroll
                for (int r = 0; r < 16; ++r) wv[r] = __builtin_amdgcn_exp2f(lb[r] - Rt[r]);
#pragma unroll
                for (int s = 0; s < 2; ++s) { const bf16x8 wp = pack_frag(wv, s);
#pragma unroll
                    for (int dt = 0; dt < 2; ++dt) O[dt] = MFMA32(Vf[s][dt], wp, O[dt]); }
                csum += __shfl_xor(csum, 32);
                carry += csum;
                if (__all(carry > 127.f)) break;
            }
            float ss = 0.f;
#pragma unroll
            for (int r = 0; r < 16; ++r) ss += O[0][r] * O[0][r] + O[1][r] * O[1][r];
            ss += __shfl_xor(ss, 32);
            const float rn = 1.0f / sqrtf(ss * (1.f / 64.f) + EPS);
#pragma unroll
            for (int dt = 0; dt < 2; ++dt)
#pragma unroll
                for (int g4 = 0; g4 < 4; ++g4) {
                    const int d = 32 * dt + 8 * g4 + 4 * hf;
                    const float4 gn = *(const float4*)(p.og + d);
                    uint2 w; w.x = pg8::cvt_pk_bf16(O[dt][4 * g4] * rn * gn.x, O[dt][4 * g4 + 1] * rn * gn.y); w.y = pg8::cvt_pk_bf16(O[dt][4 * g4 + 2] * rn * gn.z, O[dt][4 * g4 + 3] * rn * gn.w);
                    *(uint2*)(Kt + l31 * 144 + d * 2) = w;
                }
#pragma unroll
            for (int i = 0; i < 4; ++i) *(pg8::u32x4*)(ycat + (size_t)(q0 + 8 * i + r8) * 1024 + 512 + h * 64 + pc * 8) = *(const pg8::u32x4*)(Kt + (8 * i + r8) * 144 + pc * 16);
        }
    }
    xcd_barrier(bar);

    if (bid == 255 % G) for (int n = tid; n < 2048; n += 512) { float s = 0.f;
#pragma unroll
        for (int b8 = 0; b8 < 16; ++b8) s += bq_part[(size_t)b8 * 2048 + n];
        bias_q[n] = s; }
    if (bid >= 64) for (int row = (bid - 64) * 8 + wave; row < 2048; row += (G - 64) * 8) {
        const float am = __uint_as_float(ctl[CTL_CMAX + row]), qs = (am > 0.f) ? 127.f / am : 0.f;
        const pg8::u32x4 a = *(const pg8::u32x4*)(Weff_t + (size_t)row * 1024 + 16 * lane), b = *(const pg8::u32x4*)(Weff_t + (size_t)row * 1024 + 16 * lane + 8);
        pg8::u32x4 o;
#define QB(w) ((__float_as_uint(fmaf(__uint_as_float((w) << 16), qs, 12582912.f)) & 255u) | ((__float_as_uint(fmaf(__uint_as_float((w) & 0xffff0000u), qs, 12582912.f)) & 255u) << 8))
        o.x = QB(a.x) | (QB(a.y) << 16); o.y = QB(a.z) | (QB(a.w) << 16); o.z = QB(b.x) | (QB(b.y) << 16); o.w = QB(b.z) | (QB(b.w) << 16);
#undef QB
        *(pg8::u32x4*)(Weffq_t + (size_t)row * 1024 + 16 * lane) = o;
        if (lane == 0) sq[row] = am * (1.f / 127.f);
    }
    if (G > 64 && bid >= 64) convert_tables(p.down, p.up, q8, dsc, lane, (bid - 64) * 8 + wave, (G - 64) * 8, CONV_SPLIT, 32768);
    else if (G <= 64) convert_tables(p.down, p.up, q8, dsc, lane, bid * 8 + wave, G * 8, CONV_SPLIT, 32768);
    for (int idx = bid * 512 + tid; idx < 32768; idx += G * 512) {
        const int h = idx >> 12;
        const float cd = exp2f(128.f * lg2_head(h));
        float s = 0.f;
        for (int n0 = 0; n0 < 128; n0 += 32) {
            float kvv[32];
#pragma unroll
            for (int q = 0; q < 32; ++q) kvv[q] = kv[(size_t)(n0 + q) * 32768 + idx];
#pragma unroll
            for (int q = 0; q < 32; ++q) { stT[(size_t)(n0 + q) * 32768 + idx] = f2bf(s); s = cd * s + kvv[q]; }
        }
    }
    xcd_barrier(bar);

    {
        const int gw = __builtin_amdgcn_readfirstlane(bid * 8 + wave), NGW = G * 8, l31 = lane & 31, hf = lane >> 5;
        const int wv4 = __builtin_amdgcn_readfirstlane(wave);
        for (int W2 = gw; W2 < 2048; W2 += NGW) {
            const int nh = W2 >> 1, n = nh >> 3, h = nh & 7;
            const float lg = lg2_head(h);
#pragma unroll 1
            for (int pass = 0; pass < 2; ++pass) {
                const int qt = (W2 & 1) ? (pass ? 2 : 1) : (pass ? 3 : 0);
                const int il = qt * 32 + l31, tq = n * 128 + il;
                unsigned char* Kt = lds + wv4 * 9216; unsigned char* Vt = Kt + 4608;
                const int r8 = lane >> 3, pc = lane & 7, trq = (lane & 15) >> 2, trp = lane & 3, trd = (lane >> 4) & 1;
                const unsigned loff = (unsigned)(r8 * 512 + pc * 8) * 2u;
                pg8::u32x4 gK[4], gV[4];
                bf16x8 Qf[4];
                {
                    const char* qbase = (const char*)(Qr + (size_t)(n * 128 + qt * 32) * 512 + h * 64);
                    const char* sbase = (const char*)(stT + (size_t)nh * 4096) + (unsigned)(r8 * 64 + pc * 8) * 2u;
#pragma unroll
                    for (int i = 0; i < 4; ++i) gK[i] = *(const pg8::u32x4*)(qbase + (loff + i * 8192u));
#pragma unroll
                    for (int i = 0; i < 4; ++i) *(pg8::u32x4*)(Kt + (8 * i + r8) * 144 + pc * 16) = gK[i];
#pragma unroll
                    for (int s = 0; s < 4; ++s) Qf[s] = *(const bf16x8*)(Kt + l31 * 144 + 32 * s + 16 * hf);
#pragma unroll
                    for (int i = 0; i < 4; ++i) { gK[i] = *(const pg8::u32x4*)(sbase + i * 1024u); gV[i] = *(const pg8::u32x4*)(sbase + 4096u + i * 1024u); }
#pragma unroll
                    for (int i = 0; i < 4; ++i) { *(pg8::u32x4*)(Kt + (8 * i + r8) * 144 + pc * 16) = gK[i]; *(pg8::u32x4*)(Kt + (32 + 8 * i + r8) * 144 + pc * 16) = gV[i]; }
                }
                f32x16 O[2];
#pragma unroll
                for (int r = 0; r < 16; ++r) { O[0][r] = 0.f; O[1][r] = 0.f; }
#pragma unroll
                for (int s = 0; s < 4; ++s)
#pragma unroll
                    for (int dt = 0; dt < 2; ++dt) O[dt] = MFMA32(*(const bf16x8*)(Kt + (32 * dt + l31) * 144 + 32 * s + 16 * hf), Qf[s], O[dt]);
                const float xi = exp2f((float)(il + 1) * lg);
#pragma unroll
                for (int r = 0; r < 16; ++r) { O[0][r] *= xi; O[1][r] *= xi; }
                const char* kbase = (const char*)(Kr + (size_t)n * 128 * 512 + h * 64); const char* vbase = (const char*)(Vr + (size_t)n * 128 * 512 + h * 64);
#pragma unroll
                for (int i = 0; i < 4; ++i) { gK[i] = *(const pg8::u32x4*)(kbase + (loff + i * 8192u)); gV[i] = *(const pg8::u32x4*)(vbase + (loff + i * 8192u)); }
                for (int jb = 0; jb <= qt; ++jb) {
#pragma unroll
                    for (int i = 0; i < 4; ++i) { *(pg8::u32x4*)(Kt + (8 * i + r8) * 144 + pc * 16) = gK[i]; *(pg8::u32x4*)(Vt + (8 * i + r8) * 144 + pc * 16) = gV[i]; }
                    { const int jn = (jb < qt) ? jb + 1 : jb;
#pragma unroll
                      for (int i = 0; i < 4; ++i) { gK[i] = *(const pg8::u32x4*)(kbase + (size_t)jn * 32768 + (loff + i * 8192u)); gV[i] = *(const pg8::u32x4*)(vbase + (size_t)jn * 32768 + (loff + i * 8192u)); } }
                    bf16x8 Kf[4], Vf[2][2];
#pragma unroll
                    for (int s = 0; s < 4; ++s) Kf[s] = *(const bf16x8*)(Kt + l31 * 144 + 32 * s + 16 * hf);
#pragma unroll
                    for (int s = 0; s < 2; ++s)
#pragma unroll
                        for (int dt = 0; dt < 2; ++dt) Vf[s][dt] = tr_frag(Vt + (16 * s + 4 * hf + trq) * 144 + (32 * dt + 16 * trd + 4 * trp) * 2, 8);
                    f32x16 S;
#pragma unroll
                    for (int r = 0; r < 16; ++r) S[r] = 0.f;
#pragma unroll
                    for (int s = 0; s < 4; ++s) S = MFMA32(Kf[s], Qf[s], S);
#pragma unroll
                    for (int r = 0; r < 16; ++r) {
                        const int jl = jb * 32 + (r & 3) + 8 * (r >> 2) + 4 * hf, dl = il - jl;
                        S[r] = (dl >= 0) ? S[r] * __builtin_amdgcn_exp2f((float)dl * lg) : 0.f;
                    }
#pragma unroll
                    for (int s = 0; s < 2; ++s) { const bf16x8 wp = pack_frag(S, s);
#pragma unroll
                        for (int dt = 0; dt < 2; ++dt) O[dt] = MFMA32(Vf[s][dt], wp, O[dt]); }
                }
                float sm = 0.f;
#pragma unroll
                for (int r = 0; r < 16; ++r) sm += O[0][r] + O[1][r];
                sm += __shfl_xor(sm, 32);
                const float mean = sm * (1.f / 64.f);
                float vs = 0.f;
#pragma unroll
                for (int r = 0; r < 16; ++r) { const float d0 = O[0][r] - mean, d1 = O[1][r] - mean; vs += d0 * d0 + d1 * d1; }
                vs += __shfl_xor(vs, 32);
                const float rstd = 1.0f / sqrtf(vs * (1.f / 64.f) + EPS);
                {
                    const char* gbase = (const char*)(Gr + (size_t)(n * 128 + qt * 32) * 512 + h * 64);
#pragma unroll
                    for (int i = 0; i < 4; ++i) gV[i] = *(const pg8::u32x4*)(gbase + (loff + i * 8192u));
#pragma unroll
                    for (int i = 0; i < 4; ++i) *(pg8::u32x4*)(Vt + (8 * i + r8) * 144 + pc * 16) = gV[i];
                }
#pragma unroll
                for (int dt = 0; dt < 2; ++dt)
#pragma unroll
                    for (int g4 = 0; g4 < 4; ++g4) {
                        const int e = 32 * dt + 8 * g4 + 4 * hf;
                        const float4 gn = *(const float4*)(p.rgain + h * 64 + e);
                        const uint2 gg = *(const uint2*)(Vt + l31 * 144 + e * 2);
                        const float g0 = __uint_as_float(gg.x << 16), g1 = __uint_as_float(gg.x & 0xffff0000u), g2v = __uint_as_float(gg.y << 16), g3 = __uint_as_float(gg.y & 0xffff0000u);
                        uint2 w;
                        w.x = pg8::cvt_pk_bf16((O[dt][4 * g4] - mean) * rstd * gn.x * g0, (O[dt][4 * g4 + 1] - mean) * rstd * gn.y * g1);
                        w.y = pg8::cvt_pk_bf16((O[dt][4 * g4 + 2] - mean) * rstd * gn.z * g2v, (O[dt][4 * g4 + 3] - mean) * rstd * gn.w * g3);
                        *(uint2*)(Kt + l31 * 144 + e * 2) = w;
                    }
#pragma unroll
                for (int i = 0; i < 4; ++i) *(pg8::u32x4*)(ycat + (size_t)(n * 128 + qt * 32 + 8 * i + r8) * 1024 + h * 64 + pc * 8) = *(const pg8::u32x4*)(Kt + (8 * i + r8) * 144 + pc * 16);
            }
        }
    }
    xcd_barrier(bar);

    {
        pg8::Gemm g{ycat, Wout_t, T, 1024, 1024}; pg8::StaticOrder S; S.init(T, 1024, G, bid);
        EpiOutprojMF E{p.x, mod + 2048, x1b, part2, pmax, x1q, rinv2q, ctl};
        pg8::gemm_phase<EpiOutprojMF, pg8::StaticOrder>((PG8_LAS unsigned char*)lds, g, S, E);
    }
    xcd_barrier(bar);

    for (int round = 0; round < 2; ++round) {
        pg8::Gemm g{(const bf16_t*)x1q, (const bf16_t*)Weffq_t, T, 2048, 512}; OneUnitOrder S; S.base.init(T, 2048, G, bid); S.round = round;
        EpiTopkMF E{rinv2q, sq, bias_q, ids, gates};
        pg8::gemm_phase<EpiTopkMF, OneUnitOrder, true>((PG8_LAS unsigned char*)lds, g, S, E);
    }
    xcd_barrier(bar);

    {
        constexpr int IDS_LD = 136, ACT_LD = 136;
        const float* scale2 = mod + 4096; const float* shift2 = mod + 3072; const float* gate2 = mod + 5120;
        unsigned short* ids_l = (unsigned short*)lds; float* act_l = (float*)(lds + 32768);
        bf16_t* ds_l = (bf16_t*)(lds + 69632);
        const int t0 = bid * 64, tt = lane >> 3, sub = lane & 7, tl = wave * 8 + tt, t = t0 + tl;
        for (int e = tid; e < 1024; e += 512) { const int r = e >> 4, c8 = e & 15; *(uint4*)(ids_l + r * IDS_LD + c8 * 8) = *(const uint4*)(ids + (size_t)(t0 + r) * 128 + c8 * 8); }
        for (int e = tid; e < 64 * ACT_LD; e += 512) act_l[e] = 0.f;
        for (int e = tid; e < 4096; e += 512) ((uint4*)ds_l)[e] = ((const uint4*)dsc)[e];
        float* s2_l = (float*)(lds + 143360); float* sh2_l = s2_l + 1024; float* gt2_l = s2_l + 2048;
        for (int e = tid; e < 1024; e += 512) { s2_l[e] = p.g2[e] * (1.f + scale2[e]); sh2_l[e] = shift2[e]; gt2_l[e] = gate2[e]; }
        __syncthreads();
        float ri;
        { const float4* pp = (const float4*)(part2 + (size_t)t * 16); const float4 p0 = pp[0], p1 = pp[1], p2 = pp[2], p3 = pp[3];
          const float ssum = ((p0.x + p0.y) + (p0.z + p0.w)) + ((p1.x + p1.y) + (p1.z + p1.w)) + ((p2.x + p2.y) + (p2.z + p2.w)) + ((p3.x + p3.y) + (p3.z + p3.w));
          ri = 1.0f / sqrtf(ssum * (1.0f / D) + EPS); }
        const unsigned short* myids = ids_l + tl * IDS_LD;
        float* myact = act_l + tl * ACT_LD;
        const bool s4 = (sub & 4) != 0, s2 = (sub & 2) != 0, s1 = (sub & 1) != 0;
        const unsigned suboff = (unsigned)sub * 16u;
        typedef float f32x2 __attribute__((ext_vector_type(2)));
#define P9_LOAD(W, JB) do { const uint4 idv_ = *(const uint4*)(myids + 8 * (JB)); const unsigned idw_[4] = {idv_.x, idv_.y, idv_.z, idv_.w}; \
        _Pragma("unroll") for (int k_ = 0; k_ < 8; ++k_) { const unsigned id_ = (idw_[k_ >> 1] >> (16 * (k_ & 1))) & 0xffffu; W[k_] = *(const uint4*)(sbase + (id_ * 128u + suboff)); } } while (0)
#define P9_DOWN4(W, JB) do { int pd_[8]; \
        _Pragma("unroll") for (int k_ = 0; k_ < 8; ++k_) { const unsigned ww_[4] = {W[k_].x, W[k_].y, W[k_].z, W[k_].w}; int a0_ = 0, a1_ = 0; \
            _Pragma("unroll") for (int m_ = 0; m_ < 4; ++m_) { a0_ = __builtin_amdgcn_sdot4(hpe[m_], (int)(ww_[m_] & 0x0F0F0F0Fu), a0_, false); a1_ = __builtin_amdgcn_sdot4(hpo[m_], (int)((ww_[m_] >> 4) & 0x0F0F0F0Fu), a1_, false); } \
            pd_[k_] = a0_ + a1_ - hoff; } \
        int r4_[4], r2_[2]; \
        _Pragma("unroll") for (int k_ = 0; k_ < 4; ++k_) { const int snd_ = s4 ? pd_[k_] : pd_[k_ + 4], kp_ = s4 ? pd_[k_ + 4] : pd_[k_]; r4_[k_] = kp_ + __shfl_xor(snd_, 4); } \
        _Pragma("unroll") for (int k_ = 0; k_ < 2; ++k_) { const int snd_ = s2 ? r4_[k_] : r4_[k_ + 2], kp_ = s2 ? r4_[k_ + 2] : r4_[k_]; r2_[k_] = kp_ + __shfl_xor(snd_, 2); } \
        { const int snd_ = s1 ? r2_[0] : r2_[1], kp_ = s1 ? r2_[1] : r2_[0]; myact[8 * (JB) + sub] += (float)(kp_ + __shfl_xor(snd_, 1)) * hscale; } } while (0)
        for (int c = 0; c < 4; ++c) {
            float hf[8][4]; float hmax = 0.f;
#pragma unroll
            for (int q = 0; q < 8; ++q) {
                const int col = 256 * c + 4 * sub + 32 * q;
                const uint2 xw = *(const uint2*)(x1b + (size_t)t * D + col);
                const float4 sv = *(const float4*)(s2_l + col), sh = *(const float4*)(sh2_l + col);
                hf[q][0] = __uint_as_float(xw.x << 16) * ri * sv.x + sh.x; hf[q][1] = __uint_as_float(xw.x & 0xffff0000u) * ri * sv.y + sh.y;
                hf[q][2] = __uint_as_float(xw.y << 16) * ri * sv.z + sh.z; hf[q][3] = __uint_as_float(xw.y & 0xffff0000u) * ri * sv.w + sh.w;
                hmax = fmaxf(hmax, fmaxf(fmaxf(fabsf(hf[q][0]), fabsf(hf[q][1])), fmaxf(fabsf(hf[q][2]), fabsf(hf[q][3]))));
            }
            hmax = fmaxf(hmax, __shfl_xor(hmax, 1)); hmax = fmaxf(hmax, __shfl_xor(hmax, 2)); hmax = fmaxf(hmax, __shfl_xor(hmax, 4));
            const float hinv = (hmax > 0.f) ? 127.0f / hmax : 0.f, hscale = hmax * (1.0f / 127.0f);
            int hq[8][4];
#pragma unroll
            for (int q = 0; q < 8; ++q)
#pragma unroll
                for (int j = 0; j < 4; ++j) hq[q][j] = (int)__builtin_rintf(hf[q][j] * hinv);
            int hpe[4], hpo[4], hoff = 0;
#pragma unroll
            for (int m = 0; m < 4; ++m) {
                hpe[m] = (hq[2 * m][0] & 255) | ((hq[2 * m][2] & 255) << 8) | ((hq[2 * m + 1][0] & 255) << 16) | ((hq[2 * m + 1][2] & 255) << 24);
                hpo[m] = (hq[2 * m][1] & 255) | ((hq[2 * m][3] & 255) << 8) | ((hq[2 * m + 1][1] & 255) << 16) | ((hq[2 * m + 1][3] & 255) << 24);
            }
#pragma unroll
            for (int q = 0; q < 8; ++q) hoff += (hq[q][0] + hq[q][1]) + (hq[q][2] + hq[q][3]);
            hoff *= 8;
            const unsigned char* sbase = q8 + (size_t)c * (16384 * 128);
            uint4 wA[8], wB[8];
            P9_LOAD(wA, 0);
#pragma unroll 1
            for (int jb = 0; jb < 16; jb += 2) {
                P9_LOAD(wB, jb + 1);
                P9_DOWN4(wA, jb);
                if (jb + 2 < 16) P9_LOAD(wA, jb + 2);
                P9_DOWN4(wB, jb + 1);
            }
        }
#undef P9_DOWN4
        signed char* aq_l = (signed char*)(lds + 135168);
        float avv[16]; float amax = 0.f;
#pragma unroll
        for (int jb = 0; jb < 16; ++jb) {
            const int j = 8 * jb + sub; const unsigned id = myids[j];
            const float a = myact[j] * bf2f(ds_l[id]);
            const float av = fabsf(a), tq = 1.0f / (av * 0.2316418882f + 1.0f);
            float ql = tq * 0.5307027145f + (-0.7265760135f); ql = ql * tq + 0.7107068705f; ql = ql * tq + (-0.142248368f); ql = ql * tq + 0.127414796f; ql = ql * tq;
            const float mm = a * (ql * exp2f(a * a * (-0.72134752044f)));
            const float ge = (a < 0.f) ? mm : (a - mm);
            avv[jb] = ge * gates[(size_t)t * 128 + j] * bf2f(ds_l[16384 + id]);
            amax = fmaxf(amax, fabsf(avv[jb]));
        }
        amax = fmaxf(amax, __shfl_xor(amax, 1)); amax = fmaxf(amax, __shfl_xor(amax, 2)); amax = fmaxf(amax, __shfl_xor(amax, 4));
        const float ainv = (amax > 0.f) ? 127.0f / amax : 0.f, ascale = amax * (1.0f / 127.0f);
        int aqsum = 0;
#pragma unroll
        for (int jb = 0; jb < 16; ++jb) { const int aqv = (int)__builtin_rintf(avv[jb] * ainv); aq_l[tl * 128 + 8 * jb + sub] = (signed char)aqv; aqsum += aqv; }
        aqsum += __shfl_xor(aqsum, 1); aqsum += __shfl_xor(aqsum, 2); aqsum += __shfl_xor(aqsum, 4);
        __syncthreads();
#define P9_PERM(HI, LO, SEL) __builtin_amdgcn_perm((HI), (LO), (SEL))
#define P9_T4(E0, E1, E2, E3, T0, T1, T2, T3) do { const unsigned p0_ = P9_PERM(E1, E0, 0x05010400u), p1_ = P9_PERM(E1, E0, 0x07030602u), p2_ = P9_PERM(E3, E2, 0x05010400u), p3_ = P9_PERM(E3, E2, 0x07030602u); \
        T0 = P9_PERM(p2_, p0_, 0x05040100u); T1 = P9_PERM(p2_, p0_, 0x07060302u); T2 = P9_PERM(p3_, p1_, 0x05040100u); T3 = P9_PERM(p3_, p1_, 0x07060302u); } while (0)
#define P9_UP4(W, JB) do { const uint2 aq8_ = *(const uint2*)(aq_l + tl * 128 + 8 * (JB)); const int aq4_[2] = {(int)aq8_.x, (int)aq8_.y}; \
        _Pragma("unroll") for (int g_ = 0; g_ < 2; ++g_) { \
            _Pragma("unroll") for (int m_ = 0; m_ < 4; ++m_) { \
                const unsigned w0_ = ((const unsigned*)&W[4 * g_ + 0])[m_], w1_ = ((const unsigned*)&W[4 * g_ + 1])[m_], w2_ = ((const unsigned*)&W[4 * g_ + 2])[m_], w3_ = ((const unsigned*)&W[4 * g_ + 3])[m_]; \
                unsigned t_[4]; \
                P9_T4(w0_, w1_, w2_, w3_, t_[0], t_[1], t_[2], t_[3]); \
                _Pragma("unroll") for (int k_ = 0; k_ < 4; ++k_) { \
                    oraw[4 * m_ + k_] = __builtin_amdgcn_sdot4(aq4_[g_], (int)t_[k_], oraw[4 * m_ + k_], false); \
                    olo[4 * m_ + k_] = __builtin_amdgcn_sdot4(aq4_[g_], (int)(t_[k_] & 0x0F0F0F0Fu), olo[4 * m_ + k_], false); } } } } while (0)
        for (int c = 0; c < 4; ++c) {
            int oraw[16], olo[16];
#pragma unroll
            for (int q = 0; q < 16; ++q) { oraw[q] = 0; olo[q] = 0; }
            const unsigned char* sbase = q8 + (8u << 20) + (size_t)c * (16384 * 128);
            uint4 wA[8], wB[8];
            P9_LOAD(wA, 0);
#pragma unroll 1
            for (int jb = 0; jb < 16; jb += 2) {
                P9_LOAD(wB, jb + 1);
                P9_UP4(wA, jb);
                if (jb + 2 < 16) P9_LOAD(wA, jb + 2);
                P9_UP4(wB, jb + 1);
            }
#pragma unroll
            for (int q = 0; q < 8; ++q) {
                const int col = 256 * c + 4 * sub + 32 * q;
                float* op = out + (size_t)t * D + col;
                const uint2 xw = *(const uint2*)(x1b + (size_t)t * D + col); const float4 xv = make_float4(__uint_as_float(xw.x << 16), __uint_as_float(xw.x & 0xffff0000u), __uint_as_float(xw.y << 16), __uint_as_float(xw.y & 0xffff0000u)); const float4 gt = *(const float4*)(gt2_l + col);
                const int m = q >> 1, k0 = 2 * (q & 1);
                const int v0 = olo[4 * m + k0] - 8 * aqsum, v1 = (oraw[4 * m + k0] - olo[4 * m + k0]) >> 4, v2 = olo[4 * m + k0 + 1] - 8 * aqsum, v3 = (oraw[4 * m + k0 + 1] - olo[4 * m + k0 + 1]) >> 4;
                float4 r;
                r.x = xv.x + gt.x * ((float)v0 * ascale); r.y = xv.y + gt.y * ((float)v1 * ascale); r.z = xv.z + gt.z * ((float)v2 * ascale); r.w = xv.w + gt.w * ((float)v3 * ascale);
                *(float4*)op = r;
            }
        }
#undef P9_LOAD
#undef P9_UP4
#undef P9_T4
#undef P9_PERM
    }
}
}

extern "C" void kernel_launch(void* const* d_in, const int* in_sizes, int n_in, void* d_out, int out_size, void* d_ws, size_t ws_size, hipStream_t stream) {
    static int grid = 0;
    if (grid == 0) {
        int dev = 0, cus = 0, per_cu = 0;
        (void)hipGetDevice(&dev);
        (void)hipDeviceGetAttribute(&cus, hipDeviceAttributeMultiprocessorCount, dev);
        (void)hipFuncSetAttribute((const void*)mk_fwd, hipFuncAttributeMaxDynamicSharedMemorySize, LDS_BYTES);
        (void)hipOccupancyMaxActiveBlocksPerMultiprocessor(&per_cu, (const void*)mk_fwd, 512, LDS_BYTES);
        if (per_cu < 1 || cus != 256) { fprintf(stderr, "kernel_launch: needs 256 CUs with one resident workgroup each (cus %d, per_cu %d)\n", cus, per_cu); grid = -1; }
        else grid = cus;
    }
    if (grid < 0) return;
    (void)hipMemsetAsync((char*)d_ws + OFF_CTL, 0, CTL_BYTES, stream);
    Params p{};
    p.x = (const float*)d_in[0]; p.c = (const float*)d_in[1]; p.pos = (const int*)d_in[2]; p.ada_w = (const float*)d_in[3]; p.ada_b = (const float*)d_in[4];
    p.g1 = (const float*)d_in[5]; p.g2 = (const float*)d_in[6]; p.w_in = (const float*)d_in[7]; p.rgain = (const float*)d_in[8]; p.qg = (const float*)d_in[9];
    p.kg = (const float*)d_in[10]; p.og = (const float*)d_in[11]; p.w_out = (const float*)d_in[12]; p.wq = (const float*)d_in[13]; p.sk = (const float*)d_in[14];
    p.down = (const float*)d_in[15]; p.up = (const float*)d_in[16]; p.out = (float*)d_out; p.ws = (unsigned char*)d_ws;
    for (int i = 0; i < 32; ++i) {
        const double f = pow(10000.0, -(double)i / 32.0) / 6.283185307179586476925;
        float fh = (float)f; unsigned ub; memcpy(&ub, &fh, 4); ub &= 0xFFFFC000u; memcpy(&fh, &ub, 4);
        p.rc.fh[i] = fh; p.rc.fl[i] = (float)(f - (double)fh);
    }
    void* args[] = {&p};
    hipError_t e = hipLaunchCooperativeKernel((const void*)mk_fwd, dim3(grid), dim3(512), args, LDS_BYTES, stream);
    if (e != hipSuccess) fprintf(stderr, "kernel_launch: cooperative launch failed: %s (grid %d)\n", hipGetErrorString(e), grid);
}
```

```cpp
#include <hip/hip_runtime.h>
#include <stdint.h>
#include <math.h>
#include <cstdio>
#include <cstring>

namespace {
constexpr int T = 16384, D = 1024;
constexpr float EPS = 1e-6f;
typedef unsigned short bf16_t;
#define LAS __attribute__((address_space(3)))

__device__ __forceinline__ float bf2f(bf16_t b) { return __uint_as_float(((unsigned)b) << 16); }
__device__ __forceinline__ bf16_t f2bf(float f) { unsigned u = __float_as_uint(f); u += 0x7fffu + ((u >> 16) & 1u); return (bf16_t)(u >> 16); }
__device__ __forceinline__ float4 ld_nt4(const float* p) { typedef float f4v __attribute__((ext_vector_type(4))); const f4v v = __builtin_nontemporal_load((const f4v*)p); return make_float4(v[0], v[1], v[2], v[3]); }

__device__ __forceinline__ float lg2_head(int h) {
    const float x = __uint_as_float((unsigned)(127 - 5 - h) << 23);
    const float s = x * (1.f + x * (0.5f + x * (0.33333334f + x * (0.25f + x * (0.2f + x * 0.16666667f)))));
    return -s * 1.44269504089f;
}
struct RopeC { float fh[32], fl[32]; };
struct RetC { float lg2[8]; };

constexpr size_t MiB = 1u << 20;
constexpr size_t OFF_CTL = 0;
constexpr size_t CTL_BYTES = 64 * 1024;
constexpr size_t OFF_MOD = 64 * 1024, OFF_RINV1 = 128 * 1024, OFF_BIASF = 256 * 1024, OFF_ROPE = 1 * MiB;
constexpr size_t OFF_WINT = 6 * MiB;
constexpr size_t OFF_XB = 16 * MiB;
constexpr size_t OFF_YCAT = 160 * MiB;
constexpr size_t OFF_P = 48 * MiB;
constexpr size_t OFF_KV = 208 * MiB, OFF_ST = 224 * MiB;
constexpr size_t OFF_WEFFT = 240 * MiB;
constexpr size_t OFF_WOUTT = 13 * MiB;
constexpr size_t OFF_BIASQ = 272 * 1024;
constexpr size_t OFF_SWF = 320 * 1024;
constexpr size_t OFF_SQ = 336 * 1024;
constexpr size_t OFF_PMAX = 2 * MiB;
constexpr size_t OFF_RINV2Q = 3 * MiB;
constexpr size_t OFF_WEFFQ = 10 * MiB;
constexpr size_t OFF_X1Q = 16 * MiB;
constexpr int CTL_CNT = 4096, CTL_CMAX = 8192;
constexpr size_t OFF_XQ = 160 * MiB;
constexpr size_t OFF_DSC = 512 * 1024;
constexpr size_t OFF_BQPART = 576 * 1024;
constexpr size_t OFF_PART2 = 5 * MiB;
constexpr size_t OFF_X1B = 208 * MiB;
constexpr size_t OFF_IDS = 244 * MiB, OFF_GATES = 248 * MiB;
constexpr size_t OFF_Q8 = 192 * MiB;
constexpr int CONV_SPLIT = 0;
constexpr int LDS_BYTES = 163840;
constexpr int LDS_ST_OFF = LDS_BYTES - 16;

#define XB_TMO      128
#define XB_XCNT(j)  (256  + 64 * (j))
#define XB_XSUB(j)  (1280 + 64 * (j))
#define XB_XGEN(j)  (2304 + 64 * (j))
#define XB_TOP      3328
#define XB_TOPGEN   3392
#define XCD_BAR_WORDS 3456
#define XB_SPIN_CAP (1u << 20)
__device__ __forceinline__ unsigned xb_ld(unsigned* p)              { return __hip_atomic_load(p, __ATOMIC_RELAXED, __HIP_MEMORY_SCOPE_AGENT); }
__device__ __forceinline__ unsigned xb_add(unsigned* p, unsigned v) { return __hip_atomic_fetch_add(p, v, __ATOMIC_RELAXED, __HIP_MEMORY_SCOPE_AGENT); }
__device__ __forceinline__ unsigned xb_xcc_id() { return (unsigned)__builtin_amdgcn_s_getreg((3 << 11) | 20) & 0xFu; }
#define XB_SPIN(cond, bar) do { unsigned _sp = 0; while (cond) { __builtin_amdgcn_s_sleep(1); \
    if ((++_sp & 255u) == 0u) { if (xb_ld(&(bar)[XB_TMO])) break; if (_sp > XB_SPIN_CAP) { atomicAdd(&(bar)[XB_TMO], 1u); break; } } } } while (0)
struct XcdBarrier { unsigned* bar; unsigned x; volatile LAS unsigned* st; };
__device__ __forceinline__ XcdBarrier xcd_barrier_post(unsigned* bar, volatile LAS unsigned* st) {
    XcdBarrier b; b.bar = bar; b.x = xb_xcc_id(); b.st = st;
    if (threadIdx.x == 0) (void)xb_add(&bar[XB_XCNT(b.x)], 1u);
    return b;
}
__device__ __forceinline__ void xcd_barrier_complete(unsigned* bar, unsigned x, unsigned& nloc, unsigned& nx) {
    const unsigned G = gridDim.x * gridDim.y * gridDim.z;
    unsigned sum, cnt, mine, sp = 0u;
    for (;;) {
        sum = 0u; cnt = 0u; mine = 0u;
#pragma unroll
        for (unsigned j = 0; j < 16; ++j) { const unsigned c = xb_ld(&bar[XB_XCNT(j)]); sum += c; cnt += (c > 0u) ? 1u : 0u; mine = (j == x) ? c : mine; }
        if (sum == G) break;
        __builtin_amdgcn_s_sleep(1);
        if ((++sp & 255u) == 0u) { if (xb_ld(&bar[XB_TMO])) break; if (sp > XB_SPIN_CAP) { atomicAdd(&bar[XB_TMO], 1u); break; } }
    }
    nloc = mine > 0u ? mine : 1u; nx = cnt > 0u ? cnt : 1u;
}
__device__ __forceinline__ void xcd_barrier(const XcdBarrier& b) {
    asm volatile("s_waitcnt vmcnt(0)" ::: "memory");
    __syncthreads();
    if (threadIdx.x == 0) {
        unsigned* bar = b.bar;
        __builtin_amdgcn_s_waitcnt(0);
        unsigned nloc = b.st[0], nx = b.st[1];
        if (nloc == 0u) { xcd_barrier_complete(bar, b.x, nloc, nx); b.st[0] = nloc; b.st[1] = nx; }
        const unsigned old = xb_add(&bar[XB_XSUB(b.x)], 1u);
        const unsigned gen = old / nloc;
        if (old + 1u == (gen + 1u) * nloc) {
            __builtin_amdgcn_fence(__ATOMIC_RELEASE, "agent");
            asm volatile("s_waitcnt vmcnt(0)" ::: "memory");
            const unsigned og = xb_add(&bar[XB_TOP], 1u);
            const unsigned tg = og / nx;
            if (og + 1u == (tg + 1u) * nx) xb_add(&bar[XB_TOPGEN], 1u);
            else XB_SPIN(xb_ld(&bar[XB_TOPGEN]) == tg, bar);
            __builtin_amdgcn_fence(__ATOMIC_ACQUIRE, "agent");
            xb_add(&bar[XB_XGEN(b.x)], 1u);
            asm volatile("s_waitcnt vmcnt(0)" ::: "memory");
        } else {
            XB_SPIN(xb_ld(&bar[XB_XGEN(b.x)]) == gen, bar);
            __builtin_amdgcn_fence(__ATOMIC_ACQUIRE, "agent");
            asm volatile("s_waitcnt vmcnt(0)" ::: "memory");
        }
    }
    __syncthreads();
}


namespace pg8 {
#define PG8_LAS __attribute__((address_space(3)))
typedef short bf16x8 __attribute__((ext_vector_type(8)));
typedef float f32x4 __attribute__((ext_vector_type(4)));
typedef unsigned u32x4 __attribute__((ext_vector_type(4)));
typedef unsigned u32x2 __attribute__((ext_vector_type(2)));
constexpr int BM = 256, BK = 64, HALF = 128, HTB = HALF * BK * 2, STAGE_BYTES = 8 * HTB, NXCD = 8, WGM = 8;
__host__ __device__ __forceinline__ int lds_byte(int r, int c) { const int st = (r >> 4) * 2 + (c >> 5), rr = r & 15, cc = c & 31, ob = rr * 64 + cc * 2; return st * 1024 + (ob ^ (((ob >> 9) & 1) << 5)); }
__host__ __device__ __forceinline__ void stage_rc(int b, int& R, int& C) { const int st = b / 1024, sb = b % 1024, swz = sb ^ (((sb >> 9) & 1) << 5); R = (st >> 1) * 16 + swz / 64; C = (st & 1) * 32 + (swz % 64) / 2; }
__host__ __device__ __forceinline__ int perm32(int rho) { const int n = rho >> 4, i = rho & 15; return 8 * (i >> 2) + 4 * n + (i & 3); }
struct Unit { int pm, pn; };
struct Gemm { const bf16_t* A; const bf16_t* Bt; int M, N, K; };
struct StaticOrder {
    int nM, nN, nwg, G, c;
    __host__ __device__ void init(int M, int N, int G_, int c_) { nM = M / BM; nN = N / BM; nwg = nM * nN; G = G_; c = c_; }
    __host__ __device__ bool next(int i, Unit& u) const {
        const long L = (long)i * G + c; if (L >= nwg) return false;
        int wgid = (int)L; { const int q = nwg / NXCD, r = nwg % NXCD, xcd = wgid % NXCD, off = wgid / NXCD; wgid = (xcd < r ? xcd * (q + 1) : r * (q + 1) + (xcd - r) * q) + off; }
        const int nig = WGM * nN, gid = wgid / nig, fm = gid * WGM, gsz = (nM - fm) < WGM ? (nM - fm) : WGM;
        u.pm = fm + ((wgid % nig) % gsz); u.pn = (wgid % nig) / gsz; return true;
    }
    __device__ __forceinline__ void a_ready(const Unit&) const {}
    __device__ __forceinline__ void done(const Unit&) const {}
};
__device__ __forceinline__ unsigned cvt_pk_bf16(float lo, float hi) { unsigned r; asm volatile("v_cvt_pk_bf16_f32 %0, %1, %2" : "=v"(r) : "v"(lo), "v"(hi)); return r; }

typedef int i32x4 __attribute__((ext_vector_type(4)));
template <bool I8>
__device__ __forceinline__ f32x4 mma16(const bf16x8 b, const bf16x8 a, const f32x4 c) {
    if constexpr (I8) return __builtin_bit_cast(f32x4, __builtin_amdgcn_mfma_i32_16x16x64_i8(__builtin_bit_cast(i32x4, b), __builtin_bit_cast(i32x4, a), __builtin_bit_cast(i32x4, c), 0, 0, 0));
    else return __builtin_amdgcn_mfma_f32_16x16x32_bf16(b, a, c, 0, 0, 0);
}
template <class Epi, class Sched, bool I8 = false>
__device__ __forceinline__ void gemm_phase(PG8_LAS unsigned char* lds, const Gemm g, const Sched& S, const Epi& E) {
    int tid_ = threadIdx.x; asm volatile("" : "+v"(tid_));
    const int tid = tid_, wid = __builtin_amdgcn_readfirstlane(tid >> 6), lane = tid & 63, wr = wid >> 2, wc = wid & 3, fr = lane & 15, fq = lane >> 4;
    const int K = g.K, nt = K / BK;
    unsigned voffA[2], voffB[2];
#pragma unroll
    for (int i = 0; i < 2; ++i) { int R, C; stage_rc(tid * 16 + i * 8192, R, C); const int Rb = Epi::PERM ? ((R & ~31) + perm32(R & 31)) : R;
        voffA[i] = (unsigned)(R * K + C) * 2u; voffB[i] = (unsigned)(Rb * K + C) * 2u; }
    const size_t kstep = (size_t)(BK * 2);
    const size_t hstep = (size_t)HALF * K * 2;
    const size_t tstep = 2 * hstep;
    const unsigned ldsw = (unsigned)wid * 1024u;
    const int aoff = lds_byte(wr * 64 + fr, fq * 8), boff = lds_byte(wc * 32 + fr, fq * 8);
#define PG8_SA(b, h) (((b) * 2 + (h)) * HTB)
#define PG8_SB(b, h) ((4 + (b) * 2 + (h)) * HTB)
#define PG8_STAGE(bufoff, gbase, voff) do { _Pragma("unroll") for (int _i = 0; _i < 2; ++_i) \
        __builtin_amdgcn_global_load_lds((const unsigned*)((const char*)(gbase) + (voff)[_i]), (PG8_LAS unsigned*)(lds + (bufoff) + ldsw + _i * 8192), 16, 0, 0); } while (0)
#define PG8_LDA(dst, b, h) do { _Pragma("unroll") for (int m = 0; m < 4; ++m) _Pragma("unroll") for (int k = 0; k < 2; ++k) dst[m][k] = *(const PG8_LAS bf16x8*)(lds + PG8_SA(b, h) + aoff + m * 2048 + k * 1024); } while (0)
#define PG8_LDB(dst, b, h) do { _Pragma("unroll") for (int n = 0; n < 2; ++n) _Pragma("unroll") for (int k = 0; k < 2; ++k) dst[n][k] = *(const PG8_LAS bf16x8*)(lds + PG8_SB(b, h) + boff + n * 2048 + k * 1024); } while (0)
#define PG8_MMA(ai, bj, At, Bt) do { __builtin_amdgcn_s_setprio(1); _Pragma("unroll") for (int m = 0; m < 4; ++m) _Pragma("unroll") for (int n = 0; n < 2; ++n) _Pragma("unroll") for (int k = 0; k < 2; ++k) \
        acc[ai][bj][m][n] = mma16<I8>(Bt[n][k], At[m][k], acc[ai][bj][m][n]); __builtin_amdgcn_s_setprio(0); } while (0)
#define PG8_WAIT_V(n) asm volatile("s_waitcnt vmcnt(" #n ")" ::: "memory")
#define PG8_WAIT_L(n) asm volatile("s_waitcnt lgkmcnt(" #n ")" ::: "memory")
#define PG8_BAR __builtin_amdgcn_s_barrier()
#define PG8_SCHED __builtin_amdgcn_sched_barrier(0)
    Unit cur, nxt; int ui = 0;
    if (!S.next(0, cur)) return;
    f32x4 acc[2][2][4][2];
#pragma unroll
    for (int a = 0; a < 2; ++a)
#pragma unroll
        for (int b = 0; b < 2; ++b)
#pragma unroll
            for (int m = 0; m < 4; ++m)
#pragma unroll
                for (int n = 0; n < 2; ++n) acc[a][b][m][n] = (f32x4){0.f, 0.f, 0.f, 0.f};
    bf16x8 At[4][2], B0[2][2], B1[2][2];
    const char* cA = (const char*)g.A + (size_t)cur.pm * tstep; const char* cB = (const char*)g.Bt + (size_t)cur.pn * tstep;
    S.a_ready(cur);
    PG8_STAGE(PG8_SB(0, 0), cB, voffB); PG8_STAGE(PG8_SA(0, 0), cA, voffA); PG8_STAGE(PG8_SB(0, 1), cB + hstep, voffB); PG8_STAGE(PG8_SA(0, 1), cA + hstep, voffA);
    if (wr == 1) PG8_BAR;
    PG8_WAIT_V(4); PG8_BAR;
    PG8_STAGE(PG8_SB(1, 0), cB + kstep, voffB); PG8_STAGE(PG8_SA(1, 0), cA + kstep, voffA); PG8_STAGE(PG8_SB(1, 1), cB + hstep + kstep, voffB);
    PG8_WAIT_V(6); PG8_BAR;
    for (;;) {
        const bool has_next = S.next(ui + 1, nxt);
        const char* nA = has_next ? (const char*)g.A + (size_t)nxt.pm * tstep : cA; const char* nB = has_next ? (const char*)g.Bt + (size_t)nxt.pn * tstep : cB;
        for (int t = 0; t < nt; t += 2) {
            const bool last = (t == nt - 2);
            const char* a1 = cA + (size_t)(t + 1) * kstep;
            const char* a2 = last ? nA : cA + (size_t)(t + 2) * kstep; const char* b2 = last ? nB : cB + (size_t)(t + 2) * kstep;
            const char* a3 = a2 + kstep; const char* b3 = b2 + kstep;
            if (last && has_next) S.a_ready(nxt);
            PG8_LDB(B0, 0, 0); PG8_SCHED; PG8_LDA(At, 0, 0); PG8_STAGE(PG8_SA(1, 1), a1 + hstep, voffA);
            PG8_WAIT_L(8); PG8_BAR; PG8_WAIT_L(0); PG8_MMA(0, 0, At, B0); PG8_BAR; PG8_SCHED;
            PG8_LDB(B1, 0, 1); PG8_STAGE(PG8_SB(0, 0), b2, voffB);
            PG8_BAR; PG8_WAIT_L(0); PG8_MMA(0, 1, At, B1); PG8_BAR;
            PG8_LDA(At, 0, 1); PG8_STAGE(PG8_SA(0, 0), a2, voffA);
            PG8_BAR; PG8_WAIT_L(0); PG8_MMA(1, 0, At, B0); PG8_BAR; PG8_SCHED;
            PG8_STAGE(PG8_SB(0, 1), b2 + hstep, voffB);
            PG8_WAIT_V(6); PG8_BAR; PG8_MMA(1, 1, At, B1); PG8_BAR;
            PG8_LDB(B0, 1, 0); PG8_SCHED; PG8_LDA(At, 1, 0); PG8_STAGE(PG8_SA(0, 1), a2 + hstep, voffA);
            PG8_WAIT_L(8); PG8_BAR; PG8_WAIT_L(0); PG8_MMA(0, 0, At, B0); PG8_BAR; PG8_SCHED;
            PG8_LDB(B1, 1, 1); PG8_STAGE(PG8_SB(1, 0), b3, voffB);
            PG8_BAR; PG8_WAIT_L(0); PG8_MMA(0, 1, At, B1); PG8_BAR;
            PG8_LDA(At, 1, 1); PG8_STAGE(PG8_SA(1, 0), a3, voffA);
            PG8_BAR; PG8_WAIT_L(0); PG8_MMA(1, 0, At, B0); PG8_BAR; PG8_SCHED;
            PG8_STAGE(PG8_SB(1, 1), b3 + hstep, voffB);
            PG8_WAIT_V(6); PG8_BAR; PG8_MMA(1, 1, At, B1); PG8_BAR;
        }
        if constexpr (!Epi::AFTER_DRAIN) { E(acc, cur, wr, wc, fr, fq); S.done(cur); }
        if (!has_next) break;
#pragma unroll
        for (int a = 0; a < 2; ++a)
#pragma unroll
            for (int b = 0; b < 2; ++b)
#pragma unroll
                for (int m = 0; m < 4; ++m)
#pragma unroll
                    for (int n = 0; n < 2; ++n) acc[a][b][m][n] = (f32x4){0.f, 0.f, 0.f, 0.f};
        cur = nxt; cA = nA; cB = nB; ++ui;
    }
    PG8_WAIT_V(0);
    if (wr == 0) PG8_BAR;
    PG8_BAR;
    if constexpr (Epi::AFTER_DRAIN) { E.fused(acc, cur, wr, wc, fr, fq, lds, wid, lane); S.done(cur); }
#undef PG8_SA
#undef PG8_SB
#undef PG8_STAGE
#undef PG8_LDA
#undef PG8_LDB
#undef PG8_MMA
#undef PG8_WAIT_V
#undef PG8_WAIT_L
#undef PG8_BAR
#undef PG8_SCHED
}
}

__host__ __device__ __forceinline__ int cmap_in(int F) { return (F & ~255) + 128 * ((F >> 5) & 1) + 32 * ((F >> 6) & 3) + (F & 31); }
struct EpiInprojMF {
    static constexpr bool PERM = true, AFTER_DRAIN = false;
    bf16_t* P; const float* rinv; const float* bias_f; const int* pos; const float* ftab; const float* qg; const float* kg; const float* swf;
    __device__ __forceinline__ void operator()(pg8::f32x4 (&acc)[2][2][4][2], const pg8::Unit& u, int wr, int wc, int fr, int fq) const {
        typedef pg8::f32x4 f32x4;
        asm volatile("" : "+v"(fr), "+v"(fq));
        const int type = u.pn >> 1, head = 4 * (u.pn & 1) + wc, fb = 256 * u.pn + 64 * wc;
        {
            f32x4 sw[2][2];
#pragma unroll
            for (int bj = 0; bj < 2; ++bj)
#pragma unroll
                for (int n = 0; n < 2; ++n) sw[bj][n] = *(const f32x4*)(swf + fb + 32 * bj + 8 * fq + 4 * n);
#pragma unroll
            for (int ai = 0; ai < 2; ++ai)
#pragma unroll
                for (int bj = 0; bj < 2; ++bj)
#pragma unroll
                    for (int m = 0; m < 4; ++m)
#pragma unroll
                        for (int n = 0; n < 2; ++n) {
                            const pg8::i32x4 iv = __builtin_bit_cast(pg8::i32x4, acc[ai][bj][m][n]);
                            f32x4 fv; fv[0] = (float)iv[0]; fv[1] = (float)iv[1]; fv[2] = (float)iv[2]; fv[3] = (float)iv[3];
                            acc[ai][bj][m][n] = fv * sw[bj][n];
                        }
        }
        const size_t PSZ = (size_t)T * 512;
        const int rslot = (type == 0) ? 0 : (type == 1) ? 1 : (type == 2) ? 5 : (type == 3) ? 2 : (type == 4) ? 3 : (type == 5) ? 4 : 6;
        bf16_t* rowmaj = P + (size_t)rslot * PSZ;
        const int t0 = u.pm * 256 + wr * 64 + fr;
        f32x4 bv[2][2], gv[2][2], fh[2], fl[2];
#pragma unroll
        for (int bj = 0; bj < 2; ++bj)
#pragma unroll
            for (int n = 0; n < 2; ++n) bv[bj][n] = *(const f32x4*)(bias_f + fb + 32 * bj + 8 * fq + 4 * n);
        if (type <= 1) {
#pragma unroll
            for (int n = 0; n < 2; ++n) { fh[n] = *(const f32x4*)(ftab + 8 * fq + 4 * n); fl[n] = *(const f32x4*)(ftab + 32 + 8 * fq + 4 * n); }
        } else if (type == 4 || type == 5) {
            const float* gsrc = (type == 4) ? qg : kg;
#pragma unroll
            for (int bj = 0; bj < 2; ++bj)
#pragma unroll
                for (int n = 0; n < 2; ++n) gv[bj][n] = *(const f32x4*)(gsrc + 32 * bj + 8 * fq + 4 * n);
        }
#pragma unroll
        for (int ai = 0; ai < 2; ++ai) {
            float rv[4], pf[4];
#pragma unroll
            for (int m = 0; m < 4; ++m) { rv[m] = rinv[t0 + ai * 128 + m * 16]; pf[m] = (float)pos[t0 + ai * 128 + m * 16]; }
            asm volatile("" : "+v"(rv[0]), "+v"(rv[1]), "+v"(rv[2]), "+v"(rv[3]), "+v"(pf[0]), "+v"(pf[1]), "+v"(pf[2]), "+v"(pf[3]));
#pragma unroll
            for (int m = 0; m < 4; ++m) {
                const int t = t0 + ai * 128 + m * 16;
                const float r = rv[m];
                f32x4 v[2][2];
#pragma unroll
                for (int bj = 0; bj < 2; ++bj)
#pragma unroll
                    for (int n = 0; n < 2; ++n) v[bj][n] = acc[ai][bj][m][n] * r + bv[bj][n];
                if (type <= 1) {
                    const float sc = (type == 1) ? 0.125f : 1.f, pp = pf[m];
#pragma unroll
                    for (int n = 0; n < 2; ++n)
#pragma unroll
                        for (int j = 0; j < 4; ++j) {
                            const float rev = __builtin_amdgcn_fractf(__builtin_amdgcn_fractf(pp * fh[n][j]) + pp * fl[n][j]);
                            const float cs = __builtin_amdgcn_cosf(rev) * sc, sn = __builtin_amdgcn_sinf(rev) * sc;
                            const float x1 = v[0][n][j], x2 = v[1][n][j]; v[0][n][j] = x1 * cs - x2 * sn; v[1][n][j] = x2 * cs + x1 * sn;
                        }
                } else if (type == 3) {
#pragma unroll
                    for (int bj = 0; bj < 2; ++bj)
#pragma unroll
                        for (int n = 0; n < 2; ++n)
#pragma unroll
                            for (int j = 0; j < 4; ++j) { const float x = v[bj][n][j]; v[bj][n][j] = x / (1.f + __expf(-x)); }
                } else if (type == 4 || type == 5) {
                    float ss = 0.f;
#pragma unroll
                    for (int bj = 0; bj < 2; ++bj)
#pragma unroll
                        for (int n = 0; n < 2; ++n)
#pragma unroll
                            for (int j = 0; j < 4; ++j) ss += v[bj][n][j] * v[bj][n][j];
                    ss += __shfl_xor(ss, 16); ss += __shfl_xor(ss, 32);
                    const float rn = (1.0f / sqrtf(ss * (1.f / 64.f) + EPS)) * ((type == 4) ? 0.125f * 1.44269504089f : 1.f);
#pragma unroll
                    for (int bj = 0; bj < 2; ++bj)
#pragma unroll
                        for (int n = 0; n < 2; ++n) v[bj][n] = v[bj][n] * rn * gv[bj][n];
                }
#pragma unroll
                for (int bj = 0; bj < 2; ++bj) {
                    pg8::u32x4 w; w.x = pg8::cvt_pk_bf16(v[bj][0][0], v[bj][0][1]); w.y = pg8::cvt_pk_bf16(v[bj][0][2], v[bj][0][3]);
                    w.z = pg8::cvt_pk_bf16(v[bj][1][0], v[bj][1][1]); w.w = pg8::cvt_pk_bf16(v[bj][1][2], v[bj][1][3]);
                    *(pg8::u32x4*)(rowmaj + (size_t)t * 512 + head * 64 + 32 * bj + 8 * fq) = w;
                }
            }
        }
    }
};

struct EpiOutprojMF {
    static constexpr bool PERM = false, AFTER_DRAIN = true;
    const float* xf; const float* gate1; bf16_t* x1b; float* part2;
    float* pmax; unsigned char* x1q; float* rinv2q; unsigned* ctl;
    __device__ __forceinline__ void operator()(const pg8::f32x4 (&)[2][2][4][2], const pg8::Unit&, int, int, int, int) const {}
    __device__ __forceinline__ void fused(pg8::f32x4 (&acc)[2][2][4][2], const pg8::Unit& u, int wr, int wc, int fr, int fq, PG8_LAS unsigned char* lds, int wid, int lane) const {
        typedef pg8::f32x4 f32x4;
        asm volatile("" : "+v"(fr), "+v"(fq), "+v"(lane));
        constexpr int LD = 260;
        PG8_LAS float* TL = (PG8_LAS float*)lds;
        const int colw = wc * 32 + 4 * fq;
        f32x4 gv[2][2];
#pragma unroll
        for (int bj = 0; bj < 2; ++bj)
#pragma unroll
            for (int n = 0; n < 2; ++n) gv[bj][n] = *(const f32x4*)(gate1 + u.pn * 256 + colw + bj * 128 + n * 16);
        pg8::u32x2 ow[2][16];
#pragma unroll
        for (int ai = 0; ai < 2; ++ai) {
            f32x4 xv[16];
            const size_t rowbase = (size_t)(u.pm * 256 + ai * 128 + 16 * wid) * D + u.pn * 256 + 4 * lane;
#pragma unroll
            for (int r = 0; r < 16; ++r) xv[r] = __builtin_nontemporal_load((const f32x4*)(xf + rowbase + (size_t)r * D));
#pragma unroll
            for (int m = 0; m < 4; ++m)
#pragma unroll
                for (int bj = 0; bj < 2; ++bj)
#pragma unroll
                    for (int n = 0; n < 2; ++n) *(PG8_LAS f32x4*)(TL + (64 * wr + 16 * m + fr) * LD + colw + bj * 128 + n * 16) = gv[bj][n] * acc[ai][bj][m][n];
            __syncthreads();
            float ssr[16], amr[16];
#pragma unroll
            for (int r = 0; r < 16; ++r) {
                const f32x4 g = *(PG8_LAS f32x4*)(TL + (16 * wid + r) * LD + 4 * lane);
                const f32x4 o = xv[r] + g;
                pg8::u32x2 w; w.x = pg8::cvt_pk_bf16(o[0], o[1]); w.y = pg8::cvt_pk_bf16(o[2], o[3]);
                *(pg8::u32x2*)(x1b + rowbase + (size_t)r * D) = w;
                ow[ai][r] = w;
                ssr[r] = o[0] * o[0] + o[1] * o[1] + o[2] * o[2] + o[3] * o[3];
                amr[r] = fmaxf(fmaxf(__uint_as_float((w.x << 16) & 0x7fffffffu), __uint_as_float(w.x & 0x7fff0000u)), fmaxf(__uint_as_float((w.y << 16) & 0x7fffffffu), __uint_as_float(w.y & 0x7fff0000u)));
            }
            {
                const bool b5 = lane & 32, b4 = lane & 16, b3 = lane & 8, b2 = lane & 4;
                float w8[8], w4[4], w2[2], w1;
#pragma unroll
                for (int i = 0; i < 8; ++i) w8[i] = (b5 ? ssr[8 + i] : ssr[i]) + __shfl_xor(b5 ? ssr[i] : ssr[8 + i], 32);
#pragma unroll
                for (int i = 0; i < 4; ++i) w4[i] = (b4 ? w8[4 + i] : w8[i]) + __shfl_xor(b4 ? w8[i] : w8[4 + i], 16);
#pragma unroll
                for (int i = 0; i < 2; ++i) w2[i] = (b3 ? w4[2 + i] : w4[i]) + __shfl_xor(b3 ? w4[i] : w4[2 + i], 8);
                w1 = (b2 ? w2[1] : w2[0]) + __shfl_xor(b2 ? w2[0] : w2[1], 4);
                w1 += __shfl_xor(w1, 2); w1 += __shfl_xor(w1, 1);
                part2[(size_t)(u.pm * 256 + ai * 128 + 16 * wid + (lane >> 2)) * 16 + u.pn * 4 + (lane & 3)] = ((lane & 3) == 0) ? w1 : 0.f;
#pragma unroll
                for (int i = 0; i < 8; ++i) w8[i] = fmaxf(b5 ? amr[8 + i] : amr[i], __shfl_xor(b5 ? amr[i] : amr[8 + i], 32));
#pragma unroll
                for (int i = 0; i < 4; ++i) w4[i] = fmaxf(b4 ? w8[4 + i] : w8[i], __shfl_xor(b4 ? w8[i] : w8[4 + i], 16));
#pragma unroll
                for (int i = 0; i < 2; ++i) w2[i] = fmaxf(b3 ? w4[2 + i] : w4[i], __shfl_xor(b3 ? w4[i] : w4[2 + i], 8));
                w1 = fmaxf(b2 ? w2[1] : w2[0], __shfl_xor(b2 ? w2[0] : w2[1], 4));
                w1 = fmaxf(w1, __shfl_xor(w1, 2)); w1 = fmaxf(w1, __shfl_xor(w1, 1));
                if ((lane & 3) == 0) pmax[(size_t)(u.pm * 256 + ai * 128 + 16 * wid + (lane >> 2)) * 4 + u.pn] = w1;
            }
            __syncthreads();
        }
        asm volatile("s_waitcnt vmcnt(0)" ::: "memory");
        __syncthreads();
        if (wid == 0 && lane == 0) {
            unsigned* c = ctl + CTL_CNT + 16 * u.pm;
            __builtin_amdgcn_fence(__ATOMIC_RELEASE, "agent");
            asm volatile("s_waitcnt vmcnt(0)" ::: "memory");
            (void)xb_add(c, 1u);
            XB_SPIN(xb_ld(c) < 4u, ctl);
            __builtin_amdgcn_fence(__ATOMIC_ACQUIRE, "agent");
        }
        __syncthreads();
        float qsl = 0.f;
        {
            const int row = u.pm * 256 + (lane >> 4 & 1) * 128 + 16 * wid + (lane & 15);
            const f32x4* pp = (const f32x4*)(part2 + (size_t)row * 16);
            const f32x4 p0 = pp[0], p1 = pp[1], p2 = pp[2], p3 = pp[3], pm4 = *(const f32x4*)(pmax + (size_t)row * 4);
            const float ssum = ((p0[0] + p0[1]) + (p0[2] + p0[3])) + ((p1[0] + p1[1]) + (p1[2] + p1[3])) + ((p2[0] + p2[1]) + (p2[2] + p2[3])) + ((p3[0] + p3[1]) + (p3[2] + p3[3]));
            const float am = fmaxf(fmaxf(pm4[0], pm4[1]), fmaxf(pm4[2], pm4[3]));
            qsl = (am > 0.f) ? 127.f / am : 0.f;
            if (u.pn == 0 && lane < 32) rinv2q[row] = (1.0f / sqrtf(ssum * (1.0f / D) + EPS)) * (am * (1.f / 127.f));
        }
#pragma unroll
        for (int ai = 0; ai < 2; ++ai)
#pragma unroll
            for (int r = 0; r < 16; ++r) {
                const float qs = __builtin_bit_cast(float, __builtin_amdgcn_readlane(__builtin_bit_cast(int, qsl), ai * 16 + r));
                const pg8::u32x2 w = ow[ai][r];
                const unsigned b0 = __float_as_uint(fmaf(__uint_as_float(w.x << 16), qs, 12582912.f)), b1 = __float_as_uint(fmaf(__uint_as_float(w.x & 0xffff0000u), qs, 12582912.f));
                const unsigned b2 = __float_as_uint(fmaf(__uint_as_float(w.y << 16), qs, 12582912.f)), b3 = __float_as_uint(fmaf(__uint_as_float(w.y & 0xffff0000u), qs, 12582912.f));
                *(unsigned*)(x1q + (size_t)(u.pm * 256 + ai * 128 + 16 * wid + r) * D + u.pn * 256 + 4 * lane) = (b0 & 255u) | ((b1 & 255u) << 8) | ((b2 & 255u) << 16) | (b3 << 24);
            }
    }
};

__device__ __forceinline__ unsigned pk2(float lo, float hi) { return (unsigned)f2bf(lo) | ((unsigned)f2bf(hi) << 16); }
template <bool FOLD, bool CMAP>
__device__ __forceinline__ void transpose_item(const float* W, int K, int N, bf16_t* WT, float* scr, int item, int lane, const float* sg, const float* sm) {
    const int nblk = N / 32, kb = item / nblk, nb = item % nblk, k0 = 64 * kb, n0 = 32 * nb;
    float4 v[8]; float f[8];
#pragma unroll
    for (int i = 0; i < 8; ++i) { const int kk = 8 * i + (lane >> 3); v[i] = *(const float4*)(W + (size_t)(k0 + kk) * N + n0 + 4 * (lane & 7));
        f[i] = FOLD ? sg[k0 + kk] * (1.f + sm[k0 + kk]) : 1.f; }
#pragma unroll
    for (int i = 0; i < 8; ++i) { const int kk = 8 * i + (lane >> 3); float* d = scr + kk * 33 + 4 * (lane & 7);
        d[0] = v[i].x * f[i]; d[1] = v[i].y * f[i]; d[2] = v[i].z * f[i]; d[3] = v[i].w * f[i]; }
    asm volatile("s_waitcnt lgkmcnt(0)" ::: "memory");
    const int c = lane & 7, r0 = CMAP ? cmap_in(n0) : n0;
#pragma unroll
    for (int j = 0; j < 4; ++j) { const int n = (lane >> 3) + 8 * j; const float* s = scr + (8 * c) * 33 + n;
        pg8::u32x4 o; o.x = pk2(s[0 * 33], s[1 * 33]); o.y = pk2(s[2 * 33], s[3 * 33]); o.z = pk2(s[4 * 33], s[5 * 33]); o.w = pk2(s[6 * 33], s[7 * 33]);
        *(pg8::u32x4*)(WT + (size_t)(r0 + n) * K + k0 + 8 * c) = o; }
    asm volatile("s_waitcnt lgkmcnt(0)" ::: "memory");
}
template <int NC4, class VF>
__device__ __forceinline__ void gemv_cols(unsigned char* lds, const VF vf, const float* W, const int N, const int u, float* dst, const float* add) {
    constexpr int RG = 512 / NC4;
    float (*red)[NC4 * 4] = (float (*)[NC4 * 4])lds;
    const int tid = threadIdx.x, c4 = tid % NC4, rg = tid / NC4;
    if (rg < RG) {
        float4 acc = {0.f, 0.f, 0.f, 0.f};
        for (int r = rg; r < 1024; r += RG) { const float s = vf(r); const float4 w = *(const float4*)(W + (size_t)r * N + u * NC4 * 4 + c4 * 4);
            acc.x += s * w.x; acc.y += s * w.y; acc.z += s * w.z; acc.w += s * w.w; }
        red[rg][c4 * 4 + 0] = acc.x; red[rg][c4 * 4 + 1] = acc.y; red[rg][c4 * 4 + 2] = acc.z; red[rg][c4 * 4 + 3] = acc.w;
    }
    __syncthreads();
    if (tid < NC4 * 4) { float s = 0.f; for (int i = 0; i < RG; ++i) s += red[i][tid]; dst[u * NC4 * 4 + tid] = s + (add ? add[u * NC4 * 4 + tid] : 0.f); }
    __syncthreads();
}
struct VfSilu { const float* c; __device__ __forceinline__ float operator()(int r) const { const float v = c[r]; return v / (1.f + expf(-v)); } };
struct VfVec { const float* v; __device__ __forceinline__ float operator()(int r) const { return v[r]; } };


typedef float f32x16 __attribute__((ext_vector_type(16)));
typedef pg8::bf16x8 bf16x8;
#define MFMA32(a, b, c) __builtin_amdgcn_mfma_f32_32x32x16_bf16((a), (b), (c), 0, 0, 0)
__device__ __forceinline__ bf16x8 pack_frag(const f32x16& v, int s) {
    pg8::u32x4 w;
    w.x = pg8::cvt_pk_bf16(v[8 * s + 0], v[8 * s + 1]); w.y = pg8::cvt_pk_bf16(v[8 * s + 2], v[8 * s + 3]);
    w.z = pg8::cvt_pk_bf16(v[8 * s + 4], v[8 * s + 5]); w.w = pg8::cvt_pk_bf16(v[8 * s + 6], v[8 * s + 7]);
    return __builtin_bit_cast(bf16x8, w);
}
__device__ __forceinline__ bf16x8 load_tfrag(const bf16_t* rowp, int tok) {
    const uint2 a = *(const uint2*)(rowp + tok), b = *(const uint2*)(rowp + tok + 8);
    pg8::u32x4 w; w.x = a.x; w.y = a.y; w.z = b.x; w.w = b.y;
    return __builtin_bit_cast(bf16x8, w);
}


__device__ __forceinline__ bf16x8 tr_frag(const unsigned char* a0, int rows2) {
    typedef short s16x4 __attribute__((ext_vector_type(4)));
    typedef __attribute__((address_space(3))) s16x4 lds_s16x4;
    const s16x4 lo = __builtin_amdgcn_ds_read_tr16_b64_v4i16((lds_s16x4*)a0);
    const s16x4 hi = __builtin_amdgcn_ds_read_tr16_b64_v4i16((lds_s16x4*)(a0 + rows2 * 144));
    const uint2 l2 = __builtin_bit_cast(uint2, lo), h2 = __builtin_bit_cast(uint2, hi);
    pg8::u32x4 fw; fw.x = l2.x; fw.y = l2.y; fw.z = h2.x; fw.w = h2.y;
    return __builtin_bit_cast(bf16x8, fw);
}

__device__ __forceinline__ void ins16(float (&s)[16], float x) {
#pragma unroll
    for (int i = 15; i >= 1; --i) s[i] = __builtin_amdgcn_fmed3f(s[i - 1], s[i], x);
    s[0] = fmaxf(s[0], x);
}


struct OneUnitOrder {
    pg8::StaticOrder base; int round;
    __device__ __forceinline__ bool next(int i, pg8::Unit& u) const { if (i != 0) return false; return base.next(round, u); }
    __device__ __forceinline__ void a_ready(const pg8::Unit&) const {}
    __device__ __forceinline__ void done(const pg8::Unit&) const {}
};
struct EpiTopkMF {
    static constexpr bool PERM = false, AFTER_DRAIN = true;
    const float* rinv2q; const float* sq; const float* bias_q; unsigned short* ids; float* gates;
    __device__ __forceinline__ void operator()(const pg8::f32x4 (&)[2][2][4][2], const pg8::Unit&, int, int, int, int) const {}
    __device__ __forceinline__ void fused(pg8::f32x4 (&acc)[2][2][4][2], const pg8::Unit& u, int wr, int wc, int fr, int fq, PG8_LAS unsigned char* lds, int wid, int lane) const {
        typedef pg8::f32x4 f32x4;
        constexpr int SLD = 260;
        PG8_LAS float* SC = (PG8_LAS float*)lds; PG8_LAS float* MG = (PG8_LAS float*)(lds + 128 * SLD * 4);
        const int tid = wid * 64 + lane, tok = tid & 255, hk = tid >> 8;
        float rinv[2][4];
#pragma unroll
        for (int ai = 0; ai < 2; ++ai)
#pragma unroll
            for (int m = 0; m < 4; ++m) {
                const int row = u.pm * 256 + ai * 128 + wr * 64 + m * 16 + fr;
                rinv[ai][m] = rinv2q[row];
            }
        float sl[16], mine[16];
#pragma unroll
        for (int p = 0; p < 2; ++p) {
            f32x4 bv[2], sv[2];
#pragma unroll
            for (int n = 0; n < 2; ++n) { bv[n] = *(const f32x4*)(bias_q + u.pn * 256 + p * 128 + wc * 32 + n * 16 + 4 * fq); sv[n] = *(const f32x4*)(sq + u.pn * 256 + p * 128 + wc * 32 + n * 16 + 4 * fq); }
#pragma unroll
            for (int ai = 0; ai < 2; ++ai)
#pragma unroll
                for (int m = 0; m < 4; ++m)
#pragma unroll
                    for (int n = 0; n < 2; ++n)
#pragma unroll
                        for (int j = 0; j < 4; ++j)
                            SC[(32 * wc + 16 * n + 4 * fq + j) * SLD + (128 * ai + 64 * wr + 16 * m + fr)] = (float)__builtin_bit_cast(pg8::i32x4, acc[ai][p][m][n])[j] * (rinv[ai][m] * sv[n][j]) + bv[n][j];
            __syncthreads();
#pragma unroll
            for (int i = 0; i < 16; ++i) sl[i] = -INFINITY;
#pragma unroll 8
            for (int k = 0; k < 64; ++k) { const int key = 64 * hk + k; const float x = SC[key * SLD + tok]; ins16(sl, __uint_as_float((__float_as_uint(x) & 0xFFFFFF80u) | (unsigned)key)); }
            if (hk != p) {
#pragma unroll
                for (int i = 0; i < 16; ++i) MG[i * 256 + tok] = sl[i];
            }
            __syncthreads();
            if (hk == p) {
#pragma unroll
                for (int i = 0; i < 16; ++i) ins16(sl, MG[i * 256 + tok]);
#pragma unroll
                for (int i = 0; i < 16; ++i) mine[i] = sl[i];
            }
            __syncthreads();
        }
        PG8_LAS float* X1 = SC; PG8_LAS float* TL = SC + 4096; PG8_LAS unsigned* I0 = (PG8_LAS unsigned*)(SC + 8192); PG8_LAS unsigned* I1 = (PG8_LAS unsigned*)(SC + 12288);
        if (hk) {
#pragma unroll
            for (int i = 0; i < 16; ++i) { X1[i * 256 + tok] = mine[i]; I1[i * 256 + tok] = __float_as_uint(mine[i]) & 0x7Fu; }
        } else {
#pragma unroll
            for (int i = 0; i < 16; ++i) I0[i * 256 + tok] = __float_as_uint(mine[i]) & 0x7Fu;
        }
        __syncthreads();
        if (!hk) {
            float s1m[16], tl[16];
#pragma unroll
            for (int i = 0; i < 16; ++i) { s1m[i] = __uint_as_float(__float_as_uint(X1[i * 256 + tok]) & 0xFFFFFF80u); mine[i] = __uint_as_float(__float_as_uint(mine[i]) & 0xFFFFFF80u); tl[i] = -INFINITY; }
#pragma unroll
            for (int a2 = 0; a2 < 16; ++a2)
#pragma unroll
                for (int b2 = 0; b2 < 16; ++b2)
                    if ((a2 + 1) * (b2 + 1) <= 16) ins16(tl, __uint_as_float((__float_as_uint(mine[a2] + s1m[b2]) & 0xFFFFFF00u) | (unsigned)(a2 * 16 + b2)));
#pragma unroll
            for (int i = 0; i < 16; ++i) TL[i * 256 + tok] = tl[i];
        }
        __syncthreads();
        if (hk) {
            float ev[16]; float sum = 0.f; unsigned cd[16];
#pragma unroll
            for (int j = 0; j < 16; ++j) { const unsigned bits = __float_as_uint(TL[j * 256 + tok]); cd[j] = bits & 0xFFu; ev[j] = __uint_as_float(bits & 0xFFFFFF00u); }
            const float mx = ev[0];
#pragma unroll
            for (int j = 0; j < 16; ++j) { ev[j] = __expf(ev[j] - mx); sum += ev[j]; }
            const float inv = 1.f / sum;
            unsigned idw[8];
#pragma unroll
            for (int j = 0; j < 16; ++j) {
                const unsigned id = I0[(cd[j] >> 4) * 256 + tok] * 128u + I1[(cd[j] & 15u) * 256 + tok];
                if (j & 1) idw[j >> 1] |= id << 16; else idw[j >> 1] = id;
                ev[j] *= inv;
            }
            const size_t t = (size_t)u.pm * 256 + tok;
            unsigned short* idp = ids + t * 128 + u.pn * 16; float* gp = gates + t * 128 + u.pn * 16;
            *(uint4*)idp = make_uint4(idw[0], idw[1], idw[2], idw[3]); *(uint4*)(idp + 8) = make_uint4(idw[4], idw[5], idw[6], idw[7]);
#pragma unroll
            for (int q = 0; q < 4; ++q) *(float4*)(gp + 4 * q) = make_float4(ev[4 * q], ev[4 * q + 1], ev[4 * q + 2], ev[4 * q + 3]);
        }
        __syncthreads();
    }
};


__device__ __forceinline__ void convert_tables(const float* down, const float* up, unsigned char* q8, bf16_t* dsc, int lane, int cw, int nconv, int r0, int r1) {
    for (int row0 = r0 + cw * 2; row0 < r1; row0 += nconv * 2) {
        float4 v[2][4];
#pragma unroll
        for (int rr = 0; rr < 2; ++rr) {
            const int row = row0 + rr, isup = row >> 14, e = row & 16383;
            const float* sp = (isup ? up : down) + (size_t)e * 1024 + lane * 4;
#pragma unroll
            for (int q = 0; q < 4; ++q) v[rr][q] = ld_nt4(sp + 256 * q);
        }
#pragma unroll
        for (int rr = 0; rr < 2; ++rr) {
            const int row = row0 + rr, isup = row >> 14, e = row & 16383;
            {
                float ss = 0.f;
#pragma unroll
                for (int q = 0; q < 4; ++q) ss += v[rr][q].x * v[rr][q].x + v[rr][q].y * v[rr][q].y + v[rr][q].z * v[rr][q].z + v[rr][q].w * v[rr][q].w;
#pragma unroll
                for (int o = 32; o > 0; o >>= 1) ss += __shfl_xor(ss, o);
                const float sigma = sqrtf(ss * (1.0f / 1024.0f));
                const float s = (sigma > 0.f) ? 7.5f / (2.6f * sigma) : 1.f;
#pragma unroll
                for (int q = 0; q < 4; ++q) {
                    const int n0 = (int)fminf(fmaxf(__builtin_rintf(v[rr][q].x * s), -8.f), 7.f) + 8, n1 = (int)fminf(fmaxf(__builtin_rintf(v[rr][q].y * s), -8.f), 7.f) + 8;
                    const int n2 = (int)fminf(fmaxf(__builtin_rintf(v[rr][q].z * s), -8.f), 7.f) + 8, n3 = (int)fminf(fmaxf(__builtin_rintf(v[rr][q].w * s), -8.f), 7.f) + 8;
                    const int h1 = isup ? ((n1 - 8) & 15) : n1, h3 = isup ? ((n3 - 8) & 15) : n3;
                    *(unsigned short*)(q8 + (size_t)isup * (8u << 20) + ((size_t)q * 16384 + e) * 128 + (lane & 7) * 16 + (lane >> 3) * 2) = (unsigned short)(n0 | (h1 << 4) | (n2 << 8) | (h3 << 12));
                }
                if (lane == 0) dsc[row] = f2bf(1.0f / s);
            }
        }
    }
}

struct Params {
    const float *x, *c; const int* pos; const float *ada_w, *ada_b, *g1, *g2, *w_in, *rgain, *qg, *kg, *og, *w_out, *wq, *sk, *down, *up;
    float* out; unsigned char* ws; RopeC rc;
};

__global__ void __launch_bounds__(512) mk_fwd(Params p) {
    extern __shared__ __attribute__((aligned(16))) unsigned char lds[];
    const int tid = threadIdx.x, lane = tid & 63, bid = blockIdx.x, G = gridDim.x; int wave = tid >> 6;
    unsigned char* ws = p.ws;
    float* mod = (float*)(ws + OFF_MOD); float* rinv1 = (float*)(ws + OFF_RINV1); float* ftab = (float*)(ws + OFF_ROPE);
    bf16_t* P = (bf16_t*)(ws + OFF_P); float* kv = (float*)(ws + OFF_KV); bf16_t* stT = (bf16_t*)(ws + OFF_ST); bf16_t* ycat = (bf16_t*)(ws + OFF_YCAT);
    bf16_t* Win_t = (bf16_t*)(ws + OFF_WINT); float* bias_f = (float*)(ws + OFF_BIASF);
    unsigned char* xq = ws + OFF_XQ; float* swf = (float*)(ws + OFF_SWF);
    float* sq = (float*)(ws + OFF_SQ); float* pmax = (float*)(ws + OFF_PMAX); float* rinv2q = (float*)(ws + OFF_RINV2Q); unsigned char* Weffq_t = ws + OFF_WEFFQ; unsigned char* x1q = ws + OFF_X1Q;
    unsigned* ctl = (unsigned*)(ws + OFF_CTL);
    bf16_t* Weff_t = (bf16_t*)(ws + OFF_WEFFT); bf16_t* Wout_t = (bf16_t*)(ws + OFF_WOUTT); float* bias_q = (float*)(ws + OFF_BIASQ); float* bq_part = (float*)(ws + OFF_BQPART);
    float* part2 = (float*)(ws + OFF_PART2); bf16_t* x1b = (bf16_t*)(ws + OFF_X1B); unsigned short* ids = (unsigned short*)(ws + OFF_IDS); unsigned char* q8 = ws + OFF_Q8; bf16_t* dsc = (bf16_t*)(ws + OFF_DSC); float* gates = (float*)(ws + OFF_GATES);
    const size_t PS = (size_t)T * 512;
    const bf16_t *Qr = P, *Kr = P + PS, *Gr = P + 2 * PS, *Qs = P + 3 * PS, *Ks = P + 4 * PS, *Vr = P + 5 * PS, *Vs = P + 6 * PS;
    float* out = p.out;

    if (tid < 4) ((LAS unsigned*)((LAS unsigned char*)lds + LDS_ST_OFF))[tid] = 0u;
    __syncthreads();
    XcdBarrier bar = xcd_barrier_post((unsigned*)(ws + OFF_CTL), (volatile LAS unsigned*)((LAS unsigned char*)lds + LDS_ST_OFF));

    for (int u = bid; u < 256; u += G) gemv_cols<6>(lds, VfSilu{p.c}, p.ada_w, 6144, u, mod, p.ada_b);
    for (int row0 = (bid * 8 + wave) * 2; row0 < T; row0 += G * 16) {
        float4 v[2][4];
#pragma unroll
        for (int rr = 0; rr < 2; ++rr)
#pragma unroll
            for (int j = 0; j < 4; ++j) v[rr][j] = ld_nt4(p.x + (size_t)(row0 + rr) * D + (lane + 64 * j) * 4);
#pragma unroll
        for (int rr = 0; rr < 2; ++rr) {
            float s = 0.f, am = 0.f;
#pragma unroll
            for (int j = 0; j < 4; ++j) { const float4 q = v[rr][j]; s += q.x * q.x + q.y * q.y + q.z * q.z + q.w * q.w;
                am = fmaxf(fmaxf(am, fmaxf(fabsf(q.x), fabsf(q.y))), fmaxf(fabsf(q.z), fabsf(q.w))); }
#pragma unroll
            for (int o = 32; o > 0; o >>= 1) { s += __shfl_xor(s, o); am = fmaxf(am, __shfl_xor(am, o)); }
            const float qs = (am > 0.f) ? 127.f / am : 0.f;
            unsigned* xqo = (unsigned*)(xq + (size_t)(row0 + rr) * D);
#pragma unroll
            for (int j = 0; j < 4; ++j) { const float4 q = v[rr][j];
                const unsigned b0 = __float_as_uint(fmaf(q.x, qs, 12582912.f)), b1 = __float_as_uint(fmaf(q.y, qs, 12582912.f)), b2 = __float_as_uint(fmaf(q.z, qs, 12582912.f)), b3 = __float_as_uint(fmaf(q.w, qs, 12582912.f));
                xqo[lane + 64 * j] = (b0 & 255u) | ((b1 & 255u) << 8) | ((b2 & 255u) << 16) | (b3 << 24); }
            if (lane == 0) rinv1[row0 + rr] = (1.0f / sqrtf(s * (1.0f / D) + EPS)) * (am * (1.f / 127.f));
        }
    }
    if (bid == 0 && tid == 0) {
#pragma unroll
        for (int i = 0; i < 32; ++i) { ftab[i] = p.rc.fh[i]; ftab[32 + i] = p.rc.fl[i]; }
    }
    xcd_barrier(bar);

    {
        for (int nb = bid; nb < 112; nb += G) {
            const int n0 = 32 * nb, r8 = lane >> 3, c = lane & 7, kw = 128 * wave;
            float* cm = (float*)(lds + 8 * 4608);
            unsigned* tl = (unsigned*)(lds + wave * 4608);
            float4 v[16];
#pragma unroll
            for (int i = 0; i < 16; ++i) { const int kk = 32 * (i >> 2) + 4 * r8 + (i & 3); v[i] = *(const float4*)(p.w_in + (size_t)(kw + kk) * 3584 + n0 + 4 * c); }
            float4 mx = {0.f, 0.f, 0.f, 0.f};
#pragma unroll
            for (int i = 0; i < 16; ++i) { const int kk = 32 * (i >> 2) + 4 * r8 + (i & 3); const float f = p.g1[kw + kk] * (1.f + mod[1024 + kw + kk]);
                v[i].x *= f; v[i].y *= f; v[i].z *= f; v[i].w *= f;
                mx.x = fmaxf(mx.x, fabsf(v[i].x)); mx.y = fmaxf(mx.y, fabsf(v[i].y)); mx.z = fmaxf(mx.z, fabsf(v[i].z)); mx.w = fmaxf(mx.w, fabsf(v[i].w)); }
#pragma unroll
            for (int o = 8; o < 64; o <<= 1) { mx.x = fmaxf(mx.x, __shfl_xor(mx.x, o)); mx.y = fmaxf(mx.y, __shfl_xor(mx.y, o)); mx.z = fmaxf(mx.z, __shfl_xor(mx.z, o)); mx.w = fmaxf(mx.w, __shfl_xor(mx.w, o)); }
            if (lane < 8) *(float4*)(cm + wave * 32 + 4 * c) = mx;
            __syncthreads();
#pragma unroll
            for (int w2 = 0; w2 < 8; ++w2) { const float4 o = *(const float4*)(cm + w2 * 32 + 4 * c); mx.x = fmaxf(mx.x, o.x); mx.y = fmaxf(mx.y, o.y); mx.z = fmaxf(mx.z, o.z); mx.w = fmaxf(mx.w, o.w); }
            if (wave == 0 && lane < 8) *(float4*)(swf + n0 + 4 * c) = make_float4(mx.x * (1.f / 127.f), mx.y * (1.f / 127.f), mx.z * (1.f / 127.f), mx.w * (1.f / 127.f));
            const float qx = (mx.x > 0.f) ? 127.f / mx.x : 0.f, qy = (mx.y > 0.f) ? 127.f / mx.y : 0.f, qz = (mx.z > 0.f) ? 127.f / mx.z : 0.f, qw = (mx.w > 0.f) ? 127.f / mx.w : 0.f;
#pragma unroll
            for (int a = 0; a < 4; ++a) {
                unsigned d[4];
#pragma unroll
                for (int j = 0; j < 4; ++j) {
                    const float qq = (j == 0) ? qx : (j == 1) ? qy : (j == 2) ? qz : qw;
                    unsigned w = 0;
#pragma unroll
                    for (int b = 0; b < 4; ++b) { const float4 t = v[4 * a + b]; const float e = (j == 0) ? t.x : (j == 1) ? t.y : (j == 2) ? t.z : t.w;
                        w |= (__float_as_uint(fmaf(e, qq, 12582912.f)) & 255u) << (8 * b); }
                    d[j] = w;
                }
#pragma unroll
                for (int j = 0; j < 4; ++j) tl[(4 * c + j) * 34 + 8 * a + r8] = d[j];
            }
            asm volatile("s_waitcnt lgkmcnt(0)" ::: "memory");
            const int rb = cmap_in(n0);
#pragma unroll
            for (int jj = 0; jj < 4; ++jj) { const int q = lane + 64 * jj, n = q >> 3, ch = q & 7;
                const uint2 lo = *(const uint2*)(tl + n * 34 + 4 * ch), hi = *(const uint2*)(tl + n * 34 + 4 * ch + 2);
                pg8::u32x4 o; o.x = lo.x; o.y = lo.y; o.z = hi.x; o.w = hi.y;
                *(pg8::u32x4*)((unsigned char*)Win_t + (size_t)(rb + n) * 1024 + kw + 16 * ch) = o; }
            __syncthreads();
        }
        for (int u = bid - 128; u >= 0 && u < 128; u += G) gemv_cols<7>(lds, VfVec{mod}, p.w_in, 3584, u, bias_f, nullptr);
    }
    xcd_barrier(bar);

    {
        pg8::Gemm g{(const bf16_t*)xq, Win_t, T, 3584, 512}; pg8::StaticOrder S; S.init(T, 3584, G, bid);
        EpiInprojMF E{P, rinv1, bias_f, p.pos, ftab, p.qg, p.kg, swf};
        pg8::gemm_phase<EpiInprojMF, pg8::StaticOrder, true>((PG8_LAS unsigned char*)lds, g, S, E);
        const int nidle = (G > 128) ? G - 128 : G, ib = (G > 128) ? bid - 128 : bid;
        {
            float* scr = (float*)(lds + wave * 16384);
            if (ib >= 0) for (int it = ib * 8 + wave; it < 16 * 32; it += nidle * 8) transpose_item<false, false>(p.w_out, 1024, 1024, Wout_t, scr, it, lane, nullptr, nullptr);
            __syncthreads();
        }
        if (ib >= 0) for (int wu = ib; wu < 256; wu += nidle) {
            const int hp = wu >> 4, blk = wu & 15, i0 = blk * 64;
            __syncthreads();
            unsigned char* Wt = lds; unsigned char* St = lds + 64 * 272; float* bred = (float*)(lds + 64 * 272 + 128 * 272);
            for (int e4 = tid; e4 < 2048; e4 += 512) { const int r = e4 >> 5, c4 = e4 & 31; const float4 v = *(const float4*)(p.wq + (size_t)(i0 + r) * 2048 + hp * 128 + 4 * c4);
                *(uint2*)(Wt + r * 272 + c4 * 8) = make_uint2(pk2(v.x, v.y), pk2(v.z, v.w)); }
            for (int e4 = tid; e4 < 4096; e4 += 512) { const int r = e4 >> 5, c4 = e4 & 31; const float4 v = *(const float4*)(p.sk + ((size_t)hp * 128 + r) * 128 + 4 * c4);
                *(uint2*)(St + r * 272 + c4 * 8) = make_uint2(pk2(v.x, v.y), pk2(v.z, v.w)); }
            __syncthreads();
            const int rt = wave >> 2, ct = wave & 3, l31 = lane & 31, hf = lane >> 5;
            f32x16 C;
#pragma unroll
            for (int r = 0; r < 16; ++r) C[r] = 0.f;
#pragma unroll
            for (int s8 = 0; s8 < 8; ++s8) C = MFMA32(*(const bf16x8*)(Wt + (32 * rt + l31) * 272 + (16 * s8 + 8 * hf) * 2), *(const bf16x8*)(St + (32 * ct + l31) * 272 + (16 * s8 + 8 * hf) * 2), C);
            float bsum = 0.f; unsigned amx = 0u;
            bf16_t* wcol = Weff_t + (size_t)(hp * 128 + 32 * ct + l31) * 1024 + i0 + 32 * rt + 4 * hf;
#pragma unroll
            for (int g4 = 0; g4 < 4; ++g4) {
                const int i = i0 + 32 * rt + 8 * g4 + 4 * hf;
                const float4 gg = *(const float4*)(p.g2 + i), sc = *(const float4*)(mod + 4096 + i), sh = *(const float4*)(mod + 3072 + i);
                const float c0 = C[4 * g4], c1 = C[4 * g4 + 1], c2 = C[4 * g4 + 2], c3 = C[4 * g4 + 3];
                bsum += sh.x * c0 + sh.y * c1 + sh.z * c2 + sh.w * c3;
                const uint2 wv = make_uint2(pk2(c0 * gg.x * (1.f + sc.x), c1 * gg.y * (1.f + sc.y)), pk2(c2 * gg.z * (1.f + sc.z), c3 * gg.w * (1.f + sc.w)));
                *(uint2*)(wcol + 8 * g4) = wv;
                amx = max(max(amx, (wv.x << 16) & 0x7fffffffu), max(wv.x & 0x7fff0000u, max((wv.y << 16) & 0x7fffffffu, wv.y & 0x7fff0000u)));
            }
            amx = max(amx, (unsigned)__shfl_xor((int)amx, 32));
            if (hf == 0) (void)__hip_atomic_fetch_max(ctl + CTL_CMAX + hp * 128 + 32 * ct + l31, amx, __ATOMIC_RELAXED, __HIP_MEMORY_SCOPE_AGENT);
            bsum += __shfl_xor(bsum, 32);
            if (hf == 0) bred[rt * 128 + 32 * ct + l31] = bsum;
            __syncthreads();
            if (tid < 128) bq_part[(size_t)blk * 2048 + hp * 128 + tid] = bred[tid] + bred[128 + tid];
        }
        __syncthreads();
        if (ib >= 0) convert_tables(p.down, p.up, q8, dsc, lane, ib * 8 + wave, nidle * 8, 0, CONV_SPLIT);
    }
    xcd_barrier(bar);
    wave = threadIdx.x >> 6; asm volatile("" : "+v"(wave));

    {
        const int gw = __builtin_amdgcn_readfirstlane(bid * 8 + wave), NGW = G * 8, l31 = lane & 31, hf = lane >> 5;
        const int wv0 = __builtin_amdgcn_readfirstlane(wave);
        for (int U = gw; U < 1024; U += NGW) {
            const int n = U >> 3, h = U & 7;
            f32x16 C[2][2];
#pragma unroll
            for (int a = 0; a < 2; ++a)
#pragma unroll
                for (int b = 0; b < 2; ++b)
#pragma unroll
                    for (int r = 0; r < 16; ++r) C[a][b][r] = 0.f;
            unsigned char* Kt = lds + wv0 * 9216; unsigned char* Vt = Kt + 4608;
            const int r8 = lane >> 3, pc = lane & 7, trq = (lane & 15) >> 2, trp = lane & 3, trd = (lane >> 4) & 1;
            const char* kbase = (const char*)(Kr + (size_t)n * 128 * 512 + h * 64); const char* vbase = (const char*)(Vr + (size_t)n * 128 * 512 + h * 64);
            const unsigned loff = (unsigned)(r8 * 512 + pc * 8) * 2u;
            const float lg = lg2_head(h);
            pg8::u32x4 gK[4], gV[4];
#pragma unroll
            for (int i = 0; i < 4; ++i) { gK[i] = *(const pg8::u32x4*)(kbase + (loff + i * 8192u)); gV[i] = *(const pg8::u32x4*)(vbase + (loff + i * 8192u)); }
            for (int sb4 = 0; sb4 < 4; ++sb4) {
#pragma unroll
                for (int i = 0; i < 4; ++i) { *(pg8::u32x4*)(Kt + (8 * i + r8) * 144 + pc * 16) = gK[i]; *(pg8::u32x4*)(Vt + (8 * i + r8) * 144 + pc * 16) = gV[i]; }
                { const int sn = (sb4 < 3) ? sb4 + 1 : sb4;
#pragma unroll
                  for (int i = 0; i < 4; ++i) { gK[i] = *(const pg8::u32x4*)(kbase + (size_t)sn * 32768 + (loff + i * 8192u)); gV[i] = *(const pg8::u32x4*)(vbase + (size_t)sn * 32768 + (loff + i * 8192u)); } }
#pragma unroll
                for (int s = 0; s < 2; ++s) {
                    bf16x8 Af[2], Bf[2];
#pragma unroll
                    for (int a = 0; a < 2; ++a) {
                        Af[a] = tr_frag(Vt + (16 * s + 8 * hf + trq) * 144 + (32 * a + 16 * trd + 4 * trp) * 2, 4);
                        const bf16x8 kraw = tr_frag(Kt + (16 * s + 8 * hf + trq) * 144 + (32 * a + 16 * trd + 4 * trp) * 2, 4);
                        const pg8::u32x4 kw = __builtin_bit_cast(pg8::u32x4, kraw); const unsigned kk[4] = {kw.x, kw.y, kw.z, kw.w};
                        pg8::u32x4 o; unsigned* op = (unsigned*)&o;
#pragma unroll
                        for (int e2 = 0; e2 < 4; ++e2) {
                            const int j0 = 32 * sb4 + 16 * s + 8 * hf + 2 * e2;
                            const float z0 = __builtin_amdgcn_exp2f((float)(127 - j0) * lg), z1 = __builtin_amdgcn_exp2f((float)(126 - j0) * lg);
                            op[e2] = pg8::cvt_pk_bf16(__uint_as_float(kk[e2] << 16) * z0, __uint_as_float(kk[e2] & 0xffff0000u) * z1);
                        }
                        Bf[a] = __builtin_bit_cast(bf16x8, o);
                    }
#pragma unroll
                    for (int a = 0; a < 2; ++a)
#pragma unroll
                        for (int b = 0; b < 2; ++b) C[a][b] = MFMA32(Af[a], Bf[b], C[a][b]);
                }
            }
            float* dst = kv + (size_t)(n * 8 + h) * 4096;
#pragma unroll
            for (int a = 0; a < 2; ++a)
#pragma unroll
                for (int b = 0; b < 2; ++b)
#pragma unroll
                    for (int r = 0; r < 16; ++r) dst[(32 * a + (r & 3) + 8 * (r >> 2) + 4 * hf) * 64 + 32 * b + l31] = C[a][b][r];
        }
        bf16x8 Tri[2];
        {
            pg8::u32x4 w0, w1; unsigned* p0 = (unsigned*)&w0; unsigned* p1 = (unsigned*)&w1;
#pragma unroll
            for (int e2 = 0; e2 < 4; ++e2) {
                unsigned a0 = 0, a1 = 0;
#pragma unroll
                for (int q = 0; q < 2; ++q) { const int e = 2 * e2 + q, ip = 8 * (e >> 2) + 4 * hf + (e & 3);
                    a0 |= ((ip > l31) ? 0x3F80u : 0u) << (16 * q); a1 |= ((16 + ip > l31) ? 0x3F80u : 0u) << (16 * q); }
                p0[e2] = a0; p1[e2] = a1;
            }
            Tri[0] = __builtin_bit_cast(bf16x8, w0); Tri[1] = __builtin_bit_cast(bf16x8, w1);
        }
        const bool sb_local = (G % 8 == 0) && (4096 % G == 0) && ((4096 / G) % 8 == 0);
        const int sb_per_wave = sb_local ? 4096 / G / 8 : (4096 + NGW - 1 - gw) / NGW;
        const int wv = __builtin_amdgcn_readfirstlane(wave);
        for (int ps = 0; ps < sb_per_wave; ++ps) {
            const int U = sb_local ? 0 : gw + ps * NGW;
            const int h = sb_local ? (bid & 7) : (U & 7), qt = sb_local ? (bid >> 3) * (4096 / G) + ps * 8 + wv : (U >> 3), q0 = qt * 32;
            f32x16 O[2];
#pragma unroll
            for (int r = 0; r < 16; ++r) { O[0][r] = 0.f; O[1][r] = 0.f; }
            float carry = 0.f;
            unsigned char* Kt = lds + wv * 9216; unsigned char* Vt = Kt + 4608;
            const int r8 = lane >> 3, pc = lane & 7;
            const char* kbase = (const char*)(Ks + h * 64); const char* vbase = (const char*)(Vs + h * 64);
            const unsigned loff = (unsigned)(r8 * 512 + pc * 8) * 2u;
            pg8::u32x4 gK[4], gV[4];
            bf16x8 Qf[4];
            {
                const char* qbase = (const char*)(Qs + h * 64);
#pragma unroll
                for (int i = 0; i < 4; ++i) gK[i] = *(const pg8::u32x4*)(qbase + (size_t)qt * 32768 + (loff + i * 8192u));
#pragma unroll
                for (int i = 0; i < 4; ++i) *(pg8::u32x4*)(Kt + (8 * i + r8) * 144 + pc * 16) = gK[i];
#pragma unroll
                for (int s = 0; s < 4; ++s) Qf[s] = *(const bf16x8*)(Kt + l31 * 144 + 32 * s + 16 * hf);
            }
#pragma unroll
            for (int i = 0; i < 4; ++i) { gK[i] = *(const pg8::u32x4*)(kbase + (size_t)qt * 32768 + (loff + i * 8192u)); gV[i] = *(const pg8::u32x4*)(vbase + (size_t)qt * 32768 + (loff + i * 8192u)); }
            const int trq = (lane & 15) >> 2, trp = lane & 3, trd = (lane >> 4) & 1;
            for (int kb = qt; kb >= 0; --kb) {
#pragma unroll
                for (int i = 0; i < 4; ++i) { *(pg8::u32x4*)(Kt + (8 * i + r8) * 144 + pc * 16) = gK[i]; *(pg8::u32x4*)(Vt + (8 * i + r8) * 144 + pc * 16) = gV[i]; }
                {
                    const int kbn = (kb > 0) ? kb - 1 : 0;
#pragma unroll
                    for (int i = 0; i < 4; ++i) { gK[i] = *(const pg8::u32x4*)(kbase + (size_t)kbn * 32768 + (loff + i * 8192u)); gV[i] = *(const pg8::u32x4*)(vbase + (size_t)kbn * 32768 + (loff + i * 8192u)); }
                }
                bf16x8 Kf[4], Vf[2][2];
#pragma unroll
                for (int s = 0; s < 4; ++s) Kf[s] = *(const bf16x8*)(Kt + l31 * 144 + 32 * s + 16 * hf);
#pragma unroll
                for (int s = 0; s < 2; ++s)
#pragma unroll
                    for (int dt = 0; dt < 2; ++dt) {
                        Vf[s][dt] = tr_frag(Vt + (16 * s + 4 * hf + trq) * 144 + (32 * dt + 16 * trd + 4 * trp) * 2, 8);
                    }
                f32x16 S;
#pragma unroll
                for (int r = 0; r < 16; ++r) S[r] = 0.f;
#pragma unroll
                for (int s = 0; s < 4; ++s) S = MFMA32(Kf[s], Qf[s], S);
                const bool diag = (kb == qt);
                f32x16 sp, lb;
                float csum = 0.f;
                if (diag) {
#pragma unroll
                    for (int r = 0; r < 16; ++r) {
                        const int i = (r & 3) + 8 * (r >> 2) + 4 * hf;
                        const float z = S[r];
                        const float l1p = __builtin_amdgcn_logf(1.0f + __builtin_amdgcn_exp2f(-fabsf(z)));
                        const float spv = (i < l31) ? (fmaxf(z, 0.f) + l1p) : 0.f;
                        sp[r] = spv; lb[r] = (i < l31) ? (fminf(z, 0.f) - l1p) : -INFINITY; csum += spv;
                    }
                } else {
#pragma unroll
                    for (int r = 0; r < 16; ++r) {
                        const float z = S[r];
                        const float l1p = __builtin_amdgcn_logf(1.0f + __builtin_amdgcn_exp2f(-fabsf(z)));
                        const float spv = fmaxf(z, 0.f) + l1p;
                        sp[r] = spv; lb[r] = fminf(z, 0.f) - l1p; csum += spv;
                    }
                }
                f32x16 Rt;
#pragma unroll
                for (int r = 0; r < 16; ++r) Rt[r] = carry;
#pragma unroll
                for (int s = 0; s < 2; ++s) Rt = MFMA32(Tri[s], pack_frag(sp, s), Rt);
                f32x16 wv;
#pragma unroll
                for (int r = 0; r < 16; ++r) wv[r] = __builtin_amdgcn_exp2f(lb[r] - Rt[r]);
#pragma unroll
                for (int s = 0; s < 2; ++s) { const bf16x8 wp = pack_frag(wv, s);
#pragma unroll
                    for (int dt = 0; dt < 2; ++dt) O[dt] = MFMA32(Vf[s][dt], wp, O[dt]); }
                csum += __shfl_xor(csum, 32);
                carry += csum;
                if (__all(carry > 127.f)) break;
            }
            float ss = 0.f;
#pragma unroll
            for (int r = 0; r < 16; ++r) ss += O[0][r] * O[0][r] + O[1][r] * O[1][r];
            ss += __shfl_xor(ss, 32);
            const float rn = 1.0f / sqrtf(ss * (1.f / 64.f) + EPS);
#pragma unroll
            for (int dt = 0; dt < 2; ++dt)
#pragma unroll
                for (int g4 = 0; g4 < 4; ++g4) {
                    const int d = 32 * dt + 8 * g4 + 4 * hf;
                    const float4 gn = *(const float4*)(p.og + d);
                    uint2 w; w.x = pg8::cvt_pk_bf16(O[dt][4 * g4] * rn * gn.x, O[dt][4 * g4 + 1] * rn * gn.y); w.y = pg8::cvt_pk_bf16(O[dt][4 * g4 + 2] * rn * gn.z, O[dt][4 * g4 + 3] * rn * gn.w);
                    *(uint2*)(Kt + l31 * 144 + d * 2) = w;
                }
#pragma unroll
            for (int i = 0; i < 4; ++i) *(pg8::u32x4*)(ycat + (size_t)(q0 + 8 * i + r8) * 1024 + 512 + h * 64 + pc * 8) = *(const pg8::u32x4*)(Kt + (8 * i + r8) * 144 + pc * 16);
        }
    }
    xcd_barrier(bar);

    if (bid == 255 % G) for (int n = tid; n < 2048; n += 512) { float s = 0.f;
#pragma unroll
        for (int b8 = 0; b8 < 16; ++b8) s += bq_part[(size_t)b8 * 2048 + n];
        bias_q[n] = s; }
    if (bid >= 64) for (int row = (bid - 64) * 8 + wave; row < 2048; row += (G - 64) * 8) {
        const float am = __uint_as_float(ctl[CTL_CMAX + row]), qs = (am > 0.f) ? 127.f / am : 0.f;
        const pg8::u32x4 a = *(const pg8::u32x4*)(Weff_t + (size_t)row * 1024 + 16 * lane), b = *(const pg8::u32x4*)(Weff_t + (size_t)row * 1024 + 16 * lane + 8);
        pg8::u32x4 o;
#define QB(w) ((__float_as_uint(fmaf(__uint_as_float((w) << 16), qs, 12582912.f)) & 255u) | ((__float_as_uint(fmaf(__uint_as_float((w) & 0xffff0000u), qs, 12582912.f)) & 255u) << 8))
        o.x = QB(a.x) | (QB(a.y) << 16); o.y = QB(a.z) | (QB(a.w) << 16); o.z = QB(b.x) | (QB(b.y) << 16); o.w = QB(b.z) | (QB(b.w) << 16);
#undef QB
        *(pg8::u32x4*)(Weffq_t + (size_t)row * 1024 + 16 * lane) = o;
        if (lane == 0) sq[row] = am * (1.f / 127.f);
    }
    if (G > 64 && bid >= 64) convert_tables(p.down, p.up, q8, dsc, lane, (bid - 64) * 8 + wave, (G - 64) * 8, CONV_SPLIT, 32768);
    else if (G <= 64) convert_tables(p.down, p.up, q8, dsc, lane, bid * 8 + wave, G * 8, CONV_SPLIT, 32768);
    for (int idx = bid * 512 + tid; idx < 32768; idx += G * 512) {
        const int h = idx >> 12;
        const float cd = exp2f(128.f * lg2_head(h));
        float s = 0.f;
        for (int n0 = 0; n0 < 128; n0 += 32) {
            float kvv[32];
#pragma unroll
            for (int q = 0; q < 32; ++q) kvv[q] = kv[(size_t)(n0 + q) * 32768 + idx];
#pragma unroll
            for (int q = 0; q < 32; ++q) { stT[(size_t)(n0 + q) * 32768 + idx] = f2bf(s); s = cd * s + kvv[q]; }
        }
    }
    xcd_barrier(bar);

    {
        const int gw = __builtin_amdgcn_readfirstlane(bid * 8 + wave), NGW = G * 8, l31 = lane & 31, hf = lane >> 5;
        const int wv4 = __builtin_amdgcn_readfirstlane(wave);
        for (int W2 = gw; W2 < 2048; W2 += NGW) {
            const int nh = W2 >> 1, n = nh >> 3, h = nh & 7;
            const float lg = lg2_head(h);
#pragma unroll 1
            for (int pass = 0; pass < 2; ++pass) {
                const int qt = (W2 & 1) ? (pass ? 2 : 1) : (pass ? 3 : 0);
                const int il = qt * 32 + l31, tq = n * 128 + il;
                unsigned char* Kt = lds + wv4 * 9216; unsigned char* Vt = Kt + 4608;
                const int r8 = lane >> 3, pc = lane & 7, trq = (lane & 15) >> 2, trp = lane & 3, trd = (lane >> 4) & 1;
                const unsigned loff = (unsigned)(r8 * 512 + pc * 8) * 2u;
                pg8::u32x4 gK[4], gV[4];
                bf16x8 Qf[4];
                {
                    const char* qbase = (const char*)(Qr + (size_t)(n * 128 + qt * 32) * 512 + h * 64);
                    const char* sbase = (const char*)(stT + (size_t)nh * 4096) + (unsigned)(r8 * 64 + pc * 8) * 2u;
#pragma unroll
                    for (int i = 0; i < 4; ++i) gK[i] = *(const pg8::u32x4*)(qbase + (loff + i * 8192u));
#pragma unroll
                    for (int i = 0; i < 4; ++i) *(pg8::u32x4*)(Kt + (8 * i + r8) * 144 + pc * 16) = gK[i];
#pragma unroll
                    for (int s = 0; s < 4; ++s) Qf[s] = *(const bf16x8*)(Kt + l31 * 144 + 32 * s + 16 * hf);
#pragma unroll
                    for (int i = 0; i < 4; ++i) { gK[i] = *(const pg8::u32x4*)(sbase + i * 1024u); gV[i] = *(const pg8::u32x4*)(sbase + 4096u + i * 1024u); }
#pragma unroll
                    for (int i = 0; i < 4; ++i) { *(pg8::u32x4*)(Kt + (8 * i + r8) * 144 + pc * 16) = gK[i]; *(pg8::u32x4*)(Kt + (32 + 8 * i + r8) * 144 + pc * 16) = gV[i]; }
                }
                f32x16 O[2];
#pragma unroll
                for (int r = 0; r < 16; ++r) { O[0][r] = 0.f; O[1][r] = 0.f; }
#pragma unroll
                for (int s = 0; s < 4; ++s)
#pragma unroll
                    for (int dt = 0; dt < 2; ++dt) O[dt] = MFMA32(*(const bf16x8*)(Kt + (32 * dt + l31) * 144 + 32 * s + 16 * hf), Qf[s], O[dt]);
                const float xi = exp2f((float)(il + 1) * lg);
#pragma unroll
                for (int r = 0; r < 16; ++r) { O[0][r] *= xi; O[1][r] *= xi; }
                const char* kbase = (const char*)(Kr + (size_t)n * 128 * 512 + h * 64); const char* vbase = (const char*)(Vr + (size_t)n * 128 * 512 + h * 64);
#pragma unroll
                for (int i = 0; i < 4; ++i) { gK[i] = *(const pg8::u32x4*)(kbase + (loff + i * 8192u)); gV[i] = *(const pg8::u32x4*)(vbase + (loff + i * 8192u)); }
                for (int jb = 0; jb <= qt; ++jb) {
#pragma unroll
                    for (int i = 0; i < 4; ++i) { *(pg8::u32x4*)(Kt + (8 * i + r8) * 144 + pc * 16) = gK[i]; *(pg8::u32x4*)(Vt + (8 * i + r8) * 144 + pc * 16) = gV[i]; }
                    { const int jn = (jb < qt) ? jb + 1 : jb;
#pragma unroll
                      for (int i = 0; i < 4; ++i) { gK[i] = *(const pg8::u32x4*)(kbase + (size_t)jn * 32768 + (loff + i * 8192u)); gV[i] = *(const pg8::u32x4*)(vbase + (size_t)jn * 32768 + (loff + i * 8192u)); } }
                    bf16x8 Kf[4], Vf[2][2];
#pragma unroll
                    for (int s = 0; s < 4; ++s) Kf[s] = *(const bf16x8*)(Kt + l31 * 144 + 32 * s + 16 * hf);
#pragma unroll
                    for (int s = 0; s < 2; ++s)
#pragma unroll
                        for (int dt = 0; dt < 2; ++dt) Vf[s][dt] = tr_frag(Vt + (16 * s + 4 * hf + trq) * 144 + (32 * dt + 16 * trd + 4 * trp) * 2, 8);
                    f32x16 S;
#pragma unroll
                    for (int r = 0; r < 16; ++r) S[r] = 0.f;
#pragma unroll
                    for (int s = 0; s < 4; ++s) S = MFMA32(Kf[s], Qf[s], S);
#pragma unroll
                    for (int r = 0; r < 16; ++r) {
                        const int jl = jb * 32 + (r & 3) + 8 * (r >> 2) + 4 * hf, dl = il - jl;
                        S[r] = (dl >= 0) ? S[r] * __builtin_amdgcn_exp2f((float)dl * lg) : 0.f;
                    }
#pragma unroll
                    for (int s = 0; s < 2; ++s) { const bf16x8 wp = pack_frag(S, s);
#pragma unroll
                        for (int dt = 0; dt < 2; ++dt) O[dt] = MFMA32(Vf[s][dt], wp, O[dt]); }
                }
                float sm = 0.f;
#pragma unroll
                for (int r = 0; r < 16; ++r) sm += O[0][r] + O[1][r];
                sm += __shfl_xor(sm, 32);
                const float mean = sm * (1.f / 64.f);
                float vs = 0.f;
#pragma unroll
                for (int r = 0; r < 16; ++r) { const float d0 = O[0][r] - mean, d1 = O[1][r] - mean; vs += d0 * d0 + d1 * d1; }
                vs += __shfl_xor(vs, 32);
                const float rstd = 1.0f / sqrtf(vs * (1.f / 64.f) + EPS);
                {
                    const char* gbase = (const char*)(Gr + (size_t)(n * 128 + qt * 32) * 512 + h * 64);
#pragma unroll
                    for (int i = 0; i < 4; ++i) gV[i] = *(const pg8::u32x4*)(gbase + (loff + i * 8192u));
#pragma unroll
                    for (int i = 0; i < 4; ++i) *(pg8::u32x4*)(Vt + (8 * i + r8) * 144 + pc * 16) = gV[i];
                }
#pragma unroll
                for (int dt = 0; dt < 2; ++dt)
#pragma unroll
                    for (int g4 = 0; g4 < 4; ++g4) {
                        const int e = 32 * dt + 8 * g4 + 4 * hf;
                        const float4 gn = *(const float4*)(p.rgain + h * 64 + e);
                        const uint2 gg = *(const uint2*)(Vt + l31 * 144 + e * 2);
                        const float g0 = __uint_as_float(gg.x << 16), g1 = __uint_as_float(gg.x & 0xffff0000u), g2v = __uint_as_float(gg.y << 16), g3 = __uint_as_float(gg.y & 0xffff0000u);
                        uint2 w;
                        w.x = pg8::cvt_pk_bf16((O[dt][4 * g4] - mean) * rstd * gn.x * g0, (O[dt][4 * g4 + 1] - mean) * rstd * gn.y * g1);
                        w.y = pg8::cvt_pk_bf16((O[dt][4 * g4 + 2] - mean) * rstd * gn.z * g2v, (O[dt][4 * g4 + 3] - mean) * rstd * gn.w * g3);
                        *(uint2*)(Kt + l31 * 144 + e * 2) = w;
                    }
#pragma unroll
                for (int i = 0; i < 4; ++i) *(pg8::u32x4*)(ycat + (size_t)(n * 128 + qt * 32 + 8 * i + r8) * 1024 + h * 64 + pc * 8) = *(const pg8::u32x4*)(Kt + (8 * i + r8) * 144 + pc * 16);
            }
        }
    }
    xcd_barrier(bar);

    {
        pg8::Gemm g{ycat, Wout_t, T, 1024, 1024}; pg8::StaticOrder S; S.init(T, 1024, G, bid);
        EpiOutprojMF E{p.x, mod + 2048, x1b, part2, pmax, x1q, rinv2q, ctl};
        pg8::gemm_phase<EpiOutprojMF, pg8::StaticOrder>((PG8_LAS unsigned char*)lds, g, S, E);
    }
    xcd_barrier(bar);

    for (int round = 0; round < 2; ++round) {
        pg8::Gemm g{(const bf16_t*)x1q, (const bf16_t*)Weffq_t, T, 2048, 512}; OneUnitOrder S; S.base.init(T, 2048, G, bid); S.round = round;
        EpiTopkMF E{rinv2q, sq, bias_q, ids, gates};
        pg8::gemm_phase<EpiTopkMF, OneUnitOrder, true>((PG8_LAS unsigned char*)lds, g, S, E);
    }
    xcd_barrier(bar);

    {
        constexpr int IDS_LD = 136, ACT_LD = 136;
        const float* scale2 = mod + 4096; const float* shift2 = mod + 3072; const float* gate2 = mod + 5120;
        unsigned short* ids_l = (unsigned short*)lds; float* act_l = (float*)(lds + 32768);
        bf16_t* ds_l = (bf16_t*)(lds + 69632);
        const int t0 = bid * 64, tt = lane >> 3, sub = lane & 7, tl = wave * 8 + tt, t = t0 + tl;
        for (int e = tid; e < 1024; e += 512) { const int r = e >> 4, c8 = e & 15; *(uint4*)(ids_l + r * IDS_LD + c8 * 8) = *(const uint4*)(ids + (size_t)(t0 + r) * 128 + c8 * 8); }
        for (int e = tid; e < 64 * ACT_LD; e += 512) act_l[e] = 0.f;
        for (int e = tid; e < 4096; e += 512) ((uint4*)ds_l)[e] = ((const uint4*)dsc)[e];
        float* s2_l = (float*)(lds + 143360); float* sh2_l = s2_l + 1024; float* gt2_l = s2_l + 2048;
        for (int e = tid; e < 1024; e += 512) { s2_l[e] = p.g2[e] * (1.f + scale2[e]); sh2_l[e] = shift2[e]; gt2_l[e] = gate2[e]; }
        __syncthreads();
        float ri;
        { const float4* pp = (const float4*)(part2 + (size_t)t * 16); const float4 p0 = pp[0], p1 = pp[1], p2 = pp[2], p3 = pp[3];
          const float ssum = ((p0.x + p0.y) + (p0.z + p0.w)) + ((p1.x + p1.y) + (p1.z + p1.w)) + ((p2.x + p2.y) + (p2.z + p2.w)) + ((p3.x + p3.y) + (p3.z + p3.w));
          ri = 1.0f / sqrtf(ssum * (1.0f / D) + EPS); }
        const unsigned short* myids = ids_l + tl * IDS_LD;
        float* myact = act_l + tl * ACT_LD;
        const bool s4 = (sub & 4) != 0, s2 = (sub & 2) != 0, s1 = (sub & 1) != 0;
        const unsigned suboff = (unsigned)sub * 16u;
        typedef float f32x2 __attribute__((ext_vector_type(2)));
#define P9_LOAD(W, JB) do { const uint4 idv_ = *(const uint4*)(myids + 8 * (JB)); const unsigned idw_[4] = {idv_.x, idv_.y, idv_.z, idv_.w}; \
        _Pragma("unroll") for (int k_ = 0; k_ < 8; ++k_) { const unsigned id_ = (idw_[k_ >> 1] >> (16 * (k_ & 1))) & 0xffffu; W[k_] = *(const uint4*)(sbase + (id_ * 128u + suboff)); } } while (0)
#define P9_DOWN4(W, JB) do { int pd_[8]; \
        _Pragma("unroll") for (int k_ = 0; k_ < 8; ++k_) { const unsigned ww_[4] = {W[k_].x, W[k_].y, W[k_].z, W[k_].w}; int a0_ = 0, a1_ = 0; \
            _Pragma("unroll") for (int m_ = 0; m_ < 4; ++m_) { a0_ = __builtin_amdgcn_sdot4(hpe[m_], (int)(ww_[m_] & 0x0F0F0F0Fu), a0_, false); a1_ = __builtin_amdgcn_sdot4(hpo[m_], (int)((ww_[m_] >> 4) & 0x0F0F0F0Fu), a1_, false); } \
            pd_[k_] = a0_ + a1_ - hoff; } \
        int r4_[4], r2_[2]; \
        _Pragma("unroll") for (int k_ = 0; k_ < 4; ++k_) { const int snd_ = s4 ? pd_[k_] : pd_[k_ + 4], kp_ = s4 ? pd_[k_ + 4] : pd_[k_]; r4_[k_] = kp_ + __shfl_xor(snd_, 4); } \
        _Pragma("unroll") for (int k_ = 0; k_ < 2; ++k_) { const int snd_ = s2 ? r4_[k_] : r4_[k_ + 2], kp_ = s2 ? r4_[k_ + 2] : r4_[k_]; r2_[k_] = kp_ + __shfl_xor(snd_, 2); } \
        { const int snd_ = s1 ? r2_[0] : r2_[1], kp_ = s1 ? r2_[1] : r2_[0]; myact[8 * (JB) + sub] += (float)(kp_ + __shfl_xor(snd_, 1)) * hscale; } } while (0)
        uint2 xnx[8];
#pragma unroll
        for (int q = 0; q < 8; ++q) xnx[q] = *(const uint2*)(x1b + (size_t)t * D + 4 * sub + 32 * q);
        for (int c = 0; c < 4; ++c) {
            const unsigned char* sbase = q8 + (size_t)c * (16384 * 128);
            uint4 wA[8], wB[8];
            uint2 xcur[8];
#pragma unroll
            for (int q = 0; q < 8; ++q) xcur[q] = xnx[q];
            P9_LOAD(wA, 0);
            { const int cn = (c < 3) ? c + 1 : c;
#pragma unroll
              for (int q = 0; q < 8; ++q) xnx[q] = *(const uint2*)(x1b + (size_t)t * D + 256 * cn + 4 * sub + 32 * q); }
            float hf[8][4]; float hmax = 0.f;
#pragma unroll
            for (int q = 0; q < 8; ++q) {
                const int col = 256 * c + 4 * sub + 32 * q;
                const uint2 xw = xcur[q];
                const float4 sv = *(const float4*)(s2_l + col), sh = *(const float4*)(sh2_l + col);
                hf[q][0] = __uint_as_float(xw.x << 16) * ri * sv.x + sh.x; hf[q][1] = __uint_as_float(xw.x & 0xffff0000u) * ri * sv.y + sh.y;
                hf[q][2] = __uint_as_float(xw.y << 16) * ri * sv.z + sh.z; hf[q][3] = __uint_as_float(xw.y & 0xffff0000u) * ri * sv.w + sh.w;
                hmax = fmaxf(hmax, fmaxf(fmaxf(fabsf(hf[q][0]), fabsf(hf[q][1])), fmaxf(fabsf(hf[q][2]), fabsf(hf[q][3]))));
            }
            hmax = fmaxf(hmax, __shfl_xor(hmax, 1)); hmax = fmaxf(hmax, __shfl_xor(hmax, 2)); hmax = fmaxf(hmax, __shfl_xor(hmax, 4));
            const float hinv = (hmax > 0.f) ? 127.0f / hmax : 0.f, hscale = hmax * (1.0f / 127.0f);
            int hq[8][4];
#pragma unroll
            for (int q = 0; q < 8; ++q)
#pragma unroll
                for (int j = 0; j < 4; ++j) hq[q][j] = (int)__builtin_rintf(hf[q][j] * hinv);
            int hpe[4], hpo[4], hoff = 0;
#pragma unroll
            for (int m = 0; m < 4; ++m) {
                hpe[m] = (hq[2 * m][0] & 255) | ((hq[2 * m][2] & 255) << 8) | ((hq[2 * m + 1][0] & 255) << 16) | ((hq[2 * m + 1][2] & 255) << 24);
                hpo[m] = (hq[2 * m][1] & 255) | ((hq[2 * m][3] & 255) << 8) | ((hq[2 * m + 1][1] & 255) << 16) | ((hq[2 * m + 1][3] & 255) << 24);
            }
#pragma unroll
            for (int q = 0; q < 8; ++q) hoff += (hq[q][0] + hq[q][1]) + (hq[q][2] + hq[q][3]);
            hoff *= 8;
#pragma unroll 1
            for (int jb = 0; jb < 16; jb += 2) {
                P9_LOAD(wB, jb + 1);
                P9_DOWN4(wA, jb);
                if (jb + 2 < 16) P9_LOAD(wA, jb + 2);
                P9_DOWN4(wB, jb + 1);
            }
        }
#undef P9_DOWN4
        signed char* aq_l = (signed char*)(lds + 135168);
        float avv[16]; float amax = 0.f;
#pragma unroll
        for (int jb = 0; jb < 16; ++jb) {
            const int j = 8 * jb + sub; const unsigned id = myids[j];
            const float a = myact[j] * bf2f(ds_l[id]);
            const float av = fabsf(a), tq = 1.0f / (av * 0.2316418882f + 1.0f);
            float ql = tq * 0.5307027145f + (-0.7265760135f); ql = ql * tq + 0.7107068705f; ql = ql * tq + (-0.142248368f); ql = ql * tq + 0.127414796f; ql = ql * tq;
            const float mm = a * (ql * exp2f(a * a * (-0.72134752044f)));
            const float ge = (a < 0.f) ? mm : (a - mm);
            avv[jb] = ge * gates[(size_t)t * 128 + j] * bf2f(ds_l[16384 + id]);
            amax = fmaxf(amax, fabsf(avv[jb]));
        }
        amax = fmaxf(amax, __shfl_xor(amax, 1)); amax = fmaxf(amax, __shfl_xor(amax, 2)); amax = fmaxf(amax, __shfl_xor(amax, 4));
        const float ainv = (amax > 0.f) ? 127.0f / amax : 0.f, ascale = amax * (1.0f / 127.0f);
        int aqsum = 0;
#pragma unroll
        for (int jb = 0; jb < 16; ++jb) { const int aqv = (int)__builtin_rintf(avv[jb] * ainv); aq_l[tl * 128 + 8 * jb + sub] = (signed char)aqv; aqsum += aqv; }
        aqsum += __shfl_xor(aqsum, 1); aqsum += __shfl_xor(aqsum, 2); aqsum += __shfl_xor(aqsum, 4);
        __syncthreads();
#define P9_PERM(HI, LO, SEL) __builtin_amdgcn_perm((HI), (LO), (SEL))
#define P9_T4(E0, E1, E2, E3, T0, T1, T2, T3) do { const unsigned p0_ = P9_PERM(E1, E0, 0x05010400u), p1_ = P9_PERM(E1, E0, 0x07030602u), p2_ = P9_PERM(E3, E2, 0x05010400u), p3_ = P9_PERM(E3, E2, 0x07030602u); \
        T0 = P9_PERM(p2_, p0_, 0x05040100u); T1 = P9_PERM(p2_, p0_, 0x07060302u); T2 = P9_PERM(p3_, p1_, 0x05040100u); T3 = P9_PERM(p3_, p1_, 0x07060302u); } while (0)
#define P9_UP4(W, JB) do { const uint2 aq8_ = *(const uint2*)(aq_l + tl * 128 + 8 * (JB)); const int aq4_[2] = {(int)aq8_.x, (int)aq8_.y}; \
        _Pragma("unroll") for (int g_ = 0; g_ < 2; ++g_) { \
            _Pragma("unroll") for (int m_ = 0; m_ < 4; ++m_) { \
                const unsigned w0_ = ((const unsigned*)&W[4 * g_ + 0])[m_], w1_ = ((const unsigned*)&W[4 * g_ + 1])[m_], w2_ = ((const unsigned*)&W[4 * g_ + 2])[m_], w3_ = ((const unsigned*)&W[4 * g_ + 3])[m_]; \
                unsigned t_[4]; \
                P9_T4(w0_, w1_, w2_, w3_, t_[0], t_[1], t_[2], t_[3]); \
                _Pragma("unroll") for (int k_ = 0; k_ < 4; ++k_) { \
                    oraw[4 * m_ + k_] = __builtin_amdgcn_sdot4(aq4_[g_], (int)t_[k_], oraw[4 * m_ + k_], false); \
                    olo[4 * m_ + k_] = __builtin_amdgcn_sdot4(aq4_[g_], (int)(t_[k_] & 0x0F0F0F0Fu), olo[4 * m_ + k_], false); } } } } while (0)
        for (int c = 0; c < 4; ++c) {
            int oraw[16], olo[16];
#pragma unroll
            for (int q = 0; q < 16; ++q) { oraw[q] = 0; olo[q] = 0; }
            const unsigned char* sbase = q8 + (8u << 20) + (size_t)c * (16384 * 128);
            uint4 wA[8], wB[8];
            P9_LOAD(wA, 0);
            uint2 xres[8];
#pragma unroll
            for (int q = 0; q < 8; ++q) xres[q] = *(const uint2*)(x1b + (size_t)t * D + 256 * c + 4 * sub + 32 * q);
#pragma unroll 1
            for (int jb = 0; jb < 16; jb += 2) {
                P9_LOAD(wB, jb + 1);
                P9_UP4(wA, jb);
                if (jb + 2 < 16) P9_LOAD(wA, jb + 2);
                P9_UP4(wB, jb + 1);
            }
#pragma unroll
            for (int q = 0; q < 8; ++q) {
                const int col = 256 * c + 4 * sub + 32 * q;
                float* op = out + (size_t)t * D + col;
                const uint2 xw = xres[q]; const float4 xv = make_float4(__uint_as_float(xw.x << 16), __uint_as_float(xw.x & 0xffff0000u), __uint_as_float(xw.y << 16), __uint_as_float(xw.y & 0xffff0000u)); const float4 gt = *(const float4*)(gt2_l + col);
                const int m = q >> 1, k0 = 2 * (q & 1);
                const int v0 = olo[4 * m + k0] - 8 * aqsum, v1 = (oraw[4 * m + k0] - olo[4 * m + k0]) >> 4, v2 = olo[4 * m + k0 + 1] - 8 * aqsum, v3 = (oraw[4 * m + k0 + 1] - olo[4 * m + k0 + 1]) >> 4;
                float4 r;
                r.x = xv.x + gt.x * ((float)v0 * ascale); r.y = xv.y + gt.y * ((float)v1 * ascale); r.z = xv.z + gt.z * ((float)v2 * ascale); r.w = xv.w + gt.w * ((float)v3 * ascale);
                *(float4*)op = r;
            }
        }
#undef P9_LOAD
#undef P9_UP4
#undef P9_T4
#undef P9_PERM
    }
}
}

extern "C" void kernel_launch(void* const* d_in, const int* in_sizes, int n_in, void* d_out, int out_size, void* d_ws, size_t ws_size, hipStream_t stream) {
    static int grid = 0;
    if (grid == 0) {
        int dev = 0, cus = 0, per_cu = 0;
        (void)hipGetDevice(&dev);
        (void)hipDeviceGetAttribute(&cus, hipDeviceAttributeMultiprocessorCount, dev);
        (void)hipFuncSetAttribute((const void*)mk_fwd, hipFuncAttributeMaxDynamicSharedMemorySize, LDS_BYTES);
        (void)hipOccupancyMaxActiveBlocksPerMultiprocessor(&per_cu, (const void*)mk_fwd, 512, LDS_BYTES);
        if (per_cu < 1 || cus != 256) { fprintf(stderr, "kernel_launch: needs 256 CUs with one resident workgroup each (cus %d, per_cu %d)\n", cus, per_cu); grid = -1; }
        else grid = cus;
    }
    if (grid < 0) return;
    (void)hipMemsetAsync((char*)d_ws + OFF_CTL, 0, CTL_BYTES, stream);
    Params p{};
    p.x = (const float*)d_in[0]; p.c = (const float*)d_in[1]; p.pos = (const int*)d_in[2]; p.ada_w = (const float*)d_in[3]; p.ada_b = (const float*)d_in[4];
    p.g1 = (const float*)d_in[5]; p.g2 = (const float*)d_in[6]; p.w_in = (const float*)d_in[7]; p.rgain = (const float*)d_in[8]; p.qg = (const float*)d_in[9];
    p.kg = (const float*)d_in[10]; p.og = (const float*)d_in[11]; p.w_out = (const float*)d_in[12]; p.wq = (const float*)d_in[13]; p.sk = (const float*)d_in[14];
    p.down = (const float*)d_in[15]; p.up = (const float*)d_in[16]; p.out = (float*)d_out; p.ws = (unsigned char*)d_ws;
    for (int i = 0; i < 32; ++i) {
        const double f = pow(10000.0, -(double)i / 32.0) / 6.283185307179586476925;
        float fh = (float)f; unsigned ub; memcpy(&ub, &fh, 4); ub &= 0xFFFFC000u; memcpy(&fh, &ub, 4);
        p.rc.fh[i] = fh; p.rc.fl[i] = (float)(f - (double)fh);
    }
    void* args[] = {&p};
    hipError_t e = hipLaunchCooperativeKernel((const void*)mk_fwd, dim3(grid), dim3(512), args, LDS_BYTES, stream);
    if (e != hipSuccess) fprintf(stderr, "kernel_launch: cooperative launch failed: %s (grid %d)\n", hipGetErrorString(e), grid);
}
```

```cpp
#include <hip/hip_runtime.h>
#include <stdint.h>
#include <math.h>
#include <cstdio>
#include <cstring>

namespace {
constexpr int T = 16384, D = 1024;
constexpr float EPS = 1e-6f;
typedef unsigned short bf16_t;
#define LAS __attribute__((address_space(3)))

__device__ __forceinline__ float bf2f(bf16_t b) { return __uint_as_float(((unsigned)b) << 16); }
__device__ __forceinline__ bf16_t f2bf(float f) { unsigned u = __float_as_uint(f); u += 0x7fffu + ((u >> 16) & 1u); return (bf16_t)(u >> 16); }
__device__ __forceinline__ float4 ld_nt4(const float* p) { typedef float f4v __attribute__((ext_vector_type(4))); const f4v v = __builtin_nontemporal_load((const f4v*)p); return make_float4(v[0], v[1], v[2], v[3]); }

__device__ __forceinline__ float lg2_head(int h) {
    const float x = __uint_as_float((unsigned)(127 - 5 - h) << 23);
    const float s = x * (1.f + x * (0.5f + x * (0.33333334f + x * (0.25f + x * (0.2f + x * 0.16666667f)))));
    return -s * 1.44269504089f;
}
struct RopeC { float fh[32], fl[32]; };
struct RetC { float lg2[8]; };

constexpr size_t MiB = 1u << 20;
constexpr size_t OFF_CTL = 0;
constexpr size_t CTL_BYTES = 64 * 1024;
constexpr size_t OFF_MOD = 64 * 1024, OFF_RINV1 = 128 * 1024, OFF_BIASF = 256 * 1024, OFF_ROPE = 1 * MiB;
constexpr size_t OFF_WINT = 6 * MiB;
constexpr size_t OFF_XB = 16 * MiB;
constexpr size_t OFF_YCAT = 160 * MiB;
constexpr size_t OFF_P = 48 * MiB;
constexpr size_t OFF_KV = 208 * MiB, OFF_ST = 224 * MiB;
constexpr size_t OFF_WEFFT = 240 * MiB;
constexpr size_t OFF_WOUTT = 13 * MiB;
constexpr size_t OFF_BIASQ = 272 * 1024;
constexpr size_t OFF_SWF = 320 * 1024;
constexpr size_t OFF_SQ = 336 * 1024;
constexpr size_t OFF_PMAX = 2 * MiB;
constexpr size_t OFF_RINV2Q = 3 * MiB;
constexpr size_t OFF_WEFFQ = 10 * MiB;
constexpr size_t OFF_X1Q = 16 * MiB;
constexpr int CTL_CNT = 4096, CTL_CMAX = 8192;
constexpr size_t OFF_XQ = 160 * MiB;
constexpr size_t OFF_DSC = 512 * 1024;
constexpr size_t OFF_BQPART = 576 * 1024;
constexpr size_t OFF_PART2 = 5 * MiB;
constexpr size_t OFF_X1B = 208 * MiB;
constexpr size_t OFF_IDS = 244 * MiB, OFF_GATES = 248 * MiB;
constexpr size_t OFF_Q8 = 192 * MiB;
constexpr int CONV_SPLIT = 0;
constexpr int LDS_BYTES = 163840;
constexpr int LDS_ST_OFF = LDS_BYTES - 16;

#define XB_TMO      128
#define XB_XCNT(j)  (256  + 64 * (j))
#define XB_XSUB(j)  (1280 + 64 * (j))
#define XB_XGEN(j)  (2304 + 64 * (j))
#define XB_TOP      3328
#define XB_TOPGEN   3392
#define XCD_BAR_WORDS 3456
#define XB_SPIN_CAP (1u << 20)
__device__ __forceinline__ unsigned xb_ld(unsigned* p)              { return __hip_atomic_load(p, __ATOMIC_RELAXED, __HIP_MEMORY_SCOPE_AGENT); }
__device__ __forceinline__ unsigned xb_add(unsigned* p, unsigned v) { return __hip_atomic_fetch_add(p, v, __ATOMIC_RELAXED, __HIP_MEMORY_SCOPE_AGENT); }
__device__ __forceinline__ unsigned xb_xcc_id() { return (unsigned)__builtin_amdgcn_s_getreg((3 << 11) | 20) & 0xFu; }
#define XB_SPIN(cond, bar) do { unsigned _sp = 0; while (cond) { __builtin_amdgcn_s_sleep(1); \
    if ((++_sp & 255u) == 0u) { if (xb_ld(&(bar)[XB_TMO])) break; if (_sp > XB_SPIN_CAP) { atomicAdd(&(bar)[XB_TMO], 1u); break; } } } } while (0)
struct XcdBarrier { unsigned* bar; unsigned x; volatile LAS unsigned* st; };
__device__ __forceinline__ XcdBarrier xcd_barrier_post(unsigned* bar, volatile LAS unsigned* st) {
    XcdBarrier b; b.bar = bar; b.x = xb_xcc_id(); b.st = st;
    if (threadIdx.x == 0) (void)xb_add(&bar[XB_XCNT(b.x)], 1u);
    return b;
}
__device__ __forceinline__ void xcd_barrier_complete(unsigned* bar, unsigned x, unsigned& nloc, unsigned& nx) {
    const unsigned G = gridDim.x * gridDim.y * gridDim.z;
    unsigned sum, cnt, mine, sp = 0u;
    for (;;) {
        sum = 0u; cnt = 0u; mine = 0u;
#pragma unroll
        for (unsigned j = 0; j < 16; ++j) { const unsigned c = xb_ld(&bar[XB_XCNT(j)]); sum += c; cnt += (c > 0u) ? 1u : 0u; mine = (j == x) ? c : mine; }
        if (sum == G) break;
        __builtin_amdgcn_s_sleep(1);
        if ((++sp & 255u) == 0u) { if (xb_ld(&bar[XB_TMO])) break; if (sp > XB_SPIN_CAP) { atomicAdd(&bar[XB_TMO], 1u); break; } }
    }
    nloc = mine > 0u ? mine : 1u; nx = cnt > 0u ? cnt : 1u;
}
__device__ __forceinline__ void xcd_barrier(const XcdBarrier& b) {
    asm volatile("s_waitcnt vmcnt(0)" ::: "memory");
    __syncthreads();
    if (threadIdx.x == 0) {
        unsigned* bar = b.bar;
        __builtin_amdgcn_s_waitcnt(0);
        unsigned nloc = b.st[0], nx = b.st[1];
        if (nloc == 0u) { xcd_barrier_complete(bar, b.x, nloc, nx); b.st[0] = nloc; b.st[1] = nx; }
        const unsigned old = xb_add(&bar[XB_XSUB(b.x)], 1u);
        const unsigned gen = old / nloc;
        if (old + 1u == (gen + 1u) * nloc) {
            __builtin_amdgcn_fence(__ATOMIC_RELEASE, "agent");
            asm volatile("s_waitcnt vmcnt(0)" ::: "memory");
            const unsigned og = xb_add(&bar[XB_TOP], 1u);
            const unsigned tg = og / nx;
            if (og + 1u == (tg + 1u) * nx) xb_add(&bar[XB_TOPGEN], 1u);
            else XB_SPIN(xb_ld(&bar[XB_TOPGEN]) == tg, bar);
            __builtin_amdgcn_fence(__ATOMIC_ACQUIRE, "agent");
            xb_add(&bar[XB_XGEN(b.x)], 1u);
            asm volatile("s_waitcnt vmcnt(0)" ::: "memory");
        } else {
            XB_SPIN(xb_ld(&bar[XB_XGEN(b.x)]) == gen, bar);
            __builtin_amdgcn_fence(__ATOMIC_ACQUIRE, "agent");
            asm volatile("s_waitcnt vmcnt(0)" ::: "memory");
        }
    }
    __syncthreads();
}


namespace pg8 {
#define PG8_LAS __attribute__((address_space(3)))
typedef short bf16x8 __attribute__((ext_vector_type(8)));
typedef float f32x4 __attribute__((ext_vector_type(4)));
typedef unsigned u32x4 __attribute__((ext_vector_type(4)));
typedef unsigned u32x2 __attribute__((ext_vector_type(2)));
constexpr int BM = 256, BK = 64, HALF = 128, HTB = HALF * BK * 2, STAGE_BYTES = 8 * HTB, NXCD = 8, WGM = 8;
__host__ __device__ __forceinline__ int lds_byte(int r, int c) { const int st = (r >> 4) * 2 + (c >> 5), rr = r & 15, cc = c & 31, ob = rr * 64 + cc * 2; return st * 1024 + (ob ^ (((ob >> 9) & 1) << 5)); }
__host__ __device__ __forceinline__ void stage_rc(int b, int& R, int& C) { const int st = b / 1024, sb = b % 1024, swz = sb ^ (((sb >> 9) & 1) << 5); R = (st >> 1) * 16 + swz / 64; C = (st & 1) * 32 + (swz % 64) / 2; }
__host__ __device__ __forceinline__ int perm32(int rho) { const int n = rho >> 4, i = rho & 15; return 8 * (i >> 2) + 4 * n + (i & 3); }
struct Unit { int pm, pn; };
struct Gemm { const bf16_t* A; const bf16_t* Bt; int M, N, K; };
struct StaticOrder {
    int nM, nN, nwg, G, c;
    __host__ __device__ void init(int M, int N, int G_, int c_) { nM = M / BM; nN = N / BM; nwg = nM * nN; G = G_; c = c_; }
    __host__ __device__ bool next(int i, Unit& u) const {
        const long L = (long)i * G + c; if (L >= nwg) return false;
        int wgid = (int)L; { const int q = nwg / NXCD, r = nwg % NXCD, xcd = wgid % NXCD, off = wgid / NXCD; wgid = (xcd < r ? xcd * (q + 1) : r * (q + 1) + (xcd - r) * q) + off; }
        const int nig = WGM * nN, gid = wgid / nig, fm = gid * WGM, gsz = (nM - fm) < WGM ? (nM - fm) : WGM;
        u.pm = fm + ((wgid % nig) % gsz); u.pn = (wgid % nig) / gsz; return true;
    }
    __device__ __forceinline__ void a_ready(const Unit&) const {}
    __device__ __forceinline__ void done(const Unit&) const {}
};
__device__ __forceinline__ unsigned cvt_pk_bf16(float lo, float hi) { unsigned r; asm volatile("v_cvt_pk_bf16_f32 %0, %1, %2" : "=v"(r) : "v"(lo), "v"(hi)); return r; }

typedef int i32x4 __attribute__((ext_vector_type(4)));
template <bool I8>
__device__ __forceinline__ f32x4 mma16(const bf16x8 b, const bf16x8 a, const f32x4 c) {
    if constexpr (I8) return __builtin_bit_cast(f32x4, __builtin_amdgcn_mfma_i32_16x16x64_i8(__builtin_bit_cast(i32x4, b), __builtin_bit_cast(i32x4, a), __builtin_bit_cast(i32x4, c), 0, 0, 0));
    else return __builtin_amdgcn_mfma_f32_16x16x32_bf16(b, a, c, 0, 0, 0);
}
template <class Epi, class Sched, bool I8 = false>
__device__ __forceinline__ void gemm_phase(PG8_LAS unsigned char* lds, const Gemm g, const Sched& S, const Epi& E) {
    int tid_ = threadIdx.x; asm volatile("" : "+v"(tid_));
    const int tid = tid_, wid = __builtin_amdgcn_readfirstlane(tid >> 6), lane = tid & 63, wr = wid >> 2, wc = wid & 3, fr = lane & 15, fq = lane >> 4;
    const int K = g.K, nt = K / BK;
    unsigned voffA[2], voffB[2];
#pragma unroll
    for (int i = 0; i < 2; ++i) { int R, C; stage_rc(tid * 16 + i * 8192, R, C); const int Rb = Epi::PERM ? ((R & ~31) + perm32(R & 31)) : R;
        voffA[i] = (unsigned)(R * K + C) * 2u; voffB[i] = (unsigned)(Rb * K + C) * 2u; }
    const size_t kstep = (size_t)(BK * 2);
    const size_t hstep = (size_t)HALF * K * 2;
    const size_t tstep = 2 * hstep;
    const unsigned ldsw = (unsigned)wid * 1024u;
    const int aoff = lds_byte(wr * 64 + fr, fq * 8), boff = lds_byte(wc * 32 + fr, fq * 8);
#define PG8_SA(b, h) (((b) * 2 + (h)) * HTB)
#define PG8_SB(b, h) ((4 + (b) * 2 + (h)) * HTB)
#define PG8_STAGE(bufoff, gbase, voff) do { _Pragma("unroll") for (int _i = 0; _i < 2; ++_i) \
        __builtin_amdgcn_global_load_lds((const unsigned*)((const char*)(gbase) + (voff)[_i]), (PG8_LAS unsigned*)(lds + (bufoff) + ldsw + _i * 8192), 16, 0, 0); } while (0)
#define PG8_LDA(dst, b, h) do { _Pragma("unroll") for (int m = 0; m < 4; ++m) _Pragma("unroll") for (int k = 0; k < 2; ++k) dst[m][k] = *(const PG8_LAS bf16x8*)(lds + PG8_SA(b, h) + aoff + m * 2048 + k * 1024); } while (0)
#define PG8_LDB(dst, b, h) do { _Pragma("unroll") for (int n = 0; n < 2; ++n) _Pragma("unroll") for (int k = 0; k < 2; ++k) dst[n][k] = *(const PG8_LAS bf16x8*)(lds + PG8_SB(b, h) + boff + n * 2048 + k * 1024); } while (0)
#define PG8_MMA(ai, bj, At, Bt) do { __builtin_amdgcn_s_setprio(1); _Pragma("unroll") for (int m = 0; m < 4; ++m) _Pragma("unroll") for (int n = 0; n < 2; ++n) _Pragma("unroll") for (int k = 0; k < 2; ++k) \
        acc[ai][bj][m][n] = mma16<I8>(Bt[n][k], At[m][k], acc[ai][bj][m][n]); __builtin_amdgcn_s_setprio(0); } while (0)
#define PG8_WAIT_V(n) asm volatile("s_waitcnt vmcnt(" #n ")" ::: "memory")
#define PG8_WAIT_L(n) asm volatile("s_waitcnt lgkmcnt(" #n ")" ::: "memory")
#define PG8_BAR __builtin_amdgcn_s_barrier()
#define PG8_SCHED __builtin_amdgcn_sched_barrier(0)
    Unit cur, nxt; int ui = 0;
    if (!S.next(0, cur)) return;
    f32x4 acc[2][2][4][2];
#pragma unroll
    for (int a = 0; a < 2; ++a)
#pragma unroll
        for (int b = 0; b < 2; ++b)
#pragma unroll
            for (int m = 0; m < 4; ++m)
#pragma unroll
                for (int n = 0; n < 2; ++n) acc[a][b][m][n] = (f32x4){0.f, 0.f, 0.f, 0.f};
    bf16x8 At[4][2], B0[2][2], B1[2][2];
    const char* cA = (const char*)g.A + (size_t)cur.pm * tstep; const char* cB = (const char*)g.Bt + (size_t)cur.pn * tstep;
    S.a_ready(cur);
    PG8_STAGE(PG8_SB(0, 0), cB, voffB); PG8_STAGE(PG8_SA(0, 0), cA, voffA); PG8_STAGE(PG8_SB(0, 1), cB + hstep, voffB); PG8_STAGE(PG8_SA(0, 1), cA + hstep, voffA);
    if (wr == 1) PG8_BAR;
    PG8_WAIT_V(4); PG8_BAR;
    PG8_STAGE(PG8_SB(1, 0), cB + kstep, voffB); PG8_STAGE(PG8_SA(1, 0), cA + kstep, voffA); PG8_STAGE(PG8_SB(1, 1), cB + hstep + kstep, voffB);
    PG8_WAIT_V(6); PG8_BAR;
    for (;;) {
        const bool has_next = S.next(ui + 1, nxt);
        const char* nA = has_next ? (const char*)g.A + (size_t)nxt.pm * tstep : cA; const char* nB = has_next ? (const char*)g.Bt + (size_t)nxt.pn * tstep : cB;
        for (int t = 0; t < nt; t += 2) {
            const bool last = (t == nt - 2);
            const char* a1 = cA + (size_t)(t + 1) * kstep;
            const char* a2 = last ? nA : cA + (size_t)(t + 2) * kstep; const char* b2 = last ? nB : cB + (size_t)(t + 2) * kstep;
            const char* a3 = a2 + kstep; const char* b3 = b2 + kstep;
            if (last && has_next) S.a_ready(nxt);
            PG8_LDB(B0, 0, 0); PG8_SCHED; PG8_LDA(At, 0, 0); PG8_STAGE(PG8_SA(1, 1), a1 + hstep, voffA);
            PG8_WAIT_L(8); PG8_BAR; PG8_WAIT_L(0); PG8_MMA(0, 0, At, B0); PG8_BAR; PG8_SCHED;
            PG8_LDB(B1, 0, 1); PG8_STAGE(PG8_SB(0, 0), b2, voffB);
            PG8_BAR; PG8_WAIT_L(0); PG8_MMA(0, 1, At, B1); PG8_BAR;
            PG8_LDA(At, 0, 1); PG8_STAGE(PG8_SA(0, 0), a2, voffA);
            PG8_BAR; PG8_WAIT_L(0); PG8_MMA(1, 0, At, B0); PG8_BAR; PG8_SCHED;
            PG8_STAGE(PG8_SB(0, 1), b2 + hstep, voffB);
            PG8_WAIT_V(6); PG8_BAR; PG8_MMA(1, 1, At, B1); PG8_BAR;
            PG8_LDB(B0, 1, 0); PG8_SCHED; PG8_LDA(At, 1, 0); PG8_STAGE(PG8_SA(0, 1), a2 + hstep, voffA);
            PG8_WAIT_L(8); PG8_BAR; PG8_WAIT_L(0); PG8_MMA(0, 0, At, B0); PG8_BAR; PG8_SCHED;
            PG8_LDB(B1, 1, 1); PG8_STAGE(PG8_SB(1, 0), b3, voffB);
            PG8_BAR; PG8_WAIT_L(0); PG8_MMA(0, 1, At, B1); PG8_BAR;
            PG8_LDA(At, 1, 1); PG8_STAGE(PG8_SA(1, 0), a3, voffA);
            PG8_BAR; PG8_WAIT_L(0); PG8_MMA(1, 0, At, B0); PG8_BAR; PG8_SCHED;
            PG8_STAGE(PG8_SB(1, 1), b3 + hstep, voffB);
            PG8_WAIT_V(6); PG8_BAR; PG8_MMA(1, 1, At, B1); PG8_BAR;
        }
        if constexpr (!Epi::AFTER_DRAIN) { E(acc, cur, wr, wc, fr, fq); S.done(cur); }
        if (!has_next) break;
#pragma unroll
        for (int a = 0; a < 2; ++a)
#pragma unroll
            for (int b = 0; b < 2; ++b)
#pragma unroll
                for (int m = 0; m < 4; ++m)
#pragma unroll
                    for (int n = 0; n < 2; ++n) acc[a][b][m][n] = (f32x4){0.f, 0.f, 0.f, 0.f};
        cur = nxt; cA = nA; cB = nB; ++ui;
    }
    PG8_WAIT_V(0);
    if (wr == 0) PG8_BAR;
    PG8_BAR;
    if constexpr (Epi::AFTER_DRAIN) { E.fused(acc, cur, wr, wc, fr, fq, lds, wid, lane); S.done(cur); }
#undef PG8_SA
#undef PG8_SB
#undef PG8_STAGE
#undef PG8_LDA
#undef PG8_LDB
#undef PG8_MMA
#undef PG8_WAIT_V
#undef PG8_WAIT_L
#undef PG8_BAR
#undef PG8_SCHED
}
}

__host__ __device__ __forceinline__ int cmap_in(int F) { return (F & ~255) + 128 * ((F >> 5) & 1) + 32 * ((F >> 6) & 3) + (F & 31); }
struct EpiInprojMF {
    static constexpr bool PERM = true, AFTER_DRAIN = false;
    bf16_t* P; const float* rinv; const float* bias_f; const int* pos; const float* ftab; const float* qg; const float* kg; const float* swf;
    __device__ __forceinline__ void operator()(pg8::f32x4 (&acc)[2][2][4][2], const pg8::Unit& u, int wr, int wc, int fr, int fq) const {
        typedef pg8::f32x4 f32x4;
        asm volatile("" : "+v"(fr), "+v"(fq));
        const int type = u.pn >> 1, head = 4 * (u.pn & 1) + wc, fb = 256 * u.pn + 64 * wc;
        {
            f32x4 sw[2][2];
#pragma unroll
            for (int bj = 0; bj < 2; ++bj)
#pragma unroll
                for (int n = 0; n < 2; ++n) sw[bj][n] = *(const f32x4*)(swf + fb + 32 * bj + 8 * fq + 4 * n);
#pragma unroll
            for (int ai = 0; ai < 2; ++ai)
#pragma unroll
                for (int bj = 0; bj < 2; ++bj)
#pragma unroll
                    for (int m = 0; m < 4; ++m)
#pragma unroll
                        for (int n = 0; n < 2; ++n) {
                            const pg8::i32x4 iv = __builtin_bit_cast(pg8::i32x4, acc[ai][bj][m][n]);
                            f32x4 fv; fv[0] = (float)iv[0]; fv[1] = (float)iv[1]; fv[2] = (float)iv[2]; fv[3] = (float)iv[3];
                            acc[ai][bj][m][n] = fv * sw[bj][n];
                        }
        }
        const size_t PSZ = (size_t)T * 512;
        const int rslot = (type == 0) ? 0 : (type == 1) ? 1 : (type == 2) ? 5 : (type == 3) ? 2 : (type == 4) ? 3 : (type == 5) ? 4 : 6;
        bf16_t* rowmaj = P + (size_t)rslot * PSZ;
        const int t0 = u.pm * 256 + wr * 64 + fr;
        f32x4 bv[2][2], gv[2][2], fh[2], fl[2];
#pragma unroll
        for (int bj = 0; bj < 2; ++bj)
#pragma unroll
            for (int n = 0; n < 2; ++n) bv[bj][n] = *(const f32x4*)(bias_f + fb + 32 * bj + 8 * fq + 4 * n);
        if (type <= 1) {
#pragma unroll
            for (int n = 0; n < 2; ++n) { fh[n] = *(const f32x4*)(ftab + 8 * fq + 4 * n); fl[n] = *(const f32x4*)(ftab + 32 + 8 * fq + 4 * n); }
        } else if (type == 4 || type == 5) {
            const float* gsrc = (type == 4) ? qg : kg;
#pragma unroll
            for (int bj = 0; bj < 2; ++bj)
#pragma unroll
                for (int n = 0; n < 2; ++n) gv[bj][n] = *(const f32x4*)(gsrc + 32 * bj + 8 * fq + 4 * n);
        }
#pragma unroll
        for (int ai = 0; ai < 2; ++ai) {
            float rv[4], pf[4];
#pragma unroll
            for (int m = 0; m < 4; ++m) { rv[m] = rinv[t0 + ai * 128 + m * 16]; pf[m] = (float)pos[t0 + ai * 128 + m * 16]; }
            asm volatile("" : "+v"(rv[0]), "+v"(rv[1]), "+v"(rv[2]), "+v"(rv[3]), "+v"(pf[0]), "+v"(pf[1]), "+v"(pf[2]), "+v"(pf[3]));
#pragma unroll
            for (int m = 0; m < 4; ++m) {
                const int t = t0 + ai * 128 + m * 16;
                const float r = rv[m];
                f32x4 v[2][2];
#pragma unroll
                for (int bj = 0; bj < 2; ++bj)
#pragma unroll
                    for (int n = 0; n < 2; ++n) v[bj][n] = acc[ai][bj][m][n] * r + bv[bj][n];
                if (type <= 1) {
                    const float sc = (type == 1) ? 0.125f : 1.f, pp = pf[m];
#pragma unroll
                    for (int n = 0; n < 2; ++n)
#pragma unroll
                        for (int j = 0; j < 4; ++j) {
                            const float rev = __builtin_amdgcn_fractf(__builtin_amdgcn_fractf(pp * fh[n][j]) + pp * fl[n][j]);
                            const float cs = __builtin_amdgcn_cosf(rev) * sc, sn = __builtin_amdgcn_sinf(rev) * sc;
                            const float x1 = v[0][n][j], x2 = v[1][n][j]; v[0][n][j] = x1 * cs - x2 * sn; v[1][n][j] = x2 * cs + x1 * sn;
                        }
                } else if (type == 3) {
#pragma unroll
                    for (int bj = 0; bj < 2; ++bj)
#pragma unroll
                        for (int n = 0; n < 2; ++n)
#pragma unroll
                            for (int j = 0; j < 4; ++j) { const float x = v[bj][n][j]; v[bj][n][j] = x / (1.f + __expf(-x)); }
                } else if (type == 4 || type == 5) {
                    float ss = 0.f;
#pragma unroll
                    for (int bj = 0; bj < 2; ++bj)
#pragma unroll
                        for (int n = 0; n < 2; ++n)
#pragma unroll
                            for (int j = 0; j < 4; ++j) ss += v[bj][n][j] * v[bj][n][j];
                    ss += __shfl_xor(ss, 16); ss += __shfl_xor(ss, 32);
                    const float rn = (1.0f / sqrtf(ss * (1.f / 64.f) + EPS)) * ((type == 4) ? 0.125f * 1.44269504089f : 1.f);
#pragma unroll
                    for (int bj = 0; bj < 2; ++bj)
#pragma unroll
                        for (int n = 0; n < 2; ++n) v[bj][n] = v[bj][n] * rn * gv[bj][n];
                }
#pragma unroll
                for (int bj = 0; bj < 2; ++bj) {
                    pg8::u32x4 w; w.x = pg8::cvt_pk_bf16(v[bj][0][0], v[bj][0][1]); w.y = pg8::cvt_pk_bf16(v[bj][0][2], v[bj][0][3]);
                    w.z = pg8::cvt_pk_bf16(v[bj][1][0], v[bj][1][1]); w.w = pg8::cvt_pk_bf16(v[bj][1][2], v[bj][1][3]);
                    *(pg8::u32x4*)(rowmaj + (size_t)t * 512 + head * 64 + 32 * bj + 8 * fq) = w;
                }
            }
        }
    }
};

struct EpiOutprojMF {
    static constexpr bool PERM = false, AFTER_DRAIN = true;
    const float* xf; const float* gate1; bf16_t* x1b; float* part2;
    float* pmax; unsigned char* x1q; float* rinv2q; unsigned* ctl;
    __device__ __forceinline__ void operator()(const pg8::f32x4 (&)[2][2][4][2], const pg8::Unit&, int, int, int, int) const {}
    __device__ __forceinline__ void fused(pg8::f32x4 (&acc)[2][2][4][2], const pg8::Unit& u, int wr, int wc, int fr, int fq, PG8_LAS unsigned char* lds, int wid, int lane) const {
        typedef pg8::f32x4 f32x4;
        asm volatile("" : "+v"(fr), "+v"(fq), "+v"(lane));
        constexpr int LD = 260;
        PG8_LAS float* TL = (PG8_LAS float*)lds;
        const int colw = wc * 32 + 4 * fq;
        f32x4 gv[2][2];
#pragma unroll
        for (int bj = 0; bj < 2; ++bj)
#pragma unroll
            for (int n = 0; n < 2; ++n) gv[bj][n] = *(const f32x4*)(gate1 + u.pn * 256 + colw + bj * 128 + n * 16);
        pg8::u32x2 ow[2][16];
#pragma unroll
        for (int ai = 0; ai < 2; ++ai) {
            f32x4 xv[16];
            const size_t rowbase = (size_t)(u.pm * 256 + ai * 128 + 16 * wid) * D + u.pn * 256 + 4 * lane;
#pragma unroll
            for (int r = 0; r < 16; ++r) xv[r] = __builtin_nontemporal_load((const f32x4*)(xf + rowbase + (size_t)r * D));
#pragma unroll
            for (int m = 0; m < 4; ++m)
#pragma unroll
                for (int bj = 0; bj < 2; ++bj)
#pragma unroll
                    for (int n = 0; n < 2; ++n) *(PG8_LAS f32x4*)(TL + (64 * wr + 16 * m + fr) * LD + colw + bj * 128 + n * 16) = gv[bj][n] * acc[ai][bj][m][n];
            __syncthreads();
            float ssr[16], amr[16];
#pragma unroll
            for (int r = 0; r < 16; ++r) {
                const f32x4 g = *(PG8_LAS f32x4*)(TL + (16 * wid + r) * LD + 4 * lane);
                const f32x4 o = xv[r] + g;
                pg8::u32x2 w; w.x = pg8::cvt_pk_bf16(o[0], o[1]); w.y = pg8::cvt_pk_bf16(o[2], o[3]);
                *(pg8::u32x2*)(x1b + rowbase + (size_t)r * D) = w;
                ow[ai][r] = w;
                ssr[r] = o[0] * o[0] + o[1] * o[1] + o[2] * o[2] + o[3] * o[3];
                amr[r] = fmaxf(fmaxf(__uint_as_float((w.x << 16) & 0x7fffffffu), __uint_as_float(w.x & 0x7fff0000u)), fmaxf(__uint_as_float((w.y << 16) & 0x7fffffffu), __uint_as_float(w.y & 0x7fff0000u)));
            }
            {
                const bool b5 = lane & 32, b4 = lane & 16, b3 = lane & 8, b2 = lane & 4;
                float w8[8], w4[4], w2[2], w1;
#pragma unroll
                for (int i = 0; i < 8; ++i) w8[i] = (b5 ? ssr[8 + i] : ssr[i]) + __shfl_xor(b5 ? ssr[i] : ssr[8 + i], 32);
#pragma unroll
                for (int i = 0; i < 4; ++i) w4[i] = (b4 ? w8[4 + i] : w8[i]) + __shfl_xor(b4 ? w8[i] : w8[4 + i], 16);
#pragma unroll
                for (int i = 0; i < 2; ++i) w2[i] = (b3 ? w4[2 + i] : w4[i]) + __shfl_xor(b3 ? w4[i] : w4[2 + i], 8);
                w1 = (b2 ? w2[1] : w2[0]) + __shfl_xor(b2 ? w2[0] : w2[1], 4);
                w1 += __shfl_xor(w1, 2); w1 += __shfl_xor(w1, 1);
                part2[(size_t)(u.pm * 256 + ai * 128 + 16 * wid + (lane >> 2)) * 16 + u.pn * 4 + (lane & 3)] = ((lane & 3) == 0) ? w1 : 0.f;
#pragma unroll
                for (int i = 0; i < 8; ++i) w8[i] = fmaxf(b5 ? amr[8 + i] : amr[i], __shfl_xor(b5 ? amr[i] : amr[8 + i], 32));
#pragma unroll
                for (int i = 0; i < 4; ++i) w4[i] = fmaxf(b4 ? w8[4 + i] : w8[i], __shfl_xor(b4 ? w8[i] : w8[4 + i], 16));
#pragma unroll
                for (int i = 0; i < 2; ++i) w2[i] = fmaxf(b3 ? w4[2 + i] : w4[i], __shfl_xor(b3 ? w4[i] : w4[2 + i], 8));
                w1 = fmaxf(b2 ? w2[1] : w2[0], __shfl_xor(b2 ? w2[0] : w2[1], 4));
                w1 = fmaxf(w1, __shfl_xor(w1, 2)); w1 = fmaxf(w1, __shfl_xor(w1, 1));
                if ((lane & 3) == 0) pmax[(size_t)(u.pm * 256 + ai * 128 + 16 * wid + (lane >> 2)) * 4 + u.pn] = w1;
            }
            __syncthreads();
        }
        asm volatile("s_waitcnt vmcnt(0)" ::: "memory");
        __syncthreads();
        if (wid == 0 && lane == 0) {
            unsigned* c = ctl + CTL_CNT + 16 * u.pm;
            __builtin_amdgcn_fence(__ATOMIC_RELEASE, "agent");
            asm volatile("s_waitcnt vmcnt(0)" ::: "memory");
            (void)xb_add(c, 1u);
            XB_SPIN(xb_ld(c) < 4u, ctl);
            __builtin_amdgcn_fence(__ATOMIC_ACQUIRE, "agent");
        }
        __syncthreads();
        float qsl = 0.f;
        {
            const int row = u.pm * 256 + (lane >> 4 & 1) * 128 + 16 * wid + (lane & 15);
            const f32x4* pp = (const f32x4*)(part2 + (size_t)row * 16);
            const f32x4 p0 = pp[0], p1 = pp[1], p2 = pp[2], p3 = pp[3], pm4 = *(const f32x4*)(pmax + (size_t)row * 4);
            const float ssum = ((p0[0] + p0[1]) + (p0[2] + p0[3])) + ((p1[0] + p1[1]) + (p1[2] + p1[3])) + ((p2[0] + p2[1]) + (p2[2] + p2[3])) + ((p3[0] + p3[1]) + (p3[2] + p3[3]));
            const float am = fmaxf(fmaxf(pm4[0], pm4[1]), fmaxf(pm4[2], pm4[3]));
            qsl = (am > 0.f) ? 127.f / am : 0.f;
            if (u.pn == 0 && lane < 32) rinv2q[row] = (1.0f / sqrtf(ssum * (1.0f / D) + EPS)) * (am * (1.f / 127.f));
        }
#pragma unroll
        for (int ai = 0; ai < 2; ++ai)
#pragma unroll
            for (int r = 0; r < 16; ++r) {
                const float qs = __builtin_bit_cast(float, __builtin_amdgcn_readlane(__builtin_bit_cast(int, qsl), ai * 16 + r));
                const pg8::u32x2 w = ow[ai][r];
                const unsigned b0 = __float_as_uint(fmaf(__uint_as_float(w.x << 16), qs, 12582912.f)), b1 = __float_as_uint(fmaf(__uint_as_float(w.x & 0xffff0000u), qs, 12582912.f));
                const unsigned b2 = __float_as_uint(fmaf(__uint_as_float(w.y << 16), qs, 12582912.f)), b3 = __float_as_uint(fmaf(__uint_as_float(w.y & 0xffff0000u), qs, 12582912.f));
                *(unsigned*)(x1q + (size_t)(u.pm * 256 + ai * 128 + 16 * wid + r) * D + u.pn * 256 + 4 * lane) = (b0 & 255u) | ((b1 & 255u) << 8) | ((b2 & 255u) << 16) | (b3 << 24);
            }
    }
};

__device__ __forceinline__ unsigned pk2(float lo, float hi) { return (unsigned)f2bf(lo) | ((unsigned)f2bf(hi) << 16); }
template <bool FOLD, bool CMAP>
__device__ __forceinline__ void transpose_item(const float* W, int K, int N, bf16_t* WT, float* scr, int item, int lane, const float* sg, const float* sm) {
    const int nblk = N / 32, kb = item / nblk, nb = item % nblk, k0 = 64 * kb, n0 = 32 * nb;
    float4 v[8]; float f[8];
#pragma unroll
    for (int i = 0; i < 8; ++i) { const int kk = 8 * i + (lane >> 3); v[i] = *(const float4*)(W + (size_t)(k0 + kk) * N + n0 + 4 * (lane & 7));
        f[i] = FOLD ? sg[k0 + kk] * (1.f + sm[k0 + kk]) : 1.f; }
#pragma unroll
    for (int i = 0; i < 8; ++i) { const int kk = 8 * i + (lane >> 3); float* d = scr + kk * 33 + 4 * (lane & 7);
        d[0] = v[i].x * f[i]; d[1] = v[i].y * f[i]; d[2] = v[i].z * f[i]; d[3] = v[i].w * f[i]; }
    asm volatile("s_waitcnt lgkmcnt(0)" ::: "memory");
    const int c = lane & 7, r0 = CMAP ? cmap_in(n0) : n0;
#pragma unroll
    for (int j = 0; j < 4; ++j) { const int n = (lane >> 3) + 8 * j; const float* s = scr + (8 * c) * 33 + n;
        pg8::u32x4 o; o.x = pk2(s[0 * 33], s[1 * 33]); o.y = pk2(s[2 * 33], s[3 * 33]); o.z = pk2(s[4 * 33], s[5 * 33]); o.w = pk2(s[6 * 33], s[7 * 33]);
        *(pg8::u32x4*)(WT + (size_t)(r0 + n) * K + k0 + 8 * c) = o; }
    asm volatile("s_waitcnt lgkmcnt(0)" ::: "memory");
}
template <int NC4, class VF>
__device__ __forceinline__ void gemv_cols(unsigned char* lds, const VF vf, const float* W, const int N, const int u, float* dst, const float* add) {
    constexpr int RG = 512 / NC4;
    float (*red)[NC4 * 4] = (float (*)[NC4 * 4])lds;
    const int tid = threadIdx.x, c4 = tid % NC4, rg = tid / NC4;
    if (rg < RG) {
        float4 acc = {0.f, 0.f, 0.f, 0.f};
        for (int r = rg; r < 1024; r += RG) { const float s = vf(r); const float4 w = *(const float4*)(W + (size_t)r * N + u * NC4 * 4 + c4 * 4);
            acc.x += s * w.x; acc.y += s * w.y; acc.z += s * w.z; acc.w += s * w.w; }
        red[rg][c4 * 4 + 0] = acc.x; red[rg][c4 * 4 + 1] = acc.y; red[rg][c4 * 4 + 2] = acc.z; red[rg][c4 * 4 + 3] = acc.w;
    }
    __syncthreads();
    if (tid < NC4 * 4) { float s = 0.f; for (int i = 0; i < RG; ++i) s += red[i][tid]; dst[u * NC4 * 4 + tid] = s + (add ? add[u * NC4 * 4 + tid] : 0.f); }
    __syncthreads();
}
struct VfSilu { const float* c; __device__ __forceinline__ float operator()(int r) const { const float v = c[r]; return v / (1.f + expf(-v)); } };
struct VfVec { const float* v; __device__ __forceinline__ float operator()(int r) const { return v[r]; } };


typedef float f32x16 __attribute__((ext_vector_type(16)));
typedef pg8::bf16x8 bf16x8;
#define MFMA32(a, b, c) __builtin_amdgcn_mfma_f32_32x32x16_bf16((a), (b), (c), 0, 0, 0)
__device__ __forceinline__ bf16x8 pack_frag(const f32x16& v, int s) {
    pg8::u32x4 w;
    w.x = pg8::cvt_pk_bf16(v[8 * s + 0], v[8 * s + 1]); w.y = pg8::cvt_pk_bf16(v[8 * s + 2], v[8 * s + 3]);
    w.z = pg8::cvt_pk_bf16(v[8 * s + 4], v[8 * s + 5]); w.w = pg8::cvt_pk_bf16(v[8 * s + 6], v[8 * s + 7]);
    return __builtin_bit_cast(bf16x8, w);
}
__device__ __forceinline__ bf16x8 load_tfrag(const bf16_t* rowp, int tok) {
    const uint2 a = *(const uint2*)(rowp + tok), b = *(const uint2*)(rowp + tok + 8);
    pg8::u32x4 w; w.x = a.x; w.y = a.y; w.z = b.x; w.w = b.y;
    return __builtin_bit_cast(bf16x8, w);
}


__device__ __forceinline__ bf16x8 tr_frag(const unsigned char* a0, int rows2) {
    typedef short s16x4 __attribute__((ext_vector_type(4)));
    typedef __attribute__((address_space(3))) s16x4 lds_s16x4;
    const s16x4 lo = __builtin_amdgcn_ds_read_tr16_b64_v4i16((lds_s16x4*)a0);
    const s16x4 hi = __builtin_amdgcn_ds_read_tr16_b64_v4i16((lds_s16x4*)(a0 + rows2 * 144));
    const uint2 l2 = __builtin_bit_cast(uint2, lo), h2 = __builtin_bit_cast(uint2, hi);
    pg8::u32x4 fw; fw.x = l2.x; fw.y = l2.y; fw.z = h2.x; fw.w = h2.y;
    return __builtin_bit_cast(bf16x8, fw);
}

__device__ __forceinline__ void ins16(float (&s)[16], float x) {
#pragma unroll
    for (int i = 15; i >= 1; --i) s[i] = __builtin_amdgcn_fmed3f(s[i - 1], s[i], x);
    s[0] = fmaxf(s[0], x);
}


struct OneUnitOrder {
    pg8::StaticOrder base; int round;
    __device__ __forceinline__ bool next(int i, pg8::Unit& u) const { if (i != 0) return false; return base.next(round, u); }
    __device__ __forceinline__ void a_ready(const pg8::Unit&) const {}
    __device__ __forceinline__ void done(const pg8::Unit&) const {}
};
struct EpiTopkMF {
    static constexpr bool PERM = false, AFTER_DRAIN = true;
    const float* rinv2q; const float* sq; const float* bias_q; unsigned short* ids; float* gates;
    __device__ __forceinline__ void operator()(const pg8::f32x4 (&)[2][2][4][2], const pg8::Unit&, int, int, int, int) const {}
    __device__ __forceinline__ void fused(pg8::f32x4 (&acc)[2][2][4][2], const pg8::Unit& u, int wr, int wc, int fr, int fq, PG8_LAS unsigned char* lds, int wid, int lane) const {
        typedef pg8::f32x4 f32x4;
        constexpr int SLD = 260;
        PG8_LAS float* SC = (PG8_LAS float*)lds; PG8_LAS float* MG = (PG8_LAS float*)(lds + 128 * SLD * 4);
        const int tid = wid * 64 + lane, tok = tid & 255, hk = tid >> 8;
        float rinv[2][4];
#pragma unroll
        for (int ai = 0; ai < 2; ++ai)
#pragma unroll
            for (int m = 0; m < 4; ++m) {
                const int row = u.pm * 256 + ai * 128 + wr * 64 + m * 16 + fr;
                rinv[ai][m] = rinv2q[row];
            }
        float sl[16], mine[16];
#pragma unroll
        for (int p = 0; p < 2; ++p) {
            f32x4 bv[2], sv[2];
#pragma unroll
            for (int n = 0; n < 2; ++n) { bv[n] = *(const f32x4*)(bias_q + u.pn * 256 + p * 128 + wc * 32 + n * 16 + 4 * fq); sv[n] = *(const f32x4*)(sq + u.pn * 256 + p * 128 + wc * 32 + n * 16 + 4 * fq); }
#pragma unroll
            for (int ai = 0; ai < 2; ++ai)
#pragma unroll
                for (int m = 0; m < 4; ++m)
#pragma unroll
                    for (int n = 0; n < 2; ++n)
#pragma unroll
                        for (int j = 0; j < 4; ++j)
                            SC[(32 * wc + 16 * n + 4 * fq + j) * SLD + (128 * ai + 64 * wr + 16 * m + fr)] = (float)__builtin_bit_cast(pg8::i32x4, acc[ai][p][m][n])[j] * (rinv[ai][m] * sv[n][j]) + bv[n][j];
            __syncthreads();
#pragma unroll
            for (int i = 0; i < 16; ++i) sl[i] = -INFINITY;
#pragma unroll 8
            for (int k = 0; k < 64; ++k) { const int key = 64 * hk + k; const float x = SC[key * SLD + tok]; ins16(sl, __uint_as_float((__float_as_uint(x) & 0xFFFFFF80u) | (unsigned)key)); }
            if (hk != p) {
#pragma unroll
                for (int i = 0; i < 16; ++i) MG[i * 256 + tok] = sl[i];
            }
            __syncthreads();
            if (hk == p) {
#pragma unroll
                for (int i = 0; i < 16; ++i) ins16(sl, MG[i * 256 + tok]);
#pragma unroll
                for (int i = 0; i < 16; ++i) mine[i] = sl[i];
            }
            __syncthreads();
        }
        PG8_LAS float* X1 = SC; PG8_LAS float* TL = SC + 4096; PG8_LAS unsigned* I0 = (PG8_LAS unsigned*)(SC + 8192); PG8_LAS unsigned* I1 = (PG8_LAS unsigned*)(SC + 12288);
        if (hk) {
#pragma unroll
            for (int i = 0; i < 16; ++i) { X1[i * 256 + tok] = mine[i]; I1[i * 256 + tok] = __float_as_uint(mine[i]) & 0x7Fu; }
        } else {
#pragma unroll
            for (int i = 0; i < 16; ++i) I0[i * 256 + tok] = __float_as_uint(mine[i]) & 0x7Fu;
        }
        __syncthreads();
        if (!hk) {
            float s1m[16], tl[16];
#pragma unroll
            for (int i = 0; i < 16; ++i) { s1m[i] = __uint_as_float(__float_as_uint(X1[i * 256 + tok]) & 0xFFFFFF80u); mine[i] = __uint_as_float(__float_as_uint(mine[i]) & 0xFFFFFF80u); tl[i] = -INFINITY; }
#pragma unroll
            for (int a2 = 0; a2 < 16; ++a2)
#pragma unroll
                for (int b2 = 0; b2 < 16; ++b2)
                    if ((a2 + 1) * (b2 + 1) <= 16) ins16(tl, __uint_as_float((__float_as_uint(mine[a2] + s1m[b2]) & 0xFFFFFF00u) | (unsigned)(a2 * 16 + b2)));
#pragma unroll
            for (int i = 0; i < 16; ++i) TL[i * 256 + tok] = tl[i];
        }
        __syncthreads();
        if (hk) {
            float ev[16]; float sum = 0.f; unsigned cd[16];
#pragma unroll
            for (int j = 0; j < 16; ++j) { const unsigned bits = __float_as_uint(TL[j * 256 + tok]); cd[j] = bits & 0xFFu; ev[j] = __uint_as_float(bits & 0xFFFFFF00u); }
            const float mx = ev[0];
#pragma unroll
            for (int j = 0; j < 16; ++j) { ev[j] = __expf(ev[j] - mx); sum += ev[j]; }
            const float inv = 1.f / sum;
            unsigned idw[8];
#pragma unroll
            for (int j = 0; j < 16; ++j) {
                const unsigned id = I0[(cd[j] >> 4) * 256 + tok] * 128u + I1[(cd[j] & 15u) * 256 + tok];
                if (j & 1) idw[j >> 1] |= id << 16; else idw[j >> 1] = id;
                ev[j] *= inv;
            }
            const size_t t = (size_t)u.pm * 256 + tok;
            unsigned short* idp = ids + t * 128 + u.pn * 16; float* gp = gates + t * 128 + u.pn * 16;
            *(uint4*)idp = make_uint4(idw[0], idw[1], idw[2], idw[3]); *(uint4*)(idp + 8) = make_uint4(idw[4], idw[5], idw[6], idw[7]);
#pragma unroll
            for (int q = 0; q < 4; ++q) *(float4*)(gp + 4 * q) = make_float4(ev[4 * q], ev[4 * q + 1], ev[4 * q + 2], ev[4 * q + 3]);
        }
        __syncthreads();
    }
};


__device__ __forceinline__ void convert_tables(const float* down, const float* up, unsigned char* q8, bf16_t* dsc, int lane, int cw, int nconv, int r0, int r1) {
    for (int row0 = r0 + cw * 2; row0 < r1; row0 += nconv * 2) {
        float4 v[2][4];
#pragma unroll
        for (int rr = 0; rr < 2; ++rr) {
            const int row = row0 + rr, isup = row >> 14, e = row & 16383;
            const float* sp = (isup ? up : down) + (size_t)e * 1024 + lane * 4;
#pragma unroll
            for (int q = 0; q < 4; ++q) v[rr][q] = ld_nt4(sp + 256 * q);
        }
#pragma unroll
        for (int rr = 0; rr < 2; ++rr) {
            const int row = row0 + rr, isup = row >> 14, e = row & 16383;
            {
                float ss = 0.f;
#pragma unroll
                for (int q = 0; q < 4; ++q) ss += v[rr][q].x * v[rr][q].x + v[rr][q].y * v[rr][q].y + v[rr][q].z * v[rr][q].z + v[rr][q].w * v[rr][q].w;
#pragma unroll
                for (int o = 32; o > 0; o >>= 1) ss += __shfl_xor(ss, o);
                const float sigma = sqrtf(ss * (1.0f / 1024.0f));
                const float s = (sigma > 0.f) ? 7.5f / (2.6f * sigma) : 1.f;
#pragma unroll
                for (int q = 0; q < 4; ++q) {
                    const int n0 = (int)fminf(fmaxf(__builtin_rintf(v[rr][q].x * s), -8.f), 7.f) + 8, n1 = (int)fminf(fmaxf(__builtin_rintf(v[rr][q].y * s), -8.f), 7.f) + 8;
                    const int n2 = (int)fminf(fmaxf(__builtin_rintf(v[rr][q].z * s), -8.f), 7.f) + 8, n3 = (int)fminf(fmaxf(__builtin_rintf(v[rr][q].w * s), -8.f), 7.f) + 8;
                    const int h1 = isup ? ((n1 - 8) & 15) : n1, h3 = isup ? ((n3 - 8) & 15) : n3;
                    *(unsigned short*)(q8 + (size_t)isup * (8u << 20) + ((size_t)q * 16384 + e) * 128 + (lane & 7) * 16 + (lane >> 3) * 2) = (unsigned short)(n0 | (h1 << 4) | (n2 << 8) | (h3 << 12));
                }
                if (lane == 0) dsc[row] = f2bf(1.0f / s);
            }
        }
    }
}

struct Params {
    const float *x, *c; const int* pos; const float *ada_w, *ada_b, *g1, *g2, *w_in, *rgain, *qg, *kg, *og, *w_out, *wq, *sk, *down, *up;
    float* out; unsigned char* ws; RopeC rc;
};

__global__ void __launch_bounds__(512) mk_fwd(Params p) {
    extern __shared__ __attribute__((aligned(16))) unsigned char lds[];
    const int tid = threadIdx.x, lane = tid & 63, bid = blockIdx.x, G = gridDim.x; int wave = tid >> 6;
    unsigned char* ws = p.ws;
    float* mod = (float*)(ws + OFF_MOD); float* rinv1 = (float*)(ws + OFF_RINV1); float* ftab = (float*)(ws + OFF_ROPE);
    bf16_t* P = (bf16_t*)(ws + OFF_P); float* kv = (float*)(ws + OFF_KV); bf16_t* stT = (bf16_t*)(ws + OFF_ST); bf16_t* ycat = (bf16_t*)(ws + OFF_YCAT);
    bf16_t* Win_t = (bf16_t*)(ws + OFF_WINT); float* bias_f = (float*)(ws + OFF_BIASF);
    unsigned char* xq = ws + OFF_XQ; float* swf = (float*)(ws + OFF_SWF);
    float* sq = (float*)(ws + OFF_SQ); float* pmax = (float*)(ws + OFF_PMAX); float* rinv2q = (float*)(ws + OFF_RINV2Q); unsigned char* Weffq_t = ws + OFF_WEFFQ; unsigned char* x1q = ws + OFF_X1Q;
    unsigned* ctl = (unsigned*)(ws + OFF_CTL);
    bf16_t* Weff_t = (bf16_t*)(ws + OFF_WEFFT); bf16_t* Wout_t = (bf16_t*)(ws + OFF_WOUTT); float* bias_q = (float*)(ws + OFF_BIASQ); float* bq_part = (float*)(ws + OFF_BQPART);
    float* part2 = (float*)(ws + OFF_PART2); bf16_t* x1b = (bf16_t*)(ws + OFF_X1B); unsigned short* ids = (unsigned short*)(ws + OFF_IDS); unsigned char* q8 = ws + OFF_Q8; bf16_t* dsc = (bf16_t*)(ws + OFF_DSC); float* gates = (float*)(ws + OFF_GATES);
    const size_t PS = (size_t)T * 512;
    const bf16_t *Qr = P, *Kr = P + PS, *Gr = P + 2 * PS, *Qs = P + 3 * PS, *Ks = P + 4 * PS, *Vr = P + 5 * PS, *Vs = P + 6 * PS;
    float* out = p.out;

    if (tid < 4) ((LAS unsigned*)((LAS unsigned char*)lds + LDS_ST_OFF))[tid] = 0u;
    __syncthreads();
    XcdBarrier bar = xcd_barrier_post((unsigned*)(ws + OFF_CTL), (volatile LAS unsigned*)((LAS unsigned char*)lds + LDS_ST_OFF));

    for (int u = bid; u < 256; u += G) gemv_cols<6>(lds, VfSilu{p.c}, p.ada_w, 6144, u, mod, p.ada_b);
    for (int row0 = (bid * 8 + wave) * 2; row0 < T; row0 += G * 16) {
        float4 v[2][4];
#pragma unroll
        for (int rr = 0; rr < 2; ++rr)
#pragma unroll
            for (int j = 0; j < 4; ++j) v[rr][j] = ld_nt4(p.x + (size_t)(row0 + rr) * D + (lane + 64 * j) * 4);
#pragma unroll
        for (int rr = 0; rr < 2; ++rr) {
            float s = 0.f, am = 0.f;
#pragma unroll
            for (int j = 0; j < 4; ++j) { const float4 q = v[rr][j]; s += q.x * q.x + q.y * q.y + q.z * q.z + q.w * q.w;
                am = fmaxf(fmaxf(am, fmaxf(fabsf(q.x), fabsf(q.y))), fmaxf(fabsf(q.z), fabsf(q.w))); }
#pragma unroll
            for (int o = 32; o > 0; o >>= 1) { s += __shfl_xor(s, o); am = fmaxf(am, __shfl_xor(am, o)); }
            const float qs = (am > 0.f) ? 127.f / am : 0.f;
            unsigned* xqo = (unsigned*)(xq + (size_t)(row0 + rr) * D);
#pragma unroll
            for (int j = 0; j < 4; ++j) { const float4 q = v[rr][j];
                const unsigned b0 = __float_as_uint(fmaf(q.x, qs, 12582912.f)), b1 = __float_as_uint(fmaf(q.y, qs, 12582912.f)), b2 = __float_as_uint(fmaf(q.z, qs, 12582912.f)), b3 = __float_as_uint(fmaf(q.w, qs, 12582912.f));
                xqo[lane + 64 * j] = (b0 & 255u) | ((b1 & 255u) << 8) | ((b2 & 255u) << 16) | (b3 << 24); }
            if (lane == 0) rinv1[row0 + rr] = (1.0f / sqrtf(s * (1.0f / D) + EPS)) * (am * (1.f / 127.f));
        }
    }
    if (bid == 0 && tid == 0) {
#pragma unroll
        for (int i = 0; i < 32; ++i) { ftab[i] = p.rc.fh[i]; ftab[32 + i] = p.rc.fl[i]; }
    }
    xcd_barrier(bar);

    {
        for (int nb = bid; nb < 112; nb += G) {
            const int n0 = 32 * nb, r8 = lane >> 3, c = lane & 7, kw = 128 * wave;
            float* cm = (float*)(lds + 8 * 4608);
            unsigned* tl = (unsigned*)(lds + wave * 4608);
            float4 v[16];
#pragma unroll
            for (int i = 0; i < 16; ++i) { const int kk = 32 * (i >> 2) + 4 * r8 + (i & 3); v[i] = *(const float4*)(p.w_in + (size_t)(kw + kk) * 3584 + n0 + 4 * c); }
            float4 mx = {0.f, 0.f, 0.f, 0.f};
#pragma unroll
            for (int i = 0; i < 16; ++i) { const int kk = 32 * (i >> 2) + 4 * r8 + (i & 3); const float f = p.g1[kw + kk] * (1.f + mod[1024 + kw + kk]);
                v[i].x *= f; v[i].y *= f; v[i].z *= f; v[i].w *= f;
                mx.x = fmaxf(mx.x, fabsf(v[i].x)); mx.y = fmaxf(mx.y, fabsf(v[i].y)); mx.z = fmaxf(mx.z, fabsf(v[i].z)); mx.w = fmaxf(mx.w, fabsf(v[i].w)); }
#pragma unroll
            for (int o = 8; o < 64; o <<= 1) { mx.x = fmaxf(mx.x, __shfl_xor(mx.x, o)); mx.y = fmaxf(mx.y, __shfl_xor(mx.y, o)); mx.z = fmaxf(mx.z, __shfl_xor(mx.z, o)); mx.w = fmaxf(mx.w, __shfl_xor(mx.w, o)); }
            if (lane < 8) *(float4*)(cm + wave * 32 + 4 * c) = mx;
            __syncthreads();
#pragma unroll
            for (int w2 = 0; w2 < 8; ++w2) { const float4 o = *(const float4*)(cm + w2 * 32 + 4 * c); mx.x = fmaxf(mx.x, o.x); mx.y = fmaxf(mx.y, o.y); mx.z = fmaxf(mx.z, o.z); mx.w = fmaxf(mx.w, o.w); }
            if (wave == 0 && lane < 8) *(float4*)(swf + n0 + 4 * c) = make_float4(mx.x * (1.f / 127.f), mx.y * (1.f / 127.f), mx.z * (1.f / 127.f), mx.w * (1.f / 127.f));
            const float qx = (mx.x > 0.f) ? 127.f / mx.x : 0.f, qy = (mx.y > 0.f) ? 127.f / mx.y : 0.f, qz = (mx.z > 0.f) ? 127.f / mx.z : 0.f, qw = (mx.w > 0.f) ? 127.f / mx.w : 0.f;
#pragma unroll
            for (int a = 0; a < 4; ++a) {
                unsigned d[4];
#pragma unroll
                for (int j = 0; j < 4; ++j) {
                    const float qq = (j == 0) ? qx : (j == 1) ? qy : (j == 2) ? qz : qw;
                    unsigned w = 0;
#pragma unroll
                    for (int b = 0; b < 4; ++b) { const float4 t = v[4 * a + b]; const float e = (j == 0) ? t.x : (j == 1) ? t.y : (j == 2) ? t.z : t.w;
                        w |= (__float_as_uint(fmaf(e, qq, 12582912.f)) & 255u) << (8 * b); }
                    d[j] = w;
                }
#pragma unroll
                for (int j = 0; j < 4; ++j) tl[(4 * c + j) * 34 + 8 * a + r8] = d[j];
            }
            asm volatile("s_waitcnt lgkmcnt(0)" ::: "memory");
            const int rb = cmap_in(n0);
#pragma unroll
            for (int jj = 0; jj < 4; ++jj) { const int q = lane + 64 * jj, n = q >> 3, ch = q & 7;
                const uint2 lo = *(const uint2*)(tl + n * 34 + 4 * ch), hi = *(const uint2*)(tl + n * 34 + 4 * ch + 2);
                pg8::u32x4 o; o.x = lo.x; o.y = lo.y; o.z = hi.x; o.w = hi.y;
                *(pg8::u32x4*)((unsigned char*)Win_t + (size_t)(rb + n) * 1024 + kw + 16 * ch) = o; }
            __syncthreads();
        }
        for (int u = bid - 128; u >= 0 && u < 128; u += G) gemv_cols<7>(lds, VfVec{mod}, p.w_in, 3584, u, bias_f, nullptr);
    }
    xcd_barrier(bar);

    {
        pg8::Gemm g{(const bf16_t*)xq, Win_t, T, 3584, 512}; pg8::StaticOrder S; S.init(T, 3584, G, bid);
        EpiInprojMF E{P, rinv1, bias_f, p.pos, ftab, p.qg, p.kg, swf};
        pg8::gemm_phase<EpiInprojMF, pg8::StaticOrder, true>((PG8_LAS unsigned char*)lds, g, S, E);
        const int nidle = (G > 128) ? G - 128 : G, ib = (G > 128) ? bid - 128 : bid;
        {
            float* scr = (float*)(lds + wave * 16384);
            if (ib >= 0) for (int it = ib * 8 + wave; it < 16 * 32; it += nidle * 8) transpose_item<false, false>(p.w_out, 1024, 1024, Wout_t, scr, it, lane, nullptr, nullptr);
            __syncthreads();
        }
        if (ib >= 0) for (int wu = ib; wu < 256; wu += nidle) {
            const int hp = wu >> 4, blk = wu & 15, i0 = blk * 64;
            __syncthreads();
            unsigned char* Wt = lds; unsigned char* St = lds + 64 * 272; float* bred = (float*)(lds + 64 * 272 + 128 * 272);
            for (int e4 = tid; e4 < 2048; e4 += 512) { const int r = e4 >> 5, c4 = e4 & 31; const float4 v = *(const float4*)(p.wq + (size_t)(i0 + r) * 2048 + hp * 128 + 4 * c4);
                *(uint2*)(Wt + r * 272 + c4 * 8) = make_uint2(pk2(v.x, v.y), pk2(v.z, v.w)); }
            for (int e4 = tid; e4 < 4096; e4 += 512) { const int r = e4 >> 5, c4 = e4 & 31; const float4 v = *(const float4*)(p.sk + ((size_t)hp * 128 + r) * 128 + 4 * c4);
                *(uint2*)(St + r * 272 + c4 * 8) = make_uint2(pk2(v.x, v.y), pk2(v.z, v.w)); }
            __syncthreads();
            const int rt = wave >> 2, ct = wave & 3, l31 = lane & 31, hf = lane >> 5;
            f32x16 C;
#pragma unroll
            for (int r = 0; r < 16; ++r) C[r] = 0.f;
#pragma unroll
            for (int s8 = 0; s8 < 8; ++s8) C = MFMA32(*(const bf16x8*)(Wt + (32 * rt + l31) * 272 + (16 * s8 + 8 * hf) * 2), *(const bf16x8*)(St + (32 * ct + l31) * 272 + (16 * s8 + 8 * hf) * 2), C);
            float bsum = 0.f; unsigned amx = 0u;
            bf16_t* wcol = Weff_t + (size_t)(hp * 128 + 32 * ct + l31) * 1024 + i0 + 32 * rt + 4 * hf;
#pragma unroll
            for (int g4 = 0; g4 < 4; ++g4) {
                const int i = i0 + 32 * rt + 8 * g4 + 4 * hf;
                const float4 gg = *(const float4*)(p.g2 + i), sc = *(const float4*)(mod + 4096 + i), sh = *(const float4*)(mod + 3072 + i);
                const float c0 = C[4 * g4], c1 = C[4 * g4 + 1], c2 = C[4 * g4 + 2], c3 = C[4 * g4 + 3];
                bsum += sh.x * c0 + sh.y * c1 + sh.z * c2 + sh.w * c3;
                const uint2 wv = make_uint2(pk2(c0 * gg.x * (1.f + sc.x), c1 * gg.y * (1.f + sc.y)), pk2(c2 * gg.z * (1.f + sc.z), c3 * gg.w * (1.f + sc.w)));
                *(uint2*)(wcol + 8 * g4) = wv;
                amx = max(max(amx, (wv.x << 16) & 0x7fffffffu), max(wv.x & 0x7fff0000u, max((wv.y << 16) & 0x7fffffffu, wv.y & 0x7fff0000u)));
            }
            amx = max(amx, (unsigned)__shfl_xor((int)amx, 32));
            if (hf == 0) (void)__hip_atomic_fetch_max(ctl + CTL_CMAX + hp * 128 + 32 * ct + l31, amx, __ATOMIC_RELAXED, __HIP_MEMORY_SCOPE_AGENT);
            bsum += __shfl_xor(bsum, 32);
            if (hf == 0) bred[rt * 128 + 32 * ct + l31] = bsum;
            __syncthreads();
            if (tid < 128) bq_part[(size_t)blk * 2048 + hp * 128 + tid] = bred[tid] + bred[128 + tid];
        }
        __syncthreads();
        if (ib >= 0) convert_tables(p.down, p.up, q8, dsc, lane, ib * 8 + wave, nidle * 8, 0, CONV_SPLIT);
    }
    xcd_barrier(bar);
    wave = threadIdx.x >> 6; asm volatile("" : "+v"(wave));

    {
        const int gw = __builtin_amdgcn_readfirstlane(bid * 8 + wave), NGW = G * 8, l31 = lane & 31, hf = lane >> 5;
        const int wv0 = __builtin_amdgcn_readfirstlane(wave);
        for (int U = gw; U < 1024; U += NGW) {
            const int n = U >> 3, h = U & 7;
            f32x16 C[2][2];
#pragma unroll
            for (int a = 0; a < 2; ++a)
#pragma unroll
                for (int b = 0; b < 2; ++b)
#pragma unroll
                    for (int r = 0; r < 16; ++r) C[a][b][r] = 0.f;
            unsigned char* Kt = lds + wv0 * 9216; unsigned char* Vt = Kt + 4608;
            const int r8 = lane >> 3, pc = lane & 7, trq = (lane & 15) >> 2, trp = lane & 3, trd = (lane >> 4) & 1;
            const char* kbase = (const char*)(Kr + (size_t)n * 128 * 512 + h * 64); const char* vbase = (const char*)(Vr + (size_t)n * 128 * 512 + h * 64);
            const unsigned loff = (unsigned)(r8 * 512 + pc * 8) * 2u;
            const float lg = lg2_head(h);
            pg8::u32x4 gK[4], gV[4];
#pragma unroll
            for (int i = 0; i < 4; ++i) { gK[i] = *(const pg8::u32x4*)(kbase + (loff + i * 8192u)); gV[i] = *(const pg8::u32x4*)(vbase + (loff + i * 8192u)); }
            for (int sb4 = 0; sb4 < 4; ++sb4) {
#pragma unroll
                for (int i = 0; i < 4; ++i) { *(pg8::u32x4*)(Kt + (8 * i + r8) * 144 + pc * 16) = gK[i]; *(pg8::u32x4*)(Vt + (8 * i + r8) * 144 + pc * 16) = gV[i]; }
                { const int sn = (sb4 < 3) ? sb4 + 1 : sb4;
#pragma unroll
                  for (int i = 0; i < 4; ++i) { gK[i] = *(const pg8::u32x4*)(kbase + (size_t)sn * 32768 + (loff + i * 8192u)); gV[i] = *(const pg8::u32x4*)(vbase + (size_t)sn * 32768 + (loff + i * 8192u)); } }
#pragma unroll
                for (int s = 0; s < 2; ++s) {
                    bf16x8 Af[2], Bf[2];
#pragma unroll
                    for (int a = 0; a < 2; ++a) {
                        Af[a] = tr_frag(Vt + (16 * s + 8 * hf + trq) * 144 + (32 * a + 16 * trd + 4 * trp) * 2, 4);
                        const bf16x8 kraw = tr_frag(Kt + (16 * s + 8 * hf + trq) * 144 + (32 * a + 16 * trd + 4 * trp) * 2, 4);
                        const pg8::u32x4 kw = __builtin_bit_cast(pg8::u32x4, kraw); const unsigned kk[4] = {kw.x, kw.y, kw.z, kw.w};
                        pg8::u32x4 o; unsigned* op = (unsigned*)&o;
#pragma unroll
                        for (int e2 = 0; e2 < 4; ++e2) {
                            const int j0 = 32 * sb4 + 16 * s + 8 * hf + 2 * e2;
                            const float z0 = __builtin_amdgcn_exp2f((float)(127 - j0) * lg), z1 = __builtin_amdgcn_exp2f((float)(126 - j0) * lg);
                            op[e2] = pg8::cvt_pk_bf16(__uint_as_float(kk[e2] << 16) * z0, __uint_as_float(kk[e2] & 0xffff0000u) * z1);
                        }
                        Bf[a] = __builtin_bit_cast(bf16x8, o);
                    }
#pragma unroll
                    for (int a = 0; a < 2; ++a)
#pragma unroll
                        for (int b = 0; b < 2; ++b) C[a][b] = MFMA32(Af[a], Bf[b], C[a][b]);
                }
            }
            float* dst = kv + (size_t)(n * 8 + h) * 4096;
#pragma unroll
            for (int a = 0; a < 2; ++a)
#pragma unroll
                for (int b = 0; b < 2; ++b)
#pragma unroll
                    for (int r = 0; r < 16; ++r) dst[(32 * a + (r & 3) + 8 * (r >> 2) + 4 * hf) * 64 + 32 * b + l31] = C[a][b][r];
        }
        bf16x8 Tri[2];
        {
            pg8::u32x4 w0, w1; unsigned* p0 = (unsigned*)&w0; unsigned* p1 = (unsigned*)&w1;
#pragma unroll
            for (int e2 = 0; e2 < 4; ++e2) {
                unsigned a0 = 0, a1 = 0;
#pragma unroll
                for (int q = 0; q < 2; ++q) { const int e = 2 * e2 + q, ip = 8 * (e >> 2) + 4 * hf + (e & 3);
                    a0 |= ((ip > l31) ? 0x3F80u : 0u) << (16 * q); a1 |= ((16 + ip > l31) ? 0x3F80u : 0u) << (16 * q); }
                p0[e2] = a0; p1[e2] = a1;
            }
            Tri[0] = __builtin_bit_cast(bf16x8, w0); Tri[1] = __builtin_bit_cast(bf16x8, w1);
        }
        const bool sb_local = (G % 8 == 0) && (4096 % G == 0) && ((4096 / G) % 8 == 0);
        const int sb_per_wave = sb_local ? 4096 / G / 8 : (4096 + NGW - 1 - gw) / NGW;
        const int wv = __builtin_amdgcn_readfirstlane(wave);
        for (int ps = 0; ps < sb_per_wave; ++ps) {
            const int U = sb_local ? 0 : gw + ps * NGW;
            const int h = sb_local ? (bid & 7) : (U & 7), qt = sb_local ? (bid >> 3) * (4096 / G) + ps * 8 + wv : (U >> 3), q0 = qt * 32;
            f32x16 O[2];
#pragma unroll
            for (int r = 0; r < 16; ++r) { O[0][r] = 0.f; O[1][r] = 0.f; }
            float carry = 0.f;
            unsigned char* Kt = lds + wv * 9216; unsigned char* Vt = Kt + 4608;
            const int r8 = lane >> 3, pc = lane & 7;
            const char* kbase = (const char*)(Ks + h * 64); const char* vbase = (const char*)(Vs + h * 64);
            const unsigned loff = (unsigned)(r8 * 512 + pc * 8) * 2u;
            pg8::u32x4 gK[4], gV[4];
            bf16x8 Qf[4];
            {
                const char* qbase = (const char*)(Qs + h * 64);
#pragma unroll
                for (int i = 0; i < 4; ++i) gK[i] = *(const pg8::u32x4*)(qbase + (size_t)qt * 32768 + (loff + i * 8192u));
#pragma unroll
                for (int i = 0; i < 4; ++i) *(pg8::u32x4*)(Kt + (8 * i + r8) * 144 + pc * 16) = gK[i];
#pragma unroll
                for (int s = 0; s < 4; ++s) Qf[s] = *(const bf16x8*)(Kt + l31 * 144 + 32 * s + 16 * hf);
            }
#pragma unroll
            for (int i = 0; i < 4; ++i) { gK[i] = *(const pg8::u32x4*)(kbase + (size_t)qt * 32768 + (loff + i * 8192u)); gV[i] = *(const pg8::u32x4*)(vbase + (size_t)qt * 32768 + (loff + i * 8192u)); }
            const int trq = (lane & 15) >> 2, trp = lane & 3, trd = (lane >> 4) & 1;
            for (int kb = qt; kb >= 0; --kb) {
#pragma unroll
                for (int i = 0; i < 4; ++i) { *(pg8::u32x4*)(Kt + (8 * i + r8) * 144 + pc * 16) = gK[i]; *(pg8::u32x4*)(Vt + (8 * i + r8) * 144 + pc * 16) = gV[i]; }
                {
                    const int kbn = (kb > 0) ? kb - 1 : 0;
#pragma unroll
                    for (int i = 0; i < 4; ++i) { gK[i] = *(const pg8::u32x4*)(kbase + (size_t)kbn * 32768 + (loff + i * 8192u)); gV[i] = *(const pg8::u32x4*)(vbase + (size_t)kbn * 32768 + (loff + i * 8192u)); }
                }
                bf16x8 Kf[4], Vf[2][2];
#pragma unroll
                for (int s = 0; s < 4; ++s) Kf[s] = *(const bf16x8*)(Kt + l31 * 144 + 32 * s + 16 * hf);
#pragma unroll
                for (int s = 0; s < 2; ++s)
#pragma unroll
                    for (int dt = 0; dt < 2; ++dt) {
                        Vf[s][dt] = tr_frag(Vt + (16 * s + 4 * hf + trq) * 144 + (32 * dt + 16 * trd + 4 * trp) * 2, 8);
                    }
                f32x16 S;
#pragma unroll
                for (int r = 0; r < 16; ++r) S[r] = 0.f;
#pragma unroll
                for (int s = 0; s < 4; ++s) S = MFMA32(Kf[s], Qf[s], S);
                const bool diag = (kb == qt);
                f32x16 sp, lb;
                float csum = 0.f;
                if (diag) {
#pragma unroll
                    for (int r = 0; r < 16; ++r) {
                        const int i = (r & 3) + 8 * (r >> 2) + 4 * hf;
                        const float z = S[r];
                        const float l1p = __builtin_amdgcn_logf(1.0f + __builtin_amdgcn_exp2f(-fabsf(z)));
                        const float spv = (i < l31) ? (fmaxf(z, 0.f) + l1p) : 0.f;
                        sp[r] = spv; lb[r] = (i < l31) ? (fminf(z, 0.f) - l1p) : -INFINITY; csum += spv;
                    }
                } else {
#pragma unroll
                    for (int r = 0; r < 16; ++r) {
                        const float z = S[r];
                        const float l1p = __builtin_amdgcn_logf(1.0f + __builtin_amdgcn_exp2f(-fabsf(z)));
                        const float spv = fmaxf(z, 0.f) + l1p;
                        sp[r] = spv; lb[r] = fminf(z, 0.f) - l1p; csum += spv;
                    }
                }
                f32x16 Rt;
#pragma unroll
                for (int r = 0; r < 16; ++r) Rt[r] = carry;
#pragma unroll
                for (int s = 0; s < 2; ++s) Rt = MFMA32(Tri[s], pack_frag(sp, s), Rt);
                f32x16 wv;
#pragma unroll
                for (int r = 0; r < 16; ++r) wv[r] = __builtin_amdgcn_exp2f(lb[r] - Rt[r]);
#pragma unroll
                for (int s = 0; s < 2; ++s) { const bf16x8 wp = pack_frag(wv, s);
#pragma unroll
                    for (int dt = 0; dt < 2; ++dt) O[dt] = MFMA32(Vf[s][dt], wp, O[dt]); }
                csum += __shfl_xor(csum, 32);
                carry += csum;
                if (__all(carry > 127.f)) break;
            }
            float ss = 0.f;
#pragma unroll
            for (int r = 0; r < 16; ++r) ss += O[0][r] * O[0][r] + O[1][r] * O[1][r];
            ss += __shfl_xor(ss, 32);
            const float rn = 1.0f / sqrtf(ss * (1.f / 64.f) + EPS);
#pragma unroll
            for (int dt = 0; dt < 2; ++dt)
#pragma unroll
                for (int g4 = 0; g4 < 4; ++g4) {
                    const int d = 32 * dt + 8 * g4 + 4 * hf;
                    const float4 gn = *(const float4*)(p.og + d);
                    uint2 w; w.x = pg8::cvt_pk_bf16(O[dt][4 * g4] * rn * gn.x, O[dt][4 * g4 + 1] * rn * gn.y); w.y = pg8::cvt_pk_bf16(O[dt][4 * g4 + 2] * rn * gn.z, O[dt][4 * g4 + 3] * rn * gn.w);
                    *(uint2*)(Kt + l31 * 144 + d * 2) = w;
                }
#pragma unroll
            for (int i = 0; i < 4; ++i) *(pg8::u32x4*)(ycat + (size_t)(q0 + 8 * i + r8) * 1024 + 512 + h * 64 + pc * 8) = *(const pg8::u32x4*)(Kt + (8 * i + r8) * 144 + pc * 16);
        }
    }
    xcd_barrier(bar);

    if (bid == 255 % G) for (int n = tid; n < 2048; n += 512) { float s = 0.f;
#pragma unroll
        for (int b8 = 0; b8 < 16; ++b8) s += bq_part[(size_t)b8 * 2048 + n];
        bias_q[n] = s; }
    if (bid >= 64) for (int row = (bid - 64) * 8 + wave; row < 2048; row += (G - 64) * 8) {
        const float am = __uint_as_float(ctl[CTL_CMAX + row]), qs = (am > 0.f) ? 127.f / am : 0.f;
        const pg8::u32x4 a = *(const pg8::u32x4*)(Weff_t + (size_t)row * 1024 + 16 * lane), b = *(const pg8::u32x4*)(Weff_t + (size_t)row * 1024 + 16 * lane + 8);
        pg8::u32x4 o;
#define QB(w) ((__float_as_uint(fmaf(__uint_as_float((w) << 16), qs, 12582912.f)) & 255u) | ((__float_as_uint(fmaf(__uint_as_float((w) & 0xffff0000u), qs, 12582912.f)) & 255u) << 8))
        o.x = QB(a.x) | (QB(a.y) << 16); o.y = QB(a.z) | (QB(a.w) << 16); o.z = QB(b.x) | (QB(b.y) << 16); o.w = QB(b.z) | (QB(b.w) << 16);
#undef QB
        *(pg8::u32x4*)(Weffq_t + (size_t)row * 1024 + 16 * lane) = o;
        if (lane == 0) sq[row] = am * (1.f / 127.f);
    }
    if (G > 64 && bid >= 64) convert_tables(p.down, p.up, q8, dsc, lane, (bid - 64) * 8 + wave, (G - 64) * 8, CONV_SPLIT, 32768);
    else if (G <= 64) convert_tables(p.down, p.up, q8, dsc, lane, bid * 8 + wave, G * 8, CONV_SPLIT, 32768);
    for (int idx = bid * 512 + tid; idx < 32768; idx += G * 512) {
        const int h = idx >> 12;
        const float cd = exp2f(128.f * lg2_head(h));
        float s = 0.f;
        for (int n0 = 0; n0 < 128; n0 += 32) {
            float kvv[32];
#pragma unroll
            for (int q = 0; q < 32; ++q) kvv[q] = kv[(size_t)(n0 + q) * 32768 + idx];
#pragma unroll
            for (int q = 0; q < 32; ++q) { stT[(size_t)(n0 + q) * 32768 + idx] = f2bf(s); s = cd * s + kvv[q]; }
        }
    }
    xcd_barrier(bar);

    {
        const int gw = __builtin_amdgcn_readfirstlane(bid * 8 + wave), NGW = G * 8, l31 = lane & 31, hf = lane >> 5;
        const int wv4 = __builtin_amdgcn_readfirstlane(wave);
        for (int W2 = gw; W2 < 2048; W2 += NGW) {
            const int nh = W2 >> 1, n = nh >> 3, h = nh & 7;
            const float lg = lg2_head(h);
#pragma unroll 1
            for (int pass = 0; pass < 2; ++pass) {
                const int qt = (W2 & 1) ? (pass ? 2 : 1) : (pass ? 3 : 0);
                const int il = qt * 32 + l31, tq = n * 128 + il;
                unsigned char* Kt = lds + wv4 * 9216; unsigned char* Vt = Kt + 4608;
                const int r8 = lane >> 3, pc = lane & 7, trq = (lane & 15) >> 2, trp = lane & 3, trd = (lane >> 4) & 1;
                const unsigned loff = (unsigned)(r8 * 512 + pc * 8) * 2u;
                pg8::u32x4 gK[4], gV[4];
                bf16x8 Qf[4];
                {
                    const char* qbase = (const char*)(Qr + (size_t)(n * 128 + qt * 32) * 512 + h * 64);
                    const char* sbase = (const char*)(stT + (size_t)nh * 4096) + (unsigned)(r8 * 64 + pc * 8) * 2u;
#pragma unroll
                    for (int i = 0; i < 4; ++i) gK[i] = *(const pg8::u32x4*)(qbase + (loff + i * 8192u));
#pragma unroll
                    for (int i = 0; i < 4; ++i) *(pg8::u32x4*)(Kt + (8 * i + r8) * 144 + pc * 16) = gK[i];
#pragma unroll
                    for (int s = 0; s < 4; ++s) Qf[s] = *(const bf16x8*)(Kt + l31 * 144 + 32 * s + 16 * hf);
#pragma unroll
                    for (int i = 0; i < 4; ++i) { gK[i] = *(const pg8::u32x4*)(sbase + i * 1024u); gV[i] = *(const pg8::u32x4*)(sbase + 4096u + i * 1024u); }
#pragma unroll
                    for (int i = 0; i < 4; ++i) { *(pg8::u32x4*)(Kt + (8 * i + r8) * 144 + pc * 16) = gK[i]; *(pg8::u32x4*)(Kt + (32 + 8 * i + r8) * 144 + pc * 16) = gV[i]; }
                }
                f32x16 O[2];
#pragma unroll
                for (int r = 0; r < 16; ++r) { O[0][r] = 0.f; O[1][r] = 0.f; }
#pragma unroll
                for (int s = 0; s < 4; ++s)
#pragma unroll
                    for (int dt = 0; dt < 2; ++dt) O[dt] = MFMA32(*(const bf16x8*)(Kt + (32 * dt + l31) * 144 + 32 * s + 16 * hf), Qf[s], O[dt]);
                const float xi = exp2f((float)(il + 1) * lg);
#pragma unroll
                for (int r = 0; r < 16; ++r) { O[0][r] *= xi; O[1][r] *= xi; }
                const char* kbase = (const char*)(Kr + (size_t)n * 128 * 512 + h * 64); const char* vbase = (const char*)(Vr + (size_t)n * 128 * 512 + h * 64);
#pragma unroll
                for (int i = 0; i < 4; ++i) { gK[i] = *(const pg8::u32x4*)(kbase + (loff + i * 8192u)); gV[i] = *(const pg8::u32x4*)(vbase + (loff + i * 8192u)); }
                for (int jb = 0; jb <= qt; ++jb) {
#pragma unroll
                    for (int i = 0; i < 4; ++i) { *(pg8::u32x4*)(Kt + (8 * i + r8) * 144 + pc * 16) = gK[i]; *(pg8::u32x4*)(Vt + (8 * i + r8) * 144 + pc * 16) = gV[i]; }
                    { const int jn = (jb < qt) ? jb + 1 : jb;
#pragma unroll
                      for (int i = 0; i < 4; ++i) { gK[i] = *(const pg8::u32x4*)(kbase + (size_t)jn * 32768 + (loff + i * 8192u)); gV[i] = *(const pg8::u32x4*)(vbase + (size_t)jn * 32768 + (loff + i * 8192u)); } }
                    bf16x8 Kf[4], Vf[2][2];
#pragma unroll
                    for (int s = 0; s < 4; ++s) Kf[s] = *(const bf16x8*)(Kt + l31 * 144 + 32 * s + 16 * hf);
#pragma unroll
                    for (int s = 0; s < 2; ++s)
#pragma unroll
                        for (int dt = 0; dt < 2; ++dt) Vf[s][dt] = tr_frag(Vt + (16 * s + 4 * hf + trq) * 144 + (32 * dt + 16 * trd + 4 * trp) * 2, 8);
                    f32x16 S;
#pragma unroll
                    for (int r = 0; r < 16; ++r) S[r] = 0.f;
#pragma unroll
                    for (int s = 0; s < 4; ++s) S = MFMA32(Kf[s], Qf[s], S);
#pragma unroll
                    for (int r = 0; r < 16; ++r) {
                        const int jl = jb * 32 + (r & 3) + 8 * (r >> 2) + 4 * hf, dl = il - jl;
                        S[r] = (dl >= 0) ? S[r] * __builtin_amdgcn_exp2f((float)dl * lg) : 0.f;
                    }
#pragma unroll
                    for (int s = 0; s < 2; ++s) { const bf16x8 wp = pack_frag(S, s);
#pragma unroll
                        for (int dt = 0; dt < 2; ++dt) O[dt] = MFMA32(Vf[s][dt], wp, O[dt]); }
                }
                float sm = 0.f;
#pragma unroll
                for (int r = 0; r < 16; ++r) sm += O[0][r] + O[1][r];
                sm += __shfl_xor(sm, 32);
                const float mean = sm * (1.f / 64.f);
                float vs = 0.f;
#pragma unroll
                for (int r = 0; r < 16; ++r) { const float d0 = O[0][r] - mean, d1 = O[1][r] - mean; vs += d0 * d0 + d1 * d1; }
                vs += __shfl_xor(vs, 32);
                const float rstd = 1.0f / sqrtf(vs * (1.f / 64.f) + EPS);
                {
                    const char* gbase = (const char*)(Gr + (size_t)(n * 128 + qt * 32) * 512 + h * 64);
#pragma unroll
                    for (int i = 0; i < 4; ++i) gV[i] = *(const pg8::u32x4*)(gbase + (loff + i * 8192u));
#pragma unroll
                    for (int i = 0; i < 4; ++i) *(pg8::u32x4*)(Vt + (8 * i + r8) * 144 + pc * 16) = gV[i];
                }
#pragma unroll
                for (int dt = 0; dt < 2; ++dt)
#pragma unroll
                    for (int g4 = 0; g4 < 4; ++g4) {
                        const int e = 32 * dt + 8 * g4 + 4 * hf;
                        const float4 gn = *(const float4*)(p.rgain + h * 64 + e);
                        const uint2 gg = *(const uint2*)(Vt + l31 * 144 + e * 2);
                        const float g0 = __uint_as_float(gg.x << 16), g1 = __uint_as_float(gg.x & 0xffff0000u), g2v = __uint_as_float(gg.y << 16), g3 = __uint_as_float(gg.y & 0xffff0000u);
                        uint2 w;
                        w.x = pg8::cvt_pk_bf16((O[dt][4 * g4] - mean) * rstd * gn.x * g0, (O[dt][4 * g4 + 1] - mean) * rstd * gn.y * g1);
                        w.y = pg8::cvt_pk_bf16((O[dt][4 * g4 + 2] - mean) * rstd * gn.z * g2v, (O[dt][4 * g4 + 3] - mean) * rstd * gn.w * g3);
                        *(uint2*)(Kt + l31 * 144 + e * 2) = w;
                    }
#pragma unroll
                for (int i = 0; i < 4; ++i) *(pg8::u32x4*)(ycat + (size_t)(n * 128 + qt * 32 + 8 * i + r8) * 1024 + h * 64 + pc * 8) = *(const pg8::u32x4*)(Kt + (8 * i + r8) * 144 + pc * 16);
            }
        }
    }
    xcd_barrier(bar);

    {
        pg8::Gemm g{ycat, Wout_t, T, 1024, 1024}; pg8::StaticOrder S; S.init(T, 1024, G, bid);
        EpiOutprojMF E{p.x, mod + 2048, x1b, part2, pmax, x1q, rinv2q, ctl};
        pg8::gemm_phase<EpiOutprojMF, pg8::StaticOrder>((PG8_LAS unsigned char*)lds, g, S, E);
    }
    xcd_barrier(bar);

    for (int round = 0; round < 2; ++round) {
        pg8::Gemm g{(const bf16_t*)x1q, (const bf16_t*)Weffq_t, T, 2048, 512}; OneUnitOrder S; S.base.init(T, 2048, G, bid); S.round = round;
        EpiTopkMF E{rinv2q, sq, bias_q, ids, gates};
        pg8::gemm_phase<EpiTopkMF, OneUnitOrder, true>((PG8_LAS unsigned char*)lds, g, S, E);
    }
    xcd_barrier(bar);

    {
        constexpr int IDS_LD = 136, ACT_LD = 136;
        const float* scale2 = mod + 4096; const float* shift2 = mod + 3072; const float* gate2 = mod + 5120;
        unsigned short* ids_l = (unsigned short*)lds; float* act_l = (float*)(lds + 32768);
        bf16_t* ds_l = (bf16_t*)(lds + 69632);
        const int t0 = bid * 64, tt = lane >> 3, sub = lane & 7, tl = wave * 8 + tt, t = t0 + tl;
        for (int e = tid; e < 1024; e += 512) { const int r = e >> 4, c8 = e & 15; *(uint4*)(ids_l + r * IDS_LD + c8 * 8) = *(const uint4*)(ids + (size_t)(t0 + r) * 128 + c8 * 8); }
        for (int e = tid; e < 64 * ACT_LD; e += 512) act_l[e] = 0.f;
        for (int e = tid; e < 4096; e += 512) ((uint4*)ds_l)[e] = ((const uint4*)dsc)[e];
        float* s2_l = (float*)(lds + 143360); float* sh2_l = s2_l + 1024; float* gt2_l = s2_l + 2048;
        for (int e = tid; e < 1024; e += 512) { s2_l[e] = p.g2[e] * (1.f + scale2[e]); sh2_l[e] = shift2[e]; gt2_l[e] = gate2[e]; }
        __syncthreads();
        float ri;
        { const float4* pp = (const float4*)(part2 + (size_t)t * 16); const float4 p0 = pp[0], p1 = pp[1], p2 = pp[2], p3 = pp[3];
          const float ssum = ((p0.x + p0.y) + (p0.z + p0.w)) + ((p1.x + p1.y) + (p1.z + p1.w)) + ((p2.x + p2.y) + (p2.z + p2.w)) + ((p3.x + p3.y) + (p3.z + p3.w));
          ri = 1.0f / sqrtf(ssum * (1.0f / D) + EPS); }
        const unsigned short* myids = ids_l + tl * IDS_LD;
        float* myact = act_l + tl * ACT_LD;
        const bool s4 = (sub & 4) != 0, s2 = (sub & 2) != 0, s1 = (sub & 1) != 0;
        const unsigned suboff = (unsigned)sub * 16u;
        typedef float f32x2 __attribute__((ext_vector_type(2)));
#define P9_LOAD(W, JB) do { const uint4 idv_ = *(const uint4*)(myids + 8 * (JB)); const unsigned idw_[4] = {idv_.x, idv_.y, idv_.z, idv_.w}; \
        _Pragma("unroll") for (int k_ = 0; k_ < 8; ++k_) { const unsigned id_ = (idw_[k_ >> 1] >> (16 * (k_ & 1))) & 0xffffu; W[k_] = *(const uint4*)(sbase + (id_ * 128u + suboff)); } } while (0)
#define P9_DOWN4(W, JB) do { int pd_[8]; \
        _Pragma("unroll") for (int k_ = 0; k_ < 8; ++k_) { const unsigned ww_[4] = {W[k_].x, W[k_].y, W[k_].z, W[k_].w}; int a0_ = 0, a1_ = 0; \
            _Pragma("unroll") for (int m_ = 0; m_ < 4; ++m_) { a0_ = __builtin_amdgcn_sdot4(hpe[m_], (int)(ww_[m_] & 0x0F0F0F0Fu), a0_, false); a1_ = __builtin_amdgcn_sdot4(hpo[m_], (int)((ww_[m_] >> 4) & 0x0F0F0F0Fu), a1_, false); } \
            pd_[k_] = a0_ + a1_ - hoff; } \
        int r4_[4], r2_[2]; \
        _Pragma("unroll") for (int k_ = 0; k_ < 4; ++k_) { const int snd_ = s4 ? pd_[k_] : pd_[k_ + 4], kp_ = s4 ? pd_[k_ + 4] : pd_[k_]; r4_[k_] = kp_ + __shfl_xor(snd_, 4); } \
        _Pragma("unroll") for (int k_ = 0; k_ < 2; ++k_) { const int snd_ = s2 ? r4_[k_] : r4_[k_ + 2], kp_ = s2 ? r4_[k_ + 2] : r4_[k_]; r2_[k_] = kp_ + __shfl_xor(snd_, 2); } \
        { const int snd_ = s1 ? r2_[0] : r2_[1], kp_ = s1 ? r2_[1] : r2_[0]; myact[8 * (JB) + sub] += (float)(kp_ + __shfl_xor(snd_, 1)) * hscale; } } while (0)
        uint2 xnx[8];
#pragma unroll
        for (int q = 0; q < 8; ++q) xnx[q] = *(const uint2*)(x1b + (size_t)t * D + 4 * sub + 32 * q);
        float gtv[16];
#pragma unroll
        for (int jb = 0; jb < 16; ++jb) gtv[jb] = gates[(size_t)t * 128 + 8 * jb + sub];
        const unsigned char* sbase = q8;
        uint4 wA[8], wB[8];
        P9_LOAD(wA, 0);
        for (int c = 0; c < 4; ++c) {
            uint2 xcur[8];
#pragma unroll
            for (int q = 0; q < 8; ++q) xcur[q] = xnx[q];
            { const int cn = (c < 3) ? c + 1 : c;
#pragma unroll
              for (int q = 0; q < 8; ++q) xnx[q] = *(const uint2*)(x1b + (size_t)t * D + 256 * cn + 4 * sub + 32 * q); }
            float hf[8][4]; float hmax = 0.f;
#pragma unroll
            for (int q = 0; q < 8; ++q) {
                const int col = 256 * c + 4 * sub + 32 * q;
                const uint2 xw = xcur[q];
                const float4 sv = *(const float4*)(s2_l + col), sh = *(const float4*)(sh2_l + col);
                hf[q][0] = __uint_as_float(xw.x << 16) * ri * sv.x + sh.x; hf[q][1] = __uint_as_float(xw.x & 0xffff0000u) * ri * sv.y + sh.y;
                hf[q][2] = __uint_as_float(xw.y << 16) * ri * sv.z + sh.z; hf[q][3] = __uint_as_float(xw.y & 0xffff0000u) * ri * sv.w + sh.w;
                hmax = fmaxf(hmax, fmaxf(fmaxf(fabsf(hf[q][0]), fabsf(hf[q][1])), fmaxf(fabsf(hf[q][2]), fabsf(hf[q][3]))));
            }
            hmax = fmaxf(hmax, __shfl_xor(hmax, 1)); hmax = fmaxf(hmax, __shfl_xor(hmax, 2)); hmax = fmaxf(hmax, __shfl_xor(hmax, 4));
            const float hinv = (hmax > 0.f) ? 127.0f / hmax : 0.f, hscale = hmax * (1.0f / 127.0f);
            int hq[8][4];
#pragma unroll
            for (int q = 0; q < 8; ++q)
#pragma unroll
                for (int j = 0; j < 4; ++j) hq[q][j] = (int)__builtin_rintf(hf[q][j] * hinv);
            int hpe[4], hpo[4], hoff = 0;
#pragma unroll
            for (int m = 0; m < 4; ++m) {
                hpe[m] = (hq[2 * m][0] & 255) | ((hq[2 * m][2] & 255) << 8) | ((hq[2 * m + 1][0] & 255) << 16) | ((hq[2 * m + 1][2] & 255) << 24);
                hpo[m] = (hq[2 * m][1] & 255) | ((hq[2 * m][3] & 255) << 8) | ((hq[2 * m + 1][1] & 255) << 16) | ((hq[2 * m + 1][3] & 255) << 24);
            }
#pragma unroll
            for (int q = 0; q < 8; ++q) hoff += (hq[q][0] + hq[q][1]) + (hq[q][2] + hq[q][3]);
            hoff *= 8;
#pragma unroll 1
            for (int jb = 0; jb < 16; jb += 2) {
                P9_LOAD(wB, jb + 1);
                P9_DOWN4(wA, jb);
                if (jb + 2 < 16) P9_LOAD(wA, jb + 2);
                else { sbase = (c < 3) ? q8 + (size_t)(c + 1) * (16384 * 128) : q8 + (8u << 20); P9_LOAD(wA, 0); }
                P9_DOWN4(wB, jb + 1);
            }
        }
#undef P9_DOWN4
        signed char* aq_l = (signed char*)(lds + 135168);
        float avv[16]; float amax = 0.f;
#pragma unroll
        for (int jb = 0; jb < 16; ++jb) {
            const int j = 8 * jb + sub; const unsigned id = myids[j];
            const float a = myact[j] * bf2f(ds_l[id]);
            const float av = fabsf(a), tq = 1.0f / (av * 0.2316418882f + 1.0f);
            float ql = tq * 0.5307027145f + (-0.7265760135f); ql = ql * tq + 0.7107068705f; ql = ql * tq + (-0.142248368f); ql = ql * tq + 0.127414796f; ql = ql * tq;
            const float mm = a * (ql * exp2f(a * a * (-0.72134752044f)));
            const float ge = (a < 0.f) ? mm : (a - mm);
            avv[jb] = ge * gtv[jb] * bf2f(ds_l[16384 + id]);
            amax = fmaxf(amax, fabsf(avv[jb]));
        }
        amax = fmaxf(amax, __shfl_xor(amax, 1)); amax = fmaxf(amax, __shfl_xor(amax, 2)); amax = fmaxf(amax, __shfl_xor(amax, 4));
        const float ainv = (amax > 0.f) ? 127.0f / amax : 0.f, ascale = amax * (1.0f / 127.0f);
        int aqsum = 0;
#pragma unroll
        for (int jb = 0; jb < 16; ++jb) { const int aqv = (int)__builtin_rintf(avv[jb] * ainv); aq_l[tl * 128 + 8 * jb + sub] = (signed char)aqv; aqsum += aqv; }
        aqsum += __shfl_xor(aqsum, 1); aqsum += __shfl_xor(aqsum, 2); aqsum += __shfl_xor(aqsum, 4);
        __syncthreads();
#define P9_PERM(HI, LO, SEL) __builtin_amdgcn_perm((HI), (LO), (SEL))
#define P9_T4(E0, E1, E2, E3, T0, T1, T2, T3) do { const unsigned p0_ = P9_PERM(E1, E0, 0x05010400u), p1_ = P9_PERM(E1, E0, 0x07030602u), p2_ = P9_PERM(E3, E2, 0x05010400u), p3_ = P9_PERM(E3, E2, 0x07030602u); \
        T0 = P9_PERM(p2_, p0_, 0x05040100u); T1 = P9_PERM(p2_, p0_, 0x07060302u); T2 = P9_PERM(p3_, p1_, 0x05040100u); T3 = P9_PERM(p3_, p1_, 0x07060302u); } while (0)
#define P9_UP4(W, JB) do { const uint2 aq8_ = *(const uint2*)(aq_l + tl * 128 + 8 * (JB)); const int aq4_[2] = {(int)aq8_.x, (int)aq8_.y}; \
        _Pragma("unroll") for (int g_ = 0; g_ < 2; ++g_) { \
            _Pragma("unroll") for (int m_ = 0; m_ < 4; ++m_) { \
                const unsigned w0_ = ((const unsigned*)&W[4 * g_ + 0])[m_], w1_ = ((const unsigned*)&W[4 * g_ + 1])[m_], w2_ = ((const unsigned*)&W[4 * g_ + 2])[m_], w3_ = ((const unsigned*)&W[4 * g_ + 3])[m_]; \
                unsigned t_[4]; \
                P9_T4(w0_, w1_, w2_, w3_, t_[0], t_[1], t_[2], t_[3]); \
                _Pragma("unroll") for (int k_ = 0; k_ < 4; ++k_) { \
                    oraw[4 * m_ + k_] = __builtin_amdgcn_sdot4(aq4_[g_], (int)t_[k_], oraw[4 * m_ + k_], false); \
                    olo[4 * m_ + k_] = __builtin_amdgcn_sdot4(aq4_[g_], (int)(t_[k_] & 0x0F0F0F0Fu), olo[4 * m_ + k_], false); } } } } while (0)
        for (int c = 0; c < 4; ++c) {
            int oraw[16], olo[16];
#pragma unroll
            for (int q = 0; q < 16; ++q) { oraw[q] = 0; olo[q] = 0; }
            uint2 xres[8];
#pragma unroll
            for (int q = 0; q < 8; ++q) xres[q] = *(const uint2*)(x1b + (size_t)t * D + 256 * c + 4 * sub + 32 * q);
#pragma unroll 1
            for (int jb = 0; jb < 16; jb += 2) {
                P9_LOAD(wB, jb + 1);
                P9_UP4(wA, jb);
                if (jb + 2 < 16) P9_LOAD(wA, jb + 2);
                else if (c < 3) { sbase = q8 + (8u << 20) + (size_t)(c + 1) * (16384 * 128); P9_LOAD(wA, 0); }
                P9_UP4(wB, jb + 1);
            }
#pragma unroll
            for (int q = 0; q < 8; ++q) {
                const int col = 256 * c + 4 * sub + 32 * q;
                float* op = out + (size_t)t * D + col;
                const uint2 xw = xres[q]; const float4 xv = make_float4(__uint_as_float(xw.x << 16), __uint_as_float(xw.x & 0xffff0000u), __uint_as_float(xw.y << 16), __uint_as_float(xw.y & 0xffff0000u)); const float4 gt = *(const float4*)(gt2_l + col);
                const int m = q >> 1, k0 = 2 * (q & 1);
                const int v0 = olo[4 * m + k0] - 8 * aqsum, v1 = (oraw[4 * m + k0] - olo[4 * m + k0]) >> 4, v2 = olo[4 * m + k0 + 1] - 8 * aqsum, v3 = (oraw[4 * m + k0 + 1] - olo[4 * m + k0 + 1]) >> 4;
                float4 r;
                r.x = xv.x + gt.x * ((float)v0 * ascale); r.y = xv.y + gt.y * ((float)v1 * ascale); r.z = xv.z + gt.z * ((float)v2 * ascale); r.w = xv.w + gt.w * ((float)v3 * ascale);
                *(float4*)op = r;
            }
        }
#undef P9_LOAD
#undef P9_UP4
#undef P9_T4
#undef P9_PERM
    }
}
}

extern "C" void kernel_launch(void* const* d_in, const int* in_sizes, int n_in, void* d_out, int out_size, void* d_ws, size_t ws_size, hipStream_t stream) {
    static int grid = 0;
    if (grid == 0) {
        int dev = 0, cus = 0, per_cu = 0;
        (void)hipGetDevice(&dev);
        (void)hipDeviceGetAttribute(&cus, hipDeviceAttributeMultiprocessorCount, dev);
        (void)hipFuncSetAttribute((const void*)mk_fwd, hipFuncAttributeMaxDynamicSharedMemorySize, LDS_BYTES);
        (void)hipOccupancyMaxActiveBlocksPerMultiprocessor(&per_cu, (const void*)mk_fwd, 512, LDS_BYTES);
        if (per_cu < 1 || cus != 256) { fprintf(stderr, "kernel_launch: needs 256 CUs with one resident workgroup each (cus %d, per_cu %d)\n", cus, per_cu); grid = -1; }
        else grid = cus;
    }
    if (grid < 0) return;
    (void)hipMemsetAsync((char*)d_ws + OFF_CTL, 0, CTL_BYTES, stream);
    Params p{};
    p.x = (const float*)d_in[0]; p.c = (const float*)d_in[1]; p.pos = (const int*)d_in[2]; p.ada_w = (const float*)d_in[3]; p.ada_b = (const float*)d_in[4];
    p.g1 = (const float*)d_in[5]; p.g2 = (const float*)d_in[6]; p.w_in = (const float*)d_in[7]; p.rgain = (const float*)d_in[8]; p.qg = (const float*)d_in[9];
    p.kg = (const float*)d_in[10]; p.og = (const float*)d_in[11]; p.w_out = (const float*)d_in[12]; p.wq = (const float*)d_in[13]; p.sk = (const float*)d_in[14];
    p.down = (const float*)d_in[15]; p.up = (const float*)d_in[16]; p.out = (float*)d_out; p.ws = (unsigned char*)d_ws;
    for (int i = 0; i < 32; ++i) {
        const double f = pow(10000.0, -(double)i / 32.0) / 6.283185307179586476925;
        float fh = (float)f; unsigned ub; memcpy(&ub, &fh, 4); ub &= 0xFFFFC000u; memcpy(&fh, &ub, 4);
        p.rc.fh[i] = fh; p.rc.fl[i] = (float)(f - (double)fh);
    }
    void* args[] = {&p};
    hipError_t e = hipLaunchCooperativeKernel((const void*)mk_fwd, dim3(grid), dim3(512), args, LDS_BYTES, stream);
    if (e != hipSuccess) fprintf(stderr, "kernel_launch: cooperative launch failed: %s (grid %d)\n", hipGetErrorString(e), grid);
}
```

```cpp
#include <hip/hip_runtime.h>
#include <stdint.h>
#include <math.h>
#include <cstdio>
#include <cstring>

namespace {
constexpr int T = 16384, D = 1024;
constexpr float EPS = 1e-6f;
typedef unsigned short bf16_t;
#define LAS __attribute__((address_space(3)))

__device__ __forceinline__ float bf2f(bf16_t b) { return __uint_as_float(((unsigned)b) << 16); }
__device__ __forceinline__ bf16_t f2bf(float f) { unsigned u = __float_as_uint(f); u += 0x7fffu + ((u >> 16) & 1u); return (bf16_t)(u >> 16); }
__device__ __forceinline__ float4 ld_nt4(const float* p) { typedef float f4v __attribute__((ext_vector_type(4))); const f4v v = __builtin_nontemporal_load((const f4v*)p); return make_float4(v[0], v[1], v[2], v[3]); }

__device__ __forceinline__ float lg2_head(int h) {
    const float x = __uint_as_float((unsigned)(127 - 5 - h) << 23);
    const float s = x * (1.f + x * (0.5f + x * (0.33333334f + x * (0.25f + x * (0.2f + x * 0.16666667f)))));
    return -s * 1.44269504089f;
}
struct RopeC { float fh[32], fl[32]; };
struct RetC { float lg2[8]; };

constexpr size_t MiB = 1u << 20;
constexpr size_t OFF_CTL = 0;
constexpr size_t CTL_BYTES = 64 * 1024;
constexpr size_t OFF_MOD = 64 * 1024, OFF_RINV1 = 128 * 1024, OFF_BIASF = 256 * 1024, OFF_ROPE = 1 * MiB;
constexpr size_t OFF_WINT = 6 * MiB;
constexpr size_t OFF_XB = 16 * MiB;
constexpr size_t OFF_YCAT = 160 * MiB;
constexpr size_t OFF_P = 48 * MiB;
constexpr size_t OFF_KV = 208 * MiB, OFF_ST = 224 * MiB;
constexpr size_t OFF_WEFFT = 240 * MiB;
constexpr size_t OFF_WOUTT = 13 * MiB;
constexpr size_t OFF_BIASQ = 272 * 1024;
constexpr size_t OFF_SWF = 320 * 1024;
constexpr size_t OFF_SQ = 336 * 1024;
constexpr size_t OFF_PMAX = 2 * MiB;
constexpr size_t OFF_RINV2Q = 3 * MiB;
constexpr size_t OFF_WEFFQ = 10 * MiB;
constexpr size_t OFF_X1Q = 16 * MiB;
constexpr int CTL_CNT = 4096, CTL_CMAX = 8192;
constexpr size_t OFF_XQ = 160 * MiB;
constexpr size_t OFF_DSC = 512 * 1024;
constexpr size_t OFF_BQPART = 576 * 1024;
constexpr size_t OFF_PART2 = 5 * MiB;
constexpr size_t OFF_X1B = 208 * MiB;
constexpr size_t OFF_IDS = 244 * MiB, OFF_GATES = 248 * MiB;
constexpr size_t OFF_Q8 = 192 * MiB;
constexpr int CONV_SPLIT = 0;
constexpr int LDS_BYTES = 163840;
constexpr int LDS_ST_OFF = LDS_BYTES - 16;

#define XB_TMO      128
#define XB_XCNT(j)  (256  + 64 * (j))
#define XB_XSUB(j)  (1280 + 64 * (j))
#define XB_XGEN(j)  (2304 + 64 * (j))
#define XB_TOP      3328
#define XB_TOPGEN   3392
#define XCD_BAR_WORDS 3456
#define XB_SPIN_CAP (1u << 20)
__device__ __forceinline__ unsigned xb_ld(unsigned* p)              { return __hip_atomic_load(p, __ATOMIC_RELAXED, __HIP_MEMORY_SCOPE_AGENT); }
__device__ __forceinline__ unsigned xb_add(unsigned* p, unsigned v) { return __hip_atomic_fetch_add(p, v, __ATOMIC_RELAXED, __HIP_MEMORY_SCOPE_AGENT); }
__device__ __forceinline__ unsigned xb_xcc_id() { return (unsigned)__builtin_amdgcn_s_getreg((3 << 11) | 20) & 0xFu; }
#define XB_SPIN(cond, bar) do { unsigned _sp = 0; while (cond) { __builtin_amdgcn_s_sleep(1); \
    if ((++_sp & 255u) == 0u) { if (xb_ld(&(bar)[XB_TMO])) break; if (_sp > XB_SPIN_CAP) { atomicAdd(&(bar)[XB_TMO], 1u); break; } } } } while (0)
struct XcdBarrier { unsigned* bar; unsigned x; volatile LAS unsigned* st; };
__device__ __forceinline__ XcdBarrier xcd_barrier_post(unsigned* bar, volatile LAS unsigned* st) {
    XcdBarrier b; b.bar = bar; b.x = xb_xcc_id(); b.st = st;
    if (threadIdx.x == 0) (void)xb_add(&bar[XB_XCNT(b.x)], 1u);
    return b;
}
__device__ __forceinline__ void xcd_barrier_complete(unsigned* bar, unsigned x, unsigned& nloc, unsigned& nx) {
    const unsigned G = gridDim.x * gridDim.y * gridDim.z;
    unsigned sum, cnt, mine, sp = 0u;
    for (;;) {
        sum = 0u; cnt = 0u; mine = 0u;
#pragma unroll
        for (unsigned j = 0; j < 16; ++j) { const unsigned c = xb_ld(&bar[XB_XCNT(j)]); sum += c; cnt += (c > 0u) ? 1u : 0u; mine = (j == x) ? c : mine; }
        if (sum == G) break;
        __builtin_amdgcn_s_sleep(1);
        if ((++sp & 255u) == 0u) { if (xb_ld(&bar[XB_TMO])) break; if (sp > XB_SPIN_CAP) { atomicAdd(&bar[XB_TMO], 1u); break; } }
    }
    nloc = mine > 0u ? mine : 1u; nx = cnt > 0u ? cnt : 1u;
}
__device__ __forceinline__ void xcd_barrier(const XcdBarrier& b) {
    asm volatile("s_waitcnt vmcnt(0)" ::: "memory");
    __syncthreads();
    if (threadIdx.x == 0) {
        unsigned* bar = b.bar;
        __builtin_amdgcn_s_waitcnt(0);
        unsigned nloc = b.st[0], nx = b.st[1];
        if (nloc == 0u) { xcd_barrier_complete(bar, b.x, nloc, nx); b.st[0] = nloc; b.st[1] = nx; }
        const unsigned old = xb_add(&bar[XB_XSUB(b.x)], 1u);
        const unsigned gen = old / nloc;
        if (old + 1u == (gen + 1u) * nloc) {
            __builtin_amdgcn_fence(__ATOMIC_RELEASE, "agent");
            asm volatile("s_waitcnt vmcnt(0)" ::: "memory");
            const unsigned og = xb_add(&bar[XB_TOP], 1u);
            const unsigned tg = og / nx;
            if (og + 1u == (tg + 1u) * nx) xb_add(&bar[XB_TOPGEN], 1u);
            else XB_SPIN(xb_ld(&bar[XB_TOPGEN]) == tg, bar);
            __builtin_amdgcn_fence(__ATOMIC_ACQUIRE, "agent");
            xb_add(&bar[XB_XGEN(b.x)], 1u);
            asm volatile("s_waitcnt vmcnt(0)" ::: "memory");
        } else {
            XB_SPIN(xb_ld(&bar[XB_XGEN(b.x)]) == gen, bar);
            __builtin_amdgcn_fence(__ATOMIC_ACQUIRE, "agent");
            asm volatile("s_waitcnt vmcnt(0)" ::: "memory");
        }
    }
    __syncthreads();
}


namespace pg8 {
#define PG8_LAS __attribute__((address_space(3)))
typedef short bf16x8 __attribute__((ext_vector_type(8)));
typedef float f32x4 __attribute__((ext_vector_type(4)));
typedef unsigned u32x4 __attribute__((ext_vector_type(4)));
typedef unsigned u32x2 __attribute__((ext_vector_type(2)));
constexpr int BM = 256, BK = 64, HALF = 128, HTB = HALF * BK * 2, STAGE_BYTES = 8 * HTB, NXCD = 8, WGM = 8;
__host__ __device__ __forceinline__ int lds_byte(int r, int c) { const int st = (r >> 4) * 2 + (c >> 5), rr = r & 15, cc = c & 31, ob = rr * 64 + cc * 2; return st * 1024 + (ob ^ (((ob >> 9) & 1) << 5)); }
__host__ __device__ __forceinline__ void stage_rc(int b, int& R, int& C) { const int st = b / 1024, sb = b % 1024, swz = sb ^ (((sb >> 9) & 1) << 5); R = (st >> 1) * 16 + swz / 64; C = (st & 1) * 32 + (swz % 64) / 2; }
__host__ __device__ __forceinline__ int perm32(int rho) { const int n = rho >> 4, i = rho & 15; return 8 * (i >> 2) + 4 * n + (i & 3); }
struct Unit { int pm, pn; };
struct Gemm { const bf16_t* A; const bf16_t* Bt; int M, N, K; };
struct StaticOrder {
    int nM, nN, nwg, G, c;
    __host__ __device__ void init(int M, int N, int G_, int c_) { nM = M / BM; nN = N / BM; nwg = nM * nN; G = G_; c = c_; }
    __host__ __device__ bool next(int i, Unit& u) const {
        const long L = (long)i * G + c; if (L >= nwg) return false;
        int wgid = (int)L; { const int q = nwg / NXCD, r = nwg % NXCD, xcd = wgid % NXCD, off = wgid / NXCD; wgid = (xcd < r ? xcd * (q + 1) : r * (q + 1) + (xcd - r) * q) + off; }
        const int nig = WGM * nN, gid = wgid / nig, fm = gid * WGM, gsz = (nM - fm) < WGM ? (nM - fm) : WGM;
        u.pm = fm + ((wgid % nig) % gsz); u.pn = (wgid % nig) / gsz; return true;
    }
    __device__ __forceinline__ void a_ready(const Unit&) const {}
    __device__ __forceinline__ void done(const Unit&) const {}
};
__device__ __forceinline__ unsigned cvt_pk_bf16(float lo, float hi) { unsigned r; asm volatile("v_cvt_pk_bf16_f32 %0, %1, %2" : "=v"(r) : "v"(lo), "v"(hi)); return r; }

typedef int i32x4 __attribute__((ext_vector_type(4)));
template <bool I8>
__device__ __forceinline__ f32x4 mma16(const bf16x8 b, const bf16x8 a, const f32x4 c) {
    if constexpr (I8) return __builtin_bit_cast(f32x4, __builtin_amdgcn_mfma_i32_16x16x64_i8(__builtin_bit_cast(i32x4, b), __builtin_bit_cast(i32x4, a), __builtin_bit_cast(i32x4, c), 0, 0, 0));
    else return __builtin_amdgcn_mfma_f32_16x16x32_bf16(b, a, c, 0, 0, 0);
}
template <class Epi, class Sched, bool I8 = false>
__device__ __forceinline__ void gemm_phase(PG8_LAS unsigned char* lds, const Gemm g, const Sched& S, const Epi& E) {
    int tid_ = threadIdx.x; asm volatile("" : "+v"(tid_));
    const int tid = tid_, wid = __builtin_amdgcn_readfirstlane(tid >> 6), lane = tid & 63, wr = wid >> 2, wc = wid & 3, fr = lane & 15, fq = lane >> 4;
    const int K = g.K, nt = K / BK;
    unsigned voffA[2], voffB[2];
#pragma unroll
    for (int i = 0; i < 2; ++i) { int R, C; stage_rc(tid * 16 + i * 8192, R, C); const int Rb = Epi::PERM ? ((R & ~31) + perm32(R & 31)) : R;
        voffA[i] = (unsigned)(R * K + C) * 2u; voffB[i] = (unsigned)(Rb * K + C) * 2u; }
    const size_t kstep = (size_t)(BK * 2);
    const size_t hstep = (size_t)HALF * K * 2;
    const size_t tstep = 2 * hstep;
    const unsigned ldsw = (unsigned)wid * 1024u;
    const int aoff = lds_byte(wr * 64 + fr, fq * 8), boff = lds_byte(wc * 32 + fr, fq * 8);
#define PG8_SA(b, h) (((b) * 2 + (h)) * HTB)
#define PG8_SB(b, h) ((4 + (b) * 2 + (h)) * HTB)
#define PG8_STAGE(bufoff, gbase, voff) do { _Pragma("unroll") for (int _i = 0; _i < 2; ++_i) \
        __builtin_amdgcn_global_load_lds((const unsigned*)((const char*)(gbase) + (voff)[_i]), (PG8_LAS unsigned*)(lds + (bufoff) + ldsw + _i * 8192), 16, 0, 0); } while (0)
#define PG8_LDA(dst, b, h) do { _Pragma("unroll") for (int m = 0; m < 4; ++m) _Pragma("unroll") for (int k = 0; k < 2; ++k) dst[m][k] = *(const PG8_LAS bf16x8*)(lds + PG8_SA(b, h) + aoff + m * 2048 + k * 1024); } while (0)
#define PG8_LDB(dst, b, h) do { _Pragma("unroll") for (int n = 0; n < 2; ++n) _Pragma("unroll") for (int k = 0; k < 2; ++k) dst[n][k] = *(const PG8_LAS bf16x8*)(lds + PG8_SB(b, h) + boff + n * 2048 + k * 1024); } while (0)
#define PG8_MMA(ai, bj, At, Bt) do { __builtin_amdgcn_s_setprio(1); _Pragma("unroll") for (int m = 0; m < 4; ++m) _Pragma("unroll") for (int n = 0; n < 2; ++n) _Pragma("unroll") for (int k = 0; k < 2; ++k) \
        acc[ai][bj][m][n] = mma16<I8>(Bt[n][k], At[m][k], acc[ai][bj][m][n]); __builtin_amdgcn_s_setprio(0); } while (0)
#define PG8_WAIT_V(n) asm volatile("s_waitcnt vmcnt(" #n ")" ::: "memory")
#define PG8_WAIT_L(n) asm volatile("s_waitcnt lgkmcnt(" #n ")" ::: "memory")
#define PG8_BAR __builtin_amdgcn_s_barrier()
#define PG8_SCHED __builtin_amdgcn_sched_barrier(0)
    Unit cur, nxt; int ui = 0;
    if (!S.next(0, cur)) return;
    f32x4 acc[2][2][4][2];
#pragma unroll
    for (int a = 0; a < 2; ++a)
#pragma unroll
        for (int b = 0; b < 2; ++b)
#pragma unroll
            for (int m = 0; m < 4; ++m)
#pragma unroll
                for (int n = 0; n < 2; ++n) acc[a][b][m][n] = (f32x4){0.f, 0.f, 0.f, 0.f};
    bf16x8 At[4][2], B0[2][2], B1[2][2];
    const char* cA = (const char*)g.A + (size_t)cur.pm * tstep; const char* cB = (const char*)g.Bt + (size_t)cur.pn * tstep;
    S.a_ready(cur);
    PG8_STAGE(PG8_SB(0, 0), cB, voffB); PG8_STAGE(PG8_SA(0, 0), cA, voffA); PG8_STAGE(PG8_SB(0, 1), cB + hstep, voffB); PG8_STAGE(PG8_SA(0, 1), cA + hstep, voffA);
    if (wr == 1) PG8_BAR;
    PG8_WAIT_V(4); PG8_BAR;
    PG8_STAGE(PG8_SB(1, 0), cB + kstep, voffB); PG8_STAGE(PG8_SA(1, 0), cA + kstep, voffA); PG8_STAGE(PG8_SB(1, 1), cB + hstep + kstep, voffB);
    PG8_WAIT_V(6); PG8_BAR;
    for (;;) {
        const bool has_next = S.next(ui + 1, nxt);
        const char* nA = has_next ? (const char*)g.A + (size_t)nxt.pm * tstep : cA; const char* nB = has_next ? (const char*)g.Bt + (size_t)nxt.pn * tstep : cB;
        for (int t = 0; t < nt; t += 2) {
            const bool last = (t == nt - 2);
            const char* a1 = cA + (size_t)(t + 1) * kstep;
            const char* a2 = last ? nA : cA + (size_t)(t + 2) * kstep; const char* b2 = last ? nB : cB + (size_t)(t + 2) * kstep;
            const char* a3 = a2 + kstep; const char* b3 = b2 + kstep;
            if (last && has_next) S.a_ready(nxt);
            PG8_LDB(B0, 0, 0); PG8_SCHED; PG8_LDA(At, 0, 0); PG8_STAGE(PG8_SA(1, 1), a1 + hstep, voffA);
            PG8_WAIT_L(8); PG8_BAR; PG8_WAIT_L(0); PG8_MMA(0, 0, At, B0); PG8_BAR; PG8_SCHED;
            PG8_LDB(B1, 0, 1); PG8_STAGE(PG8_SB(0, 0), b2, voffB);
            PG8_BAR; PG8_WAIT_L(0); PG8_MMA(0, 1, At, B1); PG8_BAR;
            PG8_LDA(At, 0, 1); PG8_STAGE(PG8_SA(0, 0), a2, voffA);
            PG8_BAR; PG8_WAIT_L(0); PG8_MMA(1, 0, At, B0); PG8_BAR; PG8_SCHED;
            PG8_STAGE(PG8_SB(0, 1), b2 + hstep, voffB);
            PG8_WAIT_V(6); PG8_BAR; PG8_MMA(1, 1, At, B1); PG8_BAR;
            PG8_LDB(B0, 1, 0); PG8_SCHED; PG8_LDA(At, 1, 0); PG8_STAGE(PG8_SA(0, 1), a2 + hstep, voffA);
            PG8_WAIT_L(8); PG8_BAR; PG8_WAIT_L(0); PG8_MMA(0, 0, At, B0); PG8_BAR; PG8_SCHED;
            PG8_LDB(B1, 1, 1); PG8_STAGE(PG8_SB(1, 0), b3, voffB);
            PG8_BAR; PG8_WAIT_L(0); PG8_MMA(0, 1, At, B1); PG8_BAR;
            PG8_LDA(At, 1, 1); PG8_STAGE(PG8_SA(1, 0), a3, voffA);
            PG8_BAR; PG8_WAIT_L(0); PG8_MMA(1, 0, At, B0); PG8_BAR; PG8_SCHED;
            PG8_STAGE(PG8_SB(1, 1), b3 + hstep, voffB);
            PG8_WAIT_V(6); PG8_BAR; PG8_MMA(1, 1, At, B1); PG8_BAR;
        }
        if constexpr (!Epi::AFTER_DRAIN) { E(acc, cur, wr, wc, fr, fq); S.done(cur); }
        if (!has_next) break;
#pragma unroll
        for (int a = 0; a < 2; ++a)
#pragma unroll
            for (int b = 0; b < 2; ++b)
#pragma unroll
                for (int m = 0; m < 4; ++m)
#pragma unroll
                    for (int n = 0; n < 2; ++n) acc[a][b][m][n] = (f32x4){0.f, 0.f, 0.f, 0.f};
        cur = nxt; cA = nA; cB = nB; ++ui;
    }
    PG8_WAIT_V(0);
    if (wr == 0) PG8_BAR;
    PG8_BAR;
    if constexpr (Epi::AFTER_DRAIN) { E.fused(acc, cur, wr, wc, fr, fq, lds, wid, lane); S.done(cur); }
#undef PG8_SA
#undef PG8_SB
#undef PG8_STAGE
#undef PG8_LDA
#undef PG8_LDB
#undef PG8_MMA
#undef PG8_WAIT_V
#undef PG8_WAIT_L
#undef PG8_BAR
#undef PG8_SCHED
}
}

__host__ __device__ __forceinline__ int cmap_in(int F) { return (F & ~255) + 128 * ((F >> 5) & 1) + 32 * ((F >> 6) & 3) + (F & 31); }
struct EpiInprojMF {
    static constexpr bool PERM = true, AFTER_DRAIN = false;
    bf16_t* P; const float* rinv; const float* bias_f; const int* pos; const float* ftab; const float* qg; const float* kg; const float* swf;
    __device__ __forceinline__ void operator()(pg8::f32x4 (&acc)[2][2][4][2], const pg8::Unit& u, int wr, int wc, int fr, int fq) const {
        typedef pg8::f32x4 f32x4;
        asm volatile("" : "+v"(fr), "+v"(fq));
        const int type = u.pn >> 1, head = 4 * (u.pn & 1) + wc, fb = 256 * u.pn + 64 * wc;
        {
            f32x4 sw[2][2];
#pragma unroll
            for (int bj = 0; bj < 2; ++bj)
#pragma unroll
                for (int n = 0; n < 2; ++n) sw[bj][n] = *(const f32x4*)(swf + fb + 32 * bj + 8 * fq + 4 * n);
#pragma unroll
            for (int ai = 0; ai < 2; ++ai)
#pragma unroll
                for (int bj = 0; bj < 2; ++bj)
#pragma unroll
                    for (int m = 0; m < 4; ++m)
#pragma unroll
                        for (int n = 0; n < 2; ++n) {
                            const pg8::i32x4 iv = __builtin_bit_cast(pg8::i32x4, acc[ai][bj][m][n]);
                            f32x4 fv; fv[0] = (float)iv[0]; fv[1] = (float)iv[1]; fv[2] = (float)iv[2]; fv[3] = (float)iv[3];
                            acc[ai][bj][m][n] = fv * sw[bj][n];
                        }
        }
        const size_t PSZ = (size_t)T * 512;
        const int rslot = (type == 0) ? 0 : (type == 1) ? 1 : (type == 2) ? 5 : (type == 3) ? 2 : (type == 4) ? 3 : (type == 5) ? 4 : 6;
        bf16_t* rowmaj = P + (size_t)rslot * PSZ;
        const int t0 = u.pm * 256 + wr * 64 + fr;
        f32x4 bv[2][2], gv[2][2], fh[2], fl[2];
#pragma unroll
        for (int bj = 0; bj < 2; ++bj)
#pragma unroll
            for (int n = 0; n < 2; ++n) bv[bj][n] = *(const f32x4*)(bias_f + fb + 32 * bj + 8 * fq + 4 * n);
        if (type <= 1) {
#pragma unroll
            for (int n = 0; n < 2; ++n) { fh[n] = *(const f32x4*)(ftab + 8 * fq + 4 * n); fl[n] = *(const f32x4*)(ftab + 32 + 8 * fq + 4 * n); }
        } else if (type == 4 || type == 5) {
            const float* gsrc = (type == 4) ? qg : kg;
#pragma unroll
            for (int bj = 0; bj < 2; ++bj)
#pragma unroll
                for (int n = 0; n < 2; ++n) gv[bj][n] = *(const f32x4*)(gsrc + 32 * bj + 8 * fq + 4 * n);
        }
#pragma unroll
        for (int ai = 0; ai < 2; ++ai) {
            float rv[4], pf[4];
#pragma unroll
            for (int m = 0; m < 4; ++m) { rv[m] = rinv[t0 + ai * 128 + m * 16]; pf[m] = (float)pos[t0 + ai * 128 + m * 16]; }
            asm volatile("" : "+v"(rv[0]), "+v"(rv[1]), "+v"(rv[2]), "+v"(rv[3]), "+v"(pf[0]), "+v"(pf[1]), "+v"(pf[2]), "+v"(pf[3]));
#pragma unroll
            for (int m = 0; m < 4; ++m) {
                const int t = t0 + ai * 128 + m * 16;
                const float r = rv[m];
                f32x4 v[2][2];
#pragma unroll
                for (int bj = 0; bj < 2; ++bj)
#pragma unroll
                    for (int n = 0; n < 2; ++n) v[bj][n] = acc[ai][bj][m][n] * r + bv[bj][n];
                if (type <= 1) {
                    const float sc = (type == 1) ? 0.125f : 1.f, pp = pf[m];
#pragma unroll
                    for (int n = 0; n < 2; ++n)
#pragma unroll
                        for (int j = 0; j < 4; ++j) {
                            const float rev = __builtin_amdgcn_fractf(__builtin_amdgcn_fractf(pp * fh[n][j]) + pp * fl[n][j]);
                            const float cs = __builtin_amdgcn_cosf(rev) * sc, sn = __builtin_amdgcn_sinf(rev) * sc;
                            const float x1 = v[0][n][j], x2 = v[1][n][j]; v[0][n][j] = x1 * cs - x2 * sn; v[1][n][j] = x2 * cs + x1 * sn;
                        }
                } else if (type == 3) {
#pragma unroll
                    for (int bj = 0; bj < 2; ++bj)
#pragma unroll
                        for (int n = 0; n < 2; ++n)
#pragma unroll
                            for (int j = 0; j < 4; ++j) { const float x = v[bj][n][j]; v[bj][n][j] = x / (1.f + __expf(-x)); }
                } else if (type == 4 || type == 5) {
                    float ss = 0.f;
#pragma unroll
                    for (int bj = 0; bj < 2; ++bj)
#pragma unroll
                        for (int n = 0; n < 2; ++n)
#pragma unroll
                            for (int j = 0; j < 4; ++j) ss += v[bj][n][j] * v[bj][n][j];
                    ss += __shfl_xor(ss, 16); ss += __shfl_xor(ss, 32);
                    const float rn = (1.0f / sqrtf(ss * (1.f / 64.f) + EPS)) * ((type == 4) ? 0.125f * 1.44269504089f : 1.f);
#pragma unroll
                    for (int bj = 0; bj < 2; ++bj)
#pragma unroll
                        for (int n = 0; n < 2; ++n) v[bj][n] = v[bj][n] * rn * gv[bj][n];
                }
#pragma unroll
                for (int bj = 0; bj < 2; ++bj) {
                    pg8::u32x4 w; w.x = pg8::cvt_pk_bf16(v[bj][0][0], v[bj][0][1]); w.y = pg8::cvt_pk_bf16(v[bj][0][2], v[bj][0][3]);
                    w.z = pg8::cvt_pk_bf16(v[bj][1][0], v[bj][1][1]); w.w = pg8::cvt_pk_bf16(v[bj][1][2], v[bj][1][3]);
                    *(pg8::u32x4*)(rowmaj + (size_t)t * 512 + head * 64 + 32 * bj + 8 * fq) = w;
                }
            }
        }
    }
};

struct EpiOutprojMF {
    static constexpr bool PERM = false, AFTER_DRAIN = true;
    const float* xf; const float* gate1; bf16_t* x1b; float* part2;
    float* pmax; unsigned char* x1q; float* rinv2q; unsigned* ctl;
    __device__ __forceinline__ void operator()(const pg8::f32x4 (&)[2][2][4][2], const pg8::Unit&, int, int, int, int) const {}
    __device__ __forceinline__ void fused(pg8::f32x4 (&acc)[2][2][4][2], const pg8::Unit& u, int wr, int wc, int fr, int fq, PG8_LAS unsigned char* lds, int wid, int lane) const {
        typedef pg8::f32x4 f32x4;
        asm volatile("" : "+v"(fr), "+v"(fq), "+v"(lane));
        constexpr int LD = 260;
        PG8_LAS float* TL = (PG8_LAS float*)lds;
        const int colw = wc * 32 + 4 * fq;
        f32x4 gv[2][2];
#pragma unroll
        for (int bj = 0; bj < 2; ++bj)
#pragma unroll
            for (int n = 0; n < 2; ++n) gv[bj][n] = *(const f32x4*)(gate1 + u.pn * 256 + colw + bj * 128 + n * 16);
        pg8::u32x2 ow[2][16];
#pragma unroll
        for (int ai = 0; ai < 2; ++ai) {
            f32x4 xv[16];
            const size_t rowbase = (size_t)(u.pm * 256 + ai * 128 + 16 * wid) * D + u.pn * 256 + 4 * lane;
#pragma unroll
            for (int r = 0; r < 16; ++r) xv[r] = __builtin_nontemporal_load((const f32x4*)(xf + rowbase + (size_t)r * D));
#pragma unroll
            for (int m = 0; m < 4; ++m)
#pragma unroll
                for (int bj = 0; bj < 2; ++bj)
#pragma unroll
                    for (int n = 0; n < 2; ++n) *(PG8_LAS f32x4*)(TL + (64 * wr + 16 * m + fr) * LD + colw + bj * 128 + n * 16) = gv[bj][n] * acc[ai][bj][m][n];
            __syncthreads();
            float ssr[16], amr[16];
#pragma unroll
            for (int r = 0; r < 16; ++r) {
                const f32x4 g = *(PG8_LAS f32x4*)(TL + (16 * wid + r) * LD + 4 * lane);
                const f32x4 o = xv[r] + g;
                pg8::u32x2 w; w.x = pg8::cvt_pk_bf16(o[0], o[1]); w.y = pg8::cvt_pk_bf16(o[2], o[3]);
                *(pg8::u32x2*)(x1b + rowbase + (size_t)r * D) = w;
                ow[ai][r] = w;
                ssr[r] = o[0] * o[0] + o[1] * o[1] + o[2] * o[2] + o[3] * o[3];
                amr[r] = fmaxf(fmaxf(__uint_as_float((w.x << 16) & 0x7fffffffu), __uint_as_float(w.x & 0x7fff0000u)), fmaxf(__uint_as_float((w.y << 16) & 0x7fffffffu), __uint_as_float(w.y & 0x7fff0000u)));
            }
            {
                const bool b5 = lane & 32, b4 = lane & 16, b3 = lane & 8, b2 = lane & 4;
                float w8[8], w4[4], w2[2], w1;
#pragma unroll
                for (int i = 0; i < 8; ++i) w8[i] = (b5 ? ssr[8 + i] : ssr[i]) + __shfl_xor(b5 ? ssr[i] : ssr[8 + i], 32);
#pragma unroll
                for (int i = 0; i < 4; ++i) w4[i] = (b4 ? w8[4 + i] : w8[i]) + __shfl_xor(b4 ? w8[i] : w8[4 + i], 16);
#pragma unroll
                for (int i = 0; i < 2; ++i) w2[i] = (b3 ? w4[2 + i] : w4[i]) + __shfl_xor(b3 ? w4[i] : w4[2 + i], 8);
                w1 = (b2 ? w2[1] : w2[0]) + __shfl_xor(b2 ? w2[0] : w2[1], 4);
                w1 += __shfl_xor(w1, 2); w1 += __shfl_xor(w1, 1);
                part2[(size_t)(u.pm * 256 + ai * 128 + 16 * wid + (lane >> 2)) * 16 + u.pn * 4 + (lane & 3)] = ((lane & 3) == 0) ? w1 : 0.f;
#pragma unroll
                for (int i = 0; i < 8; ++i) w8[i] = fmaxf(b5 ? amr[8 + i] : amr[i], __shfl_xor(b5 ? amr[i] : amr[8 + i], 32));
#pragma unroll
                for (int i = 0; i < 4; ++i) w4[i] = fmaxf(b4 ? w8[4 + i] : w8[i], __shfl_xor(b4 ? w8[i] : w8[4 + i], 16));
#pragma unroll
                for (int i = 0; i < 2; ++i) w2[i] = fmaxf(b3 ? w4[2 + i] : w4[i], __shfl_xor(b3 ? w4[i] : w4[2 + i], 8));
                w1 = fmaxf(b2 ? w2[1] : w2[0], __shfl_xor(b2 ? w2[0] : w2[1], 4));
                w1 = fmaxf(w1, __shfl_xor(w1, 2)); w1 = fmaxf(w1, __shfl_xor(w1, 1));
                if ((lane & 3) == 0) pmax[(size_t)(u.pm * 256 + ai * 128 + 16 * wid + (lane >> 2)) * 4 + u.pn] = w1;
            }
            __syncthreads();
        }
        asm volatile("s_waitcnt vmcnt(0)" ::: "memory");
        __syncthreads();
        if (wid == 0 && lane == 0) {
            unsigned* c = ctl + CTL_CNT + 16 * u.pm;
            __builtin_amdgcn_fence(__ATOMIC_RELEASE, "agent");
            asm volatile("s_waitcnt vmcnt(0)" ::: "memory");
            (void)xb_add(c, 1u);
            XB_SPIN(xb_ld(c) < 4u, ctl);
            __builtin_amdgcn_fence(__ATOMIC_ACQUIRE, "agent");
        }
        __syncthreads();
        float qsl = 0.f;
        {
            const int row = u.pm * 256 + (lane >> 4 & 1) * 128 + 16 * wid + (lane & 15);
            const f32x4* pp = (const f32x4*)(part2 + (size_t)row * 16);
            const f32x4 p0 = pp[0], p1 = pp[1], p2 = pp[2], p3 = pp[3], pm4 = *(const f32x4*)(pmax + (size_t)row * 4);
            const float ssum = ((p0[0] + p0[1]) + (p0[2] + p0[3])) + ((p1[0] + p1[1]) + (p1[2] + p1[3])) + ((p2[0] + p2[1]) + (p2[2] + p2[3])) + ((p3[0] + p3[1]) + (p3[2] + p3[3]));
            const float am = fmaxf(fmaxf(pm4[0], pm4[1]), fmaxf(pm4[2], pm4[3]));
            qsl = (am > 0.f) ? 127.f / am : 0.f;
            if (u.pn == 0 && lane < 32) rinv2q[row] = (1.0f / sqrtf(ssum * (1.0f / D) + EPS)) * (am * (1.f / 127.f));
        }
#pragma unroll
        for (int ai = 0; ai < 2; ++ai)
#pragma unroll
            for (int r = 0; r < 16; ++r) {
                const float qs = __builtin_bit_cast(float, __builtin_amdgcn_readlane(__builtin_bit_cast(int, qsl), ai * 16 + r));
                const pg8::u32x2 w = ow[ai][r];
                const unsigned b0 = __float_as_uint(fmaf(__uint_as_float(w.x << 16), qs, 12582912.f)), b1 = __float_as_uint(fmaf(__uint_as_float(w.x & 0xffff0000u), qs, 12582912.f));
                const unsigned b2 = __float_as_uint(fmaf(__uint_as_float(w.y << 16), qs, 12582912.f)), b3 = __float_as_uint(fmaf(__uint_as_float(w.y & 0xffff0000u), qs, 12582912.f));
                *(unsigned*)(x1q + (size_t)(u.pm * 256 + ai * 128 + 16 * wid + r) * D + u.pn * 256 + 4 * lane) = (b0 & 255u) | ((b1 & 255u) << 8) | ((b2 & 255u) << 16) | (b3 << 24);
            }
    }
};

__device__ __forceinline__ unsigned pk2(float lo, float hi) { return (unsigned)f2bf(lo) | ((unsigned)f2bf(hi) << 16); }
template <bool FOLD, bool CMAP>
__device__ __forceinline__ void transpose_item(const float* W, int K, int N, bf16_t* WT, float* scr, int item, int lane, const float* sg, const float* sm) {
    const int nblk = N / 32, kb = item / nblk, nb = item % nblk, k0 = 64 * kb, n0 = 32 * nb;
    float4 v[8]; float f[8];
#pragma unroll
    for (int i = 0; i < 8; ++i) { const int kk = 8 * i + (lane >> 3); v[i] = *(const float4*)(W + (size_t)(k0 + kk) * N + n0 + 4 * (lane & 7));
        f[i] = FOLD ? sg[k0 + kk] * (1.f + sm[k0 + kk]) : 1.f; }
#pragma unroll
    for (int i = 0; i < 8; ++i) { const int kk = 8 * i + (lane >> 3); float* d = scr + kk * 33 + 4 * (lane & 7);
        d[0] = v[i].x * f[i]; d[1] = v[i].y * f[i]; d[2] = v[i].z * f[i]; d[3] = v[i].w * f[i]; }
    asm volatile("s_waitcnt lgkmcnt(0)" ::: "memory");
    const int c = lane & 7, r0 = CMAP ? cmap_in(n0) : n0;
#pragma unroll
    for (int j = 0; j < 4; ++j) { const int n = (lane >> 3) + 8 * j; const float* s = scr + (8 * c) * 33 + n;
        pg8::u32x4 o; o.x = pk2(s[0 * 33], s[1 * 33]); o.y = pk2(s[2 * 33], s[3 * 33]); o.z = pk2(s[4 * 33], s[5 * 33]); o.w = pk2(s[6 * 33], s[7 * 33]);
        *(pg8::u32x4*)(WT + (size_t)(r0 + n) * K + k0 + 8 * c) = o; }
    asm volatile("s_waitcnt lgkmcnt(0)" ::: "memory");
}
template <int NC4, class VF>
__device__ __forceinline__ void gemv_cols(unsigned char* lds, const VF vf, const float* W, const int N, const int u, float* dst, const float* add) {
    constexpr int RG = 512 / NC4;
    float (*red)[NC4 * 4] = (float (*)[NC4 * 4])lds;
    const int tid = threadIdx.x, c4 = tid % NC4, rg = tid / NC4;
    if (rg < RG) {
        constexpr int NI = (1024 + RG - 1) / RG;
        float4 acc = {0.f, 0.f, 0.f, 0.f}, w[NI]; float sv[NI];
#pragma unroll
        for (int i = 0; i < NI; ++i) { const int r = rg + i * RG, rc = (r < 1024) ? r : 1023; w[i] = *(const float4*)(W + (size_t)rc * N + u * NC4 * 4 + c4 * 4); sv[i] = (r < 1024) ? vf(rc) : 0.f; }
#pragma unroll
        for (int i = 0; i < NI; ++i) { acc.x += sv[i] * w[i].x; acc.y += sv[i] * w[i].y; acc.z += sv[i] * w[i].z; acc.w += sv[i] * w[i].w; }
        red[rg][c4 * 4 + 0] = acc.x; red[rg][c4 * 4 + 1] = acc.y; red[rg][c4 * 4 + 2] = acc.z; red[rg][c4 * 4 + 3] = acc.w;
    }
    __syncthreads();
    if (tid < NC4 * 4) { float s = 0.f; for (int i = 0; i < RG; ++i) s += red[i][tid]; dst[u * NC4 * 4 + tid] = s + (add ? add[u * NC4 * 4 + tid] : 0.f); }
    __syncthreads();
}
struct VfSilu { const float* c; __device__ __forceinline__ float operator()(int r) const { const float v = c[r]; return v / (1.f + expf(-v)); } };
struct VfVec { const float* v; __device__ __forceinline__ float operator()(int r) const { return v[r]; } };


typedef float f32x16 __attribute__((ext_vector_type(16)));
typedef pg8::bf16x8 bf16x8;
#define MFMA32(a, b, c) __builtin_amdgcn_mfma_f32_32x32x16_bf16((a), (b), (c), 0, 0, 0)
__device__ __forceinline__ bf16x8 pack_frag(const f32x16& v, int s) {
    pg8::u32x4 w;
    w.x = pg8::cvt_pk_bf16(v[8 * s + 0], v[8 * s + 1]); w.y = pg8::cvt_pk_bf16(v[8 * s + 2], v[8 * s + 3]);
    w.z = pg8::cvt_pk_bf16(v[8 * s + 4], v[8 * s + 5]); w.w = pg8::cvt_pk_bf16(v[8 * s + 6], v[8 * s + 7]);
    return __builtin_bit_cast(bf16x8, w);
}
__device__ __forceinline__ bf16x8 load_tfrag(const bf16_t* rowp, int tok) {
    const uint2 a = *(const uint2*)(rowp + tok), b = *(const uint2*)(rowp + tok + 8);
    pg8::u32x4 w; w.x = a.x; w.y = a.y; w.z = b.x; w.w = b.y;
    return __builtin_bit_cast(bf16x8, w);
}


__device__ __forceinline__ bf16x8 tr_frag(const unsigned char* a0, int rows2) {
    typedef short s16x4 __attribute__((ext_vector_type(4)));
    typedef __attribute__((address_space(3))) s16x4 lds_s16x4;
    const s16x4 lo = __builtin_amdgcn_ds_read_tr16_b64_v4i16((lds_s16x4*)a0);
    const s16x4 hi = __builtin_amdgcn_ds_read_tr16_b64_v4i16((lds_s16x4*)(a0 + rows2 * 144));
    const uint2 l2 = __builtin_bit_cast(uint2, lo), h2 = __builtin_bit_cast(uint2, hi);
    pg8::u32x4 fw; fw.x = l2.x; fw.y = l2.y; fw.z = h2.x; fw.w = h2.y;
    return __builtin_bit_cast(bf16x8, fw);
}

__device__ __forceinline__ void ins16(float (&s)[16], float x) {
#pragma unroll
    for (int i = 15; i >= 1; --i) s[i] = __builtin_amdgcn_fmed3f(s[i - 1], s[i], x);
    s[0] = fmaxf(s[0], x);
}


struct OneUnitOrder {
    pg8::StaticOrder base; int round;
    __device__ __forceinline__ bool next(int i, pg8::Unit& u) const { if (i != 0) return false; return base.next(round, u); }
    __device__ __forceinline__ void a_ready(const pg8::Unit&) const {}
    __device__ __forceinline__ void done(const pg8::Unit&) const {}
};
struct EpiTopkMF {
    static constexpr bool PERM = false, AFTER_DRAIN = true;
    const float* rinv2q; const float* sq; const float* bias_q; unsigned short* ids; float* gates;
    __device__ __forceinline__ void operator()(const pg8::f32x4 (&)[2][2][4][2], const pg8::Unit&, int, int, int, int) const {}
    __device__ __forceinline__ void fused(pg8::f32x4 (&acc)[2][2][4][2], const pg8::Unit& u, int wr, int wc, int fr, int fq, PG8_LAS unsigned char* lds, int wid, int lane) const {
        typedef pg8::f32x4 f32x4;
        constexpr int SLD = 260;
        PG8_LAS float* SC = (PG8_LAS float*)lds; PG8_LAS float* MG = (PG8_LAS float*)(lds + 128 * SLD * 4);
        const int tid = wid * 64 + lane, tok = tid & 255, hk = tid >> 8;
        float rinv[2][4];
#pragma unroll
        for (int ai = 0; ai < 2; ++ai)
#pragma unroll
            for (int m = 0; m < 4; ++m) {
                const int row = u.pm * 256 + ai * 128 + wr * 64 + m * 16 + fr;
                rinv[ai][m] = rinv2q[row];
            }
        float sl[16], mine[16];
#pragma unroll
        for (int p = 0; p < 2; ++p) {
            f32x4 bv[2], sv[2];
#pragma unroll
            for (int n = 0; n < 2; ++n) { bv[n] = *(const f32x4*)(bias_q + u.pn * 256 + p * 128 + wc * 32 + n * 16 + 4 * fq); sv[n] = *(const f32x4*)(sq + u.pn * 256 + p * 128 + wc * 32 + n * 16 + 4 * fq); }
#pragma unroll
            for (int ai = 0; ai < 2; ++ai)
#pragma unroll
                for (int m = 0; m < 4; ++m)
#pragma unroll
                    for (int n = 0; n < 2; ++n)
#pragma unroll
                        for (int j = 0; j < 4; ++j)
                            SC[(32 * wc + 16 * n + 4 * fq + j) * SLD + (128 * ai + 64 * wr + 16 * m + fr)] = (float)__builtin_bit_cast(pg8::i32x4, acc[ai][p][m][n])[j] * (rinv[ai][m] * sv[n][j]) + bv[n][j];
            __syncthreads();
#pragma unroll
            for (int i = 0; i < 16; ++i) sl[i] = -INFINITY;
#pragma unroll 8
            for (int k = 0; k < 64; ++k) { const int key = 64 * hk + k; const float x = SC[key * SLD + tok]; ins16(sl, __uint_as_float((__float_as_uint(x) & 0xFFFFFF80u) | (unsigned)key)); }
            if (hk != p) {
#pragma unroll
                for (int i = 0; i < 16; ++i) MG[i * 256 + tok] = sl[i];
            }
            __syncthreads();
            if (hk == p) {
#pragma unroll
                for (int i = 0; i < 16; ++i) ins16(sl, MG[i * 256 + tok]);
#pragma unroll
                for (int i = 0; i < 16; ++i) mine[i] = sl[i];
            }
            __syncthreads();
        }
        PG8_LAS float* X1 = SC; PG8_LAS float* TL = SC + 4096; PG8_LAS unsigned* I0 = (PG8_LAS unsigned*)(SC + 8192); PG8_LAS unsigned* I1 = (PG8_LAS unsigned*)(SC + 12288);
        if (hk) {
#pragma unroll
            for (int i = 0; i < 16; ++i) { X1[i * 256 + tok] = mine[i]; I1[i * 256 + tok] = __float_as_uint(mine[i]) & 0x7Fu; }
        } else {
#pragma unroll
            for (int i = 0; i < 16; ++i) I0[i * 256 + tok] = __float_as_uint(mine[i]) & 0x7Fu;
        }
        __syncthreads();
        if (!hk) {
            float s1m[16], tl[16];
#pragma unroll
            for (int i = 0; i < 16; ++i) { s1m[i] = __uint_as_float(__float_as_uint(X1[i * 256 + tok]) & 0xFFFFFF80u); mine[i] = __uint_as_float(__float_as_uint(mine[i]) & 0xFFFFFF80u); tl[i] = -INFINITY; }
#pragma unroll
            for (int a2 = 0; a2 < 16; ++a2)
#pragma unroll
                for (int b2 = 0; b2 < 16; ++b2)
                    if ((a2 + 1) * (b2 + 1) <= 16) ins16(tl, __uint_as_float((__float_as_uint(mine[a2] + s1m[b2]) & 0xFFFFFF00u) | (unsigned)(a2 * 16 + b2)));
#pragma unroll
            for (int i = 0; i < 16; ++i) TL[i * 256 + tok] = tl[i];
        }
        __syncthreads();
        if (hk) {
            float ev[16]; float sum = 0.f; unsigned cd[16];
#pragma unroll
            for (int j = 0; j < 16; ++j) { const unsigned bits = __float_as_uint(TL[j * 256 + tok]); cd[j] = bits & 0xFFu; ev[j] = __uint_as_float(bits & 0xFFFFFF00u); }
            const float mx = ev[0];
#pragma unroll
            for (int j = 0; j < 16; ++j) { ev[j] = __expf(ev[j] - mx); sum += ev[j]; }
            const float inv = 1.f / sum;
            unsigned idw[8];
#pragma unroll
            for (int j = 0; j < 16; ++j) {
                const unsigned id = I0[(cd[j] >> 4) * 256 + tok] * 128u + I1[(cd[j] & 15u) * 256 + tok];
                if (j & 1) idw[j >> 1] |= id << 16; else idw[j >> 1] = id;
                ev[j] *= inv;
            }
            const size_t t = (size_t)u.pm * 256 + tok;
            unsigned short* idp = ids + t * 128 + u.pn * 16; float* gp = gates + t * 128 + u.pn * 16;
            *(uint4*)idp = make_uint4(idw[0], idw[1], idw[2], idw[3]); *(uint4*)(idp + 8) = make_uint4(idw[4], idw[5], idw[6], idw[7]);
#pragma unroll
            for (int q = 0; q < 4; ++q) *(float4*)(gp + 4 * q) = make_float4(ev[4 * q], ev[4 * q + 1], ev[4 * q + 2], ev[4 * q + 3]);
        }
        __syncthreads();
    }
};


__device__ __forceinline__ void convert_tables(const float* down, const float* up, unsigned char* q8, bf16_t* dsc, int lane, int cw, int nconv, int r0, int r1) {
    for (int row0 = r0 + cw * 2; row0 < r1; row0 += nconv * 2) {
        float4 v[2][4];
#pragma unroll
        for (int rr = 0; rr < 2; ++rr) {
            const int row = row0 + rr, isup = row >> 14, e = row & 16383;
            const float* sp = (isup ? up : down) + (size_t)e * 1024 + lane * 4;
#pragma unroll
            for (int q = 0; q < 4; ++q) v[rr][q] = ld_nt4(sp + 256 * q);
        }
#pragma unroll
        for (int rr = 0; rr < 2; ++rr) {
            const int row = row0 + rr, isup = row >> 14, e = row & 16383;
            {
                float ss = 0.f;
#pragma unroll
                for (int q = 0; q < 4; ++q) ss += v[rr][q].x * v[rr][q].x + v[rr][q].y * v[rr][q].y + v[rr][q].z * v[rr][q].z + v[rr][q].w * v[rr][q].w;
#pragma unroll
                for (int o = 32; o > 0; o >>= 1) ss += __shfl_xor(ss, o);
                const float sigma = sqrtf(ss * (1.0f / 1024.0f));
                const float s = (sigma > 0.f) ? 7.5f / (2.6f * sigma) : 1.f;
#pragma unroll
                for (int q = 0; q < 4; ++q) {
                    const int n0 = (int)fminf(fmaxf(__builtin_rintf(v[rr][q].x * s), -8.f), 7.f) + 8, n1 = (int)fminf(fmaxf(__builtin_rintf(v[rr][q].y * s), -8.f), 7.f) + 8;
                    const int n2 = (int)fminf(fmaxf(__builtin_rintf(v[rr][q].z * s), -8.f), 7.f) + 8, n3 = (int)fminf(fmaxf(__builtin_rintf(v[rr][q].w * s), -8.f), 7.f) + 8;
                    const int h1 = isup ? ((n1 - 8) & 15) : n1, h3 = isup ? ((n3 - 8) & 15) : n3;
                    *(unsigned short*)(q8 + (size_t)isup * (8u << 20) + ((size_t)q * 16384 + e) * 128 + (lane & 7) * 16 + (lane >> 3) * 2) = (unsigned short)(n0 | (h1 << 4) | (n2 << 8) | (h3 << 12));
                }
                if (lane == 0) dsc[row] = f2bf(1.0f / s);
            }
        }
    }
}

struct Params {
    const float *x, *c; const int* pos; const float *ada_w, *ada_b, *g1, *g2, *w_in, *rgain, *qg, *kg, *og, *w_out, *wq, *sk, *down, *up;
    float* out; unsigned char* ws; RopeC rc;
};

__global__ void __launch_bounds__(512) mk_fwd(Params p) {
    extern __shared__ __attribute__((aligned(16))) unsigned char lds[];
    const int tid = threadIdx.x, lane = tid & 63, bid = blockIdx.x, G = gridDim.x; int wave = tid >> 6;
    unsigned char* ws = p.ws;
    float* mod = (float*)(ws + OFF_MOD); float* rinv1 = (float*)(ws + OFF_RINV1); float* ftab = (float*)(ws + OFF_ROPE);
    bf16_t* P = (bf16_t*)(ws + OFF_P); float* kv = (float*)(ws + OFF_KV); bf16_t* stT = (bf16_t*)(ws + OFF_ST); bf16_t* ycat = (bf16_t*)(ws + OFF_YCAT);
    bf16_t* Win_t = (bf16_t*)(ws + OFF_WINT); float* bias_f = (float*)(ws + OFF_BIASF);
    unsigned char* xq = ws + OFF_XQ; float* swf = (float*)(ws + OFF_SWF);
    float* sq = (float*)(ws + OFF_SQ); float* pmax = (float*)(ws + OFF_PMAX); float* rinv2q = (float*)(ws + OFF_RINV2Q); unsigned char* Weffq_t = ws + OFF_WEFFQ; unsigned char* x1q = ws + OFF_X1Q;
    unsigned* ctl = (unsigned*)(ws + OFF_CTL);
    bf16_t* Weff_t = (bf16_t*)(ws + OFF_WEFFT); bf16_t* Wout_t = (bf16_t*)(ws + OFF_WOUTT); float* bias_q = (float*)(ws + OFF_BIASQ); float* bq_part = (float*)(ws + OFF_BQPART);
    float* part2 = (float*)(ws + OFF_PART2); bf16_t* x1b = (bf16_t*)(ws + OFF_X1B); unsigned short* ids = (unsigned short*)(ws + OFF_IDS); unsigned char* q8 = ws + OFF_Q8; bf16_t* dsc = (bf16_t*)(ws + OFF_DSC); float* gates = (float*)(ws + OFF_GATES);
    const size_t PS = (size_t)T * 512;
    const bf16_t *Qr = P, *Kr = P + PS, *Gr = P + 2 * PS, *Qs = P + 3 * PS, *Ks = P + 4 * PS, *Vr = P + 5 * PS, *Vs = P + 6 * PS;
    float* out = p.out;

    if (tid < 4) ((LAS unsigned*)((LAS unsigned char*)lds + LDS_ST_OFF))[tid] = 0u;
    __syncthreads();
    XcdBarrier bar = xcd_barrier_post((unsigned*)(ws + OFF_CTL), (volatile LAS unsigned*)((LAS unsigned char*)lds + LDS_ST_OFF));

    for (int u = bid; u < 256; u += G) gemv_cols<6>(lds, VfSilu{p.c}, p.ada_w, 6144, u, mod, p.ada_b);
    if (bid == 0 && tid == 0) {
#pragma unroll
        for (int i = 0; i < 32; ++i) { ftab[i] = p.rc.fh[i]; ftab[32 + i] = p.rc.fl[i]; }
    }
    xcd_barrier(bar);

    {
        for (int nb = bid; nb < 112; nb += G) {
            const int n0 = 32 * nb, r8 = lane >> 3, c = lane & 7, kw = 128 * wave;
            float* cm = (float*)(lds + 8 * 4608);
            unsigned* tl = (unsigned*)(lds + wave * 4608);
            float4 v[16];
#pragma unroll
            for (int i = 0; i < 16; ++i) { const int kk = 32 * (i >> 2) + 4 * r8 + (i & 3); v[i] = *(const float4*)(p.w_in + (size_t)(kw + kk) * 3584 + n0 + 4 * c); }
            float4 mx = {0.f, 0.f, 0.f, 0.f};
#pragma unroll
            for (int i = 0; i < 16; ++i) { const int kk = 32 * (i >> 2) + 4 * r8 + (i & 3); const float f = p.g1[kw + kk] * (1.f + mod[1024 + kw + kk]);
                v[i].x *= f; v[i].y *= f; v[i].z *= f; v[i].w *= f;
                mx.x = fmaxf(mx.x, fabsf(v[i].x)); mx.y = fmaxf(mx.y, fabsf(v[i].y)); mx.z = fmaxf(mx.z, fabsf(v[i].z)); mx.w = fmaxf(mx.w, fabsf(v[i].w)); }
#pragma unroll
            for (int o = 8; o < 64; o <<= 1) { mx.x = fmaxf(mx.x, __shfl_xor(mx.x, o)); mx.y = fmaxf(mx.y, __shfl_xor(mx.y, o)); mx.z = fmaxf(mx.z, __shfl_xor(mx.z, o)); mx.w = fmaxf(mx.w, __shfl_xor(mx.w, o)); }
            if (lane < 8) *(float4*)(cm + wave * 32 + 4 * c) = mx;
            __syncthreads();
#pragma unroll
            for (int w2 = 0; w2 < 8; ++w2) { const float4 o = *(const float4*)(cm + w2 * 32 + 4 * c); mx.x = fmaxf(mx.x, o.x); mx.y = fmaxf(mx.y, o.y); mx.z = fmaxf(mx.z, o.z); mx.w = fmaxf(mx.w, o.w); }
            if (wave == 0 && lane < 8) *(float4*)(swf + n0 + 4 * c) = make_float4(mx.x * (1.f / 127.f), mx.y * (1.f / 127.f), mx.z * (1.f / 127.f), mx.w * (1.f / 127.f));
            const float qx = (mx.x > 0.f) ? 127.f / mx.x : 0.f, qy = (mx.y > 0.f) ? 127.f / mx.y : 0.f, qz = (mx.z > 0.f) ? 127.f / mx.z : 0.f, qw = (mx.w > 0.f) ? 127.f / mx.w : 0.f;
#pragma unroll
            for (int a = 0; a < 4; ++a) {
                unsigned d[4];
#pragma unroll
                for (int j = 0; j < 4; ++j) {
                    const float qq = (j == 0) ? qx : (j == 1) ? qy : (j == 2) ? qz : qw;
                    unsigned w = 0;
#pragma unroll
                    for (int b = 0; b < 4; ++b) { const float4 t = v[4 * a + b]; const float e = (j == 0) ? t.x : (j == 1) ? t.y : (j == 2) ? t.z : t.w;
                        w |= (__float_as_uint(fmaf(e, qq, 12582912.f)) & 255u) << (8 * b); }
                    d[j] = w;
                }
#pragma unroll
                for (int j = 0; j < 4; ++j) tl[(4 * c + j) * 34 + 8 * a + r8] = d[j];
            }
            asm volatile("s_waitcnt lgkmcnt(0)" ::: "memory");
            const int rb = cmap_in(n0);
#pragma unroll
            for (int jj = 0; jj < 4; ++jj) { const int q = lane + 64 * jj, n = q >> 3, ch = q & 7;
                const uint2 lo = *(const uint2*)(tl + n * 34 + 4 * ch), hi = *(const uint2*)(tl + n * 34 + 4 * ch + 2);
                pg8::u32x4 o; o.x = lo.x; o.y = lo.y; o.z = hi.x; o.w = hi.y;
                *(pg8::u32x4*)((unsigned char*)Win_t + (size_t)(rb + n) * 1024 + kw + 16 * ch) = o; }
            __syncthreads();
        }
        for (int u = bid - 128; u >= 0 && u < 128; u += G) gemv_cols<7>(lds, VfVec{mod}, p.w_in, 3584, u, bias_f, nullptr);
    }
    for (int row0 = (bid * 8 + wave) * 2; row0 < T; row0 += G * 16) {
        float4 v[2][4];
#pragma unroll
        for (int rr = 0; rr < 2; ++rr)
#pragma unroll
            for (int j = 0; j < 4; ++j) v[rr][j] = ld_nt4(p.x + (size_t)(row0 + rr) * D + (lane + 64 * j) * 4);
#pragma unroll
        for (int rr = 0; rr < 2; ++rr) {
            float s = 0.f, am = 0.f;
#pragma unroll
            for (int j = 0; j < 4; ++j) { const float4 q = v[rr][j]; s += q.x * q.x + q.y * q.y + q.z * q.z + q.w * q.w;
                am = fmaxf(fmaxf(am, fmaxf(fabsf(q.x), fabsf(q.y))), fmaxf(fabsf(q.z), fabsf(q.w))); }
#pragma unroll
            for (int o = 32; o > 0; o >>= 1) { s += __shfl_xor(s, o); am = fmaxf(am, __shfl_xor(am, o)); }
            const float qs = (am > 0.f) ? 127.f / am : 0.f;
            unsigned* xqo = (unsigned*)(xq + (size_t)(row0 + rr) * D);
#pragma unroll
            for (int j = 0; j < 4; ++j) { const float4 q = v[rr][j];
                const unsigned b0 = __float_as_uint(fmaf(q.x, qs, 12582912.f)), b1 = __float_as_uint(fmaf(q.y, qs, 12582912.f)), b2 = __float_as_uint(fmaf(q.z, qs, 12582912.f)), b3 = __float_as_uint(fmaf(q.w, qs, 12582912.f));
                xqo[lane + 64 * j] = (b0 & 255u) | ((b1 & 255u) << 8) | ((b2 & 255u) << 16) | (b3 << 24); }
            if (lane == 0) rinv1[row0 + rr] = (1.0f / sqrtf(s * (1.0f / D) + EPS)) * (am * (1.f / 127.f));
        }
    }

    xcd_barrier(bar);

    {
        pg8::Gemm g{(const bf16_t*)xq, Win_t, T, 3584, 512}; pg8::StaticOrder S; S.init(T, 3584, G, bid);
        EpiInprojMF E{P, rinv1, bias_f, p.pos, ftab, p.qg, p.kg, swf};
        pg8::gemm_phase<EpiInprojMF, pg8::StaticOrder, true>((PG8_LAS unsigned char*)lds, g, S, E);
        const int nidle = (G > 128) ? G - 128 : G, ib = (G > 128) ? bid - 128 : bid;
        {
            float* scr = (float*)(lds + wave * 16384);
            if (ib >= 0) for (int it = ib * 8 + wave; it < 16 * 32; it += nidle * 8) transpose_item<false, false>(p.w_out, 1024, 1024, Wout_t, scr, it, lane, nullptr, nullptr);
            __syncthreads();
        }
        if (ib >= 0) for (int wu = ib; wu < 256; wu += nidle) {
            const int hp = wu >> 4, blk = wu & 15, i0 = blk * 64;
            __syncthreads();
            unsigned char* Wt = lds; unsigned char* St = lds + 64 * 272; float* bred = (float*)(lds + 64 * 272 + 128 * 272);
            for (int e4 = tid; e4 < 2048; e4 += 512) { const int r = e4 >> 5, c4 = e4 & 31; const float4 v = *(const float4*)(p.wq + (size_t)(i0 + r) * 2048 + hp * 128 + 4 * c4);
                *(uint2*)(Wt + r * 272 + c4 * 8) = make_uint2(pk2(v.x, v.y), pk2(v.z, v.w)); }
            for (int e4 = tid; e4 < 4096; e4 += 512) { const int r = e4 >> 5, c4 = e4 & 31; const float4 v = *(const float4*)(p.sk + ((size_t)hp * 128 + r) * 128 + 4 * c4);
                *(uint2*)(St + r * 272 + c4 * 8) = make_uint2(pk2(v.x, v.y), pk2(v.z, v.w)); }
            __syncthreads();
            const int rt = wave >> 2, ct = wave & 3, l31 = lane & 31, hf = lane >> 5;
            f32x16 C;
#pragma unroll
            for (int r = 0; r < 16; ++r) C[r] = 0.f;
#pragma unroll
            for (int s8 = 0; s8 < 8; ++s8) C = MFMA32(*(const bf16x8*)(Wt + (32 * rt + l31) * 272 + (16 * s8 + 8 * hf) * 2), *(const bf16x8*)(St + (32 * ct + l31) * 272 + (16 * s8 + 8 * hf) * 2), C);
            float bsum = 0.f; unsigned amx = 0u;
            bf16_t* wcol = Weff_t + (size_t)(hp * 128 + 32 * ct + l31) * 1024 + i0 + 32 * rt + 4 * hf;
#pragma unroll
            for (int g4 = 0; g4 < 4; ++g4) {
                const int i = i0 + 32 * rt + 8 * g4 + 4 * hf;
                const float4 gg = *(const float4*)(p.g2 + i), sc = *(const float4*)(mod + 4096 + i), sh = *(const float4*)(mod + 3072 + i);
                const float c0 = C[4 * g4], c1 = C[4 * g4 + 1], c2 = C[4 * g4 + 2], c3 = C[4 * g4 + 3];
                bsum += sh.x * c0 + sh.y * c1 + sh.z * c2 + sh.w * c3;
                const uint2 wv = make_uint2(pk2(c0 * gg.x * (1.f + sc.x), c1 * gg.y * (1.f + sc.y)), pk2(c2 * gg.z * (1.f + sc.z), c3 * gg.w * (1.f + sc.w)));
                *(uint2*)(wcol + 8 * g4) = wv;
                amx = max(max(amx, (wv.x << 16) & 0x7fffffffu), max(wv.x & 0x7fff0000u, max((wv.y << 16) & 0x7fffffffu, wv.y & 0x7fff0000u)));
            }
            amx = max(amx, (unsigned)__shfl_xor((int)amx, 32));
            if (hf == 0) (void)__hip_atomic_fetch_max(ctl + CTL_CMAX + hp * 128 + 32 * ct + l31, amx, __ATOMIC_RELAXED, __HIP_MEMORY_SCOPE_AGENT);
            bsum += __shfl_xor(bsum, 32);
            if (hf == 0) bred[rt * 128 + 32 * ct + l31] = bsum;
            __syncthreads();
            if (tid < 128) bq_part[(size_t)blk * 2048 + hp * 128 + tid] = bred[tid] + bred[128 + tid];
        }
        __syncthreads();
        if (ib >= 0) convert_tables(p.down, p.up, q8, dsc, lane, ib * 8 + wave, nidle * 8, 0, CONV_SPLIT);
    }
    xcd_barrier(bar);
    wave = threadIdx.x >> 6; asm volatile("" : "+v"(wave));

    {
        const int gw = __builtin_amdgcn_readfirstlane(bid * 8 + wave), NGW = G * 8, l31 = lane & 31, hf = lane >> 5;
        const int wv0 = __builtin_amdgcn_readfirstlane(wave);
        for (int U = gw; U < 1024; U += NGW) {
            const int n = U >> 3, h = U & 7;
            f32x16 C[2][2];
#pragma unroll
            for (int a = 0; a < 2; ++a)
#pragma unroll
                for (int b = 0; b < 2; ++b)
#pragma unroll
                    for (int r = 0; r < 16; ++r) C[a][b][r] = 0.f;
            unsigned char* Kt = lds + wv0 * 9216; unsigned char* Vt = Kt + 4608;
            const int r8 = lane >> 3, pc = lane & 7, trq = (lane & 15) >> 2, trp = lane & 3, trd = (lane >> 4) & 1;
            const char* kbase = (const char*)(Kr + (size_t)n * 128 * 512 + h * 64); const char* vbase = (const char*)(Vr + (size_t)n * 128 * 512 + h * 64);
            const unsigned loff = (unsigned)(r8 * 512 + pc * 8) * 2u;
            const float lg = lg2_head(h);
            pg8::u32x4 gK[4], gV[4];
#pragma unroll
            for (int i = 0; i < 4; ++i) { gK[i] = *(const pg8::u32x4*)(kbase + (loff + i * 8192u)); gV[i] = *(const pg8::u32x4*)(vbase + (loff + i * 8192u)); }
            for (int sb4 = 0; sb4 < 4; ++sb4) {
#pragma unroll
                for (int i = 0; i < 4; ++i) { *(pg8::u32x4*)(Kt + (8 * i + r8) * 144 + pc * 16) = gK[i]; *(pg8::u32x4*)(Vt + (8 * i + r8) * 144 + pc * 16) = gV[i]; }
                { const int sn = (sb4 < 3) ? sb4 + 1 : sb4;
#pragma unroll
                  for (int i = 0; i < 4; ++i) { gK[i] = *(const pg8::u32x4*)(kbase + (size_t)sn * 32768 + (loff + i * 8192u)); gV[i] = *(const pg8::u32x4*)(vbase + (size_t)sn * 32768 + (loff + i * 8192u)); } }
#pragma unroll
                for (int s = 0; s < 2; ++s) {
                    bf16x8 Af[2], Bf[2];
#pragma unroll
                    for (int a = 0; a < 2; ++a) {
                        Af[a] = tr_frag(Vt + (16 * s + 8 * hf + trq) * 144 + (32 * a + 16 * trd + 4 * trp) * 2, 4);
                        const bf16x8 kraw = tr_frag(Kt + (16 * s + 8 * hf + trq) * 144 + (32 * a + 16 * trd + 4 * trp) * 2, 4);
                        const pg8::u32x4 kw = __builtin_bit_cast(pg8::u32x4, kraw); const unsigned kk[4] = {kw.x, kw.y, kw.z, kw.w};
                        pg8::u32x4 o; unsigned* op = (unsigned*)&o;
#pragma unroll
                        for (int e2 = 0; e2 < 4; ++e2) {
                            const int j0 = 32 * sb4 + 16 * s + 8 * hf + 2 * e2;
                            const float z0 = __builtin_amdgcn_exp2f((float)(127 - j0) * lg), z1 = __builtin_amdgcn_exp2f((float)(126 - j0) * lg);
                            op[e2] = pg8::cvt_pk_bf16(__uint_as_float(kk[e2] << 16) * z0, __uint_as_float(kk[e2] & 0xffff0000u) * z1);
                        }
                        Bf[a] = __builtin_bit_cast(bf16x8, o);
                    }
#pragma unroll
                    for (int a = 0; a < 2; ++a)
#pragma unroll
                        for (int b = 0; b < 2; ++b) C[a][b] = MFMA32(Af[a], Bf[b], C[a][b]);
                }
            }
            float* dst = kv + (size_t)(n * 8 + h) * 4096;
#pragma unroll
            for (int a = 0; a < 2; ++a)
#pragma unroll
                for (int b = 0; b < 2; ++b)
#pragma unroll
                    for (int r = 0; r < 16; ++r) dst[(32 * a + (r & 3) + 8 * (r >> 2) + 4 * hf) * 64 + 32 * b + l31] = C[a][b][r];
        }
        bf16x8 Tri[2];
        {
            pg8::u32x4 w0, w1; unsigned* p0 = (unsigned*)&w0; unsigned* p1 = (unsigned*)&w1;
#pragma unroll
            for (int e2 = 0; e2 < 4; ++e2) {
                unsigned a0 = 0, a1 = 0;
#pragma unroll
                for (int q = 0; q < 2; ++q) { const int e = 2 * e2 + q, ip = 8 * (e >> 2) + 4 * hf + (e & 3);
                    a0 |= ((ip > l31) ? 0x3F80u : 0u) << (16 * q); a1 |= ((16 + ip > l31) ? 0x3F80u : 0u) << (16 * q); }
                p0[e2] = a0; p1[e2] = a1;
            }
            Tri[0] = __builtin_bit_cast(bf16x8, w0); Tri[1] = __builtin_bit_cast(bf16x8, w1);
        }
        const bool sb_local = (G % 8 == 0) && (4096 % G == 0) && ((4096 / G) % 8 == 0);
        const int sb_per_wave = sb_local ? 4096 / G / 8 : (4096 + NGW - 1 - gw) / NGW;
        const int wv = __builtin_amdgcn_readfirstlane(wave);
        for (int ps = 0; ps < sb_per_wave; ++ps) {
            const int U = sb_local ? 0 : gw + ps * NGW;
            const int h = sb_local ? (bid & 7) : (U & 7), qt = sb_local ? (bid >> 3) * (4096 / G) + ps * 8 + wv : (U >> 3), q0 = qt * 32;
            f32x16 O[2];
#pragma unroll
            for (int r = 0; r < 16; ++r) { O[0][r] = 0.f; O[1][r] = 0.f; }
            float carry = 0.f;
            unsigned char* Kt = lds + wv * 9216; unsigned char* Vt = Kt + 4608;
            const int r8 = lane >> 3, pc = lane & 7;
            const char* kbase = (const char*)(Ks + h * 64); const char* vbase = (const char*)(Vs + h * 64);
            const unsigned loff = (unsigned)(r8 * 512 + pc * 8) * 2u;
            pg8::u32x4 gK[4], gV[4];
            bf16x8 Qf[4];
            {
                const char* qbase = (const char*)(Qs + h * 64);
#pragma unroll
                for (int i = 0; i < 4; ++i) gK[i] = *(const pg8::u32x4*)(qbase + (size_t)qt * 32768 + (loff + i * 8192u));
#pragma unroll
                for (int i = 0; i < 4; ++i) *(pg8::u32x4*)(Kt + (8 * i + r8) * 144 + pc * 16) = gK[i];
#pragma unroll
                for (int s = 0; s < 4; ++s) Qf[s] = *(const bf16x8*)(Kt + l31 * 144 + 32 * s + 16 * hf);
            }
#pragma unroll
            for (int i = 0; i < 4; ++i) { gK[i] = *(const pg8::u32x4*)(kbase + (size_t)qt * 32768 + (loff + i * 8192u)); gV[i] = *(const pg8::u32x4*)(vbase + (size_t)qt * 32768 + (loff + i * 8192u)); }
            const int trq = (lane & 15) >> 2, trp = lane & 3, trd = (lane >> 4) & 1;
            for (int kb = qt; kb >= 0; --kb) {
#pragma unroll
                for (int i = 0; i < 4; ++i) { *(pg8::u32x4*)(Kt + (8 * i + r8) * 144 + pc * 16) = gK[i]; *(pg8::u32x4*)(Vt + (8 * i + r8) * 144 + pc * 16) = gV[i]; }
                {
                    const int kbn = (kb > 0) ? kb - 1 : 0;
#pragma unroll
                    for (int i = 0; i < 4; ++i) { gK[i] = *(const pg8::u32x4*)(kbase + (size_t)kbn * 32768 + (loff + i * 8192u)); gV[i] = *(const pg8::u32x4*)(vbase + (size_t)kbn * 32768 + (loff + i * 8192u)); }
                }
                bf16x8 Kf[4], Vf[2][2];
#pragma unroll
                for (int s = 0; s < 4; ++s) Kf[s] = *(const bf16x8*)(Kt + l31 * 144 + 32 * s + 16 * hf);
#pragma unroll
                for (int s = 0; s < 2; ++s)
#pragma unroll
                    for (int dt = 0; dt < 2; ++dt) {
                        Vf[s][dt] = tr_frag(Vt + (16 * s + 4 * hf + trq) * 144 + (32 * dt + 16 * trd + 4 * trp) * 2, 8);
                    }
                f32x16 S;
#pragma unroll
                for (int r = 0; r < 16; ++r) S[r] = 0.f;
#pragma unroll
                for (int s = 0; s < 4; ++s) S = MFMA32(Kf[s], Qf[s], S);
                const bool diag = (kb == qt);
                f32x16 sp, lb;
                float csum = 0.f;
                if (diag) {
#pragma unroll
                    for (int r = 0; r < 16; ++r) {
                        const int i = (r & 3) + 8 * (r >> 2) + 4 * hf;
                        const float z = S[r];
                        const float l1p = __builtin_amdgcn_logf(1.0f + __builtin_amdgcn_exp2f(-fabsf(z)));
                        const float spv = (i < l31) ? (fmaxf(z, 0.f) + l1p) : 0.f;
                        sp[r] = spv; lb[r] = (i < l31) ? (fminf(z, 0.f) - l1p) : -INFINITY; csum += spv;
                    }
                } else {
#pragma unroll
                    for (int r = 0; r < 16; ++r) {
                        const float z = S[r];
                        const float l1p = __builtin_amdgcn_logf(1.0f + __builtin_amdgcn_exp2f(-fabsf(z)));
                        const float spv = fmaxf(z, 0.f) + l1p;
                        sp[r] = spv; lb[r] = fminf(z, 0.f) - l1p; csum += spv;
                    }
                }
                f32x16 Rt;
#pragma unroll
                for (int r = 0; r < 16; ++r) Rt[r] = carry;
#pragma unroll
                for (int s = 0; s < 2; ++s) Rt = MFMA32(Tri[s], pack_frag(sp, s), Rt);
                f32x16 wv;
#pragma unroll
                for (int r = 0; r < 16; ++r) wv[r] = __builtin_amdgcn_exp2f(lb[r] - Rt[r]);
#pragma unroll
                for (int s = 0; s < 2; ++s) { const bf16x8 wp = pack_frag(wv, s);
#pragma unroll
                    for (int dt = 0; dt < 2; ++dt) O[dt] = MFMA32(Vf[s][dt], wp, O[dt]); }
                csum += __shfl_xor(csum, 32);
                carry += csum;
                if (__all(carry > 127.f)) break;
            }
            float ss = 0.f;
#pragma unroll
            for (int r = 0; r < 16; ++r) ss += O[0][r] * O[0][r] + O[1][r] * O[1][r];
            ss += __shfl_xor(ss, 32);
            const float rn = 1.0f / sqrtf(ss * (1.f / 64.f) + EPS);
#pragma unroll
            for (int dt = 0; dt < 2; ++dt)
#pragma unroll
                for (int g4 = 0; g4 < 4; ++g4) {
                    const int d = 32 * dt + 8 * g4 + 4 * hf;
                    const float4 gn = *(const float4*)(p.og + d);
                    uint2 w; w.x = pg8::cvt_pk_bf16(O[dt][4 * g4] * rn * gn.x, O[dt][4 * g4 + 1] * rn * gn.y); w.y = pg8::cvt_pk_bf16(O[dt][4 * g4 + 2] * rn * gn.z, O[dt][4 * g4 + 3] * rn * gn.w);
                    *(uint2*)(Kt + l31 * 144 + d * 2) = w;
                }
#pragma unroll
            for (int i = 0; i < 4; ++i) *(pg8::u32x4*)(ycat + (size_t)(q0 + 8 * i + r8) * 1024 + 512 + h * 64 + pc * 8) = *(const pg8::u32x4*)(Kt + (8 * i + r8) * 144 + pc * 16);
        }
    }
    xcd_barrier(bar);

    if (bid == 255 % G) for (int n = tid; n < 2048; n += 512) { float s = 0.f;
#pragma unroll
        for (int b8 = 0; b8 < 16; ++b8) s += bq_part[(size_t)b8 * 2048 + n];
        bias_q[n] = s; }
    if (bid >= 64) for (int row = (bid - 64) * 8 + wave; row < 2048; row += (G - 64) * 8) {
        const float am = __uint_as_float(ctl[CTL_CMAX + row]), qs = (am > 0.f) ? 127.f / am : 0.f;
        const pg8::u32x4 a = *(const pg8::u32x4*)(Weff_t + (size_t)row * 1024 + 16 * lane), b = *(const pg8::u32x4*)(Weff_t + (size_t)row * 1024 + 16 * lane + 8);
        pg8::u32x4 o;
#define QB(w) ((__float_as_uint(fmaf(__uint_as_float((w) << 16), qs, 12582912.f)) & 255u) | ((__float_as_uint(fmaf(__uint_as_float((w) & 0xffff0000u), qs, 12582912.f)) & 255u) << 8))
        o.x = QB(a.x) | (QB(a.y) << 16); o.y = QB(a.z) | (QB(a.w) << 16); o.z = QB(b.x) | (QB(b.y) << 16); o.w = QB(b.z) | (QB(b.w) << 16);
#undef QB
        *(pg8::u32x4*)(Weffq_t + (size_t)row * 1024 + 16 * lane) = o;
        if (lane == 0) sq[row] = am * (1.f / 127.f);
    }
    if (G > 64 && bid >= 64) convert_tables(p.down, p.up, q8, dsc, lane, (bid - 64) * 8 + wave, (G - 64) * 8, CONV_SPLIT, 32768);
    else if (G <= 64) convert_tables(p.down, p.up, q8, dsc, lane, bid * 8 + wave, G * 8, CONV_SPLIT, 32768);
    for (int idx = bid * 512 + tid; idx < 32768; idx += G * 512) {
        const int h = idx >> 12;
        const float cd = exp2f(128.f * lg2_head(h));
        float s = 0.f;
        for (int n0 = 0; n0 < 128; n0 += 32) {
            float kvv[32];
#pragma unroll
            for (int q = 0; q < 32; ++q) kvv[q] = kv[(size_t)(n0 + q) * 32768 + idx];
#pragma unroll
            for (int q = 0; q < 32; ++q) { stT[(size_t)(n0 + q) * 32768 + idx] = f2bf(s); s = cd * s + kvv[q]; }
        }
    }
    xcd_barrier(bar);

    {
        const int gw = __builtin_amdgcn_readfirstlane(bid * 8 + wave), NGW = G * 8, l31 = lane & 31, hf = lane >> 5;
        const int wv4 = __builtin_amdgcn_readfirstlane(wave);
        for (int W2 = gw; W2 < 2048; W2 += NGW) {
            const int nh = W2 >> 1, n = nh >> 3, h = nh & 7;
            const float lg = lg2_head(h);
#pragma unroll 1
            for (int pass = 0; pass < 2; ++pass) {
                const int qt = (W2 & 1) ? (pass ? 2 : 1) : (pass ? 3 : 0);
                const int il = qt * 32 + l31, tq = n * 128 + il;
                unsigned char* Kt = lds + wv4 * 9216; unsigned char* Vt = Kt + 4608;
                const int r8 = lane >> 3, pc = lane & 7, trq = (lane & 15) >> 2, trp = lane & 3, trd = (lane >> 4) & 1;
                const unsigned loff = (unsigned)(r8 * 512 + pc * 8) * 2u;
                pg8::u32x4 gK[4], gV[4];
                bf16x8 Qf[4];
                {
                    const char* qbase = (const char*)(Qr + (size_t)(n * 128 + qt * 32) * 512 + h * 64);
                    const char* sbase = (const char*)(stT + (size_t)nh * 4096) + (unsigned)(r8 * 64 + pc * 8) * 2u;
#pragma unroll
                    for (int i = 0; i < 4; ++i) gK[i] = *(const pg8::u32x4*)(qbase + (loff + i * 8192u));
#pragma unroll
                    for (int i = 0; i < 4; ++i) *(pg8::u32x4*)(Kt + (8 * i + r8) * 144 + pc * 16) = gK[i];
#pragma unroll
                    for (int s = 0; s < 4; ++s) Qf[s] = *(const bf16x8*)(Kt + l31 * 144 + 32 * s + 16 * hf);
#pragma unroll
                    for (int i = 0; i < 4; ++i) { gK[i] = *(const pg8::u32x4*)(sbase + i * 1024u); gV[i] = *(const pg8::u32x4*)(sbase + 4096u + i * 1024u); }
#pragma unroll
                    for (int i = 0; i < 4; ++i) { *(pg8::u32x4*)(Kt + (8 * i + r8) * 144 + pc * 16) = gK[i]; *(pg8::u32x4*)(Kt + (32 + 8 * i + r8) * 144 + pc * 16) = gV[i]; }
                }
                f32x16 O[2];
#pragma unroll
                for (int r = 0; r < 16; ++r) { O[0][r] = 0.f; O[1][r] = 0.f; }
#pragma unroll
                for (int s = 0; s < 4; ++s)
#pragma unroll
                    for (int dt = 0; dt < 2; ++dt) O[dt] = MFMA32(*(const bf16x8*)(Kt + (32 * dt + l31) * 144 + 32 * s + 16 * hf), Qf[s], O[dt]);
                const float xi = exp2f((float)(il + 1) * lg);
#pragma unroll
                for (int r = 0; r < 16; ++r) { O[0][r] *= xi; O[1][r] *= xi; }
                const char* kbase = (const char*)(Kr + (size_t)n * 128 * 512 + h * 64); const char* vbase = (const char*)(Vr + (size_t)n * 128 * 512 + h * 64);
#pragma unroll
                for (int i = 0; i < 4; ++i) { gK[i] = *(const pg8::u32x4*)(kbase + (loff + i * 8192u)); gV[i] = *(const pg8::u32x4*)(vbase + (loff + i * 8192u)); }
                for (int jb = 0; jb <= qt; ++jb) {
#pragma unroll
                    for (int i = 0; i < 4; ++i) { *(pg8::u32x4*)(Kt + (8 * i + r8) * 144 + pc * 16) = gK[i]; *(pg8::u32x4*)(Vt + (8 * i + r8) * 144 + pc * 16) = gV[i]; }
                    { const int jn = (jb < qt) ? jb + 1 : jb;
#pragma unroll
                      for (int i = 0; i < 4; ++i) { gK[i] = *(const pg8::u32x4*)(kbase + (size_t)jn * 32768 + (loff + i * 8192u)); gV[i] = *(const pg8::u32x4*)(vbase + (size_t)jn * 32768 + (loff + i * 8192u)); } }
                    bf16x8 Kf[4], Vf[2][2];
#pragma unroll
                    for (int s = 0; s < 4; ++s) Kf[s] = *(const bf16x8*)(Kt + l31 * 144 + 32 * s + 16 * hf);
#pragma unroll
                    for (int s = 0; s < 2; ++s)
#pragma unroll
                        for (int dt = 0; dt < 2; ++dt) Vf[s][dt] = tr_frag(Vt + (16 * s + 4 * hf + trq) * 144 + (32 * dt + 16 * trd + 4 * trp) * 2, 8);
                    f32x16 S;
#pragma unroll
                    for (int r = 0; r < 16; ++r) S[r] = 0.f;
#pragma unroll
                    for (int s = 0; s < 4; ++s) S = MFMA32(Kf[s], Qf[s], S);
#pragma unroll
                    for (int r = 0; r < 16; ++r) {
                        const int jl = jb * 32 + (r & 3) + 8 * (r >> 2) + 4 * hf, dl = il - jl;
                        S[r] = (dl >= 0) ? S[r] * __builtin_amdgcn_exp2f((float)dl * lg) : 0.f;
                    }
#pragma unroll
                    for (int s = 0; s < 2; ++s) { const bf16x8 wp = pack_frag(S, s);
#pragma unroll
                        for (int dt = 0; dt < 2; ++dt) O[dt] = MFMA32(Vf[s][dt], wp, O[dt]); }
                }
                float sm = 0.f;
#pragma unroll
                for (int r = 0; r < 16; ++r) sm += O[0][r] + O[1][r];
                sm += __shfl_xor(sm, 32);
                const float mean = sm * (1.f / 64.f);
                float vs = 0.f;
#pragma unroll
                for (int r = 0; r < 16; ++r) { const float d0 = O[0][r] - mean, d1 = O[1][r] - mean; vs += d0 * d0 + d1 * d1; }
                vs += __shfl_xor(vs, 32);
                const float rstd = 1.0f / sqrtf(vs * (1.f / 64.f) + EPS);
                {
                    const char* gbase = (const char*)(Gr + (size_t)(n * 128 + qt * 32) * 512 + h * 64);
#pragma unroll
                    for (int i = 0; i < 4; ++i) gV[i] = *(const pg8::u32x4*)(gbase + (loff + i * 8192u));
#pragma unroll
                    for (int i = 0; i < 4; ++i) *(pg8::u32x4*)(Vt + (8 * i + r8) * 144 + pc * 16) = gV[i];
                }
#pragma unroll
                for (int dt = 0; dt < 2; ++dt)
#pragma unroll
                    for (int g4 = 0; g4 < 4; ++g4) {
                        const int e = 32 * dt + 8 * g4 + 4 * hf;
                        const float4 gn = *(const float4*)(p.rgain + h * 64 + e);
                        const uint2 gg = *(const uint2*)(Vt + l31 * 144 + e * 2);
                        const float g0 = __uint_as_float(gg.x << 16), g1 = __uint_as_float(gg.x & 0xffff0000u), g2v = __uint_as_float(gg.y << 16), g3 = __uint_as_float(gg.y & 0xffff0000u);
                        uint2 w;
                        w.x = pg8::cvt_pk_bf16((O[dt][4 * g4] - mean) * rstd * gn.x * g0, (O[dt][4 * g4 + 1] - mean) * rstd * gn.y * g1);
                        w.y = pg8::cvt_pk_bf16((O[dt][4 * g4 + 2] - mean) * rstd * gn.z * g2v, (O[dt][4 * g4 + 3] - mean) * rstd * gn.w * g3);
                        *(uint2*)(Kt + l31 * 144 + e * 2) = w;
                    }
#pragma unroll
                for (int i = 0; i < 4; ++i) *(pg8::u32x4*)(ycat + (size_t)(n * 128 + qt * 32 + 8 * i + r8) * 1024 + h * 64 + pc * 8) = *(const pg8::u32x4*)(Kt + (8 * i + r8) * 144 + pc * 16);
            }
        }
    }
    xcd_barrier(bar);

    {
        pg8::Gemm g{ycat, Wout_t, T, 1024, 1024}; pg8::StaticOrder S; S.init(T, 1024, G, bid);
        EpiOutprojMF E{p.x, mod + 2048, x1b, part2, pmax, x1q, rinv2q, ctl};
        pg8::gemm_phase<EpiOutprojMF, pg8::StaticOrder>((PG8_LAS unsigned char*)lds, g, S, E);
    }
    xcd_barrier(bar);

    for (int round = 0; round < 2; ++round) {
        pg8::Gemm g{(const bf16_t*)x1q, (const bf16_t*)Weffq_t, T, 2048, 512}; OneUnitOrder S; S.base.init(T, 2048, G, bid); S.round = round;
        EpiTopkMF E{rinv2q, sq, bias_q, ids, gates};
        pg8::gemm_phase<EpiTopkMF, OneUnitOrder, true>((PG8_LAS unsigned char*)lds, g, S, E);
    }
    xcd_barrier(bar);

    {
        constexpr int IDS_LD = 136, ACT_LD = 136;
        const float* scale2 = mod + 4096; const float* shift2 = mod + 3072; const float* gate2 = mod + 5120;
        unsigned short* ids_l = (unsigned short*)lds; float* act_l = (float*)(lds + 32768);
        bf16_t* ds_l = (bf16_t*)(lds + 69632);
        const int t0 = bid * 64, tt = lane >> 3, sub = lane & 7, tl = wave * 8 + tt, t = t0 + tl;
        for (int e = tid; e < 1024; e += 512) { const int r = e >> 4, c8 = e & 15; *(uint4*)(ids_l + r * IDS_LD + c8 * 8) = *(const uint4*)(ids + (size_t)(t0 + r) * 128 + c8 * 8); }
        for (int e = tid; e < 64 * ACT_LD; e += 512) act_l[e] = 0.f;
        for (int e = tid; e < 4096; e += 512) ((uint4*)ds_l)[e] = ((const uint4*)dsc)[e];
        float* s2_l = (float*)(lds + 143360); float* sh2_l = s2_l + 1024; float* gt2_l = s2_l + 2048;
        for (int e = tid; e < 1024; e += 512) { s2_l[e] = p.g2[e] * (1.f + scale2[e]); sh2_l[e] = shift2[e]; gt2_l[e] = gate2[e]; }
        __syncthreads();
        float ri;
        { const float4* pp = (const float4*)(part2 + (size_t)t * 16); const float4 p0 = pp[0], p1 = pp[1], p2 = pp[2], p3 = pp[3];
          const float ssum = ((p0.x + p0.y) + (p0.z + p0.w)) + ((p1.x + p1.y) + (p1.z + p1.w)) + ((p2.x + p2.y) + (p2.z + p2.w)) + ((p3.x + p3.y) + (p3.z + p3.w));
          ri = 1.0f / sqrtf(ssum * (1.0f / D) + EPS); }
        const unsigned short* myids = ids_l + tl * IDS_LD;
        float* myact = act_l + tl * ACT_LD;
        const bool s4 = (sub & 4) != 0, s2 = (sub & 2) != 0, s1 = (sub & 1) != 0;
        const unsigned suboff = (unsigned)sub * 16u;
        typedef float f32x2 __attribute__((ext_vector_type(2)));
#define P9_LOAD(W, JB) do { const uint4 idv_ = *(const uint4*)(myids + 8 * (JB)); const unsigned idw_[4] = {idv_.x, idv_.y, idv_.z, idv_.w}; \
        _Pragma("unroll") for (int k_ = 0; k_ < 8; ++k_) { const unsigned id_ = (idw_[k_ >> 1] >> (16 * (k_ & 1))) & 0xffffu; W[k_] = *(const uint4*)(sbase + (id_ * 128u + suboff)); } } while (0)
#define P9_DOWN4(W, JB) do { int pd_[8]; \
        _Pragma("unroll") for (int k_ = 0; k_ < 8; ++k_) { const unsigned ww_[4] = {W[k_].x, W[k_].y, W[k_].z, W[k_].w}; int a0_ = 0, a1_ = 0; \
            _Pragma("unroll") for (int m_ = 0; m_ < 4; ++m_) { a0_ = __builtin_amdgcn_sdot4(hpe[m_], (int)(ww_[m_] & 0x0F0F0F0Fu), a0_, false); a1_ = __builtin_amdgcn_sdot4(hpo[m_], (int)((ww_[m_] >> 4) & 0x0F0F0F0Fu), a1_, false); } \
            pd_[k_] = a0_ + a1_ - hoff; } \
        int r4_[4], r2_[2]; \
        _Pragma("unroll") for (int k_ = 0; k_ < 4; ++k_) { const int snd_ = s4 ? pd_[k_] : pd_[k_ + 4], kp_ = s4 ? pd_[k_ + 4] : pd_[k_]; r4_[k_] = kp_ + __shfl_xor(snd_, 4); } \
        _Pragma("unroll") for (int k_ = 0; k_ < 2; ++k_) { const int snd_ = s2 ? r4_[k_] : r4_[k_ + 2], kp_ = s2 ? r4_[k_ + 2] : r4_[k_]; r2_[k_] = kp_ + __shfl_xor(snd_, 2); } \
        { const int snd_ = s1 ? r2_[0] : r2_[1], kp_ = s1 ? r2_[1] : r2_[0]; myact[8 * (JB) + sub] += (float)(kp_ + __shfl_xor(snd_, 1)) * hscale; } } while (0)
        uint2 xnx[8];
#pragma unroll
        for (int q = 0; q < 8; ++q) xnx[q] = *(const uint2*)(x1b + (size_t)t * D + 4 * sub + 32 * q);
        float gtv[16];
#pragma unroll
        for (int jb = 0; jb < 16; ++jb) gtv[jb] = gates[(size_t)t * 128 + 8 * jb + sub];
        const unsigned char* sbase = q8;
        uint4 wA[8], wB[8];
        P9_LOAD(wA, 0);
        for (int c = 0; c < 4; ++c) {
            uint2 xcur[8];
#pragma unroll
            for (int q = 0; q < 8; ++q) xcur[q] = xnx[q];
            { const int cn = (c < 3) ? c + 1 : c;
#pragma unroll
              for (int q = 0; q < 8; ++q) xnx[q] = *(const uint2*)(x1b + (size_t)t * D + 256 * cn + 4 * sub + 32 * q); }
            float hf[8][4]; float hmax = 0.f;
#pragma unroll
            for (int q = 0; q < 8; ++q) {
                const int col = 256 * c + 4 * sub + 32 * q;
                const uint2 xw = xcur[q];
                const float4 sv = *(const float4*)(s2_l + col), sh = *(const float4*)(sh2_l + col);
                hf[q][0] = __uint_as_float(xw.x << 16) * ri * sv.x + sh.x; hf[q][1] = __uint_as_float(xw.x & 0xffff0000u) * ri * sv.y + sh.y;
                hf[q][2] = __uint_as_float(xw.y << 16) * ri * sv.z + sh.z; hf[q][3] = __uint_as_float(xw.y & 0xffff0000u) * ri * sv.w + sh.w;
                hmax = fmaxf(hmax, fmaxf(fmaxf(fabsf(hf[q][0]), fabsf(hf[q][1])), fmaxf(fabsf(hf[q][2]), fabsf(hf[q][3]))));
            }
            hmax = fmaxf(hmax, __shfl_xor(hmax, 1)); hmax = fmaxf(hmax, __shfl_xor(hmax, 2)); hmax = fmaxf(hmax, __shfl_xor(hmax, 4));
            const float hinv = (hmax > 0.f) ? 127.0f / hmax : 0.f, hscale = hmax * (1.0f / 127.0f);
            int hq[8][4];
#pragma unroll
            for (int q = 0; q < 8; ++q)
#pragma unroll
                for (int j = 0; j < 4; ++j) hq[q][j] = (int)__builtin_rintf(hf[q][j] * hinv);
            int hpe[4], hpo[4], hoff = 0;
#pragma unroll
            for (int m = 0; m < 4; ++m) {
                hpe[m] = (hq[2 * m][0] & 255) | ((hq[2 * m][2] & 255) << 8) | ((hq[2 * m + 1][0] & 255) << 16) | ((hq[2 * m + 1][2] & 255) << 24);
                hpo[m] = (hq[2 * m][1] & 255) | ((hq[2 * m][3] & 255) << 8) | ((hq[2 * m + 1][1] & 255) << 16) | ((hq[2 * m + 1][3] & 255) << 24);
            }
#pragma unroll
            for (int q = 0; q < 8; ++q) hoff += (hq[q][0] + hq[q][1]) + (hq[q][2] + hq[q][3]);
            hoff *= 8;
#pragma unroll 1
            for (int jb = 0; jb < 16; jb += 2) {
                P9_LOAD(wB, jb + 1);
                P9_DOWN4(wA, jb);
                if (jb + 2 < 16) P9_LOAD(wA, jb + 2);
                else { sbase = (c < 3) ? q8 + (size_t)(c + 1) * (16384 * 128) : q8 + (8u << 20); P9_LOAD(wA, 0); }
                P9_DOWN4(wB, jb + 1);
            }
        }
#undef P9_DOWN4
        signed char* aq_l = (signed char*)(lds + 135168);
        float avv[16]; float amax = 0.f;
#pragma unroll
        for (int jb = 0; jb < 16; ++jb) {
            const int j = 8 * jb + sub; const unsigned id = myids[j];
            const float a = myact[j] * bf2f(ds_l[id]);
            const float av = fabsf(a), tq = 1.0f / (av * 0.2316418882f + 1.0f);
            float ql = tq * 0.5307027145f + (-0.7265760135f); ql = ql * tq + 0.7107068705f; ql = ql * tq + (-0.142248368f); ql = ql * tq + 0.127414796f; ql = ql * tq;
            const float mm = a * (ql * exp2f(a * a * (-0.72134752044f)));
            const float ge = (a < 0.f) ? mm : (a - mm);
            avv[jb] = ge * gtv[jb] * bf2f(ds_l[16384 + id]);
            amax = fmaxf(amax, fabsf(avv[jb]));
        }
        amax = fmaxf(amax, __shfl_xor(amax, 1)); amax = fmaxf(amax, __shfl_xor(amax, 2)); amax = fmaxf(amax, __shfl_xor(amax, 4));
        const float ainv = (amax > 0.f) ? 127.0f / amax : 0.f, ascale = amax * (1.0f / 127.0f);
        int aqsum = 0;
#pragma unroll
        for (int jb = 0; jb < 16; ++jb) { const int aqv = (int)__builtin_rintf(avv[jb] * ainv); aq_l[tl * 128 + 8 * jb + sub] = (signed char)aqv; aqsum += aqv; }
        aqsum += __shfl_xor(aqsum, 1); aqsum += __shfl_xor(aqsum, 2); aqsum += __shfl_xor(aqsum, 4);
        __syncthreads();
#define P9_PERM(HI, LO, SEL) __builtin_amdgcn_perm((HI), (LO), (SEL))
#define P9_T4(E0, E1, E2, E3, T0, T1, T2, T3) do { const unsigned p0_ = P9_PERM(E1, E0, 0x05010400u), p1_ = P9_PERM(E1, E0, 0x07030602u), p2_ = P9_PERM(E3, E2, 0x05010400u), p3_ = P9_PERM(E3, E2, 0x07030602u); \
        T0 = P9_PERM(p2_, p0_, 0x05040100u); T1 = P9_PERM(p2_, p0_, 0x07060302u); T2 = P9_PERM(p3_, p1_, 0x05040100u); T3 = P9_PERM(p3_, p1_, 0x07060302u); } while (0)
#define P9_UP4(W, JB) do { const uint2 aq8_ = *(const uint2*)(aq_l + tl * 128 + 8 * (JB)); const int aq4_[2] = {(int)aq8_.x, (int)aq8_.y}; \
        _Pragma("unroll") for (int g_ = 0; g_ < 2; ++g_) { \
            _Pragma("unroll") for (int m_ = 0; m_ < 4; ++m_) { \
                const unsigned w0_ = ((const unsigned*)&W[4 * g_ + 0])[m_], w1_ = ((const unsigned*)&W[4 * g_ + 1])[m_], w2_ = ((const unsigned*)&W[4 * g_ + 2])[m_], w3_ = ((const unsigned*)&W[4 * g_ + 3])[m_]; \
                unsigned t_[4]; \
                P9_T4(w0_, w1_, w2_, w3_, t_[0], t_[1], t_[2], t_[3]); \
                _Pragma("unroll") for (int k_ = 0; k_ < 4; ++k_) { \
                    oraw[4 * m_ + k_] = __builtin_amdgcn_sdot4(aq4_[g_], (int)t_[k_], oraw[4 * m_ + k_], false); \
                    olo[4 * m_ + k_] = __builtin_amdgcn_sdot4(aq4_[g_], (int)(t_[k_] & 0x0F0F0F0Fu), olo[4 * m_ + k_], false); } } } } while (0)
        for (int c = 0; c < 4; ++c) {
            int oraw[16], olo[16];
#pragma unroll
            for (int q = 0; q < 16; ++q) { oraw[q] = 0; olo[q] = 0; }
            uint2 xres[8];
#pragma unroll
            for (int q = 0; q < 8; ++q) xres[q] = *(const uint2*)(x1b + (size_t)t * D + 256 * c + 4 * sub + 32 * q);
#pragma unroll 1
            for (int jb = 0; jb < 16; jb += 2) {
                P9_LOAD(wB, jb + 1);
                P9_UP4(wA, jb);
                if (jb + 2 < 16) P9_LOAD(wA, jb + 2);
                else if (c < 3) { sbase = q8 + (8u << 20) + (size_t)(c + 1) * (16384 * 128); P9_LOAD(wA, 0); }
                P9_UP4(wB, jb + 1);
            }
#pragma unroll
            for (int q = 0; q < 8; ++q) {
                const int col = 256 * c + 4 * sub + 32 * q;
                float* op = out + (size_t)t * D + col;
                const uint2 xw = xres[q]; const float4 xv = make_float4(__uint_as_float(xw.x << 16), __uint_as_float(xw.x & 0xffff0000u), __uint_as_float(xw.y << 16), __uint_as_float(xw.y & 0xffff0000u)); const float4 gt = *(const float4*)(gt2_l + col);
                const int m = q >> 1, k0 = 2 * (q & 1);
                const int v0 = olo[4 * m + k0] - 8 * aqsum, v1 = (oraw[4 * m + k0] - olo[4 * m + k0]) >> 4, v2 = olo[4 * m + k0 + 1] - 8 * aqsum, v3 = (oraw[4 * m + k0 + 1] - olo[4 * m + k0 + 1]) >> 4;
                float4 r;
                r.x = xv.x + gt.x * ((float)v0 * ascale); r.y = xv.y + gt.y * ((float)v1 * ascale); r.z = xv.z + gt.z * ((float)v2 * ascale); r.w = xv.w + gt.w * ((float)v3 * ascale);
                *(float4*)op = r;
            }
        }
#undef P9_LOAD
#undef P9_UP4
#undef P9_T4
#undef P9_PERM
    }
}
}

extern "C" void kernel_launch(void* const* d_in, const int* in_sizes, int n_in, void* d_out, int out_size, void* d_ws, size_t ws_size, hipStream_t stream) {
    static int grid = 0;
    if (grid == 0) {
        int dev = 0, cus = 0, per_cu = 0;
        (void)hipGetDevice(&dev);
        (void)hipDeviceGetAttribute(&cus, hipDeviceAttributeMultiprocessorCount, dev);
        (void)hipFuncSetAttribute((const void*)mk_fwd, hipFuncAttributeMaxDynamicSharedMemorySize, LDS_BYTES);
        (void)hipOccupancyMaxActiveBlocksPerMultiprocessor(&per_cu, (const void*)mk_fwd, 512, LDS_BYTES);
        if (per_cu < 1 || cus != 256) { fprintf(stderr, "kernel_launch: needs 256 CUs with one resident workgroup each (cus %d, per_cu %d)\n", cus, per_cu); grid = -1; }
        else grid = cus;
    }
    if (grid < 0) return;
    (void)hipMemsetAsync((char*)d_ws + OFF_CTL, 0, CTL_BYTES, stream);
    Params p{};
    p.x = (const float*)d_in[0]; p.c = (const float*)d_in[1]; p.pos = (const int*)d_in[2]; p.ada_w = (const float*)d_in[3]; p.ada_b = (const float*)d_in[4];
    p.g1 = (const float*)d_in[5]; p.g2 = (const float*)d_in[6]; p.w_in = (const float*)d_in[7]; p.rgain = (const float*)d_in[8]; p.qg = (const float*)d_in[9];
    p.kg = (const float*)d_in[10]; p.og = (const float*)d_in[11]; p.w_out = (const float*)d_in[12]; p.wq = (const float*)d_in[13]; p.sk = (const float*)d_in[14];
    p.down = (const float*)d_in[15]; p.up = (const float*)d_in[16]; p.out = (float*)d_out; p.ws = (unsigned char*)d_ws;
    for (int i = 0; i < 32; ++i) {
        const double f = pow(10000.0, -(double)i / 32.0) / 6.283185307179586476925;
        float fh = (float)f; unsigned ub; memcpy(&ub, &fh, 4); ub &= 0xFFFFC000u; memcpy(&fh, &ub, 4);
        p.rc.fh[i] = fh; p.rc.fl[i] = (float)(f - (double)fh);
    }
    void* args[] = {&p};
    hipError_t e = hipLaunchCooperativeKernel((const void*)mk_fwd, dim3(grid), dim3(512), args, LDS_BYTES, stream);
    if (e != hipSuccess) fprintf(stderr, "kernel_launch: cooperative launch failed: %s (grid %d)\n", hipGetErrorString(e), grid);
}
```

```cpp
#include <hip/hip_runtime.h>
#include <stdint.h>
#include <math.h>
#include <cstdio>
#include <cstring>

namespace {
constexpr int T = 16384, D = 1024;
constexpr float EPS = 1e-6f;
typedef unsigned short bf16_t;
#define LAS __attribute__((address_space(3)))

__device__ __forceinline__ float bf2f(bf16_t b) { return __uint_as_float(((unsigned)b) << 16); }
__device__ __forceinline__ bf16_t f2bf(float f) { unsigned u = __float_as_uint(f); u += 0x7fffu + ((u >> 16) & 1u); return (bf16_t)(u >> 16); }
__device__ __forceinline__ float4 ld_nt4(const float* p) { typedef float f4v __attribute__((ext_vector_type(4))); const f4v v = __builtin_nontemporal_load((const f4v*)p); return make_float4(v[0], v[1], v[2], v[3]); }

__device__ __forceinline__ float lg2_head(int h) {
    const float x = __uint_as_float((unsigned)(127 - 5 - h) << 23);
    const float s = x * (1.f + x * (0.5f + x * (0.33333334f + x * (0.25f + x * (0.2f + x * 0.16666667f)))));
    return -s * 1.44269504089f;
}
struct RopeC { float fh[32], fl[32]; };
struct RetC { float lg2[8]; };

constexpr size_t MiB = 1u << 20;
constexpr size_t OFF_CTL = 0;
constexpr size_t CTL_BYTES = 64 * 1024;
constexpr size_t OFF_MOD = 64 * 1024, OFF_RINV1 = 128 * 1024, OFF_BIASF = 256 * 1024, OFF_ROPE = 1 * MiB;
constexpr size_t OFF_WINT = 6 * MiB;
constexpr size_t OFF_XB = 16 * MiB;
constexpr size_t OFF_YCAT = 160 * MiB;
constexpr size_t OFF_P = 48 * MiB;
constexpr size_t OFF_KV = 208 * MiB, OFF_ST = 224 * MiB;
constexpr size_t OFF_WEFFT = 240 * MiB;
constexpr size_t OFF_WOUTT = 13 * MiB;
constexpr size_t OFF_BIASQ = 272 * 1024;
constexpr size_t OFF_SWF = 320 * 1024;
constexpr size_t OFF_SQ = 336 * 1024;
constexpr size_t OFF_PMAX = 2 * MiB;
constexpr size_t OFF_RINV2Q = 3 * MiB;
constexpr size_t OFF_WEFFQ = 10 * MiB;
constexpr size_t OFF_X1Q = 16 * MiB;
constexpr int CTL_CNT = 4096, CTL_CMAX = 8192;
constexpr size_t OFF_XQ = 160 * MiB;
constexpr size_t OFF_DSC = 512 * 1024;
constexpr size_t OFF_BQPART = 576 * 1024;
constexpr size_t OFF_PART2 = 5 * MiB;
constexpr size_t OFF_X1B = 208 * MiB;
constexpr size_t OFF_IDS = 244 * MiB, OFF_GATES = 248 * MiB;
constexpr size_t OFF_Q8 = 192 * MiB;
constexpr int CONV_SPLIT = 0;
constexpr int LDS_BYTES = 163840;
constexpr int LDS_ST_OFF = LDS_BYTES - 16;

#define XB_TMO      128
#define XB_XCNT(j)  (256  + 64 * (j))
#define XB_XSUB(j)  (1280 + 64 * (j))
#define XB_XGEN(j)  (2304 + 64 * (j))
#define XB_TOP      3328
#define XB_TOPGEN   3392
#define XCD_BAR_WORDS 3456
#define XB_SPIN_CAP (1u << 20)
__device__ __forceinline__ unsigned xb_ld(unsigned* p)              { return __hip_atomic_load(p, __ATOMIC_RELAXED, __HIP_MEMORY_SCOPE_AGENT); }
__device__ __forceinline__ unsigned xb_add(unsigned* p, unsigned v) { return __hip_atomic_fetch_add(p, v, __ATOMIC_RELAXED, __HIP_MEMORY_SCOPE_AGENT); }
__device__ __forceinline__ unsigned xb_xcc_id() { return (unsigned)__builtin_amdgcn_s_getreg((3 << 11) | 20) & 0xFu; }
#define XB_SPIN(cond, bar) do { unsigned _sp = 0; while (cond) { __builtin_amdgcn_s_sleep(1); \
    if ((++_sp & 255u) == 0u) { if (xb_ld(&(bar)[XB_TMO])) break; if (_sp > XB_SPIN_CAP) { atomicAdd(&(bar)[XB_TMO], 1u); break; } } } } while (0)
struct XcdBarrier { unsigned* bar; unsigned x; volatile LAS unsigned* st; };
__device__ __forceinline__ XcdBarrier xcd_barrier_post(unsigned* bar, volatile LAS unsigned* st) {
    XcdBarrier b; b.bar = bar; b.x = xb_xcc_id(); b.st = st;
    if (threadIdx.x == 0) (void)xb_add(&bar[XB_XCNT(b.x)], 1u);
    return b;
}
__device__ __forceinline__ void xcd_barrier_complete(unsigned* bar, unsigned x, unsigned& nloc, unsigned& nx) {
    const unsigned G = gridDim.x * gridDim.y * gridDim.z;
    unsigned sum, cnt, mine, sp = 0u;
    for (;;) {
        sum = 0u; cnt = 0u; mine = 0u;
#pragma unroll
        for (unsigned j = 0; j < 16; ++j) { const unsigned c = xb_ld(&bar[XB_XCNT(j)]); sum += c; cnt += (c > 0u) ? 1u : 0u; mine = (j == x) ? c : mine; }
        if (sum == G) break;
        __builtin_amdgcn_s_sleep(1);
        if ((++sp & 255u) == 0u) { if (xb_ld(&bar[XB_TMO])) break; if (sp > XB_SPIN_CAP) { atomicAdd(&bar[XB_TMO], 1u); break; } }
    }
    nloc = mine > 0u ? mine : 1u; nx = cnt > 0u ? cnt : 1u;
}
__device__ __forceinline__ void xcd_barrier(const XcdBarrier& b) {
    asm volatile("s_waitcnt vmcnt(0)" ::: "memory");
    __syncthreads();
    if (threadIdx.x == 0) {
        unsigned* bar = b.bar;
        __builtin_amdgcn_s_waitcnt(0);
        unsigned nloc = b.st[0], nx = b.st[1];
        if (nloc == 0u) { xcd_barrier_complete(bar, b.x, nloc, nx); b.st[0] = nloc; b.st[1] = nx; }
        const unsigned old = xb_add(&bar[XB_XSUB(b.x)], 1u);
        const unsigned gen = old / nloc;
        if (old + 1u == (gen + 1u) * nloc) {
            __builtin_amdgcn_fence(__ATOMIC_RELEASE, "agent");
            asm volatile("s_waitcnt vmcnt(0)" ::: "memory");
            const unsigned og = xb_add(&bar[XB_TOP], 1u);
            const unsigned tg = og / nx;
            if (og + 1u == (tg + 1u) * nx) xb_add(&bar[XB_TOPGEN], 1u);
            else XB_SPIN(xb_ld(&bar[XB_TOPGEN]) == tg, bar);
            __builtin_amdgcn_fence(__ATOMIC_ACQUIRE, "agent");
            xb_add(&bar[XB_XGEN(b.x)], 1u);
            asm volatile("s_waitcnt vmcnt(0)" ::: "memory");
        } else {
            XB_SPIN(xb_ld(&bar[XB_XGEN(b.x)]) == gen, bar);
            __builtin_amdgcn_fence(__ATOMIC_ACQUIRE, "agent");
            asm volatile("s_waitcnt vmcnt(0)" ::: "memory");
        }
    }
    __syncthreads();
}


namespace pg8 {
#define PG8_LAS __attribute__((address_space(3)))
typedef short bf16x8 __attribute__((ext_vector_type(8)));
typedef float f32x4 __attribute__((ext_vector_type(4)));
typedef unsigned u32x4 __attribute__((ext_vector_type(4)));
typedef unsigned u32x2 __attribute__((ext_vector_type(2)));
constexpr int BM = 256, BK = 64, HALF = 128, HTB = HALF * BK * 2, STAGE_BYTES = 8 * HTB, NXCD = 8, WGM = 8;
__host__ __device__ __forceinline__ int lds_byte(int r, int c) { const int st = (r >> 4) * 2 + (c >> 5), rr = r & 15, cc = c & 31, ob = rr * 64 + cc * 2; return st * 1024 + (ob ^ (((ob >> 9) & 1) << 5)); }
__host__ __device__ __forceinline__ void stage_rc(int b, int& R, int& C) { const int st = b / 1024, sb = b % 1024, swz = sb ^ (((sb >> 9) & 1) << 5); R = (st >> 1) * 16 + swz / 64; C = (st & 1) * 32 + (swz % 64) / 2; }
__host__ __device__ __forceinline__ int perm32(int rho) { const int n = rho >> 4, i = rho & 15; return 8 * (i >> 2) + 4 * n + (i & 3); }
struct Unit { int pm, pn; };
struct Gemm { const bf16_t* A; const bf16_t* Bt; int M, N, K; };
struct StaticOrder {
    int nM, nN, nwg, G, c;
    __host__ __device__ void init(int M, int N, int G_, int c_) { nM = M / BM; nN = N / BM; nwg = nM * nN; G = G_; c = c_; }
    __host__ __device__ bool next(int i, Unit& u) const {
        const long L = (long)i * G + c; if (L >= nwg) return false;
        int wgid = (int)L; { const int q = nwg / NXCD, r = nwg % NXCD, xcd = wgid % NXCD, off = wgid / NXCD; wgid = (xcd < r ? xcd * (q + 1) : r * (q + 1) + (xcd - r) * q) + off; }
        const int nig = WGM * nN, gid = wgid / nig, fm = gid * WGM, gsz = (nM - fm) < WGM ? (nM - fm) : WGM;
        u.pm = fm + ((wgid % nig) % gsz); u.pn = (wgid % nig) / gsz; return true;
    }
    __device__ __forceinline__ void a_ready(const Unit&) const {}
    __device__ __forceinline__ void done(const Unit&) const {}
};
__device__ __forceinline__ unsigned cvt_pk_bf16(float lo, float hi) { unsigned r; asm volatile("v_cvt_pk_bf16_f32 %0, %1, %2" : "=v"(r) : "v"(lo), "v"(hi)); return r; }

typedef int i32x4 __attribute__((ext_vector_type(4)));
template <bool I8>
__device__ __forceinline__ f32x4 mma16(const bf16x8 b, const bf16x8 a, const f32x4 c) {
    if constexpr (I8) return __builtin_bit_cast(f32x4, __builtin_amdgcn_mfma_i32_16x16x64_i8(__builtin_bit_cast(i32x4, b), __builtin_bit_cast(i32x4, a), __builtin_bit_cast(i32x4, c), 0, 0, 0));
    else return __builtin_amdgcn_mfma_f32_16x16x32_bf16(b, a, c, 0, 0, 0);
}
template <class Epi, class Sched, bool I8 = false>
__device__ __forceinline__ void gemm_phase(PG8_LAS unsigned char* lds, const Gemm g, const Sched& S, const Epi& E) {
    int tid_ = threadIdx.x; asm volatile("" : "+v"(tid_));
    const int tid = tid_, wid = __builtin_amdgcn_readfirstlane(tid >> 6), lane = tid & 63, wr = wid >> 2, wc = wid & 3, fr = lane & 15, fq = lane >> 4;
    const int K = g.K, nt = K / BK;
    unsigned voffA[2], voffB[2];
#pragma unroll
    for (int i = 0; i < 2; ++i) { int R, C; stage_rc(tid * 16 + i * 8192, R, C); const int Rb = Epi::PERM ? ((R & ~31) + perm32(R & 31)) : R;
        voffA[i] = (unsigned)(R * K + C) * 2u; voffB[i] = (unsigned)(Rb * K + C) * 2u; }
    const size_t kstep = (size_t)(BK * 2);
    const size_t hstep = (size_t)HALF * K * 2;
    const size_t tstep = 2 * hstep;
    const unsigned ldsw = (unsigned)wid * 1024u;
    const int aoff = lds_byte(wr * 64 + fr, fq * 8), boff = lds_byte(wc * 32 + fr, fq * 8);
#define PG8_SA(b, h) (((b) * 2 + (h)) * HTB)
#define PG8_SB(b, h) ((4 + (b) * 2 + (h)) * HTB)
#define PG8_STAGE(bufoff, gbase, voff) do { _Pragma("unroll") for (int _i = 0; _i < 2; ++_i) \
        __builtin_amdgcn_global_load_lds((const unsigned*)((const char*)(gbase) + (voff)[_i]), (PG8_LAS unsigned*)(lds + (bufoff) + ldsw + _i * 8192), 16, 0, 0); } while (0)
#define PG8_LDA(dst, b, h) do { _Pragma("unroll") for (int m = 0; m < 4; ++m) _Pragma("unroll") for (int k = 0; k < 2; ++k) dst[m][k] = *(const PG8_LAS bf16x8*)(lds + PG8_SA(b, h) + aoff + m * 2048 + k * 1024); } while (0)
#define PG8_LDB(dst, b, h) do { _Pragma("unroll") for (int n = 0; n < 2; ++n) _Pragma("unroll") for (int k = 0; k < 2; ++k) dst[n][k] = *(const PG8_LAS bf16x8*)(lds + PG8_SB(b, h) + boff + n * 2048 + k * 1024); } while (0)
#define PG8_MMA(ai, bj, At, Bt) do { __builtin_amdgcn_s_setprio(1); _Pragma("unroll") for (int m = 0; m < 4; ++m) _Pragma("unroll") for (int n = 0; n < 2; ++n) _Pragma("unroll") for (int k = 0; k < 2; ++k) \
        acc[ai][bj][m][n] = mma16<I8>(Bt[n][k], At[m][k], acc[ai][bj][m][n]); __builtin_amdgcn_s_setprio(0); } while (0)
#define PG8_WAIT_V(n) asm volatile("s_waitcnt vmcnt(" #n ")" ::: "memory")
#define PG8_WAIT_L(n) asm volatile("s_waitcnt lgkmcnt(" #n ")" ::: "memory")
#define PG8_BAR __builtin_amdgcn_s_barrier()
#define PG8_SCHED __builtin_amdgcn_sched_barrier(0)
    Unit cur, nxt; int ui = 0;
    if (!S.next(0, cur)) return;
    f32x4 acc[2][2][4][2];
#pragma unroll
    for (int a = 0; a < 2; ++a)
#pragma unroll
        for (int b = 0; b < 2; ++b)
#pragma unroll
            for (int m = 0; m < 4; ++m)
#pragma unroll
                for (int n = 0; n < 2; ++n) acc[a][b][m][n] = (f32x4){0.f, 0.f, 0.f, 0.f};
    bf16x8 At[4][2], B0[2][2], B1[2][2];
    const char* cA = (const char*)g.A + (size_t)cur.pm * tstep; const char* cB = (const char*)g.Bt + (size_t)cur.pn * tstep;
    S.a_ready(cur);
    PG8_STAGE(PG8_SB(0, 0), cB, voffB); PG8_STAGE(PG8_SA(0, 0), cA, voffA); PG8_STAGE(PG8_SB(0, 1), cB + hstep, voffB); PG8_STAGE(PG8_SA(0, 1), cA + hstep, voffA);
    if (wr == 1) PG8_BAR;
    PG8_WAIT_V(4); PG8_BAR;
    PG8_STAGE(PG8_SB(1, 0), cB + kstep, voffB); PG8_STAGE(PG8_SA(1, 0), cA + kstep, voffA); PG8_STAGE(PG8_SB(1, 1), cB + hstep + kstep, voffB);
    PG8_WAIT_V(6); PG8_BAR;
    for (;;) {
        const bool has_next = S.next(ui + 1, nxt);
        const char* nA = has_next ? (const char*)g.A + (size_t)nxt.pm * tstep : cA; const char* nB = has_next ? (const char*)g.Bt + (size_t)nxt.pn * tstep : cB;
        for (int t = 0; t < nt; t += 2) {
            const bool last = (t == nt - 2);
            const char* a1 = cA + (size_t)(t + 1) * kstep;
            const char* a2 = last ? nA : cA + (size_t)(t + 2) * kstep; const char* b2 = last ? nB : cB + (size_t)(t + 2) * kstep;
            const char* a3 = a2 + kstep; const char* b3 = b2 + kstep;
            if (last && has_next) S.a_ready(nxt);
            PG8_LDB(B0, 0, 0); PG8_SCHED; PG8_LDA(At, 0, 0); PG8_STAGE(PG8_SA(1, 1), a1 + hstep, voffA);
            PG8_WAIT_L(8); PG8_BAR; PG8_WAIT_L(0); PG8_MMA(0, 0, At, B0); PG8_BAR; PG8_SCHED;
            PG8_LDB(B1, 0, 1); PG8_STAGE(PG8_SB(0, 0), b2, voffB);
            PG8_BAR; PG8_WAIT_L(0); PG8_MMA(0, 1, At, B1); PG8_BAR;
            PG8_LDA(At, 0, 1); PG8_STAGE(PG8_SA(0, 0), a2, voffA);
            PG8_BAR; PG8_WAIT_L(0); PG8_MMA(1, 0, At, B0); PG8_BAR; PG8_SCHED;
            PG8_STAGE(PG8_SB(0, 1), b2 + hstep, voffB);
            PG8_WAIT_V(6); PG8_BAR; PG8_MMA(1, 1, At, B1); PG8_BAR;
            PG8_LDB(B0, 1, 0); PG8_SCHED; PG8_LDA(At, 1, 0); PG8_STAGE(PG8_SA(0, 1), a2 + hstep, voffA);
            PG8_WAIT_L(8); PG8_BAR; PG8_WAIT_L(0); PG8_MMA(0, 0, At, B0); PG8_BAR; PG8_SCHED;
            PG8_LDB(B1, 1, 1); PG8_STAGE(PG8_SB(1, 0), b3, voffB);
            PG8_BAR; PG8_WAIT_L(0); PG8_MMA(0, 1, At, B1); PG8_BAR;
            PG8_LDA(At, 1, 1); PG8_STAGE(PG8_SA(1, 0), a3, voffA);
            PG8_BAR; PG8_WAIT_L(0); PG8_MMA(1, 0, At, B0); PG8_BAR; PG8_SCHED;
            PG8_STAGE(PG8_SB(1, 1), b3 + hstep, voffB);
            PG8_WAIT_V(6); PG8_BAR; PG8_MMA(1, 1, At, B1); PG8_BAR;
        }
        if constexpr (!Epi::AFTER_DRAIN) { E(acc, cur, wr, wc, fr, fq); S.done(cur); }
        if (!has_next) break;
#pragma unroll
        for (int a = 0; a < 2; ++a)
#pragma unroll
            for (int b = 0; b < 2; ++b)
#pragma unroll
                for (int m = 0; m < 4; ++m)
#pragma unroll
                    for (int n = 0; n < 2; ++n) acc[a][b][m][n] = (f32x4){0.f, 0.f, 0.f, 0.f};
        cur = nxt; cA = nA; cB = nB; ++ui;
    }
    PG8_WAIT_V(0);
    if (wr == 0) PG8_BAR;
    PG8_BAR;
    if constexpr (Epi::AFTER_DRAIN) { E.fused(acc, cur, wr, wc, fr, fq, lds, wid, lane); S.done(cur); }
#undef PG8_SA
#undef PG8_SB
#undef PG8_STAGE
#undef PG8_LDA
#undef PG8_LDB
#undef PG8_MMA
#undef PG8_WAIT_V
#undef PG8_WAIT_L
#undef PG8_BAR
#undef PG8_SCHED
}
}

__host__ __device__ __forceinline__ int cmap_in(int F) { return (F & ~255) + 128 * ((F >> 5) & 1) + 32 * ((F >> 6) & 3) + (F & 31); }
struct EpiInprojMF {
    static constexpr bool PERM = true, AFTER_DRAIN = false;
    bf16_t* P; const float* rinv; const float* bias_f; const int* pos; const float* ftab; const float* qg; const float* kg; const float* swf;
    __device__ __forceinline__ void operator()(pg8::f32x4 (&acc)[2][2][4][2], const pg8::Unit& u, int wr, int wc, int fr, int fq) const {
        typedef pg8::f32x4 f32x4;
        asm volatile("" : "+v"(fr), "+v"(fq));
        const int type = u.pn >> 1, head = 4 * (u.pn & 1) + wc, fb = 256 * u.pn + 64 * wc;
        {
            f32x4 sw[2][2];
#pragma unroll
            for (int bj = 0; bj < 2; ++bj)
#pragma unroll
                for (int n = 0; n < 2; ++n) sw[bj][n] = *(const f32x4*)(swf + fb + 32 * bj + 8 * fq + 4 * n);
#pragma unroll
            for (int ai = 0; ai < 2; ++ai)
#pragma unroll
                for (int bj = 0; bj < 2; ++bj)
#pragma unroll
                    for (int m = 0; m < 4; ++m)
#pragma unroll
                        for (int n = 0; n < 2; ++n) {
                            const pg8::i32x4 iv = __builtin_bit_cast(pg8::i32x4, acc[ai][bj][m][n]);
                            f32x4 fv; fv[0] = (float)iv[0]; fv[1] = (float)iv[1]; fv[2] = (float)iv[2]; fv[3] = (float)iv[3];
                            acc[ai][bj][m][n] = fv * sw[bj][n];
                        }
        }
        const size_t PSZ = (size_t)T * 512;
        const int rslot = (type == 0) ? 0 : (type == 1) ? 1 : (type == 2) ? 5 : (type == 3) ? 2 : (type == 4) ? 3 : (type == 5) ? 4 : 6;
        bf16_t* rowmaj = P + (size_t)rslot * PSZ;
        const int t0 = u.pm * 256 + wr * 64 + fr;
        f32x4 bv[2][2], gv[2][2], fh[2], fl[2];
#pragma unroll
        for (int bj = 0; bj < 2; ++bj)
#pragma unroll
            for (int n = 0; n < 2; ++n) bv[bj][n] = *(const f32x4*)(bias_f + fb + 32 * bj + 8 * fq + 4 * n);
        if (type <= 1) {
#pragma unroll
            for (int n = 0; n < 2; ++n) { fh[n] = *(const f32x4*)(ftab + 8 * fq + 4 * n); fl[n] = *(const f32x4*)(ftab + 32 + 8 * fq + 4 * n); }
        } else if (type == 4 || type == 5) {
            const float* gsrc = (type == 4) ? qg : kg;
#pragma unroll
            for (int bj = 0; bj < 2; ++bj)
#pragma unroll
                for (int n = 0; n < 2; ++n) gv[bj][n] = *(const f32x4*)(gsrc + 32 * bj + 8 * fq + 4 * n);
        }
#pragma unroll
        for (int ai = 0; ai < 2; ++ai) {
            float rv[4], pf[4];
#pragma unroll
            for (int m = 0; m < 4; ++m) { rv[m] = rinv[t0 + ai * 128 + m * 16]; pf[m] = (float)pos[t0 + ai * 128 + m * 16]; }
            asm volatile("" : "+v"(rv[0]), "+v"(rv[1]), "+v"(rv[2]), "+v"(rv[3]), "+v"(pf[0]), "+v"(pf[1]), "+v"(pf[2]), "+v"(pf[3]));
#pragma unroll
            for (int m = 0; m < 4; ++m) {
                const int t = t0 + ai * 128 + m * 16;
                const float r = rv[m];
                f32x4 v[2][2];
#pragma unroll
                for (int bj = 0; bj < 2; ++bj)
#pragma unroll
                    for (int n = 0; n < 2; ++n) v[bj][n] = acc[ai][bj][m][n] * r + bv[bj][n];
                if (type <= 1) {
                    const float sc = (type == 1) ? 0.125f : 1.f, pp = pf[m];
#pragma unroll
                    for (int n = 0; n < 2; ++n)
#pragma unroll
                        for (int j = 0; j < 4; ++j) {
                            const float rev = __builtin_amdgcn_fractf(__builtin_amdgcn_fractf(pp * fh[n][j]) + pp * fl[n][j]);
                            const float cs = __builtin_amdgcn_cosf(rev) * sc, sn = __builtin_amdgcn_sinf(rev) * sc;
                            const float x1 = v[0][n][j], x2 = v[1][n][j]; v[0][n][j] = x1 * cs - x2 * sn; v[1][n][j] = x2 * cs + x1 * sn;
                        }
                } else if (type == 3) {
#pragma unroll
                    for (int bj = 0; bj < 2; ++bj)
#pragma unroll
                        for (int n = 0; n < 2; ++n)
#pragma unroll
                            for (int j = 0; j < 4; ++j) { const float x = v[bj][n][j]; v[bj][n][j] = x / (1.f + __expf(-x)); }
                } else if (type == 4 || type == 5) {
                    float ss = 0.f;
#pragma unroll
                    for (int bj = 0; bj < 2; ++bj)
#pragma unroll
                        for (int n = 0; n < 2; ++n)
#pragma unroll
                            for (int j = 0; j < 4; ++j) ss += v[bj][n][j] * v[bj][n][j];
                    ss += __shfl_xor(ss, 16); ss += __shfl_xor(ss, 32);
                    const float rn = (1.0f / sqrtf(ss * (1.f / 64.f) + EPS)) * ((type == 4) ? 0.125f * 1.44269504089f : 1.f);
#pragma unroll
                    for (int bj = 0; bj < 2; ++bj)
#pragma unroll
                        for (int n = 0; n < 2; ++n) v[bj][n] = v[bj][n] * rn * gv[bj][n];
                }
#pragma unroll
                for (int bj = 0; bj < 2; ++bj) {
                    pg8::u32x4 w; w.x = pg8::cvt_pk_bf16(v[bj][0][0], v[bj][0][1]); w.y = pg8::cvt_pk_bf16(v[bj][0][2], v[bj][0][3]);
                    w.z = pg8::cvt_pk_bf16(v[bj][1][0], v[bj][1][1]); w.w = pg8::cvt_pk_bf16(v[bj][1][2], v[bj][1][3]);
                    *(pg8::u32x4*)(rowmaj + (size_t)t * 512 + head * 64 + 32 * bj + 8 * fq) = w;
                }
            }
        }
    }
};

struct EpiOutprojMF {
    static constexpr bool PERM = false, AFTER_DRAIN = true;
    const float* xf; const float* gate1; bf16_t* x1b; float* part2;
    float* pmax; unsigned char* x1q; float* rinv2q; unsigned* ctl;
    __device__ __forceinline__ void operator()(const pg8::f32x4 (&)[2][2][4][2], const pg8::Unit&, int, int, int, int) const {}
    __device__ __forceinline__ void fused(pg8::f32x4 (&acc)[2][2][4][2], const pg8::Unit& u, int wr, int wc, int fr, int fq, PG8_LAS unsigned char* lds, int wid, int lane) const {
        typedef pg8::f32x4 f32x4;
        asm volatile("" : "+v"(fr), "+v"(fq), "+v"(lane));
        constexpr int LD = 260;
        PG8_LAS float* TL = (PG8_LAS float*)lds;
        const int colw = wc * 32 + 4 * fq;
        f32x4 gv[2][2];
#pragma unroll
        for (int bj = 0; bj < 2; ++bj)
#pragma unroll
            for (int n = 0; n < 2; ++n) gv[bj][n] = *(const f32x4*)(gate1 + u.pn * 256 + colw + bj * 128 + n * 16);
        pg8::u32x2 ow[2][16];
#pragma unroll
        for (int ai = 0; ai < 2; ++ai) {
            f32x4 xv[16];
            const size_t rowbase = (size_t)(u.pm * 256 + ai * 128 + 16 * wid) * D + u.pn * 256 + 4 * lane;
#pragma unroll
            for (int r = 0; r < 16; ++r) xv[r] = __builtin_nontemporal_load((const f32x4*)(xf + rowbase + (size_t)r * D));
#pragma unroll
            for (int m = 0; m < 4; ++m)
#pragma unroll
                for (int bj = 0; bj < 2; ++bj)
#pragma unroll
                    for (int n = 0; n < 2; ++n) *(PG8_LAS f32x4*)(TL + (64 * wr + 16 * m + fr) * LD + colw + bj * 128 + n * 16) = gv[bj][n] * acc[ai][bj][m][n];
            __syncthreads();
            float ssr[16], amr[16];
#pragma unroll
            for (int r = 0; r < 16; ++r) {
                const f32x4 g = *(PG8_LAS f32x4*)(TL + (16 * wid + r) * LD + 4 * lane);
                const f32x4 o = xv[r] + g;
                pg8::u32x2 w; w.x = pg8::cvt_pk_bf16(o[0], o[1]); w.y = pg8::cvt_pk_bf16(o[2], o[3]);
                *(pg8::u32x2*)(x1b + rowbase + (size_t)r * D) = w;
                ow[ai][r] = w;
                ssr[r] = o[0] * o[0] + o[1] * o[1] + o[2] * o[2] + o[3] * o[3];
                amr[r] = fmaxf(fmaxf(__uint_as_float((w.x << 16) & 0x7fffffffu), __uint_as_float(w.x & 0x7fff0000u)), fmaxf(__uint_as_float((w.y << 16) & 0x7fffffffu), __uint_as_float(w.y & 0x7fff0000u)));
            }
            {
                const bool b5 = lane & 32, b4 = lane & 16, b3 = lane & 8, b2 = lane & 4;
                float w8[8], w4[4], w2[2], w1;
#pragma unroll
                for (int i = 0; i < 8; ++i) w8[i] = (b5 ? ssr[8 + i] : ssr[i]) + __shfl_xor(b5 ? ssr[i] : ssr[8 + i], 32);
#pragma unroll
                for (int i = 0; i < 4; ++i) w4[i] = (b4 ? w8[4 + i] : w8[i]) + __shfl_xor(b4 ? w8[i] : w8[4 + i], 16);
#pragma unroll
                for (int i = 0; i < 2; ++i) w2[i] = (b3 ? w4[2 + i] : w4[i]) + __shfl_xor(b3 ? w4[i] : w4[2 + i], 8);
                w1 = (b2 ? w2[1] : w2[0]) + __shfl_xor(b2 ? w2[0] : w2[1], 4);
                w1 += __shfl_xor(w1, 2); w1 += __shfl_xor(w1, 1);
                part2[(size_t)(u.pm * 256 + ai * 128 + 16 * wid + (lane >> 2)) * 16 + u.pn * 4 + (lane & 3)] = ((lane & 3) == 0) ? w1 : 0.f;
#pragma unroll
                for (int i = 0; i < 8; ++i) w8[i] = fmaxf(b5 ? amr[8 + i] : amr[i], __shfl_xor(b5 ? amr[i] : amr[8 + i], 32));
#pragma unroll
                for (int i = 0; i < 4; ++i) w4[i] = fmaxf(b4 ? w8[4 + i] : w8[i], __shfl_xor(b4 ? w8[i] : w8[4 + i], 16));
#pragma unroll
                for (int i = 0; i < 2; ++i) w2[i] = fmaxf(b3 ? w4[2 + i] : w4[i], __shfl_xor(b3 ? w4[i] : w4[2 + i], 8));
                w1 = fmaxf(b2 ? w2[1] : w2[0], __shfl_xor(b2 ? w2[0] : w2[1], 4));
                w1 = fmaxf(w1, __shfl_xor(w1, 2)); w1 = fmaxf(w1, __shfl_xor(w1, 1));
                if ((lane & 3) == 0) pmax[(size_t)(u.pm * 256 + ai * 128 + 16 * wid + (lane >> 2)) * 4 + u.pn] = w1;
            }
            __syncthreads();
        }
        asm volatile("s_waitcnt vmcnt(0)" ::: "memory");
        __syncthreads();
        if (wid == 0 && lane == 0) {
            unsigned* c = ctl + CTL_CNT + 16 * u.pm;
            __builtin_amdgcn_fence(__ATOMIC_RELEASE, "agent");
            asm volatile("s_waitcnt vmcnt(0)" ::: "memory");
            (void)xb_add(c, 1u);
            XB_SPIN(xb_ld(c) < 4u, ctl);
            __builtin_amdgcn_fence(__ATOMIC_ACQUIRE, "agent");
        }
        __syncthreads();
        float qsl = 0.f;
        {
            const int row = u.pm * 256 + (lane >> 4 & 1) * 128 + 16 * wid + (lane & 15);
            const f32x4* pp = (const f32x4*)(part2 + (size_t)row * 16);
            const f32x4 p0 = pp[0], p1 = pp[1], p2 = pp[2], p3 = pp[3], pm4 = *(const f32x4*)(pmax + (size_t)row * 4);
            const float ssum = ((p0[0] + p0[1]) + (p0[2] + p0[3])) + ((p1[0] + p1[1]) + (p1[2] + p1[3])) + ((p2[0] + p2[1]) + (p2[2] + p2[3])) + ((p3[0] + p3[1]) + (p3[2] + p3[3]));
            const float am = fmaxf(fmaxf(pm4[0], pm4[1]), fmaxf(pm4[2], pm4[3]));
            qsl = (am > 0.f) ? 127.f / am : 0.f;
            if (u.pn == 0 && lane < 32) rinv2q[row] = (1.0f / sqrtf(ssum * (1.0f / D) + EPS)) * (am * (1.f / 127.f));
        }
#pragma unroll
        for (int ai = 0; ai < 2; ++ai)
#pragma unroll
            for (int r = 0; r < 16; ++r) {
                const float qs = __builtin_bit_cast(float, __builtin_amdgcn_readlane(__builtin_bit_cast(int, qsl), ai * 16 + r));
                const pg8::u32x2 w = ow[ai][r];
                const unsigned b0 = __float_as_uint(fmaf(__uint_as_float(w.x << 16), qs, 12582912.f)), b1 = __float_as_uint(fmaf(__uint_as_float(w.x & 0xffff0000u), qs, 12582912.f));
                const unsigned b2 = __float_as_uint(fmaf(__uint_as_float(w.y << 16), qs, 12582912.f)), b3 = __float_as_uint(fmaf(__uint_as_float(w.y & 0xffff0000u), qs, 12582912.f));
                *(unsigned*)(x1q + (size_t)(u.pm * 256 + ai * 128 + 16 * wid + r) * D + u.pn * 256 + 4 * lane) = (b0 & 255u) | ((b1 & 255u) << 8) | ((b2 & 255u) << 16) | (b3 << 24);
            }
    }
};

__device__ __forceinline__ unsigned pk2(float lo, float hi) { return (unsigned)f2bf(lo) | ((unsigned)f2bf(hi) << 16); }
template <bool FOLD, bool CMAP>
__device__ __forceinline__ void transpose_item(const float* W, int K, int N, bf16_t* WT, float* scr, int item, int lane, const float* sg, const float* sm) {
    const int nblk = N / 32, kb = item / nblk, nb = item % nblk, k0 = 64 * kb, n0 = 32 * nb;
    float4 v[8]; float f[8];
#pragma unroll
    for (int i = 0; i < 8; ++i) { const int kk = 8 * i + (lane >> 3); v[i] = *(const float4*)(W + (size_t)(k0 + kk) * N + n0 + 4 * (lane & 7));
        f[i] = FOLD ? sg[k0 + kk] * (1.f + sm[k0 + kk]) : 1.f; }
#pragma unroll
    for (int i = 0; i < 8; ++i) { const int kk = 8 * i + (lane >> 3); float* d = scr + kk * 33 + 4 * (lane & 7);
        d[0] = v[i].x * f[i]; d[1] = v[i].y * f[i]; d[2] = v[i].z * f[i]; d[3] = v[i].w * f[i]; }
    asm volatile("s_waitcnt lgkmcnt(0)" ::: "memory");
    const int c = lane & 7, r0 = CMAP ? cmap_in(n0) : n0;
#pragma unroll
    for (int j = 0; j < 4; ++j) { const int n = (lane >> 3) + 8 * j; const float* s = scr + (8 * c) * 33 + n;
        pg8::u32x4 o; o.x = pk2(s[0 * 33], s[1 * 33]); o.y = pk2(s[2 * 33], s[3 * 33]); o.z = pk2(s[4 * 33], s[5 * 33]); o.w = pk2(s[6 * 33], s[7 * 33]);
        *(pg8::u32x4*)(WT + (size_t)(r0 + n) * K + k0 + 8 * c) = o; }
    asm volatile("s_waitcnt lgkmcnt(0)" ::: "memory");
}
template <int NC4, class VF>
__device__ __forceinline__ void gemv_cols(unsigned char* lds, const VF vf, const float* W, const int N, const int u, float* dst, const float* add) {
    constexpr int RG = 512 / NC4;
    float (*red)[NC4 * 4] = (float (*)[NC4 * 4])lds;
    const int tid = threadIdx.x, c4 = tid % NC4, rg = tid / NC4;
    if (rg < RG) {
        float4 acc = {0.f, 0.f, 0.f, 0.f};
        for (int r = rg; r < 1024; r += RG) { const float s = vf(r); const float4 w = *(const float4*)(W + (size_t)r * N + u * NC4 * 4 + c4 * 4);
            acc.x += s * w.x; acc.y += s * w.y; acc.z += s * w.z; acc.w += s * w.w; }
        red[rg][c4 * 4 + 0] = acc.x; red[rg][c4 * 4 + 1] = acc.y; red[rg][c4 * 4 + 2] = acc.z; red[rg][c4 * 4 + 3] = acc.w;
    }
    __syncthreads();
    if (tid < NC4 * 4) { float s = 0.f; for (int i = 0; i < RG; ++i) s += red[i][tid]; dst[u * NC4 * 4 + tid] = s + (add ? add[u * NC4 * 4 + tid] : 0.f); }
    __syncthreads();
}
struct VfSilu { const float* c; __device__ __forceinline__ float operator()(int r) const { const float v = c[r]; return v / (1.f + expf(-v)); } };
struct VfVec { const float* v; __device__ __forceinline__ float operator()(int r) const { return v[r]; } };


typedef float f32x16 __attribute__((ext_vector_type(16)));
typedef pg8::bf16x8 bf16x8;
#define MFMA32(a, b, c) __builtin_amdgcn_mfma_f32_32x32x16_bf16((a), (b), (c), 0, 0, 0)
__device__ __forceinline__ bf16x8 pack_frag(const f32x16& v, int s) {
    pg8::u32x4 w;
    w.x = pg8::cvt_pk_bf16(v[8 * s + 0], v[8 * s + 1]); w.y = pg8::cvt_pk_bf16(v[8 * s + 2], v[8 * s + 3]);
    w.z = pg8::cvt_pk_bf16(v[8 * s + 4], v[8 * s + 5]); w.w = pg8::cvt_pk_bf16(v[8 * s + 6], v[8 * s + 7]);
    return __builtin_bit_cast(bf16x8, w);
}
__device__ __forceinline__ bf16x8 load_tfrag(const bf16_t* rowp, int tok) {
    const uint2 a = *(const uint2*)(rowp + tok), b = *(const uint2*)(rowp + tok + 8);
    pg8::u32x4 w; w.x = a.x; w.y = a.y; w.z = b.x; w.w = b.y;
    return __builtin_bit_cast(bf16x8, w);
}


__device__ __forceinline__ bf16x8 tr_frag(const unsigned char* a0, int rows2) {
    typedef short s16x4 __attribute__((ext_vector_type(4)));
    typedef __attribute__((address_space(3))) s16x4 lds_s16x4;
    const s16x4 lo = __builtin_amdgcn_ds_read_tr16_b64_v4i16((lds_s16x4*)a0);
    const s16x4 hi = __builtin_amdgcn_ds_read_tr16_b64_v4i16((lds_s16x4*)(a0 + rows2 * 144));
    const uint2 l2 = __builtin_bit_cast(uint2, lo), h2 = __builtin_bit_cast(uint2, hi);
    pg8::u32x4 fw; fw.x = l2.x; fw.y = l2.y; fw.z = h2.x; fw.w = h2.y;
    return __builtin_bit_cast(bf16x8, fw);
}

__device__ __forceinline__ void ins16(float (&s)[16], float x) {
#pragma unroll
    for (int i = 15; i >= 1; --i) s[i] = __builtin_amdgcn_fmed3f(s[i - 1], s[i], x);
    s[0] = fmaxf(s[0], x);
}


struct OneUnitOrder {
    pg8::StaticOrder base; int round;
    __device__ __forceinline__ bool next(int i, pg8::Unit& u) const { if (i != 0) return false; return base.next(round, u); }
    __device__ __forceinline__ void a_ready(const pg8::Unit&) const {}
    __device__ __forceinline__ void done(const pg8::Unit&) const {}
};
struct EpiTopkMF {
    static constexpr bool PERM = false, AFTER_DRAIN = true;
    const float* rinv2q; const float* sq; const float* bias_q; unsigned short* ids; float* gates;
    __device__ __forceinline__ void operator()(const pg8::f32x4 (&)[2][2][4][2], const pg8::Unit&, int, int, int, int) const {}
    __device__ __forceinline__ void fused(pg8::f32x4 (&acc)[2][2][4][2], const pg8::Unit& u, int wr, int wc, int fr, int fq, PG8_LAS unsigned char* lds, int wid, int lane) const {
        typedef pg8::f32x4 f32x4;
        constexpr int SLD = 260;
        PG8_LAS float* SC = (PG8_LAS float*)lds; PG8_LAS float* MG = (PG8_LAS float*)(lds + 128 * SLD * 4);
        const int tid = wid * 64 + lane, tok = tid & 255, hk = tid >> 8;
        float rinv[2][4];
#pragma unroll
        for (int ai = 0; ai < 2; ++ai)
#pragma unroll
            for (int m = 0; m < 4; ++m) {
                const int row = u.pm * 256 + ai * 128 + wr * 64 + m * 16 + fr;
                rinv[ai][m] = rinv2q[row];
            }
        float sl[16], mine[16];
#pragma unroll
        for (int p = 0; p < 2; ++p) {
            f32x4 bv[2], sv[2];
#pragma unroll
            for (int n = 0; n < 2; ++n) { bv[n] = *(const f32x4*)(bias_q + u.pn * 256 + p * 128 + wc * 32 + n * 16 + 4 * fq); sv[n] = *(const f32x4*)(sq + u.pn * 256 + p * 128 + wc * 32 + n * 16 + 4 * fq); }
#pragma unroll
            for (int ai = 0; ai < 2; ++ai)
#pragma unroll
                for (int m = 0; m < 4; ++m)
#pragma unroll
                    for (int n = 0; n < 2; ++n)
#pragma unroll
                        for (int j = 0; j < 4; ++j)
                            SC[(32 * wc + 16 * n + 4 * fq + j) * SLD + (128 * ai + 64 * wr + 16 * m + fr)] = (float)__builtin_bit_cast(pg8::i32x4, acc[ai][p][m][n])[j] * (rinv[ai][m] * sv[n][j]) + bv[n][j];
            __syncthreads();
#pragma unroll
            for (int i = 0; i < 16; ++i) sl[i] = -INFINITY;
#pragma unroll 8
            for (int k = 0; k < 64; ++k) { const int key = 64 * hk + k; const float x = SC[key * SLD + tok]; ins16(sl, __uint_as_float((__float_as_uint(x) & 0xFFFFFF80u) | (unsigned)key)); }
            if (hk != p) {
#pragma unroll
                for (int i = 0; i < 16; ++i) MG[i * 256 + tok] = sl[i];
            }
            __syncthreads();
            if (hk == p) {
#pragma unroll
                for (int i = 0; i < 16; ++i) ins16(sl, MG[i * 256 + tok]);
#pragma unroll
                for (int i = 0; i < 16; ++i) mine[i] = sl[i];
            }
            __syncthreads();
        }
        PG8_LAS float* X1 = SC; PG8_LAS float* TL = SC + 4096; PG8_LAS unsigned* I0 = (PG8_LAS unsigned*)(SC + 8192); PG8_LAS unsigned* I1 = (PG8_LAS unsigned*)(SC + 12288);
        if (hk) {
#pragma unroll
            for (int i = 0; i < 16; ++i) { X1[i * 256 + tok] = mine[i]; I1[i * 256 + tok] = __float_as_uint(mine[i]) & 0x7Fu; }
        } else {
#pragma unroll
            for (int i = 0; i < 16; ++i) I0[i * 256 + tok] = __float_as_uint(mine[i]) & 0x7Fu;
        }
        __syncthreads();
        if (!hk) {
            float s1m[16], tl[16];
#pragma unroll
            for (int i = 0; i < 16; ++i) { s1m[i] = __uint_as_float(__float_as_uint(X1[i * 256 + tok]) & 0xFFFFFF80u); mine[i] = __uint_as_float(__float_as_uint(mine[i]) & 0xFFFFFF80u); tl[i] = -INFINITY; }
#pragma unroll
            for (int a2 = 0; a2 < 16; ++a2)
#pragma unroll
                for (int b2 = 0; b2 < 16; ++b2)
                    if ((a2 + 1) * (b2 + 1) <= 16) ins16(tl, __uint_as_float((__float_as_uint(mine[a2] + s1m[b2]) & 0xFFFFFF00u) | (unsigned)(a2 * 16 + b2)));
#pragma unroll
            for (int i = 0; i < 16; ++i) TL[i * 256 + tok] = tl[i];
        }
        __syncthreads();
        if (hk) {
            float ev[16]; float sum = 0.f; unsigned cd[16];
#pragma unroll
            for (int j = 0; j < 16; ++j) { const unsigned bits = __float_as_uint(TL[j * 256 + tok]); cd[j] = bits & 0xFFu; ev[j] = __uint_as_float(bits & 0xFFFFFF00u); }
            const float mx = ev[0];
#pragma unroll
            for (int j = 0; j < 16; ++j) { ev[j] = __expf(ev[j] - mx); sum += ev[j]; }
            const float inv = 1.f / sum;
            unsigned idw[8];
#pragma unroll
            for (int j = 0; j < 16; ++j) {
                const unsigned id = I0[(cd[j] >> 4) * 256 + tok] * 128u + I1[(cd[j] & 15u) * 256 + tok];
                if (j & 1) idw[j >> 1] |= id << 16; else idw[j >> 1] = id;
                ev[j] *= inv;
            }
            const size_t t = (size_t)u.pm * 256 + tok;
            unsigned short* idp = ids + t * 128 + u.pn * 16; float* gp = gates + t * 128 + u.pn * 16;
            *(uint4*)idp = make_uint4(idw[0], idw[1], idw[2], idw[3]); *(uint4*)(idp + 8) = make_uint4(idw[4], idw[5], idw[6], idw[7]);
#pragma unroll
            for (int q = 0; q < 4; ++q) *(float4*)(gp + 4 * q) = make_float4(ev[4 * q], ev[4 * q + 1], ev[4 * q + 2], ev[4 * q + 3]);
        }
        __syncthreads();
    }
};


__device__ __forceinline__ void convert_tables(const float* down, const float* up, unsigned char* q8, bf16_t* dsc, int lane, int cw, int nconv, int r0, int r1) {
    for (int row0 = r0 + cw * 2; row0 < r1; row0 += nconv * 2) {
        float4 v[2][4];
#pragma unroll
        for (int rr = 0; rr < 2; ++rr) {
            const int row = row0 + rr, isup = row >> 14, e = row & 16383;
            const float* sp = (isup ? up : down) + (size_t)e * 1024 + lane * 4;
#pragma unroll
            for (int q = 0; q < 4; ++q) v[rr][q] = ld_nt4(sp + 256 * q);
        }
#pragma unroll
        for (int rr = 0; rr < 2; ++rr) {
            const int row = row0 + rr, isup = row >> 14, e = row & 16383;
            {
                float ss = 0.f;
#pragma unroll
                for (int q = 0; q < 4; ++q) ss += v[rr][q].x * v[rr][q].x + v[rr][q].y * v[rr][q].y + v[rr][q].z * v[rr][q].z + v[rr][q].w * v[rr][q].w;
#pragma unroll
                for (int o = 32; o > 0; o >>= 1) ss += __shfl_xor(ss, o);
                const float sigma = sqrtf(ss * (1.0f / 1024.0f));
                const float s = (sigma > 0.f) ? 7.5f / (2.6f * sigma) : 1.f;
#pragma unroll
                for (int q = 0; q < 4; ++q) {
                    const int n0 = (int)fminf(fmaxf(__builtin_rintf(v[rr][q].x * s), -8.f), 7.f) + 8, n1 = (int)fminf(fmaxf(__builtin_rintf(v[rr][q].y * s), -8.f), 7.f) + 8;
                    const int n2 = (int)fminf(fmaxf(__builtin_rintf(v[rr][q].z * s), -8.f), 7.f) + 8, n3 = (int)fminf(fmaxf(__builtin_rintf(v[rr][q].w * s), -8.f), 7.f) + 8;
                    const int h1 = isup ? ((n1 - 8) & 15) : n1, h3 = isup ? ((n3 - 8) & 15) : n3;
                    *(unsigned short*)(q8 + (size_t)isup * (8u << 20) + ((size_t)q * 16384 + e) * 128 + (lane & 7) * 16 + (lane >> 3) * 2) = (unsigned short)(n0 | (h1 << 4) | (n2 << 8) | (h3 << 12));
                }
                if (lane == 0) dsc[row] = f2bf(1.0f / s);
            }
        }
    }
}

struct Params {
    const float *x, *c; const int* pos; const float *ada_w, *ada_b, *g1, *g2, *w_in, *rgain, *qg, *kg, *og, *w_out, *wq, *sk, *down, *up;
    float* out; unsigned char* ws; RopeC rc;
};

__global__ void __launch_bounds__(512) mk_fwd(Params p) {
    extern __shared__ __attribute__((aligned(16))) unsigned char lds[];
    const int tid = threadIdx.x, lane = tid & 63, bid = blockIdx.x, G = gridDim.x; int wave = tid >> 6;
    unsigned char* ws = p.ws;
    float* mod = (float*)(ws + OFF_MOD); float* rinv1 = (float*)(ws + OFF_RINV1); float* ftab = (float*)(ws + OFF_ROPE);
    bf16_t* P = (bf16_t*)(ws + OFF_P); float* kv = (float*)(ws + OFF_KV); bf16_t* stT = (bf16_t*)(ws + OFF_ST); bf16_t* ycat = (bf16_t*)(ws + OFF_YCAT);
    bf16_t* Win_t = (bf16_t*)(ws + OFF_WINT); float* bias_f = (float*)(ws + OFF_BIASF);
    unsigned char* xq = ws + OFF_XQ; float* swf = (float*)(ws + OFF_SWF);
    float* sq = (float*)(ws + OFF_SQ); float* pmax = (float*)(ws + OFF_PMAX); float* rinv2q = (float*)(ws + OFF_RINV2Q); unsigned char* Weffq_t = ws + OFF_WEFFQ; unsigned char* x1q = ws + OFF_X1Q;
    unsigned* ctl = (unsigned*)(ws + OFF_CTL);
    bf16_t* Weff_t = (bf16_t*)(ws + OFF_WEFFT); bf16_t* Wout_t = (bf16_t*)(ws + OFF_WOUTT); float* bias_q = (float*)(ws + OFF_BIASQ); float* bq_part = (float*)(ws + OFF_BQPART);
    float* part2 = (float*)(ws + OFF_PART2); bf16_t* x1b = (bf16_t*)(ws + OFF_X1B); unsigned short* ids = (unsigned short*)(ws + OFF_IDS); unsigned char* q8 = ws + OFF_Q8; bf16_t* dsc = (bf16_t*)(ws + OFF_DSC); float* gates = (float*)(ws + OFF_GATES);
    const size_t PS = (size_t)T * 512;
    const bf16_t *Qr = P, *Kr = P + PS, *Gr = P + 2 * PS, *Qs = P + 3 * PS, *Ks = P + 4 * PS, *Vr = P + 5 * PS, *Vs = P + 6 * PS;
    float* out = p.out;

    if (tid < 4) ((LAS unsigned*)((LAS unsigned char*)lds + LDS_ST_OFF))[tid] = 0u;
    __syncthreads();
    XcdBarrier bar = xcd_barrier_post((unsigned*)(ws + OFF_CTL), (volatile LAS unsigned*)((LAS unsigned char*)lds + LDS_ST_OFF));

    for (int u = bid; u < 256; u += G) gemv_cols<6>(lds, VfSilu{p.c}, p.ada_w, 6144, u, mod, p.ada_b);
    for (int row0 = (bid * 8 + wave) * 2; row0 < T; row0 += G * 16) {
        float4 v[2][4];
#pragma unroll
        for (int rr = 0; rr < 2; ++rr)
#pragma unroll
            for (int j = 0; j < 4; ++j) v[rr][j] = ld_nt4(p.x + (size_t)(row0 + rr) * D + (lane + 64 * j) * 4);
#pragma unroll
        for (int rr = 0; rr < 2; ++rr) {
            float s = 0.f, am = 0.f;
#pragma unroll
            for (int j = 0; j < 4; ++j) { const float4 q = v[rr][j]; s += q.x * q.x + q.y * q.y + q.z * q.z + q.w * q.w;
                am = fmaxf(fmaxf(am, fmaxf(fabsf(q.x), fabsf(q.y))), fmaxf(fabsf(q.z), fabsf(q.w))); }
#pragma unroll
            for (int o = 32; o > 0; o >>= 1) { s += __shfl_xor(s, o); am = fmaxf(am, __shfl_xor(am, o)); }
            const float qs = (am > 0.f) ? 127.f / am : 0.f;
            unsigned* xqo = (unsigned*)(xq + (size_t)(row0 + rr) * D);
#pragma unroll
            for (int j = 0; j < 4; ++j) { const float4 q = v[rr][j];
                const unsigned b0 = __float_as_uint(fmaf(q.x, qs, 12582912.f)), b1 = __float_as_uint(fmaf(q.y, qs, 12582912.f)), b2 = __float_as_uint(fmaf(q.z, qs, 12582912.f)), b3 = __float_as_uint(fmaf(q.w, qs, 12582912.f));
                xqo[lane + 64 * j] = (b0 & 255u) | ((b1 & 255u) << 8) | ((b2 & 255u) << 16) | (b3 << 24); }
            if (lane == 0) rinv1[row0 + rr] = (1.0f / sqrtf(s * (1.0f / D) + EPS)) * (am * (1.f / 127.f));
        }
    }
    if (bid == 0 && tid == 0) {
#pragma unroll
        for (int i = 0; i < 32; ++i) { ftab[i] = p.rc.fh[i]; ftab[32 + i] = p.rc.fl[i]; }
    }
    xcd_barrier(bar);

    {
        for (int nb = bid; nb < 112; nb += G) {
            const int n0 = 32 * nb, r8 = lane >> 3, c = lane & 7, kw = 128 * wave;
            float* cm = (float*)(lds + 8 * 4608);
            unsigned* tl = (unsigned*)(lds + wave * 4608);
            float4 v[16];
#pragma unroll
            for (int i = 0; i < 16; ++i) { const int kk = 32 * (i >> 2) + 4 * r8 + (i & 3); v[i] = *(const float4*)(p.w_in + (size_t)(kw + kk) * 3584 + n0 + 4 * c); }
            float4 mx = {0.f, 0.f, 0.f, 0.f}, bs = {0.f, 0.f, 0.f, 0.f};
#pragma unroll
            for (int i = 0; i < 16; ++i) { const int kk = 32 * (i >> 2) + 4 * r8 + (i & 3); const float f = p.g1[kw + kk] * (1.f + mod[1024 + kw + kk]), sh = mod[kw + kk];
                bs.x += sh * v[i].x; bs.y += sh * v[i].y; bs.z += sh * v[i].z; bs.w += sh * v[i].w;
                v[i].x *= f; v[i].y *= f; v[i].z *= f; v[i].w *= f;
                mx.x = fmaxf(mx.x, fabsf(v[i].x)); mx.y = fmaxf(mx.y, fabsf(v[i].y)); mx.z = fmaxf(mx.z, fabsf(v[i].z)); mx.w = fmaxf(mx.w, fabsf(v[i].w)); }
#pragma unroll
            for (int o = 8; o < 64; o <<= 1) { mx.x = fmaxf(mx.x, __shfl_xor(mx.x, o)); mx.y = fmaxf(mx.y, __shfl_xor(mx.y, o)); mx.z = fmaxf(mx.z, __shfl_xor(mx.z, o)); mx.w = fmaxf(mx.w, __shfl_xor(mx.w, o));
                bs.x += __shfl_xor(bs.x, o); bs.y += __shfl_xor(bs.y, o); bs.z += __shfl_xor(bs.z, o); bs.w += __shfl_xor(bs.w, o); }
            if (lane < 8) { *(float4*)(cm + wave * 32 + 4 * c) = mx; *(float4*)(cm + 256 + wave * 32 + 4 * c) = bs; }
            __syncthreads();
            if (wave == 1 && lane < 8) { float4 t = {0.f, 0.f, 0.f, 0.f};
#pragma unroll
                for (int w2 = 0; w2 < 8; ++w2) { const float4 o = *(const float4*)(cm + 256 + w2 * 32 + 4 * c); t.x += o.x; t.y += o.y; t.z += o.z; t.w += o.w; }
                *(float4*)(bias_f + n0 + 4 * c) = t; }
#pragma unroll
            for (int w2 = 0; w2 < 8; ++w2) { const float4 o = *(const float4*)(cm + w2 * 32 + 4 * c); mx.x = fmaxf(mx.x, o.x); mx.y = fmaxf(mx.y, o.y); mx.z = fmaxf(mx.z, o.z); mx.w = fmaxf(mx.w, o.w); }
            if (wave == 0 && lane < 8) *(float4*)(swf + n0 + 4 * c) = make_float4(mx.x * (1.f / 127.f), mx.y * (1.f / 127.f), mx.z * (1.f / 127.f), mx.w * (1.f / 127.f));
            const float qx = (mx.x > 0.f) ? 127.f / mx.x : 0.f, qy = (mx.y > 0.f) ? 127.f / mx.y : 0.f, qz = (mx.z > 0.f) ? 127.f / mx.z : 0.f, qw = (mx.w > 0.f) ? 127.f / mx.w : 0.f;
#pragma unroll
            for (int a = 0; a < 4; ++a) {
                unsigned d[4];
#pragma unroll
                for (int j = 0; j < 4; ++j) {
                    const float qq = (j == 0) ? qx : (j == 1) ? qy : (j == 2) ? qz : qw;
                    unsigned w = 0;
#pragma unroll
                    for (int b = 0; b < 4; ++b) { const float4 t = v[4 * a + b]; const float e = (j == 0) ? t.x : (j == 1) ? t.y : (j == 2) ? t.z : t.w;
                        w |= (__float_as_uint(fmaf(e, qq, 12582912.f)) & 255u) << (8 * b); }
                    d[j] = w;
                }
#pragma unroll
                for (int j = 0; j < 4; ++j) tl[(4 * c + j) * 34 + 8 * a + r8] = d[j];
            }
            asm volatile("s_waitcnt lgkmcnt(0)" ::: "memory");
            const int rb = cmap_in(n0);
#pragma unroll
            for (int jj = 0; jj < 4; ++jj) { const int q = lane + 64 * jj, n = q >> 3, ch = q & 7;
                const uint2 lo = *(const uint2*)(tl + n * 34 + 4 * ch), hi = *(const uint2*)(tl + n * 34 + 4 * ch + 2);
                pg8::u32x4 o; o.x = lo.x; o.y = lo.y; o.z = hi.x; o.w = hi.y;
                *(pg8::u32x4*)((unsigned char*)Win_t + (size_t)(rb + n) * 1024 + kw + 16 * ch) = o; }
            __syncthreads();
        }
    }
    xcd_barrier(bar);

    {
        pg8::Gemm g{(const bf16_t*)xq, Win_t, T, 3584, 512}; pg8::StaticOrder S; S.init(T, 3584, G, bid);
        EpiInprojMF E{P, rinv1, bias_f, p.pos, ftab, p.qg, p.kg, swf};
        pg8::gemm_phase<EpiInprojMF, pg8::StaticOrder, true>((PG8_LAS unsigned char*)lds, g, S, E);
        const int nidle = (G > 128) ? G - 128 : G, ib = (G > 128) ? bid - 128 : bid;
        {
            float* scr = (float*)(lds + wave * 16384);
            if (ib >= 0) for (int it = ib * 8 + wave; it < 16 * 32; it += nidle * 8) transpose_item<false, false>(p.w_out, 1024, 1024, Wout_t, scr, it, lane, nullptr, nullptr);
            __syncthreads();
        }
        if (ib >= 0) for (int wu = ib; wu < 256; wu += nidle) {
            const int hp = wu >> 4, blk = wu & 15, i0 = blk * 64;
            __syncthreads();
            unsigned char* Wt = lds; unsigned char* St = lds + 64 * 272; float* bred = (float*)(lds + 64 * 272 + 128 * 272);
            for (int e4 = tid; e4 < 2048; e4 += 512) { const int r = e4 >> 5, c4 = e4 & 31; const float4 v = *(const float4*)(p.wq + (size_t)(i0 + r) * 2048 + hp * 128 + 4 * c4);
                *(uint2*)(Wt + r * 272 + c4 * 8) = make_uint2(pk2(v.x, v.y), pk2(v.z, v.w)); }
            for (int e4 = tid; e4 < 4096; e4 += 512) { const int r = e4 >> 5, c4 = e4 & 31; const float4 v = *(const float4*)(p.sk + ((size_t)hp * 128 + r) * 128 + 4 * c4);
                *(uint2*)(St + r * 272 + c4 * 8) = make_uint2(pk2(v.x, v.y), pk2(v.z, v.w)); }
            __syncthreads();
            const int rt = wave >> 2, ct = wave & 3, l31 = lane & 31, hf = lane >> 5;
            f32x16 C;
#pragma unroll
            for (int r = 0; r < 16; ++r) C[r] = 0.f;
#pragma unroll
            for (int s8 = 0; s8 < 8; ++s8) C = MFMA32(*(const bf16x8*)(Wt + (32 * rt + l31) * 272 + (16 * s8 + 8 * hf) * 2), *(const bf16x8*)(St + (32 * ct + l31) * 272 + (16 * s8 + 8 * hf) * 2), C);
            float bsum = 0.f; unsigned amx = 0u;
            bf16_t* wcol = Weff_t + (size_t)(hp * 128 + 32 * ct + l31) * 1024 + i0 + 32 * rt + 4 * hf;
#pragma unroll
            for (int g4 = 0; g4 < 4; ++g4) {
                const int i = i0 + 32 * rt + 8 * g4 + 4 * hf;
                const float4 gg = *(const float4*)(p.g2 + i), sc = *(const float4*)(mod + 4096 + i), sh = *(const float4*)(mod + 3072 + i);
                const float c0 = C[4 * g4], c1 = C[4 * g4 + 1], c2 = C[4 * g4 + 2], c3 = C[4 * g4 + 3];
                bsum += sh.x * c0 + sh.y * c1 + sh.z * c2 + sh.w * c3;
                const uint2 wv = make_uint2(pk2(c0 * gg.x * (1.f + sc.x), c1 * gg.y * (1.f + sc.y)), pk2(c2 * gg.z * (1.f + sc.z), c3 * gg.w * (1.f + sc.w)));
                *(uint2*)(wcol + 8 * g4) = wv;
                amx = max(max(amx, (wv.x << 16) & 0x7fffffffu), max(wv.x & 0x7fff0000u, max((wv.y << 16) & 0x7fffffffu, wv.y & 0x7fff0000u)));
            }
            amx = max(amx, (unsigned)__shfl_xor((int)amx, 32));
            if (hf == 0) (void)__hip_atomic_fetch_max(ctl + CTL_CMAX + hp * 128 + 32 * ct + l31, amx, __ATOMIC_RELAXED, __HIP_MEMORY_SCOPE_AGENT);
            bsum += __shfl_xor(bsum, 32);
            if (hf == 0) bred[rt * 128 + 32 * ct + l31] = bsum;
            __syncthreads();
            if (tid < 128) bq_part[(size_t)blk * 2048 + hp * 128 + tid] = bred[tid] + bred[128 + tid];
        }
        __syncthreads();
        if (ib >= 0) convert_tables(p.down, p.up, q8, dsc, lane, ib * 8 + wave, nidle * 8, 0, CONV_SPLIT);
    }
    xcd_barrier(bar);
    wave = threadIdx.x >> 6; asm volatile("" : "+v"(wave));

    {
        const int gw = __builtin_amdgcn_readfirstlane(bid * 8 + wave), NGW = G * 8, l31 = lane & 31, hf = lane >> 5;
        const int wv0 = __builtin_amdgcn_readfirstlane(wave);
        for (int U = gw; U < 1024; U += NGW) {
            const int n = U >> 3, h = U & 7;
            f32x16 C[2][2];
#pragma unroll
            for (int a = 0; a < 2; ++a)
#pragma unroll
                for (int b = 0; b < 2; ++b)
#pragma unroll
                    for (int r = 0; r < 16; ++r) C[a][b][r] = 0.f;
            unsigned char* Kt = lds + wv0 * 9216; unsigned char* Vt = Kt + 4608;
            const int r8 = lane >> 3, pc = lane & 7, trq = (lane & 15) >> 2, trp = lane & 3, trd = (lane >> 4) & 1;
            const char* kbase = (const char*)(Kr + (size_t)n * 128 * 512 + h * 64); const char* vbase = (const char*)(Vr + (size_t)n * 128 * 512 + h * 64);
            const unsigned loff = (unsigned)(r8 * 512 + pc * 8) * 2u;
            const float lg = lg2_head(h);
            pg8::u32x4 gK[4], gV[4];
#pragma unroll
            for (int i = 0; i < 4; ++i) { gK[i] = *(const pg8::u32x4*)(kbase + (loff + i * 8192u)); gV[i] = *(const pg8::u32x4*)(vbase + (loff + i * 8192u)); }
            for (int sb4 = 0; sb4 < 4; ++sb4) {
#pragma unroll
                for (int i = 0; i < 4; ++i) { *(pg8::u32x4*)(Kt + (8 * i + r8) * 144 + pc * 16) = gK[i]; *(pg8::u32x4*)(Vt + (8 * i + r8) * 144 + pc * 16) = gV[i]; }
                { const int sn = (sb4 < 3) ? sb4 + 1 : sb4;
#pragma unroll
                  for (int i = 0; i < 4; ++i) { gK[i] = *(const pg8::u32x4*)(kbase + (size_t)sn * 32768 + (loff + i * 8192u)); gV[i] = *(const pg8::u32x4*)(vbase + (size_t)sn * 32768 + (loff + i * 8192u)); } }
#pragma unroll
                for (int s = 0; s < 2; ++s) {
                    bf16x8 Af[2], Bf[2];
#pragma unroll
                    for (int a = 0; a < 2; ++a) {
                        Af[a] = tr_frag(Vt + (16 * s + 8 * hf + trq) * 144 + (32 * a + 16 * trd + 4 * trp) * 2, 4);
                        const bf16x8 kraw = tr_frag(Kt + (16 * s + 8 * hf + trq) * 144 + (32 * a + 16 * trd + 4 * trp) * 2, 4);
                        const pg8::u32x4 kw = __builtin_bit_cast(pg8::u32x4, kraw); const unsigned kk[4] = {kw.x, kw.y, kw.z, kw.w};
                        pg8::u32x4 o; unsigned* op = (unsigned*)&o;
#pragma unroll
                        for (int e2 = 0; e2 < 4; ++e2) {
                            const int j0 = 32 * sb4 + 16 * s + 8 * hf + 2 * e2;
                            const float z0 = __builtin_amdgcn_exp2f((float)(127 - j0) * lg), z1 = __builtin_amdgcn_exp2f((float)(126 - j0) * lg);
                            op[e2] = pg8::cvt_pk_bf16(__uint_as_float(kk[e2] << 16) * z0, __uint_as_float(kk[e2] & 0xffff0000u) * z1);
                        }
                        Bf[a] = __builtin_bit_cast(bf16x8, o);
                    }
#pragma unroll
                    for (int a = 0; a < 2; ++a)
#pragma unroll
                        for (int b = 0; b < 2; ++b) C[a][b] = MFMA32(Af[a], Bf[b], C[a][b]);
                }
            }
            float* dst = kv + (size_t)(n * 8 + h) * 4096;
#pragma unroll
            for (int a = 0; a < 2; ++a)
#pragma unroll
                for (int b = 0; b < 2; ++b)
#pragma unroll
                    for (int r = 0; r < 16; ++r) dst[(32 * a + (r & 3) + 8 * (r >> 2) + 4 * hf) * 64 + 32 * b + l31] = C[a][b][r];
        }
        bf16x8 Tri[2];
        {
            pg8::u32x4 w0, w1; unsigned* p0 = (unsigned*)&w0; unsigned* p1 = (unsigned*)&w1;
#pragma unroll
            for (int e2 = 0; e2 < 4; ++e2) {
                unsigned a0 = 0, a1 = 0;
#pragma unroll
                for (int q = 0; q < 2; ++q) { const int e = 2 * e2 + q, ip = 8 * (e >> 2) + 4 * hf + (e & 3);
                    a0 |= ((ip > l31) ? 0x3F80u : 0u) << (16 * q); a1 |= ((16 + ip > l31) ? 0x3F80u : 0u) << (16 * q); }
                p0[e2] = a0; p1[e2] = a1;
            }
            Tri[0] = __builtin_bit_cast(bf16x8, w0); Tri[1] = __builtin_bit_cast(bf16x8, w1);
        }
        const bool sb_local = (G % 8 == 0) && (4096 % G == 0) && ((4096 / G) % 8 == 0);
        const int sb_per_wave = sb_local ? 4096 / G / 8 : (4096 + NGW - 1 - gw) / NGW;
        const int wv = __builtin_amdgcn_readfirstlane(wave);
        for (int ps = 0; ps < sb_per_wave; ++ps) {
            const int U = sb_local ? 0 : gw + ps * NGW;
            const int h = sb_local ? (bid & 7) : (U & 7), qt = sb_local ? (bid >> 3) * (4096 / G) + ps * 8 + wv : (U >> 3), q0 = qt * 32;
            f32x16 O[2];
#pragma unroll
            for (int r = 0; r < 16; ++r) { O[0][r] = 0.f; O[1][r] = 0.f; }
            float carry = 0.f;
            unsigned char* Kt = lds + wv * 9216; unsigned char* Vt = Kt + 4608;
            const int r8 = lane >> 3, pc = lane & 7;
            const char* kbase = (const char*)(Ks + h * 64); const char* vbase = (const char*)(Vs + h * 64);
            const unsigned loff = (unsigned)(r8 * 512 + pc * 8) * 2u;
            pg8::u32x4 gK[4], gV[4];
            bf16x8 Qf[4];
            {
                const char* qbase = (const char*)(Qs + h * 64);
#pragma unroll
                for (int i = 0; i < 4; ++i) gK[i] = *(const pg8::u32x4*)(qbase + (size_t)qt * 32768 + (loff + i * 8192u));
#pragma unroll
                for (int i = 0; i < 4; ++i) *(pg8::u32x4*)(Kt + (8 * i + r8) * 144 + pc * 16) = gK[i];
#pragma unroll
                for (int s = 0; s < 4; ++s) Qf[s] = *(const bf16x8*)(Kt + l31 * 144 + 32 * s + 16 * hf);
            }
#pragma unroll
            for (int i = 0; i < 4; ++i) { gK[i] = *(const pg8::u32x4*)(kbase + (size_t)qt * 32768 + (loff + i * 8192u)); gV[i] = *(const pg8::u32x4*)(vbase + (size_t)qt * 32768 + (loff + i * 8192u)); }
            const int trq = (lane & 15) >> 2, trp = lane & 3, trd = (lane >> 4) & 1;
            for (int kb = qt; kb >= 0; --kb) {
#pragma unroll
                for (int i = 0; i < 4; ++i) { *(pg8::u32x4*)(Kt + (8 * i + r8) * 144 + pc * 16) = gK[i]; *(pg8::u32x4*)(Vt + (8 * i + r8) * 144 + pc * 16) = gV[i]; }
                {
                    const int kbn = (kb > 0) ? kb - 1 : 0;
#pragma unroll
                    for (int i = 0; i < 4; ++i) { gK[i] = *(const pg8::u32x4*)(kbase + (size_t)kbn * 32768 + (loff + i * 8192u)); gV[i] = *(const pg8::u32x4*)(vbase + (size_t)kbn * 32768 + (loff + i * 8192u)); }
                }
                bf16x8 Kf[4], Vf[2][2];
#pragma unroll
                for (int s = 0; s < 4; ++s) Kf[s] = *(const bf16x8*)(Kt + l31 * 144 + 32 * s + 16 * hf);
#pragma unroll
                for (int s = 0; s < 2; ++s)
#pragma unroll
                    for (int dt = 0; dt < 2; ++dt) {
                        Vf[s][dt] = tr_frag(Vt + (16 * s + 4 * hf + trq) * 144 + (32 * dt + 16 * trd + 4 * trp) * 2, 8);
                    }
                f32x16 S;
#pragma unroll
                for (int r = 0; r < 16; ++r) S[r] = 0.f;
#pragma unroll
                for (int s = 0; s < 4; ++s) S = MFMA32(Kf[s], Qf[s], S);
                const bool diag = (kb == qt);
                f32x16 sp, lb;
                float csum = 0.f;
                if (diag) {
#pragma unroll
                    for (int r = 0; r < 16; ++r) {
                        const int i = (r & 3) + 8 * (r >> 2) + 4 * hf;
                        const float z = S[r];
                        const float l1p = __builtin_amdgcn_logf(1.0f + __builtin_amdgcn_exp2f(-fabsf(z)));
                        const float spv = (i < l31) ? (fmaxf(z, 0.f) + l1p) : 0.f;
                        sp[r] = spv; lb[r] = (i < l31) ? (fminf(z, 0.f) - l1p) : -INFINITY; csum += spv;
                    }
                } else {
#pragma unroll
                    for (int r = 0; r < 16; ++r) {
                        const float z = S[r];
                        const float l1p = __builtin_amdgcn_logf(1.0f + __builtin_amdgcn_exp2f(-fabsf(z)));
                        const float spv = fmaxf(z, 0.f) + l1p;
                        sp[r] = spv; lb[r] = fminf(z, 0.f) - l1p; csum += spv;
                    }
                }
                f32x16 Rt;
#pragma unroll
                for (int r = 0; r < 16; ++r) Rt[r] = carry;
#pragma unroll
                for (int s = 0; s < 2; ++s) Rt = MFMA32(Tri[s], pack_frag(sp, s), Rt);
                f32x16 wv;
#pragma unroll
                for (int r = 0; r < 16; ++r) wv[r] = __builtin_amdgcn_exp2f(lb[r] - Rt[r]);
#pragma unroll
                for (int s = 0; s < 2; ++s) { const bf16x8 wp = pack_frag(wv, s);
#pragma unroll
                    for (int dt = 0; dt < 2; ++dt) O[dt] = MFMA32(Vf[s][dt], wp, O[dt]); }
                csum += __shfl_xor(csum, 32);
                carry += csum;
                if (__all(carry > 127.f)) break;
            }
            float ss = 0.f;
#pragma unroll
            for (int r = 0; r < 16; ++r) ss += O[0][r] * O[0][r] + O[1][r] * O[1][r];
            ss += __shfl_xor(ss, 32);
            const float rn = 1.0f / sqrtf(ss * (1.f / 64.f) + EPS);
#pragma unroll
            for (int dt = 0; dt < 2; ++dt)
#pragma unroll
                for (int g4 = 0; g4 < 4; ++g4) {
                    const int d = 32 * dt + 8 * g4 + 4 * hf;
                    const float4 gn = *(const float4*)(p.og + d);
                    uint2 w; w.x = pg8::cvt_pk_bf16(O[dt][4 * g4] * rn * gn.x, O[dt][4 * g4 + 1] * rn * gn.y); w.y = pg8::cvt_pk_bf16(O[dt][4 * g4 + 2] * rn * gn.z, O[dt][4 * g4 + 3] * rn * gn.w);
                    *(uint2*)(Kt + l31 * 144 + d * 2) = w;
                }
#pragma unroll
            for (int i = 0; i < 4; ++i) *(pg8::u32x4*)(ycat + (size_t)(q0 + 8 * i + r8) * 1024 + 512 + h * 64 + pc * 8) = *(const pg8::u32x4*)(Kt + (8 * i + r8) * 144 + pc * 16);
        }
    }
    xcd_barrier(bar);

    if (bid == 255 % G) for (int n = tid; n < 2048; n += 512) { float s = 0.f;
#pragma unroll
        for (int b8 = 0; b8 < 16; ++b8) s += bq_part[(size_t)b8 * 2048 + n];
        bias_q[n] = s; }
    if (bid >= 64) for (int row = (bid - 64) * 8 + wave; row < 2048; row += (G - 64) * 8) {
        const float am = __uint_as_float(ctl[CTL_CMAX + row]), qs = (am > 0.f) ? 127.f / am : 0.f;
        const pg8::u32x4 a = *(const pg8::u32x4*)(Weff_t + (size_t)row * 1024 + 16 * lane), b = *(const pg8::u32x4*)(Weff_t + (size_t)row * 1024 + 16 * lane + 8);
        pg8::u32x4 o;
#define QB(w) ((__float_as_uint(fmaf(__uint_as_float((w) << 16), qs, 12582912.f)) & 255u) | ((__float_as_uint(fmaf(__uint_as_float((w) & 0xffff0000u), qs, 12582912.f)) & 255u) << 8))
        o.x = QB(a.x) | (QB(a.y) << 16); o.y = QB(a.z) | (QB(a.w) << 16); o.z = QB(b.x) | (QB(b.y) << 16); o.w = QB(b.z) | (QB(b.w) << 16);
#undef QB
        *(pg8::u32x4*)(Weffq_t + (size_t)row * 1024 + 16 * lane) = o;
        if (lane == 0) sq[row] = am * (1.f / 127.f);
    }
    if (G > 64 && bid >= 64) convert_tables(p.down, p.up, q8, dsc, lane, (bid - 64) * 8 + wave, (G - 64) * 8, CONV_SPLIT, 32768);
    else if (G <= 64) convert_tables(p.down, p.up, q8, dsc, lane, bid * 8 + wave, G * 8, CONV_SPLIT, 32768);
    for (int idx = bid * 512 + tid; idx < 32768; idx += G * 512) {
        const int h = idx >> 12;
        const float cd = exp2f(128.f * lg2_head(h));
        float s = 0.f;
        for (int n0 = 0; n0 < 128; n0 += 32) {
            float kvv[32];
#pragma unroll
            for (int q = 0; q < 32; ++q) kvv[q] = kv[(size_t)(n0 + q) * 32768 + idx];
#pragma unroll
            for (int q = 0; q < 32; ++q) { stT[(size_t)(n0 + q) * 32768 + idx] = f2bf(s); s = cd * s + kvv[q]; }
        }
    }
    xcd_barrier(bar);

    {
        const int gw = __builtin_amdgcn_readfirstlane(bid * 8 + wave), NGW = G * 8, l31 = lane & 31, hf = lane >> 5;
        const int wv4 = __builtin_amdgcn_readfirstlane(wave);
        for (int W2 = gw; W2 < 2048; W2 += NGW) {
            const int nh = W2 >> 1, n = nh >> 3, h = nh & 7;
            const float lg = lg2_head(h);
#pragma unroll 1
            for (int pass = 0; pass < 2; ++pass) {
                const int qt = (W2 & 1) ? (pass ? 2 : 1) : (pass ? 3 : 0);
                const int il = qt * 32 + l31, tq = n * 128 + il;
                unsigned char* Kt = lds + wv4 * 9216; unsigned char* Vt = Kt + 4608;
                const int r8 = lane >> 3, pc = lane & 7, trq = (lane & 15) >> 2, trp = lane & 3, trd = (lane >> 4) & 1;
                const unsigned loff = (unsigned)(r8 * 512 + pc * 8) * 2u;
                pg8::u32x4 gK[4], gV[4];
                bf16x8 Qf[4];
                {
                    const char* qbase = (const char*)(Qr + (size_t)(n * 128 + qt * 32) * 512 + h * 64);
                    const char* sbase = (const char*)(stT + (size_t)nh * 4096) + (unsigned)(r8 * 64 + pc * 8) * 2u;
#pragma unroll
                    for (int i = 0; i < 4; ++i) gK[i] = *(const pg8::u32x4*)(qbase + (loff + i * 8192u));
#pragma unroll
                    for (int i = 0; i < 4; ++i) *(pg8::u32x4*)(Kt + (8 * i + r8) * 144 + pc * 16) = gK[i];
#pragma unroll
                    for (int s = 0; s < 4; ++s) Qf[s] = *(const bf16x8*)(Kt + l31 * 144 + 32 * s + 16 * hf);
#pragma unroll
                    for (int i = 0; i < 4; ++i) { gK[i] = *(const pg8::u32x4*)(sbase + i * 1024u); gV[i] = *(const pg8::u32x4*)(sbase + 4096u + i * 1024u); }
#pragma unroll
                    for (int i = 0; i < 4; ++i) { *(pg8::u32x4*)(Kt + (8 * i + r8) * 144 + pc * 16) = gK[i]; *(pg8::u32x4*)(Kt + (32 + 8 * i + r8) * 144 + pc * 16) = gV[i]; }
                }
                f32x16 O[2];
#pragma unroll
                for (int r = 0; r < 16; ++r) { O[0][r] = 0.f; O[1][r] = 0.f; }
#pragma unroll
                for (int s = 0; s < 4; ++s)
#pragma unroll
                    for (int dt = 0; dt < 2; ++dt) O[dt] = MFMA32(*(const bf16x8*)(Kt + (32 * dt + l31) * 144 + 32 * s + 16 * hf), Qf[s], O[dt]);
                const float xi = exp2f((float)(il + 1) * lg);
#pragma unroll
                for (int r = 0; r < 16; ++r) { O[0][r] *= xi; O[1][r] *= xi; }
                const char* kbase = (const char*)(Kr + (size_t)n * 128 * 512 + h * 64); const char* vbase = (const char*)(Vr + (size_t)n * 128 * 512 + h * 64);
#pragma unroll
                for (int i = 0; i < 4; ++i) { gK[i] = *(const pg8::u32x4*)(kbase + (loff + i * 8192u)); gV[i] = *(const pg8::u32x4*)(vbase + (loff + i * 8192u)); }
                for (int jb = 0; jb <= qt; ++jb) {
#pragma unroll
                    for (int i = 0; i < 4; ++i) { *(pg8::u32x4*)(Kt + (8 * i + r8) * 144 + pc * 16) = gK[i]; *(pg8::u32x4*)(Vt + (8 * i + r8) * 144 + pc * 16) = gV[i]; }
                    { const int jn = (jb < qt) ? jb + 1 : jb;
#pragma unroll
                      for (int i = 0; i < 4; ++i) { gK[i] = *(const pg8::u32x4*)(kbase + (size_t)jn * 32768 + (loff + i * 8192u)); gV[i] = *(const pg8::u32x4*)(vbase + (size_t)jn * 32768 + (loff + i * 8192u)); } }
                    bf16x8 Kf[4], Vf[2][2];
#pragma unroll
                    for (int s = 0; s < 4; ++s) Kf[s] = *(const bf16x8*)(Kt + l31 * 144 + 32 * s + 16 * hf);
#pragma unroll
                    for (int s = 0; s < 2; ++s)
#pragma unroll
                        for (int dt = 0; dt < 2; ++dt) Vf[s][dt] = tr_frag(Vt + (16 * s + 4 * hf + trq) * 144 + (32 * dt + 16 * trd + 4 * trp) * 2, 8);
                    f32x16 S;
#pragma unroll
                    for (int r = 0; r < 16; ++r) S[r] = 0.f;
#pragma unroll
                    for (int s = 0; s < 4; ++s) S = MFMA32(Kf[s], Qf[s], S);
#pragma unroll
                    for (int r = 0; r < 16; ++r) {
                        const int jl = jb * 32 + (r & 3) + 8 * (r >> 2) + 4 * hf, dl = il - jl;
                        S[r] = (dl >= 0) ? S[r] * __builtin_amdgcn_exp2f((float)dl * lg) : 0.f;
                    }
#pragma unroll
                    for (int s = 0; s < 2; ++s) { const bf16x8 wp = pack_frag(S, s);
#pragma unroll
                        for (int dt = 0; dt < 2; ++dt) O[dt] = MFMA32(Vf[s][dt], wp, O[dt]); }
                }
                float sm = 0.f;
#pragma unroll
                for (int r = 0; r < 16; ++r) sm += O[0][r] + O[1][r];
                sm += __shfl_xor(sm, 32);
                const float mean = sm * (1.f / 64.f);
                float vs = 0.f;
#pragma unroll
                for (int r = 0; r < 16; ++r) { const float d0 = O[0][r] - mean, d1 = O[1][r] - mean; vs += d0 * d0 + d1 * d1; }
                vs += __shfl_xor(vs, 32);
                const float rstd = 1.0f / sqrtf(vs * (1.f / 64.f) + EPS);
                {
                    const char* gbase = (const char*)(Gr + (size_t)(n * 128 + qt * 32) * 512 + h * 64);
#pragma unroll
                    for (int i = 0; i < 4; ++i) gV[i] = *(const pg8::u32x4*)(gbase + (loff + i * 8192u));
#pragma unroll
                    for (int i = 0; i < 4; ++i) *(pg8::u32x4*)(Vt + (8 * i + r8) * 144 + pc * 16) = gV[i];
                }
#pragma unroll
                for (int dt = 0; dt < 2; ++dt)
#pragma unroll
                    for (int g4 = 0; g4 < 4; ++g4) {
                        const int e = 32 * dt + 8 * g4 + 4 * hf;
                        const float4 gn = *(const float4*)(p.rgain + h * 64 + e);
                        const uint2 gg = *(const uint2*)(Vt + l31 * 144 + e * 2);
                        const float g0 = __uint_as_float(gg.x << 16), g1 = __uint_as_float(gg.x & 0xffff0000u), g2v = __uint_as_float(gg.y << 16), g3 = __uint_as_float(gg.y & 0xffff0000u);
                        uint2 w;
                        w.x = pg8::cvt_pk_bf16((O[dt][4 * g4] - mean) * rstd * gn.x * g0, (O[dt][4 * g4 + 1] - mean) * rstd * gn.y * g1);
                        w.y = pg8::cvt_pk_bf16((O[dt][4 * g4 + 2] - mean) * rstd * gn.z * g2v, (O[dt][4 * g4 + 3] - mean) * rstd * gn.w * g3);
                        *(uint2*)(Kt + l31 * 144 + e * 2) = w;
                    }
#pragma unroll
                for (int i = 0; i < 4; ++i) *(pg8::u32x4*)(ycat + (size_t)(n * 128 + qt * 32 + 8 * i + r8) * 1024 + h * 64 + pc * 8) = *(const pg8::u32x4*)(Kt + (8 * i + r8) * 144 + pc * 16);
            }
        }
    }
    xcd_barrier(bar);

    {
        pg8::Gemm g{ycat, Wout_t, T, 1024, 1024}; pg8::StaticOrder S; S.init(T, 1024, G, bid);
        EpiOutprojMF E{p.x, mod + 2048, x1b, part2, pmax, x1q, rinv2q, ctl};
        pg8::gemm_phase<EpiOutprojMF, pg8::StaticOrder>((PG8_LAS unsigned char*)lds, g, S, E);
    }
    xcd_barrier(bar);

    for (int round = 0; round < 2; ++round) {
        pg8::Gemm g{(const bf16_t*)x1q, (const bf16_t*)Weffq_t, T, 2048, 512}; OneUnitOrder S; S.base.init(T, 2048, G, bid); S.round = round;
        EpiTopkMF E{rinv2q, sq, bias_q, ids, gates};
        pg8::gemm_phase<EpiTopkMF, OneUnitOrder, true>((PG8_LAS unsigned char*)lds, g, S, E);
    }
    xcd_barrier(bar);

    {
        constexpr int IDS_LD = 136, ACT_LD = 136;
        const float* scale2 = mod + 4096; const float* shift2 = mod + 3072; const float* gate2 = mod + 5120;
        unsigned short* ids_l = (unsigned short*)lds; float* act_l = (float*)(lds + 32768);
        bf16_t* ds_l = (bf16_t*)(lds + 69632);
        const int t0 = bid * 64, tt = lane >> 3, sub = lane & 7, tl = wave * 8 + tt, t = t0 + tl;
        for (int e = tid; e < 1024; e += 512) { const int r = e >> 4, c8 = e & 15; *(uint4*)(ids_l + r * IDS_LD + c8 * 8) = *(const uint4*)(ids + (size_t)(t0 + r) * 128 + c8 * 8); }
        for (int e = tid; e < 64 * ACT_LD; e += 512) act_l[e] = 0.f;
        for (int e = tid; e < 4096; e += 512) ((uint4*)ds_l)[e] = ((const uint4*)dsc)[e];
        float* s2_l = (float*)(lds + 143360); float* sh2_l = s2_l + 1024; float* gt2_l = s2_l + 2048;
        for (int e = tid; e < 1024; e += 512) { s2_l[e] = p.g2[e] * (1.f + scale2[e]); sh2_l[e] = shift2[e]; gt2_l[e] = gate2[e]; }
        __syncthreads();
        float ri;
        { const float4* pp = (const float4*)(part2 + (size_t)t * 16); const float4 p0 = pp[0], p1 = pp[1], p2 = pp[2], p3 = pp[3];
          const float ssum = ((p0.x + p0.y) + (p0.z + p0.w)) + ((p1.x + p1.y) + (p1.z + p1.w)) + ((p2.x + p2.y) + (p2.z + p2.w)) + ((p3.x + p3.y) + (p3.z + p3.w));
          ri = 1.0f / sqrtf(ssum * (1.0f / D) + EPS); }
        const unsigned short* myids = ids_l + tl * IDS_LD;
        float* myact = act_l + tl * ACT_LD;
        const bool s4 = (sub & 4) != 0, s2 = (sub & 2) != 0, s1 = (sub & 1) != 0;
        const unsigned suboff = (unsigned)sub * 16u;
        typedef float f32x2 __attribute__((ext_vector_type(2)));
#define P9_LOAD(W, JB) do { const uint4 idv_ = *(const uint4*)(myids + 8 * (JB)); const unsigned idw_[4] = {idv_.x, idv_.y, idv_.z, idv_.w}; \
        _Pragma("unroll") for (int k_ = 0; k_ < 8; ++k_) { const unsigned id_ = (idw_[k_ >> 1] >> (16 * (k_ & 1))) & 0xffffu; W[k_] = *(const uint4*)(sbase + (id_ * 128u + suboff)); } } while (0)
#define P9_DOWN4(W, JB) do { int pd_[8]; \
        _Pragma("unroll") for (int k_ = 0; k_ < 8; ++k_) { const unsigned ww_[4] = {W[k_].x, W[k_].y, W[k_].z, W[k_].w}; int a0_ = 0, a1_ = 0; \
            _Pragma("unroll") for (int m_ = 0; m_ < 4; ++m_) { a0_ = __builtin_amdgcn_sdot4(hpe[m_], (int)(ww_[m_] & 0x0F0F0F0Fu), a0_, false); a1_ = __builtin_amdgcn_sdot4(hpo[m_], (int)((ww_[m_] >> 4) & 0x0F0F0F0Fu), a1_, false); } \
            pd_[k_] = a0_ + a1_ - hoff; } \
        int r4_[4], r2_[2]; \
        _Pragma("unroll") for (int k_ = 0; k_ < 4; ++k_) { const int snd_ = s4 ? pd_[k_] : pd_[k_ + 4], kp_ = s4 ? pd_[k_ + 4] : pd_[k_]; r4_[k_] = kp_ + __shfl_xor(snd_, 4); } \
        _Pragma("unroll") for (int k_ = 0; k_ < 2; ++k_) { const int snd_ = s2 ? r4_[k_] : r4_[k_ + 2], kp_ = s2 ? r4_[k_ + 2] : r4_[k_]; r2_[k_] = kp_ + __shfl_xor(snd_, 2); } \
        { const int snd_ = s1 ? r2_[0] : r2_[1], kp_ = s1 ? r2_[1] : r2_[0]; myact[8 * (JB) + sub] += (float)(kp_ + __shfl_xor(snd_, 1)) * hscale; } } while (0)
        uint2 xnx[8];
#pragma unroll
        for (int q = 0; q < 8; ++q) xnx[q] = *(const uint2*)(x1b + (size_t)t * D + 4 * sub + 32 * q);
        float gtv[16];
#pragma unroll
        for (int jb = 0; jb < 16; ++jb) gtv[jb] = gates[(size_t)t * 128 + 8 * jb + sub];
        const unsigned char* sbase = q8;
        uint4 wA[8], wB[8];
        P9_LOAD(wA, 0);
        for (int c = 0; c < 4; ++c) {
            uint2 xcur[8];
#pragma unroll
            for (int q = 0; q < 8; ++q) xcur[q] = xnx[q];
            { const int cn = (c < 3) ? c + 1 : c;
#pragma unroll
              for (int q = 0; q < 8; ++q) xnx[q] = *(const uint2*)(x1b + (size_t)t * D + 256 * cn + 4 * sub + 32 * q); }
            float hf[8][4]; float hmax = 0.f;
#pragma unroll
            for (int q = 0; q < 8; ++q) {
                const int col = 256 * c + 4 * sub + 32 * q;
                const uint2 xw = xcur[q];
                const float4 sv = *(const float4*)(s2_l + col), sh = *(const float4*)(sh2_l + col);
                hf[q][0] = __uint_as_float(xw.x << 16) * ri * sv.x + sh.x; hf[q][1] = __uint_as_float(xw.x & 0xffff0000u) * ri * sv.y + sh.y;
                hf[q][2] = __uint_as_float(xw.y << 16) * ri * sv.z + sh.z; hf[q][3] = __uint_as_float(xw.y & 0xffff0000u) * ri * sv.w + sh.w;
                hmax = fmaxf(hmax, fmaxf(fmaxf(fabsf(hf[q][0]), fabsf(hf[q][1])), fmaxf(fabsf(hf[q][2]), fabsf(hf[q][3]))));
            }
            hmax = fmaxf(hmax, __shfl_xor(hmax, 1)); hmax = fmaxf(hmax, __shfl_xor(hmax, 2)); hmax = fmaxf(hmax, __shfl_xor(hmax, 4));
            const float hinv = (hmax > 0.f) ? 127.0f / hmax : 0.f, hscale = hmax * (1.0f / 127.0f);
            int hq[8][4];
#pragma unroll
            for (int q = 0; q < 8; ++q)
#pragma unroll
                for (int j = 0; j < 4; ++j) hq[q][j] = (int)__builtin_rintf(hf[q][j] * hinv);
            int hpe[4], hpo[4], hoff = 0;
#pragma unroll
            for (int m = 0; m < 4; ++m) {
                hpe[m] = (hq[2 * m][0] & 255) | ((hq[2 * m][2] & 255) << 8) | ((hq[2 * m + 1][0] & 255) << 16) | ((hq[2 * m + 1][2] & 255) << 24);
                hpo[m] = (hq[2 * m][1] & 255) | ((hq[2 * m][3] & 255) << 8) | ((hq[2 * m + 1][1] & 255) << 16) | ((hq[2 * m + 1][3] & 255) << 24);
            }
#pragma unroll
            for (int q = 0; q < 8; ++q) hoff += (hq[q][0] + hq[q][1]) + (hq[q][2] + hq[q][3]);
            hoff *= 8;
#pragma unroll 1
            for (int jb = 0; jb < 16; jb += 2) {
                P9_LOAD(wB, jb + 1);
                P9_DOWN4(wA, jb);
                if (jb + 2 < 16) P9_LOAD(wA, jb + 2);
                else { sbase = (c < 3) ? q8 + (size_t)(c + 1) * (16384 * 128) : q8 + (8u << 20); P9_LOAD(wA, 0); }
                P9_DOWN4(wB, jb + 1);
            }
        }
#undef P9_DOWN4
        signed char* aq_l = (signed char*)(lds + 135168);
        float avv[16]; float amax = 0.f;
#pragma unroll
        for (int jb = 0; jb < 16; ++jb) {
            const int j = 8 * jb + sub; const unsigned id = myids[j];
            const float a = myact[j] * bf2f(ds_l[id]);
            const float av = fabsf(a), tq = 1.0f / (av * 0.2316418882f + 1.0f);
            float ql = tq * 0.5307027145f + (-0.7265760135f); ql = ql * tq + 0.7107068705f; ql = ql * tq + (-0.142248368f); ql = ql * tq + 0.127414796f; ql = ql * tq;
            const float mm = a * (ql * exp2f(a * a * (-0.72134752044f)));
            const float ge = (a < 0.f) ? mm : (a - mm);
            avv[jb] = ge * gtv[jb] * bf2f(ds_l[16384 + id]);
            amax = fmaxf(amax, fabsf(avv[jb]));
        }
        amax = fmaxf(amax, __shfl_xor(amax, 1)); amax = fmaxf(amax, __shfl_xor(amax, 2)); amax = fmaxf(amax, __shfl_xor(amax, 4));
        const float ainv = (amax > 0.f) ? 127.0f / amax : 0.f, ascale = amax * (1.0f / 127.0f);
        int aqsum = 0;
#pragma unroll
        for (int jb = 0; jb < 16; ++jb) { const int aqv = (int)__builtin_rintf(avv[jb] * ainv); aq_l[tl * 128 + 8 * jb + sub] = (signed char)aqv; aqsum += aqv; }
        aqsum += __shfl_xor(aqsum, 1); aqsum += __shfl_xor(aqsum, 2); aqsum += __shfl_xor(aqsum, 4);
        __syncthreads();
#define P9_PERM(HI, LO, SEL) __builtin_amdgcn_perm((HI), (LO), (SEL))
#define P9_T4(E0, E1, E2, E3, T0, T1, T2, T3) do { const unsigned p0_ = P9_PERM(E1, E0, 0x05010400u), p1_ = P9_PERM(E1, E0, 0x07030602u), p2_ = P9_PERM(E3, E2, 0x05010400u), p3_ = P9_PERM(E3, E2, 0x07030602u); \
        T0 = P9_PERM(p2_, p0_, 0x05040100u); T1 = P9_PERM(p2_, p0_, 0x07060302u); T2 = P9_PERM(p3_, p1_, 0x05040100u); T3 = P9_PERM(p3_, p1_, 0x07060302u); } while (0)
#define P9_UP4(W, JB) do { const uint2 aq8_ = *(const uint2*)(aq_l + tl * 128 + 8 * (JB)); const int aq4_[2] = {(int)aq8_.x, (int)aq8_.y}; \
        _Pragma("unroll") for (int g_ = 0; g_ < 2; ++g_) { \
            _Pragma("unroll") for (int m_ = 0; m_ < 4; ++m_) { \
                const unsigned w0_ = ((const unsigned*)&W[4 * g_ + 0])[m_], w1_ = ((const unsigned*)&W[4 * g_ + 1])[m_], w2_ = ((const unsigned*)&W[4 * g_ + 2])[m_], w3_ = ((const unsigned*)&W[4 * g_ + 3])[m_]; \
                unsigned t_[4]; \
                P9_T4(w0_, w1_, w2_, w3_, t_[0], t_[1], t_[2], t_[3]); \
                _Pragma("unroll") for (int k_ = 0; k_ < 4; ++k_) { \
                    oraw[4 * m_ + k_] = __builtin_amdgcn_sdot4(aq4_[g_], (int)t_[k_], oraw[4 * m_ + k_], false); \
                    olo[4 * m_ + k_] = __builtin_amdgcn_sdot4(aq4_[g_], (int)(t_[k_] & 0x0F0F0F0Fu), olo[4 * m_ + k_], false); } } } } while (0)
        for (int c = 0; c < 4; ++c) {
            int oraw[16], olo[16];
#pragma unroll
            for (int q = 0; q < 16; ++q) { oraw[q] = 0; olo[q] = 0; }
            uint2 xres[8];
#pragma unroll
            for (int q = 0; q < 8; ++q) xres[q] = *(const uint2*)(x1b + (size_t)t * D + 256 * c + 4 * sub + 32 * q);
#pragma unroll 1
            for (int jb = 0; jb < 16; jb += 2) {
                P9_LOAD(wB, jb + 1);
                P9_UP4(wA, jb);
                if (jb + 2 < 16) P9_LOAD(wA, jb + 2);
                else if (c < 3) { sbase = q8 + (8u << 20) + (size_t)(c + 1) * (16384 * 128); P9_LOAD(wA, 0); }
                P9_UP4(wB, jb + 1);
            }
#pragma unroll
            for (int q = 0; q < 8; ++q) {
                const int col = 256 * c + 4 * sub + 32 * q;
                float* op = out + (size_t)t * D + col;
                const uint2 xw = xres[q]; const float4 xv = make_float4(__uint_as_float(xw.x << 16), __uint_as_float(xw.x & 0xffff0000u), __uint_as_float(xw.y << 16), __uint_as_float(xw.y & 0xffff0000u)); const float4 gt = *(const float4*)(gt2_l + col);
                const int m = q >> 1, k0 = 2 * (q & 1);
                const int v0 = olo[4 * m + k0] - 8 * aqsum, v1 = (oraw[4 * m + k0] - olo[4 * m + k0]) >> 4, v2 = olo[4 * m + k0 + 1] - 8 * aqsum, v3 = (oraw[4 * m + k0 + 1] - olo[4 * m + k0 + 1]) >> 4;
                float4 r;
                r.x = xv.x + gt.x * ((float)v0 * ascale); r.y = xv.y + gt.y * ((float)v1 * ascale); r.z = xv.z + gt.z * ((float)v2 * ascale); r.w = xv.w + gt.w * ((float)v3 * ascale);
                *(float4*)op = r;
            }
        }
#undef P9_LOAD
#undef P9_UP4
#undef P9_T4
#undef P9_PERM
    }
}
}

extern "C" void kernel_launch(void* const* d_in, const int* in_sizes, int n_in, void* d_out, int out_size, void* d_ws, size_t ws_size, hipStream_t stream) {
    static int grid = 0;
    if (grid == 0) {
        int dev = 0, cus = 0, per_cu = 0;
        (void)hipGetDevice(&dev);
        (void)hipDeviceGetAttribute(&cus, hipDeviceAttributeMultiprocessorCount, dev);
        (void)hipFuncSetAttribute((const void*)mk_fwd, hipFuncAttributeMaxDynamicSharedMemorySize, LDS_BYTES);
        (void)hipOccupancyMaxActiveBlocksPerMultiprocessor(&per_cu, (const void*)mk_fwd, 512, LDS_BYTES);
        if (per_cu < 1 || cus != 256) { fprintf(stderr, "kernel_launch: needs 256 CUs with one resident workgroup each (cus %d, per_cu %d)\n", cus, per_cu); grid = -1; }
        else grid = cus;
    }
    if (grid < 0) return;
    (void)hipMemsetAsync((char*)d_ws + OFF_CTL, 0, CTL_BYTES, stream);
    Params p{};
    p.x = (const float*)d_in[0]; p.c = (const float*)d_in[1]; p.pos = (const int*)d_in[2]; p.ada_w = (const float*)d_in[3]; p.ada_b = (const float*)d_in[4];
    p.g1 = (const float*)d_in[5]; p.g2 = (const float*)d_in[6]; p.w_in = (const float*)d_in[7]; p.rgain = (const float*)d_in[8]; p.qg = (const float*)d_in[9];
    p.kg = (const float*)d_in[10]; p.og = (const float*)d_in[11]; p.w_out = (const float*)d_in[12]; p.wq = (const float*)d_in[13]; p.sk = (const float*)d_in[14];
    p.down = (const float*)d_in[15]; p.up = (const float*)d_in[16]; p.out = (float*)d_out; p.ws = (unsigned char*)d_ws;
    for (int i = 0; i < 32; ++i) {
        const double f = pow(10000.0, -(double)i / 32.0) / 6.283185307179586476925;
        float fh = (float)f; unsigned ub; memcpy(&ub, &fh, 4); ub &= 0xFFFFC000u; memcpy(&fh, &ub, 4);
        p.rc.fh[i] = fh; p.rc.fl[i] = (float)(f - (double)fh);
    }
    void* args[] = {&p};
    hipError_t e = hipLaunchCooperativeKernel((const void*)mk_fwd, dim3(grid), dim3(512), args, LDS_BYTES, stream);
    if (e != hipSuccess) fprintf(stderr, "kernel_launch: cooperative launch failed: %s (grid %d)\n", hipGetErrorString(e), grid);
}
```

```cpp
#include <hip/hip_runtime.h>
#include <stdint.h>
#include <math.h>
#include <cstdio>
#include <cstring>

namespace {
constexpr int T = 16384, D = 1024;
constexpr float EPS = 1e-6f;
typedef unsigned short bf16_t;
#define LAS __attribute__((address_space(3)))

__device__ __forceinline__ float bf2f(bf16_t b) { return __uint_as_float(((unsigned)b) << 16); }
__device__ __forceinline__ bf16_t f2bf(float f) { unsigned u = __float_as_uint(f); u += 0x7fffu + ((u >> 16) & 1u); return (bf16_t)(u >> 16); }
__device__ __forceinline__ float4 ld_nt4(const float* p) { typedef float f4v __attribute__((ext_vector_type(4))); const f4v v = __builtin_nontemporal_load((const f4v*)p); return make_float4(v[0], v[1], v[2], v[3]); }

__device__ __forceinline__ float lg2_head(int h) {
    const float x = __uint_as_float((unsigned)(127 - 5 - h) << 23);
    const float s = x * (1.f + x * (0.5f + x * (0.33333334f + x * (0.25f + x * (0.2f + x * 0.16666667f)))));
    return -s * 1.44269504089f;
}
struct RopeC { float fh[32], fl[32]; };
struct RetC { float lg2[8]; };

constexpr size_t MiB = 1u << 20;
constexpr size_t OFF_CTL = 0;
constexpr size_t CTL_BYTES = 64 * 1024;
constexpr size_t OFF_MOD = 64 * 1024, OFF_RINV1 = 128 * 1024, OFF_BIASF = 256 * 1024, OFF_ROPE = 1 * MiB;
constexpr size_t OFF_WINT = 6 * MiB;
constexpr size_t OFF_XB = 16 * MiB;
constexpr size_t OFF_YCAT = 160 * MiB;
constexpr size_t OFF_P = 48 * MiB;
constexpr size_t OFF_KV = 208 * MiB, OFF_ST = 224 * MiB;
constexpr size_t OFF_WEFFT = 240 * MiB;
constexpr size_t OFF_WOUTT = 13 * MiB;
constexpr size_t OFF_BIASQ = 272 * 1024;
constexpr size_t OFF_SWF = 320 * 1024;
constexpr size_t OFF_SQ = 336 * 1024;
constexpr size_t OFF_PMAX = 2 * MiB;
constexpr size_t OFF_RINV2Q = 3 * MiB;
constexpr size_t OFF_WEFFQ = 10 * MiB;
constexpr size_t OFF_X1Q = 16 * MiB;
constexpr int CTL_CNT = 4096, CTL_CMAX = 8192;
constexpr size_t OFF_XQ = 160 * MiB;
constexpr size_t OFF_DSC = 512 * 1024;
constexpr size_t OFF_BQPART = 576 * 1024;
constexpr size_t OFF_PART2 = 5 * MiB;
constexpr size_t OFF_X1B = 208 * MiB;
constexpr size_t OFF_IDS = 244 * MiB, OFF_GATES = 248 * MiB;
constexpr size_t OFF_Q8 = 192 * MiB;
constexpr int CONV_SPLIT = 0;
constexpr int LDS_BYTES = 163840;
constexpr int LDS_ST_OFF = LDS_BYTES - 16;

#define XB_TMO      128
#define XB_XCNT(j)  (256  + 64 * (j))
#define XB_XSUB(j)  (1280 + 64 * (j))
#define XB_XGEN(j)  (2304 + 64 * (j))
#define XB_TOP      3328
#define XB_TOPGEN   3392
#define XCD_BAR_WORDS 3456
#define XB_SPIN_CAP (1u << 20)
__device__ __forceinline__ unsigned xb_ld(unsigned* p)              { return __hip_atomic_load(p, __ATOMIC_RELAXED, __HIP_MEMORY_SCOPE_AGENT); }
__device__ __forceinline__ unsigned xb_add(unsigned* p, unsigned v) { return __hip_atomic_fetch_add(p, v, __ATOMIC_RELAXED, __HIP_MEMORY_SCOPE_AGENT); }
__device__ __forceinline__ unsigned xb_xcc_id() { return (unsigned)__builtin_amdgcn_s_getreg((3 << 11) | 20) & 0xFu; }
#define XB_SPIN(cond, bar) do { unsigned _sp = 0; while (cond) { __builtin_amdgcn_s_sleep(1); \
    if ((++_sp & 255u) == 0u) { if (xb_ld(&(bar)[XB_TMO])) break; if (_sp > XB_SPIN_CAP) { atomicAdd(&(bar)[XB_TMO], 1u); break; } } } } while (0)
struct XcdBarrier { unsigned* bar; unsigned x; volatile LAS unsigned* st; };
__device__ __forceinline__ XcdBarrier xcd_barrier_post(unsigned* bar, volatile LAS unsigned* st) {
    XcdBarrier b; b.bar = bar; b.x = xb_xcc_id(); b.st = st;
    if (threadIdx.x == 0) (void)xb_add(&bar[XB_XCNT(b.x)], 1u);
    return b;
}
__device__ __forceinline__ void xcd_barrier_complete(unsigned* bar, unsigned x, unsigned& nloc, unsigned& nx) {
    const unsigned G = gridDim.x * gridDim.y * gridDim.z;
    unsigned sum, cnt, mine, sp = 0u;
    for (;;) {
        sum = 0u; cnt = 0u; mine = 0u;
#pragma unroll
        for (unsigned j = 0; j < 16; ++j) { const unsigned c = xb_ld(&bar[XB_XCNT(j)]); sum += c; cnt += (c > 0u) ? 1u : 0u; mine = (j == x) ? c : mine; }
        if (sum == G) break;
        __builtin_amdgcn_s_sleep(1);
        if ((++sp & 255u) == 0u) { if (xb_ld(&bar[XB_TMO])) break; if (sp > XB_SPIN_CAP) { atomicAdd(&bar[XB_TMO], 1u); break; } }
    }
    nloc = mine > 0u ? mine : 1u; nx = cnt > 0u ? cnt : 1u;
}
__device__ __forceinline__ void xcd_barrier(const XcdBarrier& b) {
    asm volatile("s_waitcnt vmcnt(0)" ::: "memory");
    __syncthreads();
    if (threadIdx.x == 0) {
        unsigned* bar = b.bar;
        __builtin_amdgcn_s_waitcnt(0);
        unsigned nloc = b.st[0], nx = b.st[1];
        if (nloc == 0u) { xcd_barrier_complete(bar, b.x, nloc, nx); b.st[0] = nloc; b.st[1] = nx; }
        const unsigned old = xb_add(&bar[XB_XSUB(b.x)], 1u);
        const unsigned gen = old / nloc;
        if (old + 1u == (gen + 1u) * nloc) {
            __builtin_amdgcn_fence(__ATOMIC_RELEASE, "agent");
            asm volatile("s_waitcnt vmcnt(0)" ::: "memory");
            const unsigned og = xb_add(&bar[XB_TOP], 1u);
            const unsigned tg = og / nx;
            if (og + 1u == (tg + 1u) * nx) xb_add(&bar[XB_TOPGEN], 1u);
            else XB_SPIN(xb_ld(&bar[XB_TOPGEN]) == tg, bar);
            __builtin_amdgcn_fence(__ATOMIC_ACQUIRE, "agent");
            xb_add(&bar[XB_XGEN(b.x)], 1u);
            asm volatile("s_waitcnt vmcnt(0)" ::: "memory");
        } else {
            XB_SPIN(xb_ld(&bar[XB_XGEN(b.x)]) == gen, bar);
            __builtin_amdgcn_fence(__ATOMIC_ACQUIRE, "agent");
            asm volatile("s_waitcnt vmcnt(0)" ::: "memory");
        }
    }
    __syncthreads();
}


namespace pg8 {
#define PG8_LAS __attribute__((address_space(3)))
typedef short bf16x8 __attribute__((ext_vector_type(8)));
typedef float f32x4 __attribute__((ext_vector_type(4)));
typedef unsigned u32x4 __attribute__((ext_vector_type(4)));
typedef unsigned u32x2 __attribute__((ext_vector_type(2)));
constexpr int BM = 256, BK = 64, HALF = 128, HTB = HALF * BK * 2, STAGE_BYTES = 8 * HTB, NXCD = 8, WGM = 8;
__host__ __device__ __forceinline__ int lds_byte(int r, int c) { const int st = (r >> 4) * 2 + (c >> 5), rr = r & 15, cc = c & 31, ob = rr * 64 + cc * 2; return st * 1024 + (ob ^ (((ob >> 9) & 1) << 5)); }
__host__ __device__ __forceinline__ void stage_rc(int b, int& R, int& C) { const int st = b / 1024, sb = b % 1024, swz = sb ^ (((sb >> 9) & 1) << 5); R = (st >> 1) * 16 + swz / 64; C = (st & 1) * 32 + (swz % 64) / 2; }
__host__ __device__ __forceinline__ int perm32(int rho) { const int n = rho >> 4, i = rho & 15; return 8 * (i >> 2) + 4 * n + (i & 3); }
struct Unit { int pm, pn; };
struct Gemm { const bf16_t* A; const bf16_t* Bt; int M, N, K; };
struct StaticOrder {
    int nM, nN, nwg, G, c;
    __host__ __device__ void init(int M, int N, int G_, int c_) { nM = M / BM; nN = N / BM; nwg = nM * nN; G = G_; c = c_; }
    __host__ __device__ bool next(int i, Unit& u) const {
        const long L = (long)i * G + c; if (L >= nwg) return false;
        int wgid = (int)L; { const int q = nwg / NXCD, r = nwg % NXCD, xcd = wgid % NXCD, off = wgid / NXCD; wgid = (xcd < r ? xcd * (q + 1) : r * (q + 1) + (xcd - r) * q) + off; }
        const int nig = WGM * nN, gid = wgid / nig, fm = gid * WGM, gsz = (nM - fm) < WGM ? (nM - fm) : WGM;
        u.pm = fm + ((wgid % nig) % gsz); u.pn = (wgid % nig) / gsz; return true;
    }
    __device__ __forceinline__ void a_ready(const Unit&) const {}
    __device__ __forceinline__ void done(const Unit&) const {}
};
__device__ __forceinline__ unsigned cvt_pk_bf16(float lo, float hi) { unsigned r; asm volatile("v_cvt_pk_bf16_f32 %0, %1, %2" : "=v"(r) : "v"(lo), "v"(hi)); return r; }

typedef int i32x4 __attribute__((ext_vector_type(4)));
template <bool I8>
__device__ __forceinline__ f32x4 mma16(const bf16x8 b, const bf16x8 a, const f32x4 c) {
    if constexpr (I8) return __builtin_bit_cast(f32x4, __builtin_amdgcn_mfma_i32_16x16x64_i8(__builtin_bit_cast(i32x4, b), __builtin_bit_cast(i32x4, a), __builtin_bit_cast(i32x4, c), 0, 0, 0));
    else return __builtin_amdgcn_mfma_f32_16x16x32_bf16(b, a, c, 0, 0, 0);
}
template <class Epi, class Sched, bool I8 = false>
__device__ __forceinline__ void gemm_phase(PG8_LAS unsigned char* lds, const Gemm g, const Sched& S, const Epi& E) {
    int tid_ = threadIdx.x; asm volatile("" : "+v"(tid_));
    const int tid = tid_, wid = __builtin_amdgcn_readfirstlane(tid >> 6), lane = tid & 63, wr = wid >> 2, wc = wid & 3, fr = lane & 15, fq = lane >> 4;
    const int K = g.K, nt = K / BK;
    unsigned voffA[2], voffB[2];
#pragma unroll
    for (int i = 0; i < 2; ++i) { int R, C; stage_rc(tid * 16 + i * 8192, R, C); const int Rb = Epi::PERM ? ((R & ~31) + perm32(R & 31)) : R;
        voffA[i] = (unsigned)(R * K + C) * 2u; voffB[i] = (unsigned)(Rb * K + C) * 2u; }
    const size_t kstep = (size_t)(BK * 2);
    const size_t hstep = (size_t)HALF * K * 2;
    const size_t tstep = 2 * hstep;
    const unsigned ldsw = (unsigned)wid * 1024u;
    const int aoff = lds_byte(wr * 64 + fr, fq * 8), boff = lds_byte(wc * 32 + fr, fq * 8);
#define PG8_SA(b, h) (((b) * 2 + (h)) * HTB)
#define PG8_SB(b, h) ((4 + (b) * 2 + (h)) * HTB)
#define PG8_STAGE(bufoff, gbase, voff) do { _Pragma("unroll") for (int _i = 0; _i < 2; ++_i) \
        __builtin_amdgcn_global_load_lds((const unsigned*)((const char*)(gbase) + (voff)[_i]), (PG8_LAS unsigned*)(lds + (bufoff) + ldsw + _i * 8192), 16, 0, 0); } while (0)
#define PG8_LDA(dst, b, h) do { _Pragma("unroll") for (int m = 0; m < 4; ++m) _Pragma("unroll") for (int k = 0; k < 2; ++k) dst[m][k] = *(const PG8_LAS bf16x8*)(lds + PG8_SA(b, h) + aoff + m * 2048 + k * 1024); } while (0)
#define PG8_LDB(dst, b, h) do { _Pragma("unroll") for (int n = 0; n < 2; ++n) _Pragma("unroll") for (int k = 0; k < 2; ++k) dst[n][k] = *(const PG8_LAS bf16x8*)(lds + PG8_SB(b, h) + boff + n * 2048 + k * 1024); } while (0)
#define PG8_MMA(ai, bj, At, Bt) do { __builtin_amdgcn_s_setprio(1); _Pragma("unroll") for (int m = 0; m < 4; ++m) _Pragma("unroll") for (int n = 0; n < 2; ++n) _Pragma("unroll") for (int k = 0; k < 2; ++k) \
        acc[ai][bj][m][n] = mma16<I8>(Bt[n][k], At[m][k], acc[ai][bj][m][n]); __builtin_amdgcn_s_setprio(0); } while (0)
#define PG8_WAIT_V(n) asm volatile("s_waitcnt vmcnt(" #n ")" ::: "memory")
#define PG8_WAIT_L(n) asm volatile("s_waitcnt lgkmcnt(" #n ")" ::: "memory")
#define PG8_BAR __builtin_amdgcn_s_barrier()
#define PG8_SCHED __builtin_amdgcn_sched_barrier(0)
    Unit cur, nxt; int ui = 0;
    if (!S.next(0, cur)) return;
    f32x4 acc[2][2][4][2];
#pragma unroll
    for (int a = 0; a < 2; ++a)
#pragma unroll
        for (int b = 0; b < 2; ++b)
#pragma unroll
            for (int m = 0; m < 4; ++m)
#pragma unroll
                for (int n = 0; n < 2; ++n) acc[a][b][m][n] = (f32x4){0.f, 0.f, 0.f, 0.f};
    bf16x8 At[4][2], B0[2][2], B1[2][2];
    const char* cA = (const char*)g.A + (size_t)cur.pm * tstep; const char* cB = (const char*)g.Bt + (size_t)cur.pn * tstep;
    S.a_ready(cur);
    PG8_STAGE(PG8_SB(0, 0), cB, voffB); PG8_STAGE(PG8_SA(0, 0), cA, voffA); PG8_STAGE(PG8_SB(0, 1), cB + hstep, voffB); PG8_STAGE(PG8_SA(0, 1), cA + hstep, voffA);
    if (wr == 1) PG8_BAR;
    PG8_WAIT_V(4); PG8_BAR;
    PG8_STAGE(PG8_SB(1, 0), cB + kstep, voffB); PG8_STAGE(PG8_SA(1, 0), cA + kstep, voffA); PG8_STAGE(PG8_SB(1, 1), cB + hstep + kstep, voffB);
    PG8_WAIT_V(6); PG8_BAR;
    for (;;) {
        const bool has_next = S.next(ui + 1, nxt);
        const char* nA = has_next ? (const char*)g.A + (size_t)nxt.pm * tstep : cA; const char* nB = has_next ? (const char*)g.Bt + (size_t)nxt.pn * tstep : cB;
        for (int t = 0; t < nt; t += 2) {
            const bool last = (t == nt - 2);
            const char* a1 = cA + (size_t)(t + 1) * kstep;
            const char* a2 = last ? nA : cA + (size_t)(t + 2) * kstep; const char* b2 = last ? nB : cB + (size_t)(t + 2) * kstep;
            const char* a3 = a2 + kstep; const char* b3 = b2 + kstep;
            if (last && has_next) S.a_ready(nxt);
            PG8_LDB(B0, 0, 0); PG8_SCHED; PG8_LDA(At, 0, 0); PG8_STAGE(PG8_SA(1, 1), a1 + hstep, voffA);
            PG8_WAIT_L(8); PG8_BAR; PG8_WAIT_L(0); PG8_MMA(0, 0, At, B0); PG8_BAR; PG8_SCHED;
            PG8_LDB(B1, 0, 1); PG8_STAGE(PG8_SB(0, 0), b2, voffB);
            PG8_BAR; PG8_WAIT_L(0); PG8_MMA(0, 1, At, B1); PG8_BAR;
            PG8_LDA(At, 0, 1); PG8_STAGE(PG8_SA(0, 0), a2, voffA);
            PG8_BAR; PG8_WAIT_L(0); PG8_MMA(1, 0, At, B0); PG8_BAR; PG8_SCHED;
            PG8_STAGE(PG8_SB(0, 1), b2 + hstep, voffB);
            PG8_WAIT_V(6); PG8_BAR; PG8_MMA(1, 1, At, B1); PG8_BAR;
            PG8_LDB(B0, 1, 0); PG8_SCHED; PG8_LDA(At, 1, 0); PG8_STAGE(PG8_SA(0, 1), a2 + hstep, voffA);
            PG8_WAIT_L(8); PG8_BAR; PG8_WAIT_L(0); PG8_MMA(0, 0, At, B0); PG8_BAR; PG8_SCHED;
            PG8_LDB(B1, 1, 1); PG8_STAGE(PG8_SB(1, 0), b3, voffB);
            PG8_BAR; PG8_WAIT_L(0); PG8_MMA(0, 1, At, B1); PG8_BAR;
            PG8_LDA(At, 1, 1); PG8_STAGE(PG8_SA(1, 0), a3, voffA);
            PG8_BAR; PG8_WAIT_L(0); PG8_MMA(1, 0, At, B0); PG8_BAR; PG8_SCHED;
            PG8_STAGE(PG8_SB(1, 1), b3 + hstep, voffB);
            PG8_WAIT_V(6); PG8_BAR; PG8_MMA(1, 1, At, B1); PG8_BAR;
        }
        if constexpr (!Epi::AFTER_DRAIN) { E(acc, cur, wr, wc, fr, fq); S.done(cur); }
        if (!has_next) break;
#pragma unroll
        for (int a = 0; a < 2; ++a)
#pragma unroll
            for (int b = 0; b < 2; ++b)
#pragma unroll
                for (int m = 0; m < 4; ++m)
#pragma unroll
                    for (int n = 0; n < 2; ++n) acc[a][b][m][n] = (f32x4){0.f, 0.f, 0.f, 0.f};
        cur = nxt; cA = nA; cB = nB; ++ui;
    }
    PG8_WAIT_V(0);
    if (wr == 0) PG8_BAR;
    PG8_BAR;
    if constexpr (Epi::AFTER_DRAIN) { E.fused(acc, cur, wr, wc, fr, fq, lds, wid, lane); S.done(cur); }
#undef PG8_SA
#undef PG8_SB
#undef PG8_STAGE
#undef PG8_LDA
#undef PG8_LDB
#undef PG8_MMA
#undef PG8_WAIT_V
#undef PG8_WAIT_L
#undef PG8_BAR
#undef PG8_SCHED
}
}

__host__ __device__ __forceinline__ int cmap_in(int F) { return (F & ~255) + 128 * ((F >> 5) & 1) + 32 * ((F >> 6) & 3) + (F & 31); }
struct EpiInprojMF {
    static constexpr bool PERM = true, AFTER_DRAIN = false;
    bf16_t* P; const float* rinv; const float* bias_f; const int* pos; const float* ftab; const float* qg; const float* kg; const float* swf;
    __device__ __forceinline__ void operator()(pg8::f32x4 (&acc)[2][2][4][2], const pg8::Unit& u, int wr, int wc, int fr, int fq) const {
        typedef pg8::f32x4 f32x4;
        asm volatile("" : "+v"(fr), "+v"(fq));
        const int type = u.pn >> 1, head = 4 * (u.pn & 1) + wc, fb = 256 * u.pn + 64 * wc;
        {
            f32x4 sw[2][2];
#pragma unroll
            for (int bj = 0; bj < 2; ++bj)
#pragma unroll
                for (int n = 0; n < 2; ++n) sw[bj][n] = *(const f32x4*)(swf + fb + 32 * bj + 8 * fq + 4 * n);
#pragma unroll
            for (int ai = 0; ai < 2; ++ai)
#pragma unroll
                for (int bj = 0; bj < 2; ++bj)
#pragma unroll
                    for (int m = 0; m < 4; ++m)
#pragma unroll
                        for (int n = 0; n < 2; ++n) {
                            const pg8::i32x4 iv = __builtin_bit_cast(pg8::i32x4, acc[ai][bj][m][n]);
                            f32x4 fv; fv[0] = (float)iv[0]; fv[1] = (float)iv[1]; fv[2] = (float)iv[2]; fv[3] = (float)iv[3];
                            acc[ai][bj][m][n] = fv * sw[bj][n];
                        }
        }
        const size_t PSZ = (size_t)T * 512;
        const int rslot = (type == 0) ? 0 : (type == 1) ? 1 : (type == 2) ? 5 : (type == 3) ? 2 : (type == 4) ? 3 : (type == 5) ? 4 : 6;
        bf16_t* rowmaj = P + (size_t)rslot * PSZ;
        const int t0 = u.pm * 256 + wr * 64 + fr;
        f32x4 bv[2][2], gv[2][2], fh[2], fl[2];
#pragma unroll
        for (int bj = 0; bj < 2; ++bj)
#pragma unroll
            for (int n = 0; n < 2; ++n) bv[bj][n] = *(const f32x4*)(bias_f + fb + 32 * bj + 8 * fq + 4 * n);
        if (type <= 1) {
#pragma unroll
            for (int n = 0; n < 2; ++n) { fh[n] = *(const f32x4*)(ftab + 8 * fq + 4 * n); fl[n] = *(const f32x4*)(ftab + 32 + 8 * fq + 4 * n); }
        } else if (type == 4 || type == 5) {
            const float* gsrc = (type == 4) ? qg : kg;
#pragma unroll
            for (int bj = 0; bj < 2; ++bj)
#pragma unroll
                for (int n = 0; n < 2; ++n) gv[bj][n] = *(const f32x4*)(gsrc + 32 * bj + 8 * fq + 4 * n);
        }
#pragma unroll
        for (int ai = 0; ai < 2; ++ai) {
            float rv[4], pf[4];
#pragma unroll
            for (int m = 0; m < 4; ++m) { rv[m] = rinv[t0 + ai * 128 + m * 16]; pf[m] = (float)pos[t0 + ai * 128 + m * 16]; }
            asm volatile("" : "+v"(rv[0]), "+v"(rv[1]), "+v"(rv[2]), "+v"(rv[3]), "+v"(pf[0]), "+v"(pf[1]), "+v"(pf[2]), "+v"(pf[3]));
#pragma unroll
            for (int m = 0; m < 4; ++m) {
                const int t = t0 + ai * 128 + m * 16;
                const float r = rv[m];
                f32x4 v[2][2];
#pragma unroll
                for (int bj = 0; bj < 2; ++bj)
#pragma unroll
                    for (int n = 0; n < 2; ++n) v[bj][n] = acc[ai][bj][m][n] * r + bv[bj][n];
                if (type <= 1) {
                    const float sc = (type == 1) ? 0.125f : 1.f, pp = pf[m];
#pragma unroll
                    for (int n = 0; n < 2; ++n)
#pragma unroll
                        for (int j = 0; j < 4; ++j) {
                            const float rev = __builtin_amdgcn_fractf(__builtin_amdgcn_fractf(pp * fh[n][j]) + pp * fl[n][j]);
                            const float cs = __builtin_amdgcn_cosf(rev) * sc, sn = __builtin_amdgcn_sinf(rev) * sc;
                            const float x1 = v[0][n][j], x2 = v[1][n][j]; v[0][n][j] = x1 * cs - x2 * sn; v[1][n][j] = x2 * cs + x1 * sn;
                        }
                } else if (type == 3) {
#pragma unroll
                    for (int bj = 0; bj < 2; ++bj)
#pragma unroll
                        for (int n = 0; n < 2; ++n)
#pragma unroll
                            for (int j = 0; j < 4; ++j) { const float x = v[bj][n][j]; v[bj][n][j] = x * __builtin_amdgcn_rcpf(1.f + __builtin_amdgcn_exp2f(x * -1.44269504089f)); }
                } else if (type == 4 || type == 5) {
                    float ss = 0.f;
#pragma unroll
                    for (int bj = 0; bj < 2; ++bj)
#pragma unroll
                        for (int n = 0; n < 2; ++n)
#pragma unroll
                            for (int j = 0; j < 4; ++j) ss += v[bj][n][j] * v[bj][n][j];
                    ss += __shfl_xor(ss, 16); ss += __shfl_xor(ss, 32);
                    const float rn = (1.0f / sqrtf(ss * (1.f / 64.f) + EPS)) * ((type == 4) ? 0.125f * 1.44269504089f : 1.f);
#pragma unroll
                    for (int bj = 0; bj < 2; ++bj)
#pragma unroll
                        for (int n = 0; n < 2; ++n) v[bj][n] = v[bj][n] * rn * gv[bj][n];
                }
#pragma unroll
                for (int bj = 0; bj < 2; ++bj) {
                    pg8::u32x4 w; w.x = pg8::cvt_pk_bf16(v[bj][0][0], v[bj][0][1]); w.y = pg8::cvt_pk_bf16(v[bj][0][2], v[bj][0][3]);
                    w.z = pg8::cvt_pk_bf16(v[bj][1][0], v[bj][1][1]); w.w = pg8::cvt_pk_bf16(v[bj][1][2], v[bj][1][3]);
                    *(pg8::u32x4*)(rowmaj + (size_t)t * 512 + head * 64 + 32 * bj + 8 * fq) = w;
                }
            }
        }
    }
};

struct EpiOutprojMF {
    static constexpr bool PERM = false, AFTER_DRAIN = true;
    const float* xf; const float* gate1; bf16_t* x1b; float* part2;
    float* pmax; unsigned char* x1q; float* rinv2q; unsigned* ctl;
    __device__ __forceinline__ void operator()(const pg8::f32x4 (&)[2][2][4][2], const pg8::Unit&, int, int, int, int) const {}
    __device__ __forceinline__ void fused(pg8::f32x4 (&acc)[2][2][4][2], const pg8::Unit& u, int wr, int wc, int fr, int fq, PG8_LAS unsigned char* lds, int wid, int lane) const {
        typedef pg8::f32x4 f32x4;
        asm volatile("" : "+v"(fr), "+v"(fq), "+v"(lane));
        constexpr int LD = 260;
        PG8_LAS float* TL = (PG8_LAS float*)lds;
        const int colw = wc * 32 + 4 * fq;
        f32x4 gv[2][2];
#pragma unroll
        for (int bj = 0; bj < 2; ++bj)
#pragma unroll
            for (int n = 0; n < 2; ++n) gv[bj][n] = *(const f32x4*)(gate1 + u.pn * 256 + colw + bj * 128 + n * 16);
        pg8::u32x2 ow[2][16];
#pragma unroll
        for (int ai = 0; ai < 2; ++ai) {
            f32x4 xv[16];
            const size_t rowbase = (size_t)(u.pm * 256 + ai * 128 + 16 * wid) * D + u.pn * 256 + 4 * lane;
#pragma unroll
            for (int r = 0; r < 16; ++r) xv[r] = __builtin_nontemporal_load((const f32x4*)(xf + rowbase + (size_t)r * D));
#pragma unroll
            for (int m = 0; m < 4; ++m)
#pragma unroll
                for (int bj = 0; bj < 2; ++bj)
#pragma unroll
                    for (int n = 0; n < 2; ++n) *(PG8_LAS f32x4*)(TL + (64 * wr + 16 * m + fr) * LD + colw + bj * 128 + n * 16) = gv[bj][n] * acc[ai][bj][m][n];
            __syncthreads();
            float ssr[16], amr[16];
#pragma unroll
            for (int r = 0; r < 16; ++r) {
                const f32x4 g = *(PG8_LAS f32x4*)(TL + (16 * wid + r) * LD + 4 * lane);
                const f32x4 o = xv[r] + g;
                pg8::u32x2 w; w.x = pg8::cvt_pk_bf16(o[0], o[1]); w.y = pg8::cvt_pk_bf16(o[2], o[3]);
                *(pg8::u32x2*)(x1b + rowbase + (size_t)r * D) = w;
                ow[ai][r] = w;
                ssr[r] = o[0] * o[0] + o[1] * o[1] + o[2] * o[2] + o[3] * o[3];
                amr[r] = fmaxf(fmaxf(__uint_as_float((w.x << 16) & 0x7fffffffu), __uint_as_float(w.x & 0x7fff0000u)), fmaxf(__uint_as_float((w.y << 16) & 0x7fffffffu), __uint_as_float(w.y & 0x7fff0000u)));
            }
            {
                const bool b5 = lane & 32, b4 = lane & 16, b3 = lane & 8, b2 = lane & 4;
                float w8[8], w4[4], w2[2], w1;
#pragma unroll
                for (int i = 0; i < 8; ++i) w8[i] = (b5 ? ssr[8 + i] : ssr[i]) + __shfl_xor(b5 ? ssr[i] : ssr[8 + i], 32);
#pragma unroll
                for (int i = 0; i < 4; ++i) w4[i] = (b4 ? w8[4 + i] : w8[i]) + __shfl_xor(b4 ? w8[i] : w8[4 + i], 16);
#pragma unroll
                for (int i = 0; i < 2; ++i) w2[i] = (b3 ? w4[2 + i] : w4[i]) + __shfl_xor(b3 ? w4[i] : w4[2 + i], 8);
                w1 = (b2 ? w2[1] : w2[0]) + __shfl_xor(b2 ? w2[0] : w2[1], 4);
                w1 += __shfl_xor(w1, 2); w1 += __shfl_xor(w1, 1);
                part2[(size_t)(u.pm * 256 + ai * 128 + 16 * wid + (lane >> 2)) * 16 + u.pn * 4 + (lane & 3)] = ((lane & 3) == 0) ? w1 : 0.f;
#pragma unroll
                for (int i = 0; i < 8; ++i) w8[i] = fmaxf(b5 ? amr[8 + i] : amr[i], __shfl_xor(b5 ? amr[i] : amr[8 + i], 32));
#pragma unroll
                for (int i = 0; i < 4; ++i) w4[i] = fmaxf(b4 ? w8[4 + i] : w8[i], __shfl_xor(b4 ? w8[i] : w8[4 + i], 16));
#pragma unroll
                for (int i = 0; i < 2; ++i) w2[i] = fmaxf(b3 ? w4[2 + i] : w4[i], __shfl_xor(b3 ? w4[i] : w4[2 + i], 8));
                w1 = fmaxf(b2 ? w2[1] : w2[0], __shfl_xor(b2 ? w2[0] : w2[1], 4));
                w1 = fmaxf(w1, __shfl_xor(w1, 2)); w1 = fmaxf(w1, __shfl_xor(w1, 1));
                if ((lane & 3) == 0) pmax[(size_t)(u.pm * 256 + ai * 128 + 16 * wid + (lane >> 2)) * 4 + u.pn] = w1;
            }
            __syncthreads();
        }
        asm volatile("s_waitcnt vmcnt(0)" ::: "memory");
        __syncthreads();
        if (wid == 0 && lane == 0) {
            unsigned* c = ctl + CTL_CNT + 16 * u.pm;
            __builtin_amdgcn_fence(__ATOMIC_RELEASE, "agent");
            asm volatile("s_waitcnt vmcnt(0)" ::: "memory");
            (void)xb_add(c, 1u);
            XB_SPIN(xb_ld(c) < 4u, ctl);
            __builtin_amdgcn_fence(__ATOMIC_ACQUIRE, "agent");
        }
        __syncthreads();
        float qsl = 0.f;
        {
            const int row = u.pm * 256 + (lane >> 4 & 1) * 128 + 16 * wid + (lane & 15);
            const f32x4* pp = (const f32x4*)(part2 + (size_t)row * 16);
            const f32x4 p0 = pp[0], p1 = pp[1], p2 = pp[2], p3 = pp[3], pm4 = *(const f32x4*)(pmax + (size_t)row * 4);
            const float ssum = ((p0[0] + p0[1]) + (p0[2] + p0[3])) + ((p1[0] + p1[1]) + (p1[2] + p1[3])) + ((p2[0] + p2[1]) + (p2[2] + p2[3])) + ((p3[0] + p3[1]) + (p3[2] + p3[3]));
            const float am = fmaxf(fmaxf(pm4[0], pm4[1]), fmaxf(pm4[2], pm4[3]));
            qsl = (am > 0.f) ? 127.f / am : 0.f;
            if (u.pn == 0 && lane < 32) rinv2q[row] = (1.0f / sqrtf(ssum * (1.0f / D) + EPS)) * (am * (1.f / 127.f));
        }
#pragma unroll
        for (int ai = 0; ai < 2; ++ai)
#pragma unroll
            for (int r = 0; r < 16; ++r) {
                const float qs = __builtin_bit_cast(float, __builtin_amdgcn_readlane(__builtin_bit_cast(int, qsl), ai * 16 + r));
                const pg8::u32x2 w = ow[ai][r];
                const unsigned b0 = __float_as_uint(fmaf(__uint_as_float(w.x << 16), qs, 12582912.f)), b1 = __float_as_uint(fmaf(__uint_as_float(w.x & 0xffff0000u), qs, 12582912.f));
                const unsigned b2 = __float_as_uint(fmaf(__uint_as_float(w.y << 16), qs, 12582912.f)), b3 = __float_as_uint(fmaf(__uint_as_float(w.y & 0xffff0000u), qs, 12582912.f));
                *(unsigned*)(x1q + (size_t)(u.pm * 256 + ai * 128 + 16 * wid + r) * D + u.pn * 256 + 4 * lane) = (b0 & 255u) | ((b1 & 255u) << 8) | ((b2 & 255u) << 16) | (b3 << 24);
            }
    }
};

__device__ __forceinline__ unsigned pk2(float lo, float hi) { return (unsigned)f2bf(lo) | ((unsigned)f2bf(hi) << 16); }
template <bool FOLD, bool CMAP>
__device__ __forceinline__ void transpose_item(const float* W, int K, int N, bf16_t* WT, float* scr, int item, int lane, const float* sg, const float* sm) {
    const int nblk = N / 32, kb = item / nblk, nb = item % nblk, k0 = 64 * kb, n0 = 32 * nb;
    float4 v[8]; float f[8];
#pragma unroll
    for (int i = 0; i < 8; ++i) { const int kk = 8 * i + (lane >> 3); v[i] = *(const float4*)(W + (size_t)(k0 + kk) * N + n0 + 4 * (lane & 7));
        f[i] = FOLD ? sg[k0 + kk] * (1.f + sm[k0 + kk]) : 1.f; }
#pragma unroll
    for (int i = 0; i < 8; ++i) { const int kk = 8 * i + (lane >> 3); float* d = scr + kk * 33 + 4 * (lane & 7);
        d[0] = v[i].x * f[i]; d[1] = v[i].y * f[i]; d[2] = v[i].z * f[i]; d[3] = v[i].w * f[i]; }
    asm volatile("s_waitcnt lgkmcnt(0)" ::: "memory");
    const int c = lane & 7, r0 = CMAP ? cmap_in(n0) : n0;
#pragma unroll
    for (int j = 0; j < 4; ++j) { const int n = (lane >> 3) + 8 * j; const float* s = scr + (8 * c) * 33 + n;
        pg8::u32x4 o; o.x = pk2(s[0 * 33], s[1 * 33]); o.y = pk2(s[2 * 33], s[3 * 33]); o.z = pk2(s[4 * 33], s[5 * 33]); o.w = pk2(s[6 * 33], s[7 * 33]);
        *(pg8::u32x4*)(WT + (size_t)(r0 + n) * K + k0 + 8 * c) = o; }
    asm volatile("s_waitcnt lgkmcnt(0)" ::: "memory");
}
template <int NC4, class VF>
__device__ __forceinline__ void gemv_cols(unsigned char* lds, const VF vf, const float* W, const int N, const int u, float* dst, const float* add) {
    constexpr int RG = 512 / NC4;
    float (*red)[NC4 * 4] = (float (*)[NC4 * 4])lds;
    const int tid = threadIdx.x, c4 = tid % NC4, rg = tid / NC4;
    if (rg < RG) {
        float4 acc = {0.f, 0.f, 0.f, 0.f};
        for (int r = rg; r < 1024; r += RG) { const float s = vf(r); const float4 w = *(const float4*)(W + (size_t)r * N + u * NC4 * 4 + c4 * 4);
            acc.x += s * w.x; acc.y += s * w.y; acc.z += s * w.z; acc.w += s * w.w; }
        red[rg][c4 * 4 + 0] = acc.x; red[rg][c4 * 4 + 1] = acc.y; red[rg][c4 * 4 + 2] = acc.z; red[rg][c4 * 4 + 3] = acc.w;
    }
    __syncthreads();
    if (tid < NC4 * 4) { float s = 0.f; for (int i = 0; i < RG; ++i) s += red[i][tid]; dst[u * NC4 * 4 + tid] = s + (add ? add[u * NC4 * 4 + tid] : 0.f); }
    __syncthreads();
}
struct VfSilu { const float* c; __device__ __forceinline__ float operator()(int r) const { const float v = c[r]; return v / (1.f + expf(-v)); } };
struct VfVec { const float* v; __device__ __forceinline__ float operator()(int r) const { return v[r]; } };


typedef float f32x16 __attribute__((ext_vector_type(16)));
typedef pg8::bf16x8 bf16x8;
#define MFMA32(a, b, c) __builtin_amdgcn_mfma_f32_32x32x16_bf16((a), (b), (c), 0, 0, 0)
__device__ __forceinline__ bf16x8 pack_frag(const f32x16& v, int s) {
    pg8::u32x4 w;
    w.x = pg8::cvt_pk_bf16(v[8 * s + 0], v[8 * s + 1]); w.y = pg8::cvt_pk_bf16(v[8 * s + 2], v[8 * s + 3]);
    w.z = pg8::cvt_pk_bf16(v[8 * s + 4], v[8 * s + 5]); w.w = pg8::cvt_pk_bf16(v[8 * s + 6], v[8 * s + 7]);
    return __builtin_bit_cast(bf16x8, w);
}
__device__ __forceinline__ bf16x8 load_tfrag(const bf16_t* rowp, int tok) {
    const uint2 a = *(const uint2*)(rowp + tok), b = *(const uint2*)(rowp + tok + 8);
    pg8::u32x4 w; w.x = a.x; w.y = a.y; w.z = b.x; w.w = b.y;
    return __builtin_bit_cast(bf16x8, w);
}


__device__ __forceinline__ bf16x8 tr_frag(const unsigned char* a0, int rows2) {
    typedef short s16x4 __attribute__((ext_vector_type(4)));
    typedef __attribute__((address_space(3))) s16x4 lds_s16x4;
    const s16x4 lo = __builtin_amdgcn_ds_read_tr16_b64_v4i16((lds_s16x4*)a0);
    const s16x4 hi = __builtin_amdgcn_ds_read_tr16_b64_v4i16((lds_s16x4*)(a0 + rows2 * 144));
    const uint2 l2 = __builtin_bit_cast(uint2, lo), h2 = __builtin_bit_cast(uint2, hi);
    pg8::u32x4 fw; fw.x = l2.x; fw.y = l2.y; fw.z = h2.x; fw.w = h2.y;
    return __builtin_bit_cast(bf16x8, fw);
}

__device__ __forceinline__ void ins16(float (&s)[16], float x) {
#pragma unroll
    for (int i = 15; i >= 1; --i) s[i] = __builtin_amdgcn_fmed3f(s[i - 1], s[i], x);
    s[0] = fmaxf(s[0], x);
}


struct OneUnitOrder {
    pg8::StaticOrder base; int round;
    __device__ __forceinline__ bool next(int i, pg8::Unit& u) const { if (i != 0) return false; return base.next(round, u); }
    __device__ __forceinline__ void a_ready(const pg8::Unit&) const {}
    __device__ __forceinline__ void done(const pg8::Unit&) const {}
};
struct EpiTopkMF {
    static constexpr bool PERM = false, AFTER_DRAIN = true;
    const float* rinv2q; const float* sq; const float* bias_q; unsigned short* ids; float* gates;
    __device__ __forceinline__ void operator()(const pg8::f32x4 (&)[2][2][4][2], const pg8::Unit&, int, int, int, int) const {}
    __device__ __forceinline__ void fused(pg8::f32x4 (&acc)[2][2][4][2], const pg8::Unit& u, int wr, int wc, int fr, int fq, PG8_LAS unsigned char* lds, int wid, int lane) const {
        typedef pg8::f32x4 f32x4;
        constexpr int SLD = 260;
        PG8_LAS float* SC = (PG8_LAS float*)lds; PG8_LAS float* MG = (PG8_LAS float*)(lds + 128 * SLD * 4);
        const int tid = wid * 64 + lane, tok = tid & 255, hk = tid >> 8;
        float rinv[2][4];
#pragma unroll
        for (int ai = 0; ai < 2; ++ai)
#pragma unroll
            for (int m = 0; m < 4; ++m) {
                const int row = u.pm * 256 + ai * 128 + wr * 64 + m * 16 + fr;
                rinv[ai][m] = rinv2q[row];
            }
        float sl[16], mine[16];
#pragma unroll
        for (int p = 0; p < 2; ++p) {
            f32x4 bv[2], sv[2];
#pragma unroll
            for (int n = 0; n < 2; ++n) { bv[n] = *(const f32x4*)(bias_q + u.pn * 256 + p * 128 + wc * 32 + n * 16 + 4 * fq); sv[n] = *(const f32x4*)(sq + u.pn * 256 + p * 128 + wc * 32 + n * 16 + 4 * fq); }
#pragma unroll
            for (int ai = 0; ai < 2; ++ai)
#pragma unroll
                for (int m = 0; m < 4; ++m)
#pragma unroll
                    for (int n = 0; n < 2; ++n)
#pragma unroll
                        for (int j = 0; j < 4; ++j)
                            SC[(32 * wc + 16 * n + 4 * fq + j) * SLD + (128 * ai + 64 * wr + 16 * m + fr)] = (float)__builtin_bit_cast(pg8::i32x4, acc[ai][p][m][n])[j] * (rinv[ai][m] * sv[n][j]) + bv[n][j];
            __syncthreads();
#pragma unroll
            for (int i = 0; i < 16; ++i) sl[i] = -INFINITY;
#pragma unroll 8
            for (int k = 0; k < 64; ++k) { const int key = 64 * hk + k; const float x = SC[key * SLD + tok]; ins16(sl, __uint_as_float((__float_as_uint(x) & 0xFFFFFF80u) | (unsigned)key)); }
            if (hk != p) {
#pragma unroll
                for (int i = 0; i < 16; ++i) MG[i * 256 + tok] = sl[i];
            }
            __syncthreads();
            if (hk == p) {
#pragma unroll
                for (int i = 0; i < 16; ++i) ins16(sl, MG[i * 256 + tok]);
#pragma unroll
                for (int i = 0; i < 16; ++i) mine[i] = sl[i];
            }
            __syncthreads();
        }
        PG8_LAS float* X1 = SC; PG8_LAS float* TL = SC + 4096; PG8_LAS unsigned* I0 = (PG8_LAS unsigned*)(SC + 8192); PG8_LAS unsigned* I1 = (PG8_LAS unsigned*)(SC + 12288);
        if (hk) {
#pragma unroll
            for (int i = 0; i < 16; ++i) { X1[i * 256 + tok] = mine[i]; I1[i * 256 + tok] = __float_as_uint(mine[i]) & 0x7Fu; }
        } else {
#pragma unroll
            for (int i = 0; i < 16; ++i) I0[i * 256 + tok] = __float_as_uint(mine[i]) & 0x7Fu;
        }
        __syncthreads();
        if (!hk) {
            float s1m[16], tl[16];
#pragma unroll
            for (int i = 0; i < 16; ++i) { s1m[i] = __uint_as_float(__float_as_uint(X1[i * 256 + tok]) & 0xFFFFFF80u); mine[i] = __uint_as_float(__float_as_uint(mine[i]) & 0xFFFFFF80u); tl[i] = -INFINITY; }
#pragma unroll
            for (int a2 = 0; a2 < 16; ++a2)
#pragma unroll
                for (int b2 = 0; b2 < 16; ++b2)
                    if ((a2 + 1) * (b2 + 1) <= 16) ins16(tl, __uint_as_float((__float_as_uint(mine[a2] + s1m[b2]) & 0xFFFFFF00u) | (unsigned)(a2 * 16 + b2)));
#pragma unroll
            for (int i = 0; i < 16; ++i) TL[i * 256 + tok] = tl[i];
        }
        __syncthreads();
        if (hk) {
            float ev[16]; float sum = 0.f; unsigned cd[16];
#pragma unroll
            for (int j = 0; j < 16; ++j) { const unsigned bits = __float_as_uint(TL[j * 256 + tok]); cd[j] = bits & 0xFFu; ev[j] = __uint_as_float(bits & 0xFFFFFF00u); }
            const float mx = ev[0];
#pragma unroll
            for (int j = 0; j < 16; ++j) { ev[j] = __expf(ev[j] - mx); sum += ev[j]; }
            const float inv = 1.f / sum;
            unsigned idw[8];
#pragma unroll
            for (int j = 0; j < 16; ++j) {
                const unsigned id = I0[(cd[j] >> 4) * 256 + tok] * 128u + I1[(cd[j] & 15u) * 256 + tok];
                if (j & 1) idw[j >> 1] |= id << 16; else idw[j >> 1] = id;
                ev[j] *= inv;
            }
            const size_t t = (size_t)u.pm * 256 + tok;
            unsigned short* idp = ids + t * 128 + u.pn * 16; float* gp = gates + t * 128 + u.pn * 16;
            *(uint4*)idp = make_uint4(idw[0], idw[1], idw[2], idw[3]); *(uint4*)(idp + 8) = make_uint4(idw[4], idw[5], idw[6], idw[7]);
#pragma unroll
            for (int q = 0; q < 4; ++q) *(float4*)(gp + 4 * q) = make_float4(ev[4 * q], ev[4 * q + 1], ev[4 * q + 2], ev[4 * q + 3]);
        }
        __syncthreads();
    }
};


__device__ __forceinline__ void convert_tables(const float* down, const float* up, unsigned char* q8, bf16_t* dsc, int lane, int cw, int nconv, int r0, int r1) {
    for (int row0 = r0 + cw * 2; row0 < r1; row0 += nconv * 2) {
        float4 v[2][4];
#pragma unroll
        for (int rr = 0; rr < 2; ++rr) {
            const int row = row0 + rr, isup = row >> 14, e = row & 16383;
            const float* sp = (isup ? up : down) + (size_t)e * 1024 + lane * 4;
#pragma unroll
            for (int q = 0; q < 4; ++q) v[rr][q] = ld_nt4(sp + 256 * q);
        }
#pragma unroll
        for (int rr = 0; rr < 2; ++rr) {
            const int row = row0 + rr, isup = row >> 14, e = row & 16383;
            {
                float ss = 0.f;
#pragma unroll
                for (int q = 0; q < 4; ++q) ss += v[rr][q].x * v[rr][q].x + v[rr][q].y * v[rr][q].y + v[rr][q].z * v[rr][q].z + v[rr][q].w * v[rr][q].w;
#pragma unroll
                for (int o = 32; o > 0; o >>= 1) ss += __shfl_xor(ss, o);
                const float sigma = sqrtf(ss * (1.0f / 1024.0f));
                const float s = (sigma > 0.f) ? 7.5f / (2.6f * sigma) : 1.f;
#pragma unroll
                for (int q = 0; q < 4; ++q) {
                    const int n0 = (int)fminf(fmaxf(__builtin_rintf(v[rr][q].x * s), -8.f), 7.f) + 8, n1 = (int)fminf(fmaxf(__builtin_rintf(v[rr][q].y * s), -8.f), 7.f) + 8;
                    const int n2 = (int)fminf(fmaxf(__builtin_rintf(v[rr][q].z * s), -8.f), 7.f) + 8, n3 = (int)fminf(fmaxf(__builtin_rintf(v[rr][q].w * s), -8.f), 7.f) + 8;
                    const int h1 = isup ? ((n1 - 8) & 15) : n1, h3 = isup ? ((n3 - 8) & 15) : n3;
                    *(unsigned short*)(q8 + (size_t)isup * (8u << 20) + ((size_t)q * 16384 + e) * 128 + (lane & 7) * 16 + (lane >> 3) * 2) = (unsigned short)(n0 | (h1 << 4) | (n2 << 8) | (h3 << 12));
                }
                if (lane == 0) dsc[row] = f2bf(1.0f / s);
            }
        }
    }
}

struct Params {
    const float *x, *c; const int* pos; const float *ada_w, *ada_b, *g1, *g2, *w_in, *rgain, *qg, *kg, *og, *w_out, *wq, *sk, *down, *up;
    float* out; unsigned char* ws; RopeC rc;
};

__global__ void __launch_bounds__(512) mk_fwd(Params p) {
    extern __shared__ __attribute__((aligned(16))) unsigned char lds[];
    const int tid = threadIdx.x, lane = tid & 63, bid = blockIdx.x, G = gridDim.x; int wave = tid >> 6;
    unsigned char* ws = p.ws;
    float* mod = (float*)(ws + OFF_MOD); float* rinv1 = (float*)(ws + OFF_RINV1); float* ftab = (float*)(ws + OFF_ROPE);
    bf16_t* P = (bf16_t*)(ws + OFF_P); float* kv = (float*)(ws + OFF_KV); bf16_t* stT = (bf16_t*)(ws + OFF_ST); bf16_t* ycat = (bf16_t*)(ws + OFF_YCAT);
    bf16_t* Win_t = (bf16_t*)(ws + OFF_WINT); float* bias_f = (float*)(ws + OFF_BIASF);
    unsigned char* xq = ws + OFF_XQ; float* swf = (float*)(ws + OFF_SWF);
    float* sq = (float*)(ws + OFF_SQ); float* pmax = (float*)(ws + OFF_PMAX); float* rinv2q = (float*)(ws + OFF_RINV2Q); unsigned char* Weffq_t = ws + OFF_WEFFQ; unsigned char* x1q = ws + OFF_X1Q;
    unsigned* ctl = (unsigned*)(ws + OFF_CTL);
    bf16_t* Weff_t = (bf16_t*)(ws + OFF_WEFFT); bf16_t* Wout_t = (bf16_t*)(ws + OFF_WOUTT); float* bias_q = (float*)(ws + OFF_BIASQ); float* bq_part = (float*)(ws + OFF_BQPART);
    float* part2 = (float*)(ws + OFF_PART2); bf16_t* x1b = (bf16_t*)(ws + OFF_X1B); unsigned short* ids = (unsigned short*)(ws + OFF_IDS); unsigned char* q8 = ws + OFF_Q8; bf16_t* dsc = (bf16_t*)(ws + OFF_DSC); float* gates = (float*)(ws + OFF_GATES);
    const size_t PS = (size_t)T * 512;
    const bf16_t *Qr = P, *Kr = P + PS, *Gr = P + 2 * PS, *Qs = P + 3 * PS, *Ks = P + 4 * PS, *Vr = P + 5 * PS, *Vs = P + 6 * PS;
    float* out = p.out;

    if (tid < 4) ((LAS unsigned*)((LAS unsigned char*)lds + LDS_ST_OFF))[tid] = 0u;
    __syncthreads();
    XcdBarrier bar = xcd_barrier_post((unsigned*)(ws + OFF_CTL), (volatile LAS unsigned*)((LAS unsigned char*)lds + LDS_ST_OFF));

    for (int u = bid; u < 256; u += G) gemv_cols<6>(lds, VfSilu{p.c}, p.ada_w, 6144, u, mod, p.ada_b);
    for (int row0 = (bid * 8 + wave) * 2; row0 < T; row0 += G * 16) {
        float4 v[2][4];
#pragma unroll
        for (int rr = 0; rr < 2; ++rr)
#pragma unroll
            for (int j = 0; j < 4; ++j) v[rr][j] = ld_nt4(p.x + (size_t)(row0 + rr) * D + (lane + 64 * j) * 4);
#pragma unroll
        for (int rr = 0; rr < 2; ++rr) {
            float s = 0.f, am = 0.f;
#pragma unroll
            for (int j = 0; j < 4; ++j) { const float4 q = v[rr][j]; s += q.x * q.x + q.y * q.y + q.z * q.z + q.w * q.w;
                am = fmaxf(fmaxf(am, fmaxf(fabsf(q.x), fabsf(q.y))), fmaxf(fabsf(q.z), fabsf(q.w))); }
#pragma unroll
            for (int o = 32; o > 0; o >>= 1) { s += __shfl_xor(s, o); am = fmaxf(am, __shfl_xor(am, o)); }
            const float qs = (am > 0.f) ? 127.f / am : 0.f;
            unsigned* xqo = (unsigned*)(xq + (size_t)(row0 + rr) * D);
#pragma unroll
            for (int j = 0; j < 4; ++j) { const float4 q = v[rr][j];
                const unsigned b0 = __float_as_uint(fmaf(q.x, qs, 12582912.f)), b1 = __float_as_uint(fmaf(q.y, qs, 12582912.f)), b2 = __float_as_uint(fmaf(q.z, qs, 12582912.f)), b3 = __float_as_uint(fmaf(q.w, qs, 12582912.f));
                xqo[lane + 64 * j] = (b0 & 255u) | ((b1 & 255u) << 8) | ((b2 & 255u) << 16) | (b3 << 24); }
            if (lane == 0) rinv1[row0 + rr] = (1.0f / sqrtf(s * (1.0f / D) + EPS)) * (am * (1.f / 127.f));
        }
    }
    if (bid == 0 && tid == 0) {
#pragma unroll
        for (int i = 0; i < 32; ++i) { ftab[i] = p.rc.fh[i]; ftab[32 + i] = p.rc.fl[i]; }
    }
    xcd_barrier(bar);

    {
        for (int nb = bid; nb < 112; nb += G) {
            const int n0 = 32 * nb, r8 = lane >> 3, c = lane & 7, kw = 128 * wave;
            float* cm = (float*)(lds + 8 * 4608);
            unsigned* tl = (unsigned*)(lds + wave * 4608);
            float4 v[16];
#pragma unroll
            for (int i = 0; i < 16; ++i) { const int kk = 32 * (i >> 2) + 4 * r8 + (i & 3); v[i] = *(const float4*)(p.w_in + (size_t)(kw + kk) * 3584 + n0 + 4 * c); }
            float4 mx = {0.f, 0.f, 0.f, 0.f}, bs = {0.f, 0.f, 0.f, 0.f};
#pragma unroll
            for (int i = 0; i < 16; ++i) { const int kk = 32 * (i >> 2) + 4 * r8 + (i & 3); const float f = p.g1[kw + kk] * (1.f + mod[1024 + kw + kk]), sh = mod[kw + kk];
                bs.x += sh * v[i].x; bs.y += sh * v[i].y; bs.z += sh * v[i].z; bs.w += sh * v[i].w;
                v[i].x *= f; v[i].y *= f; v[i].z *= f; v[i].w *= f;
                mx.x = fmaxf(mx.x, fabsf(v[i].x)); mx.y = fmaxf(mx.y, fabsf(v[i].y)); mx.z = fmaxf(mx.z, fabsf(v[i].z)); mx.w = fmaxf(mx.w, fabsf(v[i].w)); }
#pragma unroll
            for (int o = 8; o < 64; o <<= 1) { mx.x = fmaxf(mx.x, __shfl_xor(mx.x, o)); mx.y = fmaxf(mx.y, __shfl_xor(mx.y, o)); mx.z = fmaxf(mx.z, __shfl_xor(mx.z, o)); mx.w = fmaxf(mx.w, __shfl_xor(mx.w, o));
                bs.x += __shfl_xor(bs.x, o); bs.y += __shfl_xor(bs.y, o); bs.z += __shfl_xor(bs.z, o); bs.w += __shfl_xor(bs.w, o); }
            if (lane < 8) { *(float4*)(cm + wave * 32 + 4 * c) = mx; *(float4*)(cm + 256 + wave * 32 + 4 * c) = bs; }
            __syncthreads();
            if (wave == 1 && lane < 8) { float4 t = {0.f, 0.f, 0.f, 0.f};
#pragma unroll
                for (int w2 = 0; w2 < 8; ++w2) { const float4 o = *(const float4*)(cm + 256 + w2 * 32 + 4 * c); t.x += o.x; t.y += o.y; t.z += o.z; t.w += o.w; }
                *(float4*)(bias_f + n0 + 4 * c) = t; }
#pragma unroll
            for (int w2 = 0; w2 < 8; ++w2) { const float4 o = *(const float4*)(cm + w2 * 32 + 4 * c); mx.x = fmaxf(mx.x, o.x); mx.y = fmaxf(mx.y, o.y); mx.z = fmaxf(mx.z, o.z); mx.w = fmaxf(mx.w, o.w); }
            if (wave == 0 && lane < 8) *(float4*)(swf + n0 + 4 * c) = make_float4(mx.x * (1.f / 127.f), mx.y * (1.f / 127.f), mx.z * (1.f / 127.f), mx.w * (1.f / 127.f));
            const float qx = (mx.x > 0.f) ? 127.f / mx.x : 0.f, qy = (mx.y > 0.f) ? 127.f / mx.y : 0.f, qz = (mx.z > 0.f) ? 127.f / mx.z : 0.f, qw = (mx.w > 0.f) ? 127.f / mx.w : 0.f;
#pragma unroll
            for (int a = 0; a < 4; ++a) {
                unsigned d[4];
#pragma unroll
                for (int j = 0; j < 4; ++j) {
                    const float qq = (j == 0) ? qx : (j == 1) ? qy : (j == 2) ? qz : qw;
                    unsigned w = 0;
#pragma unroll
                    for (int b = 0; b < 4; ++b) { const float4 t = v[4 * a + b]; const float e = (j == 0) ? t.x : (j == 1) ? t.y : (j == 2) ? t.z : t.w;
                        w |= (__float_as_uint(fmaf(e, qq, 12582912.f)) & 255u) << (8 * b); }
                    d[j] = w;
                }
#pragma unroll
                for (int j = 0; j < 4; ++j) tl[(4 * c + j) * 34 + 8 * a + r8] = d[j];
            }
            asm volatile("s_waitcnt lgkmcnt(0)" ::: "memory");
            const int rb = cmap_in(n0);
#pragma unroll
            for (int jj = 0; jj < 4; ++jj) { const int q = lane + 64 * jj, n = q >> 3, ch = q & 7;
                const uint2 lo = *(const uint2*)(tl + n * 34 + 4 * ch), hi = *(const uint2*)(tl + n * 34 + 4 * ch + 2);
                pg8::u32x4 o; o.x = lo.x; o.y = lo.y; o.z = hi.x; o.w = hi.y;
                *(pg8::u32x4*)((unsigned char*)Win_t + (size_t)(rb + n) * 1024 + kw + 16 * ch) = o; }
            __syncthreads();
        }
    }
    xcd_barrier(bar);

    {
        pg8::Gemm g{(const bf16_t*)xq, Win_t, T, 3584, 512}; pg8::StaticOrder S; S.init(T, 3584, G, bid);
        EpiInprojMF E{P, rinv1, bias_f, p.pos, ftab, p.qg, p.kg, swf};
        pg8::gemm_phase<EpiInprojMF, pg8::StaticOrder, true>((PG8_LAS unsigned char*)lds, g, S, E);
        const int nidle = (G > 128) ? G - 128 : G, ib = (G > 128) ? bid - 128 : bid;
        {
            float* scr = (float*)(lds + wave * 16384);
            if (ib >= 0) for (int it = ib * 8 + wave; it < 16 * 32; it += nidle * 8) transpose_item<false, false>(p.w_out, 1024, 1024, Wout_t, scr, it, lane, nullptr, nullptr);
            __syncthreads();
        }
        if (ib >= 0) for (int wu = ib; wu < 256; wu += nidle) {
            const int hp = wu >> 4, blk = wu & 15, i0 = blk * 64;
            __syncthreads();
            unsigned char* Wt = lds; unsigned char* St = lds + 64 * 272; float* bred = (float*)(lds + 64 * 272 + 128 * 272);
            for (int e4 = tid; e4 < 2048; e4 += 512) { const int r = e4 >> 5, c4 = e4 & 31; const float4 v = *(const float4*)(p.wq + (size_t)(i0 + r) * 2048 + hp * 128 + 4 * c4);
                *(uint2*)(Wt + r * 272 + c4 * 8) = make_uint2(pk2(v.x, v.y), pk2(v.z, v.w)); }
            for (int e4 = tid; e4 < 4096; e4 += 512) { const int r = e4 >> 5, c4 = e4 & 31; const float4 v = *(const float4*)(p.sk + ((size_t)hp * 128 + r) * 128 + 4 * c4);
                *(uint2*)(St + r * 272 + c4 * 8) = make_uint2(pk2(v.x, v.y), pk2(v.z, v.w)); }
            __syncthreads();
            const int rt = wave >> 2, ct = wave & 3, l31 = lane & 31, hf = lane >> 5;
            f32x16 C;
#pragma unroll
            for (int r = 0; r < 16; ++r) C[r] = 0.f;
#pragma unroll
            for (int s8 = 0; s8 < 8; ++s8) C = MFMA32(*(const bf16x8*)(Wt + (32 * rt + l31) * 272 + (16 * s8 + 8 * hf) * 2), *(const bf16x8*)(St + (32 * ct + l31) * 272 + (16 * s8 + 8 * hf) * 2), C);
            float bsum = 0.f; unsigned amx = 0u;
            bf16_t* wcol = Weff_t + (size_t)(hp * 128 + 32 * ct + l31) * 1024 + i0 + 32 * rt + 4 * hf;
#pragma unroll
            for (int g4 = 0; g4 < 4; ++g4) {
                const int i = i0 + 32 * rt + 8 * g4 + 4 * hf;
                const float4 gg = *(const float4*)(p.g2 + i), sc = *(const float4*)(mod + 4096 + i), sh = *(const float4*)(mod + 3072 + i);
                const float c0 = C[4 * g4], c1 = C[4 * g4 + 1], c2 = C[4 * g4 + 2], c3 = C[4 * g4 + 3];
                bsum += sh.x * c0 + sh.y * c1 + sh.z * c2 + sh.w * c3;
                const uint2 wv = make_uint2(pk2(c0 * gg.x * (1.f + sc.x), c1 * gg.y * (1.f + sc.y)), pk2(c2 * gg.z * (1.f + sc.z), c3 * gg.w * (1.f + sc.w)));
                *(uint2*)(wcol + 8 * g4) = wv;
                amx = max(max(amx, (wv.x << 16) & 0x7fffffffu), max(wv.x & 0x7fff0000u, max((wv.y << 16) & 0x7fffffffu, wv.y & 0x7fff0000u)));
            }
            amx = max(amx, (unsigned)__shfl_xor((int)amx, 32));
            if (hf == 0) (void)__hip_atomic_fetch_max(ctl + CTL_CMAX + hp * 128 + 32 * ct + l31, amx, __ATOMIC_RELAXED, __HIP_MEMORY_SCOPE_AGENT);
            bsum += __shfl_xor(bsum, 32);
            if (hf == 0) bred[rt * 128 + 32 * ct + l31] = bsum;
            __syncthreads();
            if (tid < 128) bq_part[(size_t)blk * 2048 + hp * 128 + tid] = bred[tid] + bred[128 + tid];
        }
        __syncthreads();
        if (ib >= 0) convert_tables(p.down, p.up, q8, dsc, lane, ib * 8 + wave, nidle * 8, 0, CONV_SPLIT);
    }
    xcd_barrier(bar);
    wave = threadIdx.x >> 6; asm volatile("" : "+v"(wave));

    {
        const int gw = __builtin_amdgcn_readfirstlane(bid * 8 + wave), NGW = G * 8, l31 = lane & 31, hf = lane >> 5;
        const int wv0 = __builtin_amdgcn_readfirstlane(wave);
        for (int U = gw; U < 1024; U += NGW) {
            const int n = U >> 3, h = U & 7;
            f32x16 C[2][2];
#pragma unroll
            for (int a = 0; a < 2; ++a)
#pragma unroll
                for (int b = 0; b < 2; ++b)
#pragma unroll
                    for (int r = 0; r < 16; ++r) C[a][b][r] = 0.f;
            unsigned char* Kt = lds + wv0 * 9216; unsigned char* Vt = Kt + 4608;
            const int r8 = lane >> 3, pc = lane & 7, trq = (lane & 15) >> 2, trp = lane & 3, trd = (lane >> 4) & 1;
            const char* kbase = (const char*)(Kr + (size_t)n * 128 * 512 + h * 64); const char* vbase = (const char*)(Vr + (size_t)n * 128 * 512 + h * 64);
            const unsigned loff = (unsigned)(r8 * 512 + pc * 8) * 2u;
            const float lg = lg2_head(h);
            pg8::u32x4 gK[4], gV[4];
#pragma unroll
            for (int i = 0; i < 4; ++i) { gK[i] = *(const pg8::u32x4*)(kbase + (loff + i * 8192u)); gV[i] = *(const pg8::u32x4*)(vbase + (loff + i * 8192u)); }
            for (int sb4 = 0; sb4 < 4; ++sb4) {
#pragma unroll
                for (int i = 0; i < 4; ++i) { *(pg8::u32x4*)(Kt + (8 * i + r8) * 144 + pc * 16) = gK[i]; *(pg8::u32x4*)(Vt + (8 * i + r8) * 144 + pc * 16) = gV[i]; }
                { const int sn = (sb4 < 3) ? sb4 + 1 : sb4;
#pragma unroll
                  for (int i = 0; i < 4; ++i) { gK[i] = *(const pg8::u32x4*)(kbase + (size_t)sn * 32768 + (loff + i * 8192u)); gV[i] = *(const pg8::u32x4*)(vbase + (size_t)sn * 32768 + (loff + i * 8192u)); } }
#pragma unroll
                for (int s = 0; s < 2; ++s) {
                    bf16x8 Af[2], Bf[2];
#pragma unroll
                    for (int a = 0; a < 2; ++a) {
                        Af[a] = tr_frag(Vt + (16 * s + 8 * hf + trq) * 144 + (32 * a + 16 * trd + 4 * trp) * 2, 4);
                        const bf16x8 kraw = tr_frag(Kt + (16 * s + 8 * hf + trq) * 144 + (32 * a + 16 * trd + 4 * trp) * 2, 4);
                        const pg8::u32x4 kw = __builtin_bit_cast(pg8::u32x4, kraw); const unsigned kk[4] = {kw.x, kw.y, kw.z, kw.w};
                        pg8::u32x4 o; unsigned* op = (unsigned*)&o;
#pragma unroll
                        for (int e2 = 0; e2 < 4; ++e2) {
                            const int j0 = 32 * sb4 + 16 * s + 8 * hf + 2 * e2;
                            const float z0 = __builtin_amdgcn_exp2f((float)(127 - j0) * lg), z1 = __builtin_amdgcn_exp2f((float)(126 - j0) * lg);
                            op[e2] = pg8::cvt_pk_bf16(__uint_as_float(kk[e2] << 16) * z0, __uint_as_float(kk[e2] & 0xffff0000u) * z1);
                        }
                        Bf[a] = __builtin_bit_cast(bf16x8, o);
                    }
#pragma unroll
                    for (int a = 0; a < 2; ++a)
#pragma unroll
                        for (int b = 0; b < 2; ++b) C[a][b] = MFMA32(Af[a], Bf[b], C[a][b]);
                }
            }
            float* dst = kv + (size_t)(n * 8 + h) * 4096;
#pragma unroll
            for (int a = 0; a < 2; ++a)
#pragma unroll
                for (int b = 0; b < 2; ++b)
#pragma unroll
                    for (int r = 0; r < 16; ++r) dst[(32 * a + (r & 3) + 8 * (r >> 2) + 4 * hf) * 64 + 32 * b + l31] = C[a][b][r];
        }
        bf16x8 Tri[2];
        {
            pg8::u32x4 w0, w1; unsigned* p0 = (unsigned*)&w0; unsigned* p1 = (unsigned*)&w1;
#pragma unroll
            for (int e2 = 0; e2 < 4; ++e2) {
                unsigned a0 = 0, a1 = 0;
#pragma unroll
                for (int q = 0; q < 2; ++q) { const int e = 2 * e2 + q, ip = 8 * (e >> 2) + 4 * hf + (e & 3);
                    a0 |= ((ip > l31) ? 0x3F80u : 0u) << (16 * q); a1 |= ((16 + ip > l31) ? 0x3F80u : 0u) << (16 * q); }
                p0[e2] = a0; p1[e2] = a1;
            }
            Tri[0] = __builtin_bit_cast(bf16x8, w0); Tri[1] = __builtin_bit_cast(bf16x8, w1);
        }
        const bool sb_local = (G % 8 == 0) && (4096 % G == 0) && ((4096 / G) % 8 == 0);
        const int sb_per_wave = sb_local ? 4096 / G / 8 : (4096 + NGW - 1 - gw) / NGW;
        const int wv = __builtin_amdgcn_readfirstlane(wave);
        for (int ps = 0; ps < sb_per_wave; ++ps) {
            const int U = sb_local ? 0 : gw + ps * NGW;
            const int h = sb_local ? (bid & 7) : (U & 7), qt = sb_local ? (bid >> 3) * (4096 / G) + ps * 8 + wv : (U >> 3), q0 = qt * 32;
            f32x16 O[2];
#pragma unroll
            for (int r = 0; r < 16; ++r) { O[0][r] = 0.f; O[1][r] = 0.f; }
            float carry = 0.f;
            unsigned char* Kt = lds + wv * 9216; unsigned char* Vt = Kt + 4608;
            const int r8 = lane >> 3, pc = lane & 7;
            const char* kbase = (const char*)(Ks + h * 64); const char* vbase = (const char*)(Vs + h * 64);
            const unsigned loff = (unsigned)(r8 * 512 + pc * 8) * 2u;
            pg8::u32x4 gK[4], gV[4];
            bf16x8 Qf[4];
            {
                const char* qbase = (const char*)(Qs + h * 64);
#pragma unroll
                for (int i = 0; i < 4; ++i) gK[i] = *(const pg8::u32x4*)(qbase + (size_t)qt * 32768 + (loff + i * 8192u));
#pragma unroll
                for (int i = 0; i < 4; ++i) *(pg8::u32x4*)(Kt + (8 * i + r8) * 144 + pc * 16) = gK[i];
#pragma unroll
                for (int s = 0; s < 4; ++s) Qf[s] = *(const bf16x8*)(Kt + l31 * 144 + 32 * s + 16 * hf);
            }
#pragma unroll
            for (int i = 0; i < 4; ++i) { gK[i] = *(const pg8::u32x4*)(kbase + (size_t)qt * 32768 + (loff + i * 8192u)); gV[i] = *(const pg8::u32x4*)(vbase + (size_t)qt * 32768 + (loff + i * 8192u)); }
            const int trq = (lane & 15) >> 2, trp = lane & 3, trd = (lane >> 4) & 1;
            for (int kb = qt; kb >= 0; --kb) {
#pragma unroll
                for (int i = 0; i < 4; ++i) { *(pg8::u32x4*)(Kt + (8 * i + r8) * 144 + pc * 16) = gK[i]; *(pg8::u32x4*)(Vt + (8 * i + r8) * 144 + pc * 16) = gV[i]; }
                {
                    const int kbn = (kb > 0) ? kb - 1 : 0;
#pragma unroll
                    for (int i = 0; i < 4; ++i) { gK[i] = *(const pg8::u32x4*)(kbase + (size_t)kbn * 32768 + (loff + i * 8192u)); gV[i] = *(const pg8::u32x4*)(vbase + (size_t)kbn * 32768 + (loff + i * 8192u)); }
                }
                bf16x8 Kf[4], Vf[2][2];
#pragma unroll
                for (int s = 0; s < 4; ++s) Kf[s] = *(const bf16x8*)(Kt + l31 * 144 + 32 * s + 16 * hf);
#pragma unroll
                for (int s = 0; s < 2; ++s)
#pragma unroll
                    for (int dt = 0; dt < 2; ++dt) {
                        Vf[s][dt] = tr_frag(Vt + (16 * s + 4 * hf + trq) * 144 + (32 * dt + 16 * trd + 4 * trp) * 2, 8);
                    }
                f32x16 S;
#pragma unroll
                for (int r = 0; r < 16; ++r) S[r] = 0.f;
#pragma unroll
                for (int s = 0; s < 4; ++s) S = MFMA32(Kf[s], Qf[s], S);
                const bool diag = (kb == qt);
                f32x16 sp, lb;
                float csum = 0.f;
                if (diag) {
#pragma unroll
                    for (int r = 0; r < 16; ++r) {
                        const int i = (r & 3) + 8 * (r >> 2) + 4 * hf;
                        const float z = S[r];
                        const float l1p = __builtin_amdgcn_logf(1.0f + __builtin_amdgcn_exp2f(-fabsf(z)));
                        const float spv = (i < l31) ? (fmaxf(z, 0.f) + l1p) : 0.f;
                        sp[r] = spv; lb[r] = (i < l31) ? (fminf(z, 0.f) - l1p) : -INFINITY; csum += spv;
                    }
                } else {
#pragma unroll
                    for (int r = 0; r < 16; ++r) {
                        const float z = S[r];
                        const float l1p = __builtin_amdgcn_logf(1.0f + __builtin_amdgcn_exp2f(-fabsf(z)));
                        const float spv = fmaxf(z, 0.f) + l1p;
                        sp[r] = spv; lb[r] = fminf(z, 0.f) - l1p; csum += spv;
                    }
                }
                f32x16 Rt;
#pragma unroll
                for (int r = 0; r < 16; ++r) Rt[r] = carry;
#pragma unroll
                for (int s = 0; s < 2; ++s) Rt = MFMA32(Tri[s], pack_frag(sp, s), Rt);
                f32x16 wv;
#pragma unroll
                for (int r = 0; r < 16; ++r) wv[r] = __builtin_amdgcn_exp2f(lb[r] - Rt[r]);
#pragma unroll
                for (int s = 0; s < 2; ++s) { const bf16x8 wp = pack_frag(wv, s);
#pragma unroll
                    for (int dt = 0; dt < 2; ++dt) O[dt] = MFMA32(Vf[s][dt], wp, O[dt]); }
                csum += __shfl_xor(csum, 32);
                carry += csum;
                if (__all(carry > 127.f)) break;
            }
            float ss = 0.f;
#pragma unroll
            for (int r = 0; r < 16; ++r) ss += O[0][r] * O[0][r] + O[1][r] * O[1][r];
            ss += __shfl_xor(ss, 32);
            const float rn = 1.0f / sqrtf(ss * (1.f / 64.f) + EPS);
#pragma unroll
            for (int dt = 0; dt < 2; ++dt)
#pragma unroll
                for (int g4 = 0; g4 < 4; ++g4) {
                    const int d = 32 * dt + 8 * g4 + 4 * hf;
                    const float4 gn = *(const float4*)(p.og + d);
                    uint2 w; w.x = pg8::cvt_pk_bf16(O[dt][4 * g4] * rn * gn.x, O[dt][4 * g4 + 1] * rn * gn.y); w.y = pg8::cvt_pk_bf16(O[dt][4 * g4 + 2] * rn * gn.z, O[dt][4 * g4 + 3] * rn * gn.w);
                    *(uint2*)(Kt + l31 * 144 + d * 2) = w;
                }
#pragma unroll
            for (int i = 0; i < 4; ++i) *(pg8::u32x4*)(ycat + (size_t)(q0 + 8 * i + r8) * 1024 + 512 + h * 64 + pc * 8) = *(const pg8::u32x4*)(Kt + (8 * i + r8) * 144 + pc * 16);
        }
    }
    xcd_barrier(bar);

    if (bid == 255 % G) for (int n = tid; n < 2048; n += 512) { float s = 0.f;
#pragma unroll
        for (int b8 = 0; b8 < 16; ++b8) s += bq_part[(size_t)b8 * 2048 + n];
        bias_q[n] = s; }
    if (bid >= 64) for (int row = (bid - 64) * 8 + wave; row < 2048; row += (G - 64) * 8) {
        const float am = __uint_as_float(ctl[CTL_CMAX + row]), qs = (am > 0.f) ? 127.f / am : 0.f;
        const pg8::u32x4 a = *(const pg8::u32x4*)(Weff_t + (size_t)row * 1024 + 16 * lane), b = *(const pg8::u32x4*)(Weff_t + (size_t)row * 1024 + 16 * lane + 8);
        pg8::u32x4 o;
#define QB(w) ((__float_as_uint(fmaf(__uint_as_float((w) << 16), qs, 12582912.f)) & 255u) | ((__float_as_uint(fmaf(__uint_as_float((w) & 0xffff0000u), qs, 12582912.f)) & 255u) << 8))
        o.x = QB(a.x) | (QB(a.y) << 16); o.y = QB(a.z) | (QB(a.w) << 16); o.z = QB(b.x) | (QB(b.y) << 16); o.w = QB(b.z) | (QB(b.w) << 16);
#undef QB
        *(pg8::u32x4*)(Weffq_t + (size_t)row * 1024 + 16 * lane) = o;
        if (lane == 0) sq[row] = am * (1.f / 127.f);
    }
    if (G > 64 && bid >= 64) convert_tables(p.down, p.up, q8, dsc, lane, (bid - 64) * 8 + wave, (G - 64) * 8, CONV_SPLIT, 32768);
    else if (G <= 64) convert_tables(p.down, p.up, q8, dsc, lane, bid * 8 + wave, G * 8, CONV_SPLIT, 32768);
    for (int idx = bid * 512 + tid; idx < 32768; idx += G * 512) {
        const int h = idx >> 12;
        const float cd = exp2f(128.f * lg2_head(h));
        float s = 0.f;
        for (int n0 = 0; n0 < 128; n0 += 32) {
            float kvv[32];
#pragma unroll
            for (int q = 0; q < 32; ++q) kvv[q] = kv[(size_t)(n0 + q) * 32768 + idx];
#pragma unroll
            for (int q = 0; q < 32; ++q) { stT[(size_t)(n0 + q) * 32768 + idx] = f2bf(s); s = cd * s + kvv[q]; }
        }
    }
    xcd_barrier(bar);

    {
        const int gw = __builtin_amdgcn_readfirstlane(bid * 8 + wave), NGW = G * 8, l31 = lane & 31, hf = lane >> 5;
        const int wv4 = __builtin_amdgcn_readfirstlane(wave);
        for (int W2 = gw; W2 < 2048; W2 += NGW) {
            const int nh = W2 >> 1, n = nh >> 3, h = nh & 7;
            const float lg = lg2_head(h);
#pragma unroll 1
            for (int pass = 0; pass < 2; ++pass) {
                const int qt = (W2 & 1) ? (pass ? 2 : 1) : (pass ? 3 : 0);
                const int il = qt * 32 + l31, tq = n * 128 + il;
                unsigned char* Kt = lds + wv4 * 9216; unsigned char* Vt = Kt + 4608;
                const int r8 = lane >> 3, pc = lane & 7, trq = (lane & 15) >> 2, trp = lane & 3, trd = (lane >> 4) & 1;
                const unsigned loff = (unsigned)(r8 * 512 + pc * 8) * 2u;
                pg8::u32x4 gK[4], gV[4];
                bf16x8 Qf[4];
                {
                    const char* qbase = (const char*)(Qr + (size_t)(n * 128 + qt * 32) * 512 + h * 64);
                    const char* sbase = (const char*)(stT + (size_t)nh * 4096) + (unsigned)(r8 * 64 + pc * 8) * 2u;
#pragma unroll
                    for (int i = 0; i < 4; ++i) gK[i] = *(const pg8::u32x4*)(qbase + (loff + i * 8192u));
#pragma unroll
                    for (int i = 0; i < 4; ++i) *(pg8::u32x4*)(Kt + (8 * i + r8) * 144 + pc * 16) = gK[i];
#pragma unroll
                    for (int s = 0; s < 4; ++s) Qf[s] = *(const bf16x8*)(Kt + l31 * 144 + 32 * s + 16 * hf);
#pragma unroll
                    for (int i = 0; i < 4; ++i) { gK[i] = *(const pg8::u32x4*)(sbase + i * 1024u); gV[i] = *(const pg8::u32x4*)(sbase + 4096u + i * 1024u); }
#pragma unroll
                    for (int i = 0; i < 4; ++i) { *(pg8::u32x4*)(Kt + (8 * i + r8) * 144 + pc * 16) = gK[i]; *(pg8::u32x4*)(Kt + (32 + 8 * i + r8) * 144 + pc * 16) = gV[i]; }
                }
                f32x16 O[2];
#pragma unroll
                for (int r = 0; r < 16; ++r) { O[0][r] = 0.f; O[1][r] = 0.f; }
#pragma unroll
                for (int s = 0; s < 4; ++s)
#pragma unroll
                    for (int dt = 0; dt < 2; ++dt) O[dt] = MFMA32(*(const bf16x8*)(Kt + (32 * dt + l31) * 144 + 32 * s + 16 * hf), Qf[s], O[dt]);
                const float xi = exp2f((float)(il + 1) * lg);
#pragma unroll
                for (int r = 0; r < 16; ++r) { O[0][r] *= xi; O[1][r] *= xi; }
                const char* kbase = (const char*)(Kr + (size_t)n * 128 * 512 + h * 64); const char* vbase = (const char*)(Vr + (size_t)n * 128 * 512 + h * 64);
#pragma unroll
                for (int i = 0; i < 4; ++i) { gK[i] = *(const pg8::u32x4*)(kbase + (loff + i * 8192u)); gV[i] = *(const pg8::u32x4*)(vbase + (loff + i * 8192u)); }
                for (int jb = 0; jb <= qt; ++jb) {
#pragma unroll
                    for (int i = 0; i < 4; ++i) { *(pg8::u32x4*)(Kt + (8 * i + r8) * 144 + pc * 16) = gK[i]; *(pg8::u32x4*)(Vt + (8 * i + r8) * 144 + pc * 16) = gV[i]; }
                    { const int jn = (jb < qt) ? jb + 1 : jb;
#pragma unroll
                      for (int i = 0; i < 4; ++i) { gK[i] = *(const pg8::u32x4*)(kbase + (size_t)jn * 32768 + (loff + i * 8192u)); gV[i] = *(const pg8::u32x4*)(vbase + (size_t)jn * 32768 + (loff + i * 8192u)); } }
                    bf16x8 Kf[4], Vf[2][2];
#pragma unroll
                    for (int s = 0; s < 4; ++s) Kf[s] = *(const bf16x8*)(Kt + l31 * 144 + 32 * s + 16 * hf);
#pragma unroll
                    for (int s = 0; s < 2; ++s)
#pragma unroll
                        for (int dt = 0; dt < 2; ++dt) Vf[s][dt] = tr_frag(Vt + (16 * s + 4 * hf + trq) * 144 + (32 * dt + 16 * trd + 4 * trp) * 2, 8);
                    f32x16 S;
#pragma unroll
                    for (int r = 0; r < 16; ++r) S[r] = 0.f;
#pragma unroll
                    for (int s = 0; s < 4; ++s) S = MFMA32(Kf[s], Qf[s], S);
#pragma unroll
                    for (int r = 0; r < 16; ++r) {
                        const int jl = jb * 32 + (r & 3) + 8 * (r >> 2) + 4 * hf, dl = il - jl;
                        S[r] = (dl >= 0) ? S[r] * __builtin_amdgcn_exp2f((float)dl * lg) : 0.f;
                    }
#pragma unroll
                    for (int s = 0; s < 2; ++s) { const bf16x8 wp = pack_frag(S, s);
#pragma unroll
                        for (int dt = 0; dt < 2; ++dt) O[dt] = MFMA32(Vf[s][dt], wp, O[dt]); }
                }
                float sm = 0.f;
#pragma unroll
                for (int r = 0; r < 16; ++r) sm += O[0][r] + O[1][r];
                sm += __shfl_xor(sm, 32);
                const float mean = sm * (1.f / 64.f);
                float vs = 0.f;
#pragma unroll
                for (int r = 0; r < 16; ++r) { const float d0 = O[0][r] - mean, d1 = O[1][r] - mean; vs += d0 * d0 + d1 * d1; }
                vs += __shfl_xor(vs, 32);
                const float rstd = 1.0f / sqrtf(vs * (1.f / 64.f) + EPS);
                {
                    const char* gbase = (const char*)(Gr + (size_t)(n * 128 + qt * 32) * 512 + h * 64);
#pragma unroll
                    for (int i = 0; i < 4; ++i) gV[i] = *(const pg8::u32x4*)(gbase + (loff + i * 8192u));
#pragma unroll
                    for (int i = 0; i < 4; ++i) *(pg8::u32x4*)(Vt + (8 * i + r8) * 144 + pc * 16) = gV[i];
                }
#pragma unroll
                for (int dt = 0; dt < 2; ++dt)
#pragma unroll
                    for (int g4 = 0; g4 < 4; ++g4) {
                        const int e = 32 * dt + 8 * g4 + 4 * hf;
                        const float4 gn = *(const float4*)(p.rgain + h * 64 + e);
                        const uint2 gg = *(const uint2*)(Vt + l31 * 144 + e * 2);
                        const float g0 = __uint_as_float(gg.x << 16), g1 = __uint_as_float(gg.x & 0xffff0000u), g2v = __uint_as_float(gg.y << 16), g3 = __uint_as_float(gg.y & 0xffff0000u);
                        uint2 w;
                        w.x = pg8::cvt_pk_bf16((O[dt][4 * g4] - mean) * rstd * gn.x * g0, (O[dt][4 * g4 + 1] - mean) * rstd * gn.y * g1);
                        w.y = pg8::cvt_pk_bf16((O[dt][4 * g4 + 2] - mean) * rstd * gn.z * g2v, (O[dt][4 * g4 + 3] - mean) * rstd * gn.w * g3);
                        *(uint2*)(Kt + l31 * 144 + e * 2) = w;
                    }
#pragma unroll
                for (int i = 0; i < 4; ++i) *(pg8::u32x4*)(ycat + (size_t)(n * 128 + qt * 32 + 8 * i + r8) * 1024 + h * 64 + pc * 8) = *(const pg8::u32x4*)(Kt + (8 * i + r8) * 144 + pc * 16);
            }
        }
    }
    xcd_barrier(bar);

    {
        pg8::Gemm g{ycat, Wout_t, T, 1024, 1024}; pg8::StaticOrder S; S.init(T, 1024, G, bid);
        EpiOutprojMF E{p.x, mod + 2048, x1b, part2, pmax, x1q, rinv2q, ctl};
        pg8::gemm_phase<EpiOutprojMF, pg8::StaticOrder>((PG8_LAS unsigned char*)lds, g, S, E);
    }
    xcd_barrier(bar);

    for (int round = 0; round < 2; ++round) {
        pg8::Gemm g{(const bf16_t*)x1q, (const bf16_t*)Weffq_t, T, 2048, 512}; OneUnitOrder S; S.base.init(T, 2048, G, bid); S.round = round;
        EpiTopkMF E{rinv2q, sq, bias_q, ids, gates};
        pg8::gemm_phase<EpiTopkMF, OneUnitOrder, true>((PG8_LAS unsigned char*)lds, g, S, E);
    }
    xcd_barrier(bar);

    {
        constexpr int IDS_LD = 136, ACT_LD = 136;
        const float* scale2 = mod + 4096; const float* shift2 = mod + 3072; const float* gate2 = mod + 5120;
        unsigned short* ids_l = (unsigned short*)lds; float* act_l = (float*)(lds + 32768);
        bf16_t* ds_l = (bf16_t*)(lds + 69632);
        const int t0 = bid * 64, tt = lane >> 3, sub = lane & 7, tl = wave * 8 + tt, t = t0 + tl;
        for (int e = tid; e < 1024; e += 512) { const int r = e >> 4, c8 = e & 15; *(uint4*)(ids_l + r * IDS_LD + c8 * 8) = *(const uint4*)(ids + (size_t)(t0 + r) * 128 + c8 * 8); }
        for (int e = tid; e < 64 * ACT_LD; e += 512) act_l[e] = 0.f;
        for (int e = tid; e < 4096; e += 512) ((uint4*)ds_l)[e] = ((const uint4*)dsc)[e];
        float* s2_l = (float*)(lds + 143360); float* sh2_l = s2_l + 1024; float* gt2_l = s2_l + 2048;
        for (int e = tid; e < 1024; e += 512) { s2_l[e] = p.g2[e] * (1.f + scale2[e]); sh2_l[e] = shift2[e]; gt2_l[e] = gate2[e]; }
        __syncthreads();
        float ri;
        { const float4* pp = (const float4*)(part2 + (size_t)t * 16); const float4 p0 = pp[0], p1 = pp[1], p2 = pp[2], p3 = pp[3];
          const float ssum = ((p0.x + p0.y) + (p0.z + p0.w)) + ((p1.x + p1.y) + (p1.z + p1.w)) + ((p2.x + p2.y) + (p2.z + p2.w)) + ((p3.x + p3.y) + (p3.z + p3.w));
          ri = 1.0f / sqrtf(ssum * (1.0f / D) + EPS); }
        const unsigned short* myids = ids_l + tl * IDS_LD;
        float* myact = act_l + tl * ACT_LD;
        const bool s4 = (sub & 4) != 0, s2 = (sub & 2) != 0, s1 = (sub & 1) != 0;
        const unsigned suboff = (unsigned)sub * 16u;
        typedef float f32x2 __attribute__((ext_vector_type(2)));
#define P9_LOAD(W, JB) do { const uint4 idv_ = *(const uint4*)(myids + 8 * (JB)); const unsigned idw_[4] = {idv_.x, idv_.y, idv_.z, idv_.w}; \
        _Pragma("unroll") for (int k_ = 0; k_ < 8; ++k_) { const unsigned id_ = (idw_[k_ >> 1] >> (16 * (k_ & 1))) & 0xffffu; W[k_] = *(const uint4*)(sbase + (id_ * 128u + suboff)); } } while (0)
#define P9_DOWN4(W, JB) do { int pd_[8]; \
        _Pragma("unroll") for (int k_ = 0; k_ < 8; ++k_) { const unsigned ww_[4] = {W[k_].x, W[k_].y, W[k_].z, W[k_].w}; int a0_ = 0, a1_ = 0; \
            _Pragma("unroll") for (int m_ = 0; m_ < 4; ++m_) { a0_ = __builtin_amdgcn_sdot4(hpe[m_], (int)(ww_[m_] & 0x0F0F0F0Fu), a0_, false); a1_ = __builtin_amdgcn_sdot4(hpo[m_], (int)((ww_[m_] >> 4) & 0x0F0F0F0Fu), a1_, false); } \
            pd_[k_] = a0_ + a1_ - hoff; } \
        int r4_[4], r2_[2]; \
        _Pragma("unroll") for (int k_ = 0; k_ < 4; ++k_) { const int snd_ = s4 ? pd_[k_] : pd_[k_ + 4], kp_ = s4 ? pd_[k_ + 4] : pd_[k_]; r4_[k_] = kp_ + __shfl_xor(snd_, 4); } \
        _Pragma("unroll") for (int k_ = 0; k_ < 2; ++k_) { const int snd_ = s2 ? r4_[k_] : r4_[k_ + 2], kp_ = s2 ? r4_[k_ + 2] : r4_[k_]; r2_[k_] = kp_ + __shfl_xor(snd_, 2); } \
        { const int snd_ = s1 ? r2_[0] : r2_[1], kp_ = s1 ? r2_[1] : r2_[0]; myact[8 * (JB) + sub] += (float)(kp_ + __shfl_xor(snd_, 1)) * hscale; } } while (0)
        uint2 xnx[8];
#pragma unroll
        for (int q = 0; q < 8; ++q) xnx[q] = *(const uint2*)(x1b + (size_t)t * D + 4 * sub + 32 * q);
        float gtv[16];
#pragma unroll
        for (int jb = 0; jb < 16; ++jb) gtv[jb] = gates[(size_t)t * 128 + 8 * jb + sub];
        const unsigned char* sbase = q8;
        uint4 wA[8], wB[8];
        P9_LOAD(wA, 0);
        for (int c = 0; c < 4; ++c) {
            uint2 xcur[8];
#pragma unroll
            for (int q = 0; q < 8; ++q) xcur[q] = xnx[q];
            { const int cn = (c < 3) ? c + 1 : c;
#pragma unroll
              for (int q = 0; q < 8; ++q) xnx[q] = *(const uint2*)(x1b + (size_t)t * D + 256 * cn + 4 * sub + 32 * q); }
            float hf[8][4]; float hmax = 0.f;
#pragma unroll
            for (int q = 0; q < 8; ++q) {
                const int col = 256 * c + 4 * sub + 32 * q;
                const uint2 xw = xcur[q];
                const float4 sv = *(const float4*)(s2_l + col), sh = *(const float4*)(sh2_l + col);
                hf[q][0] = __uint_as_float(xw.x << 16) * ri * sv.x + sh.x; hf[q][1] = __uint_as_float(xw.x & 0xffff0000u) * ri * sv.y + sh.y;
                hf[q][2] = __uint_as_float(xw.y << 16) * ri * sv.z + sh.z; hf[q][3] = __uint_as_float(xw.y & 0xffff0000u) * ri * sv.w + sh.w;
                hmax = fmaxf(hmax, fmaxf(fmaxf(fabsf(hf[q][0]), fabsf(hf[q][1])), fmaxf(fabsf(hf[q][2]), fabsf(hf[q][3]))));
            }
            hmax = fmaxf(hmax, __shfl_xor(hmax, 1)); hmax = fmaxf(hmax, __shfl_xor(hmax, 2)); hmax = fmaxf(hmax, __shfl_xor(hmax, 4));
            const float hinv = (hmax > 0.f) ? 127.0f / hmax : 0.f, hscale = hmax * (1.0f / 127.0f);
            int hq[8][4];
#pragma unroll
            for (int q = 0; q < 8; ++q)
#pragma unroll
                for (int j = 0; j < 4; ++j) hq[q][j] = (int)__builtin_rintf(hf[q][j] * hinv);
            int hpe[4], hpo[4], hoff = 0;
#pragma unroll
            for (int m = 0; m < 4; ++m) {
                hpe[m] = (hq[2 * m][0] & 255) | ((hq[2 * m][2] & 255) << 8) | ((hq[2 * m + 1][0] & 255) << 16) | ((hq[2 * m + 1][2] & 255) << 24);
                hpo[m] = (hq[2 * m][1] & 255) | ((hq[2 * m][3] & 255) << 8) | ((hq[2 * m + 1][1] & 255) << 16) | ((hq[2 * m + 1][3] & 255) << 24);
            }
#pragma unroll
            for (int q = 0; q < 8; ++q) hoff += (hq[q][0] + hq[q][1]) + (hq[q][2] + hq[q][3]);
            hoff *= 8;
#pragma unroll 1
            for (int jb = 0; jb < 16; jb += 2) {
                P9_LOAD(wB, jb + 1);
                P9_DOWN4(wA, jb);
                if (jb + 2 < 16) P9_LOAD(wA, jb + 2);
                else { sbase = (c < 3) ? q8 + (size_t)(c + 1) * (16384 * 128) : q8 + (8u << 20); P9_LOAD(wA, 0); }
                P9_DOWN4(wB, jb + 1);
            }
        }
#undef P9_DOWN4
        signed char* aq_l = (signed char*)(lds + 135168);
        float avv[16]; float amax = 0.f;
#pragma unroll
        for (int jb = 0; jb < 16; ++jb) {
            const int j = 8 * jb + sub; const unsigned id = myids[j];
            const float a = myact[j] * bf2f(ds_l[id]);
            const float av = fabsf(a), tq = __builtin_amdgcn_rcpf(av * 0.2316418882f + 1.0f);
            float ql = tq * 0.5307027145f + (-0.7265760135f); ql = ql * tq + 0.7107068705f; ql = ql * tq + (-0.142248368f); ql = ql * tq + 0.127414796f; ql = ql * tq;
            const float mm = a * (ql * exp2f(a * a * (-0.72134752044f)));
            const float ge = (a < 0.f) ? mm : (a - mm);
            avv[jb] = ge * gtv[jb] * bf2f(ds_l[16384 + id]);
            amax = fmaxf(amax, fabsf(avv[jb]));
        }
        amax = fmaxf(amax, __shfl_xor(amax, 1)); amax = fmaxf(amax, __shfl_xor(amax, 2)); amax = fmaxf(amax, __shfl_xor(amax, 4));
        const float ainv = (amax > 0.f) ? 127.0f / amax : 0.f, ascale = amax * (1.0f / 127.0f);
        int aqsum = 0;
#pragma unroll
        for (int jb = 0; jb < 16; ++jb) { const int aqv = (int)__builtin_rintf(avv[jb] * ainv); aq_l[tl * 128 + 8 * jb + sub] = (signed char)aqv; aqsum += aqv; }
        aqsum += __shfl_xor(aqsum, 1); aqsum += __shfl_xor(aqsum, 2); aqsum += __shfl_xor(aqsum, 4);
        __syncthreads();
#define P9_PERM(HI, LO, SEL) __builtin_amdgcn_perm((HI), (LO), (SEL))
#define P9_T4(E0, E1, E2, E3, T0, T1, T2, T3) do { const unsigned p0_ = P9_PERM(E1, E0, 0x05010400u), p1_ = P9_PERM(E1, E0, 0x07030602u), p2_ = P9_PERM(E3, E2, 0x05010400u), p3_ = P9_PERM(E3, E2, 0x07030602u); \
        T0 = P9_PERM(p2_, p0_, 0x05040100u); T1 = P9_PERM(p2_, p0_, 0x07060302u); T2 = P9_PERM(p3_, p1_, 0x05040100u); T3 = P9_PERM(p3_, p1_, 0x07060302u); } while (0)
#define P9_UP4(W, JB) do { const uint2 aq8_ = *(const uint2*)(aq_l + tl * 128 + 8 * (JB)); const int aq4_[2] = {(int)aq8_.x, (int)aq8_.y}; \
        _Pragma("unroll") for (int g_ = 0; g_ < 2; ++g_) { \
            _Pragma("unroll") for (int m_ = 0; m_ < 4; ++m_) { \
                const unsigned w0_ = ((const unsigned*)&W[4 * g_ + 0])[m_], w1_ = ((const unsigned*)&W[4 * g_ + 1])[m_], w2_ = ((const unsigned*)&W[4 * g_ + 2])[m_], w3_ = ((const unsigned*)&W[4 * g_ + 3])[m_]; \
                unsigned t_[4]; \
                P9_T4(w0_, w1_, w2_, w3_, t_[0], t_[1], t_[2], t_[3]); \
                _Pragma("unroll") for (int k_ = 0; k_ < 4; ++k_) { \
                    oraw[4 * m_ + k_] = __builtin_amdgcn_sdot4(aq4_[g_], (int)t_[k_], oraw[4 * m_ + k_], false); \
                    olo[4 * m_ + k_] = __builtin_amdgcn_sdot4(aq4_[g_], (int)(t_[k_] & 0x0F0F0F0Fu), olo[4 * m_ + k_], false); } } } } while (0)
        for (int c = 0; c < 4; ++c) {
            int oraw[16], olo[16];
#pragma unroll
            for (int q = 0; q < 16; ++q) { oraw[q] = 0; olo[q] = 0; }
            uint2 xres[8];
#pragma unroll
            for (int q = 0; q < 8; ++q) xres[q] = *(const uint2*)(x1b + (size_t)t * D + 256 * c + 4 * sub + 32 * q);
#pragma unroll 1
            for (int jb = 0; jb < 16; jb += 2) {
                P9_LOAD(wB, jb + 1);
                P9_UP4(wA, jb);
                if (jb + 2 < 16) P9_LOAD(wA, jb + 2);
                else if (c < 3) { sbase = q8 + (8u << 20) + (size_t)(c + 1) * (16384 * 128); P9_LOAD(wA, 0); }
                P9_UP4(wB, jb + 1);
            }
#pragma unroll
            for (int q = 0; q < 8; ++q) {
                const int col = 256 * c + 4 * sub + 32 * q;
                float* op = out + (size_t)t * D + col;
                const uint2 xw = xres[q]; const float4 xv = make_float4(__uint_as_float(xw.x << 16), __uint_as_float(xw.x & 0xffff0000u), __uint_as_float(xw.y << 16), __uint_as_float(xw.y & 0xffff0000u)); const float4 gt = *(const float4*)(gt2_l + col);
                const int m = q >> 1, k0 = 2 * (q & 1);
                const int v0 = olo[4 * m + k0] - 8 * aqsum, v1 = (oraw[4 * m + k0] - olo[4 * m + k0]) >> 4, v2 = olo[4 * m + k0 + 1] - 8 * aqsum, v3 = (oraw[4 * m + k0 + 1] - olo[4 * m + k0 + 1]) >> 4;
                float4 r;
                r.x = xv.x + gt.x * ((float)v0 * ascale); r.y = xv.y + gt.y * ((float)v1 * ascale); r.z = xv.z + gt.z * ((float)v2 * ascale); r.w = xv.w + gt.w * ((float)v3 * ascale);
                *(float4*)op = r;
            }
        }
#undef P9_LOAD
#undef P9_UP4
#undef P9_T4
#undef P9_PERM
    }
}
}

extern "C" void kernel_launch(void* const* d_in, const int* in_sizes, int n_in, void* d_out, int out_size, void* d_ws, size_t ws_size, hipStream_t stream) {
    static int grid = 0;
    if (grid == 0) {
        int dev = 0, cus = 0, per_cu = 0;
        (void)hipGetDevice(&dev);
        (void)hipDeviceGetAttribute(&cus, hipDeviceAttributeMultiprocessorCount, dev);
        (void)hipFuncSetAttribute((const void*)mk_fwd, hipFuncAttributeMaxDynamicSharedMemorySize, LDS_BYTES);
        (void)hipOccupancyMaxActiveBlocksPerMultiprocessor(&per_cu, (const void*)mk_fwd, 512, LDS_BYTES);
        if (per_cu < 1 || cus != 256) { fprintf(stderr, "kernel_launch: needs 256 CUs with one resident workgroup each (cus %d, per_cu %d)\n", cus, per_cu); grid = -1; }
        else grid = cus;
    }
    if (grid < 0) return;
    (void)hipMemsetAsync((char*)d_ws + OFF_CTL, 0, CTL_BYTES, stream);
    Params p{};
    p.x = (const float*)d_in[0]; p.c = (const float*)d_in[1]; p.pos = (const int*)d_in[2]; p.ada_w = (const float*)d_in[3]; p.ada_b = (const float*)d_in[4];
    p.g1 = (const float*)d_in[5]; p.g2 = (const float*)d_in[6]; p.w_in = (const float*)d_in[7]; p.rgain = (const float*)d_in[8]; p.qg = (const float*)d_in[9];
    p.kg = (const float*)d_in[10]; p.og = (const float*)d_in[11]; p.w_out = (const float*)d_in[12]; p.wq = (const float*)d_in[13]; p.sk = (const float*)d_in[14];
    p.down = (const float*)d_in[15]; p.up = (const float*)d_in[16]; p.out = (float*)d_out; p.ws = (unsigned char*)d_ws;
    for (int i = 0; i < 32; ++i) {
        const double f = pow(10000.0, -(double)i / 32.0) / 6.283185307179586476925;
        float fh = (float)f; unsigned ub; memcpy(&ub, &fh, 4); ub &= 0xFFFFC000u; memcpy(&fh, &ub, 4);
        p.rc.fh[i] = fh; p.rc.fl[i] = (float)(f - (double)fh);
    }
    void* args[] = {&p};
    hipError_t e = hipLaunchCooperativeKernel((const void*)mk_fwd, dim3(grid), dim3(512), args, LDS_BYTES, stream);
    if (e != hipSuccess) fprintf(stderr, "kernel_launch: cooperative launch failed: %s (grid %d)\n", hipGetErrorString(e), grid);
}
```

```cpp
#include <hip/hip_runtime.h>
#include <stdint.h>
#include <math.h>
#include <cstdio>
#include <cstring>

namespace {
constexpr int T = 16384, D = 1024;
constexpr float EPS = 1e-6f;
typedef unsigned short bf16_t;
#define LAS __attribute__((address_space(3)))

__device__ __forceinline__ float bf2f(bf16_t b) { return __uint_as_float(((unsigned)b) << 16); }
__device__ __forceinline__ bf16_t f2bf(float f) { unsigned u = __float_as_uint(f); u += 0x7fffu + ((u >> 16) & 1u); return (bf16_t)(u >> 16); }
__device__ __forceinline__ float4 ld_nt4(const float* p) { typedef float f4v __attribute__((ext_vector_type(4))); const f4v v = __builtin_nontemporal_load((const f4v*)p); return make_float4(v[0], v[1], v[2], v[3]); }

__device__ __forceinline__ float lg2_head(int h) {
    const float x = __uint_as_float((unsigned)(127 - 5 - h) << 23);
    const float s = x * (1.f + x * (0.5f + x * (0.33333334f + x * (0.25f + x * (0.2f + x * 0.16666667f)))));
    return -s * 1.44269504089f;
}
struct RopeC { float fh[32], fl[32]; };
struct RetC { float lg2[8]; };

constexpr size_t MiB = 1u << 20;
constexpr size_t OFF_CTL = 0;
constexpr size_t CTL_BYTES = 64 * 1024;
constexpr size_t OFF_MOD = 64 * 1024, OFF_RINV1 = 128 * 1024, OFF_BIASF = 256 * 1024, OFF_ROPE = 1 * MiB;
constexpr size_t OFF_WINT = 6 * MiB;
constexpr size_t OFF_XB = 16 * MiB;
constexpr size_t OFF_YCAT = 160 * MiB;
constexpr size_t OFF_P = 48 * MiB;
constexpr size_t OFF_KV = 208 * MiB, OFF_ST = 224 * MiB;
constexpr size_t OFF_WEFFT = 240 * MiB;
constexpr size_t OFF_WOUTT = 13 * MiB;
constexpr size_t OFF_BIASQ = 272 * 1024;
constexpr size_t OFF_SWF = 320 * 1024;
constexpr size_t OFF_SQ = 336 * 1024;
constexpr size_t OFF_PMAX = 2 * MiB;
constexpr size_t OFF_RINV2Q = 3 * MiB;
constexpr size_t OFF_WEFFQ = 10 * MiB;
constexpr size_t OFF_X1Q = 16 * MiB;
constexpr int CTL_CNT = 4096, CTL_CMAX = 8192;
constexpr size_t OFF_XQ = 160 * MiB;
constexpr size_t OFF_DSC = 512 * 1024;
constexpr size_t OFF_BQPART = 576 * 1024;
constexpr size_t OFF_PART2 = 5 * MiB;
constexpr size_t OFF_X1B = 208 * MiB;
constexpr size_t OFF_IDS = 244 * MiB, OFF_GATES = 248 * MiB;
constexpr size_t OFF_Q8 = 192 * MiB;
constexpr int CONV_SPLIT = 0;
constexpr int LDS_BYTES = 163840;
constexpr int LDS_ST_OFF = LDS_BYTES - 16;

#define XB_TMO      128
#define XB_XCNT(j)  (256  + 64 * (j))
#define XB_XSUB(j)  (1280 + 64 * (j))
#define XB_XGEN(j)  (2304 + 64 * (j))
#define XB_TOP      3328
#define XB_TOPGEN   3392
#define XCD_BAR_WORDS 3456
#define XB_SPIN_CAP (1u << 20)
__device__ __forceinline__ unsigned xb_ld(unsigned* p)              { return __hip_atomic_load(p, __ATOMIC_RELAXED, __HIP_MEMORY_SCOPE_AGENT); }
__device__ __forceinline__ unsigned xb_add(unsigned* p, unsigned v) { return __hip_atomic_fetch_add(p, v, __ATOMIC_RELAXED, __HIP_MEMORY_SCOPE_AGENT); }
__device__ __forceinline__ unsigned xb_xcc_id() { return (unsigned)__builtin_amdgcn_s_getreg((3 << 11) | 20) & 0xFu; }
#define XB_SPIN(cond, bar) do { unsigned _sp = 0; while (cond) { __builtin_amdgcn_s_sleep(1); \
    if ((++_sp & 255u) == 0u) { if (xb_ld(&(bar)[XB_TMO])) break; if (_sp > XB_SPIN_CAP) { atomicAdd(&(bar)[XB_TMO], 1u); break; } } } } while (0)
struct XcdBarrier { unsigned* bar; unsigned x; volatile LAS unsigned* st; };
__device__ __forceinline__ XcdBarrier xcd_barrier_post(unsigned* bar, volatile LAS unsigned* st) {
    XcdBarrier b; b.bar = bar; b.x = xb_xcc_id(); b.st = st;
    if (threadIdx.x == 0) (void)xb_add(&bar[XB_XCNT(b.x)], 1u);
    return b;
}
__device__ __forceinline__ void xcd_barrier_complete(unsigned* bar, unsigned x, unsigned& nloc, unsigned& nx) {
    const unsigned G = gridDim.x * gridDim.y * gridDim.z;
    unsigned sum, cnt, mine, sp = 0u;
    for (;;) {
        sum = 0u; cnt = 0u; mine = 0u;
#pragma unroll
        for (unsigned j = 0; j < 16; ++j) { const unsigned c = xb_ld(&bar[XB_XCNT(j)]); sum += c; cnt += (c > 0u) ? 1u : 0u; mine = (j == x) ? c : mine; }
        if (sum == G) break;
        __builtin_amdgcn_s_sleep(1);
        if ((++sp & 255u) == 0u) { if (xb_ld(&bar[XB_TMO])) break; if (sp > XB_SPIN_CAP) { atomicAdd(&bar[XB_TMO], 1u); break; } }
    }
    nloc = mine > 0u ? mine : 1u; nx = cnt > 0u ? cnt : 1u;
}
__device__ __forceinline__ void xcd_barrier(const XcdBarrier& b) {
    asm volatile("s_waitcnt vmcnt(0)" ::: "memory");
    __syncthreads();
    if (threadIdx.x == 0) {
        unsigned* bar = b.bar;
        __builtin_amdgcn_s_waitcnt(0);
        unsigned nloc = b.st[0], nx = b.st[1];
        if (nloc == 0u) { xcd_barrier_complete(bar, b.x, nloc, nx); b.st[0] = nloc; b.st[1] = nx; }
        const unsigned old = xb_add(&bar[XB_XSUB(b.x)], 1u);
        const unsigned gen = old / nloc;
        if (old + 1u == (gen + 1u) * nloc) {
            __builtin_amdgcn_fence(__ATOMIC_RELEASE, "agent");
            asm volatile("s_waitcnt vmcnt(0)" ::: "memory");
            const unsigned og = xb_add(&bar[XB_TOP], 1u);
            const unsigned tg = og / nx;
            if (og + 1u == (tg + 1u) * nx) xb_add(&bar[XB_TOPGEN], 1u);
            else XB_SPIN(xb_ld(&bar[XB_TOPGEN]) == tg, bar);
            __builtin_amdgcn_fence(__ATOMIC_ACQUIRE, "agent");
            xb_add(&bar[XB_XGEN(b.x)], 1u);
            asm volatile("s_waitcnt vmcnt(0)" ::: "memory");
        } else {
            XB_SPIN(xb_ld(&bar[XB_XGEN(b.x)]) == gen, bar);
            __builtin_amdgcn_fence(__ATOMIC_ACQUIRE, "agent");
            asm volatile("s_waitcnt vmcnt(0)" ::: "memory");
        }
    }
    __syncthreads();
}


namespace pg8 {
#define PG8_LAS __attribute__((address_space(3)))
typedef short bf16x8 __attribute__((ext_vector_type(8)));
typedef float f32x4 __attribute__((ext_vector_type(4)));
typedef unsigned u32x4 __attribute__((ext_vector_type(4)));
typedef unsigned u32x2 __attribute__((ext_vector_type(2)));
constexpr int BM = 256, BK = 64, HALF = 128, HTB = HALF * BK * 2, STAGE_BYTES = 8 * HTB, NXCD = 8, WGM = 8;
__host__ __device__ __forceinline__ int lds_byte(int r, int c) { const int st = (r >> 4) * 2 + (c >> 5), rr = r & 15, cc = c & 31, ob = rr * 64 + cc * 2; return st * 1024 + (ob ^ (((ob >> 9) & 1) << 5)); }
__host__ __device__ __forceinline__ void stage_rc(int b, int& R, int& C) { const int st = b / 1024, sb = b % 1024, swz = sb ^ (((sb >> 9) & 1) << 5); R = (st >> 1) * 16 + swz / 64; C = (st & 1) * 32 + (swz % 64) / 2; }
__host__ __device__ __forceinline__ int perm32(int rho) { const int n = rho >> 4, i = rho & 15; return 8 * (i >> 2) + 4 * n + (i & 3); }
struct Unit { int pm, pn; };
struct Gemm { const bf16_t* A; const bf16_t* Bt; int M, N, K; };
struct StaticOrder {
    int nM, nN, nwg, G, c;
    __host__ __device__ void init(int M, int N, int G_, int c_) { nM = M / BM; nN = N / BM; nwg = nM * nN; G = G_; c = c_; }
    __host__ __device__ bool next(int i, Unit& u) const {
        const long L = (long)i * G + c; if (L >= nwg) return false;
        int wgid = (int)L; { const int q = nwg / NXCD, r = nwg % NXCD, xcd = wgid % NXCD, off = wgid / NXCD; wgid = (xcd < r ? xcd * (q + 1) : r * (q + 1) + (xcd - r) * q) + off; }
        const int nig = WGM * nN, gid = wgid / nig, fm = gid * WGM, gsz = (nM - fm) < WGM ? (nM - fm) : WGM;
        u.pm = fm + ((wgid % nig) % gsz); u.pn = (wgid % nig) / gsz; return true;
    }
    __device__ __forceinline__ void a_ready(const Unit&) const {}
    __device__ __forceinline__ void done(const Unit&) const {}
};
__device__ __forceinline__ unsigned cvt_pk_bf16(float lo, float hi) { unsigned r; asm volatile("v_cvt_pk_bf16_f32 %0, %1, %2" : "=v"(r) : "v"(lo), "v"(hi)); return r; }

typedef int i32x4 __attribute__((ext_vector_type(4)));
template <bool I8>
__device__ __forceinline__ f32x4 mma16(const bf16x8 b, const bf16x8 a, const f32x4 c) {
    if constexpr (I8) return __builtin_bit_cast(f32x4, __builtin_amdgcn_mfma_i32_16x16x64_i8(__builtin_bit_cast(i32x4, b), __builtin_bit_cast(i32x4, a), __builtin_bit_cast(i32x4, c), 0, 0, 0));
    else return __builtin_amdgcn_mfma_f32_16x16x32_bf16(b, a, c, 0, 0, 0);
}
template <class Epi, class Sched, bool I8 = false>
__device__ __forceinline__ void gemm_phase(PG8_LAS unsigned char* lds, const Gemm g, const Sched& S, const Epi& E) {
    int tid_ = threadIdx.x; asm volatile("" : "+v"(tid_));
    const int tid = tid_, wid = __builtin_amdgcn_readfirstlane(tid >> 6), lane = tid & 63, wr = wid >> 2, wc = wid & 3, fr = lane & 15, fq = lane >> 4;
    const int K = g.K, nt = K / BK;
    unsigned voffA[2], voffB[2];
#pragma unroll
    for (int i = 0; i < 2; ++i) { int R, C; stage_rc(tid * 16 + i * 8192, R, C); const int Rb = Epi::PERM ? ((R & ~31) + perm32(R & 31)) : R;
        voffA[i] = (unsigned)(R * K + C) * 2u; voffB[i] = (unsigned)(Rb * K + C) * 2u; }
    const size_t kstep = (size_t)(BK * 2);
    const size_t hstep = (size_t)HALF * K * 2;
    const size_t tstep = 2 * hstep;
    const unsigned ldsw = (unsigned)wid * 1024u;
    const int aoff = lds_byte(wr * 64 + fr, fq * 8), boff = lds_byte(wc * 32 + fr, fq * 8);
#define PG8_SA(b, h) (((b) * 2 + (h)) * HTB)
#define PG8_SB(b, h) ((4 + (b) * 2 + (h)) * HTB)
#define PG8_STAGE(bufoff, gbase, voff) do { _Pragma("unroll") for (int _i = 0; _i < 2; ++_i) \
        __builtin_amdgcn_global_load_lds((const unsigned*)((const char*)(gbase) + (voff)[_i]), (PG8_LAS unsigned*)(lds + (bufoff) + ldsw + _i * 8192), 16, 0, 0); } while (0)
#define PG8_LDA(dst, b, h) do { _Pragma("unroll") for (int m = 0; m < 4; ++m) _Pragma("unroll") for (int k = 0; k < 2; ++k) dst[m][k] = *(const PG8_LAS bf16x8*)(lds + PG8_SA(b, h) + aoff + m * 2048 + k * 1024); } while (0)
#define PG8_LDB(dst, b, h) do { _Pragma("unroll") for (int n = 0; n < 2; ++n) _Pragma("unroll") for (int k = 0; k < 2; ++k) dst[n][k] = *(const PG8_LAS bf16x8*)(lds + PG8_SB(b, h) + boff + n * 2048 + k * 1024); } while (0)
#define PG8_MMA(ai, bj, At, Bt) do { __builtin_amdgcn_s_setprio(1); _Pragma("unroll") for (int m = 0; m < 4; ++m) _Pragma("unroll") for (int n = 0; n < 2; ++n) _Pragma("unroll") for (int k = 0; k < 2; ++k) \
        acc[ai][bj][m][n] = mma16<I8>(Bt[n][k], At[m][k], acc[ai][bj][m][n]); __builtin_amdgcn_s_setprio(0); } while (0)
#define PG8_WAIT_V(n) asm volatile("s_waitcnt vmcnt(" #n ")" ::: "memory")
#define PG8_WAIT_L(n) asm volatile("s_waitcnt lgkmcnt(" #n ")" ::: "memory")
#define PG8_BAR __builtin_amdgcn_s_barrier()
#define PG8_SCHED __builtin_amdgcn_sched_barrier(0)
    Unit cur, nxt; int ui = 0;
    if (!S.next(0, cur)) return;
    f32x4 acc[2][2][4][2];
#pragma unroll
    for (int a = 0; a < 2; ++a)
#pragma unroll
        for (int b = 0; b < 2; ++b)
#pragma unroll
            for (int m = 0; m < 4; ++m)
#pragma unroll
                for (int n = 0; n < 2; ++n) acc[a][b][m][n] = (f32x4){0.f, 0.f, 0.f, 0.f};
    bf16x8 At[4][2], B0[2][2], B1[2][2];
    const char* cA = (const char*)g.A + (size_t)cur.pm * tstep; const char* cB = (const char*)g.Bt + (size_t)cur.pn * tstep;
    S.a_ready(cur);
    PG8_STAGE(PG8_SB(0, 0), cB, voffB); PG8_STAGE(PG8_SA(0, 0), cA, voffA); PG8_STAGE(PG8_SB(0, 1), cB + hstep, voffB); PG8_STAGE(PG8_SA(0, 1), cA + hstep, voffA);
    if (wr == 1) PG8_BAR;
    PG8_WAIT_V(4); PG8_BAR;
    PG8_STAGE(PG8_SB(1, 0), cB + kstep, voffB); PG8_STAGE(PG8_SA(1, 0), cA + kstep, voffA); PG8_STAGE(PG8_SB(1, 1), cB + hstep + kstep, voffB);
    PG8_WAIT_V(6); PG8_BAR;
    for (;;) {
        const bool has_next = S.next(ui + 1, nxt);
        const char* nA = has_next ? (const char*)g.A + (size_t)nxt.pm * tstep : cA; const char* nB = has_next ? (const char*)g.Bt + (size_t)nxt.pn * tstep : cB;
        for (int t = 0; t < nt; t += 2) {
            const bool last = (t == nt - 2);
            const char* a1 = cA + (size_t)(t + 1) * kstep;
            const char* a2 = last ? nA : cA + (size_t)(t + 2) * kstep; const char* b2 = last ? nB : cB + (size_t)(t + 2) * kstep;
            const char* a3 = a2 + kstep; const char* b3 = b2 + kstep;
            if (last && has_next) S.a_ready(nxt);
            PG8_LDB(B0, 0, 0); PG8_SCHED; PG8_LDA(At, 0, 0); PG8_STAGE(PG8_SA(1, 1), a1 + hstep, voffA);
            PG8_WAIT_L(8); PG8_BAR; PG8_WAIT_L(0); PG8_MMA(0, 0, At, B0); PG8_BAR; PG8_SCHED;
            PG8_LDB(B1, 0, 1); PG8_STAGE(PG8_SB(0, 0), b2, voffB);
            PG8_BAR; PG8_WAIT_L(0); PG8_MMA(0, 1, At, B1); PG8_BAR;
            PG8_LDA(At, 0, 1); PG8_STAGE(PG8_SA(0, 0), a2, voffA);
            PG8_BAR; PG8_WAIT_L(0); PG8_MMA(1, 0, At, B0); PG8_BAR; PG8_SCHED;
            PG8_STAGE(PG8_SB(0, 1), b2 + hstep, voffB);
            PG8_WAIT_V(6); PG8_BAR; PG8_MMA(1, 1, At, B1); PG8_BAR;
            PG8_LDB(B0, 1, 0); PG8_SCHED; PG8_LDA(At, 1, 0); PG8_STAGE(PG8_SA(0, 1), a2 + hstep, voffA);
            PG8_WAIT_L(8); PG8_BAR; PG8_WAIT_L(0); PG8_MMA(0, 0, At, B0); PG8_BAR; PG8_SCHED;
            PG8_LDB(B1, 1, 1); PG8_STAGE(PG8_SB(1, 0), b3, voffB);
            PG8_BAR; PG8_WAIT_L(0); PG8_MMA(0, 1, At, B1); PG8_BAR;
            PG8_LDA(At, 1, 1); PG8_STAGE(PG8_SA(1, 0), a3, voffA);
            PG8_BAR; PG8_WAIT_L(0); PG8_MMA(1, 0, At, B0); PG8_BAR; PG8_SCHED;
            PG8_STAGE(PG8_SB(1, 1), b3 + hstep, voffB);
            PG8_WAIT_V(6); PG8_BAR; PG8_MMA(1, 1, At, B1); PG8_BAR;
        }
        if constexpr (!Epi::AFTER_DRAIN) { E(acc, cur, wr, wc, fr, fq); S.done(cur); }
        if (!has_next) break;
#pragma unroll
        for (int a = 0; a < 2; ++a)
#pragma unroll
            for (int b = 0; b < 2; ++b)
#pragma unroll
                for (int m = 0; m < 4; ++m)
#pragma unroll
                    for (int n = 0; n < 2; ++n) acc[a][b][m][n] = (f32x4){0.f, 0.f, 0.f, 0.f};
        cur = nxt; cA = nA; cB = nB; ++ui;
    }
    PG8_WAIT_V(0);
    if (wr == 0) PG8_BAR;
    PG8_BAR;
    if constexpr (Epi::AFTER_DRAIN) { E.fused(acc, cur, wr, wc, fr, fq, lds, wid, lane); S.done(cur); }
#undef PG8_SA
#undef PG8_SB
#undef PG8_STAGE
#undef PG8_LDA
#undef PG8_LDB
#undef PG8_MMA
#undef PG8_WAIT_V
#undef PG8_WAIT_L
#undef PG8_BAR
#undef PG8_SCHED
}
}

__host__ __device__ __forceinline__ int cmap_in(int F) { return (F & ~255) + 128 * ((F >> 5) & 1) + 32 * ((F >> 6) & 3) + (F & 31); }
struct EpiInprojMF {
    static constexpr bool PERM = true, AFTER_DRAIN = false;
    bf16_t* P; const float* rinv; const float* bias_f; const int* pos; const float* ftab; const float* qg; const float* kg; const float* swf;
    __device__ __forceinline__ void operator()(pg8::f32x4 (&acc)[2][2][4][2], const pg8::Unit& u, int wr, int wc, int fr, int fq) const {
        typedef pg8::f32x4 f32x4;
        asm volatile("" : "+v"(fr), "+v"(fq));
        const int type = u.pn >> 1, head = 4 * (u.pn & 1) + wc, fb = 256 * u.pn + 64 * wc;
        {
            f32x4 sw[2][2];
#pragma unroll
            for (int bj = 0; bj < 2; ++bj)
#pragma unroll
                for (int n = 0; n < 2; ++n) sw[bj][n] = *(const f32x4*)(swf + fb + 32 * bj + 8 * fq + 4 * n);
#pragma unroll
            for (int ai = 0; ai < 2; ++ai)
#pragma unroll
                for (int bj = 0; bj < 2; ++bj)
#pragma unroll
                    for (int m = 0; m < 4; ++m)
#pragma unroll
                        for (int n = 0; n < 2; ++n) {
                            const pg8::i32x4 iv = __builtin_bit_cast(pg8::i32x4, acc[ai][bj][m][n]);
                            f32x4 fv; fv[0] = (float)iv[0]; fv[1] = (float)iv[1]; fv[2] = (float)iv[2]; fv[3] = (float)iv[3];
                            acc[ai][bj][m][n] = fv * sw[bj][n];
                        }
        }
        const size_t PSZ = (size_t)T * 512;
        const int rslot = (type == 0) ? 0 : (type == 1) ? 1 : (type == 2) ? 5 : (type == 3) ? 2 : (type == 4) ? 3 : (type == 5) ? 4 : 6;
        bf16_t* rowmaj = P + (size_t)rslot * PSZ;
        const int t0 = u.pm * 256 + wr * 64 + fr;
        f32x4 bv[2][2], gv[2][2], fh[2], fl[2];
#pragma unroll
        for (int bj = 0; bj < 2; ++bj)
#pragma unroll
            for (int n = 0; n < 2; ++n) bv[bj][n] = *(const f32x4*)(bias_f + fb + 32 * bj + 8 * fq + 4 * n);
        if (type <= 1) {
#pragma unroll
            for (int n = 0; n < 2; ++n) { fh[n] = *(const f32x4*)(ftab + 8 * fq + 4 * n); fl[n] = *(const f32x4*)(ftab + 32 + 8 * fq + 4 * n); }
        } else if (type == 4 || type == 5) {
            const float* gsrc = (type == 4) ? qg : kg;
#pragma unroll
            for (int bj = 0; bj < 2; ++bj)
#pragma unroll
                for (int n = 0; n < 2; ++n) gv[bj][n] = *(const f32x4*)(gsrc + 32 * bj + 8 * fq + 4 * n);
        }
#pragma unroll
        for (int ai = 0; ai < 2; ++ai) {
            float rv[4], pf[4];
#pragma unroll
            for (int m = 0; m < 4; ++m) { rv[m] = rinv[t0 + ai * 128 + m * 16]; pf[m] = (float)pos[t0 + ai * 128 + m * 16]; }
            asm volatile("" : "+v"(rv[0]), "+v"(rv[1]), "+v"(rv[2]), "+v"(rv[3]), "+v"(pf[0]), "+v"(pf[1]), "+v"(pf[2]), "+v"(pf[3]));
#pragma unroll
            for (int m = 0; m < 4; ++m) {
                const int t = t0 + ai * 128 + m * 16;
                const float r = rv[m];
                f32x4 v[2][2];
#pragma unroll
                for (int bj = 0; bj < 2; ++bj)
#pragma unroll
                    for (int n = 0; n < 2; ++n) v[bj][n] = acc[ai][bj][m][n] * r + bv[bj][n];
                if (type <= 1) {
                    const float sc = (type == 1) ? 0.125f : 1.f, pp = pf[m];
#pragma unroll
                    for (int n = 0; n < 2; ++n)
#pragma unroll
                        for (int j = 0; j < 4; ++j) {
                            const float rev = __builtin_amdgcn_fractf(__builtin_amdgcn_fractf(pp * fh[n][j]) + pp * fl[n][j]);
                            const float cs = __builtin_amdgcn_cosf(rev) * sc, sn = __builtin_amdgcn_sinf(rev) * sc;
                            const float x1 = v[0][n][j], x2 = v[1][n][j]; v[0][n][j] = x1 * cs - x2 * sn; v[1][n][j] = x2 * cs + x1 * sn;
                        }
                } else if (type == 3) {
#pragma unroll
                    for (int bj = 0; bj < 2; ++bj)
#pragma unroll
                        for (int n = 0; n < 2; ++n)
#pragma unroll
                            for (int j = 0; j < 4; ++j) { const float x = v[bj][n][j]; v[bj][n][j] = x * __builtin_amdgcn_rcpf(1.f + __builtin_amdgcn_exp2f(x * -1.44269504089f)); }
                } else if (type == 4 || type == 5) {
                    float ss = 0.f;
#pragma unroll
                    for (int bj = 0; bj < 2; ++bj)
#pragma unroll
                        for (int n = 0; n < 2; ++n)
#pragma unroll
                            for (int j = 0; j < 4; ++j) ss += v[bj][n][j] * v[bj][n][j];
                    ss += __shfl_xor(ss, 16); ss += __shfl_xor(ss, 32);
                    const float rn = (1.0f / sqrtf(ss * (1.f / 64.f) + EPS)) * ((type == 4) ? 0.125f * 1.44269504089f : 1.f);
#pragma unroll
                    for (int bj = 0; bj < 2; ++bj)
#pragma unroll
                        for (int n = 0; n < 2; ++n) v[bj][n] = v[bj][n] * rn * gv[bj][n];
                }
                pg8::u32x4 w[2];
#pragma unroll
                for (int bj = 0; bj < 2; ++bj) {
                    w[bj].x = pg8::cvt_pk_bf16(v[bj][0][0], v[bj][0][1]); w[bj].y = pg8::cvt_pk_bf16(v[bj][0][2], v[bj][0][3]);
                    w[bj].z = pg8::cvt_pk_bf16(v[bj][1][0], v[bj][1][1]); w[bj].w = pg8::cvt_pk_bf16(v[bj][1][2], v[bj][1][3]);
                }
                {
                    const bool hi = (fr & 8) != 0;
                    pg8::u32x4 snd, rcv, sa, sb;
#pragma unroll
                    for (int q = 0; q < 4; ++q) { snd[q] = hi ? w[0][q] : w[1][q]; rcv[q] = (unsigned)__builtin_amdgcn_update_dpp(0, (int)snd[q], 0x128, 0xf, 0xf, false); }
#pragma unroll
                    for (int q = 0; q < 4; ++q) { sa[q] = hi ? rcv[q] : w[0][q]; sb[q] = hi ? w[1][q] : rcv[q]; }
                    bf16_t* rp = rowmaj + (size_t)(t - (hi ? 8 : 0)) * 512 + head * 64 + (hi ? 32 : 0) + 8 * fq;
                    __builtin_nontemporal_store(sa, (pg8::u32x4*)rp);
                    __builtin_nontemporal_store(sb, (pg8::u32x4*)(rp + 8 * 512));
                }
            }
        }
    }
};

struct EpiOutprojMF {
    static constexpr bool PERM = false, AFTER_DRAIN = true;
    const float* xf; const float* gate1; bf16_t* x1b; float* part2;
    float* pmax; unsigned char* x1q; float* rinv2q; unsigned* ctl;
    __device__ __forceinline__ void operator()(const pg8::f32x4 (&)[2][2][4][2], const pg8::Unit&, int, int, int, int) const {}
    __device__ __forceinline__ void fused(pg8::f32x4 (&acc)[2][2][4][2], const pg8::Unit& u, int wr, int wc, int fr, int fq, PG8_LAS unsigned char* lds, int wid, int lane) const {
        typedef pg8::f32x4 f32x4;
        asm volatile("" : "+v"(fr), "+v"(fq), "+v"(lane));
        constexpr int LD = 260;
        PG8_LAS float* TL = (PG8_LAS float*)lds;
        const int colw = wc * 32 + 4 * fq;
        f32x4 gv[2][2];
#pragma unroll
        for (int bj = 0; bj < 2; ++bj)
#pragma unroll
            for (int n = 0; n < 2; ++n) gv[bj][n] = *(const f32x4*)(gate1 + u.pn * 256 + colw + bj * 128 + n * 16);
        pg8::u32x2 ow[2][16];
#pragma unroll
        for (int ai = 0; ai < 2; ++ai) {
            f32x4 xv[16];
            const size_t rowbase = (size_t)(u.pm * 256 + ai * 128 + 16 * wid) * D + u.pn * 256 + 4 * lane;
#pragma unroll
            for (int r = 0; r < 16; ++r) xv[r] = __builtin_nontemporal_load((const f32x4*)(xf + rowbase + (size_t)r * D));
#pragma unroll
            for (int m = 0; m < 4; ++m)
#pragma unroll
                for (int bj = 0; bj < 2; ++bj)
#pragma unroll
                    for (int n = 0; n < 2; ++n) *(PG8_LAS f32x4*)(TL + (64 * wr + 16 * m + fr) * LD + colw + bj * 128 + n * 16) = gv[bj][n] * acc[ai][bj][m][n];
            __syncthreads();
            float ssr[16], amr[16];
#pragma unroll
            for (int r = 0; r < 16; ++r) {
                const f32x4 g = *(PG8_LAS f32x4*)(TL + (16 * wid + r) * LD + 4 * lane);
                const f32x4 o = xv[r] + g;
                pg8::u32x2 w; w.x = pg8::cvt_pk_bf16(o[0], o[1]); w.y = pg8::cvt_pk_bf16(o[2], o[3]);
                *(pg8::u32x2*)(x1b + rowbase + (size_t)r * D) = w;
                ow[ai][r] = w;
                ssr[r] = o[0] * o[0] + o[1] * o[1] + o[2] * o[2] + o[3] * o[3];
                amr[r] = fmaxf(fmaxf(__uint_as_float((w.x << 16) & 0x7fffffffu), __uint_as_float(w.x & 0x7fff0000u)), fmaxf(__uint_as_float((w.y << 16) & 0x7fffffffu), __uint_as_float(w.y & 0x7fff0000u)));
            }
            {
                const bool b5 = lane & 32, b4 = lane & 16, b3 = lane & 8, b2 = lane & 4;
                float w8[8], w4[4], w2[2], w1;
#pragma unroll
                for (int i = 0; i < 8; ++i) w8[i] = (b5 ? ssr[8 + i] : ssr[i]) + __shfl_xor(b5 ? ssr[i] : ssr[8 + i], 32);
#pragma unroll
                for (int i = 0; i < 4; ++i) w4[i] = (b4 ? w8[4 + i] : w8[i]) + __shfl_xor(b4 ? w8[i] : w8[4 + i], 16);
#pragma unroll
                for (int i = 0; i < 2; ++i) w2[i] = (b3 ? w4[2 + i] : w4[i]) + __shfl_xor(b3 ? w4[i] : w4[2 + i], 8);
                w1 = (b2 ? w2[1] : w2[0]) + __shfl_xor(b2 ? w2[0] : w2[1], 4);
                w1 += __shfl_xor(w1, 2); w1 += __shfl_xor(w1, 1);
                part2[(size_t)(u.pm * 256 + ai * 128 + 16 * wid + (lane >> 2)) * 16 + u.pn * 4 + (lane & 3)] = ((lane & 3) == 0) ? w1 : 0.f;
#pragma unroll
                for (int i = 0; i < 8; ++i) w8[i] = fmaxf(b5 ? amr[8 + i] : amr[i], __shfl_xor(b5 ? amr[i] : amr[8 + i], 32));
#pragma unroll
                for (int i = 0; i < 4; ++i) w4[i] = fmaxf(b4 ? w8[4 + i] : w8[i], __shfl_xor(b4 ? w8[i] : w8[4 + i], 16));
#pragma unroll
                for (int i = 0; i < 2; ++i) w2[i] = fmaxf(b3 ? w4[2 + i] : w4[i], __shfl_xor(b3 ? w4[i] : w4[2 + i], 8));
                w1 = fmaxf(b2 ? w2[1] : w2[0], __shfl_xor(b2 ? w2[0] : w2[1], 4));
                w1 = fmaxf(w1, __shfl_xor(w1, 2)); w1 = fmaxf(w1, __shfl_xor(w1, 1));
                if ((lane & 3) == 0) pmax[(size_t)(u.pm * 256 + ai * 128 + 16 * wid + (lane >> 2)) * 4 + u.pn] = w1;
            }
            __syncthreads();
        }
        asm volatile("s_waitcnt vmcnt(0)" ::: "memory");
        __syncthreads();
        if (wid == 0 && lane == 0) {
            unsigned* c = ctl + CTL_CNT + 16 * u.pm;
            __builtin_amdgcn_fence(__ATOMIC_RELEASE, "agent");
            asm volatile("s_waitcnt vmcnt(0)" ::: "memory");
            (void)xb_add(c, 1u);
            XB_SPIN(xb_ld(c) < 4u, ctl);
            __builtin_amdgcn_fence(__ATOMIC_ACQUIRE, "agent");
        }
        __syncthreads();
        float qsl = 0.f;
        {
            const int row = u.pm * 256 + (lane >> 4 & 1) * 128 + 16 * wid + (lane & 15);
            const f32x4* pp = (const f32x4*)(part2 + (size_t)row * 16);
            const f32x4 p0 = pp[0], p1 = pp[1], p2 = pp[2], p3 = pp[3], pm4 = *(const f32x4*)(pmax + (size_t)row * 4);
            const float ssum = ((p0[0] + p0[1]) + (p0[2] + p0[3])) + ((p1[0] + p1[1]) + (p1[2] + p1[3])) + ((p2[0] + p2[1]) + (p2[2] + p2[3])) + ((p3[0] + p3[1]) + (p3[2] + p3[3]));
            const float am = fmaxf(fmaxf(pm4[0], pm4[1]), fmaxf(pm4[2], pm4[3]));
            qsl = (am > 0.f) ? 127.f / am : 0.f;
            if (u.pn == 0 && lane < 32) rinv2q[row] = (1.0f / sqrtf(ssum * (1.0f / D) + EPS)) * (am * (1.f / 127.f));
        }
#pragma unroll
        for (int ai = 0; ai < 2; ++ai)
#pragma unroll
            for (int r = 0; r < 16; ++r) {
                const float qs = __builtin_bit_cast(float, __builtin_amdgcn_readlane(__builtin_bit_cast(int, qsl), ai * 16 + r));
                const pg8::u32x2 w = ow[ai][r];
                const unsigned b0 = __float_as_uint(fmaf(__uint_as_float(w.x << 16), qs, 12582912.f)), b1 = __float_as_uint(fmaf(__uint_as_float(w.x & 0xffff0000u), qs, 12582912.f));
                const unsigned b2 = __float_as_uint(fmaf(__uint_as_float(w.y << 16), qs, 12582912.f)), b3 = __float_as_uint(fmaf(__uint_as_float(w.y & 0xffff0000u), qs, 12582912.f));
                *(unsigned*)(x1q + (size_t)(u.pm * 256 + ai * 128 + 16 * wid + r) * D + u.pn * 256 + 4 * lane) = (b0 & 255u) | ((b1 & 255u) << 8) | ((b2 & 255u) << 16) | (b3 << 24);
            }
    }
};

__device__ __forceinline__ unsigned pk2(float lo, float hi) { return (unsigned)f2bf(lo) | ((unsigned)f2bf(hi) << 16); }
template <bool FOLD, bool CMAP>
__device__ __forceinline__ void transpose_item(const float* W, int K, int N, bf16_t* WT, float* scr, int item, int lane, const float* sg, const float* sm) {
    const int nblk = N / 32, kb = item / nblk, nb = item % nblk, k0 = 64 * kb, n0 = 32 * nb;
    float4 v[8]; float f[8];
#pragma unroll
    for (int i = 0; i < 8; ++i) { const int kk = 8 * i + (lane >> 3); v[i] = *(const float4*)(W + (size_t)(k0 + kk) * N + n0 + 4 * (lane & 7));
        f[i] = FOLD ? sg[k0 + kk] * (1.f + sm[k0 + kk]) : 1.f; }
#pragma unroll
    for (int i = 0; i < 8; ++i) { const int kk = 8 * i + (lane >> 3); float* d = scr + kk * 33 + 4 * (lane & 7);
        d[0] = v[i].x * f[i]; d[1] = v[i].y * f[i]; d[2] = v[i].z * f[i]; d[3] = v[i].w * f[i]; }
    asm volatile("s_waitcnt lgkmcnt(0)" ::: "memory");
    const int c = lane & 7, r0 = CMAP ? cmap_in(n0) : n0;
#pragma unroll
    for (int j = 0; j < 4; ++j) { const int n = (lane >> 3) + 8 * j; const float* s = scr + (8 * c) * 33 + n;
        pg8::u32x4 o; o.x = pk2(s[0 * 33], s[1 * 33]); o.y = pk2(s[2 * 33], s[3 * 33]); o.z = pk2(s[4 * 33], s[5 * 33]); o.w = pk2(s[6 * 33], s[7 * 33]);
        *(pg8::u32x4*)(WT + (size_t)(r0 + n) * K + k0 + 8 * c) = o; }
    asm volatile("s_waitcnt lgkmcnt(0)" ::: "memory");
}
template <int NC4, class VF>
__device__ __forceinline__ void gemv_cols(unsigned char* lds, const VF vf, const float* W, const int N, const int u, float* dst, const float* add) {
    constexpr int RG = 512 / NC4;
    float (*red)[NC4 * 4] = (float (*)[NC4 * 4])lds;
    const int tid = threadIdx.x, c4 = tid % NC4, rg = tid / NC4;
    if (rg < RG) {
        float4 acc = {0.f, 0.f, 0.f, 0.f};
        for (int r = rg; r < 1024; r += RG) { const float s = vf(r); const float4 w = *(const float4*)(W + (size_t)r * N + u * NC4 * 4 + c4 * 4);
            acc.x += s * w.x; acc.y += s * w.y; acc.z += s * w.z; acc.w += s * w.w; }
        red[rg][c4 * 4 + 0] = acc.x; red[rg][c4 * 4 + 1] = acc.y; red[rg][c4 * 4 + 2] = acc.z; red[rg][c4 * 4 + 3] = acc.w;
    }
    __syncthreads();
    if (tid < NC4 * 4) { float s = 0.f; for (int i = 0; i < RG; ++i) s += red[i][tid]; dst[u * NC4 * 4 + tid] = s + (add ? add[u * NC4 * 4 + tid] : 0.f); }
    __syncthreads();
}
struct VfSilu { const float* c; __device__ __forceinline__ float operator()(int r) const { const float v = c[r]; return v / (1.f + expf(-v)); } };
struct VfVec { const float* v; __device__ __forceinline__ float operator()(int r) const { return v[r]; } };


typedef float f32x16 __attribute__((ext_vector_type(16)));
typedef pg8::bf16x8 bf16x8;
#define MFMA32(a, b, c) __builtin_amdgcn_mfma_f32_32x32x16_bf16((a), (b), (c), 0, 0, 0)
__device__ __forceinline__ bf16x8 pack_frag(const f32x16& v, int s) {
    pg8::u32x4 w;
    w.x = pg8::cvt_pk_bf16(v[8 * s + 0], v[8 * s + 1]); w.y = pg8::cvt_pk_bf16(v[8 * s + 2], v[8 * s + 3]);
    w.z = pg8::cvt_pk_bf16(v[8 * s + 4], v[8 * s + 5]); w.w = pg8::cvt_pk_bf16(v[8 * s + 6], v[8 * s + 7]);
    return __builtin_bit_cast(bf16x8, w);
}
__device__ __forceinline__ bf16x8 load_tfrag(const bf16_t* rowp, int tok) {
    const uint2 a = *(const uint2*)(rowp + tok), b = *(const uint2*)(rowp + tok + 8);
    pg8::u32x4 w; w.x = a.x; w.y = a.y; w.z = b.x; w.w = b.y;
    return __builtin_bit_cast(bf16x8, w);
}


__device__ __forceinline__ bf16x8 tr_frag(const unsigned char* a0, int rows2) {
    typedef short s16x4 __attribute__((ext_vector_type(4)));
    typedef __attribute__((address_space(3))) s16x4 lds_s16x4;
    const s16x4 lo = __builtin_amdgcn_ds_read_tr16_b64_v4i16((lds_s16x4*)a0);
    const s16x4 hi = __builtin_amdgcn_ds_read_tr16_b64_v4i16((lds_s16x4*)(a0 + rows2 * 144));
    const uint2 l2 = __builtin_bit_cast(uint2, lo), h2 = __builtin_bit_cast(uint2, hi);
    pg8::u32x4 fw; fw.x = l2.x; fw.y = l2.y; fw.z = h2.x; fw.w = h2.y;
    return __builtin_bit_cast(bf16x8, fw);
}

__device__ __forceinline__ void ins16(float (&s)[16], float x) {
#pragma unroll
    for (int i = 15; i >= 1; --i) s[i] = __builtin_amdgcn_fmed3f(s[i - 1], s[i], x);
    s[0] = fmaxf(s[0], x);
}


struct OneUnitOrder {
    pg8::StaticOrder base; int round;
    __device__ __forceinline__ bool next(int i, pg8::Unit& u) const { if (i != 0) return false; return base.next(round, u); }
    __device__ __forceinline__ void a_ready(const pg8::Unit&) const {}
    __device__ __forceinline__ void done(const pg8::Unit&) const {}
};
struct EpiTopkMF {
    static constexpr bool PERM = false, AFTER_DRAIN = true;
    const float* rinv2q; const float* sq; const float* bias_q; unsigned short* ids; float* gates;
    __device__ __forceinline__ void operator()(const pg8::f32x4 (&)[2][2][4][2], const pg8::Unit&, int, int, int, int) const {}
    __device__ __forceinline__ void fused(pg8::f32x4 (&acc)[2][2][4][2], const pg8::Unit& u, int wr, int wc, int fr, int fq, PG8_LAS unsigned char* lds, int wid, int lane) const {
        typedef pg8::f32x4 f32x4;
        constexpr int SLD = 260;
        PG8_LAS float* SC = (PG8_LAS float*)lds; PG8_LAS float* MG = (PG8_LAS float*)(lds + 128 * SLD * 4);
        const int tid = wid * 64 + lane, tok = tid & 255, hk = tid >> 8;
        float rinv[2][4];
#pragma unroll
        for (int ai = 0; ai < 2; ++ai)
#pragma unroll
            for (int m = 0; m < 4; ++m) {
                const int row = u.pm * 256 + ai * 128 + wr * 64 + m * 16 + fr;
                rinv[ai][m] = rinv2q[row];
            }
        float sl[16], mine[16];
#pragma unroll
        for (int p = 0; p < 2; ++p) {
            f32x4 bv[2], sv[2];
#pragma unroll
            for (int n = 0; n < 2; ++n) { bv[n] = *(const f32x4*)(bias_q + u.pn * 256 + p * 128 + wc * 32 + n * 16 + 4 * fq); sv[n] = *(const f32x4*)(sq + u.pn * 256 + p * 128 + wc * 32 + n * 16 + 4 * fq); }
#pragma unroll
            for (int ai = 0; ai < 2; ++ai)
#pragma unroll
                for (int m = 0; m < 4; ++m)
#pragma unroll
                    for (int n = 0; n < 2; ++n)
#pragma unroll
                        for (int j = 0; j < 4; ++j)
                            SC[(32 * wc + 16 * n + 4 * fq + j) * SLD + (128 * ai + 64 * wr + 16 * m + fr)] = (float)__builtin_bit_cast(pg8::i32x4, acc[ai][p][m][n])[j] * (rinv[ai][m] * sv[n][j]) + bv[n][j];
            __syncthreads();
#pragma unroll
            for (int i = 0; i < 16; ++i) sl[i] = -INFINITY;
#pragma unroll 8
            for (int k = 0; k < 64; ++k) { const int key = 64 * hk + k; const float x = SC[key * SLD + tok]; ins16(sl, __uint_as_float((__float_as_uint(x) & 0xFFFFFF80u) | (unsigned)key)); }
            if (hk != p) {
#pragma unroll
                for (int i = 0; i < 16; ++i) MG[i * 256 + tok] = sl[i];
            }
            __syncthreads();
            if (hk == p) {
#pragma unroll
                for (int i = 0; i < 16; ++i) ins16(sl, MG[i * 256 + tok]);
#pragma unroll
                for (int i = 0; i < 16; ++i) mine[i] = sl[i];
            }
            __syncthreads();
        }
        PG8_LAS float* X1 = SC; PG8_LAS float* TL = SC + 4096; PG8_LAS unsigned* I0 = (PG8_LAS unsigned*)(SC + 8192); PG8_LAS unsigned* I1 = (PG8_LAS unsigned*)(SC + 12288);
        if (hk) {
#pragma unroll
            for (int i = 0; i < 16; ++i) { X1[i * 256 + tok] = mine[i]; I1[i * 256 + tok] = __float_as_uint(mine[i]) & 0x7Fu; }
        } else {
#pragma unroll
            for (int i = 0; i < 16; ++i) I0[i * 256 + tok] = __float_as_uint(mine[i]) & 0x7Fu;
        }
        __syncthreads();
        if (!hk) {
            float s1m[16], tl[16];
#pragma unroll
            for (int i = 0; i < 16; ++i) { s1m[i] = __uint_as_float(__float_as_uint(X1[i * 256 + tok]) & 0xFFFFFF80u); mine[i] = __uint_as_float(__float_as_uint(mine[i]) & 0xFFFFFF80u); tl[i] = -INFINITY; }
#pragma unroll
            for (int a2 = 0; a2 < 16; ++a2)
#pragma unroll
                for (int b2 = 0; b2 < 16; ++b2)
                    if ((a2 + 1) * (b2 + 1) <= 16) ins16(tl, __uint_as_float((__float_as_uint(mine[a2] + s1m[b2]) & 0xFFFFFF00u) | (unsigned)(a2 * 16 + b2)));
#pragma unroll
            for (int i = 0; i < 16; ++i) TL[i * 256 + tok] = tl[i];
        }
        __syncthreads();
        if (hk) {
            float ev[16]; float sum = 0.f; unsigned cd[16];
#pragma unroll
            for (int j = 0; j < 16; ++j) { const unsigned bits = __float_as_uint(TL[j * 256 + tok]); cd[j] = bits & 0xFFu; ev[j] = __uint_as_float(bits & 0xFFFFFF00u); }
            const float mx = ev[0];
#pragma unroll
            for (int j = 0; j < 16; ++j) { ev[j] = __expf(ev[j] - mx); sum += ev[j]; }
            const float inv = 1.f / sum;
            unsigned idw[8];
#pragma unroll
            for (int j = 0; j < 16; ++j) {
                const unsigned id = I0[(cd[j] >> 4) * 256 + tok] * 128u + I1[(cd[j] & 15u) * 256 + tok];
                if (j & 1) idw[j >> 1] |= id << 16; else idw[j >> 1] = id;
                ev[j] *= inv;
            }
            const size_t t = (size_t)u.pm * 256 + tok;
            unsigned short* idp = ids + t * 128 + u.pn * 16; float* gp = gates + t * 128 + u.pn * 16;
            *(uint4*)idp = make_uint4(idw[0], idw[1], idw[2], idw[3]); *(uint4*)(idp + 8) = make_uint4(idw[4], idw[5], idw[6], idw[7]);
#pragma unroll
            for (int q = 0; q < 4; ++q) *(float4*)(gp + 4 * q) = make_float4(ev[4 * q], ev[4 * q + 1], ev[4 * q + 2], ev[4 * q + 3]);
        }
        __syncthreads();
    }
};


__device__ __forceinline__ void convert_tables(const float* down, const float* up, unsigned char* q8, bf16_t* dsc, int lane, int cw, int nconv, int r0, int r1) {
    for (int row0 = r0 + cw * 2; row0 < r1; row0 += nconv * 2) {
        float4 v[2][4];
#pragma unroll
        for (int rr = 0; rr < 2; ++rr) {
            const int row = row0 + rr, isup = row >> 14, e = row & 16383;
            const float* sp = (isup ? up : down) + (size_t)e * 1024 + lane * 4;
#pragma unroll
            for (int q = 0; q < 4; ++q) v[rr][q] = ld_nt4(sp + 256 * q);
        }
#pragma unroll
        for (int rr = 0; rr < 2; ++rr) {
            const int row = row0 + rr, isup = row >> 14, e = row & 16383;
            {
                float ss = 0.f;
#pragma unroll
                for (int q = 0; q < 4; ++q) ss += v[rr][q].x * v[rr][q].x + v[rr][q].y * v[rr][q].y + v[rr][q].z * v[rr][q].z + v[rr][q].w * v[rr][q].w;
#pragma unroll
                for (int o = 32; o > 0; o >>= 1) ss += __shfl_xor(ss, o);
                const float sigma = sqrtf(ss * (1.0f / 1024.0f));
                const float s = (sigma > 0.f) ? 7.5f / (2.6f * sigma) : 1.f;
#pragma unroll
                for (int q = 0; q < 4; ++q) {
                    const int n0 = (int)fminf(fmaxf(__builtin_rintf(v[rr][q].x * s), -8.f), 7.f) + 8, n1 = (int)fminf(fmaxf(__builtin_rintf(v[rr][q].y * s), -8.f), 7.f) + 8;
                    const int n2 = (int)fminf(fmaxf(__builtin_rintf(v[rr][q].z * s), -8.f), 7.f) + 8, n3 = (int)fminf(fmaxf(__builtin_rintf(v[rr][q].w * s), -8.f), 7.f) + 8;
                    const int h1 = isup ? ((n1 - 8) & 15) : n1, h3 = isup ? ((n3 - 8) & 15) : n3;
                    *(unsigned short*)(q8 + (size_t)isup * (8u << 20) + ((size_t)q * 16384 + e) * 128 + (lane & 7) * 16 + (lane >> 3) * 2) = (unsigned short)(n0 | (h1 << 4) | (n2 << 8) | (h3 << 12));
                }
                if (lane == 0) dsc[row] = f2bf(1.0f / s);
            }
        }
    }
}

struct Params {
    const float *x, *c; const int* pos; const float *ada_w, *ada_b, *g1, *g2, *w_in, *rgain, *qg, *kg, *og, *w_out, *wq, *sk, *down, *up;
    float* out; unsigned char* ws; RopeC rc;
};

__global__ void __launch_bounds__(512) mk_fwd(Params p) {
    extern __shared__ __attribute__((aligned(16))) unsigned char lds[];
    const int tid = threadIdx.x, lane = tid & 63, bid = blockIdx.x, G = gridDim.x; int wave = tid >> 6;
    unsigned char* ws = p.ws;
    float* mod = (float*)(ws + OFF_MOD); float* rinv1 = (float*)(ws + OFF_RINV1); float* ftab = (float*)(ws + OFF_ROPE);
    bf16_t* P = (bf16_t*)(ws + OFF_P); float* kv = (float*)(ws + OFF_KV); bf16_t* stT = (bf16_t*)(ws + OFF_ST); bf16_t* ycat = (bf16_t*)(ws + OFF_YCAT);
    bf16_t* Win_t = (bf16_t*)(ws + OFF_WINT); float* bias_f = (float*)(ws + OFF_BIASF);
    unsigned char* xq = ws + OFF_XQ; float* swf = (float*)(ws + OFF_SWF);
    float* sq = (float*)(ws + OFF_SQ); float* pmax = (float*)(ws + OFF_PMAX); float* rinv2q = (float*)(ws + OFF_RINV2Q); unsigned char* Weffq_t = ws + OFF_WEFFQ; unsigned char* x1q = ws + OFF_X1Q;
    unsigned* ctl = (unsigned*)(ws + OFF_CTL);
    bf16_t* Weff_t = (bf16_t*)(ws + OFF_WEFFT); bf16_t* Wout_t = (bf16_t*)(ws + OFF_WOUTT); float* bias_q = (float*)(ws + OFF_BIASQ); float* bq_part = (float*)(ws + OFF_BQPART);
    float* part2 = (float*)(ws + OFF_PART2); bf16_t* x1b = (bf16_t*)(ws + OFF_X1B); unsigned short* ids = (unsigned short*)(ws + OFF_IDS); unsigned char* q8 = ws + OFF_Q8; bf16_t* dsc = (bf16_t*)(ws + OFF_DSC); float* gates = (float*)(ws + OFF_GATES);
    const size_t PS = (size_t)T * 512;
    const bf16_t *Qr = P, *Kr = P + PS, *Gr = P + 2 * PS, *Qs = P + 3 * PS, *Ks = P + 4 * PS, *Vr = P + 5 * PS, *Vs = P + 6 * PS;
    float* out = p.out;

    if (tid < 4) ((LAS unsigned*)((LAS unsigned char*)lds + LDS_ST_OFF))[tid] = 0u;
    __syncthreads();
    XcdBarrier bar = xcd_barrier_post((unsigned*)(ws + OFF_CTL), (volatile LAS unsigned*)((LAS unsigned char*)lds + LDS_ST_OFF));

    for (int u = bid; u < 256; u += G) gemv_cols<6>(lds, VfSilu{p.c}, p.ada_w, 6144, u, mod, p.ada_b);
    for (int row0 = (bid * 8 + wave) * 2; row0 < T; row0 += G * 16) {
        float4 v[2][4];
#pragma unroll
        for (int rr = 0; rr < 2; ++rr)
#pragma unroll
            for (int j = 0; j < 4; ++j) v[rr][j] = ld_nt4(p.x + (size_t)(row0 + rr) * D + (lane + 64 * j) * 4);
#pragma unroll
        for (int rr = 0; rr < 2; ++rr) {
            float s = 0.f, am = 0.f;
#pragma unroll
            for (int j = 0; j < 4; ++j) { const float4 q = v[rr][j]; s += q.x * q.x + q.y * q.y + q.z * q.z + q.w * q.w;
                am = fmaxf(fmaxf(am, fmaxf(fabsf(q.x), fabsf(q.y))), fmaxf(fabsf(q.z), fabsf(q.w))); }
#pragma unroll
            for (int o = 32; o > 0; o >>= 1) { s += __shfl_xor(s, o); am = fmaxf(am, __shfl_xor(am, o)); }
            const float qs = (am > 0.f) ? 127.f / am : 0.f;
            unsigned* xqo = (unsigned*)(xq + (size_t)(row0 + rr) * D);
#pragma unroll
            for (int j = 0; j < 4; ++j) { const float4 q = v[rr][j];
                const unsigned b0 = __float_as_uint(fmaf(q.x, qs, 12582912.f)), b1 = __float_as_uint(fmaf(q.y, qs, 12582912.f)), b2 = __float_as_uint(fmaf(q.z, qs, 12582912.f)), b3 = __float_as_uint(fmaf(q.w, qs, 12582912.f));
                xqo[lane + 64 * j] = (b0 & 255u) | ((b1 & 255u) << 8) | ((b2 & 255u) << 16) | (b3 << 24); }
            if (lane == 0) rinv1[row0 + rr] = (1.0f / sqrtf(s * (1.0f / D) + EPS)) * (am * (1.f / 127.f));
        }
    }
    if (bid == 0 && tid == 0) {
#pragma unroll
        for (int i = 0; i < 32; ++i) { ftab[i] = p.rc.fh[i]; ftab[32 + i] = p.rc.fl[i]; }
    }
    xcd_barrier(bar);

    {
        for (int nb = bid; nb < 112; nb += G) {
            const int n0 = 32 * nb, r8 = lane >> 3, c = lane & 7, kw = 128 * wave;
            float* cm = (float*)(lds + 8 * 4608);
            unsigned* tl = (unsigned*)(lds + wave * 4608);
            float4 v[16];
#pragma unroll
            for (int i = 0; i < 16; ++i) { const int kk = 32 * (i >> 2) + 4 * r8 + (i & 3); v[i] = *(const float4*)(p.w_in + (size_t)(kw + kk) * 3584 + n0 + 4 * c); }
            float4 mx = {0.f, 0.f, 0.f, 0.f}, bs = {0.f, 0.f, 0.f, 0.f};
#pragma unroll
            for (int i = 0; i < 16; ++i) { const int kk = 32 * (i >> 2) + 4 * r8 + (i & 3); const float f = p.g1[kw + kk] * (1.f + mod[1024 + kw + kk]), sh = mod[kw + kk];
                bs.x += sh * v[i].x; bs.y += sh * v[i].y; bs.z += sh * v[i].z; bs.w += sh * v[i].w;
                v[i].x *= f; v[i].y *= f; v[i].z *= f; v[i].w *= f;
                mx.x = fmaxf(mx.x, fabsf(v[i].x)); mx.y = fmaxf(mx.y, fabsf(v[i].y)); mx.z = fmaxf(mx.z, fabsf(v[i].z)); mx.w = fmaxf(mx.w, fabsf(v[i].w)); }
#pragma unroll
            for (int o = 8; o < 64; o <<= 1) { mx.x = fmaxf(mx.x, __shfl_xor(mx.x, o)); mx.y = fmaxf(mx.y, __shfl_xor(mx.y, o)); mx.z = fmaxf(mx.z, __shfl_xor(mx.z, o)); mx.w = fmaxf(mx.w, __shfl_xor(mx.w, o));
                bs.x += __shfl_xor(bs.x, o); bs.y += __shfl_xor(bs.y, o); bs.z += __shfl_xor(bs.z, o); bs.w += __shfl_xor(bs.w, o); }
            if (lane < 8) { *(float4*)(cm + wave * 32 + 4 * c) = mx; *(float4*)(cm + 256 + wave * 32 + 4 * c) = bs; }
            __syncthreads();
            if (wave == 1 && lane < 8) { float4 t = {0.f, 0.f, 0.f, 0.f};
#pragma unroll
                for (int w2 = 0; w2 < 8; ++w2) { const float4 o = *(const float4*)(cm + 256 + w2 * 32 + 4 * c); t.x += o.x; t.y += o.y; t.z += o.z; t.w += o.w; }
                *(float4*)(bias_f + n0 + 4 * c) = t; }
#pragma unroll
            for (int w2 = 0; w2 < 8; ++w2) { const float4 o = *(const float4*)(cm + w2 * 32 + 4 * c); mx.x = fmaxf(mx.x, o.x); mx.y = fmaxf(mx.y, o.y); mx.z = fmaxf(mx.z, o.z); mx.w = fmaxf(mx.w, o.w); }
            if (wave == 0 && lane < 8) *(float4*)(swf + n0 + 4 * c) = make_float4(mx.x * (1.f / 127.f), mx.y * (1.f / 127.f), mx.z * (1.f / 127.f), mx.w * (1.f / 127.f));
            const float qx = (mx.x > 0.f) ? 127.f / mx.x : 0.f, qy = (mx.y > 0.f) ? 127.f / mx.y : 0.f, qz = (mx.z > 0.f) ? 127.f / mx.z : 0.f, qw = (mx.w > 0.f) ? 127.f / mx.w : 0.f;
#pragma unroll
            for (int a = 0; a < 4; ++a) {
                unsigned d[4];
#pragma unroll
                for (int j = 0; j < 4; ++j) {
                    const float qq = (j == 0) ? qx : (j == 1) ? qy : (j == 2) ? qz : qw;
                    unsigned w = 0;
#pragma unroll
                    for (int b = 0; b < 4; ++b) { const float4 t = v[4 * a + b]; const float e = (j == 0) ? t.x : (j == 1) ? t.y : (j == 2) ? t.z : t.w;
                        w |= (__float_as_uint(fmaf(e, qq, 12582912.f)) & 255u) << (8 * b); }
                    d[j] = w;
                }
#pragma unroll
                for (int j = 0; j < 4; ++j) tl[(4 * c + j) * 34 + 8 * a + r8] = d[j];
            }
            asm volatile("s_waitcnt lgkmcnt(0)" ::: "memory");
            const int rb = cmap_in(n0);
#pragma unroll
            for (int jj = 0; jj < 4; ++jj) { const int q = lane + 64 * jj, n = q >> 3, ch = q & 7;
                const uint2 lo = *(const uint2*)(tl + n * 34 + 4 * ch), hi = *(const uint2*)(tl + n * 34 + 4 * ch + 2);
                pg8::u32x4 o; o.x = lo.x; o.y = lo.y; o.z = hi.x; o.w = hi.y;
                *(pg8::u32x4*)((unsigned char*)Win_t + (size_t)(rb + n) * 1024 + kw + 16 * ch) = o; }
            __syncthreads();
        }
    }
    xcd_barrier(bar);

    {
        pg8::Gemm g{(const bf16_t*)xq, Win_t, T, 3584, 512}; pg8::StaticOrder S; S.init(T, 3584, G, bid);
        EpiInprojMF E{P, rinv1, bias_f, p.pos, ftab, p.qg, p.kg, swf};
        pg8::gemm_phase<EpiInprojMF, pg8::StaticOrder, true>((PG8_LAS unsigned char*)lds, g, S, E);
        const int nidle = (G > 128) ? G - 128 : G, ib = (G > 128) ? bid - 128 : bid;
        {
            float* scr = (float*)(lds + wave * 16384);
            if (ib >= 0) for (int it = ib * 8 + wave; it < 16 * 32; it += nidle * 8) transpose_item<false, false>(p.w_out, 1024, 1024, Wout_t, scr, it, lane, nullptr, nullptr);
            __syncthreads();
        }
        if (ib >= 0) for (int wu = ib; wu < 256; wu += nidle) {
            const int hp = wu >> 4, blk = wu & 15, i0 = blk * 64;
            __syncthreads();
            unsigned char* Wt = lds; unsigned char* St = lds + 64 * 272; float* bred = (float*)(lds + 64 * 272 + 128 * 272);
            for (int e4 = tid; e4 < 2048; e4 += 512) { const int r = e4 >> 5, c4 = e4 & 31; const float4 v = *(const float4*)(p.wq + (size_t)(i0 + r) * 2048 + hp * 128 + 4 * c4);
                *(uint2*)(Wt + r * 272 + c4 * 8) = make_uint2(pk2(v.x, v.y), pk2(v.z, v.w)); }
            for (int e4 = tid; e4 < 4096; e4 += 512) { const int r = e4 >> 5, c4 = e4 & 31; const float4 v = *(const float4*)(p.sk + ((size_t)hp * 128 + r) * 128 + 4 * c4);
                *(uint2*)(St + r * 272 + c4 * 8) = make_uint2(pk2(v.x, v.y), pk2(v.z, v.w)); }
            __syncthreads();
            const int rt = wave >> 2, ct = wave & 3, l31 = lane & 31, hf = lane >> 5;
            f32x16 C;
#pragma unroll
            for (int r = 0; r < 16; ++r) C[r] = 0.f;
#pragma unroll
            for (int s8 = 0; s8 < 8; ++s8) C = MFMA32(*(const bf16x8*)(Wt + (32 * rt + l31) * 272 + (16 * s8 + 8 * hf) * 2), *(const bf16x8*)(St + (32 * ct + l31) * 272 + (16 * s8 + 8 * hf) * 2), C);
            float bsum = 0.f; unsigned amx = 0u;
            bf16_t* wcol = Weff_t + (size_t)(hp * 128 + 32 * ct + l31) * 1024 + i0 + 32 * rt + 4 * hf;
#pragma unroll
            for (int g4 = 0; g4 < 4; ++g4) {
                const int i = i0 + 32 * rt + 8 * g4 + 4 * hf;
                const float4 gg = *(const float4*)(p.g2 + i), sc = *(const float4*)(mod + 4096 + i), sh = *(const float4*)(mod + 3072 + i);
                const float c0 = C[4 * g4], c1 = C[4 * g4 + 1], c2 = C[4 * g4 + 2], c3 = C[4 * g4 + 3];
                bsum += sh.x * c0 + sh.y * c1 + sh.z * c2 + sh.w * c3;
                const uint2 wv = make_uint2(pk2(c0 * gg.x * (1.f + sc.x), c1 * gg.y * (1.f + sc.y)), pk2(c2 * gg.z * (1.f + sc.z), c3 * gg.w * (1.f + sc.w)));
                *(uint2*)(wcol + 8 * g4) = wv;
                amx = max(max(amx, (wv.x << 16) & 0x7fffffffu), max(wv.x & 0x7fff0000u, max((wv.y << 16) & 0x7fffffffu, wv.y & 0x7fff0000u)));
            }
            amx = max(amx, (unsigned)__shfl_xor((int)amx, 32));
            if (hf == 0) (void)__hip_atomic_fetch_max(ctl + CTL_CMAX + hp * 128 + 32 * ct + l31, amx, __ATOMIC_RELAXED, __HIP_MEMORY_SCOPE_AGENT);
            bsum += __shfl_xor(bsum, 32);
            if (hf == 0) bred[rt * 128 + 32 * ct + l31] = bsum;
            __syncthreads();
            if (tid < 128) bq_part[(size_t)blk * 2048 + hp * 128 + tid] = bred[tid] + bred[128 + tid];
        }
        __syncthreads();
        if (ib >= 0) convert_tables(p.down, p.up, q8, dsc, lane, ib * 8 + wave, nidle * 8, 0, CONV_SPLIT);
    }
    xcd_barrier(bar);
    wave = threadIdx.x >> 6; asm volatile("" : "+v"(wave));

    {
        const int gw = __builtin_amdgcn_readfirstlane(bid * 8 + wave), NGW = G * 8, l31 = lane & 31, hf = lane >> 5;
        const int wv0 = __builtin_amdgcn_readfirstlane(wave);
        for (int U = gw; U < 1024; U += NGW) {
            const int n = U >> 3, h = U & 7;
            f32x16 C[2][2];
#pragma unroll
            for (int a = 0; a < 2; ++a)
#pragma unroll
                for (int b = 0; b < 2; ++b)
#pragma unroll
                    for (int r = 0; r < 16; ++r) C[a][b][r] = 0.f;
            unsigned char* Kt = lds + wv0 * 9216; unsigned char* Vt = Kt + 4608;
            const int r8 = lane >> 3, pc = lane & 7, trq = (lane & 15) >> 2, trp = lane & 3, trd = (lane >> 4) & 1;
            const char* kbase = (const char*)(Kr + (size_t)n * 128 * 512 + h * 64); const char* vbase = (const char*)(Vr + (size_t)n * 128 * 512 + h * 64);
            const unsigned loff = (unsigned)(r8 * 512 + pc * 8) * 2u;
            const float lg = lg2_head(h);
            pg8::u32x4 gK[4], gV[4];
#pragma unroll
            for (int i = 0; i < 4; ++i) { gK[i] = *(const pg8::u32x4*)(kbase + (loff + i * 8192u)); gV[i] = *(const pg8::u32x4*)(vbase + (loff + i * 8192u)); }
            for (int sb4 = 0; sb4 < 4; ++sb4) {
#pragma unroll
                for (int i = 0; i < 4; ++i) { *(pg8::u32x4*)(Kt + (8 * i + r8) * 144 + pc * 16) = gK[i]; *(pg8::u32x4*)(Vt + (8 * i + r8) * 144 + pc * 16) = gV[i]; }
                { const int sn = (sb4 < 3) ? sb4 + 1 : sb4;
#pragma unroll
                  for (int i = 0; i < 4; ++i) { gK[i] = *(const pg8::u32x4*)(kbase + (size_t)sn * 32768 + (loff + i * 8192u)); gV[i] = *(const pg8::u32x4*)(vbase + (size_t)sn * 32768 + (loff + i * 8192u)); } }
#pragma unroll
                for (int s = 0; s < 2; ++s) {
                    bf16x8 Af[2], Bf[2];
#pragma unroll
                    for (int a = 0; a < 2; ++a) {
                        Af[a] = tr_frag(Vt + (16 * s + 8 * hf + trq) * 144 + (32 * a + 16 * trd + 4 * trp) * 2, 4);
                        const bf16x8 kraw = tr_frag(Kt + (16 * s + 8 * hf + trq) * 144 + (32 * a + 16 * trd + 4 * trp) * 2, 4);
                        const pg8::u32x4 kw = __builtin_bit_cast(pg8::u32x4, kraw); const unsigned kk[4] = {kw.x, kw.y, kw.z, kw.w};
                        pg8::u32x4 o; unsigned* op = (unsigned*)&o;
#pragma unroll
                        for (int e2 = 0; e2 < 4; ++e2) {
                            const int j0 = 32 * sb4 + 16 * s + 8 * hf + 2 * e2;
                            const float z0 = __builtin_amdgcn_exp2f((float)(127 - j0) * lg), z1 = __builtin_amdgcn_exp2f((float)(126 - j0) * lg);
                            op[e2] = pg8::cvt_pk_bf16(__uint_as_float(kk[e2] << 16) * z0, __uint_as_float(kk[e2] & 0xffff0000u) * z1);
                        }
                        Bf[a] = __builtin_bit_cast(bf16x8, o);
                    }
#pragma unroll
                    for (int a = 0; a < 2; ++a)
#pragma unroll
                        for (int b = 0; b < 2; ++b) C[a][b] = MFMA32(Af[a], Bf[b], C[a][b]);
                }
            }
            float* dst = kv + (size_t)(n * 8 + h) * 4096;
#pragma unroll
            for (int a = 0; a < 2; ++a)
#pragma unroll
                for (int b = 0; b < 2; ++b)
#pragma unroll
                    for (int r = 0; r < 16; ++r) dst[(32 * a + (r & 3) + 8 * (r >> 2) + 4 * hf) * 64 + 32 * b + l31] = C[a][b][r];
        }
        bf16x8 Tri[2];
        {
            pg8::u32x4 w0, w1; unsigned* p0 = (unsigned*)&w0; unsigned* p1 = (unsigned*)&w1;
#pragma unroll
            for (int e2 = 0; e2 < 4; ++e2) {
                unsigned a0 = 0, a1 = 0;
#pragma unroll
                for (int q = 0; q < 2; ++q) { const int e = 2 * e2 + q, ip = 8 * (e >> 2) + 4 * hf + (e & 3);
                    a0 |= ((ip > l31) ? 0x3F80u : 0u) << (16 * q); a1 |= ((16 + ip > l31) ? 0x3F80u : 0u) << (16 * q); }
                p0[e2] = a0; p1[e2] = a1;
            }
            Tri[0] = __builtin_bit_cast(bf16x8, w0); Tri[1] = __builtin_bit_cast(bf16x8, w1);
        }
        const bool sb_local = (G % 8 == 0) && (4096 % G == 0) && ((4096 / G) % 8 == 0);
        const int sb_per_wave = sb_local ? 4096 / G / 8 : (4096 + NGW - 1 - gw) / NGW;
        const int wv = __builtin_amdgcn_readfirstlane(wave);
        for (int ps = 0; ps < sb_per_wave; ++ps) {
            const int U = sb_local ? 0 : gw + ps * NGW;
            const int h = sb_local ? (bid & 7) : (U & 7), qt = sb_local ? (bid >> 3) * (4096 / G) + ps * 8 + wv : (U >> 3), q0 = qt * 32;
            f32x16 O[2];
#pragma unroll
            for (int r = 0; r < 16; ++r) { O[0][r] = 0.f; O[1][r] = 0.f; }
            float carry = 0.f;
            unsigned char* Kt = lds + wv * 9216; unsigned char* Vt = Kt + 4608;
            const int r8 = lane >> 3, pc = lane & 7;
            const char* kbase = (const char*)(Ks + h * 64); const char* vbase = (const char*)(Vs + h * 64);
            const unsigned loff = (unsigned)(r8 * 512 + pc * 8) * 2u;
            pg8::u32x4 gK[4], gV[4];
            bf16x8 Qf[4];
            {
                const char* qbase = (const char*)(Qs + h * 64);
#pragma unroll
                for (int i = 0; i < 4; ++i) gK[i] = *(const pg8::u32x4*)(qbase + (size_t)qt * 32768 + (loff + i * 8192u));
#pragma unroll
                for (int i = 0; i < 4; ++i) *(pg8::u32x4*)(Kt + (8 * i + r8) * 144 + pc * 16) = gK[i];
#pragma unroll
                for (int s = 0; s < 4; ++s) Qf[s] = *(const bf16x8*)(Kt + l31 * 144 + 32 * s + 16 * hf);
            }
#pragma unroll
            for (int i = 0; i < 4; ++i) { gK[i] = *(const pg8::u32x4*)(kbase + (size_t)qt * 32768 + (loff + i * 8192u)); gV[i] = *(const pg8::u32x4*)(vbase + (size_t)qt * 32768 + (loff + i * 8192u)); }
            const int trq = (lane & 15) >> 2, trp = lane & 3, trd = (lane >> 4) & 1;
            for (int kb = qt; kb >= 0; --kb) {
#pragma unroll
                for (int i = 0; i < 4; ++i) { *(pg8::u32x4*)(Kt + (8 * i + r8) * 144 + pc * 16) = gK[i]; *(pg8::u32x4*)(Vt + (8 * i + r8) * 144 + pc * 16) = gV[i]; }
                {
                    const int kbn = (kb > 0) ? kb - 1 : 0;
#pragma unroll
                    for (int i = 0; i < 4; ++i) { gK[i] = *(const pg8::u32x4*)(kbase + (size_t)kbn * 32768 + (loff + i * 8192u)); gV[i] = *(const pg8::u32x4*)(vbase + (size_t)kbn * 32768 + (loff + i * 8192u)); }
                }
                bf16x8 Kf[4], Vf[2][2];
#pragma unroll
                for (int s = 0; s < 4; ++s) Kf[s] = *(const bf16x8*)(Kt + l31 * 144 + 32 * s + 16 * hf);
#pragma unroll
                for (int s = 0; s < 2; ++s)
#pragma unroll
                    for (int dt = 0; dt < 2; ++dt) {
                        Vf[s][dt] = tr_frag(Vt + (16 * s + 4 * hf + trq) * 144 + (32 * dt + 16 * trd + 4 * trp) * 2, 8);
                    }
                f32x16 S;
#pragma unroll
                for (int r = 0; r < 16; ++r) S[r] = 0.f;
#pragma unroll
                for (int s = 0; s < 4; ++s) S = MFMA32(Kf[s], Qf[s], S);
                const bool diag = (kb == qt);
                f32x16 sp, lb;
                float csum = 0.f;
                if (diag) {
#pragma unroll
                    for (int r = 0; r < 16; ++r) {
                        const int i = (r & 3) + 8 * (r >> 2) + 4 * hf;
                        const float z = S[r];
                        const float l1p = __builtin_amdgcn_logf(1.0f + __builtin_amdgcn_exp2f(-fabsf(z)));
                        const float spv = (i < l31) ? (fmaxf(z, 0.f) + l1p) : 0.f;
                        sp[r] = spv; lb[r] = (i < l31) ? (fminf(z, 0.f) - l1p) : -INFINITY; csum += spv;
                    }
                } else {
#pragma unroll
                    for (int r = 0; r < 16; ++r) {
                        const float z = S[r];
                        const float l1p = __builtin_amdgcn_logf(1.0f + __builtin_amdgcn_exp2f(-fabsf(z)));
                        const float spv = fmaxf(z, 0.f) + l1p;
                        sp[r] = spv; lb[r] = fminf(z, 0.f) - l1p; csum += spv;
                    }
                }
                f32x16 Rt;
#pragma unroll
                for (int r = 0; r < 16; ++r) Rt[r] = carry;
#pragma unroll
                for (int s = 0; s < 2; ++s) Rt = MFMA32(Tri[s], pack_frag(sp, s), Rt);
                f32x16 wv;
#pragma unroll
                for (int r = 0; r < 16; ++r) wv[r] = __builtin_amdgcn_exp2f(lb[r] - Rt[r]);
#pragma unroll
                for (int s = 0; s < 2; ++s) { const bf16x8 wp = pack_frag(wv, s);
#pragma unroll
                    for (int dt = 0; dt < 2; ++dt) O[dt] = MFMA32(Vf[s][dt], wp, O[dt]); }
                csum += __shfl_xor(csum, 32);
                carry += csum;
                if (__all(carry > 127.f)) break;
            }
            float ss = 0.f;
#pragma unroll
            for (int r = 0; r < 16; ++r) ss += O[0][r] * O[0][r] + O[1][r] * O[1][r];
            ss += __shfl_xor(ss, 32);
            const float rn = 1.0f / sqrtf(ss * (1.f / 64.f) + EPS);
#pragma unroll
            for (int dt = 0; dt < 2; ++dt)
#pragma unroll
                for (int g4 = 0; g4 < 4; ++g4) {
                    const int d = 32 * dt + 8 * g4 + 4 * hf;
                    const float4 gn = *(const float4*)(p.og + d);
                    uint2 w; w.x = pg8::cvt_pk_bf16(O[dt][4 * g4] * rn * gn.x, O[dt][4 * g4 + 1] * rn * gn.y); w.y = pg8::cvt_pk_bf16(O[dt][4 * g4 + 2] * rn * gn.z, O[dt][4 * g4 + 3] * rn * gn.w);
                    *(uint2*)(Kt + l31 * 144 + d * 2) = w;
                }
#pragma unroll
            for (int i = 0; i < 4; ++i) *(pg8::u32x4*)(ycat + (size_t)(q0 + 8 * i + r8) * 1024 + 512 + h * 64 + pc * 8) = *(const pg8::u32x4*)(Kt + (8 * i + r8) * 144 + pc * 16);
        }
    }
    xcd_barrier(bar);

    if (bid == 255 % G) for (int n = tid; n < 2048; n += 512) { float s = 0.f;
#pragma unroll
        for (int b8 = 0; b8 < 16; ++b8) s += bq_part[(size_t)b8 * 2048 + n];
        bias_q[n] = s; }
    if (bid >= 64) for (int row = (bid - 64) * 8 + wave; row < 2048; row += (G - 64) * 8) {
        const float am = __uint_as_float(ctl[CTL_CMAX + row]), qs = (am > 0.f) ? 127.f / am : 0.f;
        const pg8::u32x4 a = *(const pg8::u32x4*)(Weff_t + (size_t)row * 1024 + 16 * lane), b = *(const pg8::u32x4*)(Weff_t + (size_t)row * 1024 + 16 * lane + 8);
        pg8::u32x4 o;
#define QB(w) ((__float_as_uint(fmaf(__uint_as_float((w) << 16), qs, 12582912.f)) & 255u) | ((__float_as_uint(fmaf(__uint_as_float((w) & 0xffff0000u), qs, 12582912.f)) & 255u) << 8))
        o.x = QB(a.x) | (QB(a.y) << 16); o.y = QB(a.z) | (QB(a.w) << 16); o.z = QB(b.x) | (QB(b.y) << 16); o.w = QB(b.z) | (QB(b.w) << 16);
#undef QB
        *(pg8::u32x4*)(Weffq_t + (size_t)row * 1024 + 16 * lane) = o;
        if (lane == 0) sq[row] = am * (1.f / 127.f);
    }
    if (G > 64 && bid >= 64) convert_tables(p.down, p.up, q8, dsc, lane, (bid - 64) * 8 + wave, (G - 64) * 8, CONV_SPLIT, 32768);
    else if (G <= 64) convert_tables(p.down, p.up, q8, dsc, lane, bid * 8 + wave, G * 8, CONV_SPLIT, 32768);
    for (int idx = bid * 512 + tid; idx < 32768; idx += G * 512) {
        const int h = idx >> 12;
        const float cd = exp2f(128.f * lg2_head(h));
        float s = 0.f;
        for (int n0 = 0; n0 < 128; n0 += 32) {
            float kvv[32];
#pragma unroll
            for (int q = 0; q < 32; ++q) kvv[q] = kv[(size_t)(n0 + q) * 32768 + idx];
#pragma unroll
            for (int q = 0; q < 32; ++q) { stT[(size_t)(n0 + q) * 32768 + idx] = f2bf(s); s = cd * s + kvv[q]; }
        }
    }
    xcd_barrier(bar);

    {
        const int gw = __builtin_amdgcn_readfirstlane(bid * 8 + wave), NGW = G * 8, l31 = lane & 31, hf = lane >> 5;
        const int wv4 = __builtin_amdgcn_readfirstlane(wave);
        for (int W2 = gw; W2 < 2048; W2 += NGW) {
            const int nh = W2 >> 1, n = nh >> 3, h = nh & 7;
            const float lg = lg2_head(h);
#pragma unroll 1
            for (int pass = 0; pass < 2; ++pass) {
                const int qt = (W2 & 1) ? (pass ? 2 : 1) : (pass ? 3 : 0);
                const int il = qt * 32 + l31, tq = n * 128 + il;
                unsigned char* Kt = lds + wv4 * 9216; unsigned char* Vt = Kt + 4608;
                const int r8 = lane >> 3, pc = lane & 7, trq = (lane & 15) >> 2, trp = lane & 3, trd = (lane >> 4) & 1;
                const unsigned loff = (unsigned)(r8 * 512 + pc * 8) * 2u;
                pg8::u32x4 gK[4], gV[4];
                bf16x8 Qf[4];
                {
                    const char* qbase = (const char*)(Qr + (size_t)(n * 128 + qt * 32) * 512 + h * 64);
                    const char* sbase = (const char*)(stT + (size_t)nh * 4096) + (unsigned)(r8 * 64 + pc * 8) * 2u;
#pragma unroll
                    for (int i = 0; i < 4; ++i) gK[i] = *(const pg8::u32x4*)(qbase + (loff + i * 8192u));
#pragma unroll
                    for (int i = 0; i < 4; ++i) *(pg8::u32x4*)(Kt + (8 * i + r8) * 144 + pc * 16) = gK[i];
#pragma unroll
                    for (int s = 0; s < 4; ++s) Qf[s] = *(const bf16x8*)(Kt + l31 * 144 + 32 * s + 16 * hf);
#pragma unroll
                    for (int i = 0; i < 4; ++i) { gK[i] = *(const pg8::u32x4*)(sbase + i * 1024u); gV[i] = *(const pg8::u32x4*)(sbase + 4096u + i * 1024u); }
#pragma unroll
                    for (int i = 0; i < 4; ++i) { *(pg8::u32x4*)(Kt + (8 * i + r8) * 144 + pc * 16) = gK[i]; *(pg8::u32x4*)(Kt + (32 + 8 * i + r8) * 144 + pc * 16) = gV[i]; }
                }
                f32x16 O[2];
#pragma unroll
                for (int r = 0; r < 16; ++r) { O[0][r] = 0.f; O[1][r] = 0.f; }
#pragma unroll
                for (int s = 0; s < 4; ++s)
#pragma unroll
                    for (int dt = 0; dt < 2; ++dt) O[dt] = MFMA32(*(const bf16x8*)(Kt + (32 * dt + l31) * 144 + 32 * s + 16 * hf), Qf[s], O[dt]);
                const float xi = exp2f((float)(il + 1) * lg);
#pragma unroll
                for (int r = 0; r < 16; ++r) { O[0][r] *= xi; O[1][r] *= xi; }
                const char* kbase = (const char*)(Kr + (size_t)n * 128 * 512 + h * 64); const char* vbase = (const char*)(Vr + (size_t)n * 128 * 512 + h * 64);
#pragma unroll
                for (int i = 0; i < 4; ++i) { gK[i] = *(const pg8::u32x4*)(kbase + (loff + i * 8192u)); gV[i] = *(const pg8::u32x4*)(vbase + (loff + i * 8192u)); }
                for (int jb = 0; jb <= qt; ++jb) {
#pragma unroll
                    for (int i = 0; i < 4; ++i) { *(pg8::u32x4*)(Kt + (8 * i + r8) * 144 + pc * 16) = gK[i]; *(pg8::u32x4*)(Vt + (8 * i + r8) * 144 + pc * 16) = gV[i]; }
                    { const int jn = (jb < qt) ? jb + 1 : jb;
#pragma unroll
                      for (int i = 0; i < 4; ++i) { gK[i] = *(const pg8::u32x4*)(kbase + (size_t)jn * 32768 + (loff + i * 8192u)); gV[i] = *(const pg8::u32x4*)(vbase + (size_t)jn * 32768 + (loff + i * 8192u)); } }
                    bf16x8 Kf[4], Vf[2][2];
#pragma unroll
                    for (int s = 0; s < 4; ++s) Kf[s] = *(const bf16x8*)(Kt + l31 * 144 + 32 * s + 16 * hf);
#pragma unroll
                    for (int s = 0; s < 2; ++s)
#pragma unroll
                        for (int dt = 0; dt < 2; ++dt) Vf[s][dt] = tr_frag(Vt + (16 * s + 4 * hf + trq) * 144 + (32 * dt + 16 * trd + 4 * trp) * 2, 8);
                    f32x16 S;
#pragma unroll
                    for (int r = 0; r < 16; ++r) S[r] = 0.f;
#pragma unroll
                    for (int s = 0; s < 4; ++s) S = MFMA32(Kf[s], Qf[s], S);
#pragma unroll
                    for (int r = 0; r < 16; ++r) {
                        const int jl = jb * 32 + (r & 3) + 8 * (r >> 2) + 4 * hf, dl = il - jl;
                        S[r] = (dl >= 0) ? S[r] * __builtin_amdgcn_exp2f((float)dl * lg) : 0.f;
                    }
#pragma unroll
                    for (int s = 0; s < 2; ++s) { const bf16x8 wp = pack_frag(S, s);
#pragma unroll
                        for (int dt = 0; dt < 2; ++dt) O[dt] = MFMA32(Vf[s][dt], wp, O[dt]); }
                }
                float sm = 0.f;
#pragma unroll
                for (int r = 0; r < 16; ++r) sm += O[0][r] + O[1][r];
                sm += __shfl_xor(sm, 32);
                const float mean = sm * (1.f / 64.f);
                float vs = 0.f;
#pragma unroll
                for (int r = 0; r < 16; ++r) { const float d0 = O[0][r] - mean, d1 = O[1][r] - mean; vs += d0 * d0 + d1 * d1; }
                vs += __shfl_xor(vs, 32);
                const float rstd = 1.0f / sqrtf(vs * (1.f / 64.f) + EPS);
                {
                    const char* gbase = (const char*)(Gr + (size_t)(n * 128 + qt * 32) * 512 + h * 64);
#pragma unroll
                    for (int i = 0; i < 4; ++i) gV[i] = *(const pg8::u32x4*)(gbase + (loff + i * 8192u));
#pragma unroll
                    for (int i = 0; i < 4; ++i) *(pg8::u32x4*)(Vt + (8 * i + r8) * 144 + pc * 16) = gV[i];
                }
#pragma unroll
                for (int dt = 0; dt < 2; ++dt)
#pragma unroll
                    for (int g4 = 0; g4 < 4; ++g4) {
                        const int e = 32 * dt + 8 * g4 + 4 * hf;
                        const float4 gn = *(const float4*)(p.rgain + h * 64 + e);
                        const uint2 gg = *(const uint2*)(Vt + l31 * 144 + e * 2);
                        const float g0 = __uint_as_float(gg.x << 16), g1 = __uint_as_float(gg.x & 0xffff0000u), g2v = __uint_as_float(gg.y << 16), g3 = __uint_as_float(gg.y & 0xffff0000u);
                        uint2 w;
                        w.x = pg8::cvt_pk_bf16((O[dt][4 * g4] - mean) * rstd * gn.x * g0, (O[dt][4 * g4 + 1] - mean) * rstd * gn.y * g1);
                        w.y = pg8::cvt_pk_bf16((O[dt][4 * g4 + 2] - mean) * rstd * gn.z * g2v, (O[dt][4 * g4 + 3] - mean) * rstd * gn.w * g3);
                        *(uint2*)(Kt + l31 * 144 + e * 2) = w;
                    }
#pragma unroll
                for (int i = 0; i < 4; ++i) *(pg8::u32x4*)(ycat + (size_t)(n * 128 + qt * 32 + 8 * i + r8) * 1024 + h * 64 + pc * 8) = *(const pg8::u32x4*)(Kt + (8 * i + r8) * 144 + pc * 16);
            }
        }
    }
    xcd_barrier(bar);

    {
        pg8::Gemm g{ycat, Wout_t, T, 1024, 1024}; pg8::StaticOrder S; S.init(T, 1024, G, bid);
        EpiOutprojMF E{p.x, mod + 2048, x1b, part2, pmax, x1q, rinv2q, ctl};
        pg8::gemm_phase<EpiOutprojMF, pg8::StaticOrder>((PG8_LAS unsigned char*)lds, g, S, E);
    }
    xcd_barrier(bar);

    for (int round = 0; round < 2; ++round) {
        pg8::Gemm g{(const bf16_t*)x1q, (const bf16_t*)Weffq_t, T, 2048, 512}; OneUnitOrder S; S.base.init(T, 2048, G, bid); S.round = round;
        EpiTopkMF E{rinv2q, sq, bias_q, ids, gates};
        pg8::gemm_phase<EpiTopkMF, OneUnitOrder, true>((PG8_LAS unsigned char*)lds, g, S, E);
    }
    xcd_barrier(bar);

    {
        constexpr int IDS_LD = 136, ACT_LD = 136;
        const float* scale2 = mod + 4096; const float* shift2 = mod + 3072; const float* gate2 = mod + 5120;
        unsigned short* ids_l = (unsigned short*)lds; float* act_l = (float*)(lds + 32768);
        bf16_t* ds_l = (bf16_t*)(lds + 69632);
        const int t0 = bid * 64, tt = lane >> 3, sub = lane & 7, tl = wave * 8 + tt, t = t0 + tl;
        for (int e = tid; e < 1024; e += 512) { const int r = e >> 4, c8 = e & 15; *(uint4*)(ids_l + r * IDS_LD + c8 * 8) = *(const uint4*)(ids + (size_t)(t0 + r) * 128 + c8 * 8); }
        for (int e = tid; e < 64 * ACT_LD; e += 512) act_l[e] = 0.f;
        for (int e = tid; e < 4096; e += 512) ((uint4*)ds_l)[e] = ((const uint4*)dsc)[e];
        float* s2_l = (float*)(lds + 143360); float* sh2_l = s2_l + 1024; float* gt2_l = s2_l + 2048;
        for (int e = tid; e < 1024; e += 512) { s2_l[e] = p.g2[e] * (1.f + scale2[e]); sh2_l[e] = shift2[e]; gt2_l[e] = gate2[e]; }
        __syncthreads();
        float ri;
        { const float4* pp = (const float4*)(part2 + (size_t)t * 16); const float4 p0 = pp[0], p1 = pp[1], p2 = pp[2], p3 = pp[3];
          const float ssum = ((p0.x + p0.y) + (p0.z + p0.w)) + ((p1.x + p1.y) + (p1.z + p1.w)) + ((p2.x + p2.y) + (p2.z + p2.w)) + ((p3.x + p3.y) + (p3.z + p3.w));
          ri = 1.0f / sqrtf(ssum * (1.0f / D) + EPS); }
        const unsigned short* myids = ids_l + tl * IDS_LD;
        float* myact = act_l + tl * ACT_LD;
        const bool s4 = (sub & 4) != 0, s2 = (sub & 2) != 0, s1 = (sub & 1) != 0;
        const unsigned suboff = (unsigned)sub * 16u;
        typedef float f32x2 __attribute__((ext_vector_type(2)));
#define P9_LOAD(W, JB) do { const uint4 idv_ = *(const uint4*)(myids + 8 * (JB)); const unsigned idw_[4] = {idv_.x, idv_.y, idv_.z, idv_.w}; \
        _Pragma("unroll") for (int k_ = 0; k_ < 8; ++k_) { const unsigned id_ = (idw_[k_ >> 1] >> (16 * (k_ & 1))) & 0xffffu; W[k_] = *(const uint4*)(sbase + (id_ * 128u + suboff)); } } while (0)
#define P9_DOWN4(W, JB) do { int pd_[8]; \
        _Pragma("unroll") for (int k_ = 0; k_ < 8; ++k_) { const unsigned ww_[4] = {W[k_].x, W[k_].y, W[k_].z, W[k_].w}; int a0_ = 0, a1_ = 0; \
            _Pragma("unroll") for (int m_ = 0; m_ < 4; ++m_) { a0_ = __builtin_amdgcn_sdot4(hpe[m_], (int)(ww_[m_] & 0x0F0F0F0Fu), a0_, false); a1_ = __builtin_amdgcn_sdot4(hpo[m_], (int)((ww_[m_] >> 4) & 0x0F0F0F0Fu), a1_, false); } \
            pd_[k_] = a0_ + a1_ - hoff; } \
        int r4_[4], r2_[2]; \
        _Pragma("unroll") for (int k_ = 0; k_ < 4; ++k_) { const int snd_ = s4 ? pd_[k_] : pd_[k_ + 4], kp_ = s4 ? pd_[k_ + 4] : pd_[k_]; r4_[k_] = kp_ + __shfl_xor(snd_, 4); } \
        _Pragma("unroll") for (int k_ = 0; k_ < 2; ++k_) { const int snd_ = s2 ? r4_[k_] : r4_[k_ + 2], kp_ = s2 ? r4_[k_ + 2] : r4_[k_]; r2_[k_] = kp_ + __shfl_xor(snd_, 2); } \
        { const int snd_ = s1 ? r2_[0] : r2_[1], kp_ = s1 ? r2_[1] : r2_[0]; myact[8 * (JB) + sub] += (float)(kp_ + __shfl_xor(snd_, 1)) * hscale; } } while (0)
        uint2 xnx[8];
#pragma unroll
        for (int q = 0; q < 8; ++q) xnx[q] = *(const uint2*)(x1b + (size_t)t * D + 4 * sub + 32 * q);
        float gtv[16];
#pragma unroll
        for (int jb = 0; jb < 16; ++jb) gtv[jb] = gates[(size_t)t * 128 + 8 * jb + sub];
        const unsigned char* sbase = q8;
        uint4 wA[8], wB[8];
        P9_LOAD(wA, 0);
        for (int c = 0; c < 4; ++c) {
            uint2 xcur[8];
#pragma unroll
            for (int q = 0; q < 8; ++q) xcur[q] = xnx[q];
            { const int cn = (c < 3) ? c + 1 : c;
#pragma unroll
              for (int q = 0; q < 8; ++q) xnx[q] = *(const uint2*)(x1b + (size_t)t * D + 256 * cn + 4 * sub + 32 * q); }
            float hf[8][4]; float hmax = 0.f;
#pragma unroll
            for (int q = 0; q < 8; ++q) {
                const int col = 256 * c + 4 * sub + 32 * q;
                const uint2 xw = xcur[q];
                const float4 sv = *(const float4*)(s2_l + col), sh = *(const float4*)(sh2_l + col);
                hf[q][0] = __uint_as_float(xw.x << 16) * ri * sv.x + sh.x; hf[q][1] = __uint_as_float(xw.x & 0xffff0000u) * ri * sv.y + sh.y;
                hf[q][2] = __uint_as_float(xw.y << 16) * ri * sv.z + sh.z; hf[q][3] = __uint_as_float(xw.y & 0xffff0000u) * ri * sv.w + sh.w;
                hmax = fmaxf(hmax, fmaxf(fmaxf(fabsf(hf[q][0]), fabsf(hf[q][1])), fmaxf(fabsf(hf[q][2]), fabsf(hf[q][3]))));
            }
            hmax = fmaxf(hmax, __shfl_xor(hmax, 1)); hmax = fmaxf(hmax, __shfl_xor(hmax, 2)); hmax = fmaxf(hmax, __shfl_xor(hmax, 4));
            const float hinv = (hmax > 0.f) ? 127.0f / hmax : 0.f, hscale = hmax * (1.0f / 127.0f);
            int hq[8][4];
#pragma unroll
            for (int q = 0; q < 8; ++q)
#pragma unroll
                for (int j = 0; j < 4; ++j) hq[q][j] = (int)__builtin_rintf(hf[q][j] * hinv);
            int hpe[4], hpo[4], hoff = 0;
#pragma unroll
            for (int m = 0; m < 4; ++m) {
                hpe[m] = (hq[2 * m][0] & 255) | ((hq[2 * m][2] & 255) << 8) | ((hq[2 * m + 1][0] & 255) << 16) | ((hq[2 * m + 1][2] & 255) << 24);
                hpo[m] = (hq[2 * m][1] & 255) | ((hq[2 * m][3] & 255) << 8) | ((hq[2 * m + 1][1] & 255) << 16) | ((hq[2 * m + 1][3] & 255) << 24);
            }
#pragma unroll
            for (int q = 0; q < 8; ++q) hoff += (hq[q][0] + hq[q][1]) + (hq[q][2] + hq[q][3]);
            hoff *= 8;
#pragma unroll 1
            for (int jb = 0; jb < 16; jb += 2) {
                P9_LOAD(wB, jb + 1);
                P9_DOWN4(wA, jb);
                if (jb + 2 < 16) P9_LOAD(wA, jb + 2);
                else { sbase = (c < 3) ? q8 + (size_t)(c + 1) * (16384 * 128) : q8 + (8u << 20); P9_LOAD(wA, 0); }
                P9_DOWN4(wB, jb + 1);
            }
        }
#undef P9_DOWN4
        signed char* aq_l = (signed char*)(lds + 135168);
        float avv[16]; float amax = 0.f;
#pragma unroll
        for (int jb = 0; jb < 16; ++jb) {
            const int j = 8 * jb + sub; const unsigned id = myids[j];
            const float a = myact[j] * bf2f(ds_l[id]);
            const float av = fabsf(a), tq = __builtin_amdgcn_rcpf(av * 0.2316418882f + 1.0f);
            float ql = tq * 0.5307027145f + (-0.7265760135f); ql = ql * tq + 0.7107068705f; ql = ql * tq + (-0.142248368f); ql = ql * tq + 0.127414796f; ql = ql * tq;
            const float mm = a * (ql * exp2f(a * a * (-0.72134752044f)));
            const float ge = (a < 0.f) ? mm : (a - mm);
            avv[jb] = ge * gtv[jb] * bf2f(ds_l[16384 + id]);
            amax = fmaxf(amax, fabsf(avv[jb]));
        }
        amax = fmaxf(amax, __shfl_xor(amax, 1)); amax = fmaxf(amax, __shfl_xor(amax, 2)); amax = fmaxf(amax, __shfl_xor(amax, 4));
        const float ainv = (amax > 0.f) ? 127.0f / amax : 0.f, ascale = amax * (1.0f / 127.0f);
        int aqsum = 0;
#pragma unroll
        for (int jb = 0; jb < 16; ++jb) { const int aqv = (int)__builtin_rintf(avv[jb] * ainv); aq_l[tl * 128 + 8 * jb + sub] = (signed char)aqv; aqsum += aqv; }
        aqsum += __shfl_xor(aqsum, 1); aqsum += __shfl_xor(aqsum, 2); aqsum += __shfl_xor(aqsum, 4);
        __syncthreads();
#define P9_PERM(HI, LO, SEL) __builtin_amdgcn_perm((HI), (LO), (SEL))
#define P9_T4(E0, E1, E2, E3, T0, T1, T2, T3) do { const unsigned p0_ = P9_PERM(E1, E0, 0x05010400u), p1_ = P9_PERM(E1, E0, 0x07030602u), p2_ = P9_PERM(E3, E2, 0x05010400u), p3_ = P9_PERM(E3, E2, 0x07030602u); \
        T0 = P9_PERM(p2_, p0_, 0x05040100u); T1 = P9_PERM(p2_, p0_, 0x07060302u); T2 = P9_PERM(p3_, p1_, 0x05040100u); T3 = P9_PERM(p3_, p1_, 0x07060302u); } while (0)
#define P9_UP4(W, JB) do { const uint2 aq8_ = *(const uint2*)(aq_l + tl * 128 + 8 * (JB)); const int aq4_[2] = {(int)aq8_.x, (int)aq8_.y}; \
        _Pragma("unroll") for (int g_ = 0; g_ < 2; ++g_) { \
            _Pragma("unroll") for (int m_ = 0; m_ < 4; ++m_) { \
                const unsigned w0_ = ((const unsigned*)&W[4 * g_ + 0])[m_], w1_ = ((const unsigned*)&W[4 * g_ + 1])[m_], w2_ = ((const unsigned*)&W[4 * g_ + 2])[m_], w3_ = ((const unsigned*)&W[4 * g_ + 3])[m_]; \
                unsigned t_[4]; \
                P9_T4(w0_, w1_, w2_, w3_, t_[0], t_[1], t_[2], t_[3]); \
                _Pragma("unroll") for (int k_ = 0; k_ < 4; ++k_) { \
                    oraw[4 * m_ + k_] = __builtin_amdgcn_sdot4(aq4_[g_], (int)t_[k_], oraw[4 * m_ + k_], false); \
                    olo[4 * m_ + k_] = __builtin_amdgcn_sdot4(aq4_[g_], (int)(t_[k_] & 0x0F0F0F0Fu), olo[4 * m_ + k_], false); } } } } while (0)
        for (int c = 0; c < 4; ++c) {
            int oraw[16], olo[16];
#pragma unroll
            for (int q = 0; q < 16; ++q) { oraw[q] = 0; olo[q] = 0; }
            uint2 xres[8];
#pragma unroll
            for (int q = 0; q < 8; ++q) xres[q] = *(const uint2*)(x1b + (size_t)t * D + 256 * c + 4 * sub + 32 * q);
#pragma unroll 1
            for (int jb = 0; jb < 16; jb += 2) {
                P9_LOAD(wB, jb + 1);
                P9_UP4(wA, jb);
                if (jb + 2 < 16) P9_LOAD(wA, jb + 2);
                else if (c < 3) { sbase = q8 + (8u << 20) + (size_t)(c + 1) * (16384 * 128); P9_LOAD(wA, 0); }
                P9_UP4(wB, jb + 1);
            }
#pragma unroll
            for (int q = 0; q < 8; ++q) {
                const int col = 256 * c + 4 * sub + 32 * q;
                float* op = out + (size_t)t * D + col;
                const uint2 xw = xres[q]; const float4 xv = make_float4(__uint_as_float(xw.x << 16), __uint_as_float(xw.x & 0xffff0000u), __uint_as_float(xw.y << 16), __uint_as_float(xw.y & 0xffff0000u)); const float4 gt = *(const float4*)(gt2_l + col);
                const int m = q >> 1, k0 = 2 * (q & 1);
                const int v0 = olo[4 * m + k0] - 8 * aqsum, v1 = (oraw[4 * m + k0] - olo[4 * m + k0]) >> 4, v2 = olo[4 * m + k0 + 1] - 8 * aqsum, v3 = (oraw[4 * m + k0 + 1] - olo[4 * m + k0 + 1]) >> 4;
                float4 r;
                r.x = xv.x + gt.x * ((float)v0 * ascale); r.y = xv.y + gt.y * ((float)v1 * ascale); r.z = xv.z + gt.z * ((float)v2 * ascale); r.w = xv.w + gt.w * ((float)v3 * ascale);
                *(float4*)op = r;
            }
        }
#undef P9_LOAD
#undef P9_UP4
#undef P9_T4
#undef P9_PERM
    }
}
}

extern "C" void kernel_launch(void* const* d_in, const int* in_sizes, int n_in, void* d_out, int out_size, void* d_ws, size_t ws_size, hipStream_t stream) {
    static int grid = 0;
    if (grid == 0) {
        int dev = 0, cus = 0, per_cu = 0;
        (void)hipGetDevice(&dev);
        (void)hipDeviceGetAttribute(&cus, hipDeviceAttributeMultiprocessorCount, dev);
        (void)hipFuncSetAttribute((const void*)mk_fwd, hipFuncAttributeMaxDynamicSharedMemorySize, LDS_BYTES);
        (void)hipOccupancyMaxActiveBlocksPerMultiprocessor(&per_cu, (const void*)mk_fwd, 512, LDS_BYTES);
        if (per_cu < 1 || cus != 256) { fprintf(stderr, "kernel_launch: needs 256 CUs with one resident workgroup each (cus %d, per_cu %d)\n", cus, per_cu); grid = -1; }
        else grid = cus;
    }
    if (grid < 0) return;
    (void)hipMemsetAsync((char*)d_ws + OFF_CTL, 0, CTL_BYTES, stream);
    Params p{};
    p.x = (const float*)d_in[0]; p.c = (const float*)d_in[1]; p.pos = (const int*)d_in[2]; p.ada_w = (const float*)d_in[3]; p.ada_b = (const float*)d_in[4];
    p.g1 = (const float*)d_in[5]; p.g2 = (const float*)d_in[6]; p.w_in = (const float*)d_in[7]; p.rgain = (const float*)d_in[8]; p.qg = (const float*)d_in[9];
    p.kg = (const float*)d_in[10]; p.og = (const float*)d_in[11]; p.w_out = (const float*)d_in[12]; p.wq = (const float*)d_in[13]; p.sk = (const float*)d_in[14];
    p.down = (const float*)d_in[15]; p.up = (const float*)d_in[16]; p.out = (float*)d_out; p.ws = (unsigned char*)d_ws;
    for (int i = 0; i < 32; ++i) {
        const double f = pow(10000.0, -(double)i / 32.0) / 6.283185307179586476925;
        float fh = (float)f; unsigned ub; memcpy(&ub, &fh, 4); ub &= 0xFFFFC000u; memcpy(&fh, &ub, 4);
        p.rc.fh[i] = fh; p.rc.fl[i] = (float)(f - (double)fh);
    }
    void* args[] = {&p};
    hipError_t e = hipLaunchCooperativeKernel((const void*)mk_fwd, dim3(grid), dim3(512), args, LDS_BYTES, stream);
    if (e != hipSuccess) fprintf(stderr, "kernel_launch: cooperative launch failed: %s (grid %d)\n", hipGetErrorString(e), grid);
}
```
